# Optimizing an MI355X kernel written in HIP

```python
import math
import jax
import jax.numpy as jnp
from jax import lax
import numpy as np

D_MODEL = 1024
BATCH = 8
SEQ = 2048
DEPTH = 2

CHUNK = 64
N_MEM = 256
NORM_EPS = 1e-6
GROUP_NORM_EPS = 64e-5

A_HEAD_DIM = 128
A_WIDTH = D_MODEL // 2
A_HEADS = A_WIDTH // A_HEAD_DIM
CONV_WIDTH = 4
A_COLS = 4 * A_WIDTH + 2 * A_HEADS

B_HEAD_DIM = 64
B_WIDTH = D_MODEL // 2
B_HEADS = B_WIDTH // B_HEAD_DIM
B_DECAY_LORA = 64
B_ICLR_LORA = 64
B_GATE_LORA = 128
B_COLS = 3 * B_WIDTH + B_DECAY_LORA + B_ICLR_LORA + B_GATE_LORA
B_SPLIT_IDX = (B_WIDTH, 2 * B_WIDTH, 3 * B_WIDTH, 3 * B_WIDTH + B_DECAY_LORA,
               3 * B_WIDTH + B_DECAY_LORA + B_ICLR_LORA)
AB_COLS = A_COLS + B_COLS
MIX_WIDTH_AB = A_WIDTH + B_WIDTH

C_KEY_DIM = 128
C_HEADS = D_MODEL // C_KEY_DIM
C_VAL_DIM = D_MODEL // C_HEADS
C_KEY_WIDTH = C_HEADS * C_KEY_DIM
C_VAL_WIDTH = C_HEADS * C_VAL_DIM
C_COLS = 2 * C_KEY_WIDTH + 2 * C_VAL_WIDTH

XA_HEADS = 4
XA_HEAD_DIM = D_MODEL // XA_HEADS

N_GROUPS = 4
EXPERTS_PER_GROUP = 4
N_EXPERTS = N_GROUPS * EXPERTS_PER_GROUP
TOP_K_IN_GROUP = 2
EXPERT_FF = D_MODEL // 4

N_EVEN = (DEPTH + 1) // 2
N_ODD = DEPTH // 2

kernel_name = 'hybrid_gdn_rwkv7_hgrn2_hmoe_encoder'

F32 = jnp.float32


def rms_norm(x, gain):
    xf = x.astype(F32)
    y = xf * lax.rsqrt(jnp.mean(xf * xf, axis=-1, keepdims=True) + NORM_EPS)
    return (y * gain.astype(F32)).astype(x.dtype)


def layer_norm(x, gain, bias, eps):
    xf = x.astype(F32)
    mu = jnp.mean(xf, axis=-1, keepdims=True)
    var = jnp.mean(jnp.square(xf - mu), axis=-1, keepdims=True)
    return ((xf - mu) * lax.rsqrt(var + eps) * gain.astype(F32) + bias.astype(F32)).astype(x.dtype)


def l2_normalize(x):
    xf = x.astype(F32)
    return (xf * lax.rsqrt(jnp.sum(xf * xf, axis=-1, keepdims=True) + 1e-6)).astype(x.dtype)


def causal_short_conv(x, w):
    return lax.conv_general_dilated(
        x, w[:, None, :].astype(x.dtype), window_strides=(1,),
        padding=[(w.shape[0] - 1, 0)], dimension_numbers=('NWC', 'WIO', 'NWC'),
        feature_group_count=x.shape[-1])


def token_shift_lerp(p, mu):
    prev = jnp.pad(p, ((0, 0), (1, 0), (0, 0)))[:, :-1]
    return p + mu.astype(p.dtype) * (prev - p)


def split_heads(t, n_heads, head_dim):
    b, s, _ = t.shape
    return t.reshape(b, s, n_heads, head_dim).transpose(0, 2, 1, 3).astype(F32)


def gated_delta_rule_chunked(q, k, v, log_alpha, beta):
    b, h, s, dk = q.shape
    dv = v.shape[-1]
    nc = s // CHUNK
    q = q.reshape(b, h, nc, CHUNK, dk)
    k = k.reshape(b, h, nc, CHUNK, dk)
    v = v.reshape(b, h, nc, CHUNK, dv)
    beta = beta.reshape(b, h, nc, CHUNK)
    g = jnp.cumsum(log_alpha.reshape(b, h, nc, CHUNK), axis=-1)
    idx = jnp.arange(CHUNK)
    incl = idx[:, None] >= idx[None, :]
    strict = idx[:, None] > idx[None, :]
    decay = jnp.exp(jnp.where(incl, g[..., :, None] - g[..., None, :], -jnp.inf))
    k_beta = k * beta[..., None]
    a_low = jnp.where(strict, jnp.einsum('bhnid,bhnjd->bhnij', k_beta, k) * decay, 0.0)
    m = a_low + jnp.eye(CHUNK, dtype=F32)
    rhs = jnp.concatenate([v * beta[..., None], k_beta * jnp.exp(g)[..., None]], axis=-1)
    sol = lax.linalg.triangular_solve(m, rhs, left_side=True, lower=True, unit_diagonal=True)
    u, w = sol[..., :dv], sol[..., dv:]
    qk = jnp.einsum('bhnid,bhnjd->bhnij', q, k) * decay
    q_dec = q * jnp.exp(g)[..., None]
    k_dec = k * jnp.exp(g[..., -1:] - g)[..., None]
    g_last = jnp.exp(g[..., -1])

    def step(state, inp):
        qk_c, qd_c, w_c, u_c, kd_c, gl_c = inp
        v_new = u_c - jnp.einsum('bhcd,bhde->bhce', w_c, state)
        o = jnp.einsum('bhcd,bhde->bhce', qd_c, state) + jnp.einsum('bhij,bhje->bhie', qk_c, v_new)
        state = state * gl_c[..., None, None] + jnp.einsum('bhcd,bhce->bhde', kd_c, v_new)
        return state, o

    xs = tuple(jnp.moveaxis(t, 2, 0) for t in (qk, q_dec, w, u, k_dec, g_last))
    _, o = lax.scan(step, jnp.zeros((b, h, dk, dv), F32), xs)
    return jnp.moveaxis(o, 0, 2).reshape(b, h, s, dv)


def rwkv7_recurrence(r, w, k, v, kk, a):
    b, _, h, n = r.shape

    def step(state, inp):
        r_t, w_t, k_t, v_t, kk_t, a_t = inp
        sa = jnp.einsum('bhvk,bhk->bhv', state, -kk_t)
        state = (state * w_t[:, :, None, :] + sa[..., None] * (kk_t * a_t)[:, :, None, :]
                 + v_t[..., None] * k_t[:, :, None, :])
        return state, jnp.einsum('bhvk,bhk->bhv', state, r_t)

    xs = tuple(jnp.moveaxis(t, 1, 0) for t in (r, w, k, v, kk, a))
    _, o = lax.scan(step, jnp.zeros((b, h, n, n), F32), xs)
    return jnp.moveaxis(o, 0, 1)


def hgrn2_chunked(q, k, v, log_f):
    b, h, s, dk = q.shape
    dv = v.shape[-1]
    nc = s // CHUNK

    def to_chunks(t):
        return jnp.moveaxis(t.reshape(b, h, nc, CHUNK, t.shape[-1]), 2, 0)

    qc, kc, vc = to_chunks(q), to_chunks(k), to_chunks(v)
    gc = jnp.cumsum(to_chunks(log_f), axis=3)
    idx = jnp.arange(CHUNK)
    incl = (idx[:, None] >= idx[None, :])[:, :, None]

    def step(state, inp):
        q_c, k_c, v_c, g_c = inp
        g_last = g_c[:, :, -1:, :]
        dec = jnp.exp(jnp.where(incl, g_c[:, :, :, None, :] - g_c[:, :, None, :, :], -jnp.inf))
        scores = jnp.einsum('bhid,bhjd,bhijd->bhij', q_c, k_c, dec)
        o = (jnp.einsum('bhid,bhde->bhie', q_c * jnp.exp(g_c), state)
             + jnp.einsum('bhij,bhje->bhie', scores, v_c))
        state = (state * jnp.exp(g_last)[:, :, 0, :, None]
                 + jnp.einsum('bhjd,bhje->bhde', k_c * jnp.exp(g_last - g_c), v_c))
        return state, o

    _, o = lax.scan(step, jnp.zeros((b, h, dk, dv), F32), (qc, kc, vc, gc))
    return jnp.moveaxis(o, 0, 2).reshape(b, h, s, dv)


def deltanet_rwkv_mixer(h, w_in, conv_w, a_log, dt_bias, onorm_a, shift_mu, w0, w2, a0, a2, g2,
                        k_k, k_a, r_k, ln_w, ln_b, w_out):
    bsz, s, _ = h.shape
    proj = h @ w_in
    p_a, p_b = proj[..., :A_COLS], proj[..., A_COLS:]

    qkv = jax.nn.silu(causal_short_conv(p_a[..., :3 * A_WIDTH], conv_w))
    q, k, v = jnp.split(qkv, 3, axis=-1)
    gate_a = p_a[..., 3 * A_WIDTH:4 * A_WIDTH].astype(F32)
    decay_in = p_a[..., 4 * A_WIDTH:4 * A_WIDTH + A_HEADS].astype(F32)
    beta_in = p_a[..., 4 * A_WIDTH + A_HEADS:].astype(F32)
    q = l2_normalize(split_heads(q, A_HEADS, A_HEAD_DIM)) * (A_HEAD_DIM ** -0.5)
    k = l2_normalize(split_heads(k, A_HEADS, A_HEAD_DIM))
    v = split_heads(v, A_HEADS, A_HEAD_DIM)
    log_alpha = (-jnp.exp(a_log.astype(F32)) * jax.nn.softplus(decay_in + dt_bias.astype(F32))).transpose(0, 2, 1)
    beta = jax.nn.sigmoid(beta_in).transpose(0, 2, 1)
    o_a = gated_delta_rule_chunked(q, k, v, log_alpha, beta).transpose(0, 2, 1, 3)
    o_a = rms_norm(o_a, onorm_a) * jax.nn.silu(gate_a.reshape(bsz, s, A_HEADS, A_HEAD_DIM))
    o_a = o_a.reshape(bsz, s, A_WIDTH)

    p_b = token_shift_lerp(p_b, shift_mu)
    r, kb, vb, wl, al, gl = jnp.split(p_b, B_SPLIT_IDX, axis=-1)
    hd = (bsz, s, B_HEADS, B_HEAD_DIM)
    w_raw = (w0 + jnp.tanh(wl) @ w2).astype(F32)
    decay_b = jnp.exp(-jnp.exp(-jax.nn.softplus(-w_raw) - 0.5)).reshape(hd)
    iclr = jax.nn.sigmoid((a0 + al @ a2).astype(F32)).reshape(hd)
    gate_b = (jax.nn.sigmoid(gl) @ g2).astype(F32)
    r = r.astype(F32).reshape(hd)
    kb = kb.astype(F32).reshape(hd)
    vb = vb.astype(F32).reshape(hd)
    kk = l2_normalize(kb * k_k.astype(F32).reshape(B_HEADS, B_HEAD_DIM))
    kb = kb * (1.0 + (iclr - 1.0) * k_a.astype(F32).reshape(B_HEADS, B_HEAD_DIM))
    o_b = rwkv7_recurrence(r, decay_b, kb, vb, kk, iclr)
    o_b = layer_norm(o_b, ln_w.reshape(B_HEADS, B_HEAD_DIM), ln_b.reshape(B_HEADS, B_HEAD_DIM), GROUP_NORM_EPS)
    o_b = o_b + jnp.sum(r * kb * r_k.astype(F32), axis=-1, keepdims=True) * vb
    o_b = o_b.reshape(bsz, s, B_WIDTH) * gate_b

    o = jnp.concatenate([o_a, o_b], axis=-1).astype(h.dtype)
    return o @ w_out


def hgrn_lower_bounds(lb_param):
    p = jax.nn.softmax(lb_param.astype(F32), axis=0)
    return jnp.cumsum(p, axis=0) - p[0]


def hgrn2_mixer(h, w_in, lower_bound, onorm, w_out):
    bsz, s, _ = h.shape
    proj = h @ w_in
    q = proj[..., :C_KEY_WIDTH]
    f = proj[..., C_KEY_WIDTH:2 * C_KEY_WIDTH]
    i = proj[..., 2 * C_KEY_WIDTH:2 * C_KEY_WIDTH + C_VAL_WIDTH]
    g = proj[..., 2 * C_KEY_WIDTH + C_VAL_WIDTH:]
    q = jax.nn.silu(q.astype(F32))
    lb = lower_bound.astype(F32)
    log_f = jnp.logaddexp(jnp.log(lb), jnp.log1p(-lb) + jax.nn.log_sigmoid(f.astype(F32)))
    k = -jnp.expm1(log_f)
    o = hgrn2_chunked(split_heads(q, C_HEADS, C_KEY_DIM), split_heads(k, C_HEADS, C_KEY_DIM),
                      split_heads(i, C_HEADS, C_VAL_DIM), split_heads(log_f, C_HEADS, C_KEY_DIM))
    o = rms_norm(o.transpose(0, 2, 1, 3), onorm) * jax.nn.silu(g.astype(F32).reshape(bsz, s, C_HEADS, C_VAL_DIM))
    return o.reshape(bsz, s, C_VAL_WIDTH).astype(h.dtype) @ w_out


def memory_cross_attention(h, mem_n, wq, wkv, wo):
    bsz, s, d = h.shape
    m = mem_n.shape[1]
    q = (h @ wq).reshape(bsz, s, XA_HEADS, XA_HEAD_DIM)
    k, v = jnp.split(mem_n @ wkv, 2, axis=-1)
    k = k.reshape(bsz, m, XA_HEADS, XA_HEAD_DIM)
    v = v.reshape(bsz, m, XA_HEADS, XA_HEAD_DIM)
    scores = jnp.einsum('bthd,bmhd->bhtm', q, k).astype(F32) * (XA_HEAD_DIM ** -0.5)
    p = jax.nn.softmax(scores, axis=-1).astype(v.dtype)
    o = jnp.einsum('bhtm,bmhd->bthd', p, v).reshape(bsz, s, d)
    return o @ wo


def hierarchical_moe(h, w_group, b_group, w_expert, b_expert, w1, w3, w2):
    bsz, s, d = h.shape
    x = h.reshape(bsz * s, d)
    group_logits = (x @ w_group + b_group).astype(F32)
    group_prob = jax.nn.softmax(group_logits, axis=-1)
    group_sel = jnp.argmax(group_logits, axis=-1)
    group_gate = jnp.take_along_axis(group_prob, group_sel[:, None], axis=-1)
    expert_logits = (x @ w_expert + b_expert).astype(F32).reshape(-1, N_GROUPS, EXPERTS_PER_GROUP)
    in_group = jnp.take_along_axis(expert_logits, group_sel[:, None, None], axis=1)[:, 0]
    top_p, top_i = lax.top_k(jax.nn.softmax(in_group, axis=-1), TOP_K_IN_GROUP)
    gates = group_gate * top_p / jnp.sum(top_p, axis=-1, keepdims=True)
    expert_id = group_sel[:, None] * EXPERTS_PER_GROUP + top_i
    combine = jnp.einsum('nk,nke->ne', gates, jax.nn.one_hot(expert_id, N_EXPERTS, dtype=F32))
    hid = jax.nn.silu(jnp.einsum('nd,edf->nef', x, w1)) * jnp.einsum('nd,edf->nef', x, w3)
    hid = hid * combine[:, :, None].astype(hid.dtype)
    y = jnp.einsum('nef,efd->nd', hid, w2)
    return y.reshape(bsz, s, d)


def setup_inputs(seed: int = 0) -> dict:
    key = jax.random.key(seed)
    ks = iter(jax.random.split(key, 64))

    def nrm(shape, scale):
        return jax.random.normal(next(ks), shape, F32) * scale

    def uni(shape, lo, hi):
        return jax.random.uniform(next(ks), shape, F32, lo, hi)

    d = D_MODEL
    ne, no = N_EVEN, N_ODD
    dt = jnp.exp(uni((ne, A_HEADS), math.log(1e-3), math.log(1e-1)))
    return {
        'x': nrm((BATCH, SEQ, d), 1.0),
        'mem': nrm((BATCH, N_MEM, d), 1.0),
        'norm_mix': 1.0 + nrm((DEPTH, d), 0.02),
        'norm_xattn': 1.0 + nrm((DEPTH, d), 0.02),
        'norm_mem': 1.0 + nrm((DEPTH, d), 0.02),
        'norm_ffn': 1.0 + nrm((DEPTH, d), 0.02),
        'norm_final': 1.0 + nrm((d,), 0.02),
        'ab_w_in': nrm((ne, d, AB_COLS), d ** -0.5),
        'ab_conv': nrm((ne, CONV_WIDTH, 3 * A_WIDTH), CONV_WIDTH ** -0.5),
        'ab_a_log': jnp.log(uni((ne, A_HEADS), 1.0, 16.0)),
        'ab_dt_bias': dt + jnp.log(-jnp.expm1(-dt)),
        'ab_onorm': 1.0 + nrm((ne, A_HEAD_DIM), 0.02),
        'ab_shift_mu': uni((ne, B_COLS), 0.0, 1.0),
        'ab_w0': uni((ne, B_WIDTH), -3.0, 1.0),
        'ab_w2': nrm((ne, B_DECAY_LORA, B_WIDTH), 0.5 * B_DECAY_LORA ** -0.5),
        'ab_a0': nrm((ne, B_WIDTH), 0.5),
        'ab_a2': nrm((ne, B_ICLR_LORA, B_WIDTH), B_ICLR_LORA ** -0.5),
        'ab_g2': nrm((ne, B_GATE_LORA, B_WIDTH), B_GATE_LORA ** -0.5),
        'ab_k_k': 0.85 + nrm((ne, B_WIDTH), 0.05),
        'ab_k_a': 1.0 + nrm((ne, B_WIDTH), 0.05),
        'ab_r_k': nrm((ne, B_HEADS, B_HEAD_DIM), 0.1),
        'ab_ln_w': 1.0 + nrm((ne, B_WIDTH), 0.02),
        'ab_ln_b': nrm((ne, B_WIDTH), 0.02),
        'ab_w_out': nrm((ne, MIX_WIDTH_AB, d), 0.5 * MIX_WIDTH_AB ** -0.5),
        'c_w_in': nrm((no, d, C_COLS), d ** -0.5),
        'c_lb_param': nrm((DEPTH, C_KEY_WIDTH), 0.5),
        'c_onorm': 1.0 + nrm((no, C_VAL_DIM), 0.02),
        'c_w_out': nrm((no, C_VAL_WIDTH, d), 0.5 * C_VAL_WIDTH ** -0.5),
        'xa_wq': nrm((DEPTH, d, d), d ** -0.5),
        'xa_wkv': nrm((DEPTH, d, 2 * d), d ** -0.5),
        'xa_wo': nrm((DEPTH, d, d), 0.5 * d ** -0.5),
        'moe_w_group': nrm((DEPTH, d, N_GROUPS), d ** -0.5),
        'moe_b_group': nrm((DEPTH, N_GROUPS), 0.01),
        'moe_w_expert': nrm((DEPTH, d, N_EXPERTS), d ** -0.5),
        'moe_b_expert': nrm((DEPTH, N_EXPERTS), 0.01),
        'moe_w1': nrm((DEPTH, N_EXPERTS, d, EXPERT_FF), d ** -0.5),
        'moe_w3': nrm((DEPTH, N_EXPERTS, d, EXPERT_FF), d ** -0.5),
        'moe_w2': nrm((DEPTH, N_EXPERTS, EXPERT_FF, d), EXPERT_FF ** -0.5),
    }


def reference(x, mem, norm_mix, norm_xattn, norm_mem, norm_ffn, norm_final,
              ab_w_in, ab_conv, ab_a_log, ab_dt_bias, ab_onorm, ab_shift_mu, ab_w0, ab_w2,
              ab_a0, ab_a2, ab_g2, ab_k_k, ab_k_a, ab_r_k, ab_ln_w, ab_ln_b, ab_w_out,
              c_w_in, c_lb_param, c_onorm, c_w_out,
              xa_wq, xa_wkv, xa_wo,
              moe_w_group, moe_b_group, moe_w_expert, moe_b_expert, moe_w1, moe_w3, moe_w2):
    lower_bounds = hgrn_lower_bounds(c_lb_param)
    for layer in range(DEPTH):
        h = rms_norm(x, norm_mix[layer])
        if layer % 2 == 0:
            e = layer // 2
            mix = deltanet_rwkv_mixer(h, ab_w_in[e], ab_conv[e], ab_a_log[e], ab_dt_bias[e], ab_onorm[e],
                                      ab_shift_mu[e], ab_w0[e], ab_w2[e], ab_a0[e], ab_a2[e], ab_g2[e],
                                      ab_k_k[e], ab_k_a[e], ab_r_k[e], ab_ln_w[e], ab_ln_b[e], ab_w_out[e])
        else:
            o = layer // 2
            mix = hgrn2_mixer(h, c_w_in[o], lower_bounds[layer], c_onorm[o], c_w_out[o])
        x = x + mix.astype(x.dtype)
        xa = memory_cross_attention(rms_norm(x, norm_xattn[layer]), rms_norm(mem, norm_mem[layer]),
                                    xa_wq[layer], xa_wkv[layer], xa_wo[layer])
        x = x + xa.astype(x.dtype)
        ff = hierarchical_moe(rms_norm(x, norm_ffn[layer]), moe_w_group[layer], moe_b_group[layer],
                              moe_w_expert[layer], moe_b_expert[layer], moe_w1[layer], moe_w3[layer],
                              moe_w2[layer])
        x = x + ff.astype(x.dtype)
    return rms_norm(x, norm_final)
```

```cpp
#include <hip/hip_runtime.h>
#include <cstdio>
#include <cstdint>

#ifndef N_LAUNCH_MODE
#define N_LAUNCH_MODE 0
#endif

#define LAS __attribute__((address_space(3)))
#define GAS __attribute__((address_space(1)))
typedef unsigned short bf16_t;
typedef short bf16x8 __attribute__((ext_vector_type(8)));
typedef short bf16x4 __attribute__((ext_vector_type(4)));
typedef float f32x4 __attribute__((ext_vector_type(4)));
typedef float f32x2 __attribute__((ext_vector_type(2)));
typedef unsigned u32x4 __attribute__((ext_vector_type(4)));
typedef unsigned u32x2 __attribute__((ext_vector_type(2)));

constexpr int NT = 16384, DM = 1024, NB = 8, TS = 2048, NMEM = 256;
constexpr int P0LD = 3840;
constexpr int P1LD = 4096;
constexpr int NTHREADS = 512, NWAVES = 8;

constexpr size_t MiB = 1048576;
constexpr size_t WS_CTL = 0;
constexpr size_t WS_CNT = 16384;
constexpr size_t WS_LB = 32768;
constexpr size_t WS_DB = 1 * MiB;
constexpr size_t WS_SSP = WS_DB + 512 * 1024;
constexpr size_t WS_MEMH = WS_SSP + 1 * MiB;
constexpr size_t WS_ROUTE = WS_MEMH + 4 * MiB;
constexpr size_t WS_W0 = 8 * MiB;
constexpr size_t WS_W1 = WS_W0 + 42 * MiB;
constexpr size_t WS_XB = 92 * MiB;
constexpr size_t WS_BIG = 124 * MiB;
constexpr size_t WS_END = 256 * MiB;
constexpr size_t WO_WIN = 0;
constexpr size_t WO_WOUT = WO_WIN + (size_t)4096 * 1024;
constexpr size_t WO_WQ = WO_WOUT + (size_t)1024 * 1024;
constexpr size_t WO_WKV = WO_WQ + (size_t)1024 * 1024;
constexpr size_t WO_WO = WO_WKV + (size_t)2048 * 1024;
constexpr size_t WO_W13 = WO_WO + (size_t)1024 * 1024;
constexpr size_t WO_W2T = WO_W13 + (size_t)16 * 512 * 1024;
constexpr size_t WO_END = WO_W2T + (size_t)16 * 1024 * 256;
static_assert(WO_END * 2 <= 42 * MiB, "weight region");
constexpr size_t BIG_PROJ = 0;
constexpr size_t BIG_KV0 = 120 * MiB;
constexpr size_t BIG_Q = 0;
constexpr size_t BIG_ATT = 32 * MiB;
constexpr size_t BIG_XG = 0;
constexpr size_t BIG_HID = 48 * MiB;
constexpr int MOE_MAXROWS = 22528;

__device__ __forceinline__ unsigned f2bf(float f) { unsigned u = __float_as_uint(f); u += 0x7fffu + ((u >> 16) & 1u); return u >> 16; }
__device__ __forceinline__ float bf2f(unsigned short b) { return __uint_as_float((unsigned)b << 16); }
__device__ __forceinline__ unsigned pk2(float lo, float hi) { return f2bf(lo) | (f2bf(hi) << 16); }
__device__ __forceinline__ float wave_sum(float v) {
#pragma unroll
    for (int o = 1; o < 64; o <<= 1) v += __shfl_xor(v, o);
    return v;
}
__device__ __forceinline__ float sigmoidf_(float x) { return 1.f / (1.f + __expf(-x)); }
__device__ __forceinline__ float siluf_(float x) { return x / (1.f + __expf(-x)); }
__device__ __forceinline__ float softplusf_(float x) { return x > 20.f ? x : log1pf(__expf(x)); }
__device__ __forceinline__ int lane_id_v() { int l; asm volatile("v_mbcnt_lo_u32_b32 %0, -1, 0\n\tv_mbcnt_hi_u32_b32 %0, -1, %0" : "=v"(l)); return l; }
#define LDS_WAIT() asm volatile("s_waitcnt lgkmcnt(0)" ::: "memory")
#define VM_WAIT() asm volatile("s_waitcnt vmcnt(0)" ::: "memory")

namespace pg8 {
constexpr int BM = 256, BK = 64, HALF = 128, HTB = HALF * BK * 2, STAGE_BYTES = 8 * HTB;
__host__ __device__ __forceinline__ int lds_byte(int r, int c) { const int st = (r >> 4) * 2 + (c >> 5), rr = r & 15, cc = c & 31, ob = rr * 64 + cc * 2; return st * 1024 + (ob ^ (((ob >> 9) & 1) << 5)); }
__host__ __device__ __forceinline__ void stage_rc(int b, int& R, int& C) { const int st = b / 1024, sb = b % 1024, swz = sb ^ (((sb >> 9) & 1) << 5); R = (st >> 1) * 16 + swz / 64; C = (st & 1) * 32 + (swz % 64) / 2; }

struct Unit { int pm, pn, aux; const char* a; const char* b0; const char* b1; };
struct Gemm { int lda, ldb, K, ksplit; };

template <class Epi, class Sched>
__device__ __forceinline__ void gemm_phase(LAS unsigned char* lds, const int wave_in, const Gemm g, const Sched& S, const Epi& E) {
    const int wid = wave_in, lane = lane_id_v(), tid = wid * 64 + lane, wr = wid >> 2, wc = wid & 3, fr = lane & 15, fq = lane >> 4;
    const int K = g.K, nt = K / BK, ks = g.ksplit;
    unsigned voffA[2], voffB[2];
#pragma unroll
    for (int i = 0; i < 2; ++i) { int R, C; stage_rc(tid * 16 + i * 8192, R, C);
        voffA[i] = (unsigned)(R * g.lda + C) * 2u; voffB[i] = (unsigned)(R * g.ldb + C) * 2u; }
    const size_t kstep = (size_t)(BK * 2);
    const size_t hstepA = (size_t)HALF * g.lda * 2, hstepB = (size_t)HALF * g.ldb * 2;
    const unsigned ldsw = (unsigned)wid * 1024u;
    const int aoff = lds_byte(wr * 64 + fr, fq * 8), boff = lds_byte(wc * 32 + fr, fq * 8);
#define PG8_SA(b, h) (((b) * 2 + (h)) * HTB)
#define PG8_SB(b, h) ((4 + (b) * 2 + (h)) * HTB)
#define PG8_STAGE(bufoff, gbase, voff) do { _Pragma("unroll") for (int _i = 0; _i < 2; ++_i) \
        __builtin_amdgcn_global_load_lds((const unsigned*)((const char*)(gbase) + (voff)[_i]), (LAS unsigned*)(lds + (bufoff) + ldsw + _i * 8192), 16, 0, 0); } while (0)
#define PG8_LDA(dst, b, h) do { _Pragma("unroll") for (int m = 0; m < 4; ++m) _Pragma("unroll") for (int k = 0; k < 2; ++k) dst[m][k] = *(const LAS bf16x8*)(lds + PG8_SA(b, h) + aoff + m * 2048 + k * 1024); } while (0)
#define PG8_LDB(dst, b, h) do { _Pragma("unroll") for (int n = 0; n < 2; ++n) _Pragma("unroll") for (int k = 0; k < 2; ++k) dst[n][k] = *(const LAS bf16x8*)(lds + PG8_SB(b, h) + boff + n * 2048 + k * 1024); } while (0)
#define PG8_MMA(ai, bj, At, Bt) do { __builtin_amdgcn_s_setprio(1); _Pragma("unroll") for (int m = 0; m < 4; ++m) _Pragma("unroll") for (int n = 0; n < 2; ++n) _Pragma("unroll") for (int k = 0; k < 2; ++k) \
        acc[ai][bj][m][n] = __builtin_amdgcn_mfma_f32_16x16x32_bf16(Bt[n][k], At[m][k], acc[ai][bj][m][n], 0, 0, 0); __builtin_amdgcn_s_setprio(0); } while (0)
#define PG8_WAIT_V(n) asm volatile("s_waitcnt vmcnt(" #n ")" ::: "memory")
#define PG8_WAIT_L(n) asm volatile("s_waitcnt lgkmcnt(" #n ")" ::: "memory")
#define PG8_BAR __builtin_amdgcn_s_barrier()
#define PG8_SCHED __builtin_amdgcn_sched_barrier(0)
    Unit cur, nxt; int ui = 0;
    if (!S.next(0, cur)) return;
    f32x4 acc[2][2][4][2];
#pragma unroll
    for (int a = 0; a < 2; ++a)
#pragma unroll
        for (int b = 0; b < 2; ++b)
#pragma unroll
            for (int m = 0; m < 4; ++m)
#pragma unroll
                for (int n = 0; n < 2; ++n) acc[a][b][m][n] = (f32x4){0.f, 0.f, 0.f, 0.f};
    bf16x8 At[4][2], B0[2][2], B1[2][2];
    const char* cA = cur.a; const char* cB = cur.b0; const char* cB1 = cur.b1;
    PG8_STAGE(PG8_SB(0, 0), cB, voffB); PG8_STAGE(PG8_SB(0, 1), cB + hstepB, voffB); PG8_STAGE(PG8_SA(0, 0), cA, voffA); PG8_STAGE(PG8_SA(0, 1), cA + hstepA, voffA);
    if (wr == 1) PG8_BAR;
    PG8_WAIT_V(2); PG8_BAR;
    PG8_STAGE(PG8_SB(1, 0), cB + kstep, voffB); PG8_STAGE(PG8_SA(1, 0), cA + kstep, voffA); PG8_STAGE(PG8_SB(1, 1), cB + hstepB + kstep, voffB);
    PG8_WAIT_V(6); PG8_BAR;
    for (;;) {
        const bool has_next = S.next(ui + 1, nxt);
        const char* nA = has_next ? nxt.a : cA; const char* nB = has_next ? nxt.b0 : cB;
        for (int t = 0; t < nt; t += 2) {
            const bool last = (t == nt - 2);
            const char* a1 = cA + (size_t)(t + 1) * kstep;
            const char* a2 = last ? nA : cA + (size_t)(t + 2) * kstep;
            const char* b2 = last ? nB : ((t + 2) < ks ? cB + (size_t)(t + 2) * kstep : cB1 + (size_t)(t + 2 - ks) * kstep);
            const char* a3 = a2 + kstep; const char* b3 = b2 + kstep;
            PG8_LDB(B0, 0, 0); PG8_LDB(B1, 0, 1); PG8_SCHED; PG8_LDA(At, 0, 0); PG8_STAGE(PG8_SA(1, 1), a1 + hstepA, voffA);
            PG8_WAIT_V(8); PG8_WAIT_L(0); PG8_BAR; PG8_MMA(0, 0, At, B0); PG8_MMA(0, 1, At, B1); PG8_BAR; PG8_SCHED;
            PG8_LDA(At, 0, 1); PG8_STAGE(PG8_SB(0, 0), b2, voffB); PG8_STAGE(PG8_SB(0, 1), b2 + hstepB, voffB); PG8_STAGE(PG8_SA(0, 0), a2, voffA);
            PG8_WAIT_V(8); PG8_WAIT_L(0); PG8_BAR; PG8_MMA(1, 0, At, B0); PG8_MMA(1, 1, At, B1); PG8_BAR; PG8_SCHED;
            PG8_LDB(B0, 1, 0); PG8_LDB(B1, 1, 1); PG8_SCHED; PG8_LDA(At, 1, 0); PG8_STAGE(PG8_SA(0, 1), a2 + hstepA, voffA);
            PG8_WAIT_V(8); PG8_WAIT_L(0); PG8_BAR; PG8_MMA(0, 0, At, B0); PG8_MMA(0, 1, At, B1); PG8_BAR; PG8_SCHED;
            PG8_LDA(At, 1, 1); PG8_STAGE(PG8_SB(1, 0), b3, voffB); PG8_STAGE(PG8_SB(1, 1), b3 + hstepB, voffB); PG8_STAGE(PG8_SA(1, 0), a3, voffA);
            PG8_WAIT_V(8); PG8_WAIT_L(0); PG8_BAR; PG8_MMA(1, 0, At, B0); PG8_MMA(1, 1, At, B1); PG8_BAR; PG8_SCHED;
        }
        if (wr == 0) PG8_BAR;
        E(acc, cur, wr, wc, fr, fq);
        if (!has_next) break;
#pragma unroll
        for (int a = 0; a < 2; ++a)
#pragma unroll
            for (int b = 0; b < 2; ++b)
#pragma unroll
                for (int m = 0; m < 4; ++m)
#pragma unroll
                    for (int n = 0; n < 2; ++n) acc[a][b][m][n] = (f32x4){0.f, 0.f, 0.f, 0.f};
        cur = nxt; cA = nA; cB = nB; cB1 = nxt.b1; ++ui;
        if (wr == 1) PG8_BAR;
    }
    PG8_WAIT_V(0);
    PG8_BAR;
#undef PG8_SA
#undef PG8_SB
#undef PG8_STAGE
#undef PG8_LDA
#undef PG8_LDB
#undef PG8_MMA
#undef PG8_WAIT_V
#undef PG8_WAIT_L
#undef PG8_BAR
#undef PG8_SCHED
}

struct DenseSched {
    int nM, nN, nwg, G, c; const char* A; const char* B; size_t tA, tB;
    __device__ void init(int M, int N, int G_, int c_, const bf16_t* A_, int lda, const bf16_t* B_, int ldb) { nM = M / 256; nN = N / 256; nwg = nM * nN; G = G_; c = c_; A = (const char*)A_; B = (const char*)B_; tA = (size_t)256 * lda * 2; tB = (size_t)256 * ldb * 2; }
    __device__ bool next(int i, Unit& u) const {
        const long L = (long)i * G + c; if (L >= nwg) return false;
        int wgid = (int)L; { const int q = nwg / 8, r = nwg % 8, xcd = wgid % 8, off = wgid / 8; wgid = (xcd < r ? xcd * (q + 1) : r * (q + 1) + (xcd - r) * q) + off; }
        const int nig = 8 * nN, gid = wgid / nig, fm = gid * 8, gsz = (nM - fm) < 8 ? (nM - fm) : 8;
        u.pm = fm + ((wgid % nig) % gsz); u.pn = (wgid % nig) / gsz; u.aux = 256;
        u.a = A + (size_t)u.pm * tA; u.b0 = B + (size_t)u.pn * tB; u.b1 = u.b0; return true;
    }
};
}
using pg8::Unit;

__device__ __forceinline__ float row_rstd(const float* ssp, int row) {
    const f32x4* p = (const f32x4*)(ssp + (size_t)row * 16);
    const f32x4 a = p[0], b = p[1], c = p[2], d = p[3];
    const float s = ((a.x + a.y) + (a.z + a.w)) + ((b.x + b.y) + (b.z + b.w)) + ((c.x + c.y) + (c.z + c.w)) + ((d.x + d.y) + (d.z + d.w));
    return 1.0f / sqrtf(s * (1.0f / 1024.0f) + 1e-6f);
}
__device__ __forceinline__ unsigned short f2h_bits(float f) { _Float16 h = (_Float16)f; return __builtin_bit_cast(unsigned short, h); }
__device__ __forceinline__ float h2f_bits(unsigned short b) { return (float)__builtin_bit_cast(_Float16, b); }

template <int MODE> struct EpiScale {
    bf16_t* O; int ldc; const float* ssp; float scale; const float* lb;
    __device__ __forceinline__ void operator()(const f32x4 (&acc)[2][2][4][2], const Unit& u, int wr, int wc, int fr_in, int fq_in) const {
        int fr = fr_in, fq = fq_in; asm volatile("" : "+v"(fr), "+v"(fq));
#pragma unroll
        for (int ai = 0; ai < 2; ++ai)
#pragma unroll
            for (int m = 0; m < 4; ++m) {
                const int row = u.pm * 256 + ai * 128 + wr * 64 + m * 16 + fr;
                const float rs = (MODE == 2) ? scale : row_rstd(ssp, row) * scale;
#pragma unroll
                for (int bj = 0; bj < 2; ++bj)
#pragma unroll
                    for (int n = 0; n < 2; ++n) {
                        const int col = u.pn * 256 + bj * 128 + wc * 32 + n * 16 + fq * 4;
                        f32x4 v = acc[ai][bj][m][n] * rs;
                        u32x2 w;
                        if (MODE == 1) {
                            const int blk = col >> 10;
                            if (blk == 0) { v.x = siluf_(v.x); v.y = siluf_(v.y); v.z = siluf_(v.z); v.w = siluf_(v.w); }
                            if (blk == 1) {
                                const f32x4 l = *(const f32x4*)(lb + (col - 1024));
                                float o[4]; const float vv[4] = {v.x, v.y, v.z, v.w}; const float ll[4] = {l.x, l.y, l.z, l.w};
#pragma unroll
                                for (int j = 0; j < 4; ++j) o[j] = __logf(ll[j] + (1.f - ll[j]) * sigmoidf_(vv[j]));
                                w.x = (unsigned)f2h_bits(o[0]) | ((unsigned)f2h_bits(o[1]) << 16); w.y = (unsigned)f2h_bits(o[2]) | ((unsigned)f2h_bits(o[3]) << 16);
                            } else { w.x = pk2(v.x, v.y); w.y = pk2(v.z, v.w); }
                        } else { w.x = pk2(v.x, v.y); w.y = pk2(v.z, v.w); }
                        *(u32x2*)(O + (size_t)row * ldc + col) = w;
                    }
            }
    }
};
struct EpiKV {
    bf16_t* Kb; bf16_t* VT;
    __device__ __forceinline__ void operator()(const f32x4 (&acc)[2][2][4][2], const Unit& u, int wr, int wc, int fr_in, int fq_in) const {
        int fr = fr_in, fq = fq_in; asm volatile("" : "+v"(fr), "+v"(fq));
#pragma unroll
        for (int ai = 0; ai < 2; ++ai)
#pragma unroll
            for (int m = 0; m < 4; ++m) {
                const int row = u.pm * 256 + ai * 128 + wr * 64 + m * 16 + fr;
#pragma unroll
                for (int bj = 0; bj < 2; ++bj)
#pragma unroll
                    for (int n = 0; n < 2; ++n) {
                        const int col = u.pn * 256 + bj * 128 + wc * 32 + n * 16 + fq * 4;
                        const f32x4 v = acc[ai][bj][m][n];
                        if (col < 1024) { u32x2 w; w.x = pk2(v.x, v.y); w.y = pk2(v.z, v.w); *(u32x2*)(Kb + (size_t)row * 1024 + col) = w; }
                        else {
                            const int c2 = col - 1024, h = c2 >> 8, d = c2 & 255, b = row >> 8, mm = row & 255;
                            bf16_t* p = VT + ((size_t)((b * 4 + h) * 256 + d)) * 256 + mm;
                            p[0] = (bf16_t)f2bf(v.x); p[256] = (bf16_t)f2bf(v.y); p[512] = (bf16_t)f2bf(v.z); p[768] = (bf16_t)f2bf(v.w);
                        }
                    }
            }
    }
};
template <bool SCATTER> struct EpiResid {
    const float* base; float* XF; bf16_t* XB; float* ssp; const f32x4* rowinfo;
    __device__ __forceinline__ void operator()(const f32x4 (&acc)[2][2][4][2], const Unit& u, int wr, int wc, int fr_in, int fq_in) const {
        int fr = fr_in, fq = fq_in; asm volatile("" : "+v"(fr), "+v"(fq));
#pragma unroll
        for (int ai = 0; ai < 2; ++ai)
#pragma unroll
            for (int m = 0; m < 4; ++m) {
                const int lrow = ai * 128 + wr * 64 + m * 16 + fr;
                const int row = u.pm * 256 + lrow;
                int tok = row; bool valid = true;
                if (SCATTER) { valid = lrow < u.aux; const f32x4 ri = rowinfo[row]; tok = valid ? __float_as_int(ri.w) : 0; }
                float ss = 0.f;
#pragma unroll
                for (int bj = 0; bj < 2; ++bj)
#pragma unroll
                    for (int n = 0; n < 2; ++n) {
                        const int col = u.pn * 256 + bj * 128 + wc * 32 + n * 16 + fq * 4;
                        const size_t off = (size_t)tok * 1024 + col;
                        if (valid) {
                            const f32x4 b = *(const f32x4*)(base + off);
                            const f32x4 v = b + acc[ai][bj][m][n];
                            *(f32x4*)(XF + off) = v;
                            u32x2 w; w.x = pk2(v.x, v.y); w.y = pk2(v.z, v.w); *(u32x2*)(XB + off) = w;
                            ss += (v.x * v.x + v.y * v.y) + (v.z * v.z + v.w * v.w);
                        }
                    }
                ss += __shfl_xor(ss, 16); ss += __shfl_xor(ss, 32);
                if (valid && fq == 0) ssp[(size_t)tok * 16 + u.pn * 4 + wc] = ss;
            }
    }
};
struct EpiMoeUp {
    bf16_t* HID; const f32x4* rowinfo;
    __device__ __forceinline__ void operator()(const f32x4 (&acc)[2][2][4][2], const Unit& u, int wr, int wc, int fr_in, int fq_in) const {
        int fr = fr_in, fq = fq_in; asm volatile("" : "+v"(fr), "+v"(fq));
        const int slot = u.pn >> 1, jj = u.pn & 1;
#pragma unroll
        for (int ai = 0; ai < 2; ++ai)
#pragma unroll
            for (int m = 0; m < 4; ++m) {
                const int row = u.pm * 256 + ai * 128 + wr * 64 + m * 16 + fr;
                const f32x4 ri = rowinfo[row];
                const float rs = ri.x, gt = slot ? ri.z : ri.y;
#pragma unroll
                for (int n = 0; n < 2; ++n) {
                    const f32x4 h1 = acc[ai][0][m][n] * rs, h3 = acc[ai][1][m][n] * rs;
                    const int col = slot * 256 + jj * 128 + wc * 32 + n * 16 + fq * 4;
                    u32x2 w; w.x = pk2(siluf_(h1.x) * h3.x * gt, siluf_(h1.y) * h3.y * gt); w.y = pk2(siluf_(h1.z) * h3.z * gt, siluf_(h1.w) * h3.w * gt);
                    *(u32x2*)(HID + (size_t)row * 512 + col) = w;
                }
            }
    }
};
__device__ __forceinline__ void pair_experts(int bucket, int& ea, int& eb) {
    const int g = bucket / 6, p = bucket % 6;
    const int i = (p < 3) ? 0 : (p < 5 ? 1 : 2);
    const int j = (p < 3) ? p + 1 : (p < 5 ? p - 1 : 3);
    ea = g * 4 + i; eb = g * 4 + j;
}
template <bool DOWN> struct MoeSched {
    const LAS int* tbl; int G, c; const char* A; const char* W;
    __device__ bool next(int i, Unit& u) const {
        const int L = i * G + c, mt = L >> 2, pn = L & 3;
        if (mt >= tbl[95]) return false;
        const int ent = tbl[mt], bucket = ent & 255; u.aux = ent >> 8;
        int ea, eb; pair_experts(bucket, ea, eb);
        u.pm = mt; u.pn = pn;
        if (!DOWN) { u.a = A + (size_t)mt * 256 * 1024 * 2; const int e = (pn < 2) ? ea : eb; u.b0 = W + ((size_t)e * 512 + 256 * (pn & 1)) * 1024 * 2; u.b1 = u.b0; }
        else { u.a = A + (size_t)mt * 256 * 512 * 2; u.b0 = W + ((size_t)ea * 1024 + 256 * pn) * 256 * 2; u.b1 = W + ((size_t)eb * 1024 + 256 * pn) * 256 * 2; }
        return true;
    }
};
__device__ __forceinline__ void moe_build_table(LAS int* tbl, const unsigned* cnt, int tid) {
    if (tid == 0) { int mt = 0;
        for (int b = 0; b < 24; ++b) { const int nb = (int)cnt[b]; for (int r = 0; r < nb; r += 256) { const int v = (nb - r) < 256 ? (nb - r) : 256; if (mt < 95) tbl[mt] = b | (v << 8); ++mt; } }
        tbl[95] = mt < 95 ? mt : 95; }
    __syncthreads();
}

#define XB_TMO      128
#define XB_XCNT(j)  (256  + 64 * (j))
#define XB_XSUB(j)  (1280 + 64 * (j))
#define XB_XGEN(j)  (2304 + 64 * (j))
#define XB_TOP      3328
#define XB_TOPGEN   3392
#define XCD_BAR_WORDS 3456
#define XB_SPIN_CAP (1u << 22)
__device__ __forceinline__ unsigned xb_ld(unsigned* p)              { return __hip_atomic_load(p, __ATOMIC_RELAXED, __HIP_MEMORY_SCOPE_AGENT); }
__device__ __forceinline__ unsigned xb_add(unsigned* p, unsigned v) { return __hip_atomic_fetch_add(p, v, __ATOMIC_RELAXED, __HIP_MEMORY_SCOPE_AGENT); }
__device__ __forceinline__ unsigned xb_xcc_id() { return (unsigned)__builtin_amdgcn_s_getreg((3 << 11) | 20) & 0xFu; }
#define XB_SPIN(cond, bar) do { unsigned _sp = 0; while (cond) { __builtin_amdgcn_s_sleep(1); \
    if ((++_sp & 255u) == 0u) { if (xb_ld(&(bar)[XB_TMO])) break; if (_sp > XB_SPIN_CAP) { atomicAdd(&(bar)[XB_TMO], 1u); break; } } } } while (0)
struct XcdBarrier { unsigned* bar; unsigned x; volatile LAS unsigned* st; int wave; };
__device__ __forceinline__ XcdBarrier xcd_barrier_post(unsigned* bar, volatile LAS unsigned* st, int wave) {
    XcdBarrier b; b.bar = bar; b.x = xb_xcc_id(); b.st = st; b.wave = wave;
    if (wave == 0 && lane_id_v() == 0) (void)xb_add(&bar[XB_XCNT(b.x)], 1u);
    return b;
}
__device__ __forceinline__ void xcd_barrier_complete(unsigned* bar, unsigned x, unsigned& nloc, unsigned& nx) {
    const unsigned G = gridDim.x * gridDim.y * gridDim.z;
    unsigned sum, cnt, mine, sp = 0u;
    for (;;) {
        sum = 0u; cnt = 0u; mine = 0u;
#pragma unroll
        for (unsigned j = 0; j < 16; ++j) { const unsigned c = xb_ld(&bar[XB_XCNT(j)]); sum += c; cnt += (c > 0u) ? 1u : 0u; mine = (j == x) ? c : mine; }
        if (sum == G) break;
        __builtin_amdgcn_s_sleep(1);
        if ((++sp & 255u) == 0u) { if (xb_ld(&bar[XB_TMO])) break; if (sp > XB_SPIN_CAP) { atomicAdd(&bar[XB_TMO], 1u); break; } }
    }
    nloc = mine > 0u ? mine : 1u; nx = cnt > 0u ? cnt : 1u;
}
__device__ __forceinline__ void xcd_barrier(const XcdBarrier& b) {
    asm volatile("s_waitcnt vmcnt(0)" ::: "memory");
    __syncthreads();
    if (b.wave == 0 && lane_id_v() == 0) {
        unsigned* bar = b.bar;
        __builtin_amdgcn_s_waitcnt(0);
        unsigned nloc = b.st[0], nx = b.st[1];
        if (nloc == 0u) { xcd_barrier_complete(bar, b.x, nloc, nx); b.st[0] = nloc; b.st[1] = nx; }
        const unsigned old = xb_add(&bar[XB_XSUB(b.x)], 1u);
        const unsigned gen = old / nloc;
        if (old + 1u == (gen + 1u) * nloc) {
            __builtin_amdgcn_fence(__ATOMIC_RELEASE, "agent");
            asm volatile("s_waitcnt vmcnt(0)" ::: "memory");
            const unsigned og = xb_add(&bar[XB_TOP], 1u);
            const unsigned tg = og / nx;
            if (og + 1u == (tg + 1u) * nx) xb_add(&bar[XB_TOPGEN], 1u);
            else XB_SPIN(xb_ld(&bar[XB_TOPGEN]) == tg, bar);
            __builtin_amdgcn_fence(__ATOMIC_ACQUIRE, "agent");
            xb_add(&bar[XB_XGEN(b.x)], 1u);
            asm volatile("s_waitcnt vmcnt(0)" ::: "memory");
        } else {
            XB_SPIN(xb_ld(&bar[XB_XGEN(b.x)]) == gen, bar);
            __builtin_amdgcn_fence(__ATOMIC_ACQUIRE, "agent");
            asm volatile("s_waitcnt vmcnt(0)" ::: "memory");
        }
    }
    __syncthreads();
}

struct Args { const float* in[38]; float* out; unsigned char* ws; int ph_lo, ph_hi; };
constexpr int LDS_BYTES = 147456;
constexpr int LDS_MISC = 140 * 1024;
struct InTab {
    const LAS unsigned long long* t;
    __device__ __forceinline__ const float* operator[](int i) const {
        const unsigned long long v = t[i];
        const unsigned lo = __builtin_amdgcn_readfirstlane((unsigned)v), hi = __builtin_amdgcn_readfirstlane((unsigned)(v >> 32));
        return (const float*)(((unsigned long long)hi << 32) | lo); }
};
struct Frame {
    LAS unsigned char* lds; int wave, G, wg;
    InTab in; float* out; unsigned char* ws;
};
#define IN_X 0
#define IN_MEM 1
#define IN_NORM_MIX 2
#define IN_NORM_XA 3
#define IN_NORM_MEM 4
#define IN_NORM_FFN 5
#define IN_NORM_FINAL 6
#define IN_AB_WIN 7
#define IN_AB_CONV 8
#define IN_AB_ALOG 9
#define IN_AB_DTB 10
#define IN_AB_ONORM 11
#define IN_AB_MU 12
#define IN_AB_W0 13
#define IN_AB_W2 14
#define IN_AB_A0 15
#define IN_AB_A2 16
#define IN_AB_G2 17
#define IN_AB_KK 18
#define IN_AB_KA 19
#define IN_AB_RK 20
#define IN_AB_LNW 21
#define IN_AB_LNB 22
#define IN_AB_WOUT 23
#define IN_C_WIN 24
#define IN_C_LB 25
#define IN_C_ONORM 26
#define IN_C_WOUT 27
#define IN_XA_WQ 28
#define IN_XA_WKV 29
#define IN_XA_WO 30
#define IN_MOE_WG 31
#define IN_MOE_BG 32
#define IN_MOE_WE 33
#define IN_MOE_BE 34
#define IN_MOE_W1 35
#define IN_MOE_W3 36
#define IN_MOE_W2 37

__device__ __forceinline__ void p0_transpose_item(const float* W, int ld, int col0, int ncols, int K, const float* gain, bf16_t* WT, int drow0, LAS float* scr, int item, int lane) {
    const int nblk = ncols / 32, kb = item / nblk, nb = item % nblk, k0 = 64 * kb, n0 = 32 * nb;
#pragma unroll 8
    for (int i = 0; i < 32; ++i) { const int kk = 2 * i + (lane >> 5); float v = W[(size_t)(k0 + kk) * ld + col0 + n0 + (lane & 31)]; if (gain) v *= gain[k0 + kk]; scr[kk * 33 + (lane & 31)] = v; }
    LDS_WAIT(); asm volatile("" ::: "memory");
    const int c = lane & 7;
#pragma unroll
    for (int j = 0; j < 4; ++j) { const int n = (lane >> 3) + 8 * j; const LAS float* s = scr + (8 * c) * 33 + n;
        u32x4 o; o.x = pk2(s[0 * 33], s[1 * 33]); o.y = pk2(s[2 * 33], s[3 * 33]); o.z = pk2(s[4 * 33], s[5 * 33]); o.w = pk2(s[6 * 33], s[7 * 33]);
        *(u32x4*)(WT + (size_t)(drow0 + n0 + n) * K + k0 + 8 * c) = o; }
    LDS_WAIT(); asm volatile("" ::: "memory");
}
__device__ __forceinline__ void p0_weight_item(const Frame& F, int it, LAS float* scr, int lane) {
    const InTab in = F.in;
    bf16_t* W0 = (bf16_t*)(F.ws + WS_W0); bf16_t* W1 = (bf16_t*)(F.ws + WS_W1);
    if (it < 16384) {
        const int l = it >> 13; int r = it & 8191; bf16_t* W = l ? W1 : W0;
        if (r < 512) { p0_transpose_item(in[IN_XA_WQ] + (size_t)l * 1024 * 1024, 1024, 0, 1024, 1024, in[IN_NORM_XA] + l * 1024, W + WO_WQ, 0, scr, r, lane); return; }
        r -= 512;
        if (r < 1024) { p0_transpose_item(in[IN_XA_WKV] + (size_t)l * 1024 * 2048, 2048, 0, 2048, 1024, in[IN_NORM_MEM] + l * 1024, W + WO_WKV, 0, scr, r, lane); return; }
        r -= 1024;
        if (r < 512) { p0_transpose_item(in[IN_XA_WO] + (size_t)l * 1024 * 1024, 1024, 0, 1024, 1024, nullptr, W + WO_WO, 0, scr, r, lane); return; }
        r -= 512;
        if (r < 4096) { const int sub = r >> 6, item = r & 63, e = sub >> 2, j = (sub >> 1) & 1, which = sub & 1;
            const float* src = (which ? in[IN_MOE_W3] : in[IN_MOE_W1]) + (size_t)(l * 16 + e) * 1024 * 256;
            p0_transpose_item(src, 256, 128 * j, 128, 1024, in[IN_NORM_FFN] + l * 1024, W + WO_W13, e * 512 + 256 * j + 128 * which, scr, item, lane); return; }
        r -= 4096;
        { const int e = r >> 7, item = r & 127;
            p0_transpose_item(in[IN_MOE_W2] + (size_t)(l * 16 + e) * 256 * 1024, 1024, 0, 1024, 256, nullptr, W + WO_W2T + (size_t)e * 1024 * 256, 0, scr, item, lane); return; }
    }
    int r = it - 16384;
    if (r < 1024) { p0_transpose_item(in[IN_AB_WIN], 3848, 0, 2048, 1024, in[IN_NORM_MIX], W0 + WO_WIN, 0, scr, r, lane); return; }
    r -= 1024;
    if (r < 896) { p0_transpose_item(in[IN_AB_WIN], 3848, 2056, 1792, 1024, in[IN_NORM_MIX], W0 + WO_WIN, 2048, scr, r, lane); return; }
    r -= 896;
    if (r < 512) { p0_transpose_item(in[IN_AB_WOUT], 1024, 0, 1024, 1024, nullptr, W0 + WO_WOUT, 0, scr, r, lane); return; }
    r -= 512;
    if (r < 2048) { p0_transpose_item(in[IN_C_WIN], 4096, 0, 4096, 1024, in[IN_NORM_MIX] + 1024, W1 + WO_WIN, 0, scr, r, lane); return; }
    r -= 2048;
    p0_transpose_item(in[IN_C_WOUT], 1024, 0, 1024, 1024, nullptr, W1 + WO_WOUT, 0, scr, r, lane);
}
constexpr int P0_NITEMS = 16384 + 1024 + 896 + 512 + 2048 + 512;

__device__ __forceinline__ void p0_prologue(const Frame& F) {
    const int lane = lane_id_v(); const int tid = F.wave * 64 + lane; (void)tid;
    LAS float* scr = (LAS float*)(F.lds + F.wave * 16384);
    const int gw = F.wg * NWAVES + F.wave, NGW = F.G * NWAVES;
    for (int it = gw; it < P0_NITEMS; it += NGW) p0_weight_item(F, it, scr, lane);
    const float* x = F.in[IN_X]; const float* gain = F.in[IN_NORM_MIX]; const float* win = F.in[IN_AB_WIN];
    bf16_t* XB = (bf16_t*)(F.ws + WS_XB); float* ssp = (float*)(F.ws + WS_SSP); float* db = (float*)(F.ws + WS_DB);
    for (int row = gw; row < NT; row += NGW) {
        const f32x4* xr = (const f32x4*)(x + (size_t)row * 1024) + lane;
        f32x4 v[4]; float s = 0.f; float d[8];
#pragma unroll
        for (int c = 0; c < 8; ++c) d[c] = 0.f;
#pragma unroll
        for (int j = 0; j < 4; ++j) {
            v[j] = xr[64 * j]; s += (v[j].x * v[j].x + v[j].y * v[j].y) + (v[j].z * v[j].z + v[j].w * v[j].w);
            const int k0 = 4 * lane + 256 * j;
            const f32x4 g = *(const f32x4*)(gain + k0);
            const float xv[4] = {v[j].x * g.x, v[j].y * g.y, v[j].z * g.z, v[j].w * g.w};
#pragma unroll
            for (int q = 0; q < 4; ++q) {
                const f32x4 w0 = *(const f32x4*)(win + (size_t)(k0 + q) * 3848 + 2048), w1 = *(const f32x4*)(win + (size_t)(k0 + q) * 3848 + 2052);
                d[0] += xv[q] * w0.x; d[1] += xv[q] * w0.y; d[2] += xv[q] * w0.z; d[3] += xv[q] * w0.w;
                d[4] += xv[q] * w1.x; d[5] += xv[q] * w1.y; d[6] += xv[q] * w1.z; d[7] += xv[q] * w1.w;
            }
        }
        s = wave_sum(s);
        const float rstd = 1.0f / sqrtf(s * (1.0f / 1024.0f) + 1e-6f);
#pragma unroll
        for (int c = 0; c < 8; ++c) d[c] = wave_sum(d[c]) * rstd;
        unsigned long long* o8 = (unsigned long long*)(XB + (size_t)row * 1024) + lane;
#pragma unroll
        for (int j = 0; j < 4; ++j) o8[64 * j] = (unsigned long long)pk2(v[j].x, v[j].y) | ((unsigned long long)pk2(v[j].z, v[j].w) << 32);
        if (lane < 16) ssp[(size_t)row * 16 + lane] = (lane == 0) ? s : 0.f;
        if (lane < 8) { float dv = d[0];
#pragma unroll
            for (int c = 1; c < 8; ++c) dv = (lane == c) ? d[c] : dv;
            db[(size_t)row * 8 + lane] = dv; }
    }
    const float* mem = F.in[IN_MEM]; bf16_t* MH = (bf16_t*)(F.ws + WS_MEMH);
    for (int row = gw; row < NB * NMEM; row += NGW) {
        const f32x4* xr = (const f32x4*)(mem + (size_t)row * 1024) + lane;
        f32x4 v[4]; float s = 0.f;
#pragma unroll
        for (int j = 0; j < 4; ++j) { v[j] = xr[64 * j]; s += (v[j].x * v[j].x + v[j].y * v[j].y) + (v[j].z * v[j].z + v[j].w * v[j].w); }
        s = wave_sum(s);
        const float rstd = 1.0f / sqrtf(s * (1.0f / 1024.0f) + 1e-6f);
        unsigned long long* o8 = (unsigned long long*)(MH + (size_t)row * 1024) + lane;
#pragma unroll
        for (int j = 0; j < 4; ++j) o8[64 * j] = (unsigned long long)pk2(v[j].x * rstd, v[j].y * rstd) | ((unsigned long long)pk2(v[j].z * rstd, v[j].w * rstd) << 32);
    }
    if (F.wg == 0) { const float* lbp = F.in[IN_C_LB]; float* lb = (float*)(F.ws + WS_LB);
        for (int c = tid; c < 1024; c += NTHREADS) { const float a = lbp[c], b = lbp[1024 + c]; const float mx = fmaxf(a, b), ea = __expf(a - mx), eb = __expf(b - mx); lb[c] = (ea + eb) / (ea + eb) - ea / (ea + eb); } }
}

__device__ __forceinline__ void scan_delta(const Frame& F, int b, int h) {
    const int lane = lane_id_v(); const int tid = F.wave * 64 + lane; (void)tid;
    LAS float* qs = (LAS float*)F.lds;
    LAS float* ks = qs + 64 * 128;
    LAS float* vs = ks + 64 * 128;
    LAS float* os = vs + 64 * 128;
    LAS float* al = os + 64 * 128;
    LAS float* be = al + 64;
    bf16_t* P = (bf16_t*)(F.ws + WS_BIG + BIG_PROJ);
    const float* convw = F.in[IN_AB_CONV];
    const float* db = (const float*)(F.ws + WS_DB);
    const float a_neg = -__expf(F.in[IN_AB_ALOG][h]), dtb = F.in[IN_AB_DTB][h];
    const float* onorm = F.in[IN_AB_ONORM];
    const int i_dv = tid >> 2, part = tid & 3;
    float s[32];
#pragma unroll
    for (int j = 0; j < 32; ++j) s[j] = 0.f;
    for (int c = 0; c < 32; ++c) {
        const int t0 = b * TS + c * 64;
        for (int idx = tid; idx < 64 * 384; idx += NTHREADS) {
            const int t = idx / 384, cc = idx % 384, sct = cc >> 7, col = cc & 127;
            const int gcol = sct * 512 + h * 128 + col;
            float a = 0.f;
#pragma unroll
            for (int j = 0; j < 4; ++j) { const int tl = c * 64 + t - 3 + j; if (tl >= 0) a += convw[j * 1536 + gcol] * bf2f(P[(size_t)(b * TS + tl) * P0LD + gcol]); }
            a = siluf_(a);
            (sct == 0 ? qs : (sct == 1 ? ks : vs))[t * 128 + col] = a;
        }
        if (tid < 64) { const int t = tid; const float la = a_neg * softplusf_(db[(size_t)(t0 + t) * 8 + h] + dtb); al[t] = __expf(la); be[t] = sigmoidf_(db[(size_t)(t0 + t) * 8 + 4 + h]); }
        __syncthreads();
        for (int r = F.wave; r < 128; r += NWAVES) { LAS float* p = (r < 64 ? qs + r * 128 : ks + (r - 64) * 128);
            const float v0 = p[lane], v1 = p[lane + 64]; const float ss = wave_sum(v0 * v0 + v1 * v1);
            const float sc = (1.0f / sqrtf(ss + 1e-6f)) * (r < 64 ? 0.08838834764831845f : 1.0f); p[lane] = v0 * sc; p[lane + 64] = v1 * sc; }
        __syncthreads();
        for (int t = 0; t < 64; ++t) {
            const LAS f32x4* kp = (const LAS f32x4*)(ks + t * 128 + part * 32); const LAS f32x4* qp = (const LAS f32x4*)(qs + t * 128 + part * 32);
            float kt[32], qt[32];
#pragma unroll
            for (int j = 0; j < 8; ++j) { const f32x4 a = kp[j], q = qp[j]; kt[4 * j] = a.x; kt[4 * j + 1] = a.y; kt[4 * j + 2] = a.z; kt[4 * j + 3] = a.w; qt[4 * j] = q.x; qt[4 * j + 1] = q.y; qt[4 * j + 2] = q.z; qt[4 * j + 3] = q.w; }
            float p = 0.f;
#pragma unroll
            for (int j = 0; j < 32; ++j) p += s[j] * kt[j];
            p += __shfl_xor(p, 1); p += __shfl_xor(p, 2);
            const float alpha = al[t], coef = be[t] * (vs[t * 128 + i_dv] - alpha * p);
            float o = 0.f;
#pragma unroll
            for (int j = 0; j < 32; ++j) { s[j] = alpha * s[j] + coef * kt[j]; o += s[j] * qt[j]; }
            o += __shfl_xor(o, 1); o += __shfl_xor(o, 2);
            if (part == 0) os[t * 128 + i_dv] = o;
        }
        __syncthreads();
        for (int t = F.wave; t < 64; t += NWAVES) {
            const float o0 = os[t * 128 + lane], o1 = os[t * 128 + lane + 64];
            const float ss = wave_sum(o0 * o0 + o1 * o1), rs = 1.0f / sqrtf(ss * (1.0f / 128.0f) + 1e-6f);
            bf16_t* gp = P + (size_t)(t0 + t) * P0LD + 1536 + h * 128;
            const float g0 = bf2f(gp[lane]), g1 = bf2f(gp[lane + 64]);
            gp[lane] = (bf16_t)f2bf(o0 * rs * onorm[lane] * siluf_(g0)); gp[lane + 64] = (bf16_t)f2bf(o1 * rs * onorm[lane + 64] * siluf_(g1));
        }
        __syncthreads();
    }
}
__device__ __forceinline__ void scan_rwkv(const Frame& F, int b, int h) {
    const int lane = lane_id_v(); const int tid = F.wave * 64 + lane; (void)tid;
    LAS float* bufA = (LAS float*)F.lds;
    LAS float* bufB = bufA + 4096;
    LAS float* bufC = bufB + 4096;
    LAS float* R = bufC + 8192;
    LAS float* Kb = R + 4096;
    LAS float* V = Kb + 4096;
    LAS float* KK = V + 4096;
    LAS float* halo = KK + 4096;
    LAS float* bonus = halo + 896;
    bf16_t* P = (bf16_t*)(F.ws + WS_BIG + BIG_PROJ);
    const float* mu = F.in[IN_AB_MU];
    const float* w0 = F.in[IN_AB_W0] + h * 64; const float* w2 = F.in[IN_AB_W2] + h * 64;
    const float* a0 = F.in[IN_AB_A0] + h * 64; const float* a2 = F.in[IN_AB_A2] + h * 64;
    const float* g2 = F.in[IN_AB_G2] + h * 64;
    const float* k_k = F.in[IN_AB_KK] + h * 64; const float* k_a = F.in[IN_AB_KA] + h * 64; const float* r_k = F.in[IN_AB_RK] + h * 64;
    const float* ln_w = F.in[IN_AB_LNW] + h * 64; const float* ln_b = F.in[IN_AB_LNB] + h * 64;
    const int vi = tid >> 3, part = tid & 7;
    float s[8];
#pragma unroll
    for (int j = 0; j < 8; ++j) s[j] = 0.f;
    for (int i = tid; i < 896; i += NTHREADS) halo[i] = 0.f;
    __syncthreads();
    for (int c = 0; c < 32; ++c) {
        const int t0 = b * TS + c * 64;
        const LAS float* hcur = halo + (c & 1) * 448; LAS float* hnext = halo + ((c + 1) & 1) * 448;
        for (int idx = tid; idx < 64 * 448; idx += NTHREADS) {
            const int t = idx / 448, col = idx % 448;
            int gc;
            if (col < 64) gc = 2048 + h * 64 + col; else if (col < 128) gc = 2560 + h * 64 + (col - 64); else if (col < 192) gc = 3072 + h * 64 + (col - 128); else gc = 3584 + (col - 192);
            const float cur = bf2f(P[(size_t)(t0 + t) * P0LD + gc]);
            const float prev = (t > 0) ? bf2f(P[(size_t)(t0 + t - 1) * P0LD + gc]) : hcur[col];
            const float sh = cur + mu[gc - 2048] * (prev - cur);
            if (t == 63) hnext[col] = cur;
            if (col < 64) R[t * 64 + col] = sh; else if (col < 128) Kb[t * 64 + col - 64] = sh; else if (col < 192) V[t * 64 + col - 128] = sh;
            else if (col < 256) bufA[t * 64 + col - 192] = tanhf(sh); else if (col < 320) bufB[t * 64 + col - 256] = sh; else bufC[t * 128 + col - 320] = sigmoidf_(sh);
        }
        __syncthreads();
        float wv[8], av[8], gv[8];
        {
            const int j = lane, tb = F.wave * 8;
#pragma unroll
            for (int q = 0; q < 8; ++q) { wv[q] = 0.f; av[q] = 0.f; gv[q] = 0.f; }
            for (int m = 0; m < 64; ++m) { const float x2 = w2[(size_t)m * 512 + j], y2 = a2[(size_t)m * 512 + j];
#pragma unroll
                for (int q = 0; q < 8; ++q) { wv[q] += bufA[(tb + q) * 64 + m] * x2; av[q] += bufB[(tb + q) * 64 + m] * y2; } }
            for (int m = 0; m < 128; ++m) { const float z2 = g2[(size_t)m * 512 + j];
#pragma unroll
                for (int q = 0; q < 8; ++q) gv[q] += bufC[(tb + q) * 128 + m] * z2; }
#pragma unroll
            for (int q = 0; q < 8; ++q) { wv[q] = __expf(-0.6065306597126334f * sigmoidf_(w0[j] + wv[q])); av[q] = sigmoidf_(a0[j] + av[q]); }
        }
        __syncthreads();
        {
            const int j = lane, tb = F.wave * 8;
#pragma unroll
            for (int q = 0; q < 8; ++q) { bufA[(tb + q) * 64 + j] = wv[q]; bufB[(tb + q) * 64 + j] = av[q]; bufC[(tb + q) * 64 + j] = gv[q]; }
#pragma unroll
            for (int q = 0; q < 8; ++q) { const int t = tb + q; const float kv = Kb[t * 64 + j]; const float kx = kv * k_k[j]; const float ss = wave_sum(kx * kx);
                KK[t * 64 + j] = kx * (1.0f / sqrtf(ss + 1e-6f)); const float km = kv * (1.f + (av[q] - 1.f) * k_a[j]); Kb[t * 64 + j] = km;
                const float bs = wave_sum(R[t * 64 + j] * km * r_k[j]); if (j == 0) bonus[t] = bs; }
        }
        __syncthreads();
        LAS float* O = bufC + 4096;
        for (int t = 0; t < 64; ++t) {
            const LAS f32x4* p4;
            float kk[8], ww[8], aa[8], km[8], rr[8];
            p4 = (const LAS f32x4*)(KK + t * 64 + part * 8);   { const f32x4 a = p4[0], c2 = p4[1]; kk[0] = a.x; kk[1] = a.y; kk[2] = a.z; kk[3] = a.w; kk[4] = c2.x; kk[5] = c2.y; kk[6] = c2.z; kk[7] = c2.w; }
            p4 = (const LAS f32x4*)(bufA + t * 64 + part * 8); { const f32x4 a = p4[0], c2 = p4[1]; ww[0] = a.x; ww[1] = a.y; ww[2] = a.z; ww[3] = a.w; ww[4] = c2.x; ww[5] = c2.y; ww[6] = c2.z; ww[7] = c2.w; }
            p4 = (const LAS f32x4*)(bufB + t * 64 + part * 8); { const f32x4 a = p4[0], c2 = p4[1]; aa[0] = a.x; aa[1] = a.y; aa[2] = a.z; aa[3] = a.w; aa[4] = c2.x; aa[5] = c2.y; aa[6] = c2.z; aa[7] = c2.w; }
            p4 = (const LAS f32x4*)(Kb + t * 64 + part * 8);   { const f32x4 a = p4[0], c2 = p4[1]; km[0] = a.x; km[1] = a.y; km[2] = a.z; km[3] = a.w; km[4] = c2.x; km[5] = c2.y; km[6] = c2.z; km[7] = c2.w; }
            p4 = (const LAS f32x4*)(R + t * 64 + part * 8);    { const f32x4 a = p4[0], c2 = p4[1]; rr[0] = a.x; rr[1] = a.y; rr[2] = a.z; rr[3] = a.w; rr[4] = c2.x; rr[5] = c2.y; rr[6] = c2.z; rr[7] = c2.w; }
            const float vv = V[t * 64 + vi];
            float sa = 0.f;
#pragma unroll
            for (int j = 0; j < 8; ++j) sa -= s[j] * kk[j];
            sa += __shfl_xor(sa, 1); sa += __shfl_xor(sa, 2); sa += __shfl_xor(sa, 4);
            float o = 0.f;
#pragma unroll
            for (int j = 0; j < 8; ++j) { s[j] = s[j] * ww[j] + sa * (kk[j] * aa[j]) + vv * km[j]; o += s[j] * rr[j]; }
            o += __shfl_xor(o, 1); o += __shfl_xor(o, 2); o += __shfl_xor(o, 4);
            if (part == 0) O[t * 64 + vi] = o;
        }
        __syncthreads();
        for (int t = F.wave; t < 64; t += NWAVES) {
            const float o = O[t * 64 + lane];
            const float mean = wave_sum(o) * (1.0f / 64.0f); const float dlt = o - mean; const float var = wave_sum(dlt * dlt) * (1.0f / 64.0f);
            float y = dlt * (1.0f / sqrtf(var + 64e-5f)) * ln_w[lane] + ln_b[lane];
            y += bonus[t] * V[t * 64 + lane];
            y *= bufC[t * 64 + lane];
            P[(size_t)(t0 + t) * P0LD + 2048 + h * 64 + lane] = (bf16_t)f2bf(y);
        }
        __syncthreads();
    }
}
__device__ __forceinline__ void scan_hgrn(const Frame& F, int b, int h) {
    const int lane = lane_id_v(); const int tid = F.wave * 64 + lane; (void)tid;
    LAS float* qs = (LAS float*)F.lds;
    LAS float* fs = qs + 64 * 128;
    LAS float* kf = fs + 64 * 128;
    LAS float* is = kf + 64 * 128;
    bf16_t* P = (bf16_t*)(F.ws + WS_BIG + BIG_PROJ);
    const float* onorm = F.in[IN_C_ONORM];
    const int e = tid >> 2, part = tid & 3;
    float s[32];
#pragma unroll
    for (int j = 0; j < 32; ++j) s[j] = 0.f;
    for (int c = 0; c < 32; ++c) {
        const int t0 = b * TS + c * 64;
        for (int idx = tid; idx < 64 * 128; idx += NTHREADS) {
            const int t = idx >> 7, col = idx & 127; const bf16_t* pr = P + (size_t)(t0 + t) * P1LD + h * 128 + col;
            qs[idx] = bf2f(pr[0]); const float lf = h2f_bits(pr[1024]); fs[idx] = __expf(lf); kf[idx] = -expm1f(lf); is[idx] = bf2f(pr[2048]);
        }
        __syncthreads();
        for (int t = 0; t < 64; ++t) {
            const LAS f32x4* fp = (const LAS f32x4*)(fs + t * 128 + part * 32); const LAS f32x4* kp = (const LAS f32x4*)(kf + t * 128 + part * 32); const LAS f32x4* qp = (const LAS f32x4*)(qs + t * 128 + part * 32);
            const float iv = is[t * 128 + e];
            float o = 0.f;
#pragma unroll
            for (int j = 0; j < 8; ++j) { const f32x4 f = fp[j], k = kp[j], q = qp[j];
                s[4 * j] = f.x * s[4 * j] + k.x * iv; o += s[4 * j] * q.x;
                s[4 * j + 1] = f.y * s[4 * j + 1] + k.y * iv; o += s[4 * j + 1] * q.y;
                s[4 * j + 2] = f.z * s[4 * j + 2] + k.z * iv; o += s[4 * j + 2] * q.z;
                s[4 * j + 3] = f.w * s[4 * j + 3] + k.w * iv; o += s[4 * j + 3] * q.w; }
            o += __shfl_xor(o, 1); o += __shfl_xor(o, 2);
            if (part == 0) is[t * 128 + e] = o;
        }
        __syncthreads();
        for (int t = F.wave; t < 64; t += NWAVES) {
            const float o0 = is[t * 128 + lane], o1 = is[t * 128 + lane + 64];
            const float ss = wave_sum(o0 * o0 + o1 * o1), rs = 1.0f / sqrtf(ss * (1.0f / 128.0f) + 1e-6f);
            bf16_t* gp = P + (size_t)(t0 + t) * P1LD + 3072 + h * 128;
            const float g0 = bf2f(gp[lane]), g1 = bf2f(gp[lane + 64]);
            gp[lane] = (bf16_t)f2bf(o0 * rs * onorm[lane] * siluf_(g0)); gp[lane + 64] = (bf16_t)f2bf(o1 * rs * onorm[lane + 64] * siluf_(g1));
        }
        __syncthreads();
    }
}

__device__ __forceinline__ void attn_phase(const Frame& F, const bf16_t* Q, const bf16_t* Kb, const bf16_t* VT, bf16_t* O) {
    const int lane = lane_id_v(); const int tid = F.wave * 64 + lane; (void)tid;
    const int fr = lane & 15, fq = lane >> 4;
    for (int u = F.wg; u < 512; u += F.G) {
        const int b = u >> 6, h = (u >> 4) & 3, qb = u & 15;
        const int q0 = b * TS + qb * 128 + F.wave * 16;
        bf16x8 bq[8];
#pragma unroll
        for (int ksx = 0; ksx < 8; ++ksx) bq[ksx] = *(const bf16x8*)(Q + (size_t)(q0 + fr) * 1024 + h * 256 + ksx * 32 + fq * 8);
        f32x4 sacc[16];
#pragma unroll
        for (int tl = 0; tl < 16; ++tl) {
            f32x4 a4 = {0.f, 0.f, 0.f, 0.f};
            const bf16_t* kp = Kb + (size_t)(b * 256 + tl * 16 + fr) * 1024 + h * 256 + fq * 8;
#pragma unroll
            for (int ksx = 0; ksx < 8; ++ksx) { const bf16x8 a = *(const bf16x8*)(kp + ksx * 32); a4 = __builtin_amdgcn_mfma_f32_16x16x32_bf16(a, bq[ksx], a4, 0, 0, 0); }
            sacc[tl] = a4;
        }
        float mx = -3.0e38f;
#pragma unroll
        for (int tl = 0; tl < 16; ++tl) mx = fmaxf(mx, fmaxf(fmaxf(sacc[tl].x, sacc[tl].y), fmaxf(sacc[tl].z, sacc[tl].w)));
        mx = fmaxf(mx, __shfl_xor(mx, 16)); mx = fmaxf(mx, __shfl_xor(mx, 32));
        float l = 0.f;
        bf16x8 pb[8];
#pragma unroll
        for (int ksx = 0; ksx < 8; ++ksx) {
            const f32x4 e0 = sacc[2 * ksx], e1 = sacc[2 * ksx + 1];
            const float p0 = __expf(e0.x - mx), p1 = __expf(e0.y - mx), p2 = __expf(e0.z - mx), p3 = __expf(e0.w - mx);
            const float p4 = __expf(e1.x - mx), p5 = __expf(e1.y - mx), p6 = __expf(e1.z - mx), p7 = __expf(e1.w - mx);
            l += ((p0 + p1) + (p2 + p3)) + ((p4 + p5) + (p6 + p7));
            u32x4 w; w.x = pk2(p0, p1); w.y = pk2(p2, p3); w.z = pk2(p4, p5); w.w = pk2(p6, p7);
            pb[ksx] = __builtin_bit_cast(bf16x8, w);
        }
        l += __shfl_xor(l, 16); l += __shfl_xor(l, 32);
        const float inv = 1.0f / l;
        const bf16_t* vbase = VT + (size_t)((b * 4 + h) * 256) * 256;
#pragma unroll 4
        for (int dt = 0; dt < 16; ++dt) {
            f32x4 o4 = {0.f, 0.f, 0.f, 0.f};
            const bf16_t* vp = vbase + (size_t)(dt * 16 + fr) * 256 + 4 * fq;
#pragma unroll
            for (int ksx = 0; ksx < 8; ++ksx) {
                const u32x2 lo = *(const u32x2*)(vp + ksx * 32), hi = *(const u32x2*)(vp + ksx * 32 + 16);
                u32x4 w; w.x = lo.x; w.y = lo.y; w.z = hi.x; w.w = hi.y;
                o4 = __builtin_amdgcn_mfma_f32_16x16x32_bf16(__builtin_bit_cast(bf16x8, w), pb[ksx], o4, 0, 0, 0);
            }
            u32x2 w; w.x = pk2(o4.x * inv, o4.y * inv); w.y = pk2(o4.z * inv, o4.w * inv);
            *(u32x2*)(O + (size_t)(q0 + fr) * 1024 + h * 256 + dt * 16 + 4 * fq) = w;
        }
    }
}

__device__ __forceinline__ void router_phase(const Frame& F, int layer) {
    const int lane = lane_id_v(); const int tid = F.wave * 64 + lane; (void)tid;
    const float* XF = F.out; const float* gain = F.in[IN_NORM_FFN] + layer * 1024;
    const float* wg = F.in[IN_MOE_WG] + (size_t)layer * 1024 * 4; const float* we = F.in[IN_MOE_WE] + (size_t)layer * 1024 * 16;
    const float* bg = F.in[IN_MOE_BG] + layer * 4; const float* be = F.in[IN_MOE_BE] + layer * 16;
    unsigned* cnt = (unsigned*)(F.ws + WS_CNT) + layer * 32;
    int* tokb = (int*)(F.ws + WS_ROUTE); int* tokp = tokb + NT; f32x4* tokg = (f32x4*)(tokp + NT);
    const int gw = F.wg * NWAVES + F.wave, NGW = F.G * NWAVES;
    for (int row = gw; row < NT; row += NGW) {
        const f32x4* xr = (const f32x4*)(XF + (size_t)row * 1024) + lane;
        float s = 0.f, lg[4], le[16];
#pragma unroll
        for (int c = 0; c < 4; ++c) lg[c] = 0.f;
#pragma unroll
        for (int c = 0; c < 16; ++c) le[c] = 0.f;
#pragma unroll 1
        for (int j = 0; j < 4; ++j) {
            const f32x4 v = xr[64 * j]; s += (v.x * v.x + v.y * v.y) + (v.z * v.z + v.w * v.w);
            const int k0 = 4 * lane + 256 * j; const f32x4 g = *(const f32x4*)(gain + k0);
            const float xv[4] = {v.x * g.x, v.y * g.y, v.z * g.z, v.w * g.w};
#pragma unroll
            for (int q = 0; q < 4; ++q) {
                const f32x4 a = *(const f32x4*)(wg + (size_t)(k0 + q) * 4);
                lg[0] += xv[q] * a.x; lg[1] += xv[q] * a.y; lg[2] += xv[q] * a.z; lg[3] += xv[q] * a.w;
#pragma unroll
                for (int e4 = 0; e4 < 4; ++e4) { const f32x4 w = *(const f32x4*)(we + (size_t)(k0 + q) * 16 + 4 * e4);
                    le[4 * e4] += xv[q] * w.x; le[4 * e4 + 1] += xv[q] * w.y; le[4 * e4 + 2] += xv[q] * w.z; le[4 * e4 + 3] += xv[q] * w.w; }
            }
        }
        s = wave_sum(s);
        const float rstd = 1.0f / sqrtf(s * (1.0f / 1024.0f) + 1e-6f);
#pragma unroll
        for (int c = 0; c < 4; ++c) lg[c] = wave_sum(lg[c]) * rstd + bg[c];
#pragma unroll
        for (int c = 0; c < 16; ++c) le[c] = wave_sum(le[c]) * rstd + be[c];
        int gs = 0; float gm = lg[0];
#pragma unroll
        for (int c = 1; c < 4; ++c) if (lg[c] > gm) { gm = lg[c]; gs = c; }
        float gz = 0.f;
#pragma unroll
        for (int c = 0; c < 4; ++c) gz += __expf(lg[c] - gm);
        const float ggate = 1.0f / gz;
        float l4[4];
#pragma unroll
        for (int c = 0; c < 4; ++c) { float v = le[c];
#pragma unroll
            for (int g2 = 1; g2 < 4; ++g2) v = (gs == g2) ? le[4 * g2 + c] : v;
            l4[c] = v; }
        int i0 = 0; float m0 = l4[0];
#pragma unroll
        for (int c = 1; c < 4; ++c) if (l4[c] > m0) { m0 = l4[c]; i0 = c; }
        int i1 = -1; float m1 = -3.0e38f;
#pragma unroll
        for (int c = 0; c < 4; ++c) if (c != i0 && l4[c] > m1) { m1 = l4[c]; i1 = c; }
        const float e1 = __expf(m1 - m0); const float g0 = ggate / (1.f + e1), g1 = ggate * e1 / (1.f + e1);
        const int ia = i0 < i1 ? i0 : i1, ib = i0 < i1 ? i1 : i0;
        const float ga = i0 < i1 ? g0 : g1, gb = i0 < i1 ? g1 : g0;
        const int pidx = (ia == 0) ? (ib - 1) : (ia == 1 ? ib + 1 : 5);
        const int bucket = gs * 6 + pidx;
        if (lane == 0) {
            const unsigned pos = atomicAdd(&cnt[bucket], 1u);
            tokb[row] = bucket; tokp[row] = (int)pos; tokg[row] = (f32x4){rstd, ga, gb, 0.f};
        }
    }
}
__device__ __forceinline__ void gather_phase(const Frame& F, int layer) {
    const int lane = lane_id_v(); const int tid = F.wave * 64 + lane; (void)tid;
    const unsigned* cnt = (const unsigned*)(F.ws + WS_CNT) + layer * 32;
    const int* tokb = (const int*)(F.ws + WS_ROUTE); const int* tokp = tokb + NT; const f32x4* tokg = (const f32x4*)(tokp + NT); f32x4* rowinfo = (f32x4*)(tokg + NT);
    const bf16_t* XB = (const bf16_t*)(F.ws + WS_XB); bf16_t* XG = (bf16_t*)(F.ws + WS_BIG + BIG_XG);
    LAS int* off = (LAS int*)F.lds;
    if (tid == 0) { int acc = 0; for (int b = 0; b < 24; ++b) { off[b] = acc * 256; acc += ((int)cnt[b] + 255) >> 8; } }
    __syncthreads();
    const int gw = F.wg * NWAVES + F.wave, NGW = F.G * NWAVES;
    for (int tok = gw; tok < NT; tok += NGW) {
        const int row = off[tokb[tok]] + tokp[tok];
        const u32x4* src = (const u32x4*)(XB + (size_t)tok * 1024) + lane; u32x4* dst = (u32x4*)(XG + (size_t)row * 1024) + lane;
        dst[0] = src[0]; dst[64] = src[64];
        if (lane == 0) { f32x4 g = tokg[tok]; g.w = __int_as_float(tok); rowinfo[row] = g; }
    }
    __syncthreads();
}
__device__ __forceinline__ void final_phase(const Frame& F) {
    const int lane = lane_id_v(); const int tid = F.wave * 64 + lane; (void)tid;
    float* XF = F.out; const float* gain = F.in[IN_NORM_FINAL];
    const int gw = F.wg * NWAVES + F.wave, NGW = F.G * NWAVES;
    for (int row = gw; row < NT; row += NGW) {
        f32x4* xr = (f32x4*)(XF + (size_t)row * 1024) + lane;
        f32x4 v[4]; float s = 0.f;
#pragma unroll
        for (int j = 0; j < 4; ++j) { v[j] = xr[64 * j]; s += (v[j].x * v[j].x + v[j].y * v[j].y) + (v[j].z * v[j].z + v[j].w * v[j].w); }
        s = wave_sum(s);
        const float rstd = 1.0f / sqrtf(s * (1.0f / 1024.0f) + 1e-6f);
#pragma unroll
        for (int j = 0; j < 4; ++j) { const f32x4 g = *(const f32x4*)(gain + 4 * lane + 256 * j); xr[64 * j] = v[j] * rstd * g; }
    }
}

constexpr int N_PHASES = 22;
#ifndef PH_MASK
#define PH_MASK 0xFFFFFFFFu
#endif
#define IN(k) (((PH_MASK >> ((k) > 10 ? (k) - 10 : (k))) & 1u) && lo <= (k) && (k) < hi)
#define SEAM(k) do { if (IN(k) && IN((k) + 1)) xcd_barrier(bar); } while (0)

template <int LAYER>
__device__ __forceinline__ void layer_phases(const Frame& F, const XcdBarrier& bar, const int lo, const int hi) {
    constexpr int pb = LAYER * 10;
    unsigned char* const ws = F.ws;
#define WPTR(off) ((bf16_t*)(ws + (LAYER ? WS_W1 : WS_W0)) + (off))
#define XB_ ((bf16_t*)(ws + WS_XB))
#define SSP_ ((float*)(ws + WS_SSP))
#define PROJ_ ((bf16_t*)(ws + WS_BIG + BIG_PROJ))
#define KB_ (LAYER ? (bf16_t*)(ws + WS_W0) : (bf16_t*)(ws + WS_BIG + BIG_KV0))
#define VT_ (KB_ + (size_t)2048 * 1024)
#define QB_ ((bf16_t*)(ws + WS_BIG + BIG_Q))
#define ATT_ ((bf16_t*)(ws + WS_BIG + BIG_ATT))
#define XG_ ((bf16_t*)(ws + WS_BIG + BIG_XG))
#define HID_ ((bf16_t*)(ws + WS_BIG + BIG_HID))
#define CNT_ ((const unsigned*)(ws + WS_CNT) + LAYER * 32)
#define ROWINFO_ ((const f32x4*)(ws + WS_ROUTE + (size_t)NT * 8 + (size_t)NT * 16))
    if (IN(pb + 1)) {
        if (LAYER == 0) {
            pg8::Gemm g{1024, 1024, 1024, 1 << 20}; pg8::DenseSched S; S.init(NT, 3840, F.G, F.wg, XB_, 1024, WPTR(WO_WIN), 1024);
            EpiScale<0> E{PROJ_, P0LD, SSP_, 1.0f, nullptr};
            pg8::gemm_phase(F.lds, F.wave, g, S, E);
        } else {
            pg8::Gemm g{1024, 1024, 1024, 1 << 20}; pg8::DenseSched S; S.init(NT, 4096, F.G, F.wg, XB_, 1024, WPTR(WO_WIN), 1024);
            EpiScale<1> E{PROJ_, P1LD, SSP_, 1.0f, (const float*)(ws + WS_LB)};
            pg8::gemm_phase(F.lds, F.wave, g, S, E);
        }
        { pg8::Gemm g{1024, 1024, 1024, 1 << 20}; pg8::DenseSched S; S.init(2048, 2048, F.G, F.wg, (const bf16_t*)(ws + WS_MEMH), 1024, WPTR(WO_WKV), 1024);
          EpiKV E{KB_, VT_}; pg8::gemm_phase(F.lds, F.wave, g, S, E); }
    }
    SEAM(pb + 1);
    if (IN(pb + 2)) {
        if (LAYER == 0) { if (F.wg < 32) scan_delta(F, F.wg >> 2, F.wg & 3); else if (F.wg < 96) scan_rwkv(F, (F.wg - 32) >> 3, (F.wg - 32) & 7); }
        else { if (F.wg < 64) scan_hgrn(F, F.wg >> 3, F.wg & 7); }
    }
    SEAM(pb + 2);
    if (IN(pb + 3)) {
        constexpr int lda = LAYER ? P1LD : P0LD; const bf16_t* A = PROJ_ + (LAYER ? 3072 : 1536);
        pg8::Gemm g{lda, 1024, 1024, 1 << 20}; pg8::DenseSched S; S.init(NT, 1024, F.G, F.wg, A, lda, WPTR(WO_WOUT), 1024);
        EpiResid<false> E{LAYER ? (const float*)F.out : F.in[IN_X], F.out, XB_, SSP_, nullptr};
        pg8::gemm_phase(F.lds, F.wave, g, S, E);
    }
    SEAM(pb + 3);
    if (IN(pb + 4)) {
        pg8::Gemm g{1024, 1024, 1024, 1 << 20}; pg8::DenseSched S; S.init(NT, 1024, F.G, F.wg, XB_, 1024, WPTR(WO_WQ), 1024);
        EpiScale<0> E{QB_, 1024, SSP_, 0.0625f, nullptr};
        pg8::gemm_phase(F.lds, F.wave, g, S, E);
    }
    SEAM(pb + 4);
    if (IN(pb + 5)) attn_phase(F, QB_, KB_, VT_, ATT_);
    SEAM(pb + 5);
    if (IN(pb + 6)) {
        pg8::Gemm g{1024, 1024, 1024, 1 << 20}; pg8::DenseSched S; S.init(NT, 1024, F.G, F.wg, ATT_, 1024, WPTR(WO_WO), 1024);
        EpiResid<false> E{F.out, F.out, XB_, SSP_, nullptr};
        pg8::gemm_phase(F.lds, F.wave, g, S, E);
    }
    SEAM(pb + 6);
    if (IN(pb + 7)) router_phase(F, LAYER);
    SEAM(pb + 7);
    if (IN(pb + 8)) gather_phase(F, LAYER);
    SEAM(pb + 8);
    if (IN(pb + 9)) {
        LAS int* tbl = (LAS int*)(F.lds + LDS_MISC + 512); moe_build_table(tbl, CNT_, F.wave * 64 + lane_id_v());
        pg8::Gemm g{1024, 1024, 1024, 1 << 20}; MoeSched<false> S{tbl, F.G, F.wg, (const char*)XG_, (const char*)WPTR(WO_W13)};
        EpiMoeUp E{HID_, ROWINFO_};
        pg8::gemm_phase(F.lds, F.wave, g, S, E);
    }
    SEAM(pb + 9);
    if (IN(pb + 10)) {
        LAS int* tbl = (LAS int*)(F.lds + LDS_MISC + 512); moe_build_table(tbl, CNT_, F.wave * 64 + lane_id_v());
        pg8::Gemm g{512, 256, 512, 4}; MoeSched<true> S{tbl, F.G, F.wg, (const char*)HID_, (const char*)WPTR(WO_W2T)};
        EpiResid<true> E{F.out, F.out, XB_, SSP_, ROWINFO_};
        pg8::gemm_phase(F.lds, F.wave, g, S, E);
    }
    SEAM(pb + 10);
}

__global__ void __launch_bounds__(NTHREADS, 2) fwd_mega(Args args) {
    extern __shared__ __attribute__((aligned(16))) unsigned char lds_raw[];
    Frame F;
    F.lds = (LAS unsigned char*)lds_raw;
    const int tid = threadIdx.x; F.wave = __builtin_amdgcn_readfirstlane(tid >> 6);
    F.G = gridDim.x; F.wg = blockIdx.x;
    F.out = args.out; F.ws = args.ws;
    volatile LAS unsigned* MISC = (volatile LAS unsigned*)(F.lds + LDS_MISC);
    LAS unsigned long long* tab = (LAS unsigned long long*)(F.lds + LDS_MISC + 64);
    F.in.t = tab;
    if (tid < 16) MISC[tid] = 0u;
    if (tid == 0) {
#pragma unroll
        for (int i = 0; i < 38; ++i) tab[i] = (unsigned long long)args.in[i];
    }
    __syncthreads();
    XcdBarrier bar; bar.bar = (unsigned*)(F.ws + WS_CTL); bar.x = 0; bar.st = MISC; bar.wave = F.wave;
#if N_LAUNCH_MODE == 1
    bar = xcd_barrier_post((unsigned*)(F.ws + WS_CTL), MISC, F.wave);
#endif
    const int lo = args.ph_lo, hi = args.ph_hi;
    if (IN(0)) { p0_prologue(F); }
    SEAM(0);
    layer_phases<0>(F, bar, lo, hi);
    layer_phases<1>(F, bar, lo, hi);
    if (IN(21)) final_phase(F);
}
#undef IN
#undef SEAM

extern "C" void kernel_launch(void* const* d_in, const int* in_sizes, int n_in, void* d_out, int out_size, void* d_ws, size_t ws_size, hipStream_t stream) {
    static int grid = 0;
    if (grid == 0) {
        if (n_in != 38 || out_size != NT * DM || ws_size < WS_END) { fprintf(stderr, "kernel_launch: unexpected problem (n_in %d out %d ws %zu)\n", n_in, out_size, ws_size); grid = -1; return; }
        int dev = 0, cus = 0, per_cu = 0;
        if (hipGetDevice(&dev) != hipSuccess || hipDeviceGetAttribute(&cus, hipDeviceAttributeMultiprocessorCount, dev) != hipSuccess) { grid = -1; return; }
        if (hipFuncSetAttribute((const void*)fwd_mega, hipFuncAttributeMaxDynamicSharedMemorySize, LDS_BYTES) != hipSuccess) { fprintf(stderr, "kernel_launch: hipFuncSetAttribute failed\n"); grid = -1; return; }
        if (hipOccupancyMaxActiveBlocksPerMultiprocessor(&per_cu, (const void*)fwd_mega, NTHREADS, LDS_BYTES) != hipSuccess || per_cu < 1) { fprintf(stderr, "kernel_launch: occupancy query says %d\n", per_cu); (void)hipGetLastError(); grid = -1; return; }
        grid = cus;
    }
    if (grid < 0) return;
    (void)hipMemsetAsync((char*)d_ws + WS_CTL, 0, 32768, stream);
    Args a{};
    for (int i = 0; i < 38; ++i) a.in[i] = (const float*)d_in[i];
    a.out = (float*)d_out; a.ws = (unsigned char*)d_ws;
#if N_LAUNCH_MODE == 1
    a.ph_lo = 0; a.ph_hi = N_PHASES;
    void* kargs[] = {&a};
    hipError_t e = hipLaunchCooperativeKernel((const void*)fwd_mega, dim3(grid), dim3(NTHREADS), kargs, LDS_BYTES, stream);
    if (e != hipSuccess) fprintf(stderr, "kernel_launch: cooperative launch failed: %s\n", hipGetErrorString(e));
#else
    for (int p = 0; p < N_PHASES; ++p) { a.ph_lo = p; a.ph_hi = p + 1; hipLaunchKernelGGL(fwd_mega, dim3(grid), dim3(NTHREADS), LDS_BYTES, stream, a); }
#endif
}
```

```cpp
#include <hip/hip_runtime.h>
#include <cstdio>
#include <cstdint>

#ifndef N_LAUNCH_MODE
#define N_LAUNCH_MODE 1
#endif

#define LAS __attribute__((address_space(3)))
#define GAS __attribute__((address_space(1)))
typedef unsigned short bf16_t;
typedef short bf16x8 __attribute__((ext_vector_type(8)));
typedef short bf16x4 __attribute__((ext_vector_type(4)));
typedef float f32x4 __attribute__((ext_vector_type(4)));
typedef float f32x2 __attribute__((ext_vector_type(2)));
typedef unsigned u32x4 __attribute__((ext_vector_type(4)));
typedef unsigned u32x2 __attribute__((ext_vector_type(2)));

constexpr int NT = 16384, DM = 1024, NB = 8, TS = 2048, NMEM = 256;
constexpr int P0LD = 3840;
constexpr int P1LD = 4096;
constexpr int NTHREADS = 512, NWAVES = 8;

constexpr size_t MiB = 1048576;
constexpr size_t WS_CTL = 0;
constexpr size_t WS_CNT = 16384;
constexpr size_t WS_LB = 32768;
constexpr size_t WS_DB = 1 * MiB;
constexpr size_t WS_SSP = WS_DB + 512 * 1024;
constexpr size_t WS_MEMH = WS_SSP + 1 * MiB;
constexpr size_t WS_ROUTE = WS_MEMH + 4 * MiB;
constexpr size_t WS_LORA = WS_ROUTE + 800 * 1024;
constexpr size_t WS_W0 = 8 * MiB;
constexpr size_t WS_W1 = WS_W0 + 42 * MiB;
constexpr size_t WS_XB = 92 * MiB;
constexpr size_t WS_BIG = 124 * MiB;
constexpr size_t WS_END = 256 * MiB;
constexpr size_t WO_WIN = 0;
constexpr size_t WO_WOUT = WO_WIN + (size_t)4096 * 1024;
constexpr size_t WO_WQ = WO_WOUT + (size_t)1024 * 1024;
constexpr size_t WO_WKV = WO_WQ + (size_t)1024 * 1024;
constexpr size_t WO_WO = WO_WKV + (size_t)2048 * 1024;
constexpr size_t WO_W13 = WO_WO + (size_t)1024 * 1024;
constexpr size_t WO_W2T = WO_W13 + (size_t)16 * 512 * 1024;
constexpr size_t WO_END = WO_W2T + (size_t)16 * 1024 * 256;
static_assert(WO_END * 2 <= 42 * MiB, "weight region");
constexpr size_t BIG_PROJ = 0;
constexpr size_t BIG_KV0 = 120 * MiB;
constexpr size_t BIG_Q = 0;
constexpr size_t BIG_ATT = 32 * MiB;
constexpr size_t BIG_XG = 0;
constexpr size_t BIG_HID = 48 * MiB;
constexpr int MOE_MAXROWS = 22528;

__device__ __forceinline__ unsigned f2bf(float f) { unsigned u = __float_as_uint(f); u += 0x7fffu + ((u >> 16) & 1u); return u >> 16; }
__device__ __forceinline__ float bf2f(unsigned short b) { return __uint_as_float((unsigned)b << 16); }
__device__ __forceinline__ unsigned pk2(float lo, float hi) { return f2bf(lo) | (f2bf(hi) << 16); }
__device__ __forceinline__ float wave_sum(float v) {
#pragma unroll
    for (int o = 1; o < 64; o <<= 1) v += __shfl_xor(v, o);
    return v;
}
__device__ __forceinline__ float sigmoidf_(float x) { return 1.f / (1.f + __expf(-x)); }
__device__ __forceinline__ float siluf_(float x) { return x / (1.f + __expf(-x)); }
__device__ __forceinline__ float softplusf_(float x) { return x > 20.f ? x : log1pf(__expf(x)); }
__device__ __forceinline__ int lane_id_v() { int l; asm volatile("v_mbcnt_lo_u32_b32 %0, -1, 0\n\tv_mbcnt_hi_u32_b32 %0, -1, %0" : "=v"(l)); return l; }
#define LDS_WAIT() asm volatile("s_waitcnt lgkmcnt(0)" ::: "memory")
#define VM_WAIT() asm volatile("s_waitcnt vmcnt(0)" ::: "memory")

namespace pg8 {
constexpr int BM = 256, BK = 64, HALF = 128, HTB = HALF * BK * 2, STAGE_BYTES = 8 * HTB;
__host__ __device__ __forceinline__ int lds_byte(int r, int c) { const int st = (r >> 4) * 2 + (c >> 5), rr = r & 15, cc = c & 31, ob = rr * 64 + cc * 2; return st * 1024 + (ob ^ (((ob >> 9) & 1) << 5)); }
__host__ __device__ __forceinline__ void stage_rc(int b, int& R, int& C) { const int st = b / 1024, sb = b % 1024, swz = sb ^ (((sb >> 9) & 1) << 5); R = (st >> 1) * 16 + swz / 64; C = (st & 1) * 32 + (swz % 64) / 2; }

struct Unit { int pm, pn, aux; const char* a; const char* b0; const char* b1; };
struct Gemm { int lda, ldb, K, ksplit; };

template <class Epi, class Sched>
__device__ __forceinline__ void gemm_phase(LAS unsigned char* lds, const int wave_in, const Gemm g, const Sched& S, const Epi& E) {
    const int wid = wave_in, lane = lane_id_v(), tid = wid * 64 + lane, wr = wid >> 2, wc = wid & 3, fr = lane & 15, fq = lane >> 4;
    const int K = g.K, nt = K / BK, ks = g.ksplit;
    unsigned voffA[2], voffB[2];
#pragma unroll
    for (int i = 0; i < 2; ++i) { int R, C; stage_rc(tid * 16 + i * 8192, R, C);
        voffA[i] = (unsigned)(R * g.lda + C) * 2u; voffB[i] = (unsigned)(R * g.ldb + C) * 2u; }
    const size_t kstep = (size_t)(BK * 2);
    const size_t hstepA = (size_t)HALF * g.lda * 2, hstepB = (size_t)HALF * g.ldb * 2;
    const unsigned ldsw = (unsigned)wid * 1024u;
    const int aoff = lds_byte(wr * 64 + fr, fq * 8), boff = lds_byte(wc * 32 + fr, fq * 8);
#define PG8_SA(b, h) (((b) * 2 + (h)) * HTB)
#define PG8_SB(b, h) ((4 + (b) * 2 + (h)) * HTB)
#define PG8_STAGE(bufoff, gbase, voff) do { _Pragma("unroll") for (int _i = 0; _i < 2; ++_i) \
        __builtin_amdgcn_global_load_lds((const unsigned*)((const char*)(gbase) + (voff)[_i]), (LAS unsigned*)(lds + (bufoff) + ldsw + _i * 8192), 16, 0, 0); } while (0)
#define PG8_LDA(dst, b, h) do { _Pragma("unroll") for (int m = 0; m < 4; ++m) _Pragma("unroll") for (int k = 0; k < 2; ++k) dst[m][k] = *(const LAS bf16x8*)(lds + PG8_SA(b, h) + aoff + m * 2048 + k * 1024); } while (0)
#define PG8_LDB(dst, b, h) do { _Pragma("unroll") for (int n = 0; n < 2; ++n) _Pragma("unroll") for (int k = 0; k < 2; ++k) dst[n][k] = *(const LAS bf16x8*)(lds + PG8_SB(b, h) + boff + n * 2048 + k * 1024); } while (0)
#define PG8_MMA(ai, bj, At, Bt) do { __builtin_amdgcn_s_setprio(1); _Pragma("unroll") for (int m = 0; m < 4; ++m) _Pragma("unroll") for (int n = 0; n < 2; ++n) _Pragma("unroll") for (int k = 0; k < 2; ++k) \
        acc[ai][bj][m][n] = __builtin_amdgcn_mfma_f32_16x16x32_bf16(Bt[n][k], At[m][k], acc[ai][bj][m][n], 0, 0, 0); __builtin_amdgcn_s_setprio(0); } while (0)
#define PG8_WAIT_V(n) asm volatile("s_waitcnt vmcnt(" #n ")" ::: "memory")
#define PG8_WAIT_L(n) asm volatile("s_waitcnt lgkmcnt(" #n ")" ::: "memory")
#define PG8_BAR __builtin_amdgcn_s_barrier()
#define PG8_SCHED __builtin_amdgcn_sched_barrier(0)
    Unit cur, nxt; int ui = 0;
    if (!S.next(0, cur)) return;
    f32x4 acc[2][2][4][2];
#pragma unroll
    for (int a = 0; a < 2; ++a)
#pragma unroll
        for (int b = 0; b < 2; ++b)
#pragma unroll
            for (int m = 0; m < 4; ++m)
#pragma unroll
                for (int n = 0; n < 2; ++n) acc[a][b][m][n] = (f32x4){0.f, 0.f, 0.f, 0.f};
    bf16x8 At[4][2], B0[2][2], B1[2][2];
    const char* cA = cur.a; const char* cB = cur.b0; const char* cB1 = cur.b1;
    PG8_STAGE(PG8_SB(0, 0), cB, voffB); PG8_STAGE(PG8_SB(0, 1), cB + hstepB, voffB); PG8_STAGE(PG8_SA(0, 0), cA, voffA); PG8_STAGE(PG8_SA(0, 1), cA + hstepA, voffA);
    if (wr == 1) PG8_BAR;
    PG8_WAIT_V(2); PG8_BAR;
    PG8_STAGE(PG8_SB(1, 0), cB + kstep, voffB); PG8_STAGE(PG8_SA(1, 0), cA + kstep, voffA); PG8_STAGE(PG8_SB(1, 1), cB + hstepB + kstep, voffB);
    PG8_WAIT_V(6); PG8_BAR;
    for (;;) {
        const bool has_next = S.next(ui + 1, nxt);
        const char* nA = has_next ? nxt.a : cA; const char* nB = has_next ? nxt.b0 : cB;
        for (int t = 0; t < nt; t += 2) {
            const bool last = (t == nt - 2);
            const char* a1 = cA + (size_t)(t + 1) * kstep;
            const char* a2 = last ? nA : cA + (size_t)(t + 2) * kstep;
            const char* b2 = last ? nB : ((t + 2) < ks ? cB + (size_t)(t + 2) * kstep : cB1 + (size_t)(t + 2 - ks) * kstep);
            const char* a3 = a2 + kstep; const char* b3 = b2 + kstep;
            PG8_LDB(B0, 0, 0); PG8_LDB(B1, 0, 1); PG8_SCHED; PG8_LDA(At, 0, 0); PG8_STAGE(PG8_SA(1, 1), a1 + hstepA, voffA);
            PG8_WAIT_V(8); PG8_WAIT_L(0); PG8_BAR; PG8_MMA(0, 0, At, B0); PG8_MMA(0, 1, At, B1); PG8_BAR; PG8_SCHED;
            PG8_LDA(At, 0, 1); PG8_STAGE(PG8_SB(0, 0), b2, voffB); PG8_STAGE(PG8_SB(0, 1), b2 + hstepB, voffB); PG8_STAGE(PG8_SA(0, 0), a2, voffA);
            PG8_WAIT_V(8); PG8_WAIT_L(0); PG8_BAR; PG8_MMA(1, 0, At, B0); PG8_MMA(1, 1, At, B1); PG8_BAR; PG8_SCHED;
            PG8_LDB(B0, 1, 0); PG8_LDB(B1, 1, 1); PG8_SCHED; PG8_LDA(At, 1, 0); PG8_STAGE(PG8_SA(0, 1), a2 + hstepA, voffA);
            PG8_WAIT_V(8); PG8_WAIT_L(0); PG8_BAR; PG8_MMA(0, 0, At, B0); PG8_MMA(0, 1, At, B1); PG8_BAR; PG8_SCHED;
            PG8_LDA(At, 1, 1); PG8_STAGE(PG8_SB(1, 0), b3, voffB); PG8_STAGE(PG8_SB(1, 1), b3 + hstepB, voffB); PG8_STAGE(PG8_SA(1, 0), a3, voffA);
            PG8_WAIT_V(8); PG8_WAIT_L(0); PG8_BAR; PG8_MMA(1, 0, At, B0); PG8_MMA(1, 1, At, B1); PG8_BAR; PG8_SCHED;
        }
        if (wr == 0) PG8_BAR;
        E(acc, cur, wr, wc, fr, fq);
        if (!has_next) break;
#pragma unroll
        for (int a = 0; a < 2; ++a)
#pragma unroll
            for (int b = 0; b < 2; ++b)
#pragma unroll
                for (int m = 0; m < 4; ++m)
#pragma unroll
                    for (int n = 0; n < 2; ++n) acc[a][b][m][n] = (f32x4){0.f, 0.f, 0.f, 0.f};
        cur = nxt; cA = nA; cB = nB; cB1 = nxt.b1; ++ui;
        if (wr == 1) PG8_BAR;
    }
    PG8_WAIT_V(0);
    PG8_BAR;
#undef PG8_SA
#undef PG8_SB
#undef PG8_STAGE
#undef PG8_LDA
#undef PG8_LDB
#undef PG8_MMA
#undef PG8_WAIT_V
#undef PG8_WAIT_L
#undef PG8_BAR
#undef PG8_SCHED
}

struct DenseSched {
    int nM, nN, nwg, G, c; const char* A; const char* B; size_t tA, tB;
    __device__ void init(int M, int N, int G_, int c_, const bf16_t* A_, int lda, const bf16_t* B_, int ldb) { nM = M / 256; nN = N / 256; nwg = nM * nN; G = G_; c = c_; A = (const char*)A_; B = (const char*)B_; tA = (size_t)256 * lda * 2; tB = (size_t)256 * ldb * 2; }
    __device__ bool next(int i, Unit& u) const {
        const long L = (long)i * G + c; if (L >= nwg) return false;
        int wgid = (int)L; { const int q = nwg / 8, r = nwg % 8, xcd = wgid % 8, off = wgid / 8; wgid = (xcd < r ? xcd * (q + 1) : r * (q + 1) + (xcd - r) * q) + off; }
        const int nig = 8 * nN, gid = wgid / nig, fm = gid * 8, gsz = (nM - fm) < 8 ? (nM - fm) : 8;
        u.pm = fm + ((wgid % nig) % gsz); u.pn = (wgid % nig) / gsz; u.aux = 256;
        u.a = A + (size_t)u.pm * tA; u.b0 = B + (size_t)u.pn * tB; u.b1 = u.b0; return true;
    }
};
}
using pg8::Unit;

__device__ __forceinline__ float row_rstd(const float* ssp, int row) {
    const f32x4* p = (const f32x4*)(ssp + (size_t)row * 16);
    const f32x4 a = p[0], b = p[1], c = p[2], d = p[3];
    const float s = ((a.x + a.y) + (a.z + a.w)) + ((b.x + b.y) + (b.z + b.w)) + ((c.x + c.y) + (c.z + c.w)) + ((d.x + d.y) + (d.z + d.w));
    return 1.0f / sqrtf(s * (1.0f / 1024.0f) + 1e-6f);
}
__device__ __forceinline__ unsigned short f2h_bits(float f) { _Float16 h = (_Float16)f; return __builtin_bit_cast(unsigned short, h); }
__device__ __forceinline__ float h2f_bits(unsigned short b) { return (float)__builtin_bit_cast(_Float16, b); }

template <int MODE> struct EpiScale {
    bf16_t* O; int ldc; const float* ssp; float scale; const float* lb;
    __device__ __forceinline__ void operator()(const f32x4 (&acc)[2][2][4][2], const Unit& u, int wr, int wc, int fr_in, int fq_in) const {
        int fr = fr_in, fq = fq_in; asm volatile("" : "+v"(fr), "+v"(fq));
#pragma unroll
        for (int ai = 0; ai < 2; ++ai)
#pragma unroll
            for (int m = 0; m < 4; ++m) {
                const int row = u.pm * 256 + ai * 128 + wr * 64 + m * 16 + fr;
                const float rs = (MODE == 2) ? scale : row_rstd(ssp, row) * scale;
#pragma unroll
                for (int bj = 0; bj < 2; ++bj)
#pragma unroll
                    for (int n = 0; n < 2; ++n) {
                        const int col = u.pn * 256 + bj * 128 + wc * 32 + n * 16 + fq * 4;
                        f32x4 v = acc[ai][bj][m][n] * rs;
                        u32x2 w;
                        if (MODE == 1) {
                            const int blk = col >> 10;
                            if (blk == 0) { v.x = siluf_(v.x); v.y = siluf_(v.y); v.z = siluf_(v.z); v.w = siluf_(v.w); }
                            if (blk == 1) {
                                const f32x4 l = *(const f32x4*)(lb + (col - 1024));
                                float o[4]; const float vv[4] = {v.x, v.y, v.z, v.w}; const float ll[4] = {l.x, l.y, l.z, l.w};
#pragma unroll
                                for (int j = 0; j < 4; ++j) o[j] = __logf(ll[j] + (1.f - ll[j]) * sigmoidf_(vv[j]));
                                w.x = (unsigned)f2h_bits(o[0]) | ((unsigned)f2h_bits(o[1]) << 16); w.y = (unsigned)f2h_bits(o[2]) | ((unsigned)f2h_bits(o[3]) << 16);
                            } else { w.x = pk2(v.x, v.y); w.y = pk2(v.z, v.w); }
                        } else { w.x = pk2(v.x, v.y); w.y = pk2(v.z, v.w); }
                        *(u32x2*)(O + (size_t)row * ldc + col) = w;
                    }
            }
    }
};
struct EpiKV {
    bf16_t* Kb; bf16_t* VT;
    __device__ __forceinline__ void operator()(const f32x4 (&acc)[2][2][4][2], const Unit& u, int wr, int wc, int fr_in, int fq_in) const {
        int fr = fr_in, fq = fq_in; asm volatile("" : "+v"(fr), "+v"(fq));
#pragma unroll
        for (int ai = 0; ai < 2; ++ai)
#pragma unroll
            for (int m = 0; m < 4; ++m) {
                const int row = u.pm * 256 + ai * 128 + wr * 64 + m * 16 + fr;
#pragma unroll
                for (int bj = 0; bj < 2; ++bj)
#pragma unroll
                    for (int n = 0; n < 2; ++n) {
                        const int col = u.pn * 256 + bj * 128 + wc * 32 + n * 16 + fq * 4;
                        const f32x4 v = acc[ai][bj][m][n];
                        if (col < 1024) { u32x2 w; w.x = pk2(v.x, v.y); w.y = pk2(v.z, v.w); *(u32x2*)(Kb + (size_t)row * 1024 + col) = w; }
                        else {
                            const int c2 = col - 1024, h = c2 >> 8, d = c2 & 255, b = row >> 8, mm = row & 255;
                            bf16_t* p = VT + ((size_t)((b * 4 + h) * 256 + d)) * 256 + mm;
                            p[0] = (bf16_t)f2bf(v.x); p[256] = (bf16_t)f2bf(v.y); p[512] = (bf16_t)f2bf(v.z); p[768] = (bf16_t)f2bf(v.w);
                        }
                    }
            }
    }
};
template <bool SCATTER> struct EpiResid {
    const float* base; float* XF; bf16_t* XB; float* ssp; const f32x4* rowinfo;
    __device__ __forceinline__ void operator()(const f32x4 (&acc)[2][2][4][2], const Unit& u, int wr, int wc, int fr_in, int fq_in) const {
        int fr = fr_in, fq = fq_in; asm volatile("" : "+v"(fr), "+v"(fq));
#pragma unroll
        for (int ai = 0; ai < 2; ++ai)
#pragma unroll
            for (int m = 0; m < 4; ++m) {
                const int lrow = ai * 128 + wr * 64 + m * 16 + fr;
                const int row = u.pm * 256 + lrow;
                int tok = row; bool valid = true;
                if (SCATTER) { valid = lrow < u.aux; const f32x4 ri = rowinfo[row]; tok = valid ? __float_as_int(ri.w) : 0; }
                float ss = 0.f;
#pragma unroll
                for (int bj = 0; bj < 2; ++bj)
#pragma unroll
                    for (int n = 0; n < 2; ++n) {
                        const int col = u.pn * 256 + bj * 128 + wc * 32 + n * 16 + fq * 4;
                        const size_t off = (size_t)tok * 1024 + col;
                        if (valid) {
                            const f32x4 b = *(const f32x4*)(base + off);
                            const f32x4 v = b + acc[ai][bj][m][n];
                            *(f32x4*)(XF + off) = v;
                            u32x2 w; w.x = pk2(v.x, v.y); w.y = pk2(v.z, v.w); *(u32x2*)(XB + off) = w;
                            ss += (v.x * v.x + v.y * v.y) + (v.z * v.z + v.w * v.w);
                        }
                    }
                ss += __shfl_xor(ss, 16); ss += __shfl_xor(ss, 32);
                if (valid && fq == 0) ssp[(size_t)tok * 16 + u.pn * 4 + wc] = ss;
            }
    }
};
struct EpiMoeUp {
    bf16_t* HID; const f32x4* rowinfo;
    __device__ __forceinline__ void operator()(const f32x4 (&acc)[2][2][4][2], const Unit& u, int wr, int wc, int fr_in, int fq_in) const {
        int fr = fr_in, fq = fq_in; asm volatile("" : "+v"(fr), "+v"(fq));
        const int slot = u.pn >> 1, jj = u.pn & 1;
#pragma unroll
        for (int ai = 0; ai < 2; ++ai)
#pragma unroll
            for (int m = 0; m < 4; ++m) {
                const int row = u.pm * 256 + ai * 128 + wr * 64 + m * 16 + fr;
                const f32x4 ri = rowinfo[row];
                const float rs = ri.x, gt = slot ? ri.z : ri.y;
#pragma unroll
                for (int n = 0; n < 2; ++n) {
                    const f32x4 h1 = acc[ai][0][m][n] * rs, h3 = acc[ai][1][m][n] * rs;
                    const int col = slot * 256 + jj * 128 + wc * 32 + n * 16 + fq * 4;
                    u32x2 w; w.x = pk2(siluf_(h1.x) * h3.x * gt, siluf_(h1.y) * h3.y * gt); w.y = pk2(siluf_(h1.z) * h3.z * gt, siluf_(h1.w) * h3.w * gt);
                    *(u32x2*)(HID + (size_t)row * 512 + col) = w;
                }
            }
    }
};
__device__ __forceinline__ void pair_experts(int bucket, int& ea, int& eb) {
    const int g = bucket / 6, p = bucket % 6;
    const int i = (p < 3) ? 0 : (p < 5 ? 1 : 2);
    const int j = (p < 3) ? p + 1 : (p < 5 ? p - 1 : 3);
    ea = g * 4 + i; eb = g * 4 + j;
}
template <bool DOWN> struct MoeSched {
    const LAS int* tbl; int ntiles, G, c; const char* A; const char* W;
    __device__ bool next(int i, Unit& u) const {
        const int L = i * G + c, mt = L >> 2, pn = L & 3;
        if (mt >= ntiles) return false;
        const int ent = __builtin_amdgcn_readfirstlane(tbl[mt]), bucket = ent & 255; u.aux = ent >> 8;
        int ea, eb; pair_experts(bucket, ea, eb);
        u.pm = mt; u.pn = pn;
        if (!DOWN) { u.a = A + (size_t)mt * 256 * 1024 * 2; const int e = (pn < 2) ? ea : eb; u.b0 = W + ((size_t)e * 512 + 256 * (pn & 1)) * 1024 * 2; u.b1 = u.b0; }
        else { u.a = A + (size_t)mt * 256 * 512 * 2; u.b0 = W + ((size_t)ea * 1024 + 256 * pn) * 256 * 2; u.b1 = W + ((size_t)eb * 1024 + 256 * pn) * 256 * 2; }
        return true;
    }
};
__device__ __forceinline__ void moe_build_table(LAS int* tbl, const unsigned* cnt, int tid) {
    if (tid == 0) { int mt = 0;
        for (int b = 0; b < 24; ++b) { const int nb = (int)cnt[b]; for (int r = 0; r < nb; r += 256) { const int v = (nb - r) < 256 ? (nb - r) : 256; if (mt < 95) tbl[mt] = b | (v << 8); ++mt; } }
        tbl[95] = mt < 95 ? mt : 95; }
    __syncthreads();
}

#define XB_TMO      128
#define XB_XCNT(j)  (256  + 64 * (j))
#define XB_XSUB(j)  (1280 + 64 * (j))
#define XB_XGEN(j)  (2304 + 64 * (j))
#define XB_TOP      3328
#define XB_TOPGEN   3392
#define XCD_BAR_WORDS 3456
#define XB_SPIN_CAP (1u << 22)
__device__ __forceinline__ unsigned xb_ld(unsigned* p)              { return __hip_atomic_load(p, __ATOMIC_RELAXED, __HIP_MEMORY_SCOPE_AGENT); }
__device__ __forceinline__ unsigned xb_add(unsigned* p, unsigned v) { return __hip_atomic_fetch_add(p, v, __ATOMIC_RELAXED, __HIP_MEMORY_SCOPE_AGENT); }
__device__ __forceinline__ unsigned xb_xcc_id() { return (unsigned)__builtin_amdgcn_s_getreg((3 << 11) | 20) & 0xFu; }
#define XB_SPIN(cond, bar) do { unsigned _sp = 0; while (cond) { __builtin_amdgcn_s_sleep(1); \
    if ((++_sp & 255u) == 0u) { if (xb_ld(&(bar)[XB_TMO])) break; if (_sp > XB_SPIN_CAP) { atomicAdd(&(bar)[XB_TMO], 1u); break; } } } } while (0)
struct XcdBarrier { unsigned* bar; unsigned x; volatile LAS unsigned* st; int wave; };
__device__ __forceinline__ XcdBarrier xcd_barrier_post(unsigned* bar, volatile LAS unsigned* st, int wave) {
    XcdBarrier b; b.bar = bar; b.x = xb_xcc_id(); b.st = st; b.wave = wave;
    if (wave == 0 && lane_id_v() == 0) (void)xb_add(&bar[XB_XCNT(b.x)], 1u);
    return b;
}
__device__ __forceinline__ void xcd_barrier_complete(unsigned* bar, unsigned x, unsigned& nloc, unsigned& nx) {
    const unsigned G = gridDim.x * gridDim.y * gridDim.z;
    unsigned sum, cnt, mine, sp = 0u;
    for (;;) {
        sum = 0u; cnt = 0u; mine = 0u;
#pragma unroll
        for (unsigned j = 0; j < 16; ++j) { const unsigned c = xb_ld(&bar[XB_XCNT(j)]); sum += c; cnt += (c > 0u) ? 1u : 0u; mine = (j == x) ? c : mine; }
        if (sum == G) break;
        __builtin_amdgcn_s_sleep(1);
        if ((++sp & 255u) == 0u) { if (xb_ld(&bar[XB_TMO])) break; if (sp > XB_SPIN_CAP) { atomicAdd(&bar[XB_TMO], 1u); break; } }
    }
    nloc = mine > 0u ? mine : 1u; nx = cnt > 0u ? cnt : 1u;
}
__device__ __forceinline__ void xcd_barrier(const XcdBarrier& b) {
    asm volatile("s_waitcnt vmcnt(0)" ::: "memory");
    __syncthreads();
    if (b.wave == 0 && lane_id_v() == 0) {
        unsigned* bar = b.bar;
        __builtin_amdgcn_s_waitcnt(0);
        unsigned nloc = b.st[0], nx = b.st[1];
        if (nloc == 0u) { xcd_barrier_complete(bar, b.x, nloc, nx); b.st[0] = nloc; b.st[1] = nx; }
        const unsigned old = xb_add(&bar[XB_XSUB(b.x)], 1u);
        const unsigned gen = old / nloc;
        if (old + 1u == (gen + 1u) * nloc) {
            __builtin_amdgcn_fence(__ATOMIC_RELEASE, "agent");
            asm volatile("s_waitcnt vmcnt(0)" ::: "memory");
            const unsigned og = xb_add(&bar[XB_TOP], 1u);
            const unsigned tg = og / nx;
            if (og + 1u == (tg + 1u) * nx) xb_add(&bar[XB_TOPGEN], 1u);
            else XB_SPIN(xb_ld(&bar[XB_TOPGEN]) == tg, bar);
            __builtin_amdgcn_fence(__ATOMIC_ACQUIRE, "agent");
            xb_add(&bar[XB_XGEN(b.x)], 1u);
            asm volatile("s_waitcnt vmcnt(0)" ::: "memory");
        } else {
            XB_SPIN(xb_ld(&bar[XB_XGEN(b.x)]) == gen, bar);
            __builtin_amdgcn_fence(__ATOMIC_ACQUIRE, "agent");
            asm volatile("s_waitcnt vmcnt(0)" ::: "memory");
        }
    }
    __syncthreads();
}

struct Args { const float* in[38]; float* out; unsigned char* ws; int ph_lo, ph_hi; };
constexpr int LDS_BYTES = 161792;
constexpr int LDS_MISC = 156 * 1024;
struct InTab {
    const LAS unsigned long long* t;
    __device__ __forceinline__ const float* operator[](int i) const {
        const unsigned long long v = t[i];
        const unsigned lo = __builtin_amdgcn_readfirstlane((unsigned)v), hi = __builtin_amdgcn_readfirstlane((unsigned)(v >> 32));
        return (const float*)(((unsigned long long)hi << 32) | lo); }
};
struct Frame {
    LAS unsigned char* lds; int wave, G, wg;
    InTab in; float* out; unsigned char* ws;
};
#define IN_X 0
#define IN_MEM 1
#define IN_NORM_MIX 2
#define IN_NORM_XA 3
#define IN_NORM_MEM 4
#define IN_NORM_FFN 5
#define IN_NORM_FINAL 6
#define IN_AB_WIN 7
#define IN_AB_CONV 8
#define IN_AB_ALOG 9
#define IN_AB_DTB 10
#define IN_AB_ONORM 11
#define IN_AB_MU 12
#define IN_AB_W0 13
#define IN_AB_W2 14
#define IN_AB_A0 15
#define IN_AB_A2 16
#define IN_AB_G2 17
#define IN_AB_KK 18
#define IN_AB_KA 19
#define IN_AB_RK 20
#define IN_AB_LNW 21
#define IN_AB_LNB 22
#define IN_AB_WOUT 23
#define IN_C_WIN 24
#define IN_C_LB 25
#define IN_C_ONORM 26
#define IN_C_WOUT 27
#define IN_XA_WQ 28
#define IN_XA_WKV 29
#define IN_XA_WO 30
#define IN_MOE_WG 31
#define IN_MOE_BG 32
#define IN_MOE_WE 33
#define IN_MOE_BE 34
#define IN_MOE_W1 35
#define IN_MOE_W3 36
#define IN_MOE_W2 37

__device__ __forceinline__ void p0_transpose_item(const float* W, int ld, int col0, int ncols, int K, const float* gain, bf16_t* WT, int drow0, LAS float* scr, int item, int lane) {
    const int nblk = ncols / 32, kb = item / nblk, nb = item % nblk, k0 = 64 * kb, n0 = 32 * nb;
#pragma unroll 8
    for (int i = 0; i < 32; ++i) { const int kk = 2 * i + (lane >> 5); float v = W[(size_t)(k0 + kk) * ld + col0 + n0 + (lane & 31)]; if (gain) v *= gain[k0 + kk]; scr[kk * 33 + (lane & 31)] = v; }
    LDS_WAIT(); asm volatile("" ::: "memory");
    const int c = lane & 7;
#pragma unroll
    for (int j = 0; j < 4; ++j) { const int n = (lane >> 3) + 8 * j; const LAS float* s = scr + (8 * c) * 33 + n;
        u32x4 o; o.x = pk2(s[0 * 33], s[1 * 33]); o.y = pk2(s[2 * 33], s[3 * 33]); o.z = pk2(s[4 * 33], s[5 * 33]); o.w = pk2(s[6 * 33], s[7 * 33]);
        *(u32x4*)(WT + (size_t)(drow0 + n0 + n) * K + k0 + 8 * c) = o; }
    LDS_WAIT(); asm volatile("" ::: "memory");
}
__device__ __forceinline__ void p0_weight_item(const Frame& F, int it, LAS float* scr, int lane) {
    const InTab in = F.in;
    bf16_t* W0 = (bf16_t*)(F.ws + WS_W0); bf16_t* W1 = (bf16_t*)(F.ws + WS_W1);
    if (it < 16384) {
        const int l = it >> 13; int r = it & 8191; bf16_t* W = l ? W1 : W0;
        if (r < 512) { p0_transpose_item(in[IN_XA_WQ] + (size_t)l * 1024 * 1024, 1024, 0, 1024, 1024, in[IN_NORM_XA] + l * 1024, W + WO_WQ, 0, scr, r, lane); return; }
        r -= 512;
        if (r < 1024) { p0_transpose_item(in[IN_XA_WKV] + (size_t)l * 1024 * 2048, 2048, 0, 2048, 1024, in[IN_NORM_MEM] + l * 1024, W + WO_WKV, 0, scr, r, lane); return; }
        r -= 1024;
        if (r < 512) { p0_transpose_item(in[IN_XA_WO] + (size_t)l * 1024 * 1024, 1024, 0, 1024, 1024, nullptr, W + WO_WO, 0, scr, r, lane); return; }
        r -= 512;
        if (r < 4096) { const int sub = r >> 6, item = r & 63, e = sub >> 2, j = (sub >> 1) & 1, which = sub & 1;
            const float* src = (which ? in[IN_MOE_W3] : in[IN_MOE_W1]) + (size_t)(l * 16 + e) * 1024 * 256;
            p0_transpose_item(src, 256, 128 * j, 128, 1024, in[IN_NORM_FFN] + l * 1024, W + WO_W13, e * 512 + 256 * j + 128 * which, scr, item, lane); return; }
        r -= 4096;
        { const int e = r >> 7, item = r & 127;
            p0_transpose_item(in[IN_MOE_W2] + (size_t)(l * 16 + e) * 256 * 1024, 1024, 0, 1024, 256, nullptr, W + WO_W2T + (size_t)e * 1024 * 256, 0, scr, item, lane); return; }
    }
    int r = it - 16384;
    if (r < 1024) { p0_transpose_item(in[IN_AB_WIN], 3848, 0, 2048, 1024, in[IN_NORM_MIX], W0 + WO_WIN, 0, scr, r, lane); return; }
    r -= 1024;
    if (r < 896) { p0_transpose_item(in[IN_AB_WIN], 3848, 2056, 1792, 1024, in[IN_NORM_MIX], W0 + WO_WIN, 2048, scr, r, lane); return; }
    r -= 896;
    if (r < 512) { p0_transpose_item(in[IN_AB_WOUT], 1024, 0, 1024, 1024, nullptr, W0 + WO_WOUT, 0, scr, r, lane); return; }
    r -= 512;
    if (r < 2048) { p0_transpose_item(in[IN_C_WIN], 4096, 0, 4096, 1024, in[IN_NORM_MIX] + 1024, W1 + WO_WIN, 0, scr, r, lane); return; }
    r -= 2048;
    if (r < 512) { p0_transpose_item(in[IN_C_WOUT], 1024, 0, 1024, 1024, nullptr, W1 + WO_WOUT, 0, scr, r, lane); return; }
    r -= 512;
    bf16_t* LW = (bf16_t*)(F.ws + WS_LORA);
    if (r < 16) { p0_transpose_item(in[IN_AB_W2], 512, 0, 512, 64, nullptr, LW, 0, scr, r, lane); return; }
    r -= 16;
    if (r < 16) { p0_transpose_item(in[IN_AB_A2], 512, 0, 512, 64, nullptr, LW + 512 * 64, 0, scr, r, lane); return; }
    r -= 16;
    p0_transpose_item(in[IN_AB_G2], 512, 0, 512, 128, nullptr, LW + 2 * 512 * 64, 0, scr, r, lane);
}
constexpr int P0_NITEMS = 16384 + 1024 + 896 + 512 + 2048 + 512 + 64;

__device__ __forceinline__ void p0_prologue(const Frame& F) {
    const int lane = lane_id_v(); const int tid = F.wave * 64 + lane; (void)tid;
    LAS float* scr = (LAS float*)(F.lds + F.wave * 16384);
    const int gw = F.wg * NWAVES + F.wave, NGW = F.G * NWAVES;
    for (int it = gw; it < P0_NITEMS; it += NGW) p0_weight_item(F, it, scr, lane);
    const float* x = F.in[IN_X]; const float* gain = F.in[IN_NORM_MIX]; const float* win = F.in[IN_AB_WIN];
    bf16_t* XB = (bf16_t*)(F.ws + WS_XB); float* ssp = (float*)(F.ws + WS_SSP); float* db = (float*)(F.ws + WS_DB);
    for (int row = gw; row < NT; row += NGW) {
        const f32x4* xr = (const f32x4*)(x + (size_t)row * 1024) + lane;
        f32x4 v[4]; float s = 0.f; float d[8];
#pragma unroll
        for (int c = 0; c < 8; ++c) d[c] = 0.f;
#pragma unroll
        for (int j = 0; j < 4; ++j) {
            v[j] = xr[64 * j]; s += (v[j].x * v[j].x + v[j].y * v[j].y) + (v[j].z * v[j].z + v[j].w * v[j].w);
            const int k0 = 4 * lane + 256 * j;
            const f32x4 g = *(const f32x4*)(gain + k0);
            const float xv[4] = {v[j].x * g.x, v[j].y * g.y, v[j].z * g.z, v[j].w * g.w};
#pragma unroll
            for (int q = 0; q < 4; ++q) {
                const f32x4 w0 = *(const f32x4*)(win + (size_t)(k0 + q) * 3848 + 2048), w1 = *(const f32x4*)(win + (size_t)(k0 + q) * 3848 + 2052);
                d[0] += xv[q] * w0.x; d[1] += xv[q] * w0.y; d[2] += xv[q] * w0.z; d[3] += xv[q] * w0.w;
                d[4] += xv[q] * w1.x; d[5] += xv[q] * w1.y; d[6] += xv[q] * w1.z; d[7] += xv[q] * w1.w;
            }
        }
        s = wave_sum(s);
        const float rstd = 1.0f / sqrtf(s * (1.0f / 1024.0f) + 1e-6f);
#pragma unroll
        for (int c = 0; c < 8; ++c) d[c] = wave_sum(d[c]) * rstd;
        unsigned long long* o8 = (unsigned long long*)(XB + (size_t)row * 1024) + lane;
#pragma unroll
        for (int j = 0; j < 4; ++j) o8[64 * j] = (unsigned long long)pk2(v[j].x, v[j].y) | ((unsigned long long)pk2(v[j].z, v[j].w) << 32);
        if (lane < 16) ssp[(size_t)row * 16 + lane] = (lane == 0) ? s : 0.f;
        if (lane < 8) { float dv = d[0];
#pragma unroll
            for (int c = 1; c < 8; ++c) dv = (lane == c) ? d[c] : dv;
            db[(size_t)row * 8 + lane] = dv; }
    }
    const float* mem = F.in[IN_MEM]; bf16_t* MH = (bf16_t*)(F.ws + WS_MEMH);
    for (int row = gw; row < NB * NMEM; row += NGW) {
        const f32x4* xr = (const f32x4*)(mem + (size_t)row * 1024) + lane;
        f32x4 v[4]; float s = 0.f;
#pragma unroll
        for (int j = 0; j < 4; ++j) { v[j] = xr[64 * j]; s += (v[j].x * v[j].x + v[j].y * v[j].y) + (v[j].z * v[j].z + v[j].w * v[j].w); }
        s = wave_sum(s);
        const float rstd = 1.0f / sqrtf(s * (1.0f / 1024.0f) + 1e-6f);
        unsigned long long* o8 = (unsigned long long*)(MH + (size_t)row * 1024) + lane;
#pragma unroll
        for (int j = 0; j < 4; ++j) o8[64 * j] = (unsigned long long)pk2(v[j].x * rstd, v[j].y * rstd) | ((unsigned long long)pk2(v[j].z * rstd, v[j].w * rstd) << 32);
    }
    if (F.wg == 0) { const float* lbp = F.in[IN_C_LB]; float* lb = (float*)(F.ws + WS_LB);
        for (int c = tid; c < 1024; c += NTHREADS) { const float a = lbp[c], b = lbp[1024 + c]; const float mx = fmaxf(a, b), ea = __expf(a - mx), eb = __expf(b - mx); lb[c] = (ea + eb) / (ea + eb) - ea / (ea + eb); } }
}

__device__ __forceinline__ void scan_delta(const Frame& F, int b, int h) {
    const int lane = lane_id_v(); const int tid = F.wave * 64 + lane; (void)tid;
    LAS float* qs = (LAS float*)F.lds;
    LAS float* ks = qs + 64 * 128;
    LAS float* vs = ks + 64 * 128;
    LAS float* os = vs + 64 * 128;
    LAS float* al = os + 64 * 128;
    LAS float* be = al + 64;
    bf16_t* P = (bf16_t*)(F.ws + WS_BIG + BIG_PROJ);
    const float* convw = F.in[IN_AB_CONV];
    const float* db = (const float*)(F.ws + WS_DB);
    const float a_neg = -__expf(F.in[IN_AB_ALOG][h]), dtb = F.in[IN_AB_DTB][h];
    const float* onorm = F.in[IN_AB_ONORM];
    const int i_dv = tid >> 2, part = tid & 3;
    float s[32];
#pragma unroll
    for (int j = 0; j < 32; ++j) s[j] = 0.f;
    for (int c = 0; c < 32; ++c) {
        const int t0 = b * TS + c * 64;
        for (int idx = tid; idx < 64 * 384; idx += NTHREADS) {
            const int t = idx / 384, cc = idx % 384, sct = cc >> 7, col = cc & 127;
            const int gcol = sct * 512 + h * 128 + col;
            float a = 0.f;
#pragma unroll
            for (int j = 0; j < 4; ++j) { const int tl = c * 64 + t - 3 + j; if (tl >= 0) a += convw[j * 1536 + gcol] * bf2f(P[(size_t)(b * TS + tl) * P0LD + gcol]); }
            a = siluf_(a);
            (sct == 0 ? qs : (sct == 1 ? ks : vs))[t * 128 + col] = a;
        }
        if (tid < 64) { const int t = tid; const float la = a_neg * softplusf_(db[(size_t)(t0 + t) * 8 + h] + dtb); al[t] = __expf(la); be[t] = sigmoidf_(db[(size_t)(t0 + t) * 8 + 4 + h]); }
        __syncthreads();
        for (int r = F.wave; r < 128; r += NWAVES) { LAS float* p = (r < 64 ? qs + r * 128 : ks + (r - 64) * 128);
            const float v0 = p[lane], v1 = p[lane + 64]; const float ss = wave_sum(v0 * v0 + v1 * v1);
            const float sc = (1.0f / sqrtf(ss + 1e-6f)) * (r < 64 ? 0.08838834764831845f : 1.0f); p[lane] = v0 * sc; p[lane + 64] = v1 * sc; }
        __syncthreads();
        for (int t = 0; t < 64; ++t) {
            const LAS f32x4* kp = (const LAS f32x4*)(ks + t * 128 + part * 32); const LAS f32x4* qp = (const LAS f32x4*)(qs + t * 128 + part * 32);
            float kt[32], qt[32];
#pragma unroll
            for (int j = 0; j < 8; ++j) { const f32x4 a = kp[j], q = qp[j]; kt[4 * j] = a.x; kt[4 * j + 1] = a.y; kt[4 * j + 2] = a.z; kt[4 * j + 3] = a.w; qt[4 * j] = q.x; qt[4 * j + 1] = q.y; qt[4 * j + 2] = q.z; qt[4 * j + 3] = q.w; }
            float p = 0.f;
#pragma unroll
            for (int j = 0; j < 32; ++j) p += s[j] * kt[j];
            p += __shfl_xor(p, 1); p += __shfl_xor(p, 2);
            const float alpha = al[t], coef = be[t] * (vs[t * 128 + i_dv] - alpha * p);
            float o = 0.f;
#pragma unroll
            for (int j = 0; j < 32; ++j) { s[j] = alpha * s[j] + coef * kt[j]; o += s[j] * qt[j]; }
            o += __shfl_xor(o, 1); o += __shfl_xor(o, 2);
            if (part == 0) os[t * 128 + i_dv] = o;
        }
        __syncthreads();
        for (int t = F.wave; t < 64; t += NWAVES) {
            const float o0 = os[t * 128 + lane], o1 = os[t * 128 + lane + 64];
            const float ss = wave_sum(o0 * o0 + o1 * o1), rs = 1.0f / sqrtf(ss * (1.0f / 128.0f) + 1e-6f);
            bf16_t* gp = P + (size_t)(t0 + t) * P0LD + 1536 + h * 128;
            const float g0 = bf2f(gp[lane]), g1 = bf2f(gp[lane + 64]);
            gp[lane] = (bf16_t)f2bf(o0 * rs * onorm[lane] * siluf_(g0)); gp[lane + 64] = (bf16_t)f2bf(o1 * rs * onorm[lane + 64] * siluf_(g1));
        }
        __syncthreads();
    }
}
__device__ __forceinline__ void scan_rwkv(const Frame& F, int b, int h) {
    const int lane = lane_id_v(); const int tid = F.wave * 64 + lane; (void)tid;
    LAS float* bufA = (LAS float*)F.lds;
    LAS float* bufB = bufA + 4096;
    LAS float* bufC = bufB + 4096;
    LAS float* R = bufC + 8192;
    LAS float* Kb = R + 4096;
    LAS float* V = Kb + 4096;
    LAS float* KK = V + 4096;
    LAS float* halo = KK + 4096;
    LAS float* bonus = halo + 896;
    bf16_t* P = (bf16_t*)(F.ws + WS_BIG + BIG_PROJ);
    const float* mu = F.in[IN_AB_MU];
    const float* w0 = F.in[IN_AB_W0] + h * 64; const float* w2 = F.in[IN_AB_W2] + h * 64;
    const float* a0 = F.in[IN_AB_A0] + h * 64; const float* a2 = F.in[IN_AB_A2] + h * 64;
    const float* g2 = F.in[IN_AB_G2] + h * 64;
    const float* k_k = F.in[IN_AB_KK] + h * 64; const float* k_a = F.in[IN_AB_KA] + h * 64; const float* r_k = F.in[IN_AB_RK] + h * 64;
    const float* ln_w = F.in[IN_AB_LNW] + h * 64; const float* ln_b = F.in[IN_AB_LNB] + h * 64;
    const int vi = tid >> 3, part = tid & 7;
    float s[8];
#pragma unroll
    for (int j = 0; j < 8; ++j) s[j] = 0.f;
    for (int i = tid; i < 896; i += NTHREADS) halo[i] = 0.f;
    __syncthreads();
    for (int c = 0; c < 32; ++c) {
        const int t0 = b * TS + c * 64;
        const LAS float* hcur = halo + (c & 1) * 448; LAS float* hnext = halo + ((c + 1) & 1) * 448;
        for (int idx = tid; idx < 64 * 448; idx += NTHREADS) {
            const int t = idx / 448, col = idx % 448;
            int gc;
            if (col < 64) gc = 2048 + h * 64 + col; else if (col < 128) gc = 2560 + h * 64 + (col - 64); else if (col < 192) gc = 3072 + h * 64 + (col - 128); else gc = 3584 + (col - 192);
            const float cur = bf2f(P[(size_t)(t0 + t) * P0LD + gc]);
            const float prev = (t > 0) ? bf2f(P[(size_t)(t0 + t - 1) * P0LD + gc]) : hcur[col];
            const float sh = cur + mu[gc - 2048] * (prev - cur);
            if (t == 63) hnext[col] = cur;
            if (col < 64) R[t * 64 + col] = sh; else if (col < 128) Kb[t * 64 + col - 64] = sh; else if (col < 192) V[t * 64 + col - 128] = sh;
            else if (col < 256) bufA[t * 64 + col - 192] = tanhf(sh); else if (col < 320) bufB[t * 64 + col - 256] = sh; else bufC[t * 128 + col - 320] = sigmoidf_(sh);
        }
        __syncthreads();
        float wv[8], av[8], gv[8];
        {
            const int j = lane, tb = F.wave * 8;
#pragma unroll
            for (int q = 0; q < 8; ++q) { wv[q] = 0.f; av[q] = 0.f; gv[q] = 0.f; }
            for (int m = 0; m < 64; ++m) { const float x2 = w2[(size_t)m * 512 + j], y2 = a2[(size_t)m * 512 + j];
#pragma unroll
                for (int q = 0; q < 8; ++q) { wv[q] += bufA[(tb + q) * 64 + m] * x2; av[q] += bufB[(tb + q) * 64 + m] * y2; } }
            for (int m = 0; m < 128; ++m) { const float z2 = g2[(size_t)m * 512 + j];
#pragma unroll
                for (int q = 0; q < 8; ++q) gv[q] += bufC[(tb + q) * 128 + m] * z2; }
#pragma unroll
            for (int q = 0; q < 8; ++q) { wv[q] = __expf(-0.6065306597126334f * sigmoidf_(w0[j] + wv[q])); av[q] = sigmoidf_(a0[j] + av[q]); }
        }
        __syncthreads();
        {
            const int j = lane, tb = F.wave * 8;
#pragma unroll
            for (int q = 0; q < 8; ++q) { bufA[(tb + q) * 64 + j] = wv[q]; bufB[(tb + q) * 64 + j] = av[q]; bufC[(tb + q) * 64 + j] = gv[q]; }
#pragma unroll
            for (int q = 0; q < 8; ++q) { const int t = tb + q; const float kv = Kb[t * 64 + j]; const float kx = kv * k_k[j]; const float ss = wave_sum(kx * kx);
                KK[t * 64 + j] = kx * (1.0f / sqrtf(ss + 1e-6f)); const float km = kv * (1.f + (av[q] - 1.f) * k_a[j]); Kb[t * 64 + j] = km;
                const float bs = wave_sum(R[t * 64 + j] * km * r_k[j]); if (j == 0) bonus[t] = bs; }
        }
        __syncthreads();
        LAS float* O = bufC + 4096;
        for (int t = 0; t < 64; ++t) {
            const LAS f32x4* p4;
            float kk[8], ww[8], aa[8], km[8], rr[8];
            p4 = (const LAS f32x4*)(KK + t * 64 + part * 8);   { const f32x4 a = p4[0], c2 = p4[1]; kk[0] = a.x; kk[1] = a.y; kk[2] = a.z; kk[3] = a.w; kk[4] = c2.x; kk[5] = c2.y; kk[6] = c2.z; kk[7] = c2.w; }
            p4 = (const LAS f32x4*)(bufA + t * 64 + part * 8); { const f32x4 a = p4[0], c2 = p4[1]; ww[0] = a.x; ww[1] = a.y; ww[2] = a.z; ww[3] = a.w; ww[4] = c2.x; ww[5] = c2.y; ww[6] = c2.z; ww[7] = c2.w; }
            p4 = (const LAS f32x4*)(bufB + t * 64 + part * 8); { const f32x4 a = p4[0], c2 = p4[1]; aa[0] = a.x; aa[1] = a.y; aa[2] = a.z; aa[3] = a.w; aa[4] = c2.x; aa[5] = c2.y; aa[6] = c2.z; aa[7] = c2.w; }
            p4 = (const LAS f32x4*)(Kb + t * 64 + part * 8);   { const f32x4 a = p4[0], c2 = p4[1]; km[0] = a.x; km[1] = a.y; km[2] = a.z; km[3] = a.w; km[4] = c2.x; km[5] = c2.y; km[6] = c2.z; km[7] = c2.w; }
            p4 = (const LAS f32x4*)(R + t * 64 + part * 8);    { const f32x4 a = p4[0], c2 = p4[1]; rr[0] = a.x; rr[1] = a.y; rr[2] = a.z; rr[3] = a.w; rr[4] = c2.x; rr[5] = c2.y; rr[6] = c2.z; rr[7] = c2.w; }
            const float vv = V[t * 64 + vi];
            float sa = 0.f;
#pragma unroll
            for (int j = 0; j < 8; ++j) sa -= s[j] * kk[j];
            sa += __shfl_xor(sa, 1); sa += __shfl_xor(sa, 2); sa += __shfl_xor(sa, 4);
            float o = 0.f;
#pragma unroll
            for (int j = 0; j < 8; ++j) { s[j] = s[j] * ww[j] + sa * (kk[j] * aa[j]) + vv * km[j]; o += s[j] * rr[j]; }
            o += __shfl_xor(o, 1); o += __shfl_xor(o, 2); o += __shfl_xor(o, 4);
            if (part == 0) O[t * 64 + vi] = o;
        }
        __syncthreads();
        for (int t = F.wave; t < 64; t += NWAVES) {
            const float o = O[t * 64 + lane];
            const float mean = wave_sum(o) * (1.0f / 64.0f); const float dlt = o - mean; const float var = wave_sum(dlt * dlt) * (1.0f / 64.0f);
            float y = dlt * (1.0f / sqrtf(var + 64e-5f)) * ln_w[lane] + ln_b[lane];
            y += bonus[t] * V[t * 64 + lane];
            y *= bufC[t * 64 + lane];
            P[(size_t)(t0 + t) * P0LD + 2048 + h * 64 + lane] = (bf16_t)f2bf(y);
        }
        __syncthreads();
    }
}
__device__ __forceinline__ void scan_hgrn(const Frame& F, int b, int h) {
    const int lane = lane_id_v(); const int tid = F.wave * 64 + lane; (void)tid;
    LAS float* qs = (LAS float*)F.lds;
    LAS float* fs = qs + 64 * 128;
    LAS float* kf = fs + 64 * 128;
    LAS float* is = kf + 64 * 128;
    bf16_t* P = (bf16_t*)(F.ws + WS_BIG + BIG_PROJ);
    const float* onorm = F.in[IN_C_ONORM];
    const int e = tid >> 2, part = tid & 3;
    float s[32];
#pragma unroll
    for (int j = 0; j < 32; ++j) s[j] = 0.f;
    for (int c = 0; c < 32; ++c) {
        const int t0 = b * TS + c * 64;
        for (int idx = tid; idx < 64 * 128; idx += NTHREADS) {
            const int t = idx >> 7, col = idx & 127; const bf16_t* pr = P + (size_t)(t0 + t) * P1LD + h * 128 + col;
            qs[idx] = bf2f(pr[0]); const float lf = h2f_bits(pr[1024]); fs[idx] = __expf(lf); kf[idx] = -expm1f(lf); is[idx] = bf2f(pr[2048]);
        }
        __syncthreads();
        for (int t = 0; t < 64; ++t) {
            const LAS f32x4* fp = (const LAS f32x4*)(fs + t * 128 + part * 32); const LAS f32x4* kp = (const LAS f32x4*)(kf + t * 128 + part * 32); const LAS f32x4* qp = (const LAS f32x4*)(qs + t * 128 + part * 32);
            const float iv = is[t * 128 + e];
            float o = 0.f;
#pragma unroll
            for (int j = 0; j < 8; ++j) { const f32x4 f = fp[j], k = kp[j], q = qp[j];
                s[4 * j] = f.x * s[4 * j] + k.x * iv; o += s[4 * j] * q.x;
                s[4 * j + 1] = f.y * s[4 * j + 1] + k.y * iv; o += s[4 * j + 1] * q.y;
                s[4 * j + 2] = f.z * s[4 * j + 2] + k.z * iv; o += s[4 * j + 2] * q.z;
                s[4 * j + 3] = f.w * s[4 * j + 3] + k.w * iv; o += s[4 * j + 3] * q.w; }
            o += __shfl_xor(o, 1); o += __shfl_xor(o, 2);
            if (part == 0) is[t * 128 + e] = o;
        }
        __syncthreads();
        for (int t = F.wave; t < 64; t += NWAVES) {
            const float o0 = is[t * 128 + lane], o1 = is[t * 128 + lane + 64];
            const float ss = wave_sum(o0 * o0 + o1 * o1), rs = 1.0f / sqrtf(ss * (1.0f / 128.0f) + 1e-6f);
            bf16_t* gp = P + (size_t)(t0 + t) * P1LD + 3072 + h * 128;
            const float g0 = bf2f(gp[lane]), g1 = bf2f(gp[lane + 64]);
            gp[lane] = (bf16_t)f2bf(o0 * rs * onorm[lane] * siluf_(g0)); gp[lane + 64] = (bf16_t)f2bf(o1 * rs * onorm[lane + 64] * siluf_(g1));
        }
        __syncthreads();
    }
}

template <int CTRL> __device__ __forceinline__ float dppf(float v) { return __int_as_float(__builtin_amdgcn_update_dpp(0, __float_as_int(v), CTRL, 0xF, 0xF, true)); }
__device__ __forceinline__ float red8(float v) { v += dppf<0xB1>(v); v += dppf<0x4E>(v); v += dppf<0x141>(v); return v; }
__device__ __forceinline__ float red16(float v) { v = red8(v); v += dppf<0x140>(v); return v; }

__device__ __forceinline__ void scan_delta2(const Frame& F, int b, int h, int qd) {
    const int lane = lane_id_v(); const int tid = F.wave * 64 + lane;
    LAS float* Kc = (LAS float*)F.lds;
    LAS float* Qc = Kc + 64 * 128;
    LAS float* Vc = Qc + 64 * 128;
    LAS float* Oc = Vc + 64 * 32;
    LAS float* al = Oc + 64 * 32;
    LAS float* be = al + 64;
    LAS float* vh = be + 64;
    bf16_t* P = (bf16_t*)(F.ws + WS_BIG + BIG_PROJ);
    const float* convw = F.in[IN_AB_CONV];
    const float* db = (const float*)(F.ws + WS_DB);
    const float a_neg = -__expf(F.in[IN_AB_ALOG][h]), dtb = F.in[IN_AB_DTB][h];
    const int w = F.wave;
    const int vcol = 1024 + h * 128 + qd * 32 + (lane & 31);
    float cwq[4][2], cwk[4][2], cwv[4];
#pragma unroll
    for (int j = 0; j < 4; ++j) { cwq[j][0] = convw[j * 1536 + h * 128 + lane]; cwq[j][1] = convw[j * 1536 + h * 128 + lane + 64];
        cwk[j][0] = convw[j * 1536 + 512 + h * 128 + lane]; cwk[j][1] = convw[j * 1536 + 512 + h * 128 + lane + 64]; cwv[j] = convw[j * 1536 + vcol]; }
    const int r = tid >> 4, part = tid & 15;
    float s[8];
#pragma unroll
    for (int j = 0; j < 8; ++j) s[j] = 0.f;
    if (tid < 192) vh[tid] = 0.f;
    __syncthreads();
    for (int c = 0; c < 32; ++c) {
        const int t0 = b * TS + c * 64;
        const LAS float* vhc = vh + (c & 1) * 96; LAS float* vhn = vh + ((c + 1) & 1) * 96;
        {
            float rq[11][2], rk[11][2], rv[11];
#pragma unroll
            for (int rr = 0; rr < 11; ++rr) {
                const int tl = c * 64 + 8 * w - 3 + rr;
                const bool ok = tl >= 0;
                const bf16_t* row = P + (size_t)(b * TS + (ok ? tl : 0)) * P0LD;
                rq[rr][0] = ok ? bf2f(row[h * 128 + lane]) : 0.f; rq[rr][1] = ok ? bf2f(row[h * 128 + lane + 64]) : 0.f;
                rk[rr][0] = ok ? bf2f(row[512 + h * 128 + lane]) : 0.f; rk[rr][1] = ok ? bf2f(row[512 + h * 128 + lane + 64]) : 0.f;
                const bool prevchunk = (8 * w - 3 + rr) < 0;
                rv[rr] = prevchunk ? vhc[(rr < 3 ? rr : 0) * 32 + (lane & 31)] : bf2f(row[vcol]);
            }
            if (w == 7 && lane < 32) { vhn[lane] = rv[8]; vhn[32 + lane] = rv[9]; vhn[64 + lane] = rv[10]; }
#pragma unroll
            for (int i = 0; i < 8; ++i) {
                const int t = 8 * w + i;
                float q0 = 0.f, q1 = 0.f, k0 = 0.f, k1 = 0.f, vv = 0.f;
#pragma unroll
                for (int j = 0; j < 4; ++j) { q0 += cwq[j][0] * rq[i + j][0]; q1 += cwq[j][1] * rq[i + j][1]; k0 += cwk[j][0] * rk[i + j][0]; k1 += cwk[j][1] * rk[i + j][1]; vv += cwv[j] * rv[i + j]; }
                q0 = siluf_(q0); q1 = siluf_(q1); k0 = siluf_(k0); k1 = siluf_(k1); vv = siluf_(vv);
                const float sq = wave_sum(q0 * q0 + q1 * q1), sk = wave_sum(k0 * k0 + k1 * k1);
                const float cq = (1.0f / sqrtf(sq + 1e-6f)) * 0.08838834764831845f, ck = 1.0f / sqrtf(sk + 1e-6f);
                Qc[t * 128 + lane] = q0 * cq; Qc[t * 128 + lane + 64] = q1 * cq; Kc[t * 128 + lane] = k0 * ck; Kc[t * 128 + lane + 64] = k1 * ck;
                if (lane < 32) Vc[t * 32 + lane] = vv;
            }
            if (lane < 8) { const int t = 8 * w + lane; const float la = a_neg * softplusf_(db[(size_t)(t0 + t) * 8 + h] + dtb); al[t] = __expf(la); be[t] = sigmoidf_(db[(size_t)(t0 + t) * 8 + 4 + h]); }
        }
        __syncthreads();
        {
            const LAS float* kp = Kc + part * 8; const LAS float* qp = Qc + part * 8;
            f32x4 ka = *(const LAS f32x4*)(kp), kb = *(const LAS f32x4*)(kp + 4), qa = *(const LAS f32x4*)(qp), qb = *(const LAS f32x4*)(qp + 4);
            float vv = Vc[r], alpha = al[0], beta = be[0];
            for (int t = 0; t < 64; ++t) {
                const int tn = (t + 1) & 63;
                const f32x4 nka = *(const LAS f32x4*)(kp + tn * 128), nkb = *(const LAS f32x4*)(kp + tn * 128 + 4), nqa = *(const LAS f32x4*)(qp + tn * 128), nqb = *(const LAS f32x4*)(qp + tn * 128 + 4);
                const float nvv = Vc[tn * 32 + r], nal = al[tn], nbe = be[tn];
                float p0 = s[0] * ka.x + s[1] * ka.y, p1 = s[2] * ka.z + s[3] * ka.w, p2 = s[4] * kb.x + s[5] * kb.y, p3 = s[6] * kb.z + s[7] * kb.w;
                const float p = red16((p0 + p1) + (p2 + p3));
                const float coef = beta * (vv - alpha * p);
                s[0] = alpha * s[0] + coef * ka.x; s[1] = alpha * s[1] + coef * ka.y; s[2] = alpha * s[2] + coef * ka.z; s[3] = alpha * s[3] + coef * ka.w;
                s[4] = alpha * s[4] + coef * kb.x; s[5] = alpha * s[5] + coef * kb.y; s[6] = alpha * s[6] + coef * kb.z; s[7] = alpha * s[7] + coef * kb.w;
                float o0 = s[0] * qa.x + s[1] * qa.y, o1 = s[2] * qa.z + s[3] * qa.w, o2 = s[4] * qb.x + s[5] * qb.y, o3 = s[6] * qb.z + s[7] * qb.w;
                const float o = red16((o0 + o1) + (o2 + o3));
                if (part == 0) Oc[t * 32 + r] = o;
                ka = nka; kb = nkb; qa = nqa; qb = nqb; vv = nvv; alpha = nal; beta = nbe;
            }
        }
        __syncthreads();
        {
            const int t = tid >> 3, c4 = (tid & 7) * 4;
            const f32x4 o = *(const LAS f32x4*)(Oc + t * 32 + c4);
            u32x2 wv; wv.x = pk2(o.x, o.y); wv.y = pk2(o.z, o.w);
            *(u32x2*)(P + (size_t)(t0 + t) * P0LD + 1024 + h * 128 + qd * 32 + c4) = wv;
        }
    }
}
__device__ __forceinline__ void fin_delta(const Frame& F) {
    const int lane = lane_id_v();
    bf16_t* P = (bf16_t*)(F.ws + WS_BIG + BIG_PROJ); const float* onorm = F.in[IN_AB_ONORM];
    const float on0 = onorm[lane], on1 = onorm[lane + 64];
    const int gw = F.wg * NWAVES + F.wave, NGW = F.G * NWAVES;
    for (int it = gw; it < NT * 4; it += NGW) {
        const int t = it >> 2, h = it & 3;
        bf16_t* row = P + (size_t)t * P0LD;
        const float o0 = bf2f(row[1024 + h * 128 + lane]), o1 = bf2f(row[1024 + h * 128 + lane + 64]);
        const float g0 = bf2f(row[1536 + h * 128 + lane]), g1 = bf2f(row[1536 + h * 128 + lane + 64]);
        const float ss = wave_sum(o0 * o0 + o1 * o1), rs = 1.0f / sqrtf(ss * (1.0f / 128.0f) + 1e-6f);
        row[1536 + h * 128 + lane] = (bf16_t)f2bf(o0 * rs * on0 * siluf_(g0)); row[1536 + h * 128 + lane + 64] = (bf16_t)f2bf(o1 * rs * on1 * siluf_(g1));
    }
}

__device__ __forceinline__ void scan_rwkv2(const Frame& F, int b, int h) {
    const int lane = lane_id_v(); const int tid = F.wave * 64 + lane;
    LAS float* R = (LAS float*)F.lds;
    LAS float* KM = R + 4096;
    LAS float* V = KM + 4096;
    LAS float* KK = V + 4096;
    LAS float* KA = KK + 4096;
    LAS float* W = KA + 4096;
    LAS bf16_t* TL = (LAS bf16_t*)(W + 4096);
    LAS bf16_t* AL = TL + 64 * 72;
    LAS bf16_t* SG = AL + 64 * 72;
    LAS float* O = (LAS float*)TL;
    LAS bf16_t* GB = SG + 64 * 136;
    LAS float* halo = (LAS float*)(GB + 4096);
    LAS float* bonus = halo + 896;
    bf16_t* P = (bf16_t*)(F.ws + WS_BIG + BIG_PROJ);
    const bf16_t* LW = (const bf16_t*)(F.ws + WS_LORA);
    const float* mu = F.in[IN_AB_MU];
    const float* w0 = F.in[IN_AB_W0] + h * 64; const float* a0 = F.in[IN_AB_A0] + h * 64;
    const float* k_k = F.in[IN_AB_KK] + h * 64; const float* k_a = F.in[IN_AB_KA] + h * 64; const float* r_k = F.in[IN_AB_RK] + h * 64;
    const float* ln_w = F.in[IN_AB_LNW] + h * 64; const float* ln_b = F.in[IN_AB_LNB] + h * 64;
    const int w = F.wave, fr = lane & 15, fq = lane >> 4;
    const int vi = tid >> 3, part = tid & 7;
    float s[8];
#pragma unroll
    for (int j = 0; j < 8; ++j) s[j] = 0.f;
    for (int i = tid; i < 896; i += NTHREADS) halo[i] = 0.f;
    int gc = 0; float muc = 0.f;
    if (tid < 448) { const int col = tid;
        if (col < 64) gc = 2048 + h * 64 + col; else if (col < 128) gc = 2560 + h * 64 + (col - 64); else if (col < 192) gc = 3072 + h * 64 + (col - 128); else gc = 3584 + (col - 192);
        muc = mu[gc - 2048]; }
    __syncthreads();
    for (int c = 0; c < 32; ++c) {
        const int t0 = b * TS + c * 64;
        if (tid < 448) {
            const int col = tid;
            LAS float* hc = halo + (c & 1) * 448; LAS float* hn = halo + ((c + 1) & 1) * 448;
            float prev = hc[col];
            const bf16_t* src = P + (size_t)t0 * P0LD + gc;
#pragma unroll 8
            for (int t = 0; t < 64; ++t) {
                const float cur = bf2f(src[(size_t)t * P0LD]);
                const float sh = cur + muc * (prev - cur);
                prev = cur;
                if (col < 64) R[t * 64 + col] = sh; else if (col < 128) KM[t * 64 + col - 64] = sh; else if (col < 192) V[t * 64 + col - 128] = sh;
                else if (col < 256) TL[t * 72 + col - 192] = (bf16_t)f2bf(tanhf(sh)); else if (col < 320) AL[t * 72 + col - 256] = (bf16_t)f2bf(sh); else SG[t * 136 + col - 320] = (bf16_t)f2bf(sigmoidf_(sh));
            }
            hn[col] = prev;
        }
        __syncthreads();
        {
#pragma unroll
            for (int q = 0; q < 2; ++q) {
                const int id = 2 * w + q, mi = id >> 2, nj = id & 3;
                f32x4 aw = {0.f, 0.f, 0.f, 0.f}, aa = {0.f, 0.f, 0.f, 0.f}, ag = {0.f, 0.f, 0.f, 0.f};
                const int jrow = h * 64 + nj * 16 + fr;
#pragma unroll
                for (int ksx = 0; ksx < 2; ++ksx) {
                    const bf16x8 x1 = *(const LAS bf16x8*)(TL + (mi * 16 + fr) * 72 + ksx * 32 + fq * 8), x2 = *(const LAS bf16x8*)(AL + (mi * 16 + fr) * 72 + ksx * 32 + fq * 8);
                    const bf16x8 y1 = *(const bf16x8*)(LW + (size_t)jrow * 64 + ksx * 32 + fq * 8), y2 = *(const bf16x8*)(LW + 512 * 64 + (size_t)jrow * 64 + ksx * 32 + fq * 8);
                    aw = __builtin_amdgcn_mfma_f32_16x16x32_bf16(x1, y1, aw, 0, 0, 0); aa = __builtin_amdgcn_mfma_f32_16x16x32_bf16(x2, y2, aa, 0, 0, 0);
                }
#pragma unroll
                for (int ksx = 0; ksx < 4; ++ksx) {
                    const bf16x8 x3 = *(const LAS bf16x8*)(SG + (mi * 16 + fr) * 136 + ksx * 32 + fq * 8);
                    const bf16x8 y3 = *(const bf16x8*)(LW + 2 * 512 * 64 + (size_t)jrow * 128 + ksx * 32 + fq * 8);
                    ag = __builtin_amdgcn_mfma_f32_16x16x32_bf16(x3, y3, ag, 0, 0, 0);
                }
                const int j = nj * 16 + fr; const float w0j = w0[j], a0j = a0[j];
                const float awv[4] = {aw.x, aw.y, aw.z, aw.w}, aav[4] = {aa.x, aa.y, aa.z, aa.w}, agv[4] = {ag.x, ag.y, ag.z, ag.w};
#pragma unroll
                for (int rg = 0; rg < 4; ++rg) { const int t = mi * 16 + 4 * fq + rg;
                    W[t * 64 + j] = __expf(-0.6065306597126334f * sigmoidf_(w0j + awv[rg])); KA[t * 64 + j] = sigmoidf_(a0j + aav[rg]); GB[t * 64 + j] = (bf16_t)f2bf(agv[rg]); }
            }
        }
        __syncthreads();
        {
            const int j = lane; const float kkj = k_k[j], kaj = k_a[j], rkj = r_k[j];
#pragma unroll
            for (int q = 0; q < 8; ++q) { const int t = w * 8 + q; const float kv = KM[t * 64 + j], a = KA[t * 64 + j]; const float kx = kv * kkj; const float ss = wave_sum(kx * kx);
                const float kk = kx * (1.0f / sqrtf(ss + 1e-6f)); KK[t * 64 + j] = kk; KA[t * 64 + j] = kk * a; const float km = kv * (1.f + (a - 1.f) * kaj); KM[t * 64 + j] = km;
                const float bs = wave_sum(R[t * 64 + j] * km * rkj); if (j == 0) bonus[t] = bs; }
        }
        __syncthreads();
        {
            const int o8 = part * 8;
            for (int t = 0; t < 64; ++t) {
                const f32x4 k0 = *(const LAS f32x4*)(KK + t * 64 + o8), k1 = *(const LAS f32x4*)(KK + t * 64 + o8 + 4);
                const f32x4 w0v = *(const LAS f32x4*)(W + t * 64 + o8), w1v = *(const LAS f32x4*)(W + t * 64 + o8 + 4);
                const f32x4 a0v = *(const LAS f32x4*)(KA + t * 64 + o8), a1v = *(const LAS f32x4*)(KA + t * 64 + o8 + 4);
                const f32x4 m0 = *(const LAS f32x4*)(KM + t * 64 + o8), m1 = *(const LAS f32x4*)(KM + t * 64 + o8 + 4);
                const f32x4 r0 = *(const LAS f32x4*)(R + t * 64 + o8), r1 = *(const LAS f32x4*)(R + t * 64 + o8 + 4);
                const float vv = V[t * 64 + vi];
                const float sa = -red8(((s[0] * k0.x + s[1] * k0.y) + (s[2] * k0.z + s[3] * k0.w)) + ((s[4] * k1.x + s[5] * k1.y) + (s[6] * k1.z + s[7] * k1.w)));
                s[0] = s[0] * w0v.x + sa * a0v.x + vv * m0.x; s[1] = s[1] * w0v.y + sa * a0v.y + vv * m0.y; s[2] = s[2] * w0v.z + sa * a0v.z + vv * m0.z; s[3] = s[3] * w0v.w + sa * a0v.w + vv * m0.w;
                s[4] = s[4] * w1v.x + sa * a1v.x + vv * m1.x; s[5] = s[5] * w1v.y + sa * a1v.y + vv * m1.y; s[6] = s[6] * w1v.z + sa * a1v.z + vv * m1.z; s[7] = s[7] * w1v.w + sa * a1v.w + vv * m1.w;
                const float o = red8(((s[0] * r0.x + s[1] * r0.y) + (s[2] * r0.z + s[3] * r0.w)) + ((s[4] * r1.x + s[5] * r1.y) + (s[6] * r1.z + s[7] * r1.w)));
                if (part == 0) O[t * 64 + vi] = o;
            }
        }
        __syncthreads();
        for (int t = w; t < 64; t += NWAVES) {
            const float o = O[t * 64 + lane];
            const float mean = wave_sum(o) * (1.0f / 64.0f); const float dlt = o - mean; const float var = wave_sum(dlt * dlt) * (1.0f / 64.0f);
            float y = dlt * (1.0f / sqrtf(var + 64e-5f)) * ln_w[lane] + ln_b[lane];
            y += bonus[t] * V[t * 64 + lane];
            y *= bf2f(GB[t * 64 + lane]);
            P[(size_t)(t0 + t) * P0LD + 2048 + h * 64 + lane] = (bf16_t)f2bf(y);
        }
        __syncthreads();
    }
}

__device__ __forceinline__ void scan_hgrn2(const Frame& F, int b, int h, int qd) {
    const int lane = lane_id_v(); const int tid = F.wave * 64 + lane;
    LAS float* qs = (LAS float*)F.lds;
    LAS float* fs = qs + 64 * 128;
    LAS float* kf = fs + 64 * 128;
    LAS float* is = kf + 64 * 128;
    bf16_t* P = (bf16_t*)(F.ws + WS_BIG + BIG_PROJ);
    const int e = tid >> 4, part = tid & 15;
    float s[8];
#pragma unroll
    for (int j = 0; j < 8; ++j) s[j] = 0.f;
    for (int c = 0; c < 32; ++c) {
        const int t0 = b * TS + c * 64;
        {
            const int t = tid >> 3, c16 = (tid & 7) * 16;
            const bf16_t* pr = P + (size_t)(t0 + t) * P1LD + h * 128 + c16;
            const u32x4 qa = *(const u32x4*)pr, qb = *(const u32x4*)(pr + 8), la = *(const u32x4*)(pr + 1024), lb2 = *(const u32x4*)(pr + 1024 + 8);
            const unsigned qv[8] = {qa.x, qa.y, qa.z, qa.w, qb.x, qb.y, qb.z, qb.w}, lv[8] = {la.x, la.y, la.z, la.w, lb2.x, lb2.y, lb2.z, lb2.w};
#pragma unroll
            for (int j = 0; j < 8; ++j) {
                qs[t * 128 + c16 + 2 * j] = bf2f((unsigned short)(qv[j] & 0xffffu)); qs[t * 128 + c16 + 2 * j + 1] = bf2f((unsigned short)(qv[j] >> 16));
                const float l0 = h2f_bits((unsigned short)(lv[j] & 0xffffu)), l1 = h2f_bits((unsigned short)(lv[j] >> 16));
                fs[t * 128 + c16 + 2 * j] = __expf(l0); fs[t * 128 + c16 + 2 * j + 1] = __expf(l1); kf[t * 128 + c16 + 2 * j] = -expm1f(l0); kf[t * 128 + c16 + 2 * j + 1] = -expm1f(l1);
            }
            const int c4 = (tid & 7) * 4;
            const u32x2 iv = *(const u32x2*)(P + (size_t)(t0 + t) * P1LD + 2048 + h * 128 + qd * 32 + c4);
            is[t * 32 + c4] = bf2f((unsigned short)(iv.x & 0xffffu)); is[t * 32 + c4 + 1] = bf2f((unsigned short)(iv.x >> 16)); is[t * 32 + c4 + 2] = bf2f((unsigned short)(iv.y & 0xffffu)); is[t * 32 + c4 + 3] = bf2f((unsigned short)(iv.y >> 16));
        }
        __syncthreads();
        {
            const int o8 = part * 8;
            for (int t = 0; t < 64; ++t) {
                const f32x4 f0 = *(const LAS f32x4*)(fs + t * 128 + o8), f1 = *(const LAS f32x4*)(fs + t * 128 + o8 + 4);
                const f32x4 k0 = *(const LAS f32x4*)(kf + t * 128 + o8), k1 = *(const LAS f32x4*)(kf + t * 128 + o8 + 4);
                const f32x4 q0 = *(const LAS f32x4*)(qs + t * 128 + o8), q1 = *(const LAS f32x4*)(qs + t * 128 + o8 + 4);
                const float iv = is[t * 32 + e];
                s[0] = f0.x * s[0] + k0.x * iv; s[1] = f0.y * s[1] + k0.y * iv; s[2] = f0.z * s[2] + k0.z * iv; s[3] = f0.w * s[3] + k0.w * iv;
                s[4] = f1.x * s[4] + k1.x * iv; s[5] = f1.y * s[5] + k1.y * iv; s[6] = f1.z * s[6] + k1.z * iv; s[7] = f1.w * s[7] + k1.w * iv;
                const float o = red16(((s[0] * q0.x + s[1] * q0.y) + (s[2] * q0.z + s[3] * q0.w)) + ((s[4] * q1.x + s[5] * q1.y) + (s[6] * q1.z + s[7] * q1.w)));
                if (part == 0) is[t * 32 + e] = o;
            }
        }
        __syncthreads();
        {
            const int t = tid >> 3, c4 = (tid & 7) * 4;
            const f32x4 o = *(const LAS f32x4*)(is + t * 32 + c4);
            u32x2 wv; wv.x = pk2(o.x, o.y); wv.y = pk2(o.z, o.w);
            *(u32x2*)(P + (size_t)(t0 + t) * P1LD + 2048 + h * 128 + qd * 32 + c4) = wv;
        }
        __syncthreads();
    }
}
__device__ __forceinline__ void fin_hgrn(const Frame& F) {
    const int lane = lane_id_v();
    bf16_t* P = (bf16_t*)(F.ws + WS_BIG + BIG_PROJ); const float* onorm = F.in[IN_C_ONORM];
    const float on0 = onorm[lane], on1 = onorm[lane + 64];
    const int gw = F.wg * NWAVES + F.wave, NGW = F.G * NWAVES;
    for (int it = gw; it < NT * 8; it += NGW) {
        const int t = it >> 3, h = it & 7;
        bf16_t* row = P + (size_t)t * P1LD;
        const float o0 = bf2f(row[2048 + h * 128 + lane]), o1 = bf2f(row[2048 + h * 128 + lane + 64]);
        const float g0 = bf2f(row[3072 + h * 128 + lane]), g1 = bf2f(row[3072 + h * 128 + lane + 64]);
        const float ss = wave_sum(o0 * o0 + o1 * o1), rs = 1.0f / sqrtf(ss * (1.0f / 128.0f) + 1e-6f);
        row[3072 + h * 128 + lane] = (bf16_t)f2bf(o0 * rs * on0 * siluf_(g0)); row[3072 + h * 128 + lane + 64] = (bf16_t)f2bf(o1 * rs * on1 * siluf_(g1));
    }
}

#define MFMA32(a, b, c) __builtin_amdgcn_mfma_f32_16x16x32_bf16(a, b, c, 0, 0, 0)
#define MFMA16(a, b, c) __builtin_amdgcn_mfma_f32_16x16x16bf16_1k(a, b, c, 0, 0, 0)
__device__ __forceinline__ f32x4 mm_tile(const LAS bf16_t* A, int lda, const LAS bf16_t* B, int ldb, int nks, f32x4 acc, int fr, int fq) {
    for (int ksx = 0; ksx < nks; ++ksx) acc = MFMA32(*(const LAS bf16x8*)(A + fr * lda + ksx * 32 + fq * 8), *(const LAS bf16x8*)(B + fr * ldb + ksx * 32 + fq * 8), acc);
    return acc;
}
__device__ __forceinline__ void lds_w4(LAS bf16_t* p, f32x4 v) { u32x2 w; w.x = pk2(v.x, v.y); w.y = pk2(v.z, v.w); *(LAS u32x2*)p = w; }
__device__ __forceinline__ float rdlane(float v, int l) { return __int_as_float(__builtin_amdgcn_readlane(__float_as_int(v), l)); }
__device__ __forceinline__ float wsum(float v) { v = red16(v); return (rdlane(v, 0) + rdlane(v, 16)) + (rdlane(v, 32) + rdlane(v, 48)); }

__device__ __forceinline__ void scan_delta3(const Frame& F, int b, int h) {
    const int lane0 = lane_id_v(); const int w = F.wave;
    LAS bf16_t* Qb = (LAS bf16_t*)F.lds;
    LAS bf16_t* Kb = Qb + 64 * 136;
    LAS float* Of = (LAS float*)F.lds;
    LAS bf16_t* Kdt = Kb + 64 * 136;
    LAS bf16_t* Vt = Kdt + 128 * 72;
    LAS bf16_t* St = Vt + 128 * 72;
    LAS bf16_t* Aoff = St + 128 * 136;
    LAS bf16_t* QKm = Aoff + 64 * 72;
    LAS bf16_t* Vn = QKm + 64 * 72;
    LAS bf16_t* Dg = Vn + 128 * 72;
    LAS float* Adg = (LAS float*)(Dg + 4 * 16 * 24);
    LAS float* sc = Adg + 4 * 16 * 17;
    static_assert((64 * 136 * 2 * 2 + 128 * 72 * 2 * 3 + 128 * 136 * 2 + 64 * 72 * 2 * 2 + 4 * 16 * 24 * 2 + 4 * 16 * 17 * 4 + 260 * 4) <= LDS_MISC, "delta3 LDS");
    bf16_t* P = (bf16_t*)(F.ws + WS_BIG + BIG_PROJ);
    const float* convw = F.in[IN_AB_CONV];
    const float* db = (const float*)(F.ws + WS_DB);
    const float a_neg = -__expf(F.in[IN_AB_ALOG][h]), dtb = F.in[IN_AB_DTB][h];
    const float* onorm = F.in[IN_AB_ONORM];
    float cw[3][4][2];
#pragma unroll
    for (int sct = 0; sct < 3; ++sct)
#pragma unroll
        for (int j = 0; j < 4; ++j) { cw[sct][j][0] = convw[j * 1536 + sct * 512 + h * 128 + lane0]; cw[sct][j][1] = convw[j * 1536 + sct * 512 + h * 128 + lane0 + 64]; }
    for (int i = w * 64 + lane0; i < (128 * 136 + 64 * 72 * 2 + 128 * 72) / 2; i += NTHREADS) ((LAS unsigned*)St)[i] = 0u;
    f32x4 sacc[8];
#pragma unroll
    for (int i = 0; i < 8; ++i) sacc[i] = (f32x4){0.f, 0.f, 0.f, 0.f};
    __syncthreads();
    for (int c = 0; c < 32; ++c) {
        int lane = lane0; asm volatile("" : "+v"(lane));
        const int fr = lane & 15, fq = lane >> 4;
        const int t0 = b * TS + c * 64;
        {
            const float la = a_neg * softplusf_(db[(size_t)(t0 + lane) * 8 + h] + dtb);
            const float bet = sigmoidf_(db[(size_t)(t0 + lane) * 8 + 4 + h]);
            float g = la;
#pragma unroll
            for (int o = 1; o < 64; o <<= 1) { const float n = __shfl_up(g, o); if (lane >= o) g += n; }
            const float gL = rdlane(g, 63);
            if (w == 0) { sc[lane] = g; sc[64 + lane] = __expf(g); sc[128 + lane] = bet * __expf(g); sc[192 + lane] = bet; if (lane == 0) sc[256] = __expf(gL); }
            float raw[3][11][2];
#pragma unroll
            for (int rr = 0; rr < 11; ++rr) {
                const int tl = c * 64 + 8 * w - 3 + rr; const bool ok = tl >= 0;
                const bf16_t* row = P + (size_t)(b * TS + (ok ? tl : 0)) * P0LD + h * 128 + lane;
#pragma unroll
                for (int sct = 0; sct < 3; ++sct) { raw[sct][rr][0] = ok ? bf2f(row[sct * 512]) : 0.f; raw[sct][rr][1] = ok ? bf2f(row[sct * 512 + 64]) : 0.f; }
            }
#pragma unroll
            for (int i = 0; i < 8; ++i) {
                const int t = 8 * w + i;
                float x[3][2];
#pragma unroll
                for (int sct = 0; sct < 3; ++sct) { float a0 = 0.f, a1 = 0.f;
#pragma unroll
                    for (int j = 0; j < 4; ++j) { a0 += cw[sct][j][0] * raw[sct][i + j][0]; a1 += cw[sct][j][1] * raw[sct][i + j][1]; }
                    x[sct][0] = siluf_(a0); x[sct][1] = siluf_(a1); }
                const float sq = wsum(x[0][0] * x[0][0] + x[0][1] * x[0][1]), sk = wsum(x[1][0] * x[1][0] + x[1][1] * x[1][1]);
                const float cq = (1.0f / sqrtf(sq + 1e-6f)) * 0.08838834764831845f, ck = 1.0f / sqrtf(sk + 1e-6f);
                const float egr = __expf(gL - rdlane(g, t));
                Qb[t * 136 + lane] = (bf16_t)f2bf(x[0][0] * cq); Qb[t * 136 + lane + 64] = (bf16_t)f2bf(x[0][1] * cq);
                const float k0 = x[1][0] * ck, k1 = x[1][1] * ck;
                Kb[t * 136 + lane] = (bf16_t)f2bf(k0); Kb[t * 136 + lane + 64] = (bf16_t)f2bf(k1);
                Kdt[lane * 72 + t] = (bf16_t)f2bf(k0 * egr); Kdt[(lane + 64) * 72 + t] = (bf16_t)f2bf(k1 * egr);
                Vt[lane * 72 + t] = (bf16_t)f2bf(x[2][0]); Vt[(lane + 64) * 72 + t] = (bf16_t)f2bf(x[2][1]);
            }
        }
        __syncthreads();
        {
            for (int id = w; id < 20; id += NWAVES) {
                const int which = id / 10, tix = id % 10;
                const int bi = (tix < 1) ? 0 : (tix < 3 ? 1 : (tix < 6 ? 2 : 3)); const int bj = tix - (bi * (bi + 1)) / 2;
                f32x4 acc = {0.f, 0.f, 0.f, 0.f};
                acc = mm_tile(Kb + bj * 16 * 136, 136, (which ? Qb : Kb) + bi * 16 * 136, 136, 4, acc, fr, fq);
                const int i = 16 * bi + fr; const float gi = sc[i], bi_ = sc[192 + i];
                const float av[4] = {acc.x, acc.y, acc.z, acc.w}; float ov[4];
#pragma unroll
                for (int rg = 0; rg < 4; ++rg) { const int j = 16 * bj + 4 * fq + rg; const float dec = __expf(gi - sc[j]);
                    ov[rg] = which ? ((j <= i) ? av[rg] * dec : 0.f) : ((j < i) ? bi_ * av[rg] * dec : 0.f); }
                if (which) lds_w4(QKm + i * 72 + 16 * bj + 4 * fq, (f32x4){ov[0], ov[1], ov[2], ov[3]});
                else if (bi == bj) { LAS float* d = Adg + (bi * 16 + fr) * 17 + 4 * fq; d[0] = ov[0]; d[1] = ov[1]; d[2] = ov[2]; d[3] = ov[3]; }
                else lds_w4(Aoff + i * 72 + 16 * bj + 4 * fq, (f32x4){-ov[0], -ov[1], -ov[2], -ov[3]});
            }
        }
        __syncthreads();
        f32x4 y[4], qs[4];
        {
            if (w < 4 && lane < 16) { float x[16]; const LAS float* a = Adg + w * 16 * 17;
#pragma unroll
                for (int i = 0; i < 16; ++i) { float v = (i == lane) ? 1.f : 0.f;
#pragma unroll
                    for (int k = 0; k < i; ++k) v -= a[i * 17 + k] * x[k];
                    x[i] = v; Dg[(w * 16 + i) * 24 + lane] = (bf16_t)f2bf(v); } }
            const LAS bf16_t* Sw = St + (16 * w) * 136;
#pragma unroll
            for (int mi = 0; mi < 4; ++mi) {
                f32x4 x = mm_tile(Kb + mi * 16 * 136, 136, Sw, 136, 4, (f32x4){0.f, 0.f, 0.f, 0.f}, fr, fq);
                qs[mi] = mm_tile(Qb + mi * 16 * 136, 136, Sw, 136, 4, (f32x4){0.f, 0.f, 0.f, 0.f}, fr, fq);
                const bf16x4 vv = *(const LAS bf16x4*)(Vt + (16 * w + fr) * 72 + 16 * mi + 4 * fq);
                const f32x4 be4 = *(const LAS f32x4*)(sc + 192 + 16 * mi + 4 * fq), bg4 = *(const LAS f32x4*)(sc + 128 + 16 * mi + 4 * fq);
                y[mi].x = be4.x * bf2f((unsigned short)vv.x) - bg4.x * x.x; y[mi].y = be4.y * bf2f((unsigned short)vv.y) - bg4.y * x.y;
                y[mi].z = be4.z * bf2f((unsigned short)vv.z) - bg4.z * x.z; y[mi].w = be4.w * bf2f((unsigned short)vv.w) - bg4.w * x.w;
            }
        }
        __syncthreads();
        {
            LAS bf16_t* Vw = Vn + (16 * w) * 72;
#pragma unroll
            for (int bb = 0; bb < 4; ++bb) {
                f32x4 acc = y[bb];
                if (bb >= 1) acc = mm_tile(Aoff + bb * 16 * 72, 72, Vw, 72, (bb + 1) / 2, acc, fr, fq);
                u32x2 pk; pk.x = pk2(acc.x, acc.y); pk.y = pk2(acc.z, acc.w);
                const bf16x4 dgf = *(const LAS bf16x4*)(Dg + (bb * 16 + fr) * 24 + 4 * fq);
                const f32x4 vb = MFMA16(dgf, __builtin_bit_cast(bf16x4, pk), ((f32x4){0.f, 0.f, 0.f, 0.f}));
                lds_w4(Vw + fr * 72 + 16 * bb + 4 * fq, vb);
                asm volatile("s_waitcnt lgkmcnt(0)" ::: "memory");
            }
            const float gl = sc[256];
#pragma unroll
            for (int mi = 0; mi < 4; ++mi) {
                const f32x4 eg4 = *(const LAS f32x4*)(sc + 64 + 16 * mi + 4 * fq);
                f32x4 o = qs[mi] * eg4;
                o = mm_tile(QKm + mi * 16 * 72, 72, Vw, 72, 2, o, fr, fq);
                qs[mi] = o;
            }
#pragma unroll
            for (int dk = 0; dk < 8; ++dk) {
                f32x4 sn = sacc[dk] * gl;
                sn = mm_tile(Kdt + dk * 16 * 72, 72, Vw, 72, 2, sn, fr, fq);
                sacc[dk] = sn;
                lds_w4(St + (16 * w + fr) * 136 + 16 * dk + 4 * fq, sn);
            }
        }
        __syncthreads();
#pragma unroll
        for (int mi = 0; mi < 4; ++mi) { LAS float* op = Of + (16 * mi + 4 * fq) * 132 + 16 * w + fr; op[0] = qs[mi].x; op[132] = qs[mi].y; op[264] = qs[mi].z; op[396] = qs[mi].w; }
        __syncthreads();
        for (int t = w; t < 64; t += NWAVES) {
            const float o0 = Of[t * 132 + lane], o1 = Of[t * 132 + lane + 64];
            const float ss = wsum(o0 * o0 + o1 * o1), rs = 1.0f / sqrtf(ss * (1.0f / 128.0f) + 1e-6f);
            bf16_t* gp = P + (size_t)(t0 + t) * P0LD + 1536 + h * 128;
            const float g0 = bf2f(gp[lane]), g1 = bf2f(gp[lane + 64]);
            gp[lane] = (bf16_t)f2bf(o0 * rs * onorm[lane] * siluf_(g0)); gp[lane + 64] = (bf16_t)f2bf(o1 * rs * onorm[lane + 64] * siluf_(g1));
        }
        __syncthreads();
    }
}

__device__ __forceinline__ void scan_hgrn3(const Frame& F, int b, int h) {
    const int lane0 = lane_id_v(); const int w = F.wave;
    LAS bf16_t* Qd = (LAS bf16_t*)F.lds;
    LAS bf16_t* Kp = Qd + 64 * 136;
    LAS bf16_t* Kpt = Kp + 64 * 136;
    LAS bf16_t* Vt = Kpt + 128 * 72;
    LAS bf16_t* Sc = Vt + 128 * 72;
    LAS bf16_t* Zt = Sc + 64 * 72;
    LAS float* Of = (LAS float*)(Zt + 128 * 136);
    LAS float* gl = Of + 64 * 132;
    LAS float* seg = gl + 128;
    static_assert((64 * 136 * 2 * 2 + 128 * 72 * 2 * 2 + 64 * 72 * 2 + 128 * 136 * 2 + 64 * 132 * 4 + 128 * 4 + 512 * 4) <= LDS_MISC, "hgrn3 LDS");
    bf16_t* P = (bf16_t*)(F.ws + WS_BIG + BIG_PROJ);
    const float* onorm = F.in[IN_C_ONORM];
    for (int i = w * 64 + lane0; i < (64 * 72 + 128 * 136) / 2; i += NTHREADS) ((LAS unsigned*)Sc)[i] = 0u;
    f32x4 zacc[8];
#pragma unroll
    for (int i = 0; i < 8; ++i) zacc[i] = (f32x4){0.f, 0.f, 0.f, 0.f};
    __syncthreads();
    for (int c = 0; c < 32; ++c) {
        int lane = lane0; asm volatile("" : "+v"(lane));
        const int tid = w * 64 + lane, fr = lane & 15, fq = lane >> 4, d = tid & 127, sg = tid >> 7;
        const int t0 = b * TS + c * 64;
        {
            float G[16], q[16], v[16], lf[16];
            const bf16_t* pr = P + (size_t)(t0 + 16 * sg) * P1LD + h * 128 + d;
#pragma unroll
            for (int i = 0; i < 16; ++i) { q[i] = bf2f(pr[(size_t)i * P1LD]); lf[i] = h2f_bits(pr[(size_t)i * P1LD + 1024]); v[i] = bf2f(pr[(size_t)i * P1LD + 2048]); }
            float run = 0.f;
#pragma unroll
            for (int i = 0; i < 16; ++i) { run += lf[i]; G[i] = run; }
            seg[sg * 128 + d] = run;
            __syncthreads();
            float off = 0.f;
#pragma unroll
            for (int s2 = 0; s2 < 3; ++s2) if (s2 < sg) off += seg[s2 * 128 + d];
#pragma unroll
            for (int i = 0; i < 16; ++i) {
                const int t = 16 * sg + i; const float Gt = off + G[i];
                const float qd = q[i] * __expf(Gt), kp = -expm1f(lf[i]) * __expf(fminf(-Gt, 80.f));
                Qd[t * 136 + d] = (bf16_t)f2bf(qd); const bf16_t kb = (bf16_t)f2bf(kp); Kp[t * 136 + d] = kb; Kpt[d * 72 + t] = kb; Vt[d * 72 + t] = (bf16_t)f2bf(v[i]);
            }
            if (sg == 3) gl[d] = __expf(off + G[15]);
        }
        __syncthreads();
        for (int id = w; id < 10; id += NWAVES) {
            const int bi = (id < 1) ? 0 : (id < 3 ? 1 : (id < 6 ? 2 : 3)); const int bj = id - (bi * (bi + 1)) / 2;
            const f32x4 acc = mm_tile(Kp + bj * 16 * 136, 136, Qd + bi * 16 * 136, 136, 4, (f32x4){0.f, 0.f, 0.f, 0.f}, fr, fq);
            const int i = 16 * bi + fr, j0 = 16 * bj + 4 * fq;
            lds_w4(Sc + i * 72 + j0, (f32x4){(j0 <= i) ? acc.x : 0.f, (j0 + 1 <= i) ? acc.y : 0.f, (j0 + 2 <= i) ? acc.z : 0.f, (j0 + 3 <= i) ? acc.w : 0.f});
        }
        __syncthreads();
        {
            const LAS bf16_t* Vw = Vt + (16 * w) * 72; const LAS bf16_t* Zw = Zt + (16 * w) * 136;
#pragma unroll
            for (int mi = 0; mi < 4; ++mi) {
                f32x4 o = mm_tile(Sc + mi * 16 * 72, 72, Vw, 72, 2, (f32x4){0.f, 0.f, 0.f, 0.f}, fr, fq);
                o = mm_tile(Qd + mi * 16 * 136, 136, Zw, 136, 4, o, fr, fq);
                LAS float* op = Of + (16 * mi + 4 * fq) * 132 + 16 * w + fr; op[0] = o.x; op[132] = o.y; op[264] = o.z; op[396] = o.w;
            }
            asm volatile("s_waitcnt lgkmcnt(0)" ::: "memory");
#pragma unroll
            for (int dk = 0; dk < 8; ++dk) {
                f32x4 zn = mm_tile(Kpt + dk * 16 * 72, 72, Vw, 72, 2, zacc[dk], fr, fq);
                const f32x4 g4 = *(const LAS f32x4*)(gl + 16 * dk + 4 * fq);
                zn = zn * g4; zacc[dk] = zn;
                lds_w4(Zt + (16 * w + fr) * 136 + 16 * dk + 4 * fq, zn);
            }
        }
        __syncthreads();
        for (int t = w; t < 64; t += NWAVES) {
            const float o0 = Of[t * 132 + lane], o1 = Of[t * 132 + lane + 64];
            const float ss = wsum(o0 * o0 + o1 * o1), rs = 1.0f / sqrtf(ss * (1.0f / 128.0f) + 1e-6f);
            bf16_t* gp = P + (size_t)(t0 + t) * P1LD + 3072 + h * 128;
            const float g0 = bf2f(gp[lane]), g1 = bf2f(gp[lane + 64]);
            gp[lane] = (bf16_t)f2bf(o0 * rs * onorm[lane] * siluf_(g0)); gp[lane + 64] = (bf16_t)f2bf(o1 * rs * onorm[lane + 64] * siluf_(g1));
        }
    }
}

__device__ __forceinline__ float tanh_fast(float x) { const float e = __expf(2.f * x); return 1.f - 2.f / (1.f + e); }
__device__ __forceinline__ void rwkv_shift8(const bf16_t* Pc, int t, int gc, int hidx, const float* mu, const LAS float* hc, LAS float* hn, float (&sh)[8]) {
    const bf16_t* src = Pc + (size_t)t * P0LD + gc;
    const u32x4 cu = *(const u32x4*)src;
    const u32x4 pv = *(const u32x4*)(src - (t > 0 ? P0LD : 0));
    const f32x4 h0 = *(const LAS f32x4*)(hc + hidx), h1 = *(const LAS f32x4*)(hc + hidx + 4);
    const f32x4 m0 = *(const f32x4*)(mu + gc - 2048), m1 = *(const f32x4*)(mu + gc - 2048 + 4);
    const unsigned cw_[4] = {cu.x, cu.y, cu.z, cu.w}, pw_[4] = {pv.x, pv.y, pv.z, pv.w};
    const float mv[8] = {m0.x, m0.y, m0.z, m0.w, m1.x, m1.y, m1.z, m1.w}, hv[8] = {h0.x, h0.y, h0.z, h0.w, h1.x, h1.y, h1.z, h1.w};
    float cur[8];
#pragma unroll
    for (int e = 0; e < 8; ++e) {
        cur[e] = bf2f((unsigned short)((e & 1) ? (cw_[e >> 1] >> 16) : (cw_[e >> 1] & 0xffffu)));
        const float pg = bf2f((unsigned short)((e & 1) ? (pw_[e >> 1] >> 16) : (pw_[e >> 1] & 0xffffu)));
        const float prv = (t > 0) ? pg : hv[e];
        sh[e] = cur[e] + mv[e] * (prv - cur[e]);
    }
    if (t == 63) { *(LAS f32x4*)(hn + hidx) = (f32x4){cur[0], cur[1], cur[2], cur[3]}; *(LAS f32x4*)(hn + hidx + 4) = (f32x4){cur[4], cur[5], cur[6], cur[7]}; }
}
__device__ __forceinline__ void scan_rwkv3(const Frame& F, int b, int h) {
    const int lane0 = lane_id_v(); const int w = F.wave;
    LAS unsigned char* L = F.lds;
    LAS bf16_t* RPb = (LAS bf16_t*)(L + 0);
    LAS bf16_t* KPb = (LAS bf16_t*)(L + 9216);
    LAS float* LWf = (LAS float*)(L + 18432);
    LAS float* Af = (LAS float*)(L + 34816);
    LAS float* segs = (LAS float*)(L + 51200);
    LAS bf16_t* Mak = (LAS bf16_t*)(L + 0);
    LAS bf16_t* Mrk = (LAS bf16_t*)(L + 9216);
    LAS bf16_t* Mrbn = (LAS bf16_t*)(L + 18432);
    LAS bf16_t* Aoff = (LAS bf16_t*)(L + 27648);
    LAS float* Adg = (LAS float*)(L + 36864);
    LAS bf16_t* Dg = (LAS bf16_t*)(L + 41216);
    LAS bf16_t* GB = (LAS bf16_t*)(L + 44288);
    LAS bf16_t* TL = (LAS bf16_t*)(L + 65536);
    LAS bf16_t* AL = (LAS bf16_t*)(L + 65536 + 9216);
    LAS bf16_t* SG = (LAS bf16_t*)(L + 65536 + 18432);
    LAS bf16_t* At = (LAS bf16_t*)(L + 65536);
    LAS bf16_t* Btl = (LAS bf16_t*)(L + 65536 + 9216);
    LAS bf16_t* Ktl = (LAS bf16_t*)(L + 65536 + 18432);
    LAS bf16_t* Rtl = (LAS bf16_t*)(L + 65536 + 27648);
    LAS float* Of = (LAS float*)(L + 65536);
    LAS bf16_t* BtTn = (LAS bf16_t*)(L + 102400);
    LAS bf16_t* KtT = (LAS bf16_t*)(L + 111616);
    LAS bf16_t* Vt = (LAS bf16_t*)(L + 120832);
    LAS bf16_t* Zt = (LAS bf16_t*)(L + 130048);
    LAS bf16_t* PU = (LAS bf16_t*)(L + 139264);
    LAS float* halo = (LAS float*)(L + 148480);
    LAS float* bonus = halo + 896;
    LAS float* glv = bonus + 64;
    static_assert(148480 + 4096 <= LDS_MISC, "rwkv3 LDS");
    bf16_t* P = (bf16_t*)(F.ws + WS_BIG + BIG_PROJ);
    const bf16_t* LW = (const bf16_t*)(F.ws + WS_LORA);
    const float* mu = F.in[IN_AB_MU];
    const float kkj = F.in[IN_AB_KK][h * 64 + lane0], kaj = F.in[IN_AB_KA][h * 64 + lane0], rkj = F.in[IN_AB_RK][h * 64 + lane0];
    const float lnw = F.in[IN_AB_LNW][h * 64 + lane0], lnb = F.in[IN_AB_LNB][h * 64 + lane0];
    float w0q[2], a0q[2];
#pragma unroll
    for (int q = 0; q < 2; ++q) { const int jq = ((2 * w + q) & 3) * 16 + (lane0 & 15); w0q[q] = F.in[IN_AB_W0][h * 64 + jq]; a0q[q] = F.in[IN_AB_A0][h * 64 + jq]; }
    f32x4 zacc[4];
#pragma unroll
    for (int i = 0; i < 4; ++i) zacc[i] = (f32x4){0.f, 0.f, 0.f, 0.f};
    for (int i = w * 64 + lane0; i < 896; i += NTHREADS) halo[i] = 0.f;
    for (int i = w * 64 + lane0; i < (64 * 72 * 2) / 2; i += NTHREADS) ((LAS unsigned*)Zt)[i] = 0u;
    __syncthreads();
    for (int c = 0; c < 32; ++c) {
        int lane = lane0; asm volatile("" : "+v"(lane));
        const int tid = w * 64 + lane, fr = lane & 15, fq = lane >> 4;
        const int t0 = b * TS + c * 64;
        {
            const LAS float* hc = halo + (c & 1) * 448; LAS float* hn = halo + ((c + 1) & 1) * 448;
            const bf16_t* Pc = P + (size_t)t0 * P0LD;
            float sh[8];
#pragma unroll
            for (int n = 0; n < 2; ++n) {
                const int item = tid + NTHREADS * n, t = item >> 4, cg = item & 15;
                rwkv_shift8(Pc, t, ((cg < 8) ? 2048 : 2560) + h * 64 + (cg & 7) * 8, cg * 8, mu, hc, hn, sh);
                u32x4 o; o.x = pk2(sh[0], sh[1]); o.y = pk2(sh[2], sh[3]); o.z = pk2(sh[4], sh[5]); o.w = pk2(sh[6], sh[7]);
                *(LAS u32x4*)((cg < 8 ? RPb : KPb) + t * 72 + (cg & 7) * 8) = o;
            }
            asm volatile("" ::: "memory");
            {
                const int t = tid >> 3, cg = tid & 7;
                rwkv_shift8(Pc, t, 3072 + h * 64 + cg * 8, 128 + cg * 8, mu, hc, hn, sh);
#pragma unroll
                for (int e = 0; e < 8; ++e) Vt[(cg * 8 + e) * 72 + t] = (bf16_t)f2bf(sh[e]);
            }
            {
                const int t = tid >> 3, cg = tid & 7;
                rwkv_shift8(Pc, t, 3584 + cg * 8, 192 + cg * 8, mu, hc, hn, sh);
                u32x4 o; o.x = pk2(tanh_fast(sh[0]), tanh_fast(sh[1])); o.y = pk2(tanh_fast(sh[2]), tanh_fast(sh[3])); o.z = pk2(tanh_fast(sh[4]), tanh_fast(sh[5])); o.w = pk2(tanh_fast(sh[6]), tanh_fast(sh[7]));
                *(LAS u32x4*)(TL + t * 72 + cg * 8) = o;
            }
            {
                const int t = tid >> 3, cg = tid & 7;
                rwkv_shift8(Pc, t, 3648 + cg * 8, 256 + cg * 8, mu, hc, hn, sh);
                u32x4 o; o.x = pk2(sh[0], sh[1]); o.y = pk2(sh[2], sh[3]); o.z = pk2(sh[4], sh[5]); o.w = pk2(sh[6], sh[7]);
                *(LAS u32x4*)(AL + t * 72 + cg * 8) = o;
            }
            asm volatile("" ::: "memory");
#pragma unroll
            for (int n = 0; n < 2; ++n) {
                const int item = tid + NTHREADS * n, t = item >> 4, cg = item & 15;
                rwkv_shift8(Pc, t, 3712 + cg * 8, 320 + cg * 8, mu, hc, hn, sh);
                u32x4 o; o.x = pk2(sigmoidf_(sh[0]), sigmoidf_(sh[1])); o.y = pk2(sigmoidf_(sh[2]), sigmoidf_(sh[3])); o.z = pk2(sigmoidf_(sh[4]), sigmoidf_(sh[5])); o.w = pk2(sigmoidf_(sh[6]), sigmoidf_(sh[7]));
                *(LAS u32x4*)(SG + t * 136 + cg * 8) = o;
            }
        }
        __syncthreads();
        f32x4 agate[2];
        {
#pragma unroll
            for (int q = 0; q < 2; ++q) {
                const int id = 2 * w + q, mi = id >> 2, nj = id & 3;
                f32x4 aw = {0.f, 0.f, 0.f, 0.f}, aa = {0.f, 0.f, 0.f, 0.f}, ag = {0.f, 0.f, 0.f, 0.f};
                const int jrow = h * 64 + nj * 16 + fr;
#pragma unroll
                for (int ksx = 0; ksx < 2; ++ksx) {
                    const bf16x8 x1 = *(const LAS bf16x8*)(TL + (mi * 16 + fr) * 72 + ksx * 32 + fq * 8), x2 = *(const LAS bf16x8*)(AL + (mi * 16 + fr) * 72 + ksx * 32 + fq * 8);
                    const bf16x8 y1 = *(const bf16x8*)(LW + (size_t)jrow * 64 + ksx * 32 + fq * 8), y2 = *(const bf16x8*)(LW + 512 * 64 + (size_t)jrow * 64 + ksx * 32 + fq * 8);
                    aw = MFMA32(x1, y1, aw); aa = MFMA32(x2, y2, aa);
                }
#pragma unroll
                for (int ksx = 0; ksx < 4; ++ksx) {
                    const bf16x8 x3 = *(const LAS bf16x8*)(SG + (mi * 16 + fr) * 136 + ksx * 32 + fq * 8);
                    const bf16x8 y3 = *(const bf16x8*)(LW + 2 * 512 * 64 + (size_t)jrow * 128 + ksx * 32 + fq * 8);
                    ag = MFMA32(x3, y3, ag);
                }
                agate[q] = ag;
                const int j = nj * 16 + fr; const float w0j = w0q[q], a0j = a0q[q];
                const float awv[4] = {aw.x, aw.y, aw.z, aw.w}, aav[4] = {aa.x, aa.y, aa.z, aa.w};
#pragma unroll
                for (int rg = 0; rg < 4; ++rg) { const int t = mi * 16 + 4 * fq + rg;
                    LWf[t * 64 + j] = -0.6065306597126334f * sigmoidf_(w0j + awv[rg]); Af[t * 64 + j] = sigmoidf_(a0j + aav[rg]); }
            }
        }
        __syncthreads();
        {
            float g[8]; float run = 0.f;
#pragma unroll
            for (int i = 0; i < 8; ++i) { run += LWf[(8 * w + i) * 64 + lane]; g[i] = run; }
            segs[w * 64 + lane] = run;
            __syncthreads();
            float off = 0.f;
#pragma unroll
            for (int s2 = 0; s2 < 7; ++s2) if (s2 < w) off += segs[s2 * 64 + lane];
#pragma unroll
            for (int i = 0; i < 8; ++i) LWf[(8 * w + i) * 64 + lane] = off + g[i];
        }
        __syncthreads();
        {
            const int j = lane;
#pragma unroll
            for (int i = 0; i < 8; ++i) {
                const int t = 8 * w + i;
                const float kv = bf2f(KPb[t * 72 + j]), rv = bf2f(RPb[t * 72 + j]), a = Af[t * 64 + j], G = LWf[t * 64 + j];
                const float Gp = (t > 0) ? LWf[(t - 1) * 64 + j] : 0.f;
                const float kx = kv * kkj; const float ss = wsum(kx * kx); const float kk = kx * (1.0f / sqrtf(ss + 1e-6f));
                const float km = kv * (1.f + (a - 1.f) * kaj);
                const float bs = wsum(rv * km * rkj); if (j == 0) bonus[t] = bs;
                const float eG = __expf(G), eGi = __expf(-G), eGp = __expf(Gp);
                const float bt = kk * a * eGi, kt = km * eGi;
                At[t * 72 + j] = (bf16_t)f2bf(kk * eGp); Btl[t * 72 + j] = (bf16_t)f2bf(bt); Ktl[t * 72 + j] = (bf16_t)f2bf(kt); Rtl[t * 72 + j] = (bf16_t)f2bf(rv * eG);
                BtTn[j * 72 + t] = (bf16_t)f2bf(-bt); KtT[j * 72 + t] = (bf16_t)f2bf(kt);
                if (t == 63) glv[j] = eG;
            }
        }
        __syncthreads();
        {
            for (int job = w; job < 64; job += NWAVES) {
                const int mat = job >> 4, bi = (job >> 2) & 3, bj = job & 3;
                LAS bf16_t* dst = (mat == 0) ? Aoff : (mat == 1 ? Mak : (mat == 2 ? Mrk : Mrbn));
                const int i = 16 * bi + fr, j0 = 16 * bj + 4 * fq;
                f32x4 o = {0.f, 0.f, 0.f, 0.f};
                if (bj <= bi) {
                    const LAS bf16_t* Aj = ((mat == 0 || mat == 3) ? Btl : Ktl) + bj * 16 * 72; const LAS bf16_t* Bi = ((mat < 2) ? At : Rtl) + bi * 16 * 72;
                    const f32x4 acc = mm_tile(Aj, 72, Bi, 72, 2, (f32x4){0.f, 0.f, 0.f, 0.f}, fr, fq);
                    const bool incl = mat >= 2;
                    o.x = (incl ? (j0 <= i) : (j0 < i)) ? acc.x : 0.f; o.y = (incl ? (j0 + 1 <= i) : (j0 + 1 < i)) ? acc.y : 0.f;
                    o.z = (incl ? (j0 + 2 <= i) : (j0 + 2 < i)) ? acc.z : 0.f; o.w = (incl ? (j0 + 3 <= i) : (j0 + 3 < i)) ? acc.w : 0.f;
                    if (mat == 0 && bi == bj) { LAS float* dd = Adg + (bi * 16 + fr) * 17 + 4 * fq; dd[0] = o.x; dd[1] = o.y; dd[2] = o.z; dd[3] = o.w; o = (f32x4){0.f, 0.f, 0.f, 0.f}; }
                    if (mat == 0 || mat == 3) o = -o;
                }
                lds_w4(dst + i * 72 + j0, o);
            }
#pragma unroll
            for (int q = 0; q < 2; ++q) { const int id = 2 * w + q, mi = id >> 2, nj = id & 3; const int j = nj * 16 + fr; const float gv[4] = {agate[q].x, agate[q].y, agate[q].z, agate[q].w};
#pragma unroll
                for (int rg = 0; rg < 4; ++rg) GB[(mi * 16 + 4 * fq + rg) * 64 + j] = (bf16_t)f2bf(gv[rg]); }
        }
        __syncthreads();
        f32x4 ot[4];
        if (w < 4) {
            {
                const int bb = lane >> 4, jj = lane & 15; float x[16]; const LAS float* a = Adg + bb * 16 * 17;
#pragma unroll
                for (int i = 0; i < 16; ++i) { float v = (i == jj) ? 1.f : 0.f;
#pragma unroll
                    for (int k = 0; k < i; ++k) v -= a[i * 17 + k] * x[k];
                    x[i] = v; Dg[(bb * 16 + i) * 24 + jj] = (bf16_t)f2bf(v); }
                asm volatile("s_waitcnt lgkmcnt(0)" ::: "memory");
            }
            const LAS bf16_t* Vw = Vt + (16 * w) * 72; const LAS bf16_t* Zw = Zt + (16 * w) * 72; LAS bf16_t* PUw = PU + (16 * w) * 72;
            f32x4 p[4];
#pragma unroll
            for (int mi = 0; mi < 4; ++mi) { p[mi] = mm_tile(At + mi * 16 * 72, 72, Zw, 72, 2, (f32x4){0.f, 0.f, 0.f, 0.f}, fr, fq); p[mi] = mm_tile(Mak + mi * 16 * 72, 72, Vw, 72, 2, p[mi], fr, fq); }
#pragma unroll
            for (int bb = 0; bb < 4; ++bb) {
                f32x4 acc = p[bb];
                if (bb >= 1) acc = mm_tile(Aoff + bb * 16 * 72, 72, PUw, 72, (bb + 1) / 2, acc, fr, fq);
                u32x2 pk; pk.x = pk2(acc.x, acc.y); pk.y = pk2(acc.z, acc.w);
                const bf16x4 dgf = *(const LAS bf16x4*)(Dg + (bb * 16 + fr) * 24 + 4 * fq);
                const f32x4 ub = MFMA16(dgf, __builtin_bit_cast(bf16x4, pk), ((f32x4){0.f, 0.f, 0.f, 0.f}));
                lds_w4(PUw + fr * 72 + 16 * bb + 4 * fq, ub);
                asm volatile("s_waitcnt lgkmcnt(0)" ::: "memory");
            }
#pragma unroll
            for (int mi = 0; mi < 4; ++mi) {
                f32x4 o = mm_tile(Rtl + mi * 16 * 72, 72, Zw, 72, 2, (f32x4){0.f, 0.f, 0.f, 0.f}, fr, fq);
                o = mm_tile(Mrk + mi * 16 * 72, 72, Vw, 72, 2, o, fr, fq);
                ot[mi] = mm_tile(Mrbn + mi * 16 * 72, 72, PUw, 72, 2, o, fr, fq);
            }
#pragma unroll
            for (int kb = 0; kb < 4; ++kb) {
                f32x4 zn = mm_tile(KtT + kb * 16 * 72, 72, Vw, 72, 2, zacc[kb], fr, fq);
                zn = mm_tile(BtTn + kb * 16 * 72, 72, PUw, 72, 2, zn, fr, fq);
                const f32x4 g4 = *(const LAS f32x4*)(glv + 16 * kb + 4 * fq);
                zn = zn * g4; zacc[kb] = zn;
                lds_w4(Zt + (16 * w + fr) * 72 + 16 * kb + 4 * fq, zn);
            }
        }
        __syncthreads();
        if (w < 4) {
#pragma unroll
            for (int mi = 0; mi < 4; ++mi) { LAS float* op = Of + (16 * mi + 4 * fq) * 65 + 16 * w + fr; op[0] = ot[mi].x; op[65] = ot[mi].y; op[130] = ot[mi].z; op[195] = ot[mi].w; }
        }
        __syncthreads();
        for (int t = w; t < 64; t += NWAVES) {
            const float o = Of[t * 65 + lane];
            const float mean = wsum(o) * (1.0f / 64.0f); const float dlt = o - mean; const float var = wsum(dlt * dlt) * (1.0f / 64.0f);
            float y = dlt * (1.0f / sqrtf(var + 64e-5f)) * lnw + lnb;
            y += bonus[t] * bf2f(Vt[lane * 72 + t]);
            y *= bf2f(GB[t * 64 + lane]);
            P[(size_t)(t0 + t) * P0LD + 2048 + h * 64 + lane] = (bf16_t)f2bf(y);
        }
        __syncthreads();
    }
}

__device__ __forceinline__ void attn_phase(const Frame& F, const bf16_t* Q, const bf16_t* Kb, const bf16_t* VT, bf16_t* O) {
    const int lane = lane_id_v(); const int tid = F.wave * 64 + lane; (void)tid;
    const int fr = lane & 15, fq = lane >> 4;
    for (int u = F.wg; u < 512; u += F.G) {
        const int b = u >> 6, h = (u >> 4) & 3, qb = u & 15;
        const int q0 = b * TS + qb * 128 + F.wave * 16;
        bf16x8 bq[8];
#pragma unroll
        for (int ksx = 0; ksx < 8; ++ksx) bq[ksx] = *(const bf16x8*)(Q + (size_t)(q0 + fr) * 1024 + h * 256 + ksx * 32 + fq * 8);
        f32x4 sacc[16];
#pragma unroll
        for (int tl = 0; tl < 16; ++tl) {
            f32x4 a4 = {0.f, 0.f, 0.f, 0.f};
            const bf16_t* kp = Kb + (size_t)(b * 256 + tl * 16 + fr) * 1024 + h * 256 + fq * 8;
#pragma unroll
            for (int ksx = 0; ksx < 8; ++ksx) { const bf16x8 a = *(const bf16x8*)(kp + ksx * 32); a4 = __builtin_amdgcn_mfma_f32_16x16x32_bf16(a, bq[ksx], a4, 0, 0, 0); }
            sacc[tl] = a4;
        }
        float mx = -3.0e38f;
#pragma unroll
        for (int tl = 0; tl < 16; ++tl) mx = fmaxf(mx, fmaxf(fmaxf(sacc[tl].x, sacc[tl].y), fmaxf(sacc[tl].z, sacc[tl].w)));
        mx = fmaxf(mx, __shfl_xor(mx, 16)); mx = fmaxf(mx, __shfl_xor(mx, 32));
        float l = 0.f;
        bf16x8 pb[8];
#pragma unroll
        for (int ksx = 0; ksx < 8; ++ksx) {
            const f32x4 e0 = sacc[2 * ksx], e1 = sacc[2 * ksx + 1];
            const float p0 = __expf(e0.x - mx), p1 = __expf(e0.y - mx), p2 = __expf(e0.z - mx), p3 = __expf(e0.w - mx);
            const float p4 = __expf(e1.x - mx), p5 = __expf(e1.y - mx), p6 = __expf(e1.z - mx), p7 = __expf(e1.w - mx);
            l += ((p0 + p1) + (p2 + p3)) + ((p4 + p5) + (p6 + p7));
            u32x4 w; w.x = pk2(p0, p1); w.y = pk2(p2, p3); w.z = pk2(p4, p5); w.w = pk2(p6, p7);
            pb[ksx] = __builtin_bit_cast(bf16x8, w);
        }
        l += __shfl_xor(l, 16); l += __shfl_xor(l, 32);
        const float inv = 1.0f / l;
        const bf16_t* vbase = VT + (size_t)((b * 4 + h) * 256) * 256;
#pragma unroll 4
        for (int dt = 0; dt < 16; ++dt) {
            f32x4 o4 = {0.f, 0.f, 0.f, 0.f};
            const bf16_t* vp = vbase + (size_t)(dt * 16 + fr) * 256 + 4 * fq;
#pragma unroll
            for (int ksx = 0; ksx < 8; ++ksx) {
                const u32x2 lo = *(const u32x2*)(vp + ksx * 32), hi = *(const u32x2*)(vp + ksx * 32 + 16);
                u32x4 w; w.x = lo.x; w.y = lo.y; w.z = hi.x; w.w = hi.y;
                o4 = __builtin_amdgcn_mfma_f32_16x16x32_bf16(__builtin_bit_cast(bf16x8, w), pb[ksx], o4, 0, 0, 0);
            }
            u32x2 w; w.x = pk2(o4.x * inv, o4.y * inv); w.y = pk2(o4.z * inv, o4.w * inv);
            *(u32x2*)(O + (size_t)(q0 + fr) * 1024 + h * 256 + dt * 16 + 4 * fq) = w;
        }
    }
}

__device__ __forceinline__ void router_phase(const Frame& F, int layer) {
    const int lane = lane_id_v(); const int tid = F.wave * 64 + lane; (void)tid;
    const float* XF = F.out; const float* gain = F.in[IN_NORM_FFN] + layer * 1024;
    const float* wg = F.in[IN_MOE_WG] + (size_t)layer * 1024 * 4; const float* we = F.in[IN_MOE_WE] + (size_t)layer * 1024 * 16;
    const float* bg = F.in[IN_MOE_BG] + layer * 4; const float* be = F.in[IN_MOE_BE] + layer * 16;
    unsigned* cnt = (unsigned*)(F.ws + WS_CNT) + layer * 32;
    int* tokb = (int*)(F.ws + WS_ROUTE); int* tokp = tokb + NT; f32x4* tokg = (f32x4*)(tokp + NT);
    const int gw = F.wg * NWAVES + F.wave, NGW = F.G * NWAVES;
    for (int row = gw; row < NT; row += NGW) {
        const f32x4* xr = (const f32x4*)(XF + (size_t)row * 1024) + lane;
        float s = 0.f, lg[4], le[16];
#pragma unroll
        for (int c = 0; c < 4; ++c) lg[c] = 0.f;
#pragma unroll
        for (int c = 0; c < 16; ++c) le[c] = 0.f;
#pragma unroll 1
        for (int j = 0; j < 4; ++j) {
            const f32x4 v = xr[64 * j]; s += (v.x * v.x + v.y * v.y) + (v.z * v.z + v.w * v.w);
            const int k0 = 4 * lane + 256 * j; const f32x4 g = *(const f32x4*)(gain + k0);
            const float xv[4] = {v.x * g.x, v.y * g.y, v.z * g.z, v.w * g.w};
#pragma unroll
            for (int q = 0; q < 4; ++q) {
                const f32x4 a = *(const f32x4*)(wg + (size_t)(k0 + q) * 4);
                lg[0] += xv[q] * a.x; lg[1] += xv[q] * a.y; lg[2] += xv[q] * a.z; lg[3] += xv[q] * a.w;
#pragma unroll
                for (int e4 = 0; e4 < 4; ++e4) { const f32x4 w = *(const f32x4*)(we + (size_t)(k0 + q) * 16 + 4 * e4);
                    le[4 * e4] += xv[q] * w.x; le[4 * e4 + 1] += xv[q] * w.y; le[4 * e4 + 2] += xv[q] * w.z; le[4 * e4 + 3] += xv[q] * w.w; }
            }
        }
        s = wave_sum(s);
        const float rstd = 1.0f / sqrtf(s * (1.0f / 1024.0f) + 1e-6f);
#pragma unroll
        for (int c = 0; c < 4; ++c) lg[c] = wave_sum(lg[c]) * rstd + bg[c];
#pragma unroll
        for (int c = 0; c < 16; ++c) le[c] = wave_sum(le[c]) * rstd + be[c];
        int gs = 0; float gm = lg[0];
#pragma unroll
        for (int c = 1; c < 4; ++c) if (lg[c] > gm) { gm = lg[c]; gs = c; }
        float gz = 0.f;
#pragma unroll
        for (int c = 0; c < 4; ++c) gz += __expf(lg[c] - gm);
        const float ggate = 1.0f / gz;
        float l4[4];
#pragma unroll
        for (int c = 0; c < 4; ++c) { float v = le[c];
#pragma unroll
            for (int g2 = 1; g2 < 4; ++g2) v = (gs == g2) ? le[4 * g2 + c] : v;
            l4[c] = v; }
        int i0 = 0; float m0 = l4[0];
#pragma unroll
        for (int c = 1; c < 4; ++c) if (l4[c] > m0) { m0 = l4[c]; i0 = c; }
        int i1 = -1; float m1 = -3.0e38f;
#pragma unroll
        for (int c = 0; c < 4; ++c) if (c != i0 && l4[c] > m1) { m1 = l4[c]; i1 = c; }
        const float e1 = __expf(m1 - m0); const float g0 = ggate / (1.f + e1), g1 = ggate * e1 / (1.f + e1);
        const int ia = i0 < i1 ? i0 : i1, ib = i0 < i1 ? i1 : i0;
        const float ga = i0 < i1 ? g0 : g1, gb = i0 < i1 ? g1 : g0;
        const int pidx = (ia == 0) ? (ib - 1) : (ia == 1 ? ib + 1 : 5);
        const int bucket = gs * 6 + pidx;
        if (lane == 0) {
            const unsigned pos = atomicAdd(&cnt[bucket], 1u);
            tokb[row] = bucket; tokp[row] = (int)pos; tokg[row] = (f32x4){rstd, ga, gb, 0.f};
        }
    }
}
__device__ __forceinline__ void gather_phase(const Frame& F, int layer) {
    const int lane = lane_id_v(); const int tid = F.wave * 64 + lane; (void)tid;
    const unsigned* cnt = (const unsigned*)(F.ws + WS_CNT) + layer * 32;
    const int* tokb = (const int*)(F.ws + WS_ROUTE); const int* tokp = tokb + NT; const f32x4* tokg = (const f32x4*)(tokp + NT); f32x4* rowinfo = (f32x4*)(tokg + NT);
    const bf16_t* XB = (const bf16_t*)(F.ws + WS_XB); bf16_t* XG = (bf16_t*)(F.ws + WS_BIG + BIG_XG);
    LAS int* off = (LAS int*)F.lds;
    if (tid == 0) { int acc = 0; for (int b = 0; b < 24; ++b) { off[b] = acc * 256; acc += ((int)cnt[b] + 255) >> 8; } }
    __syncthreads();
    const int gw = F.wg * NWAVES + F.wave, NGW = F.G * NWAVES;
    for (int tok = gw; tok < NT; tok += NGW) {
        const int row = off[tokb[tok]] + tokp[tok];
        const u32x4* src = (const u32x4*)(XB + (size_t)tok * 1024) + lane; u32x4* dst = (u32x4*)(XG + (size_t)row * 1024) + lane;
        dst[0] = src[0]; dst[64] = src[64];
        if (lane == 0) { f32x4 g = tokg[tok]; g.w = __int_as_float(tok); rowinfo[row] = g; }
    }
    __syncthreads();
}
__device__ __forceinline__ void final_phase(const Frame& F) {
    const int lane = lane_id_v(); const int tid = F.wave * 64 + lane; (void)tid;
    float* XF = F.out; const float* gain = F.in[IN_NORM_FINAL];
    const int gw = F.wg * NWAVES + F.wave, NGW = F.G * NWAVES;
    for (int row = gw; row < NT; row += NGW) {
        f32x4* xr = (f32x4*)(XF + (size_t)row * 1024) + lane;
        f32x4 v[4]; float s = 0.f;
#pragma unroll
        for (int j = 0; j < 4; ++j) { v[j] = xr[64 * j]; s += (v[j].x * v[j].x + v[j].y * v[j].y) + (v[j].z * v[j].z + v[j].w * v[j].w); }
        s = wave_sum(s);
        const float rstd = 1.0f / sqrtf(s * (1.0f / 1024.0f) + 1e-6f);
#pragma unroll
        for (int j = 0; j < 4; ++j) { const f32x4 g = *(const f32x4*)(gain + 4 * lane + 256 * j); xr[64 * j] = v[j] * rstd * g; }
    }
}

constexpr int N_PHASES = 24;
#ifndef PH_MASK
#define PH_MASK 0xFFFFFFFFu
#endif
#define IN(k) (((PH_MASK >> ((k) > 11 ? (k) - 11 : (k))) & 1u) && lo <= (k) && (k) < hi)
#define SEAM(k) do { if (IN(k) && IN((k) + 1)) xcd_barrier(bar); } while (0)

template <int LAYER>
__device__ __forceinline__ void layer_phases(const Frame& F, const XcdBarrier& bar, const int lo, const int hi) {
    constexpr int pb = LAYER * 11;
    unsigned char* const ws = F.ws;
#define WPTR(off) ((bf16_t*)(ws + (LAYER ? WS_W1 : WS_W0)) + (off))
#define XB_ ((bf16_t*)(ws + WS_XB))
#define SSP_ ((float*)(ws + WS_SSP))
#define PROJ_ ((bf16_t*)(ws + WS_BIG + BIG_PROJ))
#define KB_ (LAYER ? (bf16_t*)(ws + WS_W0) : (bf16_t*)(ws + WS_BIG + BIG_KV0))
#define VT_ (KB_ + (size_t)2048 * 1024)
#define QB_ ((bf16_t*)(ws + WS_BIG + BIG_Q))
#define ATT_ ((bf16_t*)(ws + WS_BIG + BIG_ATT))
#define XG_ ((bf16_t*)(ws + WS_BIG + BIG_XG))
#define HID_ ((bf16_t*)(ws + WS_BIG + BIG_HID))
#define CNT_ ((const unsigned*)(ws + WS_CNT) + LAYER * 32)
#define ROWINFO_ ((const f32x4*)(ws + WS_ROUTE + (size_t)NT * 8 + (size_t)NT * 16))
    if (IN(pb + 1)) {
        if (LAYER == 0) {
            pg8::Gemm g{1024, 1024, 1024, 1 << 20}; pg8::DenseSched S; S.init(NT, 3840, F.G, F.wg, XB_, 1024, WPTR(WO_WIN), 1024);
            EpiScale<0> E{PROJ_, P0LD, SSP_, 1.0f, nullptr};
            pg8::gemm_phase(F.lds, F.wave, g, S, E);
        } else {
            pg8::Gemm g{1024, 1024, 1024, 1 << 20}; pg8::DenseSched S; S.init(NT, 4096, F.G, F.wg, XB_, 1024, WPTR(WO_WIN), 1024);
            EpiScale<1> E{PROJ_, P1LD, SSP_, 1.0f, (const float*)(ws + WS_LB)};
            pg8::gemm_phase(F.lds, F.wave, g, S, E);
        }
        { pg8::Gemm g{1024, 1024, 1024, 1 << 20}; pg8::DenseSched S; S.init(2048, 2048, F.G, F.wg, (const bf16_t*)(ws + WS_MEMH), 1024, WPTR(WO_WKV), 1024);
          EpiKV E{KB_, VT_}; pg8::gemm_phase(F.lds, F.wave, g, S, E); }
    }
    SEAM(pb + 1);
    if (IN(pb + 2)) {
        if (LAYER == 0) {
#ifndef NO_DELTA
            if (F.wg < 32) scan_delta3(F, F.wg >> 2, F.wg & 3);
#endif
#ifndef NO_RWKV
            if (F.wg >= 32 && F.wg < 96) scan_rwkv3(F, (F.wg - 32) >> 3, (F.wg - 32) & 7);
#endif
        } else {
#ifndef NO_HGRN
            if (F.wg < 64) scan_hgrn3(F, F.wg >> 3, F.wg & 7);
#endif
        }
    }
    SEAM(pb + 2);
    SEAM(pb + 3);
    if (IN(pb + 4)) {
        constexpr int lda = LAYER ? P1LD : P0LD; const bf16_t* A = PROJ_ + (LAYER ? 3072 : 1536);
        pg8::Gemm g{lda, 1024, 1024, 1 << 20}; pg8::DenseSched S; S.init(NT, 1024, F.G, F.wg, A, lda, WPTR(WO_WOUT), 1024);
        EpiResid<false> E{LAYER ? (const float*)F.out : F.in[IN_X], F.out, XB_, SSP_, nullptr};
        pg8::gemm_phase(F.lds, F.wave, g, S, E);
    }
    SEAM(pb + 4);
    if (IN(pb + 5)) {
        pg8::Gemm g{1024, 1024, 1024, 1 << 20}; pg8::DenseSched S; S.init(NT, 1024, F.G, F.wg, XB_, 1024, WPTR(WO_WQ), 1024);
        EpiScale<0> E{QB_, 1024, SSP_, 0.0625f, nullptr};
        pg8::gemm_phase(F.lds, F.wave, g, S, E);
    }
    SEAM(pb + 5);
    if (IN(pb + 6)) attn_phase(F, QB_, KB_, VT_, ATT_);
    SEAM(pb + 6);
    if (IN(pb + 7)) {
        pg8::Gemm g{1024, 1024, 1024, 1 << 20}; pg8::DenseSched S; S.init(NT, 1024, F.G, F.wg, ATT_, 1024, WPTR(WO_WO), 1024);
        EpiResid<false> E{F.out, F.out, XB_, SSP_, nullptr};
        pg8::gemm_phase(F.lds, F.wave, g, S, E);
    }
    SEAM(pb + 7);
    if (IN(pb + 8)) router_phase(F, LAYER);
    SEAM(pb + 8);
    if (IN(pb + 9)) gather_phase(F, LAYER);
    SEAM(pb + 9);
    if (IN(pb + 10)) {
        LAS int* tbl = (LAS int*)(F.lds + LDS_MISC + 512); moe_build_table(tbl, CNT_, F.wave * 64 + lane_id_v());
        pg8::Gemm g{1024, 1024, 1024, 1 << 20}; MoeSched<false> S{tbl, __builtin_amdgcn_readfirstlane(tbl[95]), F.G, F.wg, (const char*)XG_, (const char*)WPTR(WO_W13)};
        EpiMoeUp E{HID_, ROWINFO_};
        pg8::gemm_phase(F.lds, F.wave, g, S, E);
    }
    SEAM(pb + 10);
    if (IN(pb + 11)) {
        LAS int* tbl = (LAS int*)(F.lds + LDS_MISC + 512); moe_build_table(tbl, CNT_, F.wave * 64 + lane_id_v());
        pg8::Gemm g{512, 256, 512, 4}; MoeSched<true> S{tbl, __builtin_amdgcn_readfirstlane(tbl[95]), F.G, F.wg, (const char*)HID_, (const char*)WPTR(WO_W2T)};
        EpiResid<true> E{F.out, F.out, XB_, SSP_, ROWINFO_};
        pg8::gemm_phase(F.lds, F.wave, g, S, E);
    }
    SEAM(pb + 11);
}

__global__ void __launch_bounds__(NTHREADS, 2) fwd_mega(Args args) {
    extern __shared__ __attribute__((aligned(16))) unsigned char lds_raw[];
    Frame F;
    F.lds = (LAS unsigned char*)lds_raw;
    const int tid = threadIdx.x; F.wave = __builtin_amdgcn_readfirstlane(tid >> 6);
    F.G = gridDim.x; F.wg = blockIdx.x;
    F.out = args.out; F.ws = args.ws;
    volatile LAS unsigned* MISC = (volatile LAS unsigned*)(F.lds + LDS_MISC);
    LAS unsigned long long* tab = (LAS unsigned long long*)(F.lds + LDS_MISC + 64);
    F.in.t = tab;
    if (tid < 16) MISC[tid] = 0u;
    if (tid == 0) {
#pragma unroll
        for (int i = 0; i < 38; ++i) tab[i] = (unsigned long long)args.in[i];
    }
    __syncthreads();
    XcdBarrier bar; bar.bar = (unsigned*)(F.ws + WS_CTL); bar.x = 0; bar.st = MISC; bar.wave = F.wave;
#if N_LAUNCH_MODE == 1
    bar = xcd_barrier_post((unsigned*)(F.ws + WS_CTL), MISC, F.wave);
#endif
    const int lo = args.ph_lo, hi = args.ph_hi;
    if (IN(0)) { p0_prologue(F); }
    SEAM(0);
    layer_phases<0>(F, bar, lo, hi);
    layer_phases<1>(F, bar, lo, hi);
    if (IN(23)) final_phase(F);
}
#undef IN
#undef SEAM

extern "C" void kernel_launch(void* const* d_in, const int* in_sizes, int n_in, void* d_out, int out_size, void* d_ws, size_t ws_size, hipStream_t stream) {
    static int grid = 0;
    if (grid == 0) {
        if (n_in != 38 || out_size != NT * DM || ws_size < WS_END) { fprintf(stderr, "kernel_launch: unexpected problem (n_in %d out %d ws %zu)\n", n_in, out_size, ws_size); grid = -1; return; }
        int dev = 0, cus = 0, per_cu = 0;
        if (hipGetDevice(&dev) != hipSuccess || hipDeviceGetAttribute(&cus, hipDeviceAttributeMultiprocessorCount, dev) != hipSuccess) { grid = -1; return; }
        if (hipFuncSetAttribute((const void*)fwd_mega, hipFuncAttributeMaxDynamicSharedMemorySize, LDS_BYTES) != hipSuccess) { fprintf(stderr, "kernel_launch: hipFuncSetAttribute failed\n"); grid = -1; return; }
        if (hipOccupancyMaxActiveBlocksPerMultiprocessor(&per_cu, (const void*)fwd_mega, NTHREADS, LDS_BYTES) != hipSuccess || per_cu < 1) { fprintf(stderr, "kernel_launch: occupancy query says %d\n", per_cu); (void)hipGetLastError(); grid = -1; return; }
        grid = cus;
    }
    if (grid < 0) return;
    (void)hipMemsetAsync((char*)d_ws + WS_CTL, 0, 32768, stream);
    Args a{};
    for (int i = 0; i < 38; ++i) a.in[i] = (const float*)d_in[i];
    a.out = (float*)d_out; a.ws = (unsigned char*)d_ws;
#if N_LAUNCH_MODE == 1
    a.ph_lo = 0; a.ph_hi = N_PHASES;
    void* kargs[] = {&a};
    hipError_t e = hipLaunchCooperativeKernel((const void*)fwd_mega, dim3(grid), dim3(NTHREADS), kargs, LDS_BYTES, stream);
    if (e != hipSuccess) fprintf(stderr, "kernel_launch: cooperative launch failed: %s\n", hipGetErrorString(e));
#else
    for (int p = 0; p < N_PHASES; ++p) { a.ph_lo = p; a.ph_hi = p + 1; hipLaunchKernelGGL(fwd_mega, dim3(grid), dim3(NTHREADS), LDS_BYTES, stream, a); }
#endif
}
```

```cpp
#include <hip/hip_runtime.h>
#include <cstdio>
#include <cstdint>

#ifndef N_LAUNCH_MODE
#define N_LAUNCH_MODE 1
#endif

#ifndef TS_A
#define TS_A -1
#endif
#ifndef TS_B
#define TS_B 0
#endif
#ifndef PROBE_WG
#define PROBE_WG -1
#endif
#ifndef PROBE_STAGE
#define PROBE_STAGE -1
#endif
#ifndef TS_SCALE
#define TS_SCALE 0.01f
#endif

#define LAS __attribute__((address_space(3)))
#define GAS __attribute__((address_space(1)))
typedef unsigned short bf16_t;
typedef short bf16x8 __attribute__((ext_vector_type(8)));
typedef short bf16x4 __attribute__((ext_vector_type(4)));
typedef float f32x4 __attribute__((ext_vector_type(4)));
typedef float f32x2 __attribute__((ext_vector_type(2)));
typedef unsigned u32x4 __attribute__((ext_vector_type(4)));
typedef unsigned u32x2 __attribute__((ext_vector_type(2)));

constexpr int NT = 16384, DM = 1024, NB = 8, TS = 2048, NMEM = 256;
constexpr int P0LD = 3840;
constexpr int P1LD = 4096;
constexpr int NTHREADS = 512, NWAVES = 8;

constexpr size_t MiB = 1048576;
constexpr size_t WS_CTL = 0;
constexpr size_t WS_CNT = 16384;
constexpr size_t WS_LB = 32768;
constexpr size_t WS_DB = 1 * MiB;
constexpr size_t WS_SSP = WS_DB + 512 * 1024;
constexpr size_t WS_MEMH = WS_SSP + 1 * MiB;
constexpr size_t WS_ROUTE = WS_MEMH + 4 * MiB;
constexpr size_t WS_LORA = WS_ROUTE + 800 * 1024;
constexpr size_t WS_RW = WS_LORA + 256 * 1024;
constexpr size_t WS_W0 = 8 * MiB;
static_assert(WS_RW + 2 * 1024 * 32 * 4 <= 8 * MiB, "small weights");
constexpr size_t WS_W1 = WS_W0 + 42 * MiB;
constexpr size_t WS_XB = 92 * MiB;
constexpr size_t WS_BIG = 124 * MiB;
constexpr size_t WS_END = 256 * MiB;
constexpr size_t WO_WIN = 0;
constexpr size_t WO_WOUT = WO_WIN + (size_t)4096 * 1024;
constexpr size_t WO_WQ = WO_WOUT + (size_t)1024 * 1024;
constexpr size_t WO_WKV = WO_WQ + (size_t)1024 * 1024;
constexpr size_t WO_WO = WO_WKV + (size_t)2048 * 1024;
constexpr size_t WO_W13 = WO_WO + (size_t)1024 * 1024;
constexpr size_t WO_W2T = WO_W13 + (size_t)16 * 512 * 1024;
constexpr size_t WO_END = WO_W2T + (size_t)16 * 1024 * 256;
static_assert(WO_END * 2 <= 42 * MiB, "weight region");
constexpr size_t BIG_PROJ = 0;
constexpr size_t BIG_KV0 = 120 * MiB;
constexpr size_t BIG_Q = 0;
constexpr size_t BIG_ATT = 32 * MiB;
constexpr size_t BIG_XG = 0;
constexpr size_t BIG_HID = 48 * MiB;
constexpr int MOE_MAXROWS = 22528;

__device__ __forceinline__ unsigned f2bf(float f) { unsigned u = __float_as_uint(f); u += 0x7fffu + ((u >> 16) & 1u); return u >> 16; }
__device__ __forceinline__ float bf2f(unsigned short b) { return __uint_as_float((unsigned)b << 16); }
__device__ __forceinline__ unsigned pk2(float lo, float hi) { return f2bf(lo) | (f2bf(hi) << 16); }
__device__ __forceinline__ float wave_sum(float v) {
#pragma unroll
    for (int o = 1; o < 64; o <<= 1) v += __shfl_xor(v, o);
    return v;
}
__device__ __forceinline__ float rcpf_(float x) { return __builtin_amdgcn_rcpf(x); }
__device__ __forceinline__ float rsqf_(float x) { return __builtin_amdgcn_rsqf(x); }
__device__ __forceinline__ float sigmoidf_(float x) { return rcpf_(1.f + __expf(-x)); }
__device__ __forceinline__ float siluf_(float x) { return x * rcpf_(1.f + __expf(-x)); }
__device__ __forceinline__ float softplusf_(float x) { return x > 20.f ? x : log1pf(__expf(x)); }
__device__ __forceinline__ int lane_id_v() { int l; asm volatile("v_mbcnt_lo_u32_b32 %0, -1, 0\n\tv_mbcnt_hi_u32_b32 %0, -1, %0" : "=v"(l)); return l; }
#define LDS_WAIT() asm volatile("s_waitcnt lgkmcnt(0)" ::: "memory")
#define VM_WAIT() asm volatile("s_waitcnt vmcnt(0)" ::: "memory")

namespace pg8 {
constexpr int BM = 256, BK = 64, HALF = 128, HTB = HALF * BK * 2, STAGE_BYTES = 8 * HTB;
__host__ __device__ __forceinline__ int lds_byte(int r, int c) { const int st = (r >> 4) * 2 + (c >> 5), rr = r & 15, cc = c & 31, ob = rr * 64 + cc * 2; return st * 1024 + (ob ^ (((ob >> 9) & 1) << 5)); }
__host__ __device__ __forceinline__ void stage_rc(int b, int& R, int& C) { const int st = b / 1024, sb = b % 1024, swz = sb ^ (((sb >> 9) & 1) << 5); R = (st >> 1) * 16 + swz / 64; C = (st & 1) * 32 + (swz % 64) / 2; }

struct Unit { int pm, pn, aux; const char* a; const char* b0; const char* b1; };
struct Gemm { int lda, ldb, K, ksplit; };

template <class Epi, class Sched>
__device__ __forceinline__ void gemm_phase(LAS unsigned char* lds, const int wave_in, const Gemm g, const Sched& S, const Epi& E) {
    const int wid = wave_in, lane = lane_id_v(), tid = wid * 64 + lane, wr = wid >> 2, wc = wid & 3, fr = lane & 15, fq = lane >> 4;
    const int K = g.K, nt = K / BK, ks = g.ksplit;
    unsigned voffA[2], voffB[2];
#pragma unroll
    for (int i = 0; i < 2; ++i) { int R, C; stage_rc(tid * 16 + i * 8192, R, C);
        voffA[i] = (unsigned)(R * g.lda + C) * 2u; voffB[i] = (unsigned)(R * g.ldb + C) * 2u; }
    const size_t kstep = (size_t)(BK * 2);
    const size_t hstepA = (size_t)HALF * g.lda * 2, hstepB = (size_t)HALF * g.ldb * 2;
    const unsigned ldsw = (unsigned)wid * 1024u;
    const int aoff = lds_byte(wr * 64 + fr, fq * 8), boff = lds_byte(wc * 32 + fr, fq * 8);
#define PG8_SA(b, h) (((b) * 2 + (h)) * HTB)
#define PG8_SB(b, h) ((4 + (b) * 2 + (h)) * HTB)
#define PG8_STAGE(bufoff, gbase, voff) do { _Pragma("unroll") for (int _i = 0; _i < 2; ++_i) \
        __builtin_amdgcn_global_load_lds((const unsigned*)((const char*)(gbase) + (voff)[_i]), (LAS unsigned*)(lds + (bufoff) + ldsw + _i * 8192), 16, 0, 0); } while (0)
#define PG8_LDA(dst, b, h) do { _Pragma("unroll") for (int m = 0; m < 4; ++m) _Pragma("unroll") for (int k = 0; k < 2; ++k) dst[m][k] = *(const LAS bf16x8*)(lds + PG8_SA(b, h) + aoff + m * 2048 + k * 1024); } while (0)
#define PG8_LDB(dst, b, h) do { _Pragma("unroll") for (int n = 0; n < 2; ++n) _Pragma("unroll") for (int k = 0; k < 2; ++k) dst[n][k] = *(const LAS bf16x8*)(lds + PG8_SB(b, h) + boff + n * 2048 + k * 1024); } while (0)
#define PG8_MMA(ai, bj, At, Bt) do { __builtin_amdgcn_s_setprio(1); _Pragma("unroll") for (int m = 0; m < 4; ++m) _Pragma("unroll") for (int n = 0; n < 2; ++n) _Pragma("unroll") for (int k = 0; k < 2; ++k) \
        acc[ai][bj][m][n] = __builtin_amdgcn_mfma_f32_16x16x32_bf16(Bt[n][k], At[m][k], acc[ai][bj][m][n], 0, 0, 0); __builtin_amdgcn_s_setprio(0); } while (0)
#define PG8_WAIT_V(n) asm volatile("s_waitcnt vmcnt(" #n ")" ::: "memory")
#define PG8_WAIT_L(n) asm volatile("s_waitcnt lgkmcnt(" #n ")" ::: "memory")
#define PG8_BAR __builtin_amdgcn_s_barrier()
#define PG8_SCHED __builtin_amdgcn_sched_barrier(0)
    Unit cur, nxt; int ui = 0;
    if (!S.next(0, cur)) return;
    f32x4 acc[2][2][4][2];
#pragma unroll
    for (int a = 0; a < 2; ++a)
#pragma unroll
        for (int b = 0; b < 2; ++b)
#pragma unroll
            for (int m = 0; m < 4; ++m)
#pragma unroll
                for (int n = 0; n < 2; ++n) acc[a][b][m][n] = (f32x4){0.f, 0.f, 0.f, 0.f};
    bf16x8 At[4][2], B0[2][2], B1[2][2];
    const char* cA = cur.a; const char* cB = cur.b0; const char* cB1 = cur.b1;
    PG8_STAGE(PG8_SB(0, 0), cB, voffB); PG8_STAGE(PG8_SB(0, 1), cB + hstepB, voffB); PG8_STAGE(PG8_SA(0, 0), cA, voffA); PG8_STAGE(PG8_SA(0, 1), cA + hstepA, voffA);
    if (wr == 1) PG8_BAR;
    PG8_WAIT_V(2); PG8_BAR;
    PG8_STAGE(PG8_SB(1, 0), cB + kstep, voffB); PG8_STAGE(PG8_SA(1, 0), cA + kstep, voffA); PG8_STAGE(PG8_SB(1, 1), cB + hstepB + kstep, voffB);
    PG8_WAIT_V(6); PG8_BAR;
    for (;;) {
        const bool has_next = S.next(ui + 1, nxt);
        const char* nA = has_next ? nxt.a : cA; const char* nB = has_next ? nxt.b0 : cB;
        for (int t = 0; t < nt; t += 2) {
            const bool last = (t == nt - 2);
            const char* a1 = cA + (size_t)(t + 1) * kstep;
            const char* a2 = last ? nA : cA + (size_t)(t + 2) * kstep;
            const char* b2 = last ? nB : ((t + 2) < ks ? cB + (size_t)(t + 2) * kstep : cB1 + (size_t)(t + 2 - ks) * kstep);
            const char* a3 = a2 + kstep; const char* b3 = b2 + kstep;
            PG8_LDB(B0, 0, 0); PG8_LDB(B1, 0, 1); PG8_SCHED; PG8_LDA(At, 0, 0); PG8_STAGE(PG8_SA(1, 1), a1 + hstepA, voffA);
            PG8_WAIT_V(8); PG8_WAIT_L(0); PG8_BAR; PG8_MMA(0, 0, At, B0); PG8_MMA(0, 1, At, B1); PG8_BAR; PG8_SCHED;
            PG8_LDA(At, 0, 1); PG8_STAGE(PG8_SB(0, 0), b2, voffB); PG8_STAGE(PG8_SB(0, 1), b2 + hstepB, voffB); PG8_STAGE(PG8_SA(0, 0), a2, voffA);
            PG8_WAIT_V(8); PG8_WAIT_L(0); PG8_BAR; PG8_MMA(1, 0, At, B0); PG8_MMA(1, 1, At, B1); PG8_BAR; PG8_SCHED;
            PG8_LDB(B0, 1, 0); PG8_LDB(B1, 1, 1); PG8_SCHED; PG8_LDA(At, 1, 0); PG8_STAGE(PG8_SA(0, 1), a2 + hstepA, voffA);
            PG8_WAIT_V(8); PG8_WAIT_L(0); PG8_BAR; PG8_MMA(0, 0, At, B0); PG8_MMA(0, 1, At, B1); PG8_BAR; PG8_SCHED;
            PG8_LDA(At, 1, 1); PG8_STAGE(PG8_SB(1, 0), b3, voffB); PG8_STAGE(PG8_SB(1, 1), b3 + hstepB, voffB); PG8_STAGE(PG8_SA(1, 0), a3, voffA);
            PG8_WAIT_V(8); PG8_WAIT_L(0); PG8_BAR; PG8_MMA(1, 0, At, B0); PG8_MMA(1, 1, At, B1); PG8_BAR; PG8_SCHED;
        }
        if (wr == 0) PG8_BAR;
        E(acc, cur, wr, wc, fr, fq);
        if (!has_next) break;
#pragma unroll
        for (int a = 0; a < 2; ++a)
#pragma unroll
            for (int b = 0; b < 2; ++b)
#pragma unroll
                for (int m = 0; m < 4; ++m)
#pragma unroll
                    for (int n = 0; n < 2; ++n) acc[a][b][m][n] = (f32x4){0.f, 0.f, 0.f, 0.f};
        cur = nxt; cA = nA; cB = nB; cB1 = nxt.b1; ++ui;
        if (wr == 1) PG8_BAR;
    }
    PG8_WAIT_V(0);
    PG8_BAR;
#undef PG8_SA
#undef PG8_SB
#undef PG8_STAGE
#undef PG8_LDA
#undef PG8_LDB
#undef PG8_MMA
#undef PG8_WAIT_V
#undef PG8_WAIT_L
#undef PG8_BAR
#undef PG8_SCHED
}

struct DenseSched {
    int nM, nN, nwg, G, c; const char* A; const char* B; size_t tA, tB;
    __device__ void init(int M, int N, int G_, int c_, const bf16_t* A_, int lda, const bf16_t* B_, int ldb) { nM = M / 256; nN = N / 256; nwg = nM * nN; G = G_; c = c_; A = (const char*)A_; B = (const char*)B_; tA = (size_t)256 * lda * 2; tB = (size_t)256 * ldb * 2; }
    __device__ bool next(int i, Unit& u) const {
        const long L = (long)i * G + c; if (L >= nwg) return false;
        int wgid = (int)L; { const int q = nwg / 8, r = nwg % 8, xcd = wgid % 8, off = wgid / 8; wgid = (xcd < r ? xcd * (q + 1) : r * (q + 1) + (xcd - r) * q) + off; }
        const int nig = 8 * nN, gid = wgid / nig, fm = gid * 8, gsz = (nM - fm) < 8 ? (nM - fm) : 8;
        u.pm = fm + ((wgid % nig) % gsz); u.pn = (wgid % nig) / gsz; u.aux = 256;
        u.a = A + (size_t)u.pm * tA; u.b0 = B + (size_t)u.pn * tB; u.b1 = u.b0; return true;
    }
};
}
using pg8::Unit;

__device__ __forceinline__ float row_rstd(const float* ssp, int row) {
    const f32x4* p = (const f32x4*)(ssp + (size_t)row * 16);
    const f32x4 a = p[0], b = p[1], c = p[2], d = p[3];
    const float s = ((a.x + a.y) + (a.z + a.w)) + ((b.x + b.y) + (b.z + b.w)) + ((c.x + c.y) + (c.z + c.w)) + ((d.x + d.y) + (d.z + d.w));
    return rsqf_(s * (1.0f / 1024.0f) + 1e-6f);
}
__device__ __forceinline__ unsigned short f2h_bits(float f) { _Float16 h = (_Float16)f; return __builtin_bit_cast(unsigned short, h); }
__device__ __forceinline__ float h2f_bits(unsigned short b) { return (float)__builtin_bit_cast(_Float16, b); }

template <int MODE> struct EpiScale {
    bf16_t* O; int ldc; const float* ssp; float scale; const float* lb;
    __device__ __forceinline__ void operator()(const f32x4 (&acc)[2][2][4][2], const Unit& u, int wr, int wc, int fr_in, int fq_in) const {
        int fr = fr_in, fq = fq_in; asm volatile("" : "+v"(fr), "+v"(fq));
#pragma unroll
        for (int ai = 0; ai < 2; ++ai)
#pragma unroll
            for (int m = 0; m < 4; ++m) {
                const int row = u.pm * 256 + ai * 128 + wr * 64 + m * 16 + fr;
                const float rs = (MODE == 2) ? scale : row_rstd(ssp, row) * scale;
#pragma unroll
                for (int bj = 0; bj < 2; ++bj)
#pragma unroll
                    for (int n = 0; n < 2; ++n) {
                        const int col = u.pn * 256 + bj * 128 + wc * 32 + n * 16 + fq * 4;
                        f32x4 v = acc[ai][bj][m][n] * rs;
                        u32x2 w;
                        if (MODE == 1) {
                            const int blk = col >> 10;
                            if (blk == 0) { v.x = siluf_(v.x); v.y = siluf_(v.y); v.z = siluf_(v.z); v.w = siluf_(v.w); }
                            if (blk == 1) {
                                const f32x4 l = *(const f32x4*)(lb + (col - 1024));
                                float o[4]; const float vv[4] = {v.x, v.y, v.z, v.w}; const float ll[4] = {l.x, l.y, l.z, l.w};
#pragma unroll
                                for (int j = 0; j < 4; ++j) o[j] = __logf(ll[j] + (1.f - ll[j]) * sigmoidf_(vv[j]));
                                w.x = (unsigned)f2h_bits(o[0]) | ((unsigned)f2h_bits(o[1]) << 16); w.y = (unsigned)f2h_bits(o[2]) | ((unsigned)f2h_bits(o[3]) << 16);
                            } else { w.x = pk2(v.x, v.y); w.y = pk2(v.z, v.w); }
                        } else { w.x = pk2(v.x, v.y); w.y = pk2(v.z, v.w); }
                        *(u32x2*)(O + (size_t)row * ldc + col) = w;
                    }
            }
    }
};
struct EpiKV {
    bf16_t* Kb; bf16_t* VT;
    __device__ __forceinline__ void operator()(const f32x4 (&acc)[2][2][4][2], const Unit& u, int wr, int wc, int fr_in, int fq_in) const {
        int fr = fr_in, fq = fq_in; asm volatile("" : "+v"(fr), "+v"(fq));
#pragma unroll
        for (int ai = 0; ai < 2; ++ai)
#pragma unroll
            for (int m = 0; m < 4; ++m) {
                const int row = u.pm * 256 + ai * 128 + wr * 64 + m * 16 + fr;
#pragma unroll
                for (int bj = 0; bj < 2; ++bj)
#pragma unroll
                    for (int n = 0; n < 2; ++n) {
                        const int col = u.pn * 256 + bj * 128 + wc * 32 + n * 16 + fq * 4;
                        const f32x4 v = acc[ai][bj][m][n];
                        if (col < 1024) { u32x2 w; w.x = pk2(v.x, v.y); w.y = pk2(v.z, v.w); *(u32x2*)(Kb + (size_t)row * 1024 + col) = w; }
                        else {
                            const int c2 = col - 1024, h = c2 >> 8, d = c2 & 255, b = row >> 8, mm = row & 255;
                            bf16_t* p = VT + ((size_t)((b * 4 + h) * 256 + d)) * 256 + mm;
                            p[0] = (bf16_t)f2bf(v.x); p[256] = (bf16_t)f2bf(v.y); p[512] = (bf16_t)f2bf(v.z); p[768] = (bf16_t)f2bf(v.w);
                        }
                    }
            }
    }
};
template <bool SCATTER> struct EpiResid {
    const float* base; float* XF; bf16_t* XB; float* ssp; const f32x4* rowinfo;
    __device__ __forceinline__ void operator()(const f32x4 (&acc)[2][2][4][2], const Unit& u, int wr, int wc, int fr_in, int fq_in) const {
        int fr = fr_in, fq = fq_in; asm volatile("" : "+v"(fr), "+v"(fq));
#pragma unroll
        for (int ai = 0; ai < 2; ++ai)
#pragma unroll
            for (int m = 0; m < 4; ++m) {
                const int lrow = ai * 128 + wr * 64 + m * 16 + fr;
                const int row = u.pm * 256 + lrow;
                int tok = row; bool valid = true;
                if (SCATTER) { valid = lrow < u.aux; const f32x4 ri = rowinfo[row]; tok = valid ? __float_as_int(ri.w) : 0; }
                float ss = 0.f;
#pragma unroll
                for (int bj = 0; bj < 2; ++bj)
#pragma unroll
                    for (int n = 0; n < 2; ++n) {
                        const int col = u.pn * 256 + bj * 128 + wc * 32 + n * 16 + fq * 4;
                        const size_t off = (size_t)tok * 1024 + col;
                        const f32x4 b = *(const f32x4*)(base + off);
                        const f32x4 v = b + acc[ai][bj][m][n];
                        if (valid) { *(f32x4*)(XF + off) = v; u32x2 w; w.x = pk2(v.x, v.y); w.y = pk2(v.z, v.w); *(u32x2*)(XB + off) = w; }
                        ss += (v.x * v.x + v.y * v.y) + (v.z * v.z + v.w * v.w);
                    }
                ss += __shfl_xor(ss, 16); ss += __shfl_xor(ss, 32);
                if (valid && fq == 0) ssp[(size_t)tok * 16 + u.pn * 4 + wc] = ss;
            }
    }
};
struct EpiMoeUp {
    bf16_t* HID; const f32x4* rowinfo;
    __device__ __forceinline__ void operator()(const f32x4 (&acc)[2][2][4][2], const Unit& u, int wr, int wc, int fr_in, int fq_in) const {
        int fr = fr_in, fq = fq_in; asm volatile("" : "+v"(fr), "+v"(fq));
        const int slot = u.pn >> 1, jj = u.pn & 1;
#pragma unroll
        for (int ai = 0; ai < 2; ++ai)
#pragma unroll
            for (int m = 0; m < 4; ++m) {
                const int row = u.pm * 256 + ai * 128 + wr * 64 + m * 16 + fr;
                const f32x4 ri = rowinfo[row];
                const float rs = ri.x, gt = slot ? ri.z : ri.y;
#pragma unroll
                for (int n = 0; n < 2; ++n) {
                    const f32x4 h1 = acc[ai][0][m][n] * rs, h3 = acc[ai][1][m][n] * rs;
                    const int col = slot * 256 + jj * 128 + wc * 32 + n * 16 + fq * 4;
                    u32x2 w; w.x = pk2(siluf_(h1.x) * h3.x * gt, siluf_(h1.y) * h3.y * gt); w.y = pk2(siluf_(h1.z) * h3.z * gt, siluf_(h1.w) * h3.w * gt);
                    *(u32x2*)(HID + (size_t)row * 512 + col) = w;
                }
            }
    }
};
__device__ __forceinline__ void pair_experts(int bucket, int& ea, int& eb) {
    const int g = bucket / 6, p = bucket % 6;
    const int i = (p < 3) ? 0 : (p < 5 ? 1 : 2);
    const int j = (p < 3) ? p + 1 : (p < 5 ? p - 1 : 3);
    ea = g * 4 + i; eb = g * 4 + j;
}
template <bool DOWN> struct MoeSched {
    const LAS int* tbl; int ntiles, G, c; const char* A; const char* W;
    __device__ bool next(int i, Unit& u) const {
        const int L = i * G + c, mt = L >> 2, pn = L & 3;
        if (mt >= ntiles) return false;
        const int ent = __builtin_amdgcn_readfirstlane(tbl[mt]), bucket = ent & 255; u.aux = ent >> 8;
        int ea, eb; pair_experts(bucket, ea, eb);
        u.pm = mt; u.pn = pn;
        if (!DOWN) { u.a = A + (size_t)mt * 256 * 1024 * 2; const int e = (pn < 2) ? ea : eb; u.b0 = W + ((size_t)e * 512 + 256 * (pn & 1)) * 1024 * 2; u.b1 = u.b0; }
        else { u.a = A + (size_t)mt * 256 * 512 * 2; u.b0 = W + ((size_t)ea * 1024 + 256 * pn) * 256 * 2; u.b1 = W + ((size_t)eb * 1024 + 256 * pn) * 256 * 2; }
        return true;
    }
};
__device__ __forceinline__ void moe_build_table(LAS int* tbl, const unsigned* cnt, int tid) {
    if (tid == 0) { int mt = 0;
        for (int b = 0; b < 24; ++b) { const int nb = (int)cnt[b]; for (int r = 0; r < nb; r += 256) { const int v = (nb - r) < 256 ? (nb - r) : 256; if (mt < 95) tbl[mt] = b | (v << 8); ++mt; } }
        tbl[95] = mt < 95 ? mt : 95; }
    __syncthreads();
}

#define XB_TMO      128
#define XB_XCNT(j)  (256  + 64 * (j))
#define XB_XSUB(j)  (1280 + 64 * (j))
#define XB_XGEN(j)  (2304 + 64 * (j))
#define XB_TOP      3328
#define XB_TOPGEN   3392
#define XCD_BAR_WORDS 3456
#define XB_SPIN_CAP (1u << 22)
__device__ __forceinline__ unsigned xb_ld(unsigned* p)              { return __hip_atomic_load(p, __ATOMIC_RELAXED, __HIP_MEMORY_SCOPE_AGENT); }
__device__ __forceinline__ unsigned xb_add(unsigned* p, unsigned v) { return __hip_atomic_fetch_add(p, v, __ATOMIC_RELAXED, __HIP_MEMORY_SCOPE_AGENT); }
__device__ __forceinline__ unsigned xb_xcc_id() { return (unsigned)__builtin_amdgcn_s_getreg((3 << 11) | 20) & 0xFu; }
#define XB_SPIN(cond, bar) do { unsigned _sp = 0; while (cond) { __builtin_amdgcn_s_sleep(1); \
    if ((++_sp & 255u) == 0u) { if (xb_ld(&(bar)[XB_TMO])) break; if (_sp > XB_SPIN_CAP) { atomicAdd(&(bar)[XB_TMO], 1u); break; } } } } while (0)
struct XcdBarrier { unsigned* bar; unsigned x; volatile LAS unsigned* st; int wave; };
__device__ __forceinline__ XcdBarrier xcd_barrier_post(unsigned* bar, volatile LAS unsigned* st, int wave) {
    XcdBarrier b; b.bar = bar; b.x = xb_xcc_id(); b.st = st; b.wave = wave;
    if (wave == 0 && lane_id_v() == 0) (void)xb_add(&bar[XB_XCNT(b.x)], 1u);
    return b;
}
__device__ __forceinline__ void xcd_barrier_complete(unsigned* bar, unsigned x, unsigned& nloc, unsigned& nx) {
    const unsigned G = gridDim.x * gridDim.y * gridDim.z;
    unsigned sum, cnt, mine, sp = 0u;
    for (;;) {
        sum = 0u; cnt = 0u; mine = 0u;
#pragma unroll
        for (unsigned j = 0; j < 16; ++j) { const unsigned c = xb_ld(&bar[XB_XCNT(j)]); sum += c; cnt += (c > 0u) ? 1u : 0u; mine = (j == x) ? c : mine; }
        if (sum == G) break;
        __builtin_amdgcn_s_sleep(1);
        if ((++sp & 255u) == 0u) { if (xb_ld(&bar[XB_TMO])) break; if (sp > XB_SPIN_CAP) { atomicAdd(&bar[XB_TMO], 1u); break; } }
    }
    nloc = mine > 0u ? mine : 1u; nx = cnt > 0u ? cnt : 1u;
}
__device__ __forceinline__ void xcd_barrier(const XcdBarrier& b) {
    asm volatile("s_waitcnt vmcnt(0)" ::: "memory");
    __syncthreads();
    if (b.wave == 0 && lane_id_v() == 0) {
        unsigned* bar = b.bar;
        __builtin_amdgcn_s_waitcnt(0);
        unsigned nloc = b.st[0], nx = b.st[1];
        if (nloc == 0u) { xcd_barrier_complete(bar, b.x, nloc, nx); b.st[0] = nloc; b.st[1] = nx; }
        const unsigned old = xb_add(&bar[XB_XSUB(b.x)], 1u);
        const unsigned gen = old / nloc;
        if (old + 1u == (gen + 1u) * nloc) {
            __builtin_amdgcn_fence(__ATOMIC_RELEASE, "agent");
            asm volatile("s_waitcnt vmcnt(0)" ::: "memory");
            const unsigned og = xb_add(&bar[XB_TOP], 1u);
            const unsigned tg = og / nx;
            if (og + 1u == (tg + 1u) * nx) xb_add(&bar[XB_TOPGEN], 1u);
            else XB_SPIN(xb_ld(&bar[XB_TOPGEN]) == tg, bar);
            __builtin_amdgcn_fence(__ATOMIC_ACQUIRE, "agent");
            xb_add(&bar[XB_XGEN(b.x)], 1u);
            asm volatile("s_waitcnt vmcnt(0)" ::: "memory");
        } else {
            XB_SPIN(xb_ld(&bar[XB_XGEN(b.x)]) == gen, bar);
            __builtin_amdgcn_fence(__ATOMIC_ACQUIRE, "agent");
            asm volatile("s_waitcnt vmcnt(0)" ::: "memory");
        }
    }
    __syncthreads();
}

struct Args { const float* in[38]; float* out; unsigned char* ws; int ph_lo, ph_hi; };
constexpr int LDS_BYTES = 161792;
constexpr int LDS_MISC = 156 * 1024;
struct InTab {
    const LAS unsigned long long* t;
    __device__ __forceinline__ const float* operator[](int i) const {
        const unsigned long long v = t[i];
        const unsigned lo = __builtin_amdgcn_readfirstlane((unsigned)v), hi = __builtin_amdgcn_readfirstlane((unsigned)(v >> 32));
        return (const float*)(((unsigned long long)hi << 32) | lo); }
};
struct Frame {
    LAS unsigned char* lds; int wave, G, wg;
    InTab in; float* out; unsigned char* ws;
};
#define IN_X 0
#define IN_MEM 1
#define IN_NORM_MIX 2
#define IN_NORM_XA 3
#define IN_NORM_MEM 4
#define IN_NORM_FFN 5
#define IN_NORM_FINAL 6
#define IN_AB_WIN 7
#define IN_AB_CONV 8
#define IN_AB_ALOG 9
#define IN_AB_DTB 10
#define IN_AB_ONORM 11
#define IN_AB_MU 12
#define IN_AB_W0 13
#define IN_AB_W2 14
#define IN_AB_A0 15
#define IN_AB_A2 16
#define IN_AB_G2 17
#define IN_AB_KK 18
#define IN_AB_KA 19
#define IN_AB_RK 20
#define IN_AB_LNW 21
#define IN_AB_LNB 22
#define IN_AB_WOUT 23
#define IN_C_WIN 24
#define IN_C_LB 25
#define IN_C_ONORM 26
#define IN_C_WOUT 27
#define IN_XA_WQ 28
#define IN_XA_WKV 29
#define IN_XA_WO 30
#define IN_MOE_WG 31
#define IN_MOE_BG 32
#define IN_MOE_WE 33
#define IN_MOE_BE 34
#define IN_MOE_W1 35
#define IN_MOE_W3 36
#define IN_MOE_W2 37

__device__ __forceinline__ void p0_transpose_item(const float* W, int ld, int col0, int ncols, int K, const float* gain, bf16_t* WT, int drow0, LAS float* scr, int item, int lane) {
    const int nblk = ncols / 32, kb = item / nblk, nb = item % nblk, k0 = 64 * kb, n0 = 32 * nb;
    float vv[32];
#pragma unroll
    for (int i = 0; i < 32; ++i) vv[i] = W[(size_t)(k0 + 2 * i + (lane >> 5)) * ld + col0 + n0 + (lane & 31)];
#pragma unroll
    for (int i = 0; i < 32; ++i) { const int kk = 2 * i + (lane >> 5); float v = vv[i]; if (gain) v *= gain[k0 + kk]; scr[kk * 33 + (lane & 31)] = v; }
    LDS_WAIT(); asm volatile("" ::: "memory");
    const int c = lane & 7;
#pragma unroll
    for (int j = 0; j < 4; ++j) { const int n = (lane >> 3) + 8 * j; const LAS float* s = scr + (8 * c) * 33 + n;
        u32x4 o; o.x = pk2(s[0 * 33], s[1 * 33]); o.y = pk2(s[2 * 33], s[3 * 33]); o.z = pk2(s[4 * 33], s[5 * 33]); o.w = pk2(s[6 * 33], s[7 * 33]);
        *(u32x4*)(WT + (size_t)(drow0 + n0 + n) * K + k0 + 8 * c) = o; }
    LDS_WAIT(); asm volatile("" ::: "memory");
}
__device__ __forceinline__ void p0_weight_item(const Frame& F, int it, LAS float* scr, int lane) {
    const InTab in = F.in;
    bf16_t* W0 = (bf16_t*)(F.ws + WS_W0); bf16_t* W1 = (bf16_t*)(F.ws + WS_W1);
    if (it < 16384) {
        const int l = it >> 13; int r = it & 8191; bf16_t* W = l ? W1 : W0;
        if (r < 512) { p0_transpose_item(in[IN_XA_WQ] + (size_t)l * 1024 * 1024, 1024, 0, 1024, 1024, in[IN_NORM_XA] + l * 1024, W + WO_WQ, 0, scr, r, lane); return; }
        r -= 512;
        if (r < 1024) { p0_transpose_item(in[IN_XA_WKV] + (size_t)l * 1024 * 2048, 2048, 0, 2048, 1024, in[IN_NORM_MEM] + l * 1024, W + WO_WKV, 0, scr, r, lane); return; }
        r -= 1024;
        if (r < 512) { p0_transpose_item(in[IN_XA_WO] + (size_t)l * 1024 * 1024, 1024, 0, 1024, 1024, nullptr, W + WO_WO, 0, scr, r, lane); return; }
        r -= 512;
        if (r < 4096) { const int sub = r >> 6, item = r & 63, e = sub >> 2, j = (sub >> 1) & 1, which = sub & 1;
            const float* src = (which ? in[IN_MOE_W3] : in[IN_MOE_W1]) + (size_t)(l * 16 + e) * 1024 * 256;
            p0_transpose_item(src, 256, 128 * j, 128, 1024, in[IN_NORM_FFN] + l * 1024, W + WO_W13, e * 512 + 256 * j + 128 * which, scr, item, lane); return; }
        r -= 4096;
        { const int e = r >> 7, item = r & 127;
            p0_transpose_item(in[IN_MOE_W2] + (size_t)(l * 16 + e) * 256 * 1024, 1024, 0, 1024, 256, nullptr, W + WO_W2T + (size_t)e * 1024 * 256, 0, scr, item, lane); return; }
    }
    int r = it - 16384;
    if (r < 1024) { p0_transpose_item(in[IN_AB_WIN], 3848, 0, 2048, 1024, in[IN_NORM_MIX], W0 + WO_WIN, 0, scr, r, lane); return; }
    r -= 1024;
    if (r < 896) { p0_transpose_item(in[IN_AB_WIN], 3848, 2056, 1792, 1024, in[IN_NORM_MIX], W0 + WO_WIN, 2048, scr, r, lane); return; }
    r -= 896;
    if (r < 512) { p0_transpose_item(in[IN_AB_WOUT], 1024, 0, 1024, 1024, nullptr, W0 + WO_WOUT, 0, scr, r, lane); return; }
    r -= 512;
    if (r < 2048) { p0_transpose_item(in[IN_C_WIN], 4096, 0, 4096, 1024, in[IN_NORM_MIX] + 1024, W1 + WO_WIN, 0, scr, r, lane); return; }
    r -= 2048;
    if (r < 512) { p0_transpose_item(in[IN_C_WOUT], 1024, 0, 1024, 1024, nullptr, W1 + WO_WOUT, 0, scr, r, lane); return; }
    r -= 512;
    bf16_t* LW = (bf16_t*)(F.ws + WS_LORA);
    if (r < 16) { p0_transpose_item(in[IN_AB_W2], 512, 0, 512, 64, nullptr, LW, 0, scr, r, lane); return; }
    r -= 16;
    if (r < 16) { p0_transpose_item(in[IN_AB_A2], 512, 0, 512, 64, nullptr, LW + 512 * 64, 0, scr, r, lane); return; }
    r -= 16;
    p0_transpose_item(in[IN_AB_G2], 512, 0, 512, 128, nullptr, LW + 2 * 512 * 64, 0, scr, r, lane);
}
constexpr int P0_NITEMS = 16384 + 1024 + 896 + 512 + 2048 + 512 + 64;

__device__ __forceinline__ void p0_late_weights(const Frame& F, int worker, int nworkers) {
    const int lane = lane_id_v();
    LAS float* scr = (LAS float*)(F.lds + F.wave * 16384);
    const int gw = worker * NWAVES + F.wave, NGW = nworkers * NWAVES;
    for (int it = gw; it < P0_NITEMS - 64 - 1920; it += NGW) p0_weight_item(F, it < 16384 ? it : it + 1920, scr, lane);
}
__device__ __forceinline__ void p0_prologue(const Frame& F) {
    const int lane = lane_id_v(); const int tid = F.wave * 64 + lane; (void)tid;
    LAS float* scr = (LAS float*)(F.lds + F.wave * 16384);
    const int gw = F.wg * NWAVES + F.wave, NGW = F.G * NWAVES;
    for (int it = gw; it < 1920 + 64; it += NGW) p0_weight_item(F, it < 1920 ? 16384 + it : P0_NITEMS - 64 + (it - 1920), scr, lane);
    const float* x = F.in[IN_X]; const float* gain = F.in[IN_NORM_MIX]; const float* win = F.in[IN_AB_WIN];
    bf16_t* XB = (bf16_t*)(F.ws + WS_XB); float* ssp = (float*)(F.ws + WS_SSP); float* db = (float*)(F.ws + WS_DB);
    for (int row = gw; row < NT; row += NGW) {
        const f32x4* xr = (const f32x4*)(x + (size_t)row * 1024) + lane;
        f32x4 v[4]; float s = 0.f; float d[8];
#pragma unroll
        for (int c = 0; c < 8; ++c) d[c] = 0.f;
#pragma unroll
        for (int j = 0; j < 4; ++j) {
            v[j] = xr[64 * j]; s += (v[j].x * v[j].x + v[j].y * v[j].y) + (v[j].z * v[j].z + v[j].w * v[j].w);
            const int k0 = 4 * lane + 256 * j;
            const f32x4 g = *(const f32x4*)(gain + k0);
            const float xv[4] = {v[j].x * g.x, v[j].y * g.y, v[j].z * g.z, v[j].w * g.w};
#pragma unroll
            for (int q = 0; q < 4; ++q) {
                const f32x4 w0 = *(const f32x4*)(win + (size_t)(k0 + q) * 3848 + 2048), w1 = *(const f32x4*)(win + (size_t)(k0 + q) * 3848 + 2052);
                d[0] += xv[q] * w0.x; d[1] += xv[q] * w0.y; d[2] += xv[q] * w0.z; d[3] += xv[q] * w0.w;
                d[4] += xv[q] * w1.x; d[5] += xv[q] * w1.y; d[6] += xv[q] * w1.z; d[7] += xv[q] * w1.w;
            }
        }
        s = wave_sum(s);
        const float rstd = rsqf_(s * (1.0f / 1024.0f) + 1e-6f);
#pragma unroll
        for (int c = 0; c < 8; ++c) d[c] = wave_sum(d[c]) * rstd;
        unsigned long long* o8 = (unsigned long long*)(XB + (size_t)row * 1024) + lane;
#pragma unroll
        for (int j = 0; j < 4; ++j) o8[64 * j] = (unsigned long long)pk2(v[j].x, v[j].y) | ((unsigned long long)pk2(v[j].z, v[j].w) << 32);
        if (lane < 16) ssp[(size_t)row * 16 + lane] = (lane == 0) ? s : 0.f;
        if (lane < 8) { float dv = d[0];
#pragma unroll
            for (int c = 1; c < 8; ++c) dv = (lane == c) ? d[c] : dv;
            db[(size_t)row * 8 + lane] = dv; }
    }
    const float* mem = F.in[IN_MEM]; bf16_t* MH = (bf16_t*)(F.ws + WS_MEMH);
    for (int row = gw; row < NB * NMEM; row += NGW) {
        const f32x4* xr = (const f32x4*)(mem + (size_t)row * 1024) + lane;
        f32x4 v[4]; float s = 0.f;
#pragma unroll
        for (int j = 0; j < 4; ++j) { v[j] = xr[64 * j]; s += (v[j].x * v[j].x + v[j].y * v[j].y) + (v[j].z * v[j].z + v[j].w * v[j].w); }
        s = wave_sum(s);
        const float rstd = rsqf_(s * (1.0f / 1024.0f) + 1e-6f);
        unsigned long long* o8 = (unsigned long long*)(MH + (size_t)row * 1024) + lane;
#pragma unroll
        for (int j = 0; j < 4; ++j) o8[64 * j] = (unsigned long long)pk2(v[j].x * rstd, v[j].y * rstd) | ((unsigned long long)pk2(v[j].z * rstd, v[j].w * rstd) << 32);
    }
    {
        float* rw = (float*)(F.ws + WS_RW);
        for (int idx = F.wg * NTHREADS + tid; idx < 2 * 1024 * 32; idx += F.G * NTHREADS) {
            const int l = idx >> 15, k = (idx >> 5) & 1023, cc = idx & 31;
            const float g = F.in[IN_NORM_FFN][l * 1024 + k];
            float v = 0.f;
            if (cc < 4) v = F.in[IN_MOE_WG][(size_t)l * 4096 + k * 4 + cc] * g; else if (cc < 20) v = F.in[IN_MOE_WE][(size_t)l * 16384 + k * 16 + (cc - 4)] * g;
            rw[idx] = v;
        }
    }
    if (F.wg == 0) { const float* lbp = F.in[IN_C_LB]; float* lb = (float*)(F.ws + WS_LB);
        for (int c = tid; c < 1024; c += NTHREADS) { const float a = lbp[c], b = lbp[1024 + c]; const float mx = fmaxf(a, b), ea = __expf(a - mx), eb = __expf(b - mx); lb[c] = (ea + eb) / (ea + eb) - ea / (ea + eb); } }
}

__device__ __forceinline__ void scan_delta(const Frame& F, int b, int h) {
    const int lane = lane_id_v(); const int tid = F.wave * 64 + lane; (void)tid;
    LAS float* qs = (LAS float*)F.lds;
    LAS float* ks = qs + 64 * 128;
    LAS float* vs = ks + 64 * 128;
    LAS float* os = vs + 64 * 128;
    LAS float* al = os + 64 * 128;
    LAS float* be = al + 64;
    bf16_t* P = (bf16_t*)(F.ws + WS_BIG + BIG_PROJ);
    const float* convw = F.in[IN_AB_CONV];
    const float* db = (const float*)(F.ws + WS_DB);
    const float a_neg = -__expf(F.in[IN_AB_ALOG][h]), dtb = F.in[IN_AB_DTB][h];
    const float* onorm = F.in[IN_AB_ONORM];
    const int i_dv = tid >> 2, part = tid & 3;
    float s[32];
#pragma unroll
    for (int j = 0; j < 32; ++j) s[j] = 0.f;
    for (int c = 0; c < 32; ++c) {
        const int t0 = b * TS + c * 64;
        for (int idx = tid; idx < 64 * 384; idx += NTHREADS) {
            const int t = idx / 384, cc = idx % 384, sct = cc >> 7, col = cc & 127;
            const int gcol = sct * 512 + h * 128 + col;
            float a = 0.f;
#pragma unroll
            for (int j = 0; j < 4; ++j) { const int tl = c * 64 + t - 3 + j; if (tl >= 0) a += convw[j * 1536 + gcol] * bf2f(P[(size_t)(b * TS + tl) * P0LD + gcol]); }
            a = siluf_(a);
            (sct == 0 ? qs : (sct == 1 ? ks : vs))[t * 128 + col] = a;
        }
        if (tid < 64) { const int t = tid; const float la = a_neg * softplusf_(db[(size_t)(t0 + t) * 8 + h] + dtb); al[t] = __expf(la); be[t] = sigmoidf_(db[(size_t)(t0 + t) * 8 + 4 + h]); }
        __syncthreads();
        for (int r = F.wave; r < 128; r += NWAVES) { LAS float* p = (r < 64 ? qs + r * 128 : ks + (r - 64) * 128);
            const float v0 = p[lane], v1 = p[lane + 64]; const float ss = wave_sum(v0 * v0 + v1 * v1);
            const float sc = (rsqf_(ss + 1e-6f)) * (r < 64 ? 0.08838834764831845f : 1.0f); p[lane] = v0 * sc; p[lane + 64] = v1 * sc; }
        __syncthreads();
        for (int t = 0; t < 64; ++t) {
            const LAS f32x4* kp = (const LAS f32x4*)(ks + t * 128 + part * 32); const LAS f32x4* qp = (const LAS f32x4*)(qs + t * 128 + part * 32);
            float kt[32], qt[32];
#pragma unroll
            for (int j = 0; j < 8; ++j) { const f32x4 a = kp[j], q = qp[j]; kt[4 * j] = a.x; kt[4 * j + 1] = a.y; kt[4 * j + 2] = a.z; kt[4 * j + 3] = a.w; qt[4 * j] = q.x; qt[4 * j + 1] = q.y; qt[4 * j + 2] = q.z; qt[4 * j + 3] = q.w; }
            float p = 0.f;
#pragma unroll
            for (int j = 0; j < 32; ++j) p += s[j] * kt[j];
            p += __shfl_xor(p, 1); p += __shfl_xor(p, 2);
            const float alpha = al[t], coef = be[t] * (vs[t * 128 + i_dv] - alpha * p);
            float o = 0.f;
#pragma unroll
            for (int j = 0; j < 32; ++j) { s[j] = alpha * s[j] + coef * kt[j]; o += s[j] * qt[j]; }
            o += __shfl_xor(o, 1); o += __shfl_xor(o, 2);
            if (part == 0) os[t * 128 + i_dv] = o;
        }
        __syncthreads();
        for (int t = F.wave; t < 64; t += NWAVES) {
            const float o0 = os[t * 128 + lane], o1 = os[t * 128 + lane + 64];
            const float ss = wave_sum(o0 * o0 + o1 * o1), rs = rsqf_(ss * (1.0f / 128.0f) + 1e-6f);
            bf16_t* gp = P + (size_t)(t0 + t) * P0LD + 1536 + h * 128;
            const float g0 = bf2f(gp[lane]), g1 = bf2f(gp[lane + 64]);
            gp[lane] = (bf16_t)f2bf(o0 * rs * onorm[lane] * siluf_(g0)); gp[lane + 64] = (bf16_t)f2bf(o1 * rs * onorm[lane + 64] * siluf_(g1));
        }
        __syncthreads();
    }
}
__device__ __forceinline__ void scan_rwkv(const Frame& F, int b, int h) {
    const int lane = lane_id_v(); const int tid = F.wave * 64 + lane; (void)tid;
    LAS float* bufA = (LAS float*)F.lds;
    LAS float* bufB = bufA + 4096;
    LAS float* bufC = bufB + 4096;
    LAS float* R = bufC + 8192;
    LAS float* Kb = R + 4096;
    LAS float* V = Kb + 4096;
    LAS float* KK = V + 4096;
    LAS float* halo = KK + 4096;
    LAS float* bonus = halo + 896;
    bf16_t* P = (bf16_t*)(F.ws + WS_BIG + BIG_PROJ);
    const float* mu = F.in[IN_AB_MU];
    const float* w0 = F.in[IN_AB_W0] + h * 64; const float* w2 = F.in[IN_AB_W2] + h * 64;
    const float* a0 = F.in[IN_AB_A0] + h * 64; const float* a2 = F.in[IN_AB_A2] + h * 64;
    const float* g2 = F.in[IN_AB_G2] + h * 64;
    const float* k_k = F.in[IN_AB_KK] + h * 64; const float* k_a = F.in[IN_AB_KA] + h * 64; const float* r_k = F.in[IN_AB_RK] + h * 64;
    const float* ln_w = F.in[IN_AB_LNW] + h * 64; const float* ln_b = F.in[IN_AB_LNB] + h * 64;
    const int vi = tid >> 3, part = tid & 7;
    float s[8];
#pragma unroll
    for (int j = 0; j < 8; ++j) s[j] = 0.f;
    for (int i = tid; i < 896; i += NTHREADS) halo[i] = 0.f;
    __syncthreads();
    for (int c = 0; c < 32; ++c) {
        const int t0 = b * TS + c * 64;
        const LAS float* hcur = halo + (c & 1) * 448; LAS float* hnext = halo + ((c + 1) & 1) * 448;
        for (int idx = tid; idx < 64 * 448; idx += NTHREADS) {
            const int t = idx / 448, col = idx % 448;
            int gc;
            if (col < 64) gc = 2048 + h * 64 + col; else if (col < 128) gc = 2560 + h * 64 + (col - 64); else if (col < 192) gc = 3072 + h * 64 + (col - 128); else gc = 3584 + (col - 192);
            const float cur = bf2f(P[(size_t)(t0 + t) * P0LD + gc]);
            const float prev = (t > 0) ? bf2f(P[(size_t)(t0 + t - 1) * P0LD + gc]) : hcur[col];
            const float sh = cur + mu[gc - 2048] * (prev - cur);
            if (t == 63) hnext[col] = cur;
            if (col < 64) R[t * 64 + col] = sh; else if (col < 128) Kb[t * 64 + col - 64] = sh; else if (col < 192) V[t * 64 + col - 128] = sh;
            else if (col < 256) bufA[t * 64 + col - 192] = tanhf(sh); else if (col < 320) bufB[t * 64 + col - 256] = sh; else bufC[t * 128 + col - 320] = sigmoidf_(sh);
        }
        __syncthreads();
        float wv[8], av[8], gv[8];
        {
            const int j = lane, tb = F.wave * 8;
#pragma unroll
            for (int q = 0; q < 8; ++q) { wv[q] = 0.f; av[q] = 0.f; gv[q] = 0.f; }
            for (int m = 0; m < 64; ++m) { const float x2 = w2[(size_t)m * 512 + j], y2 = a2[(size_t)m * 512 + j];
#pragma unroll
                for (int q = 0; q < 8; ++q) { wv[q] += bufA[(tb + q) * 64 + m] * x2; av[q] += bufB[(tb + q) * 64 + m] * y2; } }
            for (int m = 0; m < 128; ++m) { const float z2 = g2[(size_t)m * 512 + j];
#pragma unroll
                for (int q = 0; q < 8; ++q) gv[q] += bufC[(tb + q) * 128 + m] * z2; }
#pragma unroll
            for (int q = 0; q < 8; ++q) { wv[q] = __expf(-0.6065306597126334f * sigmoidf_(w0[j] + wv[q])); av[q] = sigmoidf_(a0[j] + av[q]); }
        }
        __syncthreads();
        {
            const int j = lane, tb = F.wave * 8;
#pragma unroll
            for (int q = 0; q < 8; ++q) { bufA[(tb + q) * 64 + j] = wv[q]; bufB[(tb + q) * 64 + j] = av[q]; bufC[(tb + q) * 64 + j] = gv[q]; }
#pragma unroll
            for (int q = 0; q < 8; ++q) { const int t = tb + q; const float kv = Kb[t * 64 + j]; const float kx = kv * k_k[j]; const float ss = wave_sum(kx * kx);
                KK[t * 64 + j] = kx * (rsqf_(ss + 1e-6f)); const float km = kv * (1.f + (av[q] - 1.f) * k_a[j]); Kb[t * 64 + j] = km;
                const float bs = wave_sum(R[t * 64 + j] * km * r_k[j]); if (j == 0) bonus[t] = bs; }
        }
        __syncthreads();
        LAS float* O = bufC + 4096;
        for (int t = 0; t < 64; ++t) {
            const LAS f32x4* p4;
            float kk[8], ww[8], aa[8], km[8], rr[8];
            p4 = (const LAS f32x4*)(KK + t * 64 + part * 8);   { const f32x4 a = p4[0], c2 = p4[1]; kk[0] = a.x; kk[1] = a.y; kk[2] = a.z; kk[3] = a.w; kk[4] = c2.x; kk[5] = c2.y; kk[6] = c2.z; kk[7] = c2.w; }
            p4 = (const LAS f32x4*)(bufA + t * 64 + part * 8); { const f32x4 a = p4[0], c2 = p4[1]; ww[0] = a.x; ww[1] = a.y; ww[2] = a.z; ww[3] = a.w; ww[4] = c2.x; ww[5] = c2.y; ww[6] = c2.z; ww[7] = c2.w; }
            p4 = (const LAS f32x4*)(bufB + t * 64 + part * 8); { const f32x4 a = p4[0], c2 = p4[1]; aa[0] = a.x; aa[1] = a.y; aa[2] = a.z; aa[3] = a.w; aa[4] = c2.x; aa[5] = c2.y; aa[6] = c2.z; aa[7] = c2.w; }
            p4 = (const LAS f32x4*)(Kb + t * 64 + part * 8);   { const f32x4 a = p4[0], c2 = p4[1]; km[0] = a.x; km[1] = a.y; km[2] = a.z; km[3] = a.w; km[4] = c2.x; km[5] = c2.y; km[6] = c2.z; km[7] = c2.w; }
            p4 = (const LAS f32x4*)(R + t * 64 + part * 8);    { const f32x4 a = p4[0], c2 = p4[1]; rr[0] = a.x; rr[1] = a.y; rr[2] = a.z; rr[3] = a.w; rr[4] = c2.x; rr[5] = c2.y; rr[6] = c2.z; rr[7] = c2.w; }
            const float vv = V[t * 64 + vi];
            float sa = 0.f;
#pragma unroll
            for (int j = 0; j < 8; ++j) sa -= s[j] * kk[j];
            sa += __shfl_xor(sa, 1); sa += __shfl_xor(sa, 2); sa += __shfl_xor(sa, 4);
            float o = 0.f;
#pragma unroll
            for (int j = 0; j < 8; ++j) { s[j] = s[j] * ww[j] + sa * (kk[j] * aa[j]) + vv * km[j]; o += s[j] * rr[j]; }
            o += __shfl_xor(o, 1); o += __shfl_xor(o, 2); o += __shfl_xor(o, 4);
            if (part == 0) O[t * 64 + vi] = o;
        }
        __syncthreads();
        for (int t = F.wave; t < 64; t += NWAVES) {
            const float o = O[t * 64 + lane];
            const float mean = wave_sum(o) * (1.0f / 64.0f); const float dlt = o - mean; const float var = wave_sum(dlt * dlt) * (1.0f / 64.0f);
            float y = dlt * (rsqf_(var + 64e-5f)) * ln_w[lane] + ln_b[lane];
            y += bonus[t] * V[t * 64 + lane];
            y *= bufC[t * 64 + lane];
            P[(size_t)(t0 + t) * P0LD + 2048 + h * 64 + lane] = (bf16_t)f2bf(y);
        }
        __syncthreads();
    }
}
__device__ __forceinline__ void scan_hgrn(const Frame& F, int b, int h) {
    const int lane = lane_id_v(); const int tid = F.wave * 64 + lane; (void)tid;
    LAS float* qs = (LAS float*)F.lds;
    LAS float* fs = qs + 64 * 128;
    LAS float* kf = fs + 64 * 128;
    LAS float* is = kf + 64 * 128;
    bf16_t* P = (bf16_t*)(F.ws + WS_BIG + BIG_PROJ);
    const float* onorm = F.in[IN_C_ONORM];
    const int e = tid >> 2, part = tid & 3;
    float s[32];
#pragma unroll
    for (int j = 0; j < 32; ++j) s[j] = 0.f;
    for (int c = 0; c < 32; ++c) {
        const int t0 = b * TS + c * 64;
        for (int idx = tid; idx < 64 * 128; idx += NTHREADS) {
            const int t = idx >> 7, col = idx & 127; const bf16_t* pr = P + (size_t)(t0 + t) * P1LD + h * 128 + col;
            qs[idx] = bf2f(pr[0]); const float lf = h2f_bits(pr[1024]); fs[idx] = __expf(lf); kf[idx] = -expm1f(lf); is[idx] = bf2f(pr[2048]);
        }
        __syncthreads();
        for (int t = 0; t < 64; ++t) {
            const LAS f32x4* fp = (const LAS f32x4*)(fs + t * 128 + part * 32); const LAS f32x4* kp = (const LAS f32x4*)(kf + t * 128 + part * 32); const LAS f32x4* qp = (const LAS f32x4*)(qs + t * 128 + part * 32);
            const float iv = is[t * 128 + e];
            float o = 0.f;
#pragma unroll
            for (int j = 0; j < 8; ++j) { const f32x4 f = fp[j], k = kp[j], q = qp[j];
                s[4 * j] = f.x * s[4 * j] + k.x * iv; o += s[4 * j] * q.x;
                s[4 * j + 1] = f.y * s[4 * j + 1] + k.y * iv; o += s[4 * j + 1] * q.y;
                s[4 * j + 2] = f.z * s[4 * j + 2] + k.z * iv; o += s[4 * j + 2] * q.z;
                s[4 * j + 3] = f.w * s[4 * j + 3] + k.w * iv; o += s[4 * j + 3] * q.w; }
            o += __shfl_xor(o, 1); o += __shfl_xor(o, 2);
            if (part == 0) is[t * 128 + e] = o;
        }
        __syncthreads();
        for (int t = F.wave; t < 64; t += NWAVES) {
            const float o0 = is[t * 128 + lane], o1 = is[t * 128 + lane + 64];
            const float ss = wave_sum(o0 * o0 + o1 * o1), rs = rsqf_(ss * (1.0f / 128.0f) + 1e-6f);
            bf16_t* gp = P + (size_t)(t0 + t) * P1LD + 3072 + h * 128;
            const float g0 = bf2f(gp[lane]), g1 = bf2f(gp[lane + 64]);
            gp[lane] = (bf16_t)f2bf(o0 * rs * onorm[lane] * siluf_(g0)); gp[lane + 64] = (bf16_t)f2bf(o1 * rs * onorm[lane + 64] * siluf_(g1));
        }
        __syncthreads();
    }
}

template <int CTRL> __device__ __forceinline__ float dppf(float v) { return __int_as_float(__builtin_amdgcn_update_dpp(0, __float_as_int(v), CTRL, 0xF, 0xF, true)); }
__device__ __forceinline__ float red8(float v) { v += dppf<0xB1>(v); v += dppf<0x4E>(v); v += dppf<0x141>(v); return v; }
__device__ __forceinline__ float red16(float v) { v = red8(v); v += dppf<0x140>(v); return v; }

__device__ __forceinline__ void scan_delta2(const Frame& F, int b, int h, int qd) {
    const int lane = lane_id_v(); const int tid = F.wave * 64 + lane;
    LAS float* Kc = (LAS float*)F.lds;
    LAS float* Qc = Kc + 64 * 128;
    LAS float* Vc = Qc + 64 * 128;
    LAS float* Oc = Vc + 64 * 32;
    LAS float* al = Oc + 64 * 32;
    LAS float* be = al + 64;
    LAS float* vh = be + 64;
    bf16_t* P = (bf16_t*)(F.ws + WS_BIG + BIG_PROJ);
    const float* convw = F.in[IN_AB_CONV];
    const float* db = (const float*)(F.ws + WS_DB);
    const float a_neg = -__expf(F.in[IN_AB_ALOG][h]), dtb = F.in[IN_AB_DTB][h];
    const int w = F.wave;
    const int vcol = 1024 + h * 128 + qd * 32 + (lane & 31);
    float cwq[4][2], cwk[4][2], cwv[4];
#pragma unroll
    for (int j = 0; j < 4; ++j) { cwq[j][0] = convw[j * 1536 + h * 128 + lane]; cwq[j][1] = convw[j * 1536 + h * 128 + lane + 64];
        cwk[j][0] = convw[j * 1536 + 512 + h * 128 + lane]; cwk[j][1] = convw[j * 1536 + 512 + h * 128 + lane + 64]; cwv[j] = convw[j * 1536 + vcol]; }
    const int r = tid >> 4, part = tid & 15;
    float s[8];
#pragma unroll
    for (int j = 0; j < 8; ++j) s[j] = 0.f;
    if (tid < 192) vh[tid] = 0.f;
    __syncthreads();
    for (int c = 0; c < 32; ++c) {
        const int t0 = b * TS + c * 64;
        const LAS float* vhc = vh + (c & 1) * 96; LAS float* vhn = vh + ((c + 1) & 1) * 96;
        {
            float rq[11][2], rk[11][2], rv[11];
#pragma unroll
            for (int rr = 0; rr < 11; ++rr) {
                const int tl = c * 64 + 8 * w - 3 + rr;
                const bool ok = tl >= 0;
                const bf16_t* row = P + (size_t)(b * TS + (ok ? tl : 0)) * P0LD;
                rq[rr][0] = ok ? bf2f(row[h * 128 + lane]) : 0.f; rq[rr][1] = ok ? bf2f(row[h * 128 + lane + 64]) : 0.f;
                rk[rr][0] = ok ? bf2f(row[512 + h * 128 + lane]) : 0.f; rk[rr][1] = ok ? bf2f(row[512 + h * 128 + lane + 64]) : 0.f;
                const bool prevchunk = (8 * w - 3 + rr) < 0;
                rv[rr] = prevchunk ? vhc[(rr < 3 ? rr : 0) * 32 + (lane & 31)] : bf2f(row[vcol]);
            }
            if (w == 7 && lane < 32) { vhn[lane] = rv[8]; vhn[32 + lane] = rv[9]; vhn[64 + lane] = rv[10]; }
#pragma unroll
            for (int i = 0; i < 8; ++i) {
                const int t = 8 * w + i;
                float q0 = 0.f, q1 = 0.f, k0 = 0.f, k1 = 0.f, vv = 0.f;
#pragma unroll
                for (int j = 0; j < 4; ++j) { q0 += cwq[j][0] * rq[i + j][0]; q1 += cwq[j][1] * rq[i + j][1]; k0 += cwk[j][0] * rk[i + j][0]; k1 += cwk[j][1] * rk[i + j][1]; vv += cwv[j] * rv[i + j]; }
                q0 = siluf_(q0); q1 = siluf_(q1); k0 = siluf_(k0); k1 = siluf_(k1); vv = siluf_(vv);
                const float sq = wave_sum(q0 * q0 + q1 * q1), sk = wave_sum(k0 * k0 + k1 * k1);
                const float cq = (rsqf_(sq + 1e-6f)) * 0.08838834764831845f, ck = rsqf_(sk + 1e-6f);
                Qc[t * 128 + lane] = q0 * cq; Qc[t * 128 + lane + 64] = q1 * cq; Kc[t * 128 + lane] = k0 * ck; Kc[t * 128 + lane + 64] = k1 * ck;
                if (lane < 32) Vc[t * 32 + lane] = vv;
            }
            if (lane < 8) { const int t = 8 * w + lane; const float la = a_neg * softplusf_(db[(size_t)(t0 + t) * 8 + h] + dtb); al[t] = __expf(la); be[t] = sigmoidf_(db[(size_t)(t0 + t) * 8 + 4 + h]); }
        }
        __syncthreads();
        {
            const LAS float* kp = Kc + part * 8; const LAS float* qp = Qc + part * 8;
            f32x4 ka = *(const LAS f32x4*)(kp), kb = *(const LAS f32x4*)(kp + 4), qa = *(const LAS f32x4*)(qp), qb = *(const LAS f32x4*)(qp + 4);
            float vv = Vc[r], alpha = al[0], beta = be[0];
            for (int t = 0; t < 64; ++t) {
                const int tn = (t + 1) & 63;
                const f32x4 nka = *(const LAS f32x4*)(kp + tn * 128), nkb = *(const LAS f32x4*)(kp + tn * 128 + 4), nqa = *(const LAS f32x4*)(qp + tn * 128), nqb = *(const LAS f32x4*)(qp + tn * 128 + 4);
                const float nvv = Vc[tn * 32 + r], nal = al[tn], nbe = be[tn];
                float p0 = s[0] * ka.x + s[1] * ka.y, p1 = s[2] * ka.z + s[3] * ka.w, p2 = s[4] * kb.x + s[5] * kb.y, p3 = s[6] * kb.z + s[7] * kb.w;
                const float p = red16((p0 + p1) + (p2 + p3));
                const float coef = beta * (vv - alpha * p);
                s[0] = alpha * s[0] + coef * ka.x; s[1] = alpha * s[1] + coef * ka.y; s[2] = alpha * s[2] + coef * ka.z; s[3] = alpha * s[3] + coef * ka.w;
                s[4] = alpha * s[4] + coef * kb.x; s[5] = alpha * s[5] + coef * kb.y; s[6] = alpha * s[6] + coef * kb.z; s[7] = alpha * s[7] + coef * kb.w;
                float o0 = s[0] * qa.x + s[1] * qa.y, o1 = s[2] * qa.z + s[3] * qa.w, o2 = s[4] * qb.x + s[5] * qb.y, o3 = s[6] * qb.z + s[7] * qb.w;
                const float o = red16((o0 + o1) + (o2 + o3));
                if (part == 0) Oc[t * 32 + r] = o;
                ka = nka; kb = nkb; qa = nqa; qb = nqb; vv = nvv; alpha = nal; beta = nbe;
            }
        }
        __syncthreads();
        {
            const int t = tid >> 3, c4 = (tid & 7) * 4;
            const f32x4 o = *(const LAS f32x4*)(Oc + t * 32 + c4);
            u32x2 wv; wv.x = pk2(o.x, o.y); wv.y = pk2(o.z, o.w);
            *(u32x2*)(P + (size_t)(t0 + t) * P0LD + 1024 + h * 128 + qd * 32 + c4) = wv;
        }
    }
}
__device__ __forceinline__ void fin_delta(const Frame& F) {
    const int lane = lane_id_v();
    bf16_t* P = (bf16_t*)(F.ws + WS_BIG + BIG_PROJ); const float* onorm = F.in[IN_AB_ONORM];
    const float on0 = onorm[lane], on1 = onorm[lane + 64];
    const int gw = F.wg * NWAVES + F.wave, NGW = F.G * NWAVES;
    for (int it = gw; it < NT * 4; it += NGW) {
        const int t = it >> 2, h = it & 3;
        bf16_t* row = P + (size_t)t * P0LD;
        const float o0 = bf2f(row[1024 + h * 128 + lane]), o1 = bf2f(row[1024 + h * 128 + lane + 64]);
        const float g0 = bf2f(row[1536 + h * 128 + lane]), g1 = bf2f(row[1536 + h * 128 + lane + 64]);
        const float ss = wave_sum(o0 * o0 + o1 * o1), rs = rsqf_(ss * (1.0f / 128.0f) + 1e-6f);
        row[1536 + h * 128 + lane] = (bf16_t)f2bf(o0 * rs * on0 * siluf_(g0)); row[1536 + h * 128 + lane + 64] = (bf16_t)f2bf(o1 * rs * on1 * siluf_(g1));
    }
}

__device__ __forceinline__ void scan_rwkv2(const Frame& F, int b, int h) {
    const int lane = lane_id_v(); const int tid = F.wave * 64 + lane;
    LAS float* R = (LAS float*)F.lds;
    LAS float* KM = R + 4096;
    LAS float* V = KM + 4096;
    LAS float* KK = V + 4096;
    LAS float* KA = KK + 4096;
    LAS float* W = KA + 4096;
    LAS bf16_t* TL = (LAS bf16_t*)(W + 4096);
    LAS bf16_t* AL = TL + 64 * 72;
    LAS bf16_t* SG = AL + 64 * 72;
    LAS float* O = (LAS float*)TL;
    LAS bf16_t* GB = SG + 64 * 136;
    LAS float* halo = (LAS float*)(GB + 4096);
    LAS float* bonus = halo + 896;
    bf16_t* P = (bf16_t*)(F.ws + WS_BIG + BIG_PROJ);
    const bf16_t* LW = (const bf16_t*)(F.ws + WS_LORA);
    const float* mu = F.in[IN_AB_MU];
    const float* w0 = F.in[IN_AB_W0] + h * 64; const float* a0 = F.in[IN_AB_A0] + h * 64;
    const float* k_k = F.in[IN_AB_KK] + h * 64; const float* k_a = F.in[IN_AB_KA] + h * 64; const float* r_k = F.in[IN_AB_RK] + h * 64;
    const float* ln_w = F.in[IN_AB_LNW] + h * 64; const float* ln_b = F.in[IN_AB_LNB] + h * 64;
    const int w = F.wave, fr = lane & 15, fq = lane >> 4;
    const int vi = tid >> 3, part = tid & 7;
    float s[8];
#pragma unroll
    for (int j = 0; j < 8; ++j) s[j] = 0.f;
    for (int i = tid; i < 896; i += NTHREADS) halo[i] = 0.f;
    int gc = 0; float muc = 0.f;
    if (tid < 448) { const int col = tid;
        if (col < 64) gc = 2048 + h * 64 + col; else if (col < 128) gc = 2560 + h * 64 + (col - 64); else if (col < 192) gc = 3072 + h * 64 + (col - 128); else gc = 3584 + (col - 192);
        muc = mu[gc - 2048]; }
    __syncthreads();
    for (int c = 0; c < 32; ++c) {
        const int t0 = b * TS + c * 64;
        if (tid < 448) {
            const int col = tid;
            LAS float* hc = halo + (c & 1) * 448; LAS float* hn = halo + ((c + 1) & 1) * 448;
            float prev = hc[col];
            const bf16_t* src = P + (size_t)t0 * P0LD + gc;
#pragma unroll 8
            for (int t = 0; t < 64; ++t) {
                const float cur = bf2f(src[(size_t)t * P0LD]);
                const float sh = cur + muc * (prev - cur);
                prev = cur;
                if (col < 64) R[t * 64 + col] = sh; else if (col < 128) KM[t * 64 + col - 64] = sh; else if (col < 192) V[t * 64 + col - 128] = sh;
                else if (col < 256) TL[t * 72 + col - 192] = (bf16_t)f2bf(tanhf(sh)); else if (col < 320) AL[t * 72 + col - 256] = (bf16_t)f2bf(sh); else SG[t * 136 + col - 320] = (bf16_t)f2bf(sigmoidf_(sh));
            }
            hn[col] = prev;
        }
        __syncthreads();
        {
#pragma unroll
            for (int q = 0; q < 2; ++q) {
                const int id = 2 * w + q, mi = id >> 2, nj = id & 3;
                f32x4 aw = {0.f, 0.f, 0.f, 0.f}, aa = {0.f, 0.f, 0.f, 0.f}, ag = {0.f, 0.f, 0.f, 0.f};
                const int jrow = h * 64 + nj * 16 + fr;
#pragma unroll
                for (int ksx = 0; ksx < 2; ++ksx) {
                    const bf16x8 x1 = *(const LAS bf16x8*)(TL + (mi * 16 + fr) * 72 + ksx * 32 + fq * 8), x2 = *(const LAS bf16x8*)(AL + (mi * 16 + fr) * 72 + ksx * 32 + fq * 8);
                    const bf16x8 y1 = *(const bf16x8*)(LW + (size_t)jrow * 64 + ksx * 32 + fq * 8), y2 = *(const bf16x8*)(LW + 512 * 64 + (size_t)jrow * 64 + ksx * 32 + fq * 8);
                    aw = __builtin_amdgcn_mfma_f32_16x16x32_bf16(x1, y1, aw, 0, 0, 0); aa = __builtin_amdgcn_mfma_f32_16x16x32_bf16(x2, y2, aa, 0, 0, 0);
                }
#pragma unroll
                for (int ksx = 0; ksx < 4; ++ksx) {
                    const bf16x8 x3 = *(const LAS bf16x8*)(SG + (mi * 16 + fr) * 136 + ksx * 32 + fq * 8);
                    const bf16x8 y3 = *(const bf16x8*)(LW + 2 * 512 * 64 + (size_t)jrow * 128 + ksx * 32 + fq * 8);
                    ag = __builtin_amdgcn_mfma_f32_16x16x32_bf16(x3, y3, ag, 0, 0, 0);
                }
                const int j = nj * 16 + fr; const float w0j = w0[j], a0j = a0[j];
                const float awv[4] = {aw.x, aw.y, aw.z, aw.w}, aav[4] = {aa.x, aa.y, aa.z, aa.w}, agv[4] = {ag.x, ag.y, ag.z, ag.w};
#pragma unroll
                for (int rg = 0; rg < 4; ++rg) { const int t = mi * 16 + 4 * fq + rg;
                    W[t * 64 + j] = __expf(-0.6065306597126334f * sigmoidf_(w0j + awv[rg])); KA[t * 64 + j] = sigmoidf_(a0j + aav[rg]); GB[t * 64 + j] = (bf16_t)f2bf(agv[rg]); }
            }
        }
        __syncthreads();
        {
            const int j = lane; const float kkj = k_k[j], kaj = k_a[j], rkj = r_k[j];
#pragma unroll
            for (int q = 0; q < 8; ++q) { const int t = w * 8 + q; const float kv = KM[t * 64 + j], a = KA[t * 64 + j]; const float kx = kv * kkj; const float ss = wave_sum(kx * kx);
                const float kk = kx * (rsqf_(ss + 1e-6f)); KK[t * 64 + j] = kk; KA[t * 64 + j] = kk * a; const float km = kv * (1.f + (a - 1.f) * kaj); KM[t * 64 + j] = km;
                const float bs = wave_sum(R[t * 64 + j] * km * rkj); if (j == 0) bonus[t] = bs; }
        }
        __syncthreads();
        {
            const int o8 = part * 8;
            for (int t = 0; t < 64; ++t) {
                const f32x4 k0 = *(const LAS f32x4*)(KK + t * 64 + o8), k1 = *(const LAS f32x4*)(KK + t * 64 + o8 + 4);
                const f32x4 w0v = *(const LAS f32x4*)(W + t * 64 + o8), w1v = *(const LAS f32x4*)(W + t * 64 + o8 + 4);
                const f32x4 a0v = *(const LAS f32x4*)(KA + t * 64 + o8), a1v = *(const LAS f32x4*)(KA + t * 64 + o8 + 4);
                const f32x4 m0 = *(const LAS f32x4*)(KM + t * 64 + o8), m1 = *(const LAS f32x4*)(KM + t * 64 + o8 + 4);
                const f32x4 r0 = *(const LAS f32x4*)(R + t * 64 + o8), r1 = *(const LAS f32x4*)(R + t * 64 + o8 + 4);
                const float vv = V[t * 64 + vi];
                const float sa = -red8(((s[0] * k0.x + s[1] * k0.y) + (s[2] * k0.z + s[3] * k0.w)) + ((s[4] * k1.x + s[5] * k1.y) + (s[6] * k1.z + s[7] * k1.w)));
                s[0] = s[0] * w0v.x + sa * a0v.x + vv * m0.x; s[1] = s[1] * w0v.y + sa * a0v.y + vv * m0.y; s[2] = s[2] * w0v.z + sa * a0v.z + vv * m0.z; s[3] = s[3] * w0v.w + sa * a0v.w + vv * m0.w;
                s[4] = s[4] * w1v.x + sa * a1v.x + vv * m1.x; s[5] = s[5] * w1v.y + sa * a1v.y + vv * m1.y; s[6] = s[6] * w1v.z + sa * a1v.z + vv * m1.z; s[7] = s[7] * w1v.w + sa * a1v.w + vv * m1.w;
                const float o = red8(((s[0] * r0.x + s[1] * r0.y) + (s[2] * r0.z + s[3] * r0.w)) + ((s[4] * r1.x + s[5] * r1.y) + (s[6] * r1.z + s[7] * r1.w)));
                if (part == 0) O[t * 64 + vi] = o;
            }
        }
        __syncthreads();
        for (int t = w; t < 64; t += NWAVES) {
            const float o = O[t * 64 + lane];
            const float mean = wave_sum(o) * (1.0f / 64.0f); const float dlt = o - mean; const float var = wave_sum(dlt * dlt) * (1.0f / 64.0f);
            float y = dlt * (rsqf_(var + 64e-5f)) * ln_w[lane] + ln_b[lane];
            y += bonus[t] * V[t * 64 + lane];
            y *= bf2f(GB[t * 64 + lane]);
            P[(size_t)(t0 + t) * P0LD + 2048 + h * 64 + lane] = (bf16_t)f2bf(y);
        }
        __syncthreads();
    }
}

__device__ __forceinline__ void scan_hgrn2(const Frame& F, int b, int h, int qd) {
    const int lane = lane_id_v(); const int tid = F.wave * 64 + lane;
    LAS float* qs = (LAS float*)F.lds;
    LAS float* fs = qs + 64 * 128;
    LAS float* kf = fs + 64 * 128;
    LAS float* is = kf + 64 * 128;
    bf16_t* P = (bf16_t*)(F.ws + WS_BIG + BIG_PROJ);
    const int e = tid >> 4, part = tid & 15;
    float s[8];
#pragma unroll
    for (int j = 0; j < 8; ++j) s[j] = 0.f;
    for (int c = 0; c < 32; ++c) {
        const int t0 = b * TS + c * 64;
        {
            const int t = tid >> 3, c16 = (tid & 7) * 16;
            const bf16_t* pr = P + (size_t)(t0 + t) * P1LD + h * 128 + c16;
            const u32x4 qa = *(const u32x4*)pr, qb = *(const u32x4*)(pr + 8), la = *(const u32x4*)(pr + 1024), lb2 = *(const u32x4*)(pr + 1024 + 8);
            const unsigned qv[8] = {qa.x, qa.y, qa.z, qa.w, qb.x, qb.y, qb.z, qb.w}, lv[8] = {la.x, la.y, la.z, la.w, lb2.x, lb2.y, lb2.z, lb2.w};
#pragma unroll
            for (int j = 0; j < 8; ++j) {
                qs[t * 128 + c16 + 2 * j] = bf2f((unsigned short)(qv[j] & 0xffffu)); qs[t * 128 + c16 + 2 * j + 1] = bf2f((unsigned short)(qv[j] >> 16));
                const float l0 = h2f_bits((unsigned short)(lv[j] & 0xffffu)), l1 = h2f_bits((unsigned short)(lv[j] >> 16));
                fs[t * 128 + c16 + 2 * j] = __expf(l0); fs[t * 128 + c16 + 2 * j + 1] = __expf(l1); kf[t * 128 + c16 + 2 * j] = -expm1f(l0); kf[t * 128 + c16 + 2 * j + 1] = -expm1f(l1);
            }
            const int c4 = (tid & 7) * 4;
            const u32x2 iv = *(const u32x2*)(P + (size_t)(t0 + t) * P1LD + 2048 + h * 128 + qd * 32 + c4);
            is[t * 32 + c4] = bf2f((unsigned short)(iv.x & 0xffffu)); is[t * 32 + c4 + 1] = bf2f((unsigned short)(iv.x >> 16)); is[t * 32 + c4 + 2] = bf2f((unsigned short)(iv.y & 0xffffu)); is[t * 32 + c4 + 3] = bf2f((unsigned short)(iv.y >> 16));
        }
        __syncthreads();
        {
            const int o8 = part * 8;
            for (int t = 0; t < 64; ++t) {
                const f32x4 f0 = *(const LAS f32x4*)(fs + t * 128 + o8), f1 = *(const LAS f32x4*)(fs + t * 128 + o8 + 4);
                const f32x4 k0 = *(const LAS f32x4*)(kf + t * 128 + o8), k1 = *(const LAS f32x4*)(kf + t * 128 + o8 + 4);
                const f32x4 q0 = *(const LAS f32x4*)(qs + t * 128 + o8), q1 = *(const LAS f32x4*)(qs + t * 128 + o8 + 4);
                const float iv = is[t * 32 + e];
                s[0] = f0.x * s[0] + k0.x * iv; s[1] = f0.y * s[1] + k0.y * iv; s[2] = f0.z * s[2] + k0.z * iv; s[3] = f0.w * s[3] + k0.w * iv;
                s[4] = f1.x * s[4] + k1.x * iv; s[5] = f1.y * s[5] + k1.y * iv; s[6] = f1.z * s[6] + k1.z * iv; s[7] = f1.w * s[7] + k1.w * iv;
                const float o = red16(((s[0] * q0.x + s[1] * q0.y) + (s[2] * q0.z + s[3] * q0.w)) + ((s[4] * q1.x + s[5] * q1.y) + (s[6] * q1.z + s[7] * q1.w)));
                if (part == 0) is[t * 32 + e] = o;
            }
        }
        __syncthreads();
        {
            const int t = tid >> 3, c4 = (tid & 7) * 4;
            const f32x4 o = *(const LAS f32x4*)(is + t * 32 + c4);
            u32x2 wv; wv.x = pk2(o.x, o.y); wv.y = pk2(o.z, o.w);
            *(u32x2*)(P + (size_t)(t0 + t) * P1LD + 2048 + h * 128 + qd * 32 + c4) = wv;
        }
        __syncthreads();
    }
}
__device__ __forceinline__ void fin_hgrn(const Frame& F) {
    const int lane = lane_id_v();
    bf16_t* P = (bf16_t*)(F.ws + WS_BIG + BIG_PROJ); const float* onorm = F.in[IN_C_ONORM];
    const float on0 = onorm[lane], on1 = onorm[lane + 64];
    const int gw = F.wg * NWAVES + F.wave, NGW = F.G * NWAVES;
    for (int it = gw; it < NT * 8; it += NGW) {
        const int t = it >> 3, h = it & 7;
        bf16_t* row = P + (size_t)t * P1LD;
        const float o0 = bf2f(row[2048 + h * 128 + lane]), o1 = bf2f(row[2048 + h * 128 + lane + 64]);
        const float g0 = bf2f(row[3072 + h * 128 + lane]), g1 = bf2f(row[3072 + h * 128 + lane + 64]);
        const float ss = wave_sum(o0 * o0 + o1 * o1), rs = rsqf_(ss * (1.0f / 128.0f) + 1e-6f);
        row[3072 + h * 128 + lane] = (bf16_t)f2bf(o0 * rs * on0 * siluf_(g0)); row[3072 + h * 128 + lane + 64] = (bf16_t)f2bf(o1 * rs * on1 * siluf_(g1));
    }
}

#define MFMA32(a, b, c) __builtin_amdgcn_mfma_f32_16x16x32_bf16(a, b, c, 0, 0, 0)
#define MFMA16(a, b, c) __builtin_amdgcn_mfma_f32_16x16x16bf16_1k(a, b, c, 0, 0, 0)
__device__ __forceinline__ f32x4 mm_tile(const LAS bf16_t* A, int lda, const LAS bf16_t* B, int ldb, int nks, f32x4 acc, int fr, int fq) {
    for (int ksx = 0; ksx < nks; ++ksx) acc = MFMA32(*(const LAS bf16x8*)(A + fr * lda + ksx * 32 + fq * 8), *(const LAS bf16x8*)(B + fr * ldb + ksx * 32 + fq * 8), acc);
    return acc;
}
__device__ __forceinline__ void lds_w4(LAS bf16_t* p, f32x4 v) { u32x2 w; w.x = pk2(v.x, v.y); w.y = pk2(v.z, v.w); *(LAS u32x2*)p = w; }
__device__ __forceinline__ float rdlane(float v, int l) { return __int_as_float(__builtin_amdgcn_readlane(__float_as_int(v), l)); }
__device__ __forceinline__ float wsum(float v) { v = red16(v); return (rdlane(v, 0) + rdlane(v, 16)) + (rdlane(v, 32) + rdlane(v, 48)); }

__device__ __forceinline__ void scan_delta3(const Frame& F, int b, int h) {
    const int lane0 = lane_id_v(); const int w = F.wave;
    LAS bf16_t* Qb = (LAS bf16_t*)F.lds;
    LAS bf16_t* Kb = Qb + 64 * 136;
    LAS float* Of = (LAS float*)F.lds;
    LAS bf16_t* Kdt = Kb + 64 * 136;
    LAS bf16_t* Vt = Kdt + 128 * 72;
    LAS bf16_t* St = Vt + 128 * 72;
    LAS bf16_t* Aoff = St + 128 * 136;
    LAS bf16_t* QKm = Aoff + 64 * 72;
    LAS bf16_t* Vn = QKm + 64 * 72;
    LAS bf16_t* Dg = Vn + 128 * 72;
    LAS float* Adg = (LAS float*)(Dg + 4 * 16 * 24);
    LAS float* sc = Adg + 4 * 16 * 17;
    static_assert((64 * 136 * 2 * 2 + 128 * 72 * 2 * 3 + 128 * 136 * 2 + 64 * 72 * 2 * 2 + 4 * 16 * 24 * 2 + 4 * 16 * 17 * 4 + 260 * 4) <= LDS_MISC, "delta3 LDS");
    bf16_t* P = (bf16_t*)(F.ws + WS_BIG + BIG_PROJ);
    const float* convw = F.in[IN_AB_CONV];
    const float* db = (const float*)(F.ws + WS_DB);
    const float a_neg = -__expf(F.in[IN_AB_ALOG][h]), dtb = F.in[IN_AB_DTB][h];
    const float* onorm = F.in[IN_AB_ONORM];
    float cw[3][4][2];
#pragma unroll
    for (int sct = 0; sct < 3; ++sct)
#pragma unroll
        for (int j = 0; j < 4; ++j) { cw[sct][j][0] = convw[j * 1536 + sct * 512 + h * 128 + lane0]; cw[sct][j][1] = convw[j * 1536 + sct * 512 + h * 128 + lane0 + 64]; }
    for (int i = w * 64 + lane0; i < (128 * 136 + 64 * 72 * 2 + 128 * 72) / 2; i += NTHREADS) ((LAS unsigned*)St)[i] = 0u;
    unsigned pacc = 0u, plast = 0u;
    f32x4 sacc[8];
#pragma unroll
    for (int i = 0; i < 8; ++i) sacc[i] = (f32x4){0.f, 0.f, 0.f, 0.f};
    __syncthreads();
    for (int c = 0; c < 32; ++c) {
        int lane = lane0; asm volatile("" : "+v"(lane));
        const int fr = lane & 15, fq = lane >> 4;
        const int t0 = b * TS + c * 64;
        if (PROBE_STAGE >= 0) plast = (unsigned)__builtin_amdgcn_s_memrealtime();
        unsigned short gq0[8], gq1[8];
#pragma unroll
        for (int i = 0; i < 8; ++i) { const bf16_t* gp = P + (size_t)(t0 + w + 8 * i) * P0LD + 1536 + h * 128; gq0[i] = gp[lane]; gq1[i] = gp[lane + 64]; }
        {
            const float la = a_neg * softplusf_(db[(size_t)(t0 + lane) * 8 + h] + dtb);
            const float bet = sigmoidf_(db[(size_t)(t0 + lane) * 8 + 4 + h]);
            float g = la;
#pragma unroll
            for (int o = 1; o < 64; o <<= 1) { const float n = __shfl_up(g, o); if (lane >= o) g += n; }
            const float gL = rdlane(g, 63);
            if (w == 0) { sc[lane] = g; sc[64 + lane] = __expf(g); sc[128 + lane] = bet * __expf(g); sc[192 + lane] = bet; if (lane == 0) sc[256] = __expf(gL); }
            float raw[3][11][2];
#pragma unroll
            for (int rr = 0; rr < 11; ++rr) {
                const int tl = c * 64 + 8 * w - 3 + rr; const bool ok = tl >= 0;
                const bf16_t* row = P + (size_t)(b * TS + (ok ? tl : 0)) * P0LD + h * 128 + lane;
#pragma unroll
                for (int sct = 0; sct < 3; ++sct) { const float r0 = bf2f(row[sct * 512]), r1 = bf2f(row[sct * 512 + 64]);
                    raw[sct][rr][0] = ok ? r0 : 0.f; raw[sct][rr][1] = ok ? r1 : 0.f; }
            }
            float kd0[8], kd1[8], vt0[8], vt1[8];
#pragma unroll
            for (int i = 0; i < 8; ++i) {
                const int t = 8 * w + i;
                float x[3][2];
#pragma unroll
                for (int sct = 0; sct < 3; ++sct) { float a0 = 0.f, a1 = 0.f;
#pragma unroll
                    for (int j = 0; j < 4; ++j) { a0 += cw[sct][j][0] * raw[sct][i + j][0]; a1 += cw[sct][j][1] * raw[sct][i + j][1]; }
                    x[sct][0] = siluf_(a0); x[sct][1] = siluf_(a1); }
                const float sq = wsum(x[0][0] * x[0][0] + x[0][1] * x[0][1]), sk = wsum(x[1][0] * x[1][0] + x[1][1] * x[1][1]);
                const float cq = (rsqf_(sq + 1e-6f)) * 0.08838834764831845f, ck = rsqf_(sk + 1e-6f);
                const float egr = __expf(gL - rdlane(g, t));
                Qb[t * 136 + lane] = (bf16_t)f2bf(x[0][0] * cq); Qb[t * 136 + lane + 64] = (bf16_t)f2bf(x[0][1] * cq);
                const float k0 = x[1][0] * ck, k1 = x[1][1] * ck;
                Kb[t * 136 + lane] = (bf16_t)f2bf(k0); Kb[t * 136 + lane + 64] = (bf16_t)f2bf(k1);
                kd0[i] = k0 * egr; kd1[i] = k1 * egr; vt0[i] = x[2][0]; vt1[i] = x[2][1];
            }
            *(LAS u32x4*)(Kdt + lane * 72 + 8 * w) = (u32x4){pk2(kd0[0], kd0[1]), pk2(kd0[2], kd0[3]), pk2(kd0[4], kd0[5]), pk2(kd0[6], kd0[7])};
            *(LAS u32x4*)(Kdt + (lane + 64) * 72 + 8 * w) = (u32x4){pk2(kd1[0], kd1[1]), pk2(kd1[2], kd1[3]), pk2(kd1[4], kd1[5]), pk2(kd1[6], kd1[7])};
            *(LAS u32x4*)(Vt + lane * 72 + 8 * w) = (u32x4){pk2(vt0[0], vt0[1]), pk2(vt0[2], vt0[3]), pk2(vt0[4], vt0[5]), pk2(vt0[6], vt0[7])};
            *(LAS u32x4*)(Vt + (lane + 64) * 72 + 8 * w) = (u32x4){pk2(vt1[0], vt1[1]), pk2(vt1[2], vt1[3]), pk2(vt1[4], vt1[5]), pk2(vt1[6], vt1[7])};
        }
        __syncthreads();
        if (PROBE_STAGE >= 0) { const unsigned tn = (unsigned)__builtin_amdgcn_s_memrealtime(); if (PROBE_STAGE == 0) pacc += tn - plast; plast = tn; }
        {
            for (int id = w; id < 20; id += NWAVES) {
                const int which = id / 10, tix = id % 10;
                const int bi = (tix < 1) ? 0 : (tix < 3 ? 1 : (tix < 6 ? 2 : 3)); const int bj = tix - (bi * (bi + 1)) / 2;
                f32x4 acc = {0.f, 0.f, 0.f, 0.f};
                acc = mm_tile(Kb + bj * 16 * 136, 136, (which ? Qb : Kb) + bi * 16 * 136, 136, 4, acc, fr, fq);
                const int i = 16 * bi + fr; const float gi = sc[i], bi_ = sc[192 + i];
                const float av[4] = {acc.x, acc.y, acc.z, acc.w}; float ov[4];
#pragma unroll
                for (int rg = 0; rg < 4; ++rg) { const int j = 16 * bj + 4 * fq + rg; const float dec = __expf(gi - sc[j]);
                    ov[rg] = which ? ((j <= i) ? av[rg] * dec : 0.f) : ((j < i) ? bi_ * av[rg] * dec : 0.f); }
                if (which) lds_w4(QKm + i * 72 + 16 * bj + 4 * fq, (f32x4){ov[0], ov[1], ov[2], ov[3]});
                else if (bi == bj) { LAS float* d = Adg + (bi * 16 + fr) * 17 + 4 * fq; d[0] = ov[0]; d[1] = ov[1]; d[2] = ov[2]; d[3] = ov[3]; }
                else lds_w4(Aoff + i * 72 + 16 * bj + 4 * fq, (f32x4){-ov[0], -ov[1], -ov[2], -ov[3]});
            }
        }
        __syncthreads();
        if (PROBE_STAGE >= 0) { const unsigned tn = (unsigned)__builtin_amdgcn_s_memrealtime(); if (PROBE_STAGE == 1) pacc += tn - plast; plast = tn; }
        f32x4 y[4], qs[4];
        {
            if (w < 4 && lane < 16) { float x[16]; const LAS float* a = Adg + w * 16 * 17;
#pragma unroll
                for (int i = 0; i < 16; ++i) { float v = (i == lane) ? 1.f : 0.f;
#pragma unroll
                    for (int k = 0; k < i; ++k) v -= a[i * 17 + k] * x[k];
                    x[i] = v; Dg[(w * 16 + i) * 24 + lane] = (bf16_t)f2bf(v); } }
            const LAS bf16_t* Sw = St + (16 * w) * 136;
#pragma unroll
            for (int mi = 0; mi < 4; ++mi) {
                f32x4 x = mm_tile(Kb + mi * 16 * 136, 136, Sw, 136, 4, (f32x4){0.f, 0.f, 0.f, 0.f}, fr, fq);
                qs[mi] = mm_tile(Qb + mi * 16 * 136, 136, Sw, 136, 4, (f32x4){0.f, 0.f, 0.f, 0.f}, fr, fq);
                const bf16x4 vv = *(const LAS bf16x4*)(Vt + (16 * w + fr) * 72 + 16 * mi + 4 * fq);
                const f32x4 be4 = *(const LAS f32x4*)(sc + 192 + 16 * mi + 4 * fq), bg4 = *(const LAS f32x4*)(sc + 128 + 16 * mi + 4 * fq);
                y[mi].x = be4.x * bf2f((unsigned short)vv.x) - bg4.x * x.x; y[mi].y = be4.y * bf2f((unsigned short)vv.y) - bg4.y * x.y;
                y[mi].z = be4.z * bf2f((unsigned short)vv.z) - bg4.z * x.z; y[mi].w = be4.w * bf2f((unsigned short)vv.w) - bg4.w * x.w;
            }
        }
        __syncthreads();
        if (PROBE_STAGE >= 0) { const unsigned tn = (unsigned)__builtin_amdgcn_s_memrealtime(); if (PROBE_STAGE == 2) pacc += tn - plast; plast = tn; }
        {
            LAS bf16_t* Vw = Vn + (16 * w) * 72;
#pragma unroll
            for (int bb = 0; bb < 4; ++bb) {
                f32x4 acc = y[bb];
                if (bb >= 1) acc = mm_tile(Aoff + bb * 16 * 72, 72, Vw, 72, (bb + 1) / 2, acc, fr, fq);
                u32x2 pk; pk.x = pk2(acc.x, acc.y); pk.y = pk2(acc.z, acc.w);
                const bf16x4 dgf = *(const LAS bf16x4*)(Dg + (bb * 16 + fr) * 24 + 4 * fq);
                const f32x4 vb = MFMA16(dgf, __builtin_bit_cast(bf16x4, pk), ((f32x4){0.f, 0.f, 0.f, 0.f}));
                lds_w4(Vw + fr * 72 + 16 * bb + 4 * fq, vb);
                asm volatile("s_waitcnt lgkmcnt(0)" ::: "memory");
            }
            const float gl = sc[256];
#pragma unroll
            for (int mi = 0; mi < 4; ++mi) {
                const f32x4 eg4 = *(const LAS f32x4*)(sc + 64 + 16 * mi + 4 * fq);
                f32x4 o = qs[mi] * eg4;
                o = mm_tile(QKm + mi * 16 * 72, 72, Vw, 72, 2, o, fr, fq);
                qs[mi] = o;
            }
#pragma unroll
            for (int dk = 0; dk < 8; ++dk) {
                f32x4 sn = sacc[dk] * gl;
                sn = mm_tile(Kdt + dk * 16 * 72, 72, Vw, 72, 2, sn, fr, fq);
                sacc[dk] = sn;
                lds_w4(St + (16 * w + fr) * 136 + 16 * dk + 4 * fq, sn);
            }
        }
        __syncthreads();
        if (PROBE_STAGE >= 0) { const unsigned tn = (unsigned)__builtin_amdgcn_s_memrealtime(); if (PROBE_STAGE == 3) pacc += tn - plast; plast = tn; }
#pragma unroll
        for (int mi = 0; mi < 4; ++mi) { LAS float* op = Of + (16 * mi + 4 * fq) * 132 + 16 * w + fr; op[0] = qs[mi].x; op[132] = qs[mi].y; op[264] = qs[mi].z; op[396] = qs[mi].w; }
        __syncthreads();
        if (PROBE_STAGE >= 0) { const unsigned tn = (unsigned)__builtin_amdgcn_s_memrealtime(); if (PROBE_STAGE == 4) pacc += tn - plast; plast = tn; }
#pragma unroll
        for (int i = 0; i < 8; ++i) {
            const int t = w + 8 * i;
            const float o0 = Of[t * 132 + lane], o1 = Of[t * 132 + lane + 64];
            const float ss = wsum(o0 * o0 + o1 * o1), rs = rsqf_(ss * (1.0f / 128.0f) + 1e-6f);
            bf16_t* gp = P + (size_t)(t0 + t) * P0LD + 1536 + h * 128;
            const float g0 = bf2f(gq0[i]), g1 = bf2f(gq1[i]);
            gp[lane] = (bf16_t)f2bf(o0 * rs * onorm[lane] * siluf_(g0)); gp[lane + 64] = (bf16_t)f2bf(o1 * rs * onorm[lane + 64] * siluf_(g1));
        }
        __syncthreads();
        if (PROBE_STAGE >= 0) { const unsigned tn = (unsigned)__builtin_amdgcn_s_memrealtime(); if (PROBE_STAGE == 5) pacc += tn - plast; plast = tn; }
    }
    if (PROBE_STAGE >= 0 && F.wg == 0 && w == 0 && lane0 == 0) __hip_atomic_store((unsigned*)(F.ws + WS_CTL + 20484), pacc, __ATOMIC_RELAXED, __HIP_MEMORY_SCOPE_AGENT);
}

__device__ __forceinline__ void scan_hgrn3(const Frame& F, int b, int h) {
    const int lane0 = lane_id_v(); const int w = F.wave;
    LAS bf16_t* Qd = (LAS bf16_t*)F.lds;
    LAS bf16_t* Kp = Qd + 64 * 136;
    LAS bf16_t* Kpt = Kp + 64 * 136;
    LAS bf16_t* Vt = Kpt + 128 * 72;
    LAS bf16_t* Sc = Vt + 128 * 72;
    LAS bf16_t* Zt = Sc + 64 * 72;
    LAS float* Of = (LAS float*)(Zt + 128 * 136);
    LAS float* gl = Of + 64 * 132;
    LAS float* seg = gl + 128;
    static_assert((64 * 136 * 2 * 2 + 128 * 72 * 2 * 2 + 64 * 72 * 2 + 128 * 136 * 2 + 64 * 132 * 4 + 128 * 4 + 512 * 4) <= LDS_MISC, "hgrn3 LDS");
    bf16_t* P = (bf16_t*)(F.ws + WS_BIG + BIG_PROJ);
    const float* onorm = F.in[IN_C_ONORM];
    for (int i = w * 64 + lane0; i < (64 * 72 + 128 * 136) / 2; i += NTHREADS) ((LAS unsigned*)Sc)[i] = 0u;
    f32x4 zacc[8];
#pragma unroll
    for (int i = 0; i < 8; ++i) zacc[i] = (f32x4){0.f, 0.f, 0.f, 0.f};
    __syncthreads();
    for (int c = 0; c < 32; ++c) {
        int lane = lane0; asm volatile("" : "+v"(lane));
        const int tid = w * 64 + lane, fr = lane & 15, fq = lane >> 4, d = tid & 127, sg = tid >> 7;
        const int t0 = b * TS + c * 64;
        {
            float G[16], q[16], v[16], lf[16];
            const bf16_t* pr = P + (size_t)(t0 + 16 * sg) * P1LD + h * 128 + d;
#pragma unroll
            for (int i = 0; i < 16; ++i) { q[i] = bf2f(pr[(size_t)i * P1LD]); lf[i] = h2f_bits(pr[(size_t)i * P1LD + 1024]); v[i] = bf2f(pr[(size_t)i * P1LD + 2048]); }
            float run = 0.f;
#pragma unroll
            for (int i = 0; i < 16; ++i) { run += lf[i]; G[i] = run; }
            seg[sg * 128 + d] = run;
            __syncthreads();
            float off = 0.f;
#pragma unroll
            for (int s2 = 0; s2 < 3; ++s2) if (s2 < sg) off += seg[s2 * 128 + d];
            float kpv[16];
#pragma unroll
            for (int i = 0; i < 16; ++i) {
                const int t = 16 * sg + i; const float Gt = off + G[i];
                const float qd = q[i] * __expf(Gt); kpv[i] = -expm1f(lf[i]) * __expf(fminf(-Gt, 80.f));
                Qd[t * 136 + d] = (bf16_t)f2bf(qd); Kp[t * 136 + d] = (bf16_t)f2bf(kpv[i]);
            }
            *(LAS u32x4*)(Kpt + d * 72 + 16 * sg) = (u32x4){pk2(kpv[0], kpv[1]), pk2(kpv[2], kpv[3]), pk2(kpv[4], kpv[5]), pk2(kpv[6], kpv[7])};
            *(LAS u32x4*)(Kpt + d * 72 + 16 * sg + 8) = (u32x4){pk2(kpv[8], kpv[9]), pk2(kpv[10], kpv[11]), pk2(kpv[12], kpv[13]), pk2(kpv[14], kpv[15])};
            *(LAS u32x4*)(Vt + d * 72 + 16 * sg) = (u32x4){pk2(v[0], v[1]), pk2(v[2], v[3]), pk2(v[4], v[5]), pk2(v[6], v[7])};
            *(LAS u32x4*)(Vt + d * 72 + 16 * sg + 8) = (u32x4){pk2(v[8], v[9]), pk2(v[10], v[11]), pk2(v[12], v[13]), pk2(v[14], v[15])};
            if (sg == 3) gl[d] = __expf(off + G[15]);
        }
        __syncthreads();
        for (int id = w; id < 10; id += NWAVES) {
            const int bi = (id < 1) ? 0 : (id < 3 ? 1 : (id < 6 ? 2 : 3)); const int bj = id - (bi * (bi + 1)) / 2;
            const f32x4 acc = mm_tile(Kp + bj * 16 * 136, 136, Qd + bi * 16 * 136, 136, 4, (f32x4){0.f, 0.f, 0.f, 0.f}, fr, fq);
            const int i = 16 * bi + fr, j0 = 16 * bj + 4 * fq;
            lds_w4(Sc + i * 72 + j0, (f32x4){(j0 <= i) ? acc.x : 0.f, (j0 + 1 <= i) ? acc.y : 0.f, (j0 + 2 <= i) ? acc.z : 0.f, (j0 + 3 <= i) ? acc.w : 0.f});
        }
        __syncthreads();
        {
            const LAS bf16_t* Vw = Vt + (16 * w) * 72; const LAS bf16_t* Zw = Zt + (16 * w) * 136;
#pragma unroll
            for (int mi = 0; mi < 4; ++mi) {
                f32x4 o = mm_tile(Sc + mi * 16 * 72, 72, Vw, 72, 2, (f32x4){0.f, 0.f, 0.f, 0.f}, fr, fq);
                o = mm_tile(Qd + mi * 16 * 136, 136, Zw, 136, 4, o, fr, fq);
                LAS float* op = Of + (16 * mi + 4 * fq) * 132 + 16 * w + fr; op[0] = o.x; op[132] = o.y; op[264] = o.z; op[396] = o.w;
            }
            asm volatile("s_waitcnt lgkmcnt(0)" ::: "memory");
#pragma unroll
            for (int dk = 0; dk < 8; ++dk) {
                f32x4 zn = mm_tile(Kpt + dk * 16 * 72, 72, Vw, 72, 2, zacc[dk], fr, fq);
                const f32x4 g4 = *(const LAS f32x4*)(gl + 16 * dk + 4 * fq);
                zn = zn * g4; zacc[dk] = zn;
                lds_w4(Zt + (16 * w + fr) * 136 + 16 * dk + 4 * fq, zn);
            }
        }
        __syncthreads();
        for (int t = w; t < 64; t += NWAVES) {
            const float o0 = Of[t * 132 + lane], o1 = Of[t * 132 + lane + 64];
            const float ss = wsum(o0 * o0 + o1 * o1), rs = rsqf_(ss * (1.0f / 128.0f) + 1e-6f);
            bf16_t* gp = P + (size_t)(t0 + t) * P1LD + 3072 + h * 128;
            const float g0 = bf2f(gp[lane]), g1 = bf2f(gp[lane + 64]);
            gp[lane] = (bf16_t)f2bf(o0 * rs * onorm[lane] * siluf_(g0)); gp[lane + 64] = (bf16_t)f2bf(o1 * rs * onorm[lane + 64] * siluf_(g1));
        }
    }
}

__device__ __forceinline__ float tanh_fast(float x) { const float e = __expf(2.f * x); return 1.f - 2.f * rcpf_(1.f + e); }
struct RwkvLd { u32x4 cu, pv; };
__device__ __forceinline__ RwkvLd rwkv_ld8(const bf16_t* Pc, int t, int gc) {
    const bf16_t* src = Pc + (size_t)t * P0LD + gc; RwkvLd r; r.cu = *(const u32x4*)src; r.pv = *(const u32x4*)(src - (t > 0 ? P0LD : 0)); return r;
}
__device__ __forceinline__ void rwkv_sh8(const RwkvLd& ld, int t, int gc, int hidx, const float* mu, const LAS float* hc, LAS float* hn, float (&sh)[8]) {
    const f32x4 h0 = *(const LAS f32x4*)(hc + hidx), h1 = *(const LAS f32x4*)(hc + hidx + 4);
    const f32x4 m0 = *(const f32x4*)(mu + gc - 2048), m1 = *(const f32x4*)(mu + gc - 2048 + 4);
    const unsigned cw_[4] = {ld.cu.x, ld.cu.y, ld.cu.z, ld.cu.w}, pw_[4] = {ld.pv.x, ld.pv.y, ld.pv.z, ld.pv.w};
    const float mv[8] = {m0.x, m0.y, m0.z, m0.w, m1.x, m1.y, m1.z, m1.w}, hv[8] = {h0.x, h0.y, h0.z, h0.w, h1.x, h1.y, h1.z, h1.w};
    float cur[8];
#pragma unroll
    for (int e = 0; e < 8; ++e) {
        cur[e] = bf2f((unsigned short)((e & 1) ? (cw_[e >> 1] >> 16) : (cw_[e >> 1] & 0xffffu)));
        const float pg = bf2f((unsigned short)((e & 1) ? (pw_[e >> 1] >> 16) : (pw_[e >> 1] & 0xffffu)));
        const float prv = (t > 0) ? pg : hv[e];
        sh[e] = cur[e] + mv[e] * (prv - cur[e]);
    }
    if (t == 63) { *(LAS f32x4*)(hn + hidx) = (f32x4){cur[0], cur[1], cur[2], cur[3]}; *(LAS f32x4*)(hn + hidx + 4) = (f32x4){cur[4], cur[5], cur[6], cur[7]}; }
}
__device__ __forceinline__ void scan_rwkv3(const Frame& F, int b, int h) {
    const int lane0 = lane_id_v(); const int w = F.wave;
    LAS unsigned char* L = F.lds;
    LAS bf16_t* RPb = (LAS bf16_t*)(L + 0);
    LAS bf16_t* KPb = (LAS bf16_t*)(L + 9216);
    LAS float* LWf = (LAS float*)(L + 18432);
    LAS float* Af = (LAS float*)(L + 34816);
    LAS float* segs = (LAS float*)(L + 51200);
    LAS bf16_t* Mak = (LAS bf16_t*)(L + 0);
    LAS bf16_t* Mrk = (LAS bf16_t*)(L + 9216);
    LAS bf16_t* Mrbn = (LAS bf16_t*)(L + 18432);
    LAS bf16_t* Aoff = (LAS bf16_t*)(L + 27648);
    LAS float* Adg = (LAS float*)(L + 36864);
    LAS bf16_t* Dg = (LAS bf16_t*)(L + 41216);
    LAS bf16_t* GB = (LAS bf16_t*)(L + 44288);
    LAS bf16_t* TL = (LAS bf16_t*)(L + 65536);
    LAS bf16_t* AL = (LAS bf16_t*)(L + 65536 + 9216);
    LAS bf16_t* SG = (LAS bf16_t*)(L + 65536 + 18432);
    LAS bf16_t* At = (LAS bf16_t*)(L + 65536);
    LAS bf16_t* Btl = (LAS bf16_t*)(L + 65536 + 9216);
    LAS bf16_t* Ktl = (LAS bf16_t*)(L + 65536 + 18432);
    LAS bf16_t* Rtl = (LAS bf16_t*)(L + 65536 + 27648);
    LAS float* Of = (LAS float*)(L + 65536);
    LAS bf16_t* BtTn = (LAS bf16_t*)(L + 102400);
    LAS bf16_t* KtT = (LAS bf16_t*)(L + 111616);
    LAS bf16_t* Vt = (LAS bf16_t*)(L + 120832);
    LAS bf16_t* Zt = (LAS bf16_t*)(L + 130048);
    LAS bf16_t* PU = (LAS bf16_t*)(L + 139264);
    LAS float* halo = (LAS float*)(L + 148480);
    LAS float* bonus = halo + 896;
    LAS float* glv = bonus + 64;
    static_assert(148480 + 4096 <= LDS_MISC, "rwkv3 LDS");
    bf16_t* P = (bf16_t*)(F.ws + WS_BIG + BIG_PROJ);
    const bf16_t* LW = (const bf16_t*)(F.ws + WS_LORA);
    const float* mu = F.in[IN_AB_MU];
    const float kkj = F.in[IN_AB_KK][h * 64 + lane0], kaj = F.in[IN_AB_KA][h * 64 + lane0], rkj = F.in[IN_AB_RK][h * 64 + lane0];
    const float lnw = F.in[IN_AB_LNW][h * 64 + lane0], lnb = F.in[IN_AB_LNB][h * 64 + lane0];
    float w0q[2], a0q[2];
#pragma unroll
    for (int q = 0; q < 2; ++q) { const int jq = ((2 * w + q) & 3) * 16 + (lane0 & 15); w0q[q] = F.in[IN_AB_W0][h * 64 + jq]; a0q[q] = F.in[IN_AB_A0][h * 64 + jq]; }
    bf16x8 yw[2][2], ya[2][2], yg[2][4];
#pragma unroll
    for (int q = 0; q < 2; ++q) { const int jrow = h * 64 + ((2 * w + q) & 3) * 16 + (lane0 & 15), fq0 = lane0 >> 4;
#pragma unroll
        for (int ksx = 0; ksx < 2; ++ksx) { yw[q][ksx] = *(const bf16x8*)(LW + (size_t)jrow * 64 + ksx * 32 + fq0 * 8); ya[q][ksx] = *(const bf16x8*)(LW + 512 * 64 + (size_t)jrow * 64 + ksx * 32 + fq0 * 8); }
#pragma unroll
        for (int ksx = 0; ksx < 4; ++ksx) yg[q][ksx] = *(const bf16x8*)(LW + 2 * 512 * 64 + (size_t)jrow * 128 + ksx * 32 + fq0 * 8); }
    f32x4 zacc[4];
#pragma unroll
    for (int i = 0; i < 4; ++i) zacc[i] = (f32x4){0.f, 0.f, 0.f, 0.f};
    for (int i = w * 64 + lane0; i < 896; i += NTHREADS) halo[i] = 0.f;
    for (int i = w * 64 + lane0; i < (64 * 72 * 2) / 2; i += NTHREADS) ((LAS unsigned*)Zt)[i] = 0u;
    __syncthreads();
    for (int c = 0; c < 32; ++c) {
        int lane = lane0; asm volatile("" : "+v"(lane));
        const int tid = w * 64 + lane, fr = lane & 15, fq = lane >> 4;
        const int t0 = b * TS + c * 64;
        {
            const LAS float* hc = halo + (c & 1) * 448; LAS float* hn = halo + ((c + 1) & 1) * 448;
            const bf16_t* Pc = P + (size_t)t0 * P0LD;
            const int t_a0 = tid >> 4, cg_a0 = tid & 15, t_a1 = (tid + NTHREADS) >> 4, cg_a1 = (tid + NTHREADS) & 15, t_b = tid >> 3, cg_b = tid & 7;
            const int gc0 = ((cg_a0 < 8) ? 2048 : 2560) + h * 64 + (cg_a0 & 7) * 8, gc1 = ((cg_a1 < 8) ? 2048 : 2560) + h * 64 + (cg_a1 & 7) * 8;
            const int gc2 = 3584 + cg_b * 8, gc3 = 3648 + cg_b * 8, gc4 = 3712 + cg_a0 * 8, gc5 = 3712 + cg_a1 * 8;
            const RwkvLd l0 = rwkv_ld8(Pc, t_a0, gc0), l1 = rwkv_ld8(Pc, t_a1, gc1), l2 = rwkv_ld8(Pc, t_b, gc2), l3 = rwkv_ld8(Pc, t_b, gc3), l4 = rwkv_ld8(Pc, t_a0, gc4), l5 = rwkv_ld8(Pc, t_a1, gc5);
            const int vcol = tid & 63, vtg = tid >> 6;
            const bf16_t* vsrc = Pc + (size_t)(8 * vtg) * P0LD + 3072 + h * 64 + vcol;
            unsigned short vr[9];
#pragma unroll
            for (int i = 0; i < 8; ++i) vr[i + 1] = vsrc[(size_t)i * P0LD];
            vr[0] = *(vsrc - (vtg > 0 ? P0LD : 0));
            float sh[8];
            { rwkv_sh8(l0, t_a0, gc0, cg_a0 * 8, mu, hc, hn, sh);
              *(LAS u32x4*)((cg_a0 < 8 ? RPb : KPb) + t_a0 * 72 + (cg_a0 & 7) * 8) = (u32x4){pk2(sh[0], sh[1]), pk2(sh[2], sh[3]), pk2(sh[4], sh[5]), pk2(sh[6], sh[7])}; }
            { rwkv_sh8(l1, t_a1, gc1, cg_a1 * 8, mu, hc, hn, sh);
              *(LAS u32x4*)((cg_a1 < 8 ? RPb : KPb) + t_a1 * 72 + (cg_a1 & 7) * 8) = (u32x4){pk2(sh[0], sh[1]), pk2(sh[2], sh[3]), pk2(sh[4], sh[5]), pk2(sh[6], sh[7])}; }
            { rwkv_sh8(l2, t_b, gc2, 192 + cg_b * 8, mu, hc, hn, sh);
              *(LAS u32x4*)(TL + t_b * 72 + cg_b * 8) = (u32x4){pk2(tanh_fast(sh[0]), tanh_fast(sh[1])), pk2(tanh_fast(sh[2]), tanh_fast(sh[3])), pk2(tanh_fast(sh[4]), tanh_fast(sh[5])), pk2(tanh_fast(sh[6]), tanh_fast(sh[7]))}; }
            { rwkv_sh8(l3, t_b, gc3, 256 + cg_b * 8, mu, hc, hn, sh);
              *(LAS u32x4*)(AL + t_b * 72 + cg_b * 8) = (u32x4){pk2(sh[0], sh[1]), pk2(sh[2], sh[3]), pk2(sh[4], sh[5]), pk2(sh[6], sh[7])}; }
            { rwkv_sh8(l4, t_a0, gc4, 320 + cg_a0 * 8, mu, hc, hn, sh);
              *(LAS u32x4*)(SG + t_a0 * 136 + cg_a0 * 8) = (u32x4){pk2(sigmoidf_(sh[0]), sigmoidf_(sh[1])), pk2(sigmoidf_(sh[2]), sigmoidf_(sh[3])), pk2(sigmoidf_(sh[4]), sigmoidf_(sh[5])), pk2(sigmoidf_(sh[6]), sigmoidf_(sh[7]))}; }
            { rwkv_sh8(l5, t_a1, gc5, 320 + cg_a1 * 8, mu, hc, hn, sh);
              *(LAS u32x4*)(SG + t_a1 * 136 + cg_a1 * 8) = (u32x4){pk2(sigmoidf_(sh[0]), sigmoidf_(sh[1])), pk2(sigmoidf_(sh[2]), sigmoidf_(sh[3])), pk2(sigmoidf_(sh[4]), sigmoidf_(sh[5])), pk2(sigmoidf_(sh[6]), sigmoidf_(sh[7]))}; }
            {
                float cur[9];
#pragma unroll
                for (int i = 0; i < 9; ++i) cur[i] = bf2f(vr[i]);
                if (vtg == 0) cur[0] = hc[128 + vcol];
                const float mvc = mu[1024 + h * 64 + vcol];
                float shv[8];
#pragma unroll
                for (int i = 0; i < 8; ++i) shv[i] = cur[i + 1] + mvc * (cur[i] - cur[i + 1]);
                if (vtg == 7) hn[128 + vcol] = cur[8];
                *(LAS u32x4*)(Vt + vcol * 72 + 8 * vtg) = (u32x4){pk2(shv[0], shv[1]), pk2(shv[2], shv[3]), pk2(shv[4], shv[5]), pk2(shv[6], shv[7])};
            }
        }
        __syncthreads();
        f32x4 agate[2];
        {
#pragma unroll
            for (int q = 0; q < 2; ++q) {
                const int id = 2 * w + q, mi = id >> 2, nj = id & 3;
                f32x4 aw = {0.f, 0.f, 0.f, 0.f}, aa = {0.f, 0.f, 0.f, 0.f}, ag = {0.f, 0.f, 0.f, 0.f};
#pragma unroll
                for (int ksx = 0; ksx < 2; ++ksx) {
                    const bf16x8 x1 = *(const LAS bf16x8*)(TL + (mi * 16 + fr) * 72 + ksx * 32 + fq * 8), x2 = *(const LAS bf16x8*)(AL + (mi * 16 + fr) * 72 + ksx * 32 + fq * 8);
                    aw = MFMA32(x1, yw[q][ksx], aw); aa = MFMA32(x2, ya[q][ksx], aa);
                }
#pragma unroll
                for (int ksx = 0; ksx < 4; ++ksx) {
                    const bf16x8 x3 = *(const LAS bf16x8*)(SG + (mi * 16 + fr) * 136 + ksx * 32 + fq * 8);
                    ag = MFMA32(x3, yg[q][ksx], ag);
                }
                agate[q] = ag;
                const int j = nj * 16 + fr; const float w0j = w0q[q], a0j = a0q[q];
                const float awv[4] = {aw.x, aw.y, aw.z, aw.w}, aav[4] = {aa.x, aa.y, aa.z, aa.w};
#pragma unroll
                for (int rg = 0; rg < 4; ++rg) { const int t = mi * 16 + 4 * fq + rg;
                    LWf[t * 64 + j] = -0.6065306597126334f * sigmoidf_(w0j + awv[rg]); Af[t * 64 + j] = sigmoidf_(a0j + aav[rg]); }
            }
        }
        __syncthreads();
        {
            float g[8]; float run = 0.f;
#pragma unroll
            for (int i = 0; i < 8; ++i) { run += LWf[(8 * w + i) * 64 + lane]; g[i] = run; }
            segs[w * 64 + lane] = run;
            __syncthreads();
            float off = 0.f;
#pragma unroll
            for (int s2 = 0; s2 < 7; ++s2) if (s2 < w) off += segs[s2 * 64 + lane];
#pragma unroll
            for (int i = 0; i < 8; ++i) LWf[(8 * w + i) * 64 + lane] = off + g[i];
        }
        __syncthreads();
        {
            const int j = lane;
            float btn[8], ktt[8];
#pragma unroll
            for (int i = 0; i < 8; ++i) {
                const int t = 8 * w + i;
                const float kv = bf2f(KPb[t * 72 + j]), rv = bf2f(RPb[t * 72 + j]), a = Af[t * 64 + j], G = LWf[t * 64 + j];
                const float Gp = (t > 0) ? LWf[(t - 1) * 64 + j] : 0.f;
                const float kx = kv * kkj; const float ss = wsum(kx * kx); const float kk = kx * (rsqf_(ss + 1e-6f));
                const float km = kv * (1.f + (a - 1.f) * kaj);
                const float bs = wsum(rv * km * rkj); if (j == 0) bonus[t] = bs;
                const float eG = __expf(G), eGi = __expf(-G), eGp = __expf(Gp);
                const float bt = kk * a * eGi, kt = km * eGi;
                At[t * 72 + j] = (bf16_t)f2bf(kk * eGp); Btl[t * 72 + j] = (bf16_t)f2bf(bt); Ktl[t * 72 + j] = (bf16_t)f2bf(kt); Rtl[t * 72 + j] = (bf16_t)f2bf(rv * eG);
                btn[i] = -bt; ktt[i] = kt;
                if (t == 63) glv[j] = eG;
            }
            *(LAS u32x4*)(BtTn + j * 72 + 8 * w) = (u32x4){pk2(btn[0], btn[1]), pk2(btn[2], btn[3]), pk2(btn[4], btn[5]), pk2(btn[6], btn[7])};
            *(LAS u32x4*)(KtT + j * 72 + 8 * w) = (u32x4){pk2(ktt[0], ktt[1]), pk2(ktt[2], ktt[3]), pk2(ktt[4], ktt[5]), pk2(ktt[6], ktt[7])};
        }
        __syncthreads();
        {
            for (int job = w; job < 64; job += NWAVES) {
                const int mat = job >> 4, bi = (job >> 2) & 3, bj = job & 3;
                LAS bf16_t* dst = (mat == 0) ? Aoff : (mat == 1 ? Mak : (mat == 2 ? Mrk : Mrbn));
                const int i = 16 * bi + fr, j0 = 16 * bj + 4 * fq;
                f32x4 o = {0.f, 0.f, 0.f, 0.f};
                if (bj <= bi) {
                    const LAS bf16_t* Aj = ((mat == 0 || mat == 3) ? Btl : Ktl) + bj * 16 * 72; const LAS bf16_t* Bi = ((mat < 2) ? At : Rtl) + bi * 16 * 72;
                    const f32x4 acc = mm_tile(Aj, 72, Bi, 72, 2, (f32x4){0.f, 0.f, 0.f, 0.f}, fr, fq);
                    const bool incl = mat >= 2;
                    o.x = (incl ? (j0 <= i) : (j0 < i)) ? acc.x : 0.f; o.y = (incl ? (j0 + 1 <= i) : (j0 + 1 < i)) ? acc.y : 0.f;
                    o.z = (incl ? (j0 + 2 <= i) : (j0 + 2 < i)) ? acc.z : 0.f; o.w = (incl ? (j0 + 3 <= i) : (j0 + 3 < i)) ? acc.w : 0.f;
                    if (mat == 0 && bi == bj) { LAS float* dd = Adg + (bi * 16 + fr) * 17 + 4 * fq; dd[0] = o.x; dd[1] = o.y; dd[2] = o.z; dd[3] = o.w; o = (f32x4){0.f, 0.f, 0.f, 0.f}; }
                    if (mat == 0 || mat == 3) o = -o;
                }
                lds_w4(dst + i * 72 + j0, o);
            }
#pragma unroll
            for (int q = 0; q < 2; ++q) { const int id = 2 * w + q, mi = id >> 2, nj = id & 3; const int j = nj * 16 + fr; const float gv[4] = {agate[q].x, agate[q].y, agate[q].z, agate[q].w};
#pragma unroll
                for (int rg = 0; rg < 4; ++rg) GB[(mi * 16 + 4 * fq + rg) * 64 + j] = (bf16_t)f2bf(gv[rg]); }
        }
        __syncthreads();
        f32x4 ot[4];
        if (w < 4) {
            {
                const int bb = lane >> 4, jj = lane & 15; float x[16]; const LAS float* a = Adg + bb * 16 * 17;
#pragma unroll
                for (int i = 0; i < 16; ++i) { float v = (i == jj) ? 1.f : 0.f;
#pragma unroll
                    for (int k = 0; k < i; ++k) v -= a[i * 17 + k] * x[k];
                    x[i] = v; Dg[(bb * 16 + i) * 24 + jj] = (bf16_t)f2bf(v); }
                asm volatile("s_waitcnt lgkmcnt(0)" ::: "memory");
            }
            const LAS bf16_t* Vw = Vt + (16 * w) * 72; const LAS bf16_t* Zw = Zt + (16 * w) * 72; LAS bf16_t* PUw = PU + (16 * w) * 72;
            f32x4 p[4];
#pragma unroll
            for (int mi = 0; mi < 4; ++mi) { p[mi] = mm_tile(At + mi * 16 * 72, 72, Zw, 72, 2, (f32x4){0.f, 0.f, 0.f, 0.f}, fr, fq); p[mi] = mm_tile(Mak + mi * 16 * 72, 72, Vw, 72, 2, p[mi], fr, fq); }
#pragma unroll
            for (int bb = 0; bb < 4; ++bb) {
                f32x4 acc = p[bb];
                if (bb >= 1) acc = mm_tile(Aoff + bb * 16 * 72, 72, PUw, 72, (bb + 1) / 2, acc, fr, fq);
                u32x2 pk; pk.x = pk2(acc.x, acc.y); pk.y = pk2(acc.z, acc.w);
                const bf16x4 dgf = *(const LAS bf16x4*)(Dg + (bb * 16 + fr) * 24 + 4 * fq);
                const f32x4 ub = MFMA16(dgf, __builtin_bit_cast(bf16x4, pk), ((f32x4){0.f, 0.f, 0.f, 0.f}));
                lds_w4(PUw + fr * 72 + 16 * bb + 4 * fq, ub);
                asm volatile("s_waitcnt lgkmcnt(0)" ::: "memory");
            }
#pragma unroll
            for (int mi = 0; mi < 4; ++mi) {
                f32x4 o = mm_tile(Rtl + mi * 16 * 72, 72, Zw, 72, 2, (f32x4){0.f, 0.f, 0.f, 0.f}, fr, fq);
                o = mm_tile(Mrk + mi * 16 * 72, 72, Vw, 72, 2, o, fr, fq);
                ot[mi] = mm_tile(Mrbn + mi * 16 * 72, 72, PUw, 72, 2, o, fr, fq);
            }
#pragma unroll
            for (int kb = 0; kb < 4; ++kb) {
                f32x4 zn = mm_tile(KtT + kb * 16 * 72, 72, Vw, 72, 2, zacc[kb], fr, fq);
                zn = mm_tile(BtTn + kb * 16 * 72, 72, PUw, 72, 2, zn, fr, fq);
                const f32x4 g4 = *(const LAS f32x4*)(glv + 16 * kb + 4 * fq);
                zn = zn * g4; zacc[kb] = zn;
                lds_w4(Zt + (16 * w + fr) * 72 + 16 * kb + 4 * fq, zn);
            }
        }
        __syncthreads();
        if (w < 4) {
#pragma unroll
            for (int mi = 0; mi < 4; ++mi) { LAS float* op = Of + (16 * mi + 4 * fq) * 65 + 16 * w + fr; op[0] = ot[mi].x; op[65] = ot[mi].y; op[130] = ot[mi].z; op[195] = ot[mi].w; }
        }
        __syncthreads();
        for (int t = w; t < 64; t += NWAVES) {
            const float o = Of[t * 65 + lane];
            const float mean = wsum(o) * (1.0f / 64.0f); const float dlt = o - mean; const float var = wsum(dlt * dlt) * (1.0f / 64.0f);
            float y = dlt * (rsqf_(var + 64e-5f)) * lnw + lnb;
            y += bonus[t] * bf2f(Vt[lane * 72 + t]);
            y *= bf2f(GB[t * 64 + lane]);
            P[(size_t)(t0 + t) * P0LD + 2048 + h * 64 + lane] = (bf16_t)f2bf(y);
        }
        __syncthreads();
    }
}

__device__ __forceinline__ void attn_phase(const Frame& F, const bf16_t* Q, const bf16_t* Kb, const bf16_t* VT, bf16_t* O) {
    const int lane = lane_id_v(); const int tid = F.wave * 64 + lane; (void)tid;
    const int fr = lane & 15, fq = lane >> 4;
    for (int u = F.wg; u < 512; u += F.G) {
        const int b = u >> 6, h = (u >> 4) & 3, qb = u & 15;
        const int q0 = b * TS + qb * 128 + F.wave * 16;
        bf16x8 bq[8];
#pragma unroll
        for (int ksx = 0; ksx < 8; ++ksx) bq[ksx] = *(const bf16x8*)(Q + (size_t)(q0 + fr) * 1024 + h * 256 + ksx * 32 + fq * 8);
        f32x4 sacc[16];
#pragma unroll
        for (int tl = 0; tl < 16; ++tl) {
            f32x4 a4 = {0.f, 0.f, 0.f, 0.f};
            const bf16_t* kp = Kb + (size_t)(b * 256 + tl * 16 + fr) * 1024 + h * 256 + fq * 8;
#pragma unroll
            for (int ksx = 0; ksx < 8; ++ksx) { const bf16x8 a = *(const bf16x8*)(kp + ksx * 32); a4 = __builtin_amdgcn_mfma_f32_16x16x32_bf16(a, bq[ksx], a4, 0, 0, 0); }
            sacc[tl] = a4;
        }
        float mx = -3.0e38f;
#pragma unroll
        for (int tl = 0; tl < 16; ++tl) mx = fmaxf(mx, fmaxf(fmaxf(sacc[tl].x, sacc[tl].y), fmaxf(sacc[tl].z, sacc[tl].w)));
        mx = fmaxf(mx, __shfl_xor(mx, 16)); mx = fmaxf(mx, __shfl_xor(mx, 32));
        float l = 0.f;
        bf16x8 pb[8];
#pragma unroll
        for (int ksx = 0; ksx < 8; ++ksx) {
            const f32x4 e0 = sacc[2 * ksx], e1 = sacc[2 * ksx + 1];
            const float p0 = __expf(e0.x - mx), p1 = __expf(e0.y - mx), p2 = __expf(e0.z - mx), p3 = __expf(e0.w - mx);
            const float p4 = __expf(e1.x - mx), p5 = __expf(e1.y - mx), p6 = __expf(e1.z - mx), p7 = __expf(e1.w - mx);
            l += ((p0 + p1) + (p2 + p3)) + ((p4 + p5) + (p6 + p7));
            u32x4 w; w.x = pk2(p0, p1); w.y = pk2(p2, p3); w.z = pk2(p4, p5); w.w = pk2(p6, p7);
            pb[ksx] = __builtin_bit_cast(bf16x8, w);
        }
        l += __shfl_xor(l, 16); l += __shfl_xor(l, 32);
        const float inv = rcpf_(l);
        const bf16_t* vbase = VT + (size_t)((b * 4 + h) * 256) * 256;
#pragma unroll 4
        for (int dt = 0; dt < 16; ++dt) {
            f32x4 o4 = {0.f, 0.f, 0.f, 0.f};
            const bf16_t* vp = vbase + (size_t)(dt * 16 + fr) * 256 + 4 * fq;
#pragma unroll
            for (int ksx = 0; ksx < 8; ++ksx) {
                const u32x2 lo = *(const u32x2*)(vp + ksx * 32), hi = *(const u32x2*)(vp + ksx * 32 + 16);
                u32x4 w; w.x = lo.x; w.y = lo.y; w.z = hi.x; w.w = hi.y;
                o4 = __builtin_amdgcn_mfma_f32_16x16x32_bf16(__builtin_bit_cast(bf16x8, w), pb[ksx], o4, 0, 0, 0);
            }
            u32x2 w; w.x = pk2(o4.x * inv, o4.y * inv); w.y = pk2(o4.z * inv, o4.w * inv);
            *(u32x2*)(O + (size_t)(q0 + fr) * 1024 + h * 256 + dt * 16 + 4 * fq) = w;
        }
    }
}

__device__ __forceinline__ void router_phase(const Frame& F, int layer) {
    const int lane = lane_id_v(); const int tid = F.wave * 64 + lane; (void)tid;
    const float* XF = F.out; const float* gain = F.in[IN_NORM_FFN] + layer * 1024;
    const float* wg = F.in[IN_MOE_WG] + (size_t)layer * 1024 * 4; const float* we = F.in[IN_MOE_WE] + (size_t)layer * 1024 * 16;
    const float* bg = F.in[IN_MOE_BG] + layer * 4; const float* be = F.in[IN_MOE_BE] + layer * 16;
    unsigned* cnt = (unsigned*)(F.ws + WS_CNT) + layer * 32;
    int* tokb = (int*)(F.ws + WS_ROUTE); int* tokp = tokb + NT; f32x4* tokg = (f32x4*)(tokp + NT);
    const int gw = F.wg * NWAVES + F.wave, NGW = F.G * NWAVES;
    for (int row = gw; row < NT; row += NGW) {
        const f32x4* xr = (const f32x4*)(XF + (size_t)row * 1024) + lane;
        float s = 0.f, lg[4], le[16];
#pragma unroll
        for (int c = 0; c < 4; ++c) lg[c] = 0.f;
#pragma unroll
        for (int c = 0; c < 16; ++c) le[c] = 0.f;
#pragma unroll 1
        for (int j = 0; j < 4; ++j) {
            const f32x4 v = xr[64 * j]; s += (v.x * v.x + v.y * v.y) + (v.z * v.z + v.w * v.w);
            const int k0 = 4 * lane + 256 * j; const f32x4 g = *(const f32x4*)(gain + k0);
            const float xv[4] = {v.x * g.x, v.y * g.y, v.z * g.z, v.w * g.w};
#pragma unroll
            for (int q = 0; q < 4; ++q) {
                const f32x4 a = *(const f32x4*)(wg + (size_t)(k0 + q) * 4);
                lg[0] += xv[q] * a.x; lg[1] += xv[q] * a.y; lg[2] += xv[q] * a.z; lg[3] += xv[q] * a.w;
#pragma unroll
                for (int e4 = 0; e4 < 4; ++e4) { const f32x4 w = *(const f32x4*)(we + (size_t)(k0 + q) * 16 + 4 * e4);
                    le[4 * e4] += xv[q] * w.x; le[4 * e4 + 1] += xv[q] * w.y; le[4 * e4 + 2] += xv[q] * w.z; le[4 * e4 + 3] += xv[q] * w.w; }
            }
        }
        s = wave_sum(s);
        const float rstd = rsqf_(s * (1.0f / 1024.0f) + 1e-6f);
#pragma unroll
        for (int c = 0; c < 4; ++c) lg[c] = wave_sum(lg[c]) * rstd + bg[c];
#pragma unroll
        for (int c = 0; c < 16; ++c) le[c] = wave_sum(le[c]) * rstd + be[c];
        int gs = 0; float gm = lg[0];
#pragma unroll
        for (int c = 1; c < 4; ++c) if (lg[c] > gm) { gm = lg[c]; gs = c; }
        float gz = 0.f;
#pragma unroll
        for (int c = 0; c < 4; ++c) gz += __expf(lg[c] - gm);
        const float ggate = 1.0f / gz;
        float l4[4];
#pragma unroll
        for (int c = 0; c < 4; ++c) { float v = le[c];
#pragma unroll
            for (int g2 = 1; g2 < 4; ++g2) v = (gs == g2) ? le[4 * g2 + c] : v;
            l4[c] = v; }
        int i0 = 0; float m0 = l4[0];
#pragma unroll
        for (int c = 1; c < 4; ++c) if (l4[c] > m0) { m0 = l4[c]; i0 = c; }
        int i1 = -1; float m1 = -3.0e38f;
#pragma unroll
        for (int c = 0; c < 4; ++c) if (c != i0 && l4[c] > m1) { m1 = l4[c]; i1 = c; }
        const float e1 = __expf(m1 - m0); const float g0 = ggate / (1.f + e1), g1 = ggate * e1 / (1.f + e1);
        const int ia = i0 < i1 ? i0 : i1, ib = i0 < i1 ? i1 : i0;
        const float ga = i0 < i1 ? g0 : g1, gb = i0 < i1 ? g1 : g0;
        const int pidx = (ia == 0) ? (ib - 1) : (ia == 1 ? ib + 1 : 5);
        const int bucket = gs * 6 + pidx;
        if (lane == 0) {
            const unsigned pos = atomicAdd(&cnt[bucket], 1u);
            tokb[row] = bucket; tokp[row] = (int)pos; tokg[row] = (f32x4){rstd, ga, gb, 0.f};
        }
    }
}
typedef float f32x16 __attribute__((ext_vector_type(16)));
__device__ __forceinline__ void router_phase2(const Frame& F, int layer) {
    const int lane = lane_id_v(); const int tid = F.wave * 64 + lane; const int w = F.wave;
    const float* XF = F.out; const float* rw = (const float*)(F.ws + WS_RW) + (size_t)layer * 1024 * 32;
    const float* ssp = (const float*)(F.ws + WS_SSP);
    unsigned* cnt = (unsigned*)(F.ws + WS_CNT) + layer * 32;
    int* tokb = (int*)(F.ws + WS_ROUTE); int* tokp = tokb + NT; f32x4* tokg = (f32x4*)(tokp + NT);
    LAS float* T = (LAS float*)F.lds + w * (32 * 132);
    LAS float* Pp = (LAS float*)F.lds;
    LAS float* Lg = Pp + 8 * 64 * 33;
    const int i31 = lane & 31, kh = lane >> 5, k0 = 128 * w;
    float bW[64];
#pragma unroll
    for (int s2 = 0; s2 < 64; ++s2) bW[s2] = rw[(size_t)(k0 + 2 * s2 + kh) * 32 + i31];
    for (int blk = F.wg; blk < NT / 64; blk += F.G) {
        const int r0 = blk * 64;
        f32x16 acc0, acc1;
#pragma unroll
        for (int e = 0; e < 16; ++e) { acc0[e] = 0.f; acc1[e] = 0.f; }
#pragma unroll
        for (int rt = 0; rt < 2; ++rt) {
#pragma unroll
            for (int n = 0; n < 16; ++n) { const int idx = lane + 64 * n, row = idx >> 5, c4 = idx & 31;
                const f32x4 v = *(const f32x4*)(XF + (size_t)(r0 + 32 * rt + row) * 1024 + k0 + 4 * c4);
                *(LAS f32x4*)(T + row * 132 + 4 * c4) = v; }
            asm volatile("s_waitcnt lgkmcnt(0)" ::: "memory");
#pragma unroll
            for (int s2 = 0; s2 < 64; ++s2) {
                const float a0 = T[i31 * 132 + 2 * s2 + kh];
                if (rt == 0) acc0 = __builtin_amdgcn_mfma_f32_32x32x2f32(a0, bW[s2], acc0, 0, 0, 0);
                else acc1 = __builtin_amdgcn_mfma_f32_32x32x2f32(a0, bW[s2], acc1, 0, 0, 0);
            }
            asm volatile("s_waitcnt lgkmcnt(0)" ::: "memory");
        }
        __syncthreads();
#pragma unroll
        for (int e = 0; e < 16; ++e) { const int row = (e & 3) + 8 * (e >> 2) + 4 * kh;
            Pp[(w * 64 + row) * 33 + i31] = acc0[e]; Pp[(w * 64 + 32 + row) * 33 + i31] = acc1[e]; }
        __syncthreads();
        for (int idx = tid; idx < 64 * 32; idx += NTHREADS) { const int row = idx >> 5, cc = idx & 31; float a = 0.f;
#pragma unroll
            for (int ww = 0; ww < 8; ++ww) a += Pp[(ww * 64 + row) * 33 + cc];
            Lg[row * 33 + cc] = a; }
        __syncthreads();
        if (tid < 64) {
            const int row = r0 + tid; const float rstd = row_rstd(ssp, row);
            const float* bg = F.in[IN_MOE_BG] + layer * 4; const float* be = F.in[IN_MOE_BE] + layer * 16;
            float lg[4], le[16];
#pragma unroll
            for (int c2 = 0; c2 < 4; ++c2) lg[c2] = Lg[tid * 33 + c2] * rstd + bg[c2];
#pragma unroll
            for (int c2 = 0; c2 < 16; ++c2) le[c2] = Lg[tid * 33 + 4 + c2] * rstd + be[c2];
            int gs = 0; float gm = lg[0];
#pragma unroll
            for (int c2 = 1; c2 < 4; ++c2) if (lg[c2] > gm) { gm = lg[c2]; gs = c2; }
            float gz = 0.f;
#pragma unroll
            for (int c2 = 0; c2 < 4; ++c2) gz += __expf(lg[c2] - gm);
            const float ggate = 1.0f / gz;
            float l4[4];
#pragma unroll
            for (int c2 = 0; c2 < 4; ++c2) { float v = le[c2];
#pragma unroll
                for (int g2 = 1; g2 < 4; ++g2) v = (gs == g2) ? le[4 * g2 + c2] : v;
                l4[c2] = v; }
            int i0 = 0; float m0 = l4[0];
#pragma unroll
            for (int c2 = 1; c2 < 4; ++c2) if (l4[c2] > m0) { m0 = l4[c2]; i0 = c2; }
            int i1 = -1; float m1 = -3.0e38f;
#pragma unroll
            for (int c2 = 0; c2 < 4; ++c2) if (c2 != i0 && l4[c2] > m1) { m1 = l4[c2]; i1 = c2; }
            const float e1 = __expf(m1 - m0); const float g0 = ggate / (1.f + e1), g1 = ggate * e1 / (1.f + e1);
            const int ia = i0 < i1 ? i0 : i1, ib = i0 < i1 ? i1 : i0;
            const float ga = i0 < i1 ? g0 : g1, gb = i0 < i1 ? g1 : g0;
            const int pidx = (ia == 0) ? (ib - 1) : (ia == 1 ? ib + 1 : 5);
            const int bucket = gs * 6 + pidx;
            const unsigned pos = atomicAdd(&cnt[bucket], 1u);
            tokb[row] = bucket; tokp[row] = (int)pos; tokg[row] = (f32x4){rstd, ga, gb, 0.f};
        }
        __syncthreads();
    }
}
__device__ __forceinline__ void gather_phase(const Frame& F, int layer) {
    const int lane = lane_id_v(); const int tid = F.wave * 64 + lane; (void)tid;
    const unsigned* cnt = (const unsigned*)(F.ws + WS_CNT) + layer * 32;
    const int* tokb = (const int*)(F.ws + WS_ROUTE); const int* tokp = tokb + NT; const f32x4* tokg = (const f32x4*)(tokp + NT); f32x4* rowinfo = (f32x4*)(tokg + NT);
    const bf16_t* XB = (const bf16_t*)(F.ws + WS_XB); bf16_t* XG = (bf16_t*)(F.ws + WS_BIG + BIG_XG);
    LAS int* off = (LAS int*)F.lds;
    if (tid == 0) { int acc = 0; for (int b = 0; b < 24; ++b) { off[b] = acc * 256; acc += ((int)cnt[b] + 255) >> 8; } }
    __syncthreads();
    const int gw = F.wg * NWAVES + F.wave, NGW = F.G * NWAVES;
    for (int tok = gw; tok < NT; tok += NGW) {
        const int row = off[tokb[tok]] + tokp[tok];
        const u32x4* src = (const u32x4*)(XB + (size_t)tok * 1024) + lane; u32x4* dst = (u32x4*)(XG + (size_t)row * 1024) + lane;
        dst[0] = src[0]; dst[64] = src[64];
        if (lane == 0) { f32x4 g = tokg[tok]; g.w = __int_as_float(tok); rowinfo[row] = g; }
    }
    __syncthreads();
}
__device__ __forceinline__ void final_phase(const Frame& F) {
    const int lane = lane_id_v(); const int tid = F.wave * 64 + lane; (void)tid;
    float* XF = F.out; const float* gain = F.in[IN_NORM_FINAL];
    const int gw = F.wg * NWAVES + F.wave, NGW = F.G * NWAVES;
    for (int row = gw; row < NT; row += NGW) {
        f32x4* xr = (f32x4*)(XF + (size_t)row * 1024) + lane;
        f32x4 v[4]; float s = 0.f;
#pragma unroll
        for (int j = 0; j < 4; ++j) { v[j] = xr[64 * j]; s += (v[j].x * v[j].x + v[j].y * v[j].y) + (v[j].z * v[j].z + v[j].w * v[j].w); }
        s = wave_sum(s);
        const float rstd = rsqf_(s * (1.0f / 1024.0f) + 1e-6f);
#pragma unroll
        for (int j = 0; j < 4; ++j) { const f32x4 g = *(const f32x4*)(gain + 4 * lane + 256 * j); xr[64 * j] = v[j] * rstd * g; }
    }
}

constexpr int N_PHASES = 24;
#ifndef PH_MASK
#define PH_MASK 0xFFFFFFFFu
#endif
#define IN(k) (((PH_MASK >> ((k) > 11 ? (k) - 11 : (k))) & 1u) && lo <= (k) && (k) < hi)
#define TS_STAMP(k) do { if (TS_A >= 0 && ((k) == TS_A || (k) == TS_B) && F.wg == 0 && F.wave == 0 && lane_id_v() == 0) ((volatile LAS unsigned*)(F.lds + LDS_MISC + 1024))[(k)] = (unsigned)__builtin_amdgcn_s_memrealtime(); } while (0)
#define SEAM(k) do { if (IN(k) && IN((k) + 1)) xcd_barrier(bar); TS_STAMP((k) + 1); } while (0)

template <int LAYER>
__device__ __forceinline__ void layer_phases(const Frame& F, const XcdBarrier& bar, const int lo, const int hi) {
    constexpr int pb = LAYER * 11;
    unsigned char* const ws = F.ws;
#define WPTR(off) ((bf16_t*)(ws + (LAYER ? WS_W1 : WS_W0)) + (off))
#define XB_ ((bf16_t*)(ws + WS_XB))
#define SSP_ ((float*)(ws + WS_SSP))
#define PROJ_ ((bf16_t*)(ws + WS_BIG + BIG_PROJ))
#define KB_ (LAYER ? (bf16_t*)(ws + WS_W0) : (bf16_t*)(ws + WS_BIG + BIG_KV0))
#define VT_ (KB_ + (size_t)2048 * 1024)
#define QB_ ((bf16_t*)(ws + WS_BIG + BIG_Q))
#define ATT_ ((bf16_t*)(ws + WS_BIG + BIG_ATT))
#define XG_ ((bf16_t*)(ws + WS_BIG + BIG_XG))
#define HID_ ((bf16_t*)(ws + WS_BIG + BIG_HID))
#define CNT_ ((const unsigned*)(ws + WS_CNT) + LAYER * 32)
#define ROWINFO_ ((const f32x4*)(ws + WS_ROUTE + (size_t)NT * 8 + (size_t)NT * 16))
    if (IN(pb + 1)) {
        if (LAYER == 0) {
            pg8::Gemm g{1024, 1024, 1024, 1 << 20}; pg8::DenseSched S; S.init(NT, 3840, F.G, F.wg, XB_, 1024, WPTR(WO_WIN), 1024);
            EpiScale<0> E{PROJ_, P0LD, SSP_, 1.0f, nullptr};
            pg8::gemm_phase(F.lds, F.wave, g, S, E);
        } else {
            pg8::Gemm g{1024, 1024, 1024, 1 << 20}; pg8::DenseSched S; S.init(NT, 4096, F.G, F.wg, XB_, 1024, WPTR(WO_WIN), 1024);
            EpiScale<1> E{PROJ_, P1LD, SSP_, 1.0f, (const float*)(ws + WS_LB)};
            pg8::gemm_phase(F.lds, F.wave, g, S, E);
        }
        if (LAYER == 1) { pg8::Gemm g{1024, 1024, 1024, 1 << 20}; pg8::DenseSched S; S.init(2048, 2048, F.G, F.wg, (const bf16_t*)(ws + WS_MEMH), 1024, WPTR(WO_WKV), 1024);
          EpiKV E{KB_, VT_}; pg8::gemm_phase(F.lds, F.wave, g, S, E); }
    }
    SEAM(pb + 1);
    if (IN(pb + 2)) {
        unsigned pt0 = 0; if (PROBE_WG >= 0 && LAYER == 0) pt0 = (unsigned)__builtin_amdgcn_s_memrealtime();
        if (LAYER == 0) {
#ifndef NO_DELTA
            if (F.wg < 32) scan_delta3(F, F.wg >> 2, F.wg & 3);
#endif
#ifndef NO_RWKV
            if (F.wg >= 32 && F.wg < 96) scan_rwkv3(F, (F.wg - 32) >> 3, (F.wg - 32) & 7);
#endif
            if (F.wg >= 96) p0_late_weights(F, F.wg - 96, F.G - 96);
        } else {
#ifndef NO_HGRN
            if (F.wg < 64) scan_hgrn3(F, F.wg >> 3, F.wg & 7);
#endif
        }
        if (PROBE_WG >= 0 && LAYER == 0 && F.wg == PROBE_WG && F.wave == 0 && lane_id_v() == 0) __hip_atomic_store((unsigned*)(F.ws + WS_CTL + 20480), (unsigned)__builtin_amdgcn_s_memrealtime() - pt0, __ATOMIC_RELAXED, __HIP_MEMORY_SCOPE_AGENT);
    }
    SEAM(pb + 2);
    SEAM(pb + 3);
    if (IN(pb + 4)) {
        constexpr int lda = LAYER ? P1LD : P0LD; const bf16_t* A = PROJ_ + (LAYER ? 3072 : 1536);
        pg8::Gemm g{lda, 1024, 1024, 1 << 20}; pg8::DenseSched S; S.init(NT, 1024, F.G, F.wg, A, lda, WPTR(WO_WOUT), 1024);
        EpiResid<false> E{LAYER ? (const float*)F.out : F.in[IN_X], F.out, XB_, SSP_, nullptr};
        pg8::gemm_phase(F.lds, F.wave, g, S, E);
    }
    SEAM(pb + 4);
    if (IN(pb + 5)) {
        pg8::Gemm g{1024, 1024, 1024, 1 << 20}; pg8::DenseSched S; S.init(NT, 1024, F.G, F.wg, XB_, 1024, WPTR(WO_WQ), 1024);
        EpiScale<0> E{QB_, 1024, SSP_, 0.0625f, nullptr};
        pg8::gemm_phase(F.lds, F.wave, g, S, E);
        if (LAYER == 0) { pg8::Gemm g2{1024, 1024, 1024, 1 << 20}; pg8::DenseSched S2; S2.init(2048, 2048, F.G, F.wg, (const bf16_t*)(ws + WS_MEMH), 1024, WPTR(WO_WKV), 1024);
          EpiKV E2{KB_, VT_}; pg8::gemm_phase(F.lds, F.wave, g2, S2, E2); }
    }
    SEAM(pb + 5);
    if (IN(pb + 6)) attn_phase(F, QB_, KB_, VT_, ATT_);
    SEAM(pb + 6);
    if (IN(pb + 7)) {
        pg8::Gemm g{1024, 1024, 1024, 1 << 20}; pg8::DenseSched S; S.init(NT, 1024, F.G, F.wg, ATT_, 1024, WPTR(WO_WO), 1024);
        EpiResid<false> E{F.out, F.out, XB_, SSP_, nullptr};
        pg8::gemm_phase(F.lds, F.wave, g, S, E);
    }
    SEAM(pb + 7);
    if (IN(pb + 8)) router_phase2(F, LAYER);
    SEAM(pb + 8);
    if (IN(pb + 9)) gather_phase(F, LAYER);
    SEAM(pb + 9);
    if (IN(pb + 10)) {
        LAS int* tbl = (LAS int*)(F.lds + LDS_MISC + 512); moe_build_table(tbl, CNT_, F.wave * 64 + lane_id_v());
        pg8::Gemm g{1024, 1024, 1024, 1 << 20}; MoeSched<false> S{tbl, __builtin_amdgcn_readfirstlane(tbl[95]), F.G, F.wg, (const char*)XG_, (const char*)WPTR(WO_W13)};
        EpiMoeUp E{HID_, ROWINFO_};
        pg8::gemm_phase(F.lds, F.wave, g, S, E);
    }
    SEAM(pb + 10);
    if (IN(pb + 11)) {
        LAS int* tbl = (LAS int*)(F.lds + LDS_MISC + 512); moe_build_table(tbl, CNT_, F.wave * 64 + lane_id_v());
        pg8::Gemm g{512, 256, 512, 4}; MoeSched<true> S{tbl, __builtin_amdgcn_readfirstlane(tbl[95]), F.G, F.wg, (const char*)HID_, (const char*)WPTR(WO_W2T)};
        EpiResid<true> E{F.out, F.out, XB_, SSP_, ROWINFO_};
        pg8::gemm_phase(F.lds, F.wave, g, S, E);
    }
    SEAM(pb + 11);
}

__global__ void __launch_bounds__(NTHREADS, 2) fwd_mega(Args args) {
    extern __shared__ __attribute__((aligned(16))) unsigned char lds_raw[];
    Frame F;
    F.lds = (LAS unsigned char*)lds_raw;
    const int tid = threadIdx.x; F.wave = __builtin_amdgcn_readfirstlane(tid >> 6);
    F.G = gridDim.x; F.wg = blockIdx.x;
    F.out = args.out; F.ws = args.ws;
    volatile LAS unsigned* MISC = (volatile LAS unsigned*)(F.lds + LDS_MISC);
    LAS unsigned long long* tab = (LAS unsigned long long*)(F.lds + LDS_MISC + 64);
    F.in.t = tab;
    if (tid < 16) MISC[tid] = 0u;
    if (tid == 0) {
#pragma unroll
        for (int i = 0; i < 38; ++i) tab[i] = (unsigned long long)args.in[i];
    }
    __syncthreads();
    XcdBarrier bar; bar.bar = (unsigned*)(F.ws + WS_CTL); bar.x = 0; bar.st = MISC; bar.wave = F.wave;
#if N_LAUNCH_MODE == 1
    bar = xcd_barrier_post((unsigned*)(F.ws + WS_CTL), MISC, F.wave);
#endif
    const int lo = args.ph_lo, hi = args.ph_hi;
    TS_STAMP(0);
    if (IN(0)) { p0_prologue(F); }
    SEAM(0);
    layer_phases<0>(F, bar, lo, hi);
    layer_phases<1>(F, bar, lo, hi);
    if (IN(23)) final_phase(F);
    if (TS_A >= 0 && F.wg == 0 && F.wave == 0) {
        asm volatile("s_waitcnt vmcnt(0)" ::: "memory");
        if (lane_id_v() == 0) { volatile LAS unsigned* ts = (volatile LAS unsigned*)(F.lds + LDS_MISC + 1024);
            float us = (float)(ts[TS_B] - ts[TS_A]) * 0.01f;
            if (PROBE_WG >= 0) us = (float)__hip_atomic_load((unsigned*)(F.ws + WS_CTL + 20480), __ATOMIC_RELAXED, __HIP_MEMORY_SCOPE_AGENT) * 0.01f;
            if (PROBE_STAGE >= 0) us = (float)__hip_atomic_load((unsigned*)(F.ws + WS_CTL + 20484), __ATOMIC_RELAXED, __HIP_MEMORY_SCOPE_AGENT) * 0.01f;
            F.out[0] = F.out[0] + us * TS_SCALE; }
    }
}
#undef IN
#undef SEAM

extern "C" void kernel_launch(void* const* d_in, const int* in_sizes, int n_in, void* d_out, int out_size, void* d_ws, size_t ws_size, hipStream_t stream) {
    static int grid = 0;
    if (grid == 0) {
        if (n_in != 38 || out_size != NT * DM || ws_size < WS_END) { fprintf(stderr, "kernel_launch: unexpected problem (n_in %d out %d ws %zu)\n", n_in, out_size, ws_size); grid = -1; return; }
        int dev = 0, cus = 0, per_cu = 0;
        if (hipGetDevice(&dev) != hipSuccess || hipDeviceGetAttribute(&cus, hipDeviceAttributeMultiprocessorCount, dev) != hipSuccess) { grid = -1; return; }
        if (hipFuncSetAttribute((const void*)fwd_mega, hipFuncAttributeMaxDynamicSharedMemorySize, LDS_BYTES) != hipSuccess) { fprintf(stderr, "kernel_launch: hipFuncSetAttribute failed\n"); grid = -1; return; }
        if (hipOccupancyMaxActiveBlocksPerMultiprocessor(&per_cu, (const void*)fwd_mega, NTHREADS, LDS_BYTES) != hipSuccess || per_cu < 1) { fprintf(stderr, "kernel_launch: occupancy query says %d\n", per_cu); (void)hipGetLastError(); grid = -1; return; }
        grid = cus;
    }
    if (grid < 0) return;
    (void)hipMemsetAsync((char*)d_ws + WS_CTL, 0, 32768, stream);
    Args a{};
    for (int i = 0; i < 38; ++i) a.in[i] = (const float*)d_in[i];
    a.out = (float*)d_out; a.ws = (unsigned char*)d_ws;
#if N_LAUNCH_MODE == 1
    a.ph_lo = 0; a.ph_hi = N_PHASES;
    void* kargs[] = {&a};
    hipError_t e = hipLaunchCooperativeKernel((const void*)fwd_mega, dim3(grid), dim3(NTHREADS), kargs, LDS_BYTES, stream);
    if (e != hipSuccess) fprintf(stderr, "kernel_launch: cooperative launch failed: %s\n", hipGetErrorString(e));
#else
    for (int p = 0; p < N_PHASES; ++p) { a.ph_lo = p; a.ph_hi = p + 1; hipLaunchKernelGGL(fwd_mega, dim3(grid), dim3(NTHREADS), LDS_BYTES, stream, a); }
#endif
}
```

```cpp
#include <hip/hip_runtime.h>
#include <cstdio>
#include <cstdint>

#ifndef N_LAUNCH_MODE
#define N_LAUNCH_MODE 1
#endif

#ifndef TS_A
#define TS_A -1
#endif
#ifndef TS_B
#define TS_B 0
#endif
#ifndef PROBE_WG
#define PROBE_WG -1
#endif
#ifndef PROBE_STAGE
#define PROBE_STAGE -1
#endif
#ifndef TS_SCALE
#define TS_SCALE 0.01f
#endif

#define LAS __attribute__((address_space(3)))
#define GAS __attribute__((address_space(1)))
typedef unsigned short bf16_t;
typedef short bf16x8 __attribute__((ext_vector_type(8)));
typedef short bf16x4 __attribute__((ext_vector_type(4)));
typedef float f32x4 __attribute__((ext_vector_type(4)));
typedef float f32x2 __attribute__((ext_vector_type(2)));
typedef unsigned u32x4 __attribute__((ext_vector_type(4)));
typedef unsigned u32x2 __attribute__((ext_vector_type(2)));

constexpr int NT = 16384, DM = 1024, NB = 8, TS = 2048, NMEM = 256;
constexpr int P0LD = 3840;
constexpr int P1LD = 4096;
constexpr int NTHREADS = 512, NWAVES = 8;

constexpr size_t MiB = 1048576;
constexpr size_t WS_CTL = 0;
constexpr size_t WS_CNT = 16384;
constexpr size_t WS_LB = 32768;
constexpr size_t WS_DB = 1 * MiB;
constexpr size_t WS_SSP = WS_DB + 512 * 1024;
constexpr size_t WS_MEMH = WS_SSP + 1 * MiB;
constexpr size_t WS_ROUTE = WS_MEMH + 4 * MiB;
constexpr size_t WS_LORA = WS_ROUTE + 800 * 1024;
constexpr size_t WS_RW = WS_LORA + 256 * 1024;
constexpr size_t WS_W0 = 8 * MiB;
static_assert(WS_RW + 2 * 1024 * 32 * 4 <= 8 * MiB, "small weights");
constexpr size_t WS_W1 = WS_W0 + 42 * MiB;
constexpr size_t WS_XB = 92 * MiB;
constexpr size_t WS_BIG = 124 * MiB;
constexpr size_t WS_END = 256 * MiB;
constexpr size_t WO_WIN = 0;
constexpr size_t WO_WOUT = WO_WIN + (size_t)4096 * 1024;
constexpr size_t WO_WQ = WO_WOUT + (size_t)1024 * 1024;
constexpr size_t WO_WKV = WO_WQ + (size_t)1024 * 1024;
constexpr size_t WO_WO = WO_WKV + (size_t)2048 * 1024;
constexpr size_t WO_W13 = WO_WO + (size_t)1024 * 1024;
constexpr size_t WO_W2T = WO_W13 + (size_t)16 * 512 * 1024;
constexpr size_t WO_END = WO_W2T + (size_t)16 * 1024 * 256;
static_assert(WO_END * 2 <= 42 * MiB, "weight region");
constexpr size_t BIG_PROJ = 0;
constexpr size_t BIG_KV0 = 120 * MiB;
constexpr size_t BIG_Q = 0;
constexpr size_t BIG_ATT = 32 * MiB;
constexpr size_t BIG_XG = 0;
constexpr size_t BIG_HID = 48 * MiB;
constexpr int MOE_MAXROWS = 22528;

__device__ __forceinline__ unsigned f2bf(float f) { unsigned u = __float_as_uint(f); u += 0x7fffu + ((u >> 16) & 1u); return u >> 16; }
__device__ __forceinline__ float bf2f(unsigned short b) { return __uint_as_float((unsigned)b << 16); }
__device__ __forceinline__ unsigned pk2(float lo, float hi) { return f2bf(lo) | (f2bf(hi) << 16); }
__device__ __forceinline__ float wave_sum(float v) {
#pragma unroll
    for (int o = 1; o < 64; o <<= 1) v += __shfl_xor(v, o);
    return v;
}
__device__ __forceinline__ float sigmoidf_(float x) { return 1.f / (1.f + __expf(-x)); }
__device__ __forceinline__ float siluf_(float x) { return x / (1.f + __expf(-x)); }
__device__ __forceinline__ float softplusf_(float x) { return x > 20.f ? x : log1pf(__expf(x)); }
__device__ __forceinline__ int lane_id_v() { int l; asm volatile("v_mbcnt_lo_u32_b32 %0, -1, 0\n\tv_mbcnt_hi_u32_b32 %0, -1, %0" : "=v"(l)); return l; }
#define LDS_WAIT() asm volatile("s_waitcnt lgkmcnt(0)" ::: "memory")
#define VM_WAIT() asm volatile("s_waitcnt vmcnt(0)" ::: "memory")

namespace pg8 {
constexpr int BM = 256, BK = 64, HALF = 128, HTB = HALF * BK * 2, STAGE_BYTES = 8 * HTB;
__host__ __device__ __forceinline__ int lds_byte(int r, int c) { const int st = (r >> 4) * 2 + (c >> 5), rr = r & 15, cc = c & 31, ob = rr * 64 + cc * 2; return st * 1024 + (ob ^ (((ob >> 9) & 1) << 5)); }
__host__ __device__ __forceinline__ void stage_rc(int b, int& R, int& C) { const int st = b / 1024, sb = b % 1024, swz = sb ^ (((sb >> 9) & 1) << 5); R = (st >> 1) * 16 + swz / 64; C = (st & 1) * 32 + (swz % 64) / 2; }

struct Unit { int pm, pn, aux; const char* a; const char* b0; const char* b1; };
struct Gemm { int lda, ldb, K, ksplit; };

template <class Epi, class Sched>
__device__ __forceinline__ void gemm_phase(LAS unsigned char* lds, const int wave_in, const Gemm g, const Sched& S, const Epi& E) {
    const int wid = wave_in, lane = lane_id_v(), tid = wid * 64 + lane, wr = wid >> 2, wc = wid & 3, fr = lane & 15, fq = lane >> 4;
    const int K = g.K, nt = K / BK, ks = g.ksplit;
    unsigned voffA[2], voffB[2];
#pragma unroll
    for (int i = 0; i < 2; ++i) { int R, C; stage_rc(tid * 16 + i * 8192, R, C);
        voffA[i] = (unsigned)(R * g.lda + C) * 2u; voffB[i] = (unsigned)(R * g.ldb + C) * 2u; }
    const size_t kstep = (size_t)(BK * 2);
    const size_t hstepA = (size_t)HALF * g.lda * 2, hstepB = (size_t)HALF * g.ldb * 2;
    const unsigned ldsw = (unsigned)wid * 1024u;
    const int aoff = lds_byte(wr * 64 + fr, fq * 8), boff = lds_byte(wc * 32 + fr, fq * 8);
#define PG8_SA(b, h) (((b) * 2 + (h)) * HTB)
#define PG8_SB(b, h) ((4 + (b) * 2 + (h)) * HTB)
#define PG8_STAGE(bufoff, gbase, voff) do { _Pragma("unroll") for (int _i = 0; _i < 2; ++_i) \
        __builtin_amdgcn_global_load_lds((const unsigned*)((const char*)(gbase) + (voff)[_i]), (LAS unsigned*)(lds + (bufoff) + ldsw + _i * 8192), 16, 0, 0); } while (0)
#define PG8_LDA(dst, b, h) do { _Pragma("unroll") for (int m = 0; m < 4; ++m) _Pragma("unroll") for (int k = 0; k < 2; ++k) dst[m][k] = *(const LAS bf16x8*)(lds + PG8_SA(b, h) + aoff + m * 2048 + k * 1024); } while (0)
#define PG8_LDB(dst, b, h) do { _Pragma("unroll") for (int n = 0; n < 2; ++n) _Pragma("unroll") for (int k = 0; k < 2; ++k) dst[n][k] = *(const LAS bf16x8*)(lds + PG8_SB(b, h) + boff + n * 2048 + k * 1024); } while (0)
#define PG8_MMA(ai, bj, At, Bt) do { __builtin_amdgcn_s_setprio(1); _Pragma("unroll") for (int m = 0; m < 4; ++m) _Pragma("unroll") for (int n = 0; n < 2; ++n) _Pragma("unroll") for (int k = 0; k < 2; ++k) \
        acc[ai][bj][m][n] = __builtin_amdgcn_mfma_f32_16x16x32_bf16(Bt[n][k], At[m][k], acc[ai][bj][m][n], 0, 0, 0); __builtin_amdgcn_s_setprio(0); } while (0)
#define PG8_WAIT_V(n) asm volatile("s_waitcnt vmcnt(" #n ")" ::: "memory")
#define PG8_WAIT_L(n) asm volatile("s_waitcnt lgkmcnt(" #n ")" ::: "memory")
#define PG8_BAR __builtin_amdgcn_s_barrier()
#define PG8_SCHED __builtin_amdgcn_sched_barrier(0)
    Unit cur, nxt; int ui = 0;
    if (!S.next(0, cur)) return;
    f32x4 acc[2][2][4][2];
#pragma unroll
    for (int a = 0; a < 2; ++a)
#pragma unroll
        for (int b = 0; b < 2; ++b)
#pragma unroll
            for (int m = 0; m < 4; ++m)
#pragma unroll
                for (int n = 0; n < 2; ++n) acc[a][b][m][n] = (f32x4){0.f, 0.f, 0.f, 0.f};
    bf16x8 At[4][2], B0[2][2], B1[2][2];
    const char* cA = cur.a; const char* cB = cur.b0; const char* cB1 = cur.b1;
    PG8_STAGE(PG8_SB(0, 0), cB, voffB); PG8_STAGE(PG8_SB(0, 1), cB + hstepB, voffB); PG8_STAGE(PG8_SA(0, 0), cA, voffA); PG8_STAGE(PG8_SA(0, 1), cA + hstepA, voffA);
    if (wr == 1) PG8_BAR;
    PG8_WAIT_V(2); PG8_BAR;
    PG8_STAGE(PG8_SB(1, 0), cB + kstep, voffB); PG8_STAGE(PG8_SA(1, 0), cA + kstep, voffA); PG8_STAGE(PG8_SB(1, 1), cB + hstepB + kstep, voffB);
    PG8_WAIT_V(6); PG8_BAR;
    for (;;) {
        const bool has_next = S.next(ui + 1, nxt);
        const char* nA = has_next ? nxt.a : cA; const char* nB = has_next ? nxt.b0 : cB;
        for (int t = 0; t < nt; t += 2) {
            const bool last = (t == nt - 2);
            const char* a1 = cA + (size_t)(t + 1) * kstep;
            const char* a2 = last ? nA : cA + (size_t)(t + 2) * kstep;
            const char* b2 = last ? nB : ((t + 2) < ks ? cB + (size_t)(t + 2) * kstep : cB1 + (size_t)(t + 2 - ks) * kstep);
            const char* a3 = a2 + kstep; const char* b3 = b2 + kstep;
            PG8_LDB(B0, 0, 0); PG8_LDB(B1, 0, 1); PG8_SCHED; PG8_LDA(At, 0, 0); PG8_STAGE(PG8_SA(1, 1), a1 + hstepA, voffA);
            PG8_WAIT_V(8); PG8_WAIT_L(0); PG8_BAR; PG8_MMA(0, 0, At, B0); PG8_MMA(0, 1, At, B1); PG8_BAR; PG8_SCHED;
            PG8_LDA(At, 0, 1); PG8_STAGE(PG8_SB(0, 0), b2, voffB); PG8_STAGE(PG8_SB(0, 1), b2 + hstepB, voffB); PG8_STAGE(PG8_SA(0, 0), a2, voffA);
            PG8_WAIT_V(8); PG8_WAIT_L(0); PG8_BAR; PG8_MMA(1, 0, At, B0); PG8_MMA(1, 1, At, B1); PG8_BAR; PG8_SCHED;
            PG8_LDB(B0, 1, 0); PG8_LDB(B1, 1, 1); PG8_SCHED; PG8_LDA(At, 1, 0); PG8_STAGE(PG8_SA(0, 1), a2 + hstepA, voffA);
            PG8_WAIT_V(8); PG8_WAIT_L(0); PG8_BAR; PG8_MMA(0, 0, At, B0); PG8_MMA(0, 1, At, B1); PG8_BAR; PG8_SCHED;
            PG8_LDA(At, 1, 1); PG8_STAGE(PG8_SB(1, 0), b3, voffB); PG8_STAGE(PG8_SB(1, 1), b3 + hstepB, voffB); PG8_STAGE(PG8_SA(1, 0), a3, voffA);
            PG8_WAIT_V(8); PG8_WAIT_L(0); PG8_BAR; PG8_MMA(1, 0, At, B0); PG8_MMA(1, 1, At, B1); PG8_BAR; PG8_SCHED;
        }
        if (wr == 0) PG8_BAR;
        E(acc, cur, wr, wc, fr, fq);
        if (!has_next) break;
#pragma unroll
        for (int a = 0; a < 2; ++a)
#pragma unroll
            for (int b = 0; b < 2; ++b)
#pragma unroll
                for (int m = 0; m < 4; ++m)
#pragma unroll
                    for (int n = 0; n < 2; ++n) acc[a][b][m][n] = (f32x4){0.f, 0.f, 0.f, 0.f};
        cur = nxt; cA = nA; cB = nB; cB1 = nxt.b1; ++ui;
        if (wr == 1) PG8_BAR;
    }
    PG8_WAIT_V(0);
    PG8_BAR;
#undef PG8_SA
#undef PG8_SB
#undef PG8_STAGE
#undef PG8_LDA
#undef PG8_LDB
#undef PG8_MMA
#undef PG8_WAIT_V
#undef PG8_WAIT_L
#undef PG8_BAR
#undef PG8_SCHED
}

struct DenseSched {
    int nM, nN, nwg, G, c; const char* A; const char* B; size_t tA, tB;
    __device__ void init(int M, int N, int G_, int c_, const bf16_t* A_, int lda, const bf16_t* B_, int ldb) { nM = M / 256; nN = N / 256; nwg = nM * nN; G = G_; c = c_; A = (const char*)A_; B = (const char*)B_; tA = (size_t)256 * lda * 2; tB = (size_t)256 * ldb * 2; }
    __device__ bool next(int i, Unit& u) const {
        const long L = (long)i * G + c; if (L >= nwg) return false;
        int wgid = (int)L; { const int q = nwg / 8, r = nwg % 8, xcd = wgid % 8, off = wgid / 8; wgid = (xcd < r ? xcd * (q + 1) : r * (q + 1) + (xcd - r) * q) + off; }
        const int nig = 8 * nN, gid = wgid / nig, fm = gid * 8, gsz = (nM - fm) < 8 ? (nM - fm) : 8;
        u.pm = fm + ((wgid % nig) % gsz); u.pn = (wgid % nig) / gsz; u.aux = 256;
        u.a = A + (size_t)u.pm * tA; u.b0 = B + (size_t)u.pn * tB; u.b1 = u.b0; return true;
    }
};
}
using pg8::Unit;

__device__ __forceinline__ float row_rstd(const float* ssp, int row) {
    const f32x4* p = (const f32x4*)(ssp + (size_t)row * 16);
    const f32x4 a = p[0], b = p[1], c = p[2], d = p[3];
    const float s = ((a.x + a.y) + (a.z + a.w)) + ((b.x + b.y) + (b.z + b.w)) + ((c.x + c.y) + (c.z + c.w)) + ((d.x + d.y) + (d.z + d.w));
    return 1.0f / sqrtf(s * (1.0f / 1024.0f) + 1e-6f);
}
__device__ __forceinline__ unsigned short f2h_bits(float f) { _Float16 h = (_Float16)f; return __builtin_bit_cast(unsigned short, h); }
__device__ __forceinline__ float h2f_bits(unsigned short b) { return (float)__builtin_bit_cast(_Float16, b); }

template <int MODE> struct EpiScale {
    bf16_t* O; int ldc; const float* ssp; float scale; const float* lb;
    __device__ __forceinline__ void operator()(const f32x4 (&acc)[2][2][4][2], const Unit& u, int wr, int wc, int fr_in, int fq_in) const {
        int fr = fr_in, fq = fq_in; asm volatile("" : "+v"(fr), "+v"(fq));
#pragma unroll
        for (int ai = 0; ai < 2; ++ai)
#pragma unroll
            for (int m = 0; m < 4; ++m) {
                const int row = u.pm * 256 + ai * 128 + wr * 64 + m * 16 + fr;
                const float rs = (MODE == 2) ? scale : row_rstd(ssp, row) * scale;
#pragma unroll
                for (int bj = 0; bj < 2; ++bj)
#pragma unroll
                    for (int n = 0; n < 2; ++n) {
                        const int col = u.pn * 256 + bj * 128 + wc * 32 + n * 16 + fq * 4;
                        f32x4 v = acc[ai][bj][m][n] * rs;
                        u32x2 w;
                        if (MODE == 1) {
                            const int blk = col >> 10;
                            if (blk == 0) { v.x = siluf_(v.x); v.y = siluf_(v.y); v.z = siluf_(v.z); v.w = siluf_(v.w); }
                            if (blk == 1) {
                                const f32x4 l = *(const f32x4*)(lb + (col - 1024));
                                float o[4]; const float vv[4] = {v.x, v.y, v.z, v.w}; const float ll[4] = {l.x, l.y, l.z, l.w};
#pragma unroll
                                for (int j = 0; j < 4; ++j) o[j] = __logf(ll[j] + (1.f - ll[j]) * sigmoidf_(vv[j]));
                                w.x = (unsigned)f2h_bits(o[0]) | ((unsigned)f2h_bits(o[1]) << 16); w.y = (unsigned)f2h_bits(o[2]) | ((unsigned)f2h_bits(o[3]) << 16);
                            } else { w.x = pk2(v.x, v.y); w.y = pk2(v.z, v.w); }
                        } else { w.x = pk2(v.x, v.y); w.y = pk2(v.z, v.w); }
                        *(u32x2*)(O + (size_t)row * ldc + col) = w;
                    }
            }
    }
};
struct EpiKV {
    bf16_t* Kb; bf16_t* VT;
    __device__ __forceinline__ void operator()(const f32x4 (&acc)[2][2][4][2], const Unit& u, int wr, int wc, int fr_in, int fq_in) const {
        int fr = fr_in, fq = fq_in; asm volatile("" : "+v"(fr), "+v"(fq));
#pragma unroll
        for (int ai = 0; ai < 2; ++ai)
#pragma unroll
            for (int m = 0; m < 4; ++m) {
                const int row = u.pm * 256 + ai * 128 + wr * 64 + m * 16 + fr;
#pragma unroll
                for (int bj = 0; bj < 2; ++bj)
#pragma unroll
                    for (int n = 0; n < 2; ++n) {
                        const int col = u.pn * 256 + bj * 128 + wc * 32 + n * 16 + fq * 4;
                        const f32x4 v = acc[ai][bj][m][n];
                        if (col < 1024) { u32x2 w; w.x = pk2(v.x, v.y); w.y = pk2(v.z, v.w); *(u32x2*)(Kb + (size_t)row * 1024 + col) = w; }
                        else {
                            const int c2 = col - 1024, h = c2 >> 8, d = c2 & 255, b = row >> 8, mm = row & 255;
                            bf16_t* p = VT + ((size_t)((b * 4 + h) * 256 + d)) * 256 + mm;
                            p[0] = (bf16_t)f2bf(v.x); p[256] = (bf16_t)f2bf(v.y); p[512] = (bf16_t)f2bf(v.z); p[768] = (bf16_t)f2bf(v.w);
                        }
                    }
            }
    }
};
template <bool SCATTER> struct EpiResid {
    const float* base; float* XF; bf16_t* XB; float* ssp; const f32x4* rowinfo;
    __device__ __forceinline__ void operator()(const f32x4 (&acc)[2][2][4][2], const Unit& u, int wr, int wc, int fr_in, int fq_in) const {
        int fr = fr_in, fq = fq_in; asm volatile("" : "+v"(fr), "+v"(fq));
#pragma unroll
        for (int ai = 0; ai < 2; ++ai)
#pragma unroll
            for (int m = 0; m < 4; ++m) {
                const int lrow = ai * 128 + wr * 64 + m * 16 + fr;
                const int row = u.pm * 256 + lrow;
                int tok = row; bool valid = true;
                if (SCATTER) { valid = lrow < u.aux; const f32x4 ri = rowinfo[row]; tok = valid ? __float_as_int(ri.w) : 0; }
                float ss = 0.f;
#pragma unroll
                for (int bj = 0; bj < 2; ++bj)
#pragma unroll
                    for (int n = 0; n < 2; ++n) {
                        const int col = u.pn * 256 + bj * 128 + wc * 32 + n * 16 + fq * 4;
                        const size_t off = (size_t)tok * 1024 + col;
                        const f32x4 b = *(const f32x4*)(base + off);
                        const f32x4 v = b + acc[ai][bj][m][n];
                        if (valid) { *(f32x4*)(XF + off) = v; u32x2 w; w.x = pk2(v.x, v.y); w.y = pk2(v.z, v.w); *(u32x2*)(XB + off) = w; }
                        ss += (v.x * v.x + v.y * v.y) + (v.z * v.z + v.w * v.w);
                    }
                ss += __shfl_xor(ss, 16); ss += __shfl_xor(ss, 32);
                if (valid && fq == 0) ssp[(size_t)tok * 16 + u.pn * 4 + wc] = ss;
            }
    }
};
struct EpiMoeUp {
    bf16_t* HID; const f32x4* rowinfo;
    __device__ __forceinline__ void operator()(const f32x4 (&acc)[2][2][4][2], const Unit& u, int wr, int wc, int fr_in, int fq_in) const {
        int fr = fr_in, fq = fq_in; asm volatile("" : "+v"(fr), "+v"(fq));
        const int slot = u.pn >> 1, jj = u.pn & 1;
#pragma unroll
        for (int ai = 0; ai < 2; ++ai)
#pragma unroll
            for (int m = 0; m < 4; ++m) {
                const int row = u.pm * 256 + ai * 128 + wr * 64 + m * 16 + fr;
                const f32x4 ri = rowinfo[row];
                const float rs = ri.x, gt = slot ? ri.z : ri.y;
#pragma unroll
                for (int n = 0; n < 2; ++n) {
                    const f32x4 h1 = acc[ai][0][m][n] * rs, h3 = acc[ai][1][m][n] * rs;
                    const int col = slot * 256 + jj * 128 + wc * 32 + n * 16 + fq * 4;
                    u32x2 w; w.x = pk2(siluf_(h1.x) * h3.x * gt, siluf_(h1.y) * h3.y * gt); w.y = pk2(siluf_(h1.z) * h3.z * gt, siluf_(h1.w) * h3.w * gt);
                    *(u32x2*)(HID + (size_t)row * 512 + col) = w;
                }
            }
    }
};
__device__ __forceinline__ void pair_experts(int bucket, int& ea, int& eb) {
    const int g = bucket / 6, p = bucket % 6;
    const int i = (p < 3) ? 0 : (p < 5 ? 1 : 2);
    const int j = (p < 3) ? p + 1 : (p < 5 ? p - 1 : 3);
    ea = g * 4 + i; eb = g * 4 + j;
}
template <bool DOWN> struct MoeSched {
    const LAS int* tbl; int ntiles, G, c; const char* A; const char* W;
    __device__ bool next(int i, Unit& u) const {
        const int L = i * G + c, mt = L >> 2, pn = L & 3;
        if (mt >= ntiles) return false;
        const int ent = __builtin_amdgcn_readfirstlane(tbl[mt]), bucket = ent & 255; u.aux = ent >> 8;
        int ea, eb; pair_experts(bucket, ea, eb);
        u.pm = mt; u.pn = pn;
        if (!DOWN) { u.a = A + (size_t)mt * 256 * 1024 * 2; const int e = (pn < 2) ? ea : eb; u.b0 = W + ((size_t)e * 512 + 256 * (pn & 1)) * 1024 * 2; u.b1 = u.b0; }
        else { u.a = A + (size_t)mt * 256 * 512 * 2; u.b0 = W + ((size_t)ea * 1024 + 256 * pn) * 256 * 2; u.b1 = W + ((size_t)eb * 1024 + 256 * pn) * 256 * 2; }
        return true;
    }
};
__device__ __forceinline__ void moe_build_table(LAS int* tbl, const unsigned* cnt, int tid) {
    if (tid == 0) { int mt = 0;
        for (int b = 0; b < 24; ++b) { const int nb = (int)cnt[b]; for (int r = 0; r < nb; r += 256) { const int v = (nb - r) < 256 ? (nb - r) : 256; if (mt < 95) tbl[mt] = b | (v << 8); ++mt; } }
        tbl[95] = mt < 95 ? mt : 95; }
    __syncthreads();
}

#define XB_TMO      128
#define XB_XCNT(j)  (256  + 64 * (j))
#define XB_XSUB(j)  (1280 + 64 * (j))
#define XB_XGEN(j)  (2304 + 64 * (j))
#define XB_TOP      3328
#define XB_TOPGEN   3392
#define XCD_BAR_WORDS 3456
#define XB_SPIN_CAP (1u << 22)
__device__ __forceinline__ unsigned xb_ld(unsigned* p)              { return __hip_atomic_load(p, __ATOMIC_RELAXED, __HIP_MEMORY_SCOPE_AGENT); }
__device__ __forceinline__ unsigned xb_add(unsigned* p, unsigned v) { return __hip_atomic_fetch_add(p, v, __ATOMIC_RELAXED, __HIP_MEMORY_SCOPE_AGENT); }
__device__ __forceinline__ unsigned xb_xcc_id() { return (unsigned)__builtin_amdgcn_s_getreg((3 << 11) | 20) & 0xFu; }
#define XB_SPIN(cond, bar) do { unsigned _sp = 0; while (cond) { __builtin_amdgcn_s_sleep(1); \
    if ((++_sp & 255u) == 0u) { if (xb_ld(&(bar)[XB_TMO])) break; if (_sp > XB_SPIN_CAP) { atomicAdd(&(bar)[XB_TMO], 1u); break; } } } } while (0)
struct XcdBarrier { unsigned* bar; unsigned x; volatile LAS unsigned* st; int wave; };
__device__ __forceinline__ XcdBarrier xcd_barrier_post(unsigned* bar, volatile LAS unsigned* st, int wave) {
    XcdBarrier b; b.bar = bar; b.x = xb_xcc_id(); b.st = st; b.wave = wave;
    if (wave == 0 && lane_id_v() == 0) (void)xb_add(&bar[XB_XCNT(b.x)], 1u);
    return b;
}
__device__ __forceinline__ void xcd_barrier_complete(unsigned* bar, unsigned x, unsigned& nloc, unsigned& nx) {
    const unsigned G = gridDim.x * gridDim.y * gridDim.z;
    unsigned sum, cnt, mine, sp = 0u;
    for (;;) {
        sum = 0u; cnt = 0u; mine = 0u;
#pragma unroll
        for (unsigned j = 0; j < 16; ++j) { const unsigned c = xb_ld(&bar[XB_XCNT(j)]); sum += c; cnt += (c > 0u) ? 1u : 0u; mine = (j == x) ? c : mine; }
        if (sum == G) break;
        __builtin_amdgcn_s_sleep(1);
        if ((++sp & 255u) == 0u) { if (xb_ld(&bar[XB_TMO])) break; if (sp > XB_SPIN_CAP) { atomicAdd(&bar[XB_TMO], 1u); break; } }
    }
    nloc = mine > 0u ? mine : 1u; nx = cnt > 0u ? cnt : 1u;
}
__device__ __forceinline__ void xcd_barrier(const XcdBarrier& b) {
    asm volatile("s_waitcnt vmcnt(0)" ::: "memory");
    __syncthreads();
    if (b.wave == 0 && lane_id_v() == 0) {
        unsigned* bar = b.bar;
        __builtin_amdgcn_s_waitcnt(0);
        unsigned nloc = b.st[0], nx = b.st[1];
        if (nloc == 0u) { xcd_barrier_complete(bar, b.x, nloc, nx); b.st[0] = nloc; b.st[1] = nx; }
        const unsigned old = xb_add(&bar[XB_XSUB(b.x)], 1u);
        const unsigned gen = old / nloc;
        if (old + 1u == (gen + 1u) * nloc) {
            __builtin_amdgcn_fence(__ATOMIC_RELEASE, "agent");
            asm volatile("s_waitcnt vmcnt(0)" ::: "memory");
            const unsigned og = xb_add(&bar[XB_TOP], 1u);
            const unsigned tg = og / nx;
            if (og + 1u == (tg + 1u) * nx) xb_add(&bar[XB_TOPGEN], 1u);
            else XB_SPIN(xb_ld(&bar[XB_TOPGEN]) == tg, bar);
            __builtin_amdgcn_fence(__ATOMIC_ACQUIRE, "agent");
            xb_add(&bar[XB_XGEN(b.x)], 1u);
            asm volatile("s_waitcnt vmcnt(0)" ::: "memory");
        } else {
            XB_SPIN(xb_ld(&bar[XB_XGEN(b.x)]) == gen, bar);
            __builtin_amdgcn_fence(__ATOMIC_ACQUIRE, "agent");
            asm volatile("s_waitcnt vmcnt(0)" ::: "memory");
        }
    }
    __syncthreads();
}

struct Args { const float* in[38]; float* out; unsigned char* ws; int ph_lo, ph_hi; };
constexpr int LDS_BYTES = 161792;
constexpr int LDS_MISC = 156 * 1024;
struct InTab {
    const LAS unsigned long long* t;
    __device__ __forceinline__ const float* operator[](int i) const {
        const unsigned long long v = t[i];
        const unsigned lo = __builtin_amdgcn_readfirstlane((unsigned)v), hi = __builtin_amdgcn_readfirstlane((unsigned)(v >> 32));
        return (const float*)(((unsigned long long)hi << 32) | lo); }
};
struct Frame {
    LAS unsigned char* lds; int wave, G, wg;
    InTab in; float* out; unsigned char* ws;
};
#define IN_X 0
#define IN_MEM 1
#define IN_NORM_MIX 2
#define IN_NORM_XA 3
#define IN_NORM_MEM 4
#define IN_NORM_FFN 5
#define IN_NORM_FINAL 6
#define IN_AB_WIN 7
#define IN_AB_CONV 8
#define IN_AB_ALOG 9
#define IN_AB_DTB 10
#define IN_AB_ONORM 11
#define IN_AB_MU 12
#define IN_AB_W0 13
#define IN_AB_W2 14
#define IN_AB_A0 15
#define IN_AB_A2 16
#define IN_AB_G2 17
#define IN_AB_KK 18
#define IN_AB_KA 19
#define IN_AB_RK 20
#define IN_AB_LNW 21
#define IN_AB_LNB 22
#define IN_AB_WOUT 23
#define IN_C_WIN 24
#define IN_C_LB 25
#define IN_C_ONORM 26
#define IN_C_WOUT 27
#define IN_XA_WQ 28
#define IN_XA_WKV 29
#define IN_XA_WO 30
#define IN_MOE_WG 31
#define IN_MOE_BG 32
#define IN_MOE_WE 33
#define IN_MOE_BE 34
#define IN_MOE_W1 35
#define IN_MOE_W3 36
#define IN_MOE_W2 37

__device__ __forceinline__ void p0_transpose_item(const float* W, int ld, int col0, int ncols, int K, const float* gain, bf16_t* WT, int drow0, LAS float* scr, int item, int lane) {
    const int nblk = ncols / 32, kb = item / nblk, nb = item % nblk, k0 = 64 * kb, n0 = 32 * nb;
    float vv[32];
#pragma unroll
    for (int i = 0; i < 32; ++i) vv[i] = W[(size_t)(k0 + 2 * i + (lane >> 5)) * ld + col0 + n0 + (lane & 31)];
#pragma unroll
    for (int i = 0; i < 32; ++i) { const int kk = 2 * i + (lane >> 5); float v = vv[i]; if (gain) v *= gain[k0 + kk]; scr[kk * 33 + (lane & 31)] = v; }
    LDS_WAIT(); asm volatile("" ::: "memory");
    const int c = lane & 7;
#pragma unroll
    for (int j = 0; j < 4; ++j) { const int n = (lane >> 3) + 8 * j; const LAS float* s = scr + (8 * c) * 33 + n;
        u32x4 o; o.x = pk2(s[0 * 33], s[1 * 33]); o.y = pk2(s[2 * 33], s[3 * 33]); o.z = pk2(s[4 * 33], s[5 * 33]); o.w = pk2(s[6 * 33], s[7 * 33]);
        *(u32x4*)(WT + (size_t)(drow0 + n0 + n) * K + k0 + 8 * c) = o; }
    LDS_WAIT(); asm volatile("" ::: "memory");
}
__device__ __forceinline__ void p0_weight_item(const Frame& F, int it, LAS float* scr, int lane) {
    const InTab in = F.in;
    bf16_t* W0 = (bf16_t*)(F.ws + WS_W0); bf16_t* W1 = (bf16_t*)(F.ws + WS_W1);
    if (it < 16384) {
        const int l = it >> 13; int r = it & 8191; bf16_t* W = l ? W1 : W0;
        if (r < 512) { p0_transpose_item(in[IN_XA_WQ] + (size_t)l * 1024 * 1024, 1024, 0, 1024, 1024, in[IN_NORM_XA] + l * 1024, W + WO_WQ, 0, scr, r, lane); return; }
        r -= 512;
        if (r < 1024) { p0_transpose_item(in[IN_XA_WKV] + (size_t)l * 1024 * 2048, 2048, 0, 2048, 1024, in[IN_NORM_MEM] + l * 1024, W + WO_WKV, 0, scr, r, lane); return; }
        r -= 1024;
        if (r < 512) { p0_transpose_item(in[IN_XA_WO] + (size_t)l * 1024 * 1024, 1024, 0, 1024, 1024, nullptr, W + WO_WO, 0, scr, r, lane); return; }
        r -= 512;
        if (r < 4096) { const int sub = r >> 6, item = r & 63, e = sub >> 2, j = (sub >> 1) & 1, which = sub & 1;
            const float* src = (which ? in[IN_MOE_W3] : in[IN_MOE_W1]) + (size_t)(l * 16 + e) * 1024 * 256;
            p0_transpose_item(src, 256, 128 * j, 128, 1024, in[IN_NORM_FFN] + l * 1024, W + WO_W13, e * 512 + 256 * j + 128 * which, scr, item, lane); return; }
        r -= 4096;
        { const int e = r >> 7, item = r & 127;
            p0_transpose_item(in[IN_MOE_W2] + (size_t)(l * 16 + e) * 256 * 1024, 1024, 0, 1024, 256, nullptr, W + WO_W2T + (size_t)e * 1024 * 256, 0, scr, item, lane); return; }
    }
    int r = it - 16384;
    if (r < 1024) { p0_transpose_item(in[IN_AB_WIN], 3848, 0, 2048, 1024, in[IN_NORM_MIX], W0 + WO_WIN, 0, scr, r, lane); return; }
    r -= 1024;
    if (r < 896) { p0_transpose_item(in[IN_AB_WIN], 3848, 2056, 1792, 1024, in[IN_NORM_MIX], W0 + WO_WIN, 2048, scr, r, lane); return; }
    r -= 896;
    if (r < 512) { p0_transpose_item(in[IN_AB_WOUT], 1024, 0, 1024, 1024, nullptr, W0 + WO_WOUT, 0, scr, r, lane); return; }
    r -= 512;
    if (r < 2048) { p0_transpose_item(in[IN_C_WIN], 4096, 0, 4096, 1024, in[IN_NORM_MIX] + 1024, W1 + WO_WIN, 0, scr, r, lane); return; }
    r -= 2048;
    if (r < 512) { p0_transpose_item(in[IN_C_WOUT], 1024, 0, 1024, 1024, nullptr, W1 + WO_WOUT, 0, scr, r, lane); return; }
    r -= 512;
    bf16_t* LW = (bf16_t*)(F.ws + WS_LORA);
    if (r < 16) { p0_transpose_item(in[IN_AB_W2], 512, 0, 512, 64, nullptr, LW, 0, scr, r, lane); return; }
    r -= 16;
    if (r < 16) { p0_transpose_item(in[IN_AB_A2], 512, 0, 512, 64, nullptr, LW + 512 * 64, 0, scr, r, lane); return; }
    r -= 16;
    p0_transpose_item(in[IN_AB_G2], 512, 0, 512, 128, nullptr, LW + 2 * 512 * 64, 0, scr, r, lane);
}
constexpr int P0_NITEMS = 16384 + 1024 + 896 + 512 + 2048 + 512 + 64;

__device__ __forceinline__ void p0_late_weights(const Frame& F, int worker, int nworkers) {
    const int lane = lane_id_v();
    LAS float* scr = (LAS float*)(F.lds + F.wave * 16384);
    const int gw = worker * NWAVES + F.wave, NGW = nworkers * NWAVES;
    for (int it = gw; it < P0_NITEMS - 64 - 1920; it += NGW) p0_weight_item(F, it < 16384 ? it : it + 1920, scr, lane);
}
__device__ __forceinline__ void p0_prologue(const Frame& F) {
    const int lane = lane_id_v(); const int tid = F.wave * 64 + lane; (void)tid;
    LAS float* scr = (LAS float*)(F.lds + F.wave * 16384);
    const int gw = F.wg * NWAVES + F.wave, NGW = F.G * NWAVES;
    for (int it = gw; it < 1920 + 64; it += NGW) p0_weight_item(F, it < 1920 ? 16384 + it : P0_NITEMS - 64 + (it - 1920), scr, lane);
    const float* x = F.in[IN_X]; const float* gain = F.in[IN_NORM_MIX]; const float* win = F.in[IN_AB_WIN];
    bf16_t* XB = (bf16_t*)(F.ws + WS_XB); float* ssp = (float*)(F.ws + WS_SSP); float* db = (float*)(F.ws + WS_DB);
    for (int row = gw; row < NT; row += NGW) {
        const f32x4* xr = (const f32x4*)(x + (size_t)row * 1024) + lane;
        f32x4 v[4]; float s = 0.f; float d[8];
#pragma unroll
        for (int c = 0; c < 8; ++c) d[c] = 0.f;
#pragma unroll
        for (int j = 0; j < 4; ++j) {
            v[j] = xr[64 * j]; s += (v[j].x * v[j].x + v[j].y * v[j].y) + (v[j].z * v[j].z + v[j].w * v[j].w);
            const int k0 = 4 * lane + 256 * j;
            const f32x4 g = *(const f32x4*)(gain + k0);
            const float xv[4] = {v[j].x * g.x, v[j].y * g.y, v[j].z * g.z, v[j].w * g.w};
#pragma unroll
            for (int q = 0; q < 4; ++q) {
                const f32x4 w0 = *(const f32x4*)(win + (size_t)(k0 + q) * 3848 + 2048), w1 = *(const f32x4*)(win + (size_t)(k0 + q) * 3848 + 2052);
                d[0] += xv[q] * w0.x; d[1] += xv[q] * w0.y; d[2] += xv[q] * w0.z; d[3] += xv[q] * w0.w;
                d[4] += xv[q] * w1.x; d[5] += xv[q] * w1.y; d[6] += xv[q] * w1.z; d[7] += xv[q] * w1.w;
            }
        }
        s = wave_sum(s);
        const float rstd = 1.0f / sqrtf(s * (1.0f / 1024.0f) + 1e-6f);
#pragma unroll
        for (int c = 0; c < 8; ++c) d[c] = wave_sum(d[c]) * rstd;
        unsigned long long* o8 = (unsigned long long*)(XB + (size_t)row * 1024) + lane;
#pragma unroll
        for (int j = 0; j < 4; ++j) o8[64 * j] = (unsigned long long)pk2(v[j].x, v[j].y) | ((unsigned long long)pk2(v[j].z, v[j].w) << 32);
        if (lane < 16) ssp[(size_t)row * 16 + lane] = (lane == 0) ? s : 0.f;
        if (lane < 8) { float dv = d[0];
#pragma unroll
            for (int c = 1; c < 8; ++c) dv = (lane == c) ? d[c] : dv;
            db[(size_t)row * 8 + lane] = dv; }
    }
    const float* mem = F.in[IN_MEM]; bf16_t* MH = (bf16_t*)(F.ws + WS_MEMH);
    for (int row = gw; row < NB * NMEM; row += NGW) {
        const f32x4* xr = (const f32x4*)(mem + (size_t)row * 1024) + lane;
        f32x4 v[4]; float s = 0.f;
#pragma unroll
        for (int j = 0; j < 4; ++j) { v[j] = xr[64 * j]; s += (v[j].x * v[j].x + v[j].y * v[j].y) + (v[j].z * v[j].z + v[j].w * v[j].w); }
        s = wave_sum(s);
        const float rstd = 1.0f / sqrtf(s * (1.0f / 1024.0f) + 1e-6f);
        unsigned long long* o8 = (unsigned long long*)(MH + (size_t)row * 1024) + lane;
#pragma unroll
        for (int j = 0; j < 4; ++j) o8[64 * j] = (unsigned long long)pk2(v[j].x * rstd, v[j].y * rstd) | ((unsigned long long)pk2(v[j].z * rstd, v[j].w * rstd) << 32);
    }
    {
        float* rw = (float*)(F.ws + WS_RW);
        for (int idx = F.wg * NTHREADS + tid; idx < 2 * 1024 * 32; idx += F.G * NTHREADS) {
            const int l = idx >> 15, k = (idx >> 5) & 1023, cc = idx & 31;
            const float g = F.in[IN_NORM_FFN][l * 1024 + k];
            float v = 0.f;
            if (cc < 4) v = F.in[IN_MOE_WG][(size_t)l * 4096 + k * 4 + cc] * g; else if (cc < 20) v = F.in[IN_MOE_WE][(size_t)l * 16384 + k * 16 + (cc - 4)] * g;
            rw[idx] = v;
        }
    }
    if (F.wg == 0) { const float* lbp = F.in[IN_C_LB]; float* lb = (float*)(F.ws + WS_LB);
        for (int c = tid; c < 1024; c += NTHREADS) { const float a = lbp[c], b = lbp[1024 + c]; const float mx = fmaxf(a, b), ea = __expf(a - mx), eb = __expf(b - mx); lb[c] = (ea + eb) / (ea + eb) - ea / (ea + eb); } }
}

__device__ __forceinline__ void scan_delta(const Frame& F, int b, int h) {
    const int lane = lane_id_v(); const int tid = F.wave * 64 + lane; (void)tid;
    LAS float* qs = (LAS float*)F.lds;
    LAS float* ks = qs + 64 * 128;
    LAS float* vs = ks + 64 * 128;
    LAS float* os = vs + 64 * 128;
    LAS float* al = os + 64 * 128;
    LAS float* be = al + 64;
    bf16_t* P = (bf16_t*)(F.ws + WS_BIG + BIG_PROJ);
    const float* convw = F.in[IN_AB_CONV];
    const float* db = (const float*)(F.ws + WS_DB);
    const float a_neg = -__expf(F.in[IN_AB_ALOG][h]), dtb = F.in[IN_AB_DTB][h];
    const float* onorm = F.in[IN_AB_ONORM];
    const int i_dv = tid >> 2, part = tid & 3;
    float s[32];
#pragma unroll
    for (int j = 0; j < 32; ++j) s[j] = 0.f;
    for (int c = 0; c < 32; ++c) {
        const int t0 = b * TS + c * 64;
        for (int idx = tid; idx < 64 * 384; idx += NTHREADS) {
            const int t = idx / 384, cc = idx % 384, sct = cc >> 7, col = cc & 127;
            const int gcol = sct * 512 + h * 128 + col;
            float a = 0.f;
#pragma unroll
            for (int j = 0; j < 4; ++j) { const int tl = c * 64 + t - 3 + j; if (tl >= 0) a += convw[j * 1536 + gcol] * bf2f(P[(size_t)(b * TS + tl) * P0LD + gcol]); }
            a = siluf_(a);
            (sct == 0 ? qs : (sct == 1 ? ks : vs))[t * 128 + col] = a;
        }
        if (tid < 64) { const int t = tid; const float la = a_neg * softplusf_(db[(size_t)(t0 + t) * 8 + h] + dtb); al[t] = __expf(la); be[t] = sigmoidf_(db[(size_t)(t0 + t) * 8 + 4 + h]); }
        __syncthreads();
        for (int r = F.wave; r < 128; r += NWAVES) { LAS float* p = (r < 64 ? qs + r * 128 : ks + (r - 64) * 128);
            const float v0 = p[lane], v1 = p[lane + 64]; const float ss = wave_sum(v0 * v0 + v1 * v1);
            const float sc = (1.0f / sqrtf(ss + 1e-6f)) * (r < 64 ? 0.08838834764831845f : 1.0f); p[lane] = v0 * sc; p[lane + 64] = v1 * sc; }
        __syncthreads();
        for (int t = 0; t < 64; ++t) {
            const LAS f32x4* kp = (const LAS f32x4*)(ks + t * 128 + part * 32); const LAS f32x4* qp = (const LAS f32x4*)(qs + t * 128 + part * 32);
            float kt[32], qt[32];
#pragma unroll
            for (int j = 0; j < 8; ++j) { const f32x4 a = kp[j], q = qp[j]; kt[4 * j] = a.x; kt[4 * j + 1] = a.y; kt[4 * j + 2] = a.z; kt[4 * j + 3] = a.w; qt[4 * j] = q.x; qt[4 * j + 1] = q.y; qt[4 * j + 2] = q.z; qt[4 * j + 3] = q.w; }
            float p = 0.f;
#pragma unroll
            for (int j = 0; j < 32; ++j) p += s[j] * kt[j];
            p += __shfl_xor(p, 1); p += __shfl_xor(p, 2);
            const float alpha = al[t], coef = be[t] * (vs[t * 128 + i_dv] - alpha * p);
            float o = 0.f;
#pragma unroll
            for (int j = 0; j < 32; ++j) { s[j] = alpha * s[j] + coef * kt[j]; o += s[j] * qt[j]; }
            o += __shfl_xor(o, 1); o += __shfl_xor(o, 2);
            if (part == 0) os[t * 128 + i_dv] = o;
        }
        __syncthreads();
        for (int t = F.wave; t < 64; t += NWAVES) {
            const float o0 = os[t * 128 + lane], o1 = os[t * 128 + lane + 64];
            const float ss = wave_sum(o0 * o0 + o1 * o1), rs = 1.0f / sqrtf(ss * (1.0f / 128.0f) + 1e-6f);
            bf16_t* gp = P + (size_t)(t0 + t) * P0LD + 1536 + h * 128;
            const float g0 = bf2f(gp[lane]), g1 = bf2f(gp[lane + 64]);
            gp[lane] = (bf16_t)f2bf(o0 * rs * onorm[lane] * siluf_(g0)); gp[lane + 64] = (bf16_t)f2bf(o1 * rs * onorm[lane + 64] * siluf_(g1));
        }
        __syncthreads();
    }
}
__device__ __forceinline__ void scan_rwkv(const Frame& F, int b, int h) {
    const int lane = lane_id_v(); const int tid = F.wave * 64 + lane; (void)tid;
    LAS float* bufA = (LAS float*)F.lds;
    LAS float* bufB = bufA + 4096;
    LAS float* bufC = bufB + 4096;
    LAS float* R = bufC + 8192;
    LAS float* Kb = R + 4096;
    LAS float* V = Kb + 4096;
    LAS float* KK = V + 4096;
    LAS float* halo = KK + 4096;
    LAS float* bonus = halo + 896;
    bf16_t* P = (bf16_t*)(F.ws + WS_BIG + BIG_PROJ);
    const float* mu = F.in[IN_AB_MU];
    const float* w0 = F.in[IN_AB_W0] + h * 64; const float* w2 = F.in[IN_AB_W2] + h * 64;
    const float* a0 = F.in[IN_AB_A0] + h * 64; const float* a2 = F.in[IN_AB_A2] + h * 64;
    const float* g2 = F.in[IN_AB_G2] + h * 64;
    const float* k_k = F.in[IN_AB_KK] + h * 64; const float* k_a = F.in[IN_AB_KA] + h * 64; const float* r_k = F.in[IN_AB_RK] + h * 64;
    const float* ln_w = F.in[IN_AB_LNW] + h * 64; const float* ln_b = F.in[IN_AB_LNB] + h * 64;
    const int vi = tid >> 3, part = tid & 7;
    float s[8];
#pragma unroll
    for (int j = 0; j < 8; ++j) s[j] = 0.f;
    for (int i = tid; i < 896; i += NTHREADS) halo[i] = 0.f;
    __syncthreads();
    for (int c = 0; c < 32; ++c) {
        const int t0 = b * TS + c * 64;
        const LAS float* hcur = halo + (c & 1) * 448; LAS float* hnext = halo + ((c + 1) & 1) * 448;
        for (int idx = tid; idx < 64 * 448; idx += NTHREADS) {
            const int t = idx / 448, col = idx % 448;
            int gc;
            if (col < 64) gc = 2048 + h * 64 + col; else if (col < 128) gc = 2560 + h * 64 + (col - 64); else if (col < 192) gc = 3072 + h * 64 + (col - 128); else gc = 3584 + (col - 192);
            const float cur = bf2f(P[(size_t)(t0 + t) * P0LD + gc]);
            const float prev = (t > 0) ? bf2f(P[(size_t)(t0 + t - 1) * P0LD + gc]) : hcur[col];
            const float sh = cur + mu[gc - 2048] * (prev - cur);
            if (t == 63) hnext[col] = cur;
            if (col < 64) R[t * 64 + col] = sh; else if (col < 128) Kb[t * 64 + col - 64] = sh; else if (col < 192) V[t * 64 + col - 128] = sh;
            else if (col < 256) bufA[t * 64 + col - 192] = tanhf(sh); else if (col < 320) bufB[t * 64 + col - 256] = sh; else bufC[t * 128 + col - 320] = sigmoidf_(sh);
        }
        __syncthreads();
        float wv[8], av[8], gv[8];
        {
            const int j = lane, tb = F.wave * 8;
#pragma unroll
            for (int q = 0; q < 8; ++q) { wv[q] = 0.f; av[q] = 0.f; gv[q] = 0.f; }
            for (int m = 0; m < 64; ++m) { const float x2 = w2[(size_t)m * 512 + j], y2 = a2[(size_t)m * 512 + j];
#pragma unroll
                for (int q = 0; q < 8; ++q) { wv[q] += bufA[(tb + q) * 64 + m] * x2; av[q] += bufB[(tb + q) * 64 + m] * y2; } }
            for (int m = 0; m < 128; ++m) { const float z2 = g2[(size_t)m * 512 + j];
#pragma unroll
                for (int q = 0; q < 8; ++q) gv[q] += bufC[(tb + q) * 128 + m] * z2; }
#pragma unroll
            for (int q = 0; q < 8; ++q) { wv[q] = __expf(-0.6065306597126334f * sigmoidf_(w0[j] + wv[q])); av[q] = sigmoidf_(a0[j] + av[q]); }
        }
        __syncthreads();
        {
            const int j = lane, tb = F.wave * 8;
#pragma unroll
            for (int q = 0; q < 8; ++q) { bufA[(tb + q) * 64 + j] = wv[q]; bufB[(tb + q) * 64 + j] = av[q]; bufC[(tb + q) * 64 + j] = gv[q]; }
#pragma unroll
            for (int q = 0; q < 8; ++q) { const int t = tb + q; const float kv = Kb[t * 64 + j]; const float kx = kv * k_k[j]; const float ss = wave_sum(kx * kx);
                KK[t * 64 + j] = kx * (1.0f / sqrtf(ss + 1e-6f)); const float km = kv * (1.f + (av[q] - 1.f) * k_a[j]); Kb[t * 64 + j] = km;
                const float bs = wave_sum(R[t * 64 + j] * km * r_k[j]); if (j == 0) bonus[t] = bs; }
        }
        __syncthreads();
        LAS float* O = bufC + 4096;
        for (int t = 0; t < 64; ++t) {
            const LAS f32x4* p4;
            float kk[8], ww[8], aa[8], km[8], rr[8];
            p4 = (const LAS f32x4*)(KK + t * 64 + part * 8);   { const f32x4 a = p4[0], c2 = p4[1]; kk[0] = a.x; kk[1] = a.y; kk[2] = a.z; kk[3] = a.w; kk[4] = c2.x; kk[5] = c2.y; kk[6] = c2.z; kk[7] = c2.w; }
            p4 = (const LAS f32x4*)(bufA + t * 64 + part * 8); { const f32x4 a = p4[0], c2 = p4[1]; ww[0] = a.x; ww[1] = a.y; ww[2] = a.z; ww[3] = a.w; ww[4] = c2.x; ww[5] = c2.y; ww[6] = c2.z; ww[7] = c2.w; }
            p4 = (const LAS f32x4*)(bufB + t * 64 + part * 8); { const f32x4 a = p4[0], c2 = p4[1]; aa[0] = a.x; aa[1] = a.y; aa[2] = a.z; aa[3] = a.w; aa[4] = c2.x; aa[5] = c2.y; aa[6] = c2.z; aa[7] = c2.w; }
            p4 = (const LAS f32x4*)(Kb + t * 64 + part * 8);   { const f32x4 a = p4[0], c2 = p4[1]; km[0] = a.x; km[1] = a.y; km[2] = a.z; km[3] = a.w; km[4] = c2.x; km[5] = c2.y; km[6] = c2.z; km[7] = c2.w; }
            p4 = (const LAS f32x4*)(R + t * 64 + part * 8);    { const f32x4 a = p4[0], c2 = p4[1]; rr[0] = a.x; rr[1] = a.y; rr[2] = a.z; rr[3] = a.w; rr[4] = c2.x; rr[5] = c2.y; rr[6] = c2.z; rr[7] = c2.w; }
            const float vv = V[t * 64 + vi];
            float sa = 0.f;
#pragma unroll
            for (int j = 0; j < 8; ++j) sa -= s[j] * kk[j];
            sa += __shfl_xor(sa, 1); sa += __shfl_xor(sa, 2); sa += __shfl_xor(sa, 4);
            float o = 0.f;
#pragma unroll
            for (int j = 0; j < 8; ++j) { s[j] = s[j] * ww[j] + sa * (kk[j] * aa[j]) + vv * km[j]; o += s[j] * rr[j]; }
            o += __shfl_xor(o, 1); o += __shfl_xor(o, 2); o += __shfl_xor(o, 4);
            if (part == 0) O[t * 64 + vi] = o;
        }
        __syncthreads();
        for (int t = F.wave; t < 64; t += NWAVES) {
            const float o = O[t * 64 + lane];
            const float mean = wave_sum(o) * (1.0f / 64.0f); const float dlt = o - mean; const float var = wave_sum(dlt * dlt) * (1.0f / 64.0f);
            float y = dlt * (1.0f / sqrtf(var + 64e-5f)) * ln_w[lane] + ln_b[lane];
            y += bonus[t] * V[t * 64 + lane];
            y *= bufC[t * 64 + lane];
            P[(size_t)(t0 + t) * P0LD + 2048 + h * 64 + lane] = (bf16_t)f2bf(y);
        }
        __syncthreads();
    }
}
__device__ __forceinline__ void scan_hgrn(const Frame& F, int b, int h) {
    const int lane = lane_id_v(); const int tid = F.wave * 64 + lane; (void)tid;
    LAS float* qs = (LAS float*)F.lds;
    LAS float* fs = qs + 64 * 128;
    LAS float* kf = fs + 64 * 128;
    LAS float* is = kf + 64 * 128;
    bf16_t* P = (bf16_t*)(F.ws + WS_BIG + BIG_PROJ);
    const float* onorm = F.in[IN_C_ONORM];
    const int e = tid >> 2, part = tid & 3;
    float s[32];
#pragma unroll
    for (int j = 0; j < 32; ++j) s[j] = 0.f;
    for (int c = 0; c < 32; ++c) {
        const int t0 = b * TS + c * 64;
        for (int idx = tid; idx < 64 * 128; idx += NTHREADS) {
            const int t = idx >> 7, col = idx & 127; const bf16_t* pr = P + (size_t)(t0 + t) * P1LD + h * 128 + col;
            qs[idx] = bf2f(pr[0]); const float lf = h2f_bits(pr[1024]); fs[idx] = __expf(lf); kf[idx] = -expm1f(lf); is[idx] = bf2f(pr[2048]);
        }
        __syncthreads();
        for (int t = 0; t < 64; ++t) {
            const LAS f32x4* fp = (const LAS f32x4*)(fs + t * 128 + part * 32); const LAS f32x4* kp = (const LAS f32x4*)(kf + t * 128 + part * 32); const LAS f32x4* qp = (const LAS f32x4*)(qs + t * 128 + part * 32);
            const float iv = is[t * 128 + e];
            float o = 0.f;
#pragma unroll
            for (int j = 0; j < 8; ++j) { const f32x4 f = fp[j], k = kp[j], q = qp[j];
                s[4 * j] = f.x * s[4 * j] + k.x * iv; o += s[4 * j] * q.x;
                s[4 * j + 1] = f.y * s[4 * j + 1] + k.y * iv; o += s[4 * j + 1] * q.y;
                s[4 * j + 2] = f.z * s[4 * j + 2] + k.z * iv; o += s[4 * j + 2] * q.z;
                s[4 * j + 3] = f.w * s[4 * j + 3] + k.w * iv; o += s[4 * j + 3] * q.w; }
            o += __shfl_xor(o, 1); o += __shfl_xor(o, 2);
            if (part == 0) is[t * 128 + e] = o;
        }
        __syncthreads();
        for (int t = F.wave; t < 64; t += NWAVES) {
            const float o0 = is[t * 128 + lane], o1 = is[t * 128 + lane + 64];
            const float ss = wave_sum(o0 * o0 + o1 * o1), rs = 1.0f / sqrtf(ss * (1.0f / 128.0f) + 1e-6f);
            bf16_t* gp = P + (size_t)(t0 + t) * P1LD + 3072 + h * 128;
            const float g0 = bf2f(gp[lane]), g1 = bf2f(gp[lane + 64]);
            gp[lane] = (bf16_t)f2bf(o0 * rs * onorm[lane] * siluf_(g0)); gp[lane + 64] = (bf16_t)f2bf(o1 * rs * onorm[lane + 64] * siluf_(g1));
        }
        __syncthreads();
    }
}

template <int CTRL> __device__ __forceinline__ float dppf(float v) { return __int_as_float(__builtin_amdgcn_update_dpp(0, __float_as_int(v), CTRL, 0xF, 0xF, true)); }
__device__ __forceinline__ float red8(float v) { v += dppf<0xB1>(v); v += dppf<0x4E>(v); v += dppf<0x141>(v); return v; }
__device__ __forceinline__ float red16(float v) { v = red8(v); v += dppf<0x140>(v); return v; }

__device__ __forceinline__ void scan_delta2(const Frame& F, int b, int h, int qd) {
    const int lane = lane_id_v(); const int tid = F.wave * 64 + lane;
    LAS float* Kc = (LAS float*)F.lds;
    LAS float* Qc = Kc + 64 * 128;
    LAS float* Vc = Qc + 64 * 128;
    LAS float* Oc = Vc + 64 * 32;
    LAS float* al = Oc + 64 * 32;
    LAS float* be = al + 64;
    LAS float* vh = be + 64;
    bf16_t* P = (bf16_t*)(F.ws + WS_BIG + BIG_PROJ);
    const float* convw = F.in[IN_AB_CONV];
    const float* db = (const float*)(F.ws + WS_DB);
    const float a_neg = -__expf(F.in[IN_AB_ALOG][h]), dtb = F.in[IN_AB_DTB][h];
    const int w = F.wave;
    const int vcol = 1024 + h * 128 + qd * 32 + (lane & 31);
    float cwq[4][2], cwk[4][2], cwv[4];
#pragma unroll
    for (int j = 0; j < 4; ++j) { cwq[j][0] = convw[j * 1536 + h * 128 + lane]; cwq[j][1] = convw[j * 1536 + h * 128 + lane + 64];
        cwk[j][0] = convw[j * 1536 + 512 + h * 128 + lane]; cwk[j][1] = convw[j * 1536 + 512 + h * 128 + lane + 64]; cwv[j] = convw[j * 1536 + vcol]; }
    const int r = tid >> 4, part = tid & 15;
    float s[8];
#pragma unroll
    for (int j = 0; j < 8; ++j) s[j] = 0.f;
    if (tid < 192) vh[tid] = 0.f;
    __syncthreads();
    for (int c = 0; c < 32; ++c) {
        const int t0 = b * TS + c * 64;
        const LAS float* vhc = vh + (c & 1) * 96; LAS float* vhn = vh + ((c + 1) & 1) * 96;
        {
            float rq[11][2], rk[11][2], rv[11];
#pragma unroll
            for (int rr = 0; rr < 11; ++rr) {
                const int tl = c * 64 + 8 * w - 3 + rr;
                const bool ok = tl >= 0;
                const bf16_t* row = P + (size_t)(b * TS + (ok ? tl : 0)) * P0LD;
                rq[rr][0] = ok ? bf2f(row[h * 128 + lane]) : 0.f; rq[rr][1] = ok ? bf2f(row[h * 128 + lane + 64]) : 0.f;
                rk[rr][0] = ok ? bf2f(row[512 + h * 128 + lane]) : 0.f; rk[rr][1] = ok ? bf2f(row[512 + h * 128 + lane + 64]) : 0.f;
                const bool prevchunk = (8 * w - 3 + rr) < 0;
                rv[rr] = prevchunk ? vhc[(rr < 3 ? rr : 0) * 32 + (lane & 31)] : bf2f(row[vcol]);
            }
            if (w == 7 && lane < 32) { vhn[lane] = rv[8]; vhn[32 + lane] = rv[9]; vhn[64 + lane] = rv[10]; }
#pragma unroll
            for (int i = 0; i < 8; ++i) {
                const int t = 8 * w + i;
                float q0 = 0.f, q1 = 0.f, k0 = 0.f, k1 = 0.f, vv = 0.f;
#pragma unroll
                for (int j = 0; j < 4; ++j) { q0 += cwq[j][0] * rq[i + j][0]; q1 += cwq[j][1] * rq[i + j][1]; k0 += cwk[j][0] * rk[i + j][0]; k1 += cwk[j][1] * rk[i + j][1]; vv += cwv[j] * rv[i + j]; }
                q0 = siluf_(q0); q1 = siluf_(q1); k0 = siluf_(k0); k1 = siluf_(k1); vv = siluf_(vv);
                const float sq = wave_sum(q0 * q0 + q1 * q1), sk = wave_sum(k0 * k0 + k1 * k1);
                const float cq = (1.0f / sqrtf(sq + 1e-6f)) * 0.08838834764831845f, ck = 1.0f / sqrtf(sk + 1e-6f);
                Qc[t * 128 + lane] = q0 * cq; Qc[t * 128 + lane + 64] = q1 * cq; Kc[t * 128 + lane] = k0 * ck; Kc[t * 128 + lane + 64] = k1 * ck;
                if (lane < 32) Vc[t * 32 + lane] = vv;
            }
            if (lane < 8) { const int t = 8 * w + lane; const float la = a_neg * softplusf_(db[(size_t)(t0 + t) * 8 + h] + dtb); al[t] = __expf(la); be[t] = sigmoidf_(db[(size_t)(t0 + t) * 8 + 4 + h]); }
        }
        __syncthreads();
        {
            const LAS float* kp = Kc + part * 8; const LAS float* qp = Qc + part * 8;
            f32x4 ka = *(const LAS f32x4*)(kp), kb = *(const LAS f32x4*)(kp + 4), qa = *(const LAS f32x4*)(qp), qb = *(const LAS f32x4*)(qp + 4);
            float vv = Vc[r], alpha = al[0], beta = be[0];
            for (int t = 0; t < 64; ++t) {
                const int tn = (t + 1) & 63;
                const f32x4 nka = *(const LAS f32x4*)(kp + tn * 128), nkb = *(const LAS f32x4*)(kp + tn * 128 + 4), nqa = *(const LAS f32x4*)(qp + tn * 128), nqb = *(const LAS f32x4*)(qp + tn * 128 + 4);
                const float nvv = Vc[tn * 32 + r], nal = al[tn], nbe = be[tn];
                float p0 = s[0] * ka.x + s[1] * ka.y, p1 = s[2] * ka.z + s[3] * ka.w, p2 = s[4] * kb.x + s[5] * kb.y, p3 = s[6] * kb.z + s[7] * kb.w;
                const float p = red16((p0 + p1) + (p2 + p3));
                const float coef = beta * (vv - alpha * p);
                s[0] = alpha * s[0] + coef * ka.x; s[1] = alpha * s[1] + coef * ka.y; s[2] = alpha * s[2] + coef * ka.z; s[3] = alpha * s[3] + coef * ka.w;
                s[4] = alpha * s[4] + coef * kb.x; s[5] = alpha * s[5] + coef * kb.y; s[6] = alpha * s[6] + coef * kb.z; s[7] = alpha * s[7] + coef * kb.w;
                float o0 = s[0] * qa.x + s[1] * qa.y, o1 = s[2] * qa.z + s[3] * qa.w, o2 = s[4] * qb.x + s[5] * qb.y, o3 = s[6] * qb.z + s[7] * qb.w;
                const float o = red16((o0 + o1) + (o2 + o3));
                if (part == 0) Oc[t * 32 + r] = o;
                ka = nka; kb = nkb; qa = nqa; qb = nqb; vv = nvv; alpha = nal; beta = nbe;
            }
        }
        __syncthreads();
        {
            const int t = tid >> 3, c4 = (tid & 7) * 4;
            const f32x4 o = *(const LAS f32x4*)(Oc + t * 32 + c4);
            u32x2 wv; wv.x = pk2(o.x, o.y); wv.y = pk2(o.z, o.w);
            *(u32x2*)(P + (size_t)(t0 + t) * P0LD + 1024 + h * 128 + qd * 32 + c4) = wv;
        }
    }
}
__device__ __forceinline__ void fin_delta(const Frame& F) {
    const int lane = lane_id_v();
    bf16_t* P = (bf16_t*)(F.ws + WS_BIG + BIG_PROJ); const float* onorm = F.in[IN_AB_ONORM];
    const float on0 = onorm[lane], on1 = onorm[lane + 64];
    const int gw = F.wg * NWAVES + F.wave, NGW = F.G * NWAVES;
    for (int it = gw; it < NT * 4; it += NGW) {
        const int t = it >> 2, h = it & 3;
        bf16_t* row = P + (size_t)t * P0LD;
        const float o0 = bf2f(row[1024 + h * 128 + lane]), o1 = bf2f(row[1024 + h * 128 + lane + 64]);
        const float g0 = bf2f(row[1536 + h * 128 + lane]), g1 = bf2f(row[1536 + h * 128 + lane + 64]);
        const float ss = wave_sum(o0 * o0 + o1 * o1), rs = 1.0f / sqrtf(ss * (1.0f / 128.0f) + 1e-6f);
        row[1536 + h * 128 + lane] = (bf16_t)f2bf(o0 * rs * on0 * siluf_(g0)); row[1536 + h * 128 + lane + 64] = (bf16_t)f2bf(o1 * rs * on1 * siluf_(g1));
    }
}

__device__ __forceinline__ void scan_rwkv2(const Frame& F, int b, int h) {
    const int lane = lane_id_v(); const int tid = F.wave * 64 + lane;
    LAS float* R = (LAS float*)F.lds;
    LAS float* KM = R + 4096;
    LAS float* V = KM + 4096;
    LAS float* KK = V + 4096;
    LAS float* KA = KK + 4096;
    LAS float* W = KA + 4096;
    LAS bf16_t* TL = (LAS bf16_t*)(W + 4096);
    LAS bf16_t* AL = TL + 64 * 72;
    LAS bf16_t* SG = AL + 64 * 72;
    LAS float* O = (LAS float*)TL;
    LAS bf16_t* GB = SG + 64 * 136;
    LAS float* halo = (LAS float*)(GB + 4096);
    LAS float* bonus = halo + 896;
    bf16_t* P = (bf16_t*)(F.ws + WS_BIG + BIG_PROJ);
    const bf16_t* LW = (const bf16_t*)(F.ws + WS_LORA);
    const float* mu = F.in[IN_AB_MU];
    const float* w0 = F.in[IN_AB_W0] + h * 64; const float* a0 = F.in[IN_AB_A0] + h * 64;
    const float* k_k = F.in[IN_AB_KK] + h * 64; const float* k_a = F.in[IN_AB_KA] + h * 64; const float* r_k = F.in[IN_AB_RK] + h * 64;
    const float* ln_w = F.in[IN_AB_LNW] + h * 64; const float* ln_b = F.in[IN_AB_LNB] + h * 64;
    const int w = F.wave, fr = lane & 15, fq = lane >> 4;
    const int vi = tid >> 3, part = tid & 7;
    float s[8];
#pragma unroll
    for (int j = 0; j < 8; ++j) s[j] = 0.f;
    for (int i = tid; i < 896; i += NTHREADS) halo[i] = 0.f;
    int gc = 0; float muc = 0.f;
    if (tid < 448) { const int col = tid;
        if (col < 64) gc = 2048 + h * 64 + col; else if (col < 128) gc = 2560 + h * 64 + (col - 64); else if (col < 192) gc = 3072 + h * 64 + (col - 128); else gc = 3584 + (col - 192);
        muc = mu[gc - 2048]; }
    __syncthreads();
    for (int c = 0; c < 32; ++c) {
        const int t0 = b * TS + c * 64;
        if (tid < 448) {
            const int col = tid;
            LAS float* hc = halo + (c & 1) * 448; LAS float* hn = halo + ((c + 1) & 1) * 448;
            float prev = hc[col];
            const bf16_t* src = P + (size_t)t0 * P0LD + gc;
#pragma unroll 8
            for (int t = 0; t < 64; ++t) {
                const float cur = bf2f(src[(size_t)t * P0LD]);
                const float sh = cur + muc * (prev - cur);
                prev = cur;
                if (col < 64) R[t * 64 + col] = sh; else if (col < 128) KM[t * 64 + col - 64] = sh; else if (col < 192) V[t * 64 + col - 128] = sh;
                else if (col < 256) TL[t * 72 + col - 192] = (bf16_t)f2bf(tanhf(sh)); else if (col < 320) AL[t * 72 + col - 256] = (bf16_t)f2bf(sh); else SG[t * 136 + col - 320] = (bf16_t)f2bf(sigmoidf_(sh));
            }
            hn[col] = prev;
        }
        __syncthreads();
        {
#pragma unroll
            for (int q = 0; q < 2; ++q) {
                const int id = 2 * w + q, mi = id >> 2, nj = id & 3;
                f32x4 aw = {0.f, 0.f, 0.f, 0.f}, aa = {0.f, 0.f, 0.f, 0.f}, ag = {0.f, 0.f, 0.f, 0.f};
                const int jrow = h * 64 + nj * 16 + fr;
#pragma unroll
                for (int ksx = 0; ksx < 2; ++ksx) {
                    const bf16x8 x1 = *(const LAS bf16x8*)(TL + (mi * 16 + fr) * 72 + ksx * 32 + fq * 8), x2 = *(const LAS bf16x8*)(AL + (mi * 16 + fr) * 72 + ksx * 32 + fq * 8);
                    const bf16x8 y1 = *(const bf16x8*)(LW + (size_t)jrow * 64 + ksx * 32 + fq * 8), y2 = *(const bf16x8*)(LW + 512 * 64 + (size_t)jrow * 64 + ksx * 32 + fq * 8);
                    aw = __builtin_amdgcn_mfma_f32_16x16x32_bf16(x1, y1, aw, 0, 0, 0); aa = __builtin_amdgcn_mfma_f32_16x16x32_bf16(x2, y2, aa, 0, 0, 0);
                }
#pragma unroll
                for (int ksx = 0; ksx < 4; ++ksx) {
                    const bf16x8 x3 = *(const LAS bf16x8*)(SG + (mi * 16 + fr) * 136 + ksx * 32 + fq * 8);
                    const bf16x8 y3 = *(const bf16x8*)(LW + 2 * 512 * 64 + (size_t)jrow * 128 + ksx * 32 + fq * 8);
                    ag = __builtin_amdgcn_mfma_f32_16x16x32_bf16(x3, y3, ag, 0, 0, 0);
                }
                const int j = nj * 16 + fr; const float w0j = w0[j], a0j = a0[j];
                const float awv[4] = {aw.x, aw.y, aw.z, aw.w}, aav[4] = {aa.x, aa.y, aa.z, aa.w}, agv[4] = {ag.x, ag.y, ag.z, ag.w};
#pragma unroll
                for (int rg = 0; rg < 4; ++rg) { const int t = mi * 16 + 4 * fq + rg;
                    W[t * 64 + j] = __expf(-0.6065306597126334f * sigmoidf_(w0j + awv[rg])); KA[t * 64 + j] = sigmoidf_(a0j + aav[rg]); GB[t * 64 + j] = (bf16_t)f2bf(agv[rg]); }
            }
        }
        __syncthreads();
        {
            const int j = lane; const float kkj = k_k[j], kaj = k_a[j], rkj = r_k[j];
#pragma unroll
            for (int q = 0; q < 8; ++q) { const int t = w * 8 + q; const float kv = KM[t * 64 + j], a = KA[t * 64 + j]; const float kx = kv * kkj; const float ss = wave_sum(kx * kx);
                const float kk = kx * (1.0f / sqrtf(ss + 1e-6f)); KK[t * 64 + j] = kk; KA[t * 64 + j] = kk * a; const float km = kv * (1.f + (a - 1.f) * kaj); KM[t * 64 + j] = km;
                const float bs = wave_sum(R[t * 64 + j] * km * rkj); if (j == 0) bonus[t] = bs; }
        }
        __syncthreads();
        {
            const int o8 = part * 8;
            for (int t = 0; t < 64; ++t) {
                const f32x4 k0 = *(const LAS f32x4*)(KK + t * 64 + o8), k1 = *(const LAS f32x4*)(KK + t * 64 + o8 + 4);
                const f32x4 w0v = *(const LAS f32x4*)(W + t * 64 + o8), w1v = *(const LAS f32x4*)(W + t * 64 + o8 + 4);
                const f32x4 a0v = *(const LAS f32x4*)(KA + t * 64 + o8), a1v = *(const LAS f32x4*)(KA + t * 64 + o8 + 4);
                const f32x4 m0 = *(const LAS f32x4*)(KM + t * 64 + o8), m1 = *(const LAS f32x4*)(KM + t * 64 + o8 + 4);
                const f32x4 r0 = *(const LAS f32x4*)(R + t * 64 + o8), r1 = *(const LAS f32x4*)(R + t * 64 + o8 + 4);
                const float vv = V[t * 64 + vi];
                const float sa = -red8(((s[0] * k0.x + s[1] * k0.y) + (s[2] * k0.z + s[3] * k0.w)) + ((s[4] * k1.x + s[5] * k1.y) + (s[6] * k1.z + s[7] * k1.w)));
                s[0] = s[0] * w0v.x + sa * a0v.x + vv * m0.x; s[1] = s[1] * w0v.y + sa * a0v.y + vv * m0.y; s[2] = s[2] * w0v.z + sa * a0v.z + vv * m0.z; s[3] = s[3] * w0v.w + sa * a0v.w + vv * m0.w;
                s[4] = s[4] * w1v.x + sa * a1v.x + vv * m1.x; s[5] = s[5] * w1v.y + sa * a1v.y + vv * m1.y; s[6] = s[6] * w1v.z + sa * a1v.z + vv * m1.z; s[7] = s[7] * w1v.w + sa * a1v.w + vv * m1.w;
                const float o = red8(((s[0] * r0.x + s[1] * r0.y) + (s[2] * r0.z + s[3] * r0.w)) + ((s[4] * r1.x + s[5] * r1.y) + (s[6] * r1.z + s[7] * r1.w)));
                if (part == 0) O[t * 64 + vi] = o;
            }
        }
        __syncthreads();
        for (int t = w; t < 64; t += NWAVES) {
            const float o = O[t * 64 + lane];
            const float mean = wave_sum(o) * (1.0f / 64.0f); const float dlt = o - mean; const float var = wave_sum(dlt * dlt) * (1.0f / 64.0f);
            float y = dlt * (1.0f / sqrtf(var + 64e-5f)) * ln_w[lane] + ln_b[lane];
            y += bonus[t] * V[t * 64 + lane];
            y *= bf2f(GB[t * 64 + lane]);
            P[(size_t)(t0 + t) * P0LD + 2048 + h * 64 + lane] = (bf16_t)f2bf(y);
        }
        __syncthreads();
    }
}

__device__ __forceinline__ void scan_hgrn2(const Frame& F, int b, int h, int qd) {
    const int lane = lane_id_v(); const int tid = F.wave * 64 + lane;
    LAS float* qs = (LAS float*)F.lds;
    LAS float* fs = qs + 64 * 128;
    LAS float* kf = fs + 64 * 128;
    LAS float* is = kf + 64 * 128;
    bf16_t* P = (bf16_t*)(F.ws + WS_BIG + BIG_PROJ);
    const int e = tid >> 4, part = tid & 15;
    float s[8];
#pragma unroll
    for (int j = 0; j < 8; ++j) s[j] = 0.f;
    for (int c = 0; c < 32; ++c) {
        const int t0 = b * TS + c * 64;
        {
            const int t = tid >> 3, c16 = (tid & 7) * 16;
            const bf16_t* pr = P + (size_t)(t0 + t) * P1LD + h * 128 + c16;
            const u32x4 qa = *(const u32x4*)pr, qb = *(const u32x4*)(pr + 8), la = *(const u32x4*)(pr + 1024), lb2 = *(const u32x4*)(pr + 1024 + 8);
            const unsigned qv[8] = {qa.x, qa.y, qa.z, qa.w, qb.x, qb.y, qb.z, qb.w}, lv[8] = {la.x, la.y, la.z, la.w, lb2.x, lb2.y, lb2.z, lb2.w};
#pragma unroll
            for (int j = 0; j < 8; ++j) {
                qs[t * 128 + c16 + 2 * j] = bf2f((unsigned short)(qv[j] & 0xffffu)); qs[t * 128 + c16 + 2 * j + 1] = bf2f((unsigned short)(qv[j] >> 16));
                const float l0 = h2f_bits((unsigned short)(lv[j] & 0xffffu)), l1 = h2f_bits((unsigned short)(lv[j] >> 16));
                fs[t * 128 + c16 + 2 * j] = __expf(l0); fs[t * 128 + c16 + 2 * j + 1] = __expf(l1); kf[t * 128 + c16 + 2 * j] = -expm1f(l0); kf[t * 128 + c16 + 2 * j + 1] = -expm1f(l1);
            }
            const int c4 = (tid & 7) * 4;
            const u32x2 iv = *(const u32x2*)(P + (size_t)(t0 + t) * P1LD + 2048 + h * 128 + qd * 32 + c4);
            is[t * 32 + c4] = bf2f((unsigned short)(iv.x & 0xffffu)); is[t * 32 + c4 + 1] = bf2f((unsigned short)(iv.x >> 16)); is[t * 32 + c4 + 2] = bf2f((unsigned short)(iv.y & 0xffffu)); is[t * 32 + c4 + 3] = bf2f((unsigned short)(iv.y >> 16));
        }
        __syncthreads();
        {
            const int o8 = part * 8;
            for (int t = 0; t < 64; ++t) {
                const f32x4 f0 = *(const LAS f32x4*)(fs + t * 128 + o8), f1 = *(const LAS f32x4*)(fs + t * 128 + o8 + 4);
                const f32x4 k0 = *(const LAS f32x4*)(kf + t * 128 + o8), k1 = *(const LAS f32x4*)(kf + t * 128 + o8 + 4);
                const f32x4 q0 = *(const LAS f32x4*)(qs + t * 128 + o8), q1 = *(const LAS f32x4*)(qs + t * 128 + o8 + 4);
                const float iv = is[t * 32 + e];
                s[0] = f0.x * s[0] + k0.x * iv; s[1] = f0.y * s[1] + k0.y * iv; s[2] = f0.z * s[2] + k0.z * iv; s[3] = f0.w * s[3] + k0.w * iv;
                s[4] = f1.x * s[4] + k1.x * iv; s[5] = f1.y * s[5] + k1.y * iv; s[6] = f1.z * s[6] + k1.z * iv; s[7] = f1.w * s[7] + k1.w * iv;
                const float o = red16(((s[0] * q0.x + s[1] * q0.y) + (s[2] * q0.z + s[3] * q0.w)) + ((s[4] * q1.x + s[5] * q1.y) + (s[6] * q1.z + s[7] * q1.w)));
                if (part == 0) is[t * 32 + e] = o;
            }
        }
        __syncthreads();
        {
            const int t = tid >> 3, c4 = (tid & 7) * 4;
            const f32x4 o = *(const LAS f32x4*)(is + t * 32 + c4);
            u32x2 wv; wv.x = pk2(o.x, o.y); wv.y = pk2(o.z, o.w);
            *(u32x2*)(P + (size_t)(t0 + t) * P1LD + 2048 + h * 128 + qd * 32 + c4) = wv;
        }
        __syncthreads();
    }
}
__device__ __forceinline__ void fin_hgrn(const Frame& F) {
    const int lane = lane_id_v();
    bf16_t* P = (bf16_t*)(F.ws + WS_BIG + BIG_PROJ); const float* onorm = F.in[IN_C_ONORM];
    const float on0 = onorm[lane], on1 = onorm[lane + 64];
    const int gw = F.wg * NWAVES + F.wave, NGW = F.G * NWAVES;
    for (int it = gw; it < NT * 8; it += NGW) {
        const int t = it >> 3, h = it & 7;
        bf16_t* row = P + (size_t)t * P1LD;
        const float o0 = bf2f(row[2048 + h * 128 + lane]), o1 = bf2f(row[2048 + h * 128 + lane + 64]);
        const float g0 = bf2f(row[3072 + h * 128 + lane]), g1 = bf2f(row[3072 + h * 128 + lane + 64]);
        const float ss = wave_sum(o0 * o0 + o1 * o1), rs = 1.0f / sqrtf(ss * (1.0f / 128.0f) + 1e-6f);
        row[3072 + h * 128 + lane] = (bf16_t)f2bf(o0 * rs * on0 * siluf_(g0)); row[3072 + h * 128 + lane + 64] = (bf16_t)f2bf(o1 * rs * on1 * siluf_(g1));
    }
}

#define MFMA32(a, b, c) __builtin_amdgcn_mfma_f32_16x16x32_bf16(a, b, c, 0, 0, 0)
#define MFMA16(a, b, c) __builtin_amdgcn_mfma_f32_16x16x16bf16_1k(a, b, c, 0, 0, 0)
__device__ __forceinline__ f32x4 mm_tile(const LAS bf16_t* A, int lda, const LAS bf16_t* B, int ldb, int nks, f32x4 acc, int fr, int fq) {
    for (int ksx = 0; ksx < nks; ++ksx) acc = MFMA32(*(const LAS bf16x8*)(A + fr * lda + ksx * 32 + fq * 8), *(const LAS bf16x8*)(B + fr * ldb + ksx * 32 + fq * 8), acc);
    return acc;
}
__device__ __forceinline__ void lds_w4(LAS bf16_t* p, f32x4 v) { u32x2 w; w.x = pk2(v.x, v.y); w.y = pk2(v.z, v.w); *(LAS u32x2*)p = w; }
__device__ __forceinline__ float rdlane(float v, int l) { return __int_as_float(__builtin_amdgcn_readlane(__float_as_int(v), l)); }
__device__ __forceinline__ float wsum(float v) { v = red16(v); return (rdlane(v, 0) + rdlane(v, 16)) + (rdlane(v, 32) + rdlane(v, 48)); }

__device__ __forceinline__ void scan_delta3(const Frame& F, int b, int h) {
    const int lane0 = lane_id_v(); const int w = F.wave;
    LAS bf16_t* Qb = (LAS bf16_t*)F.lds;
    LAS bf16_t* Kb = Qb + 64 * 136;
    LAS float* Of = (LAS float*)F.lds;
    LAS bf16_t* Kdt = Kb + 64 * 136;
    LAS bf16_t* Vt = Kdt + 128 * 72;
    LAS bf16_t* St = Vt + 128 * 72;
    LAS bf16_t* Aoff = St + 128 * 136;
    LAS bf16_t* QKm = Aoff + 64 * 72;
    LAS bf16_t* Vn = QKm + 64 * 72;
    LAS bf16_t* Dg = Vn + 128 * 72;
    LAS float* Adg = (LAS float*)(Dg + 4 * 16 * 24);
    LAS float* sc = Adg + 4 * 16 * 17;
    static_assert((64 * 136 * 2 * 2 + 128 * 72 * 2 * 3 + 128 * 136 * 2 + 64 * 72 * 2 * 2 + 4 * 16 * 24 * 2 + 4 * 16 * 17 * 4 + 260 * 4) <= LDS_MISC, "delta3 LDS");
    bf16_t* P = (bf16_t*)(F.ws + WS_BIG + BIG_PROJ);
    const float* convw = F.in[IN_AB_CONV];
    const float* db = (const float*)(F.ws + WS_DB);
    const float a_neg = -__expf(F.in[IN_AB_ALOG][h]), dtb = F.in[IN_AB_DTB][h];
    const float* onorm = F.in[IN_AB_ONORM];
    float cw[3][4][2];
#pragma unroll
    for (int sct = 0; sct < 3; ++sct)
#pragma unroll
        for (int j = 0; j < 4; ++j) { cw[sct][j][0] = convw[j * 1536 + sct * 512 + h * 128 + lane0]; cw[sct][j][1] = convw[j * 1536 + sct * 512 + h * 128 + lane0 + 64]; }
    for (int i = w * 64 + lane0; i < (128 * 136 + 64 * 72 * 2 + 128 * 72) / 2; i += NTHREADS) ((LAS unsigned*)St)[i] = 0u;
    unsigned pacc = 0u, plast = 0u;
    f32x4 sacc[8];
#pragma unroll
    for (int i = 0; i < 8; ++i) sacc[i] = (f32x4){0.f, 0.f, 0.f, 0.f};
    __syncthreads();
    for (int c = 0; c < 32; ++c) {
        int lane = lane0; asm volatile("" : "+v"(lane));
        const int fr = lane & 15, fq = lane >> 4;
        const int t0 = b * TS + c * 64;
        if (PROBE_STAGE >= 0) plast = (unsigned)__builtin_amdgcn_s_memrealtime();
        unsigned short gq0[8], gq1[8];
#pragma unroll
        for (int i = 0; i < 8; ++i) { const bf16_t* gp = P + (size_t)(t0 + w + 8 * i) * P0LD + 1536 + h * 128; gq0[i] = gp[lane]; gq1[i] = gp[lane + 64]; }
        {
            const float la = a_neg * softplusf_(db[(size_t)(t0 + lane) * 8 + h] + dtb);
            const float bet = sigmoidf_(db[(size_t)(t0 + lane) * 8 + 4 + h]);
            float g = la;
#pragma unroll
            for (int o = 1; o < 64; o <<= 1) { const float n = __shfl_up(g, o); if (lane >= o) g += n; }
            const float gL = rdlane(g, 63);
            if (w == 0) { sc[lane] = g; sc[64 + lane] = __expf(g); sc[128 + lane] = bet * __expf(g); sc[192 + lane] = bet; if (lane == 0) sc[256] = __expf(gL); }
            float raw[3][11][2];
#pragma unroll
            for (int rr = 0; rr < 11; ++rr) {
                const int tl = c * 64 + 8 * w - 3 + rr; const bool ok = tl >= 0;
                const bf16_t* row = P + (size_t)(b * TS + (ok ? tl : 0)) * P0LD + h * 128 + lane;
#pragma unroll
                for (int sct = 0; sct < 3; ++sct) { const float r0 = bf2f(row[sct * 512]), r1 = bf2f(row[sct * 512 + 64]);
                    raw[sct][rr][0] = ok ? r0 : 0.f; raw[sct][rr][1] = ok ? r1 : 0.f; }
            }
            float kd0[8], kd1[8], vt0[8], vt1[8];
#pragma unroll
            for (int i = 0; i < 8; ++i) {
                const int t = 8 * w + i;
                float x[3][2];
#pragma unroll
                for (int sct = 0; sct < 3; ++sct) { float a0 = 0.f, a1 = 0.f;
#pragma unroll
                    for (int j = 0; j < 4; ++j) { a0 += cw[sct][j][0] * raw[sct][i + j][0]; a1 += cw[sct][j][1] * raw[sct][i + j][1]; }
                    x[sct][0] = siluf_(a0); x[sct][1] = siluf_(a1); }
                const float sq = wsum(x[0][0] * x[0][0] + x[0][1] * x[0][1]), sk = wsum(x[1][0] * x[1][0] + x[1][1] * x[1][1]);
                const float cq = (1.0f / sqrtf(sq + 1e-6f)) * 0.08838834764831845f, ck = 1.0f / sqrtf(sk + 1e-6f);
                const float egr = __expf(gL - rdlane(g, t));
                Qb[t * 136 + lane] = (bf16_t)f2bf(x[0][0] * cq); Qb[t * 136 + lane + 64] = (bf16_t)f2bf(x[0][1] * cq);
                const float k0 = x[1][0] * ck, k1 = x[1][1] * ck;
                Kb[t * 136 + lane] = (bf16_t)f2bf(k0); Kb[t * 136 + lane + 64] = (bf16_t)f2bf(k1);
                kd0[i] = k0 * egr; kd1[i] = k1 * egr; vt0[i] = x[2][0]; vt1[i] = x[2][1];
            }
            *(LAS u32x4*)(Kdt + lane * 72 + 8 * w) = (u32x4){pk2(kd0[0], kd0[1]), pk2(kd0[2], kd0[3]), pk2(kd0[4], kd0[5]), pk2(kd0[6], kd0[7])};
            *(LAS u32x4*)(Kdt + (lane + 64) * 72 + 8 * w) = (u32x4){pk2(kd1[0], kd1[1]), pk2(kd1[2], kd1[3]), pk2(kd1[4], kd1[5]), pk2(kd1[6], kd1[7])};
            *(LAS u32x4*)(Vt + lane * 72 + 8 * w) = (u32x4){pk2(vt0[0], vt0[1]), pk2(vt0[2], vt0[3]), pk2(vt0[4], vt0[5]), pk2(vt0[6], vt0[7])};
            *(LAS u32x4*)(Vt + (lane + 64) * 72 + 8 * w) = (u32x4){pk2(vt1[0], vt1[1]), pk2(vt1[2], vt1[3]), pk2(vt1[4], vt1[5]), pk2(vt1[6], vt1[7])};
        }
        __syncthreads();
        if (PROBE_STAGE >= 0) { const unsigned tn = (unsigned)__builtin_amdgcn_s_memrealtime(); if (PROBE_STAGE == 0) pacc += tn - plast; plast = tn; }
        {
            for (int id = w; id < 20; id += NWAVES) {
                const int which = id / 10, tix = id % 10;
                const int bi = (tix < 1) ? 0 : (tix < 3 ? 1 : (tix < 6 ? 2 : 3)); const int bj = tix - (bi * (bi + 1)) / 2;
                f32x4 acc = {0.f, 0.f, 0.f, 0.f};
                acc = mm_tile(Kb + bj * 16 * 136, 136, (which ? Qb : Kb) + bi * 16 * 136, 136, 4, acc, fr, fq);
                const int i = 16 * bi + fr; const float gi = sc[i], bi_ = sc[192 + i];
                const float av[4] = {acc.x, acc.y, acc.z, acc.w}; float ov[4];
#pragma unroll
                for (int rg = 0; rg < 4; ++rg) { const int j = 16 * bj + 4 * fq + rg; const float dec = __expf(gi - sc[j]);
                    ov[rg] = which ? ((j <= i) ? av[rg] * dec : 0.f) : ((j < i) ? bi_ * av[rg] * dec : 0.f); }
                if (which) lds_w4(QKm + i * 72 + 16 * bj + 4 * fq, (f32x4){ov[0], ov[1], ov[2], ov[3]});
                else if (bi == bj) { LAS float* d = Adg + (bi * 16 + fr) * 17 + 4 * fq; d[0] = ov[0]; d[1] = ov[1]; d[2] = ov[2]; d[3] = ov[3]; }
                else lds_w4(Aoff + i * 72 + 16 * bj + 4 * fq, (f32x4){-ov[0], -ov[1], -ov[2], -ov[3]});
            }
        }
        __syncthreads();
        if (PROBE_STAGE >= 0) { const unsigned tn = (unsigned)__builtin_amdgcn_s_memrealtime(); if (PROBE_STAGE == 1) pacc += tn - plast; plast = tn; }
        f32x4 y[4], qs[4];
        {
            if (w < 4 && lane < 16) { float x[16]; const LAS float* a = Adg + w * 16 * 17;
#pragma unroll
                for (int i = 0; i < 16; ++i) { float v = (i == lane) ? 1.f : 0.f;
#pragma unroll
                    for (int k = 0; k < i; ++k) v -= a[i * 17 + k] * x[k];
                    x[i] = v; Dg[(w * 16 + i) * 24 + lane] = (bf16_t)f2bf(v); } }
            const LAS bf16_t* Sw = St + (16 * w) * 136;
#pragma unroll
            for (int mi = 0; mi < 4; ++mi) {
                f32x4 x = mm_tile(Kb + mi * 16 * 136, 136, Sw, 136, 4, (f32x4){0.f, 0.f, 0.f, 0.f}, fr, fq);
                qs[mi] = mm_tile(Qb + mi * 16 * 136, 136, Sw, 136, 4, (f32x4){0.f, 0.f, 0.f, 0.f}, fr, fq);
                const bf16x4 vv = *(const LAS bf16x4*)(Vt + (16 * w + fr) * 72 + 16 * mi + 4 * fq);
                const f32x4 be4 = *(const LAS f32x4*)(sc + 192 + 16 * mi + 4 * fq), bg4 = *(const LAS f32x4*)(sc + 128 + 16 * mi + 4 * fq);
                y[mi].x = be4.x * bf2f((unsigned short)vv.x) - bg4.x * x.x; y[mi].y = be4.y * bf2f((unsigned short)vv.y) - bg4.y * x.y;
                y[mi].z = be4.z * bf2f((unsigned short)vv.z) - bg4.z * x.z; y[mi].w = be4.w * bf2f((unsigned short)vv.w) - bg4.w * x.w;
            }
        }
        __syncthreads();
        if (PROBE_STAGE >= 0) { const unsigned tn = (unsigned)__builtin_amdgcn_s_memrealtime(); if (PROBE_STAGE == 2) pacc += tn - plast; plast = tn; }
        {
            LAS bf16_t* Vw = Vn + (16 * w) * 72;
#pragma unroll
            for (int bb = 0; bb < 4; ++bb) {
                f32x4 acc = y[bb];
                if (bb >= 1) acc = mm_tile(Aoff + bb * 16 * 72, 72, Vw, 72, (bb + 1) / 2, acc, fr, fq);
                u32x2 pk; pk.x = pk2(acc.x, acc.y); pk.y = pk2(acc.z, acc.w);
                const bf16x4 dgf = *(const LAS bf16x4*)(Dg + (bb * 16 + fr) * 24 + 4 * fq);
                const f32x4 vb = MFMA16(dgf, __builtin_bit_cast(bf16x4, pk), ((f32x4){0.f, 0.f, 0.f, 0.f}));
                lds_w4(Vw + fr * 72 + 16 * bb + 4 * fq, vb);
                asm volatile("s_waitcnt lgkmcnt(0)" ::: "memory");
            }
            const float gl = sc[256];
#pragma unroll
            for (int mi = 0; mi < 4; ++mi) {
                const f32x4 eg4 = *(const LAS f32x4*)(sc + 64 + 16 * mi + 4 * fq);
                f32x4 o = qs[mi] * eg4;
                o = mm_tile(QKm + mi * 16 * 72, 72, Vw, 72, 2, o, fr, fq);
                qs[mi] = o;
            }
#pragma unroll
            for (int dk = 0; dk < 8; ++dk) {
                f32x4 sn = sacc[dk] * gl;
                sn = mm_tile(Kdt + dk * 16 * 72, 72, Vw, 72, 2, sn, fr, fq);
                sacc[dk] = sn;
                lds_w4(St + (16 * w + fr) * 136 + 16 * dk + 4 * fq, sn);
            }
        }
        __syncthreads();
        if (PROBE_STAGE >= 0) { const unsigned tn = (unsigned)__builtin_amdgcn_s_memrealtime(); if (PROBE_STAGE == 3) pacc += tn - plast; plast = tn; }
#pragma unroll
        for (int mi = 0; mi < 4; ++mi) { LAS float* op = Of + (16 * mi + 4 * fq) * 132 + 16 * w + fr; op[0] = qs[mi].x; op[132] = qs[mi].y; op[264] = qs[mi].z; op[396] = qs[mi].w; }
        __syncthreads();
        if (PROBE_STAGE >= 0) { const unsigned tn = (unsigned)__builtin_amdgcn_s_memrealtime(); if (PROBE_STAGE == 4) pacc += tn - plast; plast = tn; }
#pragma unroll
        for (int i = 0; i < 8; ++i) {
            const int t = w + 8 * i;
            const float o0 = Of[t * 132 + lane], o1 = Of[t * 132 + lane + 64];
            const float ss = wsum(o0 * o0 + o1 * o1), rs = 1.0f / sqrtf(ss * (1.0f / 128.0f) + 1e-6f);
            bf16_t* gp = P + (size_t)(t0 + t) * P0LD + 1536 + h * 128;
            const float g0 = bf2f(gq0[i]), g1 = bf2f(gq1[i]);
            gp[lane] = (bf16_t)f2bf(o0 * rs * onorm[lane] * siluf_(g0)); gp[lane + 64] = (bf16_t)f2bf(o1 * rs * onorm[lane + 64] * siluf_(g1));
        }
        __syncthreads();
        if (PROBE_STAGE >= 0) { const unsigned tn = (unsigned)__builtin_amdgcn_s_memrealtime(); if (PROBE_STAGE == 5) pacc += tn - plast; plast = tn; }
    }
    if (PROBE_STAGE >= 0 && F.wg == 0 && w == 0 && lane0 == 0) __hip_atomic_store((unsigned*)(F.ws + WS_CTL + 20484), pacc, __ATOMIC_RELAXED, __HIP_MEMORY_SCOPE_AGENT);
}

__device__ __forceinline__ void scan_hgrn3(const Frame& F, int b, int h) {
    const int lane0 = lane_id_v(); const int w = F.wave;
    LAS bf16_t* Qd = (LAS bf16_t*)F.lds;
    LAS bf16_t* Kp = Qd + 64 * 136;
    LAS bf16_t* Kpt = Kp + 64 * 136;
    LAS bf16_t* Vt = Kpt + 128 * 72;
    LAS bf16_t* Sc = Vt + 128 * 72;
    LAS bf16_t* Zt = Sc + 64 * 72;
    LAS float* Of = (LAS float*)(Zt + 128 * 136);
    LAS float* gl = Of + 64 * 132;
    LAS float* seg = gl + 128;
    static_assert((64 * 136 * 2 * 2 + 128 * 72 * 2 * 2 + 64 * 72 * 2 + 128 * 136 * 2 + 64 * 132 * 4 + 128 * 4 + 512 * 4) <= LDS_MISC, "hgrn3 LDS");
    bf16_t* P = (bf16_t*)(F.ws + WS_BIG + BIG_PROJ);
    const float* onorm = F.in[IN_C_ONORM];
    for (int i = w * 64 + lane0; i < (64 * 72 + 128 * 136) / 2; i += NTHREADS) ((LAS unsigned*)Sc)[i] = 0u;
    f32x4 zacc[8];
#pragma unroll
    for (int i = 0; i < 8; ++i) zacc[i] = (f32x4){0.f, 0.f, 0.f, 0.f};
    __syncthreads();
    for (int c = 0; c < 32; ++c) {
        int lane = lane0; asm volatile("" : "+v"(lane));
        const int tid = w * 64 + lane, fr = lane & 15, fq = lane >> 4, d = tid & 127, sg = tid >> 7;
        const int t0 = b * TS + c * 64;
        {
            float G[16], q[16], v[16], lf[16];
            const bf16_t* pr = P + (size_t)(t0 + 16 * sg) * P1LD + h * 128 + d;
#pragma unroll
            for (int i = 0; i < 16; ++i) { q[i] = bf2f(pr[(size_t)i * P1LD]); lf[i] = h2f_bits(pr[(size_t)i * P1LD + 1024]); v[i] = bf2f(pr[(size_t)i * P1LD + 2048]); }
            float run = 0.f;
#pragma unroll
            for (int i = 0; i < 16; ++i) { run += lf[i]; G[i] = run; }
            seg[sg * 128 + d] = run;
            __syncthreads();
            float off = 0.f;
#pragma unroll
            for (int s2 = 0; s2 < 3; ++s2) if (s2 < sg) off += seg[s2 * 128 + d];
            float kpv[16];
#pragma unroll
            for (int i = 0; i < 16; ++i) {
                const int t = 16 * sg + i; const float Gt = off + G[i];
                const float qd = q[i] * __expf(Gt); kpv[i] = -expm1f(lf[i]) * __expf(fminf(-Gt, 80.f));
                Qd[t * 136 + d] = (bf16_t)f2bf(qd); Kp[t * 136 + d] = (bf16_t)f2bf(kpv[i]);
            }
            *(LAS u32x4*)(Kpt + d * 72 + 16 * sg) = (u32x4){pk2(kpv[0], kpv[1]), pk2(kpv[2], kpv[3]), pk2(kpv[4], kpv[5]), pk2(kpv[6], kpv[7])};
            *(LAS u32x4*)(Kpt + d * 72 + 16 * sg + 8) = (u32x4){pk2(kpv[8], kpv[9]), pk2(kpv[10], kpv[11]), pk2(kpv[12], kpv[13]), pk2(kpv[14], kpv[15])};
            *(LAS u32x4*)(Vt + d * 72 + 16 * sg) = (u32x4){pk2(v[0], v[1]), pk2(v[2], v[3]), pk2(v[4], v[5]), pk2(v[6], v[7])};
            *(LAS u32x4*)(Vt + d * 72 + 16 * sg + 8) = (u32x4){pk2(v[8], v[9]), pk2(v[10], v[11]), pk2(v[12], v[13]), pk2(v[14], v[15])};
            if (sg == 3) gl[d] = __expf(off + G[15]);
        }
        __syncthreads();
        for (int id = w; id < 10; id += NWAVES) {
            const int bi = (id < 1) ? 0 : (id < 3 ? 1 : (id < 6 ? 2 : 3)); const int bj = id - (bi * (bi + 1)) / 2;
            const f32x4 acc = mm_tile(Kp + bj * 16 * 136, 136, Qd + bi * 16 * 136, 136, 4, (f32x4){0.f, 0.f, 0.f, 0.f}, fr, fq);
            const int i = 16 * bi + fr, j0 = 16 * bj + 4 * fq;
            lds_w4(Sc + i * 72 + j0, (f32x4){(j0 <= i) ? acc.x : 0.f, (j0 + 1 <= i) ? acc.y : 0.f, (j0 + 2 <= i) ? acc.z : 0.f, (j0 + 3 <= i) ? acc.w : 0.f});
        }
        __syncthreads();
        {
            const LAS bf16_t* Vw = Vt + (16 * w) * 72; const LAS bf16_t* Zw = Zt + (16 * w) * 136;
#pragma unroll
            for (int mi = 0; mi < 4; ++mi) {
                f32x4 o = mm_tile(Sc + mi * 16 * 72, 72, Vw, 72, 2, (f32x4){0.f, 0.f, 0.f, 0.f}, fr, fq);
                o = mm_tile(Qd + mi * 16 * 136, 136, Zw, 136, 4, o, fr, fq);
                LAS float* op = Of + (16 * mi + 4 * fq) * 132 + 16 * w + fr; op[0] = o.x; op[132] = o.y; op[264] = o.z; op[396] = o.w;
            }
            asm volatile("s_waitcnt lgkmcnt(0)" ::: "memory");
#pragma unroll
            for (int dk = 0; dk < 8; ++dk) {
                f32x4 zn = mm_tile(Kpt + dk * 16 * 72, 72, Vw, 72, 2, zacc[dk], fr, fq);
                const f32x4 g4 = *(const LAS f32x4*)(gl + 16 * dk + 4 * fq);
                zn = zn * g4; zacc[dk] = zn;
                lds_w4(Zt + (16 * w + fr) * 136 + 16 * dk + 4 * fq, zn);
            }
        }
        __syncthreads();
        for (int t = w; t < 64; t += NWAVES) {
            const float o0 = Of[t * 132 + lane], o1 = Of[t * 132 + lane + 64];
            const float ss = wsum(o0 * o0 + o1 * o1), rs = 1.0f / sqrtf(ss * (1.0f / 128.0f) + 1e-6f);
            bf16_t* gp = P + (size_t)(t0 + t) * P1LD + 3072 + h * 128;
            const float g0 = bf2f(gp[lane]), g1 = bf2f(gp[lane + 64]);
            gp[lane] = (bf16_t)f2bf(o0 * rs * onorm[lane] * siluf_(g0)); gp[lane + 64] = (bf16_t)f2bf(o1 * rs * onorm[lane + 64] * siluf_(g1));
        }
    }
}

__device__ __forceinline__ float tanh_fast(float x) { const float e = __expf(2.f * x); return 1.f - 2.f / (1.f + e); }
struct RwkvLd { u32x4 cu, pv; };
__device__ __forceinline__ RwkvLd rwkv_ld8(const bf16_t* Pc, int t, int gc) {
    const bf16_t* src = Pc + (size_t)t * P0LD + gc; RwkvLd r; r.cu = *(const u32x4*)src; r.pv = *(const u32x4*)(src - (t > 0 ? P0LD : 0)); return r;
}
__device__ __forceinline__ void rwkv_sh8(const RwkvLd& ld, int t, int gc, int hidx, const float* mu, const LAS float* hc, LAS float* hn, float (&sh)[8]) {
    const f32x4 h0 = *(const LAS f32x4*)(hc + hidx), h1 = *(const LAS f32x4*)(hc + hidx + 4);
    const f32x4 m0 = *(const f32x4*)(mu + gc - 2048), m1 = *(const f32x4*)(mu + gc - 2048 + 4);
    const unsigned cw_[4] = {ld.cu.x, ld.cu.y, ld.cu.z, ld.cu.w}, pw_[4] = {ld.pv.x, ld.pv.y, ld.pv.z, ld.pv.w};
    const float mv[8] = {m0.x, m0.y, m0.z, m0.w, m1.x, m1.y, m1.z, m1.w}, hv[8] = {h0.x, h0.y, h0.z, h0.w, h1.x, h1.y, h1.z, h1.w};
    float cur[8];
#pragma unroll
    for (int e = 0; e < 8; ++e) {
        cur[e] = bf2f((unsigned short)((e & 1) ? (cw_[e >> 1] >> 16) : (cw_[e >> 1] & 0xffffu)));
        const float pg = bf2f((unsigned short)((e & 1) ? (pw_[e >> 1] >> 16) : (pw_[e >> 1] & 0xffffu)));
        const float prv = (t > 0) ? pg : hv[e];
        sh[e] = cur[e] + mv[e] * (prv - cur[e]);
    }
    if (t == 63) { *(LAS f32x4*)(hn + hidx) = (f32x4){cur[0], cur[1], cur[2], cur[3]}; *(LAS f32x4*)(hn + hidx + 4) = (f32x4){cur[4], cur[5], cur[6], cur[7]}; }
}
__device__ __forceinline__ void scan_rwkv3(const Frame& F, int b, int h) {
    const int lane0 = lane_id_v(); const int w = F.wave;
    LAS unsigned char* L = F.lds;
    LAS bf16_t* RPb = (LAS bf16_t*)(L + 0);
    LAS bf16_t* KPb = (LAS bf16_t*)(L + 9216);
    LAS float* LWf = (LAS float*)(L + 18432);
    LAS float* Af = (LAS float*)(L + 34816);
    LAS float* segs = (LAS float*)(L + 51200);
    LAS bf16_t* Mak = (LAS bf16_t*)(L + 0);
    LAS bf16_t* Mrk = (LAS bf16_t*)(L + 9216);
    LAS bf16_t* Mrbn = (LAS bf16_t*)(L + 18432);
    LAS bf16_t* Aoff = (LAS bf16_t*)(L + 27648);
    LAS float* Adg = (LAS float*)(L + 36864);
    LAS bf16_t* Dg = (LAS bf16_t*)(L + 41216);
    LAS bf16_t* GB = (LAS bf16_t*)(L + 44288);
    LAS bf16_t* TL = (LAS bf16_t*)(L + 65536);
    LAS bf16_t* AL = (LAS bf16_t*)(L + 65536 + 9216);
    LAS bf16_t* SG = (LAS bf16_t*)(L + 65536 + 18432);
    LAS bf16_t* At = (LAS bf16_t*)(L + 65536);
    LAS bf16_t* Btl = (LAS bf16_t*)(L + 65536 + 9216);
    LAS bf16_t* Ktl = (LAS bf16_t*)(L + 65536 + 18432);
    LAS bf16_t* Rtl = (LAS bf16_t*)(L + 65536 + 27648);
    LAS float* Of = (LAS float*)(L + 65536);
    LAS bf16_t* BtTn = (LAS bf16_t*)(L + 102400);
    LAS bf16_t* KtT = (LAS bf16_t*)(L + 111616);
    LAS bf16_t* Vt = (LAS bf16_t*)(L + 120832);
    LAS bf16_t* Zt = (LAS bf16_t*)(L + 130048);
    LAS bf16_t* PU = (LAS bf16_t*)(L + 139264);
    LAS float* halo = (LAS float*)(L + 148480);
    LAS float* bonus = halo + 896;
    LAS float* glv = bonus + 64;
    static_assert(148480 + 4096 <= LDS_MISC, "rwkv3 LDS");
    bf16_t* P = (bf16_t*)(F.ws + WS_BIG + BIG_PROJ);
    const bf16_t* LW = (const bf16_t*)(F.ws + WS_LORA);
    const float* mu = F.in[IN_AB_MU];
    const float kkj = F.in[IN_AB_KK][h * 64 + lane0], kaj = F.in[IN_AB_KA][h * 64 + lane0], rkj = F.in[IN_AB_RK][h * 64 + lane0];
    const float lnw = F.in[IN_AB_LNW][h * 64 + lane0], lnb = F.in[IN_AB_LNB][h * 64 + lane0];
    float w0q[2], a0q[2];
#pragma unroll
    for (int q = 0; q < 2; ++q) { const int jq = ((2 * w + q) & 3) * 16 + (lane0 & 15); w0q[q] = F.in[IN_AB_W0][h * 64 + jq]; a0q[q] = F.in[IN_AB_A0][h * 64 + jq]; }
    bf16x8 yw[2][2], ya[2][2], yg[2][4];
#pragma unroll
    for (int q = 0; q < 2; ++q) { const int jrow = h * 64 + ((2 * w + q) & 3) * 16 + (lane0 & 15), fq0 = lane0 >> 4;
#pragma unroll
        for (int ksx = 0; ksx < 2; ++ksx) { yw[q][ksx] = *(const bf16x8*)(LW + (size_t)jrow * 64 + ksx * 32 + fq0 * 8); ya[q][ksx] = *(const bf16x8*)(LW + 512 * 64 + (size_t)jrow * 64 + ksx * 32 + fq0 * 8); }
#pragma unroll
        for (int ksx = 0; ksx < 4; ++ksx) yg[q][ksx] = *(const bf16x8*)(LW + 2 * 512 * 64 + (size_t)jrow * 128 + ksx * 32 + fq0 * 8); }
    f32x4 zacc[4];
#pragma unroll
    for (int i = 0; i < 4; ++i) zacc[i] = (f32x4){0.f, 0.f, 0.f, 0.f};
    for (int i = w * 64 + lane0; i < 896; i += NTHREADS) halo[i] = 0.f;
    for (int i = w * 64 + lane0; i < (64 * 72 * 2) / 2; i += NTHREADS) ((LAS unsigned*)Zt)[i] = 0u;
    __syncthreads();
    for (int c = 0; c < 32; ++c) {
        int lane = lane0; asm volatile("" : "+v"(lane));
        const int tid = w * 64 + lane, fr = lane & 15, fq = lane >> 4;
        const int t0 = b * TS + c * 64;
        {
            const LAS float* hc = halo + (c & 1) * 448; LAS float* hn = halo + ((c + 1) & 1) * 448;
            const bf16_t* Pc = P + (size_t)t0 * P0LD;
            const int t_a0 = tid >> 4, cg_a0 = tid & 15, t_a1 = (tid + NTHREADS) >> 4, cg_a1 = (tid + NTHREADS) & 15, t_b = tid >> 3, cg_b = tid & 7;
            const int gc0 = ((cg_a0 < 8) ? 2048 : 2560) + h * 64 + (cg_a0 & 7) * 8, gc1 = ((cg_a1 < 8) ? 2048 : 2560) + h * 64 + (cg_a1 & 7) * 8;
            const int gc2 = 3584 + cg_b * 8, gc3 = 3648 + cg_b * 8, gc4 = 3712 + cg_a0 * 8, gc5 = 3712 + cg_a1 * 8;
            const RwkvLd l0 = rwkv_ld8(Pc, t_a0, gc0), l1 = rwkv_ld8(Pc, t_a1, gc1), l2 = rwkv_ld8(Pc, t_b, gc2), l3 = rwkv_ld8(Pc, t_b, gc3), l4 = rwkv_ld8(Pc, t_a0, gc4), l5 = rwkv_ld8(Pc, t_a1, gc5);
            const int vcol = tid & 63, vtg = tid >> 6;
            const bf16_t* vsrc = Pc + (size_t)(8 * vtg) * P0LD + 3072 + h * 64 + vcol;
            unsigned short vr[9];
#pragma unroll
            for (int i = 0; i < 8; ++i) vr[i + 1] = vsrc[(size_t)i * P0LD];
            vr[0] = *(vsrc - (vtg > 0 ? P0LD : 0));
            float sh[8];
            { rwkv_sh8(l0, t_a0, gc0, cg_a0 * 8, mu, hc, hn, sh);
              *(LAS u32x4*)((cg_a0 < 8 ? RPb : KPb) + t_a0 * 72 + (cg_a0 & 7) * 8) = (u32x4){pk2(sh[0], sh[1]), pk2(sh[2], sh[3]), pk2(sh[4], sh[5]), pk2(sh[6], sh[7])}; }
            { rwkv_sh8(l1, t_a1, gc1, cg_a1 * 8, mu, hc, hn, sh);
              *(LAS u32x4*)((cg_a1 < 8 ? RPb : KPb) + t_a1 * 72 + (cg_a1 & 7) * 8) = (u32x4){pk2(sh[0], sh[1]), pk2(sh[2], sh[3]), pk2(sh[4], sh[5]), pk2(sh[6], sh[7])}; }
            { rwkv_sh8(l2, t_b, gc2, 192 + cg_b * 8, mu, hc, hn, sh);
              *(LAS u32x4*)(TL + t_b * 72 + cg_b * 8) = (u32x4){pk2(tanh_fast(sh[0]), tanh_fast(sh[1])), pk2(tanh_fast(sh[2]), tanh_fast(sh[3])), pk2(tanh_fast(sh[4]), tanh_fast(sh[5])), pk2(tanh_fast(sh[6]), tanh_fast(sh[7]))}; }
            { rwkv_sh8(l3, t_b, gc3, 256 + cg_b * 8, mu, hc, hn, sh);
              *(LAS u32x4*)(AL + t_b * 72 + cg_b * 8) = (u32x4){pk2(sh[0], sh[1]), pk2(sh[2], sh[3]), pk2(sh[4], sh[5]), pk2(sh[6], sh[7])}; }
            { rwkv_sh8(l4, t_a0, gc4, 320 + cg_a0 * 8, mu, hc, hn, sh);
              *(LAS u32x4*)(SG + t_a0 * 136 + cg_a0 * 8) = (u32x4){pk2(sigmoidf_(sh[0]), sigmoidf_(sh[1])), pk2(sigmoidf_(sh[2]), sigmoidf_(sh[3])), pk2(sigmoidf_(sh[4]), sigmoidf_(sh[5])), pk2(sigmoidf_(sh[6]), sigmoidf_(sh[7]))}; }
            { rwkv_sh8(l5, t_a1, gc5, 320 + cg_a1 * 8, mu, hc, hn, sh);
              *(LAS u32x4*)(SG + t_a1 * 136 + cg_a1 * 8) = (u32x4){pk2(sigmoidf_(sh[0]), sigmoidf_(sh[1])), pk2(sigmoidf_(sh[2]), sigmoidf_(sh[3])), pk2(sigmoidf_(sh[4]), sigmoidf_(sh[5])), pk2(sigmoidf_(sh[6]), sigmoidf_(sh[7]))}; }
            {
                float cur[9];
#pragma unroll
                for (int i = 0; i < 9; ++i) cur[i] = bf2f(vr[i]);
                if (vtg == 0) cur[0] = hc[128 + vcol];
                const float mvc = mu[1024 + h * 64 + vcol];
                float shv[8];
#pragma unroll
                for (int i = 0; i < 8; ++i) shv[i] = cur[i + 1] + mvc * (cur[i] - cur[i + 1]);
                if (vtg == 7) hn[128 + vcol] = cur[8];
                *(LAS u32x4*)(Vt + vcol * 72 + 8 * vtg) = (u32x4){pk2(shv[0], shv[1]), pk2(shv[2], shv[3]), pk2(shv[4], shv[5]), pk2(shv[6], shv[7])};
            }
        }
        __syncthreads();
        f32x4 agate[2];
        {
#pragma unroll
            for (int q = 0; q < 2; ++q) {
                const int id = 2 * w + q, mi = id >> 2, nj = id & 3;
                f32x4 aw = {0.f, 0.f, 0.f, 0.f}, aa = {0.f, 0.f, 0.f, 0.f}, ag = {0.f, 0.f, 0.f, 0.f};
#pragma unroll
                for (int ksx = 0; ksx < 2; ++ksx) {
                    const bf16x8 x1 = *(const LAS bf16x8*)(TL + (mi * 16 + fr) * 72 + ksx * 32 + fq * 8), x2 = *(const LAS bf16x8*)(AL + (mi * 16 + fr) * 72 + ksx * 32 + fq * 8);
                    aw = MFMA32(x1, yw[q][ksx], aw); aa = MFMA32(x2, ya[q][ksx], aa);
                }
#pragma unroll
                for (int ksx = 0; ksx < 4; ++ksx) {
                    const bf16x8 x3 = *(const LAS bf16x8*)(SG + (mi * 16 + fr) * 136 + ksx * 32 + fq * 8);
                    ag = MFMA32(x3, yg[q][ksx], ag);
                }
                agate[q] = ag;
                const int j = nj * 16 + fr; const float w0j = w0q[q], a0j = a0q[q];
                const float awv[4] = {aw.x, aw.y, aw.z, aw.w}, aav[4] = {aa.x, aa.y, aa.z, aa.w};
#pragma unroll
                for (int rg = 0; rg < 4; ++rg) { const int t = mi * 16 + 4 * fq + rg;
                    LWf[t * 64 + j] = -0.6065306597126334f * sigmoidf_(w0j + awv[rg]); Af[t * 64 + j] = sigmoidf_(a0j + aav[rg]); }
            }
        }
        __syncthreads();
        {
            float g[8]; float run = 0.f;
#pragma unroll
            for (int i = 0; i < 8; ++i) { run += LWf[(8 * w + i) * 64 + lane]; g[i] = run; }
            segs[w * 64 + lane] = run;
            __syncthreads();
            float off = 0.f;
#pragma unroll
            for (int s2 = 0; s2 < 7; ++s2) if (s2 < w) off += segs[s2 * 64 + lane];
#pragma unroll
            for (int i = 0; i < 8; ++i) LWf[(8 * w + i) * 64 + lane] = off + g[i];
        }
        __syncthreads();
        {
            const int j = lane;
            float btn[8], ktt[8];
#pragma unroll
            for (int i = 0; i < 8; ++i) {
                const int t = 8 * w + i;
                const float kv = bf2f(KPb[t * 72 + j]), rv = bf2f(RPb[t * 72 + j]), a = Af[t * 64 + j], G = LWf[t * 64 + j];
                const float Gp = (t > 0) ? LWf[(t - 1) * 64 + j] : 0.f;
                const float kx = kv * kkj; const float ss = wsum(kx * kx); const float kk = kx * (1.0f / sqrtf(ss + 1e-6f));
                const float km = kv * (1.f + (a - 1.f) * kaj);
                const float bs = wsum(rv * km * rkj); if (j == 0) bonus[t] = bs;
                const float eG = __expf(G), eGi = __expf(-G), eGp = __expf(Gp);
                const float bt = kk * a * eGi, kt = km * eGi;
                At[t * 72 + j] = (bf16_t)f2bf(kk * eGp); Btl[t * 72 + j] = (bf16_t)f2bf(bt); Ktl[t * 72 + j] = (bf16_t)f2bf(kt); Rtl[t * 72 + j] = (bf16_t)f2bf(rv * eG);
                btn[i] = -bt; ktt[i] = kt;
                if (t == 63) glv[j] = eG;
            }
            *(LAS u32x4*)(BtTn + j * 72 + 8 * w) = (u32x4){pk2(btn[0], btn[1]), pk2(btn[2], btn[3]), pk2(btn[4], btn[5]), pk2(btn[6], btn[7])};
            *(LAS u32x4*)(KtT + j * 72 + 8 * w) = (u32x4){pk2(ktt[0], ktt[1]), pk2(ktt[2], ktt[3]), pk2(ktt[4], ktt[5]), pk2(ktt[6], ktt[7])};
        }
        __syncthreads();
        {
            for (int job = w; job < 64; job += NWAVES) {
                const int mat = job >> 4, bi = (job >> 2) & 3, bj = job & 3;
                LAS bf16_t* dst = (mat == 0) ? Aoff : (mat == 1 ? Mak : (mat == 2 ? Mrk : Mrbn));
                const int i = 16 * bi + fr, j0 = 16 * bj + 4 * fq;
                f32x4 o = {0.f, 0.f, 0.f, 0.f};
                if (bj <= bi) {
                    const LAS bf16_t* Aj = ((mat == 0 || mat == 3) ? Btl : Ktl) + bj * 16 * 72; const LAS bf16_t* Bi = ((mat < 2) ? At : Rtl) + bi * 16 * 72;
                    const f32x4 acc = mm_tile(Aj, 72, Bi, 72, 2, (f32x4){0.f, 0.f, 0.f, 0.f}, fr, fq);
                    const bool incl = mat >= 2;
                    o.x = (incl ? (j0 <= i) : (j0 < i)) ? acc.x : 0.f; o.y = (incl ? (j0 + 1 <= i) : (j0 + 1 < i)) ? acc.y : 0.f;
                    o.z = (incl ? (j0 + 2 <= i) : (j0 + 2 < i)) ? acc.z : 0.f; o.w = (incl ? (j0 + 3 <= i) : (j0 + 3 < i)) ? acc.w : 0.f;
                    if (mat == 0 && bi == bj) { LAS float* dd = Adg + (bi * 16 + fr) * 17 + 4 * fq; dd[0] = o.x; dd[1] = o.y; dd[2] = o.z; dd[3] = o.w; o = (f32x4){0.f, 0.f, 0.f, 0.f}; }
                    if (mat == 0 || mat == 3) o = -o;
                }
                lds_w4(dst + i * 72 + j0, o);
            }
#pragma unroll
            for (int q = 0; q < 2; ++q) { const int id = 2 * w + q, mi = id >> 2, nj = id & 3; const int j = nj * 16 + fr; const float gv[4] = {agate[q].x, agate[q].y, agate[q].z, agate[q].w};
#pragma unroll
                for (int rg = 0; rg < 4; ++rg) GB[(mi * 16 + 4 * fq + rg) * 64 + j] = (bf16_t)f2bf(gv[rg]); }
        }
        __syncthreads();
        f32x4 ot[4];
        if (w < 4) {
            {
                const int bb = lane >> 4, jj = lane & 15; float x[16]; const LAS float* a = Adg + bb * 16 * 17;
#pragma unroll
                for (int i = 0; i < 16; ++i) { float v = (i == jj) ? 1.f : 0.f;
#pragma unroll
                    for (int k = 0; k < i; ++k) v -= a[i * 17 + k] * x[k];
                    x[i] = v; Dg[(bb * 16 + i) * 24 + jj] = (bf16_t)f2bf(v); }
                asm volatile("s_waitcnt lgkmcnt(0)" ::: "memory");
            }
            const LAS bf16_t* Vw = Vt + (16 * w) * 72; const LAS bf16_t* Zw = Zt + (16 * w) * 72; LAS bf16_t* PUw = PU + (16 * w) * 72;
            f32x4 p[4];
#pragma unroll
            for (int mi = 0; mi < 4; ++mi) { p[mi] = mm_tile(At + mi * 16 * 72, 72, Zw, 72, 2, (f32x4){0.f, 0.f, 0.f, 0.f}, fr, fq); p[mi] = mm_tile(Mak + mi * 16 * 72, 72, Vw, 72, 2, p[mi], fr, fq); }
#pragma unroll
            for (int bb = 0; bb < 4; ++bb) {
                f32x4 acc = p[bb];
                if (bb >= 1) acc = mm_tile(Aoff + bb * 16 * 72, 72, PUw, 72, (bb + 1) / 2, acc, fr, fq);
                u32x2 pk; pk.x = pk2(acc.x, acc.y); pk.y = pk2(acc.z, acc.w);
                const bf16x4 dgf = *(const LAS bf16x4*)(Dg + (bb * 16 + fr) * 24 + 4 * fq);
                const f32x4 ub = MFMA16(dgf, __builtin_bit_cast(bf16x4, pk), ((f32x4){0.f, 0.f, 0.f, 0.f}));
                lds_w4(PUw + fr * 72 + 16 * bb + 4 * fq, ub);
                asm volatile("s_waitcnt lgkmcnt(0)" ::: "memory");
            }
#pragma unroll
            for (int mi = 0; mi < 4; ++mi) {
                f32x4 o = mm_tile(Rtl + mi * 16 * 72, 72, Zw, 72, 2, (f32x4){0.f, 0.f, 0.f, 0.f}, fr, fq);
                o = mm_tile(Mrk + mi * 16 * 72, 72, Vw, 72, 2, o, fr, fq);
                ot[mi] = mm_tile(Mrbn + mi * 16 * 72, 72, PUw, 72, 2, o, fr, fq);
            }
#pragma unroll
            for (int kb = 0; kb < 4; ++kb) {
                f32x4 zn = mm_tile(KtT + kb * 16 * 72, 72, Vw, 72, 2, zacc[kb], fr, fq);
                zn = mm_tile(BtTn + kb * 16 * 72, 72, PUw, 72, 2, zn, fr, fq);
                const f32x4 g4 = *(const LAS f32x4*)(glv + 16 * kb + 4 * fq);
                zn = zn * g4; zacc[kb] = zn;
                lds_w4(Zt + (16 * w + fr) * 72 + 16 * kb + 4 * fq, zn);
            }
        }
        __syncthreads();
        if (w < 4) {
#pragma unroll
            for (int mi = 0; mi < 4; ++mi) { LAS float* op = Of + (16 * mi + 4 * fq) * 65 + 16 * w + fr; op[0] = ot[mi].x; op[65] = ot[mi].y; op[130] = ot[mi].z; op[195] = ot[mi].w; }
        }
        __syncthreads();
        for (int t = w; t < 64; t += NWAVES) {
            const float o = Of[t * 65 + lane];
            const float mean = wsum(o) * (1.0f / 64.0f); const float dlt = o - mean; const float var = wsum(dlt * dlt) * (1.0f / 64.0f);
            float y = dlt * (1.0f / sqrtf(var + 64e-5f)) * lnw + lnb;
            y += bonus[t] * bf2f(Vt[lane * 72 + t]);
            y *= bf2f(GB[t * 64 + lane]);
            P[(size_t)(t0 + t) * P0LD + 2048 + h * 64 + lane] = (bf16_t)f2bf(y);
        }
        __syncthreads();
    }
}

__device__ __forceinline__ void attn_phase(const Frame& F, const bf16_t* Q, const bf16_t* Kb, const bf16_t* VT, bf16_t* O) {
    const int lane = lane_id_v(); const int tid = F.wave * 64 + lane; (void)tid;
    const int fr = lane & 15, fq = lane >> 4;
    for (int u = F.wg; u < 512; u += F.G) {
        const int b = u >> 6, h = (u >> 4) & 3, qb = u & 15;
        const int q0 = b * TS + qb * 128 + F.wave * 16;
        bf16x8 bq[8];
#pragma unroll
        for (int ksx = 0; ksx < 8; ++ksx) bq[ksx] = *(const bf16x8*)(Q + (size_t)(q0 + fr) * 1024 + h * 256 + ksx * 32 + fq * 8);
        f32x4 sacc[16];
#pragma unroll
        for (int tl = 0; tl < 16; ++tl) {
            f32x4 a4 = {0.f, 0.f, 0.f, 0.f};
            const bf16_t* kp = Kb + (size_t)(b * 256 + tl * 16 + fr) * 1024 + h * 256 + fq * 8;
#pragma unroll
            for (int ksx = 0; ksx < 8; ++ksx) { const bf16x8 a = *(const bf16x8*)(kp + ksx * 32); a4 = __builtin_amdgcn_mfma_f32_16x16x32_bf16(a, bq[ksx], a4, 0, 0, 0); }
            sacc[tl] = a4;
        }
        float mx = -3.0e38f;
#pragma unroll
        for (int tl = 0; tl < 16; ++tl) mx = fmaxf(mx, fmaxf(fmaxf(sacc[tl].x, sacc[tl].y), fmaxf(sacc[tl].z, sacc[tl].w)));
        mx = fmaxf(mx, __shfl_xor(mx, 16)); mx = fmaxf(mx, __shfl_xor(mx, 32));
        float l = 0.f;
        bf16x8 pb[8];
#pragma unroll
        for (int ksx = 0; ksx < 8; ++ksx) {
            const f32x4 e0 = sacc[2 * ksx], e1 = sacc[2 * ksx + 1];
            const float p0 = __expf(e0.x - mx), p1 = __expf(e0.y - mx), p2 = __expf(e0.z - mx), p3 = __expf(e0.w - mx);
            const float p4 = __expf(e1.x - mx), p5 = __expf(e1.y - mx), p6 = __expf(e1.z - mx), p7 = __expf(e1.w - mx);
            l += ((p0 + p1) + (p2 + p3)) + ((p4 + p5) + (p6 + p7));
            u32x4 w; w.x = pk2(p0, p1); w.y = pk2(p2, p3); w.z = pk2(p4, p5); w.w = pk2(p6, p7);
            pb[ksx] = __builtin_bit_cast(bf16x8, w);
        }
        l += __shfl_xor(l, 16); l += __shfl_xor(l, 32);
        const float inv = 1.0f / l;
        const bf16_t* vbase = VT + (size_t)((b * 4 + h) * 256) * 256;
#pragma unroll 4
        for (int dt = 0; dt < 16; ++dt) {
            f32x4 o4 = {0.f, 0.f, 0.f, 0.f};
            const bf16_t* vp = vbase + (size_t)(dt * 16 + fr) * 256 + 4 * fq;
#pragma unroll
            for (int ksx = 0; ksx < 8; ++ksx) {
                const u32x2 lo = *(const u32x2*)(vp + ksx * 32), hi = *(const u32x2*)(vp + ksx * 32 + 16);
                u32x4 w; w.x = lo.x; w.y = lo.y; w.z = hi.x; w.w = hi.y;
                o4 = __builtin_amdgcn_mfma_f32_16x16x32_bf16(__builtin_bit_cast(bf16x8, w), pb[ksx], o4, 0, 0, 0);
            }
            u32x2 w; w.x = pk2(o4.x * inv, o4.y * inv); w.y = pk2(o4.z * inv, o4.w * inv);
            *(u32x2*)(O + (size_t)(q0 + fr) * 1024 + h * 256 + dt * 16 + 4 * fq) = w;
        }
    }
}

__device__ __forceinline__ void attn_phase2(const Frame& F, const bf16_t* Q, const bf16_t* Kb, const bf16_t* VT, bf16_t* O) {
    const int lane = lane_id_v(); const int tid = F.wave * 64 + lane; const int fr = lane & 15, fq = lane >> 4;
    LAS bf16_t* KL = (LAS bf16_t*)F.lds;
    static_assert(256 * 264 * 2 <= LDS_MISC, "attn LDS");
    for (int u = F.wg; u < 512; u += F.G) {
        const int b = u >> 6, h = (u >> 4) & 3, qb = u & 15;
        const int q0 = b * TS + qb * 128 + F.wave * 16;
        u32x4 st[16];
#pragma unroll
        for (int n = 0; n < 16; ++n) { const int idx = tid + NTHREADS * n, row = idx >> 5, c8 = idx & 31;
            st[n] = *(const u32x4*)(Kb + (size_t)(b * 256 + row) * 1024 + h * 256 + c8 * 8); }
        bf16x8 bq[8];
#pragma unroll
        for (int ksx = 0; ksx < 8; ++ksx) bq[ksx] = *(const bf16x8*)(Q + (size_t)(q0 + fr) * 1024 + h * 256 + ksx * 32 + fq * 8);
        __syncthreads();
#pragma unroll
        for (int n = 0; n < 16; ++n) { const int idx = tid + NTHREADS * n, row = idx >> 5, c8 = idx & 31; *(LAS u32x4*)(KL + row * 264 + c8 * 8) = st[n]; }
        const bf16_t* vbase = VT + (size_t)((b * 4 + h) * 256) * 256;
#pragma unroll
        for (int n = 0; n < 16; ++n) { const int idx = tid + NTHREADS * n, row = idx >> 5, c8 = idx & 31; st[n] = *(const u32x4*)(vbase + (size_t)row * 256 + c8 * 8); }
        __syncthreads();
        f32x4 sacc[16];
#pragma unroll
        for (int tl = 0; tl < 16; ++tl) {
            f32x4 a4 = {0.f, 0.f, 0.f, 0.f};
#pragma unroll
            for (int ksx = 0; ksx < 8; ++ksx) a4 = __builtin_amdgcn_mfma_f32_16x16x32_bf16(*(const LAS bf16x8*)(KL + (tl * 16 + fr) * 264 + ksx * 32 + fq * 8), bq[ksx], a4, 0, 0, 0);
            sacc[tl] = a4;
        }
        float mx = -3.0e38f;
#pragma unroll
        for (int tl = 0; tl < 16; ++tl) mx = fmaxf(mx, fmaxf(fmaxf(sacc[tl].x, sacc[tl].y), fmaxf(sacc[tl].z, sacc[tl].w)));
        mx = fmaxf(mx, __shfl_xor(mx, 16)); mx = fmaxf(mx, __shfl_xor(mx, 32));
        float l = 0.f;
        bf16x8 pb[8];
#pragma unroll
        for (int ksx = 0; ksx < 8; ++ksx) {
            const f32x4 e0 = sacc[2 * ksx], e1 = sacc[2 * ksx + 1];
            const float p0 = __expf(e0.x - mx), p1 = __expf(e0.y - mx), p2 = __expf(e0.z - mx), p3 = __expf(e0.w - mx);
            const float p4 = __expf(e1.x - mx), p5 = __expf(e1.y - mx), p6 = __expf(e1.z - mx), p7 = __expf(e1.w - mx);
            l += ((p0 + p1) + (p2 + p3)) + ((p4 + p5) + (p6 + p7));
            u32x4 w; w.x = pk2(p0, p1); w.y = pk2(p2, p3); w.z = pk2(p4, p5); w.w = pk2(p6, p7);
            pb[ksx] = __builtin_bit_cast(bf16x8, w);
        }
        l += __shfl_xor(l, 16); l += __shfl_xor(l, 32);
        const float inv = 1.0f / l;
        __syncthreads();
#pragma unroll
        for (int n = 0; n < 16; ++n) { const int idx = tid + NTHREADS * n, row = idx >> 5, c8 = idx & 31; *(LAS u32x4*)(KL + row * 264 + c8 * 8) = st[n]; }
        __syncthreads();
#pragma unroll 4
        for (int dt = 0; dt < 16; ++dt) {
            f32x4 o4 = {0.f, 0.f, 0.f, 0.f};
            const LAS bf16_t* vp = KL + (dt * 16 + fr) * 264 + 4 * fq;
#pragma unroll
            for (int ksx = 0; ksx < 8; ++ksx) {
                const u32x2 lo = *(const LAS u32x2*)(vp + ksx * 32), hi = *(const LAS u32x2*)(vp + ksx * 32 + 16);
                u32x4 w; w.x = lo.x; w.y = lo.y; w.z = hi.x; w.w = hi.y;
                o4 = __builtin_amdgcn_mfma_f32_16x16x32_bf16(__builtin_bit_cast(bf16x8, w), pb[ksx], o4, 0, 0, 0);
            }
            u32x2 w; w.x = pk2(o4.x * inv, o4.y * inv); w.y = pk2(o4.z * inv, o4.w * inv);
            *(u32x2*)(O + (size_t)(q0 + fr) * 1024 + h * 256 + dt * 16 + 4 * fq) = w;
        }
    }
    __syncthreads();
}

__device__ __forceinline__ void router_phase(const Frame& F, int layer) {
    const int lane = lane_id_v(); const int tid = F.wave * 64 + lane; (void)tid;
    const float* XF = F.out; const float* gain = F.in[IN_NORM_FFN] + layer * 1024;
    const float* wg = F.in[IN_MOE_WG] + (size_t)layer * 1024 * 4; const float* we = F.in[IN_MOE_WE] + (size_t)layer * 1024 * 16;
    const float* bg = F.in[IN_MOE_BG] + layer * 4; const float* be = F.in[IN_MOE_BE] + layer * 16;
    unsigned* cnt = (unsigned*)(F.ws + WS_CNT) + layer * 32;
    int* tokb = (int*)(F.ws + WS_ROUTE); int* tokp = tokb + NT; f32x4* tokg = (f32x4*)(tokp + NT);
    const int gw = F.wg * NWAVES + F.wave, NGW = F.G * NWAVES;
    for (int row = gw; row < NT; row += NGW) {
        const f32x4* xr = (const f32x4*)(XF + (size_t)row * 1024) + lane;
        float s = 0.f, lg[4], le[16];
#pragma unroll
        for (int c = 0; c < 4; ++c) lg[c] = 0.f;
#pragma unroll
        for (int c = 0; c < 16; ++c) le[c] = 0.f;
#pragma unroll 1
        for (int j = 0; j < 4; ++j) {
            const f32x4 v = xr[64 * j]; s += (v.x * v.x + v.y * v.y) + (v.z * v.z + v.w * v.w);
            const int k0 = 4 * lane + 256 * j; const f32x4 g = *(const f32x4*)(gain + k0);
            const float xv[4] = {v.x * g.x, v.y * g.y, v.z * g.z, v.w * g.w};
#pragma unroll
            for (int q = 0; q < 4; ++q) {
                const f32x4 a = *(const f32x4*)(wg + (size_t)(k0 + q) * 4);
                lg[0] += xv[q] * a.x; lg[1] += xv[q] * a.y; lg[2] += xv[q] * a.z; lg[3] += xv[q] * a.w;
#pragma unroll
                for (int e4 = 0; e4 < 4; ++e4) { const f32x4 w = *(const f32x4*)(we + (size_t)(k0 + q) * 16 + 4 * e4);
                    le[4 * e4] += xv[q] * w.x; le[4 * e4 + 1] += xv[q] * w.y; le[4 * e4 + 2] += xv[q] * w.z; le[4 * e4 + 3] += xv[q] * w.w; }
            }
        }
        s = wave_sum(s);
        const float rstd = 1.0f / sqrtf(s * (1.0f / 1024.0f) + 1e-6f);
#pragma unroll
        for (int c = 0; c < 4; ++c) lg[c] = wave_sum(lg[c]) * rstd + bg[c];
#pragma unroll
        for (int c = 0; c < 16; ++c) le[c] = wave_sum(le[c]) * rstd + be[c];
        int gs = 0; float gm = lg[0];
#pragma unroll
        for (int c = 1; c < 4; ++c) if (lg[c] > gm) { gm = lg[c]; gs = c; }
        float gz = 0.f;
#pragma unroll
        for (int c = 0; c < 4; ++c) gz += __expf(lg[c] - gm);
        const float ggate = 1.0f / gz;
        float l4[4];
#pragma unroll
        for (int c = 0; c < 4; ++c) { float v = le[c];
#pragma unroll
            for (int g2 = 1; g2 < 4; ++g2) v = (gs == g2) ? le[4 * g2 + c] : v;
            l4[c] = v; }
        int i0 = 0; float m0 = l4[0];
#pragma unroll
        for (int c = 1; c < 4; ++c) if (l4[c] > m0) { m0 = l4[c]; i0 = c; }
        int i1 = -1; float m1 = -3.0e38f;
#pragma unroll
        for (int c = 0; c < 4; ++c) if (c != i0 && l4[c] > m1) { m1 = l4[c]; i1 = c; }
        const float e1 = __expf(m1 - m0); const float g0 = ggate / (1.f + e1), g1 = ggate * e1 / (1.f + e1);
        const int ia = i0 < i1 ? i0 : i1, ib = i0 < i1 ? i1 : i0;
        const float ga = i0 < i1 ? g0 : g1, gb = i0 < i1 ? g1 : g0;
        const int pidx = (ia == 0) ? (ib - 1) : (ia == 1 ? ib + 1 : 5);
        const int bucket = gs * 6 + pidx;
        if (lane == 0) {
            const unsigned pos = atomicAdd(&cnt[bucket], 1u);
            tokb[row] = bucket; tokp[row] = (int)pos; tokg[row] = (f32x4){rstd, ga, gb, 0.f};
        }
    }
}
typedef float f32x16 __attribute__((ext_vector_type(16)));
__device__ __forceinline__ void router_phase2(const Frame& F, int layer) {
    const int lane = lane_id_v(); const int tid = F.wave * 64 + lane; const int w = F.wave;
    const float* XF = F.out; const float* rw = (const float*)(F.ws + WS_RW) + (size_t)layer * 1024 * 32;
    const float* ssp = (const float*)(F.ws + WS_SSP);
    unsigned* cnt = (unsigned*)(F.ws + WS_CNT) + layer * 32;
    int* tokb = (int*)(F.ws + WS_ROUTE); int* tokp = tokb + NT; f32x4* tokg = (f32x4*)(tokp + NT);
    LAS float* T = (LAS float*)F.lds + w * (32 * 132);
    LAS float* Pp = (LAS float*)F.lds;
    LAS float* Lg = Pp + 8 * 64 * 33;
    const int i31 = lane & 31, kh = lane >> 5, k0 = 128 * w;
    float bW[64];
#pragma unroll
    for (int s2 = 0; s2 < 64; ++s2) bW[s2] = rw[(size_t)(k0 + 2 * s2 + kh) * 32 + i31];
    for (int blk = F.wg; blk < NT / 64; blk += F.G) {
        const int r0 = blk * 64;
        f32x16 acc0, acc1;
#pragma unroll
        for (int e = 0; e < 16; ++e) { acc0[e] = 0.f; acc1[e] = 0.f; }
#pragma unroll
        for (int rt = 0; rt < 2; ++rt) {
#pragma unroll
            for (int n = 0; n < 16; ++n) { const int idx = lane + 64 * n, row = idx >> 5, c4 = idx & 31;
                const f32x4 v = *(const f32x4*)(XF + (size_t)(r0 + 32 * rt + row) * 1024 + k0 + 4 * c4);
                *(LAS f32x4*)(T + row * 132 + 4 * c4) = v; }
            asm volatile("s_waitcnt lgkmcnt(0)" ::: "memory");
#pragma unroll
            for (int s2 = 0; s2 < 64; ++s2) {
                const float a0 = T[i31 * 132 + 2 * s2 + kh];
                if (rt == 0) acc0 = __builtin_amdgcn_mfma_f32_32x32x2f32(a0, bW[s2], acc0, 0, 0, 0);
                else acc1 = __builtin_amdgcn_mfma_f32_32x32x2f32(a0, bW[s2], acc1, 0, 0, 0);
            }
            asm volatile("s_waitcnt lgkmcnt(0)" ::: "memory");
        }
        __syncthreads();
#pragma unroll
        for (int e = 0; e < 16; ++e) { const int row = (e & 3) + 8 * (e >> 2) + 4 * kh;
            Pp[(w * 64 + row) * 33 + i31] = acc0[e]; Pp[(w * 64 + 32 + row) * 33 + i31] = acc1[e]; }
        __syncthreads();
        for (int idx = tid; idx < 64 * 32; idx += NTHREADS) { const int row = idx >> 5, cc = idx & 31; float a = 0.f;
#pragma unroll
            for (int ww = 0; ww < 8; ++ww) a += Pp[(ww * 64 + row) * 33 + cc];
            Lg[row * 33 + cc] = a; }
        __syncthreads();
        if (tid < 64) {
            const int row = r0 + tid; const float rstd = row_rstd(ssp, row);
            const float* bg = F.in[IN_MOE_BG] + layer * 4; const float* be = F.in[IN_MOE_BE] + layer * 16;
            float lg[4], le[16];
#pragma unroll
            for (int c2 = 0; c2 < 4; ++c2) lg[c2] = Lg[tid * 33 + c2] * rstd + bg[c2];
#pragma unroll
            for (int c2 = 0; c2 < 16; ++c2) le[c2] = Lg[tid * 33 + 4 + c2] * rstd + be[c2];
            int gs = 0; float gm = lg[0];
#pragma unroll
            for (int c2 = 1; c2 < 4; ++c2) if (lg[c2] > gm) { gm = lg[c2]; gs = c2; }
            float gz = 0.f;
#pragma unroll
            for (int c2 = 0; c2 < 4; ++c2) gz += __expf(lg[c2] - gm);
            const float ggate = 1.0f / gz;
            float l4[4];
#pragma unroll
            for (int c2 = 0; c2 < 4; ++c2) { float v = le[c2];
#pragma unroll
                for (int g2 = 1; g2 < 4; ++g2) v = (gs == g2) ? le[4 * g2 + c2] : v;
                l4[c2] = v; }
            int i0 = 0; float m0 = l4[0];
#pragma unroll
            for (int c2 = 1; c2 < 4; ++c2) if (l4[c2] > m0) { m0 = l4[c2]; i0 = c2; }
            int i1 = -1; float m1 = -3.0e38f;
#pragma unroll
            for (int c2 = 0; c2 < 4; ++c2) if (c2 != i0 && l4[c2] > m1) { m1 = l4[c2]; i1 = c2; }
            const float e1 = __expf(m1 - m0); const float g0 = ggate / (1.f + e1), g1 = ggate * e1 / (1.f + e1);
            const int ia = i0 < i1 ? i0 : i1, ib = i0 < i1 ? i1 : i0;
            const float ga = i0 < i1 ? g0 : g1, gb = i0 < i1 ? g1 : g0;
            const int pidx = (ia == 0) ? (ib - 1) : (ia == 1 ? ib + 1 : 5);
            const int bucket = gs * 6 + pidx;
            const unsigned pos = atomicAdd(&cnt[bucket], 1u);
            tokb[row] = bucket; tokp[row] = (int)pos; tokg[row] = (f32x4){rstd, ga, gb, 0.f};
        }
        __syncthreads();
    }
}
__device__ __forceinline__ void gather_phase(const Frame& F, int layer) {
    const int lane = lane_id_v(); const int tid = F.wave * 64 + lane; (void)tid;
    const unsigned* cnt = (const unsigned*)(F.ws + WS_CNT) + layer * 32;
    const int* tokb = (const int*)(F.ws + WS_ROUTE); const int* tokp = tokb + NT; const f32x4* tokg = (const f32x4*)(tokp + NT); f32x4* rowinfo = (f32x4*)(tokg + NT);
    const bf16_t* XB = (const bf16_t*)(F.ws + WS_XB); bf16_t* XG = (bf16_t*)(F.ws + WS_BIG + BIG_XG);
    LAS int* off = (LAS int*)F.lds;
    if (tid == 0) { int acc = 0; for (int b = 0; b < 24; ++b) { off[b] = acc * 256; acc += ((int)cnt[b] + 255) >> 8; } }
    __syncthreads();
    const int gw = F.wg * NWAVES + F.wave, NGW = F.G * NWAVES;
    for (int tok = gw; tok < NT; tok += NGW) {
        const int row = off[tokb[tok]] + tokp[tok];
        const u32x4* src = (const u32x4*)(XB + (size_t)tok * 1024) + lane; u32x4* dst = (u32x4*)(XG + (size_t)row * 1024) + lane;
        dst[0] = src[0]; dst[64] = src[64];
        if (lane == 0) { f32x4 g = tokg[tok]; g.w = __int_as_float(tok); rowinfo[row] = g; }
    }
    __syncthreads();
}
__device__ __forceinline__ void final_phase(const Frame& F) {
    const int lane = lane_id_v(); const int tid = F.wave * 64 + lane; (void)tid;
    float* XF = F.out; const float* gain = F.in[IN_NORM_FINAL];
    const int gw = F.wg * NWAVES + F.wave, NGW = F.G * NWAVES;
    for (int row = gw; row < NT; row += NGW) {
        f32x4* xr = (f32x4*)(XF + (size_t)row * 1024) + lane;
        f32x4 v[4]; float s = 0.f;
#pragma unroll
        for (int j = 0; j < 4; ++j) { v[j] = xr[64 * j]; s += (v[j].x * v[j].x + v[j].y * v[j].y) + (v[j].z * v[j].z + v[j].w * v[j].w); }
        s = wave_sum(s);
        const float rstd = 1.0f / sqrtf(s * (1.0f / 1024.0f) + 1e-6f);
#pragma unroll
        for (int j = 0; j < 4; ++j) { const f32x4 g = *(const f32x4*)(gain + 4 * lane + 256 * j); xr[64 * j] = v[j] * rstd * g; }
    }
}

constexpr int N_PHASES = 24;
#ifndef PH_MASK
#define PH_MASK 0xFFFFFFFFu
#endif
#define IN(k) (((PH_MASK >> ((k) > 11 ? (k) - 11 : (k))) & 1u) && lo <= (k) && (k) < hi)
#define TS_STAMP(k) do { if (TS_A >= 0 && ((k) == TS_A || (k) == TS_B) && F.wg == 0 && F.wave == 0 && lane_id_v() == 0) ((volatile LAS unsigned*)(F.lds + LDS_MISC + 1024))[(k)] = (unsigned)__builtin_amdgcn_s_memrealtime(); } while (0)
#define SEAM(k) do { if (IN(k) && IN((k) + 1)) xcd_barrier(bar); TS_STAMP((k) + 1); } while (0)
#define SEAM2(k) do { if (IN(k) && IN((k) + 2)) xcd_barrier(bar); TS_STAMP((k) + 2); } while (0)

template <int LAYER>
__device__ __forceinline__ void layer_phases(const Frame& F, const XcdBarrier& bar, const int lo, const int hi) {
    constexpr int pb = LAYER * 11;
    unsigned char* const ws = F.ws;
#define WPTR(off) ((bf16_t*)(ws + (LAYER ? WS_W1 : WS_W0)) + (off))
#define XB_ ((bf16_t*)(ws + WS_XB))
#define SSP_ ((float*)(ws + WS_SSP))
#define PROJ_ ((bf16_t*)(ws + WS_BIG + BIG_PROJ))
#define KB_ (LAYER ? (bf16_t*)(ws + WS_W0) : (bf16_t*)(ws + WS_BIG + BIG_KV0))
#define VT_ (KB_ + (size_t)2048 * 1024)
#define QB_ ((bf16_t*)(ws + WS_BIG + BIG_Q))
#define ATT_ ((bf16_t*)(ws + WS_BIG + BIG_ATT))
#define XG_ ((bf16_t*)(ws + WS_BIG + BIG_XG))
#define HID_ ((bf16_t*)(ws + WS_BIG + BIG_HID))
#define CNT_ ((const unsigned*)(ws + WS_CNT) + LAYER * 32)
#define ROWINFO_ ((const f32x4*)(ws + WS_ROUTE + (size_t)NT * 8 + (size_t)NT * 16))
    if (IN(pb + 1)) {
        if (LAYER == 0) {
            pg8::Gemm g{1024, 1024, 1024, 1 << 20}; pg8::DenseSched S; S.init(NT, 3840, F.G, F.wg, XB_, 1024, WPTR(WO_WIN), 1024);
            EpiScale<0> E{PROJ_, P0LD, SSP_, 1.0f, nullptr};
            pg8::gemm_phase(F.lds, F.wave, g, S, E);
        } else {
            pg8::Gemm g{1024, 1024, 1024, 1 << 20}; pg8::DenseSched S; S.init(NT, 4096, F.G, F.wg, XB_, 1024, WPTR(WO_WIN), 1024);
            EpiScale<1> E{PROJ_, P1LD, SSP_, 1.0f, (const float*)(ws + WS_LB)};
            pg8::gemm_phase(F.lds, F.wave, g, S, E);
        }
        if (LAYER == 1) { pg8::Gemm g{1024, 1024, 1024, 1 << 20}; pg8::DenseSched S; S.init(2048, 2048, F.G, F.wg, (const bf16_t*)(ws + WS_MEMH), 1024, WPTR(WO_WKV), 1024);
          EpiKV E{KB_, VT_}; pg8::gemm_phase(F.lds, F.wave, g, S, E); }
    }
    SEAM(pb + 1);
    if (IN(pb + 2)) {
        unsigned pt0 = 0; if (PROBE_WG >= 0 && LAYER == 0) pt0 = (unsigned)__builtin_amdgcn_s_memrealtime();
        if (LAYER == 0) {
#ifndef NO_DELTA
            if (F.wg < 32) scan_delta3(F, F.wg >> 2, F.wg & 3);
#endif
#ifndef NO_RWKV
            if (F.wg >= 32 && F.wg < 96) scan_rwkv3(F, (F.wg - 32) >> 3, (F.wg - 32) & 7);
#endif
            if (F.wg >= 96) p0_late_weights(F, F.wg - 96, F.G - 96);
        } else {
#ifndef NO_HGRN
            if (F.wg < 64) scan_hgrn3(F, F.wg >> 3, F.wg & 7);
#endif
        }
        if (PROBE_WG >= 0 && LAYER == 0 && F.wg == PROBE_WG && F.wave == 0 && lane_id_v() == 0) __hip_atomic_store((unsigned*)(F.ws + WS_CTL + 20480), (unsigned)__builtin_amdgcn_s_memrealtime() - pt0, __ATOMIC_RELAXED, __HIP_MEMORY_SCOPE_AGENT);
    }
    SEAM2(pb + 2);
    if (IN(pb + 4)) {
        constexpr int lda = LAYER ? P1LD : P0LD; const bf16_t* A = PROJ_ + (LAYER ? 3072 : 1536);
        pg8::Gemm g{lda, 1024, 1024, 1 << 20}; pg8::DenseSched S; S.init(NT, 1024, F.G, F.wg, A, lda, WPTR(WO_WOUT), 1024);
        EpiResid<false> E{LAYER ? (const float*)F.out : F.in[IN_X], F.out, XB_, SSP_, nullptr};
        pg8::gemm_phase(F.lds, F.wave, g, S, E);
    }
    SEAM(pb + 4);
    if (IN(pb + 5)) {
        pg8::Gemm g{1024, 1024, 1024, 1 << 20}; pg8::DenseSched S; S.init(NT, 1024, F.G, F.wg, XB_, 1024, WPTR(WO_WQ), 1024);
        EpiScale<0> E{QB_, 1024, SSP_, 0.0625f, nullptr};
        pg8::gemm_phase(F.lds, F.wave, g, S, E);
        if (LAYER == 0) { pg8::Gemm g2{1024, 1024, 1024, 1 << 20}; pg8::DenseSched S2; S2.init(2048, 2048, F.G, F.wg, (const bf16_t*)(ws + WS_MEMH), 1024, WPTR(WO_WKV), 1024);
          EpiKV E2{KB_, VT_}; pg8::gemm_phase(F.lds, F.wave, g2, S2, E2); }
    }
    SEAM(pb + 5);
    if (IN(pb + 6)) attn_phase2(F, QB_, KB_, VT_, ATT_);
    SEAM(pb + 6);
    if (IN(pb + 7)) {
        pg8::Gemm g{1024, 1024, 1024, 1 << 20}; pg8::DenseSched S; S.init(NT, 1024, F.G, F.wg, ATT_, 1024, WPTR(WO_WO), 1024);
        EpiResid<false> E{F.out, F.out, XB_, SSP_, nullptr};
        pg8::gemm_phase(F.lds, F.wave, g, S, E);
    }
    SEAM(pb + 7);
    if (IN(pb + 8)) router_phase2(F, LAYER);
    SEAM(pb + 8);
    if (IN(pb + 9)) gather_phase(F, LAYER);
    SEAM(pb + 9);
    if (IN(pb + 10)) {
        LAS int* tbl = (LAS int*)(F.lds + LDS_MISC + 512); moe_build_table(tbl, CNT_, F.wave * 64 + lane_id_v());
        pg8::Gemm g{1024, 1024, 1024, 1 << 20}; MoeSched<false> S{tbl, __builtin_amdgcn_readfirstlane(tbl[95]), F.G, F.wg, (const char*)XG_, (const char*)WPTR(WO_W13)};
        EpiMoeUp E{HID_, ROWINFO_};
        pg8::gemm_phase(F.lds, F.wave, g, S, E);
    }
    SEAM(pb + 10);
    if (IN(pb + 11)) {
        LAS int* tbl = (LAS int*)(F.lds + LDS_MISC + 512); moe_build_table(tbl, CNT_, F.wave * 64 + lane_id_v());
        pg8::Gemm g{512, 256, 512, 4}; MoeSched<true> S{tbl, __builtin_amdgcn_readfirstlane(tbl[95]), F.G, F.wg, (const char*)HID_, (const char*)WPTR(WO_W2T)};
        EpiResid<true> E{F.out, F.out, XB_, SSP_, ROWINFO_};
        pg8::gemm_phase(F.lds, F.wave, g, S, E);
    }
    SEAM(pb + 11);
}

__global__ void __launch_bounds__(NTHREADS, 2) fwd_mega(Args args) {
    extern __shared__ __attribute__((aligned(16))) unsigned char lds_raw[];
    Frame F;
    F.lds = (LAS unsigned char*)lds_raw;
    const int tid = threadIdx.x; F.wave = __builtin_amdgcn_readfirstlane(tid >> 6);
    F.G = gridDim.x; F.wg = blockIdx.x;
    F.out = args.out; F.ws = args.ws;
    volatile LAS unsigned* MISC = (volatile LAS unsigned*)(F.lds + LDS_MISC);
    LAS unsigned long long* tab = (LAS unsigned long long*)(F.lds + LDS_MISC + 64);
    F.in.t = tab;
    if (tid < 16) MISC[tid] = 0u;
    if (tid == 0) {
#pragma unroll
        for (int i = 0; i < 38; ++i) tab[i] = (unsigned long long)args.in[i];
    }
    __syncthreads();
    XcdBarrier bar; bar.bar = (unsigned*)(F.ws + WS_CTL); bar.x = 0; bar.st = MISC; bar.wave = F.wave;
#if N_LAUNCH_MODE == 1
    bar = xcd_barrier_post((unsigned*)(F.ws + WS_CTL), MISC, F.wave);
#endif
    const int lo = args.ph_lo, hi = args.ph_hi;
    TS_STAMP(0);
    if (IN(0)) { p0_prologue(F); }
    SEAM(0);
    layer_phases<0>(F, bar, lo, hi);
    layer_phases<1>(F, bar, lo, hi);
    if (IN(23)) final_phase(F);
    if (TS_A >= 0 && F.wg == 0 && F.wave == 0) {
        asm volatile("s_waitcnt vmcnt(0)" ::: "memory");
        if (lane_id_v() == 0) { volatile LAS unsigned* ts = (volatile LAS unsigned*)(F.lds + LDS_MISC + 1024);
            float us = (float)(ts[TS_B] - ts[TS_A]) * 0.01f;
            if (PROBE_WG >= 0) us = (float)__hip_atomic_load((unsigned*)(F.ws + WS_CTL + 20480), __ATOMIC_RELAXED, __HIP_MEMORY_SCOPE_AGENT) * 0.01f;
            if (PROBE_STAGE >= 0) us = (float)__hip_atomic_load((unsigned*)(F.ws + WS_CTL + 20484), __ATOMIC_RELAXED, __HIP_MEMORY_SCOPE_AGENT) * 0.01f;
            F.out[0] = F.out[0] + us * TS_SCALE; }
    }
}
#undef IN
#undef SEAM

extern "C" void kernel_launch(void* const* d_in, const int* in_sizes, int n_in, void* d_out, int out_size, void* d_ws, size_t ws_size, hipStream_t stream) {
    static int grid = 0;
    if (grid == 0) {
        if (n_in != 38 || out_size != NT * DM || ws_size < WS_END) { fprintf(stderr, "kernel_launch: unexpected problem (n_in %d out %d ws %zu)\n", n_in, out_size, ws_size); grid = -1; return; }
        int dev = 0, cus = 0, per_cu = 0;
        if (hipGetDevice(&dev) != hipSuccess || hipDeviceGetAttribute(&cus, hipDeviceAttributeMultiprocessorCount, dev) != hipSuccess) { grid = -1; return; }
        if (hipFuncSetAttribute((const void*)fwd_mega, hipFuncAttributeMaxDynamicSharedMemorySize, LDS_BYTES) != hipSuccess) { fprintf(stderr, "kernel_launch: hipFuncSetAttribute failed\n"); grid = -1; return; }
        if (hipOccupancyMaxActiveBlocksPerMultiprocessor(&per_cu, (const void*)fwd_mega, NTHREADS, LDS_BYTES) != hipSuccess || per_cu < 1) { fprintf(stderr, "kernel_launch: occupancy query says %d\n", per_cu); (void)hipGetLastError(); grid = -1; return; }
        grid = cus;
    }
    if (grid < 0) return;
    (void)hipMemsetAsync((char*)d_ws + WS_CTL, 0, 32768, stream);
    Args a{};
    for (int i = 0; i < 38; ++i) a.in[i] = (const float*)d_in[i];
    a.out = (float*)d_out; a.ws = (unsigned char*)d_ws;
#if N_LAUNCH_MODE == 1
    a.ph_lo = 0; a.ph_hi = N_PHASES;
    void* kargs[] = {&a};
    hipError_t e = hipLaunchCooperativeKernel((const void*)fwd_mega, dim3(grid), dim3(NTHREADS), kargs, LDS_BYTES, stream);
    if (e != hipSuccess) fprintf(stderr, "kernel_launch: cooperative launch failed: %s\n", hipGetErrorString(e));
#else
    for (int p = 0; p < N_PHASES; ++p) { a.ph_lo = p; a.ph_hi = p + 1; hipLaunchKernelGGL(fwd_mega, dim3(grid), dim3(NTHREADS), LDS_BYTES, stream, a); }
#endif
}
```

```cpp
#include <hip/hip_runtime.h>
#include <cstdio>
#include <cstdint>

#ifndef N_LAUNCH_MODE
#define N_LAUNCH_MODE 1
#endif

#ifndef TS_A
#define TS_A -1
#endif
#ifndef TS_B
#define TS_B 0
#endif
#ifndef PROBE_WG
#define PROBE_WG -1
#endif
#ifndef PROBE_STAGE
#define PROBE_STAGE -1
#endif
#ifndef TS_SCALE
#define TS_SCALE 0.01f
#endif

#define LAS __attribute__((address_space(3)))
#define GAS __attribute__((address_space(1)))
typedef unsigned short bf16_t;
typedef short bf16x8 __attribute__((ext_vector_type(8)));
typedef short bf16x4 __attribute__((ext_vector_type(4)));
typedef float f32x4 __attribute__((ext_vector_type(4)));
typedef float f32x2 __attribute__((ext_vector_type(2)));
typedef unsigned u32x4 __attribute__((ext_vector_type(4)));
typedef unsigned u32x2 __attribute__((ext_vector_type(2)));

constexpr int NT = 16384, DM = 1024, NB = 8, TS = 2048, NMEM = 256;
constexpr int P0LD = 3840;
constexpr int P1LD = 4096;
constexpr int NTHREADS = 512, NWAVES = 8;

constexpr size_t MiB = 1048576;
constexpr size_t WS_CTL = 0;
constexpr size_t WS_CNT = 16384;
constexpr size_t WS_LB = 32768;
constexpr size_t WS_DB = 1 * MiB;
constexpr size_t WS_SSP = WS_DB + 512 * 1024;
constexpr size_t WS_MEMH = WS_SSP + 1 * MiB;
constexpr size_t WS_ROUTE = WS_MEMH + 4 * MiB;
constexpr size_t WS_LORA = WS_ROUTE + 800 * 1024;
constexpr size_t WS_RW = WS_LORA + 256 * 1024;
constexpr size_t WS_W0 = 8 * MiB;
static_assert(WS_RW + 2 * 1024 * 32 * 4 <= 8 * MiB, "small weights");
constexpr size_t WS_W1 = WS_W0 + 42 * MiB;
constexpr size_t WS_XB = 92 * MiB;
constexpr size_t WS_BIG = 124 * MiB;
constexpr size_t WS_END = 256 * MiB;
constexpr size_t WS_HALOB = 252 * MiB;
constexpr size_t WS_HOB = 253 * MiB;
constexpr size_t WS_HOA = 254 * MiB;
constexpr size_t WS_HOC = 252 * MiB;
constexpr size_t WS_FLAGS = 24576;
constexpr size_t WO_WIN = 0;
constexpr size_t WO_WOUT = WO_WIN + (size_t)4096 * 1024;
constexpr size_t WO_WQ = WO_WOUT + (size_t)1024 * 1024;
constexpr size_t WO_WKV = WO_WQ + (size_t)1024 * 1024;
constexpr size_t WO_WO = WO_WKV + (size_t)2048 * 1024;
constexpr size_t WO_W13 = WO_WO + (size_t)1024 * 1024;
constexpr size_t WO_W2T = WO_W13 + (size_t)16 * 512 * 1024;
constexpr size_t WO_END = WO_W2T + (size_t)16 * 1024 * 256;
static_assert(WO_END * 2 <= 42 * MiB, "weight region");
constexpr size_t BIG_PROJ = 0;
constexpr size_t BIG_KV0 = 120 * MiB;
constexpr size_t BIG_Q = 0;
constexpr size_t BIG_ATT = 32 * MiB;
constexpr size_t BIG_XG = 0;
constexpr size_t BIG_HID = 48 * MiB;
constexpr int MOE_MAXROWS = 22528;

__device__ __forceinline__ unsigned f2bf(float f) { unsigned u = __float_as_uint(f); u += 0x7fffu + ((u >> 16) & 1u); return u >> 16; }
__device__ __forceinline__ float bf2f(unsigned short b) { return __uint_as_float((unsigned)b << 16); }
__device__ __forceinline__ unsigned pk2(float lo, float hi) { return f2bf(lo) | (f2bf(hi) << 16); }
__device__ __forceinline__ float wave_sum(float v) {
#pragma unroll
    for (int o = 1; o < 64; o <<= 1) v += __shfl_xor(v, o);
    return v;
}
__device__ __forceinline__ float sigmoidf_(float x) { return 1.f / (1.f + __expf(-x)); }
__device__ __forceinline__ float siluf_(float x) { return x / (1.f + __expf(-x)); }
__device__ __forceinline__ float softplusf_(float x) { return x > 20.f ? x : log1pf(__expf(x)); }
__device__ __forceinline__ int lane_id_v() { int l; asm volatile("v_mbcnt_lo_u32_b32 %0, -1, 0\n\tv_mbcnt_hi_u32_b32 %0, -1, %0" : "=v"(l)); return l; }
#define LDS_WAIT() asm volatile("s_waitcnt lgkmcnt(0)" ::: "memory")
#define VM_WAIT() asm volatile("s_waitcnt vmcnt(0)" ::: "memory")

namespace pg8 {
constexpr int BM = 256, BK = 64, HALF = 128, HTB = HALF * BK * 2, STAGE_BYTES = 8 * HTB;
__host__ __device__ __forceinline__ int lds_byte(int r, int c) { const int st = (r >> 4) * 2 + (c >> 5), rr = r & 15, cc = c & 31, ob = rr * 64 + cc * 2; return st * 1024 + (ob ^ (((ob >> 9) & 1) << 5)); }
__host__ __device__ __forceinline__ void stage_rc(int b, int& R, int& C) { const int st = b / 1024, sb = b % 1024, swz = sb ^ (((sb >> 9) & 1) << 5); R = (st >> 1) * 16 + swz / 64; C = (st & 1) * 32 + (swz % 64) / 2; }

struct Unit { int pm, pn, aux; const char* a; const char* b0; const char* b1; };
struct Gemm { int lda, ldb, K, ksplit; };

template <class Epi, class Sched>
__device__ __forceinline__ void gemm_phase(LAS unsigned char* lds, const int wave_in, const Gemm g, const Sched& S, const Epi& E) {
    const int wid = wave_in, lane = lane_id_v(), tid = wid * 64 + lane, wr = wid >> 2, wc = wid & 3, fr = lane & 15, fq = lane >> 4;
    const int K = g.K, nt = K / BK, ks = g.ksplit;
    unsigned voffA[2], voffB[2];
#pragma unroll
    for (int i = 0; i < 2; ++i) { int R, C; stage_rc(tid * 16 + i * 8192, R, C);
        voffA[i] = (unsigned)(R * g.lda + C) * 2u; voffB[i] = (unsigned)(R * g.ldb + C) * 2u; }
    const size_t kstep = (size_t)(BK * 2);
    const size_t hstepA = (size_t)HALF * g.lda * 2, hstepB = (size_t)HALF * g.ldb * 2;
    const unsigned ldsw = (unsigned)wid * 1024u;
    const int aoff = lds_byte(wr * 64 + fr, fq * 8), boff = lds_byte(wc * 32 + fr, fq * 8);
#define PG8_SA(b, h) (((b) * 2 + (h)) * HTB)
#define PG8_SB(b, h) ((4 + (b) * 2 + (h)) * HTB)
#define PG8_STAGE(bufoff, gbase, voff) do { _Pragma("unroll") for (int _i = 0; _i < 2; ++_i) \
        __builtin_amdgcn_global_load_lds((const unsigned*)((const char*)(gbase) + (voff)[_i]), (LAS unsigned*)(lds + (bufoff) + ldsw + _i * 8192), 16, 0, 0); } while (0)
#define PG8_LDA(dst, b, h) do { _Pragma("unroll") for (int m = 0; m < 4; ++m) _Pragma("unroll") for (int k = 0; k < 2; ++k) dst[m][k] = *(const LAS bf16x8*)(lds + PG8_SA(b, h) + aoff + m * 2048 + k * 1024); } while (0)
#define PG8_LDB(dst, b, h) do { _Pragma("unroll") for (int n = 0; n < 2; ++n) _Pragma("unroll") for (int k = 0; k < 2; ++k) dst[n][k] = *(const LAS bf16x8*)(lds + PG8_SB(b, h) + boff + n * 2048 + k * 1024); } while (0)
#define PG8_MMA(ai, bj, At, Bt) do { __builtin_amdgcn_s_setprio(1); _Pragma("unroll") for (int m = 0; m < 4; ++m) _Pragma("unroll") for (int n = 0; n < 2; ++n) _Pragma("unroll") for (int k = 0; k < 2; ++k) \
        acc[ai][bj][m][n] = __builtin_amdgcn_mfma_f32_16x16x32_bf16(Bt[n][k], At[m][k], acc[ai][bj][m][n], 0, 0, 0); __builtin_amdgcn_s_setprio(0); } while (0)
#define PG8_WAIT_V(n) asm volatile("s_waitcnt vmcnt(" #n ")" ::: "memory")
#define PG8_WAIT_L(n) asm volatile("s_waitcnt lgkmcnt(" #n ")" ::: "memory")
#define PG8_BAR __builtin_amdgcn_s_barrier()
#define PG8_SCHED __builtin_amdgcn_sched_barrier(0)
    Unit cur, nxt; int ui = 0;
    if (!S.next(0, cur)) return;
    f32x4 acc[2][2][4][2];
#pragma unroll
    for (int a = 0; a < 2; ++a)
#pragma unroll
        for (int b = 0; b < 2; ++b)
#pragma unroll
            for (int m = 0; m < 4; ++m)
#pragma unroll
                for (int n = 0; n < 2; ++n) acc[a][b][m][n] = (f32x4){0.f, 0.f, 0.f, 0.f};
    bf16x8 At[4][2], B0[2][2], B1[2][2];
    const char* cA = cur.a; const char* cB = cur.b0; const char* cB1 = cur.b1;
    PG8_STAGE(PG8_SB(0, 0), cB, voffB); PG8_STAGE(PG8_SB(0, 1), cB + hstepB, voffB); PG8_STAGE(PG8_SA(0, 0), cA, voffA); PG8_STAGE(PG8_SA(0, 1), cA + hstepA, voffA);
    if (wr == 1) PG8_BAR;
    PG8_WAIT_V(2); PG8_BAR;
    PG8_STAGE(PG8_SB(1, 0), cB + kstep, voffB); PG8_STAGE(PG8_SA(1, 0), cA + kstep, voffA); PG8_STAGE(PG8_SB(1, 1), cB + hstepB + kstep, voffB);
    PG8_WAIT_V(6); PG8_BAR;
    for (;;) {
        const bool has_next = S.next(ui + 1, nxt);
        const char* nA = has_next ? nxt.a : cA; const char* nB = has_next ? nxt.b0 : cB;
        for (int t = 0; t < nt; t += 2) {
            const bool last = (t == nt - 2);
            const char* a1 = cA + (size_t)(t + 1) * kstep;
            const char* a2 = last ? nA : cA + (size_t)(t + 2) * kstep;
            const char* b2 = last ? nB : ((t + 2) < ks ? cB + (size_t)(t + 2) * kstep : cB1 + (size_t)(t + 2 - ks) * kstep);
            const char* a3 = a2 + kstep; const char* b3 = b2 + kstep;
            PG8_LDB(B0, 0, 0); PG8_LDB(B1, 0, 1); PG8_SCHED; PG8_LDA(At, 0, 0); PG8_STAGE(PG8_SA(1, 1), a1 + hstepA, voffA);
            PG8_WAIT_V(8); PG8_WAIT_L(0); PG8_BAR; PG8_MMA(0, 0, At, B0); PG8_MMA(0, 1, At, B1); PG8_BAR; PG8_SCHED;
            PG8_LDA(At, 0, 1); PG8_STAGE(PG8_SB(0, 0), b2, voffB); PG8_STAGE(PG8_SB(0, 1), b2 + hstepB, voffB); PG8_STAGE(PG8_SA(0, 0), a2, voffA);
            PG8_WAIT_V(8); PG8_WAIT_L(0); PG8_BAR; PG8_MMA(1, 0, At, B0); PG8_MMA(1, 1, At, B1); PG8_BAR; PG8_SCHED;
            PG8_LDB(B0, 1, 0); PG8_LDB(B1, 1, 1); PG8_SCHED; PG8_LDA(At, 1, 0); PG8_STAGE(PG8_SA(0, 1), a2 + hstepA, voffA);
            PG8_WAIT_V(8); PG8_WAIT_L(0); PG8_BAR; PG8_MMA(0, 0, At, B0); PG8_MMA(0, 1, At, B1); PG8_BAR; PG8_SCHED;
            PG8_LDA(At, 1, 1); PG8_STAGE(PG8_SB(1, 0), b3, voffB); PG8_STAGE(PG8_SB(1, 1), b3 + hstepB, voffB); PG8_STAGE(PG8_SA(1, 0), a3, voffA);
            PG8_WAIT_V(8); PG8_WAIT_L(0); PG8_BAR; PG8_MMA(1, 0, At, B0); PG8_MMA(1, 1, At, B1); PG8_BAR; PG8_SCHED;
        }
        if (wr == 0) PG8_BAR;
        E(acc, cur, wr, wc, fr, fq);
        if (!has_next) break;
#pragma unroll
        for (int a = 0; a < 2; ++a)
#pragma unroll
            for (int b = 0; b < 2; ++b)
#pragma unroll
                for (int m = 0; m < 4; ++m)
#pragma unroll
                    for (int n = 0; n < 2; ++n) acc[a][b][m][n] = (f32x4){0.f, 0.f, 0.f, 0.f};
        cur = nxt; cA = nA; cB = nB; cB1 = nxt.b1; ++ui;
        if (wr == 1) PG8_BAR;
    }
    PG8_WAIT_V(0);
    PG8_BAR;
#undef PG8_SA
#undef PG8_SB
#undef PG8_STAGE
#undef PG8_LDA
#undef PG8_LDB
#undef PG8_MMA
#undef PG8_WAIT_V
#undef PG8_WAIT_L
#undef PG8_BAR
#undef PG8_SCHED
}

struct DenseSched {
    int nM, nN, nwg, G, c; const char* A; const char* B; size_t tA, tB;
    __device__ void init(int M, int N, int G_, int c_, const bf16_t* A_, int lda, const bf16_t* B_, int ldb) { nM = M / 256; nN = N / 256; nwg = nM * nN; G = G_; c = c_; A = (const char*)A_; B = (const char*)B_; tA = (size_t)256 * lda * 2; tB = (size_t)256 * ldb * 2; }
    __device__ bool next(int i, Unit& u) const {
        const long L = (long)i * G + c; if (L >= nwg) return false;
        int wgid = (int)L; { const int q = nwg / 8, r = nwg % 8, xcd = wgid % 8, off = wgid / 8; wgid = (xcd < r ? xcd * (q + 1) : r * (q + 1) + (xcd - r) * q) + off; }
        const int nig = 8 * nN, gid = wgid / nig, fm = gid * 8, gsz = (nM - fm) < 8 ? (nM - fm) : 8;
        u.pm = fm + ((wgid % nig) % gsz); u.pn = (wgid % nig) / gsz; u.aux = 256;
        u.a = A + (size_t)u.pm * tA; u.b0 = B + (size_t)u.pn * tB; u.b1 = u.b0; return true;
    }
};
}
using pg8::Unit;

__device__ __forceinline__ float row_rstd(const float* ssp, int row) {
    const f32x4* p = (const f32x4*)(ssp + (size_t)row * 16);
    const f32x4 a = p[0], b = p[1], c = p[2], d = p[3];
    const float s = ((a.x + a.y) + (a.z + a.w)) + ((b.x + b.y) + (b.z + b.w)) + ((c.x + c.y) + (c.z + c.w)) + ((d.x + d.y) + (d.z + d.w));
    return 1.0f / sqrtf(s * (1.0f / 1024.0f) + 1e-6f);
}
__device__ __forceinline__ unsigned short f2h_bits(float f) { _Float16 h = (_Float16)f; return __builtin_bit_cast(unsigned short, h); }
__device__ __forceinline__ float h2f_bits(unsigned short b) { return (float)__builtin_bit_cast(_Float16, b); }

template <int MODE> struct EpiScale {
    bf16_t* O; int ldc; const float* ssp; float scale; const float* lb; bf16_t* halo;
    __device__ __forceinline__ void operator()(const f32x4 (&acc)[2][2][4][2], const Unit& u, int wr, int wc, int fr_in, int fq_in) const {
        int fr = fr_in, fq = fq_in; asm volatile("" : "+v"(fr), "+v"(fq));
#pragma unroll
        for (int ai = 0; ai < 2; ++ai)
#pragma unroll
            for (int m = 0; m < 4; ++m) {
                const int row = u.pm * 256 + ai * 128 + wr * 64 + m * 16 + fr;
                const float rs = (MODE == 2) ? scale : row_rstd(ssp, row) * scale;
#pragma unroll
                for (int bj = 0; bj < 2; ++bj)
#pragma unroll
                    for (int n = 0; n < 2; ++n) {
                        const int col = u.pn * 256 + bj * 128 + wc * 32 + n * 16 + fq * 4;
                        f32x4 v = acc[ai][bj][m][n] * rs;
                        u32x2 w;
                        if (MODE == 1) {
                            const int blk = col >> 10;
                            if (blk == 0) { v.x = siluf_(v.x); v.y = siluf_(v.y); v.z = siluf_(v.z); v.w = siluf_(v.w); }
                            if (blk == 1) {
                                const f32x4 l = *(const f32x4*)(lb + (col - 1024));
                                float o[4]; const float vv[4] = {v.x, v.y, v.z, v.w}; const float ll[4] = {l.x, l.y, l.z, l.w};
#pragma unroll
                                for (int j = 0; j < 4; ++j) o[j] = __logf(ll[j] + (1.f - ll[j]) * sigmoidf_(vv[j]));
                                w.x = (unsigned)f2h_bits(o[0]) | ((unsigned)f2h_bits(o[1]) << 16); w.y = (unsigned)f2h_bits(o[2]) | ((unsigned)f2h_bits(o[3]) << 16);
                            } else { w.x = pk2(v.x, v.y); w.y = pk2(v.z, v.w); }
                        } else { w.x = pk2(v.x, v.y); w.y = pk2(v.z, v.w); }
                        *(u32x2*)(O + (size_t)row * ldc + col) = w;
                        if (MODE == 0 && halo && col >= 2048 && (row & 63) == 63) *(u32x2*)(halo + (size_t)(row >> 6) * 1792 + (col - 2048)) = w;
                    }
            }
    }
};
struct EpiKV {
    bf16_t* Kb; bf16_t* VT;
    __device__ __forceinline__ void operator()(const f32x4 (&acc)[2][2][4][2], const Unit& u, int wr, int wc, int fr_in, int fq_in) const {
        int fr = fr_in, fq = fq_in; asm volatile("" : "+v"(fr), "+v"(fq));
#pragma unroll
        for (int ai = 0; ai < 2; ++ai)
#pragma unroll
            for (int m = 0; m < 4; ++m) {
                const int row = u.pm * 256 + ai * 128 + wr * 64 + m * 16 + fr;
#pragma unroll
                for (int bj = 0; bj < 2; ++bj)
#pragma unroll
                    for (int n = 0; n < 2; ++n) {
                        const int col = u.pn * 256 + bj * 128 + wc * 32 + n * 16 + fq * 4;
                        const f32x4 v = acc[ai][bj][m][n];
                        if (col < 1024) { u32x2 w; w.x = pk2(v.x, v.y); w.y = pk2(v.z, v.w); *(u32x2*)(Kb + (size_t)row * 1024 + col) = w; }
                        else {
                            const int c2 = col - 1024, h = c2 >> 8, d = c2 & 255, b = row >> 8, mm = row & 255;
                            bf16_t* p = VT + ((size_t)((b * 4 + h) * 256 + d)) * 256 + mm;
                            p[0] = (bf16_t)f2bf(v.x); p[256] = (bf16_t)f2bf(v.y); p[512] = (bf16_t)f2bf(v.z); p[768] = (bf16_t)f2bf(v.w);
                        }
                    }
            }
    }
};
template <bool SCATTER> struct EpiResid {
    const float* base; float* XF; bf16_t* XB; float* ssp; const f32x4* rowinfo;
    __device__ __forceinline__ void operator()(const f32x4 (&acc)[2][2][4][2], const Unit& u, int wr, int wc, int fr_in, int fq_in) const {
        int fr = fr_in, fq = fq_in; asm volatile("" : "+v"(fr), "+v"(fq));
#pragma unroll
        for (int ai = 0; ai < 2; ++ai)
#pragma unroll
            for (int m = 0; m < 4; ++m) {
                const int lrow = ai * 128 + wr * 64 + m * 16 + fr;
                const int row = u.pm * 256 + lrow;
                int tok = row; bool valid = true;
                if (SCATTER) { valid = lrow < u.aux; const f32x4 ri = rowinfo[row]; tok = valid ? __float_as_int(ri.w) : 0; }
                float ss = 0.f;
#pragma unroll
                for (int bj = 0; bj < 2; ++bj)
#pragma unroll
                    for (int n = 0; n < 2; ++n) {
                        const int col = u.pn * 256 + bj * 128 + wc * 32 + n * 16 + fq * 4;
                        const size_t off = (size_t)tok * 1024 + col;
                        const f32x4 b = *(const f32x4*)(base + off);
                        const f32x4 v = b + acc[ai][bj][m][n];
                        if (valid) { *(f32x4*)(XF + off) = v; u32x2 w; w.x = pk2(v.x, v.y); w.y = pk2(v.z, v.w); *(u32x2*)(XB + off) = w; }
                        ss += (v.x * v.x + v.y * v.y) + (v.z * v.z + v.w * v.w);
                    }
                ss += __shfl_xor(ss, 16); ss += __shfl_xor(ss, 32);
                if (valid && fq == 0) ssp[(size_t)tok * 16 + u.pn * 4 + wc] = ss;
            }
    }
};
struct EpiMoeUp {
    bf16_t* HID; const f32x4* rowinfo;
    __device__ __forceinline__ void operator()(const f32x4 (&acc)[2][2][4][2], const Unit& u, int wr, int wc, int fr_in, int fq_in) const {
        int fr = fr_in, fq = fq_in; asm volatile("" : "+v"(fr), "+v"(fq));
        const int slot = u.pn >> 1, jj = u.pn & 1;
#pragma unroll
        for (int ai = 0; ai < 2; ++ai)
#pragma unroll
            for (int m = 0; m < 4; ++m) {
                const int row = u.pm * 256 + ai * 128 + wr * 64 + m * 16 + fr;
                const f32x4 ri = rowinfo[row];
                const float rs = ri.x, gt = slot ? ri.z : ri.y;
#pragma unroll
                for (int n = 0; n < 2; ++n) {
                    const f32x4 h1 = acc[ai][0][m][n] * rs, h3 = acc[ai][1][m][n] * rs;
                    const int col = slot * 256 + jj * 128 + wc * 32 + n * 16 + fq * 4;
                    u32x2 w; w.x = pk2(siluf_(h1.x) * h3.x * gt, siluf_(h1.y) * h3.y * gt); w.y = pk2(siluf_(h1.z) * h3.z * gt, siluf_(h1.w) * h3.w * gt);
                    *(u32x2*)(HID + (size_t)row * 512 + col) = w;
                }
            }
    }
};
__device__ __forceinline__ void pair_experts(int bucket, int& ea, int& eb) {
    const int g = bucket / 6, p = bucket % 6;
    const int i = (p < 3) ? 0 : (p < 5 ? 1 : 2);
    const int j = (p < 3) ? p + 1 : (p < 5 ? p - 1 : 3);
    ea = g * 4 + i; eb = g * 4 + j;
}
template <bool DOWN> struct MoeSched {
    const LAS int* tbl; int ntiles, G, c; const char* A; const char* W;
    __device__ bool next(int i, Unit& u) const {
        const int L = i * G + c, mt = L >> 2, pn = L & 3;
        if (mt >= ntiles) return false;
        const int ent = __builtin_amdgcn_readfirstlane(tbl[mt]), bucket = ent & 255; u.aux = ent >> 8;
        int ea, eb; pair_experts(bucket, ea, eb);
        u.pm = mt; u.pn = pn;
        if (!DOWN) { u.a = A + (size_t)mt * 256 * 1024 * 2; const int e = (pn < 2) ? ea : eb; u.b0 = W + ((size_t)e * 512 + 256 * (pn & 1)) * 1024 * 2; u.b1 = u.b0; }
        else { u.a = A + (size_t)mt * 256 * 512 * 2; u.b0 = W + ((size_t)ea * 1024 + 256 * pn) * 256 * 2; u.b1 = W + ((size_t)eb * 1024 + 256 * pn) * 256 * 2; }
        return true;
    }
};
__device__ __forceinline__ void moe_build_table(LAS int* tbl, const unsigned* cnt, int tid) {
    if (tid == 0) { int mt = 0;
        for (int b = 0; b < 24; ++b) { const int nb = (int)cnt[b]; for (int r = 0; r < nb; r += 256) { const int v = (nb - r) < 256 ? (nb - r) : 256; if (mt < 95) tbl[mt] = b | (v << 8); ++mt; } }
        tbl[95] = mt < 95 ? mt : 95; }
    __syncthreads();
}

#define XB_TMO      128
#define XB_XCNT(j)  (256  + 64 * (j))
#define XB_XSUB(j)  (1280 + 64 * (j))
#define XB_XGEN(j)  (2304 + 64 * (j))
#define XB_TOP      3328
#define XB_TOPGEN   3392
#define XCD_BAR_WORDS 3456
#define XB_SPIN_CAP (1u << 22)
__device__ __forceinline__ unsigned xb_ld(unsigned* p)              { return __hip_atomic_load(p, __ATOMIC_RELAXED, __HIP_MEMORY_SCOPE_AGENT); }
__device__ __forceinline__ unsigned xb_add(unsigned* p, unsigned v) { return __hip_atomic_fetch_add(p, v, __ATOMIC_RELAXED, __HIP_MEMORY_SCOPE_AGENT); }
__device__ __forceinline__ unsigned xb_xcc_id() { return (unsigned)__builtin_amdgcn_s_getreg((3 << 11) | 20) & 0xFu; }
#define XB_SPIN(cond, bar) do { unsigned _sp = 0; while (cond) { __builtin_amdgcn_s_sleep(1); \
    if ((++_sp & 255u) == 0u) { if (xb_ld(&(bar)[XB_TMO])) break; if (_sp > XB_SPIN_CAP) { atomicAdd(&(bar)[XB_TMO], 1u); break; } } } } while (0)
struct XcdBarrier { unsigned* bar; unsigned x; volatile LAS unsigned* st; int wave; };
__device__ __forceinline__ XcdBarrier xcd_barrier_post(unsigned* bar, volatile LAS unsigned* st, int wave) {
    XcdBarrier b; b.bar = bar; b.x = xb_xcc_id(); b.st = st; b.wave = wave;
    if (wave == 0 && lane_id_v() == 0) (void)xb_add(&bar[XB_XCNT(b.x)], 1u);
    return b;
}
__device__ __forceinline__ void xcd_barrier_complete(unsigned* bar, unsigned x, unsigned& nloc, unsigned& nx) {
    const unsigned G = gridDim.x * gridDim.y * gridDim.z;
    unsigned sum, cnt, mine, sp = 0u;
    for (;;) {
        sum = 0u; cnt = 0u; mine = 0u;
#pragma unroll
        for (unsigned j = 0; j < 16; ++j) { const unsigned c = xb_ld(&bar[XB_XCNT(j)]); sum += c; cnt += (c > 0u) ? 1u : 0u; mine = (j == x) ? c : mine; }
        if (sum == G) break;
        __builtin_amdgcn_s_sleep(1);
        if ((++sp & 255u) == 0u) { if (xb_ld(&bar[XB_TMO])) break; if (sp > XB_SPIN_CAP) { atomicAdd(&bar[XB_TMO], 1u); break; } }
    }
    nloc = mine > 0u ? mine : 1u; nx = cnt > 0u ? cnt : 1u;
}
__device__ __forceinline__ void xcd_barrier(const XcdBarrier& b) {
    asm volatile("s_waitcnt vmcnt(0)" ::: "memory");
    __syncthreads();
    if (b.wave == 0 && lane_id_v() == 0) {
        unsigned* bar = b.bar;
        __builtin_amdgcn_s_waitcnt(0);
        unsigned nloc = b.st[0], nx = b.st[1];
        if (nloc == 0u) { xcd_barrier_complete(bar, b.x, nloc, nx); b.st[0] = nloc; b.st[1] = nx; }
        const unsigned old = xb_add(&bar[XB_XSUB(b.x)], 1u);
        const unsigned gen = old / nloc;
        if (old + 1u == (gen + 1u) * nloc) {
            __builtin_amdgcn_fence(__ATOMIC_RELEASE, "agent");
            asm volatile("s_waitcnt vmcnt(0)" ::: "memory");
            const unsigned og = xb_add(&bar[XB_TOP], 1u);
            const unsigned tg = og / nx;
            if (og + 1u == (tg + 1u) * nx) xb_add(&bar[XB_TOPGEN], 1u);
            else XB_SPIN(xb_ld(&bar[XB_TOPGEN]) == tg, bar);
            __builtin_amdgcn_fence(__ATOMIC_ACQUIRE, "agent");
            xb_add(&bar[XB_XGEN(b.x)], 1u);
            asm volatile("s_waitcnt vmcnt(0)" ::: "memory");
        } else {
            XB_SPIN(xb_ld(&bar[XB_XGEN(b.x)]) == gen, bar);
            __builtin_amdgcn_fence(__ATOMIC_ACQUIRE, "agent");
            asm volatile("s_waitcnt vmcnt(0)" ::: "memory");
        }
    }
    __syncthreads();
}

struct Args { const float* in[38]; float* out; unsigned char* ws; int ph_lo, ph_hi; };
constexpr int LDS_BYTES = 161792;
constexpr int LDS_MISC = 156 * 1024;
struct InTab {
    const LAS unsigned long long* t;
    __device__ __forceinline__ const float* operator[](int i) const {
        const unsigned long long v = t[i];
        const unsigned lo = __builtin_amdgcn_readfirstlane((unsigned)v), hi = __builtin_amdgcn_readfirstlane((unsigned)(v >> 32));
        return (const float*)(((unsigned long long)hi << 32) | lo); }
};
struct Frame {
    LAS unsigned char* lds; int wave, G, wg;
    InTab in; float* out; unsigned char* ws;
};
#define IN_X 0
#define IN_MEM 1
#define IN_NORM_MIX 2
#define IN_NORM_XA 3
#define IN_NORM_MEM 4
#define IN_NORM_FFN 5
#define IN_NORM_FINAL 6
#define IN_AB_WIN 7
#define IN_AB_CONV 8
#define IN_AB_ALOG 9
#define IN_AB_DTB 10
#define IN_AB_ONORM 11
#define IN_AB_MU 12
#define IN_AB_W0 13
#define IN_AB_W2 14
#define IN_AB_A0 15
#define IN_AB_A2 16
#define IN_AB_G2 17
#define IN_AB_KK 18
#define IN_AB_KA 19
#define IN_AB_RK 20
#define IN_AB_LNW 21
#define IN_AB_LNB 22
#define IN_AB_WOUT 23
#define IN_C_WIN 24
#define IN_C_LB 25
#define IN_C_ONORM 26
#define IN_C_WOUT 27
#define IN_XA_WQ 28
#define IN_XA_WKV 29
#define IN_XA_WO 30
#define IN_MOE_WG 31
#define IN_MOE_BG 32
#define IN_MOE_WE 33
#define IN_MOE_BE 34
#define IN_MOE_W1 35
#define IN_MOE_W3 36
#define IN_MOE_W2 37

__device__ __forceinline__ void p0_transpose_item(const float* W, int ld, int col0, int ncols, int K, const float* gain, bf16_t* WT, int drow0, LAS float* scr, int item, int lane) {
    const int nblk = ncols / 32, kb = item / nblk, nb = item % nblk, k0 = 64 * kb, n0 = 32 * nb;
    float vv[32];
#pragma unroll
    for (int i = 0; i < 32; ++i) vv[i] = W[(size_t)(k0 + 2 * i + (lane >> 5)) * ld + col0 + n0 + (lane & 31)];
#pragma unroll
    for (int i = 0; i < 32; ++i) { const int kk = 2 * i + (lane >> 5); float v = vv[i]; if (gain) v *= gain[k0 + kk]; scr[kk * 33 + (lane & 31)] = v; }
    LDS_WAIT(); asm volatile("" ::: "memory");
    const int c = lane & 7;
#pragma unroll
    for (int j = 0; j < 4; ++j) { const int n = (lane >> 3) + 8 * j; const LAS float* s = scr + (8 * c) * 33 + n;
        u32x4 o; o.x = pk2(s[0 * 33], s[1 * 33]); o.y = pk2(s[2 * 33], s[3 * 33]); o.z = pk2(s[4 * 33], s[5 * 33]); o.w = pk2(s[6 * 33], s[7 * 33]);
        *(u32x4*)(WT + (size_t)(drow0 + n0 + n) * K + k0 + 8 * c) = o; }
    LDS_WAIT(); asm volatile("" ::: "memory");
}
__device__ __forceinline__ void p0_weight_item(const Frame& F, int it, LAS float* scr, int lane) {
    const InTab in = F.in;
    bf16_t* W0 = (bf16_t*)(F.ws + WS_W0); bf16_t* W1 = (bf16_t*)(F.ws + WS_W1);
    if (it < 16384) {
        const int l = it >> 13; int r = it & 8191; bf16_t* W = l ? W1 : W0;
        if (r < 512) { p0_transpose_item(in[IN_XA_WQ] + (size_t)l * 1024 * 1024, 1024, 0, 1024, 1024, in[IN_NORM_XA] + l * 1024, W + WO_WQ, 0, scr, r, lane); return; }
        r -= 512;
        if (r < 1024) { p0_transpose_item(in[IN_XA_WKV] + (size_t)l * 1024 * 2048, 2048, 0, 2048, 1024, in[IN_NORM_MEM] + l * 1024, W + WO_WKV, 0, scr, r, lane); return; }
        r -= 1024;
        if (r < 512) { p0_transpose_item(in[IN_XA_WO] + (size_t)l * 1024 * 1024, 1024, 0, 1024, 1024, nullptr, W + WO_WO, 0, scr, r, lane); return; }
        r -= 512;
        if (r < 4096) { const int sub = r >> 6, item = r & 63, e = sub >> 2, j = (sub >> 1) & 1, which = sub & 1;
            const float* src = (which ? in[IN_MOE_W3] : in[IN_MOE_W1]) + (size_t)(l * 16 + e) * 1024 * 256;
            p0_transpose_item(src, 256, 128 * j, 128, 1024, in[IN_NORM_FFN] + l * 1024, W + WO_W13, e * 512 + 256 * j + 128 * which, scr, item, lane); return; }
        r -= 4096;
        { const int e = r >> 7, item = r & 127;
            p0_transpose_item(in[IN_MOE_W2] + (size_t)(l * 16 + e) * 256 * 1024, 1024, 0, 1024, 256, nullptr, W + WO_W2T + (size_t)e * 1024 * 256, 0, scr, item, lane); return; }
    }
    int r = it - 16384;
    if (r < 1024) { p0_transpose_item(in[IN_AB_WIN], 3848, 0, 2048, 1024, in[IN_NORM_MIX], W0 + WO_WIN, 0, scr, r, lane); return; }
    r -= 1024;
    if (r < 896) { p0_transpose_item(in[IN_AB_WIN], 3848, 2056, 1792, 1024, in[IN_NORM_MIX], W0 + WO_WIN, 2048, scr, r, lane); return; }
    r -= 896;
    if (r < 512) { p0_transpose_item(in[IN_AB_WOUT], 1024, 0, 1024, 1024, nullptr, W0 + WO_WOUT, 0, scr, r, lane); return; }
    r -= 512;
    if (r < 2048) { p0_transpose_item(in[IN_C_WIN], 4096, 0, 4096, 1024, in[IN_NORM_MIX] + 1024, W1 + WO_WIN, 0, scr, r, lane); return; }
    r -= 2048;
    if (r < 512) { p0_transpose_item(in[IN_C_WOUT], 1024, 0, 1024, 1024, nullptr, W1 + WO_WOUT, 0, scr, r, lane); return; }
    r -= 512;
    bf16_t* LW = (bf16_t*)(F.ws + WS_LORA);
    if (r < 16) { p0_transpose_item(in[IN_AB_W2], 512, 0, 512, 64, nullptr, LW, 0, scr, r, lane); return; }
    r -= 16;
    if (r < 16) { p0_transpose_item(in[IN_AB_A2], 512, 0, 512, 64, nullptr, LW + 512 * 64, 0, scr, r, lane); return; }
    r -= 16;
    p0_transpose_item(in[IN_AB_G2], 512, 0, 512, 128, nullptr, LW + 2 * 512 * 64, 0, scr, r, lane);
}
constexpr int P0_NITEMS = 16384 + 1024 + 896 + 512 + 2048 + 512 + 64;

template <int SEL> __device__ __forceinline__ void p0_late_weights(const Frame& F, int worker, int nworkers) {
    const int lane = lane_id_v();
    LAS float* scr = (LAS float*)(F.lds + F.wave * 16384);
    const int gw = worker * NWAVES + F.wave, NGW = nworkers * NWAVES;
    if (SEL == 0) {
        for (int it = gw; it < 8192 + 512 + 2048 + 1024; it += NGW) {
            int item;
            if (it < 8192) item = it;
            else if (it < 8192 + 512) item = 16384 + 1920 + (it - 8192);
            else if (it < 8192 + 512 + 2048) item = 16384 + 1920 + 512 + (it - 8192 - 512);
            else item = 8192 + 512 + (it - 8192 - 512 - 2048);
            p0_weight_item(F, item, scr, lane);
        }
    } else {
        for (int it = gw; it < 512 + 6656 + 512; it += NGW) {
            int item;
            if (it < 512) item = 8192 + it;
            else if (it < 512 + 6656) item = 8192 + 1536 + (it - 512);
            else item = 16384 + 1920 + 512 + 2048 + (it - 512 - 6656);
            p0_weight_item(F, item, scr, lane);
        }
    }
}
__device__ __forceinline__ void p0_prologue(const Frame& F) {
    const int lane = lane_id_v(); const int tid = F.wave * 64 + lane; (void)tid;
    LAS float* scr = (LAS float*)(F.lds + F.wave * 16384);
    const int gw = F.wg * NWAVES + F.wave, NGW = F.G * NWAVES;
    for (int it = gw; it < 1920 + 64; it += NGW) p0_weight_item(F, it < 1920 ? 16384 + it : P0_NITEMS - 64 + (it - 1920), scr, lane);
    const float* x = F.in[IN_X]; const float* gain = F.in[IN_NORM_MIX]; const float* win = F.in[IN_AB_WIN];
    bf16_t* XB = (bf16_t*)(F.ws + WS_XB); float* ssp = (float*)(F.ws + WS_SSP); float* db = (float*)(F.ws + WS_DB);
    for (int row = gw; row < NT; row += NGW) {
        const f32x4* xr = (const f32x4*)(x + (size_t)row * 1024) + lane;
        f32x4 v[4]; float s = 0.f; float d[8];
#pragma unroll
        for (int c = 0; c < 8; ++c) d[c] = 0.f;
#pragma unroll
        for (int j = 0; j < 4; ++j) {
            v[j] = xr[64 * j]; s += (v[j].x * v[j].x + v[j].y * v[j].y) + (v[j].z * v[j].z + v[j].w * v[j].w);
            const int k0 = 4 * lane + 256 * j;
            const f32x4 g = *(const f32x4*)(gain + k0);
            const float xv[4] = {v[j].x * g.x, v[j].y * g.y, v[j].z * g.z, v[j].w * g.w};
#pragma unroll
            for (int q = 0; q < 4; ++q) {
                const f32x4 w0 = *(const f32x4*)(win + (size_t)(k0 + q) * 3848 + 2048), w1 = *(const f32x4*)(win + (size_t)(k0 + q) * 3848 + 2052);
                d[0] += xv[q] * w0.x; d[1] += xv[q] * w0.y; d[2] += xv[q] * w0.z; d[3] += xv[q] * w0.w;
                d[4] += xv[q] * w1.x; d[5] += xv[q] * w1.y; d[6] += xv[q] * w1.z; d[7] += xv[q] * w1.w;
            }
        }
        s = wave_sum(s);
        const float rstd = 1.0f / sqrtf(s * (1.0f / 1024.0f) + 1e-6f);
#pragma unroll
        for (int c = 0; c < 8; ++c) d[c] = wave_sum(d[c]) * rstd;
        unsigned long long* o8 = (unsigned long long*)(XB + (size_t)row * 1024) + lane;
#pragma unroll
        for (int j = 0; j < 4; ++j) o8[64 * j] = (unsigned long long)pk2(v[j].x, v[j].y) | ((unsigned long long)pk2(v[j].z, v[j].w) << 32);
        if (lane < 16) ssp[(size_t)row * 16 + lane] = (lane == 0) ? s : 0.f;
        if (lane < 8) { float dv = d[0];
#pragma unroll
            for (int c = 1; c < 8; ++c) dv = (lane == c) ? d[c] : dv;
            db[(size_t)row * 8 + lane] = dv; }
    }
    const float* mem = F.in[IN_MEM]; bf16_t* MH = (bf16_t*)(F.ws + WS_MEMH);
    for (int row = gw; row < NB * NMEM; row += NGW) {
        const f32x4* xr = (const f32x4*)(mem + (size_t)row * 1024) + lane;
        f32x4 v[4]; float s = 0.f;
#pragma unroll
        for (int j = 0; j < 4; ++j) { v[j] = xr[64 * j]; s += (v[j].x * v[j].x + v[j].y * v[j].y) + (v[j].z * v[j].z + v[j].w * v[j].w); }
        s = wave_sum(s);
        const float rstd = 1.0f / sqrtf(s * (1.0f / 1024.0f) + 1e-6f);
        unsigned long long* o8 = (unsigned long long*)(MH + (size_t)row * 1024) + lane;
#pragma unroll
        for (int j = 0; j < 4; ++j) o8[64 * j] = (unsigned long long)pk2(v[j].x * rstd, v[j].y * rstd) | ((unsigned long long)pk2(v[j].z * rstd, v[j].w * rstd) << 32);
    }
    {
        float* rw = (float*)(F.ws + WS_RW);
        for (int idx = F.wg * NTHREADS + tid; idx < 2 * 1024 * 32; idx += F.G * NTHREADS) {
            const int l = idx >> 15, k = (idx >> 5) & 1023, cc = idx & 31;
            const float g = F.in[IN_NORM_FFN][l * 1024 + k];
            float v = 0.f;
            if (cc < 4) v = F.in[IN_MOE_WG][(size_t)l * 4096 + k * 4 + cc] * g; else if (cc < 20) v = F.in[IN_MOE_WE][(size_t)l * 16384 + k * 16 + (cc - 4)] * g;
            rw[idx] = v;
        }
    }
    if (F.wg == 0) { const float* lbp = F.in[IN_C_LB]; float* lb = (float*)(F.ws + WS_LB);
        for (int c = tid; c < 1024; c += NTHREADS) { const float a = lbp[c], b = lbp[1024 + c]; const float mx = fmaxf(a, b), ea = __expf(a - mx), eb = __expf(b - mx); lb[c] = (ea + eb) / (ea + eb) - ea / (ea + eb); } }
}

__device__ __forceinline__ void scan_delta(const Frame& F, int b, int h) {
    const int lane = lane_id_v(); const int tid = F.wave * 64 + lane; (void)tid;
    LAS float* qs = (LAS float*)F.lds;
    LAS float* ks = qs + 64 * 128;
    LAS float* vs = ks + 64 * 128;
    LAS float* os = vs + 64 * 128;
    LAS float* al = os + 64 * 128;
    LAS float* be = al + 64;
    bf16_t* P = (bf16_t*)(F.ws + WS_BIG + BIG_PROJ);
    const float* convw = F.in[IN_AB_CONV];
    const float* db = (const float*)(F.ws + WS_DB);
    const float a_neg = -__expf(F.in[IN_AB_ALOG][h]), dtb = F.in[IN_AB_DTB][h];
    const float* onorm = F.in[IN_AB_ONORM];
    const int i_dv = tid >> 2, part = tid & 3;
    float s[32];
#pragma unroll
    for (int j = 0; j < 32; ++j) s[j] = 0.f;
    for (int c = 0; c < 32; ++c) {
        const int t0 = b * TS + c * 64;
        for (int idx = tid; idx < 64 * 384; idx += NTHREADS) {
            const int t = idx / 384, cc = idx % 384, sct = cc >> 7, col = cc & 127;
            const int gcol = sct * 512 + h * 128 + col;
            float a = 0.f;
#pragma unroll
            for (int j = 0; j < 4; ++j) { const int tl = c * 64 + t - 3 + j; if (tl >= 0) a += convw[j * 1536 + gcol] * bf2f(P[(size_t)(b * TS + tl) * P0LD + gcol]); }
            a = siluf_(a);
            (sct == 0 ? qs : (sct == 1 ? ks : vs))[t * 128 + col] = a;
        }
        if (tid < 64) { const int t = tid; const float la = a_neg * softplusf_(db[(size_t)(t0 + t) * 8 + h] + dtb); al[t] = __expf(la); be[t] = sigmoidf_(db[(size_t)(t0 + t) * 8 + 4 + h]); }
        __syncthreads();
        for (int r = F.wave; r < 128; r += NWAVES) { LAS float* p = (r < 64 ? qs + r * 128 : ks + (r - 64) * 128);
            const float v0 = p[lane], v1 = p[lane + 64]; const float ss = wave_sum(v0 * v0 + v1 * v1);
            const float sc = (1.0f / sqrtf(ss + 1e-6f)) * (r < 64 ? 0.08838834764831845f : 1.0f); p[lane] = v0 * sc; p[lane + 64] = v1 * sc; }
        __syncthreads();
        for (int t = 0; t < 64; ++t) {
            const LAS f32x4* kp = (const LAS f32x4*)(ks + t * 128 + part * 32); const LAS f32x4* qp = (const LAS f32x4*)(qs + t * 128 + part * 32);
            float kt[32], qt[32];
#pragma unroll
            for (int j = 0; j < 8; ++j) { const f32x4 a = kp[j], q = qp[j]; kt[4 * j] = a.x; kt[4 * j + 1] = a.y; kt[4 * j + 2] = a.z; kt[4 * j + 3] = a.w; qt[4 * j] = q.x; qt[4 * j + 1] = q.y; qt[4 * j + 2] = q.z; qt[4 * j + 3] = q.w; }
            float p = 0.f;
#pragma unroll
            for (int j = 0; j < 32; ++j) p += s[j] * kt[j];
            p += __shfl_xor(p, 1); p += __shfl_xor(p, 2);
            const float alpha = al[t], coef = be[t] * (vs[t * 128 + i_dv] - alpha * p);
            float o = 0.f;
#pragma unroll
            for (int j = 0; j < 32; ++j) { s[j] = alpha * s[j] + coef * kt[j]; o += s[j] * qt[j]; }
            o += __shfl_xor(o, 1); o += __shfl_xor(o, 2);
            if (part == 0) os[t * 128 + i_dv] = o;
        }
        __syncthreads();
        for (int t = F.wave; t < 64; t += NWAVES) {
            const float o0 = os[t * 128 + lane], o1 = os[t * 128 + lane + 64];
            const float ss = wave_sum(o0 * o0 + o1 * o1), rs = 1.0f / sqrtf(ss * (1.0f / 128.0f) + 1e-6f);
            bf16_t* gp = P + (size_t)(t0 + t) * P0LD + 1536 + h * 128;
            const float g0 = bf2f(gp[lane]), g1 = bf2f(gp[lane + 64]);
            gp[lane] = (bf16_t)f2bf(o0 * rs * onorm[lane] * siluf_(g0)); gp[lane + 64] = (bf16_t)f2bf(o1 * rs * onorm[lane + 64] * siluf_(g1));
        }
        __syncthreads();
    }
}
__device__ __forceinline__ void scan_rwkv(const Frame& F, int b, int h) {
    const int lane = lane_id_v(); const int tid = F.wave * 64 + lane; (void)tid;
    LAS float* bufA = (LAS float*)F.lds;
    LAS float* bufB = bufA + 4096;
    LAS float* bufC = bufB + 4096;
    LAS float* R = bufC + 8192;
    LAS float* Kb = R + 4096;
    LAS float* V = Kb + 4096;
    LAS float* KK = V + 4096;
    LAS float* halo = KK + 4096;
    LAS float* bonus = halo + 896;
    bf16_t* P = (bf16_t*)(F.ws + WS_BIG + BIG_PROJ);
    const float* mu = F.in[IN_AB_MU];
    const float* w0 = F.in[IN_AB_W0] + h * 64; const float* w2 = F.in[IN_AB_W2] + h * 64;
    const float* a0 = F.in[IN_AB_A0] + h * 64; const float* a2 = F.in[IN_AB_A2] + h * 64;
    const float* g2 = F.in[IN_AB_G2] + h * 64;
    const float* k_k = F.in[IN_AB_KK] + h * 64; const float* k_a = F.in[IN_AB_KA] + h * 64; const float* r_k = F.in[IN_AB_RK] + h * 64;
    const float* ln_w = F.in[IN_AB_LNW] + h * 64; const float* ln_b = F.in[IN_AB_LNB] + h * 64;
    const int vi = tid >> 3, part = tid & 7;
    float s[8];
#pragma unroll
    for (int j = 0; j < 8; ++j) s[j] = 0.f;
    for (int i = tid; i < 896; i += NTHREADS) halo[i] = 0.f;
    __syncthreads();
    for (int c = 0; c < 32; ++c) {
        const int t0 = b * TS + c * 64;
        const LAS float* hcur = halo + (c & 1) * 448; LAS float* hnext = halo + ((c + 1) & 1) * 448;
        for (int idx = tid; idx < 64 * 448; idx += NTHREADS) {
            const int t = idx / 448, col = idx % 448;
            int gc;
            if (col < 64) gc = 2048 + h * 64 + col; else if (col < 128) gc = 2560 + h * 64 + (col - 64); else if (col < 192) gc = 3072 + h * 64 + (col - 128); else gc = 3584 + (col - 192);
            const float cur = bf2f(P[(size_t)(t0 + t) * P0LD + gc]);
            const float prev = (t > 0) ? bf2f(P[(size_t)(t0 + t - 1) * P0LD + gc]) : hcur[col];
            const float sh = cur + mu[gc - 2048] * (prev - cur);
            if (t == 63) hnext[col] = cur;
            if (col < 64) R[t * 64 + col] = sh; else if (col < 128) Kb[t * 64 + col - 64] = sh; else if (col < 192) V[t * 64 + col - 128] = sh;
            else if (col < 256) bufA[t * 64 + col - 192] = tanhf(sh); else if (col < 320) bufB[t * 64 + col - 256] = sh; else bufC[t * 128 + col - 320] = sigmoidf_(sh);
        }
        __syncthreads();
        float wv[8], av[8], gv[8];
        {
            const int j = lane, tb = F.wave * 8;
#pragma unroll
            for (int q = 0; q < 8; ++q) { wv[q] = 0.f; av[q] = 0.f; gv[q] = 0.f; }
            for (int m = 0; m < 64; ++m) { const float x2 = w2[(size_t)m * 512 + j], y2 = a2[(size_t)m * 512 + j];
#pragma unroll
                for (int q = 0; q < 8; ++q) { wv[q] += bufA[(tb + q) * 64 + m] * x2; av[q] += bufB[(tb + q) * 64 + m] * y2; } }
            for (int m = 0; m < 128; ++m) { const float z2 = g2[(size_t)m * 512 + j];
#pragma unroll
                for (int q = 0; q < 8; ++q) gv[q] += bufC[(tb + q) * 128 + m] * z2; }
#pragma unroll
            for (int q = 0; q < 8; ++q) { wv[q] = __expf(-0.6065306597126334f * sigmoidf_(w0[j] + wv[q])); av[q] = sigmoidf_(a0[j] + av[q]); }
        }
        __syncthreads();
        {
            const int j = lane, tb = F.wave * 8;
#pragma unroll
            for (int q = 0; q < 8; ++q) { bufA[(tb + q) * 64 + j] = wv[q]; bufB[(tb + q) * 64 + j] = av[q]; bufC[(tb + q) * 64 + j] = gv[q]; }
#pragma unroll
            for (int q = 0; q < 8; ++q) { const int t = tb + q; const float kv = Kb[t * 64 + j]; const float kx = kv * k_k[j]; const float ss = wave_sum(kx * kx);
                KK[t * 64 + j] = kx * (1.0f / sqrtf(ss + 1e-6f)); const float km = kv * (1.f + (av[q] - 1.f) * k_a[j]); Kb[t * 64 + j] = km;
                const float bs = wave_sum(R[t * 64 + j] * km * r_k[j]); if (j == 0) bonus[t] = bs; }
        }
        __syncthreads();
        LAS float* O = bufC + 4096;
        for (int t = 0; t < 64; ++t) {
            const LAS f32x4* p4;
            float kk[8], ww[8], aa[8], km[8], rr[8];
            p4 = (const LAS f32x4*)(KK + t * 64 + part * 8);   { const f32x4 a = p4[0], c2 = p4[1]; kk[0] = a.x; kk[1] = a.y; kk[2] = a.z; kk[3] = a.w; kk[4] = c2.x; kk[5] = c2.y; kk[6] = c2.z; kk[7] = c2.w; }
            p4 = (const LAS f32x4*)(bufA + t * 64 + part * 8); { const f32x4 a = p4[0], c2 = p4[1]; ww[0] = a.x; ww[1] = a.y; ww[2] = a.z; ww[3] = a.w; ww[4] = c2.x; ww[5] = c2.y; ww[6] = c2.z; ww[7] = c2.w; }
            p4 = (const LAS f32x4*)(bufB + t * 64 + part * 8); { const f32x4 a = p4[0], c2 = p4[1]; aa[0] = a.x; aa[1] = a.y; aa[2] = a.z; aa[3] = a.w; aa[4] = c2.x; aa[5] = c2.y; aa[6] = c2.z; aa[7] = c2.w; }
            p4 = (const LAS f32x4*)(Kb + t * 64 + part * 8);   { const f32x4 a = p4[0], c2 = p4[1]; km[0] = a.x; km[1] = a.y; km[2] = a.z; km[3] = a.w; km[4] = c2.x; km[5] = c2.y; km[6] = c2.z; km[7] = c2.w; }
            p4 = (const LAS f32x4*)(R + t * 64 + part * 8);    { const f32x4 a = p4[0], c2 = p4[1]; rr[0] = a.x; rr[1] = a.y; rr[2] = a.z; rr[3] = a.w; rr[4] = c2.x; rr[5] = c2.y; rr[6] = c2.z; rr[7] = c2.w; }
            const float vv = V[t * 64 + vi];
            float sa = 0.f;
#pragma unroll
            for (int j = 0; j < 8; ++j) sa -= s[j] * kk[j];
            sa += __shfl_xor(sa, 1); sa += __shfl_xor(sa, 2); sa += __shfl_xor(sa, 4);
            float o = 0.f;
#pragma unroll
            for (int j = 0; j < 8; ++j) { s[j] = s[j] * ww[j] + sa * (kk[j] * aa[j]) + vv * km[j]; o += s[j] * rr[j]; }
            o += __shfl_xor(o, 1); o += __shfl_xor(o, 2); o += __shfl_xor(o, 4);
            if (part == 0) O[t * 64 + vi] = o;
        }
        __syncthreads();
        for (int t = F.wave; t < 64; t += NWAVES) {
            const float o = O[t * 64 + lane];
            const float mean = wave_sum(o) * (1.0f / 64.0f); const float dlt = o - mean; const float var = wave_sum(dlt * dlt) * (1.0f / 64.0f);
            float y = dlt * (1.0f / sqrtf(var + 64e-5f)) * ln_w[lane] + ln_b[lane];
            y += bonus[t] * V[t * 64 + lane];
            y *= bufC[t * 64 + lane];
            P[(size_t)(t0 + t) * P0LD + 2048 + h * 64 + lane] = (bf16_t)f2bf(y);
        }
        __syncthreads();
    }
}
__device__ __forceinline__ void scan_hgrn(const Frame& F, int b, int h) {
    const int lane = lane_id_v(); const int tid = F.wave * 64 + lane; (void)tid;
    LAS float* qs = (LAS float*)F.lds;
    LAS float* fs = qs + 64 * 128;
    LAS float* kf = fs + 64 * 128;
    LAS float* is = kf + 64 * 128;
    bf16_t* P = (bf16_t*)(F.ws + WS_BIG + BIG_PROJ);
    const float* onorm = F.in[IN_C_ONORM];
    const int e = tid >> 2, part = tid & 3;
    float s[32];
#pragma unroll
    for (int j = 0; j < 32; ++j) s[j] = 0.f;
    for (int c = 0; c < 32; ++c) {
        const int t0 = b * TS + c * 64;
        for (int idx = tid; idx < 64 * 128; idx += NTHREADS) {
            const int t = idx >> 7, col = idx & 127; const bf16_t* pr = P + (size_t)(t0 + t) * P1LD + h * 128 + col;
            qs[idx] = bf2f(pr[0]); const float lf = h2f_bits(pr[1024]); fs[idx] = __expf(lf); kf[idx] = -expm1f(lf); is[idx] = bf2f(pr[2048]);
        }
        __syncthreads();
        for (int t = 0; t < 64; ++t) {
            const LAS f32x4* fp = (const LAS f32x4*)(fs + t * 128 + part * 32); const LAS f32x4* kp = (const LAS f32x4*)(kf + t * 128 + part * 32); const LAS f32x4* qp = (const LAS f32x4*)(qs + t * 128 + part * 32);
            const float iv = is[t * 128 + e];
            float o = 0.f;
#pragma unroll
            for (int j = 0; j < 8; ++j) { const f32x4 f = fp[j], k = kp[j], q = qp[j];
                s[4 * j] = f.x * s[4 * j] + k.x * iv; o += s[4 * j] * q.x;
                s[4 * j + 1] = f.y * s[4 * j + 1] + k.y * iv; o += s[4 * j + 1] * q.y;
                s[4 * j + 2] = f.z * s[4 * j + 2] + k.z * iv; o += s[4 * j + 2] * q.z;
                s[4 * j + 3] = f.w * s[4 * j + 3] + k.w * iv; o += s[4 * j + 3] * q.w; }
            o += __shfl_xor(o, 1); o += __shfl_xor(o, 2);
            if (part == 0) is[t * 128 + e] = o;
        }
        __syncthreads();
        for (int t = F.wave; t < 64; t += NWAVES) {
            const float o0 = is[t * 128 + lane], o1 = is[t * 128 + lane + 64];
            const float ss = wave_sum(o0 * o0 + o1 * o1), rs = 1.0f / sqrtf(ss * (1.0f / 128.0f) + 1e-6f);
            bf16_t* gp = P + (size_t)(t0 + t) * P1LD + 3072 + h * 128;
            const float g0 = bf2f(gp[lane]), g1 = bf2f(gp[lane + 64]);
            gp[lane] = (bf16_t)f2bf(o0 * rs * onorm[lane] * siluf_(g0)); gp[lane + 64] = (bf16_t)f2bf(o1 * rs * onorm[lane + 64] * siluf_(g1));
        }
        __syncthreads();
    }
}

template <int CTRL> __device__ __forceinline__ float dppf(float v) { return __int_as_float(__builtin_amdgcn_update_dpp(0, __float_as_int(v), CTRL, 0xF, 0xF, true)); }
__device__ __forceinline__ float red8(float v) { v += dppf<0xB1>(v); v += dppf<0x4E>(v); v += dppf<0x141>(v); return v; }
__device__ __forceinline__ float red16(float v) { v = red8(v); v += dppf<0x140>(v); return v; }

__device__ __forceinline__ void scan_delta2(const Frame& F, int b, int h, int qd) {
    const int lane = lane_id_v(); const int tid = F.wave * 64 + lane;
    LAS float* Kc = (LAS float*)F.lds;
    LAS float* Qc = Kc + 64 * 128;
    LAS float* Vc = Qc + 64 * 128;
    LAS float* Oc = Vc + 64 * 32;
    LAS float* al = Oc + 64 * 32;
    LAS float* be = al + 64;
    LAS float* vh = be + 64;
    bf16_t* P = (bf16_t*)(F.ws + WS_BIG + BIG_PROJ);
    const float* convw = F.in[IN_AB_CONV];
    const float* db = (const float*)(F.ws + WS_DB);
    const float a_neg = -__expf(F.in[IN_AB_ALOG][h]), dtb = F.in[IN_AB_DTB][h];
    const int w = F.wave;
    const int vcol = 1024 + h * 128 + qd * 32 + (lane & 31);
    float cwq[4][2], cwk[4][2], cwv[4];
#pragma unroll
    for (int j = 0; j < 4; ++j) { cwq[j][0] = convw[j * 1536 + h * 128 + lane]; cwq[j][1] = convw[j * 1536 + h * 128 + lane + 64];
        cwk[j][0] = convw[j * 1536 + 512 + h * 128 + lane]; cwk[j][1] = convw[j * 1536 + 512 + h * 128 + lane + 64]; cwv[j] = convw[j * 1536 + vcol]; }
    const int r = tid >> 4, part = tid & 15;
    float s[8];
#pragma unroll
    for (int j = 0; j < 8; ++j) s[j] = 0.f;
    if (tid < 192) vh[tid] = 0.f;
    __syncthreads();
    for (int c = 0; c < 32; ++c) {
        const int t0 = b * TS + c * 64;
        const LAS float* vhc = vh + (c & 1) * 96; LAS float* vhn = vh + ((c + 1) & 1) * 96;
        {
            float rq[11][2], rk[11][2], rv[11];
#pragma unroll
            for (int rr = 0; rr < 11; ++rr) {
                const int tl = c * 64 + 8 * w - 3 + rr;
                const bool ok = tl >= 0;
                const bf16_t* row = P + (size_t)(b * TS + (ok ? tl : 0)) * P0LD;
                rq[rr][0] = ok ? bf2f(row[h * 128 + lane]) : 0.f; rq[rr][1] = ok ? bf2f(row[h * 128 + lane + 64]) : 0.f;
                rk[rr][0] = ok ? bf2f(row[512 + h * 128 + lane]) : 0.f; rk[rr][1] = ok ? bf2f(row[512 + h * 128 + lane + 64]) : 0.f;
                const bool prevchunk = (8 * w - 3 + rr) < 0;
                rv[rr] = prevchunk ? vhc[(rr < 3 ? rr : 0) * 32 + (lane & 31)] : bf2f(row[vcol]);
            }
            if (w == 7 && lane < 32) { vhn[lane] = rv[8]; vhn[32 + lane] = rv[9]; vhn[64 + lane] = rv[10]; }
#pragma unroll
            for (int i = 0; i < 8; ++i) {
                const int t = 8 * w + i;
                float q0 = 0.f, q1 = 0.f, k0 = 0.f, k1 = 0.f, vv = 0.f;
#pragma unroll
                for (int j = 0; j < 4; ++j) { q0 += cwq[j][0] * rq[i + j][0]; q1 += cwq[j][1] * rq[i + j][1]; k0 += cwk[j][0] * rk[i + j][0]; k1 += cwk[j][1] * rk[i + j][1]; vv += cwv[j] * rv[i + j]; }
                q0 = siluf_(q0); q1 = siluf_(q1); k0 = siluf_(k0); k1 = siluf_(k1); vv = siluf_(vv);
                const float sq = wave_sum(q0 * q0 + q1 * q1), sk = wave_sum(k0 * k0 + k1 * k1);
                const float cq = (1.0f / sqrtf(sq + 1e-6f)) * 0.08838834764831845f, ck = 1.0f / sqrtf(sk + 1e-6f);
                Qc[t * 128 + lane] = q0 * cq; Qc[t * 128 + lane + 64] = q1 * cq; Kc[t * 128 + lane] = k0 * ck; Kc[t * 128 + lane + 64] = k1 * ck;
                if (lane < 32) Vc[t * 32 + lane] = vv;
            }
            if (lane < 8) { const int t = 8 * w + lane; const float la = a_neg * softplusf_(db[(size_t)(t0 + t) * 8 + h] + dtb); al[t] = __expf(la); be[t] = sigmoidf_(db[(size_t)(t0 + t) * 8 + 4 + h]); }
        }
        __syncthreads();
        {
            const LAS float* kp = Kc + part * 8; const LAS float* qp = Qc + part * 8;
            f32x4 ka = *(const LAS f32x4*)(kp), kb = *(const LAS f32x4*)(kp + 4), qa = *(const LAS f32x4*)(qp), qb = *(const LAS f32x4*)(qp + 4);
            float vv = Vc[r], alpha = al[0], beta = be[0];
            for (int t = 0; t < 64; ++t) {
                const int tn = (t + 1) & 63;
                const f32x4 nka = *(const LAS f32x4*)(kp + tn * 128), nkb = *(const LAS f32x4*)(kp + tn * 128 + 4), nqa = *(const LAS f32x4*)(qp + tn * 128), nqb = *(const LAS f32x4*)(qp + tn * 128 + 4);
                const float nvv = Vc[tn * 32 + r], nal = al[tn], nbe = be[tn];
                float p0 = s[0] * ka.x + s[1] * ka.y, p1 = s[2] * ka.z + s[3] * ka.w, p2 = s[4] * kb.x + s[5] * kb.y, p3 = s[6] * kb.z + s[7] * kb.w;
                const float p = red16((p0 + p1) + (p2 + p3));
                const float coef = beta * (vv - alpha * p);
                s[0] = alpha * s[0] + coef * ka.x; s[1] = alpha * s[1] + coef * ka.y; s[2] = alpha * s[2] + coef * ka.z; s[3] = alpha * s[3] + coef * ka.w;
                s[4] = alpha * s[4] + coef * kb.x; s[5] = alpha * s[5] + coef * kb.y; s[6] = alpha * s[6] + coef * kb.z; s[7] = alpha * s[7] + coef * kb.w;
                float o0 = s[0] * qa.x + s[1] * qa.y, o1 = s[2] * qa.z + s[3] * qa.w, o2 = s[4] * qb.x + s[5] * qb.y, o3 = s[6] * qb.z + s[7] * qb.w;
                const float o = red16((o0 + o1) + (o2 + o3));
                if (part == 0) Oc[t * 32 + r] = o;
                ka = nka; kb = nkb; qa = nqa; qb = nqb; vv = nvv; alpha = nal; beta = nbe;
            }
        }
        __syncthreads();
        {
            const int t = tid >> 3, c4 = (tid & 7) * 4;
            const f32x4 o = *(const LAS f32x4*)(Oc + t * 32 + c4);
            u32x2 wv; wv.x = pk2(o.x, o.y); wv.y = pk2(o.z, o.w);
            *(u32x2*)(P + (size_t)(t0 + t) * P0LD + 1024 + h * 128 + qd * 32 + c4) = wv;
        }
    }
}
__device__ __forceinline__ void fin_delta(const Frame& F) {
    const int lane = lane_id_v();
    bf16_t* P = (bf16_t*)(F.ws + WS_BIG + BIG_PROJ); const float* onorm = F.in[IN_AB_ONORM];
    const float on0 = onorm[lane], on1 = onorm[lane + 64];
    const int gw = F.wg * NWAVES + F.wave, NGW = F.G * NWAVES;
    for (int it = gw; it < NT * 4; it += NGW) {
        const int t = it >> 2, h = it & 3;
        bf16_t* row = P + (size_t)t * P0LD;
        const float o0 = bf2f(row[1024 + h * 128 + lane]), o1 = bf2f(row[1024 + h * 128 + lane + 64]);
        const float g0 = bf2f(row[1536 + h * 128 + lane]), g1 = bf2f(row[1536 + h * 128 + lane + 64]);
        const float ss = wave_sum(o0 * o0 + o1 * o1), rs = 1.0f / sqrtf(ss * (1.0f / 128.0f) + 1e-6f);
        row[1536 + h * 128 + lane] = (bf16_t)f2bf(o0 * rs * on0 * siluf_(g0)); row[1536 + h * 128 + lane + 64] = (bf16_t)f2bf(o1 * rs * on1 * siluf_(g1));
    }
}

__device__ __forceinline__ void scan_rwkv2(const Frame& F, int b, int h) {
    const int lane = lane_id_v(); const int tid = F.wave * 64 + lane;
    LAS float* R = (LAS float*)F.lds;
    LAS float* KM = R + 4096;
    LAS float* V = KM + 4096;
    LAS float* KK = V + 4096;
    LAS float* KA = KK + 4096;
    LAS float* W = KA + 4096;
    LAS bf16_t* TL = (LAS bf16_t*)(W + 4096);
    LAS bf16_t* AL = TL + 64 * 72;
    LAS bf16_t* SG = AL + 64 * 72;
    LAS float* O = (LAS float*)TL;
    LAS bf16_t* GB = SG + 64 * 136;
    LAS float* halo = (LAS float*)(GB + 4096);
    LAS float* bonus = halo + 896;
    bf16_t* P = (bf16_t*)(F.ws + WS_BIG + BIG_PROJ);
    const bf16_t* LW = (const bf16_t*)(F.ws + WS_LORA);
    const float* mu = F.in[IN_AB_MU];
    const float* w0 = F.in[IN_AB_W0] + h * 64; const float* a0 = F.in[IN_AB_A0] + h * 64;
    const float* k_k = F.in[IN_AB_KK] + h * 64; const float* k_a = F.in[IN_AB_KA] + h * 64; const float* r_k = F.in[IN_AB_RK] + h * 64;
    const float* ln_w = F.in[IN_AB_LNW] + h * 64; const float* ln_b = F.in[IN_AB_LNB] + h * 64;
    const int w = F.wave, fr = lane & 15, fq = lane >> 4;
    const int vi = tid >> 3, part = tid & 7;
    float s[8];
#pragma unroll
    for (int j = 0; j < 8; ++j) s[j] = 0.f;
    for (int i = tid; i < 896; i += NTHREADS) halo[i] = 0.f;
    int gc = 0; float muc = 0.f;
    if (tid < 448) { const int col = tid;
        if (col < 64) gc = 2048 + h * 64 + col; else if (col < 128) gc = 2560 + h * 64 + (col - 64); else if (col < 192) gc = 3072 + h * 64 + (col - 128); else gc = 3584 + (col - 192);
        muc = mu[gc - 2048]; }
    __syncthreads();
    for (int c = 0; c < 32; ++c) {
        const int t0 = b * TS + c * 64;
        if (tid < 448) {
            const int col = tid;
            LAS float* hc = halo + (c & 1) * 448; LAS float* hn = halo + ((c + 1) & 1) * 448;
            float prev = hc[col];
            const bf16_t* src = P + (size_t)t0 * P0LD + gc;
#pragma unroll 8
            for (int t = 0; t < 64; ++t) {
                const float cur = bf2f(src[(size_t)t * P0LD]);
                const float sh = cur + muc * (prev - cur);
                prev = cur;
                if (col < 64) R[t * 64 + col] = sh; else if (col < 128) KM[t * 64 + col - 64] = sh; else if (col < 192) V[t * 64 + col - 128] = sh;
                else if (col < 256) TL[t * 72 + col - 192] = (bf16_t)f2bf(tanhf(sh)); else if (col < 320) AL[t * 72 + col - 256] = (bf16_t)f2bf(sh); else SG[t * 136 + col - 320] = (bf16_t)f2bf(sigmoidf_(sh));
            }
            hn[col] = prev;
        }
        __syncthreads();
        {
#pragma unroll
            for (int q = 0; q < 2; ++q) {
                const int id = 2 * w + q, mi = id >> 2, nj = id & 3;
                f32x4 aw = {0.f, 0.f, 0.f, 0.f}, aa = {0.f, 0.f, 0.f, 0.f}, ag = {0.f, 0.f, 0.f, 0.f};
                const int jrow = h * 64 + nj * 16 + fr;
#pragma unroll
                for (int ksx = 0; ksx < 2; ++ksx) {
                    const bf16x8 x1 = *(const LAS bf16x8*)(TL + (mi * 16 + fr) * 72 + ksx * 32 + fq * 8), x2 = *(const LAS bf16x8*)(AL + (mi * 16 + fr) * 72 + ksx * 32 + fq * 8);
                    const bf16x8 y1 = *(const bf16x8*)(LW + (size_t)jrow * 64 + ksx * 32 + fq * 8), y2 = *(const bf16x8*)(LW + 512 * 64 + (size_t)jrow * 64 + ksx * 32 + fq * 8);
                    aw = __builtin_amdgcn_mfma_f32_16x16x32_bf16(x1, y1, aw, 0, 0, 0); aa = __builtin_amdgcn_mfma_f32_16x16x32_bf16(x2, y2, aa, 0, 0, 0);
                }
#pragma unroll
                for (int ksx = 0; ksx < 4; ++ksx) {
                    const bf16x8 x3 = *(const LAS bf16x8*)(SG + (mi * 16 + fr) * 136 + ksx * 32 + fq * 8);
                    const bf16x8 y3 = *(const bf16x8*)(LW + 2 * 512 * 64 + (size_t)jrow * 128 + ksx * 32 + fq * 8);
                    ag = __builtin_amdgcn_mfma_f32_16x16x32_bf16(x3, y3, ag, 0, 0, 0);
                }
                const int j = nj * 16 + fr; const float w0j = w0[j], a0j = a0[j];
                const float awv[4] = {aw.x, aw.y, aw.z, aw.w}, aav[4] = {aa.x, aa.y, aa.z, aa.w}, agv[4] = {ag.x, ag.y, ag.z, ag.w};
#pragma unroll
                for (int rg = 0; rg < 4; ++rg) { const int t = mi * 16 + 4 * fq + rg;
                    W[t * 64 + j] = __expf(-0.6065306597126334f * sigmoidf_(w0j + awv[rg])); KA[t * 64 + j] = sigmoidf_(a0j + aav[rg]); GB[t * 64 + j] = (bf16_t)f2bf(agv[rg]); }
            }
        }
        __syncthreads();
        {
            const int j = lane; const float kkj = k_k[j], kaj = k_a[j], rkj = r_k[j];
#pragma unroll
            for (int q = 0; q < 8; ++q) { const int t = w * 8 + q; const float kv = KM[t * 64 + j], a = KA[t * 64 + j]; const float kx = kv * kkj; const float ss = wave_sum(kx * kx);
                const float kk = kx * (1.0f / sqrtf(ss + 1e-6f)); KK[t * 64 + j] = kk; KA[t * 64 + j] = kk * a; const float km = kv * (1.f + (a - 1.f) * kaj); KM[t * 64 + j] = km;
                const float bs = wave_sum(R[t * 64 + j] * km * rkj); if (j == 0) bonus[t] = bs; }
        }
        __syncthreads();
        {
            const int o8 = part * 8;
            for (int t = 0; t < 64; ++t) {
                const f32x4 k0 = *(const LAS f32x4*)(KK + t * 64 + o8), k1 = *(const LAS f32x4*)(KK + t * 64 + o8 + 4);
                const f32x4 w0v = *(const LAS f32x4*)(W + t * 64 + o8), w1v = *(const LAS f32x4*)(W + t * 64 + o8 + 4);
                const f32x4 a0v = *(const LAS f32x4*)(KA + t * 64 + o8), a1v = *(const LAS f32x4*)(KA + t * 64 + o8 + 4);
                const f32x4 m0 = *(const LAS f32x4*)(KM + t * 64 + o8), m1 = *(const LAS f32x4*)(KM + t * 64 + o8 + 4);
                const f32x4 r0 = *(const LAS f32x4*)(R + t * 64 + o8), r1 = *(const LAS f32x4*)(R + t * 64 + o8 + 4);
                const float vv = V[t * 64 + vi];
                const float sa = -red8(((s[0] * k0.x + s[1] * k0.y) + (s[2] * k0.z + s[3] * k0.w)) + ((s[4] * k1.x + s[5] * k1.y) + (s[6] * k1.z + s[7] * k1.w)));
                s[0] = s[0] * w0v.x + sa * a0v.x + vv * m0.x; s[1] = s[1] * w0v.y + sa * a0v.y + vv * m0.y; s[2] = s[2] * w0v.z + sa * a0v.z + vv * m0.z; s[3] = s[3] * w0v.w + sa * a0v.w + vv * m0.w;
                s[4] = s[4] * w1v.x + sa * a1v.x + vv * m1.x; s[5] = s[5] * w1v.y + sa * a1v.y + vv * m1.y; s[6] = s[6] * w1v.z + sa * a1v.z + vv * m1.z; s[7] = s[7] * w1v.w + sa * a1v.w + vv * m1.w;
                const float o = red8(((s[0] * r0.x + s[1] * r0.y) + (s[2] * r0.z + s[3] * r0.w)) + ((s[4] * r1.x + s[5] * r1.y) + (s[6] * r1.z + s[7] * r1.w)));
                if (part == 0) O[t * 64 + vi] = o;
            }
        }
        __syncthreads();
        for (int t = w; t < 64; t += NWAVES) {
            const float o = O[t * 64 + lane];
            const float mean = wave_sum(o) * (1.0f / 64.0f); const float dlt = o - mean; const float var = wave_sum(dlt * dlt) * (1.0f / 64.0f);
            float y = dlt * (1.0f / sqrtf(var + 64e-5f)) * ln_w[lane] + ln_b[lane];
            y += bonus[t] * V[t * 64 + lane];
            y *= bf2f(GB[t * 64 + lane]);
            P[(size_t)(t0 + t) * P0LD + 2048 + h * 64 + lane] = (bf16_t)f2bf(y);
        }
        __syncthreads();
    }
}

__device__ __forceinline__ void scan_hgrn2(const Frame& F, int b, int h, int qd) {
    const int lane = lane_id_v(); const int tid = F.wave * 64 + lane;
    LAS float* qs = (LAS float*)F.lds;
    LAS float* fs = qs + 64 * 128;
    LAS float* kf = fs + 64 * 128;
    LAS float* is = kf + 64 * 128;
    bf16_t* P = (bf16_t*)(F.ws + WS_BIG + BIG_PROJ);
    const int e = tid >> 4, part = tid & 15;
    float s[8];
#pragma unroll
    for (int j = 0; j < 8; ++j) s[j] = 0.f;
    for (int c = 0; c < 32; ++c) {
        const int t0 = b * TS + c * 64;
        {
            const int t = tid >> 3, c16 = (tid & 7) * 16;
            const bf16_t* pr = P + (size_t)(t0 + t) * P1LD + h * 128 + c16;
            const u32x4 qa = *(const u32x4*)pr, qb = *(const u32x4*)(pr + 8), la = *(const u32x4*)(pr + 1024), lb2 = *(const u32x4*)(pr + 1024 + 8);
            const unsigned qv[8] = {qa.x, qa.y, qa.z, qa.w, qb.x, qb.y, qb.z, qb.w}, lv[8] = {la.x, la.y, la.z, la.w, lb2.x, lb2.y, lb2.z, lb2.w};
#pragma unroll
            for (int j = 0; j < 8; ++j) {
                qs[t * 128 + c16 + 2 * j] = bf2f((unsigned short)(qv[j] & 0xffffu)); qs[t * 128 + c16 + 2 * j + 1] = bf2f((unsigned short)(qv[j] >> 16));
                const float l0 = h2f_bits((unsigned short)(lv[j] & 0xffffu)), l1 = h2f_bits((unsigned short)(lv[j] >> 16));
                fs[t * 128 + c16 + 2 * j] = __expf(l0); fs[t * 128 + c16 + 2 * j + 1] = __expf(l1); kf[t * 128 + c16 + 2 * j] = -expm1f(l0); kf[t * 128 + c16 + 2 * j + 1] = -expm1f(l1);
            }
            const int c4 = (tid & 7) * 4;
            const u32x2 iv = *(const u32x2*)(P + (size_t)(t0 + t) * P1LD + 2048 + h * 128 + qd * 32 + c4);
            is[t * 32 + c4] = bf2f((unsigned short)(iv.x & 0xffffu)); is[t * 32 + c4 + 1] = bf2f((unsigned short)(iv.x >> 16)); is[t * 32 + c4 + 2] = bf2f((unsigned short)(iv.y & 0xffffu)); is[t * 32 + c4 + 3] = bf2f((unsigned short)(iv.y >> 16));
        }
        __syncthreads();
        {
            const int o8 = part * 8;
            for (int t = 0; t < 64; ++t) {
                const f32x4 f0 = *(const LAS f32x4*)(fs + t * 128 + o8), f1 = *(const LAS f32x4*)(fs + t * 128 + o8 + 4);
                const f32x4 k0 = *(const LAS f32x4*)(kf + t * 128 + o8), k1 = *(const LAS f32x4*)(kf + t * 128 + o8 + 4);
                const f32x4 q0 = *(const LAS f32x4*)(qs + t * 128 + o8), q1 = *(const LAS f32x4*)(qs + t * 128 + o8 + 4);
                const float iv = is[t * 32 + e];
                s[0] = f0.x * s[0] + k0.x * iv; s[1] = f0.y * s[1] + k0.y * iv; s[2] = f0.z * s[2] + k0.z * iv; s[3] = f0.w * s[3] + k0.w * iv;
                s[4] = f1.x * s[4] + k1.x * iv; s[5] = f1.y * s[5] + k1.y * iv; s[6] = f1.z * s[6] + k1.z * iv; s[7] = f1.w * s[7] + k1.w * iv;
                const float o = red16(((s[0] * q0.x + s[1] * q0.y) + (s[2] * q0.z + s[3] * q0.w)) + ((s[4] * q1.x + s[5] * q1.y) + (s[6] * q1.z + s[7] * q1.w)));
                if (part == 0) is[t * 32 + e] = o;
            }
        }
        __syncthreads();
        {
            const int t = tid >> 3, c4 = (tid & 7) * 4;
            const f32x4 o = *(const LAS f32x4*)(is + t * 32 + c4);
            u32x2 wv; wv.x = pk2(o.x, o.y); wv.y = pk2(o.z, o.w);
            *(u32x2*)(P + (size_t)(t0 + t) * P1LD + 2048 + h * 128 + qd * 32 + c4) = wv;
        }
        __syncthreads();
    }
}
__device__ __forceinline__ void fin_hgrn(const Frame& F) {
    const int lane = lane_id_v();
    bf16_t* P = (bf16_t*)(F.ws + WS_BIG + BIG_PROJ); const float* onorm = F.in[IN_C_ONORM];
    const float on0 = onorm[lane], on1 = onorm[lane + 64];
    const int gw = F.wg * NWAVES + F.wave, NGW = F.G * NWAVES;
    for (int it = gw; it < NT * 8; it += NGW) {
        const int t = it >> 3, h = it & 7;
        bf16_t* row = P + (size_t)t * P1LD;
        const float o0 = bf2f(row[2048 + h * 128 + lane]), o1 = bf2f(row[2048 + h * 128 + lane + 64]);
        const float g0 = bf2f(row[3072 + h * 128 + lane]), g1 = bf2f(row[3072 + h * 128 + lane + 64]);
        const float ss = wave_sum(o0 * o0 + o1 * o1), rs = 1.0f / sqrtf(ss * (1.0f / 128.0f) + 1e-6f);
        row[3072 + h * 128 + lane] = (bf16_t)f2bf(o0 * rs * on0 * siluf_(g0)); row[3072 + h * 128 + lane + 64] = (bf16_t)f2bf(o1 * rs * on1 * siluf_(g1));
    }
}

#define MFMA32(a, b, c) __builtin_amdgcn_mfma_f32_16x16x32_bf16(a, b, c, 0, 0, 0)
#define MFMA16(a, b, c) __builtin_amdgcn_mfma_f32_16x16x16bf16_1k(a, b, c, 0, 0, 0)
__device__ __forceinline__ f32x4 mm_tile(const LAS bf16_t* A, int lda, const LAS bf16_t* B, int ldb, int nks, f32x4 acc, int fr, int fq) {
    for (int ksx = 0; ksx < nks; ++ksx) acc = MFMA32(*(const LAS bf16x8*)(A + fr * lda + ksx * 32 + fq * 8), *(const LAS bf16x8*)(B + fr * ldb + ksx * 32 + fq * 8), acc);
    return acc;
}
__device__ __forceinline__ void lds_w4(LAS bf16_t* p, f32x4 v) { u32x2 w; w.x = pk2(v.x, v.y); w.y = pk2(v.z, v.w); *(LAS u32x2*)p = w; }
__device__ __forceinline__ float rdlane(float v, int l) { return __int_as_float(__builtin_amdgcn_readlane(__float_as_int(v), l)); }
__device__ __forceinline__ float wsum(float v) { v = red16(v); return (rdlane(v, 0) + rdlane(v, 16)) + (rdlane(v, 32) + rdlane(v, 48)); }

struct HoBuf { __amdgpu_buffer_rsrc_t r; };
__device__ __forceinline__ HoBuf ho_buf(float* base, unsigned bytes) {
    const unsigned long long a = (unsigned long long)base;
    const unsigned lo = __builtin_amdgcn_readfirstlane((unsigned)a), hi = __builtin_amdgcn_readfirstlane((unsigned)(a >> 32));
    HoBuf h; h.r = __builtin_amdgcn_make_buffer_rsrc((void*)(((unsigned long long)hi << 32) | lo), 0, bytes, 0x00020000); return h;
}
__device__ __forceinline__ void ho_store(const HoBuf& hb, unsigned byteoff, f32x4 v) {
    __builtin_amdgcn_raw_buffer_store_b128(__builtin_bit_cast(u32x4, v), hb.r, byteoff, 0, 16);
}
__device__ __forceinline__ f32x4 ho_load(const HoBuf& hb, unsigned byteoff) {
    return __builtin_bit_cast(f32x4, __builtin_amdgcn_raw_buffer_load_b128(hb.r, byteoff, 0, 16));
}
__device__ __forceinline__ void ho_wait(unsigned* flag, unsigned need, unsigned* tmo, int wave, int lane) {
    if (wave == 0 && lane == 0) { unsigned sp = 0;
        while (__hip_atomic_load(flag, __ATOMIC_RELAXED, __HIP_MEMORY_SCOPE_AGENT) < need) { __builtin_amdgcn_s_sleep(2); if (++sp > (1u << 24)) { __hip_atomic_store(tmo, 1u, __ATOMIC_RELAXED, __HIP_MEMORY_SCOPE_AGENT); break; } } }
    __syncthreads();
}

__device__ __forceinline__ void scan_delta3(const Frame& F, int b, int h, int jpart, int kparts) {
    const int lane0 = lane_id_v(); const int w = F.wave;
    LAS bf16_t* Qb = (LAS bf16_t*)F.lds;
    LAS bf16_t* Kb = Qb + 64 * 136;
    LAS float* Of = (LAS float*)F.lds;
    LAS bf16_t* Kdt = Kb + 64 * 136;
    LAS bf16_t* Vt = Kdt + 128 * 72;
    LAS bf16_t* St = Vt + 128 * 72;
    LAS bf16_t* Aoff = St + 128 * 136;
    LAS bf16_t* QKm = Aoff + 64 * 72;
    LAS bf16_t* Vn = QKm + 64 * 72;
    LAS bf16_t* Dg = Vn + 128 * 72;
    LAS float* Adg = (LAS float*)(Dg + 4 * 16 * 24);
    LAS float* sc = Adg + 4 * 16 * 17;
    static_assert((64 * 136 * 2 * 2 + 128 * 72 * 2 * 3 + 128 * 136 * 2 + 64 * 72 * 2 * 2 + 4 * 16 * 24 * 2 + 4 * 16 * 17 * 4 + 260 * 4) <= LDS_MISC, "delta3 LDS");
    bf16_t* P = (bf16_t*)(F.ws + WS_BIG + BIG_PROJ);
    const HoBuf hb = ho_buf((float*)(F.ws + WS_HOA) + (size_t)(b * 4 + h) * 16384, 65536);
    unsigned* flag = (unsigned*)(F.ws + WS_FLAGS) + 64 + (b * 4 + h); unsigned* tmo = (unsigned*)(F.ws + WS_FLAGS) + 255;
    const float* convw = F.in[IN_AB_CONV];
    const float* db = (const float*)(F.ws + WS_DB);
    const float a_neg = -__expf(F.in[IN_AB_ALOG][h]), dtb = F.in[IN_AB_DTB][h];
    const float* onorm = F.in[IN_AB_ONORM];
    float cw[3][4][2];
#pragma unroll
    for (int sct = 0; sct < 3; ++sct)
#pragma unroll
        for (int j = 0; j < 4; ++j) { cw[sct][j][0] = convw[j * 1536 + sct * 512 + h * 128 + 2 * lane0]; cw[sct][j][1] = convw[j * 1536 + sct * 512 + h * 128 + 2 * lane0 + 1]; }
    for (int i = w * 64 + lane0; i < (128 * 136 + 64 * 72 * 2 + 128 * 72) / 2; i += NTHREADS) ((LAS unsigned*)St)[i] = 0u;
    unsigned pacc = 0u, plast = 0u;
    f32x4 sacc[8];
#pragma unroll
    for (int i = 0; i < 8; ++i) sacc[i] = (f32x4){0.f, 0.f, 0.f, 0.f};
    __syncthreads();
    unsigned rawu[3][11]; float dbv0, dbv1;
#define DELTA_FETCH(cc, ln) do { const int cc_ = (cc) < 32 ? (cc) : 31; \
        dbv0 = db[(size_t)(b * TS + cc_ * 64 + (ln)) * 8 + h]; dbv1 = db[(size_t)(b * TS + cc_ * 64 + (ln)) * 8 + 4 + h]; \
        _Pragma("unroll") for (int rr = 0; rr < 11; ++rr) { const int tl = cc_ * 64 + 8 * w - 3 + rr; \
            const unsigned* row = (const unsigned*)(P + (size_t)(b * TS + (tl >= 0 ? tl : 0)) * P0LD + h * 128) + (ln); \
            _Pragma("unroll") for (int sct = 0; sct < 3; ++sct) rawu[sct][rr] = row[sct * 256]; } } while (0)
    DELTA_FETCH(jpart, lane0);
    for (int c = jpart; c < 32; c += kparts) {
        int lane = lane0; asm volatile("" : "+v"(lane));
        const int fr = lane & 15, fq = lane >> 4;
        const int t0 = b * TS + c * 64;
        if (PROBE_STAGE >= 0) plast = (unsigned)__builtin_amdgcn_s_memrealtime();
        unsigned gq[8];
#pragma unroll
        for (int i = 0; i < 8; ++i) gq[i] = *((const unsigned*)(P + (size_t)(t0 + w + 8 * i) * P0LD + 1536 + h * 128) + lane);
        {
            const float la = a_neg * softplusf_(dbv0 + dtb);
            const float bet = sigmoidf_(dbv1);
            float g = la;
#pragma unroll
            for (int o = 1; o < 64; o <<= 1) { const float n = __shfl_up(g, o); if (lane >= o) g += n; }
            const float gL = rdlane(g, 63);
            if (w == 0) { sc[lane] = g; sc[64 + lane] = __expf(g); sc[128 + lane] = bet * __expf(g); sc[192 + lane] = bet; if (lane == 0) sc[256] = __expf(gL); }
            float raw[3][11][2];
#pragma unroll
            for (int rr = 0; rr < 11; ++rr) { const bool ok = (c * 64 + 8 * w - 3 + rr) >= 0;
#pragma unroll
                for (int sct = 0; sct < 3; ++sct) { raw[sct][rr][0] = ok ? bf2f((unsigned short)(rawu[sct][rr] & 0xffffu)) : 0.f; raw[sct][rr][1] = ok ? bf2f((unsigned short)(rawu[sct][rr] >> 16)) : 0.f; } }
            DELTA_FETCH(c + kparts, lane);
            float kd0[8], kd1[8], vt0[8], vt1[8];
#pragma unroll
            for (int i = 0; i < 8; ++i) {
                const int t = 8 * w + i;
                float x[3][2];
#pragma unroll
                for (int sct = 0; sct < 3; ++sct) { float a0 = 0.f, a1 = 0.f;
#pragma unroll
                    for (int j = 0; j < 4; ++j) { a0 += cw[sct][j][0] * raw[sct][i + j][0]; a1 += cw[sct][j][1] * raw[sct][i + j][1]; }
                    x[sct][0] = siluf_(a0); x[sct][1] = siluf_(a1); }
                const float sq = wsum(x[0][0] * x[0][0] + x[0][1] * x[0][1]), sk = wsum(x[1][0] * x[1][0] + x[1][1] * x[1][1]);
                const float cq = (1.0f / sqrtf(sq + 1e-6f)) * 0.08838834764831845f, ck = 1.0f / sqrtf(sk + 1e-6f);
                const float egr = __expf(gL - rdlane(g, t));
                *(LAS unsigned*)(Qb + t * 136 + 2 * lane) = pk2(x[0][0] * cq, x[0][1] * cq);
                const float k0 = x[1][0] * ck, k1 = x[1][1] * ck;
                *(LAS unsigned*)(Kb + t * 136 + 2 * lane) = pk2(k0, k1);
                kd0[i] = k0 * egr; kd1[i] = k1 * egr; vt0[i] = x[2][0]; vt1[i] = x[2][1];
            }
            *(LAS u32x4*)(Kdt + (2 * lane) * 72 + 8 * w) = (u32x4){pk2(kd0[0], kd0[1]), pk2(kd0[2], kd0[3]), pk2(kd0[4], kd0[5]), pk2(kd0[6], kd0[7])};
            *(LAS u32x4*)(Kdt + (2 * lane + 1) * 72 + 8 * w) = (u32x4){pk2(kd1[0], kd1[1]), pk2(kd1[2], kd1[3]), pk2(kd1[4], kd1[5]), pk2(kd1[6], kd1[7])};
            *(LAS u32x4*)(Vt + (2 * lane) * 72 + 8 * w) = (u32x4){pk2(vt0[0], vt0[1]), pk2(vt0[2], vt0[3]), pk2(vt0[4], vt0[5]), pk2(vt0[6], vt0[7])};
            *(LAS u32x4*)(Vt + (2 * lane + 1) * 72 + 8 * w) = (u32x4){pk2(vt1[0], vt1[1]), pk2(vt1[2], vt1[3]), pk2(vt1[4], vt1[5]), pk2(vt1[6], vt1[7])};
        }
        __syncthreads();
        if (PROBE_STAGE >= 0) { const unsigned tn = (unsigned)__builtin_amdgcn_s_memrealtime(); if (PROBE_STAGE == 0) pacc += tn - plast; plast = tn; }
        {
            for (int id = w; id < 20; id += NWAVES) {
                const int which = id / 10, tix = id % 10;
                const int bi = (tix < 1) ? 0 : (tix < 3 ? 1 : (tix < 6 ? 2 : 3)); const int bj = tix - (bi * (bi + 1)) / 2;
                f32x4 acc = {0.f, 0.f, 0.f, 0.f};
                acc = mm_tile(Kb + bj * 16 * 136, 136, (which ? Qb : Kb) + bi * 16 * 136, 136, 4, acc, fr, fq);
                const int i = 16 * bi + fr; const float gi = sc[i], bi_ = sc[192 + i];
                const float av[4] = {acc.x, acc.y, acc.z, acc.w}; float ov[4];
#pragma unroll
                for (int rg = 0; rg < 4; ++rg) { const int j = 16 * bj + 4 * fq + rg; const float dec = __expf(gi - sc[j]);
                    ov[rg] = which ? ((j <= i) ? av[rg] * dec : 0.f) : ((j < i) ? bi_ * av[rg] * dec : 0.f); }
                if (which) lds_w4(QKm + i * 72 + 16 * bj + 4 * fq, (f32x4){ov[0], ov[1], ov[2], ov[3]});
                else if (bi == bj) { LAS float* d = Adg + (bi * 16 + fr) * 17 + 4 * fq; d[0] = ov[0]; d[1] = ov[1]; d[2] = ov[2]; d[3] = ov[3]; }
                else lds_w4(Aoff + i * 72 + 16 * bj + 4 * fq, (f32x4){-ov[0], -ov[1], -ov[2], -ov[3]});
            }
        }
        __syncthreads();
        if (PROBE_STAGE >= 0) { const unsigned tn = (unsigned)__builtin_amdgcn_s_memrealtime(); if (PROBE_STAGE == 1) pacc += tn - plast; plast = tn; }
        f32x4 y[4], qs[4];
        if (w < 4 && lane < 16) { float x[16]; const LAS float* a = Adg + w * 16 * 17;
#pragma unroll
            for (int i = 0; i < 16; ++i) { float v = (i == lane) ? 1.f : 0.f;
#pragma unroll
                for (int k = 0; k < i; ++k) v -= a[i * 17 + k] * x[k];
                x[i] = v; Dg[(w * 16 + i) * 24 + lane] = (bf16_t)f2bf(v); } }
        if (c > 0) ho_wait(flag, (unsigned)c, tmo, w, lane); else __syncthreads();
#pragma unroll
        for (int dk = 0; dk < 8; ++dk) { { const f32x4 ld = ho_load(hb, (unsigned)(((w * 64 + lane) * 8 + dk) * 16)); sacc[dk] = (c > 0) ? ld : (f32x4){0.f, 0.f, 0.f, 0.f}; }
            lds_w4(St + (16 * w + fr) * 136 + 16 * dk + 4 * fq, sacc[dk]); }
        asm volatile("s_waitcnt lgkmcnt(0)" ::: "memory");
        {
            const LAS bf16_t* Sw = St + (16 * w) * 136;
#pragma unroll
            for (int mi = 0; mi < 4; ++mi) {
                f32x4 x = mm_tile(Kb + mi * 16 * 136, 136, Sw, 136, 4, (f32x4){0.f, 0.f, 0.f, 0.f}, fr, fq);
                qs[mi] = mm_tile(Qb + mi * 16 * 136, 136, Sw, 136, 4, (f32x4){0.f, 0.f, 0.f, 0.f}, fr, fq);
                const bf16x4 vv = *(const LAS bf16x4*)(Vt + (16 * w + fr) * 72 + 16 * mi + 4 * fq);
                const f32x4 be4 = *(const LAS f32x4*)(sc + 192 + 16 * mi + 4 * fq), bg4 = *(const LAS f32x4*)(sc + 128 + 16 * mi + 4 * fq);
                y[mi].x = be4.x * bf2f((unsigned short)vv.x) - bg4.x * x.x; y[mi].y = be4.y * bf2f((unsigned short)vv.y) - bg4.y * x.y;
                y[mi].z = be4.z * bf2f((unsigned short)vv.z) - bg4.z * x.z; y[mi].w = be4.w * bf2f((unsigned short)vv.w) - bg4.w * x.w;
            }
        }
        __syncthreads();
        if (PROBE_STAGE >= 0) { const unsigned tn = (unsigned)__builtin_amdgcn_s_memrealtime(); if (PROBE_STAGE == 2) pacc += tn - plast; plast = tn; }
        {
            LAS bf16_t* Vw = Vn + (16 * w) * 72;
#pragma unroll
            for (int bb = 0; bb < 4; ++bb) {
                f32x4 acc = y[bb];
                if (bb >= 1) acc = mm_tile(Aoff + bb * 16 * 72, 72, Vw, 72, (bb + 1) / 2, acc, fr, fq);
                u32x2 pk; pk.x = pk2(acc.x, acc.y); pk.y = pk2(acc.z, acc.w);
                const bf16x4 dgf = *(const LAS bf16x4*)(Dg + (bb * 16 + fr) * 24 + 4 * fq);
                const f32x4 vb = MFMA16(dgf, __builtin_bit_cast(bf16x4, pk), ((f32x4){0.f, 0.f, 0.f, 0.f}));
                lds_w4(Vw + fr * 72 + 16 * bb + 4 * fq, vb);
                asm volatile("s_waitcnt lgkmcnt(0)" ::: "memory");
            }
            const float gl = sc[256];
#pragma unroll
            for (int mi = 0; mi < 4; ++mi) {
                const f32x4 eg4 = *(const LAS f32x4*)(sc + 64 + 16 * mi + 4 * fq);
                f32x4 o = qs[mi] * eg4;
                o = mm_tile(QKm + mi * 16 * 72, 72, Vw, 72, 2, o, fr, fq);
                qs[mi] = o;
            }
#pragma unroll
            for (int dk = 0; dk < 8; ++dk) {
                f32x4 sn = sacc[dk] * gl;
                sn = mm_tile(Kdt + dk * 16 * 72, 72, Vw, 72, 2, sn, fr, fq);
                sacc[dk] = sn;
                lds_w4(St + (16 * w + fr) * 136 + 16 * dk + 4 * fq, sn);
            }
        }
        if (c < 31) {
#pragma unroll
            for (int dk = 0; dk < 8; ++dk) ho_store(hb, (unsigned)(((w * 64 + lane) * 8 + dk) * 16), sacc[dk]);
            asm volatile("s_waitcnt vmcnt(0)" ::: "memory");
        }
        __syncthreads();
        if (c < 31 && w == 0 && lane == 0) __hip_atomic_store(flag, (unsigned)(c + 1), __ATOMIC_RELAXED, __HIP_MEMORY_SCOPE_AGENT);
        if (PROBE_STAGE >= 0) { const unsigned tn = (unsigned)__builtin_amdgcn_s_memrealtime(); if (PROBE_STAGE == 3) pacc += tn - plast; plast = tn; }
#pragma unroll
        for (int mi = 0; mi < 4; ++mi) { LAS float* op = Of + (16 * mi + 4 * fq) * 132 + 16 * w + fr; op[0] = qs[mi].x; op[132] = qs[mi].y; op[264] = qs[mi].z; op[396] = qs[mi].w; }
        __syncthreads();
        if (PROBE_STAGE >= 0) { const unsigned tn = (unsigned)__builtin_amdgcn_s_memrealtime(); if (PROBE_STAGE == 4) pacc += tn - plast; plast = tn; }
        const float on0 = onorm[2 * lane], on1 = onorm[2 * lane + 1];
#pragma unroll
        for (int i = 0; i < 8; ++i) {
            const int t = w + 8 * i;
            const f32x2 ov = *(const LAS f32x2*)(Of + t * 132 + 2 * lane); const float o0 = ov.x, o1 = ov.y;
            const float ss = wsum(o0 * o0 + o1 * o1), rs = 1.0f / sqrtf(ss * (1.0f / 128.0f) + 1e-6f);
            const float g0 = bf2f((unsigned short)(gq[i] & 0xffffu)), g1 = bf2f((unsigned short)(gq[i] >> 16));
            *((unsigned*)(P + (size_t)(t0 + t) * P0LD + 1536 + h * 128) + lane) = pk2(o0 * rs * on0 * siluf_(g0), o1 * rs * on1 * siluf_(g1));
        }
        __syncthreads();
        if (PROBE_STAGE >= 0) { const unsigned tn = (unsigned)__builtin_amdgcn_s_memrealtime(); if (PROBE_STAGE == 5) pacc += tn - plast; plast = tn; }
    }
    if (PROBE_STAGE >= 0 && F.wg == 0 && w == 0 && lane0 == 0) __hip_atomic_store((unsigned*)(F.ws + WS_CTL + 20484), pacc, __ATOMIC_RELAXED, __HIP_MEMORY_SCOPE_AGENT);
}

__device__ __forceinline__ void scan_hgrn3(const Frame& F, int b, int h) {
    const int lane0 = lane_id_v(); const int w = F.wave;
    LAS bf16_t* Qd = (LAS bf16_t*)F.lds;
    LAS bf16_t* Kp = Qd + 64 * 136;
    LAS bf16_t* Kpt = Kp + 64 * 136;
    LAS bf16_t* Vt = Kpt + 128 * 72;
    LAS bf16_t* Sc = Vt + 128 * 72;
    LAS bf16_t* Zt = Sc + 64 * 72;
    LAS float* Of = (LAS float*)(Zt + 128 * 136);
    LAS float* gl = Of + 64 * 132;
    LAS float* seg = gl + 128;
    static_assert((64 * 136 * 2 * 2 + 128 * 72 * 2 * 2 + 64 * 72 * 2 + 128 * 136 * 2 + 64 * 132 * 4 + 128 * 4 + 512 * 4) <= LDS_MISC, "hgrn3 LDS");
    bf16_t* P = (bf16_t*)(F.ws + WS_BIG + BIG_PROJ);
    const float* onorm = F.in[IN_C_ONORM];
    for (int i = w * 64 + lane0; i < (64 * 72 + 128 * 136) / 2; i += NTHREADS) ((LAS unsigned*)Sc)[i] = 0u;
    f32x4 zacc[8];
#pragma unroll
    for (int i = 0; i < 8; ++i) zacc[i] = (f32x4){0.f, 0.f, 0.f, 0.f};
    __syncthreads();
    for (int c = 0; c < 32; ++c) {
        int lane = lane0; asm volatile("" : "+v"(lane));
        const int tid = w * 64 + lane, fr = lane & 15, fq = lane >> 4, d = tid & 127, sg = tid >> 7;
        const int t0 = b * TS + c * 64;
        {
            float G[16], q[16], v[16], lf[16];
            const bf16_t* pr = P + (size_t)(t0 + 16 * sg) * P1LD + h * 128 + d;
#pragma unroll
            for (int i = 0; i < 16; ++i) { q[i] = bf2f(pr[(size_t)i * P1LD]); lf[i] = h2f_bits(pr[(size_t)i * P1LD + 1024]); v[i] = bf2f(pr[(size_t)i * P1LD + 2048]); }
            float run = 0.f;
#pragma unroll
            for (int i = 0; i < 16; ++i) { run += lf[i]; G[i] = run; }
            seg[sg * 128 + d] = run;
            __syncthreads();
            float off = 0.f;
#pragma unroll
            for (int s2 = 0; s2 < 3; ++s2) if (s2 < sg) off += seg[s2 * 128 + d];
            float kpv[16];
#pragma unroll
            for (int i = 0; i < 16; ++i) {
                const int t = 16 * sg + i; const float Gt = off + G[i];
                const float qd = q[i] * __expf(Gt); kpv[i] = -expm1f(lf[i]) * __expf(fminf(-Gt, 80.f));
                Qd[t * 136 + d] = (bf16_t)f2bf(qd); Kp[t * 136 + d] = (bf16_t)f2bf(kpv[i]);
            }
            *(LAS u32x4*)(Kpt + d * 72 + 16 * sg) = (u32x4){pk2(kpv[0], kpv[1]), pk2(kpv[2], kpv[3]), pk2(kpv[4], kpv[5]), pk2(kpv[6], kpv[7])};
            *(LAS u32x4*)(Kpt + d * 72 + 16 * sg + 8) = (u32x4){pk2(kpv[8], kpv[9]), pk2(kpv[10], kpv[11]), pk2(kpv[12], kpv[13]), pk2(kpv[14], kpv[15])};
            *(LAS u32x4*)(Vt + d * 72 + 16 * sg) = (u32x4){pk2(v[0], v[1]), pk2(v[2], v[3]), pk2(v[4], v[5]), pk2(v[6], v[7])};
            *(LAS u32x4*)(Vt + d * 72 + 16 * sg + 8) = (u32x4){pk2(v[8], v[9]), pk2(v[10], v[11]), pk2(v[12], v[13]), pk2(v[14], v[15])};
            if (sg == 3) gl[d] = __expf(off + G[15]);
        }
        __syncthreads();
        for (int id = w; id < 10; id += NWAVES) {
            const int bi = (id < 1) ? 0 : (id < 3 ? 1 : (id < 6 ? 2 : 3)); const int bj = id - (bi * (bi + 1)) / 2;
            const f32x4 acc = mm_tile(Kp + bj * 16 * 136, 136, Qd + bi * 16 * 136, 136, 4, (f32x4){0.f, 0.f, 0.f, 0.f}, fr, fq);
            const int i = 16 * bi + fr, j0 = 16 * bj + 4 * fq;
            lds_w4(Sc + i * 72 + j0, (f32x4){(j0 <= i) ? acc.x : 0.f, (j0 + 1 <= i) ? acc.y : 0.f, (j0 + 2 <= i) ? acc.z : 0.f, (j0 + 3 <= i) ? acc.w : 0.f});
        }
        __syncthreads();
        {
            const LAS bf16_t* Vw = Vt + (16 * w) * 72; const LAS bf16_t* Zw = Zt + (16 * w) * 136;
#pragma unroll
            for (int mi = 0; mi < 4; ++mi) {
                f32x4 o = mm_tile(Sc + mi * 16 * 72, 72, Vw, 72, 2, (f32x4){0.f, 0.f, 0.f, 0.f}, fr, fq);
                o = mm_tile(Qd + mi * 16 * 136, 136, Zw, 136, 4, o, fr, fq);
                LAS float* op = Of + (16 * mi + 4 * fq) * 132 + 16 * w + fr; op[0] = o.x; op[132] = o.y; op[264] = o.z; op[396] = o.w;
            }
            asm volatile("s_waitcnt lgkmcnt(0)" ::: "memory");
#pragma unroll
            for (int dk = 0; dk < 8; ++dk) {
                f32x4 zn = mm_tile(Kpt + dk * 16 * 72, 72, Vw, 72, 2, zacc[dk], fr, fq);
                const f32x4 g4 = *(const LAS f32x4*)(gl + 16 * dk + 4 * fq);
                zn = zn * g4; zacc[dk] = zn;
                lds_w4(Zt + (16 * w + fr) * 136 + 16 * dk + 4 * fq, zn);
            }
        }
        __syncthreads();
        for (int t = w; t < 64; t += NWAVES) {
            const float o0 = Of[t * 132 + lane], o1 = Of[t * 132 + lane + 64];
            const float ss = wsum(o0 * o0 + o1 * o1), rs = 1.0f / sqrtf(ss * (1.0f / 128.0f) + 1e-6f);
            bf16_t* gp = P + (size_t)(t0 + t) * P1LD + 3072 + h * 128;
            const float g0 = bf2f(gp[lane]), g1 = bf2f(gp[lane + 64]);
            gp[lane] = (bf16_t)f2bf(o0 * rs * onorm[lane] * siluf_(g0)); gp[lane + 64] = (bf16_t)f2bf(o1 * rs * onorm[lane + 64] * siluf_(g1));
        }
    }
}

__device__ __forceinline__ float tanh_fast(float x) { const float e = __expf(2.f * x); return 1.f - 2.f / (1.f + e); }
struct RwkvLd { u32x4 cu, pv; };
__device__ __forceinline__ RwkvLd rwkv_ld8(const bf16_t* Pc, int t, int gc, const bf16_t* hal) {
    const bf16_t* src = Pc + (size_t)t * P0LD + gc; const bf16_t* psrc = (t > 0) ? src - P0LD : hal + (gc - 2048);
    RwkvLd r; r.cu = *(const u32x4*)src; r.pv = *(const u32x4*)psrc; return r;
}
__device__ __forceinline__ void rwkv_sh8(const RwkvLd& ld, int t, int gc, bool first_zero, const float* mu, float (&sh)[8]) {
    const f32x4 m0 = *(const f32x4*)(mu + gc - 2048), m1 = *(const f32x4*)(mu + gc - 2048 + 4);
    const unsigned cw_[4] = {ld.cu.x, ld.cu.y, ld.cu.z, ld.cu.w}, pw_[4] = {ld.pv.x, ld.pv.y, ld.pv.z, ld.pv.w};
    const float mv[8] = {m0.x, m0.y, m0.z, m0.w, m1.x, m1.y, m1.z, m1.w};
    float cur[8];
#pragma unroll
    for (int e = 0; e < 8; ++e) {
        cur[e] = bf2f((unsigned short)((e & 1) ? (cw_[e >> 1] >> 16) : (cw_[e >> 1] & 0xffffu)));
        const float pg = bf2f((unsigned short)((e & 1) ? (pw_[e >> 1] >> 16) : (pw_[e >> 1] & 0xffffu)));
        const float prv = (t == 0 && first_zero) ? 0.f : pg;
        sh[e] = cur[e] + mv[e] * (prv - cur[e]);
    }
}
__device__ __forceinline__ void scan_rwkv3(const Frame& F, int b, int h, int par) {
    const int lane0 = lane_id_v(); const int w = F.wave;
    LAS unsigned char* L = F.lds;
    LAS bf16_t* RPb = (LAS bf16_t*)(L + 0);
    LAS bf16_t* KPb = (LAS bf16_t*)(L + 9216);
    LAS float* LWf = (LAS float*)(L + 18432);
    LAS float* Af = (LAS float*)(L + 34816);
    LAS float* segs = (LAS float*)(L + 51200);
    LAS bf16_t* Mak = (LAS bf16_t*)(L + 0);
    LAS bf16_t* Mrk = (LAS bf16_t*)(L + 9216);
    LAS bf16_t* Mrbn = (LAS bf16_t*)(L + 18432);
    LAS bf16_t* Aoff = (LAS bf16_t*)(L + 27648);
    LAS float* Adg = (LAS float*)(L + 36864);
    LAS bf16_t* Dg = (LAS bf16_t*)(L + 41216);
    LAS bf16_t* GB = (LAS bf16_t*)(L + 44288);
    LAS bf16_t* TL = (LAS bf16_t*)(L + 65536);
    LAS bf16_t* AL = (LAS bf16_t*)(L + 65536 + 9216);
    LAS bf16_t* SG = (LAS bf16_t*)(L + 65536 + 18432);
    LAS bf16_t* At = (LAS bf16_t*)(L + 65536);
    LAS bf16_t* Btl = (LAS bf16_t*)(L + 65536 + 9216);
    LAS bf16_t* Ktl = (LAS bf16_t*)(L + 65536 + 18432);
    LAS bf16_t* Rtl = (LAS bf16_t*)(L + 65536 + 27648);
    LAS float* Of = (LAS float*)(L + 65536);
    LAS bf16_t* BtTn = (LAS bf16_t*)(L + 102400);
    LAS bf16_t* KtT = (LAS bf16_t*)(L + 111616);
    LAS bf16_t* Vt = (LAS bf16_t*)(L + 120832);
    LAS bf16_t* Zt = (LAS bf16_t*)(L + 130048);
    LAS bf16_t* PU = (LAS bf16_t*)(L + 139264);
    LAS float* bonus = (LAS float*)(L + 148480);
    LAS float* glv = bonus + 64;
    static_assert(148480 + 4096 <= LDS_MISC, "rwkv3 LDS");
    bf16_t* P = (bf16_t*)(F.ws + WS_BIG + BIG_PROJ);
    const bf16_t* LW = (const bf16_t*)(F.ws + WS_LORA);
    const bf16_t* HALO = (const bf16_t*)(F.ws + WS_HALOB);
    const HoBuf hb = ho_buf((float*)(F.ws + WS_HOB) + (size_t)(b * 8 + h) * 4096, 16384);
    unsigned* flag = (unsigned*)(F.ws + WS_FLAGS) + (b * 8 + h); unsigned* tmo = (unsigned*)(F.ws + WS_FLAGS) + 255;
    const float* mu = F.in[IN_AB_MU];
    const float kkj = F.in[IN_AB_KK][h * 64 + lane0], kaj = F.in[IN_AB_KA][h * 64 + lane0], rkj = F.in[IN_AB_RK][h * 64 + lane0];
    const float lnw = F.in[IN_AB_LNW][h * 64 + lane0], lnb = F.in[IN_AB_LNB][h * 64 + lane0];
    float w0q[2], a0q[2];
#pragma unroll
    for (int q = 0; q < 2; ++q) { const int jq = ((2 * w + q) & 3) * 16 + (lane0 & 15); w0q[q] = F.in[IN_AB_W0][h * 64 + jq]; a0q[q] = F.in[IN_AB_A0][h * 64 + jq]; }
    bf16x8 yw[2][2], ya[2][2], yg[2][4];
#pragma unroll
    for (int q = 0; q < 2; ++q) { const int jrow = h * 64 + ((2 * w + q) & 3) * 16 + (lane0 & 15), fq0 = lane0 >> 4;
#pragma unroll
        for (int ksx = 0; ksx < 2; ++ksx) { yw[q][ksx] = *(const bf16x8*)(LW + (size_t)jrow * 64 + ksx * 32 + fq0 * 8); ya[q][ksx] = *(const bf16x8*)(LW + 512 * 64 + (size_t)jrow * 64 + ksx * 32 + fq0 * 8); }
#pragma unroll
        for (int ksx = 0; ksx < 4; ++ksx) yg[q][ksx] = *(const bf16x8*)(LW + 2 * 512 * 64 + (size_t)jrow * 128 + ksx * 32 + fq0 * 8); }
    f32x4 zacc[4];
#pragma unroll
    for (int i = 0; i < 4; ++i) zacc[i] = (f32x4){0.f, 0.f, 0.f, 0.f};
    for (int i = w * 64 + lane0; i < (64 * 72 * 2) / 2; i += NTHREADS) ((LAS unsigned*)Zt)[i] = 0u;
    __syncthreads();
    for (int c = par; c < 32; c += 2) {
        int lane = lane0; asm volatile("" : "+v"(lane));
        const int tid = w * 64 + lane, fr = lane & 15, fq = lane >> 4;
        const int t0 = b * TS + c * 64;
        {
            const bf16_t* Pc = P + (size_t)t0 * P0LD; const bf16_t* hal = HALO + (size_t)(b * 32 + (c > 0 ? c - 1 : 0)) * 1792; const bool fz = (c == 0);
            const int t_a0 = tid >> 4, cg_a0 = tid & 15, t_a1 = (tid + NTHREADS) >> 4, cg_a1 = (tid + NTHREADS) & 15, t_b = tid >> 3, cg_b = tid & 7;
            const int gc0 = ((cg_a0 < 8) ? 2048 : 2560) + h * 64 + (cg_a0 & 7) * 8, gc1 = ((cg_a1 < 8) ? 2048 : 2560) + h * 64 + (cg_a1 & 7) * 8;
            const int gc2 = 3584 + cg_b * 8, gc3 = 3648 + cg_b * 8, gc4 = 3712 + cg_a0 * 8, gc5 = 3712 + cg_a1 * 8;
            const RwkvLd l0 = rwkv_ld8(Pc, t_a0, gc0, hal), l1 = rwkv_ld8(Pc, t_a1, gc1, hal), l2 = rwkv_ld8(Pc, t_b, gc2, hal), l3 = rwkv_ld8(Pc, t_b, gc3, hal), l4 = rwkv_ld8(Pc, t_a0, gc4, hal), l5 = rwkv_ld8(Pc, t_a1, gc5, hal);
            const int vcol = tid & 63, vtg = tid >> 6;
            const bf16_t* vsrc = Pc + (size_t)(8 * vtg) * P0LD + 3072 + h * 64 + vcol;
            unsigned short vr[9];
#pragma unroll
            for (int i = 0; i < 8; ++i) vr[i + 1] = vsrc[(size_t)i * P0LD];
            vr[0] = *((vtg > 0) ? vsrc - P0LD : hal + 1024 + h * 64 + vcol);
            float sh[8];
            { rwkv_sh8(l0, t_a0, gc0, fz, mu, sh);
              *(LAS u32x4*)((cg_a0 < 8 ? RPb : KPb) + t_a0 * 72 + (cg_a0 & 7) * 8) = (u32x4){pk2(sh[0], sh[1]), pk2(sh[2], sh[3]), pk2(sh[4], sh[5]), pk2(sh[6], sh[7])}; }
            { rwkv_sh8(l1, t_a1, gc1, fz, mu, sh);
              *(LAS u32x4*)((cg_a1 < 8 ? RPb : KPb) + t_a1 * 72 + (cg_a1 & 7) * 8) = (u32x4){pk2(sh[0], sh[1]), pk2(sh[2], sh[3]), pk2(sh[4], sh[5]), pk2(sh[6], sh[7])}; }
            { rwkv_sh8(l2, t_b, gc2, fz, mu, sh);
              *(LAS u32x4*)(TL + t_b * 72 + cg_b * 8) = (u32x4){pk2(tanh_fast(sh[0]), tanh_fast(sh[1])), pk2(tanh_fast(sh[2]), tanh_fast(sh[3])), pk2(tanh_fast(sh[4]), tanh_fast(sh[5])), pk2(tanh_fast(sh[6]), tanh_fast(sh[7]))}; }
            { rwkv_sh8(l3, t_b, gc3, fz, mu, sh);
              *(LAS u32x4*)(AL + t_b * 72 + cg_b * 8) = (u32x4){pk2(sh[0], sh[1]), pk2(sh[2], sh[3]), pk2(sh[4], sh[5]), pk2(sh[6], sh[7])}; }
            { rwkv_sh8(l4, t_a0, gc4, fz, mu, sh);
              *(LAS u32x4*)(SG + t_a0 * 136 + cg_a0 * 8) = (u32x4){pk2(sigmoidf_(sh[0]), sigmoidf_(sh[1])), pk2(sigmoidf_(sh[2]), sigmoidf_(sh[3])), pk2(sigmoidf_(sh[4]), sigmoidf_(sh[5])), pk2(sigmoidf_(sh[6]), sigmoidf_(sh[7]))}; }
            { rwkv_sh8(l5, t_a1, gc5, fz, mu, sh);
              *(LAS u32x4*)(SG + t_a1 * 136 + cg_a1 * 8) = (u32x4){pk2(sigmoidf_(sh[0]), sigmoidf_(sh[1])), pk2(sigmoidf_(sh[2]), sigmoidf_(sh[3])), pk2(sigmoidf_(sh[4]), sigmoidf_(sh[5])), pk2(sigmoidf_(sh[6]), sigmoidf_(sh[7]))}; }
            {
                float cur[9];
#pragma unroll
                for (int i = 0; i < 9; ++i) cur[i] = bf2f(vr[i]);
                if (vtg == 0 && fz) cur[0] = 0.f;
                const float mvc = mu[1024 + h * 64 + vcol];
                float shv[8];
#pragma unroll
                for (int i = 0; i < 8; ++i) shv[i] = cur[i + 1] + mvc * (cur[i] - cur[i + 1]);
                *(LAS u32x4*)(Vt + vcol * 72 + 8 * vtg) = (u32x4){pk2(shv[0], shv[1]), pk2(shv[2], shv[3]), pk2(shv[4], shv[5]), pk2(shv[6], shv[7])};
            }
        }
        __syncthreads();
        f32x4 agate[2];
        {
#pragma unroll
            for (int q = 0; q < 2; ++q) {
                const int id = 2 * w + q, mi = id >> 2, nj = id & 3;
                f32x4 aw = {0.f, 0.f, 0.f, 0.f}, aa = {0.f, 0.f, 0.f, 0.f}, ag = {0.f, 0.f, 0.f, 0.f};
#pragma unroll
                for (int ksx = 0; ksx < 2; ++ksx) {
                    const bf16x8 x1 = *(const LAS bf16x8*)(TL + (mi * 16 + fr) * 72 + ksx * 32 + fq * 8), x2 = *(const LAS bf16x8*)(AL + (mi * 16 + fr) * 72 + ksx * 32 + fq * 8);
                    aw = MFMA32(x1, yw[q][ksx], aw); aa = MFMA32(x2, ya[q][ksx], aa);
                }
#pragma unroll
                for (int ksx = 0; ksx < 4; ++ksx) {
                    const bf16x8 x3 = *(const LAS bf16x8*)(SG + (mi * 16 + fr) * 136 + ksx * 32 + fq * 8);
                    ag = MFMA32(x3, yg[q][ksx], ag);
                }
                agate[q] = ag;
                const int j = nj * 16 + fr; const float w0j = w0q[q], a0j = a0q[q];
                const float awv[4] = {aw.x, aw.y, aw.z, aw.w}, aav[4] = {aa.x, aa.y, aa.z, aa.w};
#pragma unroll
                for (int rg = 0; rg < 4; ++rg) { const int t = mi * 16 + 4 * fq + rg;
                    LWf[t * 64 + j] = -0.6065306597126334f * sigmoidf_(w0j + awv[rg]); Af[t * 64 + j] = sigmoidf_(a0j + aav[rg]); }
            }
        }
        __syncthreads();
        {
            float g[8]; float run = 0.f;
#pragma unroll
            for (int i = 0; i < 8; ++i) { run += LWf[(8 * w + i) * 64 + lane]; g[i] = run; }
            segs[w * 64 + lane] = run;
            __syncthreads();
            float off = 0.f;
#pragma unroll
            for (int s2 = 0; s2 < 7; ++s2) if (s2 < w) off += segs[s2 * 64 + lane];
#pragma unroll
            for (int i = 0; i < 8; ++i) LWf[(8 * w + i) * 64 + lane] = off + g[i];
        }
        __syncthreads();
        {
            const int j = lane;
            float btn[8], ktt[8];
#pragma unroll
            for (int i = 0; i < 8; ++i) {
                const int t = 8 * w + i;
                const float kv = bf2f(KPb[t * 72 + j]), rv = bf2f(RPb[t * 72 + j]), a = Af[t * 64 + j], G = LWf[t * 64 + j];
                const float Gp = (t > 0) ? LWf[(t - 1) * 64 + j] : 0.f;
                const float kx = kv * kkj; const float ss = wsum(kx * kx); const float kk = kx * (1.0f / sqrtf(ss + 1e-6f));
                const float km = kv * (1.f + (a - 1.f) * kaj);
                const float bs = wsum(rv * km * rkj); if (j == 0) bonus[t] = bs;
                const float eG = __expf(G), eGi = __expf(-G), eGp = __expf(Gp);
                const float bt = kk * a * eGi, kt = km * eGi;
                At[t * 72 + j] = (bf16_t)f2bf(kk * eGp); Btl[t * 72 + j] = (bf16_t)f2bf(bt); Ktl[t * 72 + j] = (bf16_t)f2bf(kt); Rtl[t * 72 + j] = (bf16_t)f2bf(rv * eG);
                btn[i] = -bt; ktt[i] = kt;
                if (t == 63) glv[j] = eG;
            }
            *(LAS u32x4*)(BtTn + j * 72 + 8 * w) = (u32x4){pk2(btn[0], btn[1]), pk2(btn[2], btn[3]), pk2(btn[4], btn[5]), pk2(btn[6], btn[7])};
            *(LAS u32x4*)(KtT + j * 72 + 8 * w) = (u32x4){pk2(ktt[0], ktt[1]), pk2(ktt[2], ktt[3]), pk2(ktt[4], ktt[5]), pk2(ktt[6], ktt[7])};
        }
        __syncthreads();
        {
            for (int job = w; job < 64; job += NWAVES) {
                const int mat = job >> 4, bi = (job >> 2) & 3, bj = job & 3;
                LAS bf16_t* dst = (mat == 0) ? Aoff : (mat == 1 ? Mak : (mat == 2 ? Mrk : Mrbn));
                const int i = 16 * bi + fr, j0 = 16 * bj + 4 * fq;
                f32x4 o = {0.f, 0.f, 0.f, 0.f};
                if (bj <= bi) {
                    const LAS bf16_t* Aj = ((mat == 0 || mat == 3) ? Btl : Ktl) + bj * 16 * 72; const LAS bf16_t* Bi = ((mat < 2) ? At : Rtl) + bi * 16 * 72;
                    const f32x4 acc = mm_tile(Aj, 72, Bi, 72, 2, (f32x4){0.f, 0.f, 0.f, 0.f}, fr, fq);
                    const bool incl = mat >= 2;
                    o.x = (incl ? (j0 <= i) : (j0 < i)) ? acc.x : 0.f; o.y = (incl ? (j0 + 1 <= i) : (j0 + 1 < i)) ? acc.y : 0.f;
                    o.z = (incl ? (j0 + 2 <= i) : (j0 + 2 < i)) ? acc.z : 0.f; o.w = (incl ? (j0 + 3 <= i) : (j0 + 3 < i)) ? acc.w : 0.f;
                    if (mat == 0 && bi == bj) { LAS float* dd = Adg + (bi * 16 + fr) * 17 + 4 * fq; dd[0] = o.x; dd[1] = o.y; dd[2] = o.z; dd[3] = o.w; o = (f32x4){0.f, 0.f, 0.f, 0.f}; }
                    if (mat == 0 || mat == 3) o = -o;
                }
                lds_w4(dst + i * 72 + j0, o);
            }
#pragma unroll
            for (int q = 0; q < 2; ++q) { const int id = 2 * w + q, mi = id >> 2, nj = id & 3; const int j = nj * 16 + fr; const float gv[4] = {agate[q].x, agate[q].y, agate[q].z, agate[q].w};
#pragma unroll
                for (int rg = 0; rg < 4; ++rg) GB[(mi * 16 + 4 * fq + rg) * 64 + j] = (bf16_t)f2bf(gv[rg]); }
        }
        __syncthreads();
        f32x4 ot[4];
        if (c > 0) ho_wait(flag, (unsigned)c, tmo, w, lane);
        if (w < 4) {
#pragma unroll
            for (int kb = 0; kb < 4; ++kb) { { const f32x4 ld = ho_load(hb, (unsigned)(((w * 64 + lane) * 4 + kb) * 16)); zacc[kb] = (c > 0) ? ld : (f32x4){0.f, 0.f, 0.f, 0.f}; }
                lds_w4(Zt + (16 * w + fr) * 72 + 16 * kb + 4 * fq, zacc[kb]); }
            asm volatile("s_waitcnt lgkmcnt(0)" ::: "memory");
        }
        if (w < 4) {
            {
                const int bb = lane >> 4, jj = lane & 15; float x[16]; const LAS float* a = Adg + bb * 16 * 17;
#pragma unroll
                for (int i = 0; i < 16; ++i) { float v = (i == jj) ? 1.f : 0.f;
#pragma unroll
                    for (int k = 0; k < i; ++k) v -= a[i * 17 + k] * x[k];
                    x[i] = v; Dg[(bb * 16 + i) * 24 + jj] = (bf16_t)f2bf(v); }
                asm volatile("s_waitcnt lgkmcnt(0)" ::: "memory");
            }
            const LAS bf16_t* Vw = Vt + (16 * w) * 72; const LAS bf16_t* Zw = Zt + (16 * w) * 72; LAS bf16_t* PUw = PU + (16 * w) * 72;
            f32x4 p[4];
#pragma unroll
            for (int mi = 0; mi < 4; ++mi) { p[mi] = mm_tile(At + mi * 16 * 72, 72, Zw, 72, 2, (f32x4){0.f, 0.f, 0.f, 0.f}, fr, fq); p[mi] = mm_tile(Mak + mi * 16 * 72, 72, Vw, 72, 2, p[mi], fr, fq); }
#pragma unroll
            for (int bb = 0; bb < 4; ++bb) {
                f32x4 acc = p[bb];
                if (bb >= 1) acc = mm_tile(Aoff + bb * 16 * 72, 72, PUw, 72, (bb + 1) / 2, acc, fr, fq);
                u32x2 pk; pk.x = pk2(acc.x, acc.y); pk.y = pk2(acc.z, acc.w);
                const bf16x4 dgf = *(const LAS bf16x4*)(Dg + (bb * 16 + fr) * 24 + 4 * fq);
                const f32x4 ub = MFMA16(dgf, __builtin_bit_cast(bf16x4, pk), ((f32x4){0.f, 0.f, 0.f, 0.f}));
                lds_w4(PUw + fr * 72 + 16 * bb + 4 * fq, ub);
                asm volatile("s_waitcnt lgkmcnt(0)" ::: "memory");
            }
#pragma unroll
            for (int mi = 0; mi < 4; ++mi) {
                f32x4 o = mm_tile(Rtl + mi * 16 * 72, 72, Zw, 72, 2, (f32x4){0.f, 0.f, 0.f, 0.f}, fr, fq);
                o = mm_tile(Mrk + mi * 16 * 72, 72, Vw, 72, 2, o, fr, fq);
                ot[mi] = mm_tile(Mrbn + mi * 16 * 72, 72, PUw, 72, 2, o, fr, fq);
            }
#pragma unroll
            for (int kb = 0; kb < 4; ++kb) {
                f32x4 zn = mm_tile(KtT + kb * 16 * 72, 72, Vw, 72, 2, zacc[kb], fr, fq);
                zn = mm_tile(BtTn + kb * 16 * 72, 72, PUw, 72, 2, zn, fr, fq);
                const f32x4 g4 = *(const LAS f32x4*)(glv + 16 * kb + 4 * fq);
                zn = zn * g4; zacc[kb] = zn;
                lds_w4(Zt + (16 * w + fr) * 72 + 16 * kb + 4 * fq, zn);
            }
        }
        if (w < 4 && c < 31) {
#pragma unroll
            for (int kb = 0; kb < 4; ++kb) ho_store(hb, (unsigned)(((w * 64 + lane) * 4 + kb) * 16), zacc[kb]);
            asm volatile("s_waitcnt vmcnt(0)" ::: "memory");
        }
        __syncthreads();
        if (c < 31 && w == 0 && lane == 0) __hip_atomic_store(flag, (unsigned)(c + 1), __ATOMIC_RELAXED, __HIP_MEMORY_SCOPE_AGENT);
        if (w < 4) {
#pragma unroll
            for (int mi = 0; mi < 4; ++mi) { LAS float* op = Of + (16 * mi + 4 * fq) * 65 + 16 * w + fr; op[0] = ot[mi].x; op[65] = ot[mi].y; op[130] = ot[mi].z; op[195] = ot[mi].w; }
        }
        __syncthreads();
        for (int t = w; t < 64; t += NWAVES) {
            const float o = Of[t * 65 + lane];
            const float mean = wsum(o) * (1.0f / 64.0f); const float dlt = o - mean; const float var = wsum(dlt * dlt) * (1.0f / 64.0f);
            float y = dlt * (1.0f / sqrtf(var + 64e-5f)) * lnw + lnb;
            y += bonus[t] * bf2f(Vt[lane * 72 + t]);
            y *= bf2f(GB[t * 64 + lane]);
            P[(size_t)(t0 + t) * P0LD + 2048 + h * 64 + lane] = (bf16_t)f2bf(y);
        }
        __syncthreads();
    }
}

__device__ __forceinline__ void attn_phase(const Frame& F, const bf16_t* Q, const bf16_t* Kb, const bf16_t* VT, bf16_t* O) {
    const int lane = lane_id_v(); const int tid = F.wave * 64 + lane; (void)tid;
    const int fr = lane & 15, fq = lane >> 4;
    for (int u = F.wg; u < 512; u += F.G) {
        const int b = u >> 6, h = (u >> 4) & 3, qb = u & 15;
        const int q0 = b * TS + qb * 128 + F.wave * 16;
        bf16x8 bq[8];
#pragma unroll
        for (int ksx = 0; ksx < 8; ++ksx) bq[ksx] = *(const bf16x8*)(Q + (size_t)(q0 + fr) * 1024 + h * 256 + ksx * 32 + fq * 8);
        f32x4 sacc[16];
#pragma unroll
        for (int tl = 0; tl < 16; ++tl) {
            f32x4 a4 = {0.f, 0.f, 0.f, 0.f};
            const bf16_t* kp = Kb + (size_t)(b * 256 + tl * 16 + fr) * 1024 + h * 256 + fq * 8;
#pragma unroll
            for (int ksx = 0; ksx < 8; ++ksx) { const bf16x8 a = *(const bf16x8*)(kp + ksx * 32); a4 = __builtin_amdgcn_mfma_f32_16x16x32_bf16(a, bq[ksx], a4, 0, 0, 0); }
            sacc[tl] = a4;
        }
        float mx = -3.0e38f;
#pragma unroll
        for (int tl = 0; tl < 16; ++tl) mx = fmaxf(mx, fmaxf(fmaxf(sacc[tl].x, sacc[tl].y), fmaxf(sacc[tl].z, sacc[tl].w)));
        mx = fmaxf(mx, __shfl_xor(mx, 16)); mx = fmaxf(mx, __shfl_xor(mx, 32));
        float l = 0.f;
        bf16x8 pb[8];
#pragma unroll
        for (int ksx = 0; ksx < 8; ++ksx) {
            const f32x4 e0 = sacc[2 * ksx], e1 = sacc[2 * ksx + 1];
            const float p0 = __expf(e0.x - mx), p1 = __expf(e0.y - mx), p2 = __expf(e0.z - mx), p3 = __expf(e0.w - mx);
            const float p4 = __expf(e1.x - mx), p5 = __expf(e1.y - mx), p6 = __expf(e1.z - mx), p7 = __expf(e1.w - mx);
            l += ((p0 + p1) + (p2 + p3)) + ((p4 + p5) + (p6 + p7));
            u32x4 w; w.x = pk2(p0, p1); w.y = pk2(p2, p3); w.z = pk2(p4, p5); w.w = pk2(p6, p7);
            pb[ksx] = __builtin_bit_cast(bf16x8, w);
        }
        l += __shfl_xor(l, 16); l += __shfl_xor(l, 32);
        const float inv = 1.0f / l;
        const bf16_t* vbase = VT + (size_t)((b * 4 + h) * 256) * 256;
#pragma unroll 4
        for (int dt = 0; dt < 16; ++dt) {
            f32x4 o4 = {0.f, 0.f, 0.f, 0.f};
            const bf16_t* vp = vbase + (size_t)(dt * 16 + fr) * 256 + 4 * fq;
#pragma unroll
            for (int ksx = 0; ksx < 8; ++ksx) {
                const u32x2 lo = *(const u32x2*)(vp + ksx * 32), hi = *(const u32x2*)(vp + ksx * 32 + 16);
                u32x4 w; w.x = lo.x; w.y = lo.y; w.z = hi.x; w.w = hi.y;
                o4 = __builtin_amdgcn_mfma_f32_16x16x32_bf16(__builtin_bit_cast(bf16x8, w), pb[ksx], o4, 0, 0, 0);
            }
            u32x2 w; w.x = pk2(o4.x * inv, o4.y * inv); w.y = pk2(o4.z * inv, o4.w * inv);
            *(u32x2*)(O + (size_t)(q0 + fr) * 1024 + h * 256 + dt * 16 + 4 * fq) = w;
        }
    }
}

__device__ __forceinline__ void attn_phase2(const Frame& F, const bf16_t* Q, const bf16_t* Kb, const bf16_t* VT, bf16_t* O) {
    const int lane = lane_id_v(); const int tid = F.wave * 64 + lane; const int fr = lane & 15, fq = lane >> 4;
    LAS bf16_t* KL = (LAS bf16_t*)F.lds;
    static_assert(256 * 264 * 2 <= LDS_MISC, "attn LDS");
    for (int u = F.wg; u < 512; u += F.G) {
        const int b = u >> 6, h = (u >> 4) & 3, qb = u & 15;
        const int q0 = b * TS + qb * 128 + F.wave * 16;
        u32x4 st[16];
#pragma unroll
        for (int n = 0; n < 16; ++n) { const int idx = tid + NTHREADS * n, row = idx >> 5, c8 = idx & 31;
            st[n] = *(const u32x4*)(Kb + (size_t)(b * 256 + row) * 1024 + h * 256 + c8 * 8); }
        bf16x8 bq[8];
#pragma unroll
        for (int ksx = 0; ksx < 8; ++ksx) bq[ksx] = *(const bf16x8*)(Q + (size_t)(q0 + fr) * 1024 + h * 256 + ksx * 32 + fq * 8);
        __syncthreads();
#pragma unroll
        for (int n = 0; n < 16; ++n) { const int idx = tid + NTHREADS * n, row = idx >> 5, c8 = idx & 31; *(LAS u32x4*)(KL + row * 264 + c8 * 8) = st[n]; }
        const bf16_t* vbase = VT + (size_t)((b * 4 + h) * 256) * 256;
#pragma unroll
        for (int n = 0; n < 16; ++n) { const int idx = tid + NTHREADS * n, row = idx >> 5, c8 = idx & 31; st[n] = *(const u32x4*)(vbase + (size_t)row * 256 + c8 * 8); }
        __syncthreads();
        f32x4 sacc[16];
#pragma unroll
        for (int tl = 0; tl < 16; ++tl) {
            f32x4 a4 = {0.f, 0.f, 0.f, 0.f};
#pragma unroll
            for (int ksx = 0; ksx < 8; ++ksx) a4 = __builtin_amdgcn_mfma_f32_16x16x32_bf16(*(const LAS bf16x8*)(KL + (tl * 16 + fr) * 264 + ksx * 32 + fq * 8), bq[ksx], a4, 0, 0, 0);
            sacc[tl] = a4;
        }
        float mx = -3.0e38f;
#pragma unroll
        for (int tl = 0; tl < 16; ++tl) mx = fmaxf(mx, fmaxf(fmaxf(sacc[tl].x, sacc[tl].y), fmaxf(sacc[tl].z, sacc[tl].w)));
        mx = fmaxf(mx, __shfl_xor(mx, 16)); mx = fmaxf(mx, __shfl_xor(mx, 32));
        float l = 0.f;
        bf16x8 pb[8];
#pragma unroll
        for (int ksx = 0; ksx < 8; ++ksx) {
            const f32x4 e0 = sacc[2 * ksx], e1 = sacc[2 * ksx + 1];
            const float p0 = __expf(e0.x - mx), p1 = __expf(e0.y - mx), p2 = __expf(e0.z - mx), p3 = __expf(e0.w - mx);
            const float p4 = __expf(e1.x - mx), p5 = __expf(e1.y - mx), p6 = __expf(e1.z - mx), p7 = __expf(e1.w - mx);
            l += ((p0 + p1) + (p2 + p3)) + ((p4 + p5) + (p6 + p7));
            u32x4 w; w.x = pk2(p0, p1); w.y = pk2(p2, p3); w.z = pk2(p4, p5); w.w = pk2(p6, p7);
            pb[ksx] = __builtin_bit_cast(bf16x8, w);
        }
        l += __shfl_xor(l, 16); l += __shfl_xor(l, 32);
        const float inv = 1.0f / l;
        __syncthreads();
#pragma unroll
        for (int n = 0; n < 16; ++n) { const int idx = tid + NTHREADS * n, row = idx >> 5, c8 = idx & 31; *(LAS u32x4*)(KL + row * 264 + c8 * 8) = st[n]; }
        __syncthreads();
#pragma unroll 4
        for (int dt = 0; dt < 16; ++dt) {
            f32x4 o4 = {0.f, 0.f, 0.f, 0.f};
            const LAS bf16_t* vp = KL + (dt * 16 + fr) * 264 + 4 * fq;
#pragma unroll
            for (int ksx = 0; ksx < 8; ++ksx) {
                const u32x2 lo = *(const LAS u32x2*)(vp + ksx * 32), hi = *(const LAS u32x2*)(vp + ksx * 32 + 16);
                u32x4 w; w.x = lo.x; w.y = lo.y; w.z = hi.x; w.w = hi.y;
                o4 = __builtin_amdgcn_mfma_f32_16x16x32_bf16(__builtin_bit_cast(bf16x8, w), pb[ksx], o4, 0, 0, 0);
            }
            u32x2 w; w.x = pk2(o4.x * inv, o4.y * inv); w.y = pk2(o4.z * inv, o4.w * inv);
            *(u32x2*)(O + (size_t)(q0 + fr) * 1024 + h * 256 + dt * 16 + 4 * fq) = w;
        }
    }
    __syncthreads();
}

__device__ __forceinline__ void router_phase(const Frame& F, int layer) {
    const int lane = lane_id_v(); const int tid = F.wave * 64 + lane; (void)tid;
    const float* XF = F.out; const float* gain = F.in[IN_NORM_FFN] + layer * 1024;
    const float* wg = F.in[IN_MOE_WG] + (size_t)layer * 1024 * 4; const float* we = F.in[IN_MOE_WE] + (size_t)layer * 1024 * 16;
    const float* bg = F.in[IN_MOE_BG] + layer * 4; const float* be = F.in[IN_MOE_BE] + layer * 16;
    unsigned* cnt = (unsigned*)(F.ws + WS_CNT) + layer * 32;
    int* tokb = (int*)(F.ws + WS_ROUTE); int* tokp = tokb + NT; f32x4* tokg = (f32x4*)(tokp + NT);
    const int gw = F.wg * NWAVES + F.wave, NGW = F.G * NWAVES;
    for (int row = gw; row < NT; row += NGW) {
        const f32x4* xr = (const f32x4*)(XF + (size_t)row * 1024) + lane;
        float s = 0.f, lg[4], le[16];
#pragma unroll
        for (int c = 0; c < 4; ++c) lg[c] = 0.f;
#pragma unroll
        for (int c = 0; c < 16; ++c) le[c] = 0.f;
#pragma unroll 1
        for (int j = 0; j < 4; ++j) {
            const f32x4 v = xr[64 * j]; s += (v.x * v.x + v.y * v.y) + (v.z * v.z + v.w * v.w);
            const int k0 = 4 * lane + 256 * j; const f32x4 g = *(const f32x4*)(gain + k0);
            const float xv[4] = {v.x * g.x, v.y * g.y, v.z * g.z, v.w * g.w};
#pragma unroll
            for (int q = 0; q < 4; ++q) {
                const f32x4 a = *(const f32x4*)(wg + (size_t)(k0 + q) * 4);
                lg[0] += xv[q] * a.x; lg[1] += xv[q] * a.y; lg[2] += xv[q] * a.z; lg[3] += xv[q] * a.w;
#pragma unroll
                for (int e4 = 0; e4 < 4; ++e4) { const f32x4 w = *(const f32x4*)(we + (size_t)(k0 + q) * 16 + 4 * e4);
                    le[4 * e4] += xv[q] * w.x; le[4 * e4 + 1] += xv[q] * w.y; le[4 * e4 + 2] += xv[q] * w.z; le[4 * e4 + 3] += xv[q] * w.w; }
            }
        }
        s = wave_sum(s);
        const float rstd = 1.0f / sqrtf(s * (1.0f / 1024.0f) + 1e-6f);
#pragma unroll
        for (int c = 0; c < 4; ++c) lg[c] = wave_sum(lg[c]) * rstd + bg[c];
#pragma unroll
        for (int c = 0; c < 16; ++c) le[c] = wave_sum(le[c]) * rstd + be[c];
        int gs = 0; float gm = lg[0];
#pragma unroll
        for (int c = 1; c < 4; ++c) if (lg[c] > gm) { gm = lg[c]; gs = c; }
        float gz = 0.f;
#pragma unroll
        for (int c = 0; c < 4; ++c) gz += __expf(lg[c] - gm);
        const float ggate = 1.0f / gz;
        float l4[4];
#pragma unroll
        for (int c = 0; c < 4; ++c) { float v = le[c];
#pragma unroll
            for (int g2 = 1; g2 < 4; ++g2) v = (gs == g2) ? le[4 * g2 + c] : v;
            l4[c] = v; }
        int i0 = 0; float m0 = l4[0];
#pragma unroll
        for (int c = 1; c < 4; ++c) if (l4[c] > m0) { m0 = l4[c]; i0 = c; }
        int i1 = -1; float m1 = -3.0e38f;
#pragma unroll
        for (int c = 0; c < 4; ++c) if (c != i0 && l4[c] > m1) { m1 = l4[c]; i1 = c; }
        const float e1 = __expf(m1 - m0); const float g0 = ggate / (1.f + e1), g1 = ggate * e1 / (1.f + e1);
        const int ia = i0 < i1 ? i0 : i1, ib = i0 < i1 ? i1 : i0;
        const float ga = i0 < i1 ? g0 : g1, gb = i0 < i1 ? g1 : g0;
        const int pidx = (ia == 0) ? (ib - 1) : (ia == 1 ? ib + 1 : 5);
        const int bucket = gs * 6 + pidx;
        if (lane == 0) {
            const unsigned pos = atomicAdd(&cnt[bucket], 1u);
            tokb[row] = bucket; tokp[row] = (int)pos; tokg[row] = (f32x4){rstd, ga, gb, 0.f};
        }
    }
}
typedef float f32x16 __attribute__((ext_vector_type(16)));
__device__ __forceinline__ void router_phase2(const Frame& F, int layer) {
    const int lane = lane_id_v(); const int tid = F.wave * 64 + lane; const int w = F.wave;
    const float* XF = F.out; const float* rw = (const float*)(F.ws + WS_RW) + (size_t)layer * 1024 * 32;
    const float* ssp = (const float*)(F.ws + WS_SSP);
    unsigned* cnt = (unsigned*)(F.ws + WS_CNT) + layer * 32;
    int* tokb = (int*)(F.ws + WS_ROUTE); int* tokp = tokb + NT; f32x4* tokg = (f32x4*)(tokp + NT);
    LAS float* T = (LAS float*)F.lds + w * (32 * 132);
    LAS float* Pp = (LAS float*)F.lds;
    LAS float* Lg = Pp + 8 * 64 * 33;
    const int i31 = lane & 31, kh = lane >> 5, k0 = 128 * w;
    float bW[64];
#pragma unroll
    for (int s2 = 0; s2 < 64; ++s2) bW[s2] = rw[(size_t)(k0 + 2 * s2 + kh) * 32 + i31];
    for (int blk = F.wg; blk < NT / 64; blk += F.G) {
        const int r0 = blk * 64;
        f32x16 acc0, acc1;
#pragma unroll
        for (int e = 0; e < 16; ++e) { acc0[e] = 0.f; acc1[e] = 0.f; }
#pragma unroll
        for (int rt = 0; rt < 2; ++rt) {
#pragma unroll
            for (int n = 0; n < 16; ++n) { const int idx = lane + 64 * n, row = idx >> 5, c4 = idx & 31;
                const f32x4 v = *(const f32x4*)(XF + (size_t)(r0 + 32 * rt + row) * 1024 + k0 + 4 * c4);
                *(LAS f32x4*)(T + row * 132 + 4 * c4) = v; }
            asm volatile("s_waitcnt lgkmcnt(0)" ::: "memory");
#pragma unroll
            for (int s2 = 0; s2 < 64; ++s2) {
                const float a0 = T[i31 * 132 + 2 * s2 + kh];
                if (rt == 0) acc0 = __builtin_amdgcn_mfma_f32_32x32x2f32(a0, bW[s2], acc0, 0, 0, 0);
                else acc1 = __builtin_amdgcn_mfma_f32_32x32x2f32(a0, bW[s2], acc1, 0, 0, 0);
            }
            asm volatile("s_waitcnt lgkmcnt(0)" ::: "memory");
        }
        __syncthreads();
#pragma unroll
        for (int e = 0; e < 16; ++e) { const int row = (e & 3) + 8 * (e >> 2) + 4 * kh;
            Pp[(w * 64 + row) * 33 + i31] = acc0[e]; Pp[(w * 64 + 32 + row) * 33 + i31] = acc1[e]; }
        __syncthreads();
        for (int idx = tid; idx < 64 * 32; idx += NTHREADS) { const int row = idx >> 5, cc = idx & 31; float a = 0.f;
#pragma unroll
            for (int ww = 0; ww < 8; ++ww) a += Pp[(ww * 64 + row) * 33 + cc];
            Lg[row * 33 + cc] = a; }
        __syncthreads();
        if (tid < 64) {
            const int row = r0 + tid; const float rstd = row_rstd(ssp, row);
            const float* bg = F.in[IN_MOE_BG] + layer * 4; const float* be = F.in[IN_MOE_BE] + layer * 16;
            float lg[4], le[16];
#pragma unroll
            for (int c2 = 0; c2 < 4; ++c2) lg[c2] = Lg[tid * 33 + c2] * rstd + bg[c2];
#pragma unroll
            for (int c2 = 0; c2 < 16; ++c2) le[c2] = Lg[tid * 33 + 4 + c2] * rstd + be[c2];
            int gs = 0; float gm = lg[0];
#pragma unroll
            for (int c2 = 1; c2 < 4; ++c2) if (lg[c2] > gm) { gm = lg[c2]; gs = c2; }
            float gz = 0.f;
#pragma unroll
            for (int c2 = 0; c2 < 4; ++c2) gz += __expf(lg[c2] - gm);
            const float ggate = 1.0f / gz;
            float l4[4];
#pragma unroll
            for (int c2 = 0; c2 < 4; ++c2) { float v = le[c2];
#pragma unroll
                for (int g2 = 1; g2 < 4; ++g2) v = (gs == g2) ? le[4 * g2 + c2] : v;
                l4[c2] = v; }
            int i0 = 0; float m0 = l4[0];
#pragma unroll
            for (int c2 = 1; c2 < 4; ++c2) if (l4[c2] > m0) { m0 = l4[c2]; i0 = c2; }
            int i1 = -1; float m1 = -3.0e38f;
#pragma unroll
            for (int c2 = 0; c2 < 4; ++c2) if (c2 != i0 && l4[c2] > m1) { m1 = l4[c2]; i1 = c2; }
            const float e1 = __expf(m1 - m0); const float g0 = ggate / (1.f + e1), g1 = ggate * e1 / (1.f + e1);
            const int ia = i0 < i1 ? i0 : i1, ib = i0 < i1 ? i1 : i0;
            const float ga = i0 < i1 ? g0 : g1, gb = i0 < i1 ? g1 : g0;
            const int pidx = (ia == 0) ? (ib - 1) : (ia == 1 ? ib + 1 : 5);
            const int bucket = gs * 6 + pidx;
            const unsigned pos = atomicAdd(&cnt[bucket], 1u);
            tokb[row] = bucket; tokp[row] = (int)pos; tokg[row] = (f32x4){rstd, ga, gb, 0.f};
        }
        __syncthreads();
    }
}
__device__ __forceinline__ void gather_phase(const Frame& F, int layer) {
    const int lane = lane_id_v(); const int tid = F.wave * 64 + lane; (void)tid;
    const unsigned* cnt = (const unsigned*)(F.ws + WS_CNT) + layer * 32;
    const int* tokb = (const int*)(F.ws + WS_ROUTE); const int* tokp = tokb + NT; const f32x4* tokg = (const f32x4*)(tokp + NT); f32x4* rowinfo = (f32x4*)(tokg + NT);
    const bf16_t* XB = (const bf16_t*)(F.ws + WS_XB); bf16_t* XG = (bf16_t*)(F.ws + WS_BIG + BIG_XG);
    LAS int* off = (LAS int*)F.lds;
    if (tid == 0) { int acc = 0; for (int b = 0; b < 24; ++b) { off[b] = acc * 256; acc += ((int)cnt[b] + 255) >> 8; } }
    __syncthreads();
    const int gw = F.wg * NWAVES + F.wave, NGW = F.G * NWAVES;
    for (int tok = gw; tok < NT; tok += NGW) {
        const int row = off[tokb[tok]] + tokp[tok];
        const u32x4* src = (const u32x4*)(XB + (size_t)tok * 1024) + lane; u32x4* dst = (u32x4*)(XG + (size_t)row * 1024) + lane;
        dst[0] = src[0]; dst[64] = src[64];
        if (lane == 0) { f32x4 g = tokg[tok]; g.w = __int_as_float(tok); rowinfo[row] = g; }
    }
    __syncthreads();
}
__device__ __forceinline__ void final_phase(const Frame& F) {
    const int lane = lane_id_v(); const int tid = F.wave * 64 + lane; (void)tid;
    float* XF = F.out; const float* gain = F.in[IN_NORM_FINAL];
    const int gw = F.wg * NWAVES + F.wave, NGW = F.G * NWAVES;
    for (int row = gw; row < NT; row += NGW) {
        f32x4* xr = (f32x4*)(XF + (size_t)row * 1024) + lane;
        f32x4 v[4]; float s = 0.f;
#pragma unroll
        for (int j = 0; j < 4; ++j) { v[j] = xr[64 * j]; s += (v[j].x * v[j].x + v[j].y * v[j].y) + (v[j].z * v[j].z + v[j].w * v[j].w); }
        s = wave_sum(s);
        const float rstd = 1.0f / sqrtf(s * (1.0f / 1024.0f) + 1e-6f);
#pragma unroll
        for (int j = 0; j < 4; ++j) { const f32x4 g = *(const f32x4*)(gain + 4 * lane + 256 * j); xr[64 * j] = v[j] * rstd * g; }
    }
}

constexpr int N_PHASES = 24;
#ifndef PH_MASK
#define PH_MASK 0xFFFFFFFFu
#endif
#define IN(k) (((PH_MASK >> ((k) > 11 ? (k) - 11 : (k))) & 1u) && lo <= (k) && (k) < hi)
#define TS_STAMP(k) do { if (TS_A >= 0 && ((k) == TS_A || (k) == TS_B) && F.wg == 0 && F.wave == 0 && lane_id_v() == 0) ((volatile LAS unsigned*)(F.lds + LDS_MISC + 1024))[(k)] = (unsigned)__builtin_amdgcn_s_memrealtime(); } while (0)
#define SEAM(k) do { if (IN(k) && IN((k) + 1)) xcd_barrier(bar); TS_STAMP((k) + 1); } while (0)
#define SEAM2(k) do { if (IN(k) && IN((k) + 2)) xcd_barrier(bar); TS_STAMP((k) + 2); } while (0)

template <int LAYER>
__device__ __forceinline__ void layer_phases(const Frame& F, const XcdBarrier& bar, const int lo, const int hi) {
    constexpr int pb = LAYER * 11;
    unsigned char* const ws = F.ws;
#define WPTR(off) ((bf16_t*)(ws + (LAYER ? WS_W1 : WS_W0)) + (off))
#define XB_ ((bf16_t*)(ws + WS_XB))
#define SSP_ ((float*)(ws + WS_SSP))
#define PROJ_ ((bf16_t*)(ws + WS_BIG + BIG_PROJ))
#define KB_ (LAYER ? (bf16_t*)(ws + WS_W0) : (bf16_t*)(ws + WS_BIG + BIG_KV0))
#define VT_ (KB_ + (size_t)2048 * 1024)
#define QB_ ((bf16_t*)(ws + WS_BIG + BIG_Q))
#define ATT_ ((bf16_t*)(ws + WS_BIG + BIG_ATT))
#define XG_ ((bf16_t*)(ws + WS_BIG + BIG_XG))
#define HID_ ((bf16_t*)(ws + WS_BIG + BIG_HID))
#define CNT_ ((const unsigned*)(ws + WS_CNT) + LAYER * 32)
#define ROWINFO_ ((const f32x4*)(ws + WS_ROUTE + (size_t)NT * 8 + (size_t)NT * 16))
    if (IN(pb + 1)) {
        if (LAYER == 0) {
            pg8::Gemm g{1024, 1024, 1024, 1 << 20}; pg8::DenseSched S; S.init(NT, 3840, F.G, F.wg, XB_, 1024, WPTR(WO_WIN), 1024);
            EpiScale<0> E{PROJ_, P0LD, SSP_, 1.0f, nullptr, (bf16_t*)(ws + WS_HALOB)};
            pg8::gemm_phase(F.lds, F.wave, g, S, E);
        } else {
            pg8::Gemm g{1024, 1024, 1024, 1 << 20}; pg8::DenseSched S; S.init(NT, 4096, F.G, F.wg, XB_, 1024, WPTR(WO_WIN), 1024);
            EpiScale<1> E{PROJ_, P1LD, SSP_, 1.0f, (const float*)(ws + WS_LB), nullptr};
            pg8::gemm_phase(F.lds, F.wave, g, S, E);
        }
        if (LAYER == 1) { pg8::Gemm g{1024, 1024, 1024, 1 << 20}; pg8::DenseSched S; S.init(2048, 2048, F.G, F.wg, (const bf16_t*)(ws + WS_MEMH), 1024, WPTR(WO_WKV), 1024);
          EpiKV E{KB_, VT_}; pg8::gemm_phase(F.lds, F.wave, g, S, E); }
    }
    SEAM(pb + 1);
    if (IN(pb + 2)) {
        unsigned pt0 = 0; if (PROBE_WG >= 0 && LAYER == 0) pt0 = (unsigned)__builtin_amdgcn_s_memrealtime();
        if (LAYER == 0) {
#ifndef NO_DELTA
            if (F.wg < 96) { const int st = F.wg & 31; scan_delta3(F, st >> 2, st & 3, F.wg >> 5, 3); }
#endif
#ifndef NO_RWKV
            if (F.wg >= 96 && F.wg < 224) { const int q = F.wg - 96, st = ((q >> 4) << 3) | (q & 7), par = (q >> 3) & 1; scan_rwkv3(F, st >> 3, st & 7, par); }
#endif
            if (F.wg >= 224) p0_late_weights<0>(F, F.wg - 224, F.G - 224);
        } else {
#ifndef NO_HGRN
            if (F.wg < 64) scan_hgrn3(F, F.wg >> 3, F.wg & 7);
#endif
            if (F.wg >= 64) p0_late_weights<1>(F, F.wg - 64, F.G - 64);
        }
        if (PROBE_WG >= 0 && LAYER == 0 && F.wg == PROBE_WG && F.wave == 0 && lane_id_v() == 0) __hip_atomic_store((unsigned*)(F.ws + WS_CTL + 20480), (unsigned)__builtin_amdgcn_s_memrealtime() - pt0, __ATOMIC_RELAXED, __HIP_MEMORY_SCOPE_AGENT);
    }
    SEAM2(pb + 2);
    if (IN(pb + 4)) {
        constexpr int lda = LAYER ? P1LD : P0LD; const bf16_t* A = PROJ_ + (LAYER ? 3072 : 1536);
        pg8::Gemm g{lda, 1024, 1024, 1 << 20}; pg8::DenseSched S; S.init(NT, 1024, F.G, F.wg, A, lda, WPTR(WO_WOUT), 1024);
        EpiResid<false> E{LAYER ? (const float*)F.out : F.in[IN_X], F.out, XB_, SSP_, nullptr};
        pg8::gemm_phase(F.lds, F.wave, g, S, E);
    }
    SEAM(pb + 4);
    if (IN(pb + 5)) {
        pg8::Gemm g{1024, 1024, 1024, 1 << 20}; pg8::DenseSched S; S.init(NT, 1024, F.G, F.wg, XB_, 1024, WPTR(WO_WQ), 1024);
        EpiScale<0> E{QB_, 1024, SSP_, 0.0625f, nullptr, nullptr};
        pg8::gemm_phase(F.lds, F.wave, g, S, E);
        if (LAYER == 0) { pg8::Gemm g2{1024, 1024, 1024, 1 << 20}; pg8::DenseSched S2; S2.init(2048, 2048, F.G, F.wg, (const bf16_t*)(ws + WS_MEMH), 1024, WPTR(WO_WKV), 1024);
          EpiKV E2{KB_, VT_}; pg8::gemm_phase(F.lds, F.wave, g2, S2, E2); }
    }
    SEAM(pb + 5);
    if (IN(pb + 6)) attn_phase2(F, QB_, KB_, VT_, ATT_);
    SEAM(pb + 6);
    if (IN(pb + 7)) {
        pg8::Gemm g{1024, 1024, 1024, 1 << 20}; pg8::DenseSched S; S.init(NT, 1024, F.G, F.wg, ATT_, 1024, WPTR(WO_WO), 1024);
        EpiResid<false> E{F.out, F.out, XB_, SSP_, nullptr};
        pg8::gemm_phase(F.lds, F.wave, g, S, E);
    }
    SEAM(pb + 7);
    if (IN(pb + 8)) router_phase2(F, LAYER);
    SEAM(pb + 8);
    if (IN(pb + 9)) gather_phase(F, LAYER);
    SEAM(pb + 9);
    if (IN(pb + 10)) {
        LAS int* tbl = (LAS int*)(F.lds + LDS_MISC + 512); moe_build_table(tbl, CNT_, F.wave * 64 + lane_id_v());
        pg8::Gemm g{1024, 1024, 1024, 1 << 20}; MoeSched<false> S{tbl, __builtin_amdgcn_readfirstlane(tbl[95]), F.G, F.wg, (const char*)XG_, (const char*)WPTR(WO_W13)};
        EpiMoeUp E{HID_, ROWINFO_};
        pg8::gemm_phase(F.lds, F.wave, g, S, E);
    }
    SEAM(pb + 10);
    if (IN(pb + 11)) {
        LAS int* tbl = (LAS int*)(F.lds + LDS_MISC + 512); moe_build_table(tbl, CNT_, F.wave * 64 + lane_id_v());
        pg8::Gemm g{512, 256, 512, 4}; MoeSched<true> S{tbl, __builtin_amdgcn_readfirstlane(tbl[95]), F.G, F.wg, (const char*)HID_, (const char*)WPTR(WO_W2T)};
        EpiResid<true> E{F.out, F.out, XB_, SSP_, ROWINFO_};
        pg8::gemm_phase(F.lds, F.wave, g, S, E);
    }
    SEAM(pb + 11);
}

__global__ void __launch_bounds__(NTHREADS, 2) fwd_mega(Args args) {
    extern __shared__ __attribute__((aligned(16))) unsigned char lds_raw[];
    Frame F;
    F.lds = (LAS unsigned char*)lds_raw;
    const int tid = threadIdx.x; F.wave = __builtin_amdgcn_readfirstlane(tid >> 6);
    F.G = gridDim.x; F.wg = blockIdx.x;
    F.out = args.out; F.ws = args.ws;
    volatile LAS unsigned* MISC = (volatile LAS unsigned*)(F.lds + LDS_MISC);
    LAS unsigned long long* tab = (LAS unsigned long long*)(F.lds + LDS_MISC + 64);
    F.in.t = tab;
    if (tid < 16) MISC[tid] = 0u;
    if (tid == 0) {
#pragma unroll
        for (int i = 0; i < 38; ++i) tab[i] = (unsigned long long)args.in[i];
    }
    __syncthreads();
    XcdBarrier bar; bar.bar = (unsigned*)(F.ws + WS_CTL); bar.x = 0; bar.st = MISC; bar.wave = F.wave;
#if N_LAUNCH_MODE == 1
    bar = xcd_barrier_post((unsigned*)(F.ws + WS_CTL), MISC, F.wave);
#endif
    const int lo = args.ph_lo, hi = args.ph_hi;
    TS_STAMP(0);
    if (IN(0)) { p0_prologue(F); }
    SEAM(0);
    layer_phases<0>(F, bar, lo, hi);
    layer_phases<1>(F, bar, lo, hi);
    if (IN(23)) final_phase(F);
    if (TS_A >= 0 && F.wg == 0 && F.wave == 0) {
        asm volatile("s_waitcnt vmcnt(0)" ::: "memory");
        if (lane_id_v() == 0) { volatile LAS unsigned* ts = (volatile LAS unsigned*)(F.lds + LDS_MISC + 1024);
            float us = (float)(ts[TS_B] - ts[TS_A]) * 0.01f;
            if (PROBE_WG >= 0) us = (float)__hip_atomic_load((unsigned*)(F.ws + WS_CTL + 20480), __ATOMIC_RELAXED, __HIP_MEMORY_SCOPE_AGENT) * 0.01f;
            if (PROBE_STAGE >= 0) us = (float)__hip_atomic_load((unsigned*)(F.ws + WS_CTL + 20484), __ATOMIC_RELAXED, __HIP_MEMORY_SCOPE_AGENT) * 0.01f;
            F.out[0] = F.out[0] + us * TS_SCALE; }
    }
}
#undef IN
#undef SEAM

extern "C" void kernel_launch(void* const* d_in, const int* in_sizes, int n_in, void* d_out, int out_size, void* d_ws, size_t ws_size, hipStream_t stream) {
    static int grid = 0;
    if (grid == 0) {
        if (n_in != 38 || out_size != NT * DM || ws_size < WS_END) { fprintf(stderr, "kernel_launch: unexpected problem (n_in %d out %d ws %zu)\n", n_in, out_size, ws_size); grid = -1; return; }
        int dev = 0, cus = 0, per_cu = 0;
        if (hipGetDevice(&dev) != hipSuccess || hipDeviceGetAttribute(&cus, hipDeviceAttributeMultiprocessorCount, dev) != hipSuccess) { grid = -1; return; }
        if (hipFuncSetAttribute((const void*)fwd_mega, hipFuncAttributeMaxDynamicSharedMemorySize, LDS_BYTES) != hipSuccess) { fprintf(stderr, "kernel_launch: hipFuncSetAttribute failed\n"); grid = -1; return; }
        if (hipOccupancyMaxActiveBlocksPerMultiprocessor(&per_cu, (const void*)fwd_mega, NTHREADS, LDS_BYTES) != hipSuccess || per_cu < 1) { fprintf(stderr, "kernel_launch: occupancy query says %d\n", per_cu); (void)hipGetLastError(); grid = -1; return; }
        grid = cus;
    }
    if (grid < 0) return;
    (void)hipMemsetAsync((char*)d_ws + WS_CTL, 0, 32768, stream);
    Args a{};
    for (int i = 0; i < 38; ++i) a.in[i] = (const float*)d_in[i];
    a.out = (float*)d_out; a.ws = (unsigned char*)d_ws;
#if N_LAUNCH_MODE == 1
    a.ph_lo = 0; a.ph_hi = N_PHASES;
    void* kargs[] = {&a};
    hipError_t e = hipLaunchCooperativeKernel((const void*)fwd_mega, dim3(grid), dim3(NTHREADS), kargs, LDS_BYTES, stream);
    if (e != hipSuccess) fprintf(stderr, "kernel_launch: cooperative launch failed: %s\n", hipGetErrorString(e));
#else
    for (int p = 0; p < N_PHASES; ++p) { a.ph_lo = p; a.ph_hi = p + 1; hipLaunchKernelGGL(fwd_mega, dim3(grid), dim3(NTHREADS), LDS_BYTES, stream, a); }
#endif
}
```

```cpp
#include <hip/hip_runtime.h>
#include <cstdio>
#include <cstdint>

#ifndef N_LAUNCH_MODE
#define N_LAUNCH_MODE 1
#endif

#ifndef TS_A
#define TS_A -1
#endif
#ifndef TS_B
#define TS_B 0
#endif
#ifndef PROBE_WG
#define PROBE_WG -1
#endif
#ifndef PROBE_STAGE
#define PROBE_STAGE -1
#endif
#ifndef TS_SCALE
#define TS_SCALE 0.01f
#endif

#define LAS __attribute__((address_space(3)))
#define GAS __attribute__((address_space(1)))
typedef unsigned short bf16_t;
typedef short bf16x8 __attribute__((ext_vector_type(8)));
typedef short bf16x4 __attribute__((ext_vector_type(4)));
typedef float f32x4 __attribute__((ext_vector_type(4)));
typedef float f32x2 __attribute__((ext_vector_type(2)));
typedef unsigned u32x4 __attribute__((ext_vector_type(4)));
typedef unsigned u32x2 __attribute__((ext_vector_type(2)));

constexpr int NT = 16384, DM = 1024, NB = 8, TS = 2048, NMEM = 256;
constexpr int P0LD = 3840;
constexpr int P1LD = 4096;
constexpr int NTHREADS = 512, NWAVES = 8;

constexpr size_t MiB = 1048576;
constexpr size_t WS_CTL = 0;
constexpr size_t WS_CNT = 16384;
constexpr size_t WS_LB = 32768;
constexpr size_t WS_DB = 1 * MiB;
constexpr size_t WS_SSP = WS_DB + 512 * 1024;
constexpr size_t WS_MEMH = WS_SSP + 1 * MiB;
constexpr size_t WS_ROUTE = WS_MEMH + 4 * MiB;
constexpr size_t WS_LORA = WS_ROUTE + 800 * 1024;
constexpr size_t WS_RW = WS_LORA + 256 * 1024;
constexpr size_t WS_W0 = 8 * MiB;
static_assert(WS_RW + 2 * 1024 * 32 * 4 <= 8 * MiB, "small weights");
constexpr size_t WS_W1 = WS_W0 + 42 * MiB;
constexpr size_t WS_XB = 92 * MiB;
constexpr size_t WS_BIG = 124 * MiB;
constexpr size_t WS_END = 256 * MiB;
constexpr size_t WS_HALOB = 252 * MiB;
constexpr size_t WS_HOB = 253 * MiB;
constexpr size_t WS_HOA = 254 * MiB;
constexpr size_t WS_HOC = 252 * MiB;
constexpr size_t WS_FLAGS = 24576;
constexpr size_t WO_WIN = 0;
constexpr size_t WO_WOUT = WO_WIN + (size_t)4096 * 1024;
constexpr size_t WO_WQ = WO_WOUT + (size_t)1024 * 1024;
constexpr size_t WO_WKV = WO_WQ + (size_t)1024 * 1024;
constexpr size_t WO_WO = WO_WKV + (size_t)2048 * 1024;
constexpr size_t WO_W13 = WO_WO + (size_t)1024 * 1024;
constexpr size_t WO_W2T = WO_W13 + (size_t)16 * 512 * 1024;
constexpr size_t WO_END = WO_W2T + (size_t)16 * 1024 * 256;
static_assert(WO_END * 2 <= 42 * MiB, "weight region");
constexpr size_t BIG_PROJ = 0;
constexpr size_t BIG_KV0 = 120 * MiB;
constexpr size_t BIG_Q = 0;
constexpr size_t BIG_ATT = 32 * MiB;
constexpr size_t BIG_XG = 0;
constexpr size_t BIG_HID = 48 * MiB;
constexpr int MOE_MAXROWS = 22528;

__device__ __forceinline__ unsigned f2bf(float f) { unsigned u = __float_as_uint(f); u += 0x7fffu + ((u >> 16) & 1u); return u >> 16; }
__device__ __forceinline__ float bf2f(unsigned short b) { return __uint_as_float((unsigned)b << 16); }
__device__ __forceinline__ unsigned pk2(float lo, float hi) { return f2bf(lo) | (f2bf(hi) << 16); }
__device__ __forceinline__ float wave_sum(float v) {
#pragma unroll
    for (int o = 1; o < 64; o <<= 1) v += __shfl_xor(v, o);
    return v;
}
__device__ __forceinline__ float sigmoidf_(float x) { return 1.f / (1.f + __expf(-x)); }
__device__ __forceinline__ float siluf_(float x) { return x / (1.f + __expf(-x)); }
__device__ __forceinline__ float softplusf_(float x) { return x > 20.f ? x : log1pf(__expf(x)); }
__device__ __forceinline__ int lane_id_v() { int l; asm volatile("v_mbcnt_lo_u32_b32 %0, -1, 0\n\tv_mbcnt_hi_u32_b32 %0, -1, %0" : "=v"(l)); return l; }
#define LDS_WAIT() asm volatile("s_waitcnt lgkmcnt(0)" ::: "memory")
#define VM_WAIT() asm volatile("s_waitcnt vmcnt(0)" ::: "memory")

namespace pg8 {
constexpr int BM = 256, BK = 64, HALF = 128, HTB = HALF * BK * 2, STAGE_BYTES = 8 * HTB;
__host__ __device__ __forceinline__ int lds_byte(int r, int c) { const int st = (r >> 4) * 2 + (c >> 5), rr = r & 15, cc = c & 31, ob = rr * 64 + cc * 2; return st * 1024 + (ob ^ (((ob >> 9) & 1) << 5)); }
__host__ __device__ __forceinline__ void stage_rc(int b, int& R, int& C) { const int st = b / 1024, sb = b % 1024, swz = sb ^ (((sb >> 9) & 1) << 5); R = (st >> 1) * 16 + swz / 64; C = (st & 1) * 32 + (swz % 64) / 2; }

struct Unit { int pm, pn, aux; const char* a; const char* b0; const char* b1; };
struct Gemm { int lda, ldb, K, ksplit; };

template <class Epi, class Sched>
__device__ __forceinline__ void gemm_phase(LAS unsigned char* lds, const int wave_in, const Gemm g, const Sched& S, const Epi& E) {
    const int wid = wave_in, lane = lane_id_v(), tid = wid * 64 + lane, wr = wid >> 2, wc = wid & 3, fr = lane & 15, fq = lane >> 4;
    const int K = g.K, nt = K / BK, ks = g.ksplit;
    unsigned voffA[2], voffB[2];
#pragma unroll
    for (int i = 0; i < 2; ++i) { int R, C; stage_rc(tid * 16 + i * 8192, R, C);
        voffA[i] = (unsigned)(R * g.lda + C) * 2u; voffB[i] = (unsigned)(R * g.ldb + C) * 2u; }
    const size_t kstep = (size_t)(BK * 2);
    const size_t hstepA = (size_t)HALF * g.lda * 2, hstepB = (size_t)HALF * g.ldb * 2;
    const unsigned ldsw = (unsigned)wid * 1024u;
    const int aoff = lds_byte(wr * 64 + fr, fq * 8), boff = lds_byte(wc * 32 + fr, fq * 8);
#define PG8_SA(b, h) (((b) * 2 + (h)) * HTB)
#define PG8_SB(b, h) ((4 + (b) * 2 + (h)) * HTB)
#define PG8_STAGE(bufoff, gbase, voff) do { _Pragma("unroll") for (int _i = 0; _i < 2; ++_i) \
        __builtin_amdgcn_global_load_lds((const unsigned*)((const char*)(gbase) + (voff)[_i]), (LAS unsigned*)(lds + (bufoff) + ldsw + _i * 8192), 16, 0, 0); } while (0)
#define PG8_LDA(dst, b, h) do { _Pragma("unroll") for (int m = 0; m < 4; ++m) _Pragma("unroll") for (int k = 0; k < 2; ++k) dst[m][k] = *(const LAS bf16x8*)(lds + PG8_SA(b, h) + aoff + m * 2048 + k * 1024); } while (0)
#define PG8_LDB(dst, b, h) do { _Pragma("unroll") for (int n = 0; n < 2; ++n) _Pragma("unroll") for (int k = 0; k < 2; ++k) dst[n][k] = *(const LAS bf16x8*)(lds + PG8_SB(b, h) + boff + n * 2048 + k * 1024); } while (0)
#define PG8_MMA(ai, bj, At, Bt) do { __builtin_amdgcn_s_setprio(1); _Pragma("unroll") for (int m = 0; m < 4; ++m) _Pragma("unroll") for (int n = 0; n < 2; ++n) _Pragma("unroll") for (int k = 0; k < 2; ++k) \
        acc[ai][bj][m][n] = __builtin_amdgcn_mfma_f32_16x16x32_bf16(Bt[n][k], At[m][k], acc[ai][bj][m][n], 0, 0, 0); __builtin_amdgcn_s_setprio(0); } while (0)
#define PG8_WAIT_V(n) asm volatile("s_waitcnt vmcnt(" #n ")" ::: "memory")
#define PG8_WAIT_L(n) asm volatile("s_waitcnt lgkmcnt(" #n ")" ::: "memory")
#define PG8_BAR __builtin_amdgcn_s_barrier()
#define PG8_SCHED __builtin_amdgcn_sched_barrier(0)
    Unit cur, nxt; int ui = 0;
    if (!S.next(0, cur)) return;
    f32x4 acc[2][2][4][2];
#pragma unroll
    for (int a = 0; a < 2; ++a)
#pragma unroll
        for (int b = 0; b < 2; ++b)
#pragma unroll
            for (int m = 0; m < 4; ++m)
#pragma unroll
                for (int n = 0; n < 2; ++n) acc[a][b][m][n] = (f32x4){0.f, 0.f, 0.f, 0.f};
    bf16x8 At[4][2], B0[2][2], B1[2][2];
    const char* cA = cur.a; const char* cB = cur.b0; const char* cB1 = cur.b1;
    PG8_STAGE(PG8_SB(0, 0), cB, voffB); PG8_STAGE(PG8_SB(0, 1), cB + hstepB, voffB); PG8_STAGE(PG8_SA(0, 0), cA, voffA); PG8_STAGE(PG8_SA(0, 1), cA + hstepA, voffA);
    if (wr == 1) PG8_BAR;
    PG8_WAIT_V(2); PG8_BAR;
    PG8_STAGE(PG8_SB(1, 0), cB + kstep, voffB); PG8_STAGE(PG8_SA(1, 0), cA + kstep, voffA); PG8_STAGE(PG8_SB(1, 1), cB + hstepB + kstep, voffB);
    PG8_WAIT_V(6); PG8_BAR;
    for (;;) {
        const bool has_next = S.next(ui + 1, nxt);
        const char* nA = has_next ? nxt.a : cA; const char* nB = has_next ? nxt.b0 : cB;
        for (int t = 0; t < nt; t += 2) {
            const bool last = (t == nt - 2);
            const char* a1 = cA + (size_t)(t + 1) * kstep;
            const char* a2 = last ? nA : cA + (size_t)(t + 2) * kstep;
            const char* b2 = last ? nB : ((t + 2) < ks ? cB + (size_t)(t + 2) * kstep : cB1 + (size_t)(t + 2 - ks) * kstep);
            const char* a3 = a2 + kstep; const char* b3 = b2 + kstep;
            PG8_LDB(B0, 0, 0); PG8_LDB(B1, 0, 1); PG8_SCHED; PG8_LDA(At, 0, 0); PG8_STAGE(PG8_SA(1, 1), a1 + hstepA, voffA);
            PG8_WAIT_V(8); PG8_WAIT_L(0); PG8_BAR; PG8_MMA(0, 0, At, B0); PG8_MMA(0, 1, At, B1); PG8_BAR; PG8_SCHED;
            PG8_LDA(At, 0, 1); PG8_STAGE(PG8_SB(0, 0), b2, voffB); PG8_STAGE(PG8_SB(0, 1), b2 + hstepB, voffB); PG8_STAGE(PG8_SA(0, 0), a2, voffA);
            PG8_WAIT_V(8); PG8_WAIT_L(0); PG8_BAR; PG8_MMA(1, 0, At, B0); PG8_MMA(1, 1, At, B1); PG8_BAR; PG8_SCHED;
            PG8_LDB(B0, 1, 0); PG8_LDB(B1, 1, 1); PG8_SCHED; PG8_LDA(At, 1, 0); PG8_STAGE(PG8_SA(0, 1), a2 + hstepA, voffA);
            PG8_WAIT_V(8); PG8_WAIT_L(0); PG8_BAR; PG8_MMA(0, 0, At, B0); PG8_MMA(0, 1, At, B1); PG8_BAR; PG8_SCHED;
            PG8_LDA(At, 1, 1); PG8_STAGE(PG8_SB(1, 0), b3, voffB); PG8_STAGE(PG8_SB(1, 1), b3 + hstepB, voffB); PG8_STAGE(PG8_SA(1, 0), a3, voffA);
            PG8_WAIT_V(8); PG8_WAIT_L(0); PG8_BAR; PG8_MMA(1, 0, At, B0); PG8_MMA(1, 1, At, B1); PG8_BAR; PG8_SCHED;
        }
        if (wr == 0) PG8_BAR;
        E(acc, cur, wr, wc, fr, fq);
        if (!has_next) break;
#pragma unroll
        for (int a = 0; a < 2; ++a)
#pragma unroll
            for (int b = 0; b < 2; ++b)
#pragma unroll
                for (int m = 0; m < 4; ++m)
#pragma unroll
                    for (int n = 0; n < 2; ++n) acc[a][b][m][n] = (f32x4){0.f, 0.f, 0.f, 0.f};
        cur = nxt; cA = nA; cB = nB; cB1 = nxt.b1; ++ui;
        if (wr == 1) PG8_BAR;
    }
    PG8_WAIT_V(0);
    PG8_BAR;
#undef PG8_SA
#undef PG8_SB
#undef PG8_STAGE
#undef PG8_LDA
#undef PG8_LDB
#undef PG8_MMA
#undef PG8_WAIT_V
#undef PG8_WAIT_L
#undef PG8_BAR
#undef PG8_SCHED
}

struct DenseSched {
    int nM, nN, nwg, G, c; const char* A; const char* B; size_t tA, tB;
    __device__ void init(int M, int N, int G_, int c_, const bf16_t* A_, int lda, const bf16_t* B_, int ldb) { nM = M / 256; nN = N / 256; nwg = nM * nN; G = G_; c = c_; A = (const char*)A_; B = (const char*)B_; tA = (size_t)256 * lda * 2; tB = (size_t)256 * ldb * 2; }
    __device__ bool next(int i, Unit& u) const {
        const long L = (long)i * G + c; if (L >= nwg) return false;
        int wgid = (int)L; { const int q = nwg / 8, r = nwg % 8, xcd = wgid % 8, off = wgid / 8; wgid = (xcd < r ? xcd * (q + 1) : r * (q + 1) + (xcd - r) * q) + off; }
        const int nig = 8 * nN, gid = wgid / nig, fm = gid * 8, gsz = (nM - fm) < 8 ? (nM - fm) : 8;
        u.pm = fm + ((wgid % nig) % gsz); u.pn = (wgid % nig) / gsz; u.aux = 256;
        u.a = A + (size_t)u.pm * tA; u.b0 = B + (size_t)u.pn * tB; u.b1 = u.b0; return true;
    }
};
}
using pg8::Unit;

__device__ __forceinline__ float row_rstd(const float* ssp, int row) {
    const f32x4* p = (const f32x4*)(ssp + (size_t)row * 16);
    const f32x4 a = p[0], b = p[1], c = p[2], d = p[3];
    const float s = ((a.x + a.y) + (a.z + a.w)) + ((b.x + b.y) + (b.z + b.w)) + ((c.x + c.y) + (c.z + c.w)) + ((d.x + d.y) + (d.z + d.w));
    return 1.0f / sqrtf(s * (1.0f / 1024.0f) + 1e-6f);
}
__device__ __forceinline__ unsigned short f2h_bits(float f) { _Float16 h = (_Float16)f; return __builtin_bit_cast(unsigned short, h); }
__device__ __forceinline__ float h2f_bits(unsigned short b) { return (float)__builtin_bit_cast(_Float16, b); }

template <int MODE> struct EpiScale {
    bf16_t* O; int ldc; const float* ssp; float scale; const float* lb; bf16_t* halo;
    __device__ __forceinline__ void operator()(const f32x4 (&acc)[2][2][4][2], const Unit& u, int wr, int wc, int fr_in, int fq_in) const {
        int fr = fr_in, fq = fq_in; asm volatile("" : "+v"(fr), "+v"(fq));
#pragma unroll
        for (int ai = 0; ai < 2; ++ai)
#pragma unroll
            for (int m = 0; m < 4; ++m) {
                const int row = u.pm * 256 + ai * 128 + wr * 64 + m * 16 + fr;
                const float rs = (MODE == 2) ? scale : row_rstd(ssp, row) * scale;
#pragma unroll
                for (int bj = 0; bj < 2; ++bj)
#pragma unroll
                    for (int n = 0; n < 2; ++n) {
                        const int col = u.pn * 256 + bj * 128 + wc * 32 + n * 16 + fq * 4;
                        f32x4 v = acc[ai][bj][m][n] * rs;
                        u32x2 w;
                        if (MODE == 1) {
                            const int blk = col >> 10;
                            if (blk == 0) { v.x = siluf_(v.x); v.y = siluf_(v.y); v.z = siluf_(v.z); v.w = siluf_(v.w); }
                            if (blk == 1) {
                                const f32x4 l = *(const f32x4*)(lb + (col - 1024));
                                float o[4]; const float vv[4] = {v.x, v.y, v.z, v.w}; const float ll[4] = {l.x, l.y, l.z, l.w};
#pragma unroll
                                for (int j = 0; j < 4; ++j) o[j] = __logf(ll[j] + (1.f - ll[j]) * sigmoidf_(vv[j]));
                                w.x = (unsigned)f2h_bits(o[0]) | ((unsigned)f2h_bits(o[1]) << 16); w.y = (unsigned)f2h_bits(o[2]) | ((unsigned)f2h_bits(o[3]) << 16);
                            } else { w.x = pk2(v.x, v.y); w.y = pk2(v.z, v.w); }
                        } else { w.x = pk2(v.x, v.y); w.y = pk2(v.z, v.w); }
                        *(u32x2*)(O + (size_t)row * ldc + col) = w;
                        if (MODE == 0 && halo && col >= 2048 && (row & 63) == 63) *(u32x2*)(halo + (size_t)(row >> 6) * 1792 + (col - 2048)) = w;
                    }
            }
    }
};
struct EpiKV {
    bf16_t* Kb; bf16_t* VT;
    __device__ __forceinline__ void operator()(const f32x4 (&acc)[2][2][4][2], const Unit& u, int wr, int wc, int fr_in, int fq_in) const {
        int fr = fr_in, fq = fq_in; asm volatile("" : "+v"(fr), "+v"(fq));
#pragma unroll
        for (int ai = 0; ai < 2; ++ai)
#pragma unroll
            for (int m = 0; m < 4; ++m) {
                const int row = u.pm * 256 + ai * 128 + wr * 64 + m * 16 + fr;
#pragma unroll
                for (int bj = 0; bj < 2; ++bj)
#pragma unroll
                    for (int n = 0; n < 2; ++n) {
                        const int col = u.pn * 256 + bj * 128 + wc * 32 + n * 16 + fq * 4;
                        const f32x4 v = acc[ai][bj][m][n];
                        if (col < 1024) { u32x2 w; w.x = pk2(v.x, v.y); w.y = pk2(v.z, v.w); *(u32x2*)(Kb + (size_t)row * 1024 + col) = w; }
                        else {
                            const int c2 = col - 1024, h = c2 >> 8, d = c2 & 255, b = row >> 8, mm = row & 255;
                            bf16_t* p = VT + ((size_t)((b * 4 + h) * 256 + d)) * 256 + mm;
                            p[0] = (bf16_t)f2bf(v.x); p[256] = (bf16_t)f2bf(v.y); p[512] = (bf16_t)f2bf(v.z); p[768] = (bf16_t)f2bf(v.w);
                        }
                    }
            }
    }
};
template <bool SCATTER> struct EpiResid {
    const float* base; float* XF; bf16_t* XB; float* ssp; const f32x4* rowinfo;
    __device__ __forceinline__ void operator()(const f32x4 (&acc)[2][2][4][2], const Unit& u, int wr, int wc, int fr_in, int fq_in) const {
        int fr = fr_in, fq = fq_in; asm volatile("" : "+v"(fr), "+v"(fq));
#pragma unroll
        for (int ai = 0; ai < 2; ++ai)
#pragma unroll
            for (int m = 0; m < 4; ++m) {
                const int lrow = ai * 128 + wr * 64 + m * 16 + fr;
                const int row = u.pm * 256 + lrow;
                int tok = row; bool valid = true;
                if (SCATTER) { valid = lrow < u.aux; const f32x4 ri = rowinfo[row]; tok = valid ? __float_as_int(ri.w) : 0; }
                float ss = 0.f;
#pragma unroll
                for (int bj = 0; bj < 2; ++bj)
#pragma unroll
                    for (int n = 0; n < 2; ++n) {
                        const int col = u.pn * 256 + bj * 128 + wc * 32 + n * 16 + fq * 4;
                        const size_t off = (size_t)tok * 1024 + col;
                        const f32x4 b = *(const f32x4*)(base + off);
                        const f32x4 v = b + acc[ai][bj][m][n];
                        if (valid) { *(f32x4*)(XF + off) = v; u32x2 w; w.x = pk2(v.x, v.y); w.y = pk2(v.z, v.w); *(u32x2*)(XB + off) = w; }
                        ss += (v.x * v.x + v.y * v.y) + (v.z * v.z + v.w * v.w);
                    }
                ss += __shfl_xor(ss, 16); ss += __shfl_xor(ss, 32);
                if (valid && fq == 0) ssp[(size_t)tok * 16 + u.pn * 4 + wc] = ss;
            }
    }
};
struct EpiMoeUp {
    bf16_t* HID; const f32x4* rowinfo;
    __device__ __forceinline__ void operator()(const f32x4 (&acc)[2][2][4][2], const Unit& u, int wr, int wc, int fr_in, int fq_in) const {
        int fr = fr_in, fq = fq_in; asm volatile("" : "+v"(fr), "+v"(fq));
        const int slot = u.pn >> 1, jj = u.pn & 1;
#pragma unroll
        for (int ai = 0; ai < 2; ++ai)
#pragma unroll
            for (int m = 0; m < 4; ++m) {
                const int row = u.pm * 256 + ai * 128 + wr * 64 + m * 16 + fr;
                const f32x4 ri = rowinfo[row];
                const float rs = ri.x, gt = slot ? ri.z : ri.y;
#pragma unroll
                for (int n = 0; n < 2; ++n) {
                    const f32x4 h1 = acc[ai][0][m][n] * rs, h3 = acc[ai][1][m][n] * rs;
                    const int col = slot * 256 + jj * 128 + wc * 32 + n * 16 + fq * 4;
                    u32x2 w; w.x = pk2(siluf_(h1.x) * h3.x * gt, siluf_(h1.y) * h3.y * gt); w.y = pk2(siluf_(h1.z) * h3.z * gt, siluf_(h1.w) * h3.w * gt);
                    *(u32x2*)(HID + (size_t)row * 512 + col) = w;
                }
            }
    }
};
__device__ __forceinline__ void pair_experts(int bucket, int& ea, int& eb) {
    const int g = bucket / 6, p = bucket % 6;
    const int i = (p < 3) ? 0 : (p < 5 ? 1 : 2);
    const int j = (p < 3) ? p + 1 : (p < 5 ? p - 1 : 3);
    ea = g * 4 + i; eb = g * 4 + j;
}
template <bool DOWN> struct MoeSched {
    const LAS int* tbl; int ntiles, G, c; const char* A; const char* W;
    __device__ bool next(int i, Unit& u) const {
        const int L = i * G + c, mt = L >> 2, pn = L & 3;
        if (mt >= ntiles) return false;
        const int ent = __builtin_amdgcn_readfirstlane(tbl[mt]), bucket = ent & 255; u.aux = ent >> 8;
        int ea, eb; pair_experts(bucket, ea, eb);
        u.pm = mt; u.pn = pn;
        if (!DOWN) { u.a = A + (size_t)mt * 256 * 1024 * 2; const int e = (pn < 2) ? ea : eb; u.b0 = W + ((size_t)e * 512 + 256 * (pn & 1)) * 1024 * 2; u.b1 = u.b0; }
        else { u.a = A + (size_t)mt * 256 * 512 * 2; u.b0 = W + ((size_t)ea * 1024 + 256 * pn) * 256 * 2; u.b1 = W + ((size_t)eb * 1024 + 256 * pn) * 256 * 2; }
        return true;
    }
};
__device__ __forceinline__ void moe_build_table(LAS int* tbl, const unsigned* cnt, int tid) {
    if (tid == 0) { int mt = 0;
        for (int b = 0; b < 24; ++b) { const int nb = (int)cnt[b]; for (int r = 0; r < nb; r += 256) { const int v = (nb - r) < 256 ? (nb - r) : 256; if (mt < 95) tbl[mt] = b | (v << 8); ++mt; } }
        tbl[95] = mt < 95 ? mt : 95; }
    __syncthreads();
}

#define XB_TMO      128
#define XB_XCNT(j)  (256  + 64 * (j))
#define XB_XSUB(j)  (1280 + 64 * (j))
#define XB_XGEN(j)  (2304 + 64 * (j))
#define XB_TOP      3328
#define XB_TOPGEN   3392
#define XCD_BAR_WORDS 3456
#define XB_SPIN_CAP (1u << 22)
__device__ __forceinline__ unsigned xb_ld(unsigned* p)              { return __hip_atomic_load(p, __ATOMIC_RELAXED, __HIP_MEMORY_SCOPE_AGENT); }
__device__ __forceinline__ unsigned xb_add(unsigned* p, unsigned v) { return __hip_atomic_fetch_add(p, v, __ATOMIC_RELAXED, __HIP_MEMORY_SCOPE_AGENT); }
__device__ __forceinline__ unsigned xb_xcc_id() { return (unsigned)__builtin_amdgcn_s_getreg((3 << 11) | 20) & 0xFu; }
#define XB_SPIN(cond, bar) do { unsigned _sp = 0; while (cond) { __builtin_amdgcn_s_sleep(1); \
    if ((++_sp & 255u) == 0u) { if (xb_ld(&(bar)[XB_TMO])) break; if (_sp > XB_SPIN_CAP) { atomicAdd(&(bar)[XB_TMO], 1u); break; } } } } while (0)
struct XcdBarrier { unsigned* bar; unsigned x; volatile LAS unsigned* st; int wave; };
__device__ __forceinline__ XcdBarrier xcd_barrier_post(unsigned* bar, volatile LAS unsigned* st, int wave) {
    XcdBarrier b; b.bar = bar; b.x = xb_xcc_id(); b.st = st; b.wave = wave;
    if (wave == 0 && lane_id_v() == 0) (void)xb_add(&bar[XB_XCNT(b.x)], 1u);
    return b;
}
__device__ __forceinline__ void xcd_barrier_complete(unsigned* bar, unsigned x, unsigned& nloc, unsigned& nx) {
    const unsigned G = gridDim.x * gridDim.y * gridDim.z;
    unsigned sum, cnt, mine, sp = 0u;
    for (;;) {
        sum = 0u; cnt = 0u; mine = 0u;
#pragma unroll
        for (unsigned j = 0; j < 16; ++j) { const unsigned c = xb_ld(&bar[XB_XCNT(j)]); sum += c; cnt += (c > 0u) ? 1u : 0u; mine = (j == x) ? c : mine; }
        if (sum == G) break;
        __builtin_amdgcn_s_sleep(1);
        if ((++sp & 255u) == 0u) { if (xb_ld(&bar[XB_TMO])) break; if (sp > XB_SPIN_CAP) { atomicAdd(&bar[XB_TMO], 1u); break; } }
    }
    nloc = mine > 0u ? mine : 1u; nx = cnt > 0u ? cnt : 1u;
}
__device__ __forceinline__ void xcd_barrier(const XcdBarrier& b) {
    asm volatile("s_waitcnt vmcnt(0)" ::: "memory");
    __syncthreads();
    if (b.wave == 0 && lane_id_v() == 0) {
        unsigned* bar = b.bar;
        __builtin_amdgcn_s_waitcnt(0);
        unsigned nloc = b.st[0], nx = b.st[1];
        if (nloc == 0u) { xcd_barrier_complete(bar, b.x, nloc, nx); b.st[0] = nloc; b.st[1] = nx; }
        const unsigned old = xb_add(&bar[XB_XSUB(b.x)], 1u);
        const unsigned gen = old / nloc;
        if (old + 1u == (gen + 1u) * nloc) {
            __builtin_amdgcn_fence(__ATOMIC_RELEASE, "agent");
            asm volatile("s_waitcnt vmcnt(0)" ::: "memory");
            const unsigned og = xb_add(&bar[XB_TOP], 1u);
            const unsigned tg = og / nx;
            if (og + 1u == (tg + 1u) * nx) xb_add(&bar[XB_TOPGEN], 1u);
            else XB_SPIN(xb_ld(&bar[XB_TOPGEN]) == tg, bar);
            __builtin_amdgcn_fence(__ATOMIC_ACQUIRE, "agent");
            xb_add(&bar[XB_XGEN(b.x)], 1u);
            asm volatile("s_waitcnt vmcnt(0)" ::: "memory");
        } else {
            XB_SPIN(xb_ld(&bar[XB_XGEN(b.x)]) == gen, bar);
            __builtin_amdgcn_fence(__ATOMIC_ACQUIRE, "agent");
            asm volatile("s_waitcnt vmcnt(0)" ::: "memory");
        }
    }
    __syncthreads();
}

struct Args { const float* in[38]; float* out; unsigned char* ws; int ph_lo, ph_hi; };
constexpr int LDS_BYTES = 161792;
constexpr int LDS_MISC = 156 * 1024;
struct InTab {
    const LAS unsigned long long* t;
    __device__ __forceinline__ const float* operator[](int i) const {
        const unsigned long long v = t[i];
        const unsigned lo = __builtin_amdgcn_readfirstlane((unsigned)v), hi = __builtin_amdgcn_readfirstlane((unsigned)(v >> 32));
        return (const float*)(((unsigned long long)hi << 32) | lo); }
};
struct Frame {
    LAS unsigned char* lds; int wave, G, wg;
    InTab in; float* out; unsigned char* ws;
};
#define IN_X 0
#define IN_MEM 1
#define IN_NORM_MIX 2
#define IN_NORM_XA 3
#define IN_NORM_MEM 4
#define IN_NORM_FFN 5
#define IN_NORM_FINAL 6
#define IN_AB_WIN 7
#define IN_AB_CONV 8
#define IN_AB_ALOG 9
#define IN_AB_DTB 10
#define IN_AB_ONORM 11
#define IN_AB_MU 12
#define IN_AB_W0 13
#define IN_AB_W2 14
#define IN_AB_A0 15
#define IN_AB_A2 16
#define IN_AB_G2 17
#define IN_AB_KK 18
#define IN_AB_KA 19
#define IN_AB_RK 20
#define IN_AB_LNW 21
#define IN_AB_LNB 22
#define IN_AB_WOUT 23
#define IN_C_WIN 24
#define IN_C_LB 25
#define IN_C_ONORM 26
#define IN_C_WOUT 27
#define IN_XA_WQ 28
#define IN_XA_WKV 29
#define IN_XA_WO 30
#define IN_MOE_WG 31
#define IN_MOE_BG 32
#define IN_MOE_WE 33
#define IN_MOE_BE 34
#define IN_MOE_W1 35
#define IN_MOE_W3 36
#define IN_MOE_W2 37

__device__ __forceinline__ void p0_transpose_item(const float* W, int ld, int col0, int ncols, int K, const float* gain, bf16_t* WT, int drow0, LAS float* scr, int item, int lane) {
    const int nblk = ncols / 32, kb = item / nblk, nb = item % nblk, k0 = 64 * kb, n0 = 32 * nb;
    float vv[32];
#pragma unroll
    for (int i = 0; i < 32; ++i) vv[i] = W[(size_t)(k0 + 2 * i + (lane >> 5)) * ld + col0 + n0 + (lane & 31)];
#pragma unroll
    for (int i = 0; i < 32; ++i) { const int kk = 2 * i + (lane >> 5); float v = vv[i]; if (gain) v *= gain[k0 + kk]; scr[kk * 33 + (lane & 31)] = v; }
    LDS_WAIT(); asm volatile("" ::: "memory");
    const int c = lane & 7;
#pragma unroll
    for (int j = 0; j < 4; ++j) { const int n = (lane >> 3) + 8 * j; const LAS float* s = scr + (8 * c) * 33 + n;
        u32x4 o; o.x = pk2(s[0 * 33], s[1 * 33]); o.y = pk2(s[2 * 33], s[3 * 33]); o.z = pk2(s[4 * 33], s[5 * 33]); o.w = pk2(s[6 * 33], s[7 * 33]);
        *(u32x4*)(WT + (size_t)(drow0 + n0 + n) * K + k0 + 8 * c) = o; }
    LDS_WAIT(); asm volatile("" ::: "memory");
}
__device__ __forceinline__ void p0_weight_item(const Frame& F, int it, LAS float* scr, int lane) {
    const InTab in = F.in;
    bf16_t* W0 = (bf16_t*)(F.ws + WS_W0); bf16_t* W1 = (bf16_t*)(F.ws + WS_W1);
    if (it < 16384) {
        const int l = it >> 13; int r = it & 8191; bf16_t* W = l ? W1 : W0;
        if (r < 512) { p0_transpose_item(in[IN_XA_WQ] + (size_t)l * 1024 * 1024, 1024, 0, 1024, 1024, in[IN_NORM_XA] + l * 1024, W + WO_WQ, 0, scr, r, lane); return; }
        r -= 512;
        if (r < 1024) { p0_transpose_item(in[IN_XA_WKV] + (size_t)l * 1024 * 2048, 2048, 0, 2048, 1024, in[IN_NORM_MEM] + l * 1024, W + WO_WKV, 0, scr, r, lane); return; }
        r -= 1024;
        if (r < 512) { p0_transpose_item(in[IN_XA_WO] + (size_t)l * 1024 * 1024, 1024, 0, 1024, 1024, nullptr, W + WO_WO, 0, scr, r, lane); return; }
        r -= 512;
        if (r < 4096) { const int sub = r >> 6, item = r & 63, e = sub >> 2, j = (sub >> 1) & 1, which = sub & 1;
            const float* src = (which ? in[IN_MOE_W3] : in[IN_MOE_W1]) + (size_t)(l * 16 + e) * 1024 * 256;
            p0_transpose_item(src, 256, 128 * j, 128, 1024, in[IN_NORM_FFN] + l * 1024, W + WO_W13, e * 512 + 256 * j + 128 * which, scr, item, lane); return; }
        r -= 4096;
        { const int e = r >> 7, item = r & 127;
            p0_transpose_item(in[IN_MOE_W2] + (size_t)(l * 16 + e) * 256 * 1024, 1024, 0, 1024, 256, nullptr, W + WO_W2T + (size_t)e * 1024 * 256, 0, scr, item, lane); return; }
    }
    int r = it - 16384;
    if (r < 1024) { p0_transpose_item(in[IN_AB_WIN], 3848, 0, 2048, 1024, in[IN_NORM_MIX], W0 + WO_WIN, 0, scr, r, lane); return; }
    r -= 1024;
    if (r < 896) { p0_transpose_item(in[IN_AB_WIN], 3848, 2056, 1792, 1024, in[IN_NORM_MIX], W0 + WO_WIN, 2048, scr, r, lane); return; }
    r -= 896;
    if (r < 512) { p0_transpose_item(in[IN_AB_WOUT], 1024, 0, 1024, 1024, nullptr, W0 + WO_WOUT, 0, scr, r, lane); return; }
    r -= 512;
    if (r < 2048) { p0_transpose_item(in[IN_C_WIN], 4096, 0, 4096, 1024, in[IN_NORM_MIX] + 1024, W1 + WO_WIN, 0, scr, r, lane); return; }
    r -= 2048;
    if (r < 512) { p0_transpose_item(in[IN_C_WOUT], 1024, 0, 1024, 1024, nullptr, W1 + WO_WOUT, 0, scr, r, lane); return; }
    r -= 512;
    bf16_t* LW = (bf16_t*)(F.ws + WS_LORA);
    if (r < 16) { p0_transpose_item(in[IN_AB_W2], 512, 0, 512, 64, nullptr, LW, 0, scr, r, lane); return; }
    r -= 16;
    if (r < 16) { p0_transpose_item(in[IN_AB_A2], 512, 0, 512, 64, nullptr, LW + 512 * 64, 0, scr, r, lane); return; }
    r -= 16;
    p0_transpose_item(in[IN_AB_G2], 512, 0, 512, 128, nullptr, LW + 2 * 512 * 64, 0, scr, r, lane);
}
constexpr int P0_NITEMS = 16384 + 1024 + 896 + 512 + 2048 + 512 + 64;

template <int SEL> __device__ __forceinline__ void p0_late_weights(const Frame& F, int worker, int nworkers) {
    const int lane = lane_id_v();
    LAS float* scr = (LAS float*)(F.lds + F.wave * 16384);
    const int gw = worker * NWAVES + F.wave, NGW = nworkers * NWAVES;
    if (SEL == 0) {
        for (int it = gw; it < 8192 + 512 + 2048 + 1024; it += NGW) {
            int item;
            if (it < 8192) item = it;
            else if (it < 8192 + 512) item = 16384 + 1920 + (it - 8192);
            else if (it < 8192 + 512 + 2048) item = 16384 + 1920 + 512 + (it - 8192 - 512);
            else item = 8192 + 512 + (it - 8192 - 512 - 2048);
            p0_weight_item(F, item, scr, lane);
        }
    } else {
        for (int it = gw; it < 512 + 6656 + 512; it += NGW) {
            int item;
            if (it < 512) item = 8192 + it;
            else if (it < 512 + 6656) item = 8192 + 1536 + (it - 512);
            else item = 16384 + 1920 + 512 + 2048 + (it - 512 - 6656);
            p0_weight_item(F, item, scr, lane);
        }
    }
}
__device__ __forceinline__ void p0_prologue(const Frame& F) {
    const int lane = lane_id_v(); const int tid = F.wave * 64 + lane; (void)tid;
    LAS float* scr = (LAS float*)(F.lds + F.wave * 16384);
    const int gw = F.wg * NWAVES + F.wave, NGW = F.G * NWAVES;
    for (int it = gw; it < 1920 + 64; it += NGW) p0_weight_item(F, it < 1920 ? 16384 + it : P0_NITEMS - 64 + (it - 1920), scr, lane);
    const float* x = F.in[IN_X]; const float* gain = F.in[IN_NORM_MIX]; const float* win = F.in[IN_AB_WIN];
    bf16_t* XB = (bf16_t*)(F.ws + WS_XB); float* ssp = (float*)(F.ws + WS_SSP); float* db = (float*)(F.ws + WS_DB);
    for (int row = gw; row < NT; row += NGW) {
        const f32x4* xr = (const f32x4*)(x + (size_t)row * 1024) + lane;
        f32x4 v[4]; float s = 0.f; float d[8];
#pragma unroll
        for (int c = 0; c < 8; ++c) d[c] = 0.f;
#pragma unroll
        for (int j = 0; j < 4; ++j) {
            v[j] = xr[64 * j]; s += (v[j].x * v[j].x + v[j].y * v[j].y) + (v[j].z * v[j].z + v[j].w * v[j].w);
            const int k0 = 4 * lane + 256 * j;
            const f32x4 g = *(const f32x4*)(gain + k0);
            const float xv[4] = {v[j].x * g.x, v[j].y * g.y, v[j].z * g.z, v[j].w * g.w};
#pragma unroll
            for (int q = 0; q < 4; ++q) {
                const f32x4 w0 = *(const f32x4*)(win + (size_t)(k0 + q) * 3848 + 2048), w1 = *(const f32x4*)(win + (size_t)(k0 + q) * 3848 + 2052);
                d[0] += xv[q] * w0.x; d[1] += xv[q] * w0.y; d[2] += xv[q] * w0.z; d[3] += xv[q] * w0.w;
                d[4] += xv[q] * w1.x; d[5] += xv[q] * w1.y; d[6] += xv[q] * w1.z; d[7] += xv[q] * w1.w;
            }
        }
        s = wave_sum(s);
        const float rstd = 1.0f / sqrtf(s * (1.0f / 1024.0f) + 1e-6f);
#pragma unroll
        for (int c = 0; c < 8; ++c) d[c] = wave_sum(d[c]) * rstd;
        unsigned long long* o8 = (unsigned long long*)(XB + (size_t)row * 1024) + lane;
#pragma unroll
        for (int j = 0; j < 4; ++j) o8[64 * j] = (unsigned long long)pk2(v[j].x, v[j].y) | ((unsigned long long)pk2(v[j].z, v[j].w) << 32);
        if (lane < 16) ssp[(size_t)row * 16 + lane] = (lane == 0) ? s : 0.f;
        if (lane < 8) { float dv = d[0];
#pragma unroll
            for (int c = 1; c < 8; ++c) dv = (lane == c) ? d[c] : dv;
            db[(size_t)row * 8 + lane] = dv; }
    }
    const float* mem = F.in[IN_MEM]; bf16_t* MH = (bf16_t*)(F.ws + WS_MEMH);
    for (int row = gw; row < NB * NMEM; row += NGW) {
        const f32x4* xr = (const f32x4*)(mem + (size_t)row * 1024) + lane;
        f32x4 v[4]; float s = 0.f;
#pragma unroll
        for (int j = 0; j < 4; ++j) { v[j] = xr[64 * j]; s += (v[j].x * v[j].x + v[j].y * v[j].y) + (v[j].z * v[j].z + v[j].w * v[j].w); }
        s = wave_sum(s);
        const float rstd = 1.0f / sqrtf(s * (1.0f / 1024.0f) + 1e-6f);
        unsigned long long* o8 = (unsigned long long*)(MH + (size_t)row * 1024) + lane;
#pragma unroll
        for (int j = 0; j < 4; ++j) o8[64 * j] = (unsigned long long)pk2(v[j].x * rstd, v[j].y * rstd) | ((unsigned long long)pk2(v[j].z * rstd, v[j].w * rstd) << 32);
    }
    {
        float* rw = (float*)(F.ws + WS_RW);
        for (int idx = F.wg * NTHREADS + tid; idx < 2 * 1024 * 32; idx += F.G * NTHREADS) {
            const int l = idx >> 15, k = (idx >> 5) & 1023, cc = idx & 31;
            const float g = F.in[IN_NORM_FFN][l * 1024 + k];
            float v = 0.f;
            if (cc < 4) v = F.in[IN_MOE_WG][(size_t)l * 4096 + k * 4 + cc] * g; else if (cc < 20) v = F.in[IN_MOE_WE][(size_t)l * 16384 + k * 16 + (cc - 4)] * g;
            rw[idx] = v;
        }
    }
    if (F.wg == 0) { const float* lbp = F.in[IN_C_LB]; float* lb = (float*)(F.ws + WS_LB);
        for (int c = tid; c < 1024; c += NTHREADS) { const float a = lbp[c], b = lbp[1024 + c]; const float mx = fmaxf(a, b), ea = __expf(a - mx), eb = __expf(b - mx); lb[c] = (ea + eb) / (ea + eb) - ea / (ea + eb); } }
}

__device__ __forceinline__ void scan_delta(const Frame& F, int b, int h) {
    const int lane = lane_id_v(); const int tid = F.wave * 64 + lane; (void)tid;
    LAS float* qs = (LAS float*)F.lds;
    LAS float* ks = qs + 64 * 128;
    LAS float* vs = ks + 64 * 128;
    LAS float* os = vs + 64 * 128;
    LAS float* al = os + 64 * 128;
    LAS float* be = al + 64;
    bf16_t* P = (bf16_t*)(F.ws + WS_BIG + BIG_PROJ);
    const float* convw = F.in[IN_AB_CONV];
    const float* db = (const float*)(F.ws + WS_DB);
    const float a_neg = -__expf(F.in[IN_AB_ALOG][h]), dtb = F.in[IN_AB_DTB][h];
    const float* onorm = F.in[IN_AB_ONORM];
    const int i_dv = tid >> 2, part = tid & 3;
    float s[32];
#pragma unroll
    for (int j = 0; j < 32; ++j) s[j] = 0.f;
    for (int c = 0; c < 32; ++c) {
        const int t0 = b * TS + c * 64;
        for (int idx = tid; idx < 64 * 384; idx += NTHREADS) {
            const int t = idx / 384, cc = idx % 384, sct = cc >> 7, col = cc & 127;
            const int gcol = sct * 512 + h * 128 + col;
            float a = 0.f;
#pragma unroll
            for (int j = 0; j < 4; ++j) { const int tl = c * 64 + t - 3 + j; if (tl >= 0) a += convw[j * 1536 + gcol] * bf2f(P[(size_t)(b * TS + tl) * P0LD + gcol]); }
            a = siluf_(a);
            (sct == 0 ? qs : (sct == 1 ? ks : vs))[t * 128 + col] = a;
        }
        if (tid < 64) { const int t = tid; const float la = a_neg * softplusf_(db[(size_t)(t0 + t) * 8 + h] + dtb); al[t] = __expf(la); be[t] = sigmoidf_(db[(size_t)(t0 + t) * 8 + 4 + h]); }
        __syncthreads();
        for (int r = F.wave; r < 128; r += NWAVES) { LAS float* p = (r < 64 ? qs + r * 128 : ks + (r - 64) * 128);
            const float v0 = p[lane], v1 = p[lane + 64]; const float ss = wave_sum(v0 * v0 + v1 * v1);
            const float sc = (1.0f / sqrtf(ss + 1e-6f)) * (r < 64 ? 0.08838834764831845f : 1.0f); p[lane] = v0 * sc; p[lane + 64] = v1 * sc; }
        __syncthreads();
        for (int t = 0; t < 64; ++t) {
            const LAS f32x4* kp = (const LAS f32x4*)(ks + t * 128 + part * 32); const LAS f32x4* qp = (const LAS f32x4*)(qs + t * 128 + part * 32);
            float kt[32], qt[32];
#pragma unroll
            for (int j = 0; j < 8; ++j) { const f32x4 a = kp[j], q = qp[j]; kt[4 * j] = a.x; kt[4 * j + 1] = a.y; kt[4 * j + 2] = a.z; kt[4 * j + 3] = a.w; qt[4 * j] = q.x; qt[4 * j + 1] = q.y; qt[4 * j + 2] = q.z; qt[4 * j + 3] = q.w; }
            float p = 0.f;
#pragma unroll
            for (int j = 0; j < 32; ++j) p += s[j] * kt[j];
            p += __shfl_xor(p, 1); p += __shfl_xor(p, 2);
            const float alpha = al[t], coef = be[t] * (vs[t * 128 + i_dv] - alpha * p);
            float o = 0.f;
#pragma unroll
            for (int j = 0; j < 32; ++j) { s[j] = alpha * s[j] + coef * kt[j]; o += s[j] * qt[j]; }
            o += __shfl_xor(o, 1); o += __shfl_xor(o, 2);
            if (part == 0) os[t * 128 + i_dv] = o;
        }
        __syncthreads();
        for (int t = F.wave; t < 64; t += NWAVES) {
            const float o0 = os[t * 128 + lane], o1 = os[t * 128 + lane + 64];
            const float ss = wave_sum(o0 * o0 + o1 * o1), rs = 1.0f / sqrtf(ss * (1.0f / 128.0f) + 1e-6f);
            bf16_t* gp = P + (size_t)(t0 + t) * P0LD + 1536 + h * 128;
            const float g0 = bf2f(gp[lane]), g1 = bf2f(gp[lane + 64]);
            gp[lane] = (bf16_t)f2bf(o0 * rs * onorm[lane] * siluf_(g0)); gp[lane + 64] = (bf16_t)f2bf(o1 * rs * onorm[lane + 64] * siluf_(g1));
        }
        __syncthreads();
    }
}
__device__ __forceinline__ void scan_rwkv(const Frame& F, int b, int h) {
    const int lane = lane_id_v(); const int tid = F.wave * 64 + lane; (void)tid;
    LAS float* bufA = (LAS float*)F.lds;
    LAS float* bufB = bufA + 4096;
    LAS float* bufC = bufB + 4096;
    LAS float* R = bufC + 8192;
    LAS float* Kb = R + 4096;
    LAS float* V = Kb + 4096;
    LAS float* KK = V + 4096;
    LAS float* halo = KK + 4096;
    LAS float* bonus = halo + 896;
    bf16_t* P = (bf16_t*)(F.ws + WS_BIG + BIG_PROJ);
    const float* mu = F.in[IN_AB_MU];
    const float* w0 = F.in[IN_AB_W0] + h * 64; const float* w2 = F.in[IN_AB_W2] + h * 64;
    const float* a0 = F.in[IN_AB_A0] + h * 64; const float* a2 = F.in[IN_AB_A2] + h * 64;
    const float* g2 = F.in[IN_AB_G2] + h * 64;
    const float* k_k = F.in[IN_AB_KK] + h * 64; const float* k_a = F.in[IN_AB_KA] + h * 64; const float* r_k = F.in[IN_AB_RK] + h * 64;
    const float* ln_w = F.in[IN_AB_LNW] + h * 64; const float* ln_b = F.in[IN_AB_LNB] + h * 64;
    const int vi = tid >> 3, part = tid & 7;
    float s[8];
#pragma unroll
    for (int j = 0; j < 8; ++j) s[j] = 0.f;
    for (int i = tid; i < 896; i += NTHREADS) halo[i] = 0.f;
    __syncthreads();
    for (int c = 0; c < 32; ++c) {
        const int t0 = b * TS + c * 64;
        const LAS float* hcur = halo + (c & 1) * 448; LAS float* hnext = halo + ((c + 1) & 1) * 448;
        for (int idx = tid; idx < 64 * 448; idx += NTHREADS) {
            const int t = idx / 448, col = idx % 448;
            int gc;
            if (col < 64) gc = 2048 + h * 64 + col; else if (col < 128) gc = 2560 + h * 64 + (col - 64); else if (col < 192) gc = 3072 + h * 64 + (col - 128); else gc = 3584 + (col - 192);
            const float cur = bf2f(P[(size_t)(t0 + t) * P0LD + gc]);
            const float prev = (t > 0) ? bf2f(P[(size_t)(t0 + t - 1) * P0LD + gc]) : hcur[col];
            const float sh = cur + mu[gc - 2048] * (prev - cur);
            if (t == 63) hnext[col] = cur;
            if (col < 64) R[t * 64 + col] = sh; else if (col < 128) Kb[t * 64 + col - 64] = sh; else if (col < 192) V[t * 64 + col - 128] = sh;
            else if (col < 256) bufA[t * 64 + col - 192] = tanhf(sh); else if (col < 320) bufB[t * 64 + col - 256] = sh; else bufC[t * 128 + col - 320] = sigmoidf_(sh);
        }
        __syncthreads();
        float wv[8], av[8], gv[8];
        {
            const int j = lane, tb = F.wave * 8;
#pragma unroll
            for (int q = 0; q < 8; ++q) { wv[q] = 0.f; av[q] = 0.f; gv[q] = 0.f; }
            for (int m = 0; m < 64; ++m) { const float x2 = w2[(size_t)m * 512 + j], y2 = a2[(size_t)m * 512 + j];
#pragma unroll
                for (int q = 0; q < 8; ++q) { wv[q] += bufA[(tb + q) * 64 + m] * x2; av[q] += bufB[(tb + q) * 64 + m] * y2; } }
            for (int m = 0; m < 128; ++m) { const float z2 = g2[(size_t)m * 512 + j];
#pragma unroll
                for (int q = 0; q < 8; ++q) gv[q] += bufC[(tb + q) * 128 + m] * z2; }
#pragma unroll
            for (int q = 0; q < 8; ++q) { wv[q] = __expf(-0.6065306597126334f * sigmoidf_(w0[j] + wv[q])); av[q] = sigmoidf_(a0[j] + av[q]); }
        }
        __syncthreads();
        {
            const int j = lane, tb = F.wave * 8;
#pragma unroll
            for (int q = 0; q < 8; ++q) { bufA[(tb + q) * 64 + j] = wv[q]; bufB[(tb + q) * 64 + j] = av[q]; bufC[(tb + q) * 64 + j] = gv[q]; }
#pragma unroll
            for (int q = 0; q < 8; ++q) { const int t = tb + q; const float kv = Kb[t * 64 + j]; const float kx = kv * k_k[j]; const float ss = wave_sum(kx * kx);
                KK[t * 64 + j] = kx * (1.0f / sqrtf(ss + 1e-6f)); const float km = kv * (1.f + (av[q] - 1.f) * k_a[j]); Kb[t * 64 + j] = km;
                const float bs = wave_sum(R[t * 64 + j] * km * r_k[j]); if (j == 0) bonus[t] = bs; }
        }
        __syncthreads();
        LAS float* O = bufC + 4096;
        for (int t = 0; t < 64; ++t) {
            const LAS f32x4* p4;
            float kk[8], ww[8], aa[8], km[8], rr[8];
            p4 = (const LAS f32x4*)(KK + t * 64 + part * 8);   { const f32x4 a = p4[0], c2 = p4[1]; kk[0] = a.x; kk[1] = a.y; kk[2] = a.z; kk[3] = a.w; kk[4] = c2.x; kk[5] = c2.y; kk[6] = c2.z; kk[7] = c2.w; }
            p4 = (const LAS f32x4*)(bufA + t * 64 + part * 8); { const f32x4 a = p4[0], c2 = p4[1]; ww[0] = a.x; ww[1] = a.y; ww[2] = a.z; ww[3] = a.w; ww[4] = c2.x; ww[5] = c2.y; ww[6] = c2.z; ww[7] = c2.w; }
            p4 = (const LAS f32x4*)(bufB + t * 64 + part * 8); { const f32x4 a = p4[0], c2 = p4[1]; aa[0] = a.x; aa[1] = a.y; aa[2] = a.z; aa[3] = a.w; aa[4] = c2.x; aa[5] = c2.y; aa[6] = c2.z; aa[7] = c2.w; }
            p4 = (const LAS f32x4*)(Kb + t * 64 + part * 8);   { const f32x4 a = p4[0], c2 = p4[1]; km[0] = a.x; km[1] = a.y; km[2] = a.z; km[3] = a.w; km[4] = c2.x; km[5] = c2.y; km[6] = c2.z; km[7] = c2.w; }
            p4 = (const LAS f32x4*)(R + t * 64 + part * 8);    { const f32x4 a = p4[0], c2 = p4[1]; rr[0] = a.x; rr[1] = a.y; rr[2] = a.z; rr[3] = a.w; rr[4] = c2.x; rr[5] = c2.y; rr[6] = c2.z; rr[7] = c2.w; }
            const float vv = V[t * 64 + vi];
            float sa = 0.f;
#pragma unroll
            for (int j = 0; j < 8; ++j) sa -= s[j] * kk[j];
            sa += __shfl_xor(sa, 1); sa += __shfl_xor(sa, 2); sa += __shfl_xor(sa, 4);
            float o = 0.f;
#pragma unroll
            for (int j = 0; j < 8; ++j) { s[j] = s[j] * ww[j] + sa * (kk[j] * aa[j]) + vv * km[j]; o += s[j] * rr[j]; }
            o += __shfl_xor(o, 1); o += __shfl_xor(o, 2); o += __shfl_xor(o, 4);
            if (part == 0) O[t * 64 + vi] = o;
        }
        __syncthreads();
        for (int t = F.wave; t < 64; t += NWAVES) {
            const float o = O[t * 64 + lane];
            const float mean = wave_sum(o) * (1.0f / 64.0f); const float dlt = o - mean; const float var = wave_sum(dlt * dlt) * (1.0f / 64.0f);
            float y = dlt * (1.0f / sqrtf(var + 64e-5f)) * ln_w[lane] + ln_b[lane];
            y += bonus[t] * V[t * 64 + lane];
            y *= bufC[t * 64 + lane];
            P[(size_t)(t0 + t) * P0LD + 2048 + h * 64 + lane] = (bf16_t)f2bf(y);
        }
        __syncthreads();
    }
}
__device__ __forceinline__ void scan_hgrn(const Frame& F, int b, int h) {
    const int lane = lane_id_v(); const int tid = F.wave * 64 + lane; (void)tid;
    LAS float* qs = (LAS float*)F.lds;
    LAS float* fs = qs + 64 * 128;
    LAS float* kf = fs + 64 * 128;
    LAS float* is = kf + 64 * 128;
    bf16_t* P = (bf16_t*)(F.ws + WS_BIG + BIG_PROJ);
    const float* onorm = F.in[IN_C_ONORM];
    const int e = tid >> 2, part = tid & 3;
    float s[32];
#pragma unroll
    for (int j = 0; j < 32; ++j) s[j] = 0.f;
    for (int c = 0; c < 32; ++c) {
        const int t0 = b * TS + c * 64;
        for (int idx = tid; idx < 64 * 128; idx += NTHREADS) {
            const int t = idx >> 7, col = idx & 127; const bf16_t* pr = P + (size_t)(t0 + t) * P1LD + h * 128 + col;
            qs[idx] = bf2f(pr[0]); const float lf = h2f_bits(pr[1024]); fs[idx] = __expf(lf); kf[idx] = -expm1f(lf); is[idx] = bf2f(pr[2048]);
        }
        __syncthreads();
        for (int t = 0; t < 64; ++t) {
            const LAS f32x4* fp = (const LAS f32x4*)(fs + t * 128 + part * 32); const LAS f32x4* kp = (const LAS f32x4*)(kf + t * 128 + part * 32); const LAS f32x4* qp = (const LAS f32x4*)(qs + t * 128 + part * 32);
            const float iv = is[t * 128 + e];
            float o = 0.f;
#pragma unroll
            for (int j = 0; j < 8; ++j) { const f32x4 f = fp[j], k = kp[j], q = qp[j];
                s[4 * j] = f.x * s[4 * j] + k.x * iv; o += s[4 * j] * q.x;
                s[4 * j + 1] = f.y * s[4 * j + 1] + k.y * iv; o += s[4 * j + 1] * q.y;
                s[4 * j + 2] = f.z * s[4 * j + 2] + k.z * iv; o += s[4 * j + 2] * q.z;
                s[4 * j + 3] = f.w * s[4 * j + 3] + k.w * iv; o += s[4 * j + 3] * q.w; }
            o += __shfl_xor(o, 1); o += __shfl_xor(o, 2);
            if (part == 0) is[t * 128 + e] = o;
        }
        __syncthreads();
        for (int t = F.wave; t < 64; t += NWAVES) {
            const float o0 = is[t * 128 + lane], o1 = is[t * 128 + lane + 64];
            const float ss = wave_sum(o0 * o0 + o1 * o1), rs = 1.0f / sqrtf(ss * (1.0f / 128.0f) + 1e-6f);
            bf16_t* gp = P + (size_t)(t0 + t) * P1LD + 3072 + h * 128;
            const float g0 = bf2f(gp[lane]), g1 = bf2f(gp[lane + 64]);
            gp[lane] = (bf16_t)f2bf(o0 * rs * onorm[lane] * siluf_(g0)); gp[lane + 64] = (bf16_t)f2bf(o1 * rs * onorm[lane + 64] * siluf_(g1));
        }
        __syncthreads();
    }
}

template <int CTRL> __device__ __forceinline__ float dppf(float v) { return __int_as_float(__builtin_amdgcn_update_dpp(0, __float_as_int(v), CTRL, 0xF, 0xF, true)); }
__device__ __forceinline__ float red8(float v) { v += dppf<0xB1>(v); v += dppf<0x4E>(v); v += dppf<0x141>(v); return v; }
__device__ __forceinline__ float red16(float v) { v = red8(v); v += dppf<0x140>(v); return v; }

__device__ __forceinline__ void scan_delta2(const Frame& F, int b, int h, int qd) {
    const int lane = lane_id_v(); const int tid = F.wave * 64 + lane;
    LAS float* Kc = (LAS float*)F.lds;
    LAS float* Qc = Kc + 64 * 128;
    LAS float* Vc = Qc + 64 * 128;
    LAS float* Oc = Vc + 64 * 32;
    LAS float* al = Oc + 64 * 32;
    LAS float* be = al + 64;
    LAS float* vh = be + 64;
    bf16_t* P = (bf16_t*)(F.ws + WS_BIG + BIG_PROJ);
    const float* convw = F.in[IN_AB_CONV];
    const float* db = (const float*)(F.ws + WS_DB);
    const float a_neg = -__expf(F.in[IN_AB_ALOG][h]), dtb = F.in[IN_AB_DTB][h];
    const int w = F.wave;
    const int vcol = 1024 + h * 128 + qd * 32 + (lane & 31);
    float cwq[4][2], cwk[4][2], cwv[4];
#pragma unroll
    for (int j = 0; j < 4; ++j) { cwq[j][0] = convw[j * 1536 + h * 128 + lane]; cwq[j][1] = convw[j * 1536 + h * 128 + lane + 64];
        cwk[j][0] = convw[j * 1536 + 512 + h * 128 + lane]; cwk[j][1] = convw[j * 1536 + 512 + h * 128 + lane + 64]; cwv[j] = convw[j * 1536 + vcol]; }
    const int r = tid >> 4, part = tid & 15;
    float s[8];
#pragma unroll
    for (int j = 0; j < 8; ++j) s[j] = 0.f;
    if (tid < 192) vh[tid] = 0.f;
    __syncthreads();
    for (int c = 0; c < 32; ++c) {
        const int t0 = b * TS + c * 64;
        const LAS float* vhc = vh + (c & 1) * 96; LAS float* vhn = vh + ((c + 1) & 1) * 96;
        {
            float rq[11][2], rk[11][2], rv[11];
#pragma unroll
            for (int rr = 0; rr < 11; ++rr) {
                const int tl = c * 64 + 8 * w - 3 + rr;
                const bool ok = tl >= 0;
                const bf16_t* row = P + (size_t)(b * TS + (ok ? tl : 0)) * P0LD;
                rq[rr][0] = ok ? bf2f(row[h * 128 + lane]) : 0.f; rq[rr][1] = ok ? bf2f(row[h * 128 + lane + 64]) : 0.f;
                rk[rr][0] = ok ? bf2f(row[512 + h * 128 + lane]) : 0.f; rk[rr][1] = ok ? bf2f(row[512 + h * 128 + lane + 64]) : 0.f;
                const bool prevchunk = (8 * w - 3 + rr) < 0;
                rv[rr] = prevchunk ? vhc[(rr < 3 ? rr : 0) * 32 + (lane & 31)] : bf2f(row[vcol]);
            }
            if (w == 7 && lane < 32) { vhn[lane] = rv[8]; vhn[32 + lane] = rv[9]; vhn[64 + lane] = rv[10]; }
#pragma unroll
            for (int i = 0; i < 8; ++i) {
                const int t = 8 * w + i;
                float q0 = 0.f, q1 = 0.f, k0 = 0.f, k1 = 0.f, vv = 0.f;
#pragma unroll
                for (int j = 0; j < 4; ++j) { q0 += cwq[j][0] * rq[i + j][0]; q1 += cwq[j][1] * rq[i + j][1]; k0 += cwk[j][0] * rk[i + j][0]; k1 += cwk[j][1] * rk[i + j][1]; vv += cwv[j] * rv[i + j]; }
                q0 = siluf_(q0); q1 = siluf_(q1); k0 = siluf_(k0); k1 = siluf_(k1); vv = siluf_(vv);
                const float sq = wave_sum(q0 * q0 + q1 * q1), sk = wave_sum(k0 * k0 + k1 * k1);
                const float cq = (1.0f / sqrtf(sq + 1e-6f)) * 0.08838834764831845f, ck = 1.0f / sqrtf(sk + 1e-6f);
                Qc[t * 128 + lane] = q0 * cq; Qc[t * 128 + lane + 64] = q1 * cq; Kc[t * 128 + lane] = k0 * ck; Kc[t * 128 + lane + 64] = k1 * ck;
                if (lane < 32) Vc[t * 32 + lane] = vv;
            }
            if (lane < 8) { const int t = 8 * w + lane; const float la = a_neg * softplusf_(db[(size_t)(t0 + t) * 8 + h] + dtb); al[t] = __expf(la); be[t] = sigmoidf_(db[(size_t)(t0 + t) * 8 + 4 + h]); }
        }
        __syncthreads();
        {
            const LAS float* kp = Kc + part * 8; const LAS float* qp = Qc + part * 8;
            f32x4 ka = *(const LAS f32x4*)(kp), kb = *(const LAS f32x4*)(kp + 4), qa = *(const LAS f32x4*)(qp), qb = *(const LAS f32x4*)(qp + 4);
            float vv = Vc[r], alpha = al[0], beta = be[0];
            for (int t = 0; t < 64; ++t) {
                const int tn = (t + 1) & 63;
                const f32x4 nka = *(const LAS f32x4*)(kp + tn * 128), nkb = *(const LAS f32x4*)(kp + tn * 128 + 4), nqa = *(const LAS f32x4*)(qp + tn * 128), nqb = *(const LAS f32x4*)(qp + tn * 128 + 4);
                const float nvv = Vc[tn * 32 + r], nal = al[tn], nbe = be[tn];
                float p0 = s[0] * ka.x + s[1] * ka.y, p1 = s[2] * ka.z + s[3] * ka.w, p2 = s[4] * kb.x + s[5] * kb.y, p3 = s[6] * kb.z + s[7] * kb.w;
                const float p = red16((p0 + p1) + (p2 + p3));
                const float coef = beta * (vv - alpha * p);
                s[0] = alpha * s[0] + coef * ka.x; s[1] = alpha * s[1] + coef * ka.y; s[2] = alpha * s[2] + coef * ka.z; s[3] = alpha * s[3] + coef * ka.w;
                s[4] = alpha * s[4] + coef * kb.x; s[5] = alpha * s[5] + coef * kb.y; s[6] = alpha * s[6] + coef * kb.z; s[7] = alpha * s[7] + coef * kb.w;
                float o0 = s[0] * qa.x + s[1] * qa.y, o1 = s[2] * qa.z + s[3] * qa.w, o2 = s[4] * qb.x + s[5] * qb.y, o3 = s[6] * qb.z + s[7] * qb.w;
                const float o = red16((o0 + o1) + (o2 + o3));
                if (part == 0) Oc[t * 32 + r] = o;
                ka = nka; kb = nkb; qa = nqa; qb = nqb; vv = nvv; alpha = nal; beta = nbe;
            }
        }
        __syncthreads();
        {
            const int t = tid >> 3, c4 = (tid & 7) * 4;
            const f32x4 o = *(const LAS f32x4*)(Oc + t * 32 + c4);
            u32x2 wv; wv.x = pk2(o.x, o.y); wv.y = pk2(o.z, o.w);
            *(u32x2*)(P + (size_t)(t0 + t) * P0LD + 1024 + h * 128 + qd * 32 + c4) = wv;
        }
    }
}
__device__ __forceinline__ void fin_delta(const Frame& F) {
    const int lane = lane_id_v();
    bf16_t* P = (bf16_t*)(F.ws + WS_BIG + BIG_PROJ); const float* onorm = F.in[IN_AB_ONORM];
    const float on0 = onorm[lane], on1 = onorm[lane + 64];
    const int gw = F.wg * NWAVES + F.wave, NGW = F.G * NWAVES;
    for (int it = gw; it < NT * 4; it += NGW) {
        const int t = it >> 2, h = it & 3;
        bf16_t* row = P + (size_t)t * P0LD;
        const float o0 = bf2f(row[1024 + h * 128 + lane]), o1 = bf2f(row[1024 + h * 128 + lane + 64]);
        const float g0 = bf2f(row[1536 + h * 128 + lane]), g1 = bf2f(row[1536 + h * 128 + lane + 64]);
        const float ss = wave_sum(o0 * o0 + o1 * o1), rs = 1.0f / sqrtf(ss * (1.0f / 128.0f) + 1e-6f);
        row[1536 + h * 128 + lane] = (bf16_t)f2bf(o0 * rs * on0 * siluf_(g0)); row[1536 + h * 128 + lane + 64] = (bf16_t)f2bf(o1 * rs * on1 * siluf_(g1));
    }
}

__device__ __forceinline__ void scan_rwkv2(const Frame& F, int b, int h) {
    const int lane = lane_id_v(); const int tid = F.wave * 64 + lane;
    LAS float* R = (LAS float*)F.lds;
    LAS float* KM = R + 4096;
    LAS float* V = KM + 4096;
    LAS float* KK = V + 4096;
    LAS float* KA = KK + 4096;
    LAS float* W = KA + 4096;
    LAS bf16_t* TL = (LAS bf16_t*)(W + 4096);
    LAS bf16_t* AL = TL + 64 * 72;
    LAS bf16_t* SG = AL + 64 * 72;
    LAS float* O = (LAS float*)TL;
    LAS bf16_t* GB = SG + 64 * 136;
    LAS float* halo = (LAS float*)(GB + 4096);
    LAS float* bonus = halo + 896;
    bf16_t* P = (bf16_t*)(F.ws + WS_BIG + BIG_PROJ);
    const bf16_t* LW = (const bf16_t*)(F.ws + WS_LORA);
    const float* mu = F.in[IN_AB_MU];
    const float* w0 = F.in[IN_AB_W0] + h * 64; const float* a0 = F.in[IN_AB_A0] + h * 64;
    const float* k_k = F.in[IN_AB_KK] + h * 64; const float* k_a = F.in[IN_AB_KA] + h * 64; const float* r_k = F.in[IN_AB_RK] + h * 64;
    const float* ln_w = F.in[IN_AB_LNW] + h * 64; const float* ln_b = F.in[IN_AB_LNB] + h * 64;
    const int w = F.wave, fr = lane & 15, fq = lane >> 4;
    const int vi = tid >> 3, part = tid & 7;
    float s[8];
#pragma unroll
    for (int j = 0; j < 8; ++j) s[j] = 0.f;
    for (int i = tid; i < 896; i += NTHREADS) halo[i] = 0.f;
    int gc = 0; float muc = 0.f;
    if (tid < 448) { const int col = tid;
        if (col < 64) gc = 2048 + h * 64 + col; else if (col < 128) gc = 2560 + h * 64 + (col - 64); else if (col < 192) gc = 3072 + h * 64 + (col - 128); else gc = 3584 + (col - 192);
        muc = mu[gc - 2048]; }
    __syncthreads();
    for (int c = 0; c < 32; ++c) {
        const int t0 = b * TS + c * 64;
        if (tid < 448) {
            const int col = tid;
            LAS float* hc = halo + (c & 1) * 448; LAS float* hn = halo + ((c + 1) & 1) * 448;
            float prev = hc[col];
            const bf16_t* src = P + (size_t)t0 * P0LD + gc;
#pragma unroll 8
            for (int t = 0; t < 64; ++t) {
                const float cur = bf2f(src[(size_t)t * P0LD]);
                const float sh = cur + muc * (prev - cur);
                prev = cur;
                if (col < 64) R[t * 64 + col] = sh; else if (col < 128) KM[t * 64 + col - 64] = sh; else if (col < 192) V[t * 64 + col - 128] = sh;
                else if (col < 256) TL[t * 72 + col - 192] = (bf16_t)f2bf(tanhf(sh)); else if (col < 320) AL[t * 72 + col - 256] = (bf16_t)f2bf(sh); else SG[t * 136 + col - 320] = (bf16_t)f2bf(sigmoidf_(sh));
            }
            hn[col] = prev;
        }
        __syncthreads();
        {
#pragma unroll
            for (int q = 0; q < 2; ++q) {
                const int id = 2 * w + q, mi = id >> 2, nj = id & 3;
                f32x4 aw = {0.f, 0.f, 0.f, 0.f}, aa = {0.f, 0.f, 0.f, 0.f}, ag = {0.f, 0.f, 0.f, 0.f};
                const int jrow = h * 64 + nj * 16 + fr;
#pragma unroll
                for (int ksx = 0; ksx < 2; ++ksx) {
                    const bf16x8 x1 = *(const LAS bf16x8*)(TL + (mi * 16 + fr) * 72 + ksx * 32 + fq * 8), x2 = *(const LAS bf16x8*)(AL + (mi * 16 + fr) * 72 + ksx * 32 + fq * 8);
                    const bf16x8 y1 = *(const bf16x8*)(LW + (size_t)jrow * 64 + ksx * 32 + fq * 8), y2 = *(const bf16x8*)(LW + 512 * 64 + (size_t)jrow * 64 + ksx * 32 + fq * 8);
                    aw = __builtin_amdgcn_mfma_f32_16x16x32_bf16(x1, y1, aw, 0, 0, 0); aa = __builtin_amdgcn_mfma_f32_16x16x32_bf16(x2, y2, aa, 0, 0, 0);
                }
#pragma unroll
                for (int ksx = 0; ksx < 4; ++ksx) {
                    const bf16x8 x3 = *(const LAS bf16x8*)(SG + (mi * 16 + fr) * 136 + ksx * 32 + fq * 8);
                    const bf16x8 y3 = *(const bf16x8*)(LW + 2 * 512 * 64 + (size_t)jrow * 128 + ksx * 32 + fq * 8);
                    ag = __builtin_amdgcn_mfma_f32_16x16x32_bf16(x3, y3, ag, 0, 0, 0);
                }
                const int j = nj * 16 + fr; const float w0j = w0[j], a0j = a0[j];
                const float awv[4] = {aw.x, aw.y, aw.z, aw.w}, aav[4] = {aa.x, aa.y, aa.z, aa.w}, agv[4] = {ag.x, ag.y, ag.z, ag.w};
#pragma unroll
                for (int rg = 0; rg < 4; ++rg) { const int t = mi * 16 + 4 * fq + rg;
                    W[t * 64 + j] = __expf(-0.6065306597126334f * sigmoidf_(w0j + awv[rg])); KA[t * 64 + j] = sigmoidf_(a0j + aav[rg]); GB[t * 64 + j] = (bf16_t)f2bf(agv[rg]); }
            }
        }
        __syncthreads();
        {
            const int j = lane; const float kkj = k_k[j], kaj = k_a[j], rkj = r_k[j];
#pragma unroll
            for (int q = 0; q < 8; ++q) { const int t = w * 8 + q; const float kv = KM[t * 64 + j], a = KA[t * 64 + j]; const float kx = kv * kkj; const float ss = wave_sum(kx * kx);
                const float kk = kx * (1.0f / sqrtf(ss + 1e-6f)); KK[t * 64 + j] = kk; KA[t * 64 + j] = kk * a; const float km = kv * (1.f + (a - 1.f) * kaj); KM[t * 64 + j] = km;
                const float bs = wave_sum(R[t * 64 + j] * km * rkj); if (j == 0) bonus[t] = bs; }
        }
        __syncthreads();
        {
            const int o8 = part * 8;
            for (int t = 0; t < 64; ++t) {
                const f32x4 k0 = *(const LAS f32x4*)(KK + t * 64 + o8), k1 = *(const LAS f32x4*)(KK + t * 64 + o8 + 4);
                const f32x4 w0v = *(const LAS f32x4*)(W + t * 64 + o8), w1v = *(const LAS f32x4*)(W + t * 64 + o8 + 4);
                const f32x4 a0v = *(const LAS f32x4*)(KA + t * 64 + o8), a1v = *(const LAS f32x4*)(KA + t * 64 + o8 + 4);
                const f32x4 m0 = *(const LAS f32x4*)(KM + t * 64 + o8), m1 = *(const LAS f32x4*)(KM + t * 64 + o8 + 4);
                const f32x4 r0 = *(const LAS f32x4*)(R + t * 64 + o8), r1 = *(const LAS f32x4*)(R + t * 64 + o8 + 4);
                const float vv = V[t * 64 + vi];
                const float sa = -red8(((s[0] * k0.x + s[1] * k0.y) + (s[2] * k0.z + s[3] * k0.w)) + ((s[4] * k1.x + s[5] * k1.y) + (s[6] * k1.z + s[7] * k1.w)));
                s[0] = s[0] * w0v.x + sa * a0v.x + vv * m0.x; s[1] = s[1] * w0v.y + sa * a0v.y + vv * m0.y; s[2] = s[2] * w0v.z + sa * a0v.z + vv * m0.z; s[3] = s[3] * w0v.w + sa * a0v.w + vv * m0.w;
                s[4] = s[4] * w1v.x + sa * a1v.x + vv * m1.x; s[5] = s[5] * w1v.y + sa * a1v.y + vv * m1.y; s[6] = s[6] * w1v.z + sa * a1v.z + vv * m1.z; s[7] = s[7] * w1v.w + sa * a1v.w + vv * m1.w;
                const float o = red8(((s[0] * r0.x + s[1] * r0.y) + (s[2] * r0.z + s[3] * r0.w)) + ((s[4] * r1.x + s[5] * r1.y) + (s[6] * r1.z + s[7] * r1.w)));
                if (part == 0) O[t * 64 + vi] = o;
            }
        }
        __syncthreads();
        for (int t = w; t < 64; t += NWAVES) {
            const float o = O[t * 64 + lane];
            const float mean = wave_sum(o) * (1.0f / 64.0f); const float dlt = o - mean; const float var = wave_sum(dlt * dlt) * (1.0f / 64.0f);
            float y = dlt * (1.0f / sqrtf(var + 64e-5f)) * ln_w[lane] + ln_b[lane];
            y += bonus[t] * V[t * 64 + lane];
            y *= bf2f(GB[t * 64 + lane]);
            P[(size_t)(t0 + t) * P0LD + 2048 + h * 64 + lane] = (bf16_t)f2bf(y);
        }
        __syncthreads();
    }
}

__device__ __forceinline__ void scan_hgrn2(const Frame& F, int b, int h, int qd) {
    const int lane = lane_id_v(); const int tid = F.wave * 64 + lane;
    LAS float* qs = (LAS float*)F.lds;
    LAS float* fs = qs + 64 * 128;
    LAS float* kf = fs + 64 * 128;
    LAS float* is = kf + 64 * 128;
    bf16_t* P = (bf16_t*)(F.ws + WS_BIG + BIG_PROJ);
    const int e = tid >> 4, part = tid & 15;
    float s[8];
#pragma unroll
    for (int j = 0; j < 8; ++j) s[j] = 0.f;
    for (int c = 0; c < 32; ++c) {
        const int t0 = b * TS + c * 64;
        {
            const int t = tid >> 3, c16 = (tid & 7) * 16;
            const bf16_t* pr = P + (size_t)(t0 + t) * P1LD + h * 128 + c16;
            const u32x4 qa = *(const u32x4*)pr, qb = *(const u32x4*)(pr + 8), la = *(const u32x4*)(pr + 1024), lb2 = *(const u32x4*)(pr + 1024 + 8);
            const unsigned qv[8] = {qa.x, qa.y, qa.z, qa.w, qb.x, qb.y, qb.z, qb.w}, lv[8] = {la.x, la.y, la.z, la.w, lb2.x, lb2.y, lb2.z, lb2.w};
#pragma unroll
            for (int j = 0; j < 8; ++j) {
                qs[t * 128 + c16 + 2 * j] = bf2f((unsigned short)(qv[j] & 0xffffu)); qs[t * 128 + c16 + 2 * j + 1] = bf2f((unsigned short)(qv[j] >> 16));
                const float l0 = h2f_bits((unsigned short)(lv[j] & 0xffffu)), l1 = h2f_bits((unsigned short)(lv[j] >> 16));
                fs[t * 128 + c16 + 2 * j] = __expf(l0); fs[t * 128 + c16 + 2 * j + 1] = __expf(l1); kf[t * 128 + c16 + 2 * j] = -expm1f(l0); kf[t * 128 + c16 + 2 * j + 1] = -expm1f(l1);
            }
            const int c4 = (tid & 7) * 4;
            const u32x2 iv = *(const u32x2*)(P + (size_t)(t0 + t) * P1LD + 2048 + h * 128 + qd * 32 + c4);
            is[t * 32 + c4] = bf2f((unsigned short)(iv.x & 0xffffu)); is[t * 32 + c4 + 1] = bf2f((unsigned short)(iv.x >> 16)); is[t * 32 + c4 + 2] = bf2f((unsigned short)(iv.y & 0xffffu)); is[t * 32 + c4 + 3] = bf2f((unsigned short)(iv.y >> 16));
        }
        __syncthreads();
        {
            const int o8 = part * 8;
            for (int t = 0; t < 64; ++t) {
                const f32x4 f0 = *(const LAS f32x4*)(fs + t * 128 + o8), f1 = *(const LAS f32x4*)(fs + t * 128 + o8 + 4);
                const f32x4 k0 = *(const LAS f32x4*)(kf + t * 128 + o8), k1 = *(const LAS f32x4*)(kf + t * 128 + o8 + 4);
                const f32x4 q0 = *(const LAS f32x4*)(qs + t * 128 + o8), q1 = *(const LAS f32x4*)(qs + t * 128 + o8 + 4);
                const float iv = is[t * 32 + e];
                s[0] = f0.x * s[0] + k0.x * iv; s[1] = f0.y * s[1] + k0.y * iv; s[2] = f0.z * s[2] + k0.z * iv; s[3] = f0.w * s[3] + k0.w * iv;
                s[4] = f1.x * s[4] + k1.x * iv; s[5] = f1.y * s[5] + k1.y * iv; s[6] = f1.z * s[6] + k1.z * iv; s[7] = f1.w * s[7] + k1.w * iv;
                const float o = red16(((s[0] * q0.x + s[1] * q0.y) + (s[2] * q0.z + s[3] * q0.w)) + ((s[4] * q1.x + s[5] * q1.y) + (s[6] * q1.z + s[7] * q1.w)));
                if (part == 0) is[t * 32 + e] = o;
            }
        }
        __syncthreads();
        {
            const int t = tid >> 3, c4 = (tid & 7) * 4;
            const f32x4 o = *(const LAS f32x4*)(is + t * 32 + c4);
            u32x2 wv; wv.x = pk2(o.x, o.y); wv.y = pk2(o.z, o.w);
            *(u32x2*)(P + (size_t)(t0 + t) * P1LD + 2048 + h * 128 + qd * 32 + c4) = wv;
        }
        __syncthreads();
    }
}
__device__ __forceinline__ void fin_hgrn(const Frame& F) {
    const int lane = lane_id_v();
    bf16_t* P = (bf16_t*)(F.ws + WS_BIG + BIG_PROJ); const float* onorm = F.in[IN_C_ONORM];
    const float on0 = onorm[lane], on1 = onorm[lane + 64];
    const int gw = F.wg * NWAVES + F.wave, NGW = F.G * NWAVES;
    for (int it = gw; it < NT * 8; it += NGW) {
        const int t = it >> 3, h = it & 7;
        bf16_t* row = P + (size_t)t * P1LD;
        const float o0 = bf2f(row[2048 + h * 128 + lane]), o1 = bf2f(row[2048 + h * 128 + lane + 64]);
        const float g0 = bf2f(row[3072 + h * 128 + lane]), g1 = bf2f(row[3072 + h * 128 + lane + 64]);
        const float ss = wave_sum(o0 * o0 + o1 * o1), rs = 1.0f / sqrtf(ss * (1.0f / 128.0f) + 1e-6f);
        row[3072 + h * 128 + lane] = (bf16_t)f2bf(o0 * rs * on0 * siluf_(g0)); row[3072 + h * 128 + lane + 64] = (bf16_t)f2bf(o1 * rs * on1 * siluf_(g1));
    }
}

#define MFMA32(a, b, c) __builtin_amdgcn_mfma_f32_16x16x32_bf16(a, b, c, 0, 0, 0)
#define MFMA16(a, b, c) __builtin_amdgcn_mfma_f32_16x16x16bf16_1k(a, b, c, 0, 0, 0)
__device__ __forceinline__ f32x4 mm_tile(const LAS bf16_t* A, int lda, const LAS bf16_t* B, int ldb, int nks, f32x4 acc, int fr, int fq) {
    for (int ksx = 0; ksx < nks; ++ksx) acc = MFMA32(*(const LAS bf16x8*)(A + fr * lda + ksx * 32 + fq * 8), *(const LAS bf16x8*)(B + fr * ldb + ksx * 32 + fq * 8), acc);
    return acc;
}
__device__ __forceinline__ void lds_w4(LAS bf16_t* p, f32x4 v) { u32x2 w; w.x = pk2(v.x, v.y); w.y = pk2(v.z, v.w); *(LAS u32x2*)p = w; }
__device__ __forceinline__ float rdlane(float v, int l) { return __int_as_float(__builtin_amdgcn_readlane(__float_as_int(v), l)); }
__device__ __forceinline__ float wsum(float v) { v = red16(v); return (rdlane(v, 0) + rdlane(v, 16)) + (rdlane(v, 32) + rdlane(v, 48)); }

struct HoBuf { __amdgpu_buffer_rsrc_t r; };
__device__ __forceinline__ HoBuf ho_buf(float* base, unsigned bytes) {
    const unsigned long long a = (unsigned long long)base;
    const unsigned lo = __builtin_amdgcn_readfirstlane((unsigned)a), hi = __builtin_amdgcn_readfirstlane((unsigned)(a >> 32));
    HoBuf h; h.r = __builtin_amdgcn_make_buffer_rsrc((void*)(((unsigned long long)hi << 32) | lo), 0, bytes, 0x00020000); return h;
}
__device__ __forceinline__ void ho_store(const HoBuf& hb, unsigned byteoff, f32x4 v) {
    __builtin_amdgcn_raw_buffer_store_b128(__builtin_bit_cast(u32x4, v), hb.r, byteoff, 0, 16);
}
__device__ __forceinline__ f32x4 ho_load(const HoBuf& hb, unsigned byteoff) {
    return __builtin_bit_cast(f32x4, __builtin_amdgcn_raw_buffer_load_b128(hb.r, byteoff, 0, 16));
}
__device__ __forceinline__ void ho_wait(unsigned* flag, unsigned need, unsigned* tmo, int wave, int lane) {
    if (wave == 0 && lane == 0) { unsigned sp = 0;
        while (__hip_atomic_load(flag, __ATOMIC_RELAXED, __HIP_MEMORY_SCOPE_AGENT) < need) { __builtin_amdgcn_s_sleep(2); if (++sp > (1u << 24)) { __hip_atomic_store(tmo, 1u, __ATOMIC_RELAXED, __HIP_MEMORY_SCOPE_AGENT); break; } } }
    __syncthreads();
}

__device__ __forceinline__ void scan_delta3(const Frame& F, int b, int h, int jpart, int kparts) {
    const int lane0 = lane_id_v(); const int w = F.wave;
    LAS bf16_t* Qb = (LAS bf16_t*)F.lds;
    LAS bf16_t* Kb = Qb + 64 * 136;
    LAS float* Of = (LAS float*)F.lds;
    LAS bf16_t* Kdt = Kb + 64 * 136;
    LAS bf16_t* Vt = Kdt + 128 * 72;
    LAS bf16_t* St = Vt + 128 * 72;
    LAS bf16_t* Aoff = St + 128 * 136;
    LAS bf16_t* QKm = Aoff + 64 * 72;
    LAS bf16_t* Vn = QKm + 64 * 72;
    LAS bf16_t* Dg = Vn + 128 * 72;
    LAS float* Adg = (LAS float*)(Dg + 4 * 16 * 24);
    LAS float* sc = Adg + 4 * 16 * 17;
    static_assert((64 * 136 * 2 * 2 + 128 * 72 * 2 * 3 + 128 * 136 * 2 + 64 * 72 * 2 * 2 + 4 * 16 * 24 * 2 + 4 * 16 * 17 * 4 + 260 * 4) <= LDS_MISC, "delta3 LDS");
    bf16_t* P = (bf16_t*)(F.ws + WS_BIG + BIG_PROJ);
    const HoBuf hb = ho_buf((float*)(F.ws + WS_HOA) + (size_t)(b * 4 + h) * 16384, 65536);
    unsigned* flag = (unsigned*)(F.ws + WS_FLAGS) + 64 + (b * 4 + h); unsigned* tmo = (unsigned*)(F.ws + WS_FLAGS) + 255;
    const float* convw = F.in[IN_AB_CONV];
    const float* db = (const float*)(F.ws + WS_DB);
    const float a_neg = -__expf(F.in[IN_AB_ALOG][h]), dtb = F.in[IN_AB_DTB][h];
    const float* onorm = F.in[IN_AB_ONORM];
    float cw[3][4][2];
#pragma unroll
    for (int sct = 0; sct < 3; ++sct)
#pragma unroll
        for (int j = 0; j < 4; ++j) { cw[sct][j][0] = convw[j * 1536 + sct * 512 + h * 128 + 2 * lane0]; cw[sct][j][1] = convw[j * 1536 + sct * 512 + h * 128 + 2 * lane0 + 1]; }
    for (int i = w * 64 + lane0; i < (128 * 136 + 64 * 72 * 2 + 128 * 72) / 2; i += NTHREADS) ((LAS unsigned*)St)[i] = 0u;
    unsigned pacc = 0u, plast = 0u;
    f32x4 sacc[8];
#pragma unroll
    for (int i = 0; i < 8; ++i) sacc[i] = (f32x4){0.f, 0.f, 0.f, 0.f};
    __syncthreads();
    unsigned rawu[3][11]; float dbv0, dbv1;
#define DELTA_FETCH(cc, ln) do { const int cc_ = (cc) < 32 ? (cc) : 31; \
        dbv0 = db[(size_t)(b * TS + cc_ * 64 + (ln)) * 8 + h]; dbv1 = db[(size_t)(b * TS + cc_ * 64 + (ln)) * 8 + 4 + h]; \
        _Pragma("unroll") for (int rr = 0; rr < 11; ++rr) { const int tl = cc_ * 64 + 8 * w - 3 + rr; \
            const unsigned* row = (const unsigned*)(P + (size_t)(b * TS + (tl >= 0 ? tl : 0)) * P0LD + h * 128) + (ln); \
            _Pragma("unroll") for (int sct = 0; sct < 3; ++sct) rawu[sct][rr] = row[sct * 256]; } } while (0)
    DELTA_FETCH(jpart, lane0);
    for (int c = jpart; c < 32; c += kparts) {
        int lane = lane0; asm volatile("" : "+v"(lane));
        const int fr = lane & 15, fq = lane >> 4;
        const int t0 = b * TS + c * 64;
        if (PROBE_STAGE >= 0) plast = (unsigned)__builtin_amdgcn_s_memrealtime();
        unsigned gq[8];
#pragma unroll
        for (int i = 0; i < 8; ++i) gq[i] = *((const unsigned*)(P + (size_t)(t0 + w + 8 * i) * P0LD + 1536 + h * 128) + lane);
        {
            const float la = a_neg * softplusf_(dbv0 + dtb);
            const float bet = sigmoidf_(dbv1);
            float g = la;
#pragma unroll
            for (int o = 1; o < 64; o <<= 1) { const float n = __shfl_up(g, o); if (lane >= o) g += n; }
            const float gL = rdlane(g, 63);
            if (w == 0) { sc[lane] = g; sc[64 + lane] = __expf(g); sc[128 + lane] = bet * __expf(g); sc[192 + lane] = bet; if (lane == 0) sc[256] = __expf(gL); }
            float raw[3][11][2];
#pragma unroll
            for (int rr = 0; rr < 11; ++rr) { const bool ok = (c * 64 + 8 * w - 3 + rr) >= 0;
#pragma unroll
                for (int sct = 0; sct < 3; ++sct) { raw[sct][rr][0] = ok ? bf2f((unsigned short)(rawu[sct][rr] & 0xffffu)) : 0.f; raw[sct][rr][1] = ok ? bf2f((unsigned short)(rawu[sct][rr] >> 16)) : 0.f; } }
            DELTA_FETCH(c + kparts, lane);
            float kd0[8], kd1[8], vt0[8], vt1[8];
#pragma unroll
            for (int i = 0; i < 8; ++i) {
                const int t = 8 * w + i;
                float x[3][2];
#pragma unroll
                for (int sct = 0; sct < 3; ++sct) { float a0 = 0.f, a1 = 0.f;
#pragma unroll
                    for (int j = 0; j < 4; ++j) { a0 += cw[sct][j][0] * raw[sct][i + j][0]; a1 += cw[sct][j][1] * raw[sct][i + j][1]; }
                    x[sct][0] = siluf_(a0); x[sct][1] = siluf_(a1); }
                const float sq = wsum(x[0][0] * x[0][0] + x[0][1] * x[0][1]), sk = wsum(x[1][0] * x[1][0] + x[1][1] * x[1][1]);
                const float cq = (1.0f / sqrtf(sq + 1e-6f)) * 0.08838834764831845f, ck = 1.0f / sqrtf(sk + 1e-6f);
                const float egr = __expf(gL - rdlane(g, t));
                *(LAS unsigned*)(Qb + t * 136 + 2 * lane) = pk2(x[0][0] * cq, x[0][1] * cq);
                const float k0 = x[1][0] * ck, k1 = x[1][1] * ck;
                *(LAS unsigned*)(Kb + t * 136 + 2 * lane) = pk2(k0, k1);
                kd0[i] = k0 * egr; kd1[i] = k1 * egr; vt0[i] = x[2][0]; vt1[i] = x[2][1];
            }
            *(LAS u32x4*)(Kdt + (2 * lane) * 72 + 8 * w) = (u32x4){pk2(kd0[0], kd0[1]), pk2(kd0[2], kd0[3]), pk2(kd0[4], kd0[5]), pk2(kd0[6], kd0[7])};
            *(LAS u32x4*)(Kdt + (2 * lane + 1) * 72 + 8 * w) = (u32x4){pk2(kd1[0], kd1[1]), pk2(kd1[2], kd1[3]), pk2(kd1[4], kd1[5]), pk2(kd1[6], kd1[7])};
            *(LAS u32x4*)(Vt + (2 * lane) * 72 + 8 * w) = (u32x4){pk2(vt0[0], vt0[1]), pk2(vt0[2], vt0[3]), pk2(vt0[4], vt0[5]), pk2(vt0[6], vt0[7])};
            *(LAS u32x4*)(Vt + (2 * lane + 1) * 72 + 8 * w) = (u32x4){pk2(vt1[0], vt1[1]), pk2(vt1[2], vt1[3]), pk2(vt1[4], vt1[5]), pk2(vt1[6], vt1[7])};
        }
        __syncthreads();
        if (PROBE_STAGE >= 0) { const unsigned tn = (unsigned)__builtin_amdgcn_s_memrealtime(); if (PROBE_STAGE == 0) pacc += tn - plast; plast = tn; }
        {
            for (int id = w; id < 20; id += NWAVES) {
                const int which = id / 10, tix = id % 10;
                const int bi = (tix < 1) ? 0 : (tix < 3 ? 1 : (tix < 6 ? 2 : 3)); const int bj = tix - (bi * (bi + 1)) / 2;
                f32x4 acc = {0.f, 0.f, 0.f, 0.f};
                acc = mm_tile(Kb + bj * 16 * 136, 136, (which ? Qb : Kb) + bi * 16 * 136, 136, 4, acc, fr, fq);
                const int i = 16 * bi + fr; const float gi = sc[i], bi_ = sc[192 + i];
                const float av[4] = {acc.x, acc.y, acc.z, acc.w}; float ov[4];
#pragma unroll
                for (int rg = 0; rg < 4; ++rg) { const int j = 16 * bj + 4 * fq + rg; const float dec = __expf(gi - sc[j]);
                    ov[rg] = which ? ((j <= i) ? av[rg] * dec : 0.f) : ((j < i) ? bi_ * av[rg] * dec : 0.f); }
                if (which) lds_w4(QKm + i * 72 + 16 * bj + 4 * fq, (f32x4){ov[0], ov[1], ov[2], ov[3]});
                else if (bi == bj) { LAS float* d = Adg + (bi * 16 + fr) * 17 + 4 * fq; d[0] = ov[0]; d[1] = ov[1]; d[2] = ov[2]; d[3] = ov[3]; }
                else lds_w4(Aoff + i * 72 + 16 * bj + 4 * fq, (f32x4){-ov[0], -ov[1], -ov[2], -ov[3]});
            }
        }
        __syncthreads();
        if (PROBE_STAGE >= 0) { const unsigned tn = (unsigned)__builtin_amdgcn_s_memrealtime(); if (PROBE_STAGE == 1) pacc += tn - plast; plast = tn; }
        f32x4 y[4], qs[4];
        if (w < 4 && lane < 16) { float x[16]; const LAS float* a = Adg + w * 16 * 17;
#pragma unroll
            for (int i = 0; i < 16; ++i) { float v = (i == lane) ? 1.f : 0.f;
#pragma unroll
                for (int k = 0; k < i; ++k) v -= a[i * 17 + k] * x[k];
                x[i] = v; Dg[(w * 16 + i) * 24 + lane] = (bf16_t)f2bf(v); } }
        if (c > 0) ho_wait(flag, (unsigned)c, tmo, w, lane); else __syncthreads();
#pragma unroll
        for (int dk = 0; dk < 8; dk += 2) {
            const u32x4 ldv = __builtin_bit_cast(u32x4, ho_load(hb, (unsigned)(((w * 64 + lane) * 4 + (dk >> 1)) * 16)));
            const f32x4 z0 = {bf2f((unsigned short)(ldv.x & 0xffffu)), bf2f((unsigned short)(ldv.x >> 16)), bf2f((unsigned short)(ldv.y & 0xffffu)), bf2f((unsigned short)(ldv.y >> 16))};
            const f32x4 z1 = {bf2f((unsigned short)(ldv.z & 0xffffu)), bf2f((unsigned short)(ldv.z >> 16)), bf2f((unsigned short)(ldv.w & 0xffffu)), bf2f((unsigned short)(ldv.w >> 16))};
            sacc[dk] = (c > 0) ? z0 : (f32x4){0.f, 0.f, 0.f, 0.f}; sacc[dk + 1] = (c > 0) ? z1 : (f32x4){0.f, 0.f, 0.f, 0.f}; }
#pragma unroll
        for (int dk = 0; dk < 8; ++dk) {
            lds_w4(St + (16 * w + fr) * 136 + 16 * dk + 4 * fq, sacc[dk]); }
        asm volatile("s_waitcnt lgkmcnt(0)" ::: "memory");
        {
            const LAS bf16_t* Sw = St + (16 * w) * 136;
#pragma unroll
            for (int mi = 0; mi < 4; ++mi) {
                f32x4 x = mm_tile(Kb + mi * 16 * 136, 136, Sw, 136, 4, (f32x4){0.f, 0.f, 0.f, 0.f}, fr, fq);
                qs[mi] = mm_tile(Qb + mi * 16 * 136, 136, Sw, 136, 4, (f32x4){0.f, 0.f, 0.f, 0.f}, fr, fq);
                const bf16x4 vv = *(const LAS bf16x4*)(Vt + (16 * w + fr) * 72 + 16 * mi + 4 * fq);
                const f32x4 be4 = *(const LAS f32x4*)(sc + 192 + 16 * mi + 4 * fq), bg4 = *(const LAS f32x4*)(sc + 128 + 16 * mi + 4 * fq);
                y[mi].x = be4.x * bf2f((unsigned short)vv.x) - bg4.x * x.x; y[mi].y = be4.y * bf2f((unsigned short)vv.y) - bg4.y * x.y;
                y[mi].z = be4.z * bf2f((unsigned short)vv.z) - bg4.z * x.z; y[mi].w = be4.w * bf2f((unsigned short)vv.w) - bg4.w * x.w;
            }
        }
        __syncthreads();
        if (PROBE_STAGE >= 0) { const unsigned tn = (unsigned)__builtin_amdgcn_s_memrealtime(); if (PROBE_STAGE == 2) pacc += tn - plast; plast = tn; }
        {
            LAS bf16_t* Vw = Vn + (16 * w) * 72;
#pragma unroll
            for (int bb = 0; bb < 4; ++bb) {
                f32x4 acc = y[bb];
                if (bb >= 1) acc = mm_tile(Aoff + bb * 16 * 72, 72, Vw, 72, (bb + 1) / 2, acc, fr, fq);
                u32x2 pk; pk.x = pk2(acc.x, acc.y); pk.y = pk2(acc.z, acc.w);
                const bf16x4 dgf = *(const LAS bf16x4*)(Dg + (bb * 16 + fr) * 24 + 4 * fq);
                const f32x4 vb = MFMA16(dgf, __builtin_bit_cast(bf16x4, pk), ((f32x4){0.f, 0.f, 0.f, 0.f}));
                lds_w4(Vw + fr * 72 + 16 * bb + 4 * fq, vb);
                asm volatile("s_waitcnt lgkmcnt(0)" ::: "memory");
            }
            const float gl = sc[256];
#pragma unroll
            for (int mi = 0; mi < 4; ++mi) {
                const f32x4 eg4 = *(const LAS f32x4*)(sc + 64 + 16 * mi + 4 * fq);
                f32x4 o = qs[mi] * eg4;
                o = mm_tile(QKm + mi * 16 * 72, 72, Vw, 72, 2, o, fr, fq);
                qs[mi] = o;
            }
#pragma unroll
            for (int dk = 0; dk < 8; ++dk) {
                f32x4 sn = sacc[dk] * gl;
                sn = mm_tile(Kdt + dk * 16 * 72, 72, Vw, 72, 2, sn, fr, fq);
                sacc[dk] = sn;
                lds_w4(St + (16 * w + fr) * 136 + 16 * dk + 4 * fq, sn);
            }
        }
        if (c < 31) {
#pragma unroll
            for (int dk = 0; dk < 8; dk += 2) { u32x4 pv; pv.x = pk2(sacc[dk].x, sacc[dk].y); pv.y = pk2(sacc[dk].z, sacc[dk].w); pv.z = pk2(sacc[dk + 1].x, sacc[dk + 1].y); pv.w = pk2(sacc[dk + 1].z, sacc[dk + 1].w);
                ho_store(hb, (unsigned)(((w * 64 + lane) * 4 + (dk >> 1)) * 16), __builtin_bit_cast(f32x4, pv)); }
            asm volatile("s_waitcnt vmcnt(0)" ::: "memory");
        }
        __syncthreads();
        if (c < 31 && w == 0 && lane == 0) __hip_atomic_store(flag, (unsigned)(c + 1), __ATOMIC_RELAXED, __HIP_MEMORY_SCOPE_AGENT);
        if (PROBE_STAGE >= 0) { const unsigned tn = (unsigned)__builtin_amdgcn_s_memrealtime(); if (PROBE_STAGE == 3) pacc += tn - plast; plast = tn; }
#pragma unroll
        for (int mi = 0; mi < 4; ++mi) { LAS float* op = Of + (16 * mi + 4 * fq) * 132 + 16 * w + fr; op[0] = qs[mi].x; op[132] = qs[mi].y; op[264] = qs[mi].z; op[396] = qs[mi].w; }
        __syncthreads();
        if (PROBE_STAGE >= 0) { const unsigned tn = (unsigned)__builtin_amdgcn_s_memrealtime(); if (PROBE_STAGE == 4) pacc += tn - plast; plast = tn; }
        const float on0 = onorm[2 * lane], on1 = onorm[2 * lane + 1];
#pragma unroll
        for (int i = 0; i < 8; ++i) {
            const int t = w + 8 * i;
            const f32x2 ov = *(const LAS f32x2*)(Of + t * 132 + 2 * lane); const float o0 = ov.x, o1 = ov.y;
            const float ss = wsum(o0 * o0 + o1 * o1), rs = 1.0f / sqrtf(ss * (1.0f / 128.0f) + 1e-6f);
            const float g0 = bf2f((unsigned short)(gq[i] & 0xffffu)), g1 = bf2f((unsigned short)(gq[i] >> 16));
            *((unsigned*)(P + (size_t)(t0 + t) * P0LD + 1536 + h * 128) + lane) = pk2(o0 * rs * on0 * siluf_(g0), o1 * rs * on1 * siluf_(g1));
        }
        __syncthreads();
        if (PROBE_STAGE >= 0) { const unsigned tn = (unsigned)__builtin_amdgcn_s_memrealtime(); if (PROBE_STAGE == 5) pacc += tn - plast; plast = tn; }
    }
    if (PROBE_STAGE >= 0 && F.wg == 0 && w == 0 && lane0 == 0) __hip_atomic_store((unsigned*)(F.ws + WS_CTL + 20484), pacc, __ATOMIC_RELAXED, __HIP_MEMORY_SCOPE_AGENT);
}

__device__ __forceinline__ void scan_hgrn3(const Frame& F, int b, int h, int jpart, int kparts) {
    const int lane0 = lane_id_v(); const int w = F.wave;
    LAS bf16_t* Qd = (LAS bf16_t*)F.lds;
    LAS bf16_t* Kp = Qd + 64 * 136;
    LAS bf16_t* Kpt = Kp + 64 * 136;
    LAS bf16_t* Vt = Kpt + 128 * 72;
    LAS bf16_t* Sc = Vt + 128 * 72;
    LAS bf16_t* Zt = Sc + 64 * 72;
    LAS float* Of = (LAS float*)(Zt + 128 * 136);
    LAS float* gl = Of + 64 * 132;
    LAS float* seg = gl + 128;
    static_assert((64 * 136 * 2 * 2 + 128 * 72 * 2 * 2 + 64 * 72 * 2 + 128 * 136 * 2 + 64 * 132 * 4 + 128 * 4 + 512 * 4) <= LDS_MISC, "hgrn3 LDS");
    bf16_t* P = (bf16_t*)(F.ws + WS_BIG + BIG_PROJ);
    const HoBuf hb = ho_buf((float*)(F.ws + WS_HOC) + (size_t)(b * 8 + h) * 16384, 65536);
    unsigned* flag = (unsigned*)(F.ws + WS_FLAGS) + 96 + (b * 8 + h); unsigned* tmo = (unsigned*)(F.ws + WS_FLAGS) + 255;
    const float* onorm = F.in[IN_C_ONORM];
    for (int i = w * 64 + lane0; i < (64 * 72 + 128 * 136) / 2; i += NTHREADS) ((LAS unsigned*)Sc)[i] = 0u;
    f32x4 zacc[8];
#pragma unroll
    for (int i = 0; i < 8; ++i) zacc[i] = (f32x4){0.f, 0.f, 0.f, 0.f};
    __syncthreads();
    for (int c = jpart; c < 32; c += kparts) {
        int lane = lane0; asm volatile("" : "+v"(lane));
        const int tid = w * 64 + lane, fr = lane & 15, fq = lane >> 4, d = tid & 127, sg = tid >> 7;
        const int t0 = b * TS + c * 64;
        {
            float G[16], q[16], v[16], lf[16];
            const bf16_t* pr = P + (size_t)(t0 + 16 * sg) * P1LD + h * 128 + d;
#pragma unroll
            for (int i = 0; i < 16; ++i) { q[i] = bf2f(pr[(size_t)i * P1LD]); lf[i] = h2f_bits(pr[(size_t)i * P1LD + 1024]); v[i] = bf2f(pr[(size_t)i * P1LD + 2048]); }
            float run = 0.f;
#pragma unroll
            for (int i = 0; i < 16; ++i) { run += lf[i]; G[i] = run; }
            seg[sg * 128 + d] = run;
            __syncthreads();
            float off = 0.f;
#pragma unroll
            for (int s2 = 0; s2 < 3; ++s2) if (s2 < sg) off += seg[s2 * 128 + d];
            float kpv[16];
#pragma unroll
            for (int i = 0; i < 16; ++i) {
                const int t = 16 * sg + i; const float Gt = off + G[i];
                const float qd = q[i] * __expf(Gt); kpv[i] = -expm1f(lf[i]) * __expf(fminf(-Gt, 80.f));
                Qd[t * 136 + d] = (bf16_t)f2bf(qd); Kp[t * 136 + d] = (bf16_t)f2bf(kpv[i]);
            }
            *(LAS u32x4*)(Kpt + d * 72 + 16 * sg) = (u32x4){pk2(kpv[0], kpv[1]), pk2(kpv[2], kpv[3]), pk2(kpv[4], kpv[5]), pk2(kpv[6], kpv[7])};
            *(LAS u32x4*)(Kpt + d * 72 + 16 * sg + 8) = (u32x4){pk2(kpv[8], kpv[9]), pk2(kpv[10], kpv[11]), pk2(kpv[12], kpv[13]), pk2(kpv[14], kpv[15])};
            *(LAS u32x4*)(Vt + d * 72 + 16 * sg) = (u32x4){pk2(v[0], v[1]), pk2(v[2], v[3]), pk2(v[4], v[5]), pk2(v[6], v[7])};
            *(LAS u32x4*)(Vt + d * 72 + 16 * sg + 8) = (u32x4){pk2(v[8], v[9]), pk2(v[10], v[11]), pk2(v[12], v[13]), pk2(v[14], v[15])};
            if (sg == 3) gl[d] = __expf(off + G[15]);
        }
        __syncthreads();
        for (int id = w; id < 10; id += NWAVES) {
            const int bi = (id < 1) ? 0 : (id < 3 ? 1 : (id < 6 ? 2 : 3)); const int bj = id - (bi * (bi + 1)) / 2;
            const f32x4 acc = mm_tile(Kp + bj * 16 * 136, 136, Qd + bi * 16 * 136, 136, 4, (f32x4){0.f, 0.f, 0.f, 0.f}, fr, fq);
            const int i = 16 * bi + fr, j0 = 16 * bj + 4 * fq;
            lds_w4(Sc + i * 72 + j0, (f32x4){(j0 <= i) ? acc.x : 0.f, (j0 + 1 <= i) ? acc.y : 0.f, (j0 + 2 <= i) ? acc.z : 0.f, (j0 + 3 <= i) ? acc.w : 0.f});
        }
        __syncthreads();
        if (c > 0) ho_wait(flag, (unsigned)c, tmo, w, lane);
#pragma unroll
        for (int dk = 0; dk < 8; dk += 2) {
            const u32x4 ldv = __builtin_bit_cast(u32x4, ho_load(hb, (unsigned)(((w * 64 + lane) * 4 + (dk >> 1)) * 16)));
            const f32x4 z0 = {bf2f((unsigned short)(ldv.x & 0xffffu)), bf2f((unsigned short)(ldv.x >> 16)), bf2f((unsigned short)(ldv.y & 0xffffu)), bf2f((unsigned short)(ldv.y >> 16))};
            const f32x4 z1 = {bf2f((unsigned short)(ldv.z & 0xffffu)), bf2f((unsigned short)(ldv.z >> 16)), bf2f((unsigned short)(ldv.w & 0xffffu)), bf2f((unsigned short)(ldv.w >> 16))};
            zacc[dk] = (c > 0) ? z0 : (f32x4){0.f, 0.f, 0.f, 0.f}; zacc[dk + 1] = (c > 0) ? z1 : (f32x4){0.f, 0.f, 0.f, 0.f}; }
#pragma unroll
        for (int dk = 0; dk < 8; ++dk) {
            lds_w4(Zt + (16 * w + fr) * 136 + 16 * dk + 4 * fq, zacc[dk]); }
        asm volatile("s_waitcnt lgkmcnt(0)" ::: "memory");
        {
            const LAS bf16_t* Vw = Vt + (16 * w) * 72; const LAS bf16_t* Zw = Zt + (16 * w) * 136;
#pragma unroll
            for (int mi = 0; mi < 4; ++mi) {
                f32x4 o = mm_tile(Sc + mi * 16 * 72, 72, Vw, 72, 2, (f32x4){0.f, 0.f, 0.f, 0.f}, fr, fq);
                o = mm_tile(Qd + mi * 16 * 136, 136, Zw, 136, 4, o, fr, fq);
                LAS float* op = Of + (16 * mi + 4 * fq) * 132 + 16 * w + fr; op[0] = o.x; op[132] = o.y; op[264] = o.z; op[396] = o.w;
            }
            asm volatile("s_waitcnt lgkmcnt(0)" ::: "memory");
#pragma unroll
            for (int dk = 0; dk < 8; ++dk) {
                f32x4 zn = mm_tile(Kpt + dk * 16 * 72, 72, Vw, 72, 2, zacc[dk], fr, fq);
                const f32x4 g4 = *(const LAS f32x4*)(gl + 16 * dk + 4 * fq);
                zn = zn * g4; zacc[dk] = zn;
                lds_w4(Zt + (16 * w + fr) * 136 + 16 * dk + 4 * fq, zn);
            }
        }
        if (c < 31) {
#pragma unroll
            for (int dk = 0; dk < 8; dk += 2) { u32x4 pv; pv.x = pk2(zacc[dk].x, zacc[dk].y); pv.y = pk2(zacc[dk].z, zacc[dk].w); pv.z = pk2(zacc[dk + 1].x, zacc[dk + 1].y); pv.w = pk2(zacc[dk + 1].z, zacc[dk + 1].w);
                ho_store(hb, (unsigned)(((w * 64 + lane) * 4 + (dk >> 1)) * 16), __builtin_bit_cast(f32x4, pv)); }
            asm volatile("s_waitcnt vmcnt(0)" ::: "memory");
        }
        __syncthreads();
        if (c < 31 && w == 0 && lane == 0) __hip_atomic_store(flag, (unsigned)(c + 1), __ATOMIC_RELAXED, __HIP_MEMORY_SCOPE_AGENT);
        for (int t = w; t < 64; t += NWAVES) {
            const float o0 = Of[t * 132 + lane], o1 = Of[t * 132 + lane + 64];
            const float ss = wsum(o0 * o0 + o1 * o1), rs = 1.0f / sqrtf(ss * (1.0f / 128.0f) + 1e-6f);
            bf16_t* gp = P + (size_t)(t0 + t) * P1LD + 3072 + h * 128;
            const float g0 = bf2f(gp[lane]), g1 = bf2f(gp[lane + 64]);
            gp[lane] = (bf16_t)f2bf(o0 * rs * onorm[lane] * siluf_(g0)); gp[lane + 64] = (bf16_t)f2bf(o1 * rs * onorm[lane + 64] * siluf_(g1));
        }
    }
}

__device__ __forceinline__ float tanh_fast(float x) { const float e = __expf(2.f * x); return 1.f - 2.f / (1.f + e); }
struct RwkvLd { u32x4 cu, pv; };
__device__ __forceinline__ RwkvLd rwkv_ld8(const bf16_t* Pc, int t, int gc, const bf16_t* hal) {
    const bf16_t* src = Pc + (size_t)t * P0LD + gc; const bf16_t* psrc = (t > 0) ? src - P0LD : hal + (gc - 2048);
    RwkvLd r; r.cu = *(const u32x4*)src; r.pv = *(const u32x4*)psrc; return r;
}
__device__ __forceinline__ void rwkv_sh8(const RwkvLd& ld, int t, int gc, bool first_zero, const float* mu, float (&sh)[8]) {
    const f32x4 m0 = *(const f32x4*)(mu + gc - 2048), m1 = *(const f32x4*)(mu + gc - 2048 + 4);
    const unsigned cw_[4] = {ld.cu.x, ld.cu.y, ld.cu.z, ld.cu.w}, pw_[4] = {ld.pv.x, ld.pv.y, ld.pv.z, ld.pv.w};
    const float mv[8] = {m0.x, m0.y, m0.z, m0.w, m1.x, m1.y, m1.z, m1.w};
    float cur[8];
#pragma unroll
    for (int e = 0; e < 8; ++e) {
        cur[e] = bf2f((unsigned short)((e & 1) ? (cw_[e >> 1] >> 16) : (cw_[e >> 1] & 0xffffu)));
        const float pg = bf2f((unsigned short)((e & 1) ? (pw_[e >> 1] >> 16) : (pw_[e >> 1] & 0xffffu)));
        const float prv = (t == 0 && first_zero) ? 0.f : pg;
        sh[e] = cur[e] + mv[e] * (prv - cur[e]);
    }
}
__device__ __forceinline__ void scan_rwkv3(const Frame& F, int b, int h, int par) {
    const int lane0 = lane_id_v(); const int w = F.wave;
    LAS unsigned char* L = F.lds;
    LAS bf16_t* RPb = (LAS bf16_t*)(L + 0);
    LAS bf16_t* KPb = (LAS bf16_t*)(L + 9216);
    LAS float* LWf = (LAS float*)(L + 18432);
    LAS float* Af = (LAS float*)(L + 34816);
    LAS float* segs = (LAS float*)(L + 51200);
    LAS bf16_t* Mak = (LAS bf16_t*)(L + 0);
    LAS bf16_t* Mrk = (LAS bf16_t*)(L + 9216);
    LAS bf16_t* Mrbn = (LAS bf16_t*)(L + 18432);
    LAS bf16_t* Aoff = (LAS bf16_t*)(L + 27648);
    LAS float* Adg = (LAS float*)(L + 36864);
    LAS bf16_t* Dg = (LAS bf16_t*)(L + 41216);
    LAS bf16_t* GB = (LAS bf16_t*)(L + 44288);
    LAS bf16_t* TL = (LAS bf16_t*)(L + 65536);
    LAS bf16_t* AL = (LAS bf16_t*)(L + 65536 + 9216);
    LAS bf16_t* SG = (LAS bf16_t*)(L + 65536 + 18432);
    LAS bf16_t* At = (LAS bf16_t*)(L + 65536);
    LAS bf16_t* Btl = (LAS bf16_t*)(L + 65536 + 9216);
    LAS bf16_t* Ktl = (LAS bf16_t*)(L + 65536 + 18432);
    LAS bf16_t* Rtl = (LAS bf16_t*)(L + 65536 + 27648);
    LAS float* Of = (LAS float*)(L + 65536);
    LAS bf16_t* BtTn = (LAS bf16_t*)(L + 102400);
    LAS bf16_t* KtT = (LAS bf16_t*)(L + 111616);
    LAS bf16_t* Vt = (LAS bf16_t*)(L + 120832);
    LAS bf16_t* Zt = (LAS bf16_t*)(L + 130048);
    LAS bf16_t* PU = (LAS bf16_t*)(L + 139264);
    LAS float* bonus = (LAS float*)(L + 148480);
    LAS float* glv = bonus + 64;
    static_assert(148480 + 4096 <= LDS_MISC, "rwkv3 LDS");
    bf16_t* P = (bf16_t*)(F.ws + WS_BIG + BIG_PROJ);
    const bf16_t* LW = (const bf16_t*)(F.ws + WS_LORA);
    const bf16_t* HALO = (const bf16_t*)(F.ws + WS_HALOB);
    const HoBuf hb = ho_buf((float*)(F.ws + WS_HOB) + (size_t)(b * 8 + h) * 4096, 16384);
    unsigned* flag = (unsigned*)(F.ws + WS_FLAGS) + (b * 8 + h); unsigned* tmo = (unsigned*)(F.ws + WS_FLAGS) + 255;
    const float* mu = F.in[IN_AB_MU];
    const float kkj = F.in[IN_AB_KK][h * 64 + lane0], kaj = F.in[IN_AB_KA][h * 64 + lane0], rkj = F.in[IN_AB_RK][h * 64 + lane0];
    const float lnw = F.in[IN_AB_LNW][h * 64 + lane0], lnb = F.in[IN_AB_LNB][h * 64 + lane0];
    float w0q[2], a0q[2];
#pragma unroll
    for (int q = 0; q < 2; ++q) { const int jq = ((2 * w + q) & 3) * 16 + (lane0 & 15); w0q[q] = F.in[IN_AB_W0][h * 64 + jq]; a0q[q] = F.in[IN_AB_A0][h * 64 + jq]; }
    bf16x8 yw[2][2], ya[2][2], yg[2][4];
#pragma unroll
    for (int q = 0; q < 2; ++q) { const int jrow = h * 64 + ((2 * w + q) & 3) * 16 + (lane0 & 15), fq0 = lane0 >> 4;
#pragma unroll
        for (int ksx = 0; ksx < 2; ++ksx) { yw[q][ksx] = *(const bf16x8*)(LW + (size_t)jrow * 64 + ksx * 32 + fq0 * 8); ya[q][ksx] = *(const bf16x8*)(LW + 512 * 64 + (size_t)jrow * 64 + ksx * 32 + fq0 * 8); }
#pragma unroll
        for (int ksx = 0; ksx < 4; ++ksx) yg[q][ksx] = *(const bf16x8*)(LW + 2 * 512 * 64 + (size_t)jrow * 128 + ksx * 32 + fq0 * 8); }
    f32x4 zacc[4];
#pragma unroll
    for (int i = 0; i < 4; ++i) zacc[i] = (f32x4){0.f, 0.f, 0.f, 0.f};
    for (int i = w * 64 + lane0; i < (64 * 72 * 2) / 2; i += NTHREADS) ((LAS unsigned*)Zt)[i] = 0u;
    __syncthreads();
    for (int c = par; c < 32; c += 2) {
        int lane = lane0; asm volatile("" : "+v"(lane));
        const int tid = w * 64 + lane, fr = lane & 15, fq = lane >> 4;
        const int t0 = b * TS + c * 64;
        {
            const bf16_t* Pc = P + (size_t)t0 * P0LD; const bf16_t* hal = HALO + (size_t)(b * 32 + (c > 0 ? c - 1 : 0)) * 1792; const bool fz = (c == 0);
            const int t_a0 = tid >> 4, cg_a0 = tid & 15, t_a1 = (tid + NTHREADS) >> 4, cg_a1 = (tid + NTHREADS) & 15, t_b = tid >> 3, cg_b = tid & 7;
            const int gc0 = ((cg_a0 < 8) ? 2048 : 2560) + h * 64 + (cg_a0 & 7) * 8, gc1 = ((cg_a1 < 8) ? 2048 : 2560) + h * 64 + (cg_a1 & 7) * 8;
            const int gc2 = 3584 + cg_b * 8, gc3 = 3648 + cg_b * 8, gc4 = 3712 + cg_a0 * 8, gc5 = 3712 + cg_a1 * 8;
            const RwkvLd l0 = rwkv_ld8(Pc, t_a0, gc0, hal), l1 = rwkv_ld8(Pc, t_a1, gc1, hal), l2 = rwkv_ld8(Pc, t_b, gc2, hal), l3 = rwkv_ld8(Pc, t_b, gc3, hal), l4 = rwkv_ld8(Pc, t_a0, gc4, hal), l5 = rwkv_ld8(Pc, t_a1, gc5, hal);
            const int vcol = tid & 63, vtg = tid >> 6;
            const bf16_t* vsrc = Pc + (size_t)(8 * vtg) * P0LD + 3072 + h * 64 + vcol;
            unsigned short vr[9];
#pragma unroll
            for (int i = 0; i < 8; ++i) vr[i + 1] = vsrc[(size_t)i * P0LD];
            vr[0] = *((vtg > 0) ? vsrc - P0LD : hal + 1024 + h * 64 + vcol);
            float sh[8];
            { rwkv_sh8(l0, t_a0, gc0, fz, mu, sh);
              *(LAS u32x4*)((cg_a0 < 8 ? RPb : KPb) + t_a0 * 72 + (cg_a0 & 7) * 8) = (u32x4){pk2(sh[0], sh[1]), pk2(sh[2], sh[3]), pk2(sh[4], sh[5]), pk2(sh[6], sh[7])}; }
            { rwkv_sh8(l1, t_a1, gc1, fz, mu, sh);
              *(LAS u32x4*)((cg_a1 < 8 ? RPb : KPb) + t_a1 * 72 + (cg_a1 & 7) * 8) = (u32x4){pk2(sh[0], sh[1]), pk2(sh[2], sh[3]), pk2(sh[4], sh[5]), pk2(sh[6], sh[7])}; }
            { rwkv_sh8(l2, t_b, gc2, fz, mu, sh);
              *(LAS u32x4*)(TL + t_b * 72 + cg_b * 8) = (u32x4){pk2(tanh_fast(sh[0]), tanh_fast(sh[1])), pk2(tanh_fast(sh[2]), tanh_fast(sh[3])), pk2(tanh_fast(sh[4]), tanh_fast(sh[5])), pk2(tanh_fast(sh[6]), tanh_fast(sh[7]))}; }
            { rwkv_sh8(l3, t_b, gc3, fz, mu, sh);
              *(LAS u32x4*)(AL + t_b * 72 + cg_b * 8) = (u32x4){pk2(sh[0], sh[1]), pk2(sh[2], sh[3]), pk2(sh[4], sh[5]), pk2(sh[6], sh[7])}; }
            { rwkv_sh8(l4, t_a0, gc4, fz, mu, sh);
              *(LAS u32x4*)(SG + t_a0 * 136 + cg_a0 * 8) = (u32x4){pk2(sigmoidf_(sh[0]), sigmoidf_(sh[1])), pk2(sigmoidf_(sh[2]), sigmoidf_(sh[3])), pk2(sigmoidf_(sh[4]), sigmoidf_(sh[5])), pk2(sigmoidf_(sh[6]), sigmoidf_(sh[7]))}; }
            { rwkv_sh8(l5, t_a1, gc5, fz, mu, sh);
              *(LAS u32x4*)(SG + t_a1 * 136 + cg_a1 * 8) = (u32x4){pk2(sigmoidf_(sh[0]), sigmoidf_(sh[1])), pk2(sigmoidf_(sh[2]), sigmoidf_(sh[3])), pk2(sigmoidf_(sh[4]), sigmoidf_(sh[5])), pk2(sigmoidf_(sh[6]), sigmoidf_(sh[7]))}; }
            {
                float cur[9];
#pragma unroll
                for (int i = 0; i < 9; ++i) cur[i] = bf2f(vr[i]);
                if (vtg == 0 && fz) cur[0] = 0.f;
                const float mvc = mu[1024 + h * 64 + vcol];
                float shv[8];
#pragma unroll
                for (int i = 0; i < 8; ++i) shv[i] = cur[i + 1] + mvc * (cur[i] - cur[i + 1]);
                *(LAS u32x4*)(Vt + vcol * 72 + 8 * vtg) = (u32x4){pk2(shv[0], shv[1]), pk2(shv[2], shv[3]), pk2(shv[4], shv[5]), pk2(shv[6], shv[7])};
            }
        }
        __syncthreads();
        f32x4 agate[2];
        {
#pragma unroll
            for (int q = 0; q < 2; ++q) {
                const int id = 2 * w + q, mi = id >> 2, nj = id & 3;
                f32x4 aw = {0.f, 0.f, 0.f, 0.f}, aa = {0.f, 0.f, 0.f, 0.f}, ag = {0.f, 0.f, 0.f, 0.f};
#pragma unroll
                for (int ksx = 0; ksx < 2; ++ksx) {
                    const bf16x8 x1 = *(const LAS bf16x8*)(TL + (mi * 16 + fr) * 72 + ksx * 32 + fq * 8), x2 = *(const LAS bf16x8*)(AL + (mi * 16 + fr) * 72 + ksx * 32 + fq * 8);
                    aw = MFMA32(x1, yw[q][ksx], aw); aa = MFMA32(x2, ya[q][ksx], aa);
                }
#pragma unroll
                for (int ksx = 0; ksx < 4; ++ksx) {
                    const bf16x8 x3 = *(const LAS bf16x8*)(SG + (mi * 16 + fr) * 136 + ksx * 32 + fq * 8);
                    ag = MFMA32(x3, yg[q][ksx], ag);
                }
                agate[q] = ag;
                const int j = nj * 16 + fr; const float w0j = w0q[q], a0j = a0q[q];
                const float awv[4] = {aw.x, aw.y, aw.z, aw.w}, aav[4] = {aa.x, aa.y, aa.z, aa.w};
#pragma unroll
                for (int rg = 0; rg < 4; ++rg) { const int t = mi * 16 + 4 * fq + rg;
                    LWf[t * 64 + j] = -0.6065306597126334f * sigmoidf_(w0j + awv[rg]); Af[t * 64 + j] = sigmoidf_(a0j + aav[rg]); }
            }
        }
        __syncthreads();
        {
            float g[8]; float run = 0.f;
#pragma unroll
            for (int i = 0; i < 8; ++i) { run += LWf[(8 * w + i) * 64 + lane]; g[i] = run; }
            segs[w * 64 + lane] = run;
            __syncthreads();
            float off = 0.f;
#pragma unroll
            for (int s2 = 0; s2 < 7; ++s2) if (s2 < w) off += segs[s2 * 64 + lane];
#pragma unroll
            for (int i = 0; i < 8; ++i) LWf[(8 * w + i) * 64 + lane] = off + g[i];
        }
        __syncthreads();
        {
            const int j = lane;
            float btn[8], ktt[8];
#pragma unroll
            for (int i = 0; i < 8; ++i) {
                const int t = 8 * w + i;
                const float kv = bf2f(KPb[t * 72 + j]), rv = bf2f(RPb[t * 72 + j]), a = Af[t * 64 + j], G = LWf[t * 64 + j];
                const float Gp = (t > 0) ? LWf[(t - 1) * 64 + j] : 0.f;
                const float kx = kv * kkj; const float ss = wsum(kx * kx); const float kk = kx * (1.0f / sqrtf(ss + 1e-6f));
                const float km = kv * (1.f + (a - 1.f) * kaj);
                const float bs = wsum(rv * km * rkj); if (j == 0) bonus[t] = bs;
                const float eG = __expf(G), eGi = __expf(-G), eGp = __expf(Gp);
                const float bt = kk * a * eGi, kt = km * eGi;
                At[t * 72 + j] = (bf16_t)f2bf(kk * eGp); Btl[t * 72 + j] = (bf16_t)f2bf(bt); Ktl[t * 72 + j] = (bf16_t)f2bf(kt); Rtl[t * 72 + j] = (bf16_t)f2bf(rv * eG);
                btn[i] = -bt; ktt[i] = kt;
                if (t == 63) glv[j] = eG;
            }
            *(LAS u32x4*)(BtTn + j * 72 + 8 * w) = (u32x4){pk2(btn[0], btn[1]), pk2(btn[2], btn[3]), pk2(btn[4], btn[5]), pk2(btn[6], btn[7])};
            *(LAS u32x4*)(KtT + j * 72 + 8 * w) = (u32x4){pk2(ktt[0], ktt[1]), pk2(ktt[2], ktt[3]), pk2(ktt[4], ktt[5]), pk2(ktt[6], ktt[7])};
        }
        __syncthreads();
        {
            for (int job = w; job < 64; job += NWAVES) {
                const int mat = job >> 4, bi = (job >> 2) & 3, bj = job & 3;
                LAS bf16_t* dst = (mat == 0) ? Aoff : (mat == 1 ? Mak : (mat == 2 ? Mrk : Mrbn));
                const int i = 16 * bi + fr, j0 = 16 * bj + 4 * fq;
                f32x4 o = {0.f, 0.f, 0.f, 0.f};
                if (bj <= bi) {
                    const LAS bf16_t* Aj = ((mat == 0 || mat == 3) ? Btl : Ktl) + bj * 16 * 72; const LAS bf16_t* Bi = ((mat < 2) ? At : Rtl) + bi * 16 * 72;
                    const f32x4 acc = mm_tile(Aj, 72, Bi, 72, 2, (f32x4){0.f, 0.f, 0.f, 0.f}, fr, fq);
                    const bool incl = mat >= 2;
                    o.x = (incl ? (j0 <= i) : (j0 < i)) ? acc.x : 0.f; o.y = (incl ? (j0 + 1 <= i) : (j0 + 1 < i)) ? acc.y : 0.f;
                    o.z = (incl ? (j0 + 2 <= i) : (j0 + 2 < i)) ? acc.z : 0.f; o.w = (incl ? (j0 + 3 <= i) : (j0 + 3 < i)) ? acc.w : 0.f;
                    if (mat == 0 && bi == bj) { LAS float* dd = Adg + (bi * 16 + fr) * 17 + 4 * fq; dd[0] = o.x; dd[1] = o.y; dd[2] = o.z; dd[3] = o.w; o = (f32x4){0.f, 0.f, 0.f, 0.f}; }
                    if (mat == 0 || mat == 3) o = -o;
                }
                lds_w4(dst + i * 72 + j0, o);
            }
#pragma unroll
            for (int q = 0; q < 2; ++q) { const int id = 2 * w + q, mi = id >> 2, nj = id & 3; const int j = nj * 16 + fr; const float gv[4] = {agate[q].x, agate[q].y, agate[q].z, agate[q].w};
#pragma unroll
                for (int rg = 0; rg < 4; ++rg) GB[(mi * 16 + 4 * fq + rg) * 64 + j] = (bf16_t)f2bf(gv[rg]); }
        }
        __syncthreads();
        f32x4 ot[4];
        if (c > 0) ho_wait(flag, (unsigned)c, tmo, w, lane);
        if (w < 4) {
#pragma unroll
            for (int kb = 0; kb < 4; ++kb) { { const f32x4 ld = ho_load(hb, (unsigned)(((w * 64 + lane) * 4 + kb) * 16)); zacc[kb] = (c > 0) ? ld : (f32x4){0.f, 0.f, 0.f, 0.f}; }
                lds_w4(Zt + (16 * w + fr) * 72 + 16 * kb + 4 * fq, zacc[kb]); }
            asm volatile("s_waitcnt lgkmcnt(0)" ::: "memory");
        }
        if (w < 4) {
            {
                const int bb = lane >> 4, jj = lane & 15; float x[16]; const LAS float* a = Adg + bb * 16 * 17;
#pragma unroll
                for (int i = 0; i < 16; ++i) { float v = (i == jj) ? 1.f : 0.f;
#pragma unroll
                    for (int k = 0; k < i; ++k) v -= a[i * 17 + k] * x[k];
                    x[i] = v; Dg[(bb * 16 + i) * 24 + jj] = (bf16_t)f2bf(v); }
                asm volatile("s_waitcnt lgkmcnt(0)" ::: "memory");
            }
            const LAS bf16_t* Vw = Vt + (16 * w) * 72; const LAS bf16_t* Zw = Zt + (16 * w) * 72; LAS bf16_t* PUw = PU + (16 * w) * 72;
            f32x4 p[4];
#pragma unroll
            for (int mi = 0; mi < 4; ++mi) { p[mi] = mm_tile(At + mi * 16 * 72, 72, Zw, 72, 2, (f32x4){0.f, 0.f, 0.f, 0.f}, fr, fq); p[mi] = mm_tile(Mak + mi * 16 * 72, 72, Vw, 72, 2, p[mi], fr, fq); }
#pragma unroll
            for (int bb = 0; bb < 4; ++bb) {
                f32x4 acc = p[bb];
                if (bb >= 1) acc = mm_tile(Aoff + bb * 16 * 72, 72, PUw, 72, (bb + 1) / 2, acc, fr, fq);
                u32x2 pk; pk.x = pk2(acc.x, acc.y); pk.y = pk2(acc.z, acc.w);
                const bf16x4 dgf = *(const LAS bf16x4*)(Dg + (bb * 16 + fr) * 24 + 4 * fq);
                const f32x4 ub = MFMA16(dgf, __builtin_bit_cast(bf16x4, pk), ((f32x4){0.f, 0.f, 0.f, 0.f}));
                lds_w4(PUw + fr * 72 + 16 * bb + 4 * fq, ub);
                asm volatile("s_waitcnt lgkmcnt(0)" ::: "memory");
            }
#pragma unroll
            for (int mi = 0; mi < 4; ++mi) {
                f32x4 o = mm_tile(Rtl + mi * 16 * 72, 72, Zw, 72, 2, (f32x4){0.f, 0.f, 0.f, 0.f}, fr, fq);
                o = mm_tile(Mrk + mi * 16 * 72, 72, Vw, 72, 2, o, fr, fq);
                ot[mi] = mm_tile(Mrbn + mi * 16 * 72, 72, PUw, 72, 2, o, fr, fq);
            }
#pragma unroll
            for (int kb = 0; kb < 4; ++kb) {
                f32x4 zn = mm_tile(KtT + kb * 16 * 72, 72, Vw, 72, 2, zacc[kb], fr, fq);
                zn = mm_tile(BtTn + kb * 16 * 72, 72, PUw, 72, 2, zn, fr, fq);
                const f32x4 g4 = *(const LAS f32x4*)(glv + 16 * kb + 4 * fq);
                zn = zn * g4; zacc[kb] = zn;
                lds_w4(Zt + (16 * w + fr) * 72 + 16 * kb + 4 * fq, zn);
            }
        }
        if (w < 4 && c < 31) {
#pragma unroll
            for (int kb = 0; kb < 4; ++kb) ho_store(hb, (unsigned)(((w * 64 + lane) * 4 + kb) * 16), zacc[kb]);
            asm volatile("s_waitcnt vmcnt(0)" ::: "memory");
        }
        __syncthreads();
        if (c < 31 && w == 0 && lane == 0) __hip_atomic_store(flag, (unsigned)(c + 1), __ATOMIC_RELAXED, __HIP_MEMORY_SCOPE_AGENT);
        if (w < 4) {
#pragma unroll
            for (int mi = 0; mi < 4; ++mi) { LAS float* op = Of + (16 * mi + 4 * fq) * 65 + 16 * w + fr; op[0] = ot[mi].x; op[65] = ot[mi].y; op[130] = ot[mi].z; op[195] = ot[mi].w; }
        }
        __syncthreads();
        for (int t = w; t < 64; t += NWAVES) {
            const float o = Of[t * 65 + lane];
            const float mean = wsum(o) * (1.0f / 64.0f); const float dlt = o - mean; const float var = wsum(dlt * dlt) * (1.0f / 64.0f);
            float y = dlt * (1.0f / sqrtf(var + 64e-5f)) * lnw + lnb;
            y += bonus[t] * bf2f(Vt[lane * 72 + t]);
            y *= bf2f(GB[t * 64 + lane]);
            P[(size_t)(t0 + t) * P0LD + 2048 + h * 64 + lane] = (bf16_t)f2bf(y);
        }
        __syncthreads();
    }
}

__device__ __forceinline__ void attn_phase(const Frame& F, const bf16_t* Q, const bf16_t* Kb, const bf16_t* VT, bf16_t* O) {
    const int lane = lane_id_v(); const int tid = F.wave * 64 + lane; (void)tid;
    const int fr = lane & 15, fq = lane >> 4;
    for (int u = F.wg; u < 512; u += F.G) {
        const int b = u >> 6, h = (u >> 4) & 3, qb = u & 15;
        const int q0 = b * TS + qb * 128 + F.wave * 16;
        bf16x8 bq[8];
#pragma unroll
        for (int ksx = 0; ksx < 8; ++ksx) bq[ksx] = *(const bf16x8*)(Q + (size_t)(q0 + fr) * 1024 + h * 256 + ksx * 32 + fq * 8);
        f32x4 sacc[16];
#pragma unroll
        for (int tl = 0; tl < 16; ++tl) {
            f32x4 a4 = {0.f, 0.f, 0.f, 0.f};
            const bf16_t* kp = Kb + (size_t)(b * 256 + tl * 16 + fr) * 1024 + h * 256 + fq * 8;
#pragma unroll
            for (int ksx = 0; ksx < 8; ++ksx) { const bf16x8 a = *(const bf16x8*)(kp + ksx * 32); a4 = __builtin_amdgcn_mfma_f32_16x16x32_bf16(a, bq[ksx], a4, 0, 0, 0); }
            sacc[tl] = a4;
        }
        float mx = -3.0e38f;
#pragma unroll
        for (int tl = 0; tl < 16; ++tl) mx = fmaxf(mx, fmaxf(fmaxf(sacc[tl].x, sacc[tl].y), fmaxf(sacc[tl].z, sacc[tl].w)));
        mx = fmaxf(mx, __shfl_xor(mx, 16)); mx = fmaxf(mx, __shfl_xor(mx, 32));
        float l = 0.f;
        bf16x8 pb[8];
#pragma unroll
        for (int ksx = 0; ksx < 8; ++ksx) {
            const f32x4 e0 = sacc[2 * ksx], e1 = sacc[2 * ksx + 1];
            const float p0 = __expf(e0.x - mx), p1 = __expf(e0.y - mx), p2 = __expf(e0.z - mx), p3 = __expf(e0.w - mx);
            const float p4 = __expf(e1.x - mx), p5 = __expf(e1.y - mx), p6 = __expf(e1.z - mx), p7 = __expf(e1.w - mx);
            l += ((p0 + p1) + (p2 + p3)) + ((p4 + p5) + (p6 + p7));
            u32x4 w; w.x = pk2(p0, p1); w.y = pk2(p2, p3); w.z = pk2(p4, p5); w.w = pk2(p6, p7);
            pb[ksx] = __builtin_bit_cast(bf16x8, w);
        }
        l += __shfl_xor(l, 16); l += __shfl_xor(l, 32);
        const float inv = 1.0f / l;
        const bf16_t* vbase = VT + (size_t)((b * 4 + h) * 256) * 256;
#pragma unroll 4
        for (int dt = 0; dt < 16; ++dt) {
            f32x4 o4 = {0.f, 0.f, 0.f, 0.f};
            const bf16_t* vp = vbase + (size_t)(dt * 16 + fr) * 256 + 4 * fq;
#pragma unroll
            for (int ksx = 0; ksx < 8; ++ksx) {
                const u32x2 lo = *(const u32x2*)(vp + ksx * 32), hi = *(const u32x2*)(vp + ksx * 32 + 16);
                u32x4 w; w.x = lo.x; w.y = lo.y; w.z = hi.x; w.w = hi.y;
                o4 = __builtin_amdgcn_mfma_f32_16x16x32_bf16(__builtin_bit_cast(bf16x8, w), pb[ksx], o4, 0, 0, 0);
            }
            u32x2 w; w.x = pk2(o4.x * inv, o4.y * inv); w.y = pk2(o4.z * inv, o4.w * inv);
            *(u32x2*)(O + (size_t)(q0 + fr) * 1024 + h * 256 + dt * 16 + 4 * fq) = w;
        }
    }
}

__device__ __forceinline__ void attn_phase2(const Frame& F, const bf16_t* Q, const bf16_t* Kb, const bf16_t* VT, bf16_t* O) {
    const int lane = lane_id_v(); const int tid = F.wave * 64 + lane; const int fr = lane & 15, fq = lane >> 4;
    LAS bf16_t* KL = (LAS bf16_t*)F.lds;
    static_assert(256 * 264 * 2 <= LDS_MISC, "attn LDS");
    for (int u = F.wg; u < 512; u += F.G) {
        const int b = u >> 6, h = (u >> 4) & 3, qb = u & 15;
        const int q0 = b * TS + qb * 128 + F.wave * 16;
        u32x4 st[16];
#pragma unroll
        for (int n = 0; n < 16; ++n) { const int idx = tid + NTHREADS * n, row = idx >> 5, c8 = idx & 31;
            st[n] = *(const u32x4*)(Kb + (size_t)(b * 256 + row) * 1024 + h * 256 + c8 * 8); }
        bf16x8 bq[8];
#pragma unroll
        for (int ksx = 0; ksx < 8; ++ksx) bq[ksx] = *(const bf16x8*)(Q + (size_t)(q0 + fr) * 1024 + h * 256 + ksx * 32 + fq * 8);
        __syncthreads();
#pragma unroll
        for (int n = 0; n < 16; ++n) { const int idx = tid + NTHREADS * n, row = idx >> 5, c8 = idx & 31; *(LAS u32x4*)(KL + row * 264 + c8 * 8) = st[n]; }
        const bf16_t* vbase = VT + (size_t)((b * 4 + h) * 256) * 256;
#pragma unroll
        for (int n = 0; n < 16; ++n) { const int idx = tid + NTHREADS * n, row = idx >> 5, c8 = idx & 31; st[n] = *(const u32x4*)(vbase + (size_t)row * 256 + c8 * 8); }
        __syncthreads();
        f32x4 sacc[16];
#pragma unroll
        for (int tl = 0; tl < 16; ++tl) {
            f32x4 a4 = {0.f, 0.f, 0.f, 0.f};
#pragma unroll
            for (int ksx = 0; ksx < 8; ++ksx) a4 = __builtin_amdgcn_mfma_f32_16x16x32_bf16(*(const LAS bf16x8*)(KL + (tl * 16 + fr) * 264 + ksx * 32 + fq * 8), bq[ksx], a4, 0, 0, 0);
            sacc[tl] = a4;
        }
        float mx = -3.0e38f;
#pragma unroll
        for (int tl = 0; tl < 16; ++tl) mx = fmaxf(mx, fmaxf(fmaxf(sacc[tl].x, sacc[tl].y), fmaxf(sacc[tl].z, sacc[tl].w)));
        mx = fmaxf(mx, __shfl_xor(mx, 16)); mx = fmaxf(mx, __shfl_xor(mx, 32));
        float l = 0.f;
        bf16x8 pb[8];
#pragma unroll
        for (int ksx = 0; ksx < 8; ++ksx) {
            const f32x4 e0 = sacc[2 * ksx], e1 = sacc[2 * ksx + 1];
            const float p0 = __expf(e0.x - mx), p1 = __expf(e0.y - mx), p2 = __expf(e0.z - mx), p3 = __expf(e0.w - mx);
            const float p4 = __expf(e1.x - mx), p5 = __expf(e1.y - mx), p6 = __expf(e1.z - mx), p7 = __expf(e1.w - mx);
            l += ((p0 + p1) + (p2 + p3)) + ((p4 + p5) + (p6 + p7));
            u32x4 w; w.x = pk2(p0, p1); w.y = pk2(p2, p3); w.z = pk2(p4, p5); w.w = pk2(p6, p7);
            pb[ksx] = __builtin_bit_cast(bf16x8, w);
        }
        l += __shfl_xor(l, 16); l += __shfl_xor(l, 32);
        const float inv = 1.0f / l;
        __syncthreads();
#pragma unroll
        for (int n = 0; n < 16; ++n) { const int idx = tid + NTHREADS * n, row = idx >> 5, c8 = idx & 31; *(LAS u32x4*)(KL + row * 264 + c8 * 8) = st[n]; }
        __syncthreads();
#pragma unroll 4
        for (int dt = 0; dt < 16; ++dt) {
            f32x4 o4 = {0.f, 0.f, 0.f, 0.f};
            const LAS bf16_t* vp = KL + (dt * 16 + fr) * 264 + 4 * fq;
#pragma unroll
            for (int ksx = 0; ksx < 8; ++ksx) {
                const u32x2 lo = *(const LAS u32x2*)(vp + ksx * 32), hi = *(const LAS u32x2*)(vp + ksx * 32 + 16);
                u32x4 w; w.x = lo.x; w.y = lo.y; w.z = hi.x; w.w = hi.y;
                o4 = __builtin_amdgcn_mfma_f32_16x16x32_bf16(__builtin_bit_cast(bf16x8, w), pb[ksx], o4, 0, 0, 0);
            }
            u32x2 w; w.x = pk2(o4.x * inv, o4.y * inv); w.y = pk2(o4.z * inv, o4.w * inv);
            *(u32x2*)(O + (size_t)(q0 + fr) * 1024 + h * 256 + dt * 16 + 4 * fq) = w;
        }
    }
    __syncthreads();
}

__device__ __forceinline__ void router_phase(const Frame& F, int layer) {
    const int lane = lane_id_v(); const int tid = F.wave * 64 + lane; (void)tid;
    const float* XF = F.out; const float* gain = F.in[IN_NORM_FFN] + layer * 1024;
    const float* wg = F.in[IN_MOE_WG] + (size_t)layer * 1024 * 4; const float* we = F.in[IN_MOE_WE] + (size_t)layer * 1024 * 16;
    const float* bg = F.in[IN_MOE_BG] + layer * 4; const float* be = F.in[IN_MOE_BE] + layer * 16;
    unsigned* cnt = (unsigned*)(F.ws + WS_CNT) + layer * 32;
    int* tokb = (int*)(F.ws + WS_ROUTE); int* tokp = tokb + NT; f32x4* tokg = (f32x4*)(tokp + NT);
    const int gw = F.wg * NWAVES + F.wave, NGW = F.G * NWAVES;
    for (int row = gw; row < NT; row += NGW) {
        const f32x4* xr = (const f32x4*)(XF + (size_t)row * 1024) + lane;
        float s = 0.f, lg[4], le[16];
#pragma unroll
        for (int c = 0; c < 4; ++c) lg[c] = 0.f;
#pragma unroll
        for (int c = 0; c < 16; ++c) le[c] = 0.f;
#pragma unroll 1
        for (int j = 0; j < 4; ++j) {
            const f32x4 v = xr[64 * j]; s += (v.x * v.x + v.y * v.y) + (v.z * v.z + v.w * v.w);
            const int k0 = 4 * lane + 256 * j; const f32x4 g = *(const f32x4*)(gain + k0);
            const float xv[4] = {v.x * g.x, v.y * g.y, v.z * g.z, v.w * g.w};
#pragma unroll
            for (int q = 0; q < 4; ++q) {
                const f32x4 a = *(const f32x4*)(wg + (size_t)(k0 + q) * 4);
                lg[0] += xv[q] * a.x; lg[1] += xv[q] * a.y; lg[2] += xv[q] * a.z; lg[3] += xv[q] * a.w;
#pragma unroll
                for (int e4 = 0; e4 < 4; ++e4) { const f32x4 w = *(const f32x4*)(we + (size_t)(k0 + q) * 16 + 4 * e4);
                    le[4 * e4] += xv[q] * w.x; le[4 * e4 + 1] += xv[q] * w.y; le[4 * e4 + 2] += xv[q] * w.z; le[4 * e4 + 3] += xv[q] * w.w; }
            }
        }
        s = wave_sum(s);
        const float rstd = 1.0f / sqrtf(s * (1.0f / 1024.0f) + 1e-6f);
#pragma unroll
        for (int c = 0; c < 4; ++c) lg[c] = wave_sum(lg[c]) * rstd + bg[c];
#pragma unroll
        for (int c = 0; c < 16; ++c) le[c] = wave_sum(le[c]) * rstd + be[c];
        int gs = 0; float gm = lg[0];
#pragma unroll
        for (int c = 1; c < 4; ++c) if (lg[c] > gm) { gm = lg[c]; gs = c; }
        float gz = 0.f;
#pragma unroll
        for (int c = 0; c < 4; ++c) gz += __expf(lg[c] - gm);
        const float ggate = 1.0f / gz;
        float l4[4];
#pragma unroll
        for (int c = 0; c < 4; ++c) { float v = le[c];
#pragma unroll
            for (int g2 = 1; g2 < 4; ++g2) v = (gs == g2) ? le[4 * g2 + c] : v;
            l4[c] = v; }
        int i0 = 0; float m0 = l4[0];
#pragma unroll
        for (int c = 1; c < 4; ++c) if (l4[c] > m0) { m0 = l4[c]; i0 = c; }
        int i1 = -1; float m1 = -3.0e38f;
#pragma unroll
        for (int c = 0; c < 4; ++c) if (c != i0 && l4[c] > m1) { m1 = l4[c]; i1 = c; }
        const float e1 = __expf(m1 - m0); const float g0 = ggate / (1.f + e1), g1 = ggate * e1 / (1.f + e1);
        const int ia = i0 < i1 ? i0 : i1, ib = i0 < i1 ? i1 : i0;
        const float ga = i0 < i1 ? g0 : g1, gb = i0 < i1 ? g1 : g0;
        const int pidx = (ia == 0) ? (ib - 1) : (ia == 1 ? ib + 1 : 5);
        const int bucket = gs * 6 + pidx;
        if (lane == 0) {
            const unsigned pos = atomicAdd(&cnt[bucket], 1u);
            tokb[row] = bucket; tokp[row] = (int)pos; tokg[row] = (f32x4){rstd, ga, gb, 0.f};
        }
    }
}
typedef float f32x16 __attribute__((ext_vector_type(16)));
__device__ __forceinline__ void router_phase2(const Frame& F, int layer) {
    const int lane = lane_id_v(); const int tid = F.wave * 64 + lane; const int w = F.wave;
    const float* XF = F.out; const float* rw = (const float*)(F.ws + WS_RW) + (size_t)layer * 1024 * 32;
    const float* ssp = (const float*)(F.ws + WS_SSP);
    unsigned* cnt = (unsigned*)(F.ws + WS_CNT) + layer * 32;
    int* tokb = (int*)(F.ws + WS_ROUTE); int* tokp = tokb + NT; f32x4* tokg = (f32x4*)(tokp + NT);
    LAS float* T = (LAS float*)F.lds + w * (32 * 132);
    LAS float* Pp = (LAS float*)F.lds;
    LAS float* Lg = Pp + 8 * 64 * 33;
    const int i31 = lane & 31, kh = lane >> 5, k0 = 128 * w;
    float bW[64];
#pragma unroll
    for (int s2 = 0; s2 < 64; ++s2) bW[s2] = rw[(size_t)(k0 + 2 * s2 + kh) * 32 + i31];
    for (int blk = F.wg; blk < NT / 64; blk += F.G) {
        const int r0 = blk * 64;
        f32x16 acc0, acc1;
#pragma unroll
        for (int e = 0; e < 16; ++e) { acc0[e] = 0.f; acc1[e] = 0.f; }
#pragma unroll
        for (int rt = 0; rt < 2; ++rt) {
#pragma unroll
            for (int n = 0; n < 16; ++n) { const int idx = lane + 64 * n, row = idx >> 5, c4 = idx & 31;
                const f32x4 v = *(const f32x4*)(XF + (size_t)(r0 + 32 * rt + row) * 1024 + k0 + 4 * c4);
                *(LAS f32x4*)(T + row * 132 + 4 * c4) = v; }
            asm volatile("s_waitcnt lgkmcnt(0)" ::: "memory");
#pragma unroll
            for (int s2 = 0; s2 < 64; ++s2) {
                const float a0 = T[i31 * 132 + 2 * s2 + kh];
                if (rt == 0) acc0 = __builtin_amdgcn_mfma_f32_32x32x2f32(a0, bW[s2], acc0, 0, 0, 0);
                else acc1 = __builtin_amdgcn_mfma_f32_32x32x2f32(a0, bW[s2], acc1, 0, 0, 0);
            }
            asm volatile("s_waitcnt lgkmcnt(0)" ::: "memory");
        }
        __syncthreads();
#pragma unroll
        for (int e = 0; e < 16; ++e) { const int row = (e & 3) + 8 * (e >> 2) + 4 * kh;
            Pp[(w * 64 + row) * 33 + i31] = acc0[e]; Pp[(w * 64 + 32 + row) * 33 + i31] = acc1[e]; }
        __syncthreads();
        for (int idx = tid; idx < 64 * 32; idx += NTHREADS) { const int row = idx >> 5, cc = idx & 31; float a = 0.f;
#pragma unroll
            for (int ww = 0; ww < 8; ++ww) a += Pp[(ww * 64 + row) * 33 + cc];
            Lg[row * 33 + cc] = a; }
        __syncthreads();
        if (tid < 64) {
            const int row = r0 + tid; const float rstd = row_rstd(ssp, row);
            const float* bg = F.in[IN_MOE_BG] + layer * 4; const float* be = F.in[IN_MOE_BE] + layer * 16;
            float lg[4], le[16];
#pragma unroll
            for (int c2 = 0; c2 < 4; ++c2) lg[c2] = Lg[tid * 33 + c2] * rstd + bg[c2];
#pragma unroll
            for (int c2 = 0; c2 < 16; ++c2) le[c2] = Lg[tid * 33 + 4 + c2] * rstd + be[c2];
            int gs = 0; float gm = lg[0];
#pragma unroll
            for (int c2 = 1; c2 < 4; ++c2) if (lg[c2] > gm) { gm = lg[c2]; gs = c2; }
            float gz = 0.f;
#pragma unroll
            for (int c2 = 0; c2 < 4; ++c2) gz += __expf(lg[c2] - gm);
            const float ggate = 1.0f / gz;
            float l4[4];
#pragma unroll
            for (int c2 = 0; c2 < 4; ++c2) { float v = le[c2];
#pragma unroll
                for (int g2 = 1; g2 < 4; ++g2) v = (gs == g2) ? le[4 * g2 + c2] : v;
                l4[c2] = v; }
            int i0 = 0; float m0 = l4[0];
#pragma unroll
            for (int c2 = 1; c2 < 4; ++c2) if (l4[c2] > m0) { m0 = l4[c2]; i0 = c2; }
            int i1 = -1; float m1 = -3.0e38f;
#pragma unroll
            for (int c2 = 0; c2 < 4; ++c2) if (c2 != i0 && l4[c2] > m1) { m1 = l4[c2]; i1 = c2; }
            const float e1 = __expf(m1 - m0); const float g0 = ggate / (1.f + e1), g1 = ggate * e1 / (1.f + e1);
            const int ia = i0 < i1 ? i0 : i1, ib = i0 < i1 ? i1 : i0;
            const float ga = i0 < i1 ? g0 : g1, gb = i0 < i1 ? g1 : g0;
            const int pidx = (ia == 0) ? (ib - 1) : (ia == 1 ? ib + 1 : 5);
            const int bucket = gs * 6 + pidx;
            const unsigned pos = atomicAdd(&cnt[bucket], 1u);
            tokb[row] = bucket; tokp[row] = (int)pos; tokg[row] = (f32x4){rstd, ga, gb, 0.f};
        }
        __syncthreads();
    }
}
__device__ __forceinline__ void gather_phase(const Frame& F, int layer) {
    const int lane = lane_id_v(); const int tid = F.wave * 64 + lane; (void)tid;
    const unsigned* cnt = (const unsigned*)(F.ws + WS_CNT) + layer * 32;
    const int* tokb = (const int*)(F.ws + WS_ROUTE); const int* tokp = tokb + NT; const f32x4* tokg = (const f32x4*)(tokp + NT); f32x4* rowinfo = (f32x4*)(tokg + NT);
    const bf16_t* XB = (const bf16_t*)(F.ws + WS_XB); bf16_t* XG = (bf16_t*)(F.ws + WS_BIG + BIG_XG);
    LAS int* off = (LAS int*)F.lds;
    if (tid == 0) { int acc = 0; for (int b = 0; b < 24; ++b) { off[b] = acc * 256; acc += ((int)cnt[b] + 255) >> 8; } }
    __syncthreads();
    const int gw = F.wg * NWAVES + F.wave, NGW = F.G * NWAVES;
    for (int tok = gw; tok < NT; tok += NGW) {
        const int row = off[tokb[tok]] + tokp[tok];
        const u32x4* src = (const u32x4*)(XB + (size_t)tok * 1024) + lane; u32x4* dst = (u32x4*)(XG + (size_t)row * 1024) + lane;
        dst[0] = src[0]; dst[64] = src[64];
        if (lane == 0) { f32x4 g = tokg[tok]; g.w = __int_as_float(tok); rowinfo[row] = g; }
    }
    __syncthreads();
}
__device__ __forceinline__ void final_phase(const Frame& F) {
    const int lane = lane_id_v(); const int tid = F.wave * 64 + lane; (void)tid;
    float* XF = F.out; const float* gain = F.in[IN_NORM_FINAL];
    const int gw = F.wg * NWAVES + F.wave, NGW = F.G * NWAVES;
    for (int row = gw; row < NT; row += NGW) {
        f32x4* xr = (f32x4*)(XF + (size_t)row * 1024) + lane;
        f32x4 v[4]; float s = 0.f;
#pragma unroll
        for (int j = 0; j < 4; ++j) { v[j] = xr[64 * j]; s += (v[j].x * v[j].x + v[j].y * v[j].y) + (v[j].z * v[j].z + v[j].w * v[j].w); }
        s = wave_sum(s);
        const float rstd = 1.0f / sqrtf(s * (1.0f / 1024.0f) + 1e-6f);
#pragma unroll
        for (int j = 0; j < 4; ++j) { const f32x4 g = *(const f32x4*)(gain + 4 * lane + 256 * j); xr[64 * j] = v[j] * rstd * g; }
    }
}

constexpr int N_PHASES = 24;
#ifndef PH_MASK
#define PH_MASK 0xFFFFFFFFu
#endif
#define IN(k) (((PH_MASK >> ((k) > 11 ? (k) - 11 : (k))) & 1u) && lo <= (k) && (k) < hi)
#define TS_STAMP(k) do { if (TS_A >= 0 && ((k) == TS_A || (k) == TS_B) && F.wg == 0 && F.wave == 0 && lane_id_v() == 0) ((volatile LAS unsigned*)(F.lds + LDS_MISC + 1024))[(k)] = (unsigned)__builtin_amdgcn_s_memrealtime(); } while (0)
#define SEAM(k) do { if (IN(k) && IN((k) + 1)) xcd_barrier(bar); TS_STAMP((k) + 1); } while (0)
#define SEAM2(k) do { if (IN(k) && IN((k) + 2)) xcd_barrier(bar); TS_STAMP((k) + 2); } while (0)

template <int LAYER>
__device__ __forceinline__ void layer_phases(const Frame& F, const XcdBarrier& bar, const int lo, const int hi) {
    constexpr int pb = LAYER * 11;
    unsigned char* const ws = F.ws;
#define WPTR(off) ((bf16_t*)(ws + (LAYER ? WS_W1 : WS_W0)) + (off))
#define XB_ ((bf16_t*)(ws + WS_XB))
#define SSP_ ((float*)(ws + WS_SSP))
#define PROJ_ ((bf16_t*)(ws + WS_BIG + BIG_PROJ))
#define KB_ (LAYER ? (bf16_t*)(ws + WS_W0) : (bf16_t*)(ws + WS_BIG + BIG_KV0))
#define VT_ (KB_ + (size_t)2048 * 1024)
#define QB_ ((bf16_t*)(ws + WS_BIG + BIG_Q))
#define ATT_ ((bf16_t*)(ws + WS_BIG + BIG_ATT))
#define XG_ ((bf16_t*)(ws + WS_BIG + BIG_XG))
#define HID_ ((bf16_t*)(ws + WS_BIG + BIG_HID))
#define CNT_ ((const unsigned*)(ws + WS_CNT) + LAYER * 32)
#define ROWINFO_ ((const f32x4*)(ws + WS_ROUTE + (size_t)NT * 8 + (size_t)NT * 16))
    if (IN(pb + 1)) {
        if (LAYER == 0) {
            pg8::Gemm g{1024, 1024, 1024, 1 << 20}; pg8::DenseSched S; S.init(NT, 3840, F.G, F.wg, XB_, 1024, WPTR(WO_WIN), 1024);
            EpiScale<0> E{PROJ_, P0LD, SSP_, 1.0f, nullptr, (bf16_t*)(ws + WS_HALOB)};
            pg8::gemm_phase(F.lds, F.wave, g, S, E);
        } else {
            pg8::Gemm g{1024, 1024, 1024, 1 << 20}; pg8::DenseSched S; S.init(NT, 4096, F.G, F.wg, XB_, 1024, WPTR(WO_WIN), 1024);
            EpiScale<1> E{PROJ_, P1LD, SSP_, 1.0f, (const float*)(ws + WS_LB), nullptr};
            pg8::gemm_phase(F.lds, F.wave, g, S, E);
        }
        if (LAYER == 1) { pg8::Gemm g{1024, 1024, 1024, 1 << 20}; pg8::DenseSched S; S.init(2048, 2048, F.G, F.wg, (const bf16_t*)(ws + WS_MEMH), 1024, WPTR(WO_WKV), 1024);
          EpiKV E{KB_, VT_}; pg8::gemm_phase(F.lds, F.wave, g, S, E); }
    }
    SEAM(pb + 1);
    if (IN(pb + 2)) {
        unsigned pt0 = 0; if (PROBE_WG >= 0 && LAYER == 0) pt0 = (unsigned)__builtin_amdgcn_s_memrealtime();
        if (LAYER == 0) {
#ifndef NO_DELTA
            if (F.wg < 96) { const int st = F.wg & 31; scan_delta3(F, st >> 2, st & 3, F.wg >> 5, 3); }
#endif
#ifndef NO_RWKV
            if (F.wg >= 96 && F.wg < 224) { const int q = F.wg - 96, st = ((q >> 4) << 3) | (q & 7), par = (q >> 3) & 1; scan_rwkv3(F, st >> 3, st & 7, par); }
#endif
            if (F.wg >= 224) p0_late_weights<0>(F, F.wg - 224, F.G - 224);
        } else {
#ifndef NO_HGRN
            if (F.wg < 128) { const int st = ((F.wg >> 4) << 3) | (F.wg & 7), par = (F.wg >> 3) & 1; scan_hgrn3(F, st >> 3, st & 7, par, 2); }
#endif
            if (F.wg >= 128) p0_late_weights<1>(F, F.wg - 128, F.G - 128);
        }
        if (PROBE_WG >= 0 && LAYER == 0 && F.wg == PROBE_WG && F.wave == 0 && lane_id_v() == 0) __hip_atomic_store((unsigned*)(F.ws + WS_CTL + 20480), (unsigned)__builtin_amdgcn_s_memrealtime() - pt0, __ATOMIC_RELAXED, __HIP_MEMORY_SCOPE_AGENT);
    }
    SEAM2(pb + 2);
    if (IN(pb + 4)) {
        constexpr int lda = LAYER ? P1LD : P0LD; const bf16_t* A = PROJ_ + (LAYER ? 3072 : 1536);
        pg8::Gemm g{lda, 1024, 1024, 1 << 20}; pg8::DenseSched S; S.init(NT, 1024, F.G, F.wg, A, lda, WPTR(WO_WOUT), 1024);
        EpiResid<false> E{LAYER ? (const float*)F.out : F.in[IN_X], F.out, XB_, SSP_, nullptr};
        pg8::gemm_phase(F.lds, F.wave, g, S, E);
    }
    SEAM(pb + 4);
    if (IN(pb + 5)) {
        pg8::Gemm g{1024, 1024, 1024, 1 << 20}; pg8::DenseSched S; S.init(NT, 1024, F.G, F.wg, XB_, 1024, WPTR(WO_WQ), 1024);
        EpiScale<0> E{QB_, 1024, SSP_, 0.0625f, nullptr, nullptr};
        pg8::gemm_phase(F.lds, F.wave, g, S, E);
        if (LAYER == 0) { pg8::Gemm g2{1024, 1024, 1024, 1 << 20}; pg8::DenseSched S2; S2.init(2048, 2048, F.G, F.wg, (const bf16_t*)(ws + WS_MEMH), 1024, WPTR(WO_WKV), 1024);
          EpiKV E2{KB_, VT_}; pg8::gemm_phase(F.lds, F.wave, g2, S2, E2); }
    }
    SEAM(pb + 5);
    if (IN(pb + 6)) attn_phase2(F, QB_, KB_, VT_, ATT_);
    SEAM(pb + 6);
    if (IN(pb + 7)) {
        pg8::Gemm g{1024, 1024, 1024, 1 << 20}; pg8::DenseSched S; S.init(NT, 1024, F.G, F.wg, ATT_, 1024, WPTR(WO_WO), 1024);
        EpiResid<false> E{F.out, F.out, XB_, SSP_, nullptr};
        pg8::gemm_phase(F.lds, F.wave, g, S, E);
    }
    SEAM(pb + 7);
    if (IN(pb + 8)) router_phase2(F, LAYER);
    SEAM(pb + 8);
    if (IN(pb + 9)) gather_phase(F, LAYER);
    SEAM(pb + 9);
    if (IN(pb + 10)) {
        LAS int* tbl = (LAS int*)(F.lds + LDS_MISC + 512); moe_build_table(tbl, CNT_, F.wave * 64 + lane_id_v());
        pg8::Gemm g{1024, 1024, 1024, 1 << 20}; MoeSched<false> S{tbl, __builtin_amdgcn_readfirstlane(tbl[95]), F.G, F.wg, (const char*)XG_, (const char*)WPTR(WO_W13)};
        EpiMoeUp E{HID_, ROWINFO_};
        pg8::gemm_phase(F.lds, F.wave, g, S, E);
    }
    SEAM(pb + 10);
    if (IN(pb + 11)) {
        LAS int* tbl = (LAS int*)(F.lds + LDS_MISC + 512); moe_build_table(tbl, CNT_, F.wave * 64 + lane_id_v());
        pg8::Gemm g{512, 256, 512, 4}; MoeSched<true> S{tbl, __builtin_amdgcn_readfirstlane(tbl[95]), F.G, F.wg, (const char*)HID_, (const char*)WPTR(WO_W2T)};
        EpiResid<true> E{F.out, F.out, XB_, SSP_, ROWINFO_};
        pg8::gemm_phase(F.lds, F.wave, g, S, E);
    }
    SEAM(pb + 11);
}

__global__ void __launch_bounds__(NTHREADS, 2) fwd_mega(Args args) {
    extern __shared__ __attribute__((aligned(16))) unsigned char lds_raw[];
    Frame F;
    F.lds = (LAS unsigned char*)lds_raw;
    const int tid = threadIdx.x; F.wave = __builtin_amdgcn_readfirstlane(tid >> 6);
    F.G = gridDim.x; F.wg = blockIdx.x;
    F.out = args.out; F.ws = args.ws;
    volatile LAS unsigned* MISC = (volatile LAS unsigned*)(F.lds + LDS_MISC);
    LAS unsigned long long* tab = (LAS unsigned long long*)(F.lds + LDS_MISC + 64);
    F.in.t = tab;
    if (tid < 16) MISC[tid] = 0u;
    if (tid == 0) {
#pragma unroll
        for (int i = 0; i < 38; ++i) tab[i] = (unsigned long long)args.in[i];
    }
    __syncthreads();
    XcdBarrier bar; bar.bar = (unsigned*)(F.ws + WS_CTL); bar.x = 0; bar.st = MISC; bar.wave = F.wave;
#if N_LAUNCH_MODE == 1
    bar = xcd_barrier_post((unsigned*)(F.ws + WS_CTL), MISC, F.wave);
#endif
    const int lo = args.ph_lo, hi = args.ph_hi;
    TS_STAMP(0);
    if (IN(0)) { p0_prologue(F); }
    SEAM(0);
    layer_phases<0>(F, bar, lo, hi);
    layer_phases<1>(F, bar, lo, hi);
    if (IN(23)) final_phase(F);
    if (TS_A >= 0 && F.wg == 0 && F.wave == 0) {
        asm volatile("s_waitcnt vmcnt(0)" ::: "memory");
        if (lane_id_v() == 0) { volatile LAS unsigned* ts = (volatile LAS unsigned*)(F.lds + LDS_MISC + 1024);
            float us = (float)(ts[TS_B] - ts[TS_A]) * 0.01f;
            if (PROBE_WG >= 0) us = (float)__hip_atomic_load((unsigned*)(F.ws + WS_CTL + 20480), __ATOMIC_RELAXED, __HIP_MEMORY_SCOPE_AGENT) * 0.01f;
            if (PROBE_STAGE >= 0) us = (float)__hip_atomic_load((unsigned*)(F.ws + WS_CTL + 20484), __ATOMIC_RELAXED, __HIP_MEMORY_SCOPE_AGENT) * 0.01f;
            F.out[0] = F.out[0] + us * TS_SCALE; }
    }
}
#undef IN
#undef SEAM

extern "C" void kernel_launch(void* const* d_in, const int* in_sizes, int n_in, void* d_out, int out_size, void* d_ws, size_t ws_size, hipStream_t stream) {
    static int grid = 0;
    if (grid == 0) {
        if (n_in != 38 || out_size != NT * DM || ws_size < WS_END) { fprintf(stderr, "kernel_launch: unexpected problem (n_in %d out %d ws %zu)\n", n_in, out_size, ws_size); grid = -1; return; }
        int dev = 0, cus = 0, per_cu = 0;
        if (hipGetDevice(&dev) != hipSuccess || hipDeviceGetAttribute(&cus, hipDeviceAttributeMultiprocessorCount, dev) != hipSuccess) { grid = -1; return; }
        if (hipFuncSetAttribute((const void*)fwd_mega, hipFuncAttributeMaxDynamicSharedMemorySize, LDS_BYTES) != hipSuccess) { fprintf(stderr, "kernel_launch: hipFuncSetAttribute failed\n"); grid = -1; return; }
        if (hipOccupancyMaxActiveBlocksPerMultiprocessor(&per_cu, (const void*)fwd_mega, NTHREADS, LDS_BYTES) != hipSuccess || per_cu < 1) { fprintf(stderr, "kernel_launch: occupancy query says %d\n", per_cu); (void)hipGetLastError(); grid = -1; return; }
        grid = cus;
    }
    if (grid < 0) return;
    (void)hipMemsetAsync((char*)d_ws + WS_CTL, 0, 32768, stream);
    Args a{};
    for (int i = 0; i < 38; ++i) a.in[i] = (const float*)d_in[i];
    a.out = (float*)d_out; a.ws = (unsigned char*)d_ws;
#if N_LAUNCH_MODE == 1
    a.ph_lo = 0; a.ph_hi = N_PHASES;
    void* kargs[] = {&a};
    hipError_t e = hipLaunchCooperativeKernel((const void*)fwd_mega, dim3(grid), dim3(NTHREADS), kargs, LDS_BYTES, stream);
    if (e != hipSuccess) fprintf(stderr, "kernel_launch: cooperative launch failed: %s\n", hipGetErrorString(e));
#else
    for (int p = 0; p < N_PHASES; ++p) { a.ph_lo = p; a.ph_hi = p + 1; hipLaunchKernelGGL(fwd_mega, dim3(grid), dim3(NTHREADS), LDS_BYTES, stream, a); }
#endif
}
```

```cpp
#include <hip/hip_runtime.h>
#include <cstdio>
#include <cstdint>

#ifndef N_LAUNCH_MODE
#define N_LAUNCH_MODE 1
#endif

#ifndef TS_A
#define TS_A -1
#endif
#ifndef TS_B
#define TS_B 0
#endif
#ifndef PROBE_WG
#define PROBE_WG -1
#endif
#ifndef PROBE_STAGE
#define PROBE_STAGE -1
#endif
#ifndef TS_SCALE
#define TS_SCALE 0.01f
#endif

#define LAS __attribute__((address_space(3)))
#define GAS __attribute__((address_space(1)))
typedef unsigned short bf16_t;
typedef short bf16x8 __attribute__((ext_vector_type(8)));
typedef short bf16x4 __attribute__((ext_vector_type(4)));
typedef float f32x4 __attribute__((ext_vector_type(4)));
typedef float f32x2 __attribute__((ext_vector_type(2)));
typedef unsigned u32x4 __attribute__((ext_vector_type(4)));
typedef unsigned u32x2 __attribute__((ext_vector_type(2)));

constexpr int NT = 16384, DM = 1024, NB = 8, TS = 2048, NMEM = 256;
constexpr int P0LD = 3840;
constexpr int P1LD = 4096;
constexpr int NTHREADS = 512, NWAVES = 8;

constexpr size_t MiB = 1048576;
constexpr size_t WS_CTL = 0;
constexpr size_t WS_CNT = 16384;
constexpr size_t WS_LB = 32768;
constexpr size_t WS_DB = 1 * MiB;
constexpr size_t WS_SSP = WS_DB + 512 * 1024;
constexpr size_t WS_MEMH = WS_SSP + 1 * MiB;
constexpr size_t WS_ROUTE = WS_MEMH + 4 * MiB;
constexpr size_t WS_LORA = WS_ROUTE + 800 * 1024;
constexpr size_t WS_RW = WS_LORA + 256 * 1024;
constexpr size_t WS_W0 = 8 * MiB;
static_assert(WS_RW + 2 * 1024 * 32 * 4 <= 8 * MiB, "small weights");
constexpr size_t WS_W1 = WS_W0 + 42 * MiB;
constexpr size_t WS_XB = 92 * MiB;
constexpr size_t WS_BIG = 124 * MiB;
constexpr size_t WS_END = 256 * MiB;
constexpr size_t WS_HALOB = 252 * MiB;
constexpr size_t WS_HOB = 253 * MiB;
constexpr size_t WS_HOA = 254 * MiB;
constexpr size_t WS_HOC = 252 * MiB;
constexpr size_t WS_FLAGS = 24576;
constexpr size_t WO_WIN = 0;
constexpr size_t WO_WOUT = WO_WIN + (size_t)4096 * 1024;
constexpr size_t WO_WQ = WO_WOUT + (size_t)1024 * 1024;
constexpr size_t WO_WKV = WO_WQ + (size_t)1024 * 1024;
constexpr size_t WO_WO = WO_WKV + (size_t)2048 * 1024;
constexpr size_t WO_W13 = WO_WO + (size_t)1024 * 1024;
constexpr size_t WO_W2T = WO_W13 + (size_t)16 * 512 * 1024;
constexpr size_t WO_END = WO_W2T + (size_t)16 * 1024 * 256;
static_assert(WO_END * 2 <= 42 * MiB, "weight region");
constexpr size_t BIG_PROJ = 0;
constexpr size_t BIG_KV0 = 120 * MiB;
constexpr size_t BIG_Q = 0;
constexpr size_t BIG_ATT = 32 * MiB;
constexpr size_t BIG_XG = 0;
constexpr size_t BIG_HID = 48 * MiB;
constexpr int MOE_MAXROWS = 22528;

__device__ __forceinline__ unsigned f2bf(float f) { unsigned u = __float_as_uint(f); u += 0x7fffu + ((u >> 16) & 1u); return u >> 16; }
__device__ __forceinline__ float bf2f(unsigned short b) { return __uint_as_float((unsigned)b << 16); }
__device__ __forceinline__ unsigned pk2(float lo, float hi) { return f2bf(lo) | (f2bf(hi) << 16); }
__device__ __forceinline__ float wave_sum(float v) {
#pragma unroll
    for (int o = 1; o < 64; o <<= 1) v += __shfl_xor(v, o);
    return v;
}
__device__ __forceinline__ float sigmoidf_(float x) { return 1.f / (1.f + __expf(-x)); }
__device__ __forceinline__ float siluf_(float x) { return x / (1.f + __expf(-x)); }
__device__ __forceinline__ float softplusf_(float x) { return x > 20.f ? x : log1pf(__expf(x)); }
__device__ __forceinline__ int lane_id_v() { int l; asm volatile("v_mbcnt_lo_u32_b32 %0, -1, 0\n\tv_mbcnt_hi_u32_b32 %0, -1, %0" : "=v"(l)); return l; }
#define LDS_WAIT() asm volatile("s_waitcnt lgkmcnt(0)" ::: "memory")
#define VM_WAIT() asm volatile("s_waitcnt vmcnt(0)" ::: "memory")

namespace pg8 {
constexpr int BM = 256, BK = 64, HALF = 128, HTB = HALF * BK * 2, STAGE_BYTES = 8 * HTB;
__host__ __device__ __forceinline__ int lds_byte(int r, int c) { const int st = (r >> 4) * 2 + (c >> 5), rr = r & 15, cc = c & 31, ob = rr * 64 + cc * 2; return st * 1024 + (ob ^ (((ob >> 9) & 1) << 5)); }
__host__ __device__ __forceinline__ void stage_rc(int b, int& R, int& C) { const int st = b / 1024, sb = b % 1024, swz = sb ^ (((sb >> 9) & 1) << 5); R = (st >> 1) * 16 + swz / 64; C = (st & 1) * 32 + (swz % 64) / 2; }

struct Unit { int pm, pn, aux; const char* a; const char* b0; const char* b1; };
struct Gemm { int lda, ldb, K, ksplit; };

template <class Epi, class Sched>
__device__ __forceinline__ void gemm_phase(LAS unsigned char* lds, const int wave_in, const Gemm g, const Sched& S, const Epi& E) {
    const int wid = wave_in, lane = lane_id_v(), tid = wid * 64 + lane, wr = wid >> 2, wc = wid & 3, fr = lane & 15, fq = lane >> 4;
    const int K = g.K, nt = K / BK, ks = g.ksplit;
    unsigned voffA[2], voffB[2];
#pragma unroll
    for (int i = 0; i < 2; ++i) { int R, C; stage_rc(tid * 16 + i * 8192, R, C);
        voffA[i] = (unsigned)(R * g.lda + C) * 2u; voffB[i] = (unsigned)(R * g.ldb + C) * 2u; }
    const size_t kstep = (size_t)(BK * 2);
    const size_t hstepA = (size_t)HALF * g.lda * 2, hstepB = (size_t)HALF * g.ldb * 2;
    const unsigned ldsw = (unsigned)wid * 1024u;
    const int aoff = lds_byte(wr * 64 + fr, fq * 8), boff = lds_byte(wc * 32 + fr, fq * 8);
#define PG8_SA(b, h) (((b) * 2 + (h)) * HTB)
#define PG8_SB(b, h) ((4 + (b) * 2 + (h)) * HTB)
#define PG8_STAGE(bufoff, gbase, voff) do { _Pragma("unroll") for (int _i = 0; _i < 2; ++_i) \
        __builtin_amdgcn_global_load_lds((const unsigned*)((const char*)(gbase) + (voff)[_i]), (LAS unsigned*)(lds + (bufoff) + ldsw + _i * 8192), 16, 0, 0); } while (0)
#define PG8_LDA(dst, b, h) do { _Pragma("unroll") for (int m = 0; m < 4; ++m) _Pragma("unroll") for (int k = 0; k < 2; ++k) dst[m][k] = *(const LAS bf16x8*)(lds + PG8_SA(b, h) + aoff + m * 2048 + k * 1024); } while (0)
#define PG8_LDB(dst, b, h) do { _Pragma("unroll") for (int n = 0; n < 2; ++n) _Pragma("unroll") for (int k = 0; k < 2; ++k) dst[n][k] = *(const LAS bf16x8*)(lds + PG8_SB(b, h) + boff + n * 2048 + k * 1024); } while (0)
#define PG8_MMA(ai, bj, At, Bt) do { __builtin_amdgcn_s_setprio(1); _Pragma("unroll") for (int m = 0; m < 4; ++m) _Pragma("unroll") for (int n = 0; n < 2; ++n) _Pragma("unroll") for (int k = 0; k < 2; ++k) \
        acc[ai][bj][m][n] = __builtin_amdgcn_mfma_f32_16x16x32_bf16(Bt[n][k], At[m][k], acc[ai][bj][m][n], 0, 0, 0); __builtin_amdgcn_s_setprio(0); } while (0)
#define PG8_WAIT_V(n) asm volatile("s_waitcnt vmcnt(" #n ")" ::: "memory")
#define PG8_WAIT_L(n) asm volatile("s_waitcnt lgkmcnt(" #n ")" ::: "memory")
#define PG8_BAR __builtin_amdgcn_s_barrier()
#define PG8_SCHED __builtin_amdgcn_sched_barrier(0)
    Unit cur, nxt; int ui = 0;
    if (!S.next(0, cur)) return;
    f32x4 acc[2][2][4][2];
#pragma unroll
    for (int a = 0; a < 2; ++a)
#pragma unroll
        for (int b = 0; b < 2; ++b)
#pragma unroll
            for (int m = 0; m < 4; ++m)
#pragma unroll
                for (int n = 0; n < 2; ++n) acc[a][b][m][n] = (f32x4){0.f, 0.f, 0.f, 0.f};
    bf16x8 At[4][2], B0[2][2], B1[2][2];
    const char* cA = cur.a; const char* cB = cur.b0; const char* cB1 = cur.b1;
    PG8_STAGE(PG8_SB(0, 0), cB, voffB); PG8_STAGE(PG8_SB(0, 1), cB + hstepB, voffB); PG8_STAGE(PG8_SA(0, 0), cA, voffA); PG8_STAGE(PG8_SA(0, 1), cA + hstepA, voffA);
    if (wr == 1) PG8_BAR;
    PG8_WAIT_V(2); PG8_BAR;
    PG8_STAGE(PG8_SB(1, 0), cB + kstep, voffB); PG8_STAGE(PG8_SA(1, 0), cA + kstep, voffA); PG8_STAGE(PG8_SB(1, 1), cB + hstepB + kstep, voffB);
    PG8_WAIT_V(6); PG8_BAR;
    for (;;) {
        const bool has_next = S.next(ui + 1, nxt);
        const char* nA = has_next ? nxt.a : cA; const char* nB = has_next ? nxt.b0 : cB;
        for (int t = 0; t < nt; t += 2) {
            const bool last = (t == nt - 2);
            const char* a1 = cA + (size_t)(t + 1) * kstep;
            const char* a2 = last ? nA : cA + (size_t)(t + 2) * kstep;
            const char* b2 = last ? nB : ((t + 2) < ks ? cB + (size_t)(t + 2) * kstep : cB1 + (size_t)(t + 2 - ks) * kstep);
            const char* a3 = a2 + kstep; const char* b3 = b2 + kstep;
            PG8_LDB(B0, 0, 0); PG8_LDB(B1, 0, 1); PG8_SCHED; PG8_LDA(At, 0, 0); PG8_STAGE(PG8_SA(1, 1), a1 + hstepA, voffA);
            PG8_WAIT_V(8); PG8_WAIT_L(0); PG8_BAR; PG8_MMA(0, 0, At, B0); PG8_MMA(0, 1, At, B1); PG8_BAR; PG8_SCHED;
            PG8_LDA(At, 0, 1); PG8_STAGE(PG8_SB(0, 0), b2, voffB); PG8_STAGE(PG8_SB(0, 1), b2 + hstepB, voffB); PG8_STAGE(PG8_SA(0, 0), a2, voffA);
            PG8_WAIT_V(8); PG8_WAIT_L(0); PG8_BAR; PG8_MMA(1, 0, At, B0); PG8_MMA(1, 1, At, B1); PG8_BAR; PG8_SCHED;
            PG8_LDB(B0, 1, 0); PG8_LDB(B1, 1, 1); PG8_SCHED; PG8_LDA(At, 1, 0); PG8_STAGE(PG8_SA(0, 1), a2 + hstepA, voffA);
            PG8_WAIT_V(8); PG8_WAIT_L(0); PG8_BAR; PG8_MMA(0, 0, At, B0); PG8_MMA(0, 1, At, B1); PG8_BAR; PG8_SCHED;
            PG8_LDA(At, 1, 1); PG8_STAGE(PG8_SB(1, 0), b3, voffB); PG8_STAGE(PG8_SB(1, 1), b3 + hstepB, voffB); PG8_STAGE(PG8_SA(1, 0), a3, voffA);
            PG8_WAIT_V(8); PG8_WAIT_L(0); PG8_BAR; PG8_MMA(1, 0, At, B0); PG8_MMA(1, 1, At, B1); PG8_BAR; PG8_SCHED;
        }
        if (wr == 0) PG8_BAR;
        E(acc, cur, wr, wc, fr, fq);
        if (!has_next) break;
#pragma unroll
        for (int a = 0; a < 2; ++a)
#pragma unroll
            for (int b = 0; b < 2; ++b)
#pragma unroll
                for (int m = 0; m < 4; ++m)
#pragma unroll
                    for (int n = 0; n < 2; ++n) acc[a][b][m][n] = (f32x4){0.f, 0.f, 0.f, 0.f};
        cur = nxt; cA = nA; cB = nB; cB1 = nxt.b1; ++ui;
        if (wr == 1) PG8_BAR;
    }
    PG8_WAIT_V(0);
    PG8_BAR;
#undef PG8_SA
#undef PG8_SB
#undef PG8_STAGE
#undef PG8_LDA
#undef PG8_LDB
#undef PG8_MMA
#undef PG8_WAIT_V
#undef PG8_WAIT_L
#undef PG8_BAR
#undef PG8_SCHED
}

struct DenseSched {
    int nM, nN, nwg, G, c; const char* A; const char* B; size_t tA, tB;
    __device__ void init(int M, int N, int G_, int c_, const bf16_t* A_, int lda, const bf16_t* B_, int ldb) { nM = M / 256; nN = N / 256; nwg = nM * nN; G = G_; c = c_; A = (const char*)A_; B = (const char*)B_; tA = (size_t)256 * lda * 2; tB = (size_t)256 * ldb * 2; }
    __device__ bool next(int i, Unit& u) const {
        const long L = (long)i * G + c; if (L >= nwg) return false;
        int wgid = (int)L; { const int q = nwg / 8, r = nwg % 8, xcd = wgid % 8, off = wgid / 8; wgid = (xcd < r ? xcd * (q + 1) : r * (q + 1) + (xcd - r) * q) + off; }
        const int nig = 8 * nN, gid = wgid / nig, fm = gid * 8, gsz = (nM - fm) < 8 ? (nM - fm) : 8;
        u.pm = fm + ((wgid % nig) % gsz); u.pn = (wgid % nig) / gsz; u.aux = 256;
        u.a = A + (size_t)u.pm * tA; u.b0 = B + (size_t)u.pn * tB; u.b1 = u.b0; return true;
    }
};
}
using pg8::Unit;

__device__ __forceinline__ float row_rstd(const float* ssp, int row) {
    const f32x4* p = (const f32x4*)(ssp + (size_t)row * 16);
    const f32x4 a = p[0], b = p[1], c = p[2], d = p[3];
    const float s = ((a.x + a.y) + (a.z + a.w)) + ((b.x + b.y) + (b.z + b.w)) + ((c.x + c.y) + (c.z + c.w)) + ((d.x + d.y) + (d.z + d.w));
    return 1.0f / sqrtf(s * (1.0f / 1024.0f) + 1e-6f);
}
__device__ __forceinline__ unsigned short f2h_bits(float f) { _Float16 h = (_Float16)f; return __builtin_bit_cast(unsigned short, h); }
__device__ __forceinline__ float h2f_bits(unsigned short b) { return (float)__builtin_bit_cast(_Float16, b); }

template <int MODE> struct EpiScale {
    bf16_t* O; int ldc; const float* ssp; float scale; const float* lb; bf16_t* halo;
    __device__ __forceinline__ void operator()(const f32x4 (&acc)[2][2][4][2], const Unit& u, int wr, int wc, int fr_in, int fq_in) const {
        int fr = fr_in, fq = fq_in; asm volatile("" : "+v"(fr), "+v"(fq));
#pragma unroll
        for (int ai = 0; ai < 2; ++ai)
#pragma unroll
            for (int m = 0; m < 4; ++m) {
                const int row = u.pm * 256 + ai * 128 + wr * 64 + m * 16 + fr;
                const float rs = (MODE == 2) ? scale : row_rstd(ssp, row) * scale;
#pragma unroll
                for (int bj = 0; bj < 2; ++bj)
#pragma unroll
                    for (int n = 0; n < 2; ++n) {
                        const int col = u.pn * 256 + bj * 128 + wc * 32 + n * 16 + fq * 4;
                        f32x4 v = acc[ai][bj][m][n] * rs;
                        u32x2 w;
                        if (MODE == 1) {
                            const int blk = col >> 10;
                            if (blk == 0) { v.x = siluf_(v.x); v.y = siluf_(v.y); v.z = siluf_(v.z); v.w = siluf_(v.w); }
                            if (blk == 1) {
                                const f32x4 l = *(const f32x4*)(lb + (col - 1024));
                                float o[4]; const float vv[4] = {v.x, v.y, v.z, v.w}; const float ll[4] = {l.x, l.y, l.z, l.w};
#pragma unroll
                                for (int j = 0; j < 4; ++j) o[j] = __logf(ll[j] + (1.f - ll[j]) * sigmoidf_(vv[j]));
                                w.x = (unsigned)f2h_bits(o[0]) | ((unsigned)f2h_bits(o[1]) << 16); w.y = (unsigned)f2h_bits(o[2]) | ((unsigned)f2h_bits(o[3]) << 16);
                            } else { w.x = pk2(v.x, v.y); w.y = pk2(v.z, v.w); }
                        } else { w.x = pk2(v.x, v.y); w.y = pk2(v.z, v.w); }
                        *(u32x2*)(O + (size_t)row * ldc + col) = w;
                        if (MODE == 0 && halo && col >= 2048 && (row & 63) == 63) *(u32x2*)(halo + (size_t)(row >> 6) * 1792 + (col - 2048)) = w;
                    }
            }
    }
};
struct EpiKV {
    bf16_t* Kb; bf16_t* VT;
    __device__ __forceinline__ void operator()(const f32x4 (&acc)[2][2][4][2], const Unit& u, int wr, int wc, int fr_in, int fq_in) const {
        int fr = fr_in, fq = fq_in; asm volatile("" : "+v"(fr), "+v"(fq));
#pragma unroll
        for (int ai = 0; ai < 2; ++ai)
#pragma unroll
            for (int m = 0; m < 4; ++m) {
                const int row = u.pm * 256 + ai * 128 + wr * 64 + m * 16 + fr;
#pragma unroll
                for (int bj = 0; bj < 2; ++bj)
#pragma unroll
                    for (int n = 0; n < 2; ++n) {
                        const int col = u.pn * 256 + bj * 128 + wc * 32 + n * 16 + fq * 4;
                        const f32x4 v = acc[ai][bj][m][n];
                        if (col < 1024) { u32x2 w; w.x = pk2(v.x, v.y); w.y = pk2(v.z, v.w); *(u32x2*)(Kb + (size_t)row * 1024 + col) = w; }
                        else {
                            const int c2 = col - 1024, h = c2 >> 8, d = c2 & 255, b = row >> 8, mm = row & 255;
                            bf16_t* p = VT + ((size_t)((b * 4 + h) * 256 + d)) * 256 + mm;
                            p[0] = (bf16_t)f2bf(v.x); p[256] = (bf16_t)f2bf(v.y); p[512] = (bf16_t)f2bf(v.z); p[768] = (bf16_t)f2bf(v.w);
                        }
                    }
            }
    }
};
template <bool SCATTER> struct EpiResid {
    const float* base; float* XF; bf16_t* XB; float* ssp; const f32x4* rowinfo;
    __device__ __forceinline__ void operator()(const f32x4 (&acc)[2][2][4][2], const Unit& u, int wr, int wc, int fr_in, int fq_in) const {
        int fr = fr_in, fq = fq_in; asm volatile("" : "+v"(fr), "+v"(fq));
#pragma unroll
        for (int ai = 0; ai < 2; ++ai)
#pragma unroll
            for (int m = 0; m < 4; ++m) {
                const int lrow = ai * 128 + wr * 64 + m * 16 + fr;
                const int row = u.pm * 256 + lrow;
                int tok = row; bool valid = true;
                if (SCATTER) { valid = lrow < u.aux; const f32x4 ri = rowinfo[row]; tok = valid ? __float_as_int(ri.w) : 0; }
                float ss = 0.f;
#pragma unroll
                for (int bj = 0; bj < 2; ++bj)
#pragma unroll
                    for (int n = 0; n < 2; ++n) {
                        const int col = u.pn * 256 + bj * 128 + wc * 32 + n * 16 + fq * 4;
                        const size_t off = (size_t)tok * 1024 + col;
                        const f32x4 b = *(const f32x4*)(base + off);
                        const f32x4 v = b + acc[ai][bj][m][n];
                        if (valid) { *(f32x4*)(XF + off) = v; u32x2 w; w.x = pk2(v.x, v.y); w.y = pk2(v.z, v.w); *(u32x2*)(XB + off) = w; }
                        ss += (v.x * v.x + v.y * v.y) + (v.z * v.z + v.w * v.w);
                    }
                ss += __shfl_xor(ss, 16); ss += __shfl_xor(ss, 32);
                if (valid && fq == 0) ssp[(size_t)tok * 16 + u.pn * 4 + wc] = ss;
            }
    }
};
struct EpiMoeUp {
    bf16_t* HID; const f32x4* rowinfo;
    __device__ __forceinline__ void operator()(const f32x4 (&acc)[2][2][4][2], const Unit& u, int wr, int wc, int fr_in, int fq_in) const {
        int fr = fr_in, fq = fq_in; asm volatile("" : "+v"(fr), "+v"(fq));
        const int slot = u.pn >> 1, jj = u.pn & 1;
#pragma unroll
        for (int ai = 0; ai < 2; ++ai)
#pragma unroll
            for (int m = 0; m < 4; ++m) {
                const int row = u.pm * 256 + ai * 128 + wr * 64 + m * 16 + fr;
                const f32x4 ri = rowinfo[row];
                const float rs = ri.x, gt = slot ? ri.z : ri.y;
#pragma unroll
                for (int n = 0; n < 2; ++n) {
                    const f32x4 h1 = acc[ai][0][m][n] * rs, h3 = acc[ai][1][m][n] * rs;
                    const int col = slot * 256 + jj * 128 + wc * 32 + n * 16 + fq * 4;
                    u32x2 w; w.x = pk2(siluf_(h1.x) * h3.x * gt, siluf_(h1.y) * h3.y * gt); w.y = pk2(siluf_(h1.z) * h3.z * gt, siluf_(h1.w) * h3.w * gt);
                    *(u32x2*)(HID + (size_t)row * 512 + col) = w;
                }
            }
    }
};
__device__ __forceinline__ void pair_experts(int bucket, int& ea, int& eb) {
    const int g = bucket / 6, p = bucket % 6;
    const int i = (p < 3) ? 0 : (p < 5 ? 1 : 2);
    const int j = (p < 3) ? p + 1 : (p < 5 ? p - 1 : 3);
    ea = g * 4 + i; eb = g * 4 + j;
}
template <bool DOWN> struct MoeSched {
    const LAS int* tbl; int ntiles, G, c; const char* A; const char* W;
    __device__ bool next(int i, Unit& u) const {
        const int L = i * G + c, mt = L >> 2, pn = L & 3;
        if (mt >= ntiles) return false;
        const int ent = __builtin_amdgcn_readfirstlane(tbl[mt]), bucket = ent & 255; u.aux = ent >> 8;
        int ea, eb; pair_experts(bucket, ea, eb);
        u.pm = mt; u.pn = pn;
        if (!DOWN) { u.a = A + (size_t)mt * 256 * 1024 * 2; const int e = (pn < 2) ? ea : eb; u.b0 = W + ((size_t)e * 512 + 256 * (pn & 1)) * 1024 * 2; u.b1 = u.b0; }
        else { u.a = A + (size_t)mt * 256 * 512 * 2; u.b0 = W + ((size_t)ea * 1024 + 256 * pn) * 256 * 2; u.b1 = W + ((size_t)eb * 1024 + 256 * pn) * 256 * 2; }
        return true;
    }
};
__device__ __forceinline__ void moe_build_table(LAS int* tbl, const unsigned* cnt, int tid) {
    if (tid == 0) { int mt = 0;
        for (int b = 0; b < 24; ++b) { const int nb = (int)cnt[b]; for (int r = 0; r < nb; r += 256) { const int v = (nb - r) < 256 ? (nb - r) : 256; if (mt < 95) tbl[mt] = b | (v << 8); ++mt; } }
        tbl[95] = mt < 95 ? mt : 95; }
    __syncthreads();
}

#define XB_TMO      128
#define XB_XCNT(j)  (256  + 64 * (j))
#define XB_XSUB(j)  (1280 + 64 * (j))
#define XB_XGEN(j)  (2304 + 64 * (j))
#define XB_TOP      3328
#define XB_TOPGEN   3392
#define XCD_BAR_WORDS 3456
#define XB_SPIN_CAP (1u << 22)
__device__ __forceinline__ unsigned xb_ld(unsigned* p)              { return __hip_atomic_load(p, __ATOMIC_RELAXED, __HIP_MEMORY_SCOPE_AGENT); }
__device__ __forceinline__ unsigned xb_add(unsigned* p, unsigned v) { return __hip_atomic_fetch_add(p, v, __ATOMIC_RELAXED, __HIP_MEMORY_SCOPE_AGENT); }
__device__ __forceinline__ unsigned xb_xcc_id() { return (unsigned)__builtin_amdgcn_s_getreg((3 << 11) | 20) & 0xFu; }
#define XB_SPIN(cond, bar) do { unsigned _sp = 0; while (cond) { __builtin_amdgcn_s_sleep(1); \
    if ((++_sp & 255u) == 0u) { if (xb_ld(&(bar)[XB_TMO])) break; if (_sp > XB_SPIN_CAP) { atomicAdd(&(bar)[XB_TMO], 1u); break; } } } } while (0)
struct XcdBarrier { unsigned* bar; unsigned x; volatile LAS unsigned* st; int wave; };
__device__ __forceinline__ XcdBarrier xcd_barrier_post(unsigned* bar, volatile LAS unsigned* st, int wave) {
    XcdBarrier b; b.bar = bar; b.x = xb_xcc_id(); b.st = st; b.wave = wave;
    if (wave == 0 && lane_id_v() == 0) (void)xb_add(&bar[XB_XCNT(b.x)], 1u);
    return b;
}
__device__ __forceinline__ void xcd_barrier_complete(unsigned* bar, unsigned x, unsigned& nloc, unsigned& nx) {
    const unsigned G = gridDim.x * gridDim.y * gridDim.z;
    unsigned sum, cnt, mine, sp = 0u;
    for (;;) {
        sum = 0u; cnt = 0u; mine = 0u;
#pragma unroll
        for (unsigned j = 0; j < 16; ++j) { const unsigned c = xb_ld(&bar[XB_XCNT(j)]); sum += c; cnt += (c > 0u) ? 1u : 0u; mine = (j == x) ? c : mine; }
        if (sum == G) break;
        __builtin_amdgcn_s_sleep(1);
        if ((++sp & 255u) == 0u) { if (xb_ld(&bar[XB_TMO])) break; if (sp > XB_SPIN_CAP) { atomicAdd(&bar[XB_TMO], 1u); break; } }
    }
    nloc = mine > 0u ? mine : 1u; nx = cnt > 0u ? cnt : 1u;
}
__device__ __forceinline__ void xcd_barrier(const XcdBarrier& b) {
    asm volatile("s_waitcnt vmcnt(0)" ::: "memory");
    __syncthreads();
    if (b.wave == 0 && lane_id_v() == 0) {
        unsigned* bar = b.bar;
        __builtin_amdgcn_s_waitcnt(0);
        unsigned nloc = b.st[0], nx = b.st[1];
        if (nloc == 0u) { xcd_barrier_complete(bar, b.x, nloc, nx); b.st[0] = nloc; b.st[1] = nx; }
        const unsigned old = xb_add(&bar[XB_XSUB(b.x)], 1u);
        const unsigned gen = old / nloc;
        if (old + 1u == (gen + 1u) * nloc) {
            __builtin_amdgcn_fence(__ATOMIC_RELEASE, "agent");
            asm volatile("s_waitcnt vmcnt(0)" ::: "memory");
            const unsigned og = xb_add(&bar[XB_TOP], 1u);
            const unsigned tg = og / nx;
            if (og + 1u == (tg + 1u) * nx) xb_add(&bar[XB_TOPGEN], 1u);
            else XB_SPIN(xb_ld(&bar[XB_TOPGEN]) == tg, bar);
            __builtin_amdgcn_fence(__ATOMIC_ACQUIRE, "agent");
            xb_add(&bar[XB_XGEN(b.x)], 1u);
            asm volatile("s_waitcnt vmcnt(0)" ::: "memory");
        } else {
            XB_SPIN(xb_ld(&bar[XB_XGEN(b.x)]) == gen, bar);
            __builtin_amdgcn_fence(__ATOMIC_ACQUIRE, "agent");
            asm volatile("s_waitcnt vmcnt(0)" ::: "memory");
        }
    }
    __syncthreads();
}

struct Args { const float* in[38]; float* out; unsigned char* ws; int ph_lo, ph_hi; };
constexpr int LDS_BYTES = 161792;
constexpr int LDS_MISC = 156 * 1024;
struct InTab {
    const LAS unsigned long long* t;
    __device__ __forceinline__ const float* operator[](int i) const {
        const unsigned long long v = t[i];
        const unsigned lo = __builtin_amdgcn_readfirstlane((unsigned)v), hi = __builtin_amdgcn_readfirstlane((unsigned)(v >> 32));
        return (const float*)(((unsigned long long)hi << 32) | lo); }
};
struct Frame {
    LAS unsigned char* lds; int wave, G, wg;
    InTab in; float* out; unsigned char* ws;
};
#define IN_X 0
#define IN_MEM 1
#define IN_NORM_MIX 2
#define IN_NORM_XA 3
#define IN_NORM_MEM 4
#define IN_NORM_FFN 5
#define IN_NORM_FINAL 6
#define IN_AB_WIN 7
#define IN_AB_CONV 8
#define IN_AB_ALOG 9
#define IN_AB_DTB 10
#define IN_AB_ONORM 11
#define IN_AB_MU 12
#define IN_AB_W0 13
#define IN_AB_W2 14
#define IN_AB_A0 15
#define IN_AB_A2 16
#define IN_AB_G2 17
#define IN_AB_KK 18
#define IN_AB_KA 19
#define IN_AB_RK 20
#define IN_AB_LNW 21
#define IN_AB_LNB 22
#define IN_AB_WOUT 23
#define IN_C_WIN 24
#define IN_C_LB 25
#define IN_C_ONORM 26
#define IN_C_WOUT 27
#define IN_XA_WQ 28
#define IN_XA_WKV 29
#define IN_XA_WO 30
#define IN_MOE_WG 31
#define IN_MOE_BG 32
#define IN_MOE_WE 33
#define IN_MOE_BE 34
#define IN_MOE_W1 35
#define IN_MOE_W3 36
#define IN_MOE_W2 37

__device__ __forceinline__ void p0_transpose_item(const float* W, int ld, int col0, int ncols, int K, const float* gain, bf16_t* WT, int drow0, LAS float* scr, int item, int lane) {
    const int nblk = ncols / 32, kb = item / nblk, nb = item % nblk, k0 = 64 * kb, n0 = 32 * nb;
    float vv[32];
#pragma unroll
    for (int i = 0; i < 32; ++i) vv[i] = W[(size_t)(k0 + 2 * i + (lane >> 5)) * ld + col0 + n0 + (lane & 31)];
#pragma unroll
    for (int i = 0; i < 32; ++i) { const int kk = 2 * i + (lane >> 5); float v = vv[i]; if (gain) v *= gain[k0 + kk]; scr[kk * 33 + (lane & 31)] = v; }
    LDS_WAIT(); asm volatile("" ::: "memory");
    const int c = lane & 7;
#pragma unroll
    for (int j = 0; j < 4; ++j) { const int n = (lane >> 3) + 8 * j; const LAS float* s = scr + (8 * c) * 33 + n;
        u32x4 o; o.x = pk2(s[0 * 33], s[1 * 33]); o.y = pk2(s[2 * 33], s[3 * 33]); o.z = pk2(s[4 * 33], s[5 * 33]); o.w = pk2(s[6 * 33], s[7 * 33]);
        *(u32x4*)(WT + (size_t)(drow0 + n0 + n) * K + k0 + 8 * c) = o; }
    LDS_WAIT(); asm volatile("" ::: "memory");
}
__device__ __forceinline__ void p0_weight_item(const Frame& F, int it, LAS float* scr, int lane) {
    const InTab in = F.in;
    bf16_t* W0 = (bf16_t*)(F.ws + WS_W0); bf16_t* W1 = (bf16_t*)(F.ws + WS_W1);
    if (it < 16384) {
        const int l = it >> 13; int r = it & 8191; bf16_t* W = l ? W1 : W0;
        if (r < 512) { p0_transpose_item(in[IN_XA_WQ] + (size_t)l * 1024 * 1024, 1024, 0, 1024, 1024, in[IN_NORM_XA] + l * 1024, W + WO_WQ, 0, scr, r, lane); return; }
        r -= 512;
        if (r < 1024) { p0_transpose_item(in[IN_XA_WKV] + (size_t)l * 1024 * 2048, 2048, 0, 2048, 1024, in[IN_NORM_MEM] + l * 1024, W + WO_WKV, 0, scr, r, lane); return; }
        r -= 1024;
        if (r < 512) { p0_transpose_item(in[IN_XA_WO] + (size_t)l * 1024 * 1024, 1024, 0, 1024, 1024, nullptr, W + WO_WO, 0, scr, r, lane); return; }
        r -= 512;
        if (r < 4096) { const int sub = r >> 6, item = r & 63, e = sub >> 2, j = (sub >> 1) & 1, which = sub & 1;
            const float* src = (which ? in[IN_MOE_W3] : in[IN_MOE_W1]) + (size_t)(l * 16 + e) * 1024 * 256;
            p0_transpose_item(src, 256, 128 * j, 128, 1024, in[IN_NORM_FFN] + l * 1024, W + WO_W13, e * 512 + 256 * j + 128 * which, scr, item, lane); return; }
        r -= 4096;
        { const int e = r >> 7, item = r & 127;
            p0_transpose_item(in[IN_MOE_W2] + (size_t)(l * 16 + e) * 256 * 1024, 1024, 0, 1024, 256, nullptr, W + WO_W2T + (size_t)e * 1024 * 256, 0, scr, item, lane); return; }
    }
    int r = it - 16384;
    if (r < 1024) { p0_transpose_item(in[IN_AB_WIN], 3848, 0, 2048, 1024, in[IN_NORM_MIX], W0 + WO_WIN, 0, scr, r, lane); return; }
    r -= 1024;
    if (r < 896) { p0_transpose_item(in[IN_AB_WIN], 3848, 2056, 1792, 1024, in[IN_NORM_MIX], W0 + WO_WIN, 2048, scr, r, lane); return; }
    r -= 896;
    if (r < 512) { p0_transpose_item(in[IN_AB_WOUT], 1024, 0, 1024, 1024, nullptr, W0 + WO_WOUT, 0, scr, r, lane); return; }
    r -= 512;
    if (r < 2048) { p0_transpose_item(in[IN_C_WIN], 4096, 0, 4096, 1024, in[IN_NORM_MIX] + 1024, W1 + WO_WIN, 0, scr, r, lane); return; }
    r -= 2048;
    if (r < 512) { p0_transpose_item(in[IN_C_WOUT], 1024, 0, 1024, 1024, nullptr, W1 + WO_WOUT, 0, scr, r, lane); return; }
    r -= 512;
    bf16_t* LW = (bf16_t*)(F.ws + WS_LORA);
    if (r < 16) { p0_transpose_item(in[IN_AB_W2], 512, 0, 512, 64, nullptr, LW, 0, scr, r, lane); return; }
    r -= 16;
    if (r < 16) { p0_transpose_item(in[IN_AB_A2], 512, 0, 512, 64, nullptr, LW + 512 * 64, 0, scr, r, lane); return; }
    r -= 16;
    p0_transpose_item(in[IN_AB_G2], 512, 0, 512, 128, nullptr, LW + 2 * 512 * 64, 0, scr, r, lane);
}
constexpr int P0_NITEMS = 16384 + 1024 + 896 + 512 + 2048 + 512 + 64;

template <int SEL> __device__ __forceinline__ void p0_late_weights(const Frame& F, int worker, int nworkers) {
    const int lane = lane_id_v();
    LAS float* scr = (LAS float*)(F.lds + F.wave * 16384);
    const int gw = worker * NWAVES + F.wave, NGW = nworkers * NWAVES;
    if (SEL == 0) {
        for (int it = gw; it < 8192 + 512 + 2048 + 1024; it += NGW) {
            int item;
            if (it < 8192) item = it;
            else if (it < 8192 + 512) item = 16384 + 1920 + (it - 8192);
            else if (it < 8192 + 512 + 2048) item = 16384 + 1920 + 512 + (it - 8192 - 512);
            else item = 8192 + 512 + (it - 8192 - 512 - 2048);
            p0_weight_item(F, item, scr, lane);
        }
    } else {
        for (int it = gw; it < 512 + 6656 + 512; it += NGW) {
            int item;
            if (it < 512) item = 8192 + it;
            else if (it < 512 + 6656) item = 8192 + 1536 + (it - 512);
            else item = 16384 + 1920 + 512 + 2048 + (it - 512 - 6656);
            p0_weight_item(F, item, scr, lane);
        }
    }
}
__device__ __forceinline__ void p0_prologue(const Frame& F) {
    const int lane = lane_id_v(); const int tid = F.wave * 64 + lane; (void)tid;
    LAS float* scr = (LAS float*)(F.lds + F.wave * 16384);
    const int gw = F.wg * NWAVES + F.wave, NGW = F.G * NWAVES;
    for (int it = gw; it < 1920 + 64; it += NGW) p0_weight_item(F, it < 1920 ? 16384 + it : P0_NITEMS - 64 + (it - 1920), scr, lane);
    const float* x = F.in[IN_X]; const float* gain = F.in[IN_NORM_MIX]; const float* win = F.in[IN_AB_WIN];
    bf16_t* XB = (bf16_t*)(F.ws + WS_XB); float* ssp = (float*)(F.ws + WS_SSP); float* db = (float*)(F.ws + WS_DB);
    for (int row = gw; row < NT; row += NGW) {
        const f32x4* xr = (const f32x4*)(x + (size_t)row * 1024) + lane;
        f32x4 v[4]; float s = 0.f; float d[8];
#pragma unroll
        for (int c = 0; c < 8; ++c) d[c] = 0.f;
#pragma unroll
        for (int j = 0; j < 4; ++j) {
            v[j] = xr[64 * j]; s += (v[j].x * v[j].x + v[j].y * v[j].y) + (v[j].z * v[j].z + v[j].w * v[j].w);
            const int k0 = 4 * lane + 256 * j;
            const f32x4 g = *(const f32x4*)(gain + k0);
            const float xv[4] = {v[j].x * g.x, v[j].y * g.y, v[j].z * g.z, v[j].w * g.w};
#pragma unroll
            for (int q = 0; q < 4; ++q) {
                const f32x4 w0 = *(const f32x4*)(win + (size_t)(k0 + q) * 3848 + 2048), w1 = *(const f32x4*)(win + (size_t)(k0 + q) * 3848 + 2052);
                d[0] += xv[q] * w0.x; d[1] += xv[q] * w0.y; d[2] += xv[q] * w0.z; d[3] += xv[q] * w0.w;
                d[4] += xv[q] * w1.x; d[5] += xv[q] * w1.y; d[6] += xv[q] * w1.z; d[7] += xv[q] * w1.w;
            }
        }
        s = wave_sum(s);
        const float rstd = 1.0f / sqrtf(s * (1.0f / 1024.0f) + 1e-6f);
#pragma unroll
        for (int c = 0; c < 8; ++c) d[c] = wave_sum(d[c]) * rstd;
        unsigned long long* o8 = (unsigned long long*)(XB + (size_t)row * 1024) + lane;
#pragma unroll
        for (int j = 0; j < 4; ++j) o8[64 * j] = (unsigned long long)pk2(v[j].x, v[j].y) | ((unsigned long long)pk2(v[j].z, v[j].w) << 32);
        if (lane < 16) ssp[(size_t)row * 16 + lane] = (lane == 0) ? s : 0.f;
        if (lane < 8) { float dv = d[0];
#pragma unroll
            for (int c = 1; c < 8; ++c) dv = (lane == c) ? d[c] : dv;
            db[(size_t)row * 8 + lane] = dv; }
    }
    const float* mem = F.in[IN_MEM]; bf16_t* MH = (bf16_t*)(F.ws + WS_MEMH);
    for (int row = gw; row < NB * NMEM; row += NGW) {
        const f32x4* xr = (const f32x4*)(mem + (size_t)row * 1024) + lane;
        f32x4 v[4]; float s = 0.f;
#pragma unroll
        for (int j = 0; j < 4; ++j) { v[j] = xr[64 * j]; s += (v[j].x * v[j].x + v[j].y * v[j].y) + (v[j].z * v[j].z + v[j].w * v[j].w); }
        s = wave_sum(s);
        const float rstd = 1.0f / sqrtf(s * (1.0f / 1024.0f) + 1e-6f);
        unsigned long long* o8 = (unsigned long long*)(MH + (size_t)row * 1024) + lane;
#pragma unroll
        for (int j = 0; j < 4; ++j) o8[64 * j] = (unsigned long long)pk2(v[j].x * rstd, v[j].y * rstd) | ((unsigned long long)pk2(v[j].z * rstd, v[j].w * rstd) << 32);
    }
    {
        float* rw = (float*)(F.ws + WS_RW);
        for (int idx = F.wg * NTHREADS + tid; idx < 2 * 1024 * 32; idx += F.G * NTHREADS) {
            const int l = idx >> 15, k = (idx >> 5) & 1023, cc = idx & 31;
            const float g = F.in[IN_NORM_FFN][l * 1024 + k];
            float v = 0.f;
            if (cc < 4) v = F.in[IN_MOE_WG][(size_t)l * 4096 + k * 4 + cc] * g; else if (cc < 20) v = F.in[IN_MOE_WE][(size_t)l * 16384 + k * 16 + (cc - 4)] * g;
            rw[idx] = v;
        }
    }
    if (F.wg == 0) { const float* lbp = F.in[IN_C_LB]; float* lb = (float*)(F.ws + WS_LB);
        for (int c = tid; c < 1024; c += NTHREADS) { const float a = lbp[c], b = lbp[1024 + c]; const float mx = fmaxf(a, b), ea = __expf(a - mx), eb = __expf(b - mx); lb[c] = (ea + eb) / (ea + eb) - ea / (ea + eb); } }
}

__device__ __forceinline__ void scan_delta(const Frame& F, int b, int h) {
    const int lane = lane_id_v(); const int tid = F.wave * 64 + lane; (void)tid;
    LAS float* qs = (LAS float*)F.lds;
    LAS float* ks = qs + 64 * 128;
    LAS float* vs = ks + 64 * 128;
    LAS float* os = vs + 64 * 128;
    LAS float* al = os + 64 * 128;
    LAS float* be = al + 64;
    bf16_t* P = (bf16_t*)(F.ws + WS_BIG + BIG_PROJ);
    const float* convw = F.in[IN_AB_CONV];
    const float* db = (const float*)(F.ws + WS_DB);
    const float a_neg = -__expf(F.in[IN_AB_ALOG][h]), dtb = F.in[IN_AB_DTB][h];
    const float* onorm = F.in[IN_AB_ONORM];
    const int i_dv = tid >> 2, part = tid & 3;
    float s[32];
#pragma unroll
    for (int j = 0; j < 32; ++j) s[j] = 0.f;
    for (int c = 0; c < 32; ++c) {
        const int t0 = b * TS + c * 64;
        for (int idx = tid; idx < 64 * 384; idx += NTHREADS) {
            const int t = idx / 384, cc = idx % 384, sct = cc >> 7, col = cc & 127;
            const int gcol = sct * 512 + h * 128 + col;
            float a = 0.f;
#pragma unroll
            for (int j = 0; j < 4; ++j) { const int tl = c * 64 + t - 3 + j; if (tl >= 0) a += convw[j * 1536 + gcol] * bf2f(P[(size_t)(b * TS + tl) * P0LD + gcol]); }
            a = siluf_(a);
            (sct == 0 ? qs : (sct == 1 ? ks : vs))[t * 128 + col] = a;
        }
        if (tid < 64) { const int t = tid; const float la = a_neg * softplusf_(db[(size_t)(t0 + t) * 8 + h] + dtb); al[t] = __expf(la); be[t] = sigmoidf_(db[(size_t)(t0 + t) * 8 + 4 + h]); }
        __syncthreads();
        for (int r = F.wave; r < 128; r += NWAVES) { LAS float* p = (r < 64 ? qs + r * 128 : ks + (r - 64) * 128);
            const float v0 = p[lane], v1 = p[lane + 64]; const float ss = wave_sum(v0 * v0 + v1 * v1);
            const float sc = (1.0f / sqrtf(ss + 1e-6f)) * (r < 64 ? 0.08838834764831845f : 1.0f); p[lane] = v0 * sc; p[lane + 64] = v1 * sc; }
        __syncthreads();
        for (int t = 0; t < 64; ++t) {
            const LAS f32x4* kp = (const LAS f32x4*)(ks + t * 128 + part * 32); const LAS f32x4* qp = (const LAS f32x4*)(qs + t * 128 + part * 32);
            float kt[32], qt[32];
#pragma unroll
            for (int j = 0; j < 8; ++j) { const f32x4 a = kp[j], q = qp[j]; kt[4 * j] = a.x; kt[4 * j + 1] = a.y; kt[4 * j + 2] = a.z; kt[4 * j + 3] = a.w; qt[4 * j] = q.x; qt[4 * j + 1] = q.y; qt[4 * j + 2] = q.z; qt[4 * j + 3] = q.w; }
            float p = 0.f;
#pragma unroll
            for (int j = 0; j < 32; ++j) p += s[j] * kt[j];
            p += __shfl_xor(p, 1); p += __shfl_xor(p, 2);
            const float alpha = al[t], coef = be[t] * (vs[t * 128 + i_dv] - alpha * p);
            float o = 0.f;
#pragma unroll
            for (int j = 0; j < 32; ++j) { s[j] = alpha * s[j] + coef * kt[j]; o += s[j] * qt[j]; }
            o += __shfl_xor(o, 1); o += __shfl_xor(o, 2);
            if (part == 0) os[t * 128 + i_dv] = o;
        }
        __syncthreads();
        for (int t = F.wave; t < 64; t += NWAVES) {
            const float o0 = os[t * 128 + lane], o1 = os[t * 128 + lane + 64];
            const float ss = wave_sum(o0 * o0 + o1 * o1), rs = 1.0f / sqrtf(ss * (1.0f / 128.0f) + 1e-6f);
            bf16_t* gp = P + (size_t)(t0 + t) * P0LD + 1536 + h * 128;
            const float g0 = bf2f(gp[lane]), g1 = bf2f(gp[lane + 64]);
            gp[lane] = (bf16_t)f2bf(o0 * rs * onorm[lane] * siluf_(g0)); gp[lane + 64] = (bf16_t)f2bf(o1 * rs * onorm[lane + 64] * siluf_(g1));
        }
        __syncthreads();
    }
}
__device__ __forceinline__ void scan_rwkv(const Frame& F, int b, int h) {
    const int lane = lane_id_v(); const int tid = F.wave * 64 + lane; (void)tid;
    LAS float* bufA = (LAS float*)F.lds;
    LAS float* bufB = bufA + 4096;
    LAS float* bufC = bufB + 4096;
    LAS float* R = bufC + 8192;
    LAS float* Kb = R + 4096;
    LAS float* V = Kb + 4096;
    LAS float* KK = V + 4096;
    LAS float* halo = KK + 4096;
    LAS float* bonus = halo + 896;
    bf16_t* P = (bf16_t*)(F.ws + WS_BIG + BIG_PROJ);
    const float* mu = F.in[IN_AB_MU];
    const float* w0 = F.in[IN_AB_W0] + h * 64; const float* w2 = F.in[IN_AB_W2] + h * 64;
    const float* a0 = F.in[IN_AB_A0] + h * 64; const float* a2 = F.in[IN_AB_A2] + h * 64;
    const float* g2 = F.in[IN_AB_G2] + h * 64;
    const float* k_k = F.in[IN_AB_KK] + h * 64; const float* k_a = F.in[IN_AB_KA] + h * 64; const float* r_k = F.in[IN_AB_RK] + h * 64;
    const float* ln_w = F.in[IN_AB_LNW] + h * 64; const float* ln_b = F.in[IN_AB_LNB] + h * 64;
    const int vi = tid >> 3, part = tid & 7;
    float s[8];
#pragma unroll
    for (int j = 0; j < 8; ++j) s[j] = 0.f;
    for (int i = tid; i < 896; i += NTHREADS) halo[i] = 0.f;
    __syncthreads();
    for (int c = 0; c < 32; ++c) {
        const int t0 = b * TS + c * 64;
        const LAS float* hcur = halo + (c & 1) * 448; LAS float* hnext = halo + ((c + 1) & 1) * 448;
        for (int idx = tid; idx < 64 * 448; idx += NTHREADS) {
            const int t = idx / 448, col = idx % 448;
            int gc;
            if (col < 64) gc = 2048 + h * 64 + col; else if (col < 128) gc = 2560 + h * 64 + (col - 64); else if (col < 192) gc = 3072 + h * 64 + (col - 128); else gc = 3584 + (col - 192);
            const float cur = bf2f(P[(size_t)(t0 + t) * P0LD + gc]);
            const float prev = (t > 0) ? bf2f(P[(size_t)(t0 + t - 1) * P0LD + gc]) : hcur[col];
            const float sh = cur + mu[gc - 2048] * (prev - cur);
            if (t == 63) hnext[col] = cur;
            if (col < 64) R[t * 64 + col] = sh; else if (col < 128) Kb[t * 64 + col - 64] = sh; else if (col < 192) V[t * 64 + col - 128] = sh;
            else if (col < 256) bufA[t * 64 + col - 192] = tanhf(sh); else if (col < 320) bufB[t * 64 + col - 256] = sh; else bufC[t * 128 + col - 320] = sigmoidf_(sh);
        }
        __syncthreads();
        float wv[8], av[8], gv[8];
        {
            const int j = lane, tb = F.wave * 8;
#pragma unroll
            for (int q = 0; q < 8; ++q) { wv[q] = 0.f; av[q] = 0.f; gv[q] = 0.f; }
            for (int m = 0; m < 64; ++m) { const float x2 = w2[(size_t)m * 512 + j], y2 = a2[(size_t)m * 512 + j];
#pragma unroll
                for (int q = 0; q < 8; ++q) { wv[q] += bufA[(tb + q) * 64 + m] * x2; av[q] += bufB[(tb + q) * 64 + m] * y2; } }
            for (int m = 0; m < 128; ++m) { const float z2 = g2[(size_t)m * 512 + j];
#pragma unroll
                for (int q = 0; q < 8; ++q) gv[q] += bufC[(tb + q) * 128 + m] * z2; }
#pragma unroll
            for (int q = 0; q < 8; ++q) { wv[q] = __expf(-0.6065306597126334f * sigmoidf_(w0[j] + wv[q])); av[q] = sigmoidf_(a0[j] + av[q]); }
        }
        __syncthreads();
        {
            const int j = lane, tb = F.wave * 8;
#pragma unroll
            for (int q = 0; q < 8; ++q) { bufA[(tb + q) * 64 + j] = wv[q]; bufB[(tb + q) * 64 + j] = av[q]; bufC[(tb + q) * 64 + j] = gv[q]; }
#pragma unroll
            for (int q = 0; q < 8; ++q) { const int t = tb + q; const float kv = Kb[t * 64 + j]; const float kx = kv * k_k[j]; const float ss = wave_sum(kx * kx);
                KK[t * 64 + j] = kx * (1.0f / sqrtf(ss + 1e-6f)); const float km = kv * (1.f + (av[q] - 1.f) * k_a[j]); Kb[t * 64 + j] = km;
                const float bs = wave_sum(R[t * 64 + j] * km * r_k[j]); if (j == 0) bonus[t] = bs; }
        }
        __syncthreads();
        LAS float* O = bufC + 4096;
        for (int t = 0; t < 64; ++t) {
            const LAS f32x4* p4;
            float kk[8], ww[8], aa[8], km[8], rr[8];
            p4 = (const LAS f32x4*)(KK + t * 64 + part * 8);   { const f32x4 a = p4[0], c2 = p4[1]; kk[0] = a.x; kk[1] = a.y; kk[2] = a.z; kk[3] = a.w; kk[4] = c2.x; kk[5] = c2.y; kk[6] = c2.z; kk[7] = c2.w; }
            p4 = (const LAS f32x4*)(bufA + t * 64 + part * 8); { const f32x4 a = p4[0], c2 = p4[1]; ww[0] = a.x; ww[1] = a.y; ww[2] = a.z; ww[3] = a.w; ww[4] = c2.x; ww[5] = c2.y; ww[6] = c2.z; ww[7] = c2.w; }
            p4 = (const LAS f32x4*)(bufB + t * 64 + part * 8); { const f32x4 a = p4[0], c2 = p4[1]; aa[0] = a.x; aa[1] = a.y; aa[2] = a.z; aa[3] = a.w; aa[4] = c2.x; aa[5] = c2.y; aa[6] = c2.z; aa[7] = c2.w; }
            p4 = (const LAS f32x4*)(Kb + t * 64 + part * 8);   { const f32x4 a = p4[0], c2 = p4[1]; km[0] = a.x; km[1] = a.y; km[2] = a.z; km[3] = a.w; km[4] = c2.x; km[5] = c2.y; km[6] = c2.z; km[7] = c2.w; }
            p4 = (const LAS f32x4*)(R + t * 64 + part * 8);    { const f32x4 a = p4[0], c2 = p4[1]; rr[0] = a.x; rr[1] = a.y; rr[2] = a.z; rr[3] = a.w; rr[4] = c2.x; rr[5] = c2.y; rr[6] = c2.z; rr[7] = c2.w; }
            const float vv = V[t * 64 + vi];
            float sa = 0.f;
#pragma unroll
            for (int j = 0; j < 8; ++j) sa -= s[j] * kk[j];
            sa += __shfl_xor(sa, 1); sa += __shfl_xor(sa, 2); sa += __shfl_xor(sa, 4);
            float o = 0.f;
#pragma unroll
            for (int j = 0; j < 8; ++j) { s[j] = s[j] * ww[j] + sa * (kk[j] * aa[j]) + vv * km[j]; o += s[j] * rr[j]; }
            o += __shfl_xor(o, 1); o += __shfl_xor(o, 2); o += __shfl_xor(o, 4);
            if (part == 0) O[t * 64 + vi] = o;
        }
        __syncthreads();
        for (int t = F.wave; t < 64; t += NWAVES) {
            const float o = O[t * 64 + lane];
            const float mean = wave_sum(o) * (1.0f / 64.0f); const float dlt = o - mean; const float var = wave_sum(dlt * dlt) * (1.0f / 64.0f);
            float y = dlt * (1.0f / sqrtf(var + 64e-5f)) * ln_w[lane] + ln_b[lane];
            y += bonus[t] * V[t * 64 + lane];
            y *= bufC[t * 64 + lane];
            P[(size_t)(t0 + t) * P0LD + 2048 + h * 64 + lane] = (bf16_t)f2bf(y);
        }
        __syncthreads();
    }
}
__device__ __forceinline__ void scan_hgrn(const Frame& F, int b, int h) {
    const int lane = lane_id_v(); const int tid = F.wave * 64 + lane; (void)tid;
    LAS float* qs = (LAS float*)F.lds;
    LAS float* fs = qs + 64 * 128;
    LAS float* kf = fs + 64 * 128;
    LAS float* is = kf + 64 * 128;
    bf16_t* P = (bf16_t*)(F.ws + WS_BIG + BIG_PROJ);
    const float* onorm = F.in[IN_C_ONORM];
    const int e = tid >> 2, part = tid & 3;
    float s[32];
#pragma unroll
    for (int j = 0; j < 32; ++j) s[j] = 0.f;
    for (int c = 0; c < 32; ++c) {
        const int t0 = b * TS + c * 64;
        for (int idx = tid; idx < 64 * 128; idx += NTHREADS) {
            const int t = idx >> 7, col = idx & 127; const bf16_t* pr = P + (size_t)(t0 + t) * P1LD + h * 128 + col;
            qs[idx] = bf2f(pr[0]); const float lf = h2f_bits(pr[1024]); fs[idx] = __expf(lf); kf[idx] = -expm1f(lf); is[idx] = bf2f(pr[2048]);
        }
        __syncthreads();
        for (int t = 0; t < 64; ++t) {
            const LAS f32x4* fp = (const LAS f32x4*)(fs + t * 128 + part * 32); const LAS f32x4* kp = (const LAS f32x4*)(kf + t * 128 + part * 32); const LAS f32x4* qp = (const LAS f32x4*)(qs + t * 128 + part * 32);
            const float iv = is[t * 128 + e];
            float o = 0.f;
#pragma unroll
            for (int j = 0; j < 8; ++j) { const f32x4 f = fp[j], k = kp[j], q = qp[j];
                s[4 * j] = f.x * s[4 * j] + k.x * iv; o += s[4 * j] * q.x;
                s[4 * j + 1] = f.y * s[4 * j + 1] + k.y * iv; o += s[4 * j + 1] * q.y;
                s[4 * j + 2] = f.z * s[4 * j + 2] + k.z * iv; o += s[4 * j + 2] * q.z;
                s[4 * j + 3] = f.w * s[4 * j + 3] + k.w * iv; o += s[4 * j + 3] * q.w; }
            o += __shfl_xor(o, 1); o += __shfl_xor(o, 2);
            if (part == 0) is[t * 128 + e] = o;
        }
        __syncthreads();
        for (int t = F.wave; t < 64; t += NWAVES) {
            const float o0 = is[t * 128 + lane], o1 = is[t * 128 + lane + 64];
            const float ss = wave_sum(o0 * o0 + o1 * o1), rs = 1.0f / sqrtf(ss * (1.0f / 128.0f) + 1e-6f);
            bf16_t* gp = P + (size_t)(t0 + t) * P1LD + 3072 + h * 128;
            const float g0 = bf2f(gp[lane]), g1 = bf2f(gp[lane + 64]);
            gp[lane] = (bf16_t)f2bf(o0 * rs * onorm[lane] * siluf_(g0)); gp[lane + 64] = (bf16_t)f2bf(o1 * rs * onorm[lane + 64] * siluf_(g1));
        }
        __syncthreads();
    }
}

template <int CTRL> __device__ __forceinline__ float dppf(float v) { return __int_as_float(__builtin_amdgcn_update_dpp(0, __float_as_int(v), CTRL, 0xF, 0xF, true)); }
__device__ __forceinline__ float red8(float v) { v += dppf<0xB1>(v); v += dppf<0x4E>(v); v += dppf<0x141>(v); return v; }
__device__ __forceinline__ float red16(float v) { v = red8(v); v += dppf<0x140>(v); return v; }

__device__ __forceinline__ void scan_delta2(const Frame& F, int b, int h, int qd) {
    const int lane = lane_id_v(); const int tid = F.wave * 64 + lane;
    LAS float* Kc = (LAS float*)F.lds;
    LAS float* Qc = Kc + 64 * 128;
    LAS float* Vc = Qc + 64 * 128;
    LAS float* Oc = Vc + 64 * 32;
    LAS float* al = Oc + 64 * 32;
    LAS float* be = al + 64;
    LAS float* vh = be + 64;
    bf16_t* P = (bf16_t*)(F.ws + WS_BIG + BIG_PROJ);
    const float* convw = F.in[IN_AB_CONV];
    const float* db = (const float*)(F.ws + WS_DB);
    const float a_neg = -__expf(F.in[IN_AB_ALOG][h]), dtb = F.in[IN_AB_DTB][h];
    const int w = F.wave;
    const int vcol = 1024 + h * 128 + qd * 32 + (lane & 31);
    float cwq[4][2], cwk[4][2], cwv[4];
#pragma unroll
    for (int j = 0; j < 4; ++j) { cwq[j][0] = convw[j * 1536 + h * 128 + lane]; cwq[j][1] = convw[j * 1536 + h * 128 + lane + 64];
        cwk[j][0] = convw[j * 1536 + 512 + h * 128 + lane]; cwk[j][1] = convw[j * 1536 + 512 + h * 128 + lane + 64]; cwv[j] = convw[j * 1536 + vcol]; }
    const int r = tid >> 4, part = tid & 15;
    float s[8];
#pragma unroll
    for (int j = 0; j < 8; ++j) s[j] = 0.f;
    if (tid < 192) vh[tid] = 0.f;
    __syncthreads();
    for (int c = 0; c < 32; ++c) {
        const int t0 = b * TS + c * 64;
        const LAS float* vhc = vh + (c & 1) * 96; LAS float* vhn = vh + ((c + 1) & 1) * 96;
        {
            float rq[11][2], rk[11][2], rv[11];
#pragma unroll
            for (int rr = 0; rr < 11; ++rr) {
                const int tl = c * 64 + 8 * w - 3 + rr;
                const bool ok = tl >= 0;
                const bf16_t* row = P + (size_t)(b * TS + (ok ? tl : 0)) * P0LD;
                rq[rr][0] = ok ? bf2f(row[h * 128 + lane]) : 0.f; rq[rr][1] = ok ? bf2f(row[h * 128 + lane + 64]) : 0.f;
                rk[rr][0] = ok ? bf2f(row[512 + h * 128 + lane]) : 0.f; rk[rr][1] = ok ? bf2f(row[512 + h * 128 + lane + 64]) : 0.f;
                const bool prevchunk = (8 * w - 3 + rr) < 0;
                rv[rr] = prevchunk ? vhc[(rr < 3 ? rr : 0) * 32 + (lane & 31)] : bf2f(row[vcol]);
            }
            if (w == 7 && lane < 32) { vhn[lane] = rv[8]; vhn[32 + lane] = rv[9]; vhn[64 + lane] = rv[10]; }
#pragma unroll
            for (int i = 0; i < 8; ++i) {
                const int t = 8 * w + i;
                float q0 = 0.f, q1 = 0.f, k0 = 0.f, k1 = 0.f, vv = 0.f;
#pragma unroll
                for (int j = 0; j < 4; ++j) { q0 += cwq[j][0] * rq[i + j][0]; q1 += cwq[j][1] * rq[i + j][1]; k0 += cwk[j][0] * rk[i + j][0]; k1 += cwk[j][1] * rk[i + j][1]; vv += cwv[j] * rv[i + j]; }
                q0 = siluf_(q0); q1 = siluf_(q1); k0 = siluf_(k0); k1 = siluf_(k1); vv = siluf_(vv);
                const float sq = wave_sum(q0 * q0 + q1 * q1), sk = wave_sum(k0 * k0 + k1 * k1);
                const float cq = (1.0f / sqrtf(sq + 1e-6f)) * 0.08838834764831845f, ck = 1.0f / sqrtf(sk + 1e-6f);
                Qc[t * 128 + lane] = q0 * cq; Qc[t * 128 + lane + 64] = q1 * cq; Kc[t * 128 + lane] = k0 * ck; Kc[t * 128 + lane + 64] = k1 * ck;
                if (lane < 32) Vc[t * 32 + lane] = vv;
            }
            if (lane < 8) { const int t = 8 * w + lane; const float la = a_neg * softplusf_(db[(size_t)(t0 + t) * 8 + h] + dtb); al[t] = __expf(la); be[t] = sigmoidf_(db[(size_t)(t0 + t) * 8 + 4 + h]); }
        }
        __syncthreads();
        {
            const LAS float* kp = Kc + part * 8; const LAS float* qp = Qc + part * 8;
            f32x4 ka = *(const LAS f32x4*)(kp), kb = *(const LAS f32x4*)(kp + 4), qa = *(const LAS f32x4*)(qp), qb = *(const LAS f32x4*)(qp + 4);
            float vv = Vc[r], alpha = al[0], beta = be[0];
            for (int t = 0; t < 64; ++t) {
                const int tn = (t + 1) & 63;
                const f32x4 nka = *(const LAS f32x4*)(kp + tn * 128), nkb = *(const LAS f32x4*)(kp + tn * 128 + 4), nqa = *(const LAS f32x4*)(qp + tn * 128), nqb = *(const LAS f32x4*)(qp + tn * 128 + 4);
                const float nvv = Vc[tn * 32 + r], nal = al[tn], nbe = be[tn];
                float p0 = s[0] * ka.x + s[1] * ka.y, p1 = s[2] * ka.z + s[3] * ka.w, p2 = s[4] * kb.x + s[5] * kb.y, p3 = s[6] * kb.z + s[7] * kb.w;
                const float p = red16((p0 + p1) + (p2 + p3));
                const float coef = beta * (vv - alpha * p);
                s[0] = alpha * s[0] + coef * ka.x; s[1] = alpha * s[1] + coef * ka.y; s[2] = alpha * s[2] + coef * ka.z; s[3] = alpha * s[3] + coef * ka.w;
                s[4] = alpha * s[4] + coef * kb.x; s[5] = alpha * s[5] + coef * kb.y; s[6] = alpha * s[6] + coef * kb.z; s[7] = alpha * s[7] + coef * kb.w;
                float o0 = s[0] * qa.x + s[1] * qa.y, o1 = s[2] * qa.z + s[3] * qa.w, o2 = s[4] * qb.x + s[5] * qb.y, o3 = s[6] * qb.z + s[7] * qb.w;
                const float o = red16((o0 + o1) + (o2 + o3));
                if (part == 0) Oc[t * 32 + r] = o;
                ka = nka; kb = nkb; qa = nqa; qb = nqb; vv = nvv; alpha = nal; beta = nbe;
            }
        }
        __syncthreads();
        {
            const int t = tid >> 3, c4 = (tid & 7) * 4;
            const f32x4 o = *(const LAS f32x4*)(Oc + t * 32 + c4);
            u32x2 wv; wv.x = pk2(o.x, o.y); wv.y = pk2(o.z, o.w);
            *(u32x2*)(P + (size_t)(t0 + t) * P0LD + 1024 + h * 128 + qd * 32 + c4) = wv;
        }
    }
}
__device__ __forceinline__ void fin_delta(const Frame& F) {
    const int lane = lane_id_v();
    bf16_t* P = (bf16_t*)(F.ws + WS_BIG + BIG_PROJ); const float* onorm = F.in[IN_AB_ONORM];
    const float on0 = onorm[lane], on1 = onorm[lane + 64];
    const int gw = F.wg * NWAVES + F.wave, NGW = F.G * NWAVES;
    for (int it = gw; it < NT * 4; it += NGW) {
        const int t = it >> 2, h = it & 3;
        bf16_t* row = P + (size_t)t * P0LD;
        const float o0 = bf2f(row[1024 + h * 128 + lane]), o1 = bf2f(row[1024 + h * 128 + lane + 64]);
        const float g0 = bf2f(row[1536 + h * 128 + lane]), g1 = bf2f(row[1536 + h * 128 + lane + 64]);
        const float ss = wave_sum(o0 * o0 + o1 * o1), rs = 1.0f / sqrtf(ss * (1.0f / 128.0f) + 1e-6f);
        row[1536 + h * 128 + lane] = (bf16_t)f2bf(o0 * rs * on0 * siluf_(g0)); row[1536 + h * 128 + lane + 64] = (bf16_t)f2bf(o1 * rs * on1 * siluf_(g1));
    }
}

__device__ __forceinline__ void scan_rwkv2(const Frame& F, int b, int h) {
    const int lane = lane_id_v(); const int tid = F.wave * 64 + lane;
    LAS float* R = (LAS float*)F.lds;
    LAS float* KM = R + 4096;
    LAS float* V = KM + 4096;
    LAS float* KK = V + 4096;
    LAS float* KA = KK + 4096;
    LAS float* W = KA + 4096;
    LAS bf16_t* TL = (LAS bf16_t*)(W + 4096);
    LAS bf16_t* AL = TL + 64 * 72;
    LAS bf16_t* SG = AL + 64 * 72;
    LAS float* O = (LAS float*)TL;
    LAS bf16_t* GB = SG + 64 * 136;
    LAS float* halo = (LAS float*)(GB + 4096);
    LAS float* bonus = halo + 896;
    bf16_t* P = (bf16_t*)(F.ws + WS_BIG + BIG_PROJ);
    const bf16_t* LW = (const bf16_t*)(F.ws + WS_LORA);
    const float* mu = F.in[IN_AB_MU];
    const float* w0 = F.in[IN_AB_W0] + h * 64; const float* a0 = F.in[IN_AB_A0] + h * 64;
    const float* k_k = F.in[IN_AB_KK] + h * 64; const float* k_a = F.in[IN_AB_KA] + h * 64; const float* r_k = F.in[IN_AB_RK] + h * 64;
    const float* ln_w = F.in[IN_AB_LNW] + h * 64; const float* ln_b = F.in[IN_AB_LNB] + h * 64;
    const int w = F.wave, fr = lane & 15, fq = lane >> 4;
    const int vi = tid >> 3, part = tid & 7;
    float s[8];
#pragma unroll
    for (int j = 0; j < 8; ++j) s[j] = 0.f;
    for (int i = tid; i < 896; i += NTHREADS) halo[i] = 0.f;
    int gc = 0; float muc = 0.f;
    if (tid < 448) { const int col = tid;
        if (col < 64) gc = 2048 + h * 64 + col; else if (col < 128) gc = 2560 + h * 64 + (col - 64); else if (col < 192) gc = 3072 + h * 64 + (col - 128); else gc = 3584 + (col - 192);
        muc = mu[gc - 2048]; }
    __syncthreads();
    for (int c = 0; c < 32; ++c) {
        const int t0 = b * TS + c * 64;
        if (tid < 448) {
            const int col = tid;
            LAS float* hc = halo + (c & 1) * 448; LAS float* hn = halo + ((c + 1) & 1) * 448;
            float prev = hc[col];
            const bf16_t* src = P + (size_t)t0 * P0LD + gc;
#pragma unroll 8
            for (int t = 0; t < 64; ++t) {
                const float cur = bf2f(src[(size_t)t * P0LD]);
                const float sh = cur + muc * (prev - cur);
                prev = cur;
                if (col < 64) R[t * 64 + col] = sh; else if (col < 128) KM[t * 64 + col - 64] = sh; else if (col < 192) V[t * 64 + col - 128] = sh;
                else if (col < 256) TL[t * 72 + col - 192] = (bf16_t)f2bf(tanhf(sh)); else if (col < 320) AL[t * 72 + col - 256] = (bf16_t)f2bf(sh); else SG[t * 136 + col - 320] = (bf16_t)f2bf(sigmoidf_(sh));
            }
            hn[col] = prev;
        }
        __syncthreads();
        {
#pragma unroll
            for (int q = 0; q < 2; ++q) {
                const int id = 2 * w + q, mi = id >> 2, nj = id & 3;
                f32x4 aw = {0.f, 0.f, 0.f, 0.f}, aa = {0.f, 0.f, 0.f, 0.f}, ag = {0.f, 0.f, 0.f, 0.f};
                const int jrow = h * 64 + nj * 16 + fr;
#pragma unroll
                for (int ksx = 0; ksx < 2; ++ksx) {
                    const bf16x8 x1 = *(const LAS bf16x8*)(TL + (mi * 16 + fr) * 72 + ksx * 32 + fq * 8), x2 = *(const LAS bf16x8*)(AL + (mi * 16 + fr) * 72 + ksx * 32 + fq * 8);
                    const bf16x8 y1 = *(const bf16x8*)(LW + (size_t)jrow * 64 + ksx * 32 + fq * 8), y2 = *(const bf16x8*)(LW + 512 * 64 + (size_t)jrow * 64 + ksx * 32 + fq * 8);
                    aw = __builtin_amdgcn_mfma_f32_16x16x32_bf16(x1, y1, aw, 0, 0, 0); aa = __builtin_amdgcn_mfma_f32_16x16x32_bf16(x2, y2, aa, 0, 0, 0);
                }
#pragma unroll
                for (int ksx = 0; ksx < 4; ++ksx) {
                    const bf16x8 x3 = *(const LAS bf16x8*)(SG + (mi * 16 + fr) * 136 + ksx * 32 + fq * 8);
                    const bf16x8 y3 = *(const bf16x8*)(LW + 2 * 512 * 64 + (size_t)jrow * 128 + ksx * 32 + fq * 8);
                    ag = __builtin_amdgcn_mfma_f32_16x16x32_bf16(x3, y3, ag, 0, 0, 0);
                }
                const int j = nj * 16 + fr; const float w0j = w0[j], a0j = a0[j];
                const float awv[4] = {aw.x, aw.y, aw.z, aw.w}, aav[4] = {aa.x, aa.y, aa.z, aa.w}, agv[4] = {ag.x, ag.y, ag.z, ag.w};
#pragma unroll
                for (int rg = 0; rg < 4; ++rg) { const int t = mi * 16 + 4 * fq + rg;
                    W[t * 64 + j] = __expf(-0.6065306597126334f * sigmoidf_(w0j + awv[rg])); KA[t * 64 + j] = sigmoidf_(a0j + aav[rg]); GB[t * 64 + j] = (bf16_t)f2bf(agv[rg]); }
            }
        }
        __syncthreads();
        {
            const int j = lane; const float kkj = k_k[j], kaj = k_a[j], rkj = r_k[j];
#pragma unroll
            for (int q = 0; q < 8; ++q) { const int t = w * 8 + q; const float kv = KM[t * 64 + j], a = KA[t * 64 + j]; const float kx = kv * kkj; const float ss = wave_sum(kx * kx);
                const float kk = kx * (1.0f / sqrtf(ss + 1e-6f)); KK[t * 64 + j] = kk; KA[t * 64 + j] = kk * a; const float km = kv * (1.f + (a - 1.f) * kaj); KM[t * 64 + j] = km;
                const float bs = wave_sum(R[t * 64 + j] * km * rkj); if (j == 0) bonus[t] = bs; }
        }
        __syncthreads();
        {
            const int o8 = part * 8;
            for (int t = 0; t < 64; ++t) {
                const f32x4 k0 = *(const LAS f32x4*)(KK + t * 64 + o8), k1 = *(const LAS f32x4*)(KK + t * 64 + o8 + 4);
                const f32x4 w0v = *(const LAS f32x4*)(W + t * 64 + o8), w1v = *(const LAS f32x4*)(W + t * 64 + o8 + 4);
                const f32x4 a0v = *(const LAS f32x4*)(KA + t * 64 + o8), a1v = *(const LAS f32x4*)(KA + t * 64 + o8 + 4);
                const f32x4 m0 = *(const LAS f32x4*)(KM + t * 64 + o8), m1 = *(const LAS f32x4*)(KM + t * 64 + o8 + 4);
                const f32x4 r0 = *(const LAS f32x4*)(R + t * 64 + o8), r1 = *(const LAS f32x4*)(R + t * 64 + o8 + 4);
                const float vv = V[t * 64 + vi];
                const float sa = -red8(((s[0] * k0.x + s[1] * k0.y) + (s[2] * k0.z + s[3] * k0.w)) + ((s[4] * k1.x + s[5] * k1.y) + (s[6] * k1.z + s[7] * k1.w)));
                s[0] = s[0] * w0v.x + sa * a0v.x + vv * m0.x; s[1] = s[1] * w0v.y + sa * a0v.y + vv * m0.y; s[2] = s[2] * w0v.z + sa * a0v.z + vv * m0.z; s[3] = s[3] * w0v.w + sa * a0v.w + vv * m0.w;
                s[4] = s[4] * w1v.x + sa * a1v.x + vv * m1.x; s[5] = s[5] * w1v.y + sa * a1v.y + vv * m1.y; s[6] = s[6] * w1v.z + sa * a1v.z + vv * m1.z; s[7] = s[7] * w1v.w + sa * a1v.w + vv * m1.w;
                const float o = red8(((s[0] * r0.x + s[1] * r0.y) + (s[2] * r0.z + s[3] * r0.w)) + ((s[4] * r1.x + s[5] * r1.y) + (s[6] * r1.z + s[7] * r1.w)));
                if (part == 0) O[t * 64 + vi] = o;
            }
        }
        __syncthreads();
        for (int t = w; t < 64; t += NWAVES) {
            const float o = O[t * 64 + lane];
            const float mean = wave_sum(o) * (1.0f / 64.0f); const float dlt = o - mean; const float var = wave_sum(dlt * dlt) * (1.0f / 64.0f);
            float y = dlt * (1.0f / sqrtf(var + 64e-5f)) * ln_w[lane] + ln_b[lane];
            y += bonus[t] * V[t * 64 + lane];
            y *= bf2f(GB[t * 64 + lane]);
            P[(size_t)(t0 + t) * P0LD + 2048 + h * 64 + lane] = (bf16_t)f2bf(y);
        }
        __syncthreads();
    }
}

__device__ __forceinline__ void scan_hgrn2(const Frame& F, int b, int h, int qd) {
    const int lane = lane_id_v(); const int tid = F.wave * 64 + lane;
    LAS float* qs = (LAS float*)F.lds;
    LAS float* fs = qs + 64 * 128;
    LAS float* kf = fs + 64 * 128;
    LAS float* is = kf + 64 * 128;
    bf16_t* P = (bf16_t*)(F.ws + WS_BIG + BIG_PROJ);
    const int e = tid >> 4, part = tid & 15;
    float s[8];
#pragma unroll
    for (int j = 0; j < 8; ++j) s[j] = 0.f;
    for (int c = 0; c < 32; ++c) {
        const int t0 = b * TS + c * 64;
        {
            const int t = tid >> 3, c16 = (tid & 7) * 16;
            const bf16_t* pr = P + (size_t)(t0 + t) * P1LD + h * 128 + c16;
            const u32x4 qa = *(const u32x4*)pr, qb = *(const u32x4*)(pr + 8), la = *(const u32x4*)(pr + 1024), lb2 = *(const u32x4*)(pr + 1024 + 8);
            const unsigned qv[8] = {qa.x, qa.y, qa.z, qa.w, qb.x, qb.y, qb.z, qb.w}, lv[8] = {la.x, la.y, la.z, la.w, lb2.x, lb2.y, lb2.z, lb2.w};
#pragma unroll
            for (int j = 0; j < 8; ++j) {
                qs[t * 128 + c16 + 2 * j] = bf2f((unsigned short)(qv[j] & 0xffffu)); qs[t * 128 + c16 + 2 * j + 1] = bf2f((unsigned short)(qv[j] >> 16));
                const float l0 = h2f_bits((unsigned short)(lv[j] & 0xffffu)), l1 = h2f_bits((unsigned short)(lv[j] >> 16));
                fs[t * 128 + c16 + 2 * j] = __expf(l0); fs[t * 128 + c16 + 2 * j + 1] = __expf(l1); kf[t * 128 + c16 + 2 * j] = -expm1f(l0); kf[t * 128 + c16 + 2 * j + 1] = -expm1f(l1);
            }
            const int c4 = (tid & 7) * 4;
            const u32x2 iv = *(const u32x2*)(P + (size_t)(t0 + t) * P1LD + 2048 + h * 128 + qd * 32 + c4);
            is[t * 32 + c4] = bf2f((unsigned short)(iv.x & 0xffffu)); is[t * 32 + c4 + 1] = bf2f((unsigned short)(iv.x >> 16)); is[t * 32 + c4 + 2] = bf2f((unsigned short)(iv.y & 0xffffu)); is[t * 32 + c4 + 3] = bf2f((unsigned short)(iv.y >> 16));
        }
        __syncthreads();
        {
            const int o8 = part * 8;
            for (int t = 0; t < 64; ++t) {
                const f32x4 f0 = *(const LAS f32x4*)(fs + t * 128 + o8), f1 = *(const LAS f32x4*)(fs + t * 128 + o8 + 4);
                const f32x4 k0 = *(const LAS f32x4*)(kf + t * 128 + o8), k1 = *(const LAS f32x4*)(kf + t * 128 + o8 + 4);
                const f32x4 q0 = *(const LAS f32x4*)(qs + t * 128 + o8), q1 = *(const LAS f32x4*)(qs + t * 128 + o8 + 4);
                const float iv = is[t * 32 + e];
                s[0] = f0.x * s[0] + k0.x * iv; s[1] = f0.y * s[1] + k0.y * iv; s[2] = f0.z * s[2] + k0.z * iv; s[3] = f0.w * s[3] + k0.w * iv;
                s[4] = f1.x * s[4] + k1.x * iv; s[5] = f1.y * s[5] + k1.y * iv; s[6] = f1.z * s[6] + k1.z * iv; s[7] = f1.w * s[7] + k1.w * iv;
                const float o = red16(((s[0] * q0.x + s[1] * q0.y) + (s[2] * q0.z + s[3] * q0.w)) + ((s[4] * q1.x + s[5] * q1.y) + (s[6] * q1.z + s[7] * q1.w)));
                if (part == 0) is[t * 32 + e] = o;
            }
        }
        __syncthreads();
        {
            const int t = tid >> 3, c4 = (tid & 7) * 4;
            const f32x4 o = *(const LAS f32x4*)(is + t * 32 + c4);
            u32x2 wv; wv.x = pk2(o.x, o.y); wv.y = pk2(o.z, o.w);
            *(u32x2*)(P + (size_t)(t0 + t) * P1LD + 2048 + h * 128 + qd * 32 + c4) = wv;
        }
        __syncthreads();
    }
}
__device__ __forceinline__ void fin_hgrn(const Frame& F) {
    const int lane = lane_id_v();
    bf16_t* P = (bf16_t*)(F.ws + WS_BIG + BIG_PROJ); const float* onorm = F.in[IN_C_ONORM];
    const float on0 = onorm[lane], on1 = onorm[lane + 64];
    const int gw = F.wg * NWAVES + F.wave, NGW = F.G * NWAVES;
    for (int it = gw; it < NT * 8; it += NGW) {
        const int t = it >> 3, h = it & 7;
        bf16_t* row = P + (size_t)t * P1LD;
        const float o0 = bf2f(row[2048 + h * 128 + lane]), o1 = bf2f(row[2048 + h * 128 + lane + 64]);
        const float g0 = bf2f(row[3072 + h * 128 + lane]), g1 = bf2f(row[3072 + h * 128 + lane + 64]);
        const float ss = wave_sum(o0 * o0 + o1 * o1), rs = 1.0f / sqrtf(ss * (1.0f / 128.0f) + 1e-6f);
        row[3072 + h * 128 + lane] = (bf16_t)f2bf(o0 * rs * on0 * siluf_(g0)); row[3072 + h * 128 + lane + 64] = (bf16_t)f2bf(o1 * rs * on1 * siluf_(g1));
    }
}

#define MFMA32(a, b, c) __builtin_amdgcn_mfma_f32_16x16x32_bf16(a, b, c, 0, 0, 0)
#define MFMA16(a, b, c) __builtin_amdgcn_mfma_f32_16x16x16bf16_1k(a, b, c, 0, 0, 0)
__device__ __forceinline__ f32x4 mm_tile(const LAS bf16_t* A, int lda, const LAS bf16_t* B, int ldb, int nks, f32x4 acc, int fr, int fq) {
    for (int ksx = 0; ksx < nks; ++ksx) acc = MFMA32(*(const LAS bf16x8*)(A + fr * lda + ksx * 32 + fq * 8), *(const LAS bf16x8*)(B + fr * ldb + ksx * 32 + fq * 8), acc);
    return acc;
}
__device__ __forceinline__ void lds_w4(LAS bf16_t* p, f32x4 v) { u32x2 w; w.x = pk2(v.x, v.y); w.y = pk2(v.z, v.w); *(LAS u32x2*)p = w; }
__device__ __forceinline__ float rdlane(float v, int l) { return __int_as_float(__builtin_amdgcn_readlane(__float_as_int(v), l)); }
__device__ __forceinline__ float wsum(float v) { v = red16(v); return (rdlane(v, 0) + rdlane(v, 16)) + (rdlane(v, 32) + rdlane(v, 48)); }

struct HoBuf { __amdgpu_buffer_rsrc_t r; };
__device__ __forceinline__ HoBuf ho_buf(float* base, unsigned bytes) {
    const unsigned long long a = (unsigned long long)base;
    const unsigned lo = __builtin_amdgcn_readfirstlane((unsigned)a), hi = __builtin_amdgcn_readfirstlane((unsigned)(a >> 32));
    HoBuf h; h.r = __builtin_amdgcn_make_buffer_rsrc((void*)(((unsigned long long)hi << 32) | lo), 0, bytes, 0x00020000); return h;
}
__device__ __forceinline__ void ho_store(const HoBuf& hb, unsigned byteoff, f32x4 v) {
    __builtin_amdgcn_raw_buffer_store_b128(__builtin_bit_cast(u32x4, v), hb.r, byteoff, 0, 16);
}
__device__ __forceinline__ f32x4 ho_load(const HoBuf& hb, unsigned byteoff) {
    return __builtin_bit_cast(f32x4, __builtin_amdgcn_raw_buffer_load_b128(hb.r, byteoff, 0, 16));
}
__device__ __forceinline__ void ho_wait(unsigned* flag, unsigned need, unsigned* tmo, int wave, int lane) {
    if (wave == 0 && lane == 0) { unsigned sp = 0;
        while (__hip_atomic_load(flag, __ATOMIC_RELAXED, __HIP_MEMORY_SCOPE_AGENT) < need) { __builtin_amdgcn_s_sleep(2); if (++sp > (1u << 24)) { __hip_atomic_store(tmo, 1u, __ATOMIC_RELAXED, __HIP_MEMORY_SCOPE_AGENT); break; } } }
    __syncthreads();
}

__device__ __forceinline__ void scan_delta3(const Frame& F, int b, int h, int jpart, int kparts) {
    const int lane0 = lane_id_v(); const int w = F.wave;
    LAS bf16_t* Qb = (LAS bf16_t*)F.lds;
    LAS bf16_t* Kb = Qb + 64 * 136;
    LAS float* Of = (LAS float*)F.lds;
    LAS bf16_t* Kdt = Kb + 64 * 136;
    LAS bf16_t* Vt = Kdt + 128 * 72;
    LAS bf16_t* St = Vt + 128 * 72;
    LAS bf16_t* Aoff = St + 128 * 136;
    LAS bf16_t* QKm = Aoff + 64 * 72;
    LAS bf16_t* Vn = QKm + 64 * 72;
    LAS bf16_t* Dg = Vn + 128 * 72;
    LAS float* Adg = (LAS float*)(Dg + 4 * 16 * 24);
    LAS float* sc = Adg + 4 * 16 * 17;
    static_assert((64 * 136 * 2 * 2 + 128 * 72 * 2 * 3 + 128 * 136 * 2 + 64 * 72 * 2 * 2 + 4 * 16 * 24 * 2 + 4 * 16 * 17 * 4 + 260 * 4) <= LDS_MISC, "delta3 LDS");
    bf16_t* P = (bf16_t*)(F.ws + WS_BIG + BIG_PROJ);
    const HoBuf hb = ho_buf((float*)(F.ws + WS_HOA) + (size_t)(b * 4 + h) * 16384, 65536);
    unsigned* flag = (unsigned*)(F.ws + WS_FLAGS) + 64 + (b * 4 + h); unsigned* tmo = (unsigned*)(F.ws + WS_FLAGS) + 255;
    const float* convw = F.in[IN_AB_CONV];
    const float* db = (const float*)(F.ws + WS_DB);
    const float a_neg = -__expf(F.in[IN_AB_ALOG][h]), dtb = F.in[IN_AB_DTB][h];
    const float* onorm = F.in[IN_AB_ONORM];
    float cw[3][4][2];
#pragma unroll
    for (int sct = 0; sct < 3; ++sct)
#pragma unroll
        for (int j = 0; j < 4; ++j) { cw[sct][j][0] = convw[j * 1536 + sct * 512 + h * 128 + 2 * lane0]; cw[sct][j][1] = convw[j * 1536 + sct * 512 + h * 128 + 2 * lane0 + 1]; }
    for (int i = w * 64 + lane0; i < (128 * 136 + 64 * 72 * 2 + 128 * 72) / 2; i += NTHREADS) ((LAS unsigned*)St)[i] = 0u;
    unsigned pacc = 0u, plast = 0u;
    f32x4 sacc[8];
#pragma unroll
    for (int i = 0; i < 8; ++i) sacc[i] = (f32x4){0.f, 0.f, 0.f, 0.f};
    __syncthreads();
    unsigned rawu[3][11]; float dbv0, dbv1;
#define DELTA_FETCH(cc, ln) do { const int cc_ = (cc) < 32 ? (cc) : 31; \
        dbv0 = db[(size_t)(b * TS + cc_ * 64 + (ln)) * 8 + h]; dbv1 = db[(size_t)(b * TS + cc_ * 64 + (ln)) * 8 + 4 + h]; \
        _Pragma("unroll") for (int rr = 0; rr < 11; ++rr) { const int tl = cc_ * 64 + 8 * w - 3 + rr; \
            const unsigned* row = (const unsigned*)(P + (size_t)(b * TS + (tl >= 0 ? tl : 0)) * P0LD + h * 128) + (ln); \
            _Pragma("unroll") for (int sct = 0; sct < 3; ++sct) rawu[sct][rr] = row[sct * 256]; } } while (0)
    DELTA_FETCH(jpart, lane0);
    for (int c = jpart; c < 32; c += kparts) {
        int lane = lane0; asm volatile("" : "+v"(lane));
        const int fr = lane & 15, fq = lane >> 4;
        const int t0 = b * TS + c * 64;
        if (PROBE_STAGE >= 0) plast = (unsigned)__builtin_amdgcn_s_memrealtime();
        unsigned gq[8];
#pragma unroll
        for (int i = 0; i < 8; ++i) gq[i] = *((const unsigned*)(P + (size_t)(t0 + w + 8 * i) * P0LD + 1536 + h * 128) + lane);
        {
            const float la = a_neg * softplusf_(dbv0 + dtb);
            const float bet = sigmoidf_(dbv1);
            float g = la;
#pragma unroll
            for (int o = 1; o < 64; o <<= 1) { const float n = __shfl_up(g, o); if (lane >= o) g += n; }
            const float gL = rdlane(g, 63);
            if (w == 0) { sc[lane] = g; sc[64 + lane] = __expf(g); sc[128 + lane] = bet * __expf(g); sc[192 + lane] = bet; if (lane == 0) sc[256] = __expf(gL); }
            float raw[3][11][2];
#pragma unroll
            for (int rr = 0; rr < 11; ++rr) { const bool ok = (c * 64 + 8 * w - 3 + rr) >= 0;
#pragma unroll
                for (int sct = 0; sct < 3; ++sct) { raw[sct][rr][0] = ok ? bf2f((unsigned short)(rawu[sct][rr] & 0xffffu)) : 0.f; raw[sct][rr][1] = ok ? bf2f((unsigned short)(rawu[sct][rr] >> 16)) : 0.f; } }
            DELTA_FETCH(c + kparts, lane);
            float kd0[8], kd1[8], vt0[8], vt1[8];
#pragma unroll
            for (int i = 0; i < 8; ++i) {
                const int t = 8 * w + i;
                float x[3][2];
#pragma unroll
                for (int sct = 0; sct < 3; ++sct) { float a0 = 0.f, a1 = 0.f;
#pragma unroll
                    for (int j = 0; j < 4; ++j) { a0 += cw[sct][j][0] * raw[sct][i + j][0]; a1 += cw[sct][j][1] * raw[sct][i + j][1]; }
                    x[sct][0] = siluf_(a0); x[sct][1] = siluf_(a1); }
                const float sq = wsum(x[0][0] * x[0][0] + x[0][1] * x[0][1]), sk = wsum(x[1][0] * x[1][0] + x[1][1] * x[1][1]);
                const float cq = (1.0f / sqrtf(sq + 1e-6f)) * 0.08838834764831845f, ck = 1.0f / sqrtf(sk + 1e-6f);
                const float egr = __expf(gL - rdlane(g, t));
                *(LAS unsigned*)(Qb + t * 136 + 2 * lane) = pk2(x[0][0] * cq, x[0][1] * cq);
                const float k0 = x[1][0] * ck, k1 = x[1][1] * ck;
                *(LAS unsigned*)(Kb + t * 136 + 2 * lane) = pk2(k0, k1);
                kd0[i] = k0 * egr; kd1[i] = k1 * egr; vt0[i] = x[2][0]; vt1[i] = x[2][1];
            }
            *(LAS u32x4*)(Kdt + (2 * lane) * 72 + 8 * w) = (u32x4){pk2(kd0[0], kd0[1]), pk2(kd0[2], kd0[3]), pk2(kd0[4], kd0[5]), pk2(kd0[6], kd0[7])};
            *(LAS u32x4*)(Kdt + (2 * lane + 1) * 72 + 8 * w) = (u32x4){pk2(kd1[0], kd1[1]), pk2(kd1[2], kd1[3]), pk2(kd1[4], kd1[5]), pk2(kd1[6], kd1[7])};
            *(LAS u32x4*)(Vt + (2 * lane) * 72 + 8 * w) = (u32x4){pk2(vt0[0], vt0[1]), pk2(vt0[2], vt0[3]), pk2(vt0[4], vt0[5]), pk2(vt0[6], vt0[7])};
            *(LAS u32x4*)(Vt + (2 * lane + 1) * 72 + 8 * w) = (u32x4){pk2(vt1[0], vt1[1]), pk2(vt1[2], vt1[3]), pk2(vt1[4], vt1[5]), pk2(vt1[6], vt1[7])};
        }
        __syncthreads();
        if (PROBE_STAGE >= 0) { const unsigned tn = (unsigned)__builtin_amdgcn_s_memrealtime(); if (PROBE_STAGE == 0) pacc += tn - plast; plast = tn; }
        {
            for (int id = w; id < 20; id += NWAVES) {
                const int which = id / 10, tix = id % 10;
                const int bi = (tix < 1) ? 0 : (tix < 3 ? 1 : (tix < 6 ? 2 : 3)); const int bj = tix - (bi * (bi + 1)) / 2;
                f32x4 acc = {0.f, 0.f, 0.f, 0.f};
                acc = mm_tile(Kb + bj * 16 * 136, 136, (which ? Qb : Kb) + bi * 16 * 136, 136, 4, acc, fr, fq);
                const int i = 16 * bi + fr; const float gi = sc[i], bi_ = sc[192 + i];
                const float av[4] = {acc.x, acc.y, acc.z, acc.w}; float ov[4];
#pragma unroll
                for (int rg = 0; rg < 4; ++rg) { const int j = 16 * bj + 4 * fq + rg; const float dec = __expf(gi - sc[j]);
                    ov[rg] = which ? ((j <= i) ? av[rg] * dec : 0.f) : ((j < i) ? bi_ * av[rg] * dec : 0.f); }
                if (which) lds_w4(QKm + i * 72 + 16 * bj + 4 * fq, (f32x4){ov[0], ov[1], ov[2], ov[3]});
                else if (bi == bj) { LAS float* d = Adg + (bi * 16 + fr) * 17 + 4 * fq; d[0] = ov[0]; d[1] = ov[1]; d[2] = ov[2]; d[3] = ov[3]; }
                else lds_w4(Aoff + i * 72 + 16 * bj + 4 * fq, (f32x4){-ov[0], -ov[1], -ov[2], -ov[3]});
            }
        }
        __syncthreads();
        if (PROBE_STAGE >= 0) { const unsigned tn = (unsigned)__builtin_amdgcn_s_memrealtime(); if (PROBE_STAGE == 1) pacc += tn - plast; plast = tn; }
        f32x4 y[4], qs[4];
        if (w < 4 && lane < 16) { float x[16]; const LAS float* a = Adg + w * 16 * 17;
#pragma unroll
            for (int i = 0; i < 16; ++i) { float v = (i == lane) ? 1.f : 0.f;
#pragma unroll
                for (int k = 0; k < i; ++k) v -= a[i * 17 + k] * x[k];
                x[i] = v; Dg[(w * 16 + i) * 24 + lane] = (bf16_t)f2bf(v); } }
        if (c > 0) ho_wait(flag, (unsigned)c, tmo, w, lane); else __syncthreads();
#pragma unroll
        for (int dk = 0; dk < 8; dk += 2) {
            const u32x4 ldv = __builtin_bit_cast(u32x4, ho_load(hb, (unsigned)(((w * 64 + lane) * 4 + (dk >> 1)) * 16)));
            const f32x4 z0 = {bf2f((unsigned short)(ldv.x & 0xffffu)), bf2f((unsigned short)(ldv.x >> 16)), bf2f((unsigned short)(ldv.y & 0xffffu)), bf2f((unsigned short)(ldv.y >> 16))};
            const f32x4 z1 = {bf2f((unsigned short)(ldv.z & 0xffffu)), bf2f((unsigned short)(ldv.z >> 16)), bf2f((unsigned short)(ldv.w & 0xffffu)), bf2f((unsigned short)(ldv.w >> 16))};
            sacc[dk] = (c > 0) ? z0 : (f32x4){0.f, 0.f, 0.f, 0.f}; sacc[dk + 1] = (c > 0) ? z1 : (f32x4){0.f, 0.f, 0.f, 0.f}; }
#pragma unroll
        for (int dk = 0; dk < 8; ++dk) {
            lds_w4(St + (16 * w + fr) * 136 + 16 * dk + 4 * fq, sacc[dk]); }
        asm volatile("s_waitcnt lgkmcnt(0)" ::: "memory");
        {
            const LAS bf16_t* Sw = St + (16 * w) * 136;
#pragma unroll
            for (int mi = 0; mi < 4; ++mi) {
                f32x4 x = mm_tile(Kb + mi * 16 * 136, 136, Sw, 136, 4, (f32x4){0.f, 0.f, 0.f, 0.f}, fr, fq);
                qs[mi] = mm_tile(Qb + mi * 16 * 136, 136, Sw, 136, 4, (f32x4){0.f, 0.f, 0.f, 0.f}, fr, fq);
                const bf16x4 vv = *(const LAS bf16x4*)(Vt + (16 * w + fr) * 72 + 16 * mi + 4 * fq);
                const f32x4 be4 = *(const LAS f32x4*)(sc + 192 + 16 * mi + 4 * fq), bg4 = *(const LAS f32x4*)(sc + 128 + 16 * mi + 4 * fq);
                y[mi].x = be4.x * bf2f((unsigned short)vv.x) - bg4.x * x.x; y[mi].y = be4.y * bf2f((unsigned short)vv.y) - bg4.y * x.y;
                y[mi].z = be4.z * bf2f((unsigned short)vv.z) - bg4.z * x.z; y[mi].w = be4.w * bf2f((unsigned short)vv.w) - bg4.w * x.w;
            }
        }
        __syncthreads();
        if (PROBE_STAGE >= 0) { const unsigned tn = (unsigned)__builtin_amdgcn_s_memrealtime(); if (PROBE_STAGE == 2) pacc += tn - plast; plast = tn; }
        {
            LAS bf16_t* Vw = Vn + (16 * w) * 72;
#pragma unroll
            for (int bb = 0; bb < 4; ++bb) {
                f32x4 acc = y[bb];
                if (bb >= 1) acc = mm_tile(Aoff + bb * 16 * 72, 72, Vw, 72, (bb + 1) / 2, acc, fr, fq);
                u32x2 pk; pk.x = pk2(acc.x, acc.y); pk.y = pk2(acc.z, acc.w);
                const bf16x4 dgf = *(const LAS bf16x4*)(Dg + (bb * 16 + fr) * 24 + 4 * fq);
                const f32x4 vb = MFMA16(dgf, __builtin_bit_cast(bf16x4, pk), ((f32x4){0.f, 0.f, 0.f, 0.f}));
                lds_w4(Vw + fr * 72 + 16 * bb + 4 * fq, vb);
                asm volatile("s_waitcnt lgkmcnt(0)" ::: "memory");
            }
            const float gl = sc[256];
#pragma unroll
            for (int mi = 0; mi < 4; ++mi) {
                const f32x4 eg4 = *(const LAS f32x4*)(sc + 64 + 16 * mi + 4 * fq);
                f32x4 o = qs[mi] * eg4;
                o = mm_tile(QKm + mi * 16 * 72, 72, Vw, 72, 2, o, fr, fq);
                qs[mi] = o;
            }
#pragma unroll
            for (int dk = 0; dk < 8; ++dk) {
                f32x4 sn = sacc[dk] * gl;
                sn = mm_tile(Kdt + dk * 16 * 72, 72, Vw, 72, 2, sn, fr, fq);
                sacc[dk] = sn;
                lds_w4(St + (16 * w + fr) * 136 + 16 * dk + 4 * fq, sn);
            }
        }
        if (c < 31) {
#pragma unroll
            for (int dk = 0; dk < 8; dk += 2) { u32x4 pv; pv.x = pk2(sacc[dk].x, sacc[dk].y); pv.y = pk2(sacc[dk].z, sacc[dk].w); pv.z = pk2(sacc[dk + 1].x, sacc[dk + 1].y); pv.w = pk2(sacc[dk + 1].z, sacc[dk + 1].w);
                ho_store(hb, (unsigned)(((w * 64 + lane) * 4 + (dk >> 1)) * 16), __builtin_bit_cast(f32x4, pv)); }
            asm volatile("s_waitcnt vmcnt(0)" ::: "memory");
        }
        __syncthreads();
        if (c < 31 && w == 0 && lane == 0) __hip_atomic_store(flag, (unsigned)(c + 1), __ATOMIC_RELAXED, __HIP_MEMORY_SCOPE_AGENT);
        if (PROBE_STAGE >= 0) { const unsigned tn = (unsigned)__builtin_amdgcn_s_memrealtime(); if (PROBE_STAGE == 3) pacc += tn - plast; plast = tn; }
#pragma unroll
        for (int mi = 0; mi < 4; ++mi) { LAS float* op = Of + (16 * mi + 4 * fq) * 132 + 16 * w + fr; op[0] = qs[mi].x; op[132] = qs[mi].y; op[264] = qs[mi].z; op[396] = qs[mi].w; }
        __syncthreads();
        if (PROBE_STAGE >= 0) { const unsigned tn = (unsigned)__builtin_amdgcn_s_memrealtime(); if (PROBE_STAGE == 4) pacc += tn - plast; plast = tn; }
        const float on0 = onorm[2 * lane], on1 = onorm[2 * lane + 1];
#pragma unroll
        for (int i = 0; i < 8; ++i) {
            const int t = w + 8 * i;
            const f32x2 ov = *(const LAS f32x2*)(Of + t * 132 + 2 * lane); const float o0 = ov.x, o1 = ov.y;
            const float ss = wsum(o0 * o0 + o1 * o1), rs = 1.0f / sqrtf(ss * (1.0f / 128.0f) + 1e-6f);
            const float g0 = bf2f((unsigned short)(gq[i] & 0xffffu)), g1 = bf2f((unsigned short)(gq[i] >> 16));
            *((unsigned*)(P + (size_t)(t0 + t) * P0LD + 1536 + h * 128) + lane) = pk2(o0 * rs * on0 * siluf_(g0), o1 * rs * on1 * siluf_(g1));
        }
        __syncthreads();
        if (PROBE_STAGE >= 0) { const unsigned tn = (unsigned)__builtin_amdgcn_s_memrealtime(); if (PROBE_STAGE == 5) pacc += tn - plast; plast = tn; }
    }
    if (PROBE_STAGE >= 0 && F.wg == 0 && w == 0 && lane0 == 0) __hip_atomic_store((unsigned*)(F.ws + WS_CTL + 20484), pacc, __ATOMIC_RELAXED, __HIP_MEMORY_SCOPE_AGENT);
}

__device__ __forceinline__ void scan_hgrn3(const Frame& F, int b, int h, int jpart, int kparts) {
    const int lane0 = lane_id_v(); const int w = F.wave;
    LAS bf16_t* Qd = (LAS bf16_t*)F.lds;
    LAS bf16_t* Kp = Qd + 64 * 136;
    LAS bf16_t* Kpt = Kp + 64 * 136;
    LAS bf16_t* Vt = Kpt + 128 * 72;
    LAS bf16_t* Sc = Vt + 128 * 72;
    LAS bf16_t* Zt = Sc + 64 * 72;
    LAS float* Of = (LAS float*)(Zt + 128 * 136);
    LAS float* gl = Of + 64 * 132;
    LAS float* seg = gl + 128;
    static_assert((64 * 136 * 2 * 2 + 128 * 72 * 2 * 2 + 64 * 72 * 2 + 128 * 136 * 2 + 64 * 132 * 4 + 128 * 4 + 512 * 4) <= LDS_MISC, "hgrn3 LDS");
    bf16_t* P = (bf16_t*)(F.ws + WS_BIG + BIG_PROJ);
    const HoBuf hb = ho_buf((float*)(F.ws + WS_HOC) + (size_t)(b * 8 + h) * 16384, 65536);
    unsigned* flag = (unsigned*)(F.ws + WS_FLAGS) + 96 + (b * 8 + h); unsigned* tmo = (unsigned*)(F.ws + WS_FLAGS) + 255;
    const float* onorm = F.in[IN_C_ONORM];
    for (int i = w * 64 + lane0; i < (64 * 72 + 128 * 136) / 2; i += NTHREADS) ((LAS unsigned*)Sc)[i] = 0u;
    f32x4 zacc[8];
#pragma unroll
    for (int i = 0; i < 8; ++i) zacc[i] = (f32x4){0.f, 0.f, 0.f, 0.f};
    __syncthreads();
    for (int c = jpart; c < 32; c += kparts) {
        int lane = lane0; asm volatile("" : "+v"(lane));
        const int tid = w * 64 + lane, fr = lane & 15, fq = lane >> 4, d = tid & 127, sg = tid >> 7;
        const int t0 = b * TS + c * 64;
        {
            float G[16], q[16], v[16], lf[16];
            const bf16_t* pr = P + (size_t)(t0 + 16 * sg) * P1LD + h * 128 + d;
#pragma unroll
            for (int i = 0; i < 16; ++i) { q[i] = bf2f(pr[(size_t)i * P1LD]); lf[i] = h2f_bits(pr[(size_t)i * P1LD + 1024]); v[i] = bf2f(pr[(size_t)i * P1LD + 2048]); }
            float run = 0.f;
#pragma unroll
            for (int i = 0; i < 16; ++i) { run += lf[i]; G[i] = run; }
            seg[sg * 128 + d] = run;
            __syncthreads();
            float off = 0.f;
#pragma unroll
            for (int s2 = 0; s2 < 3; ++s2) if (s2 < sg) off += seg[s2 * 128 + d];
            float kpv[16];
#pragma unroll
            for (int i = 0; i < 16; ++i) {
                const int t = 16 * sg + i; const float Gt = off + G[i];
                const float qd = q[i] * __expf(Gt); kpv[i] = -expm1f(lf[i]) * __expf(fminf(-Gt, 80.f));
                Qd[t * 136 + d] = (bf16_t)f2bf(qd); Kp[t * 136 + d] = (bf16_t)f2bf(kpv[i]);
            }
            *(LAS u32x4*)(Kpt + d * 72 + 16 * sg) = (u32x4){pk2(kpv[0], kpv[1]), pk2(kpv[2], kpv[3]), pk2(kpv[4], kpv[5]), pk2(kpv[6], kpv[7])};
            *(LAS u32x4*)(Kpt + d * 72 + 16 * sg + 8) = (u32x4){pk2(kpv[8], kpv[9]), pk2(kpv[10], kpv[11]), pk2(kpv[12], kpv[13]), pk2(kpv[14], kpv[15])};
            *(LAS u32x4*)(Vt + d * 72 + 16 * sg) = (u32x4){pk2(v[0], v[1]), pk2(v[2], v[3]), pk2(v[4], v[5]), pk2(v[6], v[7])};
            *(LAS u32x4*)(Vt + d * 72 + 16 * sg + 8) = (u32x4){pk2(v[8], v[9]), pk2(v[10], v[11]), pk2(v[12], v[13]), pk2(v[14], v[15])};
            if (sg == 3) gl[d] = __expf(off + G[15]);
        }
        __syncthreads();
        for (int id = w; id < 10; id += NWAVES) {
            const int bi = (id < 1) ? 0 : (id < 3 ? 1 : (id < 6 ? 2 : 3)); const int bj = id - (bi * (bi + 1)) / 2;
            const f32x4 acc = mm_tile(Kp + bj * 16 * 136, 136, Qd + bi * 16 * 136, 136, 4, (f32x4){0.f, 0.f, 0.f, 0.f}, fr, fq);
            const int i = 16 * bi + fr, j0 = 16 * bj + 4 * fq;
            lds_w4(Sc + i * 72 + j0, (f32x4){(j0 <= i) ? acc.x : 0.f, (j0 + 1 <= i) ? acc.y : 0.f, (j0 + 2 <= i) ? acc.z : 0.f, (j0 + 3 <= i) ? acc.w : 0.f});
        }
        __syncthreads();
        if (c > 0) ho_wait(flag, (unsigned)c, tmo, w, lane);
#pragma unroll
        for (int dk = 0; dk < 8; dk += 2) {
            const u32x4 ldv = __builtin_bit_cast(u32x4, ho_load(hb, (unsigned)(((w * 64 + lane) * 4 + (dk >> 1)) * 16)));
            const f32x4 z0 = {bf2f((unsigned short)(ldv.x & 0xffffu)), bf2f((unsigned short)(ldv.x >> 16)), bf2f((unsigned short)(ldv.y & 0xffffu)), bf2f((unsigned short)(ldv.y >> 16))};
            const f32x4 z1 = {bf2f((unsigned short)(ldv.z & 0xffffu)), bf2f((unsigned short)(ldv.z >> 16)), bf2f((unsigned short)(ldv.w & 0xffffu)), bf2f((unsigned short)(ldv.w >> 16))};
            zacc[dk] = (c > 0) ? z0 : (f32x4){0.f, 0.f, 0.f, 0.f}; zacc[dk + 1] = (c > 0) ? z1 : (f32x4){0.f, 0.f, 0.f, 0.f}; }
#pragma unroll
        for (int dk = 0; dk < 8; ++dk) {
            lds_w4(Zt + (16 * w + fr) * 136 + 16 * dk + 4 * fq, zacc[dk]); }
        asm volatile("s_waitcnt lgkmcnt(0)" ::: "memory");
        {
            const LAS bf16_t* Vw = Vt + (16 * w) * 72; const LAS bf16_t* Zw = Zt + (16 * w) * 136;
#pragma unroll
            for (int mi = 0; mi < 4; ++mi) {
                f32x4 o = mm_tile(Sc + mi * 16 * 72, 72, Vw, 72, 2, (f32x4){0.f, 0.f, 0.f, 0.f}, fr, fq);
                o = mm_tile(Qd + mi * 16 * 136, 136, Zw, 136, 4, o, fr, fq);
                LAS float* op = Of + (16 * mi + 4 * fq) * 132 + 16 * w + fr; op[0] = o.x; op[132] = o.y; op[264] = o.z; op[396] = o.w;
            }
            asm volatile("s_waitcnt lgkmcnt(0)" ::: "memory");
#pragma unroll
            for (int dk = 0; dk < 8; ++dk) {
                f32x4 zn = mm_tile(Kpt + dk * 16 * 72, 72, Vw, 72, 2, zacc[dk], fr, fq);
                const f32x4 g4 = *(const LAS f32x4*)(gl + 16 * dk + 4 * fq);
                zn = zn * g4; zacc[dk] = zn;
                lds_w4(Zt + (16 * w + fr) * 136 + 16 * dk + 4 * fq, zn);
            }
        }
        if (c < 31) {
#pragma unroll
            for (int dk = 0; dk < 8; dk += 2) { u32x4 pv; pv.x = pk2(zacc[dk].x, zacc[dk].y); pv.y = pk2(zacc[dk].z, zacc[dk].w); pv.z = pk2(zacc[dk + 1].x, zacc[dk + 1].y); pv.w = pk2(zacc[dk + 1].z, zacc[dk + 1].w);
                ho_store(hb, (unsigned)(((w * 64 + lane) * 4 + (dk >> 1)) * 16), __builtin_bit_cast(f32x4, pv)); }
            asm volatile("s_waitcnt vmcnt(0)" ::: "memory");
        }
        __syncthreads();
        if (c < 31 && w == 0 && lane == 0) __hip_atomic_store(flag, (unsigned)(c + 1), __ATOMIC_RELAXED, __HIP_MEMORY_SCOPE_AGENT);
        for (int t = w; t < 64; t += NWAVES) {
            const float o0 = Of[t * 132 + lane], o1 = Of[t * 132 + lane + 64];
            const float ss = wsum(o0 * o0 + o1 * o1), rs = 1.0f / sqrtf(ss * (1.0f / 128.0f) + 1e-6f);
            bf16_t* gp = P + (size_t)(t0 + t) * P1LD + 3072 + h * 128;
            const float g0 = bf2f(gp[lane]), g1 = bf2f(gp[lane + 64]);
            gp[lane] = (bf16_t)f2bf(o0 * rs * onorm[lane] * siluf_(g0)); gp[lane + 64] = (bf16_t)f2bf(o1 * rs * onorm[lane + 64] * siluf_(g1));
        }
    }
}

__device__ __forceinline__ float tanh_fast(float x) { const float e = __expf(2.f * x); return 1.f - 2.f / (1.f + e); }
struct RwkvLd { u32x4 cu, pv; };
__device__ __forceinline__ RwkvLd rwkv_ld8(const bf16_t* Pc, int t, int gc, const bf16_t* hal) {
    const bf16_t* src = Pc + (size_t)t * P0LD + gc; const bf16_t* psrc = (t > 0) ? src - P0LD : hal + (gc - 2048);
    RwkvLd r; r.cu = *(const u32x4*)src; r.pv = *(const u32x4*)psrc; return r;
}
__device__ __forceinline__ void rwkv_sh8(const RwkvLd& ld, int t, int gc, bool first_zero, const float* mu, float (&sh)[8]) {
    const f32x4 m0 = *(const f32x4*)(mu + gc - 2048), m1 = *(const f32x4*)(mu + gc - 2048 + 4);
    const unsigned cw_[4] = {ld.cu.x, ld.cu.y, ld.cu.z, ld.cu.w}, pw_[4] = {ld.pv.x, ld.pv.y, ld.pv.z, ld.pv.w};
    const float mv[8] = {m0.x, m0.y, m0.z, m0.w, m1.x, m1.y, m1.z, m1.w};
    float cur[8];
#pragma unroll
    for (int e = 0; e < 8; ++e) {
        cur[e] = bf2f((unsigned short)((e & 1) ? (cw_[e >> 1] >> 16) : (cw_[e >> 1] & 0xffffu)));
        const float pg = bf2f((unsigned short)((e & 1) ? (pw_[e >> 1] >> 16) : (pw_[e >> 1] & 0xffffu)));
        const float prv = (t == 0 && first_zero) ? 0.f : pg;
        sh[e] = cur[e] + mv[e] * (prv - cur[e]);
    }
}
__device__ __forceinline__ void scan_rwkv3(const Frame& F, int b, int h, int par) {
    const int lane0 = lane_id_v(); const int w = F.wave;
    LAS unsigned char* L = F.lds;
    LAS bf16_t* RPb = (LAS bf16_t*)(L + 0);
    LAS bf16_t* KPb = (LAS bf16_t*)(L + 9216);
    LAS float* LWf = (LAS float*)(L + 18432);
    LAS float* Af = (LAS float*)(L + 34816);
    LAS float* segs = (LAS float*)(L + 51200);
    LAS bf16_t* Mak = (LAS bf16_t*)(L + 0);
    LAS bf16_t* Mrk = (LAS bf16_t*)(L + 9216);
    LAS bf16_t* Mrbn = (LAS bf16_t*)(L + 18432);
    LAS bf16_t* Aoff = (LAS bf16_t*)(L + 27648);
    LAS float* Adg = (LAS float*)(L + 36864);
    LAS bf16_t* Dg = (LAS bf16_t*)(L + 41216);
    LAS bf16_t* GB = (LAS bf16_t*)(L + 44288);
    LAS bf16_t* TL = (LAS bf16_t*)(L + 65536);
    LAS bf16_t* AL = (LAS bf16_t*)(L + 65536 + 9216);
    LAS bf16_t* SG = (LAS bf16_t*)(L + 65536 + 18432);
    LAS bf16_t* At = (LAS bf16_t*)(L + 65536);
    LAS bf16_t* Btl = (LAS bf16_t*)(L + 65536 + 9216);
    LAS bf16_t* Ktl = (LAS bf16_t*)(L + 65536 + 18432);
    LAS bf16_t* Rtl = (LAS bf16_t*)(L + 65536 + 27648);
    LAS float* Of = (LAS float*)(L + 65536);
    LAS bf16_t* BtTn = (LAS bf16_t*)(L + 102400);
    LAS bf16_t* KtT = (LAS bf16_t*)(L + 111616);
    LAS bf16_t* Vt = (LAS bf16_t*)(L + 120832);
    LAS bf16_t* Zt = (LAS bf16_t*)(L + 130048);
    LAS bf16_t* PU = (LAS bf16_t*)(L + 139264);
    LAS float* bonus = (LAS float*)(L + 148480);
    LAS float* glv = bonus + 64;
    static_assert(148480 + 4096 <= LDS_MISC, "rwkv3 LDS");
    bf16_t* P = (bf16_t*)(F.ws + WS_BIG + BIG_PROJ);
    const bf16_t* LW = (const bf16_t*)(F.ws + WS_LORA);
    const bf16_t* HALO = (const bf16_t*)(F.ws + WS_HALOB);
    const HoBuf hb = ho_buf((float*)(F.ws + WS_HOB) + (size_t)(b * 8 + h) * 4096, 16384);
    unsigned* flag = (unsigned*)(F.ws + WS_FLAGS) + (b * 8 + h); unsigned* tmo = (unsigned*)(F.ws + WS_FLAGS) + 255;
    const float* mu = F.in[IN_AB_MU];
    const float kkj = F.in[IN_AB_KK][h * 64 + lane0], kaj = F.in[IN_AB_KA][h * 64 + lane0], rkj = F.in[IN_AB_RK][h * 64 + lane0];
    const float lnw = F.in[IN_AB_LNW][h * 64 + lane0], lnb = F.in[IN_AB_LNB][h * 64 + lane0];
    float w0q[2], a0q[2];
#pragma unroll
    for (int q = 0; q < 2; ++q) { const int jq = ((2 * w + q) & 3) * 16 + (lane0 & 15); w0q[q] = F.in[IN_AB_W0][h * 64 + jq]; a0q[q] = F.in[IN_AB_A0][h * 64 + jq]; }
    bf16x8 yw[2][2], ya[2][2], yg[2][4];
#pragma unroll
    for (int q = 0; q < 2; ++q) { const int jrow = h * 64 + ((2 * w + q) & 3) * 16 + (lane0 & 15), fq0 = lane0 >> 4;
#pragma unroll
        for (int ksx = 0; ksx < 2; ++ksx) { yw[q][ksx] = *(const bf16x8*)(LW + (size_t)jrow * 64 + ksx * 32 + fq0 * 8); ya[q][ksx] = *(const bf16x8*)(LW + 512 * 64 + (size_t)jrow * 64 + ksx * 32 + fq0 * 8); }
#pragma unroll
        for (int ksx = 0; ksx < 4; ++ksx) yg[q][ksx] = *(const bf16x8*)(LW + 2 * 512 * 64 + (size_t)jrow * 128 + ksx * 32 + fq0 * 8); }
    f32x4 zacc[4];
#pragma unroll
    for (int i = 0; i < 4; ++i) zacc[i] = (f32x4){0.f, 0.f, 0.f, 0.f};
    for (int i = w * 64 + lane0; i < (64 * 72 * 2) / 2; i += NTHREADS) ((LAS unsigned*)Zt)[i] = 0u;
    __syncthreads();
    for (int c = par; c < 32; c += 2) {
        int lane = lane0; asm volatile("" : "+v"(lane));
        const int tid = w * 64 + lane, fr = lane & 15, fq = lane >> 4;
        const int t0 = b * TS + c * 64;
        {
            const bf16_t* Pc = P + (size_t)t0 * P0LD; const bf16_t* hal = HALO + (size_t)(b * 32 + (c > 0 ? c - 1 : 0)) * 1792; const bool fz = (c == 0);
            const int t_a0 = tid >> 4, cg_a0 = tid & 15, t_a1 = (tid + NTHREADS) >> 4, cg_a1 = (tid + NTHREADS) & 15, t_b = tid >> 3, cg_b = tid & 7;
            const int gc0 = ((cg_a0 < 8) ? 2048 : 2560) + h * 64 + (cg_a0 & 7) * 8, gc1 = ((cg_a1 < 8) ? 2048 : 2560) + h * 64 + (cg_a1 & 7) * 8;
            const int gc2 = 3584 + cg_b * 8, gc3 = 3648 + cg_b * 8, gc4 = 3712 + cg_a0 * 8, gc5 = 3712 + cg_a1 * 8;
            const RwkvLd l0 = rwkv_ld8(Pc, t_a0, gc0, hal), l1 = rwkv_ld8(Pc, t_a1, gc1, hal), l2 = rwkv_ld8(Pc, t_b, gc2, hal), l3 = rwkv_ld8(Pc, t_b, gc3, hal), l4 = rwkv_ld8(Pc, t_a0, gc4, hal), l5 = rwkv_ld8(Pc, t_a1, gc5, hal);
            const int vcol = tid & 63, vtg = tid >> 6;
            const bf16_t* vsrc = Pc + (size_t)(8 * vtg) * P0LD + 3072 + h * 64 + vcol;
            unsigned short vr[9];
#pragma unroll
            for (int i = 0; i < 8; ++i) vr[i + 1] = vsrc[(size_t)i * P0LD];
            vr[0] = *((vtg > 0) ? vsrc - P0LD : hal + 1024 + h * 64 + vcol);
            float sh[8];
            { rwkv_sh8(l0, t_a0, gc0, fz, mu, sh);
              *(LAS u32x4*)((cg_a0 < 8 ? RPb : KPb) + t_a0 * 72 + (cg_a0 & 7) * 8) = (u32x4){pk2(sh[0], sh[1]), pk2(sh[2], sh[3]), pk2(sh[4], sh[5]), pk2(sh[6], sh[7])}; }
            { rwkv_sh8(l1, t_a1, gc1, fz, mu, sh);
              *(LAS u32x4*)((cg_a1 < 8 ? RPb : KPb) + t_a1 * 72 + (cg_a1 & 7) * 8) = (u32x4){pk2(sh[0], sh[1]), pk2(sh[2], sh[3]), pk2(sh[4], sh[5]), pk2(sh[6], sh[7])}; }
            { rwkv_sh8(l2, t_b, gc2, fz, mu, sh);
              *(LAS u32x4*)(TL + t_b * 72 + cg_b * 8) = (u32x4){pk2(tanh_fast(sh[0]), tanh_fast(sh[1])), pk2(tanh_fast(sh[2]), tanh_fast(sh[3])), pk2(tanh_fast(sh[4]), tanh_fast(sh[5])), pk2(tanh_fast(sh[6]), tanh_fast(sh[7]))}; }
            { rwkv_sh8(l3, t_b, gc3, fz, mu, sh);
              *(LAS u32x4*)(AL + t_b * 72 + cg_b * 8) = (u32x4){pk2(sh[0], sh[1]), pk2(sh[2], sh[3]), pk2(sh[4], sh[5]), pk2(sh[6], sh[7])}; }
            { rwkv_sh8(l4, t_a0, gc4, fz, mu, sh);
              *(LAS u32x4*)(SG + t_a0 * 136 + cg_a0 * 8) = (u32x4){pk2(sigmoidf_(sh[0]), sigmoidf_(sh[1])), pk2(sigmoidf_(sh[2]), sigmoidf_(sh[3])), pk2(sigmoidf_(sh[4]), sigmoidf_(sh[5])), pk2(sigmoidf_(sh[6]), sigmoidf_(sh[7]))}; }
            { rwkv_sh8(l5, t_a1, gc5, fz, mu, sh);
              *(LAS u32x4*)(SG + t_a1 * 136 + cg_a1 * 8) = (u32x4){pk2(sigmoidf_(sh[0]), sigmoidf_(sh[1])), pk2(sigmoidf_(sh[2]), sigmoidf_(sh[3])), pk2(sigmoidf_(sh[4]), sigmoidf_(sh[5])), pk2(sigmoidf_(sh[6]), sigmoidf_(sh[7]))}; }
            {
                float cur[9];
#pragma unroll
                for (int i = 0; i < 9; ++i) cur[i] = bf2f(vr[i]);
                if (vtg == 0 && fz) cur[0] = 0.f;
                const float mvc = mu[1024 + h * 64 + vcol];
                float shv[8];
#pragma unroll
                for (int i = 0; i < 8; ++i) shv[i] = cur[i + 1] + mvc * (cur[i] - cur[i + 1]);
                *(LAS u32x4*)(Vt + vcol * 72 + 8 * vtg) = (u32x4){pk2(shv[0], shv[1]), pk2(shv[2], shv[3]), pk2(shv[4], shv[5]), pk2(shv[6], shv[7])};
            }
        }
        __syncthreads();
        f32x4 agate[2];
        {
#pragma unroll
            for (int q = 0; q < 2; ++q) {
                const int id = 2 * w + q, mi = id >> 2, nj = id & 3;
                f32x4 aw = {0.f, 0.f, 0.f, 0.f}, aa = {0.f, 0.f, 0.f, 0.f}, ag = {0.f, 0.f, 0.f, 0.f};
#pragma unroll
                for (int ksx = 0; ksx < 2; ++ksx) {
                    const bf16x8 x1 = *(const LAS bf16x8*)(TL + (mi * 16 + fr) * 72 + ksx * 32 + fq * 8), x2 = *(const LAS bf16x8*)(AL + (mi * 16 + fr) * 72 + ksx * 32 + fq * 8);
                    aw = MFMA32(x1, yw[q][ksx], aw); aa = MFMA32(x2, ya[q][ksx], aa);
                }
#pragma unroll
                for (int ksx = 0; ksx < 4; ++ksx) {
                    const bf16x8 x3 = *(const LAS bf16x8*)(SG + (mi * 16 + fr) * 136 + ksx * 32 + fq * 8);
                    ag = MFMA32(x3, yg[q][ksx], ag);
                }
                agate[q] = ag;
                const int j = nj * 16 + fr; const float w0j = w0q[q], a0j = a0q[q];
                const float awv[4] = {aw.x, aw.y, aw.z, aw.w}, aav[4] = {aa.x, aa.y, aa.z, aa.w};
#pragma unroll
                for (int rg = 0; rg < 4; ++rg) { const int t = mi * 16 + 4 * fq + rg;
                    LWf[t * 64 + j] = -0.6065306597126334f * sigmoidf_(w0j + awv[rg]); Af[t * 64 + j] = sigmoidf_(a0j + aav[rg]); }
            }
        }
        __syncthreads();
        {
            float g[8]; float run = 0.f;
#pragma unroll
            for (int i = 0; i < 8; ++i) { run += LWf[(8 * w + i) * 64 + lane]; g[i] = run; }
            segs[w * 64 + lane] = run;
            __syncthreads();
            float off = 0.f;
#pragma unroll
            for (int s2 = 0; s2 < 7; ++s2) if (s2 < w) off += segs[s2 * 64 + lane];
#pragma unroll
            for (int i = 0; i < 8; ++i) LWf[(8 * w + i) * 64 + lane] = off + g[i];
        }
        __syncthreads();
        {
            const int j = lane;
            float btn[8], ktt[8];
#pragma unroll
            for (int i = 0; i < 8; ++i) {
                const int t = 8 * w + i;
                const float kv = bf2f(KPb[t * 72 + j]), rv = bf2f(RPb[t * 72 + j]), a = Af[t * 64 + j], G = LWf[t * 64 + j];
                const float Gp = (t > 0) ? LWf[(t - 1) * 64 + j] : 0.f;
                const float kx = kv * kkj; const float ss = wsum(kx * kx); const float kk = kx * (1.0f / sqrtf(ss + 1e-6f));
                const float km = kv * (1.f + (a - 1.f) * kaj);
                const float bs = wsum(rv * km * rkj); if (j == 0) bonus[t] = bs;
                const float eG = __expf(G), eGi = __expf(-G), eGp = __expf(Gp);
                const float bt = kk * a * eGi, kt = km * eGi;
                At[t * 72 + j] = (bf16_t)f2bf(kk * eGp); Btl[t * 72 + j] = (bf16_t)f2bf(bt); Ktl[t * 72 + j] = (bf16_t)f2bf(kt); Rtl[t * 72 + j] = (bf16_t)f2bf(rv * eG);
                btn[i] = -bt; ktt[i] = kt;
                if (t == 63) glv[j] = eG;
            }
            *(LAS u32x4*)(BtTn + j * 72 + 8 * w) = (u32x4){pk2(btn[0], btn[1]), pk2(btn[2], btn[3]), pk2(btn[4], btn[5]), pk2(btn[6], btn[7])};
            *(LAS u32x4*)(KtT + j * 72 + 8 * w) = (u32x4){pk2(ktt[0], ktt[1]), pk2(ktt[2], ktt[3]), pk2(ktt[4], ktt[5]), pk2(ktt[6], ktt[7])};
        }
        __syncthreads();
        {
            for (int job = w; job < 64; job += NWAVES) {
                const int mat = job >> 4, bi = (job >> 2) & 3, bj = job & 3;
                LAS bf16_t* dst = (mat == 0) ? Aoff : (mat == 1 ? Mak : (mat == 2 ? Mrk : Mrbn));
                const int i = 16 * bi + fr, j0 = 16 * bj + 4 * fq;
                f32x4 o = {0.f, 0.f, 0.f, 0.f};
                if (bj <= bi) {
                    const LAS bf16_t* Aj = ((mat == 0 || mat == 3) ? Btl : Ktl) + bj * 16 * 72; const LAS bf16_t* Bi = ((mat < 2) ? At : Rtl) + bi * 16 * 72;
                    const f32x4 acc = mm_tile(Aj, 72, Bi, 72, 2, (f32x4){0.f, 0.f, 0.f, 0.f}, fr, fq);
                    const bool incl = mat >= 2;
                    o.x = (incl ? (j0 <= i) : (j0 < i)) ? acc.x : 0.f; o.y = (incl ? (j0 + 1 <= i) : (j0 + 1 < i)) ? acc.y : 0.f;
                    o.z = (incl ? (j0 + 2 <= i) : (j0 + 2 < i)) ? acc.z : 0.f; o.w = (incl ? (j0 + 3 <= i) : (j0 + 3 < i)) ? acc.w : 0.f;
                    if (mat == 0 && bi == bj) { LAS float* dd = Adg + (bi * 16 + fr) * 17 + 4 * fq; dd[0] = o.x; dd[1] = o.y; dd[2] = o.z; dd[3] = o.w; o = (f32x4){0.f, 0.f, 0.f, 0.f}; }
                    if (mat == 0 || mat == 3) o = -o;
                }
                lds_w4(dst + i * 72 + j0, o);
            }
#pragma unroll
            for (int q = 0; q < 2; ++q) { const int id = 2 * w + q, mi = id >> 2, nj = id & 3; const int j = nj * 16 + fr; const float gv[4] = {agate[q].x, agate[q].y, agate[q].z, agate[q].w};
#pragma unroll
                for (int rg = 0; rg < 4; ++rg) GB[(mi * 16 + 4 * fq + rg) * 64 + j] = (bf16_t)f2bf(gv[rg]); }
        }
        __syncthreads();
        f32x4 ot[4];
        if (c > 0) ho_wait(flag, (unsigned)c, tmo, w, lane);
        if (w < 4) {
#pragma unroll
            for (int kb = 0; kb < 4; kb += 2) {
                const u32x4 ldv = __builtin_bit_cast(u32x4, ho_load(hb, (unsigned)(((w * 64 + lane) * 2 + (kb >> 1)) * 16)));
                const f32x4 z0 = {bf2f((unsigned short)(ldv.x & 0xffffu)), bf2f((unsigned short)(ldv.x >> 16)), bf2f((unsigned short)(ldv.y & 0xffffu)), bf2f((unsigned short)(ldv.y >> 16))};
                const f32x4 z1 = {bf2f((unsigned short)(ldv.z & 0xffffu)), bf2f((unsigned short)(ldv.z >> 16)), bf2f((unsigned short)(ldv.w & 0xffffu)), bf2f((unsigned short)(ldv.w >> 16))};
                zacc[kb] = (c > 0) ? z0 : (f32x4){0.f, 0.f, 0.f, 0.f}; zacc[kb + 1] = (c > 0) ? z1 : (f32x4){0.f, 0.f, 0.f, 0.f}; }
#pragma unroll
            for (int kb = 0; kb < 4; ++kb) lds_w4(Zt + (16 * w + fr) * 72 + 16 * kb + 4 * fq, zacc[kb]);
            asm volatile("s_waitcnt lgkmcnt(0)" ::: "memory");
        }
        if (w < 4) {
            {
                const int bb = lane >> 4, jj = lane & 15; float x[16]; const LAS float* a = Adg + bb * 16 * 17;
#pragma unroll
                for (int i = 0; i < 16; ++i) { float v = (i == jj) ? 1.f : 0.f;
#pragma unroll
                    for (int k = 0; k < i; ++k) v -= a[i * 17 + k] * x[k];
                    x[i] = v; Dg[(bb * 16 + i) * 24 + jj] = (bf16_t)f2bf(v); }
                asm volatile("s_waitcnt lgkmcnt(0)" ::: "memory");
            }
            const LAS bf16_t* Vw = Vt + (16 * w) * 72; const LAS bf16_t* Zw = Zt + (16 * w) * 72; LAS bf16_t* PUw = PU + (16 * w) * 72;
            f32x4 p[4];
#pragma unroll
            for (int mi = 0; mi < 4; ++mi) { p[mi] = mm_tile(At + mi * 16 * 72, 72, Zw, 72, 2, (f32x4){0.f, 0.f, 0.f, 0.f}, fr, fq); p[mi] = mm_tile(Mak + mi * 16 * 72, 72, Vw, 72, 2, p[mi], fr, fq); }
#pragma unroll
            for (int bb = 0; bb < 4; ++bb) {
                f32x4 acc = p[bb];
                if (bb >= 1) acc = mm_tile(Aoff + bb * 16 * 72, 72, PUw, 72, (bb + 1) / 2, acc, fr, fq);
                u32x2 pk; pk.x = pk2(acc.x, acc.y); pk.y = pk2(acc.z, acc.w);
                const bf16x4 dgf = *(const LAS bf16x4*)(Dg + (bb * 16 + fr) * 24 + 4 * fq);
                const f32x4 ub = MFMA16(dgf, __builtin_bit_cast(bf16x4, pk), ((f32x4){0.f, 0.f, 0.f, 0.f}));
                lds_w4(PUw + fr * 72 + 16 * bb + 4 * fq, ub);
                asm volatile("s_waitcnt lgkmcnt(0)" ::: "memory");
            }
#pragma unroll
            for (int mi = 0; mi < 4; ++mi) {
                f32x4 o = mm_tile(Rtl + mi * 16 * 72, 72, Zw, 72, 2, (f32x4){0.f, 0.f, 0.f, 0.f}, fr, fq);
                o = mm_tile(Mrk + mi * 16 * 72, 72, Vw, 72, 2, o, fr, fq);
                ot[mi] = mm_tile(Mrbn + mi * 16 * 72, 72, PUw, 72, 2, o, fr, fq);
            }
#pragma unroll
            for (int kb = 0; kb < 4; ++kb) {
                f32x4 zn = mm_tile(KtT + kb * 16 * 72, 72, Vw, 72, 2, zacc[kb], fr, fq);
                zn = mm_tile(BtTn + kb * 16 * 72, 72, PUw, 72, 2, zn, fr, fq);
                const f32x4 g4 = *(const LAS f32x4*)(glv + 16 * kb + 4 * fq);
                zn = zn * g4; zacc[kb] = zn;
                lds_w4(Zt + (16 * w + fr) * 72 + 16 * kb + 4 * fq, zn);
            }
        }
        if (w < 4 && c < 31) {
#pragma unroll
            for (int kb = 0; kb < 4; kb += 2) { u32x4 pv; pv.x = pk2(zacc[kb].x, zacc[kb].y); pv.y = pk2(zacc[kb].z, zacc[kb].w); pv.z = pk2(zacc[kb + 1].x, zacc[kb + 1].y); pv.w = pk2(zacc[kb + 1].z, zacc[kb + 1].w);
                ho_store(hb, (unsigned)(((w * 64 + lane) * 2 + (kb >> 1)) * 16), __builtin_bit_cast(f32x4, pv)); }
            asm volatile("s_waitcnt vmcnt(0)" ::: "memory");
        }
        __syncthreads();
        if (c < 31 && w == 0 && lane == 0) __hip_atomic_store(flag, (unsigned)(c + 1), __ATOMIC_RELAXED, __HIP_MEMORY_SCOPE_AGENT);
        if (w < 4) {
#pragma unroll
            for (int mi = 0; mi < 4; ++mi) { LAS float* op = Of + (16 * mi + 4 * fq) * 65 + 16 * w + fr; op[0] = ot[mi].x; op[65] = ot[mi].y; op[130] = ot[mi].z; op[195] = ot[mi].w; }
        }
        __syncthreads();
        for (int t = w; t < 64; t += NWAVES) {
            const float o = Of[t * 65 + lane];
            const float mean = wsum(o) * (1.0f / 64.0f); const float dlt = o - mean; const float var = wsum(dlt * dlt) * (1.0f / 64.0f);
            float y = dlt * (1.0f / sqrtf(var + 64e-5f)) * lnw + lnb;
            y += bonus[t] * bf2f(Vt[lane * 72 + t]);
            y *= bf2f(GB[t * 64 + lane]);
            P[(size_t)(t0 + t) * P0LD + 2048 + h * 64 + lane] = (bf16_t)f2bf(y);
        }
        __syncthreads();
    }
}

__device__ __forceinline__ void attn_phase(const Frame& F, const bf16_t* Q, const bf16_t* Kb, const bf16_t* VT, bf16_t* O) {
    const int lane = lane_id_v(); const int tid = F.wave * 64 + lane; (void)tid;
    const int fr = lane & 15, fq = lane >> 4;
    for (int u = F.wg; u < 512; u += F.G) {
        const int b = u >> 6, h = (u >> 4) & 3, qb = u & 15;
        const int q0 = b * TS + qb * 128 + F.wave * 16;
        bf16x8 bq[8];
#pragma unroll
        for (int ksx = 0; ksx < 8; ++ksx) bq[ksx] = *(const bf16x8*)(Q + (size_t)(q0 + fr) * 1024 + h * 256 + ksx * 32 + fq * 8);
        f32x4 sacc[16];
#pragma unroll
        for (int tl = 0; tl < 16; ++tl) {
            f32x4 a4 = {0.f, 0.f, 0.f, 0.f};
            const bf16_t* kp = Kb + (size_t)(b * 256 + tl * 16 + fr) * 1024 + h * 256 + fq * 8;
#pragma unroll
            for (int ksx = 0; ksx < 8; ++ksx) { const bf16x8 a = *(const bf16x8*)(kp + ksx * 32); a4 = __builtin_amdgcn_mfma_f32_16x16x32_bf16(a, bq[ksx], a4, 0, 0, 0); }
            sacc[tl] = a4;
        }
        float mx = -3.0e38f;
#pragma unroll
        for (int tl = 0; tl < 16; ++tl) mx = fmaxf(mx, fmaxf(fmaxf(sacc[tl].x, sacc[tl].y), fmaxf(sacc[tl].z, sacc[tl].w)));
        mx = fmaxf(mx, __shfl_xor(mx, 16)); mx = fmaxf(mx, __shfl_xor(mx, 32));
        float l = 0.f;
        bf16x8 pb[8];
#pragma unroll
        for (int ksx = 0; ksx < 8; ++ksx) {
            const f32x4 e0 = sacc[2 * ksx], e1 = sacc[2 * ksx + 1];
            const float p0 = __expf(e0.x - mx), p1 = __expf(e0.y - mx), p2 = __expf(e0.z - mx), p3 = __expf(e0.w - mx);
            const float p4 = __expf(e1.x - mx), p5 = __expf(e1.y - mx), p6 = __expf(e1.z - mx), p7 = __expf(e1.w - mx);
            l += ((p0 + p1) + (p2 + p3)) + ((p4 + p5) + (p6 + p7));
            u32x4 w; w.x = pk2(p0, p1); w.y = pk2(p2, p3); w.z = pk2(p4, p5); w.w = pk2(p6, p7);
            pb[ksx] = __builtin_bit_cast(bf16x8, w);
        }
        l += __shfl_xor(l, 16); l += __shfl_xor(l, 32);
        const float inv = 1.0f / l;
        const bf16_t* vbase = VT + (size_t)((b * 4 + h) * 256) * 256;
#pragma unroll 4
        for (int dt = 0; dt < 16; ++dt) {
            f32x4 o4 = {0.f, 0.f, 0.f, 0.f};
            const bf16_t* vp = vbase + (size_t)(dt * 16 + fr) * 256 + 4 * fq;
#pragma unroll
            for (int ksx = 0; ksx < 8; ++ksx) {
                const u32x2 lo = *(const u32x2*)(vp + ksx * 32), hi = *(const u32x2*)(vp + ksx * 32 + 16);
                u32x4 w; w.x = lo.x; w.y = lo.y; w.z = hi.x; w.w = hi.y;
                o4 = __builtin_amdgcn_mfma_f32_16x16x32_bf16(__builtin_bit_cast(bf16x8, w), pb[ksx], o4, 0, 0, 0);
            }
            u32x2 w; w.x = pk2(o4.x * inv, o4.y * inv); w.y = pk2(o4.z * inv, o4.w * inv);
            *(u32x2*)(O + (size_t)(q0 + fr) * 1024 + h * 256 + dt * 16 + 4 * fq) = w;
        }
    }
}

__device__ __forceinline__ void attn_phase2(const Frame& F, const bf16_t* Q, const bf16_t* Kb, const bf16_t* VT, bf16_t* O) {
    const int lane = lane_id_v(); const int tid = F.wave * 64 + lane; const int fr = lane & 15, fq = lane >> 4;
    LAS bf16_t* KL = (LAS bf16_t*)F.lds;
    static_assert(256 * 264 * 2 <= LDS_MISC, "attn LDS");
    for (int u = F.wg; u < 512; u += F.G) {
        const int b = u >> 6, h = (u >> 4) & 3, qb = u & 15;
        const int q0 = b * TS + qb * 128 + F.wave * 16;
        u32x4 st[16];
#pragma unroll
        for (int n = 0; n < 16; ++n) { const int idx = tid + NTHREADS * n, row = idx >> 5, c8 = idx & 31;
            st[n] = *(const u32x4*)(Kb + (size_t)(b * 256 + row) * 1024 + h * 256 + c8 * 8); }
        bf16x8 bq[8];
#pragma unroll
        for (int ksx = 0; ksx < 8; ++ksx) bq[ksx] = *(const bf16x8*)(Q + (size_t)(q0 + fr) * 1024 + h * 256 + ksx * 32 + fq * 8);
        __syncthreads();
#pragma unroll
        for (int n = 0; n < 16; ++n) { const int idx = tid + NTHREADS * n, row = idx >> 5, c8 = idx & 31; *(LAS u32x4*)(KL + row * 264 + c8 * 8) = st[n]; }
        const bf16_t* vbase = VT + (size_t)((b * 4 + h) * 256) * 256;
#pragma unroll
        for (int n = 0; n < 16; ++n) { const int idx = tid + NTHREADS * n, row = idx >> 5, c8 = idx & 31; st[n] = *(const u32x4*)(vbase + (size_t)row * 256 + c8 * 8); }
        __syncthreads();
        f32x4 sacc[16];
#pragma unroll
        for (int tl = 0; tl < 16; ++tl) {
            f32x4 a4 = {0.f, 0.f, 0.f, 0.f};
#pragma unroll
            for (int ksx = 0; ksx < 8; ++ksx) a4 = __builtin_amdgcn_mfma_f32_16x16x32_bf16(*(const LAS bf16x8*)(KL + (tl * 16 + fr) * 264 + ksx * 32 + fq * 8), bq[ksx], a4, 0, 0, 0);
            sacc[tl] = a4;
        }
        float mx = -3.0e38f;
#pragma unroll
        for (int tl = 0; tl < 16; ++tl) mx = fmaxf(mx, fmaxf(fmaxf(sacc[tl].x, sacc[tl].y), fmaxf(sacc[tl].z, sacc[tl].w)));
        mx = fmaxf(mx, __shfl_xor(mx, 16)); mx = fmaxf(mx, __shfl_xor(mx, 32));
        float l = 0.f;
        bf16x8 pb[8];
#pragma unroll
        for (int ksx = 0; ksx < 8; ++ksx) {
            const f32x4 e0 = sacc[2 * ksx], e1 = sacc[2 * ksx + 1];
            const float p0 = __expf(e0.x - mx), p1 = __expf(e0.y - mx), p2 = __expf(e0.z - mx), p3 = __expf(e0.w - mx);
            const float p4 = __expf(e1.x - mx), p5 = __expf(e1.y - mx), p6 = __expf(e1.z - mx), p7 = __expf(e1.w - mx);
            l += ((p0 + p1) + (p2 + p3)) + ((p4 + p5) + (p6 + p7));
            u32x4 w; w.x = pk2(p0, p1); w.y = pk2(p2, p3); w.z = pk2(p4, p5); w.w = pk2(p6, p7);
            pb[ksx] = __builtin_bit_cast(bf16x8, w);
        }
        l += __shfl_xor(l, 16); l += __shfl_xor(l, 32);
        const float inv = 1.0f / l;
        __syncthreads();
#pragma unroll
        for (int n = 0; n < 16; ++n) { const int idx = tid + NTHREADS * n, row = idx >> 5, c8 = idx & 31; *(LAS u32x4*)(KL + row * 264 + c8 * 8) = st[n]; }
        __syncthreads();
#pragma unroll 4
        for (int dt = 0; dt < 16; ++dt) {
            f32x4 o4 = {0.f, 0.f, 0.f, 0.f};
            const LAS bf16_t* vp = KL + (dt * 16 + fr) * 264 + 4 * fq;
#pragma unroll
            for (int ksx = 0; ksx < 8; ++ksx) {
                const u32x2 lo = *(const LAS u32x2*)(vp + ksx * 32), hi = *(const LAS u32x2*)(vp + ksx * 32 + 16);
                u32x4 w; w.x = lo.x; w.y = lo.y; w.z = hi.x; w.w = hi.y;
                o4 = __builtin_amdgcn_mfma_f32_16x16x32_bf16(__builtin_bit_cast(bf16x8, w), pb[ksx], o4, 0, 0, 0);
            }
            u32x2 w; w.x = pk2(o4.x * inv, o4.y * inv); w.y = pk2(o4.z * inv, o4.w * inv);
            *(u32x2*)(O + (size_t)(q0 + fr) * 1024 + h * 256 + dt * 16 + 4 * fq) = w;
        }
    }
    __syncthreads();
}

__device__ __forceinline__ void router_phase(const Frame& F, int layer) {
    const int lane = lane_id_v(); const int tid = F.wave * 64 + lane; (void)tid;
    const float* XF = F.out; const float* gain = F.in[IN_NORM_FFN] + layer * 1024;
    const float* wg = F.in[IN_MOE_WG] + (size_t)layer * 1024 * 4; const float* we = F.in[IN_MOE_WE] + (size_t)layer * 1024 * 16;
    const float* bg = F.in[IN_MOE_BG] + layer * 4; const float* be = F.in[IN_MOE_BE] + layer * 16;
    unsigned* cnt = (unsigned*)(F.ws + WS_CNT) + layer * 32;
    int* tokb = (int*)(F.ws + WS_ROUTE); int* tokp = tokb + NT; f32x4* tokg = (f32x4*)(tokp + NT);
    const int gw = F.wg * NWAVES + F.wave, NGW = F.G * NWAVES;
    for (int row = gw; row < NT; row += NGW) {
        const f32x4* xr = (const f32x4*)(XF + (size_t)row * 1024) + lane;
        float s = 0.f, lg[4], le[16];
#pragma unroll
        for (int c = 0; c < 4; ++c) lg[c] = 0.f;
#pragma unroll
        for (int c = 0; c < 16; ++c) le[c] = 0.f;
#pragma unroll 1
        for (int j = 0; j < 4; ++j) {
            const f32x4 v = xr[64 * j]; s += (v.x * v.x + v.y * v.y) + (v.z * v.z + v.w * v.w);
            const int k0 = 4 * lane + 256 * j; const f32x4 g = *(const f32x4*)(gain + k0);
            const float xv[4] = {v.x * g.x, v.y * g.y, v.z * g.z, v.w * g.w};
#pragma unroll
            for (int q = 0; q < 4; ++q) {
                const f32x4 a = *(const f32x4*)(wg + (size_t)(k0 + q) * 4);
                lg[0] += xv[q] * a.x; lg[1] += xv[q] * a.y; lg[2] += xv[q] * a.z; lg[3] += xv[q] * a.w;
#pragma unroll
                for (int e4 = 0; e4 < 4; ++e4) { const f32x4 w = *(const f32x4*)(we + (size_t)(k0 + q) * 16 + 4 * e4);
                    le[4 * e4] += xv[q] * w.x; le[4 * e4 + 1] += xv[q] * w.y; le[4 * e4 + 2] += xv[q] * w.z; le[4 * e4 + 3] += xv[q] * w.w; }
            }
        }
        s = wave_sum(s);
        const float rstd = 1.0f / sqrtf(s * (1.0f / 1024.0f) + 1e-6f);
#pragma unroll
        for (int c = 0; c < 4; ++c) lg[c] = wave_sum(lg[c]) * rstd + bg[c];
#pragma unroll
        for (int c = 0; c < 16; ++c) le[c] = wave_sum(le[c]) * rstd + be[c];
        int gs = 0; float gm = lg[0];
#pragma unroll
        for (int c = 1; c < 4; ++c) if (lg[c] > gm) { gm = lg[c]; gs = c; }
        float gz = 0.f;
#pragma unroll
        for (int c = 0; c < 4; ++c) gz += __expf(lg[c] - gm);
        const float ggate = 1.0f / gz;
        float l4[4];
#pragma unroll
        for (int c = 0; c < 4; ++c) { float v = le[c];
#pragma unroll
            for (int g2 = 1; g2 < 4; ++g2) v = (gs == g2) ? le[4 * g2 + c] : v;
            l4[c] = v; }
        int i0 = 0; float m0 = l4[0];
#pragma unroll
        for (int c = 1; c < 4; ++c) if (l4[c] > m0) { m0 = l4[c]; i0 = c; }
        int i1 = -1; float m1 = -3.0e38f;
#pragma unroll
        for (int c = 0; c < 4; ++c) if (c != i0 && l4[c] > m1) { m1 = l4[c]; i1 = c; }
        const float e1 = __expf(m1 - m0); const float g0 = ggate / (1.f + e1), g1 = ggate * e1 / (1.f + e1);
        const int ia = i0 < i1 ? i0 : i1, ib = i0 < i1 ? i1 : i0;
        const float ga = i0 < i1 ? g0 : g1, gb = i0 < i1 ? g1 : g0;
        const int pidx = (ia == 0) ? (ib - 1) : (ia == 1 ? ib + 1 : 5);
        const int bucket = gs * 6 + pidx;
        if (lane == 0) {
            const unsigned pos = atomicAdd(&cnt[bucket], 1u);
            tokb[row] = bucket; tokp[row] = (int)pos; tokg[row] = (f32x4){rstd, ga, gb, 0.f};
        }
    }
}
typedef float f32x16 __attribute__((ext_vector_type(16)));
__device__ __forceinline__ void router_phase2(const Frame& F, int layer) {
    const int lane = lane_id_v(); const int tid = F.wave * 64 + lane; const int w = F.wave;
    const float* XF = F.out; const float* rw = (const float*)(F.ws + WS_RW) + (size_t)layer * 1024 * 32;
    const float* ssp = (const float*)(F.ws + WS_SSP);
    unsigned* cnt = (unsigned*)(F.ws + WS_CNT) + layer * 32;
    int* tokb = (int*)(F.ws + WS_ROUTE); int* tokp = tokb + NT; f32x4* tokg = (f32x4*)(tokp + NT);
    LAS float* T = (LAS float*)F.lds + w * (32 * 132);
    LAS float* Pp = (LAS float*)F.lds;
    LAS float* Lg = Pp + 8 * 64 * 33;
    const int i31 = lane & 31, kh = lane >> 5, k0 = 128 * w;
    float bW[64];
#pragma unroll
    for (int s2 = 0; s2 < 64; ++s2) bW[s2] = rw[(size_t)(k0 + 2 * s2 + kh) * 32 + i31];
    for (int blk = F.wg; blk < NT / 64; blk += F.G) {
        const int r0 = blk * 64;
        f32x16 acc0, acc1;
#pragma unroll
        for (int e = 0; e < 16; ++e) { acc0[e] = 0.f; acc1[e] = 0.f; }
#pragma unroll
        for (int rt = 0; rt < 2; ++rt) {
#pragma unroll
            for (int n = 0; n < 16; ++n) { const int idx = lane + 64 * n, row = idx >> 5, c4 = idx & 31;
                const f32x4 v = *(const f32x4*)(XF + (size_t)(r0 + 32 * rt + row) * 1024 + k0 + 4 * c4);
                *(LAS f32x4*)(T + row * 132 + 4 * c4) = v; }
            asm volatile("s_waitcnt lgkmcnt(0)" ::: "memory");
#pragma unroll
            for (int s2 = 0; s2 < 64; ++s2) {
                const float a0 = T[i31 * 132 + 2 * s2 + kh];
                if (rt == 0) acc0 = __builtin_amdgcn_mfma_f32_32x32x2f32(a0, bW[s2], acc0, 0, 0, 0);
                else acc1 = __builtin_amdgcn_mfma_f32_32x32x2f32(a0, bW[s2], acc1, 0, 0, 0);
            }
            asm volatile("s_waitcnt lgkmcnt(0)" ::: "memory");
        }
        __syncthreads();
#pragma unroll
        for (int e = 0; e < 16; ++e) { const int row = (e & 3) + 8 * (e >> 2) + 4 * kh;
            Pp[(w * 64 + row) * 33 + i31] = acc0[e]; Pp[(w * 64 + 32 + row) * 33 + i31] = acc1[e]; }
        __syncthreads();
        for (int idx = tid; idx < 64 * 32; idx += NTHREADS) { const int row = idx >> 5, cc = idx & 31; float a = 0.f;
#pragma unroll
            for (int ww = 0; ww < 8; ++ww) a += Pp[(ww * 64 + row) * 33 + cc];
            Lg[row * 33 + cc] = a; }
        __syncthreads();
        if (tid < 64) {
            const int row = r0 + tid; const float rstd = row_rstd(ssp, row);
            const float* bg = F.in[IN_MOE_BG] + layer * 4; const float* be = F.in[IN_MOE_BE] + layer * 16;
            float lg[4], le[16];
#pragma unroll
            for (int c2 = 0; c2 < 4; ++c2) lg[c2] = Lg[tid * 33 + c2] * rstd + bg[c2];
#pragma unroll
            for (int c2 = 0; c2 < 16; ++c2) le[c2] = Lg[tid * 33 + 4 + c2] * rstd + be[c2];
            int gs = 0; float gm = lg[0];
#pragma unroll
            for (int c2 = 1; c2 < 4; ++c2) if (lg[c2] > gm) { gm = lg[c2]; gs = c2; }
            float gz = 0.f;
#pragma unroll
            for (int c2 = 0; c2 < 4; ++c2) gz += __expf(lg[c2] - gm);
            const float ggate = 1.0f / gz;
            float l4[4];
#pragma unroll
            for (int c2 = 0; c2 < 4; ++c2) { float v = le[c2];
#pragma unroll
                for (int g2 = 1; g2 < 4; ++g2) v = (gs == g2) ? le[4 * g2 + c2] : v;
                l4[c2] = v; }
            int i0 = 0; float m0 = l4[0];
#pragma unroll
            for (int c2 = 1; c2 < 4; ++c2) if (l4[c2] > m0) { m0 = l4[c2]; i0 = c2; }
            int i1 = -1; float m1 = -3.0e38f;
#pragma unroll
            for (int c2 = 0; c2 < 4; ++c2) if (c2 != i0 && l4[c2] > m1) { m1 = l4[c2]; i1 = c2; }
            const float e1 = __expf(m1 - m0); const float g0 = ggate / (1.f + e1), g1 = ggate * e1 / (1.f + e1);
            const int ia = i0 < i1 ? i0 : i1, ib = i0 < i1 ? i1 : i0;
            const float ga = i0 < i1 ? g0 : g1, gb = i0 < i1 ? g1 : g0;
            const int pidx = (ia == 0) ? (ib - 1) : (ia == 1 ? ib + 1 : 5);
            const int bucket = gs * 6 + pidx;
            const unsigned pos = atomicAdd(&cnt[bucket], 1u);
            tokb[row] = bucket; tokp[row] = (int)pos; tokg[row] = (f32x4){rstd, ga, gb, 0.f};
        }
        __syncthreads();
    }
}
__device__ __forceinline__ void gather_phase(const Frame& F, int layer) {
    const int lane = lane_id_v(); const int tid = F.wave * 64 + lane; (void)tid;
    const unsigned* cnt = (const unsigned*)(F.ws + WS_CNT) + layer * 32;
    const int* tokb = (const int*)(F.ws + WS_ROUTE); const int* tokp = tokb + NT; const f32x4* tokg = (const f32x4*)(tokp + NT); f32x4* rowinfo = (f32x4*)(tokg + NT);
    const bf16_t* XB = (const bf16_t*)(F.ws + WS_XB); bf16_t* XG = (bf16_t*)(F.ws + WS_BIG + BIG_XG);
    LAS int* off = (LAS int*)F.lds;
    if (tid == 0) { int acc = 0; for (int b = 0; b < 24; ++b) { off[b] = acc * 256; acc += ((int)cnt[b] + 255) >> 8; } }
    __syncthreads();
    const int gw = F.wg * NWAVES + F.wave, NGW = F.G * NWAVES;
    for (int tok = gw; tok < NT; tok += NGW) {
        const int row = off[tokb[tok]] + tokp[tok];
        const u32x4* src = (const u32x4*)(XB + (size_t)tok * 1024) + lane; u32x4* dst = (u32x4*)(XG + (size_t)row * 1024) + lane;
        dst[0] = src[0]; dst[64] = src[64];
        if (lane == 0) { f32x4 g = tokg[tok]; g.w = __int_as_float(tok); rowinfo[row] = g; }
    }
    __syncthreads();
}
__device__ __forceinline__ void final_phase(const Frame& F) {
    const int lane = lane_id_v(); const int tid = F.wave * 64 + lane; (void)tid;
    float* XF = F.out; const float* gain = F.in[IN_NORM_FINAL];
    const int gw = F.wg * NWAVES + F.wave, NGW = F.G * NWAVES;
    for (int row = gw; row < NT; row += NGW) {
        f32x4* xr = (f32x4*)(XF + (size_t)row * 1024) + lane;
        f32x4 v[4]; float s = 0.f;
#pragma unroll
        for (int j = 0; j < 4; ++j) { v[j] = xr[64 * j]; s += (v[j].x * v[j].x + v[j].y * v[j].y) + (v[j].z * v[j].z + v[j].w * v[j].w); }
        s = wave_sum(s);
        const float rstd = 1.0f / sqrtf(s * (1.0f / 1024.0f) + 1e-6f);
#pragma unroll
        for (int j = 0; j < 4; ++j) { const f32x4 g = *(const f32x4*)(gain + 4 * lane + 256 * j); xr[64 * j] = v[j] * rstd * g; }
    }
}

constexpr int N_PHASES = 24;
#ifndef PH_MASK
#define PH_MASK 0xFFFFFFFFu
#endif
#define IN(k) (((PH_MASK >> ((k) > 11 ? (k) - 11 : (k))) & 1u) && lo <= (k) && (k) < hi)
#define TS_STAMP(k) do { if (TS_A >= 0 && ((k) == TS_A || (k) == TS_B) && F.wg == 0 && F.wave == 0 && lane_id_v() == 0) ((volatile LAS unsigned*)(F.lds + LDS_MISC + 1024))[(k)] = (unsigned)__builtin_amdgcn_s_memrealtime(); } while (0)
#define SEAM(k) do { if (IN(k) && IN((k) + 1)) xcd_barrier(bar); TS_STAMP((k) + 1); } while (0)
#define SEAM2(k) do { if (IN(k) && IN((k) + 2)) xcd_barrier(bar); TS_STAMP((k) + 2); } while (0)

template <int LAYER>
__device__ __forceinline__ void layer_phases(const Frame& F, const XcdBarrier& bar, const int lo, const int hi) {
    constexpr int pb = LAYER * 11;
    unsigned char* const ws = F.ws;
#define WPTR(off) ((bf16_t*)(ws + (LAYER ? WS_W1 : WS_W0)) + (off))
#define XB_ ((bf16_t*)(ws + WS_XB))
#define SSP_ ((float*)(ws + WS_SSP))
#define PROJ_ ((bf16_t*)(ws + WS_BIG + BIG_PROJ))
#define KB_ (LAYER ? (bf16_t*)(ws + WS_W0) : (bf16_t*)(ws + WS_BIG + BIG_KV0))
#define VT_ (KB_ + (size_t)2048 * 1024)
#define QB_ ((bf16_t*)(ws + WS_BIG + BIG_Q))
#define ATT_ ((bf16_t*)(ws + WS_BIG + BIG_ATT))
#define XG_ ((bf16_t*)(ws + WS_BIG + BIG_XG))
#define HID_ ((bf16_t*)(ws + WS_BIG + BIG_HID))
#define CNT_ ((const unsigned*)(ws + WS_CNT) + LAYER * 32)
#define ROWINFO_ ((const f32x4*)(ws + WS_ROUTE + (size_t)NT * 8 + (size_t)NT * 16))
    if (IN(pb + 1)) {
        if (LAYER == 0) {
            pg8::Gemm g{1024, 1024, 1024, 1 << 20}; pg8::DenseSched S; S.init(NT, 3840, F.G, F.wg, XB_, 1024, WPTR(WO_WIN), 1024);
            EpiScale<0> E{PROJ_, P0LD, SSP_, 1.0f, nullptr, (bf16_t*)(ws + WS_HALOB)};
            pg8::gemm_phase(F.lds, F.wave, g, S, E);
        } else {
            pg8::Gemm g{1024, 1024, 1024, 1 << 20}; pg8::DenseSched S; S.init(NT, 4096, F.G, F.wg, XB_, 1024, WPTR(WO_WIN), 1024);
            EpiScale<1> E{PROJ_, P1LD, SSP_, 1.0f, (const float*)(ws + WS_LB), nullptr};
            pg8::gemm_phase(F.lds, F.wave, g, S, E);
        }
        if (LAYER == 1) { pg8::Gemm g{1024, 1024, 1024, 1 << 20}; pg8::DenseSched S; S.init(2048, 2048, F.G, F.wg, (const bf16_t*)(ws + WS_MEMH), 1024, WPTR(WO_WKV), 1024);
          EpiKV E{KB_, VT_}; pg8::gemm_phase(F.lds, F.wave, g, S, E); }
    }
    SEAM(pb + 1);
    if (IN(pb + 2)) {
        unsigned pt0 = 0; if (PROBE_WG >= 0 && LAYER == 0) pt0 = (unsigned)__builtin_amdgcn_s_memrealtime();
        if (LAYER == 0) {
#ifndef NO_DELTA
            if (F.wg < 96) { const int st = F.wg & 31; scan_delta3(F, st >> 2, st & 3, F.wg >> 5, 3); }
#endif
#ifndef NO_RWKV
            if (F.wg >= 96 && F.wg < 224) { const int q = F.wg - 96, st = ((q >> 4) << 3) | (q & 7), par = (q >> 3) & 1; scan_rwkv3(F, st >> 3, st & 7, par); }
#endif
            if (F.wg >= 224) p0_late_weights<0>(F, F.wg - 224, F.G - 224);
        } else {
#ifndef NO_HGRN
            if (F.wg < 192) { const int st = F.wg & 63; scan_hgrn3(F, st >> 3, st & 7, F.wg >> 6, 3); }
#endif
            if (F.wg >= 192) p0_late_weights<1>(F, F.wg - 192, F.G - 192);
        }
        if (PROBE_WG >= 0 && LAYER == 0 && F.wg == PROBE_WG && F.wave == 0 && lane_id_v() == 0) __hip_atomic_store((unsigned*)(F.ws + WS_CTL + 20480), (unsigned)__builtin_amdgcn_s_memrealtime() - pt0, __ATOMIC_RELAXED, __HIP_MEMORY_SCOPE_AGENT);
    }
    SEAM2(pb + 2);
    if (IN(pb + 4)) {
        constexpr int lda = LAYER ? P1LD : P0LD; const bf16_t* A = PROJ_ + (LAYER ? 3072 : 1536);
        pg8::Gemm g{lda, 1024, 1024, 1 << 20}; pg8::DenseSched S; S.init(NT, 1024, F.G, F.wg, A, lda, WPTR(WO_WOUT), 1024);
        EpiResid<false> E{LAYER ? (const float*)F.out : F.in[IN_X], F.out, XB_, SSP_, nullptr};
        pg8::gemm_phase(F.lds, F.wave, g, S, E);
    }
    SEAM(pb + 4);
    if (IN(pb + 5)) {
        pg8::Gemm g{1024, 1024, 1024, 1 << 20}; pg8::DenseSched S; S.init(NT, 1024, F.G, F.wg, XB_, 1024, WPTR(WO_WQ), 1024);
        EpiScale<0> E{QB_, 1024, SSP_, 0.0625f, nullptr, nullptr};
        pg8::gemm_phase(F.lds, F.wave, g, S, E);
        if (LAYER == 0) { pg8::Gemm g2{1024, 1024, 1024, 1 << 20}; pg8::DenseSched S2; S2.init(2048, 2048, F.G, F.wg, (const bf16_t*)(ws + WS_MEMH), 1024, WPTR(WO_WKV), 1024);
          EpiKV E2{KB_, VT_}; pg8::gemm_phase(F.lds, F.wave, g2, S2, E2); }
    }
    SEAM(pb + 5);
    if (IN(pb + 6)) attn_phase2(F, QB_, KB_, VT_, ATT_);
    SEAM(pb + 6);
    if (IN(pb + 7)) {
        pg8::Gemm g{1024, 1024, 1024, 1 << 20}; pg8::DenseSched S; S.init(NT, 1024, F.G, F.wg, ATT_, 1024, WPTR(WO_WO), 1024);
        EpiResid<false> E{F.out, F.out, XB_, SSP_, nullptr};
        pg8::gemm_phase(F.lds, F.wave, g, S, E);
    }
    SEAM(pb + 7);
    if (IN(pb + 8)) router_phase2(F, LAYER);
    SEAM(pb + 8);
    if (IN(pb + 9)) gather_phase(F, LAYER);
    SEAM(pb + 9);
    if (IN(pb + 10)) {
        LAS int* tbl = (LAS int*)(F.lds + LDS_MISC + 512); moe_build_table(tbl, CNT_, F.wave * 64 + lane_id_v());
        pg8::Gemm g{1024, 1024, 1024, 1 << 20}; MoeSched<false> S{tbl, __builtin_amdgcn_readfirstlane(tbl[95]), F.G, F.wg, (const char*)XG_, (const char*)WPTR(WO_W13)};
        EpiMoeUp E{HID_, ROWINFO_};
        pg8::gemm_phase(F.lds, F.wave, g, S, E);
    }
    SEAM(pb + 10);
    if (IN(pb + 11)) {
        LAS int* tbl = (LAS int*)(F.lds + LDS_MISC + 512); moe_build_table(tbl, CNT_, F.wave * 64 + lane_id_v());
        pg8::Gemm g{512, 256, 512, 4}; MoeSched<true> S{tbl, __builtin_amdgcn_readfirstlane(tbl[95]), F.G, F.wg, (const char*)HID_, (const char*)WPTR(WO_W2T)};
        EpiResid<true> E{F.out, F.out, XB_, SSP_, ROWINFO_};
        pg8::gemm_phase(F.lds, F.wave, g, S, E);
    }
    SEAM(pb + 11);
}

__global__ void __launch_bounds__(NTHREADS, 2) fwd_mega(Args args) {
    extern __shared__ __attribute__((aligned(16))) unsigned char lds_raw[];
    Frame F;
    F.lds = (LAS unsigned char*)lds_raw;
    const int tid = threadIdx.x; F.wave = __builtin_amdgcn_readfirstlane(tid >> 6);
    F.G = gridDim.x; F.wg = blockIdx.x;
    F.out = args.out; F.ws = args.ws;
    volatile LAS unsigned* MISC = (volatile LAS unsigned*)(F.lds + LDS_MISC);
    LAS unsigned long long* tab = (LAS unsigned long long*)(F.lds + LDS_MISC + 64);
    F.in.t = tab;
    if (tid < 16) MISC[tid] = 0u;
    if (tid == 0) {
#pragma unroll
        for (int i = 0; i < 38; ++i) tab[i] = (unsigned long long)args.in[i];
    }
    __syncthreads();
    XcdBarrier bar; bar.bar = (unsigned*)(F.ws + WS_CTL); bar.x = 0; bar.st = MISC; bar.wave = F.wave;
#if N_LAUNCH_MODE == 1
    bar = xcd_barrier_post((unsigned*)(F.ws + WS_CTL), MISC, F.wave);
#endif
    const int lo = args.ph_lo, hi = args.ph_hi;
    TS_STAMP(0);
    if (IN(0)) { p0_prologue(F); }
    SEAM(0);
    layer_phases<0>(F, bar, lo, hi);
    layer_phases<1>(F, bar, lo, hi);
    if (IN(23)) final_phase(F);
    if (TS_A >= 0 && F.wg == 0 && F.wave == 0) {
        asm volatile("s_waitcnt vmcnt(0)" ::: "memory");
        if (lane_id_v() == 0) { volatile LAS unsigned* ts = (volatile LAS unsigned*)(F.lds + LDS_MISC + 1024);
            float us = (float)(ts[TS_B] - ts[TS_A]) * 0.01f;
            if (PROBE_WG >= 0) us = (float)__hip_atomic_load((unsigned*)(F.ws + WS_CTL + 20480), __ATOMIC_RELAXED, __HIP_MEMORY_SCOPE_AGENT) * 0.01f;
            if (PROBE_STAGE >= 0) us = (float)__hip_atomic_load((unsigned*)(F.ws + WS_CTL + 20484), __ATOMIC_RELAXED, __HIP_MEMORY_SCOPE_AGENT) * 0.01f;
            F.out[0] = F.out[0] + us * TS_SCALE; }
    }
}
#undef IN
#undef SEAM

extern "C" void kernel_launch(void* const* d_in, const int* in_sizes, int n_in, void* d_out, int out_size, void* d_ws, size_t ws_size, hipStream_t stream) {
    static int grid = 0;
    if (grid == 0) {
        if (n_in != 38 || out_size != NT * DM || ws_size < WS_END) { fprintf(stderr, "kernel_launch: unexpected problem (n_in %d out %d ws %zu)\n", n_in, out_size, ws_size); grid = -1; return; }
        int dev = 0, cus = 0, per_cu = 0;
        if (hipGetDevice(&dev) != hipSuccess || hipDeviceGetAttribute(&cus, hipDeviceAttributeMultiprocessorCount, dev) != hipSuccess) { grid = -1; return; }
        if (hipFuncSetAttribute((const void*)fwd_mega, hipFuncAttributeMaxDynamicSharedMemorySize, LDS_BYTES) != hipSuccess) { fprintf(stderr, "kernel_launch: hipFuncSetAttribute failed\n"); grid = -1; return; }
        if (hipOccupancyMaxActiveBlocksPerMultiprocessor(&per_cu, (const void*)fwd_mega, NTHREADS, LDS_BYTES) != hipSuccess || per_cu < 1) { fprintf(stderr, "kernel_launch: occupancy query says %d\n", per_cu); (void)hipGetLastError(); grid = -1; return; }
        grid = cus;
    }
    if (grid < 0) return;
    (void)hipMemsetAsync((char*)d_ws + WS_CTL, 0, 32768, stream);
    Args a{};
    for (int i = 0; i < 38; ++i) a.in[i] = (const float*)d_in[i];
    a.out = (float*)d_out; a.ws = (unsigned char*)d_ws;
#if N_LAUNCH_MODE == 1
    a.ph_lo = 0; a.ph_hi = N_PHASES;
    void* kargs[] = {&a};
    hipError_t e = hipLaunchCooperativeKernel((const void*)fwd_mega, dim3(grid), dim3(NTHREADS), kargs, LDS_BYTES, stream);
    if (e != hipSuccess) fprintf(stderr, "kernel_launch: cooperative launch failed: %s\n", hipGetErrorString(e));
#else
    for (int p = 0; p < N_PHASES; ++p) { a.ph_lo = p; a.ph_hi = p + 1; hipLaunchKernelGGL(fwd_mega, dim3(grid), dim3(NTHREADS), LDS_BYTES, stream, a); }
#endif
}
```

```cpp
#include <hip/hip_runtime.h>
#include <cstdio>
#include <cstdint>

#ifndef N_LAUNCH_MODE
#define N_LAUNCH_MODE 1
#endif

#ifndef TS_A
#define TS_A -1
#endif
#ifndef TS_B
#define TS_B 0
#endif
#ifndef PROBE_WG
#define PROBE_WG -1
#endif
#ifndef PROBE_STAGE
#define PROBE_STAGE -1
#endif
#ifndef TS_SCALE
#define TS_SCALE 0.01f
#endif

#define LAS __attribute__((address_space(3)))
#define GAS __attribute__((address_space(1)))
typedef unsigned short bf16_t;
typedef short bf16x8 __attribute__((ext_vector_type(8)));
typedef short bf16x4 __attribute__((ext_vector_type(4)));
typedef float f32x4 __attribute__((ext_vector_type(4)));
typedef float f32x2 __attribute__((ext_vector_type(2)));
typedef unsigned u32x4 __attribute__((ext_vector_type(4)));
typedef unsigned u32x2 __attribute__((ext_vector_type(2)));

constexpr int NT = 16384, DM = 1024, NB = 8, TS = 2048, NMEM = 256;
constexpr int P0LD = 3840;
constexpr int P1LD = 4096;
constexpr int NTHREADS = 512, NWAVES = 8;

constexpr size_t MiB = 1048576;
constexpr size_t WS_CTL = 0;
constexpr size_t WS_CNT = 16384;
constexpr size_t WS_LB = 32768;
constexpr size_t WS_DB = 1 * MiB;
constexpr size_t WS_SSP = WS_DB + 512 * 1024;
constexpr size_t WS_MEMH = WS_SSP + 1 * MiB;
constexpr size_t WS_ROUTE = WS_MEMH + 4 * MiB;
constexpr size_t WS_LORA = WS_ROUTE + 800 * 1024;
constexpr size_t WS_RW = WS_LORA + 256 * 1024;
constexpr size_t WS_W0 = 8 * MiB;
static_assert(WS_RW + 2 * 1024 * 32 * 4 <= 8 * MiB, "small weights");
constexpr size_t WS_W1 = WS_W0 + 42 * MiB;
constexpr size_t WS_KV1 = WS_W0;
constexpr size_t WS_XB = 92 * MiB;
constexpr size_t WS_BIG = 124 * MiB;
constexpr size_t WS_END = 256 * MiB;
constexpr size_t WS_HALOB = 252 * MiB;
constexpr size_t WS_HOB = 253 * MiB;
constexpr size_t WS_HOA = 254 * MiB;
constexpr size_t WS_HOC = 252 * MiB;
constexpr size_t WS_FLAGS = 24576;
constexpr size_t WO_WIN = 0;
constexpr size_t WO_WOUT = WO_WIN + (size_t)4096 * 1024;
constexpr size_t WO_WQ = WO_WOUT + (size_t)1024 * 1024;
constexpr size_t WO_WKV = WO_WQ + (size_t)1024 * 1024;
constexpr size_t WO_WO = WO_WKV + (size_t)2048 * 1024;
constexpr size_t WO_W13 = WO_WO + (size_t)1024 * 1024;
constexpr size_t WO_W2T = WO_W13 + (size_t)16 * 512 * 1024;
constexpr size_t WO_END = WO_W2T + (size_t)16 * 1024 * 256;
static_assert(WO_END * 2 <= 42 * MiB, "weight region");
constexpr size_t BIG_PROJ = 0;
constexpr size_t BIG_KV0 = 120 * MiB;
constexpr size_t BIG_Q = 0;
constexpr size_t BIG_ATT = 32 * MiB;
constexpr size_t BIG_XG = 0;
constexpr size_t BIG_HID = 48 * MiB;
constexpr int MOE_MAXROWS = 22528;

__device__ __forceinline__ unsigned f2bf(float f) { unsigned u = __float_as_uint(f); u += 0x7fffu + ((u >> 16) & 1u); return u >> 16; }
__device__ __forceinline__ float bf2f(unsigned short b) { return __uint_as_float((unsigned)b << 16); }
__device__ __forceinline__ unsigned pk2(float lo, float hi) { return f2bf(lo) | (f2bf(hi) << 16); }
__device__ __forceinline__ float wave_sum(float v) {
#pragma unroll
    for (int o = 1; o < 64; o <<= 1) v += __shfl_xor(v, o);
    return v;
}
template <int CTRL> __device__ __forceinline__ float dppf(float v) { return __int_as_float(__builtin_amdgcn_update_dpp(0, __float_as_int(v), CTRL, 0xF, 0xF, true)); }
__device__ __forceinline__ float red8(float v) { v += dppf<0xB1>(v); v += dppf<0x4E>(v); v += dppf<0x141>(v); return v; }
__device__ __forceinline__ float red16(float v) { v = red8(v); v += dppf<0x140>(v); return v; }

__device__ __forceinline__ float rdlane(float v, int l) { return __int_as_float(__builtin_amdgcn_readlane(__float_as_int(v), l)); }
__device__ __forceinline__ float wsum(float v) { v = red16(v); return (rdlane(v, 0) + rdlane(v, 16)) + (rdlane(v, 32) + rdlane(v, 48)); }
__device__ __forceinline__ float sigmoidf_(float x) { return 1.f / (1.f + __expf(-x)); }
__device__ __forceinline__ float siluf_(float x) { return x / (1.f + __expf(-x)); }
__device__ __forceinline__ float softplusf_(float x) { return x > 20.f ? x : log1pf(__expf(x)); }
__device__ __forceinline__ int lane_id_v() { int l; asm volatile("v_mbcnt_lo_u32_b32 %0, -1, 0\n\tv_mbcnt_hi_u32_b32 %0, -1, %0" : "=v"(l)); return l; }
#define LDS_WAIT() asm volatile("s_waitcnt lgkmcnt(0)" ::: "memory")
#define VM_WAIT() asm volatile("s_waitcnt vmcnt(0)" ::: "memory")

namespace pg8 {
constexpr int BM = 256, BK = 64, HALF = 128, HTB = HALF * BK * 2, STAGE_BYTES = 8 * HTB;
__host__ __device__ __forceinline__ int lds_byte(int r, int c) { const int st = (r >> 4) * 2 + (c >> 5), rr = r & 15, cc = c & 31, ob = rr * 64 + cc * 2; return st * 1024 + (ob ^ (((ob >> 9) & 1) << 5)); }
__host__ __device__ __forceinline__ void stage_rc(int b, int& R, int& C) { const int st = b / 1024, sb = b % 1024, swz = sb ^ (((sb >> 9) & 1) << 5); R = (st >> 1) * 16 + swz / 64; C = (st & 1) * 32 + (swz % 64) / 2; }

struct Unit { int pm, pn, aux; const char* a; const char* b0; const char* b1; };
struct Gemm { int lda, ldb, K, ksplit; };

template <class Epi, class Sched>
__device__ __forceinline__ void gemm_phase(LAS unsigned char* lds, const int wave_in, const Gemm g, const Sched& S, const Epi& E) {
    const int wid = wave_in, lane = lane_id_v(), tid = wid * 64 + lane, wr = wid >> 2, wc = wid & 3, fr = lane & 15, fq = lane >> 4;
    const int K = g.K, nt = K / BK, ks = g.ksplit;
    unsigned voffA[2], voffB[2];
#pragma unroll
    for (int i = 0; i < 2; ++i) { int R, C; stage_rc(tid * 16 + i * 8192, R, C);
        voffA[i] = (unsigned)(R * g.lda + C) * 2u; voffB[i] = (unsigned)(R * g.ldb + C) * 2u; }
    const size_t kstep = (size_t)(BK * 2);
    const size_t hstepA = (size_t)HALF * g.lda * 2, hstepB = (size_t)HALF * g.ldb * 2;
    const unsigned ldsw = (unsigned)wid * 1024u;
    const int aoff = lds_byte(wr * 64 + fr, fq * 8), boff = lds_byte(wc * 32 + fr, fq * 8);
#define PG8_SA(b, h) (((b) * 2 + (h)) * HTB)
#define PG8_SB(b, h) ((4 + (b) * 2 + (h)) * HTB)
#define PG8_STAGE(bufoff, gbase, voff) do { _Pragma("unroll") for (int _i = 0; _i < 2; ++_i) \
        __builtin_amdgcn_global_load_lds((const unsigned*)((const char*)(gbase) + (voff)[_i]), (LAS unsigned*)(lds + (bufoff) + ldsw + _i * 8192), 16, 0, 0); } while (0)
#define PG8_LDA(dst, b, h) do { _Pragma("unroll") for (int m = 0; m < 4; ++m) _Pragma("unroll") for (int k = 0; k < 2; ++k) dst[m][k] = *(const LAS bf16x8*)(lds + PG8_SA(b, h) + aoff + m * 2048 + k * 1024); } while (0)
#define PG8_LDB(dst, b, h) do { _Pragma("unroll") for (int n = 0; n < 2; ++n) _Pragma("unroll") for (int k = 0; k < 2; ++k) dst[n][k] = *(const LAS bf16x8*)(lds + PG8_SB(b, h) + boff + n * 2048 + k * 1024); } while (0)
#define PG8_MMA(ai, bj, At, Bt) do { __builtin_amdgcn_s_setprio(1); _Pragma("unroll") for (int m = 0; m < 4; ++m) _Pragma("unroll") for (int n = 0; n < 2; ++n) _Pragma("unroll") for (int k = 0; k < 2; ++k) \
        acc[ai][bj][m][n] = __builtin_amdgcn_mfma_f32_16x16x32_bf16(Bt[n][k], At[m][k], acc[ai][bj][m][n], 0, 0, 0); __builtin_amdgcn_s_setprio(0); } while (0)
#define PG8_WAIT_V(n) asm volatile("s_waitcnt vmcnt(" #n ")" ::: "memory")
#define PG8_WAIT_L(n) asm volatile("s_waitcnt lgkmcnt(" #n ")" ::: "memory")
#define PG8_BAR __builtin_amdgcn_s_barrier()
#define PG8_SCHED __builtin_amdgcn_sched_barrier(0)
    Unit cur, nxt; int ui = 0;
    if (!S.next(0, cur)) return;
    f32x4 acc[2][2][4][2];
#pragma unroll
    for (int a = 0; a < 2; ++a)
#pragma unroll
        for (int b = 0; b < 2; ++b)
#pragma unroll
            for (int m = 0; m < 4; ++m)
#pragma unroll
                for (int n = 0; n < 2; ++n) acc[a][b][m][n] = (f32x4){0.f, 0.f, 0.f, 0.f};
    E.init(acc, cur, wr, wc, fr, fq);
    bf16x8 At[4][2], B0[2][2], B1[2][2];
    const char* cA = cur.a; const char* cB = cur.b0; const char* cB1 = cur.b1;
    PG8_STAGE(PG8_SB(0, 0), cB, voffB); PG8_STAGE(PG8_SB(0, 1), cB + hstepB, voffB); PG8_STAGE(PG8_SA(0, 0), cA, voffA); PG8_STAGE(PG8_SA(0, 1), cA + hstepA, voffA);
    if (wr == 1) PG8_BAR;
    PG8_WAIT_V(2); PG8_BAR;
    PG8_STAGE(PG8_SB(1, 0), cB + kstep, voffB); PG8_STAGE(PG8_SA(1, 0), cA + kstep, voffA); PG8_STAGE(PG8_SB(1, 1), cB + hstepB + kstep, voffB);
    PG8_WAIT_V(6); PG8_BAR;
    for (;;) {
        const bool has_next = S.next(ui + 1, nxt);
        const char* nA = has_next ? nxt.a : cA; const char* nB = has_next ? nxt.b0 : cB;
        for (int t = 0; t < nt; t += 2) {
            const bool last = (t == nt - 2);
            const char* a1 = cA + (size_t)(t + 1) * kstep;
            const char* a2 = last ? nA : cA + (size_t)(t + 2) * kstep;
            const char* b2 = last ? nB : ((t + 2) < ks ? cB + (size_t)(t + 2) * kstep : cB1 + (size_t)(t + 2 - ks) * kstep);
            const char* a3 = a2 + kstep; const char* b3 = b2 + kstep;
            PG8_LDB(B0, 0, 0); PG8_LDB(B1, 0, 1); PG8_SCHED; PG8_LDA(At, 0, 0); PG8_STAGE(PG8_SA(1, 1), a1 + hstepA, voffA);
            PG8_WAIT_V(8); PG8_WAIT_L(0); PG8_BAR; PG8_MMA(0, 0, At, B0); PG8_MMA(0, 1, At, B1); PG8_BAR; PG8_SCHED;
            PG8_LDA(At, 0, 1); PG8_STAGE(PG8_SB(0, 0), b2, voffB); PG8_STAGE(PG8_SB(0, 1), b2 + hstepB, voffB); PG8_STAGE(PG8_SA(0, 0), a2, voffA);
            PG8_WAIT_V(8); PG8_WAIT_L(0); PG8_BAR; PG8_MMA(1, 0, At, B0); PG8_MMA(1, 1, At, B1); PG8_BAR; PG8_SCHED;
            PG8_LDB(B0, 1, 0); PG8_LDB(B1, 1, 1); PG8_SCHED; PG8_LDA(At, 1, 0); PG8_STAGE(PG8_SA(0, 1), a2 + hstepA, voffA);
            PG8_WAIT_V(8); PG8_WAIT_L(0); PG8_BAR; PG8_MMA(0, 0, At, B0); PG8_MMA(0, 1, At, B1); PG8_BAR; PG8_SCHED;
            PG8_LDA(At, 1, 1); PG8_STAGE(PG8_SB(1, 0), b3, voffB); PG8_STAGE(PG8_SB(1, 1), b3 + hstepB, voffB); PG8_STAGE(PG8_SA(1, 0), a3, voffA);
            PG8_WAIT_V(8); PG8_WAIT_L(0); PG8_BAR; PG8_MMA(1, 0, At, B0); PG8_MMA(1, 1, At, B1); PG8_BAR; PG8_SCHED;
        }
        if (wr == 0) PG8_BAR;
        E(acc, cur, wr, wc, fr, fq);
        if (!has_next) break;
#pragma unroll
        for (int a = 0; a < 2; ++a)
#pragma unroll
            for (int b = 0; b < 2; ++b)
#pragma unroll
                for (int m = 0; m < 4; ++m)
#pragma unroll
                    for (int n = 0; n < 2; ++n) acc[a][b][m][n] = (f32x4){0.f, 0.f, 0.f, 0.f};
        cur = nxt; cA = nA; cB = nB; cB1 = nxt.b1; ++ui;
        E.init(acc, cur, wr, wc, fr, fq);
        if (wr == 1) PG8_BAR;
    }
    PG8_WAIT_V(0);
    PG8_BAR;
#undef PG8_SA
#undef PG8_SB
#undef PG8_STAGE
#undef PG8_LDA
#undef PG8_LDB
#undef PG8_MMA
#undef PG8_WAIT_V
#undef PG8_WAIT_L
#undef PG8_BAR
#undef PG8_SCHED
}

struct DenseSched {
    int nM, nN, nwg, G, c; const char* A; const char* B; size_t tA, tB;
    __device__ void init(int M, int N, int G_, int c_, const bf16_t* A_, int lda, const bf16_t* B_, int ldb) { nM = M / 256; nN = N / 256; nwg = nM * nN; G = G_; c = c_; A = (const char*)A_; B = (const char*)B_; tA = (size_t)256 * lda * 2; tB = (size_t)256 * ldb * 2; }
    __device__ bool next(int i, Unit& u) const {
        const long L = (long)i * G + c; if (L >= nwg) return false;
        int wgid = (int)L; { const int q = nwg / 8, r = nwg % 8, xcd = wgid % 8, off = wgid / 8; wgid = (xcd < r ? xcd * (q + 1) : r * (q + 1) + (xcd - r) * q) + off; }
        const int nig = 8 * nN, gid = wgid / nig, fm = gid * 8, gsz = (nM - fm) < 8 ? (nM - fm) : 8;
        u.pm = fm + ((wgid % nig) % gsz); u.pn = (wgid % nig) / gsz; u.aux = 256;
        u.a = A + (size_t)u.pm * tA; u.b0 = B + (size_t)u.pn * tB; u.b1 = u.b0; return true;
    }
};
}
using pg8::Unit;

__device__ __forceinline__ float row_rstd(const float* ssp, int row) {
    const f32x4* p = (const f32x4*)(ssp + (size_t)row * 16);
    const f32x4 a = p[0], b = p[1], c = p[2], d = p[3];
    const float s = ((a.x + a.y) + (a.z + a.w)) + ((b.x + b.y) + (b.z + b.w)) + ((c.x + c.y) + (c.z + c.w)) + ((d.x + d.y) + (d.z + d.w));
    return 1.0f / sqrtf(s * (1.0f / 1024.0f) + 1e-6f);
}
__device__ __forceinline__ unsigned short f2h_bits(float f) { _Float16 h = (_Float16)f; return __builtin_bit_cast(unsigned short, h); }
__device__ __forceinline__ float h2f_bits(unsigned short b) { return (float)__builtin_bit_cast(_Float16, b); }

template <int MODE> struct EpiScale {
    bf16_t* O; int ldc; const float* ssp; float scale; const float* lb; bf16_t* halo;
    __device__ __forceinline__ void init(f32x4 (&acc)[2][2][4][2], const Unit& u, int wr, int wc, int fr, int fq) const {}
    __device__ __forceinline__ void operator()(const f32x4 (&acc)[2][2][4][2], const Unit& u, int wr, int wc, int fr_in, int fq_in) const {
        int fr = fr_in, fq = fq_in; asm volatile("" : "+v"(fr), "+v"(fq));
#pragma unroll
        for (int ai = 0; ai < 2; ++ai)
#pragma unroll
            for (int m = 0; m < 4; ++m) {
                const int row = u.pm * 256 + ai * 128 + wr * 64 + m * 16 + fr;
                const float rs = (MODE == 2) ? scale : row_rstd(ssp, row) * scale;
#pragma unroll
                for (int bj = 0; bj < 2; ++bj)
#pragma unroll
                    for (int n = 0; n < 2; ++n) {
                        const int col = u.pn * 256 + bj * 128 + wc * 32 + n * 16 + fq * 4;
                        f32x4 v = acc[ai][bj][m][n] * rs;
                        u32x2 w;
                        if (MODE == 1) {
                            const int blk = col >> 10;
                            if (blk == 0) { v.x = siluf_(v.x); v.y = siluf_(v.y); v.z = siluf_(v.z); v.w = siluf_(v.w); }
                            if (blk == 1) {
                                const f32x4 l = *(const f32x4*)(lb + (col - 1024));
                                float o[4]; const float vv[4] = {v.x, v.y, v.z, v.w}; const float ll[4] = {l.x, l.y, l.z, l.w};
#pragma unroll
                                for (int j = 0; j < 4; ++j) o[j] = __logf(ll[j] + (1.f - ll[j]) * sigmoidf_(vv[j]));
                                w.x = (unsigned)f2h_bits(o[0]) | ((unsigned)f2h_bits(o[1]) << 16); w.y = (unsigned)f2h_bits(o[2]) | ((unsigned)f2h_bits(o[3]) << 16);
                            } else { w.x = pk2(v.x, v.y); w.y = pk2(v.z, v.w); }
                        } else { w.x = pk2(v.x, v.y); w.y = pk2(v.z, v.w); }
                        *(u32x2*)(O + (size_t)row * ldc + col) = w;
                        if (MODE == 0 && halo && col >= 2048 && (row & 63) == 63) *(u32x2*)(halo + (size_t)(row >> 6) * 1792 + (col - 2048)) = w;
                    }
            }
    }
};
struct EpiKV {
    bf16_t* Kb; bf16_t* VT;
    __device__ __forceinline__ void init(f32x4 (&acc)[2][2][4][2], const Unit& u, int wr, int wc, int fr, int fq) const {}
    __device__ __forceinline__ void operator()(const f32x4 (&acc)[2][2][4][2], const Unit& u, int wr, int wc, int fr_in, int fq_in) const {
        int fr = fr_in, fq = fq_in; asm volatile("" : "+v"(fr), "+v"(fq));
#pragma unroll
        for (int ai = 0; ai < 2; ++ai)
#pragma unroll
            for (int m = 0; m < 4; ++m) {
                const int row = u.pm * 256 + ai * 128 + wr * 64 + m * 16 + fr;
#pragma unroll
                for (int bj = 0; bj < 2; ++bj)
#pragma unroll
                    for (int n = 0; n < 2; ++n) {
                        const int col = u.pn * 256 + bj * 128 + wc * 32 + n * 16 + fq * 4;
                        const f32x4 v = acc[ai][bj][m][n];
                        if (col < 1024) { u32x2 w; w.x = pk2(v.x, v.y); w.y = pk2(v.z, v.w); *(u32x2*)(Kb + (size_t)row * 1024 + col) = w; }
                        else {
                            const int c2 = col - 1024, h = c2 >> 8, d = c2 & 255, b = row >> 8, mm = row & 255;
                            bf16_t* p = VT + ((size_t)((b * 4 + h) * 256 + d)) * 256 + mm;
                            p[0] = (bf16_t)f2bf(v.x); p[256] = (bf16_t)f2bf(v.y); p[512] = (bf16_t)f2bf(v.z); p[768] = (bf16_t)f2bf(v.w);
                        }
                    }
            }
    }
};
template <bool SCATTER> struct EpiResid {
    const float* base; float* XF; bf16_t* XB; float* ssp; const f32x4* rowinfo;
    __device__ __forceinline__ void init(f32x4 (&acc)[2][2][4][2], const Unit& u, int wr, int wc, int fr_in, int fq_in) const {
        if (SCATTER) return;
        int fr = fr_in, fq = fq_in; asm volatile("" : "+v"(fr), "+v"(fq));
#pragma unroll
        for (int ai = 0; ai < 2; ++ai)
#pragma unroll
            for (int m = 0; m < 4; ++m) {
                const int lrow = ai * 128 + wr * 64 + m * 16 + fr; const int row = u.pm * 256 + lrow;
                int tok = row;
                if (SCATTER) { const f32x4 ri = rowinfo[row]; tok = (lrow < u.aux) ? __float_as_int(ri.w) : 0; }
#pragma unroll
                for (int bj = 0; bj < 2; ++bj)
#pragma unroll
                    for (int n = 0; n < 2; ++n) acc[ai][bj][m][n] = *(const f32x4*)(base + (size_t)tok * 1024 + u.pn * 256 + bj * 128 + wc * 32 + n * 16 + fq * 4);
                asm volatile("" ::: "memory");
            }
    }
    __device__ __forceinline__ void operator()(const f32x4 (&acc)[2][2][4][2], const Unit& u, int wr, int wc, int fr_in, int fq_in) const {
        int fr = fr_in, fq = fq_in; asm volatile("" : "+v"(fr), "+v"(fq));
#pragma unroll
        for (int ai = 0; ai < 2; ++ai)
#pragma unroll
            for (int m = 0; m < 4; ++m) {
                const int lrow = ai * 128 + wr * 64 + m * 16 + fr;
                const int row = u.pm * 256 + lrow;
                int tok = row; bool valid = true;
                if (SCATTER) { valid = lrow < u.aux; const f32x4 ri = rowinfo[row]; tok = valid ? __float_as_int(ri.w) : 0; }
                float ss = 0.f;
#pragma unroll
                for (int bj = 0; bj < 2; ++bj)
#pragma unroll
                    for (int n = 0; n < 2; ++n) {
                        const int col = u.pn * 256 + bj * 128 + wc * 32 + n * 16 + fq * 4;
                        const size_t off = (size_t)tok * 1024 + col;
                        f32x4 v = acc[ai][bj][m][n];
                        if (SCATTER) v = v + *(const f32x4*)(base + off);
                        if (valid) { *(f32x4*)(XF + off) = v; u32x2 w; w.x = pk2(v.x, v.y); w.y = pk2(v.z, v.w); *(u32x2*)(XB + off) = w; }
                        ss += (v.x * v.x + v.y * v.y) + (v.z * v.z + v.w * v.w);
                    }
                ss += __shfl_xor(ss, 16); ss += __shfl_xor(ss, 32);
                if (valid && fq == 0) ssp[(size_t)tok * 16 + u.pn * 4 + wc] = ss;
            }
    }
};
struct EpiMoeUp {
    bf16_t* HID; const f32x4* rowinfo;
    __device__ __forceinline__ void init(f32x4 (&acc)[2][2][4][2], const Unit& u, int wr, int wc, int fr, int fq) const {}
    __device__ __forceinline__ void operator()(const f32x4 (&acc)[2][2][4][2], const Unit& u, int wr, int wc, int fr_in, int fq_in) const {
        int fr = fr_in, fq = fq_in; asm volatile("" : "+v"(fr), "+v"(fq));
        const int slot = u.pn >> 1, jj = u.pn & 1;
#pragma unroll
        for (int ai = 0; ai < 2; ++ai)
#pragma unroll
            for (int m = 0; m < 4; ++m) {
                const int row = u.pm * 256 + ai * 128 + wr * 64 + m * 16 + fr;
                const f32x4 ri = rowinfo[row];
                const float rs = ri.x, gt = slot ? ri.z : ri.y;
#pragma unroll
                for (int n = 0; n < 2; ++n) {
                    const f32x4 h1 = acc[ai][0][m][n] * rs, h3 = acc[ai][1][m][n] * rs;
                    const int col = slot * 256 + jj * 128 + wc * 32 + n * 16 + fq * 4;
                    u32x2 w; w.x = pk2(siluf_(h1.x) * h3.x * gt, siluf_(h1.y) * h3.y * gt); w.y = pk2(siluf_(h1.z) * h3.z * gt, siluf_(h1.w) * h3.w * gt);
                    *(u32x2*)(HID + (size_t)row * 512 + col) = w;
                }
            }
    }
};
__device__ __forceinline__ void pair_experts(int bucket, int& ea, int& eb) {
    const int g = bucket / 6, p = bucket % 6;
    const int i = (p < 3) ? 0 : (p < 5 ? 1 : 2);
    const int j = (p < 3) ? p + 1 : (p < 5 ? p - 1 : 3);
    ea = g * 4 + i; eb = g * 4 + j;
}
template <bool DOWN> struct MoeSched {
    const LAS int* tbl; int ntiles, G, c; const char* A; const char* W;
    __device__ bool next(int i, Unit& u) const {
        const int L = i * G + c, mt = L >> 2, pn = L & 3;
        if (mt >= ntiles) return false;
        const int ent = __builtin_amdgcn_readfirstlane(tbl[mt]), bucket = ent & 255; u.aux = ent >> 8;
        int ea, eb; pair_experts(bucket, ea, eb);
        u.pm = mt; u.pn = pn;
        if (!DOWN) { u.a = A + (size_t)mt * 256 * 1024 * 2; const int e = (pn < 2) ? ea : eb; u.b0 = W + ((size_t)e * 512 + 256 * (pn & 1)) * 1024 * 2; u.b1 = u.b0; }
        else { u.a = A + (size_t)mt * 256 * 512 * 2; u.b0 = W + ((size_t)ea * 1024 + 256 * pn) * 256 * 2; u.b1 = W + ((size_t)eb * 1024 + 256 * pn) * 256 * 2; }
        return true;
    }
};
__device__ __forceinline__ void moe_build_table(LAS int* tbl, const unsigned* cnt, int tid) {
    if (tid == 0) { int mt = 0;
        for (int b = 0; b < 24; ++b) { const int nb = (int)cnt[b]; for (int r = 0; r < nb; r += 256) { const int v = (nb - r) < 256 ? (nb - r) : 256; if (mt < 95) tbl[mt] = b | (v << 8); ++mt; } }
        tbl[95] = mt < 95 ? mt : 95; }
    __syncthreads();
}

#define XB_TMO      128
#define XB_XCNT(j)  (256  + 64 * (j))
#define XB_XSUB(j)  (1280 + 64 * (j))
#define XB_XGEN(j)  (2304 + 64 * (j))
#define XB_TOP      3328
#define XB_TOPGEN   3392
#define XCD_BAR_WORDS 3456
#define XB_SPIN_CAP (1u << 22)
__device__ __forceinline__ unsigned xb_ld(unsigned* p)              { return __hip_atomic_load(p, __ATOMIC_RELAXED, __HIP_MEMORY_SCOPE_AGENT); }
__device__ __forceinline__ unsigned xb_add(unsigned* p, unsigned v) { return __hip_atomic_fetch_add(p, v, __ATOMIC_RELAXED, __HIP_MEMORY_SCOPE_AGENT); }
__device__ __forceinline__ unsigned xb_xcc_id() { return (unsigned)__builtin_amdgcn_s_getreg((3 << 11) | 20) & 0xFu; }
#define XB_SPIN(cond, bar) do { unsigned _sp = 0; while (cond) { __builtin_amdgcn_s_sleep(1); \
    if ((++_sp & 255u) == 0u) { if (xb_ld(&(bar)[XB_TMO])) break; if (_sp > XB_SPIN_CAP) { atomicAdd(&(bar)[XB_TMO], 1u); break; } } } } while (0)
struct XcdBarrier { unsigned* bar; unsigned x; volatile LAS unsigned* st; int wave; };
__device__ __forceinline__ XcdBarrier xcd_barrier_post(unsigned* bar, volatile LAS unsigned* st, int wave) {
    XcdBarrier b; b.bar = bar; b.x = xb_xcc_id(); b.st = st; b.wave = wave;
    if (wave == 0 && lane_id_v() == 0) (void)xb_add(&bar[XB_XCNT(b.x)], 1u);
    return b;
}
__device__ __forceinline__ void xcd_barrier_complete(unsigned* bar, unsigned x, unsigned& nloc, unsigned& nx) {
    const unsigned G = gridDim.x * gridDim.y * gridDim.z;
    unsigned sum, cnt, mine, sp = 0u;
    for (;;) {
        sum = 0u; cnt = 0u; mine = 0u;
#pragma unroll
        for (unsigned j = 0; j < 16; ++j) { const unsigned c = xb_ld(&bar[XB_XCNT(j)]); sum += c; cnt += (c > 0u) ? 1u : 0u; mine = (j == x) ? c : mine; }
        if (sum == G) break;
        __builtin_amdgcn_s_sleep(1);
        if ((++sp & 255u) == 0u) { if (xb_ld(&bar[XB_TMO])) break; if (sp > XB_SPIN_CAP) { atomicAdd(&bar[XB_TMO], 1u); break; } }
    }
    nloc = mine > 0u ? mine : 1u; nx = cnt > 0u ? cnt : 1u;
}
__device__ __forceinline__ void xcd_barrier(const XcdBarrier& b) {
    asm volatile("s_waitcnt vmcnt(0)" ::: "memory");
    __syncthreads();
    if (b.wave == 0 && lane_id_v() == 0) {
        unsigned* bar = b.bar;
        __builtin_amdgcn_s_waitcnt(0);
        unsigned nloc = b.st[0], nx = b.st[1];
        if (nloc == 0u) { xcd_barrier_complete(bar, b.x, nloc, nx); b.st[0] = nloc; b.st[1] = nx; }
        const unsigned old = xb_add(&bar[XB_XSUB(b.x)], 1u);
        const unsigned gen = old / nloc;
        if (old + 1u == (gen + 1u) * nloc) {
            __builtin_amdgcn_fence(__ATOMIC_RELEASE, "agent");
            asm volatile("s_waitcnt vmcnt(0)" ::: "memory");
            const unsigned og = xb_add(&bar[XB_TOP], 1u);
            const unsigned tg = og / nx;
            if (og + 1u == (tg + 1u) * nx) xb_add(&bar[XB_TOPGEN], 1u);
            else XB_SPIN(xb_ld(&bar[XB_TOPGEN]) == tg, bar);
            __builtin_amdgcn_fence(__ATOMIC_ACQUIRE, "agent");
            xb_add(&bar[XB_XGEN(b.x)], 1u);
            asm volatile("s_waitcnt vmcnt(0)" ::: "memory");
        } else {
            XB_SPIN(xb_ld(&bar[XB_XGEN(b.x)]) == gen, bar);
            __builtin_amdgcn_fence(__ATOMIC_ACQUIRE, "agent");
            asm volatile("s_waitcnt vmcnt(0)" ::: "memory");
        }
    }
    __syncthreads();
}

struct Args { const float* in[38]; float* out; unsigned char* ws; int ph_lo, ph_hi; };
constexpr int LDS_BYTES = 161792;
constexpr int LDS_MISC = 156 * 1024;
struct InTab {
    const LAS unsigned long long* t;
    __device__ __forceinline__ const float* operator[](int i) const {
        const unsigned long long v = t[i];
        const unsigned lo = __builtin_amdgcn_readfirstlane((unsigned)v), hi = __builtin_amdgcn_readfirstlane((unsigned)(v >> 32));
        return (const float*)(((unsigned long long)hi << 32) | lo); }
};
struct Frame {
    LAS unsigned char* lds; int wave, G, wg;
    InTab in; float* out; unsigned char* ws;
};
#define IN_X 0
#define IN_MEM 1
#define IN_NORM_MIX 2
#define IN_NORM_XA 3
#define IN_NORM_MEM 4
#define IN_NORM_FFN 5
#define IN_NORM_FINAL 6
#define IN_AB_WIN 7
#define IN_AB_CONV 8
#define IN_AB_ALOG 9
#define IN_AB_DTB 10
#define IN_AB_ONORM 11
#define IN_AB_MU 12
#define IN_AB_W0 13
#define IN_AB_W2 14
#define IN_AB_A0 15
#define IN_AB_A2 16
#define IN_AB_G2 17
#define IN_AB_KK 18
#define IN_AB_KA 19
#define IN_AB_RK 20
#define IN_AB_LNW 21
#define IN_AB_LNB 22
#define IN_AB_WOUT 23
#define IN_C_WIN 24
#define IN_C_LB 25
#define IN_C_ONORM 26
#define IN_C_WOUT 27
#define IN_XA_WQ 28
#define IN_XA_WKV 29
#define IN_XA_WO 30
#define IN_MOE_WG 31
#define IN_MOE_BG 32
#define IN_MOE_WE 33
#define IN_MOE_BE 34
#define IN_MOE_W1 35
#define IN_MOE_W3 36
#define IN_MOE_W2 37

__device__ __forceinline__ void p0_transpose_item(const float* W, int ld, int col0, int ncols, int K, const float* gain, bf16_t* WT, int drow0, LAS float* scr, int item, int lane) {
    const int nblk = ncols / 32, kb = item / nblk, nb = item % nblk, k0 = 64 * kb, n0 = 32 * nb;
    float vv[32];
#pragma unroll
    for (int i = 0; i < 32; ++i) vv[i] = W[(size_t)(k0 + 2 * i + (lane >> 5)) * ld + col0 + n0 + (lane & 31)];
#pragma unroll
    for (int i = 0; i < 32; ++i) { const int kk = 2 * i + (lane >> 5); float v = vv[i]; if (gain) v *= gain[k0 + kk]; scr[kk * 33 + (lane & 31)] = v; }
    LDS_WAIT(); asm volatile("" ::: "memory");
    const int c = lane & 7;
#pragma unroll
    for (int j = 0; j < 4; ++j) { const int n = (lane >> 3) + 8 * j; const LAS float* s = scr + (8 * c) * 33 + n;
        u32x4 o; o.x = pk2(s[0 * 33], s[1 * 33]); o.y = pk2(s[2 * 33], s[3 * 33]); o.z = pk2(s[4 * 33], s[5 * 33]); o.w = pk2(s[6 * 33], s[7 * 33]);
        *(u32x4*)(WT + (size_t)(drow0 + n0 + n) * K + k0 + 8 * c) = o; }
    LDS_WAIT(); asm volatile("" ::: "memory");
}
__device__ __forceinline__ void p0_weight_item(const Frame& F, int it, LAS float* scr, int lane) {
    const InTab in = F.in;
    bf16_t* W0 = (bf16_t*)(F.ws + WS_W0); bf16_t* W1 = (bf16_t*)(F.ws + WS_W1);
    if (it < 16384) {
        const int l = it >> 13; int r = it & 8191; bf16_t* W = l ? W1 : W0;
        if (r < 512) { p0_transpose_item(in[IN_XA_WQ] + (size_t)l * 1024 * 1024, 1024, 0, 1024, 1024, in[IN_NORM_XA] + l * 1024, W + WO_WQ, 0, scr, r, lane); return; }
        r -= 512;
        if (r < 1024) { p0_transpose_item(in[IN_XA_WKV] + (size_t)l * 1024 * 2048, 2048, 0, 2048, 1024, in[IN_NORM_MEM] + l * 1024, W + WO_WKV, 0, scr, r, lane); return; }
        r -= 1024;
        if (r < 512) { p0_transpose_item(in[IN_XA_WO] + (size_t)l * 1024 * 1024, 1024, 0, 1024, 1024, nullptr, W + WO_WO, 0, scr, r, lane); return; }
        r -= 512;
        if (r < 4096) { const int sub = r >> 6, item = r & 63, e = sub >> 2, j = (sub >> 1) & 1, which = sub & 1;
            const float* src = (which ? in[IN_MOE_W3] : in[IN_MOE_W1]) + (size_t)(l * 16 + e) * 1024 * 256;
            p0_transpose_item(src, 256, 128 * j, 128, 1024, in[IN_NORM_FFN] + l * 1024, W + WO_W13, e * 512 + 256 * j + 128 * which, scr, item, lane); return; }
        r -= 4096;
        { const int e = r >> 7, item = r & 127;
            p0_transpose_item(in[IN_MOE_W2] + (size_t)(l * 16 + e) * 256 * 1024, 1024, 0, 1024, 256, nullptr, W + WO_W2T + (size_t)e * 1024 * 256, 0, scr, item, lane); return; }
    }
    int r = it - 16384;
    if (r < 1024) { p0_transpose_item(in[IN_AB_WIN], 3848, 0, 2048, 1024, in[IN_NORM_MIX], W0 + WO_WIN, 0, scr, r, lane); return; }
    r -= 1024;
    if (r < 896) { p0_transpose_item(in[IN_AB_WIN], 3848, 2056, 1792, 1024, in[IN_NORM_MIX], W0 + WO_WIN, 2048, scr, r, lane); return; }
    r -= 896;
    if (r < 512) { p0_transpose_item(in[IN_AB_WOUT], 1024, 0, 1024, 1024, nullptr, W0 + WO_WOUT, 0, scr, r, lane); return; }
    r -= 512;
    if (r < 2048) { p0_transpose_item(in[IN_C_WIN], 4096, 0, 4096, 1024, in[IN_NORM_MIX] + 1024, W1 + WO_WIN, 0, scr, r, lane); return; }
    r -= 2048;
    if (r < 512) { p0_transpose_item(in[IN_C_WOUT], 1024, 0, 1024, 1024, nullptr, W1 + WO_WOUT, 0, scr, r, lane); return; }
    r -= 512;
    bf16_t* LW = (bf16_t*)(F.ws + WS_LORA);
    if (r < 16) { p0_transpose_item(in[IN_AB_W2], 512, 0, 512, 64, nullptr, LW, 0, scr, r, lane); return; }
    r -= 16;
    if (r < 16) { p0_transpose_item(in[IN_AB_A2], 512, 0, 512, 64, nullptr, LW + 512 * 64, 0, scr, r, lane); return; }
    r -= 16;
    p0_transpose_item(in[IN_AB_G2], 512, 0, 512, 128, nullptr, LW + 2 * 512 * 64, 0, scr, r, lane);
}
constexpr int P0_NITEMS = 16384 + 1024 + 896 + 512 + 2048 + 512 + 64;

template <int SEL> __device__ __forceinline__ void p0_late_weights(const Frame& F, int worker, int nworkers) {
    const int lane = lane_id_v();
    LAS float* scr = (LAS float*)(F.lds + F.wave * 16384);
    const int gw = worker * NWAVES + F.wave, NGW = nworkers * NWAVES;
    if (SEL == 0) {
        for (int it = gw; it < 8192 + 512 + 2048 + 1024; it += NGW) {
            int item;
            if (it < 8192) { item = it; if (item >= 512 && item < 1536) continue; }
            else if (it < 8192 + 512) item = 16384 + 1920 + (it - 8192);
            else if (it < 8192 + 512 + 2048) item = 16384 + 1920 + 512 + (it - 8192 - 512);
            else item = 8192 + 512 + (it - 8192 - 512 - 2048);
            p0_weight_item(F, item, scr, lane);
        }
    } else {
        for (int it = gw; it < 512 + 6656 + 512; it += NGW) {
            int item;
            if (it < 512) item = 8192 + it;
            else if (it < 512 + 6656) item = 8192 + 1536 + (it - 512);
            else item = 16384 + 1920 + 512 + 2048 + (it - 512 - 6656);
            p0_weight_item(F, item, scr, lane);
        }
    }
}
__device__ __forceinline__ void p0_prologue(const Frame& F) {
    const int lane = lane_id_v(); const int tid = F.wave * 64 + lane; (void)tid;
    LAS float* scr = (LAS float*)(F.lds + F.wave * 16384);
    const int gw = F.wg * NWAVES + F.wave, NGW = F.G * NWAVES;
    for (int it = gw; it < 1920 + 64 + 1024; it += NGW) p0_weight_item(F, it < 1920 ? 16384 + it : (it < 1984 ? P0_NITEMS - 64 + (it - 1920) : 512 + (it - 1984)), scr, lane);
    const float* x = F.in[IN_X]; const float* gain = F.in[IN_NORM_MIX]; const float* win = F.in[IN_AB_WIN];
    bf16_t* XB = (bf16_t*)(F.ws + WS_XB); float* ssp = (float*)(F.ws + WS_SSP); float* db = (float*)(F.ws + WS_DB);
    for (int row = gw; row < NT; row += NGW) {
        const f32x4* xr = (const f32x4*)(x + (size_t)row * 1024) + lane;
        f32x4 v[4]; float s = 0.f; float d[8];
#pragma unroll
        for (int c = 0; c < 8; ++c) d[c] = 0.f;
#pragma unroll
        for (int j = 0; j < 4; ++j) {
            v[j] = xr[64 * j]; s += (v[j].x * v[j].x + v[j].y * v[j].y) + (v[j].z * v[j].z + v[j].w * v[j].w);
            const int k0 = 4 * lane + 256 * j;
            const f32x4 g = *(const f32x4*)(gain + k0);
            const float xv[4] = {v[j].x * g.x, v[j].y * g.y, v[j].z * g.z, v[j].w * g.w};
#pragma unroll
            for (int q = 0; q < 4; ++q) {
                const f32x4 w0 = *(const f32x4*)(win + (size_t)(k0 + q) * 3848 + 2048), w1 = *(const f32x4*)(win + (size_t)(k0 + q) * 3848 + 2052);
                d[0] += xv[q] * w0.x; d[1] += xv[q] * w0.y; d[2] += xv[q] * w0.z; d[3] += xv[q] * w0.w;
                d[4] += xv[q] * w1.x; d[5] += xv[q] * w1.y; d[6] += xv[q] * w1.z; d[7] += xv[q] * w1.w;
            }
        }
        s = wsum(s);
        const float rstd = 1.0f / sqrtf(s * (1.0f / 1024.0f) + 1e-6f);
#pragma unroll
        for (int c = 0; c < 8; ++c) d[c] = wsum(d[c]) * rstd;
        unsigned long long* o8 = (unsigned long long*)(XB + (size_t)row * 1024) + lane;
#pragma unroll
        for (int j = 0; j < 4; ++j) o8[64 * j] = (unsigned long long)pk2(v[j].x, v[j].y) | ((unsigned long long)pk2(v[j].z, v[j].w) << 32);
        if (lane < 16) ssp[(size_t)row * 16 + lane] = (lane == 0) ? s : 0.f;
        if (lane < 8) { float dv = d[0];
#pragma unroll
            for (int c = 1; c < 8; ++c) dv = (lane == c) ? d[c] : dv;
            db[(size_t)row * 8 + lane] = dv; }
    }
    const float* mem = F.in[IN_MEM]; bf16_t* MH = (bf16_t*)(F.ws + WS_MEMH);
    for (int row = gw; row < NB * NMEM; row += NGW) {
        const f32x4* xr = (const f32x4*)(mem + (size_t)row * 1024) + lane;
        f32x4 v[4]; float s = 0.f;
#pragma unroll
        for (int j = 0; j < 4; ++j) { v[j] = xr[64 * j]; s += (v[j].x * v[j].x + v[j].y * v[j].y) + (v[j].z * v[j].z + v[j].w * v[j].w); }
        s = wsum(s);
        const float rstd = 1.0f / sqrtf(s * (1.0f / 1024.0f) + 1e-6f);
        unsigned long long* o8 = (unsigned long long*)(MH + (size_t)row * 1024) + lane;
#pragma unroll
        for (int j = 0; j < 4; ++j) o8[64 * j] = (unsigned long long)pk2(v[j].x * rstd, v[j].y * rstd) | ((unsigned long long)pk2(v[j].z * rstd, v[j].w * rstd) << 32);
    }
    {
        float* rw = (float*)(F.ws + WS_RW);
        for (int idx = F.wg * NTHREADS + tid; idx < 2 * 1024 * 32; idx += F.G * NTHREADS) {
            const int l = idx >> 15, k = (idx >> 5) & 1023, cc = idx & 31;
            const float g = F.in[IN_NORM_FFN][l * 1024 + k];
            float v = 0.f;
            if (cc < 4) v = F.in[IN_MOE_WG][(size_t)l * 4096 + k * 4 + cc] * g; else if (cc < 20) v = F.in[IN_MOE_WE][(size_t)l * 16384 + k * 16 + (cc - 4)] * g;
            rw[idx] = v;
        }
    }
    if (F.wg == 0) { const float* lbp = F.in[IN_C_LB]; float* lb = (float*)(F.ws + WS_LB);
        for (int c = tid; c < 1024; c += NTHREADS) { const float a = lbp[c], b = lbp[1024 + c]; const float mx = fmaxf(a, b), ea = __expf(a - mx), eb = __expf(b - mx); lb[c] = (ea + eb) / (ea + eb) - ea / (ea + eb); } }
}

__device__ __forceinline__ void scan_delta(const Frame& F, int b, int h) {
    const int lane = lane_id_v(); const int tid = F.wave * 64 + lane; (void)tid;
    LAS float* qs = (LAS float*)F.lds;
    LAS float* ks = qs + 64 * 128;
    LAS float* vs = ks + 64 * 128;
    LAS float* os = vs + 64 * 128;
    LAS float* al = os + 64 * 128;
    LAS float* be = al + 64;
    bf16_t* P = (bf16_t*)(F.ws + WS_BIG + BIG_PROJ);
    const float* convw = F.in[IN_AB_CONV];
    const float* db = (const float*)(F.ws + WS_DB);
    const float a_neg = -__expf(F.in[IN_AB_ALOG][h]), dtb = F.in[IN_AB_DTB][h];
    const float* onorm = F.in[IN_AB_ONORM];
    const int i_dv = tid >> 2, part = tid & 3;
    float s[32];
#pragma unroll
    for (int j = 0; j < 32; ++j) s[j] = 0.f;
    for (int c = 0; c < 32; ++c) {
        const int t0 = b * TS + c * 64;
        for (int idx = tid; idx < 64 * 384; idx += NTHREADS) {
            const int t = idx / 384, cc = idx % 384, sct = cc >> 7, col = cc & 127;
            const int gcol = sct * 512 + h * 128 + col;
            float a = 0.f;
#pragma unroll
            for (int j = 0; j < 4; ++j) { const int tl = c * 64 + t - 3 + j; if (tl >= 0) a += convw[j * 1536 + gcol] * bf2f(P[(size_t)(b * TS + tl) * P0LD + gcol]); }
            a = siluf_(a);
            (sct == 0 ? qs : (sct == 1 ? ks : vs))[t * 128 + col] = a;
        }
        if (tid < 64) { const int t = tid; const float la = a_neg * softplusf_(db[(size_t)(t0 + t) * 8 + h] + dtb); al[t] = __expf(la); be[t] = sigmoidf_(db[(size_t)(t0 + t) * 8 + 4 + h]); }
        __syncthreads();
        for (int r = F.wave; r < 128; r += NWAVES) { LAS float* p = (r < 64 ? qs + r * 128 : ks + (r - 64) * 128);
            const float v0 = p[lane], v1 = p[lane + 64]; const float ss = wave_sum(v0 * v0 + v1 * v1);
            const float sc = (1.0f / sqrtf(ss + 1e-6f)) * (r < 64 ? 0.08838834764831845f : 1.0f); p[lane] = v0 * sc; p[lane + 64] = v1 * sc; }
        __syncthreads();
        for (int t = 0; t < 64; ++t) {
            const LAS f32x4* kp = (const LAS f32x4*)(ks + t * 128 + part * 32); const LAS f32x4* qp = (const LAS f32x4*)(qs + t * 128 + part * 32);
            float kt[32], qt[32];
#pragma unroll
            for (int j = 0; j < 8; ++j) { const f32x4 a = kp[j], q = qp[j]; kt[4 * j] = a.x; kt[4 * j + 1] = a.y; kt[4 * j + 2] = a.z; kt[4 * j + 3] = a.w; qt[4 * j] = q.x; qt[4 * j + 1] = q.y; qt[4 * j + 2] = q.z; qt[4 * j + 3] = q.w; }
            float p = 0.f;
#pragma unroll
            for (int j = 0; j < 32; ++j) p += s[j] * kt[j];
            p += __shfl_xor(p, 1); p += __shfl_xor(p, 2);
            const float alpha = al[t], coef = be[t] * (vs[t * 128 + i_dv] - alpha * p);
            float o = 0.f;
#pragma unroll
            for (int j = 0; j < 32; ++j) { s[j] = alpha * s[j] + coef * kt[j]; o += s[j] * qt[j]; }
            o += __shfl_xor(o, 1); o += __shfl_xor(o, 2);
            if (part == 0) os[t * 128 + i_dv] = o;
        }
        __syncthreads();
        for (int t = F.wave; t < 64; t += NWAVES) {
            const float o0 = os[t * 128 + lane], o1 = os[t * 128 + lane + 64];
            const float ss = wave_sum(o0 * o0 + o1 * o1), rs = 1.0f / sqrtf(ss * (1.0f / 128.0f) + 1e-6f);
            bf16_t* gp = P + (size_t)(t0 + t) * P0LD + 1536 + h * 128;
            const float g0 = bf2f(gp[lane]), g1 = bf2f(gp[lane + 64]);
            gp[lane] = (bf16_t)f2bf(o0 * rs * onorm[lane] * siluf_(g0)); gp[lane + 64] = (bf16_t)f2bf(o1 * rs * onorm[lane + 64] * siluf_(g1));
        }
        __syncthreads();
    }
}
__device__ __forceinline__ void scan_rwkv(const Frame& F, int b, int h) {
    const int lane = lane_id_v(); const int tid = F.wave * 64 + lane; (void)tid;
    LAS float* bufA = (LAS float*)F.lds;
    LAS float* bufB = bufA + 4096;
    LAS float* bufC = bufB + 4096;
    LAS float* R = bufC + 8192;
    LAS float* Kb = R + 4096;
    LAS float* V = Kb + 4096;
    LAS float* KK = V + 4096;
    LAS float* halo = KK + 4096;
    LAS float* bonus = halo + 896;
    bf16_t* P = (bf16_t*)(F.ws + WS_BIG + BIG_PROJ);
    const float* mu = F.in[IN_AB_MU];
    const float* w0 = F.in[IN_AB_W0] + h * 64; const float* w2 = F.in[IN_AB_W2] + h * 64;
    const float* a0 = F.in[IN_AB_A0] + h * 64; const float* a2 = F.in[IN_AB_A2] + h * 64;
    const float* g2 = F.in[IN_AB_G2] + h * 64;
    const float* k_k = F.in[IN_AB_KK] + h * 64; const float* k_a = F.in[IN_AB_KA] + h * 64; const float* r_k = F.in[IN_AB_RK] + h * 64;
    const float* ln_w = F.in[IN_AB_LNW] + h * 64; const float* ln_b = F.in[IN_AB_LNB] + h * 64;
    const int vi = tid >> 3, part = tid & 7;
    float s[8];
#pragma unroll
    for (int j = 0; j < 8; ++j) s[j] = 0.f;
    for (int i = tid; i < 896; i += NTHREADS) halo[i] = 0.f;
    __syncthreads();
    for (int c = 0; c < 32; ++c) {
        const int t0 = b * TS + c * 64;
        const LAS float* hcur = halo + (c & 1) * 448; LAS float* hnext = halo + ((c + 1) & 1) * 448;
        for (int idx = tid; idx < 64 * 448; idx += NTHREADS) {
            const int t = idx / 448, col = idx % 448;
            int gc;
            if (col < 64) gc = 2048 + h * 64 + col; else if (col < 128) gc = 2560 + h * 64 + (col - 64); else if (col < 192) gc = 3072 + h * 64 + (col - 128); else gc = 3584 + (col - 192);
            const float cur = bf2f(P[(size_t)(t0 + t) * P0LD + gc]);
            const float prev = (t > 0) ? bf2f(P[(size_t)(t0 + t - 1) * P0LD + gc]) : hcur[col];
            const float sh = cur + mu[gc - 2048] * (prev - cur);
            if (t == 63) hnext[col] = cur;
            if (col < 64) R[t * 64 + col] = sh; else if (col < 128) Kb[t * 64 + col - 64] = sh; else if (col < 192) V[t * 64 + col - 128] = sh;
            else if (col < 256) bufA[t * 64 + col - 192] = tanhf(sh); else if (col < 320) bufB[t * 64 + col - 256] = sh; else bufC[t * 128 + col - 320] = sigmoidf_(sh);
        }
        __syncthreads();
        float wv[8], av[8], gv[8];
        {
            const int j = lane, tb = F.wave * 8;
#pragma unroll
            for (int q = 0; q < 8; ++q) { wv[q] = 0.f; av[q] = 0.f; gv[q] = 0.f; }
            for (int m = 0; m < 64; ++m) { const float x2 = w2[(size_t)m * 512 + j], y2 = a2[(size_t)m * 512 + j];
#pragma unroll
                for (int q = 0; q < 8; ++q) { wv[q] += bufA[(tb + q) * 64 + m] * x2; av[q] += bufB[(tb + q) * 64 + m] * y2; } }
            for (int m = 0; m < 128; ++m) { const float z2 = g2[(size_t)m * 512 + j];
#pragma unroll
                for (int q = 0; q < 8; ++q) gv[q] += bufC[(tb + q) * 128 + m] * z2; }
#pragma unroll
            for (int q = 0; q < 8; ++q) { wv[q] = __expf(-0.6065306597126334f * sigmoidf_(w0[j] + wv[q])); av[q] = sigmoidf_(a0[j] + av[q]); }
        }
        __syncthreads();
        {
            const int j = lane, tb = F.wave * 8;
#pragma unroll
            for (int q = 0; q < 8; ++q) { bufA[(tb + q) * 64 + j] = wv[q]; bufB[(tb + q) * 64 + j] = av[q]; bufC[(tb + q) * 64 + j] = gv[q]; }
#pragma unroll
            for (int q = 0; q < 8; ++q) { const int t = tb + q; const float kv = Kb[t * 64 + j]; const float kx = kv * k_k[j]; const float ss = wave_sum(kx * kx);
                KK[t * 64 + j] = kx * (1.0f / sqrtf(ss + 1e-6f)); const float km = kv * (1.f + (av[q] - 1.f) * k_a[j]); Kb[t * 64 + j] = km;
                const float bs = wave_sum(R[t * 64 + j] * km * r_k[j]); if (j == 0) bonus[t] = bs; }
        }
        __syncthreads();
        LAS float* O = bufC + 4096;
        for (int t = 0; t < 64; ++t) {
            const LAS f32x4* p4;
            float kk[8], ww[8], aa[8], km[8], rr[8];
            p4 = (const LAS f32x4*)(KK + t * 64 + part * 8);   { const f32x4 a = p4[0], c2 = p4[1]; kk[0] = a.x; kk[1] = a.y; kk[2] = a.z; kk[3] = a.w; kk[4] = c2.x; kk[5] = c2.y; kk[6] = c2.z; kk[7] = c2.w; }
            p4 = (const LAS f32x4*)(bufA + t * 64 + part * 8); { const f32x4 a = p4[0], c2 = p4[1]; ww[0] = a.x; ww[1] = a.y; ww[2] = a.z; ww[3] = a.w; ww[4] = c2.x; ww[5] = c2.y; ww[6] = c2.z; ww[7] = c2.w; }
            p4 = (const LAS f32x4*)(bufB + t * 64 + part * 8); { const f32x4 a = p4[0], c2 = p4[1]; aa[0] = a.x; aa[1] = a.y; aa[2] = a.z; aa[3] = a.w; aa[4] = c2.x; aa[5] = c2.y; aa[6] = c2.z; aa[7] = c2.w; }
            p4 = (const LAS f32x4*)(Kb + t * 64 + part * 8);   { const f32x4 a = p4[0], c2 = p4[1]; km[0] = a.x; km[1] = a.y; km[2] = a.z; km[3] = a.w; km[4] = c2.x; km[5] = c2.y; km[6] = c2.z; km[7] = c2.w; }
            p4 = (const LAS f32x4*)(R + t * 64 + part * 8);    { const f32x4 a = p4[0], c2 = p4[1]; rr[0] = a.x; rr[1] = a.y; rr[2] = a.z; rr[3] = a.w; rr[4] = c2.x; rr[5] = c2.y; rr[6] = c2.z; rr[7] = c2.w; }
            const float vv = V[t * 64 + vi];
            float sa = 0.f;
#pragma unroll
            for (int j = 0; j < 8; ++j) sa -= s[j] * kk[j];
            sa += __shfl_xor(sa, 1); sa += __shfl_xor(sa, 2); sa += __shfl_xor(sa, 4);
            float o = 0.f;
#pragma unroll
            for (int j = 0; j < 8; ++j) { s[j] = s[j] * ww[j] + sa * (kk[j] * aa[j]) + vv * km[j]; o += s[j] * rr[j]; }
            o += __shfl_xor(o, 1); o += __shfl_xor(o, 2); o += __shfl_xor(o, 4);
            if (part == 0) O[t * 64 + vi] = o;
        }
        __syncthreads();
        for (int t = F.wave; t < 64; t += NWAVES) {
            const float o = O[t * 64 + lane];
            const float mean = wave_sum(o) * (1.0f / 64.0f); const float dlt = o - mean; const float var = wave_sum(dlt * dlt) * (1.0f / 64.0f);
            float y = dlt * (1.0f / sqrtf(var + 64e-5f)) * ln_w[lane] + ln_b[lane];
            y += bonus[t] * V[t * 64 + lane];
            y *= bufC[t * 64 + lane];
            P[(size_t)(t0 + t) * P0LD + 2048 + h * 64 + lane] = (bf16_t)f2bf(y);
        }
        __syncthreads();
    }
}
__device__ __forceinline__ void scan_hgrn(const Frame& F, int b, int h) {
    const int lane = lane_id_v(); const int tid = F.wave * 64 + lane; (void)tid;
    LAS float* qs = (LAS float*)F.lds;
    LAS float* fs = qs + 64 * 128;
    LAS float* kf = fs + 64 * 128;
    LAS float* is = kf + 64 * 128;
    bf16_t* P = (bf16_t*)(F.ws + WS_BIG + BIG_PROJ);
    const float* onorm = F.in[IN_C_ONORM];
    const int e = tid >> 2, part = tid & 3;
    float s[32];
#pragma unroll
    for (int j = 0; j < 32; ++j) s[j] = 0.f;
    for (int c = 0; c < 32; ++c) {
        const int t0 = b * TS + c * 64;
        for (int idx = tid; idx < 64 * 128; idx += NTHREADS) {
            const int t = idx >> 7, col = idx & 127; const bf16_t* pr = P + (size_t)(t0 + t) * P1LD + h * 128 + col;
            qs[idx] = bf2f(pr[0]); const float lf = h2f_bits(pr[1024]); fs[idx] = __expf(lf); kf[idx] = -expm1f(lf); is[idx] = bf2f(pr[2048]);
        }
        __syncthreads();
        for (int t = 0; t < 64; ++t) {
            const LAS f32x4* fp = (const LAS f32x4*)(fs + t * 128 + part * 32); const LAS f32x4* kp = (const LAS f32x4*)(kf + t * 128 + part * 32); const LAS f32x4* qp = (const LAS f32x4*)(qs + t * 128 + part * 32);
            const float iv = is[t * 128 + e];
            float o = 0.f;
#pragma unroll
            for (int j = 0; j < 8; ++j) { const f32x4 f = fp[j], k = kp[j], q = qp[j];
                s[4 * j] = f.x * s[4 * j] + k.x * iv; o += s[4 * j] * q.x;
                s[4 * j + 1] = f.y * s[4 * j + 1] + k.y * iv; o += s[4 * j + 1] * q.y;
                s[4 * j + 2] = f.z * s[4 * j + 2] + k.z * iv; o += s[4 * j + 2] * q.z;
                s[4 * j + 3] = f.w * s[4 * j + 3] + k.w * iv; o += s[4 * j + 3] * q.w; }
            o += __shfl_xor(o, 1); o += __shfl_xor(o, 2);
            if (part == 0) is[t * 128 + e] = o;
        }
        __syncthreads();
        for (int t = F.wave; t < 64; t += NWAVES) {
            const float o0 = is[t * 128 + lane], o1 = is[t * 128 + lane + 64];
            const float ss = wave_sum(o0 * o0 + o1 * o1), rs = 1.0f / sqrtf(ss * (1.0f / 128.0f) + 1e-6f);
            bf16_t* gp = P + (size_t)(t0 + t) * P1LD + 3072 + h * 128;
            const float g0 = bf2f(gp[lane]), g1 = bf2f(gp[lane + 64]);
            gp[lane] = (bf16_t)f2bf(o0 * rs * onorm[lane] * siluf_(g0)); gp[lane + 64] = (bf16_t)f2bf(o1 * rs * onorm[lane + 64] * siluf_(g1));
        }
        __syncthreads();
    }
}

__device__ __forceinline__ void scan_delta2(const Frame& F, int b, int h, int qd) {
    const int lane = lane_id_v(); const int tid = F.wave * 64 + lane;
    LAS float* Kc = (LAS float*)F.lds;
    LAS float* Qc = Kc + 64 * 128;
    LAS float* Vc = Qc + 64 * 128;
    LAS float* Oc = Vc + 64 * 32;
    LAS float* al = Oc + 64 * 32;
    LAS float* be = al + 64;
    LAS float* vh = be + 64;
    bf16_t* P = (bf16_t*)(F.ws + WS_BIG + BIG_PROJ);
    const float* convw = F.in[IN_AB_CONV];
    const float* db = (const float*)(F.ws + WS_DB);
    const float a_neg = -__expf(F.in[IN_AB_ALOG][h]), dtb = F.in[IN_AB_DTB][h];
    const int w = F.wave;
    const int vcol = 1024 + h * 128 + qd * 32 + (lane & 31);
    float cwq[4][2], cwk[4][2], cwv[4];
#pragma unroll
    for (int j = 0; j < 4; ++j) { cwq[j][0] = convw[j * 1536 + h * 128 + lane]; cwq[j][1] = convw[j * 1536 + h * 128 + lane + 64];
        cwk[j][0] = convw[j * 1536 + 512 + h * 128 + lane]; cwk[j][1] = convw[j * 1536 + 512 + h * 128 + lane + 64]; cwv[j] = convw[j * 1536 + vcol]; }
    const int r = tid >> 4, part = tid & 15;
    float s[8];
#pragma unroll
    for (int j = 0; j < 8; ++j) s[j] = 0.f;
    if (tid < 192) vh[tid] = 0.f;
    __syncthreads();
    for (int c = 0; c < 32; ++c) {
        const int t0 = b * TS + c * 64;
        const LAS float* vhc = vh + (c & 1) * 96; LAS float* vhn = vh + ((c + 1) & 1) * 96;
        {
            float rq[11][2], rk[11][2], rv[11];
#pragma unroll
            for (int rr = 0; rr < 11; ++rr) {
                const int tl = c * 64 + 8 * w - 3 + rr;
                const bool ok = tl >= 0;
                const bf16_t* row = P + (size_t)(b * TS + (ok ? tl : 0)) * P0LD;
                rq[rr][0] = ok ? bf2f(row[h * 128 + lane]) : 0.f; rq[rr][1] = ok ? bf2f(row[h * 128 + lane + 64]) : 0.f;
                rk[rr][0] = ok ? bf2f(row[512 + h * 128 + lane]) : 0.f; rk[rr][1] = ok ? bf2f(row[512 + h * 128 + lane + 64]) : 0.f;
                const bool prevchunk = (8 * w - 3 + rr) < 0;
                rv[rr] = prevchunk ? vhc[(rr < 3 ? rr : 0) * 32 + (lane & 31)] : bf2f(row[vcol]);
            }
            if (w == 7 && lane < 32) { vhn[lane] = rv[8]; vhn[32 + lane] = rv[9]; vhn[64 + lane] = rv[10]; }
#pragma unroll
            for (int i = 0; i < 8; ++i) {
                const int t = 8 * w + i;
                float q0 = 0.f, q1 = 0.f, k0 = 0.f, k1 = 0.f, vv = 0.f;
#pragma unroll
                for (int j = 0; j < 4; ++j) { q0 += cwq[j][0] * rq[i + j][0]; q1 += cwq[j][1] * rq[i + j][1]; k0 += cwk[j][0] * rk[i + j][0]; k1 += cwk[j][1] * rk[i + j][1]; vv += cwv[j] * rv[i + j]; }
                q0 = siluf_(q0); q1 = siluf_(q1); k0 = siluf_(k0); k1 = siluf_(k1); vv = siluf_(vv);
                const float sq = wave_sum(q0 * q0 + q1 * q1), sk = wave_sum(k0 * k0 + k1 * k1);
                const float cq = (1.0f / sqrtf(sq + 1e-6f)) * 0.08838834764831845f, ck = 1.0f / sqrtf(sk + 1e-6f);
                Qc[t * 128 + lane] = q0 * cq; Qc[t * 128 + lane + 64] = q1 * cq; Kc[t * 128 + lane] = k0 * ck; Kc[t * 128 + lane + 64] = k1 * ck;
                if (lane < 32) Vc[t * 32 + lane] = vv;
            }
            if (lane < 8) { const int t = 8 * w + lane; const float la = a_neg * softplusf_(db[(size_t)(t0 + t) * 8 + h] + dtb); al[t] = __expf(la); be[t] = sigmoidf_(db[(size_t)(t0 + t) * 8 + 4 + h]); }
        }
        __syncthreads();
        {
            const LAS float* kp = Kc + part * 8; const LAS float* qp = Qc + part * 8;
            f32x4 ka = *(const LAS f32x4*)(kp), kb = *(const LAS f32x4*)(kp + 4), qa = *(const LAS f32x4*)(qp), qb = *(const LAS f32x4*)(qp + 4);
            float vv = Vc[r], alpha = al[0], beta = be[0];
            for (int t = 0; t < 64; ++t) {
                const int tn = (t + 1) & 63;
                const f32x4 nka = *(const LAS f32x4*)(kp + tn * 128), nkb = *(const LAS f32x4*)(kp + tn * 128 + 4), nqa = *(const LAS f32x4*)(qp + tn * 128), nqb = *(const LAS f32x4*)(qp + tn * 128 + 4);
                const float nvv = Vc[tn * 32 + r], nal = al[tn], nbe = be[tn];
                float p0 = s[0] * ka.x + s[1] * ka.y, p1 = s[2] * ka.z + s[3] * ka.w, p2 = s[4] * kb.x + s[5] * kb.y, p3 = s[6] * kb.z + s[7] * kb.w;
                const float p = red16((p0 + p1) + (p2 + p3));
                const float coef = beta * (vv - alpha * p);
                s[0] = alpha * s[0] + coef * ka.x; s[1] = alpha * s[1] + coef * ka.y; s[2] = alpha * s[2] + coef * ka.z; s[3] = alpha * s[3] + coef * ka.w;
                s[4] = alpha * s[4] + coef * kb.x; s[5] = alpha * s[5] + coef * kb.y; s[6] = alpha * s[6] + coef * kb.z; s[7] = alpha * s[7] + coef * kb.w;
                float o0 = s[0] * qa.x + s[1] * qa.y, o1 = s[2] * qa.z + s[3] * qa.w, o2 = s[4] * qb.x + s[5] * qb.y, o3 = s[6] * qb.z + s[7] * qb.w;
                const float o = red16((o0 + o1) + (o2 + o3));
                if (part == 0) Oc[t * 32 + r] = o;
                ka = nka; kb = nkb; qa = nqa; qb = nqb; vv = nvv; alpha = nal; beta = nbe;
            }
        }
        __syncthreads();
        {
            const int t = tid >> 3, c4 = (tid & 7) * 4;
            const f32x4 o = *(const LAS f32x4*)(Oc + t * 32 + c4);
            u32x2 wv; wv.x = pk2(o.x, o.y); wv.y = pk2(o.z, o.w);
            *(u32x2*)(P + (size_t)(t0 + t) * P0LD + 1024 + h * 128 + qd * 32 + c4) = wv;
        }
    }
}
__device__ __forceinline__ void fin_delta(const Frame& F) {
    const int lane = lane_id_v();
    bf16_t* P = (bf16_t*)(F.ws + WS_BIG + BIG_PROJ); const float* onorm = F.in[IN_AB_ONORM];
    const float on0 = onorm[lane], on1 = onorm[lane + 64];
    const int gw = F.wg * NWAVES + F.wave, NGW = F.G * NWAVES;
    for (int it = gw; it < NT * 4; it += NGW) {
        const int t = it >> 2, h = it & 3;
        bf16_t* row = P + (size_t)t * P0LD;
        const float o0 = bf2f(row[1024 + h * 128 + lane]), o1 = bf2f(row[1024 + h * 128 + lane + 64]);
        const float g0 = bf2f(row[1536 + h * 128 + lane]), g1 = bf2f(row[1536 + h * 128 + lane + 64]);
        const float ss = wave_sum(o0 * o0 + o1 * o1), rs = 1.0f / sqrtf(ss * (1.0f / 128.0f) + 1e-6f);
        row[1536 + h * 128 + lane] = (bf16_t)f2bf(o0 * rs * on0 * siluf_(g0)); row[1536 + h * 128 + lane + 64] = (bf16_t)f2bf(o1 * rs * on1 * siluf_(g1));
    }
}

__device__ __forceinline__ void scan_rwkv2(const Frame& F, int b, int h) {
    const int lane = lane_id_v(); const int tid = F.wave * 64 + lane;
    LAS float* R = (LAS float*)F.lds;
    LAS float* KM = R + 4096;
    LAS float* V = KM + 4096;
    LAS float* KK = V + 4096;
    LAS float* KA = KK + 4096;
    LAS float* W = KA + 4096;
    LAS bf16_t* TL = (LAS bf16_t*)(W + 4096);
    LAS bf16_t* AL = TL + 64 * 72;
    LAS bf16_t* SG = AL + 64 * 72;
    LAS float* O = (LAS float*)TL;
    LAS bf16_t* GB = SG + 64 * 136;
    LAS float* halo = (LAS float*)(GB + 4096);
    LAS float* bonus = halo + 896;
    bf16_t* P = (bf16_t*)(F.ws + WS_BIG + BIG_PROJ);
    const bf16_t* LW = (const bf16_t*)(F.ws + WS_LORA);
    const float* mu = F.in[IN_AB_MU];
    const float* w0 = F.in[IN_AB_W0] + h * 64; const float* a0 = F.in[IN_AB_A0] + h * 64;
    const float* k_k = F.in[IN_AB_KK] + h * 64; const float* k_a = F.in[IN_AB_KA] + h * 64; const float* r_k = F.in[IN_AB_RK] + h * 64;
    const float* ln_w = F.in[IN_AB_LNW] + h * 64; const float* ln_b = F.in[IN_AB_LNB] + h * 64;
    const int w = F.wave, fr = lane & 15, fq = lane >> 4;
    const int vi = tid >> 3, part = tid & 7;
    float s[8];
#pragma unroll
    for (int j = 0; j < 8; ++j) s[j] = 0.f;
    for (int i = tid; i < 896; i += NTHREADS) halo[i] = 0.f;
    int gc = 0; float muc = 0.f;
    if (tid < 448) { const int col = tid;
        if (col < 64) gc = 2048 + h * 64 + col; else if (col < 128) gc = 2560 + h * 64 + (col - 64); else if (col < 192) gc = 3072 + h * 64 + (col - 128); else gc = 3584 + (col - 192);
        muc = mu[gc - 2048]; }
    __syncthreads();
    for (int c = 0; c < 32; ++c) {
        const int t0 = b * TS + c * 64;
        if (tid < 448) {
            const int col = tid;
            LAS float* hc = halo + (c & 1) * 448; LAS float* hn = halo + ((c + 1) & 1) * 448;
            float prev = hc[col];
            const bf16_t* src = P + (size_t)t0 * P0LD + gc;
#pragma unroll 8
            for (int t = 0; t < 64; ++t) {
                const float cur = bf2f(src[(size_t)t * P0LD]);
                const float sh = cur + muc * (prev - cur);
                prev = cur;
                if (col < 64) R[t * 64 + col] = sh; else if (col < 128) KM[t * 64 + col - 64] = sh; else if (col < 192) V[t * 64 + col - 128] = sh;
                else if (col < 256) TL[t * 72 + col - 192] = (bf16_t)f2bf(tanhf(sh)); else if (col < 320) AL[t * 72 + col - 256] = (bf16_t)f2bf(sh); else SG[t * 136 + col - 320] = (bf16_t)f2bf(sigmoidf_(sh));
            }
            hn[col] = prev;
        }
        __syncthreads();
        {
#pragma unroll
            for (int q = 0; q < 2; ++q) {
                const int id = 2 * w + q, mi = id >> 2, nj = id & 3;
                f32x4 aw = {0.f, 0.f, 0.f, 0.f}, aa = {0.f, 0.f, 0.f, 0.f}, ag = {0.f, 0.f, 0.f, 0.f};
                const int jrow = h * 64 + nj * 16 + fr;
#pragma unroll
                for (int ksx = 0; ksx < 2; ++ksx) {
                    const bf16x8 x1 = *(const LAS bf16x8*)(TL + (mi * 16 + fr) * 72 + ksx * 32 + fq * 8), x2 = *(const LAS bf16x8*)(AL + (mi * 16 + fr) * 72 + ksx * 32 + fq * 8);
                    const bf16x8 y1 = *(const bf16x8*)(LW + (size_t)jrow * 64 + ksx * 32 + fq * 8), y2 = *(const bf16x8*)(LW + 512 * 64 + (size_t)jrow * 64 + ksx * 32 + fq * 8);
                    aw = __builtin_amdgcn_mfma_f32_16x16x32_bf16(x1, y1, aw, 0, 0, 0); aa = __builtin_amdgcn_mfma_f32_16x16x32_bf16(x2, y2, aa, 0, 0, 0);
                }
#pragma unroll
                for (int ksx = 0; ksx < 4; ++ksx) {
                    const bf16x8 x3 = *(const LAS bf16x8*)(SG + (mi * 16 + fr) * 136 + ksx * 32 + fq * 8);
                    const bf16x8 y3 = *(const bf16x8*)(LW + 2 * 512 * 64 + (size_t)jrow * 128 + ksx * 32 + fq * 8);
                    ag = __builtin_amdgcn_mfma_f32_16x16x32_bf16(x3, y3, ag, 0, 0, 0);
                }
                const int j = nj * 16 + fr; const float w0j = w0[j], a0j = a0[j];
                const float awv[4] = {aw.x, aw.y, aw.z, aw.w}, aav[4] = {aa.x, aa.y, aa.z, aa.w}, agv[4] = {ag.x, ag.y, ag.z, ag.w};
#pragma unroll
                for (int rg = 0; rg < 4; ++rg) { const int t = mi * 16 + 4 * fq + rg;
                    W[t * 64 + j] = __expf(-0.6065306597126334f * sigmoidf_(w0j + awv[rg])); KA[t * 64 + j] = sigmoidf_(a0j + aav[rg]); GB[t * 64 + j] = (bf16_t)f2bf(agv[rg]); }
            }
        }
        __syncthreads();
        {
            const int j = lane; const float kkj = k_k[j], kaj = k_a[j], rkj = r_k[j];
#pragma unroll
            for (int q = 0; q < 8; ++q) { const int t = w * 8 + q; const float kv = KM[t * 64 + j], a = KA[t * 64 + j]; const float kx = kv * kkj; const float ss = wave_sum(kx * kx);
                const float kk = kx * (1.0f / sqrtf(ss + 1e-6f)); KK[t * 64 + j] = kk; KA[t * 64 + j] = kk * a; const float km = kv * (1.f + (a - 1.f) * kaj); KM[t * 64 + j] = km;
                const float bs = wave_sum(R[t * 64 + j] * km * rkj); if (j == 0) bonus[t] = bs; }
        }
        __syncthreads();
        {
            const int o8 = part * 8;
            for (int t = 0; t < 64; ++t) {
                const f32x4 k0 = *(const LAS f32x4*)(KK + t * 64 + o8), k1 = *(const LAS f32x4*)(KK + t * 64 + o8 + 4);
                const f32x4 w0v = *(const LAS f32x4*)(W + t * 64 + o8), w1v = *(const LAS f32x4*)(W + t * 64 + o8 + 4);
                const f32x4 a0v = *(const LAS f32x4*)(KA + t * 64 + o8), a1v = *(const LAS f32x4*)(KA + t * 64 + o8 + 4);
                const f32x4 m0 = *(const LAS f32x4*)(KM + t * 64 + o8), m1 = *(const LAS f32x4*)(KM + t * 64 + o8 + 4);
                const f32x4 r0 = *(const LAS f32x4*)(R + t * 64 + o8), r1 = *(const LAS f32x4*)(R + t * 64 + o8 + 4);
                const float vv = V[t * 64 + vi];
                const float sa = -red8(((s[0] * k0.x + s[1] * k0.y) + (s[2] * k0.z + s[3] * k0.w)) + ((s[4] * k1.x + s[5] * k1.y) + (s[6] * k1.z + s[7] * k1.w)));
                s[0] = s[0] * w0v.x + sa * a0v.x + vv * m0.x; s[1] = s[1] * w0v.y + sa * a0v.y + vv * m0.y; s[2] = s[2] * w0v.z + sa * a0v.z + vv * m0.z; s[3] = s[3] * w0v.w + sa * a0v.w + vv * m0.w;
                s[4] = s[4] * w1v.x + sa * a1v.x + vv * m1.x; s[5] = s[5] * w1v.y + sa * a1v.y + vv * m1.y; s[6] = s[6] * w1v.z + sa * a1v.z + vv * m1.z; s[7] = s[7] * w1v.w + sa * a1v.w + vv * m1.w;
                const float o = red8(((s[0] * r0.x + s[1] * r0.y) + (s[2] * r0.z + s[3] * r0.w)) + ((s[4] * r1.x + s[5] * r1.y) + (s[6] * r1.z + s[7] * r1.w)));
                if (part == 0) O[t * 64 + vi] = o;
            }
        }
        __syncthreads();
        for (int t = w; t < 64; t += NWAVES) {
            const float o = O[t * 64 + lane];
            const float mean = wave_sum(o) * (1.0f / 64.0f); const float dlt = o - mean; const float var = wave_sum(dlt * dlt) * (1.0f / 64.0f);
            float y = dlt * (1.0f / sqrtf(var + 64e-5f)) * ln_w[lane] + ln_b[lane];
            y += bonus[t] * V[t * 64 + lane];
            y *= bf2f(GB[t * 64 + lane]);
            P[(size_t)(t0 + t) * P0LD + 2048 + h * 64 + lane] = (bf16_t)f2bf(y);
        }
        __syncthreads();
    }
}

__device__ __forceinline__ void scan_hgrn2(const Frame& F, int b, int h, int qd) {
    const int lane = lane_id_v(); const int tid = F.wave * 64 + lane;
    LAS float* qs = (LAS float*)F.lds;
    LAS float* fs = qs + 64 * 128;
    LAS float* kf = fs + 64 * 128;
    LAS float* is = kf + 64 * 128;
    bf16_t* P = (bf16_t*)(F.ws + WS_BIG + BIG_PROJ);
    const int e = tid >> 4, part = tid & 15;
    float s[8];
#pragma unroll
    for (int j = 0; j < 8; ++j) s[j] = 0.f;
    for (int c = 0; c < 32; ++c) {
        const int t0 = b * TS + c * 64;
        {
            const int t = tid >> 3, c16 = (tid & 7) * 16;
            const bf16_t* pr = P + (size_t)(t0 + t) * P1LD + h * 128 + c16;
            const u32x4 qa = *(const u32x4*)pr, qb = *(const u32x4*)(pr + 8), la = *(const u32x4*)(pr + 1024), lb2 = *(const u32x4*)(pr + 1024 + 8);
            const unsigned qv[8] = {qa.x, qa.y, qa.z, qa.w, qb.x, qb.y, qb.z, qb.w}, lv[8] = {la.x, la.y, la.z, la.w, lb2.x, lb2.y, lb2.z, lb2.w};
#pragma unroll
            for (int j = 0; j < 8; ++j) {
                qs[t * 128 + c16 + 2 * j] = bf2f((unsigned short)(qv[j] & 0xffffu)); qs[t * 128 + c16 + 2 * j + 1] = bf2f((unsigned short)(qv[j] >> 16));
                const float l0 = h2f_bits((unsigned short)(lv[j] & 0xffffu)), l1 = h2f_bits((unsigned short)(lv[j] >> 16));
                fs[t * 128 + c16 + 2 * j] = __expf(l0); fs[t * 128 + c16 + 2 * j + 1] = __expf(l1); kf[t * 128 + c16 + 2 * j] = -expm1f(l0); kf[t * 128 + c16 + 2 * j + 1] = -expm1f(l1);
            }
            const int c4 = (tid & 7) * 4;
            const u32x2 iv = *(const u32x2*)(P + (size_t)(t0 + t) * P1LD + 2048 + h * 128 + qd * 32 + c4);
            is[t * 32 + c4] = bf2f((unsigned short)(iv.x & 0xffffu)); is[t * 32 + c4 + 1] = bf2f((unsigned short)(iv.x >> 16)); is[t * 32 + c4 + 2] = bf2f((unsigned short)(iv.y & 0xffffu)); is[t * 32 + c4 + 3] = bf2f((unsigned short)(iv.y >> 16));
        }
        __syncthreads();
        {
            const int o8 = part * 8;
            for (int t = 0; t < 64; ++t) {
                const f32x4 f0 = *(const LAS f32x4*)(fs + t * 128 + o8), f1 = *(const LAS f32x4*)(fs + t * 128 + o8 + 4);
                const f32x4 k0 = *(const LAS f32x4*)(kf + t * 128 + o8), k1 = *(const LAS f32x4*)(kf + t * 128 + o8 + 4);
                const f32x4 q0 = *(const LAS f32x4*)(qs + t * 128 + o8), q1 = *(const LAS f32x4*)(qs + t * 128 + o8 + 4);
                const float iv = is[t * 32 + e];
                s[0] = f0.x * s[0] + k0.x * iv; s[1] = f0.y * s[1] + k0.y * iv; s[2] = f0.z * s[2] + k0.z * iv; s[3] = f0.w * s[3] + k0.w * iv;
                s[4] = f1.x * s[4] + k1.x * iv; s[5] = f1.y * s[5] + k1.y * iv; s[6] = f1.z * s[6] + k1.z * iv; s[7] = f1.w * s[7] + k1.w * iv;
                const float o = red16(((s[0] * q0.x + s[1] * q0.y) + (s[2] * q0.z + s[3] * q0.w)) + ((s[4] * q1.x + s[5] * q1.y) + (s[6] * q1.z + s[7] * q1.w)));
                if (part == 0) is[t * 32 + e] = o;
            }
        }
        __syncthreads();
        {
            const int t = tid >> 3, c4 = (tid & 7) * 4;
            const f32x4 o = *(const LAS f32x4*)(is + t * 32 + c4);
            u32x2 wv; wv.x = pk2(o.x, o.y); wv.y = pk2(o.z, o.w);
            *(u32x2*)(P + (size_t)(t0 + t) * P1LD + 2048 + h * 128 + qd * 32 + c4) = wv;
        }
        __syncthreads();
    }
}
__device__ __forceinline__ void fin_hgrn(const Frame& F) {
    const int lane = lane_id_v();
    bf16_t* P = (bf16_t*)(F.ws + WS_BIG + BIG_PROJ); const float* onorm = F.in[IN_C_ONORM];
    const float on0 = onorm[lane], on1 = onorm[lane + 64];
    const int gw = F.wg * NWAVES + F.wave, NGW = F.G * NWAVES;
    for (int it = gw; it < NT * 8; it += NGW) {
        const int t = it >> 3, h = it & 7;
        bf16_t* row = P + (size_t)t * P1LD;
        const float o0 = bf2f(row[2048 + h * 128 + lane]), o1 = bf2f(row[2048 + h * 128 + lane + 64]);
        const float g0 = bf2f(row[3072 + h * 128 + lane]), g1 = bf2f(row[3072 + h * 128 + lane + 64]);
        const float ss = wave_sum(o0 * o0 + o1 * o1), rs = 1.0f / sqrtf(ss * (1.0f / 128.0f) + 1e-6f);
        row[3072 + h * 128 + lane] = (bf16_t)f2bf(o0 * rs * on0 * siluf_(g0)); row[3072 + h * 128 + lane + 64] = (bf16_t)f2bf(o1 * rs * on1 * siluf_(g1));
    }
}

#define MFMA32(a, b, c) __builtin_amdgcn_mfma_f32_16x16x32_bf16(a, b, c, 0, 0, 0)
#define MFMA16(a, b, c) __builtin_amdgcn_mfma_f32_16x16x16bf16_1k(a, b, c, 0, 0, 0)
__device__ __forceinline__ f32x4 mm_tile(const LAS bf16_t* A, int lda, const LAS bf16_t* B, int ldb, int nks, f32x4 acc, int fr, int fq) {
    for (int ksx = 0; ksx < nks; ++ksx) acc = MFMA32(*(const LAS bf16x8*)(A + fr * lda + ksx * 32 + fq * 8), *(const LAS bf16x8*)(B + fr * ldb + ksx * 32 + fq * 8), acc);
    return acc;
}
__device__ __forceinline__ void lds_w4(LAS bf16_t* p, f32x4 v) { u32x2 w; w.x = pk2(v.x, v.y); w.y = pk2(v.z, v.w); *(LAS u32x2*)p = w; }

struct HoBuf { __amdgpu_buffer_rsrc_t r; };
__device__ __forceinline__ HoBuf ho_buf(float* base, unsigned bytes) {
    const unsigned long long a = (unsigned long long)base;
    const unsigned lo = __builtin_amdgcn_readfirstlane((unsigned)a), hi = __builtin_amdgcn_readfirstlane((unsigned)(a >> 32));
    HoBuf h; h.r = __builtin_amdgcn_make_buffer_rsrc((void*)(((unsigned long long)hi << 32) | lo), 0, bytes, 0x00020000); return h;
}
__device__ __forceinline__ void ho_store(const HoBuf& hb, unsigned byteoff, f32x4 v) {
    __builtin_amdgcn_raw_buffer_store_b128(__builtin_bit_cast(u32x4, v), hb.r, byteoff, 0, 16);
}
__device__ __forceinline__ f32x4 ho_load(const HoBuf& hb, unsigned byteoff) {
    return __builtin_bit_cast(f32x4, __builtin_amdgcn_raw_buffer_load_b128(hb.r, byteoff, 0, 16));
}
__device__ __forceinline__ void ho_wait(unsigned* flag, unsigned need, unsigned* tmo, int wave, int lane) {
    if (wave == 0 && lane == 0) { unsigned sp = 0;
        while (__hip_atomic_load(flag, __ATOMIC_RELAXED, __HIP_MEMORY_SCOPE_AGENT) < need) { __builtin_amdgcn_s_sleep(2); if (++sp > (1u << 24)) { __hip_atomic_store(tmo, 1u, __ATOMIC_RELAXED, __HIP_MEMORY_SCOPE_AGENT); break; } } }
    __syncthreads();
}

__device__ __forceinline__ void scan_delta3(const Frame& F, int b, int h, int jpart, int kparts) {
    const int lane0 = lane_id_v(); const int w = F.wave;
    LAS bf16_t* Qb = (LAS bf16_t*)F.lds;
    LAS bf16_t* Kb = Qb + 64 * 136;
    LAS float* Of = (LAS float*)F.lds;
    LAS bf16_t* Kdt = Kb + 64 * 136;
    LAS bf16_t* Vt = Kdt + 128 * 72;
    LAS bf16_t* St = Vt + 128 * 72;
    LAS bf16_t* Aoff = St + 128 * 136;
    LAS bf16_t* QKm = Aoff + 64 * 72;
    LAS bf16_t* Vn = QKm + 64 * 72;
    LAS bf16_t* Dg = Vn + 128 * 72;
    LAS float* Adg = (LAS float*)(Dg + 4 * 16 * 24);
    LAS float* sc = Adg + 4 * 16 * 17;
    static_assert((64 * 136 * 2 * 2 + 128 * 72 * 2 * 3 + 128 * 136 * 2 + 64 * 72 * 2 * 2 + 4 * 16 * 24 * 2 + 4 * 16 * 17 * 4 + 260 * 4) <= LDS_MISC, "delta3 LDS");
    bf16_t* P = (bf16_t*)(F.ws + WS_BIG + BIG_PROJ);
    const HoBuf hb = ho_buf((float*)(F.ws + WS_HOA) + (size_t)(b * 4 + h) * 16384, 65536);
    unsigned* flag = (unsigned*)(F.ws + WS_FLAGS) + 64 + (b * 4 + h); unsigned* tmo = (unsigned*)(F.ws + WS_FLAGS) + 255;
    const float* convw = F.in[IN_AB_CONV];
    const float* db = (const float*)(F.ws + WS_DB);
    const float a_neg = -__expf(F.in[IN_AB_ALOG][h]), dtb = F.in[IN_AB_DTB][h];
    const float* onorm = F.in[IN_AB_ONORM];
    float cw[3][4][2];
#pragma unroll
    for (int sct = 0; sct < 3; ++sct)
#pragma unroll
        for (int j = 0; j < 4; ++j) { cw[sct][j][0] = convw[j * 1536 + sct * 512 + h * 128 + 2 * lane0]; cw[sct][j][1] = convw[j * 1536 + sct * 512 + h * 128 + 2 * lane0 + 1]; }
    for (int i = w * 64 + lane0; i < (128 * 136 + 64 * 72 * 2 + 128 * 72) / 2; i += NTHREADS) ((LAS unsigned*)St)[i] = 0u;
    unsigned pacc = 0u, plast = 0u;
    f32x4 sacc[8];
#pragma unroll
    for (int i = 0; i < 8; ++i) sacc[i] = (f32x4){0.f, 0.f, 0.f, 0.f};
    __syncthreads();
    unsigned rawu[3][11]; float dbv0, dbv1;
#define DELTA_FETCH(cc, ln) do { const int cc_ = (cc) < 32 ? (cc) : 31; \
        dbv0 = db[(size_t)(b * TS + cc_ * 64 + (ln)) * 8 + h]; dbv1 = db[(size_t)(b * TS + cc_ * 64 + (ln)) * 8 + 4 + h]; \
        _Pragma("unroll") for (int rr = 0; rr < 11; ++rr) { const int tl = cc_ * 64 + 8 * w - 3 + rr; \
            const unsigned* row = (const unsigned*)(P + (size_t)(b * TS + (tl >= 0 ? tl : 0)) * P0LD + h * 128) + (ln); \
            _Pragma("unroll") for (int sct = 0; sct < 3; ++sct) rawu[sct][rr] = row[sct * 256]; } } while (0)
    DELTA_FETCH(jpart, lane0);
    for (int c = jpart; c < 32; c += kparts) {
        int lane = lane0; asm volatile("" : "+v"(lane));
        const int fr = lane & 15, fq = lane >> 4;
        const int t0 = b * TS + c * 64;
        if (PROBE_STAGE >= 0) plast = (unsigned)__builtin_amdgcn_s_memrealtime();
        unsigned gq[8];
#pragma unroll
        for (int i = 0; i < 8; ++i) gq[i] = *((const unsigned*)(P + (size_t)(t0 + w + 8 * i) * P0LD + 1536 + h * 128) + lane);
        {
            const float la = a_neg * softplusf_(dbv0 + dtb);
            const float bet = sigmoidf_(dbv1);
            float g = la;
#pragma unroll
            for (int o = 1; o < 64; o <<= 1) { const float n = __shfl_up(g, o); if (lane >= o) g += n; }
            const float gL = rdlane(g, 63);
            if (w == 0) { sc[lane] = g; sc[64 + lane] = __expf(g); sc[128 + lane] = bet * __expf(g); sc[192 + lane] = bet; if (lane == 0) sc[256] = __expf(gL); }
            float raw[3][11][2];
#pragma unroll
            for (int rr = 0; rr < 11; ++rr) { const bool ok = (c * 64 + 8 * w - 3 + rr) >= 0;
#pragma unroll
                for (int sct = 0; sct < 3; ++sct) { raw[sct][rr][0] = ok ? bf2f((unsigned short)(rawu[sct][rr] & 0xffffu)) : 0.f; raw[sct][rr][1] = ok ? bf2f((unsigned short)(rawu[sct][rr] >> 16)) : 0.f; } }
            DELTA_FETCH(c + kparts, lane);
            float kd0[8], kd1[8], vt0[8], vt1[8];
#pragma unroll
            for (int i = 0; i < 8; ++i) {
                const int t = 8 * w + i;
                float x[3][2];
#pragma unroll
                for (int sct = 0; sct < 3; ++sct) { float a0 = 0.f, a1 = 0.f;
#pragma unroll
                    for (int j = 0; j < 4; ++j) { a0 += cw[sct][j][0] * raw[sct][i + j][0]; a1 += cw[sct][j][1] * raw[sct][i + j][1]; }
                    x[sct][0] = siluf_(a0); x[sct][1] = siluf_(a1); }
                const float sq = wsum(x[0][0] * x[0][0] + x[0][1] * x[0][1]), sk = wsum(x[1][0] * x[1][0] + x[1][1] * x[1][1]);
                const float cq = (1.0f / sqrtf(sq + 1e-6f)) * 0.08838834764831845f, ck = 1.0f / sqrtf(sk + 1e-6f);
                const float egr = __expf(gL - rdlane(g, t));
                *(LAS unsigned*)(Qb + t * 136 + 2 * lane) = pk2(x[0][0] * cq, x[0][1] * cq);
                const float k0 = x[1][0] * ck, k1 = x[1][1] * ck;
                *(LAS unsigned*)(Kb + t * 136 + 2 * lane) = pk2(k0, k1);
                kd0[i] = k0 * egr; kd1[i] = k1 * egr; vt0[i] = x[2][0]; vt1[i] = x[2][1];
            }
            *(LAS u32x4*)(Kdt + (2 * lane) * 72 + 8 * w) = (u32x4){pk2(kd0[0], kd0[1]), pk2(kd0[2], kd0[3]), pk2(kd0[4], kd0[5]), pk2(kd0[6], kd0[7])};
            *(LAS u32x4*)(Kdt + (2 * lane + 1) * 72 + 8 * w) = (u32x4){pk2(kd1[0], kd1[1]), pk2(kd1[2], kd1[3]), pk2(kd1[4], kd1[5]), pk2(kd1[6], kd1[7])};
            *(LAS u32x4*)(Vt + (2 * lane) * 72 + 8 * w) = (u32x4){pk2(vt0[0], vt0[1]), pk2(vt0[2], vt0[3]), pk2(vt0[4], vt0[5]), pk2(vt0[6], vt0[7])};
            *(LAS u32x4*)(Vt + (2 * lane + 1) * 72 + 8 * w) = (u32x4){pk2(vt1[0], vt1[1]), pk2(vt1[2], vt1[3]), pk2(vt1[4], vt1[5]), pk2(vt1[6], vt1[7])};
        }
        __syncthreads();
        if (PROBE_STAGE >= 0) { const unsigned tn = (unsigned)__builtin_amdgcn_s_memrealtime(); if (PROBE_STAGE == 0) pacc += tn - plast; plast = tn; }
        {
            for (int id = w; id < 20; id += NWAVES) {
                const int which = id / 10, tix = id % 10;
                const int bi = (tix < 1) ? 0 : (tix < 3 ? 1 : (tix < 6 ? 2 : 3)); const int bj = tix - (bi * (bi + 1)) / 2;
                f32x4 acc = {0.f, 0.f, 0.f, 0.f};
                acc = mm_tile(Kb + bj * 16 * 136, 136, (which ? Qb : Kb) + bi * 16 * 136, 136, 4, acc, fr, fq);
                const int i = 16 * bi + fr; const float gi = sc[i], bi_ = sc[192 + i];
                const float av[4] = {acc.x, acc.y, acc.z, acc.w}; float ov[4];
#pragma unroll
                for (int rg = 0; rg < 4; ++rg) { const int j = 16 * bj + 4 * fq + rg; const float dec = __expf(gi - sc[j]);
                    ov[rg] = which ? ((j <= i) ? av[rg] * dec : 0.f) : ((j < i) ? bi_ * av[rg] * dec : 0.f); }
                if (which) lds_w4(QKm + i * 72 + 16 * bj + 4 * fq, (f32x4){ov[0], ov[1], ov[2], ov[3]});
                else if (bi == bj) { LAS float* d = Adg + (bi * 16 + fr) * 17 + 4 * fq; d[0] = ov[0]; d[1] = ov[1]; d[2] = ov[2]; d[3] = ov[3]; }
                else lds_w4(Aoff + i * 72 + 16 * bj + 4 * fq, (f32x4){-ov[0], -ov[1], -ov[2], -ov[3]});
            }
        }
        __syncthreads();
        if (PROBE_STAGE >= 0) { const unsigned tn = (unsigned)__builtin_amdgcn_s_memrealtime(); if (PROBE_STAGE == 1) pacc += tn - plast; plast = tn; }
        f32x4 y[4], qs[4];
        if (w < 4 && lane < 16) { float x[16]; const LAS float* a = Adg + w * 16 * 17;
#pragma unroll
            for (int i = 0; i < 16; ++i) { float v = (i == lane) ? 1.f : 0.f;
#pragma unroll
                for (int k = 0; k < i; ++k) v -= a[i * 17 + k] * x[k];
                x[i] = v; Dg[(w * 16 + i) * 24 + lane] = (bf16_t)f2bf(v); } }
        if (c > 0) ho_wait(flag, (unsigned)c, tmo, w, lane); else __syncthreads();
#pragma unroll
        for (int dk = 0; dk < 8; dk += 2) {
            const u32x4 ldv = __builtin_bit_cast(u32x4, ho_load(hb, (unsigned)(((w * 64 + lane) * 4 + (dk >> 1)) * 16)));
            const f32x4 z0 = {bf2f((unsigned short)(ldv.x & 0xffffu)), bf2f((unsigned short)(ldv.x >> 16)), bf2f((unsigned short)(ldv.y & 0xffffu)), bf2f((unsigned short)(ldv.y >> 16))};
            const f32x4 z1 = {bf2f((unsigned short)(ldv.z & 0xffffu)), bf2f((unsigned short)(ldv.z >> 16)), bf2f((unsigned short)(ldv.w & 0xffffu)), bf2f((unsigned short)(ldv.w >> 16))};
            sacc[dk] = (c > 0) ? z0 : (f32x4){0.f, 0.f, 0.f, 0.f}; sacc[dk + 1] = (c > 0) ? z1 : (f32x4){0.f, 0.f, 0.f, 0.f}; }
#pragma unroll
        for (int dk = 0; dk < 8; ++dk) {
            lds_w4(St + (16 * w + fr) * 136 + 16 * dk + 4 * fq, sacc[dk]); }
        asm volatile("s_waitcnt lgkmcnt(0)" ::: "memory");
        {
            const LAS bf16_t* Sw = St + (16 * w) * 136;
#pragma unroll
            for (int mi = 0; mi < 4; ++mi) {
                f32x4 x = mm_tile(Kb + mi * 16 * 136, 136, Sw, 136, 4, (f32x4){0.f, 0.f, 0.f, 0.f}, fr, fq);
                qs[mi] = mm_tile(Qb + mi * 16 * 136, 136, Sw, 136, 4, (f32x4){0.f, 0.f, 0.f, 0.f}, fr, fq);
                const bf16x4 vv = *(const LAS bf16x4*)(Vt + (16 * w + fr) * 72 + 16 * mi + 4 * fq);
                const f32x4 be4 = *(const LAS f32x4*)(sc + 192 + 16 * mi + 4 * fq), bg4 = *(const LAS f32x4*)(sc + 128 + 16 * mi + 4 * fq);
                y[mi].x = be4.x * bf2f((unsigned short)vv.x) - bg4.x * x.x; y[mi].y = be4.y * bf2f((unsigned short)vv.y) - bg4.y * x.y;
                y[mi].z = be4.z * bf2f((unsigned short)vv.z) - bg4.z * x.z; y[mi].w = be4.w * bf2f((unsigned short)vv.w) - bg4.w * x.w;
            }
        }
        __syncthreads();
        if (PROBE_STAGE >= 0) { const unsigned tn = (unsigned)__builtin_amdgcn_s_memrealtime(); if (PROBE_STAGE == 2) pacc += tn - plast; plast = tn; }
        {
            LAS bf16_t* Vw = Vn + (16 * w) * 72;
#pragma unroll
            for (int bb = 0; bb < 4; ++bb) {
                f32x4 acc = y[bb];
                if (bb >= 1) acc = mm_tile(Aoff + bb * 16 * 72, 72, Vw, 72, (bb + 1) / 2, acc, fr, fq);
                u32x2 pk; pk.x = pk2(acc.x, acc.y); pk.y = pk2(acc.z, acc.w);
                const bf16x4 dgf = *(const LAS bf16x4*)(Dg + (bb * 16 + fr) * 24 + 4 * fq);
                const f32x4 vb = MFMA16(dgf, __builtin_bit_cast(bf16x4, pk), ((f32x4){0.f, 0.f, 0.f, 0.f}));
                lds_w4(Vw + fr * 72 + 16 * bb + 4 * fq, vb);
                asm volatile("s_waitcnt lgkmcnt(0)" ::: "memory");
            }
            const float gl = sc[256];
#pragma unroll
            for (int mi = 0; mi < 4; ++mi) {
                const f32x4 eg4 = *(const LAS f32x4*)(sc + 64 + 16 * mi + 4 * fq);
                f32x4 o = qs[mi] * eg4;
                o = mm_tile(QKm + mi * 16 * 72, 72, Vw, 72, 2, o, fr, fq);
                qs[mi] = o;
            }
#pragma unroll
            for (int dk = 0; dk < 8; ++dk) {
                f32x4 sn = sacc[dk] * gl;
                sn = mm_tile(Kdt + dk * 16 * 72, 72, Vw, 72, 2, sn, fr, fq);
                sacc[dk] = sn;
                lds_w4(St + (16 * w + fr) * 136 + 16 * dk + 4 * fq, sn);
            }
        }
        if (c < 31) {
#pragma unroll
            for (int dk = 0; dk < 8; dk += 2) { u32x4 pv; pv.x = pk2(sacc[dk].x, sacc[dk].y); pv.y = pk2(sacc[dk].z, sacc[dk].w); pv.z = pk2(sacc[dk + 1].x, sacc[dk + 1].y); pv.w = pk2(sacc[dk + 1].z, sacc[dk + 1].w);
                ho_store(hb, (unsigned)(((w * 64 + lane) * 4 + (dk >> 1)) * 16), __builtin_bit_cast(f32x4, pv)); }
            asm volatile("s_waitcnt vmcnt(0)" ::: "memory");
        }
        __syncthreads();
        if (c < 31 && w == 0 && lane == 0) __hip_atomic_store(flag, (unsigned)(c + 1), __ATOMIC_RELAXED, __HIP_MEMORY_SCOPE_AGENT);
        if (PROBE_STAGE >= 0) { const unsigned tn = (unsigned)__builtin_amdgcn_s_memrealtime(); if (PROBE_STAGE == 3) pacc += tn - plast; plast = tn; }
#pragma unroll
        for (int mi = 0; mi < 4; ++mi) { LAS float* op = Of + (16 * mi + 4 * fq) * 132 + 16 * w + fr; op[0] = qs[mi].x; op[132] = qs[mi].y; op[264] = qs[mi].z; op[396] = qs[mi].w; }
        __syncthreads();
        if (PROBE_STAGE >= 0) { const unsigned tn = (unsigned)__builtin_amdgcn_s_memrealtime(); if (PROBE_STAGE == 4) pacc += tn - plast; plast = tn; }
        const float on0 = onorm[2 * lane], on1 = onorm[2 * lane + 1];
#pragma unroll
        for (int i = 0; i < 8; ++i) {
            const int t = w + 8 * i;
            const f32x2 ov = *(const LAS f32x2*)(Of + t * 132 + 2 * lane); const float o0 = ov.x, o1 = ov.y;
            const float ss = wsum(o0 * o0 + o1 * o1), rs = 1.0f / sqrtf(ss * (1.0f / 128.0f) + 1e-6f);
            const float g0 = bf2f((unsigned short)(gq[i] & 0xffffu)), g1 = bf2f((unsigned short)(gq[i] >> 16));
            *((unsigned*)(P + (size_t)(t0 + t) * P0LD + 1536 + h * 128) + lane) = pk2(o0 * rs * on0 * siluf_(g0), o1 * rs * on1 * siluf_(g1));
        }
        __syncthreads();
        if (PROBE_STAGE >= 0) { const unsigned tn = (unsigned)__builtin_amdgcn_s_memrealtime(); if (PROBE_STAGE == 5) pacc += tn - plast; plast = tn; }
    }
    if (PROBE_STAGE >= 0 && F.wg == 0 && w == 0 && lane0 == 0) __hip_atomic_store((unsigned*)(F.ws + WS_CTL + 20484), pacc, __ATOMIC_RELAXED, __HIP_MEMORY_SCOPE_AGENT);
}

__device__ __forceinline__ void scan_hgrn3(const Frame& F, int b, int h, int jpart, int kparts) {
    const int lane0 = lane_id_v(); const int w = F.wave;
    LAS bf16_t* Qd = (LAS bf16_t*)F.lds;
    LAS bf16_t* Kp = Qd + 64 * 136;
    LAS bf16_t* Kpt = Kp + 64 * 136;
    LAS bf16_t* Vt = Kpt + 128 * 72;
    LAS bf16_t* Sc = Vt + 128 * 72;
    LAS bf16_t* Zt = Sc + 64 * 72;
    LAS float* Of = (LAS float*)(Zt + 128 * 136);
    LAS float* gl = Of + 64 * 132;
    LAS float* seg = gl + 128;
    static_assert((64 * 136 * 2 * 2 + 128 * 72 * 2 * 2 + 64 * 72 * 2 + 128 * 136 * 2 + 64 * 132 * 4 + 128 * 4 + 512 * 4) <= LDS_MISC, "hgrn3 LDS");
    bf16_t* P = (bf16_t*)(F.ws + WS_BIG + BIG_PROJ);
    const HoBuf hb = ho_buf((float*)(F.ws + WS_HOC) + (size_t)(b * 8 + h) * 16384, 65536);
    unsigned* flag = (unsigned*)(F.ws + WS_FLAGS) + 96 + (b * 8 + h); unsigned* tmo = (unsigned*)(F.ws + WS_FLAGS) + 255;
    const float* onorm = F.in[IN_C_ONORM];
    for (int i = w * 64 + lane0; i < (64 * 72 + 128 * 136) / 2; i += NTHREADS) ((LAS unsigned*)Sc)[i] = 0u;
    f32x4 zacc[8];
#pragma unroll
    for (int i = 0; i < 8; ++i) zacc[i] = (f32x4){0.f, 0.f, 0.f, 0.f};
    __syncthreads();
    for (int c = jpart; c < 32; c += kparts) {
        int lane = lane0; asm volatile("" : "+v"(lane));
        const int tid = w * 64 + lane, fr = lane & 15, fq = lane >> 4, d = tid & 127, sg = tid >> 7;
        const int t0 = b * TS + c * 64;
        {
            float G[16], q[16], v[16], lf[16];
            const bf16_t* pr = P + (size_t)(t0 + 16 * sg) * P1LD + h * 128 + d;
#pragma unroll
            for (int i = 0; i < 16; ++i) { q[i] = bf2f(pr[(size_t)i * P1LD]); lf[i] = h2f_bits(pr[(size_t)i * P1LD + 1024]); v[i] = bf2f(pr[(size_t)i * P1LD + 2048]); }
            float run = 0.f;
#pragma unroll
            for (int i = 0; i < 16; ++i) { run += lf[i]; G[i] = run; }
            seg[sg * 128 + d] = run;
            __syncthreads();
            float off = 0.f;
#pragma unroll
            for (int s2 = 0; s2 < 3; ++s2) if (s2 < sg) off += seg[s2 * 128 + d];
            float kpv[16];
#pragma unroll
            for (int i = 0; i < 16; ++i) {
                const int t = 16 * sg + i; const float Gt = off + G[i];
                const float qd = q[i] * __expf(Gt); kpv[i] = -expm1f(lf[i]) * __expf(fminf(-Gt, 80.f));
                Qd[t * 136 + d] = (bf16_t)f2bf(qd); Kp[t * 136 + d] = (bf16_t)f2bf(kpv[i]);
            }
            *(LAS u32x4*)(Kpt + d * 72 + 16 * sg) = (u32x4){pk2(kpv[0], kpv[1]), pk2(kpv[2], kpv[3]), pk2(kpv[4], kpv[5]), pk2(kpv[6], kpv[7])};
            *(LAS u32x4*)(Kpt + d * 72 + 16 * sg + 8) = (u32x4){pk2(kpv[8], kpv[9]), pk2(kpv[10], kpv[11]), pk2(kpv[12], kpv[13]), pk2(kpv[14], kpv[15])};
            *(LAS u32x4*)(Vt + d * 72 + 16 * sg) = (u32x4){pk2(v[0], v[1]), pk2(v[2], v[3]), pk2(v[4], v[5]), pk2(v[6], v[7])};
            *(LAS u32x4*)(Vt + d * 72 + 16 * sg + 8) = (u32x4){pk2(v[8], v[9]), pk2(v[10], v[11]), pk2(v[12], v[13]), pk2(v[14], v[15])};
            if (sg == 3) gl[d] = __expf(off + G[15]);
        }
        __syncthreads();
        for (int id = w; id < 10; id += NWAVES) {
            const int bi = (id < 1) ? 0 : (id < 3 ? 1 : (id < 6 ? 2 : 3)); const int bj = id - (bi * (bi + 1)) / 2;
            const f32x4 acc = mm_tile(Kp + bj * 16 * 136, 136, Qd + bi * 16 * 136, 136, 4, (f32x4){0.f, 0.f, 0.f, 0.f}, fr, fq);
            const int i = 16 * bi + fr, j0 = 16 * bj + 4 * fq;
            lds_w4(Sc + i * 72 + j0, (f32x4){(j0 <= i) ? acc.x : 0.f, (j0 + 1 <= i) ? acc.y : 0.f, (j0 + 2 <= i) ? acc.z : 0.f, (j0 + 3 <= i) ? acc.w : 0.f});
        }
        __syncthreads();
        if (c > 0) ho_wait(flag, (unsigned)c, tmo, w, lane);
#pragma unroll
        for (int dk = 0; dk < 8; dk += 2) {
            const u32x4 ldv = __builtin_bit_cast(u32x4, ho_load(hb, (unsigned)(((w * 64 + lane) * 4 + (dk >> 1)) * 16)));
            const f32x4 z0 = {bf2f((unsigned short)(ldv.x & 0xffffu)), bf2f((unsigned short)(ldv.x >> 16)), bf2f((unsigned short)(ldv.y & 0xffffu)), bf2f((unsigned short)(ldv.y >> 16))};
            const f32x4 z1 = {bf2f((unsigned short)(ldv.z & 0xffffu)), bf2f((unsigned short)(ldv.z >> 16)), bf2f((unsigned short)(ldv.w & 0xffffu)), bf2f((unsigned short)(ldv.w >> 16))};
            zacc[dk] = (c > 0) ? z0 : (f32x4){0.f, 0.f, 0.f, 0.f}; zacc[dk + 1] = (c > 0) ? z1 : (f32x4){0.f, 0.f, 0.f, 0.f}; }
#pragma unroll
        for (int dk = 0; dk < 8; ++dk) {
            lds_w4(Zt + (16 * w + fr) * 136 + 16 * dk + 4 * fq, zacc[dk]); }
        asm volatile("s_waitcnt lgkmcnt(0)" ::: "memory");
        {
            const LAS bf16_t* Vw = Vt + (16 * w) * 72; const LAS bf16_t* Zw = Zt + (16 * w) * 136;
#pragma unroll
            for (int mi = 0; mi < 4; ++mi) {
                f32x4 o = mm_tile(Sc + mi * 16 * 72, 72, Vw, 72, 2, (f32x4){0.f, 0.f, 0.f, 0.f}, fr, fq);
                o = mm_tile(Qd + mi * 16 * 136, 136, Zw, 136, 4, o, fr, fq);
                LAS float* op = Of + (16 * mi + 4 * fq) * 132 + 16 * w + fr; op[0] = o.x; op[132] = o.y; op[264] = o.z; op[396] = o.w;
            }
            asm volatile("s_waitcnt lgkmcnt(0)" ::: "memory");
#pragma unroll
            for (int dk = 0; dk < 8; ++dk) {
                f32x4 zn = mm_tile(Kpt + dk * 16 * 72, 72, Vw, 72, 2, zacc[dk], fr, fq);
                const f32x4 g4 = *(const LAS f32x4*)(gl + 16 * dk + 4 * fq);
                zn = zn * g4; zacc[dk] = zn;
                lds_w4(Zt + (16 * w + fr) * 136 + 16 * dk + 4 * fq, zn);
            }
        }
        if (c < 31) {
#pragma unroll
            for (int dk = 0; dk < 8; dk += 2) { u32x4 pv; pv.x = pk2(zacc[dk].x, zacc[dk].y); pv.y = pk2(zacc[dk].z, zacc[dk].w); pv.z = pk2(zacc[dk + 1].x, zacc[dk + 1].y); pv.w = pk2(zacc[dk + 1].z, zacc[dk + 1].w);
                ho_store(hb, (unsigned)(((w * 64 + lane) * 4 + (dk >> 1)) * 16), __builtin_bit_cast(f32x4, pv)); }
            asm volatile("s_waitcnt vmcnt(0)" ::: "memory");
        }
        __syncthreads();
        if (c < 31 && w == 0 && lane == 0) __hip_atomic_store(flag, (unsigned)(c + 1), __ATOMIC_RELAXED, __HIP_MEMORY_SCOPE_AGENT);
        for (int t = w; t < 64; t += NWAVES) {
            const float o0 = Of[t * 132 + lane], o1 = Of[t * 132 + lane + 64];
            const float ss = wsum(o0 * o0 + o1 * o1), rs = 1.0f / sqrtf(ss * (1.0f / 128.0f) + 1e-6f);
            bf16_t* gp = P + (size_t)(t0 + t) * P1LD + 3072 + h * 128;
            const float g0 = bf2f(gp[lane]), g1 = bf2f(gp[lane + 64]);
            gp[lane] = (bf16_t)f2bf(o0 * rs * onorm[lane] * siluf_(g0)); gp[lane + 64] = (bf16_t)f2bf(o1 * rs * onorm[lane + 64] * siluf_(g1));
        }
    }
}

__device__ __forceinline__ float tanh_fast(float x) { const float e = __expf(2.f * x); return 1.f - 2.f / (1.f + e); }
struct RwkvLd { u32x4 cu, pv; };
__device__ __forceinline__ RwkvLd rwkv_ld8(const bf16_t* Pc, int t, int gc, const bf16_t* hal) {
    const bf16_t* src = Pc + (size_t)t * P0LD + gc; const bf16_t* psrc = (t > 0) ? src - P0LD : hal + (gc - 2048);
    RwkvLd r; r.cu = *(const u32x4*)src; r.pv = *(const u32x4*)psrc; return r;
}
__device__ __forceinline__ void rwkv_sh8(const RwkvLd& ld, int t, int gc, bool first_zero, const float* mu, float (&sh)[8]) {
    const f32x4 m0 = *(const f32x4*)(mu + gc - 2048), m1 = *(const f32x4*)(mu + gc - 2048 + 4);
    const unsigned cw_[4] = {ld.cu.x, ld.cu.y, ld.cu.z, ld.cu.w}, pw_[4] = {ld.pv.x, ld.pv.y, ld.pv.z, ld.pv.w};
    const float mv[8] = {m0.x, m0.y, m0.z, m0.w, m1.x, m1.y, m1.z, m1.w};
    float cur[8];
#pragma unroll
    for (int e = 0; e < 8; ++e) {
        cur[e] = bf2f((unsigned short)((e & 1) ? (cw_[e >> 1] >> 16) : (cw_[e >> 1] & 0xffffu)));
        const float pg = bf2f((unsigned short)((e & 1) ? (pw_[e >> 1] >> 16) : (pw_[e >> 1] & 0xffffu)));
        const float prv = (t == 0 && first_zero) ? 0.f : pg;
        sh[e] = cur[e] + mv[e] * (prv - cur[e]);
    }
}
__device__ __forceinline__ void scan_rwkv3(const Frame& F, int b, int h, int par) {
    const int lane0 = lane_id_v(); const int w = F.wave;
    LAS unsigned char* L = F.lds;
    LAS bf16_t* RPb = (LAS bf16_t*)(L + 0);
    LAS bf16_t* KPb = (LAS bf16_t*)(L + 9216);
    LAS float* LWf = (LAS float*)(L + 18432);
    LAS float* Af = (LAS float*)(L + 34816);
    LAS float* segs = (LAS float*)(L + 51200);
    LAS bf16_t* Mak = (LAS bf16_t*)(L + 0);
    LAS bf16_t* Mrk = (LAS bf16_t*)(L + 9216);
    LAS bf16_t* Mrbn = (LAS bf16_t*)(L + 18432);
    LAS bf16_t* Aoff = (LAS bf16_t*)(L + 27648);
    LAS float* Adg = (LAS float*)(L + 36864);
    LAS bf16_t* Dg = (LAS bf16_t*)(L + 41216);
    LAS bf16_t* GB = (LAS bf16_t*)(L + 44288);
    LAS bf16_t* TL = (LAS bf16_t*)(L + 65536);
    LAS bf16_t* AL = (LAS bf16_t*)(L + 65536 + 9216);
    LAS bf16_t* SG = (LAS bf16_t*)(L + 65536 + 18432);
    LAS bf16_t* At = (LAS bf16_t*)(L + 65536);
    LAS bf16_t* Btl = (LAS bf16_t*)(L + 65536 + 9216);
    LAS bf16_t* Ktl = (LAS bf16_t*)(L + 65536 + 18432);
    LAS bf16_t* Rtl = (LAS bf16_t*)(L + 65536 + 27648);
    LAS float* Of = (LAS float*)(L + 65536);
    LAS bf16_t* BtTn = (LAS bf16_t*)(L + 102400);
    LAS bf16_t* KtT = (LAS bf16_t*)(L + 111616);
    LAS bf16_t* Vt = (LAS bf16_t*)(L + 120832);
    LAS bf16_t* Zt = (LAS bf16_t*)(L + 130048);
    LAS bf16_t* PU = (LAS bf16_t*)(L + 139264);
    LAS float* bonus = (LAS float*)(L + 148480);
    LAS float* glv = bonus + 64;
    static_assert(148480 + 4096 <= LDS_MISC, "rwkv3 LDS");
    bf16_t* P = (bf16_t*)(F.ws + WS_BIG + BIG_PROJ);
    const bf16_t* LW = (const bf16_t*)(F.ws + WS_LORA);
    const bf16_t* HALO = (const bf16_t*)(F.ws + WS_HALOB);
    const HoBuf hb = ho_buf((float*)(F.ws + WS_HOB) + (size_t)(b * 8 + h) * 4096, 16384);
    unsigned* flag = (unsigned*)(F.ws + WS_FLAGS) + (b * 8 + h); unsigned* tmo = (unsigned*)(F.ws + WS_FLAGS) + 255;
    const float* mu = F.in[IN_AB_MU];
    const float kkj = F.in[IN_AB_KK][h * 64 + lane0], kaj = F.in[IN_AB_KA][h * 64 + lane0], rkj = F.in[IN_AB_RK][h * 64 + lane0];
    const float lnw = F.in[IN_AB_LNW][h * 64 + lane0], lnb = F.in[IN_AB_LNB][h * 64 + lane0];
    float w0q[2], a0q[2];
#pragma unroll
    for (int q = 0; q < 2; ++q) { const int jq = ((2 * w + q) & 3) * 16 + (lane0 & 15); w0q[q] = F.in[IN_AB_W0][h * 64 + jq]; a0q[q] = F.in[IN_AB_A0][h * 64 + jq]; }
    bf16x8 yw[2][2], ya[2][2], yg[2][4];
#pragma unroll
    for (int q = 0; q < 2; ++q) { const int jrow = h * 64 + ((2 * w + q) & 3) * 16 + (lane0 & 15), fq0 = lane0 >> 4;
#pragma unroll
        for (int ksx = 0; ksx < 2; ++ksx) { yw[q][ksx] = *(const bf16x8*)(LW + (size_t)jrow * 64 + ksx * 32 + fq0 * 8); ya[q][ksx] = *(const bf16x8*)(LW + 512 * 64 + (size_t)jrow * 64 + ksx * 32 + fq0 * 8); }
#pragma unroll
        for (int ksx = 0; ksx < 4; ++ksx) yg[q][ksx] = *(const bf16x8*)(LW + 2 * 512 * 64 + (size_t)jrow * 128 + ksx * 32 + fq0 * 8); }
    f32x4 zacc[4];
#pragma unroll
    for (int i = 0; i < 4; ++i) zacc[i] = (f32x4){0.f, 0.f, 0.f, 0.f};
    for (int i = w * 64 + lane0; i < (64 * 72 * 2) / 2; i += NTHREADS) ((LAS unsigned*)Zt)[i] = 0u;
    __syncthreads();
    for (int c = par; c < 32; c += 2) {
        int lane = lane0; asm volatile("" : "+v"(lane));
        const int tid = w * 64 + lane, fr = lane & 15, fq = lane >> 4;
        const int t0 = b * TS + c * 64;
        {
            const bf16_t* Pc = P + (size_t)t0 * P0LD; const bf16_t* hal = HALO + (size_t)(b * 32 + (c > 0 ? c - 1 : 0)) * 1792; const bool fz = (c == 0);
            const int t_a0 = tid >> 4, cg_a0 = tid & 15, t_a1 = (tid + NTHREADS) >> 4, cg_a1 = (tid + NTHREADS) & 15, t_b = tid >> 3, cg_b = tid & 7;
            const int gc0 = ((cg_a0 < 8) ? 2048 : 2560) + h * 64 + (cg_a0 & 7) * 8, gc1 = ((cg_a1 < 8) ? 2048 : 2560) + h * 64 + (cg_a1 & 7) * 8;
            const int gc2 = 3584 + cg_b * 8, gc3 = 3648 + cg_b * 8, gc4 = 3712 + cg_a0 * 8, gc5 = 3712 + cg_a1 * 8;
            const RwkvLd l0 = rwkv_ld8(Pc, t_a0, gc0, hal), l1 = rwkv_ld8(Pc, t_a1, gc1, hal), l2 = rwkv_ld8(Pc, t_b, gc2, hal), l3 = rwkv_ld8(Pc, t_b, gc3, hal), l4 = rwkv_ld8(Pc, t_a0, gc4, hal), l5 = rwkv_ld8(Pc, t_a1, gc5, hal);
            const int vcol = tid & 63, vtg = tid >> 6;
            const bf16_t* vsrc = Pc + (size_t)(8 * vtg) * P0LD + 3072 + h * 64 + vcol;
            unsigned short vr[9];
#pragma unroll
            for (int i = 0; i < 8; ++i) vr[i + 1] = vsrc[(size_t)i * P0LD];
            vr[0] = *((vtg > 0) ? vsrc - P0LD : hal + 1024 + h * 64 + vcol);
            float sh[8];
            { rwkv_sh8(l0, t_a0, gc0, fz, mu, sh);
              *(LAS u32x4*)((cg_a0 < 8 ? RPb : KPb) + t_a0 * 72 + (cg_a0 & 7) * 8) = (u32x4){pk2(sh[0], sh[1]), pk2(sh[2], sh[3]), pk2(sh[4], sh[5]), pk2(sh[6], sh[7])}; }
            { rwkv_sh8(l1, t_a1, gc1, fz, mu, sh);
              *(LAS u32x4*)((cg_a1 < 8 ? RPb : KPb) + t_a1 * 72 + (cg_a1 & 7) * 8) = (u32x4){pk2(sh[0], sh[1]), pk2(sh[2], sh[3]), pk2(sh[4], sh[5]), pk2(sh[6], sh[7])}; }
            { rwkv_sh8(l2, t_b, gc2, fz, mu, sh);
              *(LAS u32x4*)(TL + t_b * 72 + cg_b * 8) = (u32x4){pk2(tanh_fast(sh[0]), tanh_fast(sh[1])), pk2(tanh_fast(sh[2]), tanh_fast(sh[3])), pk2(tanh_fast(sh[4]), tanh_fast(sh[5])), pk2(tanh_fast(sh[6]), tanh_fast(sh[7]))}; }
            { rwkv_sh8(l3, t_b, gc3, fz, mu, sh);
              *(LAS u32x4*)(AL + t_b * 72 + cg_b * 8) = (u32x4){pk2(sh[0], sh[1]), pk2(sh[2], sh[3]), pk2(sh[4], sh[5]), pk2(sh[6], sh[7])}; }
            { rwkv_sh8(l4, t_a0, gc4, fz, mu, sh);
              *(LAS u32x4*)(SG + t_a0 * 136 + cg_a0 * 8) = (u32x4){pk2(sigmoidf_(sh[0]), sigmoidf_(sh[1])), pk2(sigmoidf_(sh[2]), sigmoidf_(sh[3])), pk2(sigmoidf_(sh[4]), sigmoidf_(sh[5])), pk2(sigmoidf_(sh[6]), sigmoidf_(sh[7]))}; }
            { rwkv_sh8(l5, t_a1, gc5, fz, mu, sh);
              *(LAS u32x4*)(SG + t_a1 * 136 + cg_a1 * 8) = (u32x4){pk2(sigmoidf_(sh[0]), sigmoidf_(sh[1])), pk2(sigmoidf_(sh[2]), sigmoidf_(sh[3])), pk2(sigmoidf_(sh[4]), sigmoidf_(sh[5])), pk2(sigmoidf_(sh[6]), sigmoidf_(sh[7]))}; }
            {
                float cur[9];
#pragma unroll
                for (int i = 0; i < 9; ++i) cur[i] = bf2f(vr[i]);
                if (vtg == 0 && fz) cur[0] = 0.f;
                const float mvc = mu[1024 + h * 64 + vcol];
                float shv[8];
#pragma unroll
                for (int i = 0; i < 8; ++i) shv[i] = cur[i + 1] + mvc * (cur[i] - cur[i + 1]);
                *(LAS u32x4*)(Vt + vcol * 72 + 8 * vtg) = (u32x4){pk2(shv[0], shv[1]), pk2(shv[2], shv[3]), pk2(shv[4], shv[5]), pk2(shv[6], shv[7])};
            }
        }
        __syncthreads();
        f32x4 agate[2];
        {
#pragma unroll
            for (int q = 0; q < 2; ++q) {
                const int id = 2 * w + q, mi = id >> 2, nj = id & 3;
                f32x4 aw = {0.f, 0.f, 0.f, 0.f}, aa = {0.f, 0.f, 0.f, 0.f}, ag = {0.f, 0.f, 0.f, 0.f};
#pragma unroll
                for (int ksx = 0; ksx < 2; ++ksx) {
                    const bf16x8 x1 = *(const LAS bf16x8*)(TL + (mi * 16 + fr) * 72 + ksx * 32 + fq * 8), x2 = *(const LAS bf16x8*)(AL + (mi * 16 + fr) * 72 + ksx * 32 + fq * 8);
                    aw = MFMA32(x1, yw[q][ksx], aw); aa = MFMA32(x2, ya[q][ksx], aa);
                }
#pragma unroll
                for (int ksx = 0; ksx < 4; ++ksx) {
                    const bf16x8 x3 = *(const LAS bf16x8*)(SG + (mi * 16 + fr) * 136 + ksx * 32 + fq * 8);
                    ag = MFMA32(x3, yg[q][ksx], ag);
                }
                agate[q] = ag;
                const int j = nj * 16 + fr; const float w0j = w0q[q], a0j = a0q[q];
                const float awv[4] = {aw.x, aw.y, aw.z, aw.w}, aav[4] = {aa.x, aa.y, aa.z, aa.w};
#pragma unroll
                for (int rg = 0; rg < 4; ++rg) { const int t = mi * 16 + 4 * fq + rg;
                    LWf[t * 64 + j] = -0.6065306597126334f * sigmoidf_(w0j + awv[rg]); Af[t * 64 + j] = sigmoidf_(a0j + aav[rg]); }
            }
        }
        __syncthreads();
        {
            float g[8]; float run = 0.f;
#pragma unroll
            for (int i = 0; i < 8; ++i) { run += LWf[(8 * w + i) * 64 + lane]; g[i] = run; }
            segs[w * 64 + lane] = run;
            __syncthreads();
            float off = 0.f;
#pragma unroll
            for (int s2 = 0; s2 < 7; ++s2) if (s2 < w) off += segs[s2 * 64 + lane];
#pragma unroll
            for (int i = 0; i < 8; ++i) LWf[(8 * w + i) * 64 + lane] = off + g[i];
        }
        __syncthreads();
        {
            const int j = lane;
            float btn[8], ktt[8];
#pragma unroll
            for (int i = 0; i < 8; ++i) {
                const int t = 8 * w + i;
                const float kv = bf2f(KPb[t * 72 + j]), rv = bf2f(RPb[t * 72 + j]), a = Af[t * 64 + j], G = LWf[t * 64 + j];
                const float Gp = (t > 0) ? LWf[(t - 1) * 64 + j] : 0.f;
                const float kx = kv * kkj; const float ss = wsum(kx * kx); const float kk = kx * (1.0f / sqrtf(ss + 1e-6f));
                const float km = kv * (1.f + (a - 1.f) * kaj);
                const float bs = wsum(rv * km * rkj); if (j == 0) bonus[t] = bs;
                const float eG = __expf(G), eGi = __expf(-G), eGp = __expf(Gp);
                const float bt = kk * a * eGi, kt = km * eGi;
                At[t * 72 + j] = (bf16_t)f2bf(kk * eGp); Btl[t * 72 + j] = (bf16_t)f2bf(bt); Ktl[t * 72 + j] = (bf16_t)f2bf(kt); Rtl[t * 72 + j] = (bf16_t)f2bf(rv * eG);
                btn[i] = -bt; ktt[i] = kt;
                if (t == 63) glv[j] = eG;
            }
            *(LAS u32x4*)(BtTn + j * 72 + 8 * w) = (u32x4){pk2(btn[0], btn[1]), pk2(btn[2], btn[3]), pk2(btn[4], btn[5]), pk2(btn[6], btn[7])};
            *(LAS u32x4*)(KtT + j * 72 + 8 * w) = (u32x4){pk2(ktt[0], ktt[1]), pk2(ktt[2], ktt[3]), pk2(ktt[4], ktt[5]), pk2(ktt[6], ktt[7])};
        }
        __syncthreads();
        {
            for (int job = w; job < 64; job += NWAVES) {
                const int mat = job >> 4, bi = (job >> 2) & 3, bj = job & 3;
                LAS bf16_t* dst = (mat == 0) ? Aoff : (mat == 1 ? Mak : (mat == 2 ? Mrk : Mrbn));
                const int i = 16 * bi + fr, j0 = 16 * bj + 4 * fq;
                f32x4 o = {0.f, 0.f, 0.f, 0.f};
                if (bj <= bi) {
                    const LAS bf16_t* Aj = ((mat == 0 || mat == 3) ? Btl : Ktl) + bj * 16 * 72; const LAS bf16_t* Bi = ((mat < 2) ? At : Rtl) + bi * 16 * 72;
                    const f32x4 acc = mm_tile(Aj, 72, Bi, 72, 2, (f32x4){0.f, 0.f, 0.f, 0.f}, fr, fq);
                    const bool incl = mat >= 2;
                    o.x = (incl ? (j0 <= i) : (j0 < i)) ? acc.x : 0.f; o.y = (incl ? (j0 + 1 <= i) : (j0 + 1 < i)) ? acc.y : 0.f;
                    o.z = (incl ? (j0 + 2 <= i) : (j0 + 2 < i)) ? acc.z : 0.f; o.w = (incl ? (j0 + 3 <= i) : (j0 + 3 < i)) ? acc.w : 0.f;
                    if (mat == 0 && bi == bj) { LAS float* dd = Adg + (bi * 16 + fr) * 17 + 4 * fq; dd[0] = o.x; dd[1] = o.y; dd[2] = o.z; dd[3] = o.w; o = (f32x4){0.f, 0.f, 0.f, 0.f}; }
                    if (mat == 0 || mat == 3) o = -o;
                }
                lds_w4(dst + i * 72 + j0, o);
            }
#pragma unroll
            for (int q = 0; q < 2; ++q) { const int id = 2 * w + q, mi = id >> 2, nj = id & 3; const int j = nj * 16 + fr; const float gv[4] = {agate[q].x, agate[q].y, agate[q].z, agate[q].w};
#pragma unroll
                for (int rg = 0; rg < 4; ++rg) GB[(mi * 16 + 4 * fq + rg) * 64 + j] = (bf16_t)f2bf(gv[rg]); }
        }
        __syncthreads();
        f32x4 ot[4];
        if (c > 0) ho_wait(flag, (unsigned)c, tmo, w, lane);
        if (w < 4) {
#pragma unroll
            for (int kb = 0; kb < 4; kb += 2) {
                const u32x4 ldv = __builtin_bit_cast(u32x4, ho_load(hb, (unsigned)(((w * 64 + lane) * 2 + (kb >> 1)) * 16)));
                const f32x4 z0 = {bf2f((unsigned short)(ldv.x & 0xffffu)), bf2f((unsigned short)(ldv.x >> 16)), bf2f((unsigned short)(ldv.y & 0xffffu)), bf2f((unsigned short)(ldv.y >> 16))};
                const f32x4 z1 = {bf2f((unsigned short)(ldv.z & 0xffffu)), bf2f((unsigned short)(ldv.z >> 16)), bf2f((unsigned short)(ldv.w & 0xffffu)), bf2f((unsigned short)(ldv.w >> 16))};
                zacc[kb] = (c > 0) ? z0 : (f32x4){0.f, 0.f, 0.f, 0.f}; zacc[kb + 1] = (c > 0) ? z1 : (f32x4){0.f, 0.f, 0.f, 0.f}; }
#pragma unroll
            for (int kb = 0; kb < 4; ++kb) lds_w4(Zt + (16 * w + fr) * 72 + 16 * kb + 4 * fq, zacc[kb]);
            asm volatile("s_waitcnt lgkmcnt(0)" ::: "memory");
        }
        if (w < 4) {
            {
                const int bb = lane >> 4, jj = lane & 15; float x[16]; const LAS float* a = Adg + bb * 16 * 17;
#pragma unroll
                for (int i = 0; i < 16; ++i) { float v = (i == jj) ? 1.f : 0.f;
#pragma unroll
                    for (int k = 0; k < i; ++k) v -= a[i * 17 + k] * x[k];
                    x[i] = v; Dg[(bb * 16 + i) * 24 + jj] = (bf16_t)f2bf(v); }
                asm volatile("s_waitcnt lgkmcnt(0)" ::: "memory");
            }
            const LAS bf16_t* Vw = Vt + (16 * w) * 72; const LAS bf16_t* Zw = Zt + (16 * w) * 72; LAS bf16_t* PUw = PU + (16 * w) * 72;
            f32x4 p[4];
#pragma unroll
            for (int mi = 0; mi < 4; ++mi) { p[mi] = mm_tile(At + mi * 16 * 72, 72, Zw, 72, 2, (f32x4){0.f, 0.f, 0.f, 0.f}, fr, fq); p[mi] = mm_tile(Mak + mi * 16 * 72, 72, Vw, 72, 2, p[mi], fr, fq); }
#pragma unroll
            for (int bb = 0; bb < 4; ++bb) {
                f32x4 acc = p[bb];
                if (bb >= 1) acc = mm_tile(Aoff + bb * 16 * 72, 72, PUw, 72, (bb + 1) / 2, acc, fr, fq);
                u32x2 pk; pk.x = pk2(acc.x, acc.y); pk.y = pk2(acc.z, acc.w);
                const bf16x4 dgf = *(const LAS bf16x4*)(Dg + (bb * 16 + fr) * 24 + 4 * fq);
                const f32x4 ub = MFMA16(dgf, __builtin_bit_cast(bf16x4, pk), ((f32x4){0.f, 0.f, 0.f, 0.f}));
                lds_w4(PUw + fr * 72 + 16 * bb + 4 * fq, ub);
                asm volatile("s_waitcnt lgkmcnt(0)" ::: "memory");
            }
#pragma unroll
            for (int mi = 0; mi < 4; ++mi) {
                f32x4 o = mm_tile(Rtl + mi * 16 * 72, 72, Zw, 72, 2, (f32x4){0.f, 0.f, 0.f, 0.f}, fr, fq);
                o = mm_tile(Mrk + mi * 16 * 72, 72, Vw, 72, 2, o, fr, fq);
                ot[mi] = mm_tile(Mrbn + mi * 16 * 72, 72, PUw, 72, 2, o, fr, fq);
            }
#pragma unroll
            for (int kb = 0; kb < 4; ++kb) {
                f32x4 zn = mm_tile(KtT + kb * 16 * 72, 72, Vw, 72, 2, zacc[kb], fr, fq);
                zn = mm_tile(BtTn + kb * 16 * 72, 72, PUw, 72, 2, zn, fr, fq);
                const f32x4 g4 = *(const LAS f32x4*)(glv + 16 * kb + 4 * fq);
                zn = zn * g4; zacc[kb] = zn;
                lds_w4(Zt + (16 * w + fr) * 72 + 16 * kb + 4 * fq, zn);
            }
        }
        if (w < 4 && c < 31) {
#pragma unroll
            for (int kb = 0; kb < 4; kb += 2) { u32x4 pv; pv.x = pk2(zacc[kb].x, zacc[kb].y); pv.y = pk2(zacc[kb].z, zacc[kb].w); pv.z = pk2(zacc[kb + 1].x, zacc[kb + 1].y); pv.w = pk2(zacc[kb + 1].z, zacc[kb + 1].w);
                ho_store(hb, (unsigned)(((w * 64 + lane) * 2 + (kb >> 1)) * 16), __builtin_bit_cast(f32x4, pv)); }
            asm volatile("s_waitcnt vmcnt(0)" ::: "memory");
        }
        __syncthreads();
        if (c < 31 && w == 0 && lane == 0) __hip_atomic_store(flag, (unsigned)(c + 1), __ATOMIC_RELAXED, __HIP_MEMORY_SCOPE_AGENT);
        if (w < 4) {
#pragma unroll
            for (int mi = 0; mi < 4; ++mi) { LAS float* op = Of + (16 * mi + 4 * fq) * 65 + 16 * w + fr; op[0] = ot[mi].x; op[65] = ot[mi].y; op[130] = ot[mi].z; op[195] = ot[mi].w; }
        }
        __syncthreads();
        for (int t = w; t < 64; t += NWAVES) {
            const float o = Of[t * 65 + lane];
            const float mean = wsum(o) * (1.0f / 64.0f); const float dlt = o - mean; const float var = wsum(dlt * dlt) * (1.0f / 64.0f);
            float y = dlt * (1.0f / sqrtf(var + 64e-5f)) * lnw + lnb;
            y += bonus[t] * bf2f(Vt[lane * 72 + t]);
            y *= bf2f(GB[t * 64 + lane]);
            P[(size_t)(t0 + t) * P0LD + 2048 + h * 64 + lane] = (bf16_t)f2bf(y);
        }
        __syncthreads();
    }
}

__device__ __forceinline__ void attn_phase(const Frame& F, const bf16_t* Q, const bf16_t* Kb, const bf16_t* VT, bf16_t* O) {
    const int lane = lane_id_v(); const int tid = F.wave * 64 + lane; (void)tid;
    const int fr = lane & 15, fq = lane >> 4;
    for (int u = F.wg; u < 512; u += F.G) {
        const int b = u >> 6, h = (u >> 4) & 3, qb = u & 15;
        const int q0 = b * TS + qb * 128 + F.wave * 16;
        bf16x8 bq[8];
#pragma unroll
        for (int ksx = 0; ksx < 8; ++ksx) bq[ksx] = *(const bf16x8*)(Q + (size_t)(q0 + fr) * 1024 + h * 256 + ksx * 32 + fq * 8);
        f32x4 sacc[16];
#pragma unroll
        for (int tl = 0; tl < 16; ++tl) {
            f32x4 a4 = {0.f, 0.f, 0.f, 0.f};
            const bf16_t* kp = Kb + (size_t)(b * 256 + tl * 16 + fr) * 1024 + h * 256 + fq * 8;
#pragma unroll
            for (int ksx = 0; ksx < 8; ++ksx) { const bf16x8 a = *(const bf16x8*)(kp + ksx * 32); a4 = __builtin_amdgcn_mfma_f32_16x16x32_bf16(a, bq[ksx], a4, 0, 0, 0); }
            sacc[tl] = a4;
        }
        float mx = -3.0e38f;
#pragma unroll
        for (int tl = 0; tl < 16; ++tl) mx = fmaxf(mx, fmaxf(fmaxf(sacc[tl].x, sacc[tl].y), fmaxf(sacc[tl].z, sacc[tl].w)));
        mx = fmaxf(mx, __shfl_xor(mx, 16)); mx = fmaxf(mx, __shfl_xor(mx, 32));
        float l = 0.f;
        bf16x8 pb[8];
#pragma unroll
        for (int ksx = 0; ksx < 8; ++ksx) {
            const f32x4 e0 = sacc[2 * ksx], e1 = sacc[2 * ksx + 1];
            const float p0 = __expf(e0.x - mx), p1 = __expf(e0.y - mx), p2 = __expf(e0.z - mx), p3 = __expf(e0.w - mx);
            const float p4 = __expf(e1.x - mx), p5 = __expf(e1.y - mx), p6 = __expf(e1.z - mx), p7 = __expf(e1.w - mx);
            l += ((p0 + p1) + (p2 + p3)) + ((p4 + p5) + (p6 + p7));
            u32x4 w; w.x = pk2(p0, p1); w.y = pk2(p2, p3); w.z = pk2(p4, p5); w.w = pk2(p6, p7);
            pb[ksx] = __builtin_bit_cast(bf16x8, w);
        }
        l += __shfl_xor(l, 16); l += __shfl_xor(l, 32);
        const float inv = 1.0f / l;
        const bf16_t* vbase = VT + (size_t)((b * 4 + h) * 256) * 256;
#pragma unroll 4
        for (int dt = 0; dt < 16; ++dt) {
            f32x4 o4 = {0.f, 0.f, 0.f, 0.f};
            const bf16_t* vp = vbase + (size_t)(dt * 16 + fr) * 256 + 4 * fq;
#pragma unroll
            for (int ksx = 0; ksx < 8; ++ksx) {
                const u32x2 lo = *(const u32x2*)(vp + ksx * 32), hi = *(const u32x2*)(vp + ksx * 32 + 16);
                u32x4 w; w.x = lo.x; w.y = lo.y; w.z = hi.x; w.w = hi.y;
                o4 = __builtin_amdgcn_mfma_f32_16x16x32_bf16(__builtin_bit_cast(bf16x8, w), pb[ksx], o4, 0, 0, 0);
            }
            u32x2 w; w.x = pk2(o4.x * inv, o4.y * inv); w.y = pk2(o4.z * inv, o4.w * inv);
            *(u32x2*)(O + (size_t)(q0 + fr) * 1024 + h * 256 + dt * 16 + 4 * fq) = w;
        }
    }
}

__device__ __forceinline__ void attn_phase2(const Frame& F, const bf16_t* Q, const bf16_t* Kb, const bf16_t* VT, bf16_t* O) {
    const int lane = lane_id_v(); const int tid = F.wave * 64 + lane; const int fr = lane & 15, fq = lane >> 4;
    LAS bf16_t* KL = (LAS bf16_t*)F.lds;
    static_assert(256 * 264 * 2 <= LDS_MISC, "attn LDS");
    for (int u = F.wg; u < 512; u += F.G) {
        const int b = u >> 6, h = (u >> 4) & 3, qb = u & 15;
        const int q0 = b * TS + qb * 128 + F.wave * 16;
        u32x4 st[16];
#pragma unroll
        for (int n = 0; n < 16; ++n) { const int idx = tid + NTHREADS * n, row = idx >> 5, c8 = idx & 31;
            st[n] = *(const u32x4*)(Kb + (size_t)(b * 256 + row) * 1024 + h * 256 + c8 * 8); }
        bf16x8 bq[8];
#pragma unroll
        for (int ksx = 0; ksx < 8; ++ksx) bq[ksx] = *(const bf16x8*)(Q + (size_t)(q0 + fr) * 1024 + h * 256 + ksx * 32 + fq * 8);
        __syncthreads();
#pragma unroll
        for (int n = 0; n < 16; ++n) { const int idx = tid + NTHREADS * n, row = idx >> 5, c8 = idx & 31; *(LAS u32x4*)(KL + row * 264 + c8 * 8) = st[n]; }
        const bf16_t* vbase = VT + (size_t)((b * 4 + h) * 256) * 256;
#pragma unroll
        for (int n = 0; n < 16; ++n) { const int idx = tid + NTHREADS * n, row = idx >> 5, c8 = idx & 31; st[n] = *(const u32x4*)(vbase + (size_t)row * 256 + c8 * 8); }
        __syncthreads();
        f32x4 sacc[16];
#pragma unroll
        for (int tl = 0; tl < 16; ++tl) {
            f32x4 a4 = {0.f, 0.f, 0.f, 0.f};
#pragma unroll
            for (int ksx = 0; ksx < 8; ++ksx) a4 = __builtin_amdgcn_mfma_f32_16x16x32_bf16(*(const LAS bf16x8*)(KL + (tl * 16 + fr) * 264 + ksx * 32 + fq * 8), bq[ksx], a4, 0, 0, 0);
            sacc[tl] = a4;
        }
        float mx = -3.0e38f;
#pragma unroll
        for (int tl = 0; tl < 16; ++tl) mx = fmaxf(mx, fmaxf(fmaxf(sacc[tl].x, sacc[tl].y), fmaxf(sacc[tl].z, sacc[tl].w)));
        mx = fmaxf(mx, __shfl_xor(mx, 16)); mx = fmaxf(mx, __shfl_xor(mx, 32));
        float l = 0.f;
        bf16x8 pb[8];
#pragma unroll
        for (int ksx = 0; ksx < 8; ++ksx) {
            const f32x4 e0 = sacc[2 * ksx], e1 = sacc[2 * ksx + 1];
            const float p0 = __expf(e0.x - mx), p1 = __expf(e0.y - mx), p2 = __expf(e0.z - mx), p3 = __expf(e0.w - mx);
            const float p4 = __expf(e1.x - mx), p5 = __expf(e1.y - mx), p6 = __expf(e1.z - mx), p7 = __expf(e1.w - mx);
            l += ((p0 + p1) + (p2 + p3)) + ((p4 + p5) + (p6 + p7));
            u32x4 w; w.x = pk2(p0, p1); w.y = pk2(p2, p3); w.z = pk2(p4, p5); w.w = pk2(p6, p7);
            pb[ksx] = __builtin_bit_cast(bf16x8, w);
        }
        l += __shfl_xor(l, 16); l += __shfl_xor(l, 32);
        const float inv = 1.0f / l;
        __syncthreads();
#pragma unroll
        for (int n = 0; n < 16; ++n) { const int idx = tid + NTHREADS * n, row = idx >> 5, c8 = idx & 31; *(LAS u32x4*)(KL + row * 264 + c8 * 8) = st[n]; }
        __syncthreads();
#pragma unroll 4
        for (int dt = 0; dt < 16; ++dt) {
            f32x4 o4 = {0.f, 0.f, 0.f, 0.f};
            const LAS bf16_t* vp = KL + (dt * 16 + fr) * 264 + 4 * fq;
#pragma unroll
            for (int ksx = 0; ksx < 8; ++ksx) {
                const u32x2 lo = *(const LAS u32x2*)(vp + ksx * 32), hi = *(const LAS u32x2*)(vp + ksx * 32 + 16);
                u32x4 w; w.x = lo.x; w.y = lo.y; w.z = hi.x; w.w = hi.y;
                o4 = __builtin_amdgcn_mfma_f32_16x16x32_bf16(__builtin_bit_cast(bf16x8, w), pb[ksx], o4, 0, 0, 0);
            }
            u32x2 w; w.x = pk2(o4.x * inv, o4.y * inv); w.y = pk2(o4.z * inv, o4.w * inv);
            *(u32x2*)(O + (size_t)(q0 + fr) * 1024 + h * 256 + dt * 16 + 4 * fq) = w;
        }
    }
    __syncthreads();
}

__device__ __forceinline__ void router_phase(const Frame& F, int layer) {
    const int lane = lane_id_v(); const int tid = F.wave * 64 + lane; (void)tid;
    const float* XF = F.out; const float* gain = F.in[IN_NORM_FFN] + layer * 1024;
    const float* wg = F.in[IN_MOE_WG] + (size_t)layer * 1024 * 4; const float* we = F.in[IN_MOE_WE] + (size_t)layer * 1024 * 16;
    const float* bg = F.in[IN_MOE_BG] + layer * 4; const float* be = F.in[IN_MOE_BE] + layer * 16;
    unsigned* cnt = (unsigned*)(F.ws + WS_CNT) + layer * 32;
    int* tokb = (int*)(F.ws + WS_ROUTE); int* tokp = tokb + NT; f32x4* tokg = (f32x4*)(tokp + NT);
    const int gw = F.wg * NWAVES + F.wave, NGW = F.G * NWAVES;
    for (int row = gw; row < NT; row += NGW) {
        const f32x4* xr = (const f32x4*)(XF + (size_t)row * 1024) + lane;
        float s = 0.f, lg[4], le[16];
#pragma unroll
        for (int c = 0; c < 4; ++c) lg[c] = 0.f;
#pragma unroll
        for (int c = 0; c < 16; ++c) le[c] = 0.f;
#pragma unroll 1
        for (int j = 0; j < 4; ++j) {
            const f32x4 v = xr[64 * j]; s += (v.x * v.x + v.y * v.y) + (v.z * v.z + v.w * v.w);
            const int k0 = 4 * lane + 256 * j; const f32x4 g = *(const f32x4*)(gain + k0);
            const float xv[4] = {v.x * g.x, v.y * g.y, v.z * g.z, v.w * g.w};
#pragma unroll
            for (int q = 0; q < 4; ++q) {
                const f32x4 a = *(const f32x4*)(wg + (size_t)(k0 + q) * 4);
                lg[0] += xv[q] * a.x; lg[1] += xv[q] * a.y; lg[2] += xv[q] * a.z; lg[3] += xv[q] * a.w;
#pragma unroll
                for (int e4 = 0; e4 < 4; ++e4) { const f32x4 w = *(const f32x4*)(we + (size_t)(k0 + q) * 16 + 4 * e4);
                    le[4 * e4] += xv[q] * w.x; le[4 * e4 + 1] += xv[q] * w.y; le[4 * e4 + 2] += xv[q] * w.z; le[4 * e4 + 3] += xv[q] * w.w; }
            }
        }
        s = wave_sum(s);
        const float rstd = 1.0f / sqrtf(s * (1.0f / 1024.0f) + 1e-6f);
#pragma unroll
        for (int c = 0; c < 4; ++c) lg[c] = wave_sum(lg[c]) * rstd + bg[c];
#pragma unroll
        for (int c = 0; c < 16; ++c) le[c] = wave_sum(le[c]) * rstd + be[c];
        int gs = 0; float gm = lg[0];
#pragma unroll
        for (int c = 1; c < 4; ++c) if (lg[c] > gm) { gm = lg[c]; gs = c; }
        float gz = 0.f;
#pragma unroll
        for (int c = 0; c < 4; ++c) gz += __expf(lg[c] - gm);
        const float ggate = 1.0f / gz;
        float l4[4];
#pragma unroll
        for (int c = 0; c < 4; ++c) { float v = le[c];
#pragma unroll
            for (int g2 = 1; g2 < 4; ++g2) v = (gs == g2) ? le[4 * g2 + c] : v;
            l4[c] = v; }
        int i0 = 0; float m0 = l4[0];
#pragma unroll
        for (int c = 1; c < 4; ++c) if (l4[c] > m0) { m0 = l4[c]; i0 = c; }
        int i1 = -1; float m1 = -3.0e38f;
#pragma unroll
        for (int c = 0; c < 4; ++c) if (c != i0 && l4[c] > m1) { m1 = l4[c]; i1 = c; }
        const float e1 = __expf(m1 - m0); const float g0 = ggate / (1.f + e1), g1 = ggate * e1 / (1.f + e1);
        const int ia = i0 < i1 ? i0 : i1, ib = i0 < i1 ? i1 : i0;
        const float ga = i0 < i1 ? g0 : g1, gb = i0 < i1 ? g1 : g0;
        const int pidx = (ia == 0) ? (ib - 1) : (ia == 1 ? ib + 1 : 5);
        const int bucket = gs * 6 + pidx;
        if (lane == 0) {
            const unsigned pos = atomicAdd(&cnt[bucket], 1u);
            tokb[row] = bucket; tokp[row] = (int)pos; tokg[row] = (f32x4){rstd, ga, gb, 0.f};
        }
    }
}
typedef float f32x16 __attribute__((ext_vector_type(16)));
__device__ __forceinline__ void router_phase2(const Frame& F, int layer) {
    const int lane = lane_id_v(); const int tid = F.wave * 64 + lane; const int w = F.wave;
    const float* XF = F.out; const float* rw = (const float*)(F.ws + WS_RW) + (size_t)layer * 1024 * 32;
    const float* ssp = (const float*)(F.ws + WS_SSP);
    unsigned* cnt = (unsigned*)(F.ws + WS_CNT) + layer * 32;
    int* tokb = (int*)(F.ws + WS_ROUTE); int* tokp = tokb + NT; f32x4* tokg = (f32x4*)(tokp + NT);
    LAS float* T = (LAS float*)F.lds + w * (32 * 132);
    LAS float* Pp = (LAS float*)F.lds;
    LAS float* Lg = Pp + 8 * 64 * 33;
    const int i31 = lane & 31, kh = lane >> 5, k0 = 128 * w;
    float bW[64];
#pragma unroll
    for (int s2 = 0; s2 < 64; ++s2) bW[s2] = rw[(size_t)(k0 + 2 * s2 + kh) * 32 + i31];
    for (int blk = F.wg; blk < NT / 64; blk += F.G) {
        const int r0 = blk * 64;
        f32x16 acc0, acc1;
#pragma unroll
        for (int e = 0; e < 16; ++e) { acc0[e] = 0.f; acc1[e] = 0.f; }
#pragma unroll
        for (int rt = 0; rt < 2; ++rt) {
#pragma unroll
            for (int n = 0; n < 16; ++n) { const int idx = lane + 64 * n, row = idx >> 5, c4 = idx & 31;
                const f32x4 v = *(const f32x4*)(XF + (size_t)(r0 + 32 * rt + row) * 1024 + k0 + 4 * c4);
                *(LAS f32x4*)(T + row * 132 + 4 * c4) = v; }
            asm volatile("s_waitcnt lgkmcnt(0)" ::: "memory");
#pragma unroll
            for (int s2 = 0; s2 < 64; ++s2) {
                const float a0 = T[i31 * 132 + 2 * s2 + kh];
                if (rt == 0) acc0 = __builtin_amdgcn_mfma_f32_32x32x2f32(a0, bW[s2], acc0, 0, 0, 0);
                else acc1 = __builtin_amdgcn_mfma_f32_32x32x2f32(a0, bW[s2], acc1, 0, 0, 0);
            }
            asm volatile("s_waitcnt lgkmcnt(0)" ::: "memory");
        }
        __syncthreads();
#pragma unroll
        for (int e = 0; e < 16; ++e) { const int row = (e & 3) + 8 * (e >> 2) + 4 * kh;
            Pp[(w * 64 + row) * 33 + i31] = acc0[e]; Pp[(w * 64 + 32 + row) * 33 + i31] = acc1[e]; }
        __syncthreads();
        for (int idx = tid; idx < 64 * 32; idx += NTHREADS) { const int row = idx >> 5, cc = idx & 31; float a = 0.f;
#pragma unroll
            for (int ww = 0; ww < 8; ++ww) a += Pp[(ww * 64 + row) * 33 + cc];
            Lg[row * 33 + cc] = a; }
        __syncthreads();
        if (tid < 64) {
            const int row = r0 + tid; const float rstd = row_rstd(ssp, row);
            const float* bg = F.in[IN_MOE_BG] + layer * 4; const float* be = F.in[IN_MOE_BE] + layer * 16;
            float lg[4], le[16];
#pragma unroll
            for (int c2 = 0; c2 < 4; ++c2) lg[c2] = Lg[tid * 33 + c2] * rstd + bg[c2];
#pragma unroll
            for (int c2 = 0; c2 < 16; ++c2) le[c2] = Lg[tid * 33 + 4 + c2] * rstd + be[c2];
            int gs = 0; float gm = lg[0];
#pragma unroll
            for (int c2 = 1; c2 < 4; ++c2) if (lg[c2] > gm) { gm = lg[c2]; gs = c2; }
            float gz = 0.f;
#pragma unroll
            for (int c2 = 0; c2 < 4; ++c2) gz += __expf(lg[c2] - gm);
            const float ggate = 1.0f / gz;
            float l4[4];
#pragma unroll
            for (int c2 = 0; c2 < 4; ++c2) { float v = le[c2];
#pragma unroll
                for (int g2 = 1; g2 < 4; ++g2) v = (gs == g2) ? le[4 * g2 + c2] : v;
                l4[c2] = v; }
            int i0 = 0; float m0 = l4[0];
#pragma unroll
            for (int c2 = 1; c2 < 4; ++c2) if (l4[c2] > m0) { m0 = l4[c2]; i0 = c2; }
            int i1 = -1; float m1 = -3.0e38f;
#pragma unroll
            for (int c2 = 0; c2 < 4; ++c2) if (c2 != i0 && l4[c2] > m1) { m1 = l4[c2]; i1 = c2; }
            const float e1 = __expf(m1 - m0); const float g0 = ggate / (1.f + e1), g1 = ggate * e1 / (1.f + e1);
            const int ia = i0 < i1 ? i0 : i1, ib = i0 < i1 ? i1 : i0;
            const float ga = i0 < i1 ? g0 : g1, gb = i0 < i1 ? g1 : g0;
            const int pidx = (ia == 0) ? (ib - 1) : (ia == 1 ? ib + 1 : 5);
            const int bucket = gs * 6 + pidx;
            const unsigned pos = atomicAdd(&cnt[bucket], 1u);
            tokb[row] = bucket; tokp[row] = (int)pos; tokg[row] = (f32x4){rstd, ga, gb, 0.f};
        }
        __syncthreads();
    }
}
__device__ __forceinline__ void gather_phase(const Frame& F, int layer) {
    const int lane = lane_id_v(); const int tid = F.wave * 64 + lane; (void)tid;
    const unsigned* cnt = (const unsigned*)(F.ws + WS_CNT) + layer * 32;
    const int* tokb = (const int*)(F.ws + WS_ROUTE); const int* tokp = tokb + NT; const f32x4* tokg = (const f32x4*)(tokp + NT); f32x4* rowinfo = (f32x4*)(tokg + NT);
    const bf16_t* XB = (const bf16_t*)(F.ws + WS_XB); bf16_t* XG = (bf16_t*)(F.ws + WS_BIG + BIG_XG);
    LAS int* off = (LAS int*)F.lds;
    if (tid == 0) { int acc = 0; for (int b = 0; b < 24; ++b) { off[b] = acc * 256; acc += ((int)cnt[b] + 255) >> 8; } }
    __syncthreads();
    const int gw = F.wg * NWAVES + F.wave, NGW = F.G * NWAVES;
    for (int tok = gw; tok < NT; tok += NGW) {
        const int row = off[tokb[tok]] + tokp[tok];
        const u32x4* src = (const u32x4*)(XB + (size_t)tok * 1024) + lane; u32x4* dst = (u32x4*)(XG + (size_t)row * 1024) + lane;
        dst[0] = src[0]; dst[64] = src[64];
        if (lane == 0) { f32x4 g = tokg[tok]; g.w = __int_as_float(tok); rowinfo[row] = g; }
    }
    __syncthreads();
}
__device__ __forceinline__ void final_phase(const Frame& F) {
    const int lane = lane_id_v(); const int tid = F.wave * 64 + lane; (void)tid;
    float* XF = F.out; const float* gain = F.in[IN_NORM_FINAL];
    const int gw = F.wg * NWAVES + F.wave, NGW = F.G * NWAVES;
    for (int row = gw; row < NT; row += NGW) {
        f32x4* xr = (f32x4*)(XF + (size_t)row * 1024) + lane;
        f32x4 v[4]; float s = 0.f;
#pragma unroll
        for (int j = 0; j < 4; ++j) { v[j] = xr[64 * j]; s += (v[j].x * v[j].x + v[j].y * v[j].y) + (v[j].z * v[j].z + v[j].w * v[j].w); }
        s = wsum(s);
        const float rstd = 1.0f / sqrtf(s * (1.0f / 1024.0f) + 1e-6f);
#pragma unroll
        for (int j = 0; j < 4; ++j) { const f32x4 g = *(const f32x4*)(gain + 4 * lane + 256 * j); xr[64 * j] = v[j] * rstd * g; }
    }
}

constexpr int N_PHASES = 24;
#ifndef PH_MASK
#define PH_MASK 0xFFFFFFFFu
#endif
#define IN(k) (((PH_MASK >> ((k) > 11 ? (k) - 11 : (k))) & 1u) && lo <= (k) && (k) < hi)
#define TS_STAMP(k) do { if (TS_A >= 0 && ((k) == TS_A || (k) == TS_B) && F.wg == 0 && F.wave == 0 && lane_id_v() == 0) ((volatile LAS unsigned*)(F.lds + LDS_MISC + 1024))[(k)] = (unsigned)__builtin_amdgcn_s_memrealtime(); } while (0)
#define SEAM(k) do { if (IN(k) && IN((k) + 1)) xcd_barrier(bar); TS_STAMP((k) + 1); } while (0)
#define SEAM2(k) do { if (IN(k) && IN((k) + 2)) xcd_barrier(bar); TS_STAMP((k) + 2); } while (0)

template <int LAYER>
__device__ __forceinline__ void layer_phases(const Frame& F, const XcdBarrier& bar, const int lo, const int hi) {
    constexpr int pb = LAYER * 11;
    unsigned char* const ws = F.ws;
#define WPTR(off) ((bf16_t*)(ws + (LAYER ? WS_W1 : WS_W0)) + (off))
#define XB_ ((bf16_t*)(ws + WS_XB))
#define SSP_ ((float*)(ws + WS_SSP))
#define PROJ_ ((bf16_t*)(ws + WS_BIG + BIG_PROJ))
#define KB_ (LAYER ? (bf16_t*)(ws + WS_W0) : (bf16_t*)(ws + WS_BIG + BIG_KV0))
#define VT_ (KB_ + (size_t)2048 * 1024)
#define QB_ ((bf16_t*)(ws + WS_BIG + BIG_Q))
#define ATT_ ((bf16_t*)(ws + WS_BIG + BIG_ATT))
#define XG_ ((bf16_t*)(ws + WS_BIG + BIG_XG))
#define HID_ ((bf16_t*)(ws + WS_BIG + BIG_HID))
#define CNT_ ((const unsigned*)(ws + WS_CNT) + LAYER * 32)
#define ROWINFO_ ((const f32x4*)(ws + WS_ROUTE + (size_t)NT * 8 + (size_t)NT * 16))
    if (IN(pb + 1)) {
        if (LAYER == 0) {
            pg8::Gemm g{1024, 1024, 1024, 1 << 20}; pg8::DenseSched S; S.init(NT, 3840, F.G, F.wg, XB_, 1024, WPTR(WO_WIN), 1024);
            EpiScale<0> E{PROJ_, P0LD, SSP_, 1.0f, nullptr, (bf16_t*)(ws + WS_HALOB)};
            pg8::gemm_phase(F.lds, F.wave, g, S, E);
            { pg8::Gemm g2{1024, 1024, 1024, 1 << 20}; pg8::DenseSched S2; S2.init(2048, 2048, F.G, F.wg, (const bf16_t*)(ws + WS_MEMH), 1024, WPTR(WO_WKV), 1024);
              EpiKV E2{KB_, VT_}; pg8::gemm_phase(F.lds, F.wave, g2, S2, E2); }
        } else {
            pg8::Gemm g{1024, 1024, 1024, 1 << 20}; pg8::DenseSched S; S.init(NT, 4096, F.G, F.wg, XB_, 1024, WPTR(WO_WIN), 1024);
            EpiScale<1> E{PROJ_, P1LD, SSP_, 1.0f, (const float*)(ws + WS_LB), nullptr};
            pg8::gemm_phase(F.lds, F.wave, g, S, E);
        }
    }
    SEAM(pb + 1);
    if (IN(pb + 2)) {
        unsigned pt0 = 0; if (PROBE_WG >= 0 && LAYER == 0) pt0 = (unsigned)__builtin_amdgcn_s_memrealtime();
        if (LAYER == 0) {
#ifndef NO_DELTA
            if (F.wg < 96) { const int st = F.wg & 31; scan_delta3(F, st >> 2, st & 3, F.wg >> 5, 3); }
#endif
#ifndef NO_RWKV
            if (F.wg >= 96 && F.wg < 224) { const int q = F.wg - 96, st = ((q >> 4) << 3) | (q & 7), par = (q >> 3) & 1; scan_rwkv3(F, st >> 3, st & 7, par); }
#endif
            if (F.wg >= 224) p0_late_weights<0>(F, F.wg - 224, F.G - 224);
        } else {
#ifndef NO_HGRN
            if (F.wg < 192) { const int st = F.wg & 63; scan_hgrn3(F, st >> 3, st & 7, F.wg >> 6, 3); }
#endif
            if (F.wg >= 192) p0_late_weights<1>(F, F.wg - 192, F.G - 192);
        }
        if (PROBE_WG >= 0 && LAYER == 0 && F.wg == PROBE_WG && F.wave == 0 && lane_id_v() == 0) __hip_atomic_store((unsigned*)(F.ws + WS_CTL + 20480), (unsigned)__builtin_amdgcn_s_memrealtime() - pt0, __ATOMIC_RELAXED, __HIP_MEMORY_SCOPE_AGENT);
    }
    SEAM2(pb + 2);
    if (IN(pb + 4)) {
        constexpr int lda = LAYER ? P1LD : P0LD; const bf16_t* A = PROJ_ + (LAYER ? 3072 : 1536);
        pg8::Gemm g{lda, 1024, 1024, 1 << 20}; pg8::DenseSched S; S.init(NT, 1024, F.G, F.wg, A, lda, WPTR(WO_WOUT), 1024);
        EpiResid<false> E{LAYER ? (const float*)F.out : F.in[IN_X], F.out, XB_, SSP_, nullptr};
        pg8::gemm_phase(F.lds, F.wave, g, S, E);
    }
    SEAM(pb + 4);
    if (IN(pb + 5)) {
        pg8::Gemm g{1024, 1024, 1024, 1 << 20}; pg8::DenseSched S; S.init(NT, 1024, F.G, F.wg, XB_, 1024, WPTR(WO_WQ), 1024);
        EpiScale<0> E{QB_, 1024, SSP_, 0.0625f, nullptr, nullptr};
        pg8::gemm_phase(F.lds, F.wave, g, S, E);
    }
    SEAM(pb + 5);
    if (IN(pb + 6)) attn_phase2(F, QB_, KB_, VT_, ATT_);
    SEAM(pb + 6);
    if (IN(pb + 7)) {
        pg8::Gemm g{1024, 1024, 1024, 1 << 20}; pg8::DenseSched S; S.init(NT, 1024, F.G, F.wg, ATT_, 1024, WPTR(WO_WO), 1024);
        EpiResid<false> E{F.out, F.out, XB_, SSP_, nullptr};
        pg8::gemm_phase(F.lds, F.wave, g, S, E);
    }
    SEAM(pb + 7);
    if (IN(pb + 8)) router_phase2(F, LAYER);
    SEAM(pb + 8);
    if (IN(pb + 9)) gather_phase(F, LAYER);
    SEAM(pb + 9);
    if (IN(pb + 10)) {
        if (LAYER == 0 && F.wg >= 192) {
            pg8::Gemm g2{1024, 1024, 1024, 1 << 20}; pg8::DenseSched S2; S2.init(2048, 2048, 64, F.wg - 192, (const bf16_t*)(ws + WS_MEMH), 1024, (const bf16_t*)(ws + WS_W1) + WO_WKV, 1024);
            EpiKV E2{(bf16_t*)(ws + WS_KV1), (bf16_t*)(ws + WS_KV1) + (size_t)2048 * 1024}; pg8::gemm_phase(F.lds, F.wave, g2, S2, E2); }
        LAS int* tbl = (LAS int*)(F.lds + LDS_MISC + 512); moe_build_table(tbl, CNT_, F.wave * 64 + lane_id_v());
        pg8::Gemm g{1024, 1024, 1024, 1 << 20}; MoeSched<false> S{tbl, __builtin_amdgcn_readfirstlane(tbl[95]), F.G, F.wg, (const char*)XG_, (const char*)WPTR(WO_W13)};
        EpiMoeUp E{HID_, ROWINFO_};
        pg8::gemm_phase(F.lds, F.wave, g, S, E);
    }
    SEAM(pb + 10);
    if (IN(pb + 11)) {
        LAS int* tbl = (LAS int*)(F.lds + LDS_MISC + 512); moe_build_table(tbl, CNT_, F.wave * 64 + lane_id_v());
        pg8::Gemm g{512, 256, 512, 4}; MoeSched<true> S{tbl, __builtin_amdgcn_readfirstlane(tbl[95]), F.G, F.wg, (const char*)HID_, (const char*)WPTR(WO_W2T)};
        EpiResid<true> E{F.out, F.out, XB_, SSP_, ROWINFO_};
        pg8::gemm_phase(F.lds, F.wave, g, S, E);
    }
    SEAM(pb + 11);
}

__global__ void __launch_bounds__(NTHREADS, 2) fwd_mega(Args args) {
    extern __shared__ __attribute__((aligned(16))) unsigned char lds_raw[];
    Frame F;
    F.lds = (LAS unsigned char*)lds_raw;
    const int tid = threadIdx.x; F.wave = __builtin_amdgcn_readfirstlane(tid >> 6);
    F.G = gridDim.x; F.wg = blockIdx.x;
    F.out = args.out; F.ws = args.ws;
    volatile LAS unsigned* MISC = (volatile LAS unsigned*)(F.lds + LDS_MISC);
    LAS unsigned long long* tab = (LAS unsigned long long*)(F.lds + LDS_MISC + 64);
    F.in.t = tab;
    if (tid < 16) MISC[tid] = 0u;
    if (tid == 0) {
#pragma unroll
        for (int i = 0; i < 38; ++i) tab[i] = (unsigned long long)args.in[i];
    }
    __syncthreads();
    XcdBarrier bar; bar.bar = (unsigned*)(F.ws + WS_CTL); bar.x = 0; bar.st = MISC; bar.wave = F.wave;
#if N_LAUNCH_MODE == 1
    bar = xcd_barrier_post((unsigned*)(F.ws + WS_CTL), MISC, F.wave);
#endif
    const int lo = args.ph_lo, hi = args.ph_hi;
    TS_STAMP(0);
    if (IN(0)) { p0_prologue(F); }
    SEAM(0);
    layer_phases<0>(F, bar, lo, hi);
    layer_phases<1>(F, bar, lo, hi);
    if (IN(23)) final_phase(F);
    if (TS_A >= 0 && F.wg == 0 && F.wave == 0) {
        asm volatile("s_waitcnt vmcnt(0)" ::: "memory");
        if (lane_id_v() == 0) { volatile LAS unsigned* ts = (volatile LAS unsigned*)(F.lds + LDS_MISC + 1024);
            float us = (float)(ts[TS_B] - ts[TS_A]) * 0.01f;
            if (PROBE_WG >= 0) us = (float)__hip_atomic_load((unsigned*)(F.ws + WS_CTL + 20480), __ATOMIC_RELAXED, __HIP_MEMORY_SCOPE_AGENT) * 0.01f;
            if (PROBE_STAGE >= 0) us = (float)__hip_atomic_load((unsigned*)(F.ws + WS_CTL + 20484), __ATOMIC_RELAXED, __HIP_MEMORY_SCOPE_AGENT) * 0.01f;
            F.out[0] = F.out[0] + us * TS_SCALE; }
    }
}
#undef IN
#undef SEAM

extern "C" void kernel_launch(void* const* d_in, const int* in_sizes, int n_in, void* d_out, int out_size, void* d_ws, size_t ws_size, hipStream_t stream) {
    static int grid = 0;
    if (grid == 0) {
        if (n_in != 38 || out_size != NT * DM || ws_size < WS_END) { fprintf(stderr, "kernel_launch: unexpected problem (n_in %d out %d ws %zu)\n", n_in, out_size, ws_size); grid = -1; return; }
        int dev = 0, cus = 0, per_cu = 0;
        if (hipGetDevice(&dev) != hipSuccess || hipDeviceGetAttribute(&cus, hipDeviceAttributeMultiprocessorCount, dev) != hipSuccess) { grid = -1; return; }
        if (hipFuncSetAttribute((const void*)fwd_mega, hipFuncAttributeMaxDynamicSharedMemorySize, LDS_BYTES) != hipSuccess) { fprintf(stderr, "kernel_launch: hipFuncSetAttribute failed\n"); grid = -1; return; }
        if (hipOccupancyMaxActiveBlocksPerMultiprocessor(&per_cu, (const void*)fwd_mega, NTHREADS, LDS_BYTES) != hipSuccess || per_cu < 1) { fprintf(stderr, "kernel_launch: occupancy query says %d\n", per_cu); (void)hipGetLastError(); grid = -1; return; }
        grid = cus;
    }
    if (grid < 0) return;
    (void)hipMemsetAsync((char*)d_ws + WS_CTL, 0, 32768, stream);
    Args a{};
    for (int i = 0; i < 38; ++i) a.in[i] = (const float*)d_in[i];
    a.out = (float*)d_out; a.ws = (unsigned char*)d_ws;
#if N_LAUNCH_MODE == 1
    a.ph_lo = 0; a.ph_hi = N_PHASES;
    void* kargs[] = {&a};
    hipError_t e = hipLaunchCooperativeKernel((const void*)fwd_mega, dim3(grid), dim3(NTHREADS), kargs, LDS_BYTES, stream);
    if (e != hipSuccess) fprintf(stderr, "kernel_launch: cooperative launch failed: %s\n", hipGetErrorString(e));
#else
    for (int p = 0; p < N_PHASES; ++p) { a.ph_lo = p; a.ph_hi = p + 1; hipLaunchKernelGGL(fwd_mega, dim3(grid), dim3(NTHREADS), LDS_BYTES, stream, a); }
#endif
}
```

```cpp
#include <hip/hip_runtime.h>
#include <cstdio>
#include <cstdint>

#ifndef N_LAUNCH_MODE
#define N_LAUNCH_MODE 1
#endif

#ifndef TS_A
#define TS_A -1
#endif
#ifndef TS_B
#define TS_B 0
#endif
#ifndef PROBE_WG
#define PROBE_WG -1
#endif
#ifndef PROBE_STAGE
#define PROBE_STAGE -1
#endif
#ifndef TS_SCALE
#define TS_SCALE 0.01f
#endif

#define LAS __attribute__((address_space(3)))
#define GAS __attribute__((address_space(1)))
typedef unsigned short bf16_t;
typedef short bf16x8 __attribute__((ext_vector_type(8)));
typedef short bf16x4 __attribute__((ext_vector_type(4)));
typedef float f32x4 __attribute__((ext_vector_type(4)));
typedef float f32x2 __attribute__((ext_vector_type(2)));
typedef unsigned u32x4 __attribute__((ext_vector_type(4)));
typedef unsigned u32x2 __attribute__((ext_vector_type(2)));

constexpr int NT = 16384, DM = 1024, NB = 8, TS = 2048, NMEM = 256;
constexpr int P0LD = 3840;
constexpr int P1LD = 4096;
constexpr int NTHREADS = 512, NWAVES = 8;

constexpr size_t MiB = 1048576;
constexpr size_t WS_CTL = 0;
constexpr size_t WS_CNT = 16384;
constexpr size_t WS_LB = 32768;
constexpr size_t WS_DB = 1 * MiB;
constexpr size_t WS_SSP = WS_DB + 512 * 1024;
constexpr size_t WS_MEMH = WS_SSP + 1 * MiB;
constexpr size_t WS_ROUTE = WS_MEMH + 4 * MiB;
constexpr size_t WS_LORA = WS_ROUTE + 800 * 1024;
constexpr size_t WS_RW = WS_LORA + 256 * 1024;
constexpr size_t WS_W0 = 8 * MiB;
static_assert(WS_RW + 2 * 1024 * 32 * 4 <= 8 * MiB, "small weights");
constexpr size_t WS_W1 = WS_W0 + 42 * MiB;
constexpr size_t WS_KV1 = WS_W0;
constexpr size_t WS_XB = 92 * MiB;
constexpr size_t WS_BIG = 124 * MiB;
constexpr size_t WS_END = 256 * MiB;
constexpr size_t WS_HALOB = 252 * MiB;
constexpr size_t WS_HOB = 253 * MiB;
constexpr size_t WS_HOA = 254 * MiB;
constexpr size_t WS_HOC = 252 * MiB;
constexpr size_t WS_FLAGS = 24576;
constexpr size_t WO_WIN = 0;
constexpr size_t WO_WOUT = WO_WIN + (size_t)4096 * 1024;
constexpr size_t WO_WQ = WO_WOUT + (size_t)1024 * 1024;
constexpr size_t WO_WKV = WO_WQ + (size_t)1024 * 1024;
constexpr size_t WO_WO = WO_WKV + (size_t)2048 * 1024;
constexpr size_t WO_W13 = WO_WO + (size_t)1024 * 1024;
constexpr size_t WO_W2T = WO_W13 + (size_t)16 * 512 * 1024;
constexpr size_t WO_END = WO_W2T + (size_t)16 * 1024 * 256;
static_assert(WO_END * 2 <= 42 * MiB, "weight region");
constexpr size_t BIG_PROJ = 0;
constexpr size_t BIG_KV0 = 120 * MiB;
constexpr size_t BIG_Q = 0;
constexpr size_t BIG_ATT = 32 * MiB;
constexpr size_t BIG_XG = 0;
constexpr size_t BIG_HID = 48 * MiB;
constexpr int MOE_MAXROWS = 22528;

__device__ __forceinline__ unsigned f2bf(float f) { unsigned u = __float_as_uint(f); u += 0x7fffu + ((u >> 16) & 1u); return u >> 16; }
__device__ __forceinline__ float bf2f(unsigned short b) { return __uint_as_float((unsigned)b << 16); }
__device__ __forceinline__ unsigned pk2(float lo, float hi) { return f2bf(lo) | (f2bf(hi) << 16); }
__device__ __forceinline__ float wave_sum(float v) {
#pragma unroll
    for (int o = 1; o < 64; o <<= 1) v += __shfl_xor(v, o);
    return v;
}
template <int CTRL> __device__ __forceinline__ float dppf(float v) { return __int_as_float(__builtin_amdgcn_update_dpp(0, __float_as_int(v), CTRL, 0xF, 0xF, true)); }
__device__ __forceinline__ float red8(float v) { v += dppf<0xB1>(v); v += dppf<0x4E>(v); v += dppf<0x141>(v); return v; }
__device__ __forceinline__ float red16(float v) { v = red8(v); v += dppf<0x140>(v); return v; }

__device__ __forceinline__ float rdlane(float v, int l) { return __int_as_float(__builtin_amdgcn_readlane(__float_as_int(v), l)); }
__device__ __forceinline__ float wsum(float v) { v = red16(v); return (rdlane(v, 0) + rdlane(v, 16)) + (rdlane(v, 32) + rdlane(v, 48)); }
__device__ __forceinline__ float sigmoidf_(float x) { return 1.f / (1.f + __expf(-x)); }
__device__ __forceinline__ float siluf_(float x) { return x / (1.f + __expf(-x)); }
__device__ __forceinline__ float softplusf_(float x) { return x > 20.f ? x : log1pf(__expf(x)); }
__device__ __forceinline__ int lane_id_v() { int l; asm volatile("v_mbcnt_lo_u32_b32 %0, -1, 0\n\tv_mbcnt_hi_u32_b32 %0, -1, %0" : "=v"(l)); return l; }
#define LDS_WAIT() asm volatile("s_waitcnt lgkmcnt(0)" ::: "memory")
#define VM_WAIT() asm volatile("s_waitcnt vmcnt(0)" ::: "memory")

namespace pg8 {
constexpr int BM = 256, BK = 64, HALF = 128, HTB = HALF * BK * 2, STAGE_BYTES = 8 * HTB;
__host__ __device__ __forceinline__ int lds_byte(int r, int c) { const int st = (r >> 4) * 2 + (c >> 5), rr = r & 15, cc = c & 31, ob = rr * 64 + cc * 2; return st * 1024 + (ob ^ (((ob >> 9) & 1) << 5)); }
__host__ __device__ __forceinline__ void stage_rc(int b, int& R, int& C) { const int st = b / 1024, sb = b % 1024, swz = sb ^ (((sb >> 9) & 1) << 5); R = (st >> 1) * 16 + swz / 64; C = (st & 1) * 32 + (swz % 64) / 2; }

struct Unit { int pm, pn, aux; const char* a; const char* b0; const char* b1; };
struct Gemm { int lda, ldb, K, ksplit; };

template <class Epi, class Sched>
__device__ __forceinline__ void gemm_phase(LAS unsigned char* lds, const int wave_in, const Gemm g, const Sched& S, const Epi& E) {
    const int wid = wave_in, lane = lane_id_v(), tid = wid * 64 + lane, wr = wid >> 2, wc = wid & 3, fr = lane & 15, fq = lane >> 4;
    const int K = g.K, nt = K / BK, ks = g.ksplit;
    unsigned voffA[2], voffB[2];
#pragma unroll
    for (int i = 0; i < 2; ++i) { int R, C; stage_rc(tid * 16 + i * 8192, R, C);
        voffA[i] = (unsigned)(R * g.lda + C) * 2u; voffB[i] = (unsigned)(R * g.ldb + C) * 2u; }
    const size_t kstep = (size_t)(BK * 2);
    const size_t hstepA = (size_t)HALF * g.lda * 2, hstepB = (size_t)HALF * g.ldb * 2;
    const unsigned ldsw = (unsigned)wid * 1024u;
    const int aoff = lds_byte(wr * 64 + fr, fq * 8), boff = lds_byte(wc * 32 + fr, fq * 8);
#define PG8_SA(b, h) (((b) * 2 + (h)) * HTB)
#define PG8_SB(b, h) ((4 + (b) * 2 + (h)) * HTB)
#define PG8_STAGE(bufoff, gbase, voff) do { _Pragma("unroll") for (int _i = 0; _i < 2; ++_i) \
        __builtin_amdgcn_global_load_lds((const unsigned*)((const char*)(gbase) + (voff)[_i]), (LAS unsigned*)(lds + (bufoff) + ldsw + _i * 8192), 16, 0, 0); } while (0)
#define PG8_LDA(dst, b, h) do { _Pragma("unroll") for (int m = 0; m < 4; ++m) _Pragma("unroll") for (int k = 0; k < 2; ++k) dst[m][k] = *(const LAS bf16x8*)(lds + PG8_SA(b, h) + aoff + m * 2048 + k * 1024); } while (0)
#define PG8_LDB(dst, b, h) do { _Pragma("unroll") for (int n = 0; n < 2; ++n) _Pragma("unroll") for (int k = 0; k < 2; ++k) dst[n][k] = *(const LAS bf16x8*)(lds + PG8_SB(b, h) + boff + n * 2048 + k * 1024); } while (0)
#define PG8_MMA(ai, bj, At, Bt) do { __builtin_amdgcn_s_setprio(1); _Pragma("unroll") for (int m = 0; m < 4; ++m) _Pragma("unroll") for (int n = 0; n < 2; ++n) _Pragma("unroll") for (int k = 0; k < 2; ++k) \
        acc[ai][bj][m][n] = __builtin_amdgcn_mfma_f32_16x16x32_bf16(Bt[n][k], At[m][k], acc[ai][bj][m][n], 0, 0, 0); __builtin_amdgcn_s_setprio(0); } while (0)
#define PG8_WAIT_V(n) asm volatile("s_waitcnt vmcnt(" #n ")" ::: "memory")
#define PG8_WAIT_L(n) asm volatile("s_waitcnt lgkmcnt(" #n ")" ::: "memory")
#define PG8_BAR __builtin_amdgcn_s_barrier()
#define PG8_SCHED __builtin_amdgcn_sched_barrier(0)
    Unit cur, nxt; int ui = 0;
    if (!S.next(0, cur)) return;
    f32x4 acc[2][2][4][2];
#pragma unroll
    for (int a = 0; a < 2; ++a)
#pragma unroll
        for (int b = 0; b < 2; ++b)
#pragma unroll
            for (int m = 0; m < 4; ++m)
#pragma unroll
                for (int n = 0; n < 2; ++n) acc[a][b][m][n] = (f32x4){0.f, 0.f, 0.f, 0.f};
    E.init(acc, cur, wr, wc, fr, fq);
    bf16x8 At[4][2], B0[2][2], B1[2][2];
    const char* cA = cur.a; const char* cB = cur.b0; const char* cB1 = cur.b1;
    PG8_STAGE(PG8_SB(0, 0), cB, voffB); PG8_STAGE(PG8_SB(0, 1), cB + hstepB, voffB); PG8_STAGE(PG8_SA(0, 0), cA, voffA); PG8_STAGE(PG8_SA(0, 1), cA + hstepA, voffA);
    if (wr == 1) PG8_BAR;
    PG8_WAIT_V(2); PG8_BAR;
    PG8_STAGE(PG8_SB(1, 0), cB + kstep, voffB); PG8_STAGE(PG8_SA(1, 0), cA + kstep, voffA); PG8_STAGE(PG8_SB(1, 1), cB + hstepB + kstep, voffB);
    PG8_WAIT_V(6); PG8_BAR;
    for (;;) {
        const bool has_next = S.next(ui + 1, nxt);
        const char* nA = has_next ? nxt.a : cA; const char* nB = has_next ? nxt.b0 : cB;
        for (int t = 0; t < nt; t += 2) {
            const bool last = (t == nt - 2);
            const char* a1 = cA + (size_t)(t + 1) * kstep;
            const char* a2 = last ? nA : cA + (size_t)(t + 2) * kstep;
            const char* b2 = last ? nB : ((t + 2) < ks ? cB + (size_t)(t + 2) * kstep : cB1 + (size_t)(t + 2 - ks) * kstep);
            const char* a3 = a2 + kstep; const char* b3 = b2 + kstep;
            PG8_LDB(B0, 0, 0); PG8_LDB(B1, 0, 1); PG8_SCHED; PG8_LDA(At, 0, 0); PG8_STAGE(PG8_SA(1, 1), a1 + hstepA, voffA);
            PG8_WAIT_V(8); PG8_WAIT_L(0); PG8_BAR; PG8_MMA(0, 0, At, B0); PG8_MMA(0, 1, At, B1); PG8_BAR; PG8_SCHED;
            PG8_LDA(At, 0, 1); PG8_STAGE(PG8_SB(0, 0), b2, voffB); PG8_STAGE(PG8_SB(0, 1), b2 + hstepB, voffB); PG8_STAGE(PG8_SA(0, 0), a2, voffA);
            PG8_WAIT_V(8); PG8_WAIT_L(0); PG8_BAR; PG8_MMA(1, 0, At, B0); PG8_MMA(1, 1, At, B1); PG8_BAR; PG8_SCHED;
            PG8_LDB(B0, 1, 0); PG8_LDB(B1, 1, 1); PG8_SCHED; PG8_LDA(At, 1, 0); PG8_STAGE(PG8_SA(0, 1), a2 + hstepA, voffA);
            PG8_WAIT_V(8); PG8_WAIT_L(0); PG8_BAR; PG8_MMA(0, 0, At, B0); PG8_MMA(0, 1, At, B1); PG8_BAR; PG8_SCHED;
            PG8_LDA(At, 1, 1); PG8_STAGE(PG8_SB(1, 0), b3, voffB); PG8_STAGE(PG8_SB(1, 1), b3 + hstepB, voffB); PG8_STAGE(PG8_SA(1, 0), a3, voffA);
            PG8_WAIT_V(8); PG8_WAIT_L(0); PG8_BAR; PG8_MMA(1, 0, At, B0); PG8_MMA(1, 1, At, B1); PG8_BAR; PG8_SCHED;
        }
        if (wr == 0) PG8_BAR;
        E(acc, cur, wr, wc, fr, fq);
        if (!has_next) break;
#pragma unroll
        for (int a = 0; a < 2; ++a)
#pragma unroll
            for (int b = 0; b < 2; ++b)
#pragma unroll
                for (int m = 0; m < 4; ++m)
#pragma unroll
                    for (int n = 0; n < 2; ++n) acc[a][b][m][n] = (f32x4){0.f, 0.f, 0.f, 0.f};
        cur = nxt; cA = nA; cB = nB; cB1 = nxt.b1; ++ui;
        E.init(acc, cur, wr, wc, fr, fq);
        if (wr == 1) PG8_BAR;
    }
    PG8_WAIT_V(0);
    PG8_BAR;
#undef PG8_SA
#undef PG8_SB
#undef PG8_STAGE
#undef PG8_LDA
#undef PG8_LDB
#undef PG8_MMA
#undef PG8_WAIT_V
#undef PG8_WAIT_L
#undef PG8_BAR
#undef PG8_SCHED
}

struct DenseSched {
    int nM, nN, nwg, G, c; const char* A; const char* B; size_t tA, tB;
    __device__ void init(int M, int N, int G_, int c_, const bf16_t* A_, int lda, const bf16_t* B_, int ldb) { nM = M / 256; nN = N / 256; nwg = nM * nN; G = G_; c = c_; A = (const char*)A_; B = (const char*)B_; tA = (size_t)256 * lda * 2; tB = (size_t)256 * ldb * 2; }
    __device__ bool next(int i, Unit& u) const {
        const long L = (long)i * G + c; if (L >= nwg) return false;
        int wgid = (int)L; { const int q = nwg / 8, r = nwg % 8, xcd = wgid % 8, off = wgid / 8; wgid = (xcd < r ? xcd * (q + 1) : r * (q + 1) + (xcd - r) * q) + off; }
        const int nig = 8 * nN, gid = wgid / nig, fm = gid * 8, gsz = (nM - fm) < 8 ? (nM - fm) : 8;
        u.pm = fm + ((wgid % nig) % gsz); u.pn = (wgid % nig) / gsz; u.aux = 256;
        u.a = A + (size_t)u.pm * tA; u.b0 = B + (size_t)u.pn * tB; u.b1 = u.b0; return true;
    }
};
}
using pg8::Unit;

__device__ __forceinline__ float row_rstd(const float* ssp, int row) {
    const f32x4* p = (const f32x4*)(ssp + (size_t)row * 16);
    const f32x4 a = p[0], b = p[1], c = p[2], d = p[3];
    const float s = ((a.x + a.y) + (a.z + a.w)) + ((b.x + b.y) + (b.z + b.w)) + ((c.x + c.y) + (c.z + c.w)) + ((d.x + d.y) + (d.z + d.w));
    return 1.0f / sqrtf(s * (1.0f / 1024.0f) + 1e-6f);
}
__device__ __forceinline__ unsigned short f2h_bits(float f) { _Float16 h = (_Float16)f; return __builtin_bit_cast(unsigned short, h); }
__device__ __forceinline__ float h2f_bits(unsigned short b) { return (float)__builtin_bit_cast(_Float16, b); }

template <int MODE> struct EpiScale {
    bf16_t* O; int ldc; const float* ssp; float scale; const float* lb; bf16_t* halo;
    __device__ __forceinline__ void init(f32x4 (&acc)[2][2][4][2], const Unit& u, int wr, int wc, int fr, int fq) const {}
    __device__ __forceinline__ void operator()(const f32x4 (&acc)[2][2][4][2], const Unit& u, int wr, int wc, int fr_in, int fq_in) const {
        int fr = fr_in, fq = fq_in; asm volatile("" : "+v"(fr), "+v"(fq));
#pragma unroll
        for (int ai = 0; ai < 2; ++ai)
#pragma unroll
            for (int m = 0; m < 4; ++m) {
                const int row = u.pm * 256 + ai * 128 + wr * 64 + m * 16 + fr;
                const float rs = (MODE == 2) ? scale : row_rstd(ssp, row) * scale;
#pragma unroll
                for (int bj = 0; bj < 2; ++bj)
#pragma unroll
                    for (int n = 0; n < 2; ++n) {
                        const int col = u.pn * 256 + bj * 128 + wc * 32 + n * 16 + fq * 4;
                        f32x4 v = acc[ai][bj][m][n] * rs;
                        u32x2 w;
                        if (MODE == 1) {
                            const int blk = col >> 10;
                            if (blk == 0) { v.x = siluf_(v.x); v.y = siluf_(v.y); v.z = siluf_(v.z); v.w = siluf_(v.w); }
                            if (blk == 1) {
                                const f32x4 l = *(const f32x4*)(lb + (col - 1024));
                                float o[4]; const float vv[4] = {v.x, v.y, v.z, v.w}; const float ll[4] = {l.x, l.y, l.z, l.w};
#pragma unroll
                                for (int j = 0; j < 4; ++j) o[j] = __logf(ll[j] + (1.f - ll[j]) * sigmoidf_(vv[j]));
                                w.x = (unsigned)f2h_bits(o[0]) | ((unsigned)f2h_bits(o[1]) << 16); w.y = (unsigned)f2h_bits(o[2]) | ((unsigned)f2h_bits(o[3]) << 16);
                            } else { w.x = pk2(v.x, v.y); w.y = pk2(v.z, v.w); }
                        } else { w.x = pk2(v.x, v.y); w.y = pk2(v.z, v.w); }
                        *(u32x2*)(O + (size_t)row * ldc + col) = w;
                        if (MODE == 0 && halo && col >= 2048 && (row & 63) == 63) *(u32x2*)(halo + (size_t)(row >> 6) * 1792 + (col - 2048)) = w;
                    }
            }
    }
};
struct EpiKV {
    bf16_t* Kb; bf16_t* VT;
    __device__ __forceinline__ void init(f32x4 (&acc)[2][2][4][2], const Unit& u, int wr, int wc, int fr, int fq) const {}
    __device__ __forceinline__ void operator()(const f32x4 (&acc)[2][2][4][2], const Unit& u, int wr, int wc, int fr_in, int fq_in) const {
        int fr = fr_in, fq = fq_in; asm volatile("" : "+v"(fr), "+v"(fq));
#pragma unroll
        for (int ai = 0; ai < 2; ++ai)
#pragma unroll
            for (int m = 0; m < 4; ++m) {
                const int row = u.pm * 256 + ai * 128 + wr * 64 + m * 16 + fr;
#pragma unroll
                for (int bj = 0; bj < 2; ++bj)
#pragma unroll
                    for (int n = 0; n < 2; ++n) {
                        const int col = u.pn * 256 + bj * 128 + wc * 32 + n * 16 + fq * 4;
                        const f32x4 v = acc[ai][bj][m][n];
                        if (col < 1024) { u32x2 w; w.x = pk2(v.x, v.y); w.y = pk2(v.z, v.w); *(u32x2*)(Kb + (size_t)row * 1024 + col) = w; }
                        else {
                            const int c2 = col - 1024, h = c2 >> 8, d = c2 & 255, b = row >> 8, mm = row & 255;
                            bf16_t* p = VT + ((size_t)((b * 4 + h) * 256 + d)) * 256 + mm;
                            p[0] = (bf16_t)f2bf(v.x); p[256] = (bf16_t)f2bf(v.y); p[512] = (bf16_t)f2bf(v.z); p[768] = (bf16_t)f2bf(v.w);
                        }
                    }
            }
    }
};
template <bool SCATTER> struct EpiResid {
    const float* base32; bf16_t* XB; float* ssp; const f32x4* rowinfo;
    __device__ __forceinline__ f32x4 ld_base(size_t off) const {
        if (base32) return *(const f32x4*)(base32 + off);
        const u32x2 r = *(const u32x2*)(XB + off);
        return (f32x4){bf2f((unsigned short)(r.x & 0xffffu)), bf2f((unsigned short)(r.x >> 16)), bf2f((unsigned short)(r.y & 0xffffu)), bf2f((unsigned short)(r.y >> 16))};
    }
    __device__ __forceinline__ void init(f32x4 (&acc)[2][2][4][2], const Unit& u, int wr, int wc, int fr_in, int fq_in) const {
        if (SCATTER) return;
        int fr = fr_in, fq = fq_in; asm volatile("" : "+v"(fr), "+v"(fq));
#pragma unroll
        for (int ai = 0; ai < 2; ++ai)
#pragma unroll
            for (int m = 0; m < 4; ++m) {
                const int row = u.pm * 256 + ai * 128 + wr * 64 + m * 16 + fr;
#pragma unroll
                for (int bj = 0; bj < 2; ++bj)
#pragma unroll
                    for (int n = 0; n < 2; ++n) acc[ai][bj][m][n] = ld_base((size_t)row * 1024 + u.pn * 256 + bj * 128 + wc * 32 + n * 16 + fq * 4);
                asm volatile("" ::: "memory");
            }
    }
    __device__ __forceinline__ void operator()(const f32x4 (&acc)[2][2][4][2], const Unit& u, int wr, int wc, int fr_in, int fq_in) const {
        int fr = fr_in, fq = fq_in; asm volatile("" : "+v"(fr), "+v"(fq));
#pragma unroll
        for (int ai = 0; ai < 2; ++ai)
#pragma unroll
            for (int m = 0; m < 4; ++m) {
                const int lrow = ai * 128 + wr * 64 + m * 16 + fr;
                const int row = u.pm * 256 + lrow;
                int tok = row; bool valid = true;
                if (SCATTER) { valid = lrow < u.aux; const f32x4 ri = rowinfo[row]; tok = valid ? __float_as_int(ri.w) : 0; }
                float ss = 0.f;
#pragma unroll
                for (int bj = 0; bj < 2; ++bj)
#pragma unroll
                    for (int n = 0; n < 2; ++n) {
                        const int col = u.pn * 256 + bj * 128 + wc * 32 + n * 16 + fq * 4;
                        const size_t off = (size_t)tok * 1024 + col;
                        f32x4 v = acc[ai][bj][m][n];
                        if (SCATTER) v = v + ld_base(off);
                        if (valid) { u32x2 w; w.x = pk2(v.x, v.y); w.y = pk2(v.z, v.w); *(u32x2*)(XB + off) = w; }
                        ss += (v.x * v.x + v.y * v.y) + (v.z * v.z + v.w * v.w);
                    }
                ss += __shfl_xor(ss, 16); ss += __shfl_xor(ss, 32);
                if (valid && fq == 0) ssp[(size_t)tok * 16 + u.pn * 4 + wc] = ss;
            }
    }
};
struct EpiMoeUp {
    bf16_t* HID; const f32x4* rowinfo;
    __device__ __forceinline__ void init(f32x4 (&acc)[2][2][4][2], const Unit& u, int wr, int wc, int fr, int fq) const {}
    __device__ __forceinline__ void operator()(const f32x4 (&acc)[2][2][4][2], const Unit& u, int wr, int wc, int fr_in, int fq_in) const {
        int fr = fr_in, fq = fq_in; asm volatile("" : "+v"(fr), "+v"(fq));
        const int slot = u.pn >> 1, jj = u.pn & 1;
#pragma unroll
        for (int ai = 0; ai < 2; ++ai)
#pragma unroll
            for (int m = 0; m < 4; ++m) {
                const int row = u.pm * 256 + ai * 128 + wr * 64 + m * 16 + fr;
                const f32x4 ri = rowinfo[row];
                const float rs = ri.x, gt = slot ? ri.z : ri.y;
#pragma unroll
                for (int n = 0; n < 2; ++n) {
                    const f32x4 h1 = acc[ai][0][m][n] * rs, h3 = acc[ai][1][m][n] * rs;
                    const int col = slot * 256 + jj * 128 + wc * 32 + n * 16 + fq * 4;
                    u32x2 w; w.x = pk2(siluf_(h1.x) * h3.x * gt, siluf_(h1.y) * h3.y * gt); w.y = pk2(siluf_(h1.z) * h3.z * gt, siluf_(h1.w) * h3.w * gt);
                    *(u32x2*)(HID + (size_t)row * 512 + col) = w;
                }
            }
    }
};
__device__ __forceinline__ void pair_experts(int bucket, int& ea, int& eb) {
    const int g = bucket / 6, p = bucket % 6;
    const int i = (p < 3) ? 0 : (p < 5 ? 1 : 2);
    const int j = (p < 3) ? p + 1 : (p < 5 ? p - 1 : 3);
    ea = g * 4 + i; eb = g * 4 + j;
}
template <bool DOWN> struct MoeSched {
    const LAS int* tbl; int ntiles, G, c; const char* A; const char* W;
    __device__ bool next(int i, Unit& u) const {
        const int L = i * G + c, mt = L >> 2, pn = L & 3;
        if (mt >= ntiles) return false;
        const int ent = __builtin_amdgcn_readfirstlane(tbl[mt]), bucket = ent & 255; u.aux = ent >> 8;
        int ea, eb; pair_experts(bucket, ea, eb);
        u.pm = mt; u.pn = pn;
        if (!DOWN) { u.a = A + (size_t)mt * 256 * 1024 * 2; const int e = (pn < 2) ? ea : eb; u.b0 = W + ((size_t)e * 512 + 256 * (pn & 1)) * 1024 * 2; u.b1 = u.b0; }
        else { u.a = A + (size_t)mt * 256 * 512 * 2; u.b0 = W + ((size_t)ea * 1024 + 256 * pn) * 256 * 2; u.b1 = W + ((size_t)eb * 1024 + 256 * pn) * 256 * 2; }
        return true;
    }
};
__device__ __forceinline__ void moe_build_table(LAS int* tbl, const unsigned* cnt, int tid) {
    if (tid == 0) { int mt = 0;
        for (int b = 0; b < 24; ++b) { const int nb = (int)cnt[b]; for (int r = 0; r < nb; r += 256) { const int v = (nb - r) < 256 ? (nb - r) : 256; if (mt < 95) tbl[mt] = b | (v << 8); ++mt; } }
        tbl[95] = mt < 95 ? mt : 95; }
    __syncthreads();
}

#define XB_TMO      128
#define XB_XCNT(j)  (256  + 64 * (j))
#define XB_XSUB(j)  (1280 + 64 * (j))
#define XB_XGEN(j)  (2304 + 64 * (j))
#define XB_TOP      3328
#define XB_TOPGEN   3392
#define XCD_BAR_WORDS 3456
#define XB_SPIN_CAP (1u << 22)
__device__ __forceinline__ unsigned xb_ld(unsigned* p)              { return __hip_atomic_load(p, __ATOMIC_RELAXED, __HIP_MEMORY_SCOPE_AGENT); }
__device__ __forceinline__ unsigned xb_add(unsigned* p, unsigned v) { return __hip_atomic_fetch_add(p, v, __ATOMIC_RELAXED, __HIP_MEMORY_SCOPE_AGENT); }
__device__ __forceinline__ unsigned xb_xcc_id() { return (unsigned)__builtin_amdgcn_s_getreg((3 << 11) | 20) & 0xFu; }
#define XB_SPIN(cond, bar) do { unsigned _sp = 0; while (cond) { __builtin_amdgcn_s_sleep(1); \
    if ((++_sp & 255u) == 0u) { if (xb_ld(&(bar)[XB_TMO])) break; if (_sp > XB_SPIN_CAP) { atomicAdd(&(bar)[XB_TMO], 1u); break; } } } } while (0)
struct XcdBarrier { unsigned* bar; unsigned x; volatile LAS unsigned* st; int wave; };
__device__ __forceinline__ XcdBarrier xcd_barrier_post(unsigned* bar, volatile LAS unsigned* st, int wave) {
    XcdBarrier b; b.bar = bar; b.x = xb_xcc_id(); b.st = st; b.wave = wave;
    if (wave == 0 && lane_id_v() == 0) (void)xb_add(&bar[XB_XCNT(b.x)], 1u);
    return b;
}
__device__ __forceinline__ void xcd_barrier_complete(unsigned* bar, unsigned x, unsigned& nloc, unsigned& nx) {
    const unsigned G = gridDim.x * gridDim.y * gridDim.z;
    unsigned sum, cnt, mine, sp = 0u;
    for (;;) {
        sum = 0u; cnt = 0u; mine = 0u;
#pragma unroll
        for (unsigned j = 0; j < 16; ++j) { const unsigned c = xb_ld(&bar[XB_XCNT(j)]); sum += c; cnt += (c > 0u) ? 1u : 0u; mine = (j == x) ? c : mine; }
        if (sum == G) break;
        __builtin_amdgcn_s_sleep(1);
        if ((++sp & 255u) == 0u) { if (xb_ld(&bar[XB_TMO])) break; if (sp > XB_SPIN_CAP) { atomicAdd(&bar[XB_TMO], 1u); break; } }
    }
    nloc = mine > 0u ? mine : 1u; nx = cnt > 0u ? cnt : 1u;
}
__device__ __forceinline__ void xcd_barrier(const XcdBarrier& b) {
    asm volatile("s_waitcnt vmcnt(0)" ::: "memory");
    __syncthreads();
    if (b.wave == 0 && lane_id_v() == 0) {
        unsigned* bar = b.bar;
        __builtin_amdgcn_s_waitcnt(0);
        unsigned nloc = b.st[0], nx = b.st[1];
        if (nloc == 0u) { xcd_barrier_complete(bar, b.x, nloc, nx); b.st[0] = nloc; b.st[1] = nx; }
        const unsigned old = xb_add(&bar[XB_XSUB(b.x)], 1u);
        const unsigned gen = old / nloc;
        if (old + 1u == (gen + 1u) * nloc) {
            __builtin_amdgcn_fence(__ATOMIC_RELEASE, "agent");
            asm volatile("s_waitcnt vmcnt(0)" ::: "memory");
            const unsigned og = xb_add(&bar[XB_TOP], 1u);
            const unsigned tg = og / nx;
            if (og + 1u == (tg + 1u) * nx) xb_add(&bar[XB_TOPGEN], 1u);
            else XB_SPIN(xb_ld(&bar[XB_TOPGEN]) == tg, bar);
            __builtin_amdgcn_fence(__ATOMIC_ACQUIRE, "agent");
            xb_add(&bar[XB_XGEN(b.x)], 1u);
            asm volatile("s_waitcnt vmcnt(0)" ::: "memory");
        } else {
            XB_SPIN(xb_ld(&bar[XB_XGEN(b.x)]) == gen, bar);
            __builtin_amdgcn_fence(__ATOMIC_ACQUIRE, "agent");
            asm volatile("s_waitcnt vmcnt(0)" ::: "memory");
        }
    }
    __syncthreads();
}

struct Args { const float* in[38]; float* out; unsigned char* ws; int ph_lo, ph_hi; };
constexpr int LDS_BYTES = 161792;
constexpr int LDS_MISC = 156 * 1024;
struct InTab {
    const LAS unsigned long long* t;
    __device__ __forceinline__ const float* operator[](int i) const {
        const unsigned long long v = t[i];
        const unsigned lo = __builtin_amdgcn_readfirstlane((unsigned)v), hi = __builtin_amdgcn_readfirstlane((unsigned)(v >> 32));
        return (const float*)(((unsigned long long)hi << 32) | lo); }
};
struct Frame {
    LAS unsigned char* lds; int wave, G, wg;
    InTab in; float* out; unsigned char* ws;
};
#define IN_X 0
#define IN_MEM 1
#define IN_NORM_MIX 2
#define IN_NORM_XA 3
#define IN_NORM_MEM 4
#define IN_NORM_FFN 5
#define IN_NORM_FINAL 6
#define IN_AB_WIN 7
#define IN_AB_CONV 8
#define IN_AB_ALOG 9
#define IN_AB_DTB 10
#define IN_AB_ONORM 11
#define IN_AB_MU 12
#define IN_AB_W0 13
#define IN_AB_W2 14
#define IN_AB_A0 15
#define IN_AB_A2 16
#define IN_AB_G2 17
#define IN_AB_KK 18
#define IN_AB_KA 19
#define IN_AB_RK 20
#define IN_AB_LNW 21
#define IN_AB_LNB 22
#define IN_AB_WOUT 23
#define IN_C_WIN 24
#define IN_C_LB 25
#define IN_C_ONORM 26
#define IN_C_WOUT 27
#define IN_XA_WQ 28
#define IN_XA_WKV 29
#define IN_XA_WO 30
#define IN_MOE_WG 31
#define IN_MOE_BG 32
#define IN_MOE_WE 33
#define IN_MOE_BE 34
#define IN_MOE_W1 35
#define IN_MOE_W3 36
#define IN_MOE_W2 37

__device__ __forceinline__ void p0_transpose_item(const float* W, int ld, int col0, int ncols, int K, const float* gain, bf16_t* WT, int drow0, LAS float* scr, int item, int lane) {
    const int nblk = ncols / 32, kb = item / nblk, nb = item % nblk, k0 = 64 * kb, n0 = 32 * nb;
    float vv[32];
#pragma unroll
    for (int i = 0; i < 32; ++i) vv[i] = W[(size_t)(k0 + 2 * i + (lane >> 5)) * ld + col0 + n0 + (lane & 31)];
#pragma unroll
    for (int i = 0; i < 32; ++i) { const int kk = 2 * i + (lane >> 5); float v = vv[i]; if (gain) v *= gain[k0 + kk]; scr[kk * 33 + (lane & 31)] = v; }
    LDS_WAIT(); asm volatile("" ::: "memory");
    const int c = lane & 7;
#pragma unroll
    for (int j = 0; j < 4; ++j) { const int n = (lane >> 3) + 8 * j; const LAS float* s = scr + (8 * c) * 33 + n;
        u32x4 o; o.x = pk2(s[0 * 33], s[1 * 33]); o.y = pk2(s[2 * 33], s[3 * 33]); o.z = pk2(s[4 * 33], s[5 * 33]); o.w = pk2(s[6 * 33], s[7 * 33]);
        *(u32x4*)(WT + (size_t)(drow0 + n0 + n) * K + k0 + 8 * c) = o; }
    LDS_WAIT(); asm volatile("" ::: "memory");
}
__device__ __forceinline__ void p0_weight_item(const Frame& F, int it, LAS float* scr, int lane) {
    const InTab in = F.in;
    bf16_t* W0 = (bf16_t*)(F.ws + WS_W0); bf16_t* W1 = (bf16_t*)(F.ws + WS_W1);
    if (it < 16384) {
        const int l = it >> 13; int r = it & 8191; bf16_t* W = l ? W1 : W0;
        if (r < 512) { p0_transpose_item(in[IN_XA_WQ] + (size_t)l * 1024 * 1024, 1024, 0, 1024, 1024, in[IN_NORM_XA] + l * 1024, W + WO_WQ, 0, scr, r, lane); return; }
        r -= 512;
        if (r < 1024) { p0_transpose_item(in[IN_XA_WKV] + (size_t)l * 1024 * 2048, 2048, 0, 2048, 1024, in[IN_NORM_MEM] + l * 1024, W + WO_WKV, 0, scr, r, lane); return; }
        r -= 1024;
        if (r < 512) { p0_transpose_item(in[IN_XA_WO] + (size_t)l * 1024 * 1024, 1024, 0, 1024, 1024, nullptr, W + WO_WO, 0, scr, r, lane); return; }
        r -= 512;
        if (r < 4096) { const int sub = r >> 6, item = r & 63, e = sub >> 2, j = (sub >> 1) & 1, which = sub & 1;
            const float* src = (which ? in[IN_MOE_W3] : in[IN_MOE_W1]) + (size_t)(l * 16 + e) * 1024 * 256;
            p0_transpose_item(src, 256, 128 * j, 128, 1024, in[IN_NORM_FFN] + l * 1024, W + WO_W13, e * 512 + 256 * j + 128 * which, scr, item, lane); return; }
        r -= 4096;
        { const int e = r >> 7, item = r & 127;
            p0_transpose_item(in[IN_MOE_W2] + (size_t)(l * 16 + e) * 256 * 1024, 1024, 0, 1024, 256, nullptr, W + WO_W2T + (size_t)e * 1024 * 256, 0, scr, item, lane); return; }
    }
    int r = it - 16384;
    if (r < 1024) { p0_transpose_item(in[IN_AB_WIN], 3848, 0, 2048, 1024, in[IN_NORM_MIX], W0 + WO_WIN, 0, scr, r, lane); return; }
    r -= 1024;
    if (r < 896) { p0_transpose_item(in[IN_AB_WIN], 3848, 2056, 1792, 1024, in[IN_NORM_MIX], W0 + WO_WIN, 2048, scr, r, lane); return; }
    r -= 896;
    if (r < 512) { p0_transpose_item(in[IN_AB_WOUT], 1024, 0, 1024, 1024, nullptr, W0 + WO_WOUT, 0, scr, r, lane); return; }
    r -= 512;
    if (r < 2048) { p0_transpose_item(in[IN_C_WIN], 4096, 0, 4096, 1024, in[IN_NORM_MIX] + 1024, W1 + WO_WIN, 0, scr, r, lane); return; }
    r -= 2048;
    if (r < 512) { p0_transpose_item(in[IN_C_WOUT], 1024, 0, 1024, 1024, nullptr, W1 + WO_WOUT, 0, scr, r, lane); return; }
    r -= 512;
    bf16_t* LW = (bf16_t*)(F.ws + WS_LORA);
    if (r < 16) { p0_transpose_item(in[IN_AB_W2], 512, 0, 512, 64, nullptr, LW, 0, scr, r, lane); return; }
    r -= 16;
    if (r < 16) { p0_transpose_item(in[IN_AB_A2], 512, 0, 512, 64, nullptr, LW + 512 * 64, 0, scr, r, lane); return; }
    r -= 16;
    p0_transpose_item(in[IN_AB_G2], 512, 0, 512, 128, nullptr, LW + 2 * 512 * 64, 0, scr, r, lane);
}
constexpr int P0_NITEMS = 16384 + 1024 + 896 + 512 + 2048 + 512 + 64;

template <int SEL> __device__ __forceinline__ void p0_late_weights(const Frame& F, int worker, int nworkers) {
    const int lane = lane_id_v();
    LAS float* scr = (LAS float*)(F.lds + F.wave * 16384);
    const int gw = worker * NWAVES + F.wave, NGW = nworkers * NWAVES;
    if (SEL == 0) {
        for (int it = gw; it < 8192 + 512 + 2048 + 1024; it += NGW) {
            int item;
            if (it < 8192) { item = it; if (item >= 512 && item < 1536) continue; }
            else if (it < 8192 + 512) item = 16384 + 1920 + (it - 8192);
            else if (it < 8192 + 512 + 2048) item = 16384 + 1920 + 512 + (it - 8192 - 512);
            else item = 8192 + 512 + (it - 8192 - 512 - 2048);
            p0_weight_item(F, item, scr, lane);
        }
    } else {
        for (int it = gw; it < 512 + 6656 + 512; it += NGW) {
            int item;
            if (it < 512) item = 8192 + it;
            else if (it < 512 + 6656) item = 8192 + 1536 + (it - 512);
            else item = 16384 + 1920 + 512 + 2048 + (it - 512 - 6656);
            p0_weight_item(F, item, scr, lane);
        }
    }
}
__device__ __forceinline__ void p0_prologue(const Frame& F) {
    const int lane = lane_id_v(); const int tid = F.wave * 64 + lane; (void)tid;
    LAS float* scr = (LAS float*)(F.lds + F.wave * 16384);
    const int gw = F.wg * NWAVES + F.wave, NGW = F.G * NWAVES;
    for (int it = gw; it < 1920 + 64 + 1024; it += NGW) p0_weight_item(F, it < 1920 ? 16384 + it : (it < 1984 ? P0_NITEMS - 64 + (it - 1920) : 512 + (it - 1984)), scr, lane);
    const float* x = F.in[IN_X]; const float* gain = F.in[IN_NORM_MIX]; const float* win = F.in[IN_AB_WIN];
    bf16_t* XB = (bf16_t*)(F.ws + WS_XB); float* ssp = (float*)(F.ws + WS_SSP); float* db = (float*)(F.ws + WS_DB);
    for (int row = gw; row < NT; row += NGW) {
        const f32x4* xr = (const f32x4*)(x + (size_t)row * 1024) + lane;
        f32x4 v[4]; float s = 0.f; float d[8];
#pragma unroll
        for (int c = 0; c < 8; ++c) d[c] = 0.f;
#pragma unroll
        for (int j = 0; j < 4; ++j) {
            v[j] = xr[64 * j]; s += (v[j].x * v[j].x + v[j].y * v[j].y) + (v[j].z * v[j].z + v[j].w * v[j].w);
            const int k0 = 4 * lane + 256 * j;
            const f32x4 g = *(const f32x4*)(gain + k0);
            const float xv[4] = {v[j].x * g.x, v[j].y * g.y, v[j].z * g.z, v[j].w * g.w};
#pragma unroll
            for (int q = 0; q < 4; ++q) {
                const f32x4 w0 = *(const f32x4*)(win + (size_t)(k0 + q) * 3848 + 2048), w1 = *(const f32x4*)(win + (size_t)(k0 + q) * 3848 + 2052);
                d[0] += xv[q] * w0.x; d[1] += xv[q] * w0.y; d[2] += xv[q] * w0.z; d[3] += xv[q] * w0.w;
                d[4] += xv[q] * w1.x; d[5] += xv[q] * w1.y; d[6] += xv[q] * w1.z; d[7] += xv[q] * w1.w;
            }
        }
        s = wsum(s);
        const float rstd = 1.0f / sqrtf(s * (1.0f / 1024.0f) + 1e-6f);
#pragma unroll
        for (int c = 0; c < 8; ++c) d[c] = wsum(d[c]) * rstd;
        unsigned long long* o8 = (unsigned long long*)(XB + (size_t)row * 1024) + lane;
#pragma unroll
        for (int j = 0; j < 4; ++j) o8[64 * j] = (unsigned long long)pk2(v[j].x, v[j].y) | ((unsigned long long)pk2(v[j].z, v[j].w) << 32);
        if (lane < 16) ssp[(size_t)row * 16 + lane] = (lane == 0) ? s : 0.f;
        if (lane < 8) { float dv = d[0];
#pragma unroll
            for (int c = 1; c < 8; ++c) dv = (lane == c) ? d[c] : dv;
            db[(size_t)row * 8 + lane] = dv; }
    }
    const float* mem = F.in[IN_MEM]; bf16_t* MH = (bf16_t*)(F.ws + WS_MEMH);
    for (int row = gw; row < NB * NMEM; row += NGW) {
        const f32x4* xr = (const f32x4*)(mem + (size_t)row * 1024) + lane;
        f32x4 v[4]; float s = 0.f;
#pragma unroll
        for (int j = 0; j < 4; ++j) { v[j] = xr[64 * j]; s += (v[j].x * v[j].x + v[j].y * v[j].y) + (v[j].z * v[j].z + v[j].w * v[j].w); }
        s = wsum(s);
        const float rstd = 1.0f / sqrtf(s * (1.0f / 1024.0f) + 1e-6f);
        unsigned long long* o8 = (unsigned long long*)(MH + (size_t)row * 1024) + lane;
#pragma unroll
        for (int j = 0; j < 4; ++j) o8[64 * j] = (unsigned long long)pk2(v[j].x * rstd, v[j].y * rstd) | ((unsigned long long)pk2(v[j].z * rstd, v[j].w * rstd) << 32);
    }
    {
        float* rw = (float*)(F.ws + WS_RW);
        for (int idx = F.wg * NTHREADS + tid; idx < 2 * 1024 * 32; idx += F.G * NTHREADS) {
            const int l = idx >> 15, k = (idx >> 5) & 1023, cc = idx & 31;
            const float g = F.in[IN_NORM_FFN][l * 1024 + k];
            float v = 0.f;
            if (cc < 4) v = F.in[IN_MOE_WG][(size_t)l * 4096 + k * 4 + cc] * g; else if (cc < 20) v = F.in[IN_MOE_WE][(size_t)l * 16384 + k * 16 + (cc - 4)] * g;
            rw[idx] = v;
        }
    }
    if (F.wg == 0) { const float* lbp = F.in[IN_C_LB]; float* lb = (float*)(F.ws + WS_LB);
        for (int c = tid; c < 1024; c += NTHREADS) { const float a = lbp[c], b = lbp[1024 + c]; const float mx = fmaxf(a, b), ea = __expf(a - mx), eb = __expf(b - mx); lb[c] = (ea + eb) / (ea + eb) - ea / (ea + eb); } }
}

__device__ __forceinline__ void scan_delta(const Frame& F, int b, int h) {
    const int lane = lane_id_v(); const int tid = F.wave * 64 + lane; (void)tid;
    LAS float* qs = (LAS float*)F.lds;
    LAS float* ks = qs + 64 * 128;
    LAS float* vs = ks + 64 * 128;
    LAS float* os = vs + 64 * 128;
    LAS float* al = os + 64 * 128;
    LAS float* be = al + 64;
    bf16_t* P = (bf16_t*)(F.ws + WS_BIG + BIG_PROJ);
    const float* convw = F.in[IN_AB_CONV];
    const float* db = (const float*)(F.ws + WS_DB);
    const float a_neg = -__expf(F.in[IN_AB_ALOG][h]), dtb = F.in[IN_AB_DTB][h];
    const float* onorm = F.in[IN_AB_ONORM];
    const int i_dv = tid >> 2, part = tid & 3;
    float s[32];
#pragma unroll
    for (int j = 0; j < 32; ++j) s[j] = 0.f;
    for (int c = 0; c < 32; ++c) {
        const int t0 = b * TS + c * 64;
        for (int idx = tid; idx < 64 * 384; idx += NTHREADS) {
            const int t = idx / 384, cc = idx % 384, sct = cc >> 7, col = cc & 127;
            const int gcol = sct * 512 + h * 128 + col;
            float a = 0.f;
#pragma unroll
            for (int j = 0; j < 4; ++j) { const int tl = c * 64 + t - 3 + j; if (tl >= 0) a += convw[j * 1536 + gcol] * bf2f(P[(size_t)(b * TS + tl) * P0LD + gcol]); }
            a = siluf_(a);
            (sct == 0 ? qs : (sct == 1 ? ks : vs))[t * 128 + col] = a;
        }
        if (tid < 64) { const int t = tid; const float la = a_neg * softplusf_(db[(size_t)(t0 + t) * 8 + h] + dtb); al[t] = __expf(la); be[t] = sigmoidf_(db[(size_t)(t0 + t) * 8 + 4 + h]); }
        __syncthreads();
        for (int r = F.wave; r < 128; r += NWAVES) { LAS float* p = (r < 64 ? qs + r * 128 : ks + (r - 64) * 128);
            const float v0 = p[lane], v1 = p[lane + 64]; const float ss = wave_sum(v0 * v0 + v1 * v1);
            const float sc = (1.0f / sqrtf(ss + 1e-6f)) * (r < 64 ? 0.08838834764831845f : 1.0f); p[lane] = v0 * sc; p[lane + 64] = v1 * sc; }
        __syncthreads();
        for (int t = 0; t < 64; ++t) {
            const LAS f32x4* kp = (const LAS f32x4*)(ks + t * 128 + part * 32); const LAS f32x4* qp = (const LAS f32x4*)(qs + t * 128 + part * 32);
            float kt[32], qt[32];
#pragma unroll
            for (int j = 0; j < 8; ++j) { const f32x4 a = kp[j], q = qp[j]; kt[4 * j] = a.x; kt[4 * j + 1] = a.y; kt[4 * j + 2] = a.z; kt[4 * j + 3] = a.w; qt[4 * j] = q.x; qt[4 * j + 1] = q.y; qt[4 * j + 2] = q.z; qt[4 * j + 3] = q.w; }
            float p = 0.f;
#pragma unroll
            for (int j = 0; j < 32; ++j) p += s[j] * kt[j];
            p += __shfl_xor(p, 1); p += __shfl_xor(p, 2);
            const float alpha = al[t], coef = be[t] * (vs[t * 128 + i_dv] - alpha * p);
            float o = 0.f;
#pragma unroll
            for (int j = 0; j < 32; ++j) { s[j] = alpha * s[j] + coef * kt[j]; o += s[j] * qt[j]; }
            o += __shfl_xor(o, 1); o += __shfl_xor(o, 2);
            if (part == 0) os[t * 128 + i_dv] = o;
        }
        __syncthreads();
        for (int t = F.wave; t < 64; t += NWAVES) {
            const float o0 = os[t * 128 + lane], o1 = os[t * 128 + lane + 64];
            const float ss = wave_sum(o0 * o0 + o1 * o1), rs = 1.0f / sqrtf(ss * (1.0f / 128.0f) + 1e-6f);
            bf16_t* gp = P + (size_t)(t0 + t) * P0LD + 1536 + h * 128;
            const float g0 = bf2f(gp[lane]), g1 = bf2f(gp[lane + 64]);
            gp[lane] = (bf16_t)f2bf(o0 * rs * onorm[lane] * siluf_(g0)); gp[lane + 64] = (bf16_t)f2bf(o1 * rs * onorm[lane + 64] * siluf_(g1));
        }
        __syncthreads();
    }
}
__device__ __forceinline__ void scan_rwkv(const Frame& F, int b, int h) {
    const int lane = lane_id_v(); const int tid = F.wave * 64 + lane; (void)tid;
    LAS float* bufA = (LAS float*)F.lds;
    LAS float* bufB = bufA + 4096;
    LAS float* bufC = bufB + 4096;
    LAS float* R = bufC + 8192;
    LAS float* Kb = R + 4096;
    LAS float* V = Kb + 4096;
    LAS float* KK = V + 4096;
    LAS float* halo = KK + 4096;
    LAS float* bonus = halo + 896;
    bf16_t* P = (bf16_t*)(F.ws + WS_BIG + BIG_PROJ);
    const float* mu = F.in[IN_AB_MU];
    const float* w0 = F.in[IN_AB_W0] + h * 64; const float* w2 = F.in[IN_AB_W2] + h * 64;
    const float* a0 = F.in[IN_AB_A0] + h * 64; const float* a2 = F.in[IN_AB_A2] + h * 64;
    const float* g2 = F.in[IN_AB_G2] + h * 64;
    const float* k_k = F.in[IN_AB_KK] + h * 64; const float* k_a = F.in[IN_AB_KA] + h * 64; const float* r_k = F.in[IN_AB_RK] + h * 64;
    const float* ln_w = F.in[IN_AB_LNW] + h * 64; const float* ln_b = F.in[IN_AB_LNB] + h * 64;
    const int vi = tid >> 3, part = tid & 7;
    float s[8];
#pragma unroll
    for (int j = 0; j < 8; ++j) s[j] = 0.f;
    for (int i = tid; i < 896; i += NTHREADS) halo[i] = 0.f;
    __syncthreads();
    for (int c = 0; c < 32; ++c) {
        const int t0 = b * TS + c * 64;
        const LAS float* hcur = halo + (c & 1) * 448; LAS float* hnext = halo + ((c + 1) & 1) * 448;
        for (int idx = tid; idx < 64 * 448; idx += NTHREADS) {
            const int t = idx / 448, col = idx % 448;
            int gc;
            if (col < 64) gc = 2048 + h * 64 + col; else if (col < 128) gc = 2560 + h * 64 + (col - 64); else if (col < 192) gc = 3072 + h * 64 + (col - 128); else gc = 3584 + (col - 192);
            const float cur = bf2f(P[(size_t)(t0 + t) * P0LD + gc]);
            const float prev = (t > 0) ? bf2f(P[(size_t)(t0 + t - 1) * P0LD + gc]) : hcur[col];
            const float sh = cur + mu[gc - 2048] * (prev - cur);
            if (t == 63) hnext[col] = cur;
            if (col < 64) R[t * 64 + col] = sh; else if (col < 128) Kb[t * 64 + col - 64] = sh; else if (col < 192) V[t * 64 + col - 128] = sh;
            else if (col < 256) bufA[t * 64 + col - 192] = tanhf(sh); else if (col < 320) bufB[t * 64 + col - 256] = sh; else bufC[t * 128 + col - 320] = sigmoidf_(sh);
        }
        __syncthreads();
        float wv[8], av[8], gv[8];
        {
            const int j = lane, tb = F.wave * 8;
#pragma unroll
            for (int q = 0; q < 8; ++q) { wv[q] = 0.f; av[q] = 0.f; gv[q] = 0.f; }
            for (int m = 0; m < 64; ++m) { const float x2 = w2[(size_t)m * 512 + j], y2 = a2[(size_t)m * 512 + j];
#pragma unroll
                for (int q = 0; q < 8; ++q) { wv[q] += bufA[(tb + q) * 64 + m] * x2; av[q] += bufB[(tb + q) * 64 + m] * y2; } }
            for (int m = 0; m < 128; ++m) { const float z2 = g2[(size_t)m * 512 + j];
#pragma unroll
                for (int q = 0; q < 8; ++q) gv[q] += bufC[(tb + q) * 128 + m] * z2; }
#pragma unroll
            for (int q = 0; q < 8; ++q) { wv[q] = __expf(-0.6065306597126334f * sigmoidf_(w0[j] + wv[q])); av[q] = sigmoidf_(a0[j] + av[q]); }
        }
        __syncthreads();
        {
            const int j = lane, tb = F.wave * 8;
#pragma unroll
            for (int q = 0; q < 8; ++q) { bufA[(tb + q) * 64 + j] = wv[q]; bufB[(tb + q) * 64 + j] = av[q]; bufC[(tb + q) * 64 + j] = gv[q]; }
#pragma unroll
            for (int q = 0; q < 8; ++q) { const int t = tb + q; const float kv = Kb[t * 64 + j]; const float kx = kv * k_k[j]; const float ss = wave_sum(kx * kx);
                KK[t * 64 + j] = kx * (1.0f / sqrtf(ss + 1e-6f)); const float km = kv * (1.f + (av[q] - 1.f) * k_a[j]); Kb[t * 64 + j] = km;
                const float bs = wave_sum(R[t * 64 + j] * km * r_k[j]); if (j == 0) bonus[t] = bs; }
        }
        __syncthreads();
        LAS float* O = bufC + 4096;
        for (int t = 0; t < 64; ++t) {
            const LAS f32x4* p4;
            float kk[8], ww[8], aa[8], km[8], rr[8];
            p4 = (const LAS f32x4*)(KK + t * 64 + part * 8);   { const f32x4 a = p4[0], c2 = p4[1]; kk[0] = a.x; kk[1] = a.y; kk[2] = a.z; kk[3] = a.w; kk[4] = c2.x; kk[5] = c2.y; kk[6] = c2.z; kk[7] = c2.w; }
            p4 = (const LAS f32x4*)(bufA + t * 64 + part * 8); { const f32x4 a = p4[0], c2 = p4[1]; ww[0] = a.x; ww[1] = a.y; ww[2] = a.z; ww[3] = a.w; ww[4] = c2.x; ww[5] = c2.y; ww[6] = c2.z; ww[7] = c2.w; }
            p4 = (const LAS f32x4*)(bufB + t * 64 + part * 8); { const f32x4 a = p4[0], c2 = p4[1]; aa[0] = a.x; aa[1] = a.y; aa[2] = a.z; aa[3] = a.w; aa[4] = c2.x; aa[5] = c2.y; aa[6] = c2.z; aa[7] = c2.w; }
            p4 = (const LAS f32x4*)(Kb + t * 64 + part * 8);   { const f32x4 a = p4[0], c2 = p4[1]; km[0] = a.x; km[1] = a.y; km[2] = a.z; km[3] = a.w; km[4] = c2.x; km[5] = c2.y; km[6] = c2.z; km[7] = c2.w; }
            p4 = (const LAS f32x4*)(R + t * 64 + part * 8);    { const f32x4 a = p4[0], c2 = p4[1]; rr[0] = a.x; rr[1] = a.y; rr[2] = a.z; rr[3] = a.w; rr[4] = c2.x; rr[5] = c2.y; rr[6] = c2.z; rr[7] = c2.w; }
            const float vv = V[t * 64 + vi];
            float sa = 0.f;
#pragma unroll
            for (int j = 0; j < 8; ++j) sa -= s[j] * kk[j];
            sa += __shfl_xor(sa, 1); sa += __shfl_xor(sa, 2); sa += __shfl_xor(sa, 4);
            float o = 0.f;
#pragma unroll
            for (int j = 0; j < 8; ++j) { s[j] = s[j] * ww[j] + sa * (kk[j] * aa[j]) + vv * km[j]; o += s[j] * rr[j]; }
            o += __shfl_xor(o, 1); o += __shfl_xor(o, 2); o += __shfl_xor(o, 4);
            if (part == 0) O[t * 64 + vi] = o;
        }
        __syncthreads();
        for (int t = F.wave; t < 64; t += NWAVES) {
            const float o = O[t * 64 + lane];
            const float mean = wave_sum(o) * (1.0f / 64.0f); const float dlt = o - mean; const float var = wave_sum(dlt * dlt) * (1.0f / 64.0f);
            float y = dlt * (1.0f / sqrtf(var + 64e-5f)) * ln_w[lane] + ln_b[lane];
            y += bonus[t] * V[t * 64 + lane];
            y *= bufC[t * 64 + lane];
            P[(size_t)(t0 + t) * P0LD + 2048 + h * 64 + lane] = (bf16_t)f2bf(y);
        }
        __syncthreads();
    }
}
__device__ __forceinline__ void scan_hgrn(const Frame& F, int b, int h) {
    const int lane = lane_id_v(); const int tid = F.wave * 64 + lane; (void)tid;
    LAS float* qs = (LAS float*)F.lds;
    LAS float* fs = qs + 64 * 128;
    LAS float* kf = fs + 64 * 128;
    LAS float* is = kf + 64 * 128;
    bf16_t* P = (bf16_t*)(F.ws + WS_BIG + BIG_PROJ);
    const float* onorm = F.in[IN_C_ONORM];
    const int e = tid >> 2, part = tid & 3;
    float s[32];
#pragma unroll
    for (int j = 0; j < 32; ++j) s[j] = 0.f;
    for (int c = 0; c < 32; ++c) {
        const int t0 = b * TS + c * 64;
        for (int idx = tid; idx < 64 * 128; idx += NTHREADS) {
            const int t = idx >> 7, col = idx & 127; const bf16_t* pr = P + (size_t)(t0 + t) * P1LD + h * 128 + col;
            qs[idx] = bf2f(pr[0]); const float lf = h2f_bits(pr[1024]); fs[idx] = __expf(lf); kf[idx] = -expm1f(lf); is[idx] = bf2f(pr[2048]);
        }
        __syncthreads();
        for (int t = 0; t < 64; ++t) {
            const LAS f32x4* fp = (const LAS f32x4*)(fs + t * 128 + part * 32); const LAS f32x4* kp = (const LAS f32x4*)(kf + t * 128 + part * 32); const LAS f32x4* qp = (const LAS f32x4*)(qs + t * 128 + part * 32);
            const float iv = is[t * 128 + e];
            float o = 0.f;
#pragma unroll
            for (int j = 0; j < 8; ++j) { const f32x4 f = fp[j], k = kp[j], q = qp[j];
                s[4 * j] = f.x * s[4 * j] + k.x * iv; o += s[4 * j] * q.x;
                s[4 * j + 1] = f.y * s[4 * j + 1] + k.y * iv; o += s[4 * j + 1] * q.y;
                s[4 * j + 2] = f.z * s[4 * j + 2] + k.z * iv; o += s[4 * j + 2] * q.z;
                s[4 * j + 3] = f.w * s[4 * j + 3] + k.w * iv; o += s[4 * j + 3] * q.w; }
            o += __shfl_xor(o, 1); o += __shfl_xor(o, 2);
            if (part == 0) is[t * 128 + e] = o;
        }
        __syncthreads();
        for (int t = F.wave; t < 64; t += NWAVES) {
            const float o0 = is[t * 128 + lane], o1 = is[t * 128 + lane + 64];
            const float ss = wave_sum(o0 * o0 + o1 * o1), rs = 1.0f / sqrtf(ss * (1.0f / 128.0f) + 1e-6f);
            bf16_t* gp = P + (size_t)(t0 + t) * P1LD + 3072 + h * 128;
            const float g0 = bf2f(gp[lane]), g1 = bf2f(gp[lane + 64]);
            gp[lane] = (bf16_t)f2bf(o0 * rs * onorm[lane] * siluf_(g0)); gp[lane + 64] = (bf16_t)f2bf(o1 * rs * onorm[lane + 64] * siluf_(g1));
        }
        __syncthreads();
    }
}

__device__ __forceinline__ void scan_delta2(const Frame& F, int b, int h, int qd) {
    const int lane = lane_id_v(); const int tid = F.wave * 64 + lane;
    LAS float* Kc = (LAS float*)F.lds;
    LAS float* Qc = Kc + 64 * 128;
    LAS float* Vc = Qc + 64 * 128;
    LAS float* Oc = Vc + 64 * 32;
    LAS float* al = Oc + 64 * 32;
    LAS float* be = al + 64;
    LAS float* vh = be + 64;
    bf16_t* P = (bf16_t*)(F.ws + WS_BIG + BIG_PROJ);
    const float* convw = F.in[IN_AB_CONV];
    const float* db = (const float*)(F.ws + WS_DB);
    const float a_neg = -__expf(F.in[IN_AB_ALOG][h]), dtb = F.in[IN_AB_DTB][h];
    const int w = F.wave;
    const int vcol = 1024 + h * 128 + qd * 32 + (lane & 31);
    float cwq[4][2], cwk[4][2], cwv[4];
#pragma unroll
    for (int j = 0; j < 4; ++j) { cwq[j][0] = convw[j * 1536 + h * 128 + lane]; cwq[j][1] = convw[j * 1536 + h * 128 + lane + 64];
        cwk[j][0] = convw[j * 1536 + 512 + h * 128 + lane]; cwk[j][1] = convw[j * 1536 + 512 + h * 128 + lane + 64]; cwv[j] = convw[j * 1536 + vcol]; }
    const int r = tid >> 4, part = tid & 15;
    float s[8];
#pragma unroll
    for (int j = 0; j < 8; ++j) s[j] = 0.f;
    if (tid < 192) vh[tid] = 0.f;
    __syncthreads();
    for (int c = 0; c < 32; ++c) {
        const int t0 = b * TS + c * 64;
        const LAS float* vhc = vh + (c & 1) * 96; LAS float* vhn = vh + ((c + 1) & 1) * 96;
        {
            float rq[11][2], rk[11][2], rv[11];
#pragma unroll
            for (int rr = 0; rr < 11; ++rr) {
                const int tl = c * 64 + 8 * w - 3 + rr;
                const bool ok = tl >= 0;
                const bf16_t* row = P + (size_t)(b * TS + (ok ? tl : 0)) * P0LD;
                rq[rr][0] = ok ? bf2f(row[h * 128 + lane]) : 0.f; rq[rr][1] = ok ? bf2f(row[h * 128 + lane + 64]) : 0.f;
                rk[rr][0] = ok ? bf2f(row[512 + h * 128 + lane]) : 0.f; rk[rr][1] = ok ? bf2f(row[512 + h * 128 + lane + 64]) : 0.f;
                const bool prevchunk = (8 * w - 3 + rr) < 0;
                rv[rr] = prevchunk ? vhc[(rr < 3 ? rr : 0) * 32 + (lane & 31)] : bf2f(row[vcol]);
            }
            if (w == 7 && lane < 32) { vhn[lane] = rv[8]; vhn[32 + lane] = rv[9]; vhn[64 + lane] = rv[10]; }
#pragma unroll
            for (int i = 0; i < 8; ++i) {
                const int t = 8 * w + i;
                float q0 = 0.f, q1 = 0.f, k0 = 0.f, k1 = 0.f, vv = 0.f;
#pragma unroll
                for (int j = 0; j < 4; ++j) { q0 += cwq[j][0] * rq[i + j][0]; q1 += cwq[j][1] * rq[i + j][1]; k0 += cwk[j][0] * rk[i + j][0]; k1 += cwk[j][1] * rk[i + j][1]; vv += cwv[j] * rv[i + j]; }
                q0 = siluf_(q0); q1 = siluf_(q1); k0 = siluf_(k0); k1 = siluf_(k1); vv = siluf_(vv);
                const float sq = wave_sum(q0 * q0 + q1 * q1), sk = wave_sum(k0 * k0 + k1 * k1);
                const float cq = (1.0f / sqrtf(sq + 1e-6f)) * 0.08838834764831845f, ck = 1.0f / sqrtf(sk + 1e-6f);
                Qc[t * 128 + lane] = q0 * cq; Qc[t * 128 + lane + 64] = q1 * cq; Kc[t * 128 + lane] = k0 * ck; Kc[t * 128 + lane + 64] = k1 * ck;
                if (lane < 32) Vc[t * 32 + lane] = vv;
            }
            if (lane < 8) { const int t = 8 * w + lane; const float la = a_neg * softplusf_(db[(size_t)(t0 + t) * 8 + h] + dtb); al[t] = __expf(la); be[t] = sigmoidf_(db[(size_t)(t0 + t) * 8 + 4 + h]); }
        }
        __syncthreads();
        {
            const LAS float* kp = Kc + part * 8; const LAS float* qp = Qc + part * 8;
            f32x4 ka = *(const LAS f32x4*)(kp), kb = *(const LAS f32x4*)(kp + 4), qa = *(const LAS f32x4*)(qp), qb = *(const LAS f32x4*)(qp + 4);
            float vv = Vc[r], alpha = al[0], beta = be[0];
            for (int t = 0; t < 64; ++t) {
                const int tn = (t + 1) & 63;
                const f32x4 nka = *(const LAS f32x4*)(kp + tn * 128), nkb = *(const LAS f32x4*)(kp + tn * 128 + 4), nqa = *(const LAS f32x4*)(qp + tn * 128), nqb = *(const LAS f32x4*)(qp + tn * 128 + 4);
                const float nvv = Vc[tn * 32 + r], nal = al[tn], nbe = be[tn];
                float p0 = s[0] * ka.x + s[1] * ka.y, p1 = s[2] * ka.z + s[3] * ka.w, p2 = s[4] * kb.x + s[5] * kb.y, p3 = s[6] * kb.z + s[7] * kb.w;
                const float p = red16((p0 + p1) + (p2 + p3));
                const float coef = beta * (vv - alpha * p);
                s[0] = alpha * s[0] + coef * ka.x; s[1] = alpha * s[1] + coef * ka.y; s[2] = alpha * s[2] + coef * ka.z; s[3] = alpha * s[3] + coef * ka.w;
                s[4] = alpha * s[4] + coef * kb.x; s[5] = alpha * s[5] + coef * kb.y; s[6] = alpha * s[6] + coef * kb.z; s[7] = alpha * s[7] + coef * kb.w;
                float o0 = s[0] * qa.x + s[1] * qa.y, o1 = s[2] * qa.z + s[3] * qa.w, o2 = s[4] * qb.x + s[5] * qb.y, o3 = s[6] * qb.z + s[7] * qb.w;
                const float o = red16((o0 + o1) + (o2 + o3));
                if (part == 0) Oc[t * 32 + r] = o;
                ka = nka; kb = nkb; qa = nqa; qb = nqb; vv = nvv; alpha = nal; beta = nbe;
            }
        }
        __syncthreads();
        {
            const int t = tid >> 3, c4 = (tid & 7) * 4;
            const f32x4 o = *(const LAS f32x4*)(Oc + t * 32 + c4);
            u32x2 wv; wv.x = pk2(o.x, o.y); wv.y = pk2(o.z, o.w);
            *(u32x2*)(P + (size_t)(t0 + t) * P0LD + 1024 + h * 128 + qd * 32 + c4) = wv;
        }
    }
}
__device__ __forceinline__ void fin_delta(const Frame& F) {
    const int lane = lane_id_v();
    bf16_t* P = (bf16_t*)(F.ws + WS_BIG + BIG_PROJ); const float* onorm = F.in[IN_AB_ONORM];
    const float on0 = onorm[lane], on1 = onorm[lane + 64];
    const int gw = F.wg * NWAVES + F.wave, NGW = F.G * NWAVES;
    for (int it = gw; it < NT * 4; it += NGW) {
        const int t = it >> 2, h = it & 3;
        bf16_t* row = P + (size_t)t * P0LD;
        const float o0 = bf2f(row[1024 + h * 128 + lane]), o1 = bf2f(row[1024 + h * 128 + lane + 64]);
        const float g0 = bf2f(row[1536 + h * 128 + lane]), g1 = bf2f(row[1536 + h * 128 + lane + 64]);
        const float ss = wave_sum(o0 * o0 + o1 * o1), rs = 1.0f / sqrtf(ss * (1.0f / 128.0f) + 1e-6f);
        row[1536 + h * 128 + lane] = (bf16_t)f2bf(o0 * rs * on0 * siluf_(g0)); row[1536 + h * 128 + lane + 64] = (bf16_t)f2bf(o1 * rs * on1 * siluf_(g1));
    }
}

__device__ __forceinline__ void scan_rwkv2(const Frame& F, int b, int h) {
    const int lane = lane_id_v(); const int tid = F.wave * 64 + lane;
    LAS float* R = (LAS float*)F.lds;
    LAS float* KM = R + 4096;
    LAS float* V = KM + 4096;
    LAS float* KK = V + 4096;
    LAS float* KA = KK + 4096;
    LAS float* W = KA + 4096;
    LAS bf16_t* TL = (LAS bf16_t*)(W + 4096);
    LAS bf16_t* AL = TL + 64 * 72;
    LAS bf16_t* SG = AL + 64 * 72;
    LAS float* O = (LAS float*)TL;
    LAS bf16_t* GB = SG + 64 * 136;
    LAS float* halo = (LAS float*)(GB + 4096);
    LAS float* bonus = halo + 896;
    bf16_t* P = (bf16_t*)(F.ws + WS_BIG + BIG_PROJ);
    const bf16_t* LW = (const bf16_t*)(F.ws + WS_LORA);
    const float* mu = F.in[IN_AB_MU];
    const float* w0 = F.in[IN_AB_W0] + h * 64; const float* a0 = F.in[IN_AB_A0] + h * 64;
    const float* k_k = F.in[IN_AB_KK] + h * 64; const float* k_a = F.in[IN_AB_KA] + h * 64; const float* r_k = F.in[IN_AB_RK] + h * 64;
    const float* ln_w = F.in[IN_AB_LNW] + h * 64; const float* ln_b = F.in[IN_AB_LNB] + h * 64;
    const int w = F.wave, fr = lane & 15, fq = lane >> 4;
    const int vi = tid >> 3, part = tid & 7;
    float s[8];
#pragma unroll
    for (int j = 0; j < 8; ++j) s[j] = 0.f;
    for (int i = tid; i < 896; i += NTHREADS) halo[i] = 0.f;
    int gc = 0; float muc = 0.f;
    if (tid < 448) { const int col = tid;
        if (col < 64) gc = 2048 + h * 64 + col; else if (col < 128) gc = 2560 + h * 64 + (col - 64); else if (col < 192) gc = 3072 + h * 64 + (col - 128); else gc = 3584 + (col - 192);
        muc = mu[gc - 2048]; }
    __syncthreads();
    for (int c = 0; c < 32; ++c) {
        const int t0 = b * TS + c * 64;
        if (tid < 448) {
            const int col = tid;
            LAS float* hc = halo + (c & 1) * 448; LAS float* hn = halo + ((c + 1) & 1) * 448;
            float prev = hc[col];
            const bf16_t* src = P + (size_t)t0 * P0LD + gc;
#pragma unroll 8
            for (int t = 0; t < 64; ++t) {
                const float cur = bf2f(src[(size_t)t * P0LD]);
                const float sh = cur + muc * (prev - cur);
                prev = cur;
                if (col < 64) R[t * 64 + col] = sh; else if (col < 128) KM[t * 64 + col - 64] = sh; else if (col < 192) V[t * 64 + col - 128] = sh;
                else if (col < 256) TL[t * 72 + col - 192] = (bf16_t)f2bf(tanhf(sh)); else if (col < 320) AL[t * 72 + col - 256] = (bf16_t)f2bf(sh); else SG[t * 136 + col - 320] = (bf16_t)f2bf(sigmoidf_(sh));
            }
            hn[col] = prev;
        }
        __syncthreads();
        {
#pragma unroll
            for (int q = 0; q < 2; ++q) {
                const int id = 2 * w + q, mi = id >> 2, nj = id & 3;
                f32x4 aw = {0.f, 0.f, 0.f, 0.f}, aa = {0.f, 0.f, 0.f, 0.f}, ag = {0.f, 0.f, 0.f, 0.f};
                const int jrow = h * 64 + nj * 16 + fr;
#pragma unroll
                for (int ksx = 0; ksx < 2; ++ksx) {
                    const bf16x8 x1 = *(const LAS bf16x8*)(TL + (mi * 16 + fr) * 72 + ksx * 32 + fq * 8), x2 = *(const LAS bf16x8*)(AL + (mi * 16 + fr) * 72 + ksx * 32 + fq * 8);
                    const bf16x8 y1 = *(const bf16x8*)(LW + (size_t)jrow * 64 + ksx * 32 + fq * 8), y2 = *(const bf16x8*)(LW + 512 * 64 + (size_t)jrow * 64 + ksx * 32 + fq * 8);
                    aw = __builtin_amdgcn_mfma_f32_16x16x32_bf16(x1, y1, aw, 0, 0, 0); aa = __builtin_amdgcn_mfma_f32_16x16x32_bf16(x2, y2, aa, 0, 0, 0);
                }
#pragma unroll
                for (int ksx = 0; ksx < 4; ++ksx) {
                    const bf16x8 x3 = *(const LAS bf16x8*)(SG + (mi * 16 + fr) * 136 + ksx * 32 + fq * 8);
                    const bf16x8 y3 = *(const bf16x8*)(LW + 2 * 512 * 64 + (size_t)jrow * 128 + ksx * 32 + fq * 8);
                    ag = __builtin_amdgcn_mfma_f32_16x16x32_bf16(x3, y3, ag, 0, 0, 0);
                }
                const int j = nj * 16 + fr; const float w0j = w0[j], a0j = a0[j];
                const float awv[4] = {aw.x, aw.y, aw.z, aw.w}, aav[4] = {aa.x, aa.y, aa.z, aa.w}, agv[4] = {ag.x, ag.y, ag.z, ag.w};
#pragma unroll
                for (int rg = 0; rg < 4; ++rg) { const int t = mi * 16 + 4 * fq + rg;
                    W[t * 64 + j] = __expf(-0.6065306597126334f * sigmoidf_(w0j + awv[rg])); KA[t * 64 + j] = sigmoidf_(a0j + aav[rg]); GB[t * 64 + j] = (bf16_t)f2bf(agv[rg]); }
            }
        }
        __syncthreads();
        {
            const int j = lane; const float kkj = k_k[j], kaj = k_a[j], rkj = r_k[j];
#pragma unroll
            for (int q = 0; q < 8; ++q) { const int t = w * 8 + q; const float kv = KM[t * 64 + j], a = KA[t * 64 + j]; const float kx = kv * kkj; const float ss = wave_sum(kx * kx);
                const float kk = kx * (1.0f / sqrtf(ss + 1e-6f)); KK[t * 64 + j] = kk; KA[t * 64 + j] = kk * a; const float km = kv * (1.f + (a - 1.f) * kaj); KM[t * 64 + j] = km;
                const float bs = wave_sum(R[t * 64 + j] * km * rkj); if (j == 0) bonus[t] = bs; }
        }
        __syncthreads();
        {
            const int o8 = part * 8;
            for (int t = 0; t < 64; ++t) {
                const f32x4 k0 = *(const LAS f32x4*)(KK + t * 64 + o8), k1 = *(const LAS f32x4*)(KK + t * 64 + o8 + 4);
                const f32x4 w0v = *(const LAS f32x4*)(W + t * 64 + o8), w1v = *(const LAS f32x4*)(W + t * 64 + o8 + 4);
                const f32x4 a0v = *(const LAS f32x4*)(KA + t * 64 + o8), a1v = *(const LAS f32x4*)(KA + t * 64 + o8 + 4);
                const f32x4 m0 = *(const LAS f32x4*)(KM + t * 64 + o8), m1 = *(const LAS f32x4*)(KM + t * 64 + o8 + 4);
                const f32x4 r0 = *(const LAS f32x4*)(R + t * 64 + o8), r1 = *(const LAS f32x4*)(R + t * 64 + o8 + 4);
                const float vv = V[t * 64 + vi];
                const float sa = -red8(((s[0] * k0.x + s[1] * k0.y) + (s[2] * k0.z + s[3] * k0.w)) + ((s[4] * k1.x + s[5] * k1.y) + (s[6] * k1.z + s[7] * k1.w)));
                s[0] = s[0] * w0v.x + sa * a0v.x + vv * m0.x; s[1] = s[1] * w0v.y + sa * a0v.y + vv * m0.y; s[2] = s[2] * w0v.z + sa * a0v.z + vv * m0.z; s[3] = s[3] * w0v.w + sa * a0v.w + vv * m0.w;
                s[4] = s[4] * w1v.x + sa * a1v.x + vv * m1.x; s[5] = s[5] * w1v.y + sa * a1v.y + vv * m1.y; s[6] = s[6] * w1v.z + sa * a1v.z + vv * m1.z; s[7] = s[7] * w1v.w + sa * a1v.w + vv * m1.w;
                const float o = red8(((s[0] * r0.x + s[1] * r0.y) + (s[2] * r0.z + s[3] * r0.w)) + ((s[4] * r1.x + s[5] * r1.y) + (s[6] * r1.z + s[7] * r1.w)));
                if (part == 0) O[t * 64 + vi] = o;
            }
        }
        __syncthreads();
        for (int t = w; t < 64; t += NWAVES) {
            const float o = O[t * 64 + lane];
            const float mean = wave_sum(o) * (1.0f / 64.0f); const float dlt = o - mean; const float var = wave_sum(dlt * dlt) * (1.0f / 64.0f);
            float y = dlt * (1.0f / sqrtf(var + 64e-5f)) * ln_w[lane] + ln_b[lane];
            y += bonus[t] * V[t * 64 + lane];
            y *= bf2f(GB[t * 64 + lane]);
            P[(size_t)(t0 + t) * P0LD + 2048 + h * 64 + lane] = (bf16_t)f2bf(y);
        }
        __syncthreads();
    }
}

__device__ __forceinline__ void scan_hgrn2(const Frame& F, int b, int h, int qd) {
    const int lane = lane_id_v(); const int tid = F.wave * 64 + lane;
    LAS float* qs = (LAS float*)F.lds;
    LAS float* fs = qs + 64 * 128;
    LAS float* kf = fs + 64 * 128;
    LAS float* is = kf + 64 * 128;
    bf16_t* P = (bf16_t*)(F.ws + WS_BIG + BIG_PROJ);
    const int e = tid >> 4, part = tid & 15;
    float s[8];
#pragma unroll
    for (int j = 0; j < 8; ++j) s[j] = 0.f;
    for (int c = 0; c < 32; ++c) {
        const int t0 = b * TS + c * 64;
        {
            const int t = tid >> 3, c16 = (tid & 7) * 16;
            const bf16_t* pr = P + (size_t)(t0 + t) * P1LD + h * 128 + c16;
            const u32x4 qa = *(const u32x4*)pr, qb = *(const u32x4*)(pr + 8), la = *(const u32x4*)(pr + 1024), lb2 = *(const u32x4*)(pr + 1024 + 8);
            const unsigned qv[8] = {qa.x, qa.y, qa.z, qa.w, qb.x, qb.y, qb.z, qb.w}, lv[8] = {la.x, la.y, la.z, la.w, lb2.x, lb2.y, lb2.z, lb2.w};
#pragma unroll
            for (int j = 0; j < 8; ++j) {
                qs[t * 128 + c16 + 2 * j] = bf2f((unsigned short)(qv[j] & 0xffffu)); qs[t * 128 + c16 + 2 * j + 1] = bf2f((unsigned short)(qv[j] >> 16));
                const float l0 = h2f_bits((unsigned short)(lv[j] & 0xffffu)), l1 = h2f_bits((unsigned short)(lv[j] >> 16));
                fs[t * 128 + c16 + 2 * j] = __expf(l0); fs[t * 128 + c16 + 2 * j + 1] = __expf(l1); kf[t * 128 + c16 + 2 * j] = -expm1f(l0); kf[t * 128 + c16 + 2 * j + 1] = -expm1f(l1);
            }
            const int c4 = (tid & 7) * 4;
            const u32x2 iv = *(const u32x2*)(P + (size_t)(t0 + t) * P1LD + 2048 + h * 128 + qd * 32 + c4);
            is[t * 32 + c4] = bf2f((unsigned short)(iv.x & 0xffffu)); is[t * 32 + c4 + 1] = bf2f((unsigned short)(iv.x >> 16)); is[t * 32 + c4 + 2] = bf2f((unsigned short)(iv.y & 0xffffu)); is[t * 32 + c4 + 3] = bf2f((unsigned short)(iv.y >> 16));
        }
        __syncthreads();
        {
            const int o8 = part * 8;
            for (int t = 0; t < 64; ++t) {
                const f32x4 f0 = *(const LAS f32x4*)(fs + t * 128 + o8), f1 = *(const LAS f32x4*)(fs + t * 128 + o8 + 4);
                const f32x4 k0 = *(const LAS f32x4*)(kf + t * 128 + o8), k1 = *(const LAS f32x4*)(kf + t * 128 + o8 + 4);
                const f32x4 q0 = *(const LAS f32x4*)(qs + t * 128 + o8), q1 = *(const LAS f32x4*)(qs + t * 128 + o8 + 4);
                const float iv = is[t * 32 + e];
                s[0] = f0.x * s[0] + k0.x * iv; s[1] = f0.y * s[1] + k0.y * iv; s[2] = f0.z * s[2] + k0.z * iv; s[3] = f0.w * s[3] + k0.w * iv;
                s[4] = f1.x * s[4] + k1.x * iv; s[5] = f1.y * s[5] + k1.y * iv; s[6] = f1.z * s[6] + k1.z * iv; s[7] = f1.w * s[7] + k1.w * iv;
                const float o = red16(((s[0] * q0.x + s[1] * q0.y) + (s[2] * q0.z + s[3] * q0.w)) + ((s[4] * q1.x + s[5] * q1.y) + (s[6] * q1.z + s[7] * q1.w)));
                if (part == 0) is[t * 32 + e] = o;
            }
        }
        __syncthreads();
        {
            const int t = tid >> 3, c4 = (tid & 7) * 4;
            const f32x4 o = *(const LAS f32x4*)(is + t * 32 + c4);
            u32x2 wv; wv.x = pk2(o.x, o.y); wv.y = pk2(o.z, o.w);
            *(u32x2*)(P + (size_t)(t0 + t) * P1LD + 2048 + h * 128 + qd * 32 + c4) = wv;
        }
        __syncthreads();
    }
}
__device__ __forceinline__ void fin_hgrn(const Frame& F) {
    const int lane = lane_id_v();
    bf16_t* P = (bf16_t*)(F.ws + WS_BIG + BIG_PROJ); const float* onorm = F.in[IN_C_ONORM];
    const float on0 = onorm[lane], on1 = onorm[lane + 64];
    const int gw = F.wg * NWAVES + F.wave, NGW = F.G * NWAVES;
    for (int it = gw; it < NT * 8; it += NGW) {
        const int t = it >> 3, h = it & 7;
        bf16_t* row = P + (size_t)t * P1LD;
        const float o0 = bf2f(row[2048 + h * 128 + lane]), o1 = bf2f(row[2048 + h * 128 + lane + 64]);
        const float g0 = bf2f(row[3072 + h * 128 + lane]), g1 = bf2f(row[3072 + h * 128 + lane + 64]);
        const float ss = wave_sum(o0 * o0 + o1 * o1), rs = 1.0f / sqrtf(ss * (1.0f / 128.0f) + 1e-6f);
        row[3072 + h * 128 + lane] = (bf16_t)f2bf(o0 * rs * on0 * siluf_(g0)); row[3072 + h * 128 + lane + 64] = (bf16_t)f2bf(o1 * rs * on1 * siluf_(g1));
    }
}

#define MFMA32(a, b, c) __builtin_amdgcn_mfma_f32_16x16x32_bf16(a, b, c, 0, 0, 0)
#define MFMA16(a, b, c) __builtin_amdgcn_mfma_f32_16x16x16bf16_1k(a, b, c, 0, 0, 0)
__device__ __forceinline__ f32x4 mm_tile(const LAS bf16_t* A, int lda, const LAS bf16_t* B, int ldb, int nks, f32x4 acc, int fr, int fq) {
    for (int ksx = 0; ksx < nks; ++ksx) acc = MFMA32(*(const LAS bf16x8*)(A + fr * lda + ksx * 32 + fq * 8), *(const LAS bf16x8*)(B + fr * ldb + ksx * 32 + fq * 8), acc);
    return acc;
}
__device__ __forceinline__ void lds_w4(LAS bf16_t* p, f32x4 v) { u32x2 w; w.x = pk2(v.x, v.y); w.y = pk2(v.z, v.w); *(LAS u32x2*)p = w; }

struct HoBuf { __amdgpu_buffer_rsrc_t r; };
__device__ __forceinline__ HoBuf ho_buf(float* base, unsigned bytes) {
    const unsigned long long a = (unsigned long long)base;
    const unsigned lo = __builtin_amdgcn_readfirstlane((unsigned)a), hi = __builtin_amdgcn_readfirstlane((unsigned)(a >> 32));
    HoBuf h; h.r = __builtin_amdgcn_make_buffer_rsrc((void*)(((unsigned long long)hi << 32) | lo), 0, bytes, 0x00020000); return h;
}
__device__ __forceinline__ void ho_store(const HoBuf& hb, unsigned byteoff, f32x4 v) {
    __builtin_amdgcn_raw_buffer_store_b128(__builtin_bit_cast(u32x4, v), hb.r, byteoff, 0, 16);
}
__device__ __forceinline__ f32x4 ho_load(const HoBuf& hb, unsigned byteoff) {
    return __builtin_bit_cast(f32x4, __builtin_amdgcn_raw_buffer_load_b128(hb.r, byteoff, 0, 16));
}
__device__ __forceinline__ void ho_wait(unsigned* flag, unsigned need, unsigned* tmo, int wave, int lane) {
    if (wave == 0 && lane == 0) { unsigned sp = 0;
        while (__hip_atomic_load(flag, __ATOMIC_RELAXED, __HIP_MEMORY_SCOPE_AGENT) < need) { __builtin_amdgcn_s_sleep(2); if (++sp > (1u << 24)) { __hip_atomic_store(tmo, 1u, __ATOMIC_RELAXED, __HIP_MEMORY_SCOPE_AGENT); break; } } }
    __syncthreads();
}

__device__ __forceinline__ void scan_delta3(const Frame& F, int b, int h, int jpart, int kparts) {
    const int lane0 = lane_id_v(); const int w = F.wave;
    LAS bf16_t* Qb = (LAS bf16_t*)F.lds;
    LAS bf16_t* Kb = Qb + 64 * 136;
    LAS float* Of = (LAS float*)F.lds;
    LAS bf16_t* Kdt = Kb + 64 * 136;
    LAS bf16_t* Vt = Kdt + 128 * 72;
    LAS bf16_t* St = Vt + 128 * 72;
    LAS bf16_t* Aoff = St + 128 * 136;
    LAS bf16_t* QKm = Aoff + 64 * 72;
    LAS bf16_t* Vn = QKm + 64 * 72;
    LAS bf16_t* Dg = Vn + 128 * 72;
    LAS float* Adg = (LAS float*)(Dg + 4 * 16 * 24);
    LAS float* sc = Adg + 4 * 16 * 17;
    static_assert((64 * 136 * 2 * 2 + 128 * 72 * 2 * 3 + 128 * 136 * 2 + 64 * 72 * 2 * 2 + 4 * 16 * 24 * 2 + 4 * 16 * 17 * 4 + 260 * 4) <= LDS_MISC, "delta3 LDS");
    bf16_t* P = (bf16_t*)(F.ws + WS_BIG + BIG_PROJ);
    const HoBuf hb = ho_buf((float*)(F.ws + WS_HOA) + (size_t)(b * 4 + h) * 16384, 65536);
    unsigned* flag = (unsigned*)(F.ws + WS_FLAGS) + 64 + (b * 4 + h); unsigned* tmo = (unsigned*)(F.ws + WS_FLAGS) + 255;
    const float* convw = F.in[IN_AB_CONV];
    const float* db = (const float*)(F.ws + WS_DB);
    const float a_neg = -__expf(F.in[IN_AB_ALOG][h]), dtb = F.in[IN_AB_DTB][h];
    const float* onorm = F.in[IN_AB_ONORM];
    float cw[3][4][2];
#pragma unroll
    for (int sct = 0; sct < 3; ++sct)
#pragma unroll
        for (int j = 0; j < 4; ++j) { cw[sct][j][0] = convw[j * 1536 + sct * 512 + h * 128 + 2 * lane0]; cw[sct][j][1] = convw[j * 1536 + sct * 512 + h * 128 + 2 * lane0 + 1]; }
    for (int i = w * 64 + lane0; i < (128 * 136 + 64 * 72 * 2 + 128 * 72) / 2; i += NTHREADS) ((LAS unsigned*)St)[i] = 0u;
    unsigned pacc = 0u, plast = 0u;
    f32x4 sacc[8];
#pragma unroll
    for (int i = 0; i < 8; ++i) sacc[i] = (f32x4){0.f, 0.f, 0.f, 0.f};
    __syncthreads();
    unsigned rawu[3][11]; float dbv0, dbv1;
#define DELTA_FETCH(cc, ln) do { const int cc_ = (cc) < 32 ? (cc) : 31; \
        dbv0 = db[(size_t)(b * TS + cc_ * 64 + (ln)) * 8 + h]; dbv1 = db[(size_t)(b * TS + cc_ * 64 + (ln)) * 8 + 4 + h]; \
        _Pragma("unroll") for (int rr = 0; rr < 11; ++rr) { const int tl = cc_ * 64 + 8 * w - 3 + rr; \
            const unsigned* row = (const unsigned*)(P + (size_t)(b * TS + (tl >= 0 ? tl : 0)) * P0LD + h * 128) + (ln); \
            _Pragma("unroll") for (int sct = 0; sct < 3; ++sct) rawu[sct][rr] = row[sct * 256]; } } while (0)
    DELTA_FETCH(jpart, lane0);
    for (int c = jpart; c < 32; c += kparts) {
        int lane = lane0; asm volatile("" : "+v"(lane));
        const int fr = lane & 15, fq = lane >> 4;
        const int t0 = b * TS + c * 64;
        if (PROBE_STAGE >= 0) plast = (unsigned)__builtin_amdgcn_s_memrealtime();
        unsigned gq[8];
#pragma unroll
        for (int i = 0; i < 8; ++i) gq[i] = *((const unsigned*)(P + (size_t)(t0 + w + 8 * i) * P0LD + 1536 + h * 128) + lane);
        {
            const float la = a_neg * softplusf_(dbv0 + dtb);
            const float bet = sigmoidf_(dbv1);
            float g = la;
#pragma unroll
            for (int o = 1; o < 64; o <<= 1) { const float n = __shfl_up(g, o); if (lane >= o) g += n; }
            const float gL = rdlane(g, 63);
            if (w == 0) { sc[lane] = g; sc[64 + lane] = __expf(g); sc[128 + lane] = bet * __expf(g); sc[192 + lane] = bet; if (lane == 0) sc[256] = __expf(gL); }
            float raw[3][11][2];
#pragma unroll
            for (int rr = 0; rr < 11; ++rr) { const bool ok = (c * 64 + 8 * w - 3 + rr) >= 0;
#pragma unroll
                for (int sct = 0; sct < 3; ++sct) { raw[sct][rr][0] = ok ? bf2f((unsigned short)(rawu[sct][rr] & 0xffffu)) : 0.f; raw[sct][rr][1] = ok ? bf2f((unsigned short)(rawu[sct][rr] >> 16)) : 0.f; } }
            DELTA_FETCH(c + kparts, lane);
            float kd0[8], kd1[8], vt0[8], vt1[8];
#pragma unroll
            for (int i = 0; i < 8; ++i) {
                const int t = 8 * w + i;
                float x[3][2];
#pragma unroll
                for (int sct = 0; sct < 3; ++sct) { float a0 = 0.f, a1 = 0.f;
#pragma unroll
                    for (int j = 0; j < 4; ++j) { a0 += cw[sct][j][0] * raw[sct][i + j][0]; a1 += cw[sct][j][1] * raw[sct][i + j][1]; }
                    x[sct][0] = siluf_(a0); x[sct][1] = siluf_(a1); }
                const float sq = wsum(x[0][0] * x[0][0] + x[0][1] * x[0][1]), sk = wsum(x[1][0] * x[1][0] + x[1][1] * x[1][1]);
                const float cq = (1.0f / sqrtf(sq + 1e-6f)) * 0.08838834764831845f, ck = 1.0f / sqrtf(sk + 1e-6f);
                const float egr = __expf(gL - rdlane(g, t));
                *(LAS unsigned*)(Qb + t * 136 + 2 * lane) = pk2(x[0][0] * cq, x[0][1] * cq);
                const float k0 = x[1][0] * ck, k1 = x[1][1] * ck;
                *(LAS unsigned*)(Kb + t * 136 + 2 * lane) = pk2(k0, k1);
                kd0[i] = k0 * egr; kd1[i] = k1 * egr; vt0[i] = x[2][0]; vt1[i] = x[2][1];
            }
            *(LAS u32x4*)(Kdt + (2 * lane) * 72 + 8 * w) = (u32x4){pk2(kd0[0], kd0[1]), pk2(kd0[2], kd0[3]), pk2(kd0[4], kd0[5]), pk2(kd0[6], kd0[7])};
            *(LAS u32x4*)(Kdt + (2 * lane + 1) * 72 + 8 * w) = (u32x4){pk2(kd1[0], kd1[1]), pk2(kd1[2], kd1[3]), pk2(kd1[4], kd1[5]), pk2(kd1[6], kd1[7])};
            *(LAS u32x4*)(Vt + (2 * lane) * 72 + 8 * w) = (u32x4){pk2(vt0[0], vt0[1]), pk2(vt0[2], vt0[3]), pk2(vt0[4], vt0[5]), pk2(vt0[6], vt0[7])};
            *(LAS u32x4*)(Vt + (2 * lane + 1) * 72 + 8 * w) = (u32x4){pk2(vt1[0], vt1[1]), pk2(vt1[2], vt1[3]), pk2(vt1[4], vt1[5]), pk2(vt1[6], vt1[7])};
        }
        __syncthreads();
        if (PROBE_STAGE >= 0) { const unsigned tn = (unsigned)__builtin_amdgcn_s_memrealtime(); if (PROBE_STAGE == 0) pacc += tn - plast; plast = tn; }
        {
            for (int id = w; id < 20; id += NWAVES) {
                const int which = id / 10, tix = id % 10;
                const int bi = (tix < 1) ? 0 : (tix < 3 ? 1 : (tix < 6 ? 2 : 3)); const int bj = tix - (bi * (bi + 1)) / 2;
                f32x4 acc = {0.f, 0.f, 0.f, 0.f};
                acc = mm_tile(Kb + bj * 16 * 136, 136, (which ? Qb : Kb) + bi * 16 * 136, 136, 4, acc, fr, fq);
                const int i = 16 * bi + fr; const float gi = sc[i], bi_ = sc[192 + i];
                const float av[4] = {acc.x, acc.y, acc.z, acc.w}; float ov[4];
#pragma unroll
                for (int rg = 0; rg < 4; ++rg) { const int j = 16 * bj + 4 * fq + rg; const float dec = __expf(gi - sc[j]);
                    ov[rg] = which ? ((j <= i) ? av[rg] * dec : 0.f) : ((j < i) ? bi_ * av[rg] * dec : 0.f); }
                if (which) lds_w4(QKm + i * 72 + 16 * bj + 4 * fq, (f32x4){ov[0], ov[1], ov[2], ov[3]});
                else if (bi == bj) { LAS float* d = Adg + (bi * 16 + fr) * 17 + 4 * fq; d[0] = ov[0]; d[1] = ov[1]; d[2] = ov[2]; d[3] = ov[3]; }
                else lds_w4(Aoff + i * 72 + 16 * bj + 4 * fq, (f32x4){-ov[0], -ov[1], -ov[2], -ov[3]});
            }
        }
        __syncthreads();
        if (PROBE_STAGE >= 0) { const unsigned tn = (unsigned)__builtin_amdgcn_s_memrealtime(); if (PROBE_STAGE == 1) pacc += tn - plast; plast = tn; }
        f32x4 y[4], qs[4];
        if (w < 4 && lane < 16) { float x[16]; const LAS float* a = Adg + w * 16 * 17;
#pragma unroll
            for (int i = 0; i < 16; ++i) { float v = (i == lane) ? 1.f : 0.f;
#pragma unroll
                for (int k = 0; k < i; ++k) v -= a[i * 17 + k] * x[k];
                x[i] = v; Dg[(w * 16 + i) * 24 + lane] = (bf16_t)f2bf(v); } }
        if (c > 0) ho_wait(flag, (unsigned)c, tmo, w, lane); else __syncthreads();
#pragma unroll
        for (int dk = 0; dk < 8; dk += 2) {
            const u32x4 ldv = __builtin_bit_cast(u32x4, ho_load(hb, (unsigned)(((w * 64 + lane) * 4 + (dk >> 1)) * 16)));
            const f32x4 z0 = {bf2f((unsigned short)(ldv.x & 0xffffu)), bf2f((unsigned short)(ldv.x >> 16)), bf2f((unsigned short)(ldv.y & 0xffffu)), bf2f((unsigned short)(ldv.y >> 16))};
            const f32x4 z1 = {bf2f((unsigned short)(ldv.z & 0xffffu)), bf2f((unsigned short)(ldv.z >> 16)), bf2f((unsigned short)(ldv.w & 0xffffu)), bf2f((unsigned short)(ldv.w >> 16))};
            sacc[dk] = (c > 0) ? z0 : (f32x4){0.f, 0.f, 0.f, 0.f}; sacc[dk + 1] = (c > 0) ? z1 : (f32x4){0.f, 0.f, 0.f, 0.f}; }
#pragma unroll
        for (int dk = 0; dk < 8; ++dk) {
            lds_w4(St + (16 * w + fr) * 136 + 16 * dk + 4 * fq, sacc[dk]); }
        asm volatile("s_waitcnt lgkmcnt(0)" ::: "memory");
        {
            const LAS bf16_t* Sw = St + (16 * w) * 136;
#pragma unroll
            for (int mi = 0; mi < 4; ++mi) {
                f32x4 x = mm_tile(Kb + mi * 16 * 136, 136, Sw, 136, 4, (f32x4){0.f, 0.f, 0.f, 0.f}, fr, fq);
                qs[mi] = mm_tile(Qb + mi * 16 * 136, 136, Sw, 136, 4, (f32x4){0.f, 0.f, 0.f, 0.f}, fr, fq);
                const bf16x4 vv = *(const LAS bf16x4*)(Vt + (16 * w + fr) * 72 + 16 * mi + 4 * fq);
                const f32x4 be4 = *(const LAS f32x4*)(sc + 192 + 16 * mi + 4 * fq), bg4 = *(const LAS f32x4*)(sc + 128 + 16 * mi + 4 * fq);
                y[mi].x = be4.x * bf2f((unsigned short)vv.x) - bg4.x * x.x; y[mi].y = be4.y * bf2f((unsigned short)vv.y) - bg4.y * x.y;
                y[mi].z = be4.z * bf2f((unsigned short)vv.z) - bg4.z * x.z; y[mi].w = be4.w * bf2f((unsigned short)vv.w) - bg4.w * x.w;
            }
        }
        __syncthreads();
        if (PROBE_STAGE >= 0) { const unsigned tn = (unsigned)__builtin_amdgcn_s_memrealtime(); if (PROBE_STAGE == 2) pacc += tn - plast; plast = tn; }
        {
            LAS bf16_t* Vw = Vn + (16 * w) * 72;
#pragma unroll
            for (int bb = 0; bb < 4; ++bb) {
                f32x4 acc = y[bb];
                if (bb >= 1) acc = mm_tile(Aoff + bb * 16 * 72, 72, Vw, 72, (bb + 1) / 2, acc, fr, fq);
                u32x2 pk; pk.x = pk2(acc.x, acc.y); pk.y = pk2(acc.z, acc.w);
                const bf16x4 dgf = *(const LAS bf16x4*)(Dg + (bb * 16 + fr) * 24 + 4 * fq);
                const f32x4 vb = MFMA16(dgf, __builtin_bit_cast(bf16x4, pk), ((f32x4){0.f, 0.f, 0.f, 0.f}));
                lds_w4(Vw + fr * 72 + 16 * bb + 4 * fq, vb);
                asm volatile("s_waitcnt lgkmcnt(0)" ::: "memory");
            }
            const float gl = sc[256];
#pragma unroll
            for (int mi = 0; mi < 4; ++mi) {
                const f32x4 eg4 = *(const LAS f32x4*)(sc + 64 + 16 * mi + 4 * fq);
                f32x4 o = qs[mi] * eg4;
                o = mm_tile(QKm + mi * 16 * 72, 72, Vw, 72, 2, o, fr, fq);
                qs[mi] = o;
            }
#pragma unroll
            for (int dk = 0; dk < 8; ++dk) {
                f32x4 sn = sacc[dk] * gl;
                sn = mm_tile(Kdt + dk * 16 * 72, 72, Vw, 72, 2, sn, fr, fq);
                sacc[dk] = sn;
                lds_w4(St + (16 * w + fr) * 136 + 16 * dk + 4 * fq, sn);
            }
        }
        if (c < 31) {
#pragma unroll
            for (int dk = 0; dk < 8; dk += 2) { u32x4 pv; pv.x = pk2(sacc[dk].x, sacc[dk].y); pv.y = pk2(sacc[dk].z, sacc[dk].w); pv.z = pk2(sacc[dk + 1].x, sacc[dk + 1].y); pv.w = pk2(sacc[dk + 1].z, sacc[dk + 1].w);
                ho_store(hb, (unsigned)(((w * 64 + lane) * 4 + (dk >> 1)) * 16), __builtin_bit_cast(f32x4, pv)); }
            asm volatile("s_waitcnt vmcnt(0)" ::: "memory");
        }
        __syncthreads();
        if (c < 31 && w == 0 && lane == 0) __hip_atomic_store(flag, (unsigned)(c + 1), __ATOMIC_RELAXED, __HIP_MEMORY_SCOPE_AGENT);
        if (PROBE_STAGE >= 0) { const unsigned tn = (unsigned)__builtin_amdgcn_s_memrealtime(); if (PROBE_STAGE == 3) pacc += tn - plast; plast = tn; }
#pragma unroll
        for (int mi = 0; mi < 4; ++mi) { LAS float* op = Of + (16 * mi + 4 * fq) * 132 + 16 * w + fr; op[0] = qs[mi].x; op[132] = qs[mi].y; op[264] = qs[mi].z; op[396] = qs[mi].w; }
        __syncthreads();
        if (PROBE_STAGE >= 0) { const unsigned tn = (unsigned)__builtin_amdgcn_s_memrealtime(); if (PROBE_STAGE == 4) pacc += tn - plast; plast = tn; }
        const float on0 = onorm[2 * lane], on1 = onorm[2 * lane + 1];
#pragma unroll
        for (int i = 0; i < 8; ++i) {
            const int t = w + 8 * i;
            const f32x2 ov = *(const LAS f32x2*)(Of + t * 132 + 2 * lane); const float o0 = ov.x, o1 = ov.y;
            const float ss = wsum(o0 * o0 + o1 * o1), rs = 1.0f / sqrtf(ss * (1.0f / 128.0f) + 1e-6f);
            const float g0 = bf2f((unsigned short)(gq[i] & 0xffffu)), g1 = bf2f((unsigned short)(gq[i] >> 16));
            *((unsigned*)(P + (size_t)(t0 + t) * P0LD + 1536 + h * 128) + lane) = pk2(o0 * rs * on0 * siluf_(g0), o1 * rs * on1 * siluf_(g1));
        }
        __syncthreads();
        if (PROBE_STAGE >= 0) { const unsigned tn = (unsigned)__builtin_amdgcn_s_memrealtime(); if (PROBE_STAGE == 5) pacc += tn - plast; plast = tn; }
    }
    if (PROBE_STAGE >= 0 && F.wg == 0 && w == 0 && lane0 == 0) __hip_atomic_store((unsigned*)(F.ws + WS_CTL + 20484), pacc, __ATOMIC_RELAXED, __HIP_MEMORY_SCOPE_AGENT);
}

__device__ __forceinline__ void scan_hgrn3(const Frame& F, int b, int h, int jpart, int kparts) {
    const int lane0 = lane_id_v(); const int w = F.wave;
    LAS bf16_t* Qd = (LAS bf16_t*)F.lds;
    LAS bf16_t* Kp = Qd + 64 * 136;
    LAS bf16_t* Kpt = Kp + 64 * 136;
    LAS bf16_t* Vt = Kpt + 128 * 72;
    LAS bf16_t* Sc = Vt + 128 * 72;
    LAS bf16_t* Zt = Sc + 64 * 72;
    LAS float* Of = (LAS float*)(Zt + 128 * 136);
    LAS float* gl = Of + 64 * 132;
    LAS float* seg = gl + 128;
    static_assert((64 * 136 * 2 * 2 + 128 * 72 * 2 * 2 + 64 * 72 * 2 + 128 * 136 * 2 + 64 * 132 * 4 + 128 * 4 + 512 * 4) <= LDS_MISC, "hgrn3 LDS");
    bf16_t* P = (bf16_t*)(F.ws + WS_BIG + BIG_PROJ);
    const HoBuf hb = ho_buf((float*)(F.ws + WS_HOC) + (size_t)(b * 8 + h) * 16384, 65536);
    unsigned* flag = (unsigned*)(F.ws + WS_FLAGS) + 96 + (b * 8 + h); unsigned* tmo = (unsigned*)(F.ws + WS_FLAGS) + 255;
    const float* onorm = F.in[IN_C_ONORM];
    for (int i = w * 64 + lane0; i < (64 * 72 + 128 * 136) / 2; i += NTHREADS) ((LAS unsigned*)Sc)[i] = 0u;
    f32x4 zacc[8];
#pragma unroll
    for (int i = 0; i < 8; ++i) zacc[i] = (f32x4){0.f, 0.f, 0.f, 0.f};
    __syncthreads();
    for (int c = jpart; c < 32; c += kparts) {
        int lane = lane0; asm volatile("" : "+v"(lane));
        const int tid = w * 64 + lane, fr = lane & 15, fq = lane >> 4, d = tid & 127, sg = tid >> 7;
        const int t0 = b * TS + c * 64;
        {
            float G[16], q[16], v[16], lf[16];
            const bf16_t* pr = P + (size_t)(t0 + 16 * sg) * P1LD + h * 128 + d;
#pragma unroll
            for (int i = 0; i < 16; ++i) { q[i] = bf2f(pr[(size_t)i * P1LD]); lf[i] = h2f_bits(pr[(size_t)i * P1LD + 1024]); v[i] = bf2f(pr[(size_t)i * P1LD + 2048]); }
            float run = 0.f;
#pragma unroll
            for (int i = 0; i < 16; ++i) { run += lf[i]; G[i] = run; }
            seg[sg * 128 + d] = run;
            __syncthreads();
            float off = 0.f;
#pragma unroll
            for (int s2 = 0; s2 < 3; ++s2) if (s2 < sg) off += seg[s2 * 128 + d];
            float kpv[16];
#pragma unroll
            for (int i = 0; i < 16; ++i) {
                const int t = 16 * sg + i; const float Gt = off + G[i];
                const float qd = q[i] * __expf(Gt); kpv[i] = -expm1f(lf[i]) * __expf(fminf(-Gt, 80.f));
                Qd[t * 136 + d] = (bf16_t)f2bf(qd); Kp[t * 136 + d] = (bf16_t)f2bf(kpv[i]);
            }
            *(LAS u32x4*)(Kpt + d * 72 + 16 * sg) = (u32x4){pk2(kpv[0], kpv[1]), pk2(kpv[2], kpv[3]), pk2(kpv[4], kpv[5]), pk2(kpv[6], kpv[7])};
            *(LAS u32x4*)(Kpt + d * 72 + 16 * sg + 8) = (u32x4){pk2(kpv[8], kpv[9]), pk2(kpv[10], kpv[11]), pk2(kpv[12], kpv[13]), pk2(kpv[14], kpv[15])};
            *(LAS u32x4*)(Vt + d * 72 + 16 * sg) = (u32x4){pk2(v[0], v[1]), pk2(v[2], v[3]), pk2(v[4], v[5]), pk2(v[6], v[7])};
            *(LAS u32x4*)(Vt + d * 72 + 16 * sg + 8) = (u32x4){pk2(v[8], v[9]), pk2(v[10], v[11]), pk2(v[12], v[13]), pk2(v[14], v[15])};
            if (sg == 3) gl[d] = __expf(off + G[15]);
        }
        __syncthreads();
        for (int id = w; id < 10; id += NWAVES) {
            const int bi = (id < 1) ? 0 : (id < 3 ? 1 : (id < 6 ? 2 : 3)); const int bj = id - (bi * (bi + 1)) / 2;
            const f32x4 acc = mm_tile(Kp + bj * 16 * 136, 136, Qd + bi * 16 * 136, 136, 4, (f32x4){0.f, 0.f, 0.f, 0.f}, fr, fq);
            const int i = 16 * bi + fr, j0 = 16 * bj + 4 * fq;
            lds_w4(Sc + i * 72 + j0, (f32x4){(j0 <= i) ? acc.x : 0.f, (j0 + 1 <= i) ? acc.y : 0.f, (j0 + 2 <= i) ? acc.z : 0.f, (j0 + 3 <= i) ? acc.w : 0.f});
        }
        __syncthreads();
        if (c > 0) ho_wait(flag, (unsigned)c, tmo, w, lane);
#pragma unroll
        for (int dk = 0; dk < 8; dk += 2) {
            const u32x4 ldv = __builtin_bit_cast(u32x4, ho_load(hb, (unsigned)(((w * 64 + lane) * 4 + (dk >> 1)) * 16)));
            const f32x4 z0 = {bf2f((unsigned short)(ldv.x & 0xffffu)), bf2f((unsigned short)(ldv.x >> 16)), bf2f((unsigned short)(ldv.y & 0xffffu)), bf2f((unsigned short)(ldv.y >> 16))};
            const f32x4 z1 = {bf2f((unsigned short)(ldv.z & 0xffffu)), bf2f((unsigned short)(ldv.z >> 16)), bf2f((unsigned short)(ldv.w & 0xffffu)), bf2f((unsigned short)(ldv.w >> 16))};
            zacc[dk] = (c > 0) ? z0 : (f32x4){0.f, 0.f, 0.f, 0.f}; zacc[dk + 1] = (c > 0) ? z1 : (f32x4){0.f, 0.f, 0.f, 0.f}; }
#pragma unroll
        for (int dk = 0; dk < 8; ++dk) {
            lds_w4(Zt + (16 * w + fr) * 136 + 16 * dk + 4 * fq, zacc[dk]); }
        asm volatile("s_waitcnt lgkmcnt(0)" ::: "memory");
        {
            const LAS bf16_t* Vw = Vt + (16 * w) * 72; const LAS bf16_t* Zw = Zt + (16 * w) * 136;
#pragma unroll
            for (int mi = 0; mi < 4; ++mi) {
                f32x4 o = mm_tile(Sc + mi * 16 * 72, 72, Vw, 72, 2, (f32x4){0.f, 0.f, 0.f, 0.f}, fr, fq);
                o = mm_tile(Qd + mi * 16 * 136, 136, Zw, 136, 4, o, fr, fq);
                LAS float* op = Of + (16 * mi + 4 * fq) * 132 + 16 * w + fr; op[0] = o.x; op[132] = o.y; op[264] = o.z; op[396] = o.w;
            }
            asm volatile("s_waitcnt lgkmcnt(0)" ::: "memory");
#pragma unroll
            for (int dk = 0; dk < 8; ++dk) {
                f32x4 zn = mm_tile(Kpt + dk * 16 * 72, 72, Vw, 72, 2, zacc[dk], fr, fq);
                const f32x4 g4 = *(const LAS f32x4*)(gl + 16 * dk + 4 * fq);
                zn = zn * g4; zacc[dk] = zn;
                lds_w4(Zt + (16 * w + fr) * 136 + 16 * dk + 4 * fq, zn);
            }
        }
        if (c < 31) {
#pragma unroll
            for (int dk = 0; dk < 8; dk += 2) { u32x4 pv; pv.x = pk2(zacc[dk].x, zacc[dk].y); pv.y = pk2(zacc[dk].z, zacc[dk].w); pv.z = pk2(zacc[dk + 1].x, zacc[dk + 1].y); pv.w = pk2(zacc[dk + 1].z, zacc[dk + 1].w);
                ho_store(hb, (unsigned)(((w * 64 + lane) * 4 + (dk >> 1)) * 16), __builtin_bit_cast(f32x4, pv)); }
            asm volatile("s_waitcnt vmcnt(0)" ::: "memory");
        }
        __syncthreads();
        if (c < 31 && w == 0 && lane == 0) __hip_atomic_store(flag, (unsigned)(c + 1), __ATOMIC_RELAXED, __HIP_MEMORY_SCOPE_AGENT);
        for (int t = w; t < 64; t += NWAVES) {
            const float o0 = Of[t * 132 + lane], o1 = Of[t * 132 + lane + 64];
            const float ss = wsum(o0 * o0 + o1 * o1), rs = 1.0f / sqrtf(ss * (1.0f / 128.0f) + 1e-6f);
            bf16_t* gp = P + (size_t)(t0 + t) * P1LD + 3072 + h * 128;
            const float g0 = bf2f(gp[lane]), g1 = bf2f(gp[lane + 64]);
            gp[lane] = (bf16_t)f2bf(o0 * rs * onorm[lane] * siluf_(g0)); gp[lane + 64] = (bf16_t)f2bf(o1 * rs * onorm[lane + 64] * siluf_(g1));
        }
    }
}

__device__ __forceinline__ float tanh_fast(float x) { const float e = __expf(2.f * x); return 1.f - 2.f / (1.f + e); }
struct RwkvLd { u32x4 cu, pv; };
__device__ __forceinline__ RwkvLd rwkv_ld8(const bf16_t* Pc, int t, int gc, const bf16_t* hal) {
    const bf16_t* src = Pc + (size_t)t * P0LD + gc; const bf16_t* psrc = (t > 0) ? src - P0LD : hal + (gc - 2048);
    RwkvLd r; r.cu = *(const u32x4*)src; r.pv = *(const u32x4*)psrc; return r;
}
__device__ __forceinline__ void rwkv_sh8(const RwkvLd& ld, int t, int gc, bool first_zero, const float* mu, float (&sh)[8]) {
    const f32x4 m0 = *(const f32x4*)(mu + gc - 2048), m1 = *(const f32x4*)(mu + gc - 2048 + 4);
    const unsigned cw_[4] = {ld.cu.x, ld.cu.y, ld.cu.z, ld.cu.w}, pw_[4] = {ld.pv.x, ld.pv.y, ld.pv.z, ld.pv.w};
    const float mv[8] = {m0.x, m0.y, m0.z, m0.w, m1.x, m1.y, m1.z, m1.w};
    float cur[8];
#pragma unroll
    for (int e = 0; e < 8; ++e) {
        cur[e] = bf2f((unsigned short)((e & 1) ? (cw_[e >> 1] >> 16) : (cw_[e >> 1] & 0xffffu)));
        const float pg = bf2f((unsigned short)((e & 1) ? (pw_[e >> 1] >> 16) : (pw_[e >> 1] & 0xffffu)));
        const float prv = (t == 0 && first_zero) ? 0.f : pg;
        sh[e] = cur[e] + mv[e] * (prv - cur[e]);
    }
}
__device__ __forceinline__ void scan_rwkv3(const Frame& F, int b, int h, int par) {
    const int lane0 = lane_id_v(); const int w = F.wave;
    LAS unsigned char* L = F.lds;
    LAS bf16_t* RPb = (LAS bf16_t*)(L + 0);
    LAS bf16_t* KPb = (LAS bf16_t*)(L + 9216);
    LAS float* LWf = (LAS float*)(L + 18432);
    LAS float* Af = (LAS float*)(L + 34816);
    LAS float* segs = (LAS float*)(L + 51200);
    LAS bf16_t* Mak = (LAS bf16_t*)(L + 0);
    LAS bf16_t* Mrk = (LAS bf16_t*)(L + 9216);
    LAS bf16_t* Mrbn = (LAS bf16_t*)(L + 18432);
    LAS bf16_t* Aoff = (LAS bf16_t*)(L + 27648);
    LAS float* Adg = (LAS float*)(L + 36864);
    LAS bf16_t* Dg = (LAS bf16_t*)(L + 41216);
    LAS bf16_t* GB = (LAS bf16_t*)(L + 44288);
    LAS bf16_t* TL = (LAS bf16_t*)(L + 65536);
    LAS bf16_t* AL = (LAS bf16_t*)(L + 65536 + 9216);
    LAS bf16_t* SG = (LAS bf16_t*)(L + 65536 + 18432);
    LAS bf16_t* At = (LAS bf16_t*)(L + 65536);
    LAS bf16_t* Btl = (LAS bf16_t*)(L + 65536 + 9216);
    LAS bf16_t* Ktl = (LAS bf16_t*)(L + 65536 + 18432);
    LAS bf16_t* Rtl = (LAS bf16_t*)(L + 65536 + 27648);
    LAS float* Of = (LAS float*)(L + 65536);
    LAS bf16_t* BtTn = (LAS bf16_t*)(L + 102400);
    LAS bf16_t* KtT = (LAS bf16_t*)(L + 111616);
    LAS bf16_t* Vt = (LAS bf16_t*)(L + 120832);
    LAS bf16_t* Zt = (LAS bf16_t*)(L + 130048);
    LAS bf16_t* PU = (LAS bf16_t*)(L + 139264);
    LAS float* bonus = (LAS float*)(L + 148480);
    LAS float* glv = bonus + 64;
    static_assert(148480 + 4096 <= LDS_MISC, "rwkv3 LDS");
    bf16_t* P = (bf16_t*)(F.ws + WS_BIG + BIG_PROJ);
    const bf16_t* LW = (const bf16_t*)(F.ws + WS_LORA);
    const bf16_t* HALO = (const bf16_t*)(F.ws + WS_HALOB);
    const HoBuf hb = ho_buf((float*)(F.ws + WS_HOB) + (size_t)(b * 8 + h) * 4096, 16384);
    unsigned* flag = (unsigned*)(F.ws + WS_FLAGS) + (b * 8 + h); unsigned* tmo = (unsigned*)(F.ws + WS_FLAGS) + 255;
    const float* mu = F.in[IN_AB_MU];
    const float kkj = F.in[IN_AB_KK][h * 64 + lane0], kaj = F.in[IN_AB_KA][h * 64 + lane0], rkj = F.in[IN_AB_RK][h * 64 + lane0];
    const float lnw = F.in[IN_AB_LNW][h * 64 + lane0], lnb = F.in[IN_AB_LNB][h * 64 + lane0];
    float w0q[2], a0q[2];
#pragma unroll
    for (int q = 0; q < 2; ++q) { const int jq = ((2 * w + q) & 3) * 16 + (lane0 & 15); w0q[q] = F.in[IN_AB_W0][h * 64 + jq]; a0q[q] = F.in[IN_AB_A0][h * 64 + jq]; }
    bf16x8 yw[2][2], ya[2][2], yg[2][4];
#pragma unroll
    for (int q = 0; q < 2; ++q) { const int jrow = h * 64 + ((2 * w + q) & 3) * 16 + (lane0 & 15), fq0 = lane0 >> 4;
#pragma unroll
        for (int ksx = 0; ksx < 2; ++ksx) { yw[q][ksx] = *(const bf16x8*)(LW + (size_t)jrow * 64 + ksx * 32 + fq0 * 8); ya[q][ksx] = *(const bf16x8*)(LW + 512 * 64 + (size_t)jrow * 64 + ksx * 32 + fq0 * 8); }
#pragma unroll
        for (int ksx = 0; ksx < 4; ++ksx) yg[q][ksx] = *(const bf16x8*)(LW + 2 * 512 * 64 + (size_t)jrow * 128 + ksx * 32 + fq0 * 8); }
    f32x4 zacc[4];
#pragma unroll
    for (int i = 0; i < 4; ++i) zacc[i] = (f32x4){0.f, 0.f, 0.f, 0.f};
    for (int i = w * 64 + lane0; i < (64 * 72 * 2) / 2; i += NTHREADS) ((LAS unsigned*)Zt)[i] = 0u;
    __syncthreads();
    for (int c = par; c < 32; c += 2) {
        int lane = lane0; asm volatile("" : "+v"(lane));
        const int tid = w * 64 + lane, fr = lane & 15, fq = lane >> 4;
        const int t0 = b * TS + c * 64;
        {
            const bf16_t* Pc = P + (size_t)t0 * P0LD; const bf16_t* hal = HALO + (size_t)(b * 32 + (c > 0 ? c - 1 : 0)) * 1792; const bool fz = (c == 0);
            const int t_a0 = tid >> 4, cg_a0 = tid & 15, t_a1 = (tid + NTHREADS) >> 4, cg_a1 = (tid + NTHREADS) & 15, t_b = tid >> 3, cg_b = tid & 7;
            const int gc0 = ((cg_a0 < 8) ? 2048 : 2560) + h * 64 + (cg_a0 & 7) * 8, gc1 = ((cg_a1 < 8) ? 2048 : 2560) + h * 64 + (cg_a1 & 7) * 8;
            const int gc2 = 3584 + cg_b * 8, gc3 = 3648 + cg_b * 8, gc4 = 3712 + cg_a0 * 8, gc5 = 3712 + cg_a1 * 8;
            const RwkvLd l0 = rwkv_ld8(Pc, t_a0, gc0, hal), l1 = rwkv_ld8(Pc, t_a1, gc1, hal), l2 = rwkv_ld8(Pc, t_b, gc2, hal), l3 = rwkv_ld8(Pc, t_b, gc3, hal), l4 = rwkv_ld8(Pc, t_a0, gc4, hal), l5 = rwkv_ld8(Pc, t_a1, gc5, hal);
            const int vcol = tid & 63, vtg = tid >> 6;
            const bf16_t* vsrc = Pc + (size_t)(8 * vtg) * P0LD + 3072 + h * 64 + vcol;
            unsigned short vr[9];
#pragma unroll
            for (int i = 0; i < 8; ++i) vr[i + 1] = vsrc[(size_t)i * P0LD];
            vr[0] = *((vtg > 0) ? vsrc - P0LD : hal + 1024 + h * 64 + vcol);
            float sh[8];
            { rwkv_sh8(l0, t_a0, gc0, fz, mu, sh);
              *(LAS u32x4*)((cg_a0 < 8 ? RPb : KPb) + t_a0 * 72 + (cg_a0 & 7) * 8) = (u32x4){pk2(sh[0], sh[1]), pk2(sh[2], sh[3]), pk2(sh[4], sh[5]), pk2(sh[6], sh[7])}; }
            { rwkv_sh8(l1, t_a1, gc1, fz, mu, sh);
              *(LAS u32x4*)((cg_a1 < 8 ? RPb : KPb) + t_a1 * 72 + (cg_a1 & 7) * 8) = (u32x4){pk2(sh[0], sh[1]), pk2(sh[2], sh[3]), pk2(sh[4], sh[5]), pk2(sh[6], sh[7])}; }
            { rwkv_sh8(l2, t_b, gc2, fz, mu, sh);
              *(LAS u32x4*)(TL + t_b * 72 + cg_b * 8) = (u32x4){pk2(tanh_fast(sh[0]), tanh_fast(sh[1])), pk2(tanh_fast(sh[2]), tanh_fast(sh[3])), pk2(tanh_fast(sh[4]), tanh_fast(sh[5])), pk2(tanh_fast(sh[6]), tanh_fast(sh[7]))}; }
            { rwkv_sh8(l3, t_b, gc3, fz, mu, sh);
              *(LAS u32x4*)(AL + t_b * 72 + cg_b * 8) = (u32x4){pk2(sh[0], sh[1]), pk2(sh[2], sh[3]), pk2(sh[4], sh[5]), pk2(sh[6], sh[7])}; }
            { rwkv_sh8(l4, t_a0, gc4, fz, mu, sh);
              *(LAS u32x4*)(SG + t_a0 * 136 + cg_a0 * 8) = (u32x4){pk2(sigmoidf_(sh[0]), sigmoidf_(sh[1])), pk2(sigmoidf_(sh[2]), sigmoidf_(sh[3])), pk2(sigmoidf_(sh[4]), sigmoidf_(sh[5])), pk2(sigmoidf_(sh[6]), sigmoidf_(sh[7]))}; }
            { rwkv_sh8(l5, t_a1, gc5, fz, mu, sh);
              *(LAS u32x4*)(SG + t_a1 * 136 + cg_a1 * 8) = (u32x4){pk2(sigmoidf_(sh[0]), sigmoidf_(sh[1])), pk2(sigmoidf_(sh[2]), sigmoidf_(sh[3])), pk2(sigmoidf_(sh[4]), sigmoidf_(sh[5])), pk2(sigmoidf_(sh[6]), sigmoidf_(sh[7]))}; }
            {
                float cur[9];
#pragma unroll
                for (int i = 0; i < 9; ++i) cur[i] = bf2f(vr[i]);
                if (vtg == 0 && fz) cur[0] = 0.f;
                const float mvc = mu[1024 + h * 64 + vcol];
                float shv[8];
#pragma unroll
                for (int i = 0; i < 8; ++i) shv[i] = cur[i + 1] + mvc * (cur[i] - cur[i + 1]);
                *(LAS u32x4*)(Vt + vcol * 72 + 8 * vtg) = (u32x4){pk2(shv[0], shv[1]), pk2(shv[2], shv[3]), pk2(shv[4], shv[5]), pk2(shv[6], shv[7])};
            }
        }
        __syncthreads();
        f32x4 agate[2];
        {
#pragma unroll
            for (int q = 0; q < 2; ++q) {
                const int id = 2 * w + q, mi = id >> 2, nj = id & 3;
                f32x4 aw = {0.f, 0.f, 0.f, 0.f}, aa = {0.f, 0.f, 0.f, 0.f}, ag = {0.f, 0.f, 0.f, 0.f};
#pragma unroll
                for (int ksx = 0; ksx < 2; ++ksx) {
                    const bf16x8 x1 = *(const LAS bf16x8*)(TL + (mi * 16 + fr) * 72 + ksx * 32 + fq * 8), x2 = *(const LAS bf16x8*)(AL + (mi * 16 + fr) * 72 + ksx * 32 + fq * 8);
                    aw = MFMA32(x1, yw[q][ksx], aw); aa = MFMA32(x2, ya[q][ksx], aa);
                }
#pragma unroll
                for (int ksx = 0; ksx < 4; ++ksx) {
                    const bf16x8 x3 = *(const LAS bf16x8*)(SG + (mi * 16 + fr) * 136 + ksx * 32 + fq * 8);
                    ag = MFMA32(x3, yg[q][ksx], ag);
                }
                agate[q] = ag;
                const int j = nj * 16 + fr; const float w0j = w0q[q], a0j = a0q[q];
                const float awv[4] = {aw.x, aw.y, aw.z, aw.w}, aav[4] = {aa.x, aa.y, aa.z, aa.w};
#pragma unroll
                for (int rg = 0; rg < 4; ++rg) { const int t = mi * 16 + 4 * fq + rg;
                    LWf[t * 64 + j] = -0.6065306597126334f * sigmoidf_(w0j + awv[rg]); Af[t * 64 + j] = sigmoidf_(a0j + aav[rg]); }
            }
        }
        __syncthreads();
        {
            float g[8]; float run = 0.f;
#pragma unroll
            for (int i = 0; i < 8; ++i) { run += LWf[(8 * w + i) * 64 + lane]; g[i] = run; }
            segs[w * 64 + lane] = run;
            __syncthreads();
            float off = 0.f;
#pragma unroll
            for (int s2 = 0; s2 < 7; ++s2) if (s2 < w) off += segs[s2 * 64 + lane];
#pragma unroll
            for (int i = 0; i < 8; ++i) LWf[(8 * w + i) * 64 + lane] = off + g[i];
        }
        __syncthreads();
        {
            const int j = lane;
            float btn[8], ktt[8];
#pragma unroll
            for (int i = 0; i < 8; ++i) {
                const int t = 8 * w + i;
                const float kv = bf2f(KPb[t * 72 + j]), rv = bf2f(RPb[t * 72 + j]), a = Af[t * 64 + j], G = LWf[t * 64 + j];
                const float Gp = (t > 0) ? LWf[(t - 1) * 64 + j] : 0.f;
                const float kx = kv * kkj; const float ss = wsum(kx * kx); const float kk = kx * (1.0f / sqrtf(ss + 1e-6f));
                const float km = kv * (1.f + (a - 1.f) * kaj);
                const float bs = wsum(rv * km * rkj); if (j == 0) bonus[t] = bs;
                const float eG = __expf(G), eGi = __expf(-G), eGp = __expf(Gp);
                const float bt = kk * a * eGi, kt = km * eGi;
                At[t * 72 + j] = (bf16_t)f2bf(kk * eGp); Btl[t * 72 + j] = (bf16_t)f2bf(bt); Ktl[t * 72 + j] = (bf16_t)f2bf(kt); Rtl[t * 72 + j] = (bf16_t)f2bf(rv * eG);
                btn[i] = -bt; ktt[i] = kt;
                if (t == 63) glv[j] = eG;
            }
            *(LAS u32x4*)(BtTn + j * 72 + 8 * w) = (u32x4){pk2(btn[0], btn[1]), pk2(btn[2], btn[3]), pk2(btn[4], btn[5]), pk2(btn[6], btn[7])};
            *(LAS u32x4*)(KtT + j * 72 + 8 * w) = (u32x4){pk2(ktt[0], ktt[1]), pk2(ktt[2], ktt[3]), pk2(ktt[4], ktt[5]), pk2(ktt[6], ktt[7])};
        }
        __syncthreads();
        {
            for (int job = w; job < 64; job += NWAVES) {
                const int mat = job >> 4, bi = (job >> 2) & 3, bj = job & 3;
                LAS bf16_t* dst = (mat == 0) ? Aoff : (mat == 1 ? Mak : (mat == 2 ? Mrk : Mrbn));
                const int i = 16 * bi + fr, j0 = 16 * bj + 4 * fq;
                f32x4 o = {0.f, 0.f, 0.f, 0.f};
                if (bj <= bi) {
                    const LAS bf16_t* Aj = ((mat == 0 || mat == 3) ? Btl : Ktl) + bj * 16 * 72; const LAS bf16_t* Bi = ((mat < 2) ? At : Rtl) + bi * 16 * 72;
                    const f32x4 acc = mm_tile(Aj, 72, Bi, 72, 2, (f32x4){0.f, 0.f, 0.f, 0.f}, fr, fq);
                    const bool incl = mat >= 2;
                    o.x = (incl ? (j0 <= i) : (j0 < i)) ? acc.x : 0.f; o.y = (incl ? (j0 + 1 <= i) : (j0 + 1 < i)) ? acc.y : 0.f;
                    o.z = (incl ? (j0 + 2 <= i) : (j0 + 2 < i)) ? acc.z : 0.f; o.w = (incl ? (j0 + 3 <= i) : (j0 + 3 < i)) ? acc.w : 0.f;
                    if (mat == 0 && bi == bj) { LAS float* dd = Adg + (bi * 16 + fr) * 17 + 4 * fq; dd[0] = o.x; dd[1] = o.y; dd[2] = o.z; dd[3] = o.w; o = (f32x4){0.f, 0.f, 0.f, 0.f}; }
                    if (mat == 0 || mat == 3) o = -o;
                }
                lds_w4(dst + i * 72 + j0, o);
            }
#pragma unroll
            for (int q = 0; q < 2; ++q) { const int id = 2 * w + q, mi = id >> 2, nj = id & 3; const int j = nj * 16 + fr; const float gv[4] = {agate[q].x, agate[q].y, agate[q].z, agate[q].w};
#pragma unroll
                for (int rg = 0; rg < 4; ++rg) GB[(mi * 16 + 4 * fq + rg) * 64 + j] = (bf16_t)f2bf(gv[rg]); }
        }
        __syncthreads();
        f32x4 ot[4];
        if (c > 0) ho_wait(flag, (unsigned)c, tmo, w, lane);
        if (w < 4) {
#pragma unroll
            for (int kb = 0; kb < 4; kb += 2) {
                const u32x4 ldv = __builtin_bit_cast(u32x4, ho_load(hb, (unsigned)(((w * 64 + lane) * 2 + (kb >> 1)) * 16)));
                const f32x4 z0 = {bf2f((unsigned short)(ldv.x & 0xffffu)), bf2f((unsigned short)(ldv.x >> 16)), bf2f((unsigned short)(ldv.y & 0xffffu)), bf2f((unsigned short)(ldv.y >> 16))};
                const f32x4 z1 = {bf2f((unsigned short)(ldv.z & 0xffffu)), bf2f((unsigned short)(ldv.z >> 16)), bf2f((unsigned short)(ldv.w & 0xffffu)), bf2f((unsigned short)(ldv.w >> 16))};
                zacc[kb] = (c > 0) ? z0 : (f32x4){0.f, 0.f, 0.f, 0.f}; zacc[kb + 1] = (c > 0) ? z1 : (f32x4){0.f, 0.f, 0.f, 0.f}; }
#pragma unroll
            for (int kb = 0; kb < 4; ++kb) lds_w4(Zt + (16 * w + fr) * 72 + 16 * kb + 4 * fq, zacc[kb]);
            asm volatile("s_waitcnt lgkmcnt(0)" ::: "memory");
        }
        if (w < 4) {
            {
                const int bb = lane >> 4, jj = lane & 15; float x[16]; const LAS float* a = Adg + bb * 16 * 17;
#pragma unroll
                for (int i = 0; i < 16; ++i) { float v = (i == jj) ? 1.f : 0.f;
#pragma unroll
                    for (int k = 0; k < i; ++k) v -= a[i * 17 + k] * x[k];
                    x[i] = v; Dg[(bb * 16 + i) * 24 + jj] = (bf16_t)f2bf(v); }
                asm volatile("s_waitcnt lgkmcnt(0)" ::: "memory");
            }
            const LAS bf16_t* Vw = Vt + (16 * w) * 72; const LAS bf16_t* Zw = Zt + (16 * w) * 72; LAS bf16_t* PUw = PU + (16 * w) * 72;
            f32x4 p[4];
#pragma unroll
            for (int mi = 0; mi < 4; ++mi) { p[mi] = mm_tile(At + mi * 16 * 72, 72, Zw, 72, 2, (f32x4){0.f, 0.f, 0.f, 0.f}, fr, fq); p[mi] = mm_tile(Mak + mi * 16 * 72, 72, Vw, 72, 2, p[mi], fr, fq); }
#pragma unroll
            for (int bb = 0; bb < 4; ++bb) {
                f32x4 acc = p[bb];
                if (bb >= 1) acc = mm_tile(Aoff + bb * 16 * 72, 72, PUw, 72, (bb + 1) / 2, acc, fr, fq);
                u32x2 pk; pk.x = pk2(acc.x, acc.y); pk.y = pk2(acc.z, acc.w);
                const bf16x4 dgf = *(const LAS bf16x4*)(Dg + (bb * 16 + fr) * 24 + 4 * fq);
                const f32x4 ub = MFMA16(dgf, __builtin_bit_cast(bf16x4, pk), ((f32x4){0.f, 0.f, 0.f, 0.f}));
                lds_w4(PUw + fr * 72 + 16 * bb + 4 * fq, ub);
                asm volatile("s_waitcnt lgkmcnt(0)" ::: "memory");
            }
#pragma unroll
            for (int mi = 0; mi < 4; ++mi) {
                f32x4 o = mm_tile(Rtl + mi * 16 * 72, 72, Zw, 72, 2, (f32x4){0.f, 0.f, 0.f, 0.f}, fr, fq);
                o = mm_tile(Mrk + mi * 16 * 72, 72, Vw, 72, 2, o, fr, fq);
                ot[mi] = mm_tile(Mrbn + mi * 16 * 72, 72, PUw, 72, 2, o, fr, fq);
            }
#pragma unroll
            for (int kb = 0; kb < 4; ++kb) {
                f32x4 zn = mm_tile(KtT + kb * 16 * 72, 72, Vw, 72, 2, zacc[kb], fr, fq);
                zn = mm_tile(BtTn + kb * 16 * 72, 72, PUw, 72, 2, zn, fr, fq);
                const f32x4 g4 = *(const LAS f32x4*)(glv + 16 * kb + 4 * fq);
                zn = zn * g4; zacc[kb] = zn;
                lds_w4(Zt + (16 * w + fr) * 72 + 16 * kb + 4 * fq, zn);
            }
        }
        if (w < 4 && c < 31) {
#pragma unroll
            for (int kb = 0; kb < 4; kb += 2) { u32x4 pv; pv.x = pk2(zacc[kb].x, zacc[kb].y); pv.y = pk2(zacc[kb].z, zacc[kb].w); pv.z = pk2(zacc[kb + 1].x, zacc[kb + 1].y); pv.w = pk2(zacc[kb + 1].z, zacc[kb + 1].w);
                ho_store(hb, (unsigned)(((w * 64 + lane) * 2 + (kb >> 1)) * 16), __builtin_bit_cast(f32x4, pv)); }
            asm volatile("s_waitcnt vmcnt(0)" ::: "memory");
        }
        __syncthreads();
        if (c < 31 && w == 0 && lane == 0) __hip_atomic_store(flag, (unsigned)(c + 1), __ATOMIC_RELAXED, __HIP_MEMORY_SCOPE_AGENT);
        if (w < 4) {
#pragma unroll
            for (int mi = 0; mi < 4; ++mi) { LAS float* op = Of + (16 * mi + 4 * fq) * 65 + 16 * w + fr; op[0] = ot[mi].x; op[65] = ot[mi].y; op[130] = ot[mi].z; op[195] = ot[mi].w; }
        }
        __syncthreads();
        for (int t = w; t < 64; t += NWAVES) {
            const float o = Of[t * 65 + lane];
            const float mean = wsum(o) * (1.0f / 64.0f); const float dlt = o - mean; const float var = wsum(dlt * dlt) * (1.0f / 64.0f);
            float y = dlt * (1.0f / sqrtf(var + 64e-5f)) * lnw + lnb;
            y += bonus[t] * bf2f(Vt[lane * 72 + t]);
            y *= bf2f(GB[t * 64 + lane]);
            P[(size_t)(t0 + t) * P0LD + 2048 + h * 64 + lane] = (bf16_t)f2bf(y);
        }
        __syncthreads();
    }
}

__device__ __forceinline__ void attn_phase(const Frame& F, const bf16_t* Q, const bf16_t* Kb, const bf16_t* VT, bf16_t* O) {
    const int lane = lane_id_v(); const int tid = F.wave * 64 + lane; (void)tid;
    const int fr = lane & 15, fq = lane >> 4;
    for (int u = F.wg; u < 512; u += F.G) {
        const int b = u >> 6, h = (u >> 4) & 3, qb = u & 15;
        const int q0 = b * TS + qb * 128 + F.wave * 16;
        bf16x8 bq[8];
#pragma unroll
        for (int ksx = 0; ksx < 8; ++ksx) bq[ksx] = *(const bf16x8*)(Q + (size_t)(q0 + fr) * 1024 + h * 256 + ksx * 32 + fq * 8);
        f32x4 sacc[16];
#pragma unroll
        for (int tl = 0; tl < 16; ++tl) {
            f32x4 a4 = {0.f, 0.f, 0.f, 0.f};
            const bf16_t* kp = Kb + (size_t)(b * 256 + tl * 16 + fr) * 1024 + h * 256 + fq * 8;
#pragma unroll
            for (int ksx = 0; ksx < 8; ++ksx) { const bf16x8 a = *(const bf16x8*)(kp + ksx * 32); a4 = __builtin_amdgcn_mfma_f32_16x16x32_bf16(a, bq[ksx], a4, 0, 0, 0); }
            sacc[tl] = a4;
        }
        float mx = -3.0e38f;
#pragma unroll
        for (int tl = 0; tl < 16; ++tl) mx = fmaxf(mx, fmaxf(fmaxf(sacc[tl].x, sacc[tl].y), fmaxf(sacc[tl].z, sacc[tl].w)));
        mx = fmaxf(mx, __shfl_xor(mx, 16)); mx = fmaxf(mx, __shfl_xor(mx, 32));
        float l = 0.f;
        bf16x8 pb[8];
#pragma unroll
        for (int ksx = 0; ksx < 8; ++ksx) {
            const f32x4 e0 = sacc[2 * ksx], e1 = sacc[2 * ksx + 1];
            const float p0 = __expf(e0.x - mx), p1 = __expf(e0.y - mx), p2 = __expf(e0.z - mx), p3 = __expf(e0.w - mx);
            const float p4 = __expf(e1.x - mx), p5 = __expf(e1.y - mx), p6 = __expf(e1.z - mx), p7 = __expf(e1.w - mx);
            l += ((p0 + p1) + (p2 + p3)) + ((p4 + p5) + (p6 + p7));
            u32x4 w; w.x = pk2(p0, p1); w.y = pk2(p2, p3); w.z = pk2(p4, p5); w.w = pk2(p6, p7);
            pb[ksx] = __builtin_bit_cast(bf16x8, w);
        }
        l += __shfl_xor(l, 16); l += __shfl_xor(l, 32);
        const float inv = 1.0f / l;
        const bf16_t* vbase = VT + (size_t)((b * 4 + h) * 256) * 256;
#pragma unroll 4
        for (int dt = 0; dt < 16; ++dt) {
            f32x4 o4 = {0.f, 0.f, 0.f, 0.f};
            const bf16_t* vp = vbase + (size_t)(dt * 16 + fr) * 256 + 4 * fq;
#pragma unroll
            for (int ksx = 0; ksx < 8; ++ksx) {
                const u32x2 lo = *(const u32x2*)(vp + ksx * 32), hi = *(const u32x2*)(vp + ksx * 32 + 16);
                u32x4 w; w.x = lo.x; w.y = lo.y; w.z = hi.x; w.w = hi.y;
                o4 = __builtin_amdgcn_mfma_f32_16x16x32_bf16(__builtin_bit_cast(bf16x8, w), pb[ksx], o4, 0, 0, 0);
            }
            u32x2 w; w.x = pk2(o4.x * inv, o4.y * inv); w.y = pk2(o4.z * inv, o4.w * inv);
            *(u32x2*)(O + (size_t)(q0 + fr) * 1024 + h * 256 + dt * 16 + 4 * fq) = w;
        }
    }
}

__device__ __forceinline__ void attn_phase2(const Frame& F, const bf16_t* Q, const bf16_t* Kb, const bf16_t* VT, bf16_t* O) {
    const int lane = lane_id_v(); const int tid = F.wave * 64 + lane; const int fr = lane & 15, fq = lane >> 4;
    LAS bf16_t* KL = (LAS bf16_t*)F.lds;
    static_assert(256 * 264 * 2 <= LDS_MISC, "attn LDS");
    for (int u = F.wg; u < 512; u += F.G) {
        const int b = u >> 6, h = (u >> 4) & 3, qb = u & 15;
        const int q0 = b * TS + qb * 128 + F.wave * 16;
        u32x4 st[16];
#pragma unroll
        for (int n = 0; n < 16; ++n) { const int idx = tid + NTHREADS * n, row = idx >> 5, c8 = idx & 31;
            st[n] = *(const u32x4*)(Kb + (size_t)(b * 256 + row) * 1024 + h * 256 + c8 * 8); }
        bf16x8 bq[8];
#pragma unroll
        for (int ksx = 0; ksx < 8; ++ksx) bq[ksx] = *(const bf16x8*)(Q + (size_t)(q0 + fr) * 1024 + h * 256 + ksx * 32 + fq * 8);
        __syncthreads();
#pragma unroll
        for (int n = 0; n < 16; ++n) { const int idx = tid + NTHREADS * n, row = idx >> 5, c8 = idx & 31; *(LAS u32x4*)(KL + row * 264 + c8 * 8) = st[n]; }
        const bf16_t* vbase = VT + (size_t)((b * 4 + h) * 256) * 256;
#pragma unroll
        for (int n = 0; n < 16; ++n) { const int idx = tid + NTHREADS * n, row = idx >> 5, c8 = idx & 31; st[n] = *(const u32x4*)(vbase + (size_t)row * 256 + c8 * 8); }
        __syncthreads();
        f32x4 sacc[16];
#pragma unroll
        for (int tl = 0; tl < 16; ++tl) {
            f32x4 a4 = {0.f, 0.f, 0.f, 0.f};
#pragma unroll
            for (int ksx = 0; ksx < 8; ++ksx) a4 = __builtin_amdgcn_mfma_f32_16x16x32_bf16(*(const LAS bf16x8*)(KL + (tl * 16 + fr) * 264 + ksx * 32 + fq * 8), bq[ksx], a4, 0, 0, 0);
            sacc[tl] = a4;
        }
        float mx = -3.0e38f;
#pragma unroll
        for (int tl = 0; tl < 16; ++tl) mx = fmaxf(mx, fmaxf(fmaxf(sacc[tl].x, sacc[tl].y), fmaxf(sacc[tl].z, sacc[tl].w)));
        mx = fmaxf(mx, __shfl_xor(mx, 16)); mx = fmaxf(mx, __shfl_xor(mx, 32));
        float l = 0.f;
        bf16x8 pb[8];
#pragma unroll
        for (int ksx = 0; ksx < 8; ++ksx) {
            const f32x4 e0 = sacc[2 * ksx], e1 = sacc[2 * ksx + 1];
            const float p0 = __expf(e0.x - mx), p1 = __expf(e0.y - mx), p2 = __expf(e0.z - mx), p3 = __expf(e0.w - mx);
            const float p4 = __expf(e1.x - mx), p5 = __expf(e1.y - mx), p6 = __expf(e1.z - mx), p7 = __expf(e1.w - mx);
            l += ((p0 + p1) + (p2 + p3)) + ((p4 + p5) + (p6 + p7));
            u32x4 w; w.x = pk2(p0, p1); w.y = pk2(p2, p3); w.z = pk2(p4, p5); w.w = pk2(p6, p7);
            pb[ksx] = __builtin_bit_cast(bf16x8, w);
        }
        l += __shfl_xor(l, 16); l += __shfl_xor(l, 32);
        const float inv = 1.0f / l;
        __syncthreads();
#pragma unroll
        for (int n = 0; n < 16; ++n) { const int idx = tid + NTHREADS * n, row = idx >> 5, c8 = idx & 31; *(LAS u32x4*)(KL + row * 264 + c8 * 8) = st[n]; }
        __syncthreads();
#pragma unroll 4
        for (int dt = 0; dt < 16; ++dt) {
            f32x4 o4 = {0.f, 0.f, 0.f, 0.f};
            const LAS bf16_t* vp = KL + (dt * 16 + fr) * 264 + 4 * fq;
#pragma unroll
            for (int ksx = 0; ksx < 8; ++ksx) {
                const u32x2 lo = *(const LAS u32x2*)(vp + ksx * 32), hi = *(const LAS u32x2*)(vp + ksx * 32 + 16);
                u32x4 w; w.x = lo.x; w.y = lo.y; w.z = hi.x; w.w = hi.y;
                o4 = __builtin_amdgcn_mfma_f32_16x16x32_bf16(__builtin_bit_cast(bf16x8, w), pb[ksx], o4, 0, 0, 0);
            }
            u32x2 w; w.x = pk2(o4.x * inv, o4.y * inv); w.y = pk2(o4.z * inv, o4.w * inv);
            *(u32x2*)(O + (size_t)(q0 + fr) * 1024 + h * 256 + dt * 16 + 4 * fq) = w;
        }
    }
    __syncthreads();
}

__device__ __forceinline__ void router_phase(const Frame& F, int layer) {
    const int lane = lane_id_v(); const int tid = F.wave * 64 + lane; (void)tid;
    const float* XF = F.out; const float* gain = F.in[IN_NORM_FFN] + layer * 1024;
    const float* wg = F.in[IN_MOE_WG] + (size_t)layer * 1024 * 4; const float* we = F.in[IN_MOE_WE] + (size_t)layer * 1024 * 16;
    const float* bg = F.in[IN_MOE_BG] + layer * 4; const float* be = F.in[IN_MOE_BE] + layer * 16;
    unsigned* cnt = (unsigned*)(F.ws + WS_CNT) + layer * 32;
    int* tokb = (int*)(F.ws + WS_ROUTE); int* tokp = tokb + NT; f32x4* tokg = (f32x4*)(tokp + NT);
    const int gw = F.wg * NWAVES + F.wave, NGW = F.G * NWAVES;
    for (int row = gw; row < NT; row += NGW) {
        const f32x4* xr = (const f32x4*)(XF + (size_t)row * 1024) + lane;
        float s = 0.f, lg[4], le[16];
#pragma unroll
        for (int c = 0; c < 4; ++c) lg[c] = 0.f;
#pragma unroll
        for (int c = 0; c < 16; ++c) le[c] = 0.f;
#pragma unroll 1
        for (int j = 0; j < 4; ++j) {
            const f32x4 v = xr[64 * j]; s += (v.x * v.x + v.y * v.y) + (v.z * v.z + v.w * v.w);
            const int k0 = 4 * lane + 256 * j; const f32x4 g = *(const f32x4*)(gain + k0);
            const float xv[4] = {v.x * g.x, v.y * g.y, v.z * g.z, v.w * g.w};
#pragma unroll
            for (int q = 0; q < 4; ++q) {
                const f32x4 a = *(const f32x4*)(wg + (size_t)(k0 + q) * 4);
                lg[0] += xv[q] * a.x; lg[1] += xv[q] * a.y; lg[2] += xv[q] * a.z; lg[3] += xv[q] * a.w;
#pragma unroll
                for (int e4 = 0; e4 < 4; ++e4) { const f32x4 w = *(const f32x4*)(we + (size_t)(k0 + q) * 16 + 4 * e4);
                    le[4 * e4] += xv[q] * w.x; le[4 * e4 + 1] += xv[q] * w.y; le[4 * e4 + 2] += xv[q] * w.z; le[4 * e4 + 3] += xv[q] * w.w; }
            }
        }
        s = wave_sum(s);
        const float rstd = 1.0f / sqrtf(s * (1.0f / 1024.0f) + 1e-6f);
#pragma unroll
        for (int c = 0; c < 4; ++c) lg[c] = wave_sum(lg[c]) * rstd + bg[c];
#pragma unroll
        for (int c = 0; c < 16; ++c) le[c] = wave_sum(le[c]) * rstd + be[c];
        int gs = 0; float gm = lg[0];
#pragma unroll
        for (int c = 1; c < 4; ++c) if (lg[c] > gm) { gm = lg[c]; gs = c; }
        float gz = 0.f;
#pragma unroll
        for (int c = 0; c < 4; ++c) gz += __expf(lg[c] - gm);
        const float ggate = 1.0f / gz;
        float l4[4];
#pragma unroll
        for (int c = 0; c < 4; ++c) { float v = le[c];
#pragma unroll
            for (int g2 = 1; g2 < 4; ++g2) v = (gs == g2) ? le[4 * g2 + c] : v;
            l4[c] = v; }
        int i0 = 0; float m0 = l4[0];
#pragma unroll
        for (int c = 1; c < 4; ++c) if (l4[c] > m0) { m0 = l4[c]; i0 = c; }
        int i1 = -1; float m1 = -3.0e38f;
#pragma unroll
        for (int c = 0; c < 4; ++c) if (c != i0 && l4[c] > m1) { m1 = l4[c]; i1 = c; }
        const float e1 = __expf(m1 - m0); const float g0 = ggate / (1.f + e1), g1 = ggate * e1 / (1.f + e1);
        const int ia = i0 < i1 ? i0 : i1, ib = i0 < i1 ? i1 : i0;
        const float ga = i0 < i1 ? g0 : g1, gb = i0 < i1 ? g1 : g0;
        const int pidx = (ia == 0) ? (ib - 1) : (ia == 1 ? ib + 1 : 5);
        const int bucket = gs * 6 + pidx;
        if (lane == 0) {
            const unsigned pos = atomicAdd(&cnt[bucket], 1u);
            tokb[row] = bucket; tokp[row] = (int)pos; tokg[row] = (f32x4){rstd, ga, gb, 0.f};
        }
    }
}
typedef float f32x16 __attribute__((ext_vector_type(16)));
__device__ __forceinline__ void router_phase2(const Frame& F, int layer) {
    const int lane = lane_id_v(); const int tid = F.wave * 64 + lane; const int w = F.wave;
    const bf16_t* XBr = (const bf16_t*)(F.ws + WS_XB); const float* rw = (const float*)(F.ws + WS_RW) + (size_t)layer * 1024 * 32;
    const float* ssp = (const float*)(F.ws + WS_SSP);
    unsigned* cnt = (unsigned*)(F.ws + WS_CNT) + layer * 32;
    int* tokb = (int*)(F.ws + WS_ROUTE); int* tokp = tokb + NT; f32x4* tokg = (f32x4*)(tokp + NT);
    LAS float* T = (LAS float*)F.lds + w * (32 * 132);
    LAS float* Pp = (LAS float*)F.lds;
    LAS float* Lg = Pp + 8 * 64 * 33;
    const int i31 = lane & 31, kh = lane >> 5, k0 = 128 * w;
    float bW[64];
#pragma unroll
    for (int s2 = 0; s2 < 64; ++s2) bW[s2] = rw[(size_t)(k0 + 2 * s2 + kh) * 32 + i31];
    for (int blk = F.wg; blk < NT / 64; blk += F.G) {
        const int r0 = blk * 64;
        f32x16 acc0, acc1;
#pragma unroll
        for (int e = 0; e < 16; ++e) { acc0[e] = 0.f; acc1[e] = 0.f; }
#pragma unroll
        for (int rt = 0; rt < 2; ++rt) {
#pragma unroll
            for (int n = 0; n < 16; ++n) { const int idx = lane + 64 * n, row = idx >> 5, c4 = idx & 31;
                const u32x2 rv = *(const u32x2*)(XBr + (size_t)(r0 + 32 * rt + row) * 1024 + k0 + 4 * c4);
                *(LAS f32x4*)(T + row * 132 + 4 * c4) = (f32x4){bf2f((unsigned short)(rv.x & 0xffffu)), bf2f((unsigned short)(rv.x >> 16)), bf2f((unsigned short)(rv.y & 0xffffu)), bf2f((unsigned short)(rv.y >> 16))}; }
            asm volatile("s_waitcnt lgkmcnt(0)" ::: "memory");
#pragma unroll
            for (int s2 = 0; s2 < 64; ++s2) {
                const float a0 = T[i31 * 132 + 2 * s2 + kh];
                if (rt == 0) acc0 = __builtin_amdgcn_mfma_f32_32x32x2f32(a0, bW[s2], acc0, 0, 0, 0);
                else acc1 = __builtin_amdgcn_mfma_f32_32x32x2f32(a0, bW[s2], acc1, 0, 0, 0);
            }
            asm volatile("s_waitcnt lgkmcnt(0)" ::: "memory");
        }
        __syncthreads();
#pragma unroll
        for (int e = 0; e < 16; ++e) { const int row = (e & 3) + 8 * (e >> 2) + 4 * kh;
            Pp[(w * 64 + row) * 33 + i31] = acc0[e]; Pp[(w * 64 + 32 + row) * 33 + i31] = acc1[e]; }
        __syncthreads();
        for (int idx = tid; idx < 64 * 32; idx += NTHREADS) { const int row = idx >> 5, cc = idx & 31; float a = 0.f;
#pragma unroll
            for (int ww = 0; ww < 8; ++ww) a += Pp[(ww * 64 + row) * 33 + cc];
            Lg[row * 33 + cc] = a; }
        __syncthreads();
        if (tid < 64) {
            const int row = r0 + tid; const float rstd = row_rstd(ssp, row);
            const float* bg = F.in[IN_MOE_BG] + layer * 4; const float* be = F.in[IN_MOE_BE] + layer * 16;
            float lg[4], le[16];
#pragma unroll
            for (int c2 = 0; c2 < 4; ++c2) lg[c2] = Lg[tid * 33 + c2] * rstd + bg[c2];
#pragma unroll
            for (int c2 = 0; c2 < 16; ++c2) le[c2] = Lg[tid * 33 + 4 + c2] * rstd + be[c2];
            int gs = 0; float gm = lg[0];
#pragma unroll
            for (int c2 = 1; c2 < 4; ++c2) if (lg[c2] > gm) { gm = lg[c2]; gs = c2; }
            float gz = 0.f;
#pragma unroll
            for (int c2 = 0; c2 < 4; ++c2) gz += __expf(lg[c2] - gm);
            const float ggate = 1.0f / gz;
            float l4[4];
#pragma unroll
            for (int c2 = 0; c2 < 4; ++c2) { float v = le[c2];
#pragma unroll
                for (int g2 = 1; g2 < 4; ++g2) v = (gs == g2) ? le[4 * g2 + c2] : v;
                l4[c2] = v; }
            int i0 = 0; float m0 = l4[0];
#pragma unroll
            for (int c2 = 1; c2 < 4; ++c2) if (l4[c2] > m0) { m0 = l4[c2]; i0 = c2; }
            int i1 = -1; float m1 = -3.0e38f;
#pragma unroll
            for (int c2 = 0; c2 < 4; ++c2) if (c2 != i0 && l4[c2] > m1) { m1 = l4[c2]; i1 = c2; }
            const float e1 = __expf(m1 - m0); const float g0 = ggate / (1.f + e1), g1 = ggate * e1 / (1.f + e1);
            const int ia = i0 < i1 ? i0 : i1, ib = i0 < i1 ? i1 : i0;
            const float ga = i0 < i1 ? g0 : g1, gb = i0 < i1 ? g1 : g0;
            const int pidx = (ia == 0) ? (ib - 1) : (ia == 1 ? ib + 1 : 5);
            const int bucket = gs * 6 + pidx;
            const unsigned pos = atomicAdd(&cnt[bucket], 1u);
            tokb[row] = bucket; tokp[row] = (int)pos; tokg[row] = (f32x4){rstd, ga, gb, 0.f};
        }
        __syncthreads();
    }
}
__device__ __forceinline__ void gather_phase(const Frame& F, int layer) {
    const int lane = lane_id_v(); const int tid = F.wave * 64 + lane; (void)tid;
    const unsigned* cnt = (const unsigned*)(F.ws + WS_CNT) + layer * 32;
    const int* tokb = (const int*)(F.ws + WS_ROUTE); const int* tokp = tokb + NT; const f32x4* tokg = (const f32x4*)(tokp + NT); f32x4* rowinfo = (f32x4*)(tokg + NT);
    const bf16_t* XB = (const bf16_t*)(F.ws + WS_XB); bf16_t* XG = (bf16_t*)(F.ws + WS_BIG + BIG_XG);
    LAS int* off = (LAS int*)F.lds;
    if (tid == 0) { int acc = 0; for (int b = 0; b < 24; ++b) { off[b] = acc * 256; acc += ((int)cnt[b] + 255) >> 8; } }
    __syncthreads();
    const int gw = F.wg * NWAVES + F.wave, NGW = F.G * NWAVES;
    for (int tok = gw; tok < NT; tok += NGW) {
        const int row = off[tokb[tok]] + tokp[tok];
        const u32x4* src = (const u32x4*)(XB + (size_t)tok * 1024) + lane; u32x4* dst = (u32x4*)(XG + (size_t)row * 1024) + lane;
        dst[0] = src[0]; dst[64] = src[64];
        if (lane == 0) { f32x4 g = tokg[tok]; g.w = __int_as_float(tok); rowinfo[row] = g; }
    }
    __syncthreads();
}
__device__ __forceinline__ void final_phase(const Frame& F) {
    const int lane = lane_id_v();
    float* out = F.out; const bf16_t* XBr = (const bf16_t*)(F.ws + WS_XB); const float* gain = F.in[IN_NORM_FINAL];
    const int gw = F.wg * NWAVES + F.wave, NGW = F.G * NWAVES;
    for (int row = gw; row < NT; row += NGW) {
        const u32x2* xr = (const u32x2*)(XBr + (size_t)row * 1024) + lane;
        f32x4 v[4]; float s = 0.f;
#pragma unroll
        for (int j = 0; j < 4; ++j) { const u32x2 r = xr[64 * j]; v[j] = (f32x4){bf2f((unsigned short)(r.x & 0xffffu)), bf2f((unsigned short)(r.x >> 16)), bf2f((unsigned short)(r.y & 0xffffu)), bf2f((unsigned short)(r.y >> 16))};
            s += (v[j].x * v[j].x + v[j].y * v[j].y) + (v[j].z * v[j].z + v[j].w * v[j].w); }
        s = wsum(s);
        const float rstd = 1.0f / sqrtf(s * (1.0f / 1024.0f) + 1e-6f);
        f32x4* orow = (f32x4*)(out + (size_t)row * 1024) + lane;
#pragma unroll
        for (int j = 0; j < 4; ++j) { const f32x4 g = *(const f32x4*)(gain + 4 * lane + 256 * j); orow[64 * j] = v[j] * rstd * g; }
    }
}

constexpr int N_PHASES = 24;
#ifndef PH_MASK
#define PH_MASK 0xFFFFFFFFu
#endif
#define IN(k) (((PH_MASK >> ((k) > 11 ? (k) - 11 : (k))) & 1u) && lo <= (k) && (k) < hi)
#define TS_STAMP(k) do { if (TS_A >= 0 && ((k) == TS_A || (k) == TS_B) && F.wg == 0 && F.wave == 0 && lane_id_v() == 0) ((volatile LAS unsigned*)(F.lds + LDS_MISC + 1024))[(k)] = (unsigned)__builtin_amdgcn_s_memrealtime(); } while (0)
#define SEAM(k) do { if (IN(k) && IN((k) + 1)) xcd_barrier(bar); TS_STAMP((k) + 1); } while (0)
#define SEAM2(k) do { if (IN(k) && IN((k) + 2)) xcd_barrier(bar); TS_STAMP((k) + 2); } while (0)

template <int LAYER>
__device__ __forceinline__ void layer_phases(const Frame& F, const XcdBarrier& bar, const int lo, const int hi) {
    constexpr int pb = LAYER * 11;
    unsigned char* const ws = F.ws;
#define WPTR(off) ((bf16_t*)(ws + (LAYER ? WS_W1 : WS_W0)) + (off))
#define XB_ ((bf16_t*)(ws + WS_XB))
#define SSP_ ((float*)(ws + WS_SSP))
#define PROJ_ ((bf16_t*)(ws + WS_BIG + BIG_PROJ))
#define KB_ (LAYER ? (bf16_t*)(ws + WS_W0) : (bf16_t*)(ws + WS_BIG + BIG_KV0))
#define VT_ (KB_ + (size_t)2048 * 1024)
#define QB_ ((bf16_t*)(ws + WS_BIG + BIG_Q))
#define ATT_ ((bf16_t*)(ws + WS_BIG + BIG_ATT))
#define XG_ ((bf16_t*)(ws + WS_BIG + BIG_XG))
#define HID_ ((bf16_t*)(ws + WS_BIG + BIG_HID))
#define CNT_ ((const unsigned*)(ws + WS_CNT) + LAYER * 32)
#define ROWINFO_ ((const f32x4*)(ws + WS_ROUTE + (size_t)NT * 8 + (size_t)NT * 16))
    if (IN(pb + 1)) {
        if (LAYER == 0) {
            pg8::Gemm g{1024, 1024, 1024, 1 << 20}; pg8::DenseSched S; S.init(NT, 3840, F.G, F.wg, XB_, 1024, WPTR(WO_WIN), 1024);
            EpiScale<0> E{PROJ_, P0LD, SSP_, 1.0f, nullptr, (bf16_t*)(ws + WS_HALOB)};
            pg8::gemm_phase(F.lds, F.wave, g, S, E);
            { pg8::Gemm g2{1024, 1024, 1024, 1 << 20}; pg8::DenseSched S2; S2.init(2048, 2048, F.G, F.wg, (const bf16_t*)(ws + WS_MEMH), 1024, WPTR(WO_WKV), 1024);
              EpiKV E2{KB_, VT_}; pg8::gemm_phase(F.lds, F.wave, g2, S2, E2); }
        } else {
            pg8::Gemm g{1024, 1024, 1024, 1 << 20}; pg8::DenseSched S; S.init(NT, 4096, F.G, F.wg, XB_, 1024, WPTR(WO_WIN), 1024);
            EpiScale<1> E{PROJ_, P1LD, SSP_, 1.0f, (const float*)(ws + WS_LB), nullptr};
            pg8::gemm_phase(F.lds, F.wave, g, S, E);
        }
    }
    SEAM(pb + 1);
    if (IN(pb + 2)) {
        unsigned pt0 = 0; if (PROBE_WG >= 0 && LAYER == 0) pt0 = (unsigned)__builtin_amdgcn_s_memrealtime();
        if (LAYER == 0) {
#ifndef NO_DELTA
            if (F.wg < 96) { const int st = F.wg & 31; scan_delta3(F, st >> 2, st & 3, F.wg >> 5, 3); }
#endif
#ifndef NO_RWKV
            if (F.wg >= 96 && F.wg < 224) { const int q = F.wg - 96, st = ((q >> 4) << 3) | (q & 7), par = (q >> 3) & 1; scan_rwkv3(F, st >> 3, st & 7, par); }
#endif
            if (F.wg >= 224) p0_late_weights<0>(F, F.wg - 224, F.G - 224);
        } else {
#ifndef NO_HGRN
            if (F.wg < 192) { const int st = F.wg & 63; scan_hgrn3(F, st >> 3, st & 7, F.wg >> 6, 3); }
#endif
            if (F.wg >= 192) p0_late_weights<1>(F, F.wg - 192, F.G - 192);
        }
        if (PROBE_WG >= 0 && LAYER == 0 && F.wg == PROBE_WG && F.wave == 0 && lane_id_v() == 0) __hip_atomic_store((unsigned*)(F.ws + WS_CTL + 20480), (unsigned)__builtin_amdgcn_s_memrealtime() - pt0, __ATOMIC_RELAXED, __HIP_MEMORY_SCOPE_AGENT);
    }
    SEAM2(pb + 2);
    if (IN(pb + 4)) {
        constexpr int lda = LAYER ? P1LD : P0LD; const bf16_t* A = PROJ_ + (LAYER ? 3072 : 1536);
        pg8::Gemm g{lda, 1024, 1024, 1 << 20}; pg8::DenseSched S; S.init(NT, 1024, F.G, F.wg, A, lda, WPTR(WO_WOUT), 1024);
        EpiResid<false> E{LAYER ? (const float*)nullptr : F.in[IN_X], XB_, SSP_, nullptr};
        pg8::gemm_phase(F.lds, F.wave, g, S, E);
    }
    SEAM(pb + 4);
    if (IN(pb + 5)) {
        pg8::Gemm g{1024, 1024, 1024, 1 << 20}; pg8::DenseSched S; S.init(NT, 1024, F.G, F.wg, XB_, 1024, WPTR(WO_WQ), 1024);
        EpiScale<0> E{QB_, 1024, SSP_, 0.0625f, nullptr, nullptr};
        pg8::gemm_phase(F.lds, F.wave, g, S, E);
    }
    SEAM(pb + 5);
    if (IN(pb + 6)) attn_phase2(F, QB_, KB_, VT_, ATT_);
    SEAM(pb + 6);
    if (IN(pb + 7)) {
        pg8::Gemm g{1024, 1024, 1024, 1 << 20}; pg8::DenseSched S; S.init(NT, 1024, F.G, F.wg, ATT_, 1024, WPTR(WO_WO), 1024);
        EpiResid<false> E{nullptr, XB_, SSP_, nullptr};
        pg8::gemm_phase(F.lds, F.wave, g, S, E);
    }
    SEAM(pb + 7);
    if (IN(pb + 8)) router_phase2(F, LAYER);
    SEAM(pb + 8);
    if (IN(pb + 9)) gather_phase(F, LAYER);
    SEAM(pb + 9);
    if (IN(pb + 10)) {
        if (LAYER == 0 && F.wg >= 192) {
            pg8::Gemm g2{1024, 1024, 1024, 1 << 20}; pg8::DenseSched S2; S2.init(2048, 2048, 64, F.wg - 192, (const bf16_t*)(ws + WS_MEMH), 1024, (const bf16_t*)(ws + WS_W1) + WO_WKV, 1024);
            EpiKV E2{(bf16_t*)(ws + WS_KV1), (bf16_t*)(ws + WS_KV1) + (size_t)2048 * 1024}; pg8::gemm_phase(F.lds, F.wave, g2, S2, E2); }
        LAS int* tbl = (LAS int*)(F.lds + LDS_MISC + 512); moe_build_table(tbl, CNT_, F.wave * 64 + lane_id_v());
        pg8::Gemm g{1024, 1024, 1024, 1 << 20}; MoeSched<false> S{tbl, __builtin_amdgcn_readfirstlane(tbl[95]), F.G, F.wg, (const char*)XG_, (const char*)WPTR(WO_W13)};
        EpiMoeUp E{HID_, ROWINFO_};
        pg8::gemm_phase(F.lds, F.wave, g, S, E);
    }
    SEAM(pb + 10);
    if (IN(pb + 11)) {
        LAS int* tbl = (LAS int*)(F.lds + LDS_MISC + 512); moe_build_table(tbl, CNT_, F.wave * 64 + lane_id_v());
        pg8::Gemm g{512, 256, 512, 4}; MoeSched<true> S{tbl, __builtin_amdgcn_readfirstlane(tbl[95]), F.G, F.wg, (const char*)HID_, (const char*)WPTR(WO_W2T)};
        EpiResid<true> E{nullptr, XB_, SSP_, ROWINFO_};
        pg8::gemm_phase(F.lds, F.wave, g, S, E);
    }
    SEAM(pb + 11);
}

__global__ void __launch_bounds__(NTHREADS, 2) fwd_mega(Args args) {
    extern __shared__ __attribute__((aligned(16))) unsigned char lds_raw[];
    Frame F;
    F.lds = (LAS unsigned char*)lds_raw;
    const int tid = threadIdx.x; F.wave = __builtin_amdgcn_readfirstlane(tid >> 6);
    F.G = gridDim.x; F.wg = blockIdx.x;
    F.out = args.out; F.ws = args.ws;
    volatile LAS unsigned* MISC = (volatile LAS unsigned*)(F.lds + LDS_MISC);
    LAS unsigned long long* tab = (LAS unsigned long long*)(F.lds + LDS_MISC + 64);
    F.in.t = tab;
    if (tid < 16) MISC[tid] = 0u;
    if (tid == 0) {
#pragma unroll
        for (int i = 0; i < 38; ++i) tab[i] = (unsigned long long)args.in[i];
    }
    __syncthreads();
    XcdBarrier bar; bar.bar = (unsigned*)(F.ws + WS_CTL); bar.x = 0; bar.st = MISC; bar.wave = F.wave;
#if N_LAUNCH_MODE == 1
    bar = xcd_barrier_post((unsigned*)(F.ws + WS_CTL), MISC, F.wave);
#endif
    const int lo = args.ph_lo, hi = args.ph_hi;
    TS_STAMP(0);
    if (IN(0)) { p0_prologue(F); }
    SEAM(0);
    layer_phases<0>(F, bar, lo, hi);
    layer_phases<1>(F, bar, lo, hi);
    if (IN(23)) final_phase(F);
    if (TS_A >= 0 && F.wg == 0 && F.wave == 0) {
        asm volatile("s_waitcnt vmcnt(0)" ::: "memory");
        if (lane_id_v() == 0) { volatile LAS unsigned* ts = (volatile LAS unsigned*)(F.lds + LDS_MISC + 1024);
            float us = (float)(ts[TS_B] - ts[TS_A]) * 0.01f;
            if (PROBE_WG >= 0) us = (float)__hip_atomic_load((unsigned*)(F.ws + WS_CTL + 20480), __ATOMIC_RELAXED, __HIP_MEMORY_SCOPE_AGENT) * 0.01f;
            if (PROBE_STAGE >= 0) us = (float)__hip_atomic_load((unsigned*)(F.ws + WS_CTL + 20484), __ATOMIC_RELAXED, __HIP_MEMORY_SCOPE_AGENT) * 0.01f;
            F.out[0] = F.out[0] + us * TS_SCALE; }
    }
}
#undef IN
#undef SEAM

extern "C" void kernel_launch(void* const* d_in, const int* in_sizes, int n_in, void* d_out, int out_size, void* d_ws, size_t ws_size, hipStream_t stream) {
    static int grid = 0;
    if (grid == 0) {
        if (n_in != 38 || out_size != NT * DM || ws_size < WS_END) { fprintf(stderr, "kernel_launch: unexpected problem (n_in %d out %d ws %zu)\n", n_in, out_size, ws_size); grid = -1; return; }
        int dev = 0, cus = 0, per_cu = 0;
        if (hipGetDevice(&dev) != hipSuccess || hipDeviceGetAttribute(&cus, hipDeviceAttributeMultiprocessorCount, dev) != hipSuccess) { grid = -1; return; }
        if (hipFuncSetAttribute((const void*)fwd_mega, hipFuncAttributeMaxDynamicSharedMemorySize, LDS_BYTES) != hipSuccess) { fprintf(stderr, "kernel_launch: hipFuncSetAttribute failed\n"); grid = -1; return; }
        if (hipOccupancyMaxActiveBlocksPerMultiprocessor(&per_cu, (const void*)fwd_mega, NTHREADS, LDS_BYTES) != hipSuccess || per_cu < 1) { fprintf(stderr, "kernel_launch: occupancy query says %d\n", per_cu); (void)hipGetLastError(); grid = -1; return; }
        grid = cus;
    }
    if (grid < 0) return;
    (void)hipMemsetAsync((char*)d_ws + WS_CTL, 0, 32768, stream);
    Args a{};
    for (int i = 0; i < 38; ++i) a.in[i] = (const float*)d_in[i];
    a.out = (float*)d_out; a.ws = (unsigned char*)d_ws;
#if N_LAUNCH_MODE == 1
    a.ph_lo = 0; a.ph_hi = N_PHASES;
    void* kargs[] = {&a};
    hipError_t e = hipLaunchCooperativeKernel((const void*)fwd_mega, dim3(grid), dim3(NTHREADS), kargs, LDS_BYTES, stream);
    if (e != hipSuccess) fprintf(stderr, "kernel_launch: cooperative launch failed: %s\n", hipGetErrorString(e));
#else
    for (int p = 0; p < N_PHASES; ++p) { a.ph_lo = p; a.ph_hi = p + 1; hipLaunchKernelGGL(fwd_mega, dim3(grid), dim3(NTHREADS), LDS_BYTES, stream, a); }
#endif
}
```

```cpp
#include <hip/hip_runtime.h>
#include <cstdio>
#include <cstdint>

#ifndef N_LAUNCH_MODE
#define N_LAUNCH_MODE 1
#endif

#ifndef TS_A
#define TS_A -1
#endif
#ifndef TS_B
#define TS_B 0
#endif
#ifndef PROBE_WG
#define PROBE_WG -1
#endif
#ifndef PROBE_STAGE
#define PROBE_STAGE -1
#endif
#ifndef TS_SCALE
#define TS_SCALE 0.01f
#endif

#define LAS __attribute__((address_space(3)))
#define GAS __attribute__((address_space(1)))
typedef unsigned short bf16_t;
typedef short bf16x8 __attribute__((ext_vector_type(8)));
typedef short bf16x4 __attribute__((ext_vector_type(4)));
typedef float f32x4 __attribute__((ext_vector_type(4)));
typedef float f32x2 __attribute__((ext_vector_type(2)));
typedef unsigned u32x4 __attribute__((ext_vector_type(4)));
typedef unsigned u32x2 __attribute__((ext_vector_type(2)));

constexpr int NT = 16384, DM = 1024, NB = 8, TS = 2048, NMEM = 256;
constexpr int P0LD = 3840;
constexpr int P1LD = 4096;
constexpr int NTHREADS = 512, NWAVES = 8;

constexpr size_t MiB = 1048576;
constexpr size_t WS_CTL = 0;
constexpr size_t WS_CNT = 16384;
constexpr size_t WS_LB = 32768;
constexpr size_t WS_DB = 1 * MiB;
constexpr size_t WS_SSP = WS_DB + 512 * 1024;
constexpr size_t WS_MEMH = WS_SSP + 1 * MiB;
constexpr size_t WS_ROUTE = WS_MEMH + 4 * MiB;
constexpr size_t WS_CNTWG = WS_ROUTE + 740 * 1024;
constexpr size_t WS_LORA = WS_ROUTE + 800 * 1024;
constexpr size_t WS_RW = WS_LORA + 256 * 1024;
constexpr size_t WS_W0 = 8 * MiB;
static_assert(WS_RW + 2 * 1024 * 32 * 4 <= 8 * MiB, "small weights");
constexpr size_t WS_W1 = WS_W0 + 42 * MiB;
constexpr size_t WS_KV1 = WS_W0;
constexpr size_t WS_XB = 92 * MiB;
constexpr size_t WS_BIG = 124 * MiB;
constexpr size_t WS_END = 256 * MiB;
constexpr size_t WS_HALOB = 252 * MiB;
constexpr size_t WS_HOB = 253 * MiB;
constexpr size_t WS_HOA = 254 * MiB;
constexpr size_t WS_HOC = 252 * MiB;
constexpr size_t WS_FLAGS = 24576;
constexpr size_t WO_WIN = 0;
constexpr size_t WO_WOUT = WO_WIN + (size_t)4096 * 1024;
constexpr size_t WO_WQ = WO_WOUT + (size_t)1024 * 1024;
constexpr size_t WO_WKV = WO_WQ + (size_t)1024 * 1024;
constexpr size_t WO_WO = WO_WKV + (size_t)2048 * 1024;
constexpr size_t WO_W13 = WO_WO + (size_t)1024 * 1024;
constexpr size_t WO_W2T = WO_W13 + (size_t)16 * 512 * 1024;
constexpr size_t WO_END = WO_W2T + (size_t)16 * 1024 * 256;
static_assert(WO_END * 2 <= 42 * MiB, "weight region");
constexpr size_t BIG_PROJ = 0;
constexpr size_t BIG_KV0 = 120 * MiB;
constexpr size_t BIG_Q = 0;
constexpr size_t BIG_ATT = 32 * MiB;
constexpr size_t BIG_XG = 0;
constexpr size_t BIG_HID = 48 * MiB;
constexpr int MOE_MAXROWS = 22528;

__device__ __forceinline__ unsigned f2bf(float f) { unsigned u = __float_as_uint(f); u += 0x7fffu + ((u >> 16) & 1u); return u >> 16; }
__device__ __forceinline__ float bf2f(unsigned short b) { return __uint_as_float((unsigned)b << 16); }
__device__ __forceinline__ unsigned pk2(float lo, float hi) { return f2bf(lo) | (f2bf(hi) << 16); }
__device__ __forceinline__ float wave_sum(float v) {
#pragma unroll
    for (int o = 1; o < 64; o <<= 1) v += __shfl_xor(v, o);
    return v;
}
template <int CTRL> __device__ __forceinline__ float dppf(float v) { return __int_as_float(__builtin_amdgcn_update_dpp(0, __float_as_int(v), CTRL, 0xF, 0xF, true)); }
__device__ __forceinline__ float red8(float v) { v += dppf<0xB1>(v); v += dppf<0x4E>(v); v += dppf<0x141>(v); return v; }
__device__ __forceinline__ float red16(float v) { v = red8(v); v += dppf<0x140>(v); return v; }

__device__ __forceinline__ float rdlane(float v, int l) { return __int_as_float(__builtin_amdgcn_readlane(__float_as_int(v), l)); }
__device__ __forceinline__ float wsum(float v) { v = red16(v); return (rdlane(v, 0) + rdlane(v, 16)) + (rdlane(v, 32) + rdlane(v, 48)); }
__device__ __forceinline__ float sigmoidf_(float x) { return 1.f / (1.f + __expf(-x)); }
__device__ __forceinline__ float siluf_(float x) { return x / (1.f + __expf(-x)); }
__device__ __forceinline__ float softplusf_(float x) { return x > 20.f ? x : log1pf(__expf(x)); }
__device__ __forceinline__ int lane_id_v() { int l; asm volatile("v_mbcnt_lo_u32_b32 %0, -1, 0\n\tv_mbcnt_hi_u32_b32 %0, -1, %0" : "=v"(l)); return l; }
#define LDS_WAIT() asm volatile("s_waitcnt lgkmcnt(0)" ::: "memory")
#define VM_WAIT() asm volatile("s_waitcnt vmcnt(0)" ::: "memory")

namespace pg8 {
constexpr int BM = 256, BK = 64, HALF = 128, HTB = HALF * BK * 2, STAGE_BYTES = 8 * HTB;
__host__ __device__ __forceinline__ int lds_byte(int r, int c) { const int st = (r >> 4) * 2 + (c >> 5), rr = r & 15, cc = c & 31, ob = rr * 64 + cc * 2; return st * 1024 + (ob ^ (((ob >> 9) & 1) << 5)); }
__host__ __device__ __forceinline__ void stage_rc(int b, int& R, int& C) { const int st = b / 1024, sb = b % 1024, swz = sb ^ (((sb >> 9) & 1) << 5); R = (st >> 1) * 16 + swz / 64; C = (st & 1) * 32 + (swz % 64) / 2; }

struct Unit { int pm, pn, aux; const char* a; const char* b0; const char* b1; };
struct Gemm { int lda, ldb, K, ksplit; };

template <class Epi, class Sched>
__device__ __forceinline__ void gemm_phase(LAS unsigned char* lds, const int wave_in, const Gemm g, const Sched& S, const Epi& E) {
    const int wid = wave_in, lane = lane_id_v(), tid = wid * 64 + lane, wr = wid >> 2, wc = wid & 3, fr = lane & 15, fq = lane >> 4;
    const int K = g.K, nt = K / BK, ks = g.ksplit;
    unsigned voffA[2], voffB[2];
#pragma unroll
    for (int i = 0; i < 2; ++i) { int R, C; stage_rc(tid * 16 + i * 8192, R, C);
        voffA[i] = (unsigned)(R * g.lda + C) * 2u; voffB[i] = (unsigned)(R * g.ldb + C) * 2u; }
    const size_t kstep = (size_t)(BK * 2);
    const size_t hstepA = (size_t)HALF * g.lda * 2, hstepB = (size_t)HALF * g.ldb * 2;
    const unsigned ldsw = (unsigned)wid * 1024u;
    const int aoff = lds_byte(wr * 64 + fr, fq * 8), boff = lds_byte(wc * 32 + fr, fq * 8);
#define PG8_SA(b, h) (((b) * 2 + (h)) * HTB)
#define PG8_SB(b, h) ((4 + (b) * 2 + (h)) * HTB)
#define PG8_STAGE(bufoff, gbase, voff) do { _Pragma("unroll") for (int _i = 0; _i < 2; ++_i) \
        __builtin_amdgcn_global_load_lds((const unsigned*)((const char*)(gbase) + (voff)[_i]), (LAS unsigned*)(lds + (bufoff) + ldsw + _i * 8192), 16, 0, 0); } while (0)
#define PG8_LDA(dst, b, h) do { _Pragma("unroll") for (int m = 0; m < 4; ++m) _Pragma("unroll") for (int k = 0; k < 2; ++k) dst[m][k] = *(const LAS bf16x8*)(lds + PG8_SA(b, h) + aoff + m * 2048 + k * 1024); } while (0)
#define PG8_LDB(dst, b, h) do { _Pragma("unroll") for (int n = 0; n < 2; ++n) _Pragma("unroll") for (int k = 0; k < 2; ++k) dst[n][k] = *(const LAS bf16x8*)(lds + PG8_SB(b, h) + boff + n * 2048 + k * 1024); } while (0)
#define PG8_MMA(ai, bj, At, Bt) do { __builtin_amdgcn_s_setprio(1); _Pragma("unroll") for (int m = 0; m < 4; ++m) _Pragma("unroll") for (int n = 0; n < 2; ++n) _Pragma("unroll") for (int k = 0; k < 2; ++k) \
        acc[ai][bj][m][n] = __builtin_amdgcn_mfma_f32_16x16x32_bf16(Bt[n][k], At[m][k], acc[ai][bj][m][n], 0, 0, 0); __builtin_amdgcn_s_setprio(0); } while (0)
#define PG8_WAIT_V(n) asm volatile("s_waitcnt vmcnt(" #n ")" ::: "memory")
#define PG8_WAIT_L(n) asm volatile("s_waitcnt lgkmcnt(" #n ")" ::: "memory")
#define PG8_BAR __builtin_amdgcn_s_barrier()
#define PG8_SCHED __builtin_amdgcn_sched_barrier(0)
    Unit cur, nxt; int ui = 0;
    if (!S.next(0, cur)) return;
    f32x4 acc[2][2][4][2];
#pragma unroll
    for (int a = 0; a < 2; ++a)
#pragma unroll
        for (int b = 0; b < 2; ++b)
#pragma unroll
            for (int m = 0; m < 4; ++m)
#pragma unroll
                for (int n = 0; n < 2; ++n) acc[a][b][m][n] = (f32x4){0.f, 0.f, 0.f, 0.f};
    E.init(acc, cur, wr, wc, fr, fq);
    bf16x8 At[4][2], B0[2][2], B1[2][2];
    const char* cA = cur.a; const char* cB = cur.b0; const char* cB1 = cur.b1;
    PG8_STAGE(PG8_SB(0, 0), cB, voffB); PG8_STAGE(PG8_SB(0, 1), cB + hstepB, voffB); PG8_STAGE(PG8_SA(0, 0), cA, voffA); PG8_STAGE(PG8_SA(0, 1), cA + hstepA, voffA);
    if (wr == 1) PG8_BAR;
    PG8_WAIT_V(2); PG8_BAR;
    PG8_STAGE(PG8_SB(1, 0), cB + kstep, voffB); PG8_STAGE(PG8_SA(1, 0), cA + kstep, voffA); PG8_STAGE(PG8_SB(1, 1), cB + hstepB + kstep, voffB);
    PG8_WAIT_V(6); PG8_BAR;
    for (;;) {
        const bool has_next = S.next(ui + 1, nxt);
        const char* nA = has_next ? nxt.a : cA; const char* nB = has_next ? nxt.b0 : cB;
        for (int t = 0; t < nt; t += 2) {
            const bool last = (t == nt - 2);
            const char* a1 = cA + (size_t)(t + 1) * kstep;
            const char* a2 = last ? nA : cA + (size_t)(t + 2) * kstep;
            const char* b2 = last ? nB : ((t + 2) < ks ? cB + (size_t)(t + 2) * kstep : cB1 + (size_t)(t + 2 - ks) * kstep);
            const char* a3 = a2 + kstep; const char* b3 = b2 + kstep;
            PG8_LDB(B0, 0, 0); PG8_LDB(B1, 0, 1); PG8_SCHED; PG8_LDA(At, 0, 0); PG8_STAGE(PG8_SA(1, 1), a1 + hstepA, voffA);
            PG8_WAIT_V(8); PG8_WAIT_L(0); PG8_BAR; PG8_MMA(0, 0, At, B0); PG8_MMA(0, 1, At, B1); PG8_BAR; PG8_SCHED;
            PG8_LDA(At, 0, 1); PG8_STAGE(PG8_SB(0, 0), b2, voffB); PG8_STAGE(PG8_SB(0, 1), b2 + hstepB, voffB); PG8_STAGE(PG8_SA(0, 0), a2, voffA);
            PG8_WAIT_V(8); PG8_WAIT_L(0); PG8_BAR; PG8_MMA(1, 0, At, B0); PG8_MMA(1, 1, At, B1); PG8_BAR; PG8_SCHED;
            PG8_LDB(B0, 1, 0); PG8_LDB(B1, 1, 1); PG8_SCHED; PG8_LDA(At, 1, 0); PG8_STAGE(PG8_SA(0, 1), a2 + hstepA, voffA);
            PG8_WAIT_V(8); PG8_WAIT_L(0); PG8_BAR; PG8_MMA(0, 0, At, B0); PG8_MMA(0, 1, At, B1); PG8_BAR; PG8_SCHED;
            PG8_LDA(At, 1, 1); PG8_STAGE(PG8_SB(1, 0), b3, voffB); PG8_STAGE(PG8_SB(1, 1), b3 + hstepB, voffB); PG8_STAGE(PG8_SA(1, 0), a3, voffA);
            PG8_WAIT_V(8); PG8_WAIT_L(0); PG8_BAR; PG8_MMA(1, 0, At, B0); PG8_MMA(1, 1, At, B1); PG8_BAR; PG8_SCHED;
        }
        if (wr == 0) PG8_BAR;
        E(acc, cur, wr, wc, fr, fq);
        if (!has_next) break;
#pragma unroll
        for (int a = 0; a < 2; ++a)
#pragma unroll
            for (int b = 0; b < 2; ++b)
#pragma unroll
                for (int m = 0; m < 4; ++m)
#pragma unroll
                    for (int n = 0; n < 2; ++n) acc[a][b][m][n] = (f32x4){0.f, 0.f, 0.f, 0.f};
        cur = nxt; cA = nA; cB = nB; cB1 = nxt.b1; ++ui;
        E.init(acc, cur, wr, wc, fr, fq);
        if (wr == 1) PG8_BAR;
    }
    PG8_WAIT_V(0);
    PG8_BAR;
#undef PG8_SA
#undef PG8_SB
#undef PG8_STAGE
#undef PG8_LDA
#undef PG8_LDB
#undef PG8_MMA
#undef PG8_WAIT_V
#undef PG8_WAIT_L
#undef PG8_BAR
#undef PG8_SCHED
}

struct DenseSched {
    int nM, nN, nwg, G, c; const char* A; const char* B; size_t tA, tB;
    __device__ void init(int M, int N, int G_, int c_, const bf16_t* A_, int lda, const bf16_t* B_, int ldb) { nM = M / 256; nN = N / 256; nwg = nM * nN; G = G_; c = c_; A = (const char*)A_; B = (const char*)B_; tA = (size_t)256 * lda * 2; tB = (size_t)256 * ldb * 2; }
    __device__ bool next(int i, Unit& u) const {
        const long L = (long)i * G + c; if (L >= nwg) return false;
        int wgid = (int)L; { const int q = nwg / 8, r = nwg % 8, xcd = wgid % 8, off = wgid / 8; wgid = (xcd < r ? xcd * (q + 1) : r * (q + 1) + (xcd - r) * q) + off; }
        const int nig = 8 * nN, gid = wgid / nig, fm = gid * 8, gsz = (nM - fm) < 8 ? (nM - fm) : 8;
        u.pm = fm + ((wgid % nig) % gsz); u.pn = (wgid % nig) / gsz; u.aux = 256;
        u.a = A + (size_t)u.pm * tA; u.b0 = B + (size_t)u.pn * tB; u.b1 = u.b0; return true;
    }
};
}
using pg8::Unit;

__device__ __forceinline__ float row_rstd(const float* ssp, int row) {
    const f32x4* p = (const f32x4*)(ssp + (size_t)row * 16);
    const f32x4 a = p[0], b = p[1], c = p[2], d = p[3];
    const float s = ((a.x + a.y) + (a.z + a.w)) + ((b.x + b.y) + (b.z + b.w)) + ((c.x + c.y) + (c.z + c.w)) + ((d.x + d.y) + (d.z + d.w));
    return 1.0f / sqrtf(s * (1.0f / 1024.0f) + 1e-6f);
}
__device__ __forceinline__ unsigned short f2h_bits(float f) { _Float16 h = (_Float16)f; return __builtin_bit_cast(unsigned short, h); }
__device__ __forceinline__ float h2f_bits(unsigned short b) { return (float)__builtin_bit_cast(_Float16, b); }

template <int MODE> struct EpiScale {
    bf16_t* O; int ldc; const float* ssp; float scale; const float* lb; bf16_t* halo;
    __device__ __forceinline__ void init(f32x4 (&acc)[2][2][4][2], const Unit& u, int wr, int wc, int fr, int fq) const {}
    __device__ __forceinline__ void operator()(const f32x4 (&acc)[2][2][4][2], const Unit& u, int wr, int wc, int fr_in, int fq_in) const {
        int fr = fr_in, fq = fq_in; asm volatile("" : "+v"(fr), "+v"(fq));
#pragma unroll
        for (int ai = 0; ai < 2; ++ai)
#pragma unroll
            for (int m = 0; m < 4; ++m) {
                const int row = u.pm * 256 + ai * 128 + wr * 64 + m * 16 + fr;
                const float rs = (MODE == 2) ? scale : row_rstd(ssp, row) * scale;
#pragma unroll
                for (int bj = 0; bj < 2; ++bj)
#pragma unroll
                    for (int n = 0; n < 2; ++n) {
                        const int col = u.pn * 256 + bj * 128 + wc * 32 + n * 16 + fq * 4;
                        f32x4 v = acc[ai][bj][m][n] * rs;
                        u32x2 w;
                        if (MODE == 1) {
                            const int blk = col >> 10;
                            if (blk == 0) { v.x = siluf_(v.x); v.y = siluf_(v.y); v.z = siluf_(v.z); v.w = siluf_(v.w); }
                            if (blk == 1) {
                                const f32x4 l = *(const f32x4*)(lb + (col - 1024));
                                float o[4]; const float vv[4] = {v.x, v.y, v.z, v.w}; const float ll[4] = {l.x, l.y, l.z, l.w};
#pragma unroll
                                for (int j = 0; j < 4; ++j) o[j] = __logf(ll[j] + (1.f - ll[j]) * sigmoidf_(vv[j]));
                                w.x = (unsigned)f2h_bits(o[0]) | ((unsigned)f2h_bits(o[1]) << 16); w.y = (unsigned)f2h_bits(o[2]) | ((unsigned)f2h_bits(o[3]) << 16);
                            } else { w.x = pk2(v.x, v.y); w.y = pk2(v.z, v.w); }
                        } else { w.x = pk2(v.x, v.y); w.y = pk2(v.z, v.w); }
                        *(u32x2*)(O + (size_t)row * ldc + col) = w;
                        if (MODE == 0 && halo && col >= 2048 && (row & 63) == 63) *(u32x2*)(halo + (size_t)(row >> 6) * 1792 + (col - 2048)) = w;
                    }
            }
    }
};
struct EpiKV {
    bf16_t* Kb; bf16_t* VT;
    __device__ __forceinline__ void init(f32x4 (&acc)[2][2][4][2], const Unit& u, int wr, int wc, int fr, int fq) const {}
    __device__ __forceinline__ void operator()(const f32x4 (&acc)[2][2][4][2], const Unit& u, int wr, int wc, int fr_in, int fq_in) const {
        int fr = fr_in, fq = fq_in; asm volatile("" : "+v"(fr), "+v"(fq));
#pragma unroll
        for (int ai = 0; ai < 2; ++ai)
#pragma unroll
            for (int m = 0; m < 4; ++m) {
                const int row = u.pm * 256 + ai * 128 + wr * 64 + m * 16 + fr;
#pragma unroll
                for (int bj = 0; bj < 2; ++bj)
#pragma unroll
                    for (int n = 0; n < 2; ++n) {
                        const int col = u.pn * 256 + bj * 128 + wc * 32 + n * 16 + fq * 4;
                        const f32x4 v = acc[ai][bj][m][n];
                        if (col < 1024) { u32x2 w; w.x = pk2(v.x, v.y); w.y = pk2(v.z, v.w); *(u32x2*)(Kb + (size_t)row * 1024 + col) = w; }
                        else {
                            const int c2 = col - 1024, h = c2 >> 8, d = c2 & 255, b = row >> 8, mm = row & 255;
                            bf16_t* p = VT + ((size_t)((b * 4 + h) * 256 + d)) * 256 + mm;
                            p[0] = (bf16_t)f2bf(v.x); p[256] = (bf16_t)f2bf(v.y); p[512] = (bf16_t)f2bf(v.z); p[768] = (bf16_t)f2bf(v.w);
                        }
                    }
            }
    }
};
template <bool SCATTER> struct EpiResid {
    const float* base32; bf16_t* XB; float* ssp; const f32x4* rowinfo;
    __device__ __forceinline__ f32x4 ld_base(size_t off) const {
        if (base32) return *(const f32x4*)(base32 + off);
        const u32x2 r = *(const u32x2*)(XB + off);
        return (f32x4){bf2f((unsigned short)(r.x & 0xffffu)), bf2f((unsigned short)(r.x >> 16)), bf2f((unsigned short)(r.y & 0xffffu)), bf2f((unsigned short)(r.y >> 16))};
    }
    __device__ __forceinline__ void init(f32x4 (&acc)[2][2][4][2], const Unit& u, int wr, int wc, int fr_in, int fq_in) const {
        if (SCATTER) return;
        int fr = fr_in, fq = fq_in; asm volatile("" : "+v"(fr), "+v"(fq));
#pragma unroll
        for (int ai = 0; ai < 2; ++ai)
#pragma unroll
            for (int m = 0; m < 4; ++m) {
                const int row = u.pm * 256 + ai * 128 + wr * 64 + m * 16 + fr;
#pragma unroll
                for (int bj = 0; bj < 2; ++bj)
#pragma unroll
                    for (int n = 0; n < 2; ++n) acc[ai][bj][m][n] = ld_base((size_t)row * 1024 + u.pn * 256 + bj * 128 + wc * 32 + n * 16 + fq * 4);
                asm volatile("" ::: "memory");
            }
    }
    __device__ __forceinline__ void operator()(const f32x4 (&acc)[2][2][4][2], const Unit& u, int wr, int wc, int fr_in, int fq_in) const {
        int fr = fr_in, fq = fq_in; asm volatile("" : "+v"(fr), "+v"(fq));
#pragma unroll
        for (int ai = 0; ai < 2; ++ai)
#pragma unroll
            for (int m = 0; m < 4; ++m) {
                const int lrow = ai * 128 + wr * 64 + m * 16 + fr;
                const int row = u.pm * 256 + lrow;
                int tok = row; bool valid = true;
                if (SCATTER) { valid = lrow < u.aux; const f32x4 ri = rowinfo[row]; tok = valid ? __float_as_int(ri.w) : 0; }
                float ss = 0.f;
#pragma unroll
                for (int bj = 0; bj < 2; ++bj)
#pragma unroll
                    for (int n = 0; n < 2; ++n) {
                        const int col = u.pn * 256 + bj * 128 + wc * 32 + n * 16 + fq * 4;
                        const size_t off = (size_t)tok * 1024 + col;
                        f32x4 v = acc[ai][bj][m][n];
                        if (SCATTER) v = v + ld_base(off);
                        if (valid) { u32x2 w; w.x = pk2(v.x, v.y); w.y = pk2(v.z, v.w); *(u32x2*)(XB + off) = w; }
                        ss += (v.x * v.x + v.y * v.y) + (v.z * v.z + v.w * v.w);
                    }
                ss += __shfl_xor(ss, 16); ss += __shfl_xor(ss, 32);
                if (valid && fq == 0) ssp[(size_t)tok * 16 + u.pn * 4 + wc] = ss;
            }
    }
};
struct EpiMoeUp {
    bf16_t* HID; const f32x4* rowinfo;
    __device__ __forceinline__ void init(f32x4 (&acc)[2][2][4][2], const Unit& u, int wr, int wc, int fr, int fq) const {}
    __device__ __forceinline__ void operator()(const f32x4 (&acc)[2][2][4][2], const Unit& u, int wr, int wc, int fr_in, int fq_in) const {
        int fr = fr_in, fq = fq_in; asm volatile("" : "+v"(fr), "+v"(fq));
        const int slot = u.pn >> 1, jj = u.pn & 1;
#pragma unroll
        for (int ai = 0; ai < 2; ++ai)
#pragma unroll
            for (int m = 0; m < 4; ++m) {
                const int row = u.pm * 256 + ai * 128 + wr * 64 + m * 16 + fr;
                const f32x4 ri = rowinfo[row];
                const float rs = ri.x, gt = slot ? ri.z : ri.y;
#pragma unroll
                for (int n = 0; n < 2; ++n) {
                    const f32x4 h1 = acc[ai][0][m][n] * rs, h3 = acc[ai][1][m][n] * rs;
                    const int col = slot * 256 + jj * 128 + wc * 32 + n * 16 + fq * 4;
                    u32x2 w; w.x = pk2(siluf_(h1.x) * h3.x * gt, siluf_(h1.y) * h3.y * gt); w.y = pk2(siluf_(h1.z) * h3.z * gt, siluf_(h1.w) * h3.w * gt);
                    *(u32x2*)(HID + (size_t)row * 512 + col) = w;
                }
            }
    }
};
__device__ __forceinline__ void pair_experts(int bucket, int& ea, int& eb) {
    const int g = bucket / 6, p = bucket % 6;
    const int i = (p < 3) ? 0 : (p < 5 ? 1 : 2);
    const int j = (p < 3) ? p + 1 : (p < 5 ? p - 1 : 3);
    ea = g * 4 + i; eb = g * 4 + j;
}
template <bool DOWN> struct MoeSched {
    const LAS int* tbl; int ntiles, G, c; const char* A; const char* W;
    __device__ bool next(int i, Unit& u) const {
        const int L = i * G + c, mt = L >> 2, pn = L & 3;
        if (mt >= ntiles) return false;
        const int ent = __builtin_amdgcn_readfirstlane(tbl[mt]), bucket = ent & 255; u.aux = ent >> 8;
        int ea, eb; pair_experts(bucket, ea, eb);
        u.pm = mt; u.pn = pn;
        if (!DOWN) { u.a = A + (size_t)mt * 256 * 1024 * 2; const int e = (pn < 2) ? ea : eb; u.b0 = W + ((size_t)e * 512 + 256 * (pn & 1)) * 1024 * 2; u.b1 = u.b0; }
        else { u.a = A + (size_t)mt * 256 * 512 * 2; u.b0 = W + ((size_t)ea * 1024 + 256 * pn) * 256 * 2; u.b1 = W + ((size_t)eb * 1024 + 256 * pn) * 256 * 2; }
        return true;
    }
};
__device__ __forceinline__ void moe_build_table(LAS int* tbl, const unsigned* cnt, int tid) {
    if (tid == 0) { int mt = 0;
        for (int b = 0; b < 24; ++b) { const int nb = (int)cnt[b]; for (int r = 0; r < nb; r += 256) { const int v = (nb - r) < 256 ? (nb - r) : 256; if (mt < 95) tbl[mt] = b | (v << 8); ++mt; } }
        tbl[95] = mt < 95 ? mt : 95; }
    __syncthreads();
}

#define XB_TMO      128
#define XB_XCNT(j)  (256  + 64 * (j))
#define XB_XSUB(j)  (1280 + 64 * (j))
#define XB_XGEN(j)  (2304 + 64 * (j))
#define XB_TOP      3328
#define XB_TOPGEN   3392
#define XCD_BAR_WORDS 3456
#define XB_SPIN_CAP (1u << 22)
__device__ __forceinline__ unsigned xb_ld(unsigned* p)              { return __hip_atomic_load(p, __ATOMIC_RELAXED, __HIP_MEMORY_SCOPE_AGENT); }
__device__ __forceinline__ unsigned xb_add(unsigned* p, unsigned v) { return __hip_atomic_fetch_add(p, v, __ATOMIC_RELAXED, __HIP_MEMORY_SCOPE_AGENT); }
__device__ __forceinline__ unsigned xb_xcc_id() { return (unsigned)__builtin_amdgcn_s_getreg((3 << 11) | 20) & 0xFu; }
#define XB_SPIN(cond, bar) do { unsigned _sp = 0; while (cond) { __builtin_amdgcn_s_sleep(1); \
    if ((++_sp & 255u) == 0u) { if (xb_ld(&(bar)[XB_TMO])) break; if (_sp > XB_SPIN_CAP) { atomicAdd(&(bar)[XB_TMO], 1u); break; } } } } while (0)
struct XcdBarrier { unsigned* bar; unsigned x; volatile LAS unsigned* st; int wave; };
__device__ __forceinline__ XcdBarrier xcd_barrier_post(unsigned* bar, volatile LAS unsigned* st, int wave) {
    XcdBarrier b; b.bar = bar; b.x = xb_xcc_id(); b.st = st; b.wave = wave;
    if (wave == 0 && lane_id_v() == 0) (void)xb_add(&bar[XB_XCNT(b.x)], 1u);
    return b;
}
__device__ __forceinline__ void xcd_barrier_complete(unsigned* bar, unsigned x, unsigned& nloc, unsigned& nx) {
    const unsigned G = gridDim.x * gridDim.y * gridDim.z;
    unsigned sum, cnt, mine, sp = 0u;
    for (;;) {
        sum = 0u; cnt = 0u; mine = 0u;
#pragma unroll
        for (unsigned j = 0; j < 16; ++j) { const unsigned c = xb_ld(&bar[XB_XCNT(j)]); sum += c; cnt += (c > 0u) ? 1u : 0u; mine = (j == x) ? c : mine; }
        if (sum == G) break;
        __builtin_amdgcn_s_sleep(1);
        if ((++sp & 255u) == 0u) { if (xb_ld(&bar[XB_TMO])) break; if (sp > XB_SPIN_CAP) { atomicAdd(&bar[XB_TMO], 1u); break; } }
    }
    nloc = mine > 0u ? mine : 1u; nx = cnt > 0u ? cnt : 1u;
}
__device__ __forceinline__ void xcd_barrier(const XcdBarrier& b) {
    asm volatile("s_waitcnt vmcnt(0)" ::: "memory");
    __syncthreads();
    if (b.wave == 0 && lane_id_v() == 0) {
        unsigned* bar = b.bar;
        __builtin_amdgcn_s_waitcnt(0);
        unsigned nloc = b.st[0], nx = b.st[1];
        if (nloc == 0u) { xcd_barrier_complete(bar, b.x, nloc, nx); b.st[0] = nloc; b.st[1] = nx; }
        const unsigned old = xb_add(&bar[XB_XSUB(b.x)], 1u);
        const unsigned gen = old / nloc;
        if (old + 1u == (gen + 1u) * nloc) {
            __builtin_amdgcn_fence(__ATOMIC_RELEASE, "agent");
            asm volatile("s_waitcnt vmcnt(0)" ::: "memory");
            const unsigned og = xb_add(&bar[XB_TOP], 1u);
            const unsigned tg = og / nx;
            if (og + 1u == (tg + 1u) * nx) xb_add(&bar[XB_TOPGEN], 1u);
            else XB_SPIN(xb_ld(&bar[XB_TOPGEN]) == tg, bar);
            __builtin_amdgcn_fence(__ATOMIC_ACQUIRE, "agent");
            xb_add(&bar[XB_XGEN(b.x)], 1u);
            asm volatile("s_waitcnt vmcnt(0)" ::: "memory");
        } else {
            XB_SPIN(xb_ld(&bar[XB_XGEN(b.x)]) == gen, bar);
            __builtin_amdgcn_fence(__ATOMIC_ACQUIRE, "agent");
            asm volatile("s_waitcnt vmcnt(0)" ::: "memory");
        }
    }
    __syncthreads();
}

struct Args { const float* in[38]; float* out; unsigned char* ws; int ph_lo, ph_hi; };
constexpr int LDS_BYTES = 161792;
constexpr int LDS_MISC = 156 * 1024;
struct InTab {
    const LAS unsigned long long* t;
    __device__ __forceinline__ const float* operator[](int i) const {
        const unsigned long long v = t[i];
        const unsigned lo = __builtin_amdgcn_readfirstlane((unsigned)v), hi = __builtin_amdgcn_readfirstlane((unsigned)(v >> 32));
        return (const float*)(((unsigned long long)hi << 32) | lo); }
};
struct Frame {
    LAS unsigned char* lds; int wave, G, wg;
    InTab in; float* out; unsigned char* ws;
};
#define IN_X 0
#define IN_MEM 1
#define IN_NORM_MIX 2
#define IN_NORM_XA 3
#define IN_NORM_MEM 4
#define IN_NORM_FFN 5
#define IN_NORM_FINAL 6
#define IN_AB_WIN 7
#define IN_AB_CONV 8
#define IN_AB_ALOG 9
#define IN_AB_DTB 10
#define IN_AB_ONORM 11
#define IN_AB_MU 12
#define IN_AB_W0 13
#define IN_AB_W2 14
#define IN_AB_A0 15
#define IN_AB_A2 16
#define IN_AB_G2 17
#define IN_AB_KK 18
#define IN_AB_KA 19
#define IN_AB_RK 20
#define IN_AB_LNW 21
#define IN_AB_LNB 22
#define IN_AB_WOUT 23
#define IN_C_WIN 24
#define IN_C_LB 25
#define IN_C_ONORM 26
#define IN_C_WOUT 27
#define IN_XA_WQ 28
#define IN_XA_WKV 29
#define IN_XA_WO 30
#define IN_MOE_WG 31
#define IN_MOE_BG 32
#define IN_MOE_WE 33
#define IN_MOE_BE 34
#define IN_MOE_W1 35
#define IN_MOE_W3 36
#define IN_MOE_W2 37

__device__ __forceinline__ void p0_transpose_item(const float* W, int ld, int col0, int ncols, int K, const float* gain, bf16_t* WT, int drow0, LAS float* scr, int item, int lane) {
    const int nblk = ncols / 32, kb = item / nblk, nb = item % nblk, k0 = 64 * kb, n0 = 32 * nb;
    float vv[32];
#pragma unroll
    for (int i = 0; i < 32; ++i) vv[i] = W[(size_t)(k0 + 2 * i + (lane >> 5)) * ld + col0 + n0 + (lane & 31)];
#pragma unroll
    for (int i = 0; i < 32; ++i) { const int kk = 2 * i + (lane >> 5); float v = vv[i]; if (gain) v *= gain[k0 + kk]; scr[kk * 33 + (lane & 31)] = v; }
    LDS_WAIT(); asm volatile("" ::: "memory");
    const int c = lane & 7;
#pragma unroll
    for (int j = 0; j < 4; ++j) { const int n = (lane >> 3) + 8 * j; const LAS float* s = scr + (8 * c) * 33 + n;
        u32x4 o; o.x = pk2(s[0 * 33], s[1 * 33]); o.y = pk2(s[2 * 33], s[3 * 33]); o.z = pk2(s[4 * 33], s[5 * 33]); o.w = pk2(s[6 * 33], s[7 * 33]);
        *(u32x4*)(WT + (size_t)(drow0 + n0 + n) * K + k0 + 8 * c) = o; }
    LDS_WAIT(); asm volatile("" ::: "memory");
}
__device__ __forceinline__ void p0_weight_item(const Frame& F, int it, LAS float* scr, int lane) {
    const InTab in = F.in;
    bf16_t* W0 = (bf16_t*)(F.ws + WS_W0); bf16_t* W1 = (bf16_t*)(F.ws + WS_W1);
    if (it < 16384) {
        const int l = it >> 13; int r = it & 8191; bf16_t* W = l ? W1 : W0;
        if (r < 512) { p0_transpose_item(in[IN_XA_WQ] + (size_t)l * 1024 * 1024, 1024, 0, 1024, 1024, in[IN_NORM_XA] + l * 1024, W + WO_WQ, 0, scr, r, lane); return; }
        r -= 512;
        if (r < 1024) { p0_transpose_item(in[IN_XA_WKV] + (size_t)l * 1024 * 2048, 2048, 0, 2048, 1024, in[IN_NORM_MEM] + l * 1024, W + WO_WKV, 0, scr, r, lane); return; }
        r -= 1024;
        if (r < 512) { p0_transpose_item(in[IN_XA_WO] + (size_t)l * 1024 * 1024, 1024, 0, 1024, 1024, nullptr, W + WO_WO, 0, scr, r, lane); return; }
        r -= 512;
        if (r < 4096) { const int sub = r >> 6, item = r & 63, e = sub >> 2, j = (sub >> 1) & 1, which = sub & 1;
            const float* src = (which ? in[IN_MOE_W3] : in[IN_MOE_W1]) + (size_t)(l * 16 + e) * 1024 * 256;
            p0_transpose_item(src, 256, 128 * j, 128, 1024, in[IN_NORM_FFN] + l * 1024, W + WO_W13, e * 512 + 256 * j + 128 * which, scr, item, lane); return; }
        r -= 4096;
        { const int e = r >> 7, item = r & 127;
            p0_transpose_item(in[IN_MOE_W2] + (size_t)(l * 16 + e) * 256 * 1024, 1024, 0, 1024, 256, nullptr, W + WO_W2T + (size_t)e * 1024 * 256, 0, scr, item, lane); return; }
    }
    int r = it - 16384;
    if (r < 1024) { p0_transpose_item(in[IN_AB_WIN], 3848, 0, 2048, 1024, in[IN_NORM_MIX], W0 + WO_WIN, 0, scr, r, lane); return; }
    r -= 1024;
    if (r < 896) { p0_transpose_item(in[IN_AB_WIN], 3848, 2056, 1792, 1024, in[IN_NORM_MIX], W0 + WO_WIN, 2048, scr, r, lane); return; }
    r -= 896;
    if (r < 512) { p0_transpose_item(in[IN_AB_WOUT], 1024, 0, 1024, 1024, nullptr, W0 + WO_WOUT, 0, scr, r, lane); return; }
    r -= 512;
    if (r < 2048) { p0_transpose_item(in[IN_C_WIN], 4096, 0, 4096, 1024, in[IN_NORM_MIX] + 1024, W1 + WO_WIN, 0, scr, r, lane); return; }
    r -= 2048;
    if (r < 512) { p0_transpose_item(in[IN_C_WOUT], 1024, 0, 1024, 1024, nullptr, W1 + WO_WOUT, 0, scr, r, lane); return; }
    r -= 512;
    bf16_t* LW = (bf16_t*)(F.ws + WS_LORA);
    if (r < 16) { p0_transpose_item(in[IN_AB_W2], 512, 0, 512, 64, nullptr, LW, 0, scr, r, lane); return; }
    r -= 16;
    if (r < 16) { p0_transpose_item(in[IN_AB_A2], 512, 0, 512, 64, nullptr, LW + 512 * 64, 0, scr, r, lane); return; }
    r -= 16;
    p0_transpose_item(in[IN_AB_G2], 512, 0, 512, 128, nullptr, LW + 2 * 512 * 64, 0, scr, r, lane);
}
constexpr int P0_NITEMS = 16384 + 1024 + 896 + 512 + 2048 + 512 + 64;

template <int SEL> __device__ __forceinline__ void p0_late_weights(const Frame& F, int worker, int nworkers) {
    const int lane = lane_id_v();
    LAS float* scr = (LAS float*)(F.lds + F.wave * 16384);
    const int gw = worker * NWAVES + F.wave, NGW = nworkers * NWAVES;
    if (SEL == 0) {
        for (int it = gw; it < 8192 + 512 + 2048 + 1024; it += NGW) {
            int item;
            if (it < 8192) { item = it; if (item >= 512 && item < 1536) continue; }
            else if (it < 8192 + 512) item = 16384 + 1920 + (it - 8192);
            else if (it < 8192 + 512 + 2048) item = 16384 + 1920 + 512 + (it - 8192 - 512);
            else item = 8192 + 512 + (it - 8192 - 512 - 2048);
            p0_weight_item(F, item, scr, lane);
        }
    } else {
        for (int it = gw; it < 512 + 6656 + 512; it += NGW) {
            int item;
            if (it < 512) item = 8192 + it;
            else if (it < 512 + 6656) item = 8192 + 1536 + (it - 512);
            else item = 16384 + 1920 + 512 + 2048 + (it - 512 - 6656);
            p0_weight_item(F, item, scr, lane);
        }
    }
}
__device__ __forceinline__ void p0_prologue(const Frame& F) {
    const int lane = lane_id_v(); const int tid = F.wave * 64 + lane; (void)tid;
    LAS float* scr = (LAS float*)(F.lds + F.wave * 16384);
    const int gw = F.wg * NWAVES + F.wave, NGW = F.G * NWAVES;
    for (int it = gw; it < 1920 + 64 + 1024; it += NGW) p0_weight_item(F, it < 1920 ? 16384 + it : (it < 1984 ? P0_NITEMS - 64 + (it - 1920) : 512 + (it - 1984)), scr, lane);
    const float* x = F.in[IN_X]; const float* gain = F.in[IN_NORM_MIX]; const float* win = F.in[IN_AB_WIN];
    bf16_t* XB = (bf16_t*)(F.ws + WS_XB); float* ssp = (float*)(F.ws + WS_SSP); float* db = (float*)(F.ws + WS_DB);
    for (int grp = gw; grp < NT / 4; grp += NGW) {
        const int r0 = grp * 4;
        float d[4][8], sq[4];
#pragma unroll
        for (int r = 0; r < 4; ++r) { sq[r] = 0.f;
#pragma unroll
            for (int c = 0; c < 8; ++c) d[r][c] = 0.f; }
#pragma unroll 1
        for (int j = 0; j < 4; ++j) {
            const int k0 = 4 * lane + 256 * j;
            const f32x4 g = *(const f32x4*)(gain + k0); const float gq[4] = {g.x, g.y, g.z, g.w};
            float wq[4][8];
#pragma unroll
            for (int q = 0; q < 4; ++q) {
                const f32x4 w0 = *(const f32x4*)(win + (size_t)(k0 + q) * 3848 + 2048), w1 = *(const f32x4*)(win + (size_t)(k0 + q) * 3848 + 2052);
                wq[q][0] = w0.x * gq[q]; wq[q][1] = w0.y * gq[q]; wq[q][2] = w0.z * gq[q]; wq[q][3] = w0.w * gq[q];
                wq[q][4] = w1.x * gq[q]; wq[q][5] = w1.y * gq[q]; wq[q][6] = w1.z * gq[q]; wq[q][7] = w1.w * gq[q];
            }
#pragma unroll
            for (int r = 0; r < 4; ++r) {
                const f32x4 v = *((const f32x4*)(x + (size_t)(r0 + r) * 1024) + lane + 64 * j);
                sq[r] += (v.x * v.x + v.y * v.y) + (v.z * v.z + v.w * v.w);
                *((unsigned long long*)(XB + (size_t)(r0 + r) * 1024) + lane + 64 * j) = (unsigned long long)pk2(v.x, v.y) | ((unsigned long long)pk2(v.z, v.w) << 32);
                const float xv[4] = {v.x, v.y, v.z, v.w};
#pragma unroll
                for (int q = 0; q < 4; ++q)
#pragma unroll
                    for (int c = 0; c < 8; ++c) d[r][c] += xv[q] * wq[q][c];
            }
        }
#pragma unroll
        for (int r = 0; r < 4; ++r) {
            const float s = wsum(sq[r]);
            const float rstd = 1.0f / sqrtf(s * (1.0f / 1024.0f) + 1e-6f);
            float dv = 0.f;
#pragma unroll
            for (int c = 0; c < 8; ++c) { const float t = wsum(d[r][c]) * rstd; dv = (lane == c) ? t : dv; }
            if (lane < 16) ssp[(size_t)(r0 + r) * 16 + lane] = (lane == 0) ? s : 0.f;
            if (lane < 8) db[(size_t)(r0 + r) * 8 + lane] = dv;
        }
    }
    const float* mem = F.in[IN_MEM]; bf16_t* MH = (bf16_t*)(F.ws + WS_MEMH);
    for (int row = gw; row < NB * NMEM; row += NGW) {
        const f32x4* xr = (const f32x4*)(mem + (size_t)row * 1024) + lane;
        f32x4 v[4]; float s = 0.f;
#pragma unroll
        for (int j = 0; j < 4; ++j) { v[j] = xr[64 * j]; s += (v[j].x * v[j].x + v[j].y * v[j].y) + (v[j].z * v[j].z + v[j].w * v[j].w); }
        s = wsum(s);
        const float rstd = 1.0f / sqrtf(s * (1.0f / 1024.0f) + 1e-6f);
        unsigned long long* o8 = (unsigned long long*)(MH + (size_t)row * 1024) + lane;
#pragma unroll
        for (int j = 0; j < 4; ++j) o8[64 * j] = (unsigned long long)pk2(v[j].x * rstd, v[j].y * rstd) | ((unsigned long long)pk2(v[j].z * rstd, v[j].w * rstd) << 32);
    }
    {
        float* rw = (float*)(F.ws + WS_RW);
        for (int idx = F.wg * NTHREADS + tid; idx < 2 * 1024 * 32; idx += F.G * NTHREADS) {
            const int l = idx >> 15, k = (idx >> 5) & 1023, cc = idx & 31;
            const float g = F.in[IN_NORM_FFN][l * 1024 + k];
            float v = 0.f;
            if (cc < 4) v = F.in[IN_MOE_WG][(size_t)l * 4096 + k * 4 + cc] * g; else if (cc < 20) v = F.in[IN_MOE_WE][(size_t)l * 16384 + k * 16 + (cc - 4)] * g;
            rw[idx] = v;
        }
    }
    if (F.wg == 0) { const float* lbp = F.in[IN_C_LB]; float* lb = (float*)(F.ws + WS_LB);
        for (int c = tid; c < 1024; c += NTHREADS) { const float a = lbp[c], b = lbp[1024 + c]; const float mx = fmaxf(a, b), ea = __expf(a - mx), eb = __expf(b - mx); lb[c] = (ea + eb) / (ea + eb) - ea / (ea + eb); } }
}

__device__ __forceinline__ void scan_delta(const Frame& F, int b, int h) {
    const int lane = lane_id_v(); const int tid = F.wave * 64 + lane; (void)tid;
    LAS float* qs = (LAS float*)F.lds;
    LAS float* ks = qs + 64 * 128;
    LAS float* vs = ks + 64 * 128;
    LAS float* os = vs + 64 * 128;
    LAS float* al = os + 64 * 128;
    LAS float* be = al + 64;
    bf16_t* P = (bf16_t*)(F.ws + WS_BIG + BIG_PROJ);
    const float* convw = F.in[IN_AB_CONV];
    const float* db = (const float*)(F.ws + WS_DB);
    const float a_neg = -__expf(F.in[IN_AB_ALOG][h]), dtb = F.in[IN_AB_DTB][h];
    const float* onorm = F.in[IN_AB_ONORM];
    const int i_dv = tid >> 2, part = tid & 3;
    float s[32];
#pragma unroll
    for (int j = 0; j < 32; ++j) s[j] = 0.f;
    for (int c = 0; c < 32; ++c) {
        const int t0 = b * TS + c * 64;
        for (int idx = tid; idx < 64 * 384; idx += NTHREADS) {
            const int t = idx / 384, cc = idx % 384, sct = cc >> 7, col = cc & 127;
            const int gcol = sct * 512 + h * 128 + col;
            float a = 0.f;
#pragma unroll
            for (int j = 0; j < 4; ++j) { const int tl = c * 64 + t - 3 + j; if (tl >= 0) a += convw[j * 1536 + gcol] * bf2f(P[(size_t)(b * TS + tl) * P0LD + gcol]); }
            a = siluf_(a);
            (sct == 0 ? qs : (sct == 1 ? ks : vs))[t * 128 + col] = a;
        }
        if (tid < 64) { const int t = tid; const float la = a_neg * softplusf_(db[(size_t)(t0 + t) * 8 + h] + dtb); al[t] = __expf(la); be[t] = sigmoidf_(db[(size_t)(t0 + t) * 8 + 4 + h]); }
        __syncthreads();
        for (int r = F.wave; r < 128; r += NWAVES) { LAS float* p = (r < 64 ? qs + r * 128 : ks + (r - 64) * 128);
            const float v0 = p[lane], v1 = p[lane + 64]; const float ss = wave_sum(v0 * v0 + v1 * v1);
            const float sc = (1.0f / sqrtf(ss + 1e-6f)) * (r < 64 ? 0.08838834764831845f : 1.0f); p[lane] = v0 * sc; p[lane + 64] = v1 * sc; }
        __syncthreads();
        for (int t = 0; t < 64; ++t) {
            const LAS f32x4* kp = (const LAS f32x4*)(ks + t * 128 + part * 32); const LAS f32x4* qp = (const LAS f32x4*)(qs + t * 128 + part * 32);
            float kt[32], qt[32];
#pragma unroll
            for (int j = 0; j < 8; ++j) { const f32x4 a = kp[j], q = qp[j]; kt[4 * j] = a.x; kt[4 * j + 1] = a.y; kt[4 * j + 2] = a.z; kt[4 * j + 3] = a.w; qt[4 * j] = q.x; qt[4 * j + 1] = q.y; qt[4 * j + 2] = q.z; qt[4 * j + 3] = q.w; }
            float p = 0.f;
#pragma unroll
            for (int j = 0; j < 32; ++j) p += s[j] * kt[j];
            p += __shfl_xor(p, 1); p += __shfl_xor(p, 2);
            const float alpha = al[t], coef = be[t] * (vs[t * 128 + i_dv] - alpha * p);
            float o = 0.f;
#pragma unroll
            for (int j = 0; j < 32; ++j) { s[j] = alpha * s[j] + coef * kt[j]; o += s[j] * qt[j]; }
            o += __shfl_xor(o, 1); o += __shfl_xor(o, 2);
            if (part == 0) os[t * 128 + i_dv] = o;
        }
        __syncthreads();
        for (int t = F.wave; t < 64; t += NWAVES) {
            const float o0 = os[t * 128 + lane], o1 = os[t * 128 + lane + 64];
            const float ss = wave_sum(o0 * o0 + o1 * o1), rs = 1.0f / sqrtf(ss * (1.0f / 128.0f) + 1e-6f);
            bf16_t* gp = P + (size_t)(t0 + t) * P0LD + 1536 + h * 128;
            const float g0 = bf2f(gp[lane]), g1 = bf2f(gp[lane + 64]);
            gp[lane] = (bf16_t)f2bf(o0 * rs * onorm[lane] * siluf_(g0)); gp[lane + 64] = (bf16_t)f2bf(o1 * rs * onorm[lane + 64] * siluf_(g1));
        }
        __syncthreads();
    }
}
__device__ __forceinline__ void scan_rwkv(const Frame& F, int b, int h) {
    const int lane = lane_id_v(); const int tid = F.wave * 64 + lane; (void)tid;
    LAS float* bufA = (LAS float*)F.lds;
    LAS float* bufB = bufA + 4096;
    LAS float* bufC = bufB + 4096;
    LAS float* R = bufC + 8192;
    LAS float* Kb = R + 4096;
    LAS float* V = Kb + 4096;
    LAS float* KK = V + 4096;
    LAS float* halo = KK + 4096;
    LAS float* bonus = halo + 896;
    bf16_t* P = (bf16_t*)(F.ws + WS_BIG + BIG_PROJ);
    const float* mu = F.in[IN_AB_MU];
    const float* w0 = F.in[IN_AB_W0] + h * 64; const float* w2 = F.in[IN_AB_W2] + h * 64;
    const float* a0 = F.in[IN_AB_A0] + h * 64; const float* a2 = F.in[IN_AB_A2] + h * 64;
    const float* g2 = F.in[IN_AB_G2] + h * 64;
    const float* k_k = F.in[IN_AB_KK] + h * 64; const float* k_a = F.in[IN_AB_KA] + h * 64; const float* r_k = F.in[IN_AB_RK] + h * 64;
    const float* ln_w = F.in[IN_AB_LNW] + h * 64; const float* ln_b = F.in[IN_AB_LNB] + h * 64;
    const int vi = tid >> 3, part = tid & 7;
    float s[8];
#pragma unroll
    for (int j = 0; j < 8; ++j) s[j] = 0.f;
    for (int i = tid; i < 896; i += NTHREADS) halo[i] = 0.f;
    __syncthreads();
    for (int c = 0; c < 32; ++c) {
        const int t0 = b * TS + c * 64;
        const LAS float* hcur = halo + (c & 1) * 448; LAS float* hnext = halo + ((c + 1) & 1) * 448;
        for (int idx = tid; idx < 64 * 448; idx += NTHREADS) {
            const int t = idx / 448, col = idx % 448;
            int gc;
            if (col < 64) gc = 2048 + h * 64 + col; else if (col < 128) gc = 2560 + h * 64 + (col - 64); else if (col < 192) gc = 3072 + h * 64 + (col - 128); else gc = 3584 + (col - 192);
            const float cur = bf2f(P[(size_t)(t0 + t) * P0LD + gc]);
            const float prev = (t > 0) ? bf2f(P[(size_t)(t0 + t - 1) * P0LD + gc]) : hcur[col];
            const float sh = cur + mu[gc - 2048] * (prev - cur);
            if (t == 63) hnext[col] = cur;
            if (col < 64) R[t * 64 + col] = sh; else if (col < 128) Kb[t * 64 + col - 64] = sh; else if (col < 192) V[t * 64 + col - 128] = sh;
            else if (col < 256) bufA[t * 64 + col - 192] = tanhf(sh); else if (col < 320) bufB[t * 64 + col - 256] = sh; else bufC[t * 128 + col - 320] = sigmoidf_(sh);
        }
        __syncthreads();
        float wv[8], av[8], gv[8];
        {
            const int j = lane, tb = F.wave * 8;
#pragma unroll
            for (int q = 0; q < 8; ++q) { wv[q] = 0.f; av[q] = 0.f; gv[q] = 0.f; }
            for (int m = 0; m < 64; ++m) { const float x2 = w2[(size_t)m * 512 + j], y2 = a2[(size_t)m * 512 + j];
#pragma unroll
                for (int q = 0; q < 8; ++q) { wv[q] += bufA[(tb + q) * 64 + m] * x2; av[q] += bufB[(tb + q) * 64 + m] * y2; } }
            for (int m = 0; m < 128; ++m) { const float z2 = g2[(size_t)m * 512 + j];
#pragma unroll
                for (int q = 0; q < 8; ++q) gv[q] += bufC[(tb + q) * 128 + m] * z2; }
#pragma unroll
            for (int q = 0; q < 8; ++q) { wv[q] = __expf(-0.6065306597126334f * sigmoidf_(w0[j] + wv[q])); av[q] = sigmoidf_(a0[j] + av[q]); }
        }
        __syncthreads();
        {
            const int j = lane, tb = F.wave * 8;
#pragma unroll
            for (int q = 0; q < 8; ++q) { bufA[(tb + q) * 64 + j] = wv[q]; bufB[(tb + q) * 64 + j] = av[q]; bufC[(tb + q) * 64 + j] = gv[q]; }
#pragma unroll
            for (int q = 0; q < 8; ++q) { const int t = tb + q; const float kv = Kb[t * 64 + j]; const float kx = kv * k_k[j]; const float ss = wave_sum(kx * kx);
                KK[t * 64 + j] = kx * (1.0f / sqrtf(ss + 1e-6f)); const float km = kv * (1.f + (av[q] - 1.f) * k_a[j]); Kb[t * 64 + j] = km;
                const float bs = wave_sum(R[t * 64 + j] * km * r_k[j]); if (j == 0) bonus[t] = bs; }
        }
        __syncthreads();
        LAS float* O = bufC + 4096;
        for (int t = 0; t < 64; ++t) {
            const LAS f32x4* p4;
            float kk[8], ww[8], aa[8], km[8], rr[8];
            p4 = (const LAS f32x4*)(KK + t * 64 + part * 8);   { const f32x4 a = p4[0], c2 = p4[1]; kk[0] = a.x; kk[1] = a.y; kk[2] = a.z; kk[3] = a.w; kk[4] = c2.x; kk[5] = c2.y; kk[6] = c2.z; kk[7] = c2.w; }
            p4 = (const LAS f32x4*)(bufA + t * 64 + part * 8); { const f32x4 a = p4[0], c2 = p4[1]; ww[0] = a.x; ww[1] = a.y; ww[2] = a.z; ww[3] = a.w; ww[4] = c2.x; ww[5] = c2.y; ww[6] = c2.z; ww[7] = c2.w; }
            p4 = (const LAS f32x4*)(bufB + t * 64 + part * 8); { const f32x4 a = p4[0], c2 = p4[1]; aa[0] = a.x; aa[1] = a.y; aa[2] = a.z; aa[3] = a.w; aa[4] = c2.x; aa[5] = c2.y; aa[6] = c2.z; aa[7] = c2.w; }
            p4 = (const LAS f32x4*)(Kb + t * 64 + part * 8);   { const f32x4 a = p4[0], c2 = p4[1]; km[0] = a.x; km[1] = a.y; km[2] = a.z; km[3] = a.w; km[4] = c2.x; km[5] = c2.y; km[6] = c2.z; km[7] = c2.w; }
            p4 = (const LAS f32x4*)(R + t * 64 + part * 8);    { const f32x4 a = p4[0], c2 = p4[1]; rr[0] = a.x; rr[1] = a.y; rr[2] = a.z; rr[3] = a.w; rr[4] = c2.x; rr[5] = c2.y; rr[6] = c2.z; rr[7] = c2.w; }
            const float vv = V[t * 64 + vi];
            float sa = 0.f;
#pragma unroll
            for (int j = 0; j < 8; ++j) sa -= s[j] * kk[j];
            sa += __shfl_xor(sa, 1); sa += __shfl_xor(sa, 2); sa += __shfl_xor(sa, 4);
            float o = 0.f;
#pragma unroll
            for (int j = 0; j < 8; ++j) { s[j] = s[j] * ww[j] + sa * (kk[j] * aa[j]) + vv * km[j]; o += s[j] * rr[j]; }
            o += __shfl_xor(o, 1); o += __shfl_xor(o, 2); o += __shfl_xor(o, 4);
            if (part == 0) O[t * 64 + vi] = o;
        }
        __syncthreads();
        for (int t = F.wave; t < 64; t += NWAVES) {
            const float o = O[t * 64 + lane];
            const float mean = wave_sum(o) * (1.0f / 64.0f); const float dlt = o - mean; const float var = wave_sum(dlt * dlt) * (1.0f / 64.0f);
            float y = dlt * (1.0f / sqrtf(var + 64e-5f)) * ln_w[lane] + ln_b[lane];
            y += bonus[t] * V[t * 64 + lane];
            y *= bufC[t * 64 + lane];
            P[(size_t)(t0 + t) * P0LD + 2048 + h * 64 + lane] = (bf16_t)f2bf(y);
        }
        __syncthreads();
    }
}
__device__ __forceinline__ void scan_hgrn(const Frame& F, int b, int h) {
    const int lane = lane_id_v(); const int tid = F.wave * 64 + lane; (void)tid;
    LAS float* qs = (LAS float*)F.lds;
    LAS float* fs = qs + 64 * 128;
    LAS float* kf = fs + 64 * 128;
    LAS float* is = kf + 64 * 128;
    bf16_t* P = (bf16_t*)(F.ws + WS_BIG + BIG_PROJ);
    const float* onorm = F.in[IN_C_ONORM];
    const int e = tid >> 2, part = tid & 3;
    float s[32];
#pragma unroll
    for (int j = 0; j < 32; ++j) s[j] = 0.f;
    for (int c = 0; c < 32; ++c) {
        const int t0 = b * TS + c * 64;
        for (int idx = tid; idx < 64 * 128; idx += NTHREADS) {
            const int t = idx >> 7, col = idx & 127; const bf16_t* pr = P + (size_t)(t0 + t) * P1LD + h * 128 + col;
            qs[idx] = bf2f(pr[0]); const float lf = h2f_bits(pr[1024]); fs[idx] = __expf(lf); kf[idx] = -expm1f(lf); is[idx] = bf2f(pr[2048]);
        }
        __syncthreads();
        for (int t = 0; t < 64; ++t) {
            const LAS f32x4* fp = (const LAS f32x4*)(fs + t * 128 + part * 32); const LAS f32x4* kp = (const LAS f32x4*)(kf + t * 128 + part * 32); const LAS f32x4* qp = (const LAS f32x4*)(qs + t * 128 + part * 32);
            const float iv = is[t * 128 + e];
            float o = 0.f;
#pragma unroll
            for (int j = 0; j < 8; ++j) { const f32x4 f = fp[j], k = kp[j], q = qp[j];
                s[4 * j] = f.x * s[4 * j] + k.x * iv; o += s[4 * j] * q.x;
                s[4 * j + 1] = f.y * s[4 * j + 1] + k.y * iv; o += s[4 * j + 1] * q.y;
                s[4 * j + 2] = f.z * s[4 * j + 2] + k.z * iv; o += s[4 * j + 2] * q.z;
                s[4 * j + 3] = f.w * s[4 * j + 3] + k.w * iv; o += s[4 * j + 3] * q.w; }
            o += __shfl_xor(o, 1); o += __shfl_xor(o, 2);
            if (part == 0) is[t * 128 + e] = o;
        }
        __syncthreads();
        for (int t = F.wave; t < 64; t += NWAVES) {
            const float o0 = is[t * 128 + lane], o1 = is[t * 128 + lane + 64];
            const float ss = wave_sum(o0 * o0 + o1 * o1), rs = 1.0f / sqrtf(ss * (1.0f / 128.0f) + 1e-6f);
            bf16_t* gp = P + (size_t)(t0 + t) * P1LD + 3072 + h * 128;
            const float g0 = bf2f(gp[lane]), g1 = bf2f(gp[lane + 64]);
            gp[lane] = (bf16_t)f2bf(o0 * rs * onorm[lane] * siluf_(g0)); gp[lane + 64] = (bf16_t)f2bf(o1 * rs * onorm[lane + 64] * siluf_(g1));
        }
        __syncthreads();
    }
}

__device__ __forceinline__ void scan_delta2(const Frame& F, int b, int h, int qd) {
    const int lane = lane_id_v(); const int tid = F.wave * 64 + lane;
    LAS float* Kc = (LAS float*)F.lds;
    LAS float* Qc = Kc + 64 * 128;
    LAS float* Vc = Qc + 64 * 128;
    LAS float* Oc = Vc + 64 * 32;
    LAS float* al = Oc + 64 * 32;
    LAS float* be = al + 64;
    LAS float* vh = be + 64;
    bf16_t* P = (bf16_t*)(F.ws + WS_BIG + BIG_PROJ);
    const float* convw = F.in[IN_AB_CONV];
    const float* db = (const float*)(F.ws + WS_DB);
    const float a_neg = -__expf(F.in[IN_AB_ALOG][h]), dtb = F.in[IN_AB_DTB][h];
    const int w = F.wave;
    const int vcol = 1024 + h * 128 + qd * 32 + (lane & 31);
    float cwq[4][2], cwk[4][2], cwv[4];
#pragma unroll
    for (int j = 0; j < 4; ++j) { cwq[j][0] = convw[j * 1536 + h * 128 + lane]; cwq[j][1] = convw[j * 1536 + h * 128 + lane + 64];
        cwk[j][0] = convw[j * 1536 + 512 + h * 128 + lane]; cwk[j][1] = convw[j * 1536 + 512 + h * 128 + lane + 64]; cwv[j] = convw[j * 1536 + vcol]; }
    const int r = tid >> 4, part = tid & 15;
    float s[8];
#pragma unroll
    for (int j = 0; j < 8; ++j) s[j] = 0.f;
    if (tid < 192) vh[tid] = 0.f;
    __syncthreads();
    for (int c = 0; c < 32; ++c) {
        const int t0 = b * TS + c * 64;
        const LAS float* vhc = vh + (c & 1) * 96; LAS float* vhn = vh + ((c + 1) & 1) * 96;
        {
            float rq[11][2], rk[11][2], rv[11];
#pragma unroll
            for (int rr = 0; rr < 11; ++rr) {
                const int tl = c * 64 + 8 * w - 3 + rr;
                const bool ok = tl >= 0;
                const bf16_t* row = P + (size_t)(b * TS + (ok ? tl : 0)) * P0LD;
                rq[rr][0] = ok ? bf2f(row[h * 128 + lane]) : 0.f; rq[rr][1] = ok ? bf2f(row[h * 128 + lane + 64]) : 0.f;
                rk[rr][0] = ok ? bf2f(row[512 + h * 128 + lane]) : 0.f; rk[rr][1] = ok ? bf2f(row[512 + h * 128 + lane + 64]) : 0.f;
                const bool prevchunk = (8 * w - 3 + rr) < 0;
                rv[rr] = prevchunk ? vhc[(rr < 3 ? rr : 0) * 32 + (lane & 31)] : bf2f(row[vcol]);
            }
            if (w == 7 && lane < 32) { vhn[lane] = rv[8]; vhn[32 + lane] = rv[9]; vhn[64 + lane] = rv[10]; }
#pragma unroll
            for (int i = 0; i < 8; ++i) {
                const int t = 8 * w + i;
                float q0 = 0.f, q1 = 0.f, k0 = 0.f, k1 = 0.f, vv = 0.f;
#pragma unroll
                for (int j = 0; j < 4; ++j) { q0 += cwq[j][0] * rq[i + j][0]; q1 += cwq[j][1] * rq[i + j][1]; k0 += cwk[j][0] * rk[i + j][0]; k1 += cwk[j][1] * rk[i + j][1]; vv += cwv[j] * rv[i + j]; }
                q0 = siluf_(q0); q1 = siluf_(q1); k0 = siluf_(k0); k1 = siluf_(k1); vv = siluf_(vv);
                const float sq = wave_sum(q0 * q0 + q1 * q1), sk = wave_sum(k0 * k0 + k1 * k1);
                const float cq = (1.0f / sqrtf(sq + 1e-6f)) * 0.08838834764831845f, ck = 1.0f / sqrtf(sk + 1e-6f);
                Qc[t * 128 + lane] = q0 * cq; Qc[t * 128 + lane + 64] = q1 * cq; Kc[t * 128 + lane] = k0 * ck; Kc[t * 128 + lane + 64] = k1 * ck;
                if (lane < 32) Vc[t * 32 + lane] = vv;
            }
            if (lane < 8) { const int t = 8 * w + lane; const float la = a_neg * softplusf_(db[(size_t)(t0 + t) * 8 + h] + dtb); al[t] = __expf(la); be[t] = sigmoidf_(db[(size_t)(t0 + t) * 8 + 4 + h]); }
        }
        __syncthreads();
        {
            const LAS float* kp = Kc + part * 8; const LAS float* qp = Qc + part * 8;
            f32x4 ka = *(const LAS f32x4*)(kp), kb = *(const LAS f32x4*)(kp + 4), qa = *(const LAS f32x4*)(qp), qb = *(const LAS f32x4*)(qp + 4);
            float vv = Vc[r], alpha = al[0], beta = be[0];
            for (int t = 0; t < 64; ++t) {
                const int tn = (t + 1) & 63;
                const f32x4 nka = *(const LAS f32x4*)(kp + tn * 128), nkb = *(const LAS f32x4*)(kp + tn * 128 + 4), nqa = *(const LAS f32x4*)(qp + tn * 128), nqb = *(const LAS f32x4*)(qp + tn * 128 + 4);
                const float nvv = Vc[tn * 32 + r], nal = al[tn], nbe = be[tn];
                float p0 = s[0] * ka.x + s[1] * ka.y, p1 = s[2] * ka.z + s[3] * ka.w, p2 = s[4] * kb.x + s[5] * kb.y, p3 = s[6] * kb.z + s[7] * kb.w;
                const float p = red16((p0 + p1) + (p2 + p3));
                const float coef = beta * (vv - alpha * p);
                s[0] = alpha * s[0] + coef * ka.x; s[1] = alpha * s[1] + coef * ka.y; s[2] = alpha * s[2] + coef * ka.z; s[3] = alpha * s[3] + coef * ka.w;
                s[4] = alpha * s[4] + coef * kb.x; s[5] = alpha * s[5] + coef * kb.y; s[6] = alpha * s[6] + coef * kb.z; s[7] = alpha * s[7] + coef * kb.w;
                float o0 = s[0] * qa.x + s[1] * qa.y, o1 = s[2] * qa.z + s[3] * qa.w, o2 = s[4] * qb.x + s[5] * qb.y, o3 = s[6] * qb.z + s[7] * qb.w;
                const float o = red16((o0 + o1) + (o2 + o3));
                if (part == 0) Oc[t * 32 + r] = o;
                ka = nka; kb = nkb; qa = nqa; qb = nqb; vv = nvv; alpha = nal; beta = nbe;
            }
        }
        __syncthreads();
        {
            const int t = tid >> 3, c4 = (tid & 7) * 4;
            const f32x4 o = *(const LAS f32x4*)(Oc + t * 32 + c4);
            u32x2 wv; wv.x = pk2(o.x, o.y); wv.y = pk2(o.z, o.w);
            *(u32x2*)(P + (size_t)(t0 + t) * P0LD + 1024 + h * 128 + qd * 32 + c4) = wv;
        }
    }
}
__device__ __forceinline__ void fin_delta(const Frame& F) {
    const int lane = lane_id_v();
    bf16_t* P = (bf16_t*)(F.ws + WS_BIG + BIG_PROJ); const float* onorm = F.in[IN_AB_ONORM];
    const float on0 = onorm[lane], on1 = onorm[lane + 64];
    const int gw = F.wg * NWAVES + F.wave, NGW = F.G * NWAVES;
    for (int it = gw; it < NT * 4; it += NGW) {
        const int t = it >> 2, h = it & 3;
        bf16_t* row = P + (size_t)t * P0LD;
        const float o0 = bf2f(row[1024 + h * 128 + lane]), o1 = bf2f(row[1024 + h * 128 + lane + 64]);
        const float g0 = bf2f(row[1536 + h * 128 + lane]), g1 = bf2f(row[1536 + h * 128 + lane + 64]);
        const float ss = wave_sum(o0 * o0 + o1 * o1), rs = 1.0f / sqrtf(ss * (1.0f / 128.0f) + 1e-6f);
        row[1536 + h * 128 + lane] = (bf16_t)f2bf(o0 * rs * on0 * siluf_(g0)); row[1536 + h * 128 + lane + 64] = (bf16_t)f2bf(o1 * rs * on1 * siluf_(g1));
    }
}

__device__ __forceinline__ void scan_rwkv2(const Frame& F, int b, int h) {
    const int lane = lane_id_v(); const int tid = F.wave * 64 + lane;
    LAS float* R = (LAS float*)F.lds;
    LAS float* KM = R + 4096;
    LAS float* V = KM + 4096;
    LAS float* KK = V + 4096;
    LAS float* KA = KK + 4096;
    LAS float* W = KA + 4096;
    LAS bf16_t* TL = (LAS bf16_t*)(W + 4096);
    LAS bf16_t* AL = TL + 64 * 72;
    LAS bf16_t* SG = AL + 64 * 72;
    LAS float* O = (LAS float*)TL;
    LAS bf16_t* GB = SG + 64 * 136;
    LAS float* halo = (LAS float*)(GB + 4096);
    LAS float* bonus = halo + 896;
    bf16_t* P = (bf16_t*)(F.ws + WS_BIG + BIG_PROJ);
    const bf16_t* LW = (const bf16_t*)(F.ws + WS_LORA);
    const float* mu = F.in[IN_AB_MU];
    const float* w0 = F.in[IN_AB_W0] + h * 64; const float* a0 = F.in[IN_AB_A0] + h * 64;
    const float* k_k = F.in[IN_AB_KK] + h * 64; const float* k_a = F.in[IN_AB_KA] + h * 64; const float* r_k = F.in[IN_AB_RK] + h * 64;
    const float* ln_w = F.in[IN_AB_LNW] + h * 64; const float* ln_b = F.in[IN_AB_LNB] + h * 64;
    const int w = F.wave, fr = lane & 15, fq = lane >> 4;
    const int vi = tid >> 3, part = tid & 7;
    float s[8];
#pragma unroll
    for (int j = 0; j < 8; ++j) s[j] = 0.f;
    for (int i = tid; i < 896; i += NTHREADS) halo[i] = 0.f;
    int gc = 0; float muc = 0.f;
    if (tid < 448) { const int col = tid;
        if (col < 64) gc = 2048 + h * 64 + col; else if (col < 128) gc = 2560 + h * 64 + (col - 64); else if (col < 192) gc = 3072 + h * 64 + (col - 128); else gc = 3584 + (col - 192);
        muc = mu[gc - 2048]; }
    __syncthreads();
    for (int c = 0; c < 32; ++c) {
        const int t0 = b * TS + c * 64;
        if (tid < 448) {
            const int col = tid;
            LAS float* hc = halo + (c & 1) * 448; LAS float* hn = halo + ((c + 1) & 1) * 448;
            float prev = hc[col];
            const bf16_t* src = P + (size_t)t0 * P0LD + gc;
#pragma unroll 8
            for (int t = 0; t < 64; ++t) {
                const float cur = bf2f(src[(size_t)t * P0LD]);
                const float sh = cur + muc * (prev - cur);
                prev = cur;
                if (col < 64) R[t * 64 + col] = sh; else if (col < 128) KM[t * 64 + col - 64] = sh; else if (col < 192) V[t * 64 + col - 128] = sh;
                else if (col < 256) TL[t * 72 + col - 192] = (bf16_t)f2bf(tanhf(sh)); else if (col < 320) AL[t * 72 + col - 256] = (bf16_t)f2bf(sh); else SG[t * 136 + col - 320] = (bf16_t)f2bf(sigmoidf_(sh));
            }
            hn[col] = prev;
        }
        __syncthreads();
        {
#pragma unroll
            for (int q = 0; q < 2; ++q) {
                const int id = 2 * w + q, mi = id >> 2, nj = id & 3;
                f32x4 aw = {0.f, 0.f, 0.f, 0.f}, aa = {0.f, 0.f, 0.f, 0.f}, ag = {0.f, 0.f, 0.f, 0.f};
                const int jrow = h * 64 + nj * 16 + fr;
#pragma unroll
                for (int ksx = 0; ksx < 2; ++ksx) {
                    const bf16x8 x1 = *(const LAS bf16x8*)(TL + (mi * 16 + fr) * 72 + ksx * 32 + fq * 8), x2 = *(const LAS bf16x8*)(AL + (mi * 16 + fr) * 72 + ksx * 32 + fq * 8);
                    const bf16x8 y1 = *(const bf16x8*)(LW + (size_t)jrow * 64 + ksx * 32 + fq * 8), y2 = *(const bf16x8*)(LW + 512 * 64 + (size_t)jrow * 64 + ksx * 32 + fq * 8);
                    aw = __builtin_amdgcn_mfma_f32_16x16x32_bf16(x1, y1, aw, 0, 0, 0); aa = __builtin_amdgcn_mfma_f32_16x16x32_bf16(x2, y2, aa, 0, 0, 0);
                }
#pragma unroll
                for (int ksx = 0; ksx < 4; ++ksx) {
                    const bf16x8 x3 = *(const LAS bf16x8*)(SG + (mi * 16 + fr) * 136 + ksx * 32 + fq * 8);
                    const bf16x8 y3 = *(const bf16x8*)(LW + 2 * 512 * 64 + (size_t)jrow * 128 + ksx * 32 + fq * 8);
                    ag = __builtin_amdgcn_mfma_f32_16x16x32_bf16(x3, y3, ag, 0, 0, 0);
                }
                const int j = nj * 16 + fr; const float w0j = w0[j], a0j = a0[j];
                const float awv[4] = {aw.x, aw.y, aw.z, aw.w}, aav[4] = {aa.x, aa.y, aa.z, aa.w}, agv[4] = {ag.x, ag.y, ag.z, ag.w};
#pragma unroll
                for (int rg = 0; rg < 4; ++rg) { const int t = mi * 16 + 4 * fq + rg;
                    W[t * 64 + j] = __expf(-0.6065306597126334f * sigmoidf_(w0j + awv[rg])); KA[t * 64 + j] = sigmoidf_(a0j + aav[rg]); GB[t * 64 + j] = (bf16_t)f2bf(agv[rg]); }
            }
        }
        __syncthreads();
        {
            const int j = lane; const float kkj = k_k[j], kaj = k_a[j], rkj = r_k[j];
#pragma unroll
            for (int q = 0; q < 8; ++q) { const int t = w * 8 + q; const float kv = KM[t * 64 + j], a = KA[t * 64 + j]; const float kx = kv * kkj; const float ss = wave_sum(kx * kx);
                const float kk = kx * (1.0f / sqrtf(ss + 1e-6f)); KK[t * 64 + j] = kk; KA[t * 64 + j] = kk * a; const float km = kv * (1.f + (a - 1.f) * kaj); KM[t * 64 + j] = km;
                const float bs = wave_sum(R[t * 64 + j] * km * rkj); if (j == 0) bonus[t] = bs; }
        }
        __syncthreads();
        {
            const int o8 = part * 8;
            for (int t = 0; t < 64; ++t) {
                const f32x4 k0 = *(const LAS f32x4*)(KK + t * 64 + o8), k1 = *(const LAS f32x4*)(KK + t * 64 + o8 + 4);
                const f32x4 w0v = *(const LAS f32x4*)(W + t * 64 + o8), w1v = *(const LAS f32x4*)(W + t * 64 + o8 + 4);
                const f32x4 a0v = *(const LAS f32x4*)(KA + t * 64 + o8), a1v = *(const LAS f32x4*)(KA + t * 64 + o8 + 4);
                const f32x4 m0 = *(const LAS f32x4*)(KM + t * 64 + o8), m1 = *(const LAS f32x4*)(KM + t * 64 + o8 + 4);
                const f32x4 r0 = *(const LAS f32x4*)(R + t * 64 + o8), r1 = *(const LAS f32x4*)(R + t * 64 + o8 + 4);
                const float vv = V[t * 64 + vi];
                const float sa = -red8(((s[0] * k0.x + s[1] * k0.y) + (s[2] * k0.z + s[3] * k0.w)) + ((s[4] * k1.x + s[5] * k1.y) + (s[6] * k1.z + s[7] * k1.w)));
                s[0] = s[0] * w0v.x + sa * a0v.x + vv * m0.x; s[1] = s[1] * w0v.y + sa * a0v.y + vv * m0.y; s[2] = s[2] * w0v.z + sa * a0v.z + vv * m0.z; s[3] = s[3] * w0v.w + sa * a0v.w + vv * m0.w;
                s[4] = s[4] * w1v.x + sa * a1v.x + vv * m1.x; s[5] = s[5] * w1v.y + sa * a1v.y + vv * m1.y; s[6] = s[6] * w1v.z + sa * a1v.z + vv * m1.z; s[7] = s[7] * w1v.w + sa * a1v.w + vv * m1.w;
                const float o = red8(((s[0] * r0.x + s[1] * r0.y) + (s[2] * r0.z + s[3] * r0.w)) + ((s[4] * r1.x + s[5] * r1.y) + (s[6] * r1.z + s[7] * r1.w)));
                if (part == 0) O[t * 64 + vi] = o;
            }
        }
        __syncthreads();
        for (int t = w; t < 64; t += NWAVES) {
            const float o = O[t * 64 + lane];
            const float mean = wave_sum(o) * (1.0f / 64.0f); const float dlt = o - mean; const float var = wave_sum(dlt * dlt) * (1.0f / 64.0f);
            float y = dlt * (1.0f / sqrtf(var + 64e-5f)) * ln_w[lane] + ln_b[lane];
            y += bonus[t] * V[t * 64 + lane];
            y *= bf2f(GB[t * 64 + lane]);
            P[(size_t)(t0 + t) * P0LD + 2048 + h * 64 + lane] = (bf16_t)f2bf(y);
        }
        __syncthreads();
    }
}

__device__ __forceinline__ void scan_hgrn2(const Frame& F, int b, int h, int qd) {
    const int lane = lane_id_v(); const int tid = F.wave * 64 + lane;
    LAS float* qs = (LAS float*)F.lds;
    LAS float* fs = qs + 64 * 128;
    LAS float* kf = fs + 64 * 128;
    LAS float* is = kf + 64 * 128;
    bf16_t* P = (bf16_t*)(F.ws + WS_BIG + BIG_PROJ);
    const int e = tid >> 4, part = tid & 15;
    float s[8];
#pragma unroll
    for (int j = 0; j < 8; ++j) s[j] = 0.f;
    for (int c = 0; c < 32; ++c) {
        const int t0 = b * TS + c * 64;
        {
            const int t = tid >> 3, c16 = (tid & 7) * 16;
            const bf16_t* pr = P + (size_t)(t0 + t) * P1LD + h * 128 + c16;
            const u32x4 qa = *(const u32x4*)pr, qb = *(const u32x4*)(pr + 8), la = *(const u32x4*)(pr + 1024), lb2 = *(const u32x4*)(pr + 1024 + 8);
            const unsigned qv[8] = {qa.x, qa.y, qa.z, qa.w, qb.x, qb.y, qb.z, qb.w}, lv[8] = {la.x, la.y, la.z, la.w, lb2.x, lb2.y, lb2.z, lb2.w};
#pragma unroll
            for (int j = 0; j < 8; ++j) {
                qs[t * 128 + c16 + 2 * j] = bf2f((unsigned short)(qv[j] & 0xffffu)); qs[t * 128 + c16 + 2 * j + 1] = bf2f((unsigned short)(qv[j] >> 16));
                const float l0 = h2f_bits((unsigned short)(lv[j] & 0xffffu)), l1 = h2f_bits((unsigned short)(lv[j] >> 16));
                fs[t * 128 + c16 + 2 * j] = __expf(l0); fs[t * 128 + c16 + 2 * j + 1] = __expf(l1); kf[t * 128 + c16 + 2 * j] = -expm1f(l0); kf[t * 128 + c16 + 2 * j + 1] = -expm1f(l1);
            }
            const int c4 = (tid & 7) * 4;
            const u32x2 iv = *(const u32x2*)(P + (size_t)(t0 + t) * P1LD + 2048 + h * 128 + qd * 32 + c4);
            is[t * 32 + c4] = bf2f((unsigned short)(iv.x & 0xffffu)); is[t * 32 + c4 + 1] = bf2f((unsigned short)(iv.x >> 16)); is[t * 32 + c4 + 2] = bf2f((unsigned short)(iv.y & 0xffffu)); is[t * 32 + c4 + 3] = bf2f((unsigned short)(iv.y >> 16));
        }
        __syncthreads();
        {
            const int o8 = part * 8;
            for (int t = 0; t < 64; ++t) {
                const f32x4 f0 = *(const LAS f32x4*)(fs + t * 128 + o8), f1 = *(const LAS f32x4*)(fs + t * 128 + o8 + 4);
                const f32x4 k0 = *(const LAS f32x4*)(kf + t * 128 + o8), k1 = *(const LAS f32x4*)(kf + t * 128 + o8 + 4);
                const f32x4 q0 = *(const LAS f32x4*)(qs + t * 128 + o8), q1 = *(const LAS f32x4*)(qs + t * 128 + o8 + 4);
                const float iv = is[t * 32 + e];
                s[0] = f0.x * s[0] + k0.x * iv; s[1] = f0.y * s[1] + k0.y * iv; s[2] = f0.z * s[2] + k0.z * iv; s[3] = f0.w * s[3] + k0.w * iv;
                s[4] = f1.x * s[4] + k1.x * iv; s[5] = f1.y * s[5] + k1.y * iv; s[6] = f1.z * s[6] + k1.z * iv; s[7] = f1.w * s[7] + k1.w * iv;
                const float o = red16(((s[0] * q0.x + s[1] * q0.y) + (s[2] * q0.z + s[3] * q0.w)) + ((s[4] * q1.x + s[5] * q1.y) + (s[6] * q1.z + s[7] * q1.w)));
                if (part == 0) is[t * 32 + e] = o;
            }
        }
        __syncthreads();
        {
            const int t = tid >> 3, c4 = (tid & 7) * 4;
            const f32x4 o = *(const LAS f32x4*)(is + t * 32 + c4);
            u32x2 wv; wv.x = pk2(o.x, o.y); wv.y = pk2(o.z, o.w);
            *(u32x2*)(P + (size_t)(t0 + t) * P1LD + 2048 + h * 128 + qd * 32 + c4) = wv;
        }
        __syncthreads();
    }
}
__device__ __forceinline__ void fin_hgrn(const Frame& F) {
    const int lane = lane_id_v();
    bf16_t* P = (bf16_t*)(F.ws + WS_BIG + BIG_PROJ); const float* onorm = F.in[IN_C_ONORM];
    const float on0 = onorm[lane], on1 = onorm[lane + 64];
    const int gw = F.wg * NWAVES + F.wave, NGW = F.G * NWAVES;
    for (int it = gw; it < NT * 8; it += NGW) {
        const int t = it >> 3, h = it & 7;
        bf16_t* row = P + (size_t)t * P1LD;
        const float o0 = bf2f(row[2048 + h * 128 + lane]), o1 = bf2f(row[2048 + h * 128 + lane + 64]);
        const float g0 = bf2f(row[3072 + h * 128 + lane]), g1 = bf2f(row[3072 + h * 128 + lane + 64]);
        const float ss = wave_sum(o0 * o0 + o1 * o1), rs = 1.0f / sqrtf(ss * (1.0f / 128.0f) + 1e-6f);
        row[3072 + h * 128 + lane] = (bf16_t)f2bf(o0 * rs * on0 * siluf_(g0)); row[3072 + h * 128 + lane + 64] = (bf16_t)f2bf(o1 * rs * on1 * siluf_(g1));
    }
}

#define MFMA32(a, b, c) __builtin_amdgcn_mfma_f32_16x16x32_bf16(a, b, c, 0, 0, 0)
#define MFMA16(a, b, c) __builtin_amdgcn_mfma_f32_16x16x16bf16_1k(a, b, c, 0, 0, 0)
__device__ __forceinline__ f32x4 mm_tile(const LAS bf16_t* A, int lda, const LAS bf16_t* B, int ldb, int nks, f32x4 acc, int fr, int fq) {
    for (int ksx = 0; ksx < nks; ++ksx) acc = MFMA32(*(const LAS bf16x8*)(A + fr * lda + ksx * 32 + fq * 8), *(const LAS bf16x8*)(B + fr * ldb + ksx * 32 + fq * 8), acc);
    return acc;
}
__device__ __forceinline__ void lds_w4(LAS bf16_t* p, f32x4 v) { u32x2 w; w.x = pk2(v.x, v.y); w.y = pk2(v.z, v.w); *(LAS u32x2*)p = w; }

struct HoBuf { __amdgpu_buffer_rsrc_t r; };
__device__ __forceinline__ HoBuf ho_buf(float* base, unsigned bytes) {
    const unsigned long long a = (unsigned long long)base;
    const unsigned lo = __builtin_amdgcn_readfirstlane((unsigned)a), hi = __builtin_amdgcn_readfirstlane((unsigned)(a >> 32));
    HoBuf h; h.r = __builtin_amdgcn_make_buffer_rsrc((void*)(((unsigned long long)hi << 32) | lo), 0, bytes, 0x00020000); return h;
}
__device__ __forceinline__ void ho_store(const HoBuf& hb, unsigned byteoff, f32x4 v) {
    __builtin_amdgcn_raw_buffer_store_b128(__builtin_bit_cast(u32x4, v), hb.r, byteoff, 0, 16);
}
__device__ __forceinline__ f32x4 ho_load(const HoBuf& hb, unsigned byteoff) {
    return __builtin_bit_cast(f32x4, __builtin_amdgcn_raw_buffer_load_b128(hb.r, byteoff, 0, 16));
}
__device__ __forceinline__ void ho_wait_wave(unsigned* flag, unsigned need, unsigned* tmo) {
    unsigned sp = 0;
    while (__hip_atomic_load(flag, __ATOMIC_RELAXED, __HIP_MEMORY_SCOPE_AGENT) < need) { __builtin_amdgcn_s_sleep(1); if (++sp > (1u << 24)) { __hip_atomic_store(tmo, 1u, __ATOMIC_RELAXED, __HIP_MEMORY_SCOPE_AGENT); break; } }
}
__device__ __forceinline__ void ho_wait(unsigned* flag, unsigned need, unsigned* tmo, int wave, int lane) {
    if (wave == 0 && lane == 0) { unsigned sp = 0;
        while (__hip_atomic_load(flag, __ATOMIC_RELAXED, __HIP_MEMORY_SCOPE_AGENT) < need) { __builtin_amdgcn_s_sleep(2); if (++sp > (1u << 24)) { __hip_atomic_store(tmo, 1u, __ATOMIC_RELAXED, __HIP_MEMORY_SCOPE_AGENT); break; } } }
    __syncthreads();
}

__device__ __forceinline__ void scan_delta3(const Frame& F, int b, int h, int jpart, int kparts) {
    const int lane0 = lane_id_v(); const int w = F.wave;
    LAS bf16_t* Qb = (LAS bf16_t*)F.lds;
    LAS bf16_t* Kb = Qb + 64 * 136;
    LAS float* Of = (LAS float*)F.lds;
    LAS bf16_t* Kdt = Kb + 64 * 136;
    LAS bf16_t* Vt = Kdt + 128 * 72;
    LAS bf16_t* St = Vt + 128 * 72;
    LAS bf16_t* Aoff = St + 128 * 136;
    LAS bf16_t* QKm = Aoff + 64 * 72;
    LAS bf16_t* Vn = QKm + 64 * 72;
    LAS bf16_t* Dg = Vn + 128 * 72;
    LAS float* Adg = (LAS float*)(Dg + 4 * 16 * 24);
    LAS float* sc = Adg + 4 * 16 * 17;
    static_assert((64 * 136 * 2 * 2 + 128 * 72 * 2 * 3 + 128 * 136 * 2 + 64 * 72 * 2 * 2 + 4 * 16 * 24 * 2 + 4 * 16 * 17 * 4 + 260 * 4) <= LDS_MISC, "delta3 LDS");
    bf16_t* P = (bf16_t*)(F.ws + WS_BIG + BIG_PROJ);
    const HoBuf hb = ho_buf((float*)(F.ws + WS_HOA) + (size_t)(b * 4 + h) * 16384, 65536);
    unsigned* flag = (unsigned*)(F.ws + WS_FLAGS) + (b * 4 + h) * 8 + w; unsigned* tmo = (unsigned*)(F.ws + WS_FLAGS) + 2047;
    const float* convw = F.in[IN_AB_CONV];
    const float* db = (const float*)(F.ws + WS_DB);
    const float a_neg = -__expf(F.in[IN_AB_ALOG][h]), dtb = F.in[IN_AB_DTB][h];
    const float* onorm = F.in[IN_AB_ONORM];
    float cw[3][4][2];
#pragma unroll
    for (int sct = 0; sct < 3; ++sct)
#pragma unroll
        for (int j = 0; j < 4; ++j) { cw[sct][j][0] = convw[j * 1536 + sct * 512 + h * 128 + 2 * lane0]; cw[sct][j][1] = convw[j * 1536 + sct * 512 + h * 128 + 2 * lane0 + 1]; }
    for (int i = w * 64 + lane0; i < (128 * 136 + 64 * 72 * 2 + 128 * 72) / 2; i += NTHREADS) ((LAS unsigned*)St)[i] = 0u;
    unsigned pacc = 0u, plast = 0u;
    f32x4 sacc[8];
#pragma unroll
    for (int i = 0; i < 8; ++i) sacc[i] = (f32x4){0.f, 0.f, 0.f, 0.f};
    __syncthreads();
    unsigned rawu[3][11]; float dbv0, dbv1;
#define DELTA_FETCH(cc, ln) do { const int cc_ = (cc) < 32 ? (cc) : 31; \
        dbv0 = db[(size_t)(b * TS + cc_ * 64 + (ln)) * 8 + h]; dbv1 = db[(size_t)(b * TS + cc_ * 64 + (ln)) * 8 + 4 + h]; \
        _Pragma("unroll") for (int rr = 0; rr < 11; ++rr) { const int tl = cc_ * 64 + 8 * w - 3 + rr; \
            const unsigned* row = (const unsigned*)(P + (size_t)(b * TS + (tl >= 0 ? tl : 0)) * P0LD + h * 128) + (ln); \
            _Pragma("unroll") for (int sct = 0; sct < 3; ++sct) rawu[sct][rr] = row[sct * 256]; } } while (0)
    DELTA_FETCH(jpart, lane0);
    for (int c = jpart; c < 32; c += kparts) {
        int lane = lane0; asm volatile("" : "+v"(lane));
        const int fr = lane & 15, fq = lane >> 4;
        const int t0 = b * TS + c * 64;
        if (PROBE_STAGE >= 0) plast = (unsigned)__builtin_amdgcn_s_memrealtime();
        unsigned gq[8];
#pragma unroll
        for (int i = 0; i < 8; ++i) gq[i] = *((const unsigned*)(P + (size_t)(t0 + w + 8 * i) * P0LD + 1536 + h * 128) + lane);
        {
            const float la = a_neg * softplusf_(dbv0 + dtb);
            const float bet = sigmoidf_(dbv1);
            float g = la;
#pragma unroll
            for (int o = 1; o < 64; o <<= 1) { const float n = __shfl_up(g, o); if (lane >= o) g += n; }
            const float gL = rdlane(g, 63);
            if (w == 0) { sc[lane] = g; sc[64 + lane] = __expf(g); sc[128 + lane] = bet * __expf(g); sc[192 + lane] = bet; if (lane == 0) sc[256] = __expf(gL); }
            float raw[3][11][2];
#pragma unroll
            for (int rr = 0; rr < 11; ++rr) { const bool ok = (c * 64 + 8 * w - 3 + rr) >= 0;
#pragma unroll
                for (int sct = 0; sct < 3; ++sct) { raw[sct][rr][0] = ok ? bf2f((unsigned short)(rawu[sct][rr] & 0xffffu)) : 0.f; raw[sct][rr][1] = ok ? bf2f((unsigned short)(rawu[sct][rr] >> 16)) : 0.f; } }
            DELTA_FETCH(c + kparts, lane);
            float kd0[8], kd1[8], vt0[8], vt1[8];
#pragma unroll
            for (int i = 0; i < 8; ++i) {
                const int t = 8 * w + i;
                float x[3][2];
#pragma unroll
                for (int sct = 0; sct < 3; ++sct) { float a0 = 0.f, a1 = 0.f;
#pragma unroll
                    for (int j = 0; j < 4; ++j) { a0 += cw[sct][j][0] * raw[sct][i + j][0]; a1 += cw[sct][j][1] * raw[sct][i + j][1]; }
                    x[sct][0] = siluf_(a0); x[sct][1] = siluf_(a1); }
                const float sq = wsum(x[0][0] * x[0][0] + x[0][1] * x[0][1]), sk = wsum(x[1][0] * x[1][0] + x[1][1] * x[1][1]);
                const float cq = (1.0f / sqrtf(sq + 1e-6f)) * 0.08838834764831845f, ck = 1.0f / sqrtf(sk + 1e-6f);
                const float egr = __expf(gL - rdlane(g, t));
                *(LAS unsigned*)(Qb + t * 136 + 2 * lane) = pk2(x[0][0] * cq, x[0][1] * cq);
                const float k0 = x[1][0] * ck, k1 = x[1][1] * ck;
                *(LAS unsigned*)(Kb + t * 136 + 2 * lane) = pk2(k0, k1);
                kd0[i] = k0 * egr; kd1[i] = k1 * egr; vt0[i] = x[2][0]; vt1[i] = x[2][1];
            }
            *(LAS u32x4*)(Kdt + (2 * lane) * 72 + 8 * w) = (u32x4){pk2(kd0[0], kd0[1]), pk2(kd0[2], kd0[3]), pk2(kd0[4], kd0[5]), pk2(kd0[6], kd0[7])};
            *(LAS u32x4*)(Kdt + (2 * lane + 1) * 72 + 8 * w) = (u32x4){pk2(kd1[0], kd1[1]), pk2(kd1[2], kd1[3]), pk2(kd1[4], kd1[5]), pk2(kd1[6], kd1[7])};
            *(LAS u32x4*)(Vt + (2 * lane) * 72 + 8 * w) = (u32x4){pk2(vt0[0], vt0[1]), pk2(vt0[2], vt0[3]), pk2(vt0[4], vt0[5]), pk2(vt0[6], vt0[7])};
            *(LAS u32x4*)(Vt + (2 * lane + 1) * 72 + 8 * w) = (u32x4){pk2(vt1[0], vt1[1]), pk2(vt1[2], vt1[3]), pk2(vt1[4], vt1[5]), pk2(vt1[6], vt1[7])};
        }
        __syncthreads();
        if (PROBE_STAGE >= 0) { const unsigned tn = (unsigned)__builtin_amdgcn_s_memrealtime(); if (PROBE_STAGE == 0) pacc += tn - plast; plast = tn; }
        {
            for (int id = w; id < 20; id += NWAVES) {
                const int which = id / 10, tix = id % 10;
                const int bi = (tix < 1) ? 0 : (tix < 3 ? 1 : (tix < 6 ? 2 : 3)); const int bj = tix - (bi * (bi + 1)) / 2;
                f32x4 acc = {0.f, 0.f, 0.f, 0.f};
                acc = mm_tile(Kb + bj * 16 * 136, 136, (which ? Qb : Kb) + bi * 16 * 136, 136, 4, acc, fr, fq);
                const int i = 16 * bi + fr; const float gi = sc[i], bi_ = sc[192 + i];
                const float av[4] = {acc.x, acc.y, acc.z, acc.w}; float ov[4];
#pragma unroll
                for (int rg = 0; rg < 4; ++rg) { const int j = 16 * bj + 4 * fq + rg; const float dec = __expf(gi - sc[j]);
                    ov[rg] = which ? ((j <= i) ? av[rg] * dec : 0.f) : ((j < i) ? bi_ * av[rg] * dec : 0.f); }
                if (which) lds_w4(QKm + i * 72 + 16 * bj + 4 * fq, (f32x4){ov[0], ov[1], ov[2], ov[3]});
                else if (bi == bj) { LAS float* d = Adg + (bi * 16 + fr) * 17 + 4 * fq; d[0] = ov[0]; d[1] = ov[1]; d[2] = ov[2]; d[3] = ov[3]; }
                else lds_w4(Aoff + i * 72 + 16 * bj + 4 * fq, (f32x4){-ov[0], -ov[1], -ov[2], -ov[3]});
            }
        }
        __syncthreads();
        if (PROBE_STAGE >= 0) { const unsigned tn = (unsigned)__builtin_amdgcn_s_memrealtime(); if (PROBE_STAGE == 1) pacc += tn - plast; plast = tn; }
        f32x4 y[4], qs[4];
        if (w < 4 && lane < 16) { float x[16]; const LAS float* a = Adg + w * 16 * 17;
#pragma unroll
            for (int i = 0; i < 16; ++i) { float v = (i == lane) ? 1.f : 0.f;
#pragma unroll
                for (int k = 0; k < i; ++k) v -= a[i * 17 + k] * x[k];
                x[i] = v; Dg[(w * 16 + i) * 24 + lane] = (bf16_t)f2bf(v); } }
        __syncthreads();
        if (c > 0) ho_wait_wave(flag, (unsigned)c, tmo);
#pragma unroll
        for (int dk = 0; dk < 8; dk += 2) {
            const u32x4 ldv = __builtin_bit_cast(u32x4, ho_load(hb, (unsigned)(((w * 64 + lane) * 4 + (dk >> 1)) * 16)));
            const f32x4 z0 = {bf2f((unsigned short)(ldv.x & 0xffffu)), bf2f((unsigned short)(ldv.x >> 16)), bf2f((unsigned short)(ldv.y & 0xffffu)), bf2f((unsigned short)(ldv.y >> 16))};
            const f32x4 z1 = {bf2f((unsigned short)(ldv.z & 0xffffu)), bf2f((unsigned short)(ldv.z >> 16)), bf2f((unsigned short)(ldv.w & 0xffffu)), bf2f((unsigned short)(ldv.w >> 16))};
            sacc[dk] = (c > 0) ? z0 : (f32x4){0.f, 0.f, 0.f, 0.f}; sacc[dk + 1] = (c > 0) ? z1 : (f32x4){0.f, 0.f, 0.f, 0.f}; }
#pragma unroll
        for (int dk = 0; dk < 8; ++dk) {
            lds_w4(St + (16 * w + fr) * 136 + 16 * dk + 4 * fq, sacc[dk]); }
        asm volatile("s_waitcnt lgkmcnt(0)" ::: "memory");
        {
            const LAS bf16_t* Sw = St + (16 * w) * 136;
#pragma unroll
            for (int mi = 0; mi < 4; ++mi) {
                f32x4 x = mm_tile(Kb + mi * 16 * 136, 136, Sw, 136, 4, (f32x4){0.f, 0.f, 0.f, 0.f}, fr, fq);
                qs[mi] = mm_tile(Qb + mi * 16 * 136, 136, Sw, 136, 4, (f32x4){0.f, 0.f, 0.f, 0.f}, fr, fq);
                const bf16x4 vv = *(const LAS bf16x4*)(Vt + (16 * w + fr) * 72 + 16 * mi + 4 * fq);
                const f32x4 be4 = *(const LAS f32x4*)(sc + 192 + 16 * mi + 4 * fq), bg4 = *(const LAS f32x4*)(sc + 128 + 16 * mi + 4 * fq);
                y[mi].x = be4.x * bf2f((unsigned short)vv.x) - bg4.x * x.x; y[mi].y = be4.y * bf2f((unsigned short)vv.y) - bg4.y * x.y;
                y[mi].z = be4.z * bf2f((unsigned short)vv.z) - bg4.z * x.z; y[mi].w = be4.w * bf2f((unsigned short)vv.w) - bg4.w * x.w;
            }
        }
        __syncthreads();
        if (PROBE_STAGE >= 0) { const unsigned tn = (unsigned)__builtin_amdgcn_s_memrealtime(); if (PROBE_STAGE == 2) pacc += tn - plast; plast = tn; }
        {
            LAS bf16_t* Vw = Vn + (16 * w) * 72;
#pragma unroll
            for (int bb = 0; bb < 4; ++bb) {
                f32x4 acc = y[bb];
                if (bb >= 1) acc = mm_tile(Aoff + bb * 16 * 72, 72, Vw, 72, (bb + 1) / 2, acc, fr, fq);
                u32x2 pk; pk.x = pk2(acc.x, acc.y); pk.y = pk2(acc.z, acc.w);
                const bf16x4 dgf = *(const LAS bf16x4*)(Dg + (bb * 16 + fr) * 24 + 4 * fq);
                const f32x4 vb = MFMA16(dgf, __builtin_bit_cast(bf16x4, pk), ((f32x4){0.f, 0.f, 0.f, 0.f}));
                lds_w4(Vw + fr * 72 + 16 * bb + 4 * fq, vb);
                asm volatile("s_waitcnt lgkmcnt(0)" ::: "memory");
            }
            const float gl = sc[256];
#pragma unroll
            for (int mi = 0; mi < 4; ++mi) {
                const f32x4 eg4 = *(const LAS f32x4*)(sc + 64 + 16 * mi + 4 * fq);
                f32x4 o = qs[mi] * eg4;
                o = mm_tile(QKm + mi * 16 * 72, 72, Vw, 72, 2, o, fr, fq);
                qs[mi] = o;
            }
#pragma unroll
            for (int dk = 0; dk < 8; ++dk) {
                f32x4 sn = sacc[dk] * gl;
                sn = mm_tile(Kdt + dk * 16 * 72, 72, Vw, 72, 2, sn, fr, fq);
                sacc[dk] = sn;
                lds_w4(St + (16 * w + fr) * 136 + 16 * dk + 4 * fq, sn);
            }
        }
        if (c < 31) {
#pragma unroll
            for (int dk = 0; dk < 8; dk += 2) { u32x4 pv; pv.x = pk2(sacc[dk].x, sacc[dk].y); pv.y = pk2(sacc[dk].z, sacc[dk].w); pv.z = pk2(sacc[dk + 1].x, sacc[dk + 1].y); pv.w = pk2(sacc[dk + 1].z, sacc[dk + 1].w);
                ho_store(hb, (unsigned)(((w * 64 + lane) * 4 + (dk >> 1)) * 16), __builtin_bit_cast(f32x4, pv)); }
            asm volatile("s_waitcnt vmcnt(0)" ::: "memory");
            if (lane == 0) __hip_atomic_store(flag, (unsigned)(c + 1), __ATOMIC_RELAXED, __HIP_MEMORY_SCOPE_AGENT);
        }
        __syncthreads();
        if (PROBE_STAGE >= 0) { const unsigned tn = (unsigned)__builtin_amdgcn_s_memrealtime(); if (PROBE_STAGE == 3) pacc += tn - plast; plast = tn; }
#pragma unroll
        for (int mi = 0; mi < 4; ++mi) { LAS float* op = Of + (16 * mi + 4 * fq) * 132 + 16 * w + fr; op[0] = qs[mi].x; op[132] = qs[mi].y; op[264] = qs[mi].z; op[396] = qs[mi].w; }
        __syncthreads();
        if (PROBE_STAGE >= 0) { const unsigned tn = (unsigned)__builtin_amdgcn_s_memrealtime(); if (PROBE_STAGE == 4) pacc += tn - plast; plast = tn; }
        const float on0 = onorm[2 * lane], on1 = onorm[2 * lane + 1];
#pragma unroll
        for (int i = 0; i < 8; ++i) {
            const int t = w + 8 * i;
            const f32x2 ov = *(const LAS f32x2*)(Of + t * 132 + 2 * lane); const float o0 = ov.x, o1 = ov.y;
            const float ss = wsum(o0 * o0 + o1 * o1), rs = 1.0f / sqrtf(ss * (1.0f / 128.0f) + 1e-6f);
            const float g0 = bf2f((unsigned short)(gq[i] & 0xffffu)), g1 = bf2f((unsigned short)(gq[i] >> 16));
            *((unsigned*)(P + (size_t)(t0 + t) * P0LD + 1536 + h * 128) + lane) = pk2(o0 * rs * on0 * siluf_(g0), o1 * rs * on1 * siluf_(g1));
        }
        __syncthreads();
        if (PROBE_STAGE >= 0) { const unsigned tn = (unsigned)__builtin_amdgcn_s_memrealtime(); if (PROBE_STAGE == 5) pacc += tn - plast; plast = tn; }
    }
    if (PROBE_STAGE >= 0 && F.wg == 0 && w == 0 && lane0 == 0) __hip_atomic_store((unsigned*)(F.ws + WS_CTL + 20484), pacc, __ATOMIC_RELAXED, __HIP_MEMORY_SCOPE_AGENT);
}

__device__ __forceinline__ void scan_hgrn3(const Frame& F, int b, int h, int jpart, int kparts) {
    const int lane0 = lane_id_v(); const int w = F.wave;
    LAS bf16_t* Qd = (LAS bf16_t*)F.lds;
    LAS bf16_t* Kp = Qd + 64 * 136;
    LAS bf16_t* Kpt = Kp + 64 * 136;
    LAS bf16_t* Vt = Kpt + 128 * 72;
    LAS bf16_t* Sc = Vt + 128 * 72;
    LAS bf16_t* Zt = Sc + 64 * 72;
    LAS float* Of = (LAS float*)(Zt + 128 * 136);
    LAS float* gl = Of + 64 * 132;
    LAS float* seg = gl + 128;
    static_assert((64 * 136 * 2 * 2 + 128 * 72 * 2 * 2 + 64 * 72 * 2 + 128 * 136 * 2 + 64 * 132 * 4 + 128 * 4 + 512 * 4) <= LDS_MISC, "hgrn3 LDS");
    bf16_t* P = (bf16_t*)(F.ws + WS_BIG + BIG_PROJ);
    const HoBuf hb = ho_buf((float*)(F.ws + WS_HOC) + (size_t)(b * 8 + h) * 16384, 65536);
    unsigned* flag = (unsigned*)(F.ws + WS_FLAGS) + 768 + (b * 8 + h) * 8 + w; unsigned* tmo = (unsigned*)(F.ws + WS_FLAGS) + 2047;
    const float* onorm = F.in[IN_C_ONORM];
    for (int i = w * 64 + lane0; i < (64 * 72 + 128 * 136) / 2; i += NTHREADS) ((LAS unsigned*)Sc)[i] = 0u;
    f32x4 zacc[8];
#pragma unroll
    for (int i = 0; i < 8; ++i) zacc[i] = (f32x4){0.f, 0.f, 0.f, 0.f};
    __syncthreads();
    for (int c = jpart; c < 32; c += kparts) {
        int lane = lane0; asm volatile("" : "+v"(lane));
        const int tid = w * 64 + lane, fr = lane & 15, fq = lane >> 4, d = tid & 127, sg = tid >> 7;
        const int t0 = b * TS + c * 64;
        {
            float G[16], q[16], v[16], lf[16];
            const bf16_t* pr = P + (size_t)(t0 + 16 * sg) * P1LD + h * 128 + d;
#pragma unroll
            for (int i = 0; i < 16; ++i) { q[i] = bf2f(pr[(size_t)i * P1LD]); lf[i] = h2f_bits(pr[(size_t)i * P1LD + 1024]); v[i] = bf2f(pr[(size_t)i * P1LD + 2048]); }
            float run = 0.f;
#pragma unroll
            for (int i = 0; i < 16; ++i) { run += lf[i]; G[i] = run; }
            seg[sg * 128 + d] = run;
            __syncthreads();
            float off = 0.f;
#pragma unroll
            for (int s2 = 0; s2 < 3; ++s2) if (s2 < sg) off += seg[s2 * 128 + d];
            float kpv[16];
#pragma unroll
            for (int i = 0; i < 16; ++i) {
                const int t = 16 * sg + i; const float Gt = off + G[i];
                const float qd = q[i] * __expf(Gt); kpv[i] = -expm1f(lf[i]) * __expf(fminf(-Gt, 80.f));
                Qd[t * 136 + d] = (bf16_t)f2bf(qd); Kp[t * 136 + d] = (bf16_t)f2bf(kpv[i]);
            }
            *(LAS u32x4*)(Kpt + d * 72 + 16 * sg) = (u32x4){pk2(kpv[0], kpv[1]), pk2(kpv[2], kpv[3]), pk2(kpv[4], kpv[5]), pk2(kpv[6], kpv[7])};
            *(LAS u32x4*)(Kpt + d * 72 + 16 * sg + 8) = (u32x4){pk2(kpv[8], kpv[9]), pk2(kpv[10], kpv[11]), pk2(kpv[12], kpv[13]), pk2(kpv[14], kpv[15])};
            *(LAS u32x4*)(Vt + d * 72 + 16 * sg) = (u32x4){pk2(v[0], v[1]), pk2(v[2], v[3]), pk2(v[4], v[5]), pk2(v[6], v[7])};
            *(LAS u32x4*)(Vt + d * 72 + 16 * sg + 8) = (u32x4){pk2(v[8], v[9]), pk2(v[10], v[11]), pk2(v[12], v[13]), pk2(v[14], v[15])};
            if (sg == 3) gl[d] = __expf(off + G[15]);
        }
        __syncthreads();
        for (int id = w; id < 10; id += NWAVES) {
            const int bi = (id < 1) ? 0 : (id < 3 ? 1 : (id < 6 ? 2 : 3)); const int bj = id - (bi * (bi + 1)) / 2;
            const f32x4 acc = mm_tile(Kp + bj * 16 * 136, 136, Qd + bi * 16 * 136, 136, 4, (f32x4){0.f, 0.f, 0.f, 0.f}, fr, fq);
            const int i = 16 * bi + fr, j0 = 16 * bj + 4 * fq;
            lds_w4(Sc + i * 72 + j0, (f32x4){(j0 <= i) ? acc.x : 0.f, (j0 + 1 <= i) ? acc.y : 0.f, (j0 + 2 <= i) ? acc.z : 0.f, (j0 + 3 <= i) ? acc.w : 0.f});
        }
        __syncthreads();
        const LAS bf16_t* Vw = Vt + (16 * w) * 72; const LAS bf16_t* Zw = Zt + (16 * w) * 136;
        f32x4 cacc[8], opart[4];
#pragma unroll
        for (int dk = 0; dk < 8; ++dk) cacc[dk] = mm_tile(Kpt + dk * 16 * 72, 72, Vw, 72, 2, (f32x4){0.f, 0.f, 0.f, 0.f}, fr, fq);
#pragma unroll
        for (int mi = 0; mi < 4; ++mi) opart[mi] = mm_tile(Sc + mi * 16 * 72, 72, Vw, 72, 2, (f32x4){0.f, 0.f, 0.f, 0.f}, fr, fq);
        if (c > 0) ho_wait_wave(flag, (unsigned)c, tmo);
#pragma unroll
        for (int dk = 0; dk < 8; dk += 2) {
            const u32x4 ldv = __builtin_bit_cast(u32x4, ho_load(hb, (unsigned)(((w * 64 + lane) * 4 + (dk >> 1)) * 16)));
            const f32x4 z0 = {bf2f((unsigned short)(ldv.x & 0xffffu)), bf2f((unsigned short)(ldv.x >> 16)), bf2f((unsigned short)(ldv.y & 0xffffu)), bf2f((unsigned short)(ldv.y >> 16))};
            const f32x4 z1 = {bf2f((unsigned short)(ldv.z & 0xffffu)), bf2f((unsigned short)(ldv.z >> 16)), bf2f((unsigned short)(ldv.w & 0xffffu)), bf2f((unsigned short)(ldv.w >> 16))};
            zacc[dk] = (c > 0) ? z0 : (f32x4){0.f, 0.f, 0.f, 0.f}; zacc[dk + 1] = (c > 0) ? z1 : (f32x4){0.f, 0.f, 0.f, 0.f}; }
        if (c < 31) {
#pragma unroll
            for (int dk = 0; dk < 8; dk += 2) {
                const f32x4 g0 = *(const LAS f32x4*)(gl + 16 * dk + 4 * fq), g1 = *(const LAS f32x4*)(gl + 16 * (dk + 1) + 4 * fq);
                const f32x4 n0 = (zacc[dk] + cacc[dk]) * g0, n1 = (zacc[dk + 1] + cacc[dk + 1]) * g1;
                u32x4 pv; pv.x = pk2(n0.x, n0.y); pv.y = pk2(n0.z, n0.w); pv.z = pk2(n1.x, n1.y); pv.w = pk2(n1.z, n1.w);
                ho_store(hb, (unsigned)(((w * 64 + lane) * 4 + (dk >> 1)) * 16), __builtin_bit_cast(f32x4, pv)); }
            asm volatile("s_waitcnt vmcnt(0)" ::: "memory");
            if (lane == 0) __hip_atomic_store(flag, (unsigned)(c + 1), __ATOMIC_RELAXED, __HIP_MEMORY_SCOPE_AGENT);
        }
#pragma unroll
        for (int dk = 0; dk < 8; ++dk) lds_w4(Zt + (16 * w + fr) * 136 + 16 * dk + 4 * fq, zacc[dk]);
        asm volatile("s_waitcnt lgkmcnt(0)" ::: "memory");
#pragma unroll
        for (int mi = 0; mi < 4; ++mi) {
            const f32x4 o = mm_tile(Qd + mi * 16 * 136, 136, Zw, 136, 4, opart[mi], fr, fq);
            LAS float* op = Of + (16 * mi + 4 * fq) * 132 + 16 * w + fr; op[0] = o.x; op[132] = o.y; op[264] = o.z; op[396] = o.w;
        }
        __syncthreads();
        for (int t = w; t < 64; t += NWAVES) {
            const float o0 = Of[t * 132 + lane], o1 = Of[t * 132 + lane + 64];
            const float ss = wsum(o0 * o0 + o1 * o1), rs = 1.0f / sqrtf(ss * (1.0f / 128.0f) + 1e-6f);
            bf16_t* gp = P + (size_t)(t0 + t) * P1LD + 3072 + h * 128;
            const float g0 = bf2f(gp[lane]), g1 = bf2f(gp[lane + 64]);
            gp[lane] = (bf16_t)f2bf(o0 * rs * onorm[lane] * siluf_(g0)); gp[lane + 64] = (bf16_t)f2bf(o1 * rs * onorm[lane + 64] * siluf_(g1));
        }
    }
}

__device__ __forceinline__ float tanh_fast(float x) { const float e = __expf(2.f * x); return 1.f - 2.f / (1.f + e); }
struct RwkvLd { u32x4 cu, pv; };
__device__ __forceinline__ RwkvLd rwkv_ld8(const bf16_t* Pc, int t, int gc, const bf16_t* hal) {
    const bf16_t* src = Pc + (size_t)t * P0LD + gc; const bf16_t* psrc = (t > 0) ? src - P0LD : hal + (gc - 2048);
    RwkvLd r; r.cu = *(const u32x4*)src; r.pv = *(const u32x4*)psrc; return r;
}
__device__ __forceinline__ void rwkv_sh8(const RwkvLd& ld, int t, int gc, bool first_zero, const float* mu, float (&sh)[8]) {
    const f32x4 m0 = *(const f32x4*)(mu + gc - 2048), m1 = *(const f32x4*)(mu + gc - 2048 + 4);
    const unsigned cw_[4] = {ld.cu.x, ld.cu.y, ld.cu.z, ld.cu.w}, pw_[4] = {ld.pv.x, ld.pv.y, ld.pv.z, ld.pv.w};
    const float mv[8] = {m0.x, m0.y, m0.z, m0.w, m1.x, m1.y, m1.z, m1.w};
    float cur[8];
#pragma unroll
    for (int e = 0; e < 8; ++e) {
        cur[e] = bf2f((unsigned short)((e & 1) ? (cw_[e >> 1] >> 16) : (cw_[e >> 1] & 0xffffu)));
        const float pg = bf2f((unsigned short)((e & 1) ? (pw_[e >> 1] >> 16) : (pw_[e >> 1] & 0xffffu)));
        const float prv = (t == 0 && first_zero) ? 0.f : pg;
        sh[e] = cur[e] + mv[e] * (prv - cur[e]);
    }
}
__device__ __forceinline__ void scan_rwkv3(const Frame& F, int b, int h, int par) {
    const int lane0 = lane_id_v(); const int w = F.wave;
    LAS unsigned char* L = F.lds;
    LAS bf16_t* RPb = (LAS bf16_t*)(L + 0);
    LAS bf16_t* KPb = (LAS bf16_t*)(L + 9216);
    LAS float* LWf = (LAS float*)(L + 18432);
    LAS float* Af = (LAS float*)(L + 34816);
    LAS float* segs = (LAS float*)(L + 51200);
    LAS bf16_t* Mak = (LAS bf16_t*)(L + 0);
    LAS bf16_t* Mrk = (LAS bf16_t*)(L + 9216);
    LAS bf16_t* Mrbn = (LAS bf16_t*)(L + 18432);
    LAS bf16_t* Aoff = (LAS bf16_t*)(L + 27648);
    LAS float* Adg = (LAS float*)(L + 36864);
    LAS bf16_t* Dg = (LAS bf16_t*)(L + 41216);
    LAS bf16_t* GB = (LAS bf16_t*)(L + 44288);
    LAS bf16_t* TL = (LAS bf16_t*)(L + 65536);
    LAS bf16_t* AL = (LAS bf16_t*)(L + 65536 + 9216);
    LAS bf16_t* SG = (LAS bf16_t*)(L + 65536 + 18432);
    LAS bf16_t* At = (LAS bf16_t*)(L + 65536);
    LAS bf16_t* Btl = (LAS bf16_t*)(L + 65536 + 9216);
    LAS bf16_t* Ktl = (LAS bf16_t*)(L + 65536 + 18432);
    LAS bf16_t* Rtl = (LAS bf16_t*)(L + 65536 + 27648);
    LAS float* Of = (LAS float*)(L + 65536);
    LAS bf16_t* BtTn = (LAS bf16_t*)(L + 102400);
    LAS bf16_t* KtT = (LAS bf16_t*)(L + 111616);
    LAS bf16_t* Vt = (LAS bf16_t*)(L + 120832);
    LAS bf16_t* Zt = (LAS bf16_t*)(L + 130048);
    LAS bf16_t* PU = (LAS bf16_t*)(L + 139264);
    LAS float* bonus = (LAS float*)(L + 148480);
    LAS float* glv = bonus + 64;
    static_assert(148480 + 4096 <= LDS_MISC, "rwkv3 LDS");
    bf16_t* P = (bf16_t*)(F.ws + WS_BIG + BIG_PROJ);
    const bf16_t* LW = (const bf16_t*)(F.ws + WS_LORA);
    const bf16_t* HALO = (const bf16_t*)(F.ws + WS_HALOB);
    const HoBuf hb = ho_buf((float*)(F.ws + WS_HOB) + (size_t)(b * 8 + h) * 4096, 16384);
    unsigned* flag = (unsigned*)(F.ws + WS_FLAGS) + 256 + (b * 8 + h) * 8 + w; unsigned* tmo = (unsigned*)(F.ws + WS_FLAGS) + 2047;
    const float* mu = F.in[IN_AB_MU];
    const float kkj = F.in[IN_AB_KK][h * 64 + lane0], kaj = F.in[IN_AB_KA][h * 64 + lane0], rkj = F.in[IN_AB_RK][h * 64 + lane0];
    const float lnw = F.in[IN_AB_LNW][h * 64 + lane0], lnb = F.in[IN_AB_LNB][h * 64 + lane0];
    float w0q[2], a0q[2];
#pragma unroll
    for (int q = 0; q < 2; ++q) { const int jq = ((2 * w + q) & 3) * 16 + (lane0 & 15); w0q[q] = F.in[IN_AB_W0][h * 64 + jq]; a0q[q] = F.in[IN_AB_A0][h * 64 + jq]; }
    bf16x8 yw[2][2], ya[2][2], yg[2][4];
#pragma unroll
    for (int q = 0; q < 2; ++q) { const int jrow = h * 64 + ((2 * w + q) & 3) * 16 + (lane0 & 15), fq0 = lane0 >> 4;
#pragma unroll
        for (int ksx = 0; ksx < 2; ++ksx) { yw[q][ksx] = *(const bf16x8*)(LW + (size_t)jrow * 64 + ksx * 32 + fq0 * 8); ya[q][ksx] = *(const bf16x8*)(LW + 512 * 64 + (size_t)jrow * 64 + ksx * 32 + fq0 * 8); }
#pragma unroll
        for (int ksx = 0; ksx < 4; ++ksx) yg[q][ksx] = *(const bf16x8*)(LW + 2 * 512 * 64 + (size_t)jrow * 128 + ksx * 32 + fq0 * 8); }
    f32x4 zacc[4];
#pragma unroll
    for (int i = 0; i < 4; ++i) zacc[i] = (f32x4){0.f, 0.f, 0.f, 0.f};
    for (int i = w * 64 + lane0; i < (64 * 72 * 2) / 2; i += NTHREADS) ((LAS unsigned*)Zt)[i] = 0u;
    __syncthreads();
    for (int c = par; c < 32; c += 2) {
        int lane = lane0; asm volatile("" : "+v"(lane));
        const int tid = w * 64 + lane, fr = lane & 15, fq = lane >> 4;
        const int t0 = b * TS + c * 64;
        {
            const bf16_t* Pc = P + (size_t)t0 * P0LD; const bf16_t* hal = HALO + (size_t)(b * 32 + (c > 0 ? c - 1 : 0)) * 1792; const bool fz = (c == 0);
            const int t_a0 = tid >> 4, cg_a0 = tid & 15, t_a1 = (tid + NTHREADS) >> 4, cg_a1 = (tid + NTHREADS) & 15, t_b = tid >> 3, cg_b = tid & 7;
            const int gc0 = ((cg_a0 < 8) ? 2048 : 2560) + h * 64 + (cg_a0 & 7) * 8, gc1 = ((cg_a1 < 8) ? 2048 : 2560) + h * 64 + (cg_a1 & 7) * 8;
            const int gc2 = 3584 + cg_b * 8, gc3 = 3648 + cg_b * 8, gc4 = 3712 + cg_a0 * 8, gc5 = 3712 + cg_a1 * 8;
            const RwkvLd l0 = rwkv_ld8(Pc, t_a0, gc0, hal), l1 = rwkv_ld8(Pc, t_a1, gc1, hal), l2 = rwkv_ld8(Pc, t_b, gc2, hal), l3 = rwkv_ld8(Pc, t_b, gc3, hal), l4 = rwkv_ld8(Pc, t_a0, gc4, hal), l5 = rwkv_ld8(Pc, t_a1, gc5, hal);
            const int vcol = tid & 63, vtg = tid >> 6;
            const bf16_t* vsrc = Pc + (size_t)(8 * vtg) * P0LD + 3072 + h * 64 + vcol;
            unsigned short vr[9];
#pragma unroll
            for (int i = 0; i < 8; ++i) vr[i + 1] = vsrc[(size_t)i * P0LD];
            vr[0] = *((vtg > 0) ? vsrc - P0LD : hal + 1024 + h * 64 + vcol);
            float sh[8];
            { rwkv_sh8(l0, t_a0, gc0, fz, mu, sh);
              *(LAS u32x4*)((cg_a0 < 8 ? RPb : KPb) + t_a0 * 72 + (cg_a0 & 7) * 8) = (u32x4){pk2(sh[0], sh[1]), pk2(sh[2], sh[3]), pk2(sh[4], sh[5]), pk2(sh[6], sh[7])}; }
            { rwkv_sh8(l1, t_a1, gc1, fz, mu, sh);
              *(LAS u32x4*)((cg_a1 < 8 ? RPb : KPb) + t_a1 * 72 + (cg_a1 & 7) * 8) = (u32x4){pk2(sh[0], sh[1]), pk2(sh[2], sh[3]), pk2(sh[4], sh[5]), pk2(sh[6], sh[7])}; }
            { rwkv_sh8(l2, t_b, gc2, fz, mu, sh);
              *(LAS u32x4*)(TL + t_b * 72 + cg_b * 8) = (u32x4){pk2(tanh_fast(sh[0]), tanh_fast(sh[1])), pk2(tanh_fast(sh[2]), tanh_fast(sh[3])), pk2(tanh_fast(sh[4]), tanh_fast(sh[5])), pk2(tanh_fast(sh[6]), tanh_fast(sh[7]))}; }
            { rwkv_sh8(l3, t_b, gc3, fz, mu, sh);
              *(LAS u32x4*)(AL + t_b * 72 + cg_b * 8) = (u32x4){pk2(sh[0], sh[1]), pk2(sh[2], sh[3]), pk2(sh[4], sh[5]), pk2(sh[6], sh[7])}; }
            { rwkv_sh8(l4, t_a0, gc4, fz, mu, sh);
              *(LAS u32x4*)(SG + t_a0 * 136 + cg_a0 * 8) = (u32x4){pk2(sigmoidf_(sh[0]), sigmoidf_(sh[1])), pk2(sigmoidf_(sh[2]), sigmoidf_(sh[3])), pk2(sigmoidf_(sh[4]), sigmoidf_(sh[5])), pk2(sigmoidf_(sh[6]), sigmoidf_(sh[7]))}; }
            { rwkv_sh8(l5, t_a1, gc5, fz, mu, sh);
              *(LAS u32x4*)(SG + t_a1 * 136 + cg_a1 * 8) = (u32x4){pk2(sigmoidf_(sh[0]), sigmoidf_(sh[1])), pk2(sigmoidf_(sh[2]), sigmoidf_(sh[3])), pk2(sigmoidf_(sh[4]), sigmoidf_(sh[5])), pk2(sigmoidf_(sh[6]), sigmoidf_(sh[7]))}; }
            {
                float cur[9];
#pragma unroll
                for (int i = 0; i < 9; ++i) cur[i] = bf2f(vr[i]);
                if (vtg == 0 && fz) cur[0] = 0.f;
                const float mvc = mu[1024 + h * 64 + vcol];
                float shv[8];
#pragma unroll
                for (int i = 0; i < 8; ++i) shv[i] = cur[i + 1] + mvc * (cur[i] - cur[i + 1]);
                *(LAS u32x4*)(Vt + vcol * 72 + 8 * vtg) = (u32x4){pk2(shv[0], shv[1]), pk2(shv[2], shv[3]), pk2(shv[4], shv[5]), pk2(shv[6], shv[7])};
            }
        }
        __syncthreads();
        f32x4 agate[2];
        {
#pragma unroll
            for (int q = 0; q < 2; ++q) {
                const int id = 2 * w + q, mi = id >> 2, nj = id & 3;
                f32x4 aw = {0.f, 0.f, 0.f, 0.f}, aa = {0.f, 0.f, 0.f, 0.f}, ag = {0.f, 0.f, 0.f, 0.f};
#pragma unroll
                for (int ksx = 0; ksx < 2; ++ksx) {
                    const bf16x8 x1 = *(const LAS bf16x8*)(TL + (mi * 16 + fr) * 72 + ksx * 32 + fq * 8), x2 = *(const LAS bf16x8*)(AL + (mi * 16 + fr) * 72 + ksx * 32 + fq * 8);
                    aw = MFMA32(x1, yw[q][ksx], aw); aa = MFMA32(x2, ya[q][ksx], aa);
                }
#pragma unroll
                for (int ksx = 0; ksx < 4; ++ksx) {
                    const bf16x8 x3 = *(const LAS bf16x8*)(SG + (mi * 16 + fr) * 136 + ksx * 32 + fq * 8);
                    ag = MFMA32(x3, yg[q][ksx], ag);
                }
                agate[q] = ag;
                const int j = nj * 16 + fr; const float w0j = w0q[q], a0j = a0q[q];
                const float awv[4] = {aw.x, aw.y, aw.z, aw.w}, aav[4] = {aa.x, aa.y, aa.z, aa.w};
#pragma unroll
                for (int rg = 0; rg < 4; ++rg) { const int t = mi * 16 + 4 * fq + rg;
                    LWf[t * 64 + j] = -0.6065306597126334f * sigmoidf_(w0j + awv[rg]); Af[t * 64 + j] = sigmoidf_(a0j + aav[rg]); }
            }
        }
        __syncthreads();
        {
            float g[8]; float run = 0.f;
#pragma unroll
            for (int i = 0; i < 8; ++i) { run += LWf[(8 * w + i) * 64 + lane]; g[i] = run; }
            segs[w * 64 + lane] = run;
            __syncthreads();
            float off = 0.f;
#pragma unroll
            for (int s2 = 0; s2 < 7; ++s2) if (s2 < w) off += segs[s2 * 64 + lane];
#pragma unroll
            for (int i = 0; i < 8; ++i) LWf[(8 * w + i) * 64 + lane] = off + g[i];
        }
        __syncthreads();
        {
            const int j = lane;
            float btn[8], ktt[8];
#pragma unroll
            for (int i = 0; i < 8; ++i) {
                const int t = 8 * w + i;
                const float kv = bf2f(KPb[t * 72 + j]), rv = bf2f(RPb[t * 72 + j]), a = Af[t * 64 + j], G = LWf[t * 64 + j];
                const float Gp = (t > 0) ? LWf[(t - 1) * 64 + j] : 0.f;
                const float kx = kv * kkj; const float ss = wsum(kx * kx); const float kk = kx * (1.0f / sqrtf(ss + 1e-6f));
                const float km = kv * (1.f + (a - 1.f) * kaj);
                const float bs = wsum(rv * km * rkj); if (j == 0) bonus[t] = bs;
                const float eG = __expf(G), eGi = __expf(-G), eGp = __expf(Gp);
                const float bt = kk * a * eGi, kt = km * eGi;
                At[t * 72 + j] = (bf16_t)f2bf(kk * eGp); Btl[t * 72 + j] = (bf16_t)f2bf(bt); Ktl[t * 72 + j] = (bf16_t)f2bf(kt); Rtl[t * 72 + j] = (bf16_t)f2bf(rv * eG);
                btn[i] = -bt; ktt[i] = kt;
                if (t == 63) glv[j] = eG;
            }
            *(LAS u32x4*)(BtTn + j * 72 + 8 * w) = (u32x4){pk2(btn[0], btn[1]), pk2(btn[2], btn[3]), pk2(btn[4], btn[5]), pk2(btn[6], btn[7])};
            *(LAS u32x4*)(KtT + j * 72 + 8 * w) = (u32x4){pk2(ktt[0], ktt[1]), pk2(ktt[2], ktt[3]), pk2(ktt[4], ktt[5]), pk2(ktt[6], ktt[7])};
        }
        __syncthreads();
        {
            for (int job = w; job < 64; job += NWAVES) {
                const int mat = job >> 4, bi = (job >> 2) & 3, bj = job & 3;
                LAS bf16_t* dst = (mat == 0) ? Aoff : (mat == 1 ? Mak : (mat == 2 ? Mrk : Mrbn));
                const int i = 16 * bi + fr, j0 = 16 * bj + 4 * fq;
                f32x4 o = {0.f, 0.f, 0.f, 0.f};
                if (bj <= bi) {
                    const LAS bf16_t* Aj = ((mat == 0 || mat == 3) ? Btl : Ktl) + bj * 16 * 72; const LAS bf16_t* Bi = ((mat < 2) ? At : Rtl) + bi * 16 * 72;
                    const f32x4 acc = mm_tile(Aj, 72, Bi, 72, 2, (f32x4){0.f, 0.f, 0.f, 0.f}, fr, fq);
                    const bool incl = mat >= 2;
                    o.x = (incl ? (j0 <= i) : (j0 < i)) ? acc.x : 0.f; o.y = (incl ? (j0 + 1 <= i) : (j0 + 1 < i)) ? acc.y : 0.f;
                    o.z = (incl ? (j0 + 2 <= i) : (j0 + 2 < i)) ? acc.z : 0.f; o.w = (incl ? (j0 + 3 <= i) : (j0 + 3 < i)) ? acc.w : 0.f;
                    if (mat == 0 && bi == bj) { LAS float* dd = Adg + (bi * 16 + fr) * 17 + 4 * fq; dd[0] = o.x; dd[1] = o.y; dd[2] = o.z; dd[3] = o.w; o = (f32x4){0.f, 0.f, 0.f, 0.f}; }
                    if (mat == 0 || mat == 3) o = -o;
                }
                lds_w4(dst + i * 72 + j0, o);
            }
#pragma unroll
            for (int q = 0; q < 2; ++q) { const int id = 2 * w + q, mi = id >> 2, nj = id & 3; const int j = nj * 16 + fr; const float gv[4] = {agate[q].x, agate[q].y, agate[q].z, agate[q].w};
#pragma unroll
                for (int rg = 0; rg < 4; ++rg) GB[(mi * 16 + 4 * fq + rg) * 64 + j] = (bf16_t)f2bf(gv[rg]); }
        }
        __syncthreads();
        f32x4 ot[4];
        if (w < 4 && c > 0) ho_wait_wave(flag, (unsigned)c, tmo);
        if (w < 4) {
#pragma unroll
            for (int kb = 0; kb < 4; kb += 2) {
                const u32x4 ldv = __builtin_bit_cast(u32x4, ho_load(hb, (unsigned)(((w * 64 + lane) * 2 + (kb >> 1)) * 16)));
                const f32x4 z0 = {bf2f((unsigned short)(ldv.x & 0xffffu)), bf2f((unsigned short)(ldv.x >> 16)), bf2f((unsigned short)(ldv.y & 0xffffu)), bf2f((unsigned short)(ldv.y >> 16))};
                const f32x4 z1 = {bf2f((unsigned short)(ldv.z & 0xffffu)), bf2f((unsigned short)(ldv.z >> 16)), bf2f((unsigned short)(ldv.w & 0xffffu)), bf2f((unsigned short)(ldv.w >> 16))};
                zacc[kb] = (c > 0) ? z0 : (f32x4){0.f, 0.f, 0.f, 0.f}; zacc[kb + 1] = (c > 0) ? z1 : (f32x4){0.f, 0.f, 0.f, 0.f}; }
#pragma unroll
            for (int kb = 0; kb < 4; ++kb) lds_w4(Zt + (16 * w + fr) * 72 + 16 * kb + 4 * fq, zacc[kb]);
            asm volatile("s_waitcnt lgkmcnt(0)" ::: "memory");
        }
        if (w < 4) {
            {
                const int bb = lane >> 4, jj = lane & 15; float x[16]; const LAS float* a = Adg + bb * 16 * 17;
#pragma unroll
                for (int i = 0; i < 16; ++i) { float v = (i == jj) ? 1.f : 0.f;
#pragma unroll
                    for (int k = 0; k < i; ++k) v -= a[i * 17 + k] * x[k];
                    x[i] = v; Dg[(bb * 16 + i) * 24 + jj] = (bf16_t)f2bf(v); }
                asm volatile("s_waitcnt lgkmcnt(0)" ::: "memory");
            }
            const LAS bf16_t* Vw = Vt + (16 * w) * 72; const LAS bf16_t* Zw = Zt + (16 * w) * 72; LAS bf16_t* PUw = PU + (16 * w) * 72;
            f32x4 p[4];
#pragma unroll
            for (int mi = 0; mi < 4; ++mi) { p[mi] = mm_tile(At + mi * 16 * 72, 72, Zw, 72, 2, (f32x4){0.f, 0.f, 0.f, 0.f}, fr, fq); p[mi] = mm_tile(Mak + mi * 16 * 72, 72, Vw, 72, 2, p[mi], fr, fq); }
#pragma unroll
            for (int bb = 0; bb < 4; ++bb) {
                f32x4 acc = p[bb];
                if (bb >= 1) acc = mm_tile(Aoff + bb * 16 * 72, 72, PUw, 72, (bb + 1) / 2, acc, fr, fq);
                u32x2 pk; pk.x = pk2(acc.x, acc.y); pk.y = pk2(acc.z, acc.w);
                const bf16x4 dgf = *(const LAS bf16x4*)(Dg + (bb * 16 + fr) * 24 + 4 * fq);
                const f32x4 ub = MFMA16(dgf, __builtin_bit_cast(bf16x4, pk), ((f32x4){0.f, 0.f, 0.f, 0.f}));
                lds_w4(PUw + fr * 72 + 16 * bb + 4 * fq, ub);
                asm volatile("s_waitcnt lgkmcnt(0)" ::: "memory");
            }
#pragma unroll
            for (int mi = 0; mi < 4; ++mi) {
                f32x4 o = mm_tile(Rtl + mi * 16 * 72, 72, Zw, 72, 2, (f32x4){0.f, 0.f, 0.f, 0.f}, fr, fq);
                o = mm_tile(Mrk + mi * 16 * 72, 72, Vw, 72, 2, o, fr, fq);
                ot[mi] = mm_tile(Mrbn + mi * 16 * 72, 72, PUw, 72, 2, o, fr, fq);
            }
#pragma unroll
            for (int kb = 0; kb < 4; ++kb) {
                f32x4 zn = mm_tile(KtT + kb * 16 * 72, 72, Vw, 72, 2, zacc[kb], fr, fq);
                zn = mm_tile(BtTn + kb * 16 * 72, 72, PUw, 72, 2, zn, fr, fq);
                const f32x4 g4 = *(const LAS f32x4*)(glv + 16 * kb + 4 * fq);
                zn = zn * g4; zacc[kb] = zn;
                lds_w4(Zt + (16 * w + fr) * 72 + 16 * kb + 4 * fq, zn);
            }
        }
        if (w < 4 && c < 31) {
#pragma unroll
            for (int kb = 0; kb < 4; kb += 2) { u32x4 pv; pv.x = pk2(zacc[kb].x, zacc[kb].y); pv.y = pk2(zacc[kb].z, zacc[kb].w); pv.z = pk2(zacc[kb + 1].x, zacc[kb + 1].y); pv.w = pk2(zacc[kb + 1].z, zacc[kb + 1].w);
                ho_store(hb, (unsigned)(((w * 64 + lane) * 2 + (kb >> 1)) * 16), __builtin_bit_cast(f32x4, pv)); }
            asm volatile("s_waitcnt vmcnt(0)" ::: "memory");
            if (lane == 0) __hip_atomic_store(flag, (unsigned)(c + 1), __ATOMIC_RELAXED, __HIP_MEMORY_SCOPE_AGENT);
        }
        __syncthreads();
        if (w < 4) {
#pragma unroll
            for (int mi = 0; mi < 4; ++mi) { LAS float* op = Of + (16 * mi + 4 * fq) * 65 + 16 * w + fr; op[0] = ot[mi].x; op[65] = ot[mi].y; op[130] = ot[mi].z; op[195] = ot[mi].w; }
        }
        __syncthreads();
        for (int t = w; t < 64; t += NWAVES) {
            const float o = Of[t * 65 + lane];
            const float mean = wsum(o) * (1.0f / 64.0f); const float dlt = o - mean; const float var = wsum(dlt * dlt) * (1.0f / 64.0f);
            float y = dlt * (1.0f / sqrtf(var + 64e-5f)) * lnw + lnb;
            y += bonus[t] * bf2f(Vt[lane * 72 + t]);
            y *= bf2f(GB[t * 64 + lane]);
            P[(size_t)(t0 + t) * P0LD + 2048 + h * 64 + lane] = (bf16_t)f2bf(y);
        }
        __syncthreads();
    }
}

__device__ __forceinline__ void attn_phase(const Frame& F, const bf16_t* Q, const bf16_t* Kb, const bf16_t* VT, bf16_t* O) {
    const int lane = lane_id_v(); const int tid = F.wave * 64 + lane; (void)tid;
    const int fr = lane & 15, fq = lane >> 4;
    for (int u = F.wg; u < 512; u += F.G) {
        const int b = u >> 6, h = (u >> 4) & 3, qb = u & 15;
        const int q0 = b * TS + qb * 128 + F.wave * 16;
        bf16x8 bq[8];
#pragma unroll
        for (int ksx = 0; ksx < 8; ++ksx) bq[ksx] = *(const bf16x8*)(Q + (size_t)(q0 + fr) * 1024 + h * 256 + ksx * 32 + fq * 8);
        f32x4 sacc[16];
#pragma unroll
        for (int tl = 0; tl < 16; ++tl) {
            f32x4 a4 = {0.f, 0.f, 0.f, 0.f};
            const bf16_t* kp = Kb + (size_t)(b * 256 + tl * 16 + fr) * 1024 + h * 256 + fq * 8;
#pragma unroll
            for (int ksx = 0; ksx < 8; ++ksx) { const bf16x8 a = *(const bf16x8*)(kp + ksx * 32); a4 = __builtin_amdgcn_mfma_f32_16x16x32_bf16(a, bq[ksx], a4, 0, 0, 0); }
            sacc[tl] = a4;
        }
        float mx = -3.0e38f;
#pragma unroll
        for (int tl = 0; tl < 16; ++tl) mx = fmaxf(mx, fmaxf(fmaxf(sacc[tl].x, sacc[tl].y), fmaxf(sacc[tl].z, sacc[tl].w)));
        mx = fmaxf(mx, __shfl_xor(mx, 16)); mx = fmaxf(mx, __shfl_xor(mx, 32));
        float l = 0.f;
        bf16x8 pb[8];
#pragma unroll
        for (int ksx = 0; ksx < 8; ++ksx) {
            const f32x4 e0 = sacc[2 * ksx], e1 = sacc[2 * ksx + 1];
            const float p0 = __expf(e0.x - mx), p1 = __expf(e0.y - mx), p2 = __expf(e0.z - mx), p3 = __expf(e0.w - mx);
            const float p4 = __expf(e1.x - mx), p5 = __expf(e1.y - mx), p6 = __expf(e1.z - mx), p7 = __expf(e1.w - mx);
            l += ((p0 + p1) + (p2 + p3)) + ((p4 + p5) + (p6 + p7));
            u32x4 w; w.x = pk2(p0, p1); w.y = pk2(p2, p3); w.z = pk2(p4, p5); w.w = pk2(p6, p7);
            pb[ksx] = __builtin_bit_cast(bf16x8, w);
        }
        l += __shfl_xor(l, 16); l += __shfl_xor(l, 32);
        const float inv = 1.0f / l;
        const bf16_t* vbase = VT + (size_t)((b * 4 + h) * 256) * 256;
#pragma unroll 4
        for (int dt = 0; dt < 16; ++dt) {
            f32x4 o4 = {0.f, 0.f, 0.f, 0.f};
            const bf16_t* vp = vbase + (size_t)(dt * 16 + fr) * 256 + 4 * fq;
#pragma unroll
            for (int ksx = 0; ksx < 8; ++ksx) {
                const u32x2 lo = *(const u32x2*)(vp + ksx * 32), hi = *(const u32x2*)(vp + ksx * 32 + 16);
                u32x4 w; w.x = lo.x; w.y = lo.y; w.z = hi.x; w.w = hi.y;
                o4 = __builtin_amdgcn_mfma_f32_16x16x32_bf16(__builtin_bit_cast(bf16x8, w), pb[ksx], o4, 0, 0, 0);
            }
            u32x2 w; w.x = pk2(o4.x * inv, o4.y * inv); w.y = pk2(o4.z * inv, o4.w * inv);
            *(u32x2*)(O + (size_t)(q0 + fr) * 1024 + h * 256 + dt * 16 + 4 * fq) = w;
        }
    }
}

__device__ __forceinline__ void attn_phase2(const Frame& F, const bf16_t* Q, const bf16_t* Kb, const bf16_t* VT, bf16_t* O) {
    const int lane = lane_id_v(); const int tid = F.wave * 64 + lane; const int fr = lane & 15, fq = lane >> 4;
    LAS bf16_t* KL = (LAS bf16_t*)F.lds;
    static_assert(256 * 264 * 2 <= LDS_MISC, "attn LDS");
    for (int u = F.wg; u < 512; u += F.G) {
        const int b = u >> 6, h = (u >> 4) & 3, qb = u & 15;
        const int q0 = b * TS + qb * 128 + F.wave * 16;
        u32x4 st[16];
#pragma unroll
        for (int n = 0; n < 16; ++n) { const int idx = tid + NTHREADS * n, row = idx >> 5, c8 = idx & 31;
            st[n] = *(const u32x4*)(Kb + (size_t)(b * 256 + row) * 1024 + h * 256 + c8 * 8); }
        bf16x8 bq[8];
#pragma unroll
        for (int ksx = 0; ksx < 8; ++ksx) bq[ksx] = *(const bf16x8*)(Q + (size_t)(q0 + fr) * 1024 + h * 256 + ksx * 32 + fq * 8);
        __syncthreads();
#pragma unroll
        for (int n = 0; n < 16; ++n) { const int idx = tid + NTHREADS * n, row = idx >> 5, c8 = idx & 31; *(LAS u32x4*)(KL + row * 264 + c8 * 8) = st[n]; }
        const bf16_t* vbase = VT + (size_t)((b * 4 + h) * 256) * 256;
#pragma unroll
        for (int n = 0; n < 16; ++n) { const int idx = tid + NTHREADS * n, row = idx >> 5, c8 = idx & 31; st[n] = *(const u32x4*)(vbase + (size_t)row * 256 + c8 * 8); }
        __syncthreads();
        f32x4 sacc[16];
#pragma unroll
        for (int tl = 0; tl < 16; ++tl) {
            f32x4 a4 = {0.f, 0.f, 0.f, 0.f};
#pragma unroll
            for (int ksx = 0; ksx < 8; ++ksx) a4 = __builtin_amdgcn_mfma_f32_16x16x32_bf16(*(const LAS bf16x8*)(KL + (tl * 16 + fr) * 264 + ksx * 32 + fq * 8), bq[ksx], a4, 0, 0, 0);
            sacc[tl] = a4;
        }
        float mx = -3.0e38f;
#pragma unroll
        for (int tl = 0; tl < 16; ++tl) mx = fmaxf(mx, fmaxf(fmaxf(sacc[tl].x, sacc[tl].y), fmaxf(sacc[tl].z, sacc[tl].w)));
        mx = fmaxf(mx, __shfl_xor(mx, 16)); mx = fmaxf(mx, __shfl_xor(mx, 32));
        float l = 0.f;
        bf16x8 pb[8];
#pragma unroll
        for (int ksx = 0; ksx < 8; ++ksx) {
            const f32x4 e0 = sacc[2 * ksx], e1 = sacc[2 * ksx + 1];
            const float p0 = __expf(e0.x - mx), p1 = __expf(e0.y - mx), p2 = __expf(e0.z - mx), p3 = __expf(e0.w - mx);
            const float p4 = __expf(e1.x - mx), p5 = __expf(e1.y - mx), p6 = __expf(e1.z - mx), p7 = __expf(e1.w - mx);
            l += ((p0 + p1) + (p2 + p3)) + ((p4 + p5) + (p6 + p7));
            u32x4 w; w.x = pk2(p0, p1); w.y = pk2(p2, p3); w.z = pk2(p4, p5); w.w = pk2(p6, p7);
            pb[ksx] = __builtin_bit_cast(bf16x8, w);
        }
        l += __shfl_xor(l, 16); l += __shfl_xor(l, 32);
        const float inv = 1.0f / l;
        __syncthreads();
#pragma unroll
        for (int n = 0; n < 16; ++n) { const int idx = tid + NTHREADS * n, row = idx >> 5, c8 = idx & 31; *(LAS u32x4*)(KL + row * 264 + c8 * 8) = st[n]; }
        __syncthreads();
#pragma unroll 4
        for (int dt = 0; dt < 16; ++dt) {
            f32x4 o4 = {0.f, 0.f, 0.f, 0.f};
            const LAS bf16_t* vp = KL + (dt * 16 + fr) * 264 + 4 * fq;
#pragma unroll
            for (int ksx = 0; ksx < 8; ++ksx) {
                const u32x2 lo = *(const LAS u32x2*)(vp + ksx * 32), hi = *(const LAS u32x2*)(vp + ksx * 32 + 16);
                u32x4 w; w.x = lo.x; w.y = lo.y; w.z = hi.x; w.w = hi.y;
                o4 = __builtin_amdgcn_mfma_f32_16x16x32_bf16(__builtin_bit_cast(bf16x8, w), pb[ksx], o4, 0, 0, 0);
            }
            u32x2 w; w.x = pk2(o4.x * inv, o4.y * inv); w.y = pk2(o4.z * inv, o4.w * inv);
            *(u32x2*)(O + (size_t)(q0 + fr) * 1024 + h * 256 + dt * 16 + 4 * fq) = w;
        }
    }
    __syncthreads();
}

__device__ __forceinline__ void router_phase(const Frame& F, int layer) {
    const int lane = lane_id_v(); const int tid = F.wave * 64 + lane; (void)tid;
    const float* XF = F.out; const float* gain = F.in[IN_NORM_FFN] + layer * 1024;
    const float* wg = F.in[IN_MOE_WG] + (size_t)layer * 1024 * 4; const float* we = F.in[IN_MOE_WE] + (size_t)layer * 1024 * 16;
    const float* bg = F.in[IN_MOE_BG] + layer * 4; const float* be = F.in[IN_MOE_BE] + layer * 16;
    unsigned* cnt = (unsigned*)(F.ws + WS_CNT) + layer * 32;
    int* tokb = (int*)(F.ws + WS_ROUTE); int* tokp = tokb + NT; f32x4* tokg = (f32x4*)(tokp + NT);
    const int gw = F.wg * NWAVES + F.wave, NGW = F.G * NWAVES;
    for (int row = gw; row < NT; row += NGW) {
        const f32x4* xr = (const f32x4*)(XF + (size_t)row * 1024) + lane;
        float s = 0.f, lg[4], le[16];
#pragma unroll
        for (int c = 0; c < 4; ++c) lg[c] = 0.f;
#pragma unroll
        for (int c = 0; c < 16; ++c) le[c] = 0.f;
#pragma unroll 1
        for (int j = 0; j < 4; ++j) {
            const f32x4 v = xr[64 * j]; s += (v.x * v.x + v.y * v.y) + (v.z * v.z + v.w * v.w);
            const int k0 = 4 * lane + 256 * j; const f32x4 g = *(const f32x4*)(gain + k0);
            const float xv[4] = {v.x * g.x, v.y * g.y, v.z * g.z, v.w * g.w};
#pragma unroll
            for (int q = 0; q < 4; ++q) {
                const f32x4 a = *(const f32x4*)(wg + (size_t)(k0 + q) * 4);
                lg[0] += xv[q] * a.x; lg[1] += xv[q] * a.y; lg[2] += xv[q] * a.z; lg[3] += xv[q] * a.w;
#pragma unroll
                for (int e4 = 0; e4 < 4; ++e4) { const f32x4 w = *(const f32x4*)(we + (size_t)(k0 + q) * 16 + 4 * e4);
                    le[4 * e4] += xv[q] * w.x; le[4 * e4 + 1] += xv[q] * w.y; le[4 * e4 + 2] += xv[q] * w.z; le[4 * e4 + 3] += xv[q] * w.w; }
            }
        }
        s = wave_sum(s);
        const float rstd = 1.0f / sqrtf(s * (1.0f / 1024.0f) + 1e-6f);
#pragma unroll
        for (int c = 0; c < 4; ++c) lg[c] = wave_sum(lg[c]) * rstd + bg[c];
#pragma unroll
        for (int c = 0; c < 16; ++c) le[c] = wave_sum(le[c]) * rstd + be[c];
        int gs = 0; float gm = lg[0];
#pragma unroll
        for (int c = 1; c < 4; ++c) if (lg[c] > gm) { gm = lg[c]; gs = c; }
        float gz = 0.f;
#pragma unroll
        for (int c = 0; c < 4; ++c) gz += __expf(lg[c] - gm);
        const float ggate = 1.0f / gz;
        float l4[4];
#pragma unroll
        for (int c = 0; c < 4; ++c) { float v = le[c];
#pragma unroll
            for (int g2 = 1; g2 < 4; ++g2) v = (gs == g2) ? le[4 * g2 + c] : v;
            l4[c] = v; }
        int i0 = 0; float m0 = l4[0];
#pragma unroll
        for (int c = 1; c < 4; ++c) if (l4[c] > m0) { m0 = l4[c]; i0 = c; }
        int i1 = -1; float m1 = -3.0e38f;
#pragma unroll
        for (int c = 0; c < 4; ++c) if (c != i0 && l4[c] > m1) { m1 = l4[c]; i1 = c; }
        const float e1 = __expf(m1 - m0); const float g0 = ggate / (1.f + e1), g1 = ggate * e1 / (1.f + e1);
        const int ia = i0 < i1 ? i0 : i1, ib = i0 < i1 ? i1 : i0;
        const float ga = i0 < i1 ? g0 : g1, gb = i0 < i1 ? g1 : g0;
        const int pidx = (ia == 0) ? (ib - 1) : (ia == 1 ? ib + 1 : 5);
        const int bucket = gs * 6 + pidx;
        if (lane == 0) {
            const unsigned pos = atomicAdd(&cnt[bucket], 1u);
            tokb[row] = bucket; tokp[row] = (int)pos; tokg[row] = (f32x4){rstd, ga, gb, 0.f};
        }
    }
}
typedef float f32x16 __attribute__((ext_vector_type(16)));
__device__ __forceinline__ void router_phase2(const Frame& F, int layer) {
    const int lane = lane_id_v(); const int tid = F.wave * 64 + lane; const int w = F.wave;
    const bf16_t* XBr = (const bf16_t*)(F.ws + WS_XB); const float* rw = (const float*)(F.ws + WS_RW) + (size_t)layer * 1024 * 32;
    const float* ssp = (const float*)(F.ws + WS_SSP);
    unsigned* cntwg = (unsigned*)(F.ws + WS_CNTWG);
    int* tokb = (int*)(F.ws + WS_ROUTE); int* tokp = tokb + NT; f32x4* tokg = (f32x4*)(tokp + NT);
    LAS float* T = (LAS float*)F.lds + w * (32 * 132);
    LAS float* Pp = (LAS float*)F.lds;
    LAS float* Lg = Pp + 8 * 64 * 33;
    LAS unsigned* lcnt = (LAS unsigned*)(Lg + 64 * 33);
    const int i31 = lane & 31, kh = lane >> 5, k0 = 128 * w;
    float bW[64];
#pragma unroll
    for (int s2 = 0; s2 < 64; ++s2) bW[s2] = rw[(size_t)(k0 + 2 * s2 + kh) * 32 + i31];
    unsigned rp0 = 0, rp1 = 0, rp2 = 0, rp3 = 0; if (PROBE_STAGE >= 10) rp0 = (unsigned)__builtin_amdgcn_s_memrealtime();
    for (int blk = F.wg; blk < NT / 64; blk += F.G) {
        const int r0 = blk * 64;
        f32x16 acc0, acc1;
#pragma unroll
        for (int e = 0; e < 16; ++e) { acc0[e] = 0.f; acc1[e] = 0.f; }
#pragma unroll
        for (int rt = 0; rt < 2; ++rt) {
#pragma unroll
            for (int n = 0; n < 16; ++n) { const int idx = lane + 64 * n, row = idx >> 5, c4 = idx & 31;
                const u32x2 rv = *(const u32x2*)(XBr + (size_t)(r0 + 32 * rt + row) * 1024 + k0 + 4 * c4);
                *(LAS f32x4*)(T + row * 132 + 4 * c4) = (f32x4){bf2f((unsigned short)(rv.x & 0xffffu)), bf2f((unsigned short)(rv.x >> 16)), bf2f((unsigned short)(rv.y & 0xffffu)), bf2f((unsigned short)(rv.y >> 16))}; }
            asm volatile("s_waitcnt lgkmcnt(0)" ::: "memory");
#pragma unroll
            for (int s2 = 0; s2 < 64; ++s2) {
                const float a0 = T[i31 * 132 + 2 * s2 + kh];
                if (rt == 0) acc0 = __builtin_amdgcn_mfma_f32_32x32x2f32(a0, bW[s2], acc0, 0, 0, 0);
                else acc1 = __builtin_amdgcn_mfma_f32_32x32x2f32(a0, bW[s2], acc1, 0, 0, 0);
            }
            asm volatile("s_waitcnt lgkmcnt(0)" ::: "memory");
        }
        __syncthreads();
        if (PROBE_STAGE >= 10) rp1 = (unsigned)__builtin_amdgcn_s_memrealtime();
#pragma unroll
        for (int e = 0; e < 16; ++e) { const int row = (e & 3) + 8 * (e >> 2) + 4 * kh;
            Pp[(w * 64 + row) * 33 + i31] = acc0[e]; Pp[(w * 64 + 32 + row) * 33 + i31] = acc1[e]; }
        __syncthreads();
        for (int idx = tid; idx < 64 * 32; idx += NTHREADS) { const int row = idx >> 5, cc = idx & 31; float a = 0.f;
#pragma unroll
            for (int ww = 0; ww < 8; ++ww) a += Pp[(ww * 64 + row) * 33 + cc];
            Lg[row * 33 + cc] = a; }
        if (tid < 24) lcnt[tid] = 0u;
        __syncthreads();
        if (PROBE_STAGE >= 10) rp2 = (unsigned)__builtin_amdgcn_s_memrealtime();
        if (tid < 64) {
            const int row = r0 + tid; const float rstd = row_rstd(ssp, row);
            const float* bg = F.in[IN_MOE_BG] + layer * 4; const float* be = F.in[IN_MOE_BE] + layer * 16;
            float lg[4], le[16];
#pragma unroll
            for (int c2 = 0; c2 < 4; ++c2) lg[c2] = Lg[tid * 33 + c2] * rstd + bg[c2];
#pragma unroll
            for (int c2 = 0; c2 < 16; ++c2) le[c2] = Lg[tid * 33 + 4 + c2] * rstd + be[c2];
            int gs = 0; float gm = lg[0];
#pragma unroll
            for (int c2 = 1; c2 < 4; ++c2) if (lg[c2] > gm) { gm = lg[c2]; gs = c2; }
            float gz = 0.f;
#pragma unroll
            for (int c2 = 0; c2 < 4; ++c2) gz += __expf(lg[c2] - gm);
            const float ggate = 1.0f / gz;
            float l4[4];
#pragma unroll
            for (int c2 = 0; c2 < 4; ++c2) { float v = le[c2];
#pragma unroll
                for (int g2 = 1; g2 < 4; ++g2) v = (gs == g2) ? le[4 * g2 + c2] : v;
                l4[c2] = v; }
            int i0 = 0; float m0 = l4[0];
#pragma unroll
            for (int c2 = 1; c2 < 4; ++c2) if (l4[c2] > m0) { m0 = l4[c2]; i0 = c2; }
            int i1 = -1; float m1 = -3.0e38f;
#pragma unroll
            for (int c2 = 0; c2 < 4; ++c2) if (c2 != i0 && l4[c2] > m1) { m1 = l4[c2]; i1 = c2; }
            const float e1 = __expf(m1 - m0); const float g0 = ggate / (1.f + e1), g1 = ggate * e1 / (1.f + e1);
            const int ia = i0 < i1 ? i0 : i1, ib = i0 < i1 ? i1 : i0;
            const float ga = i0 < i1 ? g0 : g1, gb = i0 < i1 ? g1 : g0;
            const int pidx = (ia == 0) ? (ib - 1) : (ia == 1 ? ib + 1 : 5);
            const int bucket = gs * 6 + pidx;
            const unsigned pos = __hip_atomic_fetch_add(&lcnt[bucket], 1u, __ATOMIC_RELAXED, __HIP_MEMORY_SCOPE_WORKGROUP);
            tokb[row] = bucket; tokp[row] = (int)pos; tokg[row] = (f32x4){rstd, ga, gb, 0.f};
        }
        __syncthreads();
        if (tid < 24) cntwg[blk * 24 + tid] = lcnt[tid];
        if (PROBE_STAGE >= 10) rp3 = (unsigned)__builtin_amdgcn_s_memrealtime();
    }
    if (PROBE_STAGE >= 10 && layer == 0 && F.wg == 0 && w == 0 && lane == 0) __hip_atomic_store((unsigned*)(F.ws + WS_CTL + 20484), PROBE_STAGE == 10 ? rp1 - rp0 : (PROBE_STAGE == 11 ? rp2 - rp1 : rp3 - rp2), __ATOMIC_RELAXED, __HIP_MEMORY_SCOPE_AGENT);
}
__device__ __forceinline__ void gather_phase(const Frame& F, int layer) {
    const int lane = lane_id_v(); const int tid = F.wave * 64 + lane; (void)tid;
    const int* tokb = (const int*)(F.ws + WS_ROUTE); const int* tokp = tokb + NT; const f32x4* tokg = (const f32x4*)(tokp + NT); f32x4* rowinfo = (f32x4*)(tokg + NT);
    const bf16_t* XB = (const bf16_t*)(F.ws + WS_XB); bf16_t* XG = (bf16_t*)(F.ws + WS_BIG + BIG_XG);
    LAS int* off = (LAS int*)F.lds;
    LAS int* tot = off + 32;
    LAS int* offs = off + 64;
    const unsigned* cntwg = (const unsigned*)(F.ws + WS_CNTWG);
    if (tid < 24) { int run = 0;
        for (int blk = 0; blk < 256; ++blk) { offs[blk * 24 + tid] = run; run += (int)cntwg[blk * 24 + tid]; }
        tot[tid] = run;
        if (F.wg == 0) ((unsigned*)(F.ws + WS_CNT))[layer * 32 + tid] = (unsigned)run; }
    __syncthreads();
    if (tid == 0) { int acc = 0; for (int b = 0; b < 24; ++b) { off[b] = acc * 256; acc += (tot[b] + 255) >> 8; } }
    __syncthreads();
    const int gw = F.wg * NWAVES + F.wave, NGW = F.G * NWAVES;
    for (int tok = gw; tok < NT; tok += NGW) {
        const int bk = tokb[tok]; const int row = off[bk] + offs[(tok >> 6) * 24 + bk] + tokp[tok];
        const u32x4* src = (const u32x4*)(XB + (size_t)tok * 1024) + lane; u32x4* dst = (u32x4*)(XG + (size_t)row * 1024) + lane;
        dst[0] = src[0]; dst[64] = src[64];
        if (lane == 0) { f32x4 g = tokg[tok]; g.w = __int_as_float(tok); rowinfo[row] = g; }
    }
    __syncthreads();
}
__device__ __forceinline__ void final_phase(const Frame& F) {
    const int lane = lane_id_v();
    float* out = F.out; const bf16_t* XBr = (const bf16_t*)(F.ws + WS_XB); const float* gain = F.in[IN_NORM_FINAL];
    const int gw = F.wg * NWAVES + F.wave, NGW = F.G * NWAVES;
    for (int row = gw; row < NT; row += NGW) {
        const u32x2* xr = (const u32x2*)(XBr + (size_t)row * 1024) + lane;
        f32x4 v[4]; float s = 0.f;
#pragma unroll
        for (int j = 0; j < 4; ++j) { const u32x2 r = xr[64 * j]; v[j] = (f32x4){bf2f((unsigned short)(r.x & 0xffffu)), bf2f((unsigned short)(r.x >> 16)), bf2f((unsigned short)(r.y & 0xffffu)), bf2f((unsigned short)(r.y >> 16))};
            s += (v[j].x * v[j].x + v[j].y * v[j].y) + (v[j].z * v[j].z + v[j].w * v[j].w); }
        s = wsum(s);
        const float rstd = 1.0f / sqrtf(s * (1.0f / 1024.0f) + 1e-6f);
        f32x4* orow = (f32x4*)(out + (size_t)row * 1024) + lane;
#pragma unroll
        for (int j = 0; j < 4; ++j) { const f32x4 g = *(const f32x4*)(gain + 4 * lane + 256 * j); orow[64 * j] = v[j] * rstd * g; }
    }
}

constexpr int N_PHASES = 24;
#ifndef PH_MASK
#define PH_MASK 0xFFFFFFFFu
#endif
#define IN(k) (((PH_MASK >> ((k) > 11 ? (k) - 11 : (k))) & 1u) && lo <= (k) && (k) < hi)
#define TS_STAMP(k) do { if (TS_A >= 0 && ((k) == TS_A || (k) == TS_B) && F.wg == 0 && F.wave == 0 && lane_id_v() == 0) ((volatile LAS unsigned*)(F.lds + LDS_MISC + 1024))[(k)] = (unsigned)__builtin_amdgcn_s_memrealtime(); } while (0)
#define SEAM(k) do { if (IN(k) && IN((k) + 1)) xcd_barrier(bar); TS_STAMP((k) + 1); } while (0)
#define SEAM2(k) do { if (IN(k) && IN((k) + 2)) xcd_barrier(bar); TS_STAMP((k) + 2); } while (0)

template <int LAYER>
__device__ __forceinline__ void layer_phases(const Frame& F, const XcdBarrier& bar, const int lo, const int hi) {
    constexpr int pb = LAYER * 11;
    unsigned char* const ws = F.ws;
#define WPTR(off) ((bf16_t*)(ws + (LAYER ? WS_W1 : WS_W0)) + (off))
#define XB_ ((bf16_t*)(ws + WS_XB))
#define SSP_ ((float*)(ws + WS_SSP))
#define PROJ_ ((bf16_t*)(ws + WS_BIG + BIG_PROJ))
#define KB_ (LAYER ? (bf16_t*)(ws + WS_W0) : (bf16_t*)(ws + WS_BIG + BIG_KV0))
#define VT_ (KB_ + (size_t)2048 * 1024)
#define QB_ ((bf16_t*)(ws + WS_BIG + BIG_Q))
#define ATT_ ((bf16_t*)(ws + WS_BIG + BIG_ATT))
#define XG_ ((bf16_t*)(ws + WS_BIG + BIG_XG))
#define HID_ ((bf16_t*)(ws + WS_BIG + BIG_HID))
#define CNT_ ((const unsigned*)(ws + WS_CNT) + LAYER * 32)
#define ROWINFO_ ((const f32x4*)(ws + WS_ROUTE + (size_t)NT * 8 + (size_t)NT * 16))
    if (IN(pb + 1)) {
        if (LAYER == 0) {
            pg8::Gemm g{1024, 1024, 1024, 1 << 20}; pg8::DenseSched S; S.init(NT, 3840, F.G, F.wg, XB_, 1024, WPTR(WO_WIN), 1024);
            EpiScale<0> E{PROJ_, P0LD, SSP_, 1.0f, nullptr, (bf16_t*)(ws + WS_HALOB)};
            pg8::gemm_phase(F.lds, F.wave, g, S, E);
            { pg8::Gemm g2{1024, 1024, 1024, 1 << 20}; pg8::DenseSched S2; S2.init(2048, 2048, F.G, F.wg, (const bf16_t*)(ws + WS_MEMH), 1024, WPTR(WO_WKV), 1024);
              EpiKV E2{KB_, VT_}; pg8::gemm_phase(F.lds, F.wave, g2, S2, E2); }
        } else {
            pg8::Gemm g{1024, 1024, 1024, 1 << 20}; pg8::DenseSched S; S.init(NT, 4096, F.G, F.wg, XB_, 1024, WPTR(WO_WIN), 1024);
            EpiScale<1> E{PROJ_, P1LD, SSP_, 1.0f, (const float*)(ws + WS_LB), nullptr};
            pg8::gemm_phase(F.lds, F.wave, g, S, E);
        }
    }
    SEAM(pb + 1);
    if (IN(pb + 2)) {
        unsigned pt0 = 0; if (PROBE_WG >= 0 && LAYER == 0) pt0 = (unsigned)__builtin_amdgcn_s_memrealtime();
        if (LAYER == 0) {
#ifndef NO_DELTA
            if (F.wg < 96) { const int st = F.wg & 31; scan_delta3(F, st >> 2, st & 3, F.wg >> 5, 3); }
#endif
#ifndef NO_RWKV
            if (F.wg >= 96 && F.wg < 224) { const int q = F.wg - 96, st = ((q >> 4) << 3) | (q & 7), par = (q >> 3) & 1; scan_rwkv3(F, st >> 3, st & 7, par); }
#endif
            if (F.wg >= 224) p0_late_weights<0>(F, F.wg - 224, F.G - 224);
        } else {
#ifndef NO_HGRN
            if (F.wg < 192) { const int st = F.wg & 63; scan_hgrn3(F, st >> 3, st & 7, F.wg >> 6, 3); }
#endif
            if (F.wg >= 192) p0_late_weights<1>(F, F.wg - 192, F.G - 192);
        }
        if (PROBE_WG >= 0 && LAYER == 0 && F.wg == PROBE_WG && F.wave == 0 && lane_id_v() == 0) __hip_atomic_store((unsigned*)(F.ws + WS_CTL + 20480), (unsigned)__builtin_amdgcn_s_memrealtime() - pt0, __ATOMIC_RELAXED, __HIP_MEMORY_SCOPE_AGENT);
    }
    SEAM2(pb + 2);
    if (IN(pb + 4)) {
        constexpr int lda = LAYER ? P1LD : P0LD; const bf16_t* A = PROJ_ + (LAYER ? 3072 : 1536);
        pg8::Gemm g{lda, 1024, 1024, 1 << 20}; pg8::DenseSched S; S.init(NT, 1024, F.G, F.wg, A, lda, WPTR(WO_WOUT), 1024);
        EpiResid<false> E{LAYER ? (const float*)nullptr : F.in[IN_X], XB_, SSP_, nullptr};
        pg8::gemm_phase(F.lds, F.wave, g, S, E);
    }
    SEAM(pb + 4);
    if (IN(pb + 5)) {
        pg8::Gemm g{1024, 1024, 1024, 1 << 20}; pg8::DenseSched S; S.init(NT, 1024, F.G, F.wg, XB_, 1024, WPTR(WO_WQ), 1024);
        EpiScale<0> E{QB_, 1024, SSP_, 0.0625f, nullptr, nullptr};
        pg8::gemm_phase(F.lds, F.wave, g, S, E);
    }
    SEAM(pb + 5);
    if (IN(pb + 6)) attn_phase2(F, QB_, KB_, VT_, ATT_);
    SEAM(pb + 6);
    if (IN(pb + 7)) {
        pg8::Gemm g{1024, 1024, 1024, 1 << 20}; pg8::DenseSched S; S.init(NT, 1024, F.G, F.wg, ATT_, 1024, WPTR(WO_WO), 1024);
        EpiResid<false> E{nullptr, XB_, SSP_, nullptr};
        pg8::gemm_phase(F.lds, F.wave, g, S, E);
    }
    SEAM(pb + 7);
    if (IN(pb + 8)) router_phase2(F, LAYER);
    SEAM(pb + 8);
    if (IN(pb + 9)) gather_phase(F, LAYER);
    SEAM(pb + 9);
    if (IN(pb + 10)) {
        if (LAYER == 0 && F.wg >= 192) {
            pg8::Gemm g2{1024, 1024, 1024, 1 << 20}; pg8::DenseSched S2; S2.init(2048, 2048, 64, F.wg - 192, (const bf16_t*)(ws + WS_MEMH), 1024, (const bf16_t*)(ws + WS_W1) + WO_WKV, 1024);
            EpiKV E2{(bf16_t*)(ws + WS_KV1), (bf16_t*)(ws + WS_KV1) + (size_t)2048 * 1024}; pg8::gemm_phase(F.lds, F.wave, g2, S2, E2); }
        LAS int* tbl = (LAS int*)(F.lds + LDS_MISC + 512); moe_build_table(tbl, CNT_, F.wave * 64 + lane_id_v());
        pg8::Gemm g{1024, 1024, 1024, 1 << 20}; MoeSched<false> S{tbl, __builtin_amdgcn_readfirstlane(tbl[95]), F.G, F.wg, (const char*)XG_, (const char*)WPTR(WO_W13)};
        EpiMoeUp E{HID_, ROWINFO_};
        pg8::gemm_phase(F.lds, F.wave, g, S, E);
    }
    SEAM(pb + 10);
    if (IN(pb + 11)) {
        LAS int* tbl = (LAS int*)(F.lds + LDS_MISC + 512); moe_build_table(tbl, CNT_, F.wave * 64 + lane_id_v());
        pg8::Gemm g{512, 256, 512, 4}; MoeSched<true> S{tbl, __builtin_amdgcn_readfirstlane(tbl[95]), F.G, F.wg, (const char*)HID_, (const char*)WPTR(WO_W2T)};
        EpiResid<true> E{nullptr, XB_, SSP_, ROWINFO_};
        pg8::gemm_phase(F.lds, F.wave, g, S, E);
    }
    SEAM(pb + 11);
}

__global__ void __launch_bounds__(NTHREADS, 2) fwd_mega(Args args) {
    extern __shared__ __attribute__((aligned(16))) unsigned char lds_raw[];
    Frame F;
    F.lds = (LAS unsigned char*)lds_raw;
    const int tid = threadIdx.x; F.wave = __builtin_amdgcn_readfirstlane(tid >> 6);
    F.G = gridDim.x; F.wg = blockIdx.x;
    F.out = args.out; F.ws = args.ws;
    volatile LAS unsigned* MISC = (volatile LAS unsigned*)(F.lds + LDS_MISC);
    LAS unsigned long long* tab = (LAS unsigned long long*)(F.lds + LDS_MISC + 64);
    F.in.t = tab;
    if (tid < 16) MISC[tid] = 0u;
    if (tid == 0) {
#pragma unroll
        for (int i = 0; i < 38; ++i) tab[i] = (unsigned long long)args.in[i];
    }
    __syncthreads();
    XcdBarrier bar; bar.bar = (unsigned*)(F.ws + WS_CTL); bar.x = 0; bar.st = MISC; bar.wave = F.wave;
#if N_LAUNCH_MODE == 1
    bar = xcd_barrier_post((unsigned*)(F.ws + WS_CTL), MISC, F.wave);
#endif
    const int lo = args.ph_lo, hi = args.ph_hi;
    TS_STAMP(0);
    if (IN(0)) { p0_prologue(F); }
    SEAM(0);
    layer_phases<0>(F, bar, lo, hi);
    layer_phases<1>(F, bar, lo, hi);
    if (IN(23)) final_phase(F);
#ifdef EXTRA_BARS
    for (int eb = 0; eb < EXTRA_BARS; ++eb) xcd_barrier(bar);
#endif
    if (TS_A >= 0 && F.wg == 0 && F.wave == 0) {
        asm volatile("s_waitcnt vmcnt(0)" ::: "memory");
        if (lane_id_v() == 0) { volatile LAS unsigned* ts = (volatile LAS unsigned*)(F.lds + LDS_MISC + 1024);
            float us = (float)(ts[TS_B] - ts[TS_A]) * 0.01f;
            if (PROBE_WG >= 0) us = (float)__hip_atomic_load((unsigned*)(F.ws + WS_CTL + 20480), __ATOMIC_RELAXED, __HIP_MEMORY_SCOPE_AGENT) * 0.01f;
            if (PROBE_STAGE >= 0) us = (float)__hip_atomic_load((unsigned*)(F.ws + WS_CTL + 20484), __ATOMIC_RELAXED, __HIP_MEMORY_SCOPE_AGENT) * 0.01f;
            F.out[0] = F.out[0] + us * TS_SCALE; }
    }
}
#undef IN
#undef SEAM

extern "C" void kernel_launch(void* const* d_in, const int* in_sizes, int n_in, void* d_out, int out_size, void* d_ws, size_t ws_size, hipStream_t stream) {
    static int grid = 0;
    if (grid == 0) {
        if (n_in != 38 || out_size != NT * DM || ws_size < WS_END) { fprintf(stderr, "kernel_launch: unexpected problem (n_in %d out %d ws %zu)\n", n_in, out_size, ws_size); grid = -1; return; }
        int dev = 0, cus = 0, per_cu = 0;
        if (hipGetDevice(&dev) != hipSuccess || hipDeviceGetAttribute(&cus, hipDeviceAttributeMultiprocessorCount, dev) != hipSuccess) { grid = -1; return; }
        if (hipFuncSetAttribute((const void*)fwd_mega, hipFuncAttributeMaxDynamicSharedMemorySize, LDS_BYTES) != hipSuccess) { fprintf(stderr, "kernel_launch: hipFuncSetAttribute failed\n"); grid = -1; return; }
        if (hipOccupancyMaxActiveBlocksPerMultiprocessor(&per_cu, (const void*)fwd_mega, NTHREADS, LDS_BYTES) != hipSuccess || per_cu < 1) { fprintf(stderr, "kernel_launch: occupancy query says %d\n", per_cu); (void)hipGetLastError(); grid = -1; return; }
        grid = cus;
    }
    if (grid < 0) return;
    (void)hipMemsetAsync((char*)d_ws + WS_CTL, 0, 32768, stream);
    Args a{};
    for (int i = 0; i < 38; ++i) a.in[i] = (const float*)d_in[i];
    a.out = (float*)d_out; a.ws = (unsigned char*)d_ws;
#if N_LAUNCH_MODE == 1
    a.ph_lo = 0; a.ph_hi = N_PHASES;
    void* kargs[] = {&a};
    hipError_t e = hipLaunchCooperativeKernel((const void*)fwd_mega, dim3(grid), dim3(NTHREADS), kargs, LDS_BYTES, stream);
    if (e != hipSuccess) fprintf(stderr, "kernel_launch: cooperative launch failed: %s\n", hipGetErrorString(e));
#else
    for (int p = 0; p < N_PHASES; ++p) { a.ph_lo = p; a.ph_hi = p + 1; hipLaunchKernelGGL(fwd_mega, dim3(grid), dim3(NTHREADS), LDS_BYTES, stream, a); }
#endif
}
```

```cpp
#include <hip/hip_runtime.h>
#include <cstdio>
#include <cstdint>

#ifndef N_LAUNCH_MODE
#define N_LAUNCH_MODE 1
#endif

#ifndef TS_A
#define TS_A -1
#endif
#ifndef TS_B
#define TS_B 0
#endif
#ifndef PROBE_WG
#define PROBE_WG -1
#endif
#ifndef PROBE_STAGE
#define PROBE_STAGE -1
#endif
#ifndef TS_SCALE
#define TS_SCALE 0.01f
#endif

#define LAS __attribute__((address_space(3)))
#define GAS __attribute__((address_space(1)))
typedef unsigned short bf16_t;
typedef short bf16x8 __attribute__((ext_vector_type(8)));
typedef short bf16x4 __attribute__((ext_vector_type(4)));
typedef float f32x4 __attribute__((ext_vector_type(4)));
typedef float f32x2 __attribute__((ext_vector_type(2)));
typedef unsigned u32x4 __attribute__((ext_vector_type(4)));
typedef unsigned u32x2 __attribute__((ext_vector_type(2)));

constexpr int NT = 16384, DM = 1024, NB = 8, TS = 2048, NMEM = 256;
constexpr int P0LD = 3840;
constexpr int P1LD = 4096;
constexpr int NTHREADS = 512, NWAVES = 8;

constexpr size_t MiB = 1048576;
constexpr size_t WS_CTL = 0;
constexpr size_t WS_CNT = 16384;
constexpr size_t WS_LB = 32768;
constexpr size_t WS_DB = 1 * MiB;
constexpr size_t WS_SSP = WS_DB + 512 * 1024;
constexpr size_t WS_MEMH = WS_SSP + 1 * MiB;
constexpr size_t WS_ROUTE = WS_MEMH + 4 * MiB;
constexpr size_t WS_CNTWG = WS_ROUTE + 740 * 1024;
constexpr size_t WS_LORA = WS_ROUTE + 800 * 1024;
constexpr size_t WS_RW = WS_LORA + 256 * 1024;
constexpr size_t WS_W0 = 8 * MiB;
static_assert(WS_RW + 2 * 1024 * 32 * 4 <= 8 * MiB, "small weights");
constexpr size_t WS_W1 = WS_W0 + 42 * MiB;
constexpr size_t WS_KV1 = WS_W0;
constexpr size_t WS_XB = 92 * MiB;
constexpr size_t WS_BIG = 124 * MiB;
constexpr size_t WS_END = 256 * MiB;
constexpr size_t WS_HALOB = 252 * MiB;
constexpr size_t WS_HOB = 253 * MiB;
constexpr size_t WS_HOA = 254 * MiB;
constexpr size_t WS_HOC = 252 * MiB;
constexpr size_t WS_FLAGS = 24576;
constexpr size_t WO_WIN = 0;
constexpr size_t WO_WOUT = WO_WIN + (size_t)4096 * 1024;
constexpr size_t WO_WQ = WO_WOUT + (size_t)1024 * 1024;
constexpr size_t WO_WKV = WO_WQ + (size_t)1024 * 1024;
constexpr size_t WO_WO = WO_WKV + (size_t)2048 * 1024;
constexpr size_t WO_W13 = WO_WO + (size_t)1024 * 1024;
constexpr size_t WO_W2T = WO_W13 + (size_t)16 * 512 * 1024;
constexpr size_t WO_END = WO_W2T + (size_t)16 * 1024 * 256;
static_assert(WO_END * 2 <= 42 * MiB, "weight region");
constexpr size_t BIG_PROJ = 0;
constexpr size_t BIG_KV0 = 120 * MiB;
constexpr size_t BIG_Q = 0;
constexpr size_t BIG_ATT = 32 * MiB;
constexpr size_t BIG_XG = 0;
constexpr size_t BIG_HID = 48 * MiB;
constexpr int MOE_MAXROWS = 22528;

__device__ __forceinline__ unsigned f2bf(float f) { unsigned u = __float_as_uint(f); u += 0x7fffu + ((u >> 16) & 1u); return u >> 16; }
__device__ __forceinline__ float bf2f(unsigned short b) { return __uint_as_float((unsigned)b << 16); }
__device__ __forceinline__ unsigned pk2(float lo, float hi) { return f2bf(lo) | (f2bf(hi) << 16); }
__device__ __forceinline__ float wave_sum(float v) {
#pragma unroll
    for (int o = 1; o < 64; o <<= 1) v += __shfl_xor(v, o);
    return v;
}
template <int CTRL> __device__ __forceinline__ float dppf(float v) { return __int_as_float(__builtin_amdgcn_update_dpp(0, __float_as_int(v), CTRL, 0xF, 0xF, true)); }
__device__ __forceinline__ float red8(float v) { v += dppf<0xB1>(v); v += dppf<0x4E>(v); v += dppf<0x141>(v); return v; }
__device__ __forceinline__ float red16(float v) { v = red8(v); v += dppf<0x140>(v); return v; }

__device__ __forceinline__ float rdlane(float v, int l) { return __int_as_float(__builtin_amdgcn_readlane(__float_as_int(v), l)); }
__device__ __forceinline__ float wsum(float v) { v = red16(v); return (rdlane(v, 0) + rdlane(v, 16)) + (rdlane(v, 32) + rdlane(v, 48)); }
__device__ __forceinline__ float sigmoidf_(float x) { return 1.f / (1.f + __expf(-x)); }
__device__ __forceinline__ float siluf_(float x) { return x / (1.f + __expf(-x)); }
__device__ __forceinline__ float softplusf_(float x) { return x > 20.f ? x : log1pf(__expf(x)); }
__device__ __forceinline__ int lane_id_v() { int l; asm volatile("v_mbcnt_lo_u32_b32 %0, -1, 0\n\tv_mbcnt_hi_u32_b32 %0, -1, %0" : "=v"(l)); return l; }
#define LDS_WAIT() asm volatile("s_waitcnt lgkmcnt(0)" ::: "memory")
#define VM_WAIT() asm volatile("s_waitcnt vmcnt(0)" ::: "memory")

namespace pg8 {
constexpr int BM = 256, BK = 64, HALF = 128, HTB = HALF * BK * 2, STAGE_BYTES = 8 * HTB;
__host__ __device__ __forceinline__ int lds_byte(int r, int c) { const int st = (r >> 4) * 2 + (c >> 5), rr = r & 15, cc = c & 31, ob = rr * 64 + cc * 2; return st * 1024 + (ob ^ (((ob >> 9) & 1) << 5)); }
__host__ __device__ __forceinline__ void stage_rc(int b, int& R, int& C) { const int st = b / 1024, sb = b % 1024, swz = sb ^ (((sb >> 9) & 1) << 5); R = (st >> 1) * 16 + swz / 64; C = (st & 1) * 32 + (swz % 64) / 2; }

struct Unit { int pm, pn, aux; const char* a; const char* b0; const char* b1; };
struct Gemm { int lda, ldb, K, ksplit; const char* abase; const float* ginfo; };

template <class Epi, class Sched, bool GATHER = false>
__device__ __forceinline__ void gemm_phase(LAS unsigned char* lds, const int wave_in, const Gemm g, const Sched& S, const Epi& E) {
    const int wid = wave_in, lane = lane_id_v(), tid = wid * 64 + lane, wr = wid >> 2, wc = wid & 3, fr = lane & 15, fq = lane >> 4;
    const int K = g.K, nt = K / BK, ks = g.ksplit;
    unsigned voffA[2], voffB[2];
#pragma unroll
    for (int i = 0; i < 2; ++i) { int R, C; stage_rc(tid * 16 + i * 8192, R, C);
        voffA[i] = (unsigned)(R * g.lda + C) * 2u; voffB[i] = (unsigned)(R * g.ldb + C) * 2u; }
    const size_t kstep = (size_t)(BK * 2);
    const size_t hstepA = (size_t)HALF * g.lda * 2, hstepB = (size_t)HALF * g.ldb * 2;
    int rA[2], cA2[2];
#pragma unroll
    for (int i = 0; i < 2; ++i) { int R, C; stage_rc(tid * 16 + i * 8192, R, C); rA[i] = R; cA2[i] = C * 2; }
    unsigned vA[2][2], vN[2][2];
    auto set_off = [&](unsigned (&v)[2][2], const Unit& u) {
#pragma unroll
        for (int h = 0; h < 2; ++h)
#pragma unroll
            for (int i = 0; i < 2; ++i) {
                if (GATHER) { const int lr = h * HALF + rA[i]; const int tok = __float_as_int(g.ginfo[(size_t)(u.pm * 256 + lr) * 4 + 3]);
                    v[h][i] = (unsigned)((lr < u.aux ? tok : 0) * g.lda * 2 + cA2[i]); }
                else v[h][i] = 0u;
            } };
    const unsigned ldsw = (unsigned)wid * 1024u;
    const int aoff = lds_byte(wr * 64 + fr, fq * 8), boff = lds_byte(wc * 32 + fr, fq * 8);
#define PG8_SA(b, h) (((b) * 2 + (h)) * HTB)
#define PG8_SB(b, h) ((4 + (b) * 2 + (h)) * HTB)
#define PG8_STAGE(bufoff, gbase, voff) do { _Pragma("unroll") for (int _i = 0; _i < 2; ++_i) \
        __builtin_amdgcn_global_load_lds((const unsigned*)((const char*)(gbase) + (voff)[_i]), (LAS unsigned*)(lds + (bufoff) + ldsw + _i * 8192), 16, 0, 0); } while (0)
#define PG8_STAGEA(bufoff, ptr, h, offs) do { if (GATHER) PG8_STAGE(bufoff, ptr, (offs)[h]); else PG8_STAGE(bufoff, (ptr) + (h) * hstepA, voffA); } while (0)
#define PG8_LDA(dst, b, h) do { _Pragma("unroll") for (int m = 0; m < 4; ++m) _Pragma("unroll") for (int k = 0; k < 2; ++k) dst[m][k] = *(const LAS bf16x8*)(lds + PG8_SA(b, h) + aoff + m * 2048 + k * 1024); } while (0)
#define PG8_LDB(dst, b, h) do { _Pragma("unroll") for (int n = 0; n < 2; ++n) _Pragma("unroll") for (int k = 0; k < 2; ++k) dst[n][k] = *(const LAS bf16x8*)(lds + PG8_SB(b, h) + boff + n * 2048 + k * 1024); } while (0)
#define PG8_MMA(ai, bj, At, Bt) do { __builtin_amdgcn_s_setprio(1); _Pragma("unroll") for (int m = 0; m < 4; ++m) _Pragma("unroll") for (int n = 0; n < 2; ++n) _Pragma("unroll") for (int k = 0; k < 2; ++k) \
        acc[ai][bj][m][n] = __builtin_amdgcn_mfma_f32_16x16x32_bf16(Bt[n][k], At[m][k], acc[ai][bj][m][n], 0, 0, 0); __builtin_amdgcn_s_setprio(0); } while (0)
#define PG8_WAIT_V(n) asm volatile("s_waitcnt vmcnt(" #n ")" ::: "memory")
#define PG8_WAIT_L(n) asm volatile("s_waitcnt lgkmcnt(" #n ")" ::: "memory")
#define PG8_BAR __builtin_amdgcn_s_barrier()
#define PG8_SCHED __builtin_amdgcn_sched_barrier(0)
    Unit cur, nxt; int ui = 0;
    if (!S.next(0, cur)) return;
    f32x4 acc[2][2][4][2];
#pragma unroll
    for (int a = 0; a < 2; ++a)
#pragma unroll
        for (int b = 0; b < 2; ++b)
#pragma unroll
            for (int m = 0; m < 4; ++m)
#pragma unroll
                for (int n = 0; n < 2; ++n) acc[a][b][m][n] = (f32x4){0.f, 0.f, 0.f, 0.f};
    E.init(acc, cur, wr, wc, fr, fq);
    bf16x8 At[4][2], B0[2][2], B1[2][2];
    const char* cA = GATHER ? g.abase : cur.a; const char* cB = cur.b0; const char* cB1 = cur.b1;
    if (GATHER) set_off(vA, cur);
    PG8_STAGE(PG8_SB(0, 0), cB, voffB); PG8_STAGE(PG8_SB(0, 1), cB + hstepB, voffB); PG8_STAGEA(PG8_SA(0, 0), cA, 0, vA); PG8_STAGEA(PG8_SA(0, 1), cA, 1, vA);
    if (wr == 1) PG8_BAR;
    PG8_WAIT_V(2); PG8_BAR;
    PG8_STAGE(PG8_SB(1, 0), cB + kstep, voffB); PG8_STAGEA(PG8_SA(1, 0), cA + kstep, 0, vA); PG8_STAGE(PG8_SB(1, 1), cB + hstepB + kstep, voffB);
    PG8_WAIT_V(6); PG8_BAR;
    for (;;) {
        const bool has_next = S.next(ui + 1, nxt);
        const char* nA = GATHER ? cA : (has_next ? nxt.a : cA); const char* nB = has_next ? nxt.b0 : cB;
        if (GATHER) { if (has_next) set_off(vN, nxt); else { vN[0][0] = vA[0][0]; vN[0][1] = vA[0][1]; vN[1][0] = vA[1][0]; vN[1][1] = vA[1][1]; } }
        for (int t = 0; t < nt; t += 2) {
            const bool last = (t == nt - 2);
            const char* a1 = cA + (size_t)(t + 1) * kstep;
            const char* a2 = last ? nA : cA + (size_t)(t + 2) * kstep;
            const char* b2 = last ? nB : ((t + 2) < ks ? cB + (size_t)(t + 2) * kstep : cB1 + (size_t)(t + 2 - ks) * kstep);
            const char* a3 = a2 + kstep; const char* b3 = b2 + kstep;
            unsigned o2[2][2];
            if (GATHER) { o2[0][0] = last ? vN[0][0] : vA[0][0]; o2[0][1] = last ? vN[0][1] : vA[0][1]; o2[1][0] = last ? vN[1][0] : vA[1][0]; o2[1][1] = last ? vN[1][1] : vA[1][1]; }
            PG8_LDB(B0, 0, 0); PG8_LDB(B1, 0, 1); PG8_SCHED; PG8_LDA(At, 0, 0); PG8_STAGEA(PG8_SA(1, 1), a1, 1, vA);
            PG8_WAIT_V(8); PG8_WAIT_L(0); PG8_BAR; PG8_MMA(0, 0, At, B0); PG8_MMA(0, 1, At, B1); PG8_BAR; PG8_SCHED;
            PG8_LDA(At, 0, 1); PG8_STAGE(PG8_SB(0, 0), b2, voffB); PG8_STAGE(PG8_SB(0, 1), b2 + hstepB, voffB); PG8_STAGEA(PG8_SA(0, 0), a2, 0, o2);
            PG8_WAIT_V(8); PG8_WAIT_L(0); PG8_BAR; PG8_MMA(1, 0, At, B0); PG8_MMA(1, 1, At, B1); PG8_BAR; PG8_SCHED;
            PG8_LDB(B0, 1, 0); PG8_LDB(B1, 1, 1); PG8_SCHED; PG8_LDA(At, 1, 0); PG8_STAGEA(PG8_SA(0, 1), a2, 1, o2);
            PG8_WAIT_V(8); PG8_WAIT_L(0); PG8_BAR; PG8_MMA(0, 0, At, B0); PG8_MMA(0, 1, At, B1); PG8_BAR; PG8_SCHED;
            PG8_LDA(At, 1, 1); PG8_STAGE(PG8_SB(1, 0), b3, voffB); PG8_STAGE(PG8_SB(1, 1), b3 + hstepB, voffB); PG8_STAGEA(PG8_SA(1, 0), a3, 0, o2);
            PG8_WAIT_V(8); PG8_WAIT_L(0); PG8_BAR; PG8_MMA(1, 0, At, B0); PG8_MMA(1, 1, At, B1); PG8_BAR; PG8_SCHED;
        }
        if (wr == 0) PG8_BAR;
        E(acc, cur, wr, wc, fr, fq);
        if (!has_next) break;
#pragma unroll
        for (int a = 0; a < 2; ++a)
#pragma unroll
            for (int b = 0; b < 2; ++b)
#pragma unroll
                for (int m = 0; m < 4; ++m)
#pragma unroll
                    for (int n = 0; n < 2; ++n) acc[a][b][m][n] = (f32x4){0.f, 0.f, 0.f, 0.f};
        cur = nxt; cA = nA; cB = nB; cB1 = nxt.b1; ++ui;
        if (GATHER) { vA[0][0] = vN[0][0]; vA[0][1] = vN[0][1]; vA[1][0] = vN[1][0]; vA[1][1] = vN[1][1]; }
        E.init(acc, cur, wr, wc, fr, fq);
        if (wr == 1) PG8_BAR;
    }
    PG8_WAIT_V(0);
    PG8_BAR;
#undef PG8_SA
#undef PG8_SB
#undef PG8_STAGE
#undef PG8_STAGEA
#undef PG8_LDA
#undef PG8_LDB
#undef PG8_MMA
#undef PG8_WAIT_V
#undef PG8_WAIT_L
#undef PG8_BAR
#undef PG8_SCHED
}

struct DenseSched {
    int nM, nN, nwg, G, c; const char* A; const char* B; size_t tA, tB;
    __device__ void init(int M, int N, int G_, int c_, const bf16_t* A_, int lda, const bf16_t* B_, int ldb) { nM = M / 256; nN = N / 256; nwg = nM * nN; G = G_; c = c_; A = (const char*)A_; B = (const char*)B_; tA = (size_t)256 * lda * 2; tB = (size_t)256 * ldb * 2; }
    __device__ bool next(int i, Unit& u) const {
        const long L = (long)i * G + c; if (L >= nwg) return false;
        int wgid = (int)L; { const int q = nwg / 8, r = nwg % 8, xcd = wgid % 8, off = wgid / 8; wgid = (xcd < r ? xcd * (q + 1) : r * (q + 1) + (xcd - r) * q) + off; }
        const int nig = 8 * nN, gid = wgid / nig, fm = gid * 8, gsz = (nM - fm) < 8 ? (nM - fm) : 8;
        u.pm = fm + ((wgid % nig) % gsz); u.pn = (wgid % nig) / gsz; u.aux = 256;
        u.a = A + (size_t)u.pm * tA; u.b0 = B + (size_t)u.pn * tB; u.b1 = u.b0; return true;
    }
};
}
using pg8::Unit;

__device__ __forceinline__ float row_rstd(const float* ssp, int row) {
    const f32x4* p = (const f32x4*)(ssp + (size_t)row * 16);
    const f32x4 a = p[0], b = p[1], c = p[2], d = p[3];
    const float s = ((a.x + a.y) + (a.z + a.w)) + ((b.x + b.y) + (b.z + b.w)) + ((c.x + c.y) + (c.z + c.w)) + ((d.x + d.y) + (d.z + d.w));
    return 1.0f / sqrtf(s * (1.0f / 1024.0f) + 1e-6f);
}
__device__ __forceinline__ unsigned short f2h_bits(float f) { _Float16 h = (_Float16)f; return __builtin_bit_cast(unsigned short, h); }
__device__ __forceinline__ float h2f_bits(unsigned short b) { return (float)__builtin_bit_cast(_Float16, b); }

template <int MODE> struct EpiScale {
    bf16_t* O; int ldc; const float* ssp; float scale; const float* lb; bf16_t* halo;
    __device__ __forceinline__ void init(f32x4 (&acc)[2][2][4][2], const Unit& u, int wr, int wc, int fr, int fq) const {}
    __device__ __forceinline__ void operator()(const f32x4 (&acc)[2][2][4][2], const Unit& u, int wr, int wc, int fr_in, int fq_in) const {
        int fr = fr_in, fq = fq_in; asm volatile("" : "+v"(fr), "+v"(fq));
#pragma unroll
        for (int ai = 0; ai < 2; ++ai)
#pragma unroll
            for (int m = 0; m < 4; ++m) {
                const int row = u.pm * 256 + ai * 128 + wr * 64 + m * 16 + fr;
                const float rs = (MODE == 2) ? scale : row_rstd(ssp, row) * scale;
#pragma unroll
                for (int bj = 0; bj < 2; ++bj)
#pragma unroll
                    for (int n = 0; n < 2; ++n) {
                        const int col = u.pn * 256 + bj * 128 + wc * 32 + n * 16 + fq * 4;
                        f32x4 v = acc[ai][bj][m][n] * rs;
                        u32x2 w;
                        if (MODE == 1) {
                            const int blk = col >> 10;
                            if (blk == 0) { v.x = siluf_(v.x); v.y = siluf_(v.y); v.z = siluf_(v.z); v.w = siluf_(v.w); }
                            if (blk == 1) {
                                const f32x4 l = *(const f32x4*)(lb + (col - 1024));
                                float o[4]; const float vv[4] = {v.x, v.y, v.z, v.w}; const float ll[4] = {l.x, l.y, l.z, l.w};
#pragma unroll
                                for (int j = 0; j < 4; ++j) o[j] = __logf(ll[j] + (1.f - ll[j]) * sigmoidf_(vv[j]));
                                w.x = (unsigned)f2h_bits(o[0]) | ((unsigned)f2h_bits(o[1]) << 16); w.y = (unsigned)f2h_bits(o[2]) | ((unsigned)f2h_bits(o[3]) << 16);
                            } else { w.x = pk2(v.x, v.y); w.y = pk2(v.z, v.w); }
                        } else { w.x = pk2(v.x, v.y); w.y = pk2(v.z, v.w); }
                        *(u32x2*)(O + (size_t)row * ldc + col) = w;
                        if (MODE == 0 && halo && col >= 2048 && (row & 63) == 63) *(u32x2*)(halo + (size_t)(row >> 6) * 1792 + (col - 2048)) = w;
                    }
            }
    }
};
struct EpiKV {
    bf16_t* Kb; bf16_t* VT;
    __device__ __forceinline__ void init(f32x4 (&acc)[2][2][4][2], const Unit& u, int wr, int wc, int fr, int fq) const {}
    __device__ __forceinline__ void operator()(const f32x4 (&acc)[2][2][4][2], const Unit& u, int wr, int wc, int fr_in, int fq_in) const {
        int fr = fr_in, fq = fq_in; asm volatile("" : "+v"(fr), "+v"(fq));
#pragma unroll
        for (int ai = 0; ai < 2; ++ai)
#pragma unroll
            for (int m = 0; m < 4; ++m) {
                const int row = u.pm * 256 + ai * 128 + wr * 64 + m * 16 + fr;
#pragma unroll
                for (int bj = 0; bj < 2; ++bj)
#pragma unroll
                    for (int n = 0; n < 2; ++n) {
                        const int col = u.pn * 256 + bj * 128 + wc * 32 + n * 16 + fq * 4;
                        const f32x4 v = acc[ai][bj][m][n];
                        if (col < 1024) { u32x2 w; w.x = pk2(v.x, v.y); w.y = pk2(v.z, v.w); *(u32x2*)(Kb + (size_t)row * 1024 + col) = w; }
                        else {
                            const int c2 = col - 1024, h = c2 >> 8, d = c2 & 255, b = row >> 8, mm = row & 255;
                            bf16_t* p = VT + ((size_t)((b * 4 + h) * 256 + d)) * 256 + mm;
                            p[0] = (bf16_t)f2bf(v.x); p[256] = (bf16_t)f2bf(v.y); p[512] = (bf16_t)f2bf(v.z); p[768] = (bf16_t)f2bf(v.w);
                        }
                    }
            }
    }
};
template <bool SCATTER> struct EpiResid {
    const float* base32; bf16_t* XB; float* ssp; const f32x4* rowinfo;
    __device__ __forceinline__ f32x4 ld_base(size_t off) const {
        if (base32) return *(const f32x4*)(base32 + off);
        const u32x2 r = *(const u32x2*)(XB + off);
        return (f32x4){bf2f((unsigned short)(r.x & 0xffffu)), bf2f((unsigned short)(r.x >> 16)), bf2f((unsigned short)(r.y & 0xffffu)), bf2f((unsigned short)(r.y >> 16))};
    }
    __device__ __forceinline__ void init(f32x4 (&acc)[2][2][4][2], const Unit& u, int wr, int wc, int fr_in, int fq_in) const {
        if (SCATTER) return;
        int fr = fr_in, fq = fq_in; asm volatile("" : "+v"(fr), "+v"(fq));
#pragma unroll
        for (int ai = 0; ai < 2; ++ai)
#pragma unroll
            for (int m = 0; m < 4; ++m) {
                const int row = u.pm * 256 + ai * 128 + wr * 64 + m * 16 + fr;
#pragma unroll
                for (int bj = 0; bj < 2; ++bj)
#pragma unroll
                    for (int n = 0; n < 2; ++n) acc[ai][bj][m][n] = ld_base((size_t)row * 1024 + u.pn * 256 + bj * 128 + wc * 32 + n * 16 + fq * 4);
                asm volatile("" ::: "memory");
            }
    }
    __device__ __forceinline__ void operator()(const f32x4 (&acc)[2][2][4][2], const Unit& u, int wr, int wc, int fr_in, int fq_in) const {
        int fr = fr_in, fq = fq_in; asm volatile("" : "+v"(fr), "+v"(fq));
#pragma unroll
        for (int ai = 0; ai < 2; ++ai)
#pragma unroll
            for (int m = 0; m < 4; ++m) {
                const int lrow = ai * 128 + wr * 64 + m * 16 + fr;
                const int row = u.pm * 256 + lrow;
                int tok = row; bool valid = true;
                if (SCATTER) { valid = lrow < u.aux; const f32x4 ri = rowinfo[row]; tok = valid ? __float_as_int(ri.w) : 0; }
                float ss = 0.f;
#pragma unroll
                for (int bj = 0; bj < 2; ++bj)
#pragma unroll
                    for (int n = 0; n < 2; ++n) {
                        const int col = u.pn * 256 + bj * 128 + wc * 32 + n * 16 + fq * 4;
                        const size_t off = (size_t)tok * 1024 + col;
                        f32x4 v = acc[ai][bj][m][n];
                        if (SCATTER) v = v + ld_base(off);
                        if (valid) { u32x2 w; w.x = pk2(v.x, v.y); w.y = pk2(v.z, v.w); *(u32x2*)(XB + off) = w; }
                        ss += (v.x * v.x + v.y * v.y) + (v.z * v.z + v.w * v.w);
                    }
                ss += __shfl_xor(ss, 16); ss += __shfl_xor(ss, 32);
                if (valid && fq == 0) ssp[(size_t)tok * 16 + u.pn * 4 + wc] = ss;
            }
    }
};
struct EpiMoeUp {
    bf16_t* HID; const f32x4* rowinfo;
    __device__ __forceinline__ void init(f32x4 (&acc)[2][2][4][2], const Unit& u, int wr, int wc, int fr, int fq) const {}
    __device__ __forceinline__ void operator()(const f32x4 (&acc)[2][2][4][2], const Unit& u, int wr, int wc, int fr_in, int fq_in) const {
        int fr = fr_in, fq = fq_in; asm volatile("" : "+v"(fr), "+v"(fq));
        const int slot = u.pn >> 1, jj = u.pn & 1;
#pragma unroll
        for (int ai = 0; ai < 2; ++ai)
#pragma unroll
            for (int m = 0; m < 4; ++m) {
                const int row = u.pm * 256 + ai * 128 + wr * 64 + m * 16 + fr;
                const f32x4 ri = rowinfo[row];
                const float rs = ri.x, gt = slot ? ri.z : ri.y;
#pragma unroll
                for (int n = 0; n < 2; ++n) {
                    const f32x4 h1 = acc[ai][0][m][n] * rs, h3 = acc[ai][1][m][n] * rs;
                    const int col = slot * 256 + jj * 128 + wc * 32 + n * 16 + fq * 4;
                    u32x2 w; w.x = pk2(siluf_(h1.x) * h3.x * gt, siluf_(h1.y) * h3.y * gt); w.y = pk2(siluf_(h1.z) * h3.z * gt, siluf_(h1.w) * h3.w * gt);
                    *(u32x2*)(HID + (size_t)row * 512 + col) = w;
                }
            }
    }
};
__device__ __forceinline__ void pair_experts(int bucket, int& ea, int& eb) {
    const int g = bucket / 6, p = bucket % 6;
    const int i = (p < 3) ? 0 : (p < 5 ? 1 : 2);
    const int j = (p < 3) ? p + 1 : (p < 5 ? p - 1 : 3);
    ea = g * 4 + i; eb = g * 4 + j;
}
template <bool DOWN> struct MoeSched {
    const LAS int* tbl; int ntiles, G, c; const char* A; const char* W;
    __device__ bool next(int i, Unit& u) const {
        const int L = i * G + c, mt = L >> 2, pn = L & 3;
        if (mt >= ntiles) return false;
        const int ent = __builtin_amdgcn_readfirstlane(tbl[mt]), bucket = ent & 255; u.aux = ent >> 8;
        int ea, eb; pair_experts(bucket, ea, eb);
        u.pm = mt; u.pn = pn;
        if (!DOWN) { u.a = A + (size_t)mt * 256 * 1024 * 2; const int e = (pn < 2) ? ea : eb; u.b0 = W + ((size_t)e * 512 + 256 * (pn & 1)) * 1024 * 2; u.b1 = u.b0; }
        else { u.a = A + (size_t)mt * 256 * 512 * 2; u.b0 = W + ((size_t)ea * 1024 + 256 * pn) * 256 * 2; u.b1 = W + ((size_t)eb * 1024 + 256 * pn) * 256 * 2; }
        return true;
    }
};
__device__ __forceinline__ void moe_build_table(LAS int* tbl, const unsigned* cnt, int tid) {
    if (tid == 0) { int mt = 0;
        for (int b = 0; b < 24; ++b) { const int nb = (int)cnt[b]; for (int r = 0; r < nb; r += 256) { const int v = (nb - r) < 256 ? (nb - r) : 256; if (mt < 95) tbl[mt] = b | (v << 8); ++mt; } }
        tbl[95] = mt < 95 ? mt : 95; }
    __syncthreads();
}

#define XB_TMO      128
#define XB_XCNT(j)  (256  + 64 * (j))
#define XB_XSUB(j)  (1280 + 64 * (j))
#define XB_XGEN(j)  (2304 + 64 * (j))
#define XB_TOP      3328
#define XB_TOPGEN   3392
#define XCD_BAR_WORDS 3456
#define XB_SPIN_CAP (1u << 22)
__device__ __forceinline__ unsigned xb_ld(unsigned* p)              { return __hip_atomic_load(p, __ATOMIC_RELAXED, __HIP_MEMORY_SCOPE_AGENT); }
__device__ __forceinline__ unsigned xb_add(unsigned* p, unsigned v) { return __hip_atomic_fetch_add(p, v, __ATOMIC_RELAXED, __HIP_MEMORY_SCOPE_AGENT); }
__device__ __forceinline__ unsigned xb_xcc_id() { return (unsigned)__builtin_amdgcn_s_getreg((3 << 11) | 20) & 0xFu; }
#define XB_SPIN(cond, bar) do { unsigned _sp = 0; while (cond) { __builtin_amdgcn_s_sleep(1); \
    if ((++_sp & 255u) == 0u) { if (xb_ld(&(bar)[XB_TMO])) break; if (_sp > XB_SPIN_CAP) { atomicAdd(&(bar)[XB_TMO], 1u); break; } } } } while (0)
struct XcdBarrier { unsigned* bar; unsigned x; volatile LAS unsigned* st; int wave; };
__device__ __forceinline__ XcdBarrier xcd_barrier_post(unsigned* bar, volatile LAS unsigned* st, int wave) {
    XcdBarrier b; b.bar = bar; b.x = xb_xcc_id(); b.st = st; b.wave = wave;
    if (wave == 0 && lane_id_v() == 0) (void)xb_add(&bar[XB_XCNT(b.x)], 1u);
    return b;
}
__device__ __forceinline__ void xcd_barrier_complete(unsigned* bar, unsigned x, unsigned& nloc, unsigned& nx) {
    const unsigned G = gridDim.x * gridDim.y * gridDim.z;
    unsigned sum, cnt, mine, sp = 0u;
    for (;;) {
        sum = 0u; cnt = 0u; mine = 0u;
#pragma unroll
        for (unsigned j = 0; j < 16; ++j) { const unsigned c = xb_ld(&bar[XB_XCNT(j)]); sum += c; cnt += (c > 0u) ? 1u : 0u; mine = (j == x) ? c : mine; }
        if (sum == G) break;
        __builtin_amdgcn_s_sleep(1);
        if ((++sp & 255u) == 0u) { if (xb_ld(&bar[XB_TMO])) break; if (sp > XB_SPIN_CAP) { atomicAdd(&bar[XB_TMO], 1u); break; } }
    }
    nloc = mine > 0u ? mine : 1u; nx = cnt > 0u ? cnt : 1u;
}
__device__ __forceinline__ void xcd_barrier(const XcdBarrier& b) {
    asm volatile("s_waitcnt vmcnt(0)" ::: "memory");
    __syncthreads();
    if (b.wave == 0 && lane_id_v() == 0) {
        unsigned* bar = b.bar;
        __builtin_amdgcn_s_waitcnt(0);
        unsigned nloc = b.st[0], nx = b.st[1];
        if (nloc == 0u) { xcd_barrier_complete(bar, b.x, nloc, nx); b.st[0] = nloc; b.st[1] = nx; }
        const unsigned old = xb_add(&bar[XB_XSUB(b.x)], 1u);
        const unsigned gen = old / nloc;
        if (old + 1u == (gen + 1u) * nloc) {
            __builtin_amdgcn_fence(__ATOMIC_RELEASE, "agent");
            asm volatile("s_waitcnt vmcnt(0)" ::: "memory");
            const unsigned og = xb_add(&bar[XB_TOP], 1u);
            const unsigned tg = og / nx;
            if (og + 1u == (tg + 1u) * nx) xb_add(&bar[XB_TOPGEN], 1u);
            else XB_SPIN(xb_ld(&bar[XB_TOPGEN]) == tg, bar);
            __builtin_amdgcn_fence(__ATOMIC_ACQUIRE, "agent");
            xb_add(&bar[XB_XGEN(b.x)], 1u);
            asm volatile("s_waitcnt vmcnt(0)" ::: "memory");
        } else {
            XB_SPIN(xb_ld(&bar[XB_XGEN(b.x)]) == gen, bar);
            __builtin_amdgcn_fence(__ATOMIC_ACQUIRE, "agent");
            asm volatile("s_waitcnt vmcnt(0)" ::: "memory");
        }
    }
    __syncthreads();
}

struct Args { const float* in[38]; float* out; unsigned char* ws; int ph_lo, ph_hi; };
constexpr int LDS_BYTES = 161792;
constexpr int LDS_MISC = 156 * 1024;
struct InTab {
    const LAS unsigned long long* t;
    __device__ __forceinline__ const float* operator[](int i) const {
        const unsigned long long v = t[i];
        const unsigned lo = __builtin_amdgcn_readfirstlane((unsigned)v), hi = __builtin_amdgcn_readfirstlane((unsigned)(v >> 32));
        return (const float*)(((unsigned long long)hi << 32) | lo); }
};
struct Frame {
    LAS unsigned char* lds; int wave, G, wg;
    InTab in; float* out; unsigned char* ws;
};
#define IN_X 0
#define IN_MEM 1
#define IN_NORM_MIX 2
#define IN_NORM_XA 3
#define IN_NORM_MEM 4
#define IN_NORM_FFN 5
#define IN_NORM_FINAL 6
#define IN_AB_WIN 7
#define IN_AB_CONV 8
#define IN_AB_ALOG 9
#define IN_AB_DTB 10
#define IN_AB_ONORM 11
#define IN_AB_MU 12
#define IN_AB_W0 13
#define IN_AB_W2 14
#define IN_AB_A0 15
#define IN_AB_A2 16
#define IN_AB_G2 17
#define IN_AB_KK 18
#define IN_AB_KA 19
#define IN_AB_RK 20
#define IN_AB_LNW 21
#define IN_AB_LNB 22
#define IN_AB_WOUT 23
#define IN_C_WIN 24
#define IN_C_LB 25
#define IN_C_ONORM 26
#define IN_C_WOUT 27
#define IN_XA_WQ 28
#define IN_XA_WKV 29
#define IN_XA_WO 30
#define IN_MOE_WG 31
#define IN_MOE_BG 32
#define IN_MOE_WE 33
#define IN_MOE_BE 34
#define IN_MOE_W1 35
#define IN_MOE_W3 36
#define IN_MOE_W2 37

__device__ __forceinline__ void p0_transpose_item(const float* W, int ld, int col0, int ncols, int K, const float* gain, bf16_t* WT, int drow0, LAS float* scr, int item, int lane) {
    const int nblk = ncols / 32, kb = item / nblk, nb = item % nblk, k0 = 64 * kb, n0 = 32 * nb;
    float vv[32];
#pragma unroll
    for (int i = 0; i < 32; ++i) vv[i] = W[(size_t)(k0 + 2 * i + (lane >> 5)) * ld + col0 + n0 + (lane & 31)];
#pragma unroll
    for (int i = 0; i < 32; ++i) { const int kk = 2 * i + (lane >> 5); float v = vv[i]; if (gain) v *= gain[k0 + kk]; scr[kk * 33 + (lane & 31)] = v; }
    LDS_WAIT(); asm volatile("" ::: "memory");
    const int c = lane & 7;
#pragma unroll
    for (int j = 0; j < 4; ++j) { const int n = (lane >> 3) + 8 * j; const LAS float* s = scr + (8 * c) * 33 + n;
        u32x4 o; o.x = pk2(s[0 * 33], s[1 * 33]); o.y = pk2(s[2 * 33], s[3 * 33]); o.z = pk2(s[4 * 33], s[5 * 33]); o.w = pk2(s[6 * 33], s[7 * 33]);
        *(u32x4*)(WT + (size_t)(drow0 + n0 + n) * K + k0 + 8 * c) = o; }
    LDS_WAIT(); asm volatile("" ::: "memory");
}
__device__ __forceinline__ void p0_weight_item(const Frame& F, int it, LAS float* scr, int lane) {
    const InTab in = F.in;
    bf16_t* W0 = (bf16_t*)(F.ws + WS_W0); bf16_t* W1 = (bf16_t*)(F.ws + WS_W1);
    if (it < 16384) {
        const int l = it >> 13; int r = it & 8191; bf16_t* W = l ? W1 : W0;
        if (r < 512) { p0_transpose_item(in[IN_XA_WQ] + (size_t)l * 1024 * 1024, 1024, 0, 1024, 1024, in[IN_NORM_XA] + l * 1024, W + WO_WQ, 0, scr, r, lane); return; }
        r -= 512;
        if (r < 1024) { p0_transpose_item(in[IN_XA_WKV] + (size_t)l * 1024 * 2048, 2048, 0, 2048, 1024, in[IN_NORM_MEM] + l * 1024, W + WO_WKV, 0, scr, r, lane); return; }
        r -= 1024;
        if (r < 512) { p0_transpose_item(in[IN_XA_WO] + (size_t)l * 1024 * 1024, 1024, 0, 1024, 1024, nullptr, W + WO_WO, 0, scr, r, lane); return; }
        r -= 512;
        if (r < 4096) { const int sub = r >> 6, item = r & 63, e = sub >> 2, j = (sub >> 1) & 1, which = sub & 1;
            const float* src = (which ? in[IN_MOE_W3] : in[IN_MOE_W1]) + (size_t)(l * 16 + e) * 1024 * 256;
            p0_transpose_item(src, 256, 128 * j, 128, 1024, in[IN_NORM_FFN] + l * 1024, W + WO_W13, e * 512 + 256 * j + 128 * which, scr, item, lane); return; }
        r -= 4096;
        { const int e = r >> 7, item = r & 127;
            p0_transpose_item(in[IN_MOE_W2] + (size_t)(l * 16 + e) * 256 * 1024, 1024, 0, 1024, 256, nullptr, W + WO_W2T + (size_t)e * 1024 * 256, 0, scr, item, lane); return; }
    }
    int r = it - 16384;
    if (r < 1024) { p0_transpose_item(in[IN_AB_WIN], 3848, 0, 2048, 1024, in[IN_NORM_MIX], W0 + WO_WIN, 0, scr, r, lane); return; }
    r -= 1024;
    if (r < 896) { p0_transpose_item(in[IN_AB_WIN], 3848, 2056, 1792, 1024, in[IN_NORM_MIX], W0 + WO_WIN, 2048, scr, r, lane); return; }
    r -= 896;
    if (r < 512) { p0_transpose_item(in[IN_AB_WOUT], 1024, 0, 1024, 1024, nullptr, W0 + WO_WOUT, 0, scr, r, lane); return; }
    r -= 512;
    if (r < 2048) { p0_transpose_item(in[IN_C_WIN], 4096, 0, 4096, 1024, in[IN_NORM_MIX] + 1024, W1 + WO_WIN, 0, scr, r, lane); return; }
    r -= 2048;
    if (r < 512) { p0_transpose_item(in[IN_C_WOUT], 1024, 0, 1024, 1024, nullptr, W1 + WO_WOUT, 0, scr, r, lane); return; }
    r -= 512;
    bf16_t* LW = (bf16_t*)(F.ws + WS_LORA);
    if (r < 16) { p0_transpose_item(in[IN_AB_W2], 512, 0, 512, 64, nullptr, LW, 0, scr, r, lane); return; }
    r -= 16;
    if (r < 16) { p0_transpose_item(in[IN_AB_A2], 512, 0, 512, 64, nullptr, LW + 512 * 64, 0, scr, r, lane); return; }
    r -= 16;
    p0_transpose_item(in[IN_AB_G2], 512, 0, 512, 128, nullptr, LW + 2 * 512 * 64, 0, scr, r, lane);
}
constexpr int P0_NITEMS = 16384 + 1024 + 896 + 512 + 2048 + 512 + 64;

template <int SEL> __device__ __forceinline__ void p0_late_weights(const Frame& F, int worker, int nworkers) {
    const int lane = lane_id_v();
    LAS float* scr = (LAS float*)(F.lds + F.wave * 16384);
    const int gw = worker * NWAVES + F.wave, NGW = nworkers * NWAVES;
    if (SEL == 0) {
        for (int it = gw; it < 8192 + 512 + 2048 + 1024; it += NGW) {
            int item;
            if (it < 8192) { item = it; if (item >= 512 && item < 1536) continue; }
            else if (it < 8192 + 512) item = 16384 + 1920 + (it - 8192);
            else if (it < 8192 + 512 + 2048) item = 16384 + 1920 + 512 + (it - 8192 - 512);
            else item = 8192 + 512 + (it - 8192 - 512 - 2048);
            p0_weight_item(F, item, scr, lane);
        }
    } else {
        for (int it = gw; it < 512 + 6656 + 512; it += NGW) {
            int item;
            if (it < 512) item = 8192 + it;
            else if (it < 512 + 6656) item = 8192 + 1536 + (it - 512);
            else item = 16384 + 1920 + 512 + 2048 + (it - 512 - 6656);
            p0_weight_item(F, item, scr, lane);
        }
    }
}
__device__ __forceinline__ void p0_prologue(const Frame& F) {
    const int lane = lane_id_v(); const int tid = F.wave * 64 + lane; (void)tid;
    LAS float* scr = (LAS float*)(F.lds + F.wave * 16384);
    const int gw = F.wg * NWAVES + F.wave, NGW = F.G * NWAVES;
    for (int it = gw; it < 1920 + 64 + 1024; it += NGW) p0_weight_item(F, it < 1920 ? 16384 + it : (it < 1984 ? P0_NITEMS - 64 + (it - 1920) : 512 + (it - 1984)), scr, lane);
    const float* x = F.in[IN_X]; const float* gain = F.in[IN_NORM_MIX]; const float* win = F.in[IN_AB_WIN];
    bf16_t* XB = (bf16_t*)(F.ws + WS_XB); float* ssp = (float*)(F.ws + WS_SSP); float* db = (float*)(F.ws + WS_DB);
    for (int grp = gw; grp < NT / 4; grp += NGW) {
        const int r0 = grp * 4;
        float d[4][8], sq[4];
#pragma unroll
        for (int r = 0; r < 4; ++r) { sq[r] = 0.f;
#pragma unroll
            for (int c = 0; c < 8; ++c) d[r][c] = 0.f; }
#pragma unroll 1
        for (int j = 0; j < 4; ++j) {
            const int k0 = 4 * lane + 256 * j;
            const f32x4 g = *(const f32x4*)(gain + k0); const float gq[4] = {g.x, g.y, g.z, g.w};
            float wq[4][8];
#pragma unroll
            for (int q = 0; q < 4; ++q) {
                const f32x4 w0 = *(const f32x4*)(win + (size_t)(k0 + q) * 3848 + 2048), w1 = *(const f32x4*)(win + (size_t)(k0 + q) * 3848 + 2052);
                wq[q][0] = w0.x * gq[q]; wq[q][1] = w0.y * gq[q]; wq[q][2] = w0.z * gq[q]; wq[q][3] = w0.w * gq[q];
                wq[q][4] = w1.x * gq[q]; wq[q][5] = w1.y * gq[q]; wq[q][6] = w1.z * gq[q]; wq[q][7] = w1.w * gq[q];
            }
#pragma unroll
            for (int r = 0; r < 4; ++r) {
                const f32x4 v = *((const f32x4*)(x + (size_t)(r0 + r) * 1024) + lane + 64 * j);
                sq[r] += (v.x * v.x + v.y * v.y) + (v.z * v.z + v.w * v.w);
                *((unsigned long long*)(XB + (size_t)(r0 + r) * 1024) + lane + 64 * j) = (unsigned long long)pk2(v.x, v.y) | ((unsigned long long)pk2(v.z, v.w) << 32);
                const float xv[4] = {v.x, v.y, v.z, v.w};
#pragma unroll
                for (int q = 0; q < 4; ++q)
#pragma unroll
                    for (int c = 0; c < 8; ++c) d[r][c] += xv[q] * wq[q][c];
            }
        }
#pragma unroll
        for (int r = 0; r < 4; ++r) {
            const float s = wsum(sq[r]);
            const float rstd = 1.0f / sqrtf(s * (1.0f / 1024.0f) + 1e-6f);
            float dv = 0.f;
#pragma unroll
            for (int c = 0; c < 8; ++c) { const float t = wsum(d[r][c]) * rstd; dv = (lane == c) ? t : dv; }
            if (lane < 16) ssp[(size_t)(r0 + r) * 16 + lane] = (lane == 0) ? s : 0.f;
            if (lane < 8) db[(size_t)(r0 + r) * 8 + lane] = dv;
        }
    }
    const float* mem = F.in[IN_MEM]; bf16_t* MH = (bf16_t*)(F.ws + WS_MEMH);
    for (int row = gw; row < NB * NMEM; row += NGW) {
        const f32x4* xr = (const f32x4*)(mem + (size_t)row * 1024) + lane;
        f32x4 v[4]; float s = 0.f;
#pragma unroll
        for (int j = 0; j < 4; ++j) { v[j] = xr[64 * j]; s += (v[j].x * v[j].x + v[j].y * v[j].y) + (v[j].z * v[j].z + v[j].w * v[j].w); }
        s = wsum(s);
        const float rstd = 1.0f / sqrtf(s * (1.0f / 1024.0f) + 1e-6f);
        unsigned long long* o8 = (unsigned long long*)(MH + (size_t)row * 1024) + lane;
#pragma unroll
        for (int j = 0; j < 4; ++j) o8[64 * j] = (unsigned long long)pk2(v[j].x * rstd, v[j].y * rstd) | ((unsigned long long)pk2(v[j].z * rstd, v[j].w * rstd) << 32);
    }
    {
        float* rw = (float*)(F.ws + WS_RW);
        for (int idx = F.wg * NTHREADS + tid; idx < 2 * 1024 * 32; idx += F.G * NTHREADS) {
            const int l = idx >> 15, k = (idx >> 5) & 1023, cc = idx & 31;
            const float g = F.in[IN_NORM_FFN][l * 1024 + k];
            float v = 0.f;
            if (cc < 4) v = F.in[IN_MOE_WG][(size_t)l * 4096 + k * 4 + cc] * g; else if (cc < 20) v = F.in[IN_MOE_WE][(size_t)l * 16384 + k * 16 + (cc - 4)] * g;
            rw[idx] = v;
        }
    }
    if (F.wg == 0) { const float* lbp = F.in[IN_C_LB]; float* lb = (float*)(F.ws + WS_LB);
        for (int c = tid; c < 1024; c += NTHREADS) { const float a = lbp[c], b = lbp[1024 + c]; const float mx = fmaxf(a, b), ea = __expf(a - mx), eb = __expf(b - mx); lb[c] = (ea + eb) / (ea + eb) - ea / (ea + eb); } }
}


#define MFMA32(a, b, c) __builtin_amdgcn_mfma_f32_16x16x32_bf16(a, b, c, 0, 0, 0)
#define MFMA16(a, b, c) __builtin_amdgcn_mfma_f32_16x16x16bf16_1k(a, b, c, 0, 0, 0)
__device__ __forceinline__ f32x4 mm_tile(const LAS bf16_t* A, int lda, const LAS bf16_t* B, int ldb, int nks, f32x4 acc, int fr, int fq) {
    for (int ksx = 0; ksx < nks; ++ksx) acc = MFMA32(*(const LAS bf16x8*)(A + fr * lda + ksx * 32 + fq * 8), *(const LAS bf16x8*)(B + fr * ldb + ksx * 32 + fq * 8), acc);
    return acc;
}
__device__ __forceinline__ void lds_w4(LAS bf16_t* p, f32x4 v) { u32x2 w; w.x = pk2(v.x, v.y); w.y = pk2(v.z, v.w); *(LAS u32x2*)p = w; }

struct HoBuf { __amdgpu_buffer_rsrc_t r; };
__device__ __forceinline__ HoBuf ho_buf(float* base, unsigned bytes) {
    const unsigned long long a = (unsigned long long)base;
    const unsigned lo = __builtin_amdgcn_readfirstlane((unsigned)a), hi = __builtin_amdgcn_readfirstlane((unsigned)(a >> 32));
    HoBuf h; h.r = __builtin_amdgcn_make_buffer_rsrc((void*)(((unsigned long long)hi << 32) | lo), 0, bytes, 0x00020000); return h;
}
__device__ __forceinline__ void ho_store(const HoBuf& hb, unsigned byteoff, f32x4 v) {
    __builtin_amdgcn_raw_buffer_store_b128(__builtin_bit_cast(u32x4, v), hb.r, byteoff, 0, 16);
}
__device__ __forceinline__ f32x4 ho_load(const HoBuf& hb, unsigned byteoff) {
    return __builtin_bit_cast(f32x4, __builtin_amdgcn_raw_buffer_load_b128(hb.r, byteoff, 0, 16));
}
__device__ __forceinline__ void ho_wait_wave(unsigned* flag, unsigned need, unsigned* tmo) {
    unsigned sp = 0;
    while (__hip_atomic_load(flag, __ATOMIC_RELAXED, __HIP_MEMORY_SCOPE_AGENT) < need) { __builtin_amdgcn_s_sleep(1); if (++sp > (1u << 24)) { __hip_atomic_store(tmo, 1u, __ATOMIC_RELAXED, __HIP_MEMORY_SCOPE_AGENT); break; } }
}
__device__ __forceinline__ void ho_wait(unsigned* flag, unsigned need, unsigned* tmo, int wave, int lane) {
    if (wave == 0 && lane == 0) { unsigned sp = 0;
        while (__hip_atomic_load(flag, __ATOMIC_RELAXED, __HIP_MEMORY_SCOPE_AGENT) < need) { __builtin_amdgcn_s_sleep(2); if (++sp > (1u << 24)) { __hip_atomic_store(tmo, 1u, __ATOMIC_RELAXED, __HIP_MEMORY_SCOPE_AGENT); break; } } }
    __syncthreads();
}

__device__ __forceinline__ void scan_delta3(const Frame& F, int b, int h, int jpart, int kparts) {
    const int lane0 = lane_id_v(); const int w = F.wave;
    LAS bf16_t* Qb = (LAS bf16_t*)F.lds;
    LAS bf16_t* Kb = Qb + 64 * 136;
    LAS float* Of = (LAS float*)F.lds;
    LAS bf16_t* Kdt = Kb + 64 * 136;
    LAS bf16_t* Vt = Kdt + 128 * 72;
    LAS bf16_t* St = Vt + 128 * 72;
    LAS bf16_t* Aoff = St + 128 * 136;
    LAS bf16_t* QKm = Aoff + 64 * 72;
    LAS bf16_t* Vn = QKm + 64 * 72;
    LAS bf16_t* Dg = Vn + 128 * 72;
    LAS float* Adg = (LAS float*)(Dg + 4 * 16 * 24);
    LAS float* sc = Adg + 4 * 16 * 17;
    static_assert((64 * 136 * 2 * 2 + 128 * 72 * 2 * 3 + 128 * 136 * 2 + 64 * 72 * 2 * 2 + 4 * 16 * 24 * 2 + 4 * 16 * 17 * 4 + 260 * 4) <= LDS_MISC, "delta3 LDS");
    bf16_t* P = (bf16_t*)(F.ws + WS_BIG + BIG_PROJ);
    const HoBuf hb = ho_buf((float*)(F.ws + WS_HOA) + (size_t)(b * 4 + h) * 16384, 65536);
    unsigned* flag = (unsigned*)(F.ws + WS_FLAGS) + (b * 4 + h) * 8 + w; unsigned* tmo = (unsigned*)(F.ws + WS_FLAGS) + 2047;
    const float* convw = F.in[IN_AB_CONV];
    const float* db = (const float*)(F.ws + WS_DB);
    const float a_neg = -__expf(F.in[IN_AB_ALOG][h]), dtb = F.in[IN_AB_DTB][h];
    const float* onorm = F.in[IN_AB_ONORM];
    float cw[3][4][2];
#pragma unroll
    for (int sct = 0; sct < 3; ++sct)
#pragma unroll
        for (int j = 0; j < 4; ++j) { cw[sct][j][0] = convw[j * 1536 + sct * 512 + h * 128 + 2 * lane0]; cw[sct][j][1] = convw[j * 1536 + sct * 512 + h * 128 + 2 * lane0 + 1]; }
    for (int i = w * 64 + lane0; i < (128 * 136 + 64 * 72 * 2 + 128 * 72) / 2; i += NTHREADS) ((LAS unsigned*)St)[i] = 0u;
    unsigned pacc = 0u, plast = 0u;
    f32x4 sacc[8];
#pragma unroll
    for (int i = 0; i < 8; ++i) sacc[i] = (f32x4){0.f, 0.f, 0.f, 0.f};
    __syncthreads();
    unsigned rawu[3][11]; float dbv0, dbv1;
#define DELTA_FETCH(cc, ln) do { const int cc_ = (cc) < 32 ? (cc) : 31; \
        dbv0 = db[(size_t)(b * TS + cc_ * 64 + (ln)) * 8 + h]; dbv1 = db[(size_t)(b * TS + cc_ * 64 + (ln)) * 8 + 4 + h]; \
        _Pragma("unroll") for (int rr = 0; rr < 11; ++rr) { const int tl = cc_ * 64 + 8 * w - 3 + rr; \
            const unsigned* row = (const unsigned*)(P + (size_t)(b * TS + (tl >= 0 ? tl : 0)) * P0LD + h * 128) + (ln); \
            _Pragma("unroll") for (int sct = 0; sct < 3; ++sct) rawu[sct][rr] = row[sct * 256]; } } while (0)
    DELTA_FETCH(jpart, lane0);
    for (int c = jpart; c < 32; c += kparts) {
        int lane = lane0; asm volatile("" : "+v"(lane));
        const int fr = lane & 15, fq = lane >> 4;
        const int t0 = b * TS + c * 64;
        if (PROBE_STAGE >= 0) plast = (unsigned)__builtin_amdgcn_s_memrealtime();
        unsigned gq[8];
#pragma unroll
        for (int i = 0; i < 8; ++i) gq[i] = *((const unsigned*)(P + (size_t)(t0 + w + 8 * i) * P0LD + 1536 + h * 128) + lane);
        {
            const float la = a_neg * softplusf_(dbv0 + dtb);
            const float bet = sigmoidf_(dbv1);
            float g = la;
#pragma unroll
            for (int o = 1; o < 64; o <<= 1) { const float n = __shfl_up(g, o); if (lane >= o) g += n; }
            const float gL = rdlane(g, 63);
            if (w == 0) { sc[lane] = g; sc[64 + lane] = __expf(g); sc[128 + lane] = bet * __expf(g); sc[192 + lane] = bet; if (lane == 0) sc[256] = __expf(gL); }
            float raw[3][11][2];
#pragma unroll
            for (int rr = 0; rr < 11; ++rr) { const bool ok = (c * 64 + 8 * w - 3 + rr) >= 0;
#pragma unroll
                for (int sct = 0; sct < 3; ++sct) { raw[sct][rr][0] = ok ? bf2f((unsigned short)(rawu[sct][rr] & 0xffffu)) : 0.f; raw[sct][rr][1] = ok ? bf2f((unsigned short)(rawu[sct][rr] >> 16)) : 0.f; } }
            DELTA_FETCH(c + kparts, lane);
            float kd0[8], kd1[8], vt0[8], vt1[8];
#pragma unroll
            for (int i = 0; i < 8; ++i) {
                const int t = 8 * w + i;
                float x[3][2];
#pragma unroll
                for (int sct = 0; sct < 3; ++sct) { float a0 = 0.f, a1 = 0.f;
#pragma unroll
                    for (int j = 0; j < 4; ++j) { a0 += cw[sct][j][0] * raw[sct][i + j][0]; a1 += cw[sct][j][1] * raw[sct][i + j][1]; }
                    x[sct][0] = siluf_(a0); x[sct][1] = siluf_(a1); }
                const float sq = wsum(x[0][0] * x[0][0] + x[0][1] * x[0][1]), sk = wsum(x[1][0] * x[1][0] + x[1][1] * x[1][1]);
                const float cq = (1.0f / sqrtf(sq + 1e-6f)) * 0.08838834764831845f, ck = 1.0f / sqrtf(sk + 1e-6f);
                const float egr = __expf(gL - rdlane(g, t));
                *(LAS unsigned*)(Qb + t * 136 + 2 * lane) = pk2(x[0][0] * cq, x[0][1] * cq);
                const float k0 = x[1][0] * ck, k1 = x[1][1] * ck;
                *(LAS unsigned*)(Kb + t * 136 + 2 * lane) = pk2(k0, k1);
                kd0[i] = k0 * egr; kd1[i] = k1 * egr; vt0[i] = x[2][0]; vt1[i] = x[2][1];
            }
            *(LAS u32x4*)(Kdt + (2 * lane) * 72 + 8 * w) = (u32x4){pk2(kd0[0], kd0[1]), pk2(kd0[2], kd0[3]), pk2(kd0[4], kd0[5]), pk2(kd0[6], kd0[7])};
            *(LAS u32x4*)(Kdt + (2 * lane + 1) * 72 + 8 * w) = (u32x4){pk2(kd1[0], kd1[1]), pk2(kd1[2], kd1[3]), pk2(kd1[4], kd1[5]), pk2(kd1[6], kd1[7])};
            *(LAS u32x4*)(Vt + (2 * lane) * 72 + 8 * w) = (u32x4){pk2(vt0[0], vt0[1]), pk2(vt0[2], vt0[3]), pk2(vt0[4], vt0[5]), pk2(vt0[6], vt0[7])};
            *(LAS u32x4*)(Vt + (2 * lane + 1) * 72 + 8 * w) = (u32x4){pk2(vt1[0], vt1[1]), pk2(vt1[2], vt1[3]), pk2(vt1[4], vt1[5]), pk2(vt1[6], vt1[7])};
        }
        __syncthreads();
        if (PROBE_STAGE >= 0) { const unsigned tn = (unsigned)__builtin_amdgcn_s_memrealtime(); if (PROBE_STAGE == 0) pacc += tn - plast; plast = tn; }
        {
            for (int id = w; id < 20; id += NWAVES) {
                const int which = id / 10, tix = id % 10;
                const int bi = (tix < 1) ? 0 : (tix < 3 ? 1 : (tix < 6 ? 2 : 3)); const int bj = tix - (bi * (bi + 1)) / 2;
                f32x4 acc = {0.f, 0.f, 0.f, 0.f};
                acc = mm_tile(Kb + bj * 16 * 136, 136, (which ? Qb : Kb) + bi * 16 * 136, 136, 4, acc, fr, fq);
                const int i = 16 * bi + fr; const float gi = sc[i], bi_ = sc[192 + i];
                const float av[4] = {acc.x, acc.y, acc.z, acc.w}; float ov[4];
#pragma unroll
                for (int rg = 0; rg < 4; ++rg) { const int j = 16 * bj + 4 * fq + rg; const float dec = __expf(gi - sc[j]);
                    ov[rg] = which ? ((j <= i) ? av[rg] * dec : 0.f) : ((j < i) ? bi_ * av[rg] * dec : 0.f); }
                if (which) lds_w4(QKm + i * 72 + 16 * bj + 4 * fq, (f32x4){ov[0], ov[1], ov[2], ov[3]});
                else if (bi == bj) { LAS float* d = Adg + (bi * 16 + fr) * 17 + 4 * fq; d[0] = ov[0]; d[1] = ov[1]; d[2] = ov[2]; d[3] = ov[3]; }
                else lds_w4(Aoff + i * 72 + 16 * bj + 4 * fq, (f32x4){-ov[0], -ov[1], -ov[2], -ov[3]});
            }
        }
        __syncthreads();
        if (PROBE_STAGE >= 0) { const unsigned tn = (unsigned)__builtin_amdgcn_s_memrealtime(); if (PROBE_STAGE == 1) pacc += tn - plast; plast = tn; }
        f32x4 y[4], qs[4];
        if (w < 4 && lane < 16) { float x[16]; const LAS float* a = Adg + w * 16 * 17;
#pragma unroll
            for (int i = 0; i < 16; ++i) { float v = (i == lane) ? 1.f : 0.f;
#pragma unroll
                for (int k = 0; k < i; ++k) v -= a[i * 17 + k] * x[k];
                x[i] = v; Dg[(w * 16 + i) * 24 + lane] = (bf16_t)f2bf(v); } }
        __syncthreads();
        if (c > 0) ho_wait_wave(flag, (unsigned)c, tmo);
#pragma unroll
        for (int dk = 0; dk < 8; dk += 2) {
            const u32x4 ldv = __builtin_bit_cast(u32x4, ho_load(hb, (unsigned)(((w * 64 + lane) * 4 + (dk >> 1)) * 16)));
            const f32x4 z0 = {bf2f((unsigned short)(ldv.x & 0xffffu)), bf2f((unsigned short)(ldv.x >> 16)), bf2f((unsigned short)(ldv.y & 0xffffu)), bf2f((unsigned short)(ldv.y >> 16))};
            const f32x4 z1 = {bf2f((unsigned short)(ldv.z & 0xffffu)), bf2f((unsigned short)(ldv.z >> 16)), bf2f((unsigned short)(ldv.w & 0xffffu)), bf2f((unsigned short)(ldv.w >> 16))};
            sacc[dk] = (c > 0) ? z0 : (f32x4){0.f, 0.f, 0.f, 0.f}; sacc[dk + 1] = (c > 0) ? z1 : (f32x4){0.f, 0.f, 0.f, 0.f}; }
#pragma unroll
        for (int dk = 0; dk < 8; ++dk) {
            lds_w4(St + (16 * w + fr) * 136 + 16 * dk + 4 * fq, sacc[dk]); }
        asm volatile("s_waitcnt lgkmcnt(0)" ::: "memory");
        {
            const LAS bf16_t* Sw = St + (16 * w) * 136;
#pragma unroll
            for (int mi = 0; mi < 4; ++mi) {
                f32x4 x = mm_tile(Kb + mi * 16 * 136, 136, Sw, 136, 4, (f32x4){0.f, 0.f, 0.f, 0.f}, fr, fq);
                qs[mi] = mm_tile(Qb + mi * 16 * 136, 136, Sw, 136, 4, (f32x4){0.f, 0.f, 0.f, 0.f}, fr, fq);
                const bf16x4 vv = *(const LAS bf16x4*)(Vt + (16 * w + fr) * 72 + 16 * mi + 4 * fq);
                const f32x4 be4 = *(const LAS f32x4*)(sc + 192 + 16 * mi + 4 * fq), bg4 = *(const LAS f32x4*)(sc + 128 + 16 * mi + 4 * fq);
                y[mi].x = be4.x * bf2f((unsigned short)vv.x) - bg4.x * x.x; y[mi].y = be4.y * bf2f((unsigned short)vv.y) - bg4.y * x.y;
                y[mi].z = be4.z * bf2f((unsigned short)vv.z) - bg4.z * x.z; y[mi].w = be4.w * bf2f((unsigned short)vv.w) - bg4.w * x.w;
            }
        }
        __syncthreads();
        if (PROBE_STAGE >= 0) { const unsigned tn = (unsigned)__builtin_amdgcn_s_memrealtime(); if (PROBE_STAGE == 2) pacc += tn - plast; plast = tn; }
        {
            LAS bf16_t* Vw = Vn + (16 * w) * 72;
#pragma unroll
            for (int bb = 0; bb < 4; ++bb) {
                f32x4 acc = y[bb];
                if (bb >= 1) acc = mm_tile(Aoff + bb * 16 * 72, 72, Vw, 72, (bb + 1) / 2, acc, fr, fq);
                u32x2 pk; pk.x = pk2(acc.x, acc.y); pk.y = pk2(acc.z, acc.w);
                const bf16x4 dgf = *(const LAS bf16x4*)(Dg + (bb * 16 + fr) * 24 + 4 * fq);
                const f32x4 vb = MFMA16(dgf, __builtin_bit_cast(bf16x4, pk), ((f32x4){0.f, 0.f, 0.f, 0.f}));
                lds_w4(Vw + fr * 72 + 16 * bb + 4 * fq, vb);
                asm volatile("s_waitcnt lgkmcnt(0)" ::: "memory");
            }
            const float gl = sc[256];
#pragma unroll
            for (int mi = 0; mi < 4; ++mi) {
                const f32x4 eg4 = *(const LAS f32x4*)(sc + 64 + 16 * mi + 4 * fq);
                f32x4 o = qs[mi] * eg4;
                o = mm_tile(QKm + mi * 16 * 72, 72, Vw, 72, 2, o, fr, fq);
                qs[mi] = o;
            }
#pragma unroll
            for (int dk = 0; dk < 8; ++dk) {
                f32x4 sn = sacc[dk] * gl;
                sn = mm_tile(Kdt + dk * 16 * 72, 72, Vw, 72, 2, sn, fr, fq);
                sacc[dk] = sn;
                lds_w4(St + (16 * w + fr) * 136 + 16 * dk + 4 * fq, sn);
            }
        }
        if (c < 31) {
#pragma unroll
            for (int dk = 0; dk < 8; dk += 2) { u32x4 pv; pv.x = pk2(sacc[dk].x, sacc[dk].y); pv.y = pk2(sacc[dk].z, sacc[dk].w); pv.z = pk2(sacc[dk + 1].x, sacc[dk + 1].y); pv.w = pk2(sacc[dk + 1].z, sacc[dk + 1].w);
                ho_store(hb, (unsigned)(((w * 64 + lane) * 4 + (dk >> 1)) * 16), __builtin_bit_cast(f32x4, pv)); }
            asm volatile("s_waitcnt vmcnt(0)" ::: "memory");
            if (lane == 0) __hip_atomic_store(flag, (unsigned)(c + 1), __ATOMIC_RELAXED, __HIP_MEMORY_SCOPE_AGENT);
        }
        __syncthreads();
        if (PROBE_STAGE >= 0) { const unsigned tn = (unsigned)__builtin_amdgcn_s_memrealtime(); if (PROBE_STAGE == 3) pacc += tn - plast; plast = tn; }
#pragma unroll
        for (int mi = 0; mi < 4; ++mi) { LAS float* op = Of + (16 * mi + 4 * fq) * 132 + 16 * w + fr; op[0] = qs[mi].x; op[132] = qs[mi].y; op[264] = qs[mi].z; op[396] = qs[mi].w; }
        __syncthreads();
        if (PROBE_STAGE >= 0) { const unsigned tn = (unsigned)__builtin_amdgcn_s_memrealtime(); if (PROBE_STAGE == 4) pacc += tn - plast; plast = tn; }
        const float on0 = onorm[2 * lane], on1 = onorm[2 * lane + 1];
#pragma unroll
        for (int i = 0; i < 8; ++i) {
            const int t = w + 8 * i;
            const f32x2 ov = *(const LAS f32x2*)(Of + t * 132 + 2 * lane); const float o0 = ov.x, o1 = ov.y;
            const float ss = wsum(o0 * o0 + o1 * o1), rs = 1.0f / sqrtf(ss * (1.0f / 128.0f) + 1e-6f);
            const float g0 = bf2f((unsigned short)(gq[i] & 0xffffu)), g1 = bf2f((unsigned short)(gq[i] >> 16));
            *((unsigned*)(P + (size_t)(t0 + t) * P0LD + 1536 + h * 128) + lane) = pk2(o0 * rs * on0 * siluf_(g0), o1 * rs * on1 * siluf_(g1));
        }
        __syncthreads();
        if (PROBE_STAGE >= 0) { const unsigned tn = (unsigned)__builtin_amdgcn_s_memrealtime(); if (PROBE_STAGE == 5) pacc += tn - plast; plast = tn; }
    }
    if (PROBE_STAGE >= 0 && F.wg == 0 && w == 0 && lane0 == 0) __hip_atomic_store((unsigned*)(F.ws + WS_CTL + 20484), pacc, __ATOMIC_RELAXED, __HIP_MEMORY_SCOPE_AGENT);
}

__device__ __forceinline__ void scan_hgrn3(const Frame& F, int b, int h, int jpart, int kparts) {
    const int lane0 = lane_id_v(); const int w = F.wave;
    LAS bf16_t* Qd = (LAS bf16_t*)F.lds;
    LAS bf16_t* Kp = Qd + 64 * 136;
    LAS bf16_t* Kpt = Kp + 64 * 136;
    LAS bf16_t* Vt = Kpt + 128 * 72;
    LAS bf16_t* Sc = Vt + 128 * 72;
    LAS bf16_t* Zt = Sc + 64 * 72;
    LAS float* Of = (LAS float*)(Zt + 128 * 136);
    LAS float* gl = Of + 64 * 132;
    LAS float* seg = gl + 128;
    static_assert((64 * 136 * 2 * 2 + 128 * 72 * 2 * 2 + 64 * 72 * 2 + 128 * 136 * 2 + 64 * 132 * 4 + 128 * 4 + 512 * 4) <= LDS_MISC, "hgrn3 LDS");
    bf16_t* P = (bf16_t*)(F.ws + WS_BIG + BIG_PROJ);
    const HoBuf hb = ho_buf((float*)(F.ws + WS_HOC) + (size_t)(b * 8 + h) * 16384, 65536);
    unsigned* flag = (unsigned*)(F.ws + WS_FLAGS) + 768 + (b * 8 + h) * 8 + w; unsigned* tmo = (unsigned*)(F.ws + WS_FLAGS) + 2047;
    const float* onorm = F.in[IN_C_ONORM];
    for (int i = w * 64 + lane0; i < (64 * 72 + 128 * 136) / 2; i += NTHREADS) ((LAS unsigned*)Sc)[i] = 0u;
    f32x4 zacc[8];
#pragma unroll
    for (int i = 0; i < 8; ++i) zacc[i] = (f32x4){0.f, 0.f, 0.f, 0.f};
    __syncthreads();
    for (int c = jpart; c < 32; c += kparts) {
        int lane = lane0; asm volatile("" : "+v"(lane));
        const int tid = w * 64 + lane, fr = lane & 15, fq = lane >> 4, d = tid & 127, sg = tid >> 7;
        const int t0 = b * TS + c * 64;
        {
            float G[16], q[16], v[16], lf[16];
            const bf16_t* pr = P + (size_t)(t0 + 16 * sg) * P1LD + h * 128 + d;
#pragma unroll
            for (int i = 0; i < 16; ++i) { q[i] = bf2f(pr[(size_t)i * P1LD]); lf[i] = h2f_bits(pr[(size_t)i * P1LD + 1024]); v[i] = bf2f(pr[(size_t)i * P1LD + 2048]); }
            float run = 0.f;
#pragma unroll
            for (int i = 0; i < 16; ++i) { run += lf[i]; G[i] = run; }
            seg[sg * 128 + d] = run;
            __syncthreads();
            float off = 0.f;
#pragma unroll
            for (int s2 = 0; s2 < 3; ++s2) if (s2 < sg) off += seg[s2 * 128 + d];
            float kpv[16];
#pragma unroll
            for (int i = 0; i < 16; ++i) {
                const int t = 16 * sg + i; const float Gt = off + G[i];
                const float qd = q[i] * __expf(Gt); kpv[i] = -expm1f(lf[i]) * __expf(fminf(-Gt, 80.f));
                Qd[t * 136 + d] = (bf16_t)f2bf(qd); Kp[t * 136 + d] = (bf16_t)f2bf(kpv[i]);
            }
            *(LAS u32x4*)(Kpt + d * 72 + 16 * sg) = (u32x4){pk2(kpv[0], kpv[1]), pk2(kpv[2], kpv[3]), pk2(kpv[4], kpv[5]), pk2(kpv[6], kpv[7])};
            *(LAS u32x4*)(Kpt + d * 72 + 16 * sg + 8) = (u32x4){pk2(kpv[8], kpv[9]), pk2(kpv[10], kpv[11]), pk2(kpv[12], kpv[13]), pk2(kpv[14], kpv[15])};
            *(LAS u32x4*)(Vt + d * 72 + 16 * sg) = (u32x4){pk2(v[0], v[1]), pk2(v[2], v[3]), pk2(v[4], v[5]), pk2(v[6], v[7])};
            *(LAS u32x4*)(Vt + d * 72 + 16 * sg + 8) = (u32x4){pk2(v[8], v[9]), pk2(v[10], v[11]), pk2(v[12], v[13]), pk2(v[14], v[15])};
            if (sg == 3) gl[d] = __expf(off + G[15]);
        }
        __syncthreads();
        for (int id = w; id < 10; id += NWAVES) {
            const int bi = (id < 1) ? 0 : (id < 3 ? 1 : (id < 6 ? 2 : 3)); const int bj = id - (bi * (bi + 1)) / 2;
            const f32x4 acc = mm_tile(Kp + bj * 16 * 136, 136, Qd + bi * 16 * 136, 136, 4, (f32x4){0.f, 0.f, 0.f, 0.f}, fr, fq);
            const int i = 16 * bi + fr, j0 = 16 * bj + 4 * fq;
            lds_w4(Sc + i * 72 + j0, (f32x4){(j0 <= i) ? acc.x : 0.f, (j0 + 1 <= i) ? acc.y : 0.f, (j0 + 2 <= i) ? acc.z : 0.f, (j0 + 3 <= i) ? acc.w : 0.f});
        }
        __syncthreads();
        const LAS bf16_t* Vw = Vt + (16 * w) * 72; const LAS bf16_t* Zw = Zt + (16 * w) * 136;
        f32x4 cacc[8], opart[4];
#pragma unroll
        for (int dk = 0; dk < 8; ++dk) cacc[dk] = mm_tile(Kpt + dk * 16 * 72, 72, Vw, 72, 2, (f32x4){0.f, 0.f, 0.f, 0.f}, fr, fq);
#pragma unroll
        for (int mi = 0; mi < 4; ++mi) opart[mi] = mm_tile(Sc + mi * 16 * 72, 72, Vw, 72, 2, (f32x4){0.f, 0.f, 0.f, 0.f}, fr, fq);
        if (c > 0) ho_wait_wave(flag, (unsigned)c, tmo);
#pragma unroll
        for (int dk = 0; dk < 8; dk += 2) {
            const u32x4 ldv = __builtin_bit_cast(u32x4, ho_load(hb, (unsigned)(((w * 64 + lane) * 4 + (dk >> 1)) * 16)));
            const f32x4 z0 = {bf2f((unsigned short)(ldv.x & 0xffffu)), bf2f((unsigned short)(ldv.x >> 16)), bf2f((unsigned short)(ldv.y & 0xffffu)), bf2f((unsigned short)(ldv.y >> 16))};
            const f32x4 z1 = {bf2f((unsigned short)(ldv.z & 0xffffu)), bf2f((unsigned short)(ldv.z >> 16)), bf2f((unsigned short)(ldv.w & 0xffffu)), bf2f((unsigned short)(ldv.w >> 16))};
            zacc[dk] = (c > 0) ? z0 : (f32x4){0.f, 0.f, 0.f, 0.f}; zacc[dk + 1] = (c > 0) ? z1 : (f32x4){0.f, 0.f, 0.f, 0.f}; }
        if (c < 31) {
#pragma unroll
            for (int dk = 0; dk < 8; dk += 2) {
                const f32x4 g0 = *(const LAS f32x4*)(gl + 16 * dk + 4 * fq), g1 = *(const LAS f32x4*)(gl + 16 * (dk + 1) + 4 * fq);
                const f32x4 n0 = (zacc[dk] + cacc[dk]) * g0, n1 = (zacc[dk + 1] + cacc[dk + 1]) * g1;
                u32x4 pv; pv.x = pk2(n0.x, n0.y); pv.y = pk2(n0.z, n0.w); pv.z = pk2(n1.x, n1.y); pv.w = pk2(n1.z, n1.w);
                ho_store(hb, (unsigned)(((w * 64 + lane) * 4 + (dk >> 1)) * 16), __builtin_bit_cast(f32x4, pv)); }
            asm volatile("s_waitcnt vmcnt(0)" ::: "memory");
            if (lane == 0) __hip_atomic_store(flag, (unsigned)(c + 1), __ATOMIC_RELAXED, __HIP_MEMORY_SCOPE_AGENT);
        }
#pragma unroll
        for (int dk = 0; dk < 8; ++dk) lds_w4(Zt + (16 * w + fr) * 136 + 16 * dk + 4 * fq, zacc[dk]);
        asm volatile("s_waitcnt lgkmcnt(0)" ::: "memory");
#pragma unroll
        for (int mi = 0; mi < 4; ++mi) {
            const f32x4 o = mm_tile(Qd + mi * 16 * 136, 136, Zw, 136, 4, opart[mi], fr, fq);
            LAS float* op = Of + (16 * mi + 4 * fq) * 132 + 16 * w + fr; op[0] = o.x; op[132] = o.y; op[264] = o.z; op[396] = o.w;
        }
        __syncthreads();
        for (int t = w; t < 64; t += NWAVES) {
            const float o0 = Of[t * 132 + lane], o1 = Of[t * 132 + lane + 64];
            const float ss = wsum(o0 * o0 + o1 * o1), rs = 1.0f / sqrtf(ss * (1.0f / 128.0f) + 1e-6f);
            bf16_t* gp = P + (size_t)(t0 + t) * P1LD + 3072 + h * 128;
            const float g0 = bf2f(gp[lane]), g1 = bf2f(gp[lane + 64]);
            gp[lane] = (bf16_t)f2bf(o0 * rs * onorm[lane] * siluf_(g0)); gp[lane + 64] = (bf16_t)f2bf(o1 * rs * onorm[lane + 64] * siluf_(g1));
        }
    }
}

__device__ __forceinline__ float tanh_fast(float x) { const float e = __expf(2.f * x); return 1.f - 2.f / (1.f + e); }
struct RwkvLd { u32x4 cu, pv; };
__device__ __forceinline__ RwkvLd rwkv_ld8(const bf16_t* Pc, int t, int gc, const bf16_t* hal) {
    const bf16_t* src = Pc + (size_t)t * P0LD + gc; const bf16_t* psrc = (t > 0) ? src - P0LD : hal + (gc - 2048);
    RwkvLd r; r.cu = *(const u32x4*)src; r.pv = *(const u32x4*)psrc; return r;
}
__device__ __forceinline__ void rwkv_sh8(const RwkvLd& ld, int t, int gc, bool first_zero, const float* mu, float (&sh)[8]) {
    const f32x4 m0 = *(const f32x4*)(mu + gc - 2048), m1 = *(const f32x4*)(mu + gc - 2048 + 4);
    const unsigned cw_[4] = {ld.cu.x, ld.cu.y, ld.cu.z, ld.cu.w}, pw_[4] = {ld.pv.x, ld.pv.y, ld.pv.z, ld.pv.w};
    const float mv[8] = {m0.x, m0.y, m0.z, m0.w, m1.x, m1.y, m1.z, m1.w};
    float cur[8];
#pragma unroll
    for (int e = 0; e < 8; ++e) {
        cur[e] = bf2f((unsigned short)((e & 1) ? (cw_[e >> 1] >> 16) : (cw_[e >> 1] & 0xffffu)));
        const float pg = bf2f((unsigned short)((e & 1) ? (pw_[e >> 1] >> 16) : (pw_[e >> 1] & 0xffffu)));
        const float prv = (t == 0 && first_zero) ? 0.f : pg;
        sh[e] = cur[e] + mv[e] * (prv - cur[e]);
    }
}
__device__ __forceinline__ void scan_rwkv3(const Frame& F, int b, int h, int par) {
    const int lane0 = lane_id_v(); const int w = F.wave;
    LAS unsigned char* L = F.lds;
    LAS bf16_t* RPb = (LAS bf16_t*)(L + 0);
    LAS bf16_t* KPb = (LAS bf16_t*)(L + 9216);
    LAS float* LWf = (LAS float*)(L + 18432);
    LAS float* Af = (LAS float*)(L + 34816);
    LAS float* segs = (LAS float*)(L + 51200);
    LAS bf16_t* Mak = (LAS bf16_t*)(L + 0);
    LAS bf16_t* Mrk = (LAS bf16_t*)(L + 9216);
    LAS bf16_t* Mrbn = (LAS bf16_t*)(L + 18432);
    LAS bf16_t* Aoff = (LAS bf16_t*)(L + 27648);
    LAS float* Adg = (LAS float*)(L + 36864);
    LAS bf16_t* Dg = (LAS bf16_t*)(L + 41216);
    LAS bf16_t* GB = (LAS bf16_t*)(L + 44288);
    LAS bf16_t* TL = (LAS bf16_t*)(L + 65536);
    LAS bf16_t* AL = (LAS bf16_t*)(L + 65536 + 9216);
    LAS bf16_t* SG = (LAS bf16_t*)(L + 65536 + 18432);
    LAS bf16_t* At = (LAS bf16_t*)(L + 65536);
    LAS bf16_t* Btl = (LAS bf16_t*)(L + 65536 + 9216);
    LAS bf16_t* Ktl = (LAS bf16_t*)(L + 65536 + 18432);
    LAS bf16_t* Rtl = (LAS bf16_t*)(L + 65536 + 27648);
    LAS float* Of = (LAS float*)(L + 65536);
    LAS bf16_t* BtTn = (LAS bf16_t*)(L + 102400);
    LAS bf16_t* KtT = (LAS bf16_t*)(L + 111616);
    LAS bf16_t* Vt = (LAS bf16_t*)(L + 120832);
    LAS bf16_t* Zt = (LAS bf16_t*)(L + 130048);
    LAS bf16_t* PU = (LAS bf16_t*)(L + 139264);
    LAS float* bonus = (LAS float*)(L + 148480);
    LAS float* glv = bonus + 64;
    static_assert(148480 + 4096 <= LDS_MISC, "rwkv3 LDS");
    bf16_t* P = (bf16_t*)(F.ws + WS_BIG + BIG_PROJ);
    const bf16_t* LW = (const bf16_t*)(F.ws + WS_LORA);
    const bf16_t* HALO = (const bf16_t*)(F.ws + WS_HALOB);
    const HoBuf hb = ho_buf((float*)(F.ws + WS_HOB) + (size_t)(b * 8 + h) * 4096, 16384);
    unsigned* flag = (unsigned*)(F.ws + WS_FLAGS) + 256 + (b * 8 + h) * 8 + w; unsigned* tmo = (unsigned*)(F.ws + WS_FLAGS) + 2047;
    const float* mu = F.in[IN_AB_MU];
    const float kkj = F.in[IN_AB_KK][h * 64 + lane0], kaj = F.in[IN_AB_KA][h * 64 + lane0], rkj = F.in[IN_AB_RK][h * 64 + lane0];
    const float lnw = F.in[IN_AB_LNW][h * 64 + lane0], lnb = F.in[IN_AB_LNB][h * 64 + lane0];
    float w0q[2], a0q[2];
#pragma unroll
    for (int q = 0; q < 2; ++q) { const int jq = ((2 * w + q) & 3) * 16 + (lane0 & 15); w0q[q] = F.in[IN_AB_W0][h * 64 + jq]; a0q[q] = F.in[IN_AB_A0][h * 64 + jq]; }
    bf16x8 yw[2][2], ya[2][2], yg[2][4];
#pragma unroll
    for (int q = 0; q < 2; ++q) { const int jrow = h * 64 + ((2 * w + q) & 3) * 16 + (lane0 & 15), fq0 = lane0 >> 4;
#pragma unroll
        for (int ksx = 0; ksx < 2; ++ksx) { yw[q][ksx] = *(const bf16x8*)(LW + (size_t)jrow * 64 + ksx * 32 + fq0 * 8); ya[q][ksx] = *(const bf16x8*)(LW + 512 * 64 + (size_t)jrow * 64 + ksx * 32 + fq0 * 8); }
#pragma unroll
        for (int ksx = 0; ksx < 4; ++ksx) yg[q][ksx] = *(const bf16x8*)(LW + 2 * 512 * 64 + (size_t)jrow * 128 + ksx * 32 + fq0 * 8); }
    f32x4 zacc[4];
#pragma unroll
    for (int i = 0; i < 4; ++i) zacc[i] = (f32x4){0.f, 0.f, 0.f, 0.f};
    for (int i = w * 64 + lane0; i < (64 * 72 * 2) / 2; i += NTHREADS) ((LAS unsigned*)Zt)[i] = 0u;
    __syncthreads();
    for (int c = par; c < 32; c += 2) {
        int lane = lane0; asm volatile("" : "+v"(lane));
        const int tid = w * 64 + lane, fr = lane & 15, fq = lane >> 4;
        const int t0 = b * TS + c * 64;
        {
            const bf16_t* Pc = P + (size_t)t0 * P0LD; const bf16_t* hal = HALO + (size_t)(b * 32 + (c > 0 ? c - 1 : 0)) * 1792; const bool fz = (c == 0);
            const int t_a0 = tid >> 4, cg_a0 = tid & 15, t_a1 = (tid + NTHREADS) >> 4, cg_a1 = (tid + NTHREADS) & 15, t_b = tid >> 3, cg_b = tid & 7;
            const int gc0 = ((cg_a0 < 8) ? 2048 : 2560) + h * 64 + (cg_a0 & 7) * 8, gc1 = ((cg_a1 < 8) ? 2048 : 2560) + h * 64 + (cg_a1 & 7) * 8;
            const int gc2 = 3584 + cg_b * 8, gc3 = 3648 + cg_b * 8, gc4 = 3712 + cg_a0 * 8, gc5 = 3712 + cg_a1 * 8;
            const RwkvLd l0 = rwkv_ld8(Pc, t_a0, gc0, hal), l1 = rwkv_ld8(Pc, t_a1, gc1, hal), l2 = rwkv_ld8(Pc, t_b, gc2, hal), l3 = rwkv_ld8(Pc, t_b, gc3, hal), l4 = rwkv_ld8(Pc, t_a0, gc4, hal), l5 = rwkv_ld8(Pc, t_a1, gc5, hal);
            const int vcol = tid & 63, vtg = tid >> 6;
            const bf16_t* vsrc = Pc + (size_t)(8 * vtg) * P0LD + 3072 + h * 64 + vcol;
            unsigned short vr[9];
#pragma unroll
            for (int i = 0; i < 8; ++i) vr[i + 1] = vsrc[(size_t)i * P0LD];
            vr[0] = *((vtg > 0) ? vsrc - P0LD : hal + 1024 + h * 64 + vcol);
            float sh[8];
            { rwkv_sh8(l0, t_a0, gc0, fz, mu, sh);
              *(LAS u32x4*)((cg_a0 < 8 ? RPb : KPb) + t_a0 * 72 + (cg_a0 & 7) * 8) = (u32x4){pk2(sh[0], sh[1]), pk2(sh[2], sh[3]), pk2(sh[4], sh[5]), pk2(sh[6], sh[7])}; }
            { rwkv_sh8(l1, t_a1, gc1, fz, mu, sh);
              *(LAS u32x4*)((cg_a1 < 8 ? RPb : KPb) + t_a1 * 72 + (cg_a1 & 7) * 8) = (u32x4){pk2(sh[0], sh[1]), pk2(sh[2], sh[3]), pk2(sh[4], sh[5]), pk2(sh[6], sh[7])}; }
            { rwkv_sh8(l2, t_b, gc2, fz, mu, sh);
              *(LAS u32x4*)(TL + t_b * 72 + cg_b * 8) = (u32x4){pk2(tanh_fast(sh[0]), tanh_fast(sh[1])), pk2(tanh_fast(sh[2]), tanh_fast(sh[3])), pk2(tanh_fast(sh[4]), tanh_fast(sh[5])), pk2(tanh_fast(sh[6]), tanh_fast(sh[7]))}; }
            { rwkv_sh8(l3, t_b, gc3, fz, mu, sh);
              *(LAS u32x4*)(AL + t_b * 72 + cg_b * 8) = (u32x4){pk2(sh[0], sh[1]), pk2(sh[2], sh[3]), pk2(sh[4], sh[5]), pk2(sh[6], sh[7])}; }
            { rwkv_sh8(l4, t_a0, gc4, fz, mu, sh);
              *(LAS u32x4*)(SG + t_a0 * 136 + cg_a0 * 8) = (u32x4){pk2(sigmoidf_(sh[0]), sigmoidf_(sh[1])), pk2(sigmoidf_(sh[2]), sigmoidf_(sh[3])), pk2(sigmoidf_(sh[4]), sigmoidf_(sh[5])), pk2(sigmoidf_(sh[6]), sigmoidf_(sh[7]))}; }
            { rwkv_sh8(l5, t_a1, gc5, fz, mu, sh);
              *(LAS u32x4*)(SG + t_a1 * 136 + cg_a1 * 8) = (u32x4){pk2(sigmoidf_(sh[0]), sigmoidf_(sh[1])), pk2(sigmoidf_(sh[2]), sigmoidf_(sh[3])), pk2(sigmoidf_(sh[4]), sigmoidf_(sh[5])), pk2(sigmoidf_(sh[6]), sigmoidf_(sh[7]))}; }
            {
                float cur[9];
#pragma unroll
                for (int i = 0; i < 9; ++i) cur[i] = bf2f(vr[i]);
                if (vtg == 0 && fz) cur[0] = 0.f;
                const float mvc = mu[1024 + h * 64 + vcol];
                float shv[8];
#pragma unroll
                for (int i = 0; i < 8; ++i) shv[i] = cur[i + 1] + mvc * (cur[i] - cur[i + 1]);
                *(LAS u32x4*)(Vt + vcol * 72 + 8 * vtg) = (u32x4){pk2(shv[0], shv[1]), pk2(shv[2], shv[3]), pk2(shv[4], shv[5]), pk2(shv[6], shv[7])};
            }
        }
        __syncthreads();
        f32x4 agate[2];
        {
#pragma unroll
            for (int q = 0; q < 2; ++q) {
                const int id = 2 * w + q, mi = id >> 2, nj = id & 3;
                f32x4 aw = {0.f, 0.f, 0.f, 0.f}, aa = {0.f, 0.f, 0.f, 0.f}, ag = {0.f, 0.f, 0.f, 0.f};
#pragma unroll
                for (int ksx = 0; ksx < 2; ++ksx) {
                    const bf16x8 x1 = *(const LAS bf16x8*)(TL + (mi * 16 + fr) * 72 + ksx * 32 + fq * 8), x2 = *(const LAS bf16x8*)(AL + (mi * 16 + fr) * 72 + ksx * 32 + fq * 8);
                    aw = MFMA32(x1, yw[q][ksx], aw); aa = MFMA32(x2, ya[q][ksx], aa);
                }
#pragma unroll
                for (int ksx = 0; ksx < 4; ++ksx) {
                    const bf16x8 x3 = *(const LAS bf16x8*)(SG + (mi * 16 + fr) * 136 + ksx * 32 + fq * 8);
                    ag = MFMA32(x3, yg[q][ksx], ag);
                }
                agate[q] = ag;
                const int j = nj * 16 + fr; const float w0j = w0q[q], a0j = a0q[q];
                const float awv[4] = {aw.x, aw.y, aw.z, aw.w}, aav[4] = {aa.x, aa.y, aa.z, aa.w};
#pragma unroll
                for (int rg = 0; rg < 4; ++rg) { const int t = mi * 16 + 4 * fq + rg;
                    LWf[t * 64 + j] = -0.6065306597126334f * sigmoidf_(w0j + awv[rg]); Af[t * 64 + j] = sigmoidf_(a0j + aav[rg]); }
            }
        }
        __syncthreads();
        {
            float g[8]; float run = 0.f;
#pragma unroll
            for (int i = 0; i < 8; ++i) { run += LWf[(8 * w + i) * 64 + lane]; g[i] = run; }
            segs[w * 64 + lane] = run;
            __syncthreads();
            float off = 0.f;
#pragma unroll
            for (int s2 = 0; s2 < 7; ++s2) if (s2 < w) off += segs[s2 * 64 + lane];
#pragma unroll
            for (int i = 0; i < 8; ++i) LWf[(8 * w + i) * 64 + lane] = off + g[i];
        }
        __syncthreads();
        {
            const int j = lane;
            float btn[8], ktt[8];
#pragma unroll
            for (int i = 0; i < 8; ++i) {
                const int t = 8 * w + i;
                const float kv = bf2f(KPb[t * 72 + j]), rv = bf2f(RPb[t * 72 + j]), a = Af[t * 64 + j], G = LWf[t * 64 + j];
                const float Gp = (t > 0) ? LWf[(t - 1) * 64 + j] : 0.f;
                const float kx = kv * kkj; const float ss = wsum(kx * kx); const float kk = kx * (1.0f / sqrtf(ss + 1e-6f));
                const float km = kv * (1.f + (a - 1.f) * kaj);
                const float bs = wsum(rv * km * rkj); if (j == 0) bonus[t] = bs;
                const float eG = __expf(G), eGi = __expf(-G), eGp = __expf(Gp);
                const float bt = kk * a * eGi, kt = km * eGi;
                At[t * 72 + j] = (bf16_t)f2bf(kk * eGp); Btl[t * 72 + j] = (bf16_t)f2bf(bt); Ktl[t * 72 + j] = (bf16_t)f2bf(kt); Rtl[t * 72 + j] = (bf16_t)f2bf(rv * eG);
                btn[i] = -bt; ktt[i] = kt;
                if (t == 63) glv[j] = eG;
            }
            *(LAS u32x4*)(BtTn + j * 72 + 8 * w) = (u32x4){pk2(btn[0], btn[1]), pk2(btn[2], btn[3]), pk2(btn[4], btn[5]), pk2(btn[6], btn[7])};
            *(LAS u32x4*)(KtT + j * 72 + 8 * w) = (u32x4){pk2(ktt[0], ktt[1]), pk2(ktt[2], ktt[3]), pk2(ktt[4], ktt[5]), pk2(ktt[6], ktt[7])};
        }
        __syncthreads();
        {
            for (int job = w; job < 64; job += NWAVES) {
                const int mat = job >> 4, bi = (job >> 2) & 3, bj = job & 3;
                LAS bf16_t* dst = (mat == 0) ? Aoff : (mat == 1 ? Mak : (mat == 2 ? Mrk : Mrbn));
                const int i = 16 * bi + fr, j0 = 16 * bj + 4 * fq;
                f32x4 o = {0.f, 0.f, 0.f, 0.f};
                if (bj <= bi) {
                    const LAS bf16_t* Aj = ((mat == 0 || mat == 3) ? Btl : Ktl) + bj * 16 * 72; const LAS bf16_t* Bi = ((mat < 2) ? At : Rtl) + bi * 16 * 72;
                    const f32x4 acc = mm_tile(Aj, 72, Bi, 72, 2, (f32x4){0.f, 0.f, 0.f, 0.f}, fr, fq);
                    const bool incl = mat >= 2;
                    o.x = (incl ? (j0 <= i) : (j0 < i)) ? acc.x : 0.f; o.y = (incl ? (j0 + 1 <= i) : (j0 + 1 < i)) ? acc.y : 0.f;
                    o.z = (incl ? (j0 + 2 <= i) : (j0 + 2 < i)) ? acc.z : 0.f; o.w = (incl ? (j0 + 3 <= i) : (j0 + 3 < i)) ? acc.w : 0.f;
                    if (mat == 0 && bi == bj) { LAS float* dd = Adg + (bi * 16 + fr) * 17 + 4 * fq; dd[0] = o.x; dd[1] = o.y; dd[2] = o.z; dd[3] = o.w; o = (f32x4){0.f, 0.f, 0.f, 0.f}; }
                    if (mat == 0 || mat == 3) o = -o;
                }
                lds_w4(dst + i * 72 + j0, o);
            }
#pragma unroll
            for (int q = 0; q < 2; ++q) { const int id = 2 * w + q, mi = id >> 2, nj = id & 3; const int j = nj * 16 + fr; const float gv[4] = {agate[q].x, agate[q].y, agate[q].z, agate[q].w};
#pragma unroll
                for (int rg = 0; rg < 4; ++rg) GB[(mi * 16 + 4 * fq + rg) * 64 + j] = (bf16_t)f2bf(gv[rg]); }
        }
        __syncthreads();
        f32x4 ot[4];
        if (w < 4 && c > 0) ho_wait_wave(flag, (unsigned)c, tmo);
        if (w < 4) {
#pragma unroll
            for (int kb = 0; kb < 4; kb += 2) {
                const u32x4 ldv = __builtin_bit_cast(u32x4, ho_load(hb, (unsigned)(((w * 64 + lane) * 2 + (kb >> 1)) * 16)));
                const f32x4 z0 = {bf2f((unsigned short)(ldv.x & 0xffffu)), bf2f((unsigned short)(ldv.x >> 16)), bf2f((unsigned short)(ldv.y & 0xffffu)), bf2f((unsigned short)(ldv.y >> 16))};
                const f32x4 z1 = {bf2f((unsigned short)(ldv.z & 0xffffu)), bf2f((unsigned short)(ldv.z >> 16)), bf2f((unsigned short)(ldv.w & 0xffffu)), bf2f((unsigned short)(ldv.w >> 16))};
                zacc[kb] = (c > 0) ? z0 : (f32x4){0.f, 0.f, 0.f, 0.f}; zacc[kb + 1] = (c > 0) ? z1 : (f32x4){0.f, 0.f, 0.f, 0.f}; }
#pragma unroll
            for (int kb = 0; kb < 4; ++kb) lds_w4(Zt + (16 * w + fr) * 72 + 16 * kb + 4 * fq, zacc[kb]);
            asm volatile("s_waitcnt lgkmcnt(0)" ::: "memory");
        }
        if (w < 4) {
            {
                const int bb = lane >> 4, jj = lane & 15; float x[16]; const LAS float* a = Adg + bb * 16 * 17;
#pragma unroll
                for (int i = 0; i < 16; ++i) { float v = (i == jj) ? 1.f : 0.f;
#pragma unroll
                    for (int k = 0; k < i; ++k) v -= a[i * 17 + k] * x[k];
                    x[i] = v; Dg[(bb * 16 + i) * 24 + jj] = (bf16_t)f2bf(v); }
                asm volatile("s_waitcnt lgkmcnt(0)" ::: "memory");
            }
            const LAS bf16_t* Vw = Vt + (16 * w) * 72; const LAS bf16_t* Zw = Zt + (16 * w) * 72; LAS bf16_t* PUw = PU + (16 * w) * 72;
            f32x4 p[4];
#pragma unroll
            for (int mi = 0; mi < 4; ++mi) { p[mi] = mm_tile(At + mi * 16 * 72, 72, Zw, 72, 2, (f32x4){0.f, 0.f, 0.f, 0.f}, fr, fq); p[mi] = mm_tile(Mak + mi * 16 * 72, 72, Vw, 72, 2, p[mi], fr, fq); }
#pragma unroll
            for (int bb = 0; bb < 4; ++bb) {
                f32x4 acc = p[bb];
                if (bb >= 1) acc = mm_tile(Aoff + bb * 16 * 72, 72, PUw, 72, (bb + 1) / 2, acc, fr, fq);
                u32x2 pk; pk.x = pk2(acc.x, acc.y); pk.y = pk2(acc.z, acc.w);
                const bf16x4 dgf = *(const LAS bf16x4*)(Dg + (bb * 16 + fr) * 24 + 4 * fq);
                const f32x4 ub = MFMA16(dgf, __builtin_bit_cast(bf16x4, pk), ((f32x4){0.f, 0.f, 0.f, 0.f}));
                lds_w4(PUw + fr * 72 + 16 * bb + 4 * fq, ub);
                asm volatile("s_waitcnt lgkmcnt(0)" ::: "memory");
            }
#pragma unroll
            for (int mi = 0; mi < 4; ++mi) {
                f32x4 o = mm_tile(Rtl + mi * 16 * 72, 72, Zw, 72, 2, (f32x4){0.f, 0.f, 0.f, 0.f}, fr, fq);
                o = mm_tile(Mrk + mi * 16 * 72, 72, Vw, 72, 2, o, fr, fq);
                ot[mi] = mm_tile(Mrbn + mi * 16 * 72, 72, PUw, 72, 2, o, fr, fq);
            }
#pragma unroll
            for (int kb = 0; kb < 4; ++kb) {
                f32x4 zn = mm_tile(KtT + kb * 16 * 72, 72, Vw, 72, 2, zacc[kb], fr, fq);
                zn = mm_tile(BtTn + kb * 16 * 72, 72, PUw, 72, 2, zn, fr, fq);
                const f32x4 g4 = *(const LAS f32x4*)(glv + 16 * kb + 4 * fq);
                zn = zn * g4; zacc[kb] = zn;
                lds_w4(Zt + (16 * w + fr) * 72 + 16 * kb + 4 * fq, zn);
            }
        }
        if (w < 4 && c < 31) {
#pragma unroll
            for (int kb = 0; kb < 4; kb += 2) { u32x4 pv; pv.x = pk2(zacc[kb].x, zacc[kb].y); pv.y = pk2(zacc[kb].z, zacc[kb].w); pv.z = pk2(zacc[kb + 1].x, zacc[kb + 1].y); pv.w = pk2(zacc[kb + 1].z, zacc[kb + 1].w);
                ho_store(hb, (unsigned)(((w * 64 + lane) * 2 + (kb >> 1)) * 16), __builtin_bit_cast(f32x4, pv)); }
            asm volatile("s_waitcnt vmcnt(0)" ::: "memory");
            if (lane == 0) __hip_atomic_store(flag, (unsigned)(c + 1), __ATOMIC_RELAXED, __HIP_MEMORY_SCOPE_AGENT);
        }
        __syncthreads();
        if (w < 4) {
#pragma unroll
            for (int mi = 0; mi < 4; ++mi) { LAS float* op = Of + (16 * mi + 4 * fq) * 65 + 16 * w + fr; op[0] = ot[mi].x; op[65] = ot[mi].y; op[130] = ot[mi].z; op[195] = ot[mi].w; }
        }
        __syncthreads();
        for (int t = w; t < 64; t += NWAVES) {
            const float o = Of[t * 65 + lane];
            const float mean = wsum(o) * (1.0f / 64.0f); const float dlt = o - mean; const float var = wsum(dlt * dlt) * (1.0f / 64.0f);
            float y = dlt * (1.0f / sqrtf(var + 64e-5f)) * lnw + lnb;
            y += bonus[t] * bf2f(Vt[lane * 72 + t]);
            y *= bf2f(GB[t * 64 + lane]);
            P[(size_t)(t0 + t) * P0LD + 2048 + h * 64 + lane] = (bf16_t)f2bf(y);
        }
        __syncthreads();
    }
}


__device__ __forceinline__ void attn_phase2(const Frame& F, const bf16_t* Q, const bf16_t* Kb, const bf16_t* VT, bf16_t* O) {
    const int lane = lane_id_v(); const int tid = F.wave * 64 + lane; const int fr = lane & 15, fq = lane >> 4;
    LAS bf16_t* KL = (LAS bf16_t*)F.lds;
    static_assert(256 * 264 * 2 <= LDS_MISC, "attn LDS");
    for (int u = F.wg; u < 512; u += F.G) {
        const int b = u >> 6, h = (u >> 4) & 3, qb = u & 15;
        const int q0 = b * TS + qb * 128 + F.wave * 16;
        u32x4 st[16];
#pragma unroll
        for (int n = 0; n < 16; ++n) { const int idx = tid + NTHREADS * n, row = idx >> 5, c8 = idx & 31;
            st[n] = *(const u32x4*)(Kb + (size_t)(b * 256 + row) * 1024 + h * 256 + c8 * 8); }
        bf16x8 bq[8];
#pragma unroll
        for (int ksx = 0; ksx < 8; ++ksx) bq[ksx] = *(const bf16x8*)(Q + (size_t)(q0 + fr) * 1024 + h * 256 + ksx * 32 + fq * 8);
        __syncthreads();
#pragma unroll
        for (int n = 0; n < 16; ++n) { const int idx = tid + NTHREADS * n, row = idx >> 5, c8 = idx & 31; *(LAS u32x4*)(KL + row * 264 + c8 * 8) = st[n]; }
        const bf16_t* vbase = VT + (size_t)((b * 4 + h) * 256) * 256;
#pragma unroll
        for (int n = 0; n < 16; ++n) { const int idx = tid + NTHREADS * n, row = idx >> 5, c8 = idx & 31; st[n] = *(const u32x4*)(vbase + (size_t)row * 256 + c8 * 8); }
        __syncthreads();
        f32x4 sacc[16];
#pragma unroll
        for (int tl = 0; tl < 16; ++tl) {
            f32x4 a4 = {0.f, 0.f, 0.f, 0.f};
#pragma unroll
            for (int ksx = 0; ksx < 8; ++ksx) a4 = __builtin_amdgcn_mfma_f32_16x16x32_bf16(*(const LAS bf16x8*)(KL + (tl * 16 + fr) * 264 + ksx * 32 + fq * 8), bq[ksx], a4, 0, 0, 0);
            sacc[tl] = a4;
        }
        float mx = -3.0e38f;
#pragma unroll
        for (int tl = 0; tl < 16; ++tl) mx = fmaxf(mx, fmaxf(fmaxf(sacc[tl].x, sacc[tl].y), fmaxf(sacc[tl].z, sacc[tl].w)));
        mx = fmaxf(mx, __shfl_xor(mx, 16)); mx = fmaxf(mx, __shfl_xor(mx, 32));
        float l = 0.f;
        bf16x8 pb[8];
#pragma unroll
        for (int ksx = 0; ksx < 8; ++ksx) {
            const f32x4 e0 = sacc[2 * ksx], e1 = sacc[2 * ksx + 1];
            const float p0 = __expf(e0.x - mx), p1 = __expf(e0.y - mx), p2 = __expf(e0.z - mx), p3 = __expf(e0.w - mx);
            const float p4 = __expf(e1.x - mx), p5 = __expf(e1.y - mx), p6 = __expf(e1.z - mx), p7 = __expf(e1.w - mx);
            l += ((p0 + p1) + (p2 + p3)) + ((p4 + p5) + (p6 + p7));
            u32x4 w; w.x = pk2(p0, p1); w.y = pk2(p2, p3); w.z = pk2(p4, p5); w.w = pk2(p6, p7);
            pb[ksx] = __builtin_bit_cast(bf16x8, w);
        }
        l += __shfl_xor(l, 16); l += __shfl_xor(l, 32);
        const float inv = 1.0f / l;
        __syncthreads();
#pragma unroll
        for (int n = 0; n < 16; ++n) { const int idx = tid + NTHREADS * n, row = idx >> 5, c8 = idx & 31; *(LAS u32x4*)(KL + row * 264 + c8 * 8) = st[n]; }
        __syncthreads();
#pragma unroll 4
        for (int dt = 0; dt < 16; ++dt) {
            f32x4 o4 = {0.f, 0.f, 0.f, 0.f};
            const LAS bf16_t* vp = KL + (dt * 16 + fr) * 264 + 4 * fq;
#pragma unroll
            for (int ksx = 0; ksx < 8; ++ksx) {
                const u32x2 lo = *(const LAS u32x2*)(vp + ksx * 32), hi = *(const LAS u32x2*)(vp + ksx * 32 + 16);
                u32x4 w; w.x = lo.x; w.y = lo.y; w.z = hi.x; w.w = hi.y;
                o4 = __builtin_amdgcn_mfma_f32_16x16x32_bf16(__builtin_bit_cast(bf16x8, w), pb[ksx], o4, 0, 0, 0);
            }
            u32x2 w; w.x = pk2(o4.x * inv, o4.y * inv); w.y = pk2(o4.z * inv, o4.w * inv);
            *(u32x2*)(O + (size_t)(q0 + fr) * 1024 + h * 256 + dt * 16 + 4 * fq) = w;
        }
    }
    __syncthreads();
}

typedef float f32x16 __attribute__((ext_vector_type(16)));
__device__ __forceinline__ void router_phase2(const Frame& F, int layer) {
    const int lane = lane_id_v(); const int tid = F.wave * 64 + lane; const int w = F.wave;
    const bf16_t* XBr = (const bf16_t*)(F.ws + WS_XB); const float* rw = (const float*)(F.ws + WS_RW) + (size_t)layer * 1024 * 32;
    const float* ssp = (const float*)(F.ws + WS_SSP);
    unsigned* cntwg = (unsigned*)(F.ws + WS_CNTWG);
    int* tokb = (int*)(F.ws + WS_ROUTE); int* tokp = tokb + NT; f32x4* tokg = (f32x4*)(tokp + NT);
    LAS float* T = (LAS float*)F.lds + w * (32 * 132);
    LAS float* Pp = (LAS float*)F.lds;
    LAS float* Lg = Pp + 8 * 64 * 33;
    LAS unsigned* lcnt = (LAS unsigned*)(Lg + 64 * 33);
    const int i31 = lane & 31, kh = lane >> 5, k0 = 128 * w;
    float bW[64];
#pragma unroll
    for (int s2 = 0; s2 < 64; ++s2) bW[s2] = rw[(size_t)(k0 + 2 * s2 + kh) * 32 + i31];
    unsigned rp0 = 0, rp1 = 0, rp2 = 0, rp3 = 0; if (PROBE_STAGE >= 10) rp0 = (unsigned)__builtin_amdgcn_s_memrealtime();
    for (int blk = F.wg; blk < NT / 64; blk += F.G) {
        const int r0 = blk * 64;
        f32x16 acc0, acc1;
#pragma unroll
        for (int e = 0; e < 16; ++e) { acc0[e] = 0.f; acc1[e] = 0.f; }
#pragma unroll
        for (int rt = 0; rt < 2; ++rt) {
#pragma unroll
            for (int n = 0; n < 16; ++n) { const int idx = lane + 64 * n, row = idx >> 5, c4 = idx & 31;
                const u32x2 rv = *(const u32x2*)(XBr + (size_t)(r0 + 32 * rt + row) * 1024 + k0 + 4 * c4);
                *(LAS f32x4*)(T + row * 132 + 4 * c4) = (f32x4){bf2f((unsigned short)(rv.x & 0xffffu)), bf2f((unsigned short)(rv.x >> 16)), bf2f((unsigned short)(rv.y & 0xffffu)), bf2f((unsigned short)(rv.y >> 16))}; }
            asm volatile("s_waitcnt lgkmcnt(0)" ::: "memory");
#pragma unroll
            for (int s2 = 0; s2 < 64; ++s2) {
                const float a0 = T[i31 * 132 + 2 * s2 + kh];
                if (rt == 0) acc0 = __builtin_amdgcn_mfma_f32_32x32x2f32(a0, bW[s2], acc0, 0, 0, 0);
                else acc1 = __builtin_amdgcn_mfma_f32_32x32x2f32(a0, bW[s2], acc1, 0, 0, 0);
            }
            asm volatile("s_waitcnt lgkmcnt(0)" ::: "memory");
        }
        __syncthreads();
        if (PROBE_STAGE >= 10) rp1 = (unsigned)__builtin_amdgcn_s_memrealtime();
#pragma unroll
        for (int e = 0; e < 16; ++e) { const int row = (e & 3) + 8 * (e >> 2) + 4 * kh;
            Pp[(w * 64 + row) * 33 + i31] = acc0[e]; Pp[(w * 64 + 32 + row) * 33 + i31] = acc1[e]; }
        __syncthreads();
        for (int idx = tid; idx < 64 * 32; idx += NTHREADS) { const int row = idx >> 5, cc = idx & 31; float a = 0.f;
#pragma unroll
            for (int ww = 0; ww < 8; ++ww) a += Pp[(ww * 64 + row) * 33 + cc];
            Lg[row * 33 + cc] = a; }
        if (tid < 24) lcnt[tid] = 0u;
        __syncthreads();
        if (PROBE_STAGE >= 10) rp2 = (unsigned)__builtin_amdgcn_s_memrealtime();
        if (tid < 64) {
            const int row = r0 + tid; const float rstd = row_rstd(ssp, row);
            const float* bg = F.in[IN_MOE_BG] + layer * 4; const float* be = F.in[IN_MOE_BE] + layer * 16;
            float lg[4], le[16];
#pragma unroll
            for (int c2 = 0; c2 < 4; ++c2) lg[c2] = Lg[tid * 33 + c2] * rstd + bg[c2];
#pragma unroll
            for (int c2 = 0; c2 < 16; ++c2) le[c2] = Lg[tid * 33 + 4 + c2] * rstd + be[c2];
            int gs = 0; float gm = lg[0];
#pragma unroll
            for (int c2 = 1; c2 < 4; ++c2) if (lg[c2] > gm) { gm = lg[c2]; gs = c2; }
            float gz = 0.f;
#pragma unroll
            for (int c2 = 0; c2 < 4; ++c2) gz += __expf(lg[c2] - gm);
            const float ggate = 1.0f / gz;
            float l4[4];
#pragma unroll
            for (int c2 = 0; c2 < 4; ++c2) { float v = le[c2];
#pragma unroll
                for (int g2 = 1; g2 < 4; ++g2) v = (gs == g2) ? le[4 * g2 + c2] : v;
                l4[c2] = v; }
            int i0 = 0; float m0 = l4[0];
#pragma unroll
            for (int c2 = 1; c2 < 4; ++c2) if (l4[c2] > m0) { m0 = l4[c2]; i0 = c2; }
            int i1 = -1; float m1 = -3.0e38f;
#pragma unroll
            for (int c2 = 0; c2 < 4; ++c2) if (c2 != i0 && l4[c2] > m1) { m1 = l4[c2]; i1 = c2; }
            const float e1 = __expf(m1 - m0); const float g0 = ggate / (1.f + e1), g1 = ggate * e1 / (1.f + e1);
            const int ia = i0 < i1 ? i0 : i1, ib = i0 < i1 ? i1 : i0;
            const float ga = i0 < i1 ? g0 : g1, gb = i0 < i1 ? g1 : g0;
            const int pidx = (ia == 0) ? (ib - 1) : (ia == 1 ? ib + 1 : 5);
            const int bucket = gs * 6 + pidx;
            const unsigned pos = __hip_atomic_fetch_add(&lcnt[bucket], 1u, __ATOMIC_RELAXED, __HIP_MEMORY_SCOPE_WORKGROUP);
            tokb[row] = bucket; tokp[row] = (int)pos; tokg[row] = (f32x4){rstd, ga, gb, 0.f};
        }
        __syncthreads();
        if (tid < 24) cntwg[blk * 24 + tid] = lcnt[tid];
        if (PROBE_STAGE >= 10) rp3 = (unsigned)__builtin_amdgcn_s_memrealtime();
    }
    if (PROBE_STAGE >= 10 && layer == 0 && F.wg == 0 && w == 0 && lane == 0) __hip_atomic_store((unsigned*)(F.ws + WS_CTL + 20484), PROBE_STAGE == 10 ? rp1 - rp0 : (PROBE_STAGE == 11 ? rp2 - rp1 : rp3 - rp2), __ATOMIC_RELAXED, __HIP_MEMORY_SCOPE_AGENT);
}
__device__ __forceinline__ void gather_phase(const Frame& F, int layer) {
    const int lane = lane_id_v(); const int tid = F.wave * 64 + lane; (void)tid;
    const int* tokb = (const int*)(F.ws + WS_ROUTE); const int* tokp = tokb + NT; const f32x4* tokg = (const f32x4*)(tokp + NT); f32x4* rowinfo = (f32x4*)(tokg + NT);
    const bf16_t* XB = (const bf16_t*)(F.ws + WS_XB); bf16_t* XG = (bf16_t*)(F.ws + WS_BIG + BIG_XG);
    LAS int* off = (LAS int*)F.lds;
    LAS int* tot = off + 32;
    LAS int* offs = off + 64;
    const unsigned* cntwg = (const unsigned*)(F.ws + WS_CNTWG);
    if (tid < 24) { int run = 0;
        for (int blk = 0; blk < 256; ++blk) { offs[blk * 24 + tid] = run; run += (int)cntwg[blk * 24 + tid]; }
        tot[tid] = run;
        if (F.wg == 0) ((unsigned*)(F.ws + WS_CNT))[layer * 32 + tid] = (unsigned)run; }
    __syncthreads();
    if (tid == 0) { int acc = 0; for (int b = 0; b < 24; ++b) { off[b] = acc * 256; acc += (tot[b] + 255) >> 8; } }
    __syncthreads();
    const int gw = F.wg * NWAVES + F.wave, NGW = F.G * NWAVES;
    for (int tok = gw; tok < NT; tok += NGW) {
        const int bk = tokb[tok]; const int row = off[bk] + offs[(tok >> 6) * 24 + bk] + tokp[tok];
        if (lane == 0) { f32x4 g = tokg[tok]; g.w = __int_as_float(tok); rowinfo[row] = g; }
    }
    __syncthreads();
}
__device__ __forceinline__ void final_phase(const Frame& F) {
    const int lane = lane_id_v();
    float* out = F.out; const bf16_t* XBr = (const bf16_t*)(F.ws + WS_XB); const float* gain = F.in[IN_NORM_FINAL];
    const int gw = F.wg * NWAVES + F.wave, NGW = F.G * NWAVES;
    for (int row = gw; row < NT; row += NGW) {
        const u32x2* xr = (const u32x2*)(XBr + (size_t)row * 1024) + lane;
        f32x4 v[4]; float s = 0.f;
#pragma unroll
        for (int j = 0; j < 4; ++j) { const u32x2 r = xr[64 * j]; v[j] = (f32x4){bf2f((unsigned short)(r.x & 0xffffu)), bf2f((unsigned short)(r.x >> 16)), bf2f((unsigned short)(r.y & 0xffffu)), bf2f((unsigned short)(r.y >> 16))};
            s += (v[j].x * v[j].x + v[j].y * v[j].y) + (v[j].z * v[j].z + v[j].w * v[j].w); }
        s = wsum(s);
        const float rstd = 1.0f / sqrtf(s * (1.0f / 1024.0f) + 1e-6f);
        f32x4* orow = (f32x4*)(out + (size_t)row * 1024) + lane;
#pragma unroll
        for (int j = 0; j < 4; ++j) { const f32x4 g = *(const f32x4*)(gain + 4 * lane + 256 * j); orow[64 * j] = v[j] * rstd * g; }
    }
}

constexpr int N_PHASES = 24;
#ifndef PH_MASK
#define PH_MASK 0xFFFFFFFFu
#endif
#define IN(k) (((PH_MASK >> ((k) > 11 ? (k) - 11 : (k))) & 1u) && lo <= (k) && (k) < hi)
#define TS_STAMP(k) do { if (TS_A >= 0 && ((k) == TS_A || (k) == TS_B) && F.wg == 0 && F.wave == 0 && lane_id_v() == 0) ((volatile LAS unsigned*)(F.lds + LDS_MISC + 1024))[(k)] = (unsigned)__builtin_amdgcn_s_memrealtime(); } while (0)
#define SEAM(k) do { if (IN(k) && IN((k) + 1)) xcd_barrier(bar); TS_STAMP((k) + 1); } while (0)
#define SEAM2(k) do { if (IN(k) && IN((k) + 2)) xcd_barrier(bar); TS_STAMP((k) + 2); } while (0)

template <int LAYER>
__device__ __forceinline__ void layer_phases(const Frame& F, const XcdBarrier& bar, const int lo, const int hi) {
    constexpr int pb = LAYER * 11;
    unsigned char* const ws = F.ws;
#define WPTR(off) ((bf16_t*)(ws + (LAYER ? WS_W1 : WS_W0)) + (off))
#define XB_ ((bf16_t*)(ws + WS_XB))
#define SSP_ ((float*)(ws + WS_SSP))
#define PROJ_ ((bf16_t*)(ws + WS_BIG + BIG_PROJ))
#define KB_ (LAYER ? (bf16_t*)(ws + WS_W0) : (bf16_t*)(ws + WS_BIG + BIG_KV0))
#define VT_ (KB_ + (size_t)2048 * 1024)
#define QB_ ((bf16_t*)(ws + WS_BIG + BIG_Q))
#define ATT_ ((bf16_t*)(ws + WS_BIG + BIG_ATT))
#define XG_ ((bf16_t*)(ws + WS_BIG + BIG_XG))
#define HID_ ((bf16_t*)(ws + WS_BIG + BIG_HID))
#define CNT_ ((const unsigned*)(ws + WS_CNT) + LAYER * 32)
#define ROWINFO_ ((const f32x4*)(ws + WS_ROUTE + (size_t)NT * 8 + (size_t)NT * 16))
    if (IN(pb + 1)) {
        if (LAYER == 0) {
            pg8::Gemm g{1024, 1024, 1024, 1 << 20, nullptr, nullptr}; pg8::DenseSched S; S.init(NT, 3840, F.G, F.wg, XB_, 1024, WPTR(WO_WIN), 1024);
            EpiScale<0> E{PROJ_, P0LD, SSP_, 1.0f, nullptr, (bf16_t*)(ws + WS_HALOB)};
            pg8::gemm_phase(F.lds, F.wave, g, S, E);
            { pg8::Gemm g2{1024, 1024, 1024, 1 << 20, nullptr, nullptr}; pg8::DenseSched S2; S2.init(2048, 2048, F.G, F.wg, (const bf16_t*)(ws + WS_MEMH), 1024, WPTR(WO_WKV), 1024);
              EpiKV E2{KB_, VT_}; pg8::gemm_phase(F.lds, F.wave, g2, S2, E2); }
        } else {
            pg8::Gemm g{1024, 1024, 1024, 1 << 20, nullptr, nullptr}; pg8::DenseSched S; S.init(NT, 4096, F.G, F.wg, XB_, 1024, WPTR(WO_WIN), 1024);
            EpiScale<1> E{PROJ_, P1LD, SSP_, 1.0f, (const float*)(ws + WS_LB), nullptr};
            pg8::gemm_phase(F.lds, F.wave, g, S, E);
        }
    }
    SEAM(pb + 1);
    if (IN(pb + 2)) {
        unsigned pt0 = 0; if (PROBE_WG >= 0 && LAYER == 0) pt0 = (unsigned)__builtin_amdgcn_s_memrealtime();
        if (LAYER == 0) {
#ifndef NO_DELTA
            if (F.wg < 96) { const int st = F.wg & 31; scan_delta3(F, st >> 2, st & 3, F.wg >> 5, 3); }
#endif
#ifndef NO_RWKV
            if (F.wg >= 96 && F.wg < 224) { const int q = F.wg - 96, st = ((q >> 4) << 3) | (q & 7), par = (q >> 3) & 1; scan_rwkv3(F, st >> 3, st & 7, par); }
#endif
            if (F.wg >= 224) p0_late_weights<0>(F, F.wg - 224, F.G - 224);
        } else {
#ifndef NO_HGRN
            { const int st = F.wg & 63; scan_hgrn3(F, st >> 3, st & 7, F.wg >> 6, 4); }
#endif
            p0_late_weights<1>(F, F.wg, F.G);
        }
        if (PROBE_WG >= 0 && LAYER == 0 && F.wg == PROBE_WG && F.wave == 0 && lane_id_v() == 0) __hip_atomic_store((unsigned*)(F.ws + WS_CTL + 20480), (unsigned)__builtin_amdgcn_s_memrealtime() - pt0, __ATOMIC_RELAXED, __HIP_MEMORY_SCOPE_AGENT);
    }
    SEAM2(pb + 2);
    if (IN(pb + 4)) {
        constexpr int lda = LAYER ? P1LD : P0LD; const bf16_t* A = PROJ_ + (LAYER ? 3072 : 1536);
        pg8::Gemm g{lda, 1024, 1024, 1 << 20, nullptr, nullptr}; pg8::DenseSched S; S.init(NT, 1024, F.G, F.wg, A, lda, WPTR(WO_WOUT), 1024);
        EpiResid<false> E{LAYER ? (const float*)nullptr : F.in[IN_X], XB_, SSP_, nullptr};
        pg8::gemm_phase(F.lds, F.wave, g, S, E);
    }
    SEAM(pb + 4);
    if (IN(pb + 5)) {
        pg8::Gemm g{1024, 1024, 1024, 1 << 20, nullptr, nullptr}; pg8::DenseSched S; S.init(NT, 1024, F.G, F.wg, XB_, 1024, WPTR(WO_WQ), 1024);
        EpiScale<0> E{QB_, 1024, SSP_, 0.0625f, nullptr, nullptr};
        pg8::gemm_phase(F.lds, F.wave, g, S, E);
    }
    SEAM(pb + 5);
    if (IN(pb + 6)) attn_phase2(F, QB_, KB_, VT_, ATT_);
    SEAM(pb + 6);
    if (IN(pb + 7)) {
        pg8::Gemm g{1024, 1024, 1024, 1 << 20, nullptr, nullptr}; pg8::DenseSched S; S.init(NT, 1024, F.G, F.wg, ATT_, 1024, WPTR(WO_WO), 1024);
        EpiResid<false> E{nullptr, XB_, SSP_, nullptr};
        pg8::gemm_phase(F.lds, F.wave, g, S, E);
    }
    SEAM(pb + 7);
    if (IN(pb + 8)) router_phase2(F, LAYER);
    SEAM(pb + 8);
    if (IN(pb + 9)) gather_phase(F, LAYER);
    SEAM(pb + 9);
    if (IN(pb + 10)) {
        if (LAYER == 0 && F.wg >= 192) {
            pg8::Gemm g2{1024, 1024, 1024, 1 << 20, nullptr, nullptr}; pg8::DenseSched S2; S2.init(2048, 2048, 64, F.wg - 192, (const bf16_t*)(ws + WS_MEMH), 1024, (const bf16_t*)(ws + WS_W1) + WO_WKV, 1024);
            EpiKV E2{(bf16_t*)(ws + WS_KV1), (bf16_t*)(ws + WS_KV1) + (size_t)2048 * 1024}; pg8::gemm_phase(F.lds, F.wave, g2, S2, E2); }
        LAS int* tbl = (LAS int*)(F.lds + LDS_MISC + 512); moe_build_table(tbl, CNT_, F.wave * 64 + lane_id_v());
        pg8::Gemm g{1024, 1024, 1024, 1 << 20, (const char*)XB_, (const float*)ROWINFO_}; MoeSched<false> S{tbl, __builtin_amdgcn_readfirstlane(tbl[95]), F.G, F.wg, (const char*)XB_, (const char*)WPTR(WO_W13)};
        EpiMoeUp E{HID_, ROWINFO_};
        pg8::gemm_phase<EpiMoeUp, MoeSched<false>, true>(F.lds, F.wave, g, S, E);
    }
    SEAM(pb + 10);
    if (IN(pb + 11)) {
        LAS int* tbl = (LAS int*)(F.lds + LDS_MISC + 512); moe_build_table(tbl, CNT_, F.wave * 64 + lane_id_v());
        pg8::Gemm g{512, 256, 512, 4, nullptr, nullptr}; MoeSched<true> S{tbl, __builtin_amdgcn_readfirstlane(tbl[95]), F.G, F.wg, (const char*)HID_, (const char*)WPTR(WO_W2T)};
        EpiResid<true> E{nullptr, XB_, SSP_, ROWINFO_};
        pg8::gemm_phase(F.lds, F.wave, g, S, E);
    }
    SEAM(pb + 11);
}

__global__ void __launch_bounds__(NTHREADS, 2) fwd_mega(Args args) {
    extern __shared__ __attribute__((aligned(16))) unsigned char lds_raw[];
    Frame F;
    F.lds = (LAS unsigned char*)lds_raw;
    const int tid = threadIdx.x; F.wave = __builtin_amdgcn_readfirstlane(tid >> 6);
    F.G = gridDim.x; F.wg = blockIdx.x;
    F.out = args.out; F.ws = args.ws;
    volatile LAS unsigned* MISC = (volatile LAS unsigned*)(F.lds + LDS_MISC);
    LAS unsigned long long* tab = (LAS unsigned long long*)(F.lds + LDS_MISC + 64);
    F.in.t = tab;
    if (tid < 16) MISC[tid] = 0u;
    if (tid == 0) {
#pragma unroll
        for (int i = 0; i < 38; ++i) tab[i] = (unsigned long long)args.in[i];
    }
    __syncthreads();
    XcdBarrier bar; bar.bar = (unsigned*)(F.ws + WS_CTL); bar.x = 0; bar.st = MISC; bar.wave = F.wave;
#if N_LAUNCH_MODE == 1
    bar = xcd_barrier_post((unsigned*)(F.ws + WS_CTL), MISC, F.wave);
#endif
    const int lo = args.ph_lo, hi = args.ph_hi;
    TS_STAMP(0);
    if (IN(0)) { p0_prologue(F); }
    SEAM(0);
    layer_phases<0>(F, bar, lo, hi);
    layer_phases<1>(F, bar, lo, hi);
    if (IN(23)) final_phase(F);
#ifdef EXTRA_BARS
    for (int eb = 0; eb < EXTRA_BARS; ++eb) xcd_barrier(bar);
#endif
    if (TS_A >= 0 && F.wg == 0 && F.wave == 0) {
        asm volatile("s_waitcnt vmcnt(0)" ::: "memory");
        if (lane_id_v() == 0) { volatile LAS unsigned* ts = (volatile LAS unsigned*)(F.lds + LDS_MISC + 1024);
            float us = (float)(ts[TS_B] - ts[TS_A]) * 0.01f;
            if (PROBE_WG >= 0) us = (float)__hip_atomic_load((unsigned*)(F.ws + WS_CTL + 20480), __ATOMIC_RELAXED, __HIP_MEMORY_SCOPE_AGENT) * 0.01f;
            if (PROBE_STAGE >= 0) us = (float)__hip_atomic_load((unsigned*)(F.ws + WS_CTL + 20484), __ATOMIC_RELAXED, __HIP_MEMORY_SCOPE_AGENT) * 0.01f;
            F.out[0] = F.out[0] + us * TS_SCALE; }
    }
}
#undef IN
#undef SEAM

extern "C" void kernel_launch(void* const* d_in, const int* in_sizes, int n_in, void* d_out, int out_size, void* d_ws, size_t ws_size, hipStream_t stream) {
    static int grid = 0;
    if (grid == 0) {
        if (n_in != 38 || out_size != NT * DM || ws_size < WS_END) { fprintf(stderr, "kernel_launch: unexpected problem (n_in %d out %d ws %zu)\n", n_in, out_size, ws_size); grid = -1; return; }
        int dev = 0, cus = 0, per_cu = 0;
        if (hipGetDevice(&dev) != hipSuccess || hipDeviceGetAttribute(&cus, hipDeviceAttributeMultiprocessorCount, dev) != hipSuccess) { grid = -1; return; }
        if (hipFuncSetAttribute((const void*)fwd_mega, hipFuncAttributeMaxDynamicSharedMemorySize, LDS_BYTES) != hipSuccess) { fprintf(stderr, "kernel_launch: hipFuncSetAttribute failed\n"); grid = -1; return; }
        if (hipOccupancyMaxActiveBlocksPerMultiprocessor(&per_cu, (const void*)fwd_mega, NTHREADS, LDS_BYTES) != hipSuccess || per_cu < 1) { fprintf(stderr, "kernel_launch: occupancy query says %d\n", per_cu); (void)hipGetLastError(); grid = -1; return; }
        grid = cus;
    }
    if (grid < 0) return;
    (void)hipMemsetAsync((char*)d_ws + WS_CTL, 0, 32768, stream);
    Args a{};
    for (int i = 0; i < 38; ++i) a.in[i] = (const float*)d_in[i];
    a.out = (float*)d_out; a.ws = (unsigned char*)d_ws;
#if N_LAUNCH_MODE == 1
    a.ph_lo = 0; a.ph_hi = N_PHASES;
    void* kargs[] = {&a};
    hipError_t e = hipLaunchCooperativeKernel((const void*)fwd_mega, dim3(grid), dim3(NTHREADS), kargs, LDS_BYTES, stream);
    if (e != hipSuccess) fprintf(stderr, "kernel_launch: cooperative launch failed: %s\n", hipGetErrorString(e));
#else
    for (int p = 0; p < N_PHASES; ++p) { a.ph_lo = p; a.ph_hi = p + 1; hipLaunchKernelGGL(fwd_mega, dim3(grid), dim3(NTHREADS), LDS_BYTES, stream, a); }
#endif
}
```
